# Optimizing an MI355X kernel written in HIP

```python
import jax, jax.numpy as jnp
from jax import lax
import numpy as np

D_MODEL = 1024
BATCH = 16
SEQ = 2048
DEPTH = 2

EPS = 1e-6
SB_HEADS = 8
SB_HEAD_DIM = D_MODEL // 16
SB_WIDTH = SB_HEADS * SB_HEAD_DIM
SB_BLOCK = 128
GLA_HEADS = 4
GLA_DV = D_MODEL // 8
GLA_DK = GLA_DV // 2
GLA_KW = GLA_HEADS * GLA_DK
GLA_VW = GLA_HEADS * GLA_DV
GLA_GATE_RANK = 16
GLA_GATE_NORM = 16.0
GLA_CHUNK = 64
AB_SPLITS = [SB_WIDTH, 2 * SB_WIDTH, 3 * SB_WIDTH,
             3 * SB_WIDTH + GLA_KW, 3 * SB_WIDTH + 2 * GLA_KW,
             3 * SB_WIDTH + 2 * GLA_KW + GLA_VW,
             3 * SB_WIDTH + 2 * GLA_KW + 2 * GLA_VW]
AB_IN = 3 * SB_WIDTH + 2 * GLA_KW + 2 * GLA_VW + GLA_GATE_RANK
AB_MIX = SB_WIDTH + GLA_VW
SGU_WIDTH = 2 * D_MODEL
SGU_GROUPS = 8
SGU_GROUP_DIM = SGU_WIDTH // SGU_GROUPS
SGU_CHUNK = 128
PEER_HEADS = 8
PEER_TOPK = 16
N_KEYS = 128
N_EXPERTS = N_KEYS * N_KEYS
PEER_QDIM = 256
PEER_QHALF = PEER_QDIM // 2
PEER_TOKEN_BLOCK = 128

kernel_name = "hybrid_sb_gla_sgu_peer"


def rmsnorm(x, g):
    xf = x.astype(jnp.float32)
    y = xf * lax.rsqrt(jnp.mean(xf * xf, axis=-1, keepdims=True) + EPS)
    return (y * g.astype(jnp.float32)).astype(x.dtype)


def stick_breaking(q, k, v):
    b_, h_, s_, dh = q.shape
    nb = s_ // SB_BLOCK
    qb = q.astype(jnp.float32).reshape(b_, h_, nb, SB_BLOCK, dh).transpose(2, 0, 1, 3, 4)
    kf = k.astype(jnp.float32)
    vf = v.astype(jnp.float32)
    key_pos = jnp.arange(s_)
    scale = dh ** -0.5

    def one_block(args):
        qi, start = args
        z = jnp.einsum('bhqd,bhkd->bhqk', qi, kf) * scale
        q_pos = start + jnp.arange(SB_BLOCK)
        mask = key_pos[None, :] < q_pos[:, None]
        log_stay = jnp.where(mask, jax.nn.log_sigmoid(-z), 0.0)
        suffix = lax.cumsum(log_stay, axis=3, reverse=True) - log_stay
        a = jnp.where(mask, jnp.exp(jax.nn.log_sigmoid(z) + suffix), 0.0)
        return jnp.einsum('bhqk,bhkd->bhqd', a, vf)

    out = lax.map(one_block, (qb, jnp.arange(nb) * SB_BLOCK))
    return out.transpose(1, 0, 3, 2, 4).reshape(b_, s_, h_ * dh)


def gla(q, k, v, log_a):
    b_, h_, s_, dk = q.shape
    dv = v.shape[-1]
    n = s_ // GLA_CHUNK

    def ch(t):
        return t.reshape(b_, h_, n, GLA_CHUNK, t.shape[-1])

    q, k, v, log_a = ch(q), ch(k), ch(v), ch(log_a)
    bcum = jnp.cumsum(log_a, axis=3)
    q_in = q * (dk ** -0.5) * jnp.exp(bcum)
    k_in = k * jnp.exp(-bcum)
    causal = jnp.tril(jnp.ones((GLA_CHUNK, GLA_CHUNK), dtype=bool))
    scores = jnp.where(causal, jnp.einsum('bhnqd,bhnkd->bhnqk', q_in, k_in), 0.0)
    o_intra = jnp.einsum('bhnqk,bhnke->bhnqe', scores, v)
    b_last = bcum[:, :, :, -1:, :]
    kv = jnp.einsum('bhnkd,bhnke->bhnde', k * jnp.exp(b_last - bcum), v)
    decay = jnp.exp(b_last[:, :, :, 0, :])

    def step(state, inp):
        dec, kv_c = inp
        return dec[..., None] * state + kv_c, state

    init = jnp.zeros((b_, h_, dk, dv), jnp.float32)
    _, prev = lax.scan(step, init, (jnp.moveaxis(decay, 2, 0), jnp.moveaxis(kv, 2, 0)))
    prev = jnp.moveaxis(prev, 0, 2)
    o = o_intra + jnp.einsum('bhnqd,bhnde->bhnqe', q_in, prev)
    return o.reshape(b_, h_, s_, dv)


def layer_ab(h, w_in, w_alpha2, b_alpha2, gla_norm, w_out):
    b_, s_, _ = h.shape
    p = h @ w_in
    q_sb, k_sb, v_sb, q_g, k_g, v_g, g_g, a_lr = jnp.split(p, AB_SPLITS, axis=-1)

    def heads(t, nh):
        return t.reshape(b_, s_, nh, -1).transpose(0, 2, 1, 3)

    o_sb = stick_breaking(heads(q_sb, SB_HEADS), heads(k_sb, SB_HEADS), heads(v_sb, SB_HEADS))

    log_a = jax.nn.log_sigmoid((a_lr @ w_alpha2 + b_alpha2).astype(jnp.float32)) / GLA_GATE_NORM
    f32 = jnp.float32
    o_g = gla(heads(q_g, GLA_HEADS).astype(f32), heads(k_g, GLA_HEADS).astype(f32),
              heads(v_g, GLA_HEADS).astype(f32), heads(log_a, GLA_HEADS))
    o_g = o_g * lax.rsqrt(jnp.mean(o_g * o_g, axis=-1, keepdims=True) + EPS)
    o_g = o_g.transpose(0, 2, 1, 3).reshape(b_, s_, GLA_VW) * gla_norm.astype(f32)
    o_g = o_g * jax.nn.silu(g_g.astype(f32))

    mix = jnp.concatenate([o_sb, o_g], axis=-1).astype(h.dtype)
    return mix @ w_out


def layer_c(h, w_in, v_norm, w_spatial, b_spatial, w_out):
    b_, s_, _ = h.shape
    n = s_ // SGU_CHUNK
    z = jax.nn.gelu(h @ w_in, approximate=False)
    u, v = jnp.split(z, 2, axis=-1)
    v = rmsnorm(v, v_norm).reshape(b_, n, SGU_CHUNK, SGU_GROUPS, SGU_GROUP_DIM)
    causal = jnp.tril(jnp.ones((SGU_CHUNK, SGU_CHUNK), dtype=bool))
    w = jnp.where(causal[None], w_spatial, 0.0)
    mixed = jnp.einsum('gts,bnsgc->bntgc', w, v) + b_spatial.T[:, :, None]
    return (u * mixed.reshape(b_, s_, SGU_WIDTH)) @ w_out


def peer(h, w_q, subkeys, u_tab, v_tab):
    b_, s_, d = h.shape
    t_ = b_ * s_
    hf = h.reshape(t_, d)
    q = (hf @ w_q).astype(jnp.float32).reshape(t_, PEER_HEADS, 2, PEER_QHALF)
    scores = jnp.einsum('thpd,hpnd->thpn', q, subkeys.astype(jnp.float32))
    top_s, top_i = lax.top_k(scores, PEER_TOPK)
    cand_s = (top_s[:, :, 0, :, None] + top_s[:, :, 1, None, :]).reshape(t_, PEER_HEADS, -1)
    cand_i = (top_i[:, :, 0, :, None] * N_KEYS + top_i[:, :, 1, None, :]).reshape(t_, PEER_HEADS, -1)
    best_s, pos = lax.top_k(cand_s, PEER_TOPK)
    idx = jnp.take_along_axis(cand_i, pos, axis=-1)
    gate = jax.nn.softmax(best_s, axis=-1)

    nblk = t_ // PEER_TOKEN_BLOCK
    xb = hf.reshape(nblk, PEER_TOKEN_BLOCK, d)
    ib = idx.reshape(nblk, PEER_TOKEN_BLOCK, PEER_HEADS * PEER_TOPK)
    gb = gate.reshape(nblk, PEER_TOKEN_BLOCK, PEER_HEADS * PEER_TOPK)

    def expert_block(args):
        xi, ii, gi = args
        u_sel = u_tab[ii]
        act = jax.nn.gelu(jnp.einsum('td,tkd->tk', xi, u_sel).astype(jnp.float32), approximate=False)
        w = (gi * act).astype(v_tab.dtype)
        return jnp.einsum('tk,tkd->td', w, v_tab[ii])

    out = lax.map(expert_block, (xb, ib, gb))
    return out.reshape(b_, s_, d).astype(h.dtype)


def setup_inputs(seed: int = 0) -> dict:
    key = jax.random.key(seed)
    ks = jax.random.split(key, 20)
    n_even = (DEPTH + 1) // 2
    n_odd = DEPTH // 2
    nrm = jax.random.normal
    f32 = jnp.float32
    return {
        "x": nrm(ks[0], (BATCH, SEQ, D_MODEL), f32),
        "norm_mix": 1.0 + 0.02 * nrm(ks[1], (DEPTH, D_MODEL), f32),
        "norm_ffn": 1.0 + 0.02 * nrm(ks[2], (DEPTH, D_MODEL), f32),
        "ab_w_in": nrm(ks[3], (n_even, D_MODEL, AB_IN), f32) * D_MODEL ** -0.5,
        "ab_w_alpha2": nrm(ks[4], (n_even, GLA_GATE_RANK, GLA_KW), f32) * GLA_GATE_RANK ** -0.5,
        "ab_b_alpha2": 0.1 * nrm(ks[5], (n_even, GLA_KW), f32),
        "ab_gla_norm": 1.0 + 0.02 * nrm(ks[6], (n_even, GLA_VW), f32),
        "ab_w_out": nrm(ks[7], (n_even, AB_MIX, D_MODEL), f32) * AB_MIX ** -0.5,
        "c_w_in": nrm(ks[8], (n_odd, D_MODEL, 2 * SGU_WIDTH), f32) * D_MODEL ** -0.5,
        "c_v_norm": 1.0 + 0.02 * nrm(ks[9], (n_odd, SGU_WIDTH), f32),
        "c_w_spatial": nrm(ks[10], (n_odd, SGU_GROUPS, SGU_CHUNK, SGU_CHUNK), f32) * SGU_CHUNK ** -0.5,
        "c_b_spatial": 1.0 + 0.02 * nrm(ks[11], (n_odd, SGU_GROUPS, SGU_CHUNK), f32),
        "c_w_out": nrm(ks[12], (n_odd, SGU_WIDTH, D_MODEL), f32) * SGU_WIDTH ** -0.5,
        "peer_w_q": nrm(ks[13], (DEPTH, D_MODEL, PEER_HEADS * PEER_QDIM), f32) * D_MODEL ** -0.5,
        "peer_subkeys": nrm(ks[14], (DEPTH, PEER_HEADS, 2, N_KEYS, PEER_QHALF), f32) * PEER_QHALF ** -0.5,
        "peer_u": nrm(ks[15], (DEPTH, N_EXPERTS, D_MODEL), f32) * D_MODEL ** -0.5,
        "peer_v": nrm(ks[16], (DEPTH, N_EXPERTS, D_MODEL), f32) * PEER_HEADS ** -0.5,
        "final_norm": 1.0 + 0.02 * nrm(ks[17], (D_MODEL,), f32),
    }


def reference(x, norm_mix, norm_ffn, ab_w_in, ab_w_alpha2, ab_b_alpha2, ab_gla_norm, ab_w_out,
              c_w_in, c_v_norm, c_w_spatial, c_b_spatial, c_w_out,
              peer_w_q, peer_subkeys, peer_u, peer_v, final_norm):
    for i in range(DEPTH):
        j = i // 2
        h = rmsnorm(x, norm_mix[i])
        if i % 2 == 0:
            x = x + layer_ab(h, ab_w_in[j], ab_w_alpha2[j], ab_b_alpha2[j], ab_gla_norm[j], ab_w_out[j])
        else:
            x = x + layer_c(h, c_w_in[j], c_v_norm[j], c_w_spatial[j], c_b_spatial[j], c_w_out[j])
        x = x + peer(rmsnorm(x, norm_ffn[i]), peer_w_q[i], peer_subkeys[i], peer_u[i], peer_v[i])
    return rmsnorm(x, final_norm)
```

```cpp
#include <hip/hip_runtime.h>
#include <hip/hip_cooperative_groups.h>
#include <cstdio>
#include <cstdint>
namespace cg = cooperative_groups;

#ifndef ONE_LAUNCH
#define ONE_LAUNCH 0
#endif

typedef unsigned short bf16_t;
typedef short bf16x8 __attribute__((ext_vector_type(8)));
typedef float f32x4 __attribute__((ext_vector_type(4)));
typedef __bf16 bf16x2_t __attribute__((ext_vector_type(2)));

constexpr int T = 32768, D = 1024, SEQ = 2048, NB = 16;
constexpr int AB_IN = 3088, AB_IN_PAD = 3200;
constexpr float EPS = 1e-6f;
constexpr int NEXP = 16384;

constexpr size_t SZ_WT_IN = (size_t)AB_IN_PAD * 1024 * 2;
constexpr size_t SZ_WT_OUT = (size_t)1024 * 1024 * 2;
constexpr size_t SZ_WT_CIN = (size_t)4096 * 1024 * 2;
constexpr size_t SZ_WT_COUT = (size_t)1024 * 2048 * 2;
constexpr size_t SZ_WT_Q = (size_t)2 * 2048 * 1024 * 2;
constexpr size_t SZ_SK = (size_t)2 * 8 * 2 * 128 * 128 * 2;
constexpr size_t SZ_TAB = (size_t)2 * NEXP * 1024 * 2;
constexpr size_t OFF_WT_IN = 0;
constexpr size_t OFF_WT_OUT = OFF_WT_IN + SZ_WT_IN;
constexpr size_t OFF_WT_CIN = OFF_WT_OUT + SZ_WT_OUT;
constexpr size_t OFF_WT_COUT = OFF_WT_CIN + SZ_WT_CIN;
constexpr size_t OFF_WT_Q = OFF_WT_COUT + SZ_WT_COUT;
constexpr size_t OFF_SK = OFF_WT_Q + SZ_WT_Q;
constexpr size_t OFF_UT = OFF_SK + SZ_SK;
constexpr size_t OFF_VT = OFF_UT + SZ_TAB;
constexpr size_t OFF_H = OFF_VT + SZ_TAB;
constexpr size_t OFF_IDX = OFF_H + (size_t)T * 1024 * 2;
constexpr size_t OFF_GATE = OFF_IDX + (size_t)T * 128 * 2;
constexpr size_t OFF_SSQ = OFF_GATE + (size_t)T * 128 * 4;
constexpr size_t OFF_REGION = OFF_SSQ + (size_t)T * 32 * 4;
constexpr size_t SZ_REGION = (size_t)256 << 20;
constexpr size_t WS_END = OFF_REGION + SZ_REGION;
constexpr size_t R_QSB = 0;
constexpr size_t R_KSB = R_QSB + (size_t)T * 512;
constexpr size_t R_VTSB = R_KSB + (size_t)T * 512;
constexpr size_t R_QG = R_VTSB + (size_t)T * 512;
constexpr size_t R_KG = R_QG + (size_t)T * 256;
constexpr size_t R_VTG = R_KG + (size_t)T * 256;
constexpr size_t R_GG = R_VTG + (size_t)T * 512;
constexpr size_t R_ALR = R_GG + (size_t)T * 512;

struct Params {
    const float* x; const float* norm_mix; const float* norm_ffn; const float* ab_w_in; const float* ab_w_alpha2; const float* ab_b_alpha2;
    const float* ab_gla_norm; const float* ab_w_out; const float* c_w_in; const float* c_v_norm; const float* c_w_spatial; const float* c_b_spatial;
    const float* c_w_out; const float* peer_w_q; const float* peer_subkeys; const float* peer_u; const float* peer_v; const float* final_norm;
    float* out; unsigned char* ws;
};

__device__ __forceinline__ float bf2f(bf16_t v) { return __uint_as_float(((unsigned)v) << 16); }
__device__ __forceinline__ bf16_t f2bf(float f) { unsigned u = __float_as_uint(f); u += 0x7fffu + ((u >> 16) & 1u); return (bf16_t)(u >> 16); }
__device__ __forceinline__ unsigned pack2(float lo, float hi) { return (unsigned)f2bf(lo) | ((unsigned)f2bf(hi) << 16); }
__device__ __forceinline__ float lo2f(unsigned w) { return __uint_as_float(w << 16); }
__device__ __forceinline__ float hi2f(unsigned w) { return __uint_as_float(w & 0xffff0000u); }
__device__ __forceinline__ float dot2(unsigned a, unsigned b, float acc) { return __builtin_amdgcn_fdot2_f32_bf16(__builtin_bit_cast(bf16x2_t, a), __builtin_bit_cast(bf16x2_t, b), acc, false); }
__device__ __forceinline__ float gelu_exact(float v) { return 0.5f * v * (1.0f + erff(v * 0.70710678118654752f)); }
__device__ __forceinline__ float wave_sum(float v) {
#pragma unroll
    for (int o = 32; o >= 1; o >>= 1) v += __shfl_xor(v, o);
    return v;
}

__device__ __forceinline__ void transpose_convert(const float* __restrict__ W, bf16_t* __restrict__ Wt, int K, int N, int Npad, char* smem) {
    float* tile = (float*)smem;
    const int tk = K / 64, tn = Npad / 64, ntile = tk * tn;
    const int tid = threadIdx.x;
    for (int tl = blockIdx.x; tl < ntile; tl += gridDim.x) {
        const int k0 = (tl % tk) * 64, n0 = (tl / tk) * 64;
        const int c = tid & 63, r0 = tid >> 6;
#pragma unroll
        for (int i = 0; i < 16; ++i) {
            const int r = r0 + 4 * i;
            const float v = (n0 + c < N) ? W[(size_t)(k0 + r) * N + n0 + c] : 0.f;
            tile[c * 65 + r] = v;
        }
        __syncthreads();
#pragma unroll
        for (int i = 0; i < 16; ++i) {
            const int n = r0 + 4 * i;
            Wt[(size_t)(n0 + n) * K + k0 + c] = f2bf(tile[n * 65 + c]);
        }
        __syncthreads();
    }
}
__device__ __forceinline__ void convert_flat(const float* __restrict__ src, bf16_t* __restrict__ dst, size_t n) {
    const size_t nv = n / 8;
    for (size_t i = (size_t)blockIdx.x * blockDim.x + threadIdx.x; i < nv; i += (size_t)gridDim.x * blockDim.x) {
        const float4 a = ((const float4*)src)[2 * i], b = ((const float4*)src)[2 * i + 1];
        uint4 o; o.x = pack2(a.x, a.y); o.y = pack2(a.z, a.w); o.z = pack2(b.x, b.y); o.w = pack2(b.z, b.w);
        ((uint4*)dst)[i] = o;
    }
}
__device__ __forceinline__ void rmsnorm_rows(const float* __restrict__ X, const float* __restrict__ g, bf16_t* __restrict__ Hout) {
    const int lane = threadIdx.x & 63, wid = threadIdx.x >> 6;
    const int gw = blockIdx.x * 4 + wid, nw = gridDim.x * 4;
    for (int t = gw; t < T; t += nw) {
        const float* xr = X + (size_t)t * D;
        float4 v[4]; float ss = 0.f;
#pragma unroll
        for (int i = 0; i < 4; ++i) { v[i] = *(const float4*)(xr + i * 256 + lane * 4); ss += v[i].x * v[i].x + v[i].y * v[i].y + v[i].z * v[i].z + v[i].w * v[i].w; }
        ss = wave_sum(ss);
        const float rstd = rsqrtf(ss * (1.0f / D) + EPS);
#pragma unroll
        for (int i = 0; i < 4; ++i) {
            const float4 gg = *(const float4*)(g + i * 256 + lane * 4);
            uint2 o; o.x = pack2(v[i].x * rstd * gg.x, v[i].y * rstd * gg.y); o.y = pack2(v[i].z * rstd * gg.z, v[i].w * rstd * gg.w);
            *(uint2*)(Hout + (size_t)t * D + i * 256 + lane * 4) = o;
        }
    }
}

template <int MODE>
__device__ __forceinline__ void gemm_mainloop(const bf16_t* __restrict__ A0, const bf16_t* __restrict__ A1, int lda, int ksplit,
                                              const bf16_t* __restrict__ Bt, int K, int m0, int n0, f32x4 (&acc)[4][4], char* smem) {
    const int tid = threadIdx.x, lane = tid & 63, wid = tid >> 6, wm = wid >> 1, wn = wid & 1;
    const int lrow = tid >> 3, lch = tid & 7;
#pragma unroll
    for (int i = 0; i < 4; ++i)
#pragma unroll
        for (int j = 0; j < 4; ++j) acc[i][j] = (f32x4){0.f, 0.f, 0.f, 0.f};
    uint4 ra[4], rb[4];
    const int nk = K / 64;
    auto gload = [&](int kt) {
        const int kb = kt * 64;
        const bf16_t* Ab; int kk;
        if (kb < ksplit) { Ab = A0; kk = kb; } else { Ab = A1; kk = kb - ksplit; }
#pragma unroll
        for (int i = 0; i < 4; ++i) ra[i] = *(const uint4*)(Ab + (size_t)(m0 + lrow + 32 * i) * lda + kk + lch * 8);
#pragma unroll
        for (int i = 0; i < 4; ++i) rb[i] = *(const uint4*)(Bt + (size_t)(n0 + lrow + 32 * i) * K + kb + lch * 8);
    };
    auto lwrite = [&](int buf) {
        char* sa = smem + buf * 32768; char* sb = sa + 16384;
#pragma unroll
        for (int i = 0; i < 4; ++i) {
            const int row = lrow + 32 * i; const int off = row * 128 + ((lch ^ (row & 7)) << 4);
            *(uint4*)(sa + off) = ra[i]; *(uint4*)(sb + off) = rb[i];
        }
    };
    gload(0); lwrite(0); __syncthreads();
    for (int kt = 0; kt < nk; ++kt) {
        if (kt + 1 < nk) gload(kt + 1);
        const char* sa = smem + (kt & 1) * 32768; const char* sb = sa + 16384;
#pragma unroll
        for (int ks = 0; ks < 2; ++ks) {
            bf16x8 af[4], bfr[4];
            const int ch = ks * 4 + (lane >> 4);
#pragma unroll
            for (int i = 0; i < 4; ++i) { const int row = wm * 64 + i * 16 + (lane & 15); af[i] = *(const bf16x8*)(sa + row * 128 + ((ch ^ (row & 7)) << 4)); }
#pragma unroll
            for (int j = 0; j < 4; ++j) { const int row = wn * 64 + j * 16 + (lane & 15); bfr[j] = *(const bf16x8*)(sb + row * 128 + ((ch ^ (row & 7)) << 4)); }
#pragma unroll
            for (int i = 0; i < 4; ++i)
#pragma unroll
                for (int j = 0; j < 4; ++j) {
                    if (MODE == 0) acc[i][j] = __builtin_amdgcn_mfma_f32_16x16x32_bf16(bfr[j], af[i], acc[i][j], 0, 0, 0);
                    else acc[i][j] = __builtin_amdgcn_mfma_f32_16x16x32_bf16(af[i], bfr[j], acc[i][j], 0, 0, 0);
                }
        }
        if (kt + 1 < nk) lwrite((kt + 1) & 1);
        __syncthreads();
    }
}
__device__ __forceinline__ void store_bf16x4(bf16_t* p, f32x4 v) { uint2 o; o.x = pack2(v[0], v[1]); o.y = pack2(v[2], v[3]); *(uint2*)p = o; }

__device__ __forceinline__ void phase_gemm_in(const Params& p, char* smem) {
    const bf16_t* A = (const bf16_t*)(p.ws + OFF_H); const bf16_t* Bt = (const bf16_t*)(p.ws + OFF_WT_IN);
    bf16_t* R = (bf16_t*)(p.ws + OFF_REGION);
    const int lane = threadIdx.x & 63, wid = threadIdx.x >> 6, wm = wid >> 1, wn = wid & 1;
    constexpr int NT = AB_IN_PAD / 128, MT = T / 128;
    for (int tile = blockIdx.x; tile < NT * MT; tile += gridDim.x) {
        const int m0 = (tile / NT) * 128, n0 = (tile % NT) * 128;
        f32x4 acc[4][4];
        const bool tr = (n0 >= 1024 && n0 < 1536) || (n0 >= 2048 && n0 < 2560);
        if (!tr) {
            gemm_mainloop<0>(A, A, 1024, 1024, Bt, 1024, m0, n0, acc, smem);
#pragma unroll
            for (int i = 0; i < 4; ++i)
#pragma unroll
                for (int j = 0; j < 4; ++j) {
                    const int m = m0 + wm * 64 + i * 16 + (lane & 15), n = n0 + wn * 64 + j * 16 + 4 * (lane >> 4);
                    const f32x4 v = acc[i][j];
                    if (n < 512) store_bf16x4(R + R_QSB + (size_t)m * 512 + n, v * 0.125f);
                    else if (n < 1024) store_bf16x4(R + R_KSB + (size_t)m * 512 + (n - 512), v);
                    else if (n < 1792) store_bf16x4(R + R_QG + (size_t)m * 256 + (n - 1536), v);
                    else if (n < 2048) store_bf16x4(R + R_KG + (size_t)m * 256 + (n - 1792), v);
                    else if (n < 3072) store_bf16x4(R + R_GG + (size_t)m * 512 + (n - 2560), v);
                    else if (n < AB_IN) *(f32x4*)((float*)(R + R_ALR) + (size_t)m * 16 + (n - 3072)) = v;
                }
        } else {
            gemm_mainloop<1>(A, A, 1024, 1024, Bt, 1024, m0, n0, acc, smem);
#pragma unroll
            for (int i = 0; i < 4; ++i)
#pragma unroll
                for (int j = 0; j < 4; ++j) {
                    const int m = m0 + wm * 64 + i * 16 + 4 * (lane >> 4), n = n0 + wn * 64 + j * 16 + (lane & 15);
                    const int b = m >> 11, s = m & 2047;
                    if (n < 1536) { const int c = n - 1024, hh = c >> 6, e = c & 63; store_bf16x4(R + R_VTSB + ((size_t)((b * 8 + hh) * 64 + e)) * 2048 + s, acc[i][j]); }
                    else { const int c = n - 2048, hh = c >> 7, e = c & 127; store_bf16x4(R + R_VTG + ((size_t)((b * 4 + hh) * 128 + e)) * 2048 + s, acc[i][j]); }
                }
        }
    }
}
__device__ __forceinline__ void phase_gemm_resid(const bf16_t* A0, const bf16_t* A1, int lda, int ksplit, const bf16_t* Bt, int K, const float* Rs, float* O, char* smem) {
    const int lane = threadIdx.x & 63, wid = threadIdx.x >> 6, wm = wid >> 1, wn = wid & 1;
    constexpr int NT = 8, MT = T / 128;
    for (int tile = blockIdx.x; tile < NT * MT; tile += gridDim.x) {
        const int m0 = (tile / NT) * 128, n0 = (tile % NT) * 128;
        f32x4 acc[4][4];
        gemm_mainloop<0>(A0, A1, lda, ksplit, Bt, K, m0, n0, acc, smem);
#pragma unroll
        for (int i = 0; i < 4; ++i)
#pragma unroll
            for (int j = 0; j < 4; ++j) {
                const int m = m0 + wm * 64 + i * 16 + (lane & 15), n = n0 + wn * 64 + j * 16 + 4 * (lane >> 4);
                const f32x4 r = *(const f32x4*)(Rs + (size_t)m * 1024 + n);
                *(f32x4*)(O + (size_t)m * 1024 + n) = r + acc[i][j];
            }
    }
}
__device__ __forceinline__ void phase_gemm_bf16(const bf16_t* A, const bf16_t* Bt, int N, int K, bf16_t* O, char* smem) {
    const int lane = threadIdx.x & 63, wid = threadIdx.x >> 6, wm = wid >> 1, wn = wid & 1;
    const int NT = N / 128, MT = T / 128;
    for (int tile = blockIdx.x; tile < NT * MT; tile += gridDim.x) {
        const int m0 = (tile / NT) * 128, n0 = (tile % NT) * 128;
        f32x4 acc[4][4];
        gemm_mainloop<0>(A, A, K, K, Bt, K, m0, n0, acc, smem);
#pragma unroll
        for (int i = 0; i < 4; ++i)
#pragma unroll
            for (int j = 0; j < 4; ++j) {
                const int m = m0 + wm * 64 + i * 16 + (lane & 15), n = n0 + wn * 64 + j * 16 + 4 * (lane >> 4);
                store_bf16x4(O + (size_t)m * N + n, acc[i][j]);
            }
    }
}
__device__ __forceinline__ void phase_gemm_cin(const Params& p, char* smem) {
    const bf16_t* A = (const bf16_t*)(p.ws + OFF_H); const bf16_t* Bt = (const bf16_t*)(p.ws + OFF_WT_CIN);
    bf16_t* U = (bf16_t*)(p.ws + OFF_REGION); bf16_t* VT = U + (size_t)T * 2048; float* SSQ = (float*)(p.ws + OFF_SSQ);
    const int lane = threadIdx.x & 63, wid = threadIdx.x >> 6, wm = wid >> 1, wn = wid & 1;
    constexpr int NT = 32, MT = T / 128;
    for (int tile = blockIdx.x; tile < NT * MT; tile += gridDim.x) {
        const int m0 = (tile / NT) * 128, n0 = (tile % NT) * 128;
        f32x4 acc[4][4];
        if (n0 < 2048) {
            gemm_mainloop<0>(A, A, 1024, 1024, Bt, 1024, m0, n0, acc, smem);
#pragma unroll
            for (int i = 0; i < 4; ++i)
#pragma unroll
                for (int j = 0; j < 4; ++j) {
                    const int m = m0 + wm * 64 + i * 16 + (lane & 15), n = n0 + wn * 64 + j * 16 + 4 * (lane >> 4);
                    f32x4 v = acc[i][j];
#pragma unroll
                    for (int r = 0; r < 4; ++r) v[r] = gelu_exact(v[r]);
                    store_bf16x4(U + (size_t)m * 2048 + n, v);
                }
        } else {
            gemm_mainloop<1>(A, A, 1024, 1024, Bt, 1024, m0, n0, acc, smem);
#pragma unroll
            for (int i = 0; i < 4; ++i) {
                float ss[4] = {0.f, 0.f, 0.f, 0.f};
#pragma unroll
                for (int j = 0; j < 4; ++j) {
                    const int m = m0 + wm * 64 + i * 16 + 4 * (lane >> 4), n = n0 + wn * 64 + j * 16 + (lane & 15);
                    f32x4 v = acc[i][j];
#pragma unroll
                    for (int r = 0; r < 4; ++r) { v[r] = gelu_exact(v[r]); ss[r] += v[r] * v[r]; }
                    const int chunk = m >> 7, s = m & 127, c = n - 2048;
                    store_bf16x4(VT + ((size_t)chunk * 2048 + c) * 128 + s, v);
                }
#pragma unroll
                for (int r = 0; r < 4; ++r) {
                    float v = ss[r];
                    v += __shfl_xor(v, 1); v += __shfl_xor(v, 2); v += __shfl_xor(v, 4); v += __shfl_xor(v, 8);
                    if ((lane & 15) == 0) { const int m = m0 + wm * 64 + i * 16 + 4 * (lane >> 4) + r; SSQ[(size_t)m * 32 + ((n0 - 2048) >> 6) + wn] = v; }
                }
            }
        }
    }
}

__device__ __forceinline__ void sb_naive(const Params& p, char* smem) {
    bf16_t* R = (bf16_t*)(p.ws + OFF_REGION);
    float* sK = (float*)smem; float* sV = sK + 4096;
    const int tid = threadIdx.x;
    for (int task = blockIdx.x; task < 1024; task += gridDim.x) {
        const int bh = task & 127, qb = 7 - (task >> 7);
        const int b = bh >> 3, hh = bh & 7;
        const int t = qb * 256 + tid;
        bf16_t* qrow = R + R_QSB + (size_t)(b * 2048 + t) * 512 + hh * 64;
        float q[64], o[64];
#pragma unroll
        for (int d8 = 0; d8 < 8; ++d8) {
            const uint4 w = *(const uint4*)(qrow + d8 * 8);
            q[d8 * 8 + 0] = lo2f(w.x); q[d8 * 8 + 1] = hi2f(w.x); q[d8 * 8 + 2] = lo2f(w.y); q[d8 * 8 + 3] = hi2f(w.y);
            q[d8 * 8 + 4] = lo2f(w.z); q[d8 * 8 + 5] = hi2f(w.z); q[d8 * 8 + 6] = lo2f(w.w); q[d8 * 8 + 7] = hi2f(w.w);
        }
#pragma unroll
        for (int e = 0; e < 64; ++e) o[e] = 0.f;
        float Rp = 1.f;
        for (int kb = qb * 4 + 3; kb >= 0; --kb) {
            __syncthreads();
#pragma unroll
            for (int i = 0; i < 16; ++i) {
                const int idx = tid + 256 * i;
                { const int key = idx >> 6, d = idx & 63; sK[idx] = bf2f(R[R_KSB + (size_t)(b * 2048 + kb * 64 + key) * 512 + hh * 64 + d]); }
                { const int e = idx >> 6, key = idx & 63; sV[key * 64 + e] = bf2f(R[R_VTSB + ((size_t)((b * 8 + hh) * 64 + e)) * 2048 + kb * 64 + key]); }
            }
            __syncthreads();
            for (int key = 63; key >= 0; --key) {
                const int s = kb * 64 + key;
                const float* kr = sK + key * 64; const float* vr = sV + key * 64;
                float z = 0.f;
#pragma unroll
                for (int d4 = 0; d4 < 16; ++d4) { const float4 kk = *(const float4*)(kr + d4 * 4); z += q[d4 * 4] * kk.x + q[d4 * 4 + 1] * kk.y + q[d4 * 4 + 2] * kk.z + q[d4 * 4 + 3] * kk.w; }
                z = fminf(fmaxf(z, -80.f), 80.f);
                const float ez = __expf(-z), sig = 1.0f / (1.0f + ez), om = ez * sig;
                const bool valid = s < t;
                const float a = valid ? sig * Rp : 0.f;
                Rp = valid ? Rp * om : Rp;
#pragma unroll
                for (int e4 = 0; e4 < 16; ++e4) { const float4 vv = *(const float4*)(vr + e4 * 4); o[e4 * 4] += a * vv.x; o[e4 * 4 + 1] += a * vv.y; o[e4 * 4 + 2] += a * vv.z; o[e4 * 4 + 3] += a * vv.w; }
            }
        }
#pragma unroll
        for (int d8 = 0; d8 < 8; ++d8) {
            uint4 w; w.x = pack2(o[d8 * 8 + 0], o[d8 * 8 + 1]); w.y = pack2(o[d8 * 8 + 2], o[d8 * 8 + 3]); w.z = pack2(o[d8 * 8 + 4], o[d8 * 8 + 5]); w.w = pack2(o[d8 * 8 + 6], o[d8 * 8 + 7]);
            *(uint4*)(qrow + d8 * 8) = w;
        }
    }
}
__device__ __forceinline__ float log_sigmoid(float x) { return fminf(x, 0.f) - log1pf(__expf(-fabsf(x))); }
__device__ __forceinline__ void gla_naive(const Params& p, char* smem) {
    bf16_t* R = (bf16_t*)(p.ws + OFF_REGION);
    const float* ALR = (const float*)(R + R_ALR);
    float* sq = (float*)smem; float* sk = sq + 2048; float* sa = sk + 2048; float* so = sa + 2048;
    const int tid = threadIdx.x, lane = tid & 63, wid = tid >> 6;
    for (int task = blockIdx.x; task < 64; task += gridDim.x) {
        const int b = task >> 2, hh = task & 3;
        float S[64];
#pragma unroll
        for (int d = 0; d < 64; ++d) S[d] = 0.f;
        for (int s0 = 0; s0 < 2048; s0 += 32) {
#pragma unroll
            for (int i = 0; i < 8; ++i) {
                const int idx = tid + 256 * i, tt = idx >> 6, d = idx & 63;
                const size_t row = (size_t)(b * 2048 + s0 + tt);
                sq[idx] = bf2f(R[R_QG + row * 256 + hh * 64 + d]) * 0.125f;
                sk[idx] = bf2f(R[R_KG + row * 256 + hh * 64 + d]);
                float pre = p.ab_b_alpha2[hh * 64 + d];
#pragma unroll
                for (int r = 0; r < 16; ++r) pre += ALR[row * 16 + r] * p.ab_w_alpha2[r * 256 + hh * 64 + d];
                sa[idx] = __expf(log_sigmoid(pre) * (1.0f / 16.0f));
            }
            __syncthreads();
            if (tid < 128) {
                const bf16_t* vr = R + R_VTG + ((size_t)((b * 4 + hh) * 128 + tid)) * 2048 + s0;
                for (int tt = 0; tt < 32; ++tt) {
                    const float v = bf2f(vr[tt]);
                    float o = 0.f;
#pragma unroll
                    for (int d = 0; d < 64; ++d) { S[d] = sa[tt * 64 + d] * S[d] + sk[tt * 64 + d] * v; o += sq[tt * 64 + d] * S[d]; }
                    so[tt * 128 + tid] = o;
                }
            }
            __syncthreads();
#pragma unroll
            for (int i = 0; i < 8; ++i) {
                const int tt = wid * 8 + i;
                const float o0 = so[tt * 128 + lane], o1 = so[tt * 128 + 64 + lane];
                const float ss = wave_sum(o0 * o0 + o1 * o1);
                const float rstd = rsqrtf(ss * (1.0f / 128.0f) + EPS);
                const size_t row = (size_t)(b * 2048 + s0 + tt);
                bf16_t* gp = R + R_GG + row * 512 + hh * 128;
                const float g0 = bf2f(gp[lane]), g1 = bf2f(gp[64 + lane]);
                const float r0 = o0 * rstd * p.ab_gla_norm[hh * 128 + lane] * (g0 / (1.0f + __expf(-g0)));
                const float r1 = o1 * rstd * p.ab_gla_norm[hh * 128 + 64 + lane] * (g1 / (1.0f + __expf(-g1)));
                gp[lane] = f2bf(r0); gp[64 + lane] = f2bf(r1);
            }
            __syncthreads();
        }
    }
}

__device__ __forceinline__ void argmax_step(float& v, int& i, int off) {
    const float ov = __shfl_xor(v, off); const int oi = __shfl_xor(i, off);
    if (ov > v || (ov == v && oi < i)) { v = ov; i = oi; }
}
__device__ __forceinline__ void peer_select_naive(const Params& p, int layer) {
    const bf16_t* Q = (const bf16_t*)(p.ws + OFF_REGION);
    const bf16_t* SK = (const bf16_t*)(p.ws + OFF_SK) + (size_t)layer * 8 * 2 * 128 * 128;
    unsigned short* IDX = (unsigned short*)(p.ws + OFF_IDX); float* GATE = (float*)(p.ws + OFF_GATE);
    const int lane = threadIdx.x & 63, wid = threadIdx.x >> 6;
    const int gw = blockIdx.x * 4 + wid, nw = gridDim.x * 4;
    for (int task = gw; task < T * 8; task += nw) {
        const int t = task >> 3, hh = task & 7;
        const bf16_t* qp = Q + (size_t)t * 2048 + hh * 256;
        float ts[2]; int ti[2];
#pragma unroll
        for (int pp = 0; pp < 2; ++pp) {
            const bf16_t* k0 = SK + ((size_t)(hh * 2 + pp) * 128 + lane) * 128;
            const bf16_t* k1 = k0 + 64 * 128;
            float a0 = 0.f, a1 = 0.f;
#pragma unroll
            for (int c = 0; c < 16; ++c) {
                const uint4 qv = *(const uint4*)(qp + pp * 128 + c * 8);
                const uint4 x0 = *(const uint4*)(k0 + c * 8), x1 = *(const uint4*)(k1 + c * 8);
                a0 = dot2(qv.x, x0.x, a0); a0 = dot2(qv.y, x0.y, a0); a0 = dot2(qv.z, x0.z, a0); a0 = dot2(qv.w, x0.w, a0);
                a1 = dot2(qv.x, x1.x, a1); a1 = dot2(qv.y, x1.y, a1); a1 = dot2(qv.z, x1.z, a1); a1 = dot2(qv.w, x1.w, a1);
            }
            float keep_s = 0.f; int keep_i = 0;
            for (int r = 0; r < 16; ++r) {
                float v; int i;
                if (a0 >= a1) { v = a0; i = lane; } else { v = a1; i = lane + 64; }
#pragma unroll
                for (int off = 32; off >= 1; off >>= 1) argmax_step(v, i, off);
                if (i == lane) a0 = -INFINITY;
                if (i == lane + 64) a1 = -INFINITY;
                if (lane == r) { keep_s = v; keep_i = i; }
            }
            ts[pp] = keep_s; ti[pp] = keep_i;
        }
        float cs[4];
#pragma unroll
        for (int jj = 0; jj < 4; ++jj) { const int c = lane * 4 + jj; cs[jj] = __shfl(ts[0], c >> 4) + __shfl(ts[1], c & 15); }
        float best_s = 0.f; int best_c = 0;
        for (int r = 0; r < 16; ++r) {
            float v = cs[0]; int i = lane * 4;
#pragma unroll
            for (int jj = 1; jj < 4; ++jj) if (cs[jj] > v) { v = cs[jj]; i = lane * 4 + jj; }
#pragma unroll
            for (int off = 32; off >= 1; off >>= 1) argmax_step(v, i, off);
#pragma unroll
            for (int jj = 0; jj < 4; ++jj) if (i == lane * 4 + jj) cs[jj] = -INFINITY;
            if (lane == r) { best_s = v; best_c = i; }
        }
        const float mx = __shfl(best_s, 0);
        float e = (lane < 16) ? __expf(best_s - mx) : 0.f;
        float sum = e;
        sum += __shfl_xor(sum, 1); sum += __shfl_xor(sum, 2); sum += __shfl_xor(sum, 4); sum += __shfl_xor(sum, 8);
        const int i0 = __shfl(ti[0], best_c >> 4), i1 = __shfl(ti[1], best_c & 15);
        if (lane < 16) {
            IDX[(size_t)t * 128 + hh * 16 + lane] = (unsigned short)(i0 * 128 + i1);
            GATE[(size_t)t * 128 + hh * 16 + lane] = e / sum;
        }
    }
}

__device__ __forceinline__ void peer_gather(const Params& p, int layer, const float* __restrict__ gnext, bool final_out) {
    const bf16_t* UT = (const bf16_t*)(p.ws + OFF_UT) + (size_t)layer * NEXP * 1024;
    const bf16_t* VT = (const bf16_t*)(p.ws + OFF_VT) + (size_t)layer * NEXP * 1024;
    bf16_t* H = (bf16_t*)(p.ws + OFF_H);
    const unsigned short* IDX = (const unsigned short*)(p.ws + OFF_IDX); const float* GATE = (const float*)(p.ws + OFF_GATE);
    float* X = p.out;
    const int lane = threadIdx.x & 63, wid = threadIdx.x >> 6, sub = lane >> 4, li = lane & 15;
    const int gw = blockIdx.x * 4 + wid, nw = gridDim.x * 4;
    for (int t = gw; t < T; t += nw) {
        uint4 xr[8];
#pragma unroll
        for (int j = 0; j < 8; ++j) xr[j] = *(const uint4*)(H + (size_t)t * 1024 + j * 128 + li * 8);
        float acc[8][8];
#pragma unroll
        for (int j = 0; j < 8; ++j)
#pragma unroll
            for (int c = 0; c < 8; ++c) acc[j][c] = 0.f;
#pragma unroll 2
        for (int sg = 0; sg < 32; ++sg) {
            const int slot = sg * 4 + sub;
            const int e = IDX[(size_t)t * 128 + slot];
            const float gt = GATE[(size_t)t * 128 + slot];
            const bf16_t* ur = UT + (size_t)e * 1024 + li * 8;
            const bf16_t* vr = VT + (size_t)e * 1024 + li * 8;
            uint4 du[8], dv[8];
#pragma unroll
            for (int j = 0; j < 8; ++j) du[j] = *(const uint4*)(ur + j * 128);
#pragma unroll
            for (int j = 0; j < 8; ++j) dv[j] = *(const uint4*)(vr + j * 128);
            float a = 0.f;
#pragma unroll
            for (int j = 0; j < 8; ++j) { a = dot2(du[j].x, xr[j].x, a); a = dot2(du[j].y, xr[j].y, a); a = dot2(du[j].z, xr[j].z, a); a = dot2(du[j].w, xr[j].w, a); }
            a += __shfl_xor(a, 1); a += __shfl_xor(a, 2); a += __shfl_xor(a, 4); a += __shfl_xor(a, 8);
            const float ww = gt * gelu_exact(a);
#pragma unroll
            for (int j = 0; j < 8; ++j) {
                const uint4 d = dv[j];
                acc[j][0] += ww * lo2f(d.x); acc[j][1] += ww * hi2f(d.x); acc[j][2] += ww * lo2f(d.y); acc[j][3] += ww * hi2f(d.y);
                acc[j][4] += ww * lo2f(d.z); acc[j][5] += ww * hi2f(d.z); acc[j][6] += ww * lo2f(d.w); acc[j][7] += ww * hi2f(d.w);
            }
        }
        float r1[4][8];
        const bool up2 = (sub & 2) != 0;
#pragma unroll
        for (int j = 0; j < 4; ++j)
#pragma unroll
            for (int c = 0; c < 8; ++c) {
                const float mine = up2 ? acc[j + 4][c] : acc[j][c];
                const float theirs = up2 ? acc[j][c] : acc[j + 4][c];
                r1[j][c] = mine + __shfl_xor(theirs, 32);
            }
        float r2[2][8];
        const bool up1 = (sub & 1) != 0;
#pragma unroll
        for (int j = 0; j < 2; ++j)
#pragma unroll
            for (int c = 0; c < 8; ++c) {
                const float mine = up1 ? r1[j + 2][c] : r1[j][c];
                const float theirs = up1 ? r1[j][c] : r1[j + 2][c];
                r2[j][c] = mine + __shfl_xor(theirs, 16);
            }
        float ss = 0.f;
        float* xrow = X + (size_t)t * 1024;
#pragma unroll
        for (int jj = 0; jj < 2; ++jj) {
            const int d0 = (2 * sub + jj) * 128 + li * 8;
            const float4 a = *(const float4*)(xrow + d0), b = *(const float4*)(xrow + d0 + 4);
            r2[jj][0] += a.x; r2[jj][1] += a.y; r2[jj][2] += a.z; r2[jj][3] += a.w; r2[jj][4] += b.x; r2[jj][5] += b.y; r2[jj][6] += b.z; r2[jj][7] += b.w;
#pragma unroll
            for (int c = 0; c < 8; ++c) ss += r2[jj][c] * r2[jj][c];
        }
        ss = wave_sum(ss);
        const float rstd = rsqrtf(ss * (1.0f / D) + EPS);
#pragma unroll
        for (int jj = 0; jj < 2; ++jj) {
            const int d0 = (2 * sub + jj) * 128 + li * 8;
            const float4 ga = *(const float4*)(gnext + d0), gb = *(const float4*)(gnext + d0 + 4);
            const float n0 = r2[jj][0] * rstd * ga.x, n1 = r2[jj][1] * rstd * ga.y, n2 = r2[jj][2] * rstd * ga.z, n3 = r2[jj][3] * rstd * ga.w;
            const float n4 = r2[jj][4] * rstd * gb.x, n5 = r2[jj][5] * rstd * gb.y, n6 = r2[jj][6] * rstd * gb.z, n7 = r2[jj][7] * rstd * gb.w;
            if (final_out) {
                *(float4*)(xrow + d0) = make_float4(n0, n1, n2, n3); *(float4*)(xrow + d0 + 4) = make_float4(n4, n5, n6, n7);
            } else {
                *(float4*)(xrow + d0) = make_float4(r2[jj][0], r2[jj][1], r2[jj][2], r2[jj][3]);
                *(float4*)(xrow + d0 + 4) = make_float4(r2[jj][4], r2[jj][5], r2[jj][6], r2[jj][7]);
                uint4 o; o.x = pack2(n0, n1); o.y = pack2(n2, n3); o.z = pack2(n4, n5); o.w = pack2(n6, n7);
                *(uint4*)(H + (size_t)t * 1024 + d0) = o;
            }
        }
    }
}

__device__ __forceinline__ void spatial_naive(const Params& p, char* smem) {
    bf16_t* U = (bf16_t*)(p.ws + OFF_REGION); const bf16_t* VT = U + (size_t)T * 2048; const float* SSQ = (const float*)(p.ws + OFF_SSQ);
    float* rstd = (float*)smem; float* wr = rstd + 128;
    const int tid = threadIdx.x;
    for (int task = blockIdx.x; task < 2048; task += gridDim.x) {
        const int chunk = task >> 3, g = task & 7;
        if (tid < 128) {
            float s = 0.f;
#pragma unroll
            for (int i = 0; i < 32; ++i) s += SSQ[(size_t)(chunk * 128 + tid) * 32 + i];
            rstd[tid] = rsqrtf(s * (1.0f / 2048.0f) + EPS);
        }
        unsigned v[64];
        const bf16_t* vrow = VT + ((size_t)chunk * 2048 + g * 256 + tid) * 128;
#pragma unroll
        for (int i = 0; i < 16; ++i) { const uint4 w = *(const uint4*)(vrow + i * 8); v[4 * i] = w.x; v[4 * i + 1] = w.y; v[4 * i + 2] = w.z; v[4 * i + 3] = w.w; }
        const float vn = p.c_v_norm[g * 256 + tid];
        __syncthreads();
        for (int t = 0; t < 128; ++t) {
            if (tid < 128) wr[tid] = (tid <= t) ? p.c_w_spatial[((size_t)g * 128 + t) * 128 + tid] * rstd[tid] : 0.f;
            __syncthreads();
            float m = 0.f;
#pragma unroll
            for (int s2 = 0; s2 < 64; ++s2) m += wr[2 * s2] * lo2f(v[s2]) + wr[2 * s2 + 1] * hi2f(v[s2]);
            const float mixed = vn * m + p.c_b_spatial[g * 128 + t];
            bf16_t* up = U + (size_t)(chunk * 128 + t) * 2048 + g * 256 + tid;
            *up = f2bf(bf2f(*up) * mixed);
            __syncthreads();
        }
    }
}

constexpr int NPHASE = 15;
__global__ void __launch_bounds__(256, 2) mega(Params p, int ph_lo, int ph_hi) {
    __shared__ __attribute__((aligned(16))) char smem[65536];
    cg::grid_group grid = cg::this_grid();
    bf16_t* Rg = (bf16_t*)(p.ws + OFF_REGION);
    bf16_t* Hb = (bf16_t*)(p.ws + OFF_H);
#define PHASE(k, ...) if (ph_lo <= (k) && (k) < ph_hi) { __VA_ARGS__; if ((k) + 1 < ph_hi) grid.sync(); }
    PHASE(0,
        transpose_convert(p.ab_w_in, (bf16_t*)(p.ws + OFF_WT_IN), 1024, AB_IN, AB_IN_PAD, smem);
        transpose_convert(p.ab_w_out, (bf16_t*)(p.ws + OFF_WT_OUT), 1024, 1024, 1024, smem);
        transpose_convert(p.c_w_in, (bf16_t*)(p.ws + OFF_WT_CIN), 1024, 4096, 4096, smem);
        transpose_convert(p.c_w_out, (bf16_t*)(p.ws + OFF_WT_COUT), 2048, 1024, 1024, smem);
        transpose_convert(p.peer_w_q, (bf16_t*)(p.ws + OFF_WT_Q), 1024, 2048, 2048, smem);
        transpose_convert(p.peer_w_q + (size_t)1024 * 2048, (bf16_t*)(p.ws + OFF_WT_Q) + (size_t)2048 * 1024, 1024, 2048, 2048, smem);
        convert_flat(p.peer_subkeys, (bf16_t*)(p.ws + OFF_SK), (size_t)2 * 8 * 2 * 128 * 128);
        convert_flat(p.peer_u, (bf16_t*)(p.ws + OFF_UT), (size_t)2 * NEXP * 1024);
        convert_flat(p.peer_v, (bf16_t*)(p.ws + OFF_VT), (size_t)2 * NEXP * 1024);
        rmsnorm_rows(p.x, p.norm_mix, Hb))
    PHASE(1, phase_gemm_in(p, smem))
    PHASE(2, gla_naive(p, smem); sb_naive(p, smem))
    PHASE(3, phase_gemm_resid(Rg + R_QSB, Rg + R_GG, 512, 512, (const bf16_t*)(p.ws + OFF_WT_OUT), 1024, p.x, p.out, smem))
    PHASE(4, rmsnorm_rows(p.out, p.norm_ffn, Hb))
    PHASE(5, phase_gemm_bf16(Hb, (const bf16_t*)(p.ws + OFF_WT_Q), 2048, 1024, Rg, smem))
    PHASE(6, peer_select_naive(p, 0))
    PHASE(7, peer_gather(p, 0, p.norm_mix + 1024, false))
    PHASE(8, phase_gemm_cin(p, smem))
    PHASE(9, spatial_naive(p, smem))
    PHASE(10, phase_gemm_resid(Rg, Rg, 2048, 2048, (const bf16_t*)(p.ws + OFF_WT_COUT), 2048, p.out, p.out, smem))
    PHASE(11, rmsnorm_rows(p.out, p.norm_ffn + 1024, Hb))
    PHASE(12, phase_gemm_bf16(Hb, (const bf16_t*)(p.ws + OFF_WT_Q) + (size_t)2048 * 1024, 2048, 1024, Rg, smem))
    PHASE(13, peer_select_naive(p, 1))
    PHASE(14, peer_gather(p, 1, p.final_norm, true))
}

extern "C" void kernel_launch(void* const* d_in, const int* in_sizes, int n_in, void* d_out, int out_size, void* d_ws, size_t ws_size, hipStream_t stream) {
    static int grid_blocks = 0;
    if (!grid_blocks) {
        int dev = 0, cus = 0, per_cu = 0;
        hipGetDevice(&dev);
        hipDeviceGetAttribute(&cus, hipDeviceAttributeMultiprocessorCount, dev);
        hipOccupancyMaxActiveBlocksPerMultiprocessor(&per_cu, mega, 256, 0);
        if (per_cu < 1) per_cu = 1;
        if (per_cu > 2) per_cu = 2;
        grid_blocks = cus * per_cu;
        if (n_in != 18 || ws_size < WS_END) fprintf(stderr, "kernel_launch: unexpected n_in %d or ws_size %zu < %zu\n", n_in, ws_size, (size_t)WS_END);
    }
    Params p{};
    p.x = (const float*)d_in[0]; p.norm_mix = (const float*)d_in[1]; p.norm_ffn = (const float*)d_in[2]; p.ab_w_in = (const float*)d_in[3];
    p.ab_w_alpha2 = (const float*)d_in[4]; p.ab_b_alpha2 = (const float*)d_in[5]; p.ab_gla_norm = (const float*)d_in[6]; p.ab_w_out = (const float*)d_in[7];
    p.c_w_in = (const float*)d_in[8]; p.c_v_norm = (const float*)d_in[9]; p.c_w_spatial = (const float*)d_in[10]; p.c_b_spatial = (const float*)d_in[11];
    p.c_w_out = (const float*)d_in[12]; p.peer_w_q = (const float*)d_in[13]; p.peer_subkeys = (const float*)d_in[14]; p.peer_u = (const float*)d_in[15];
    p.peer_v = (const float*)d_in[16]; p.final_norm = (const float*)d_in[17];
    p.out = (float*)d_out; p.ws = (unsigned char*)d_ws;
#if ONE_LAUNCH
    int lo = 0, hi = NPHASE;
    void* args[] = {&p, &lo, &hi};
    hipError_t e = hipLaunchCooperativeKernel((void*)mega, dim3(grid_blocks), dim3(256), args, 0, stream);
    if (e != hipSuccess) fprintf(stderr, "cooperative launch failed: %s (grid %d)\n", hipGetErrorString(e), grid_blocks);
#else
    for (int ph = 0; ph < NPHASE; ++ph) hipLaunchKernelGGL(mega, dim3(grid_blocks), dim3(256), 0, stream, p, ph, ph + 1);
#endif
}
```

```cpp
#include <hip/hip_runtime.h>
#include <hip/hip_cooperative_groups.h>
#include <cstdio>
#include <cstdint>
namespace cg = cooperative_groups;

#ifndef ONE_LAUNCH
#define ONE_LAUNCH 1
#endif

typedef unsigned short bf16_t;
typedef short bf16x8 __attribute__((ext_vector_type(8)));
typedef float f32x4 __attribute__((ext_vector_type(4)));
typedef unsigned u32x4 __attribute__((ext_vector_type(4)));
typedef __bf16 bf16x2_t __attribute__((ext_vector_type(2)));

constexpr int T = 32768, D = 1024, SEQ = 2048, NB = 16;
constexpr int AB_IN = 3088, AB_IN_PAD = 3200;
constexpr float EPS = 1e-6f;
constexpr int NEXP = 16384;

constexpr size_t SZ_WT_IN = (size_t)AB_IN_PAD * 1024 * 2;
constexpr size_t SZ_WT_OUT = (size_t)1024 * 1024 * 2;
constexpr size_t SZ_WT_CIN = (size_t)4096 * 1024 * 2;
constexpr size_t SZ_WT_COUT = (size_t)1024 * 2048 * 2;
constexpr size_t SZ_WT_Q = (size_t)2 * 2048 * 1024 * 2;
constexpr size_t SZ_SK = (size_t)2 * 8 * 2 * 128 * 128 * 2;
constexpr size_t SZ_TAB = (size_t)2 * NEXP * 1024;
constexpr size_t SZ_TSC = (size_t)2 * NEXP * 4;
constexpr size_t OFF_WT_IN = 0;
constexpr size_t OFF_WT_OUT = OFF_WT_IN + SZ_WT_IN;
constexpr size_t OFF_WT_CIN = OFF_WT_OUT + SZ_WT_OUT;
constexpr size_t OFF_WT_COUT = OFF_WT_CIN + SZ_WT_CIN;
constexpr size_t OFF_WT_Q = OFF_WT_COUT + SZ_WT_COUT;
constexpr size_t OFF_SK = OFF_WT_Q + SZ_WT_Q;
constexpr size_t OFF_UT = OFF_SK + SZ_SK;
constexpr size_t OFF_VT = OFF_UT + SZ_TAB;
constexpr size_t OFF_USC = OFF_VT + SZ_TAB;
constexpr size_t OFF_VSC = OFF_USC + SZ_TSC;
constexpr size_t OFF_H = OFF_VSC + SZ_TSC;
constexpr size_t OFF_IDX = OFF_H + (size_t)T * 1024 * 2;
constexpr size_t OFF_GATE = OFF_IDX + (size_t)T * 128 * 2;
constexpr size_t OFF_SSQ = OFF_GATE + (size_t)T * 128 * 4;
constexpr size_t OFF_REGION = OFF_SSQ + (size_t)T * 32 * 4;
constexpr size_t SZ_REGION = (size_t)256 << 20;
constexpr size_t OFF_BAR = OFF_REGION + SZ_REGION;
constexpr size_t WS_END = OFF_BAR + 16384;
constexpr size_t R_QSB = 0;
constexpr size_t R_KSB = R_QSB + (size_t)T * 512;
constexpr size_t R_VTSB = R_KSB + (size_t)T * 512;
constexpr size_t R_QG = R_VTSB + (size_t)T * 512;
constexpr size_t R_KG = R_QG + (size_t)T * 256;
constexpr size_t R_VTG = R_KG + (size_t)T * 256;
constexpr size_t R_GG = R_VTG + (size_t)T * 512;
constexpr size_t R_ALR = R_GG + (size_t)T * 512;
constexpr size_t R_KOT = R_ALR + (size_t)T * 32;
constexpr size_t R_DEC = R_KOT + (size_t)T * 256;

struct Params {
    const float* x; const float* norm_mix; const float* norm_ffn; const float* ab_w_in; const float* ab_w_alpha2; const float* ab_b_alpha2;
    const float* ab_gla_norm; const float* ab_w_out; const float* c_w_in; const float* c_v_norm; const float* c_w_spatial; const float* c_b_spatial;
    const float* c_w_out; const float* peer_w_q; const float* peer_subkeys; const float* peer_u; const float* peer_v; const float* final_norm;
    float* out; unsigned char* ws;
};

__device__ __forceinline__ float bf2f(bf16_t v) { return __uint_as_float(((unsigned)v) << 16); }
__device__ __forceinline__ bf16_t f2bf(float f) { unsigned u = __float_as_uint(f); u += 0x7fffu + ((u >> 16) & 1u); return (bf16_t)(u >> 16); }
__device__ __forceinline__ unsigned pack2(float lo, float hi) { return (unsigned)f2bf(lo) | ((unsigned)f2bf(hi) << 16); }
__device__ __forceinline__ float lo2f(unsigned w) { return __uint_as_float(w << 16); }
__device__ __forceinline__ float hi2f(unsigned w) { return __uint_as_float(w & 0xffff0000u); }
__device__ __forceinline__ float dot2(unsigned a, unsigned b, float acc) { return __builtin_amdgcn_fdot2_f32_bf16(__builtin_bit_cast(bf16x2_t, a), __builtin_bit_cast(bf16x2_t, b), acc, false); }
__device__ __forceinline__ float gelu_exact(float v) {
    const float av = fabsf(v);
    const float t = __builtin_amdgcn_rcpf(av * 0.2316418882f + 1.0f);
    float q = t * 0.5307027145f - 0.7265760135f; q = q * t + 0.7107068705f; q = q * t - 0.142248368f; q = q * t + 0.127414796f; q = q * t;
    const float e = __builtin_amdgcn_exp2f(v * v * -0.72134752044f);
    const float m = v * (q * e);
    return v < 0.f ? m : v - m;
}
__device__ __forceinline__ float wave_sum(float v) {
#pragma unroll
    for (int o = 32; o >= 1; o >>= 1) v += __shfl_xor(v, o);
    return v;
}

__device__ __forceinline__ void transpose_convert(const float* __restrict__ W, bf16_t* __restrict__ Wt, int K, int N, int Npad, char* smem) {
    float* tile = (float*)smem;
    const int tk = K / 64, tn = Npad / 64, ntile = tk * tn;
    const int tid = threadIdx.x;
    for (int tl = blockIdx.x; tl < ntile; tl += gridDim.x) {
        const int k0 = (tl % tk) * 64, n0 = (tl / tk) * 64;
        const int c = tid & 63, r0 = tid >> 6;
#pragma unroll
        for (int i = 0; i < 16; ++i) {
            const int r = r0 + 4 * i;
            const float v = (n0 + c < N) ? W[(size_t)(k0 + r) * N + n0 + c] : 0.f;
            tile[c * 65 + r] = v;
        }
        __syncthreads();
#pragma unroll
        for (int i = 0; i < 16; ++i) {
            const int n = r0 + 4 * i;
            Wt[(size_t)(n0 + n) * K + k0 + c] = f2bf(tile[n * 65 + c]);
        }
        __syncthreads();
    }
}
__device__ __forceinline__ void convert_flat(const float* __restrict__ src, bf16_t* __restrict__ dst, size_t n) {
    const size_t nv = n / 8;
    for (size_t i = (size_t)blockIdx.x * blockDim.x + threadIdx.x; i < nv; i += (size_t)gridDim.x * blockDim.x) {
        const float4 a = ((const float4*)src)[2 * i], b = ((const float4*)src)[2 * i + 1];
        uint4 o; o.x = pack2(a.x, a.y); o.y = pack2(a.z, a.w); o.z = pack2(b.x, b.y); o.w = pack2(b.z, b.w);
        ((uint4*)dst)[i] = o;
    }
}
__device__ __forceinline__ void quantize_tables_queued(const Params& p, char* smem, unsigned* ctr) {
    volatile unsigned* slot = (volatile unsigned*)(smem + 32800);
    const int lane = threadIdx.x & 63, wid = threadIdx.x >> 6;
    for (;;) {
        __syncthreads();
        if (threadIdx.x == 0) *slot = atomicAdd(ctr, 1u);
        __syncthreads();
        const unsigned task = *slot;
        if (task >= 512u) break;
        const bool isv = task >= 256u;
        const int r0 = (int)(task & 255u) * 128 + wid * 32;
        const float* src = isv ? p.peer_v : p.peer_u;
        unsigned char* recs = p.ws + OFF_UT;
        for (int rr = 0; rr < 32; ++rr) {
            const int r = r0 + rr;
            const float* xr = src + (size_t)r * 1024 + lane * 16;
            f32x4 v[4]; float aml = 0.f;
#pragma unroll
            for (int i = 0; i < 4; ++i) {
                v[i] = *(const f32x4*)(xr + i * 4);
                aml = fmaxf(aml, fmaxf(fmaxf(fabsf(v[i][0]), fabsf(v[i][1])), fmaxf(fabsf(v[i][2]), fabsf(v[i][3]))));
            }
            const float gs = fmaxf(aml, __shfl_xor(aml, 1)) * (1.002f / 7.5f);
            const _Float16 hs = (_Float16)gs;
            const float gsd = (float)hs, ginv = gsd > 0.f ? 1.0f / gsd : 0.f;
            unsigned wd[2];
#pragma unroll
            for (int dd = 0; dd < 2; ++dd) {
                unsigned wv = 0;
#pragma unroll
                for (int b = 0; b < 4; ++b) {
                    const int qa = min(15, max(0, __float2int_rn(v[2 * dd][b] * ginv + 7.5f)));
                    const int qb = min(15, max(0, __float2int_rn(v[2 * dd + 1][b] * ginv + 7.5f)));
                    wv |= ((unsigned)qa | ((unsigned)qb << 4)) << (8 * b);
                }
                wd[dd] = wv;
            }
            unsigned char* rec = recs + (size_t)r * 1152;
            *(uint2*)(rec + (isv ? 512 : 0) + lane * 8) = make_uint2(wd[0], wd[1]);
            if ((lane & 1) == 0) { const int g = lane >> 1; *(_Float16*)(rec + 1024 + (g & 15) * 8 + (isv ? 4 : 0) + (g >> 4) * 2) = hs; }
        }
    }
}
__device__ __forceinline__ void rmsnorm_rows(const float* __restrict__ X, const float* __restrict__ g, bf16_t* __restrict__ Hout) {
    const int lane = threadIdx.x & 63, wid = threadIdx.x >> 6;
    const int gw = blockIdx.x * 4 + wid, nw = gridDim.x * 4;
    for (int t = gw; t < T; t += nw) {
        const float* xr = X + (size_t)t * D;
        float4 v[4]; float ss = 0.f;
#pragma unroll
        for (int i = 0; i < 4; ++i) { v[i] = *(const float4*)(xr + i * 256 + lane * 4); ss += v[i].x * v[i].x + v[i].y * v[i].y + v[i].z * v[i].z + v[i].w * v[i].w; }
        ss = wave_sum(ss);
        const float rstd = rsqrtf(ss * (1.0f / D) + EPS);
#pragma unroll
        for (int i = 0; i < 4; ++i) {
            const float4 gg = *(const float4*)(g + i * 256 + lane * 4);
            uint2 o; o.x = pack2(v[i].x * rstd * gg.x, v[i].y * rstd * gg.y); o.y = pack2(v[i].z * rstd * gg.z, v[i].w * rstd * gg.w);
            *(uint2*)(Hout + (size_t)t * D + i * 256 + lane * 4) = o;
        }
    }
}

template <int MODE>
__device__ __forceinline__ void gemm_mainloop(const bf16_t* __restrict__ A0, const bf16_t* __restrict__ A1, int lda, int ksplit,
                                              const bf16_t* __restrict__ Bt, int K, int m0, int n0, f32x4 (&acc)[4][4], char* smem) {
    const int tid = threadIdx.x, lane = tid & 63, wid = tid >> 6, wm = wid >> 1, wn = wid & 1;
    const int lrow = tid >> 3, lch = tid & 7;
#pragma unroll
    for (int i = 0; i < 4; ++i)
#pragma unroll
        for (int j = 0; j < 4; ++j) acc[i][j] = (f32x4){0.f, 0.f, 0.f, 0.f};
    const int nk = K / 64;
    unsigned aoff[4], boff[4];
    {
        const int rr = lane >> 3, cc = ((lane & 7) ^ rr) * 8;
#pragma unroll
        for (int i = 0; i < 4; ++i) {
            aoff[i] = (unsigned)(((m0 + 32 * wid + 8 * i + rr) * lda + cc) * 2);
            boff[i] = (unsigned)(((n0 + 32 * wid + 8 * i + rr) * K + cc) * 2);
        }
    }
    auto stage = [&](int kt, int buf) {
        const int kb = kt * 64;
        const char* Ab; const char* Bb = (const char*)(Bt + kb);
        if (kb < ksplit) Ab = (const char*)(A0 + kb); else Ab = (const char*)(A1 + (kb - ksplit));
        char* sa = smem + buf * 32768 + wid * 4096 + lane * 16; char* sb = sa + 16384;
#pragma unroll
        for (int i = 0; i < 4; ++i) __builtin_amdgcn_global_load_lds((const unsigned*)(Ab + aoff[i]), (unsigned*)(sa + i * 1024), 16, 0, 0);
#pragma unroll
        for (int i = 0; i < 4; ++i) __builtin_amdgcn_global_load_lds((const unsigned*)(Bb + boff[i]), (unsigned*)(sb + i * 1024), 16, 0, 0);
    };
    auto compute = [&](int buf) {
        const char* sa = smem + buf * 32768; const char* sb = sa + 16384;
#pragma unroll
        for (int ks = 0; ks < 2; ++ks) {
            bf16x8 af[4], bfr[4];
            const int ch = ks * 4 + (lane >> 4);
#pragma unroll
            for (int i = 0; i < 4; ++i) { const int row = wm * 64 + i * 16 + (lane & 15); af[i] = *(const bf16x8*)(sa + row * 128 + ((ch ^ (row & 7)) << 4)); }
#pragma unroll
            for (int j = 0; j < 4; ++j) { const int row = wn * 64 + j * 16 + (lane & 15); bfr[j] = *(const bf16x8*)(sb + row * 128 + ((ch ^ (row & 7)) << 4)); }
            __builtin_amdgcn_s_setprio(1);
#pragma unroll
            for (int i = 0; i < 4; ++i)
#pragma unroll
                for (int j = 0; j < 4; ++j) {
                    if (MODE == 0) acc[i][j] = __builtin_amdgcn_mfma_f32_16x16x32_bf16(bfr[j], af[i], acc[i][j], 0, 0, 0);
                    else acc[i][j] = __builtin_amdgcn_mfma_f32_16x16x32_bf16(af[i], bfr[j], acc[i][j], 0, 0, 0);
                }
            __builtin_amdgcn_s_setprio(0);
        }
    };
    stage(0, 0);
    asm volatile("s_waitcnt vmcnt(0)" ::: "memory");
    __syncthreads();
    for (int kt = 0; kt < nk; ++kt) {
        if (kt + 1 < nk) stage(kt + 1, (kt + 1) & 1);
        compute(kt & 1);
        asm volatile("s_waitcnt vmcnt(0)" ::: "memory");
        __syncthreads();
    }
}
template <int MODE>
__device__ __forceinline__ void gemm_mainloop256(const bf16_t* __restrict__ A0, const bf16_t* __restrict__ A1, int lda, int ksplit,
                                                 const bf16_t* __restrict__ Bt, int K, int m0, int n0, f32x4 (&acc)[8][4], char* smem) {
    const int tid = threadIdx.x, lane = tid & 63, wid = tid >> 6, wm = wid >> 1, wn = wid & 1;
#pragma unroll
    for (int i = 0; i < 8; ++i)
#pragma unroll
        for (int j = 0; j < 4; ++j) acc[i][j] = (f32x4){0.f, 0.f, 0.f, 0.f};
    const int nk = K / 32;
    unsigned aoff[4], boff[2];
    {
        const int rr = lane >> 2, cc = ((lane & 3) ^ (3 * ((lane >> 5) & 1))) * 8;
#pragma unroll
        for (int i = 0; i < 4; ++i) aoff[i] = (unsigned)(((m0 + 64 * wid + 16 * i + rr) * lda + cc) * 2);
#pragma unroll
        for (int i = 0; i < 2; ++i) boff[i] = (unsigned)(((n0 + 32 * wid + 16 * i + rr) * K + cc) * 2);
    }
    auto stage = [&](int kt, int buf) {
        const int kb = kt * 32;
        const char* Ab; const char* Bb = (const char*)(Bt + kb);
        if (kb < ksplit) Ab = (const char*)(A0 + kb); else Ab = (const char*)(A1 + (kb - ksplit));
        char* sa = smem + buf * 24576 + wid * 4096 + lane * 16; char* sb = smem + buf * 24576 + 16384 + wid * 2048 + lane * 16;
#pragma unroll
        for (int i = 0; i < 4; ++i) __builtin_amdgcn_global_load_lds((const unsigned*)(Ab + aoff[i]), (unsigned*)(sa + i * 1024), 16, 0, 0);
#pragma unroll
        for (int i = 0; i < 2; ++i) __builtin_amdgcn_global_load_lds((const unsigned*)(Bb + boff[i]), (unsigned*)(sb + i * 1024), 16, 0, 0);
    };
    const int fpos = (((lane >> 4) ^ (3 * ((lane >> 3) & 1))) << 4) + (lane & 15) * 64;
    auto compute = [&](int buf) {
        const char* sa = smem + buf * 24576 + wm * 8192 + fpos; const char* sb = smem + buf * 24576 + 16384 + wn * 4096 + fpos;
        bf16x8 af[8], bfr[4];
#pragma unroll
        for (int i = 0; i < 8; ++i) af[i] = *(const bf16x8*)(sa + i * 1024);
#pragma unroll
        for (int j = 0; j < 4; ++j) bfr[j] = *(const bf16x8*)(sb + j * 1024);
        __builtin_amdgcn_s_setprio(1);
#pragma unroll
        for (int i = 0; i < 8; ++i)
#pragma unroll
            for (int j = 0; j < 4; ++j) {
                if (MODE == 0) acc[i][j] = __builtin_amdgcn_mfma_f32_16x16x32_bf16(bfr[j], af[i], acc[i][j], 0, 0, 0);
                else acc[i][j] = __builtin_amdgcn_mfma_f32_16x16x32_bf16(af[i], bfr[j], acc[i][j], 0, 0, 0);
            }
        __builtin_amdgcn_s_setprio(0);
    };
    stage(0, 0);
    asm volatile("s_waitcnt vmcnt(0)" ::: "memory");
    __syncthreads();
    for (int kt = 0; kt < nk; ++kt) {
        if (kt + 1 < nk) stage(kt + 1, (kt + 1) & 1);
        compute(kt & 1);
        asm volatile("s_waitcnt vmcnt(0)" ::: "memory");
        __syncthreads();
    }
}
__device__ __forceinline__ bool tile_sched(int it, int MT, int NT, int& mt, int& nt) {
    const int xg = blockIdx.x & 7, xi = blockIdx.x >> 3, nper = gridDim.x >> 3;
    const int li = xi + nper * it;
    if (li >= (MT >> 3) * NT) return false;
    const int band = li / (8 * NT), r = li - band * 8 * NT;
    nt = r >> 3; mt = xg * (MT >> 3) + band * 8 + (r & 7);
    return true;
}
__device__ __forceinline__ void store_bf16x4(bf16_t* p, f32x4 v) { uint2 o; o.x = pack2(v[0], v[1]); o.y = pack2(v[2], v[3]); *(uint2*)p = o; }

__device__ __forceinline__ void phase_gemm_in(const Params& p, char* smem) {
    const bf16_t* A = (const bf16_t*)(p.ws + OFF_H); const bf16_t* Bt = (const bf16_t*)(p.ws + OFF_WT_IN);
    bf16_t* R = (bf16_t*)(p.ws + OFF_REGION);
    const int lane = threadIdx.x & 63, wid = threadIdx.x >> 6, wm = wid >> 1, wn = wid & 1;
    constexpr int NT = AB_IN_PAD / 128, MT = T / 128;
    int mt_, nt_;
    for (int it = 0; tile_sched(it, MT, NT, mt_, nt_); ++it) {
        const int m0 = mt_ * 128, n0 = nt_ * 128;
        f32x4 acc[4][4];
        const bool tr = (n0 >= 1024 && n0 < 1536) || (n0 >= 2048 && n0 < 2560);
        if (!tr) {
            gemm_mainloop<0>(A, A, 1024, 1024, Bt, 1024, m0, n0, acc, smem);
#pragma unroll
            for (int i = 0; i < 4; ++i)
#pragma unroll
                for (int j = 0; j < 4; ++j) {
                    const int m = m0 + wm * 64 + i * 16 + (lane & 15), n = n0 + wn * 64 + j * 16 + 4 * (lane >> 4);
                    const f32x4 v = acc[i][j];
                    if (n < 512) store_bf16x4(R + R_QSB + (size_t)m * 512 + n, v * 0.125f);
                    else if (n < 1024) store_bf16x4(R + R_KSB + (size_t)m * 512 + (n - 512), v);
                    else if (n < 1792) store_bf16x4(R + R_QG + (size_t)m * 256 + (n - 1536), v);
                    else if (n < 2048) store_bf16x4(R + R_KG + (size_t)m * 256 + (n - 1792), v);
                    else if (n < 3072) store_bf16x4(R + R_GG + (size_t)m * 512 + (n - 2560), v);
                    else if (n < AB_IN) *(f32x4*)((float*)(R + R_ALR) + (size_t)m * 16 + (n - 3072)) = v;
                }
        } else {
            gemm_mainloop<1>(A, A, 1024, 1024, Bt, 1024, m0, n0, acc, smem);
#pragma unroll
            for (int i = 0; i < 4; ++i)
#pragma unroll
                for (int j = 0; j < 4; ++j) {
                    const int m = m0 + wm * 64 + i * 16 + 4 * (lane >> 4), n = n0 + wn * 64 + j * 16 + (lane & 15);
                    const int b = m >> 11, s = m & 2047;
                    if (n < 1536) { const int c = n - 1024, hh = c >> 6, e = c & 63; store_bf16x4(R + R_VTSB + ((size_t)((b * 8 + hh) * 64 + e)) * 2048 + s, acc[i][j]); }
                    else { const int c = n - 2048, hh = c >> 7, e = c & 127; store_bf16x4(R + R_VTG + ((size_t)((b * 4 + hh) * 128 + e)) * 2048 + s, acc[i][j]); }
                }
        }
    }
}
__device__ __forceinline__ void phase_gemm_resid(const bf16_t* A0, const bf16_t* A1, int lda, int ksplit, const bf16_t* Bt, int K, const float* Rs, float* O, char* smem) {
    const int lane = threadIdx.x & 63, wid = threadIdx.x >> 6, wm = wid >> 1, wn = wid & 1;
    constexpr int NT = 8, MT = T / 256;
    int mt_, nt_;
    for (int it = 0; tile_sched(it, MT, NT, mt_, nt_); ++it) {
        const int m0 = mt_ * 256, n0 = nt_ * 128;
        f32x4 acc[8][4];
        gemm_mainloop256<0>(A0, A1, lda, ksplit, Bt, K, m0, n0, acc, smem);
#pragma unroll
        for (int i = 0; i < 8; ++i)
#pragma unroll
            for (int j = 0; j < 4; ++j) {
                const int m = m0 + wm * 128 + i * 16 + (lane & 15), n = n0 + wn * 64 + j * 16 + 4 * (lane >> 4);
                const f32x4 r = *(const f32x4*)(Rs + (size_t)m * 1024 + n);
                *(f32x4*)(O + (size_t)m * 1024 + n) = r + acc[i][j];
            }
    }
}
__device__ __forceinline__ void phase_gemm_cin(const Params& p, char* smem) {
    const bf16_t* A = (const bf16_t*)(p.ws + OFF_H); const bf16_t* Bt = (const bf16_t*)(p.ws + OFF_WT_CIN);
    bf16_t* U = (bf16_t*)(p.ws + OFF_REGION); bf16_t* VT = U + (size_t)T * 2048; float* SSQ = (float*)(p.ws + OFF_SSQ);
    const int lane = threadIdx.x & 63, wid = threadIdx.x >> 6, wm = wid >> 1, wn = wid & 1;
    constexpr int NT = 32, MT = T / 128;
    int mt_, nt_;
    for (int it = 0; tile_sched(it, MT, NT, mt_, nt_); ++it) {
        const int m0 = mt_ * 128, n0 = nt_ * 128;
        f32x4 acc[4][4];
        if (n0 < 2048) {
            gemm_mainloop<0>(A, A, 1024, 1024, Bt, 1024, m0, n0, acc, smem);
#pragma unroll
            for (int i = 0; i < 4; ++i)
#pragma unroll
                for (int j = 0; j < 4; ++j) {
                    const int m = m0 + wm * 64 + i * 16 + (lane & 15), n = n0 + wn * 64 + j * 16 + 4 * (lane >> 4);
                    f32x4 v = acc[i][j];
#pragma unroll
                    for (int r = 0; r < 4; ++r) v[r] = gelu_exact(v[r]);
                    store_bf16x4(U + (size_t)m * 2048 + n, v);
                }
        } else {
            gemm_mainloop<1>(A, A, 1024, 1024, Bt, 1024, m0, n0, acc, smem);
#pragma unroll
            for (int i = 0; i < 4; ++i) {
                float ss[4] = {0.f, 0.f, 0.f, 0.f};
#pragma unroll
                for (int j = 0; j < 4; ++j) {
                    const int m = m0 + wm * 64 + i * 16 + 4 * (lane >> 4), n = n0 + wn * 64 + j * 16 + (lane & 15);
                    f32x4 v = acc[i][j];
#pragma unroll
                    for (int r = 0; r < 4; ++r) { v[r] = gelu_exact(v[r]); ss[r] += v[r] * v[r]; }
                    const int chunk = m >> 7, s = m & 127, c = n - 2048;
                    store_bf16x4(VT + ((size_t)chunk * 2048 + c) * 128 + s, v);
                }
#pragma unroll
                for (int r = 0; r < 4; ++r) {
                    float v = ss[r];
                    v += __shfl_xor(v, 1); v += __shfl_xor(v, 2); v += __shfl_xor(v, 4); v += __shfl_xor(v, 8);
                    if ((lane & 15) == 0) { const int m = m0 + wm * 64 + i * 16 + 4 * (lane >> 4) + r; SSQ[(size_t)m * 32 + ((n0 - 2048) >> 6) + wn] = v; }
                }
            }
        }
    }
}

typedef float f32x16 __attribute__((ext_vector_type(16)));
__device__ __forceinline__ void sb_fast(const Params& p, char* smem, unsigned* ctr) {
    bf16_t* R = (bf16_t*)(p.ws + OFF_REGION);
    char* KT = smem; char* VTt = smem + 8192;
    volatile int* flags = (volatile int*)(smem + 32768); volatile unsigned* slot = (volatile unsigned*)(smem + 32800);
    const int tid = threadIdx.x, lane = tid & 63, w = tid >> 6, r31 = lane & 31, h = lane >> 5;
    for (;;) {
        __syncthreads();
        if (tid == 0) *slot = atomicAdd(ctr, 1u);
        __syncthreads();
        const unsigned task = *slot;
        if (task >= 2048u) break;
        const int qblk = 15 - (int)(task >> 7), bh = task & 127, b = bh >> 3, hh = bh & 7;
        const int q0 = qblk * 128, qbase = q0 + 32 * w;
        bf16_t* qrow = R + R_QSB + (size_t)(b * 2048 + qbase + r31) * 512 + hh * 64;
        bf16x8 qf[4];
#pragma unroll
        for (int kk = 0; kk < 4; ++kk) qf[kk] = *(const bf16x8*)(qrow + 16 * kk + 8 * h);
        f32x16 oacc[2];
#pragma unroll
        for (int nt = 0; nt < 2; ++nt)
#pragma unroll
            for (int i = 0; i < 16; ++i) oacc[nt][i] = 0.f;
        float Rr = 1.0f;
        const int t = qbase + r31;
        for (int kt = q0 / 64 + 1; kt >= 0; --kt) {
            __syncthreads();
            { const int wd = __all(Rr == 0.f); if (lane == 0) flags[w] = wd; }
            __syncthreads();
            if (flags[0] & flags[1] & flags[2] & flags[3]) break;
            const int s_tile = kt * 64;
#pragma unroll
            for (int i = 0; i < 2; ++i) {
                const int c = tid + 256 * i, row = c >> 3, ch = c & 7;
                const u32x4 kv = *(const u32x4*)(R + R_KSB + (size_t)(b * 2048 + s_tile + row) * 512 + hh * 64 + ch * 8);
                const u32x4 vv = *(const u32x4*)(R + R_VTSB + ((size_t)((b * 8 + hh) * 64 + row)) * 2048 + s_tile + ch * 8);
                *(u32x4*)(KT + row * 128 + ((ch ^ (row & 7)) << 4)) = kv;
                *(uint2*)(VTt + row * 136 + ch * 16) = make_uint2(vv[0], vv[1]);
                *(uint2*)(VTt + row * 136 + ch * 16 + 8) = make_uint2(vv[2], vv[3]);
            }
            __syncthreads();
#pragma unroll
            for (int sbk = 1; sbk >= 0; --sbk) {
                const int key_lo = s_tile + 32 * sbk;
                if (key_lo >= qbase + 31) continue;
                if (__all(Rr == 0.f)) continue;
                f32x16 st;
#pragma unroll
                for (int i = 0; i < 16; ++i) st[i] = 0.f;
                const int krow = 32 * sbk + r31;
#pragma unroll
                for (int kk = 0; kk < 4; ++kk) {
                    const bf16x8 kf = *(const bf16x8*)(KT + krow * 128 + (((2 * kk + h) ^ (krow & 7)) << 4));
                    st = __builtin_amdgcn_mfma_f32_32x32x16_bf16(kf, qf[kk], st, 0, 0, 0);
                }
                float a[16], G[4];
#pragma unroll
                for (int g = 0; g < 4; ++g) {
                    float sg[4], m[4];
#pragma unroll
                    for (int i = 0; i < 4; ++i) {
                        const int s = key_lo + 8 * g + 4 * h + i;
                        const float z = fminf(fmaxf(st[4 * g + i], -80.f), 80.f);
                        const float ez = __expf(-z), sig = 1.0f / (1.0f + ez);
                        const bool valid = s < t;
                        sg[i] = valid ? sig : 0.f; m[i] = valid ? ez * sig : 1.0f;
                    }
                    const float x2 = m[3], x1 = x2 * m[2], x0 = x1 * m[1];
                    G[g] = x0 * m[0];
                    a[4 * g + 3] = sg[3]; a[4 * g + 2] = sg[2] * x2; a[4 * g + 1] = sg[1] * x1; a[4 * g] = sg[0] * x0;
                }
                float Go[4], P[4];
#pragma unroll
                for (int g = 0; g < 4; ++g) { Go[g] = __shfl_xor(G[g], 32); P[g] = G[g] * Go[g]; }
                const float c2 = P[3], c1 = c2 * P[2], c0 = c1 * P[1];
                float Tg[4];
                Tg[3] = Rr; Tg[2] = Rr * c2; Tg[1] = Rr * c1; Tg[0] = Rr * c0;
#pragma unroll
                for (int g = 0; g < 4; ++g) {
                    const float tg = (h == 0) ? Tg[g] * Go[g] : Tg[g];
                    a[4 * g] *= tg; a[4 * g + 1] *= tg; a[4 * g + 2] *= tg; a[4 * g + 3] *= tg;
                }
                Rr = Rr * c0 * P[0];
#pragma unroll
                for (int s2 = 0; s2 < 2; ++s2) {
                    union { bf16x8 v; unsigned u[4]; } af;
#pragma unroll
                    for (int j2 = 0; j2 < 4; ++j2) af.u[j2] = pack2(a[8 * s2 + 2 * j2], a[8 * s2 + 2 * j2 + 1]);
#pragma unroll
                    for (int nt = 0; nt < 2; ++nt) {
                        const char* vp = VTt + (32 * nt + r31) * 136 + 64 * sbk + 32 * s2 + 8 * h;
                        union { bf16x8 v; uint2 hh2[2]; } vf;
                        vf.hh2[0] = *(const uint2*)vp; vf.hh2[1] = *(const uint2*)(vp + 16);
                        oacc[nt] = __builtin_amdgcn_mfma_f32_32x32x16_bf16(af.v, vf.v, oacc[nt], 0, 0, 0);
                    }
                }
            }
        }
#pragma unroll
        for (int nt = 0; nt < 2; ++nt)
#pragma unroll
            for (int i = 0; i < 16; ++i) {
                const int qq = (i & 3) + 8 * (i >> 2) + 4 * h;
                R[R_QSB + (size_t)(b * 2048 + qbase + qq) * 512 + hh * 64 + 32 * nt + r31] = f2bf(oacc[nt][i]);
            }
    }
}
__device__ __forceinline__ float log_sigmoid(float x) { return fminf(x, 0.f) - log1pf(__expf(-fabsf(x))); }
__device__ __forceinline__ int swz(int row, int chunk) { return row * 128 + ((chunk ^ (row & 7)) << 4); }
__device__ __forceinline__ void gla_prep(const Params& p, char* smem) {
    bf16_t* R = (bf16_t*)(p.ws + OFF_REGION);
    const float* ALR = (const float*)(R + R_ALR);
    bf16_t* KOTg = R + R_KOT; float* DECg = (float*)(R + R_DEC);
    float* SEG = (float*)smem; float* ALRs = SEG + 256;
    const int tid = threadIdx.x, d = tid & 63, w = tid >> 6;
    for (int task = blockIdx.x; task < 2048; task += gridDim.x) {
        const int bh = task >> 5, c = task & 31, b = bh >> 2, hh = bh & 3;
        const size_t rowbase = (size_t)b * 2048 + c * 64;
        unsigned qr[16], kr[16];
#pragma unroll
        for (int i = 0; i < 16; ++i) { const size_t row = rowbase + w * 16 + i; qr[i] = R[R_QG + row * 256 + hh * 64 + d]; kr[i] = R[R_KG + row * 256 + hh * 64 + d]; }
        const f32x4 ar = *(const f32x4*)(ALR + rowbase * 16 + tid * 4);
        float w2r[16];
#pragma unroll
        for (int r = 0; r < 16; ++r) w2r[r] = p.ab_w_alpha2[r * 256 + hh * 64 + d];
        const float b2r = p.ab_b_alpha2[hh * 64 + d];
        __syncthreads();
        *(f32x4*)(ALRs + tid * 4) = ar;
        __syncthreads();
        float cs[16]; float run = 0.f;
#pragma unroll
        for (int i = 0; i < 16; ++i) {
            const float* al = ALRs + (w * 16 + i) * 16;
            float pre = b2r;
#pragma unroll
            for (int r = 0; r < 16; ++r) pre += al[r] * w2r[r];
            run += log_sigmoid(pre) * (1.0f / 16.0f);
            cs[i] = run;
        }
        SEG[w * 64 + d] = run;
        __syncthreads();
        float off = 0.f, tot = 0.f;
#pragma unroll
        for (int w2 = 0; w2 < 4; ++w2) { const float s = SEG[w2 * 64 + d]; tot += s; if (w2 < w) off += s; }
        unsigned kop[8];
#pragma unroll
        for (int i2 = 0; i2 < 8; ++i2) {
            float kov[2];
#pragma unroll
            for (int u = 0; u < 2; ++u) {
                const int i = 2 * i2 + u;
                const float bc = off + cs[i];
                const float kv = bf2f((bf16_t)kr[i]);
                const size_t row = rowbase + w * 16 + i;
                R[R_QG + row * 256 + hh * 64 + d] = f2bf(bf2f((bf16_t)qr[i]) * 0.125f * __expf(bc));
                R[R_KG + row * 256 + hh * 64 + d] = f2bf(kv * __expf(-bc));
                kov[u] = kv * __expf(tot - bc);
            }
            kop[i2] = pack2(kov[0], kov[1]);
        }
        bf16_t* kp = KOTg + ((size_t)task * 64 + d) * 64 + w * 16;
        *(uint4*)kp = make_uint4(kop[0], kop[1], kop[2], kop[3]);
        *(uint4*)(kp + 8) = make_uint4(kop[4], kop[5], kop[6], kop[7]);
        if (w == 0) DECg[(size_t)task * 64 + d] = __expf(tot);
    }
}
__device__ __forceinline__ void gla_scan(const Params& p, char* smem, bool dry = false) {
    bf16_t* R = (bf16_t*)(p.ws + OFF_REGION);
    const bf16_t* KOTg = R + R_KOT; const float* DECg = (const float*)(R + R_DEC);
    char* QS = smem; char* KS = smem + 8192; char* KOT = smem + 16384; char* VTs = smem + 24576; char* SPT = smem + 40960;
    float* DEC = (float*)(smem + 57344); float* GN = DEC + 64;
    const int tid = threadIdx.x, lane = tid & 63, w = tid >> 6, l15_ = lane & 15, q4 = lane >> 4;
    for (int task = blockIdx.x; task < 64; task += gridDim.x) {
        const int b = task >> 2, hh = task & 3;
        f32x4 Sacc[8];
#pragma unroll
        for (int nt = 0; nt < 8; ++nt) Sacc[nt] = (f32x4){0.f, 0.f, 0.f, 0.f};
        __syncthreads();
        for (int i = tid; i < 1024; i += 256) *(uint4*)(SPT + i * 16) = make_uint4(0, 0, 0, 0);
        if (tid < 128) GN[tid] = p.ab_gla_norm[hh * 128 + tid];
        const size_t rowbase = (size_t)b * 2048;
        const bf16_t* vbase = R + R_VTG + ((size_t)((b * 4 + hh) * 128)) * 2048;
        u32x4 tq[2], tk[2], tko[2], vr[4]; float td = 0.f;
        auto prefetch = [&](int c) {
            const int t0 = c * 64;
#pragma unroll
            for (int i = 0; i < 2; ++i) {
                const int cid = tid + 256 * i, row = cid >> 3, ch = cid & 7;
                tq[i] = *(const u32x4*)(R + R_QG + (rowbase + t0 + row) * 256 + hh * 64 + ch * 8);
                tk[i] = *(const u32x4*)(R + R_KG + (rowbase + t0 + row) * 256 + hh * 64 + ch * 8);
                tko[i] = *(const u32x4*)(KOTg + (((size_t)task * 32 + c) * 64 + row) * 64 + ch * 8);
            }
#pragma unroll
            for (int i = 0; i < 4; ++i) { const int cid = tid + 256 * i, e = cid >> 3, ch = cid & 7; vr[i] = *(const u32x4*)(vbase + (size_t)e * 2048 + t0 + ch * 8); }
            if (tid < 64) td = DECg[((size_t)task * 32 + c) * 64 + tid];
        };
        prefetch(0);
        for (int c = 0; c < 32; ++c) {
            int lz = 0; asm volatile("" : "+v"(lz));
            const int l15 = l15_ + lz;
            const int cx = (q4 ^ (l15 & 7)) << 4;
            const int rb0 = l15 * 128 + cx, rb1 = l15 * 128 + (cx ^ 64);
#pragma unroll
            for (int i = 0; i < 2; ++i) {
                const int cid = tid + 256 * i + lz, row = cid >> 3, ch = cid & 7;
                *(u32x4*)(QS + swz(row, ch)) = tq[i]; *(u32x4*)(KS + swz(row, ch)) = tk[i]; *(u32x4*)(KOT + swz(row, ch)) = tko[i];
            }
#pragma unroll
            for (int i = 0; i < 4; ++i) { const int cid = tid + 256 * i + lz, e = cid >> 3, ch = cid & 7; *(u32x4*)(VTs + swz(e, ch)) = vr[i]; }
            if (tid < 64) DEC[tid] = td;
            uint2 gr[8];
            const unsigned goff = (unsigned)((rowbase + c * 64 + 16 * w + l15) * 512 + hh * 128 + 4 * q4);
            bf16_t* const gbase = R + R_GG;
#pragma unroll
            for (int nt = 0; nt < 8; ++nt) gr[nt] = *(const uint2*)(gbase + (goff + 16 * nt));
            if (c + 1 < 32) prefetch(c + 1);
            __syncthreads();
            bf16x8 qf[2];
#pragma unroll
            for (int kk = 0; kk < 2; ++kk) qf[kk] = *(const bf16x8*)(QS + w * 2048 + (kk ? rb1 : rb0));
            f32x4 sT[4];
#pragma unroll
            for (int st = 0; st < 4; ++st) {
                sT[st] = (f32x4){0.f, 0.f, 0.f, 0.f};
                if (st <= w) {
#pragma unroll
                    for (int kk = 0; kk < 2; ++kk) { const bf16x8 kf = *(const bf16x8*)(KS + st * 2048 + (kk ? rb1 : rb0)); sT[st] = __builtin_amdgcn_mfma_f32_16x16x32_bf16(kf, qf[kk], sT[st], 0, 0, 0); }
#pragma unroll
                    for (int r = 0; r < 4; ++r) if (16 * st + 4 * q4 + r > 16 * w + l15) sT[st][r] = 0.f;
                }
            }
            bf16x8 af[2];
#pragma unroll
            for (int ks2 = 0; ks2 < 2; ++ks2) {
                union { bf16x8 v; unsigned u[4]; } cv;
                cv.u[0] = pack2(sT[2 * ks2][0], sT[2 * ks2][1]); cv.u[1] = pack2(sT[2 * ks2][2], sT[2 * ks2][3]);
                cv.u[2] = pack2(sT[2 * ks2 + 1][0], sT[2 * ks2 + 1][1]); cv.u[3] = pack2(sT[2 * ks2 + 1][2], sT[2 * ks2 + 1][3]);
                af[ks2] = cv.v;
            }
            const int vb = l15 * 128 + ((((q4 >> 1) ^ (l15 & 7)) << 4) | ((q4 & 1) * 8));
            f32x4 o[8];
#pragma unroll
            for (int nt = 0; nt < 8; ++nt) {
                o[nt] = (f32x4){0.f, 0.f, 0.f, 0.f};
                const int e = 16 * nt + l15;
#pragma unroll
                for (int kk = 0; kk < 2; ++kk) { const bf16x8 sf = *(const bf16x8*)(SPT + nt * 2048 + (kk ? rb1 : rb0)); o[nt] = __builtin_amdgcn_mfma_f32_16x16x32_bf16(sf, qf[kk], o[nt], 0, 0, 0); }
#pragma unroll
                for (int ks2 = 0; ks2 < 2; ++ks2) {
                    if (2 * ks2 <= w) {
                        union { bf16x8 v; uint2 h[2]; } cv;
                        cv.h[0] = *(const uint2*)(VTs + nt * 2048 + (vb ^ (ks2 * 64)));
                        cv.h[1] = *(const uint2*)(VTs + nt * 2048 + (vb ^ (ks2 * 64) ^ 32));
                        o[nt] = __builtin_amdgcn_mfma_f32_16x16x32_bf16(cv.v, af[ks2], o[nt], 0, 0, 0);
                    }
                }
            }
            {
                const float4 dc = *(const float4*)(DEC + 16 * w + 4 * q4);
                bf16x8 kof[2];
#pragma unroll
                for (int kk = 0; kk < 2; ++kk) kof[kk] = *(const bf16x8*)(KOT + w * 2048 + (kk ? rb1 : rb0));
#pragma unroll
                for (int nt = 0; nt < 8; ++nt) {
                    Sacc[nt][0] *= dc.x; Sacc[nt][1] *= dc.y; Sacc[nt][2] *= dc.z; Sacc[nt][3] *= dc.w;
#pragma unroll
                    for (int kk = 0; kk < 2; ++kk) { const bf16x8 vf = *(const bf16x8*)(VTs + nt * 2048 + (kk ? rb1 : rb0)); Sacc[nt] = __builtin_amdgcn_mfma_f32_16x16x32_bf16(kof[kk], vf, Sacc[nt], 0, 0, 0); }
                }
            }
            __syncthreads();
#pragma unroll
            for (int nt = 0; nt < 8; ++nt) {
                const int e = 16 * nt + l15;
                uint2 pk; pk.x = pack2(Sacc[nt][0], Sacc[nt][1]); pk.y = pack2(Sacc[nt][2], Sacc[nt][3]);
                *(uint2*)(SPT + nt * 2048 + l15 * 128 + (((2 * w + (q4 >> 1)) ^ (l15 & 7)) << 4) + (q4 & 1) * 8) = pk;
            }
            float ssq = 0.f;
#pragma unroll
            for (int nt = 0; nt < 8; ++nt) ssq += (o[nt][0] * o[nt][0] + o[nt][1] * o[nt][1]) + (o[nt][2] * o[nt][2] + o[nt][3] * o[nt][3]);
            ssq += __shfl_xor(ssq, 16); ssq += __shfl_xor(ssq, 32);
            const float rsd = rsqrtf(ssq * (1.0f / 128.0f) + EPS);
#pragma unroll
            for (int nt = 0; nt < 8; ++nt) {
                asm volatile("" ::: "memory");
                const f32x4 gn = *(const f32x4*)(GN + 16 * nt + 4 * q4);
                const float g0 = lo2f(gr[nt].x), g1 = hi2f(gr[nt].x), g2 = lo2f(gr[nt].y), g3 = hi2f(gr[nt].y);
                uint2 ov;
                ov.x = pack2(o[nt][0] * rsd * gn[0] * (g0 / (1.0f + __expf(-g0))), o[nt][1] * rsd * gn[1] * (g1 / (1.0f + __expf(-g1))));
                ov.y = pack2(o[nt][2] * rsd * gn[2] * (g2 / (1.0f + __expf(-g2))), o[nt][3] * rsd * gn[3] * (g3 / (1.0f + __expf(-g3))));
                if (!dry || ov.x == 0x7fc17fc1u) *(uint2*)(gbase + (goff + 16 * nt)) = ov;
            }
        }
    }
}

__device__ __forceinline__ unsigned ord_key(float f) { const unsigned u = __float_as_uint(f); return (u & 0x80000000u) ? ~u : (u | 0x80000000u); }
__device__ __forceinline__ float unord_key(unsigned k) { return __uint_as_float((k & 0x80000000u) ? (k & 0x7fffffffu) : ~k); }
__device__ __forceinline__ void ce_desc(unsigned& a, unsigned& b) { const unsigned hi = max(a, b), lo = min(a, b); a = hi; b = lo; }
__device__ __forceinline__ void bitonic_sort16_desc(unsigned (&a)[16]) {
#pragma unroll
    for (int k = 2; k <= 16; k <<= 1)
#pragma unroll
        for (int j = k >> 1; j > 0; j >>= 1)
#pragma unroll
            for (int i = 0; i < 16; ++i) { const int l = i ^ j; if (l > i) { if ((i & k) == 0) ce_desc(a[i], a[l]); else ce_desc(a[l], a[i]); } }
}
__device__ __forceinline__ void merge_top16(unsigned (&L)[16], const unsigned (&B)[16]) {
#pragma unroll
    for (int i = 0; i < 16; ++i) L[i] = max(L[i], B[15 - i]);
#pragma unroll
    for (int j = 8; j > 0; j >>= 1)
#pragma unroll
        for (int i = 0; i < 16; ++i) { const int l = i ^ j; if (l > i) ce_desc(L[i], L[l]); }
}
__device__ constexpr int cand_i(int n) { int c = 0; for (int i = 0; i < 16; ++i) for (int j = 0; j < 16; ++j) if ((i + 1) * (j + 1) <= 16) { if (c == n) return i; ++c; } return -1; }
__device__ constexpr int cand_j(int n) { int c = 0; for (int i = 0; i < 16; ++i) for (int j = 0; j < 16; ++j) if ((i + 1) * (j + 1) <= 16) { if (c == n) return j; ++c; } return -1; }
template <int N> struct CandTab { int i[N], j[N]; constexpr CandTab() : i(), j() { for (int n = 0; n < N; ++n) { i[n] = cand_i(n); j[n] = cand_j(n); } } };
__device__ __forceinline__ void peer_select_fast(const Params& p, int layer, char* smem) {
    const bf16_t* A = (const bf16_t*)(p.ws + OFF_H);
    const bf16_t* Bt = (const bf16_t*)(p.ws + OFF_WT_Q) + (size_t)layer * 2048 * 1024;
    const bf16_t* SK = (const bf16_t*)(p.ws + OFF_SK) + (size_t)layer * 8 * 2 * 128 * 128;
    unsigned short* IDX = (unsigned short*)(p.ws + OFF_IDX); float* GATE = (float*)(p.ws + OFF_GATE);
    const int tid_ = threadIdx.x;
    float* SC = (float*)smem; unsigned* XCH = (unsigned*)smem;
    int mt_, hh;
    for (int it = 0; tile_sched(it, T / 128, 8, mt_, hh); ++it) {
        const int m0 = mt_ * 128;
        unsigned L0[16], L1[16];
#pragma unroll
        for (int pp = 0; pp < 2; ++pp) {
            f32x4 acc[4][4];
            gemm_mainloop<0>(A, A, 1024, 1024, Bt, 1024, m0, hh * 256 + pp * 128, acc, smem);
            int lz = 0; asm volatile("" : "+v"(lz));
            const int tid = tid_ + lz, lane = tid & 63, wid = tid >> 6, wm = wid >> 1, wn = wid & 1, l15 = lane & 15, q4 = lane >> 4, token = tid & 127, half = tid >> 7;
#pragma unroll
            for (int i = 0; i < 4; ++i)
#pragma unroll
                for (int j = 0; j < 4; ++j) {
                    const int row = wm * 64 + i * 16 + l15, chunk = 2 * j + (q4 >> 1);
                    uint2 o; o.x = pack2(acc[i][j][0], acc[i][j][1]); o.y = pack2(acc[i][j][2], acc[i][j][3]);
                    *(uint2*)(smem + wn * 32768 + row * 128 + ((chunk ^ (row & 7)) << 4) + (q4 & 1) * 8) = o;
                }
            const bf16_t* SKp = SK + (size_t)((hh * 2 + pp) * 128) * 128;
#pragma unroll
            for (int i = 0; i < 8; ++i) {
                const int c = tid + 256 * i, row = c >> 4, ch16 = c & 15, ks = ch16 >> 3, ch = ch16 & 7;
                *(uint4*)(smem + ks * 32768 + 16384 + row * 128 + ((ch ^ (row & 7)) << 4)) = *(const uint4*)(SKp + (size_t)row * 128 + ch16 * 8);
            }
            __syncthreads();
#pragma unroll
            for (int i = 0; i < 4; ++i)
#pragma unroll
                for (int j = 0; j < 4; ++j) acc[i][j] = (f32x4){0.f, 0.f, 0.f, 0.f};
#pragma unroll
            for (int kt = 0; kt < 2; ++kt) {
                const char* sa = smem + kt * 32768; const char* sb = sa + 16384;
#pragma unroll
                for (int ks = 0; ks < 2; ++ks) {
                    bf16x8 af[4], bfr[4];
                    const int ch = ks * 4 + q4;
#pragma unroll
                    for (int i = 0; i < 4; ++i) { const int row = wm * 64 + i * 16 + l15; af[i] = *(const bf16x8*)(sa + row * 128 + ((ch ^ (row & 7)) << 4)); }
#pragma unroll
                    for (int j = 0; j < 4; ++j) { const int row = wn * 64 + j * 16 + l15; bfr[j] = *(const bf16x8*)(sb + row * 128 + ((ch ^ (row & 7)) << 4)); }
#pragma unroll
                    for (int i = 0; i < 4; ++i)
#pragma unroll
                        for (int j = 0; j < 4; ++j) acc[i][j] = __builtin_amdgcn_mfma_f32_16x16x32_bf16(bfr[j], af[i], acc[i][j], 0, 0, 0);
                }
            }
            __syncthreads();
#pragma unroll
            for (int i = 0; i < 4; ++i)
#pragma unroll
                for (int j = 0; j < 4; ++j) {
                    const int m = wm * 64 + i * 16 + l15, n = wn * 64 + j * 16 + 4 * q4;
#pragma unroll
                    for (int r = 0; r < 4; ++r) SC[m * 128 + ((n + r) ^ (m & 31))] = acc[i][j][r];
                }
            __syncthreads();
            unsigned L[16];
            {
                const float* srow = SC + token * 128 + half * 64; const int x = token & 31;
#pragma unroll
                for (int ch = 0; ch < 4; ++ch) {
                    unsigned Cc[16];
#pragma unroll
                    for (int i = 0; i < 16; ++i) { const int c = ch * 16 + i; Cc[i] = (ord_key(srow[c ^ x]) & ~127u) | (unsigned)(127 - (half * 64 + c)); }
                    bitonic_sort16_desc(Cc);
                    if (ch == 0) {
#pragma unroll
                        for (int i = 0; i < 16; ++i) L[i] = Cc[i];
                    } else merge_top16(L, Cc);
                }
            }
            __syncthreads();
            if (half == 1) {
#pragma unroll
                for (int i = 0; i < 16; ++i) XCH[token * 17 + i] = L[i];
            }
            __syncthreads();
            if (half == 0) {
                unsigned Xc[16];
#pragma unroll
                for (int i = 0; i < 16; ++i) Xc[i] = XCH[token * 17 + i];
                merge_top16(L, Xc);
            }
#pragma unroll
            for (int i = 0; i < 16; ++i) { if (pp == 0) L0[i] = L[i]; else L1[i] = L[i]; }
            __syncthreads();
        }
        unsigned* NIDX = (unsigned*)smem;
        const int token = tid_ & 127, half = tid_ >> 7;
        if (half == 0) {
            float s0[16], s1[16];
#pragma unroll
            for (int i = 0; i < 16; ++i) { s0[i] = unord_key(L0[i] & ~127u); s1[i] = unord_key(L1[i] & ~127u); }
            constexpr CandTab<64> ct{};
            unsigned C[16];
#pragma unroll
            for (int ch = 0; ch < 4; ++ch) {
                unsigned Cc[16];
#pragma unroll
                for (int i = 0; i < 16; ++i) {
                    const int n = ch * 16 + i;
                    if (ct.i[n] >= 0) Cc[i] = (ord_key(s0[ct.i[n] < 0 ? 0 : ct.i[n]] + s1[ct.j[n] < 0 ? 0 : ct.j[n]]) & ~255u) | (unsigned)(255 - (ct.i[n] * 16 + ct.j[n]));
                    else Cc[i] = 0u;
                }
                bitonic_sort16_desc(Cc);
                if (ch == 0) {
#pragma unroll
                    for (int i = 0; i < 16; ++i) C[i] = Cc[i];
                } else merge_top16(C, Cc);
            }
#pragma unroll
            for (int i = 0; i < 16; ++i) { NIDX[token * 33 + i] = 127u - (L0[i] & 127u); NIDX[token * 33 + 16 + i] = 127u - (L1[i] & 127u); }
            const float mx = unord_key(C[0] & ~255u);
            float e[16]; float sum = 0.f;
#pragma unroll
            for (int r = 0; r < 16; ++r) { e[r] = __expf(unord_key(C[r] & ~255u) - mx); sum += e[r]; }
            const float inv = 1.0f / sum;
            const size_t ob = (size_t)(m0 + token) * 128 + hh * 16;
#pragma unroll
            for (int r = 0; r < 16; ++r) {
                const unsigned code = 255u - (C[r] & 255u);
                const unsigned e0 = NIDX[token * 33 + (code >> 4)], e1 = NIDX[token * 33 + 16 + (code & 15)];
                IDX[ob + r] = (unsigned short)(e0 * 128 + e1);
                GATE[ob + r] = e[r] * inv;
            }
        }
        __syncthreads();
    }
}

__device__ __forceinline__ float ub0(unsigned w) { float f; asm("v_cvt_f32_ubyte0 %0, %1" : "=v"(f) : "v"(w)); return f; }
__device__ __forceinline__ float ub1(unsigned w) { float f; asm("v_cvt_f32_ubyte1 %0, %1" : "=v"(f) : "v"(w)); return f; }
__device__ __forceinline__ float ub2(unsigned w) { float f; asm("v_cvt_f32_ubyte2 %0, %1" : "=v"(f) : "v"(w)); return f; }
__device__ __forceinline__ float ub3(unsigned w) { float f; asm("v_cvt_f32_ubyte3 %0, %1" : "=v"(f) : "v"(w)); return f; }
typedef _Float16 f16x2 __attribute__((ext_vector_type(2)));
__device__ __forceinline__ float row16_sum(float v) {
    v += __builtin_bit_cast(float, __builtin_amdgcn_update_dpp(0, __builtin_bit_cast(int, v), 0x128, 0xf, 0xf, false));
    v += __builtin_bit_cast(float, __builtin_amdgcn_update_dpp(0, __builtin_bit_cast(int, v), 0x124, 0xf, 0xf, false));
    v += __builtin_bit_cast(float, __builtin_amdgcn_update_dpp(0, __builtin_bit_cast(int, v), 0x122, 0xf, 0xf, false));
    v += __builtin_bit_cast(float, __builtin_amdgcn_update_dpp(0, __builtin_bit_cast(int, v), 0x121, 0xf, 0xf, false));
    return v;
}
__device__ __forceinline__ void glds16(const void* gsrc, unsigned lds_dst) {
    unsigned keep; const unsigned d = (unsigned)__builtin_amdgcn_readfirstlane((int)lds_dst);
    asm volatile("s_mov_b32 %0, m0\n\ts_mov_b32 m0, %2\n\ts_nop 0\n\tglobal_load_lds_dwordx4 %1, off\n\ts_mov_b32 m0, %0" : "=&s"(keep) : "v"(gsrc), "s"(d) : "memory");
}
__device__ __forceinline__ void peer_gather(const Params& p, int layer, const float* __restrict__ gnext, bool final_out, char* smem) {
    const unsigned char* REC = p.ws + OFF_UT + (size_t)layer * NEXP * 1152;
    bf16_t* H = (bf16_t*)(p.ws + OFF_H);
    const unsigned short* IDX = (const unsigned short*)(p.ws + OFF_IDX); const float* GATE = (const float*)(p.ws + OFF_GATE);
    float* X = p.out;
    const int lane = threadIdx.x & 63, wid = threadIdx.x >> 6, sub = lane >> 4, li = lane & 15;
    char* wbase = smem + wid * 19456;
    unsigned short* sIdx = (unsigned short*)wbase; float* sGate = (float*)(wbase + 256);
    const char* ring = wbase + 1024; const unsigned ringb = (unsigned)(size_t)ring;
    const int gw = blockIdx.x * 4 + wid, nw = gridDim.x * 4;
    for (int t = gw; t < T; t += nw) {
        {
            int lz = 0; asm volatile("" : "+v"(lz));
            const int l2 = 2 * (lane + lz);
            const unsigned idp = *(const unsigned*)(IDX + (size_t)t * 128 + l2);
            const float2 g2 = *(const float2*)(GATE + (size_t)t * 128 + l2);
            *(unsigned*)(sIdx + l2) = idp; *(float2*)(sGate + l2) = g2;
        }
        int xq[2][8]; float sx; float xg[2];
        {
            u32x4 xr[8]; float am = 0.f;
#pragma unroll
            for (int k = 0; k < 8; ++k) {
                xr[k] = *(const u32x4*)(H + (size_t)t * 1024 + (16 * (k >> 2) + li) * 32 + (k & 3) * 8);
#pragma unroll
                for (int c = 0; c < 4; ++c) am = fmaxf(am, fmaxf(fabsf(lo2f(xr[k][c])), fabsf(hi2f(xr[k][c]))));
            }
            am = fmaxf(am, __shfl_xor(am, 1)); am = fmaxf(am, __shfl_xor(am, 2)); am = fmaxf(am, __shfl_xor(am, 4)); am = fmaxf(am, __shfl_xor(am, 8));
            const float inv = am > 0.f ? 127.0f / am : 0.f;
            sx = am * (1.0f / 127.0f);
#pragma unroll
            for (int j = 0; j < 2; ++j) {
                int xs = 0;
#pragma unroll
                for (int d = 0; d < 8; ++d) {
                    const unsigned w0 = xr[j * 4 + (d >> 1)][(d & 1) * 2], w1 = xr[j * 4 + (d >> 1)][(d & 1) * 2 + 1];
                    const int q0 = __float2int_rn(lo2f(w0) * inv), q1 = __float2int_rn(hi2f(w0) * inv), q2 = __float2int_rn(lo2f(w1) * inv), q3 = __float2int_rn(hi2f(w1) * inv);
                    xq[j][d] = (q0 & 0xff) | ((q1 & 0xff) << 8) | ((q2 & 0xff) << 16) | ((q3 & 0xff) << 24);
                    xs += (q0 + q1) + (q2 + q3);
                }
                xg[j] = -7.5f * (float)xs;
            }
        }
        f16x2 accp[2][16];
#pragma unroll
        for (int j = 0; j < 2; ++j)
#pragma unroll
            for (int c = 0; c < 16; ++c) accp[j][c] = (f16x2){(_Float16)0.f, (_Float16)0.f};
        float wsg[2] = {0.f, 0.f};
        auto issue = [&](int sg) {
            const unsigned e_ = sIdx[sg * 4 + sub];
            const unsigned char* rec = REC + (size_t)e_ * 1152 + li * 16;
            const unsigned dst = ringb + (unsigned)(sg & 3) * 4608u;
            glds16(rec, dst); glds16(rec + 256, dst + 1024u); glds16(rec + 512, dst + 2048u); glds16(rec + 768, dst + 3072u);
            if (lane < 32) {
                const unsigned e2 = sIdx[sg * 4 + (lane >> 3)];
                glds16(REC + (size_t)e2 * 1152 + 1024 + (lane & 7) * 16, dst + 4096u);
            }
        };
        auto compute = [&](int sg) {
            const char* sl = ring + (sg & 3) * 4608;
            const u32x4 du0 = *(const u32x4*)(sl + lane * 16), du1 = *(const u32x4*)(sl + 1024 + lane * 16);
            const u32x4 dv0 = *(const u32x4*)(sl + 2048 + lane * 16), dv1 = *(const u32x4*)(sl + 3072 + lane * 16);
            const uint2 sc = *(const uint2*)(sl + 4096 + sub * 128 + li * 8);
            const float gt = sGate[sg * 4 + sub];
            const f16x2 us = __builtin_bit_cast(f16x2, sc.x), vs = __builtin_bit_cast(f16x2, sc.y);
            float pa = 0.f;
#pragma unroll
            for (int j = 0; j < 2; ++j) {
                int ia = 0;
#pragma unroll
                for (int d = 0; d < 4; ++d) {
                    const unsigned w = j ? du1[d] : du0[d];
                    ia = __builtin_amdgcn_sdot4((int)(w & 0x0f0f0f0fu), xq[j][2 * d], ia, false);
                    ia = __builtin_amdgcn_sdot4((int)((w >> 4) & 0x0f0f0f0fu), xq[j][2 * d + 1], ia, false);
                }
                pa += (float)us[j] * ((float)ia + xg[j]);
            }
            pa = row16_sum(pa);
            const float ww = gt * gelu_exact(pa * sx);
#pragma unroll
            for (int j = 0; j < 2; ++j) {
                const float wg = ww * (float)vs[j];
                wsg[j] += wg;
                const _Float16 wh = (_Float16)fminf(fmaxf(wg * 65536.0f, -65504.0f), 65504.0f);
                const f16x2 w2 = {wh, wh};
#pragma unroll
                for (int d = 0; d < 4; ++d) {
                    const unsigned wv = j ? dv1[d] : dv0[d];
                    const f16x2 c0 = __builtin_bit_cast(f16x2, (wv << 4) & 0x00f000f0u), c1 = __builtin_bit_cast(f16x2, wv & 0x00f000f0u);
                    const f16x2 c2 = __builtin_bit_cast(f16x2, (wv >> 4) & 0x00f000f0u), c3 = __builtin_bit_cast(f16x2, (wv >> 8) & 0x00f000f0u);
                    accp[j][4 * d + 0] = __builtin_elementwise_fma(c0, w2, accp[j][4 * d + 0]); accp[j][4 * d + 1] = __builtin_elementwise_fma(c1, w2, accp[j][4 * d + 1]);
                    accp[j][4 * d + 2] = __builtin_elementwise_fma(c2, w2, accp[j][4 * d + 2]); accp[j][4 * d + 3] = __builtin_elementwise_fma(c3, w2, accp[j][4 * d + 3]);
                }
            }
        };
        asm volatile("s_waitcnt vmcnt(0)" ::: "memory");
        issue(0); issue(1); issue(2);
#pragma unroll 1
        for (int sg = 0; sg < 29; ++sg) {
            issue(sg + 3);
            asm volatile("s_waitcnt vmcnt(15)" ::: "memory");
            compute(sg);
        }
        asm volatile("s_waitcnt vmcnt(10)" ::: "memory");
        compute(29);
        asm volatile("s_waitcnt vmcnt(5)" ::: "memory");
        compute(30);
        asm volatile("s_waitcnt vmcnt(0)" ::: "memory");
        compute(31);
        float acc[2][32];
#pragma unroll
        for (int j = 0; j < 2; ++j)
#pragma unroll
            for (int d = 0; d < 4; ++d) {
                acc[j][8 * d + 0] = 16.0f * (float)accp[j][4 * d + 0][0]; acc[j][8 * d + 2] = 16.0f * (float)accp[j][4 * d + 0][1];
                acc[j][8 * d + 4] = 16.0f * (float)accp[j][4 * d + 1][0]; acc[j][8 * d + 6] = 16.0f * (float)accp[j][4 * d + 1][1];
                acc[j][8 * d + 1] = 16.0f * (float)accp[j][4 * d + 2][0]; acc[j][8 * d + 3] = 16.0f * (float)accp[j][4 * d + 2][1];
                acc[j][8 * d + 5] = 16.0f * (float)accp[j][4 * d + 3][0]; acc[j][8 * d + 7] = 16.0f * (float)accp[j][4 * d + 3][1];
            }
        const bool up2 = (sub & 2) != 0, up1 = (sub & 1) != 0;
        float wsum = (up2 ? wsg[1] : wsg[0]) + __shfl_xor(up2 ? wsg[0] : wsg[1], 32);
        wsum += __shfl_xor(wsum, 16);
        float r1[32];
#pragma unroll
        for (int c = 0; c < 32; ++c) r1[c] = (up2 ? acc[1][c] : acc[0][c]) + __shfl_xor(up2 ? acc[0][c] : acc[1][c], 32);
        float r2[16];
#pragma unroll
        for (int c = 0; c < 16; ++c) r2[c] = (up1 ? r1[16 + c] : r1[c]) + __shfl_xor(up1 ? r1[c] : r1[16 + c], 16);
        const int col0 = (16 * (sub >> 1) + li) * 32 + (sub & 1) * 16;
        float ss = 0.f;
        float* xrow = X + (size_t)t * 1024 + col0;
#pragma unroll
        for (int c4 = 0; c4 < 4; ++c4) {
            const f32x4 a = *(const f32x4*)(xrow + c4 * 4);
#pragma unroll
            for (int c = 0; c < 4; ++c) { r2[c4 * 4 + c] = r2[c4 * 4 + c] - 7.5f * wsum + a[c]; ss += r2[c4 * 4 + c] * r2[c4 * 4 + c]; }
        }
        ss = wave_sum(ss);
        const float rstd = rsqrtf(ss * (1.0f / D) + EPS);
        const float* gp = gnext + col0;
        if (final_out) {
#pragma unroll
            for (int c4 = 0; c4 < 4; ++c4) {
                const f32x4 g = *(const f32x4*)(gp + c4 * 4);
                *(f32x4*)(xrow + c4 * 4) = (f32x4){r2[c4 * 4] * rstd * g[0], r2[c4 * 4 + 1] * rstd * g[1], r2[c4 * 4 + 2] * rstd * g[2], r2[c4 * 4 + 3] * rstd * g[3]};
            }
        } else {
            u32x4 o[2];
#pragma unroll
            for (int c4 = 0; c4 < 4; ++c4) {
                const f32x4 g = *(const f32x4*)(gp + c4 * 4);
                *(f32x4*)(xrow + c4 * 4) = (f32x4){r2[c4 * 4], r2[c4 * 4 + 1], r2[c4 * 4 + 2], r2[c4 * 4 + 3]};
                o[c4 >> 1][(c4 & 1) * 2] = pack2(r2[c4 * 4] * rstd * g[0], r2[c4 * 4 + 1] * rstd * g[1]);
                o[c4 >> 1][(c4 & 1) * 2 + 1] = pack2(r2[c4 * 4 + 2] * rstd * g[2], r2[c4 * 4 + 3] * rstd * g[3]);
            }
            bf16_t* hp = H + (size_t)t * 1024 + col0;
            *(u32x4*)hp = o[0]; *(u32x4*)(hp + 8) = o[1];
        }
    }
}

__device__ __forceinline__ void spatial_fast(const Params& p, char* smem) {
    bf16_t* U = (bf16_t*)(p.ws + OFF_REGION); const bf16_t* VT = U + (size_t)T * 2048; const float* SSQ = (const float*)(p.ws + OFF_SSQ);
    const int tid_ = threadIdx.x;
    for (int task = blockIdx.x; task < 2048; task += gridDim.x) {
        const int chunk = task >> 3, g = task & 7;
        int lz = 0; asm volatile("" : "+v"(lz));
        const int tid = tid_ + lz, lane = tid & 63, wid = tid >> 6, wm = wid >> 1, wn = wid & 1, l15 = lane & 15, q4 = lane >> 4;
        float* rs = (float*)(smem + 16384);
        if (tid < 128) {
            const float* sp = SSQ + (size_t)(chunk * 128 + tid) * 32;
            float s = 0.f;
#pragma unroll
            for (int i = 0; i < 8; ++i) { const f32x4 v = *(const f32x4*)(sp + 4 * i); s += (v[0] + v[1]) + (v[2] + v[3]); }
            rs[tid] = rsqrtf(s * (1.0f / 2048.0f) + EPS);
        }
        __syncthreads();
#pragma unroll
        for (int i = 0; i < 8; ++i) {
            const int c = tid + 256 * i, row = c >> 4, ch16 = c & 15, ks = ch16 >> 3, ch = ch16 & 7, s0 = ch16 * 8;
            const float* wp = p.c_w_spatial + ((size_t)(g * 128 + row)) * 128 + s0;
            const f32x4 w0 = *(const f32x4*)wp, w1 = *(const f32x4*)(wp + 4);
            const f32x4 r0 = *(const f32x4*)(rs + s0), r1 = *(const f32x4*)(rs + s0 + 4);
            float v[8];
#pragma unroll
            for (int j = 0; j < 4; ++j) { v[j] = (s0 + j <= row) ? w0[j] * r0[j] : 0.f; v[4 + j] = (s0 + 4 + j <= row) ? w1[j] * r1[j] : 0.f; }
            *(uint4*)(smem + ks * 32768 + row * 128 + ((ch ^ (row & 7)) << 4)) = make_uint4(pack2(v[0], v[1]), pack2(v[2], v[3]), pack2(v[4], v[5]), pack2(v[6], v[7]));
        }
        __syncthreads();
#pragma unroll 1
        for (int nh = 0; nh < 2; ++nh) {
            const int chan0 = g * 256 + nh * 128;
#pragma unroll
            for (int i = 0; i < 8; ++i) {
                const int c = tid + 256 * i, row = c >> 4, ch16 = c & 15, ks = ch16 >> 3, ch = ch16 & 7;
                *(uint4*)(smem + ks * 32768 + 16384 + row * 128 + ((ch ^ (row & 7)) << 4)) = *(const uint4*)(VT + ((size_t)chunk * 2048 + chan0 + row) * 128 + ch16 * 8);
            }
            __syncthreads();
            f32x4 acc[4][4];
#pragma unroll
            for (int i = 0; i < 4; ++i)
#pragma unroll
                for (int j = 0; j < 4; ++j) acc[i][j] = (f32x4){0.f, 0.f, 0.f, 0.f};
#pragma unroll
            for (int kt = 0; kt < 2; ++kt) {
                if (kt == 1 && wm == 0) continue;
                const char* sa = smem + kt * 32768; const char* sb = sa + 16384;
#pragma unroll
                for (int ks = 0; ks < 2; ++ks) {
                    bf16x8 af[4], bfr[4];
                    const int ch = ks * 4 + q4;
#pragma unroll
                    for (int i = 0; i < 4; ++i) { const int row = wm * 64 + i * 16 + l15; af[i] = *(const bf16x8*)(sa + row * 128 + ((ch ^ (row & 7)) << 4)); }
#pragma unroll
                    for (int j = 0; j < 4; ++j) { const int row = wn * 64 + j * 16 + l15; bfr[j] = *(const bf16x8*)(sb + row * 128 + ((ch ^ (row & 7)) << 4)); }
#pragma unroll
                    for (int i = 0; i < 4; ++i)
#pragma unroll
                        for (int j = 0; j < 4; ++j) acc[i][j] = __builtin_amdgcn_mfma_f32_16x16x32_bf16(bfr[j], af[i], acc[i][j], 0, 0, 0);
                }
            }
            __syncthreads();
#pragma unroll
            for (int i = 0; i < 4; ++i) {
                const int m = wm * 64 + i * 16 + l15;
                const float bias = p.c_b_spatial[g * 128 + m];
#pragma unroll
                for (int j = 0; j < 4; ++j) {
                    const int chan = chan0 + wn * 64 + j * 16 + 4 * q4;
                    const f32x4 vn = *(const f32x4*)(p.c_v_norm + chan);
                    bf16_t* up = U + (size_t)(chunk * 128 + m) * 2048 + chan;
                    const uint2 uu = *(const uint2*)up;
                    uint2 o;
                    o.x = pack2(lo2f(uu.x) * (vn[0] * acc[i][j][0] + bias), hi2f(uu.x) * (vn[1] * acc[i][j][1] + bias));
                    o.y = pack2(lo2f(uu.y) * (vn[2] * acc[i][j][2] + bias), hi2f(uu.y) * (vn[3] * acc[i][j][3] + bias));
                    *(uint2*)up = o;
                }
            }
        }
    }
}

#define XB_TMO      128
#define XB_XCNT(j)  (256  + 64 * (j))
#define XB_XSUB(j)  (1280 + 64 * (j))
#define XB_XGEN(j)  (2304 + 64 * (j))
#define XB_TOP      3328
#define XB_TOPGEN   3392
#define XCD_BAR_WORDS 3456
#define XB_SPIN_CAP (1u << 22)
#define LAS __attribute__((address_space(3)))
__device__ __forceinline__ unsigned xb_ld(unsigned* p)              { return __hip_atomic_load(p, __ATOMIC_RELAXED, __HIP_MEMORY_SCOPE_AGENT); }
__device__ __forceinline__ unsigned xb_add(unsigned* p, unsigned v) { return __hip_atomic_fetch_add(p, v, __ATOMIC_RELAXED, __HIP_MEMORY_SCOPE_AGENT); }
__device__ __forceinline__ unsigned xb_xcc_id() { return (unsigned)__builtin_amdgcn_s_getreg((3 << 11) | 20) & 0xFu; }
#define XB_SPIN(cond, bar) do { unsigned _sp = 0; while (cond) { __builtin_amdgcn_s_sleep(1); \
    if ((++_sp & 255u) == 0u) { if (xb_ld(&(bar)[XB_TMO])) break; if (_sp > XB_SPIN_CAP) { atomicAdd(&(bar)[XB_TMO], 1u); break; } } } } while (0)
struct XcdBarrier { unsigned* bar; unsigned x; volatile LAS unsigned* st; };
__device__ __forceinline__ XcdBarrier xcd_barrier_post(unsigned* bar, volatile LAS unsigned* st) {
    XcdBarrier b; b.bar = bar; b.x = xb_xcc_id(); b.st = st;
    if (threadIdx.x == 0) (void)xb_add(&bar[XB_XCNT(b.x)], 1u);
    return b;
}
__device__ __forceinline__ void xcd_barrier_complete(unsigned* bar, unsigned x, unsigned& nloc, unsigned& nx) {
    const unsigned G = gridDim.x * gridDim.y * gridDim.z;
    unsigned sum, cnt, mine, sp = 0u;
    for (;;) {
        sum = 0u; cnt = 0u; mine = 0u;
#pragma unroll
        for (unsigned j = 0; j < 16; ++j) { const unsigned c = xb_ld(&bar[XB_XCNT(j)]); sum += c; cnt += (c > 0u) ? 1u : 0u; mine = (j == x) ? c : mine; }
        if (sum == G) break;
        __builtin_amdgcn_s_sleep(1);
        if ((++sp & 255u) == 0u) { if (xb_ld(&bar[XB_TMO])) break; if (sp > XB_SPIN_CAP) { atomicAdd(&bar[XB_TMO], 1u); break; } }
    }
    nloc = mine > 0u ? mine : 1u; nx = cnt > 0u ? cnt : 1u;
}
__device__ __forceinline__ void xcd_barrier(const XcdBarrier& b) {
    asm volatile("s_waitcnt vmcnt(0)" ::: "memory");
    __syncthreads();
    if (threadIdx.x == 0) {
        unsigned* bar = b.bar;
        __builtin_amdgcn_s_waitcnt(0);
        unsigned nloc = b.st[0], nx = b.st[1];
        if (nloc == 0u) { xcd_barrier_complete(bar, b.x, nloc, nx); b.st[0] = nloc; b.st[1] = nx; }
        const unsigned old = xb_add(&bar[XB_XSUB(b.x)], 1u);
        const unsigned gen = old / nloc;
        if (old + 1u == (gen + 1u) * nloc) {
            __builtin_amdgcn_fence(__ATOMIC_RELEASE, "agent");
            asm volatile("s_waitcnt vmcnt(0)" ::: "memory");
            const unsigned og = xb_add(&bar[XB_TOP], 1u);
            const unsigned tg = og / nx;
            if (og + 1u == (tg + 1u) * nx) xb_add(&bar[XB_TOPGEN], 1u);
            else XB_SPIN(xb_ld(&bar[XB_TOPGEN]) == tg, bar);
            __builtin_amdgcn_fence(__ATOMIC_ACQUIRE, "agent");
            xb_add(&bar[XB_XGEN(b.x)], 1u);
            asm volatile("s_waitcnt vmcnt(0)" ::: "memory");
        } else {
            XB_SPIN(xb_ld(&bar[XB_XGEN(b.x)]) == gen, bar);
            __builtin_amdgcn_fence(__ATOMIC_ACQUIRE, "agent");
            asm volatile("s_waitcnt vmcnt(0)" ::: "memory");
        }
    }
    __syncthreads();
}

constexpr int NPHASE = 14;
constexpr int kDynLds = 81920;
__global__ void __launch_bounds__(256, 2) mega(Params p, int ph_lo, int ph_hi) {
    extern __shared__ __attribute__((aligned(16))) char smem[];
    cg::grid_group grid = cg::this_grid();
    uint4& xb_words = *(uint4*)(smem + kDynLds - 16);
    if (threadIdx.x == 0) xb_words = make_uint4(0u, 0u, 0u, 0u);
    __syncthreads();
    const XcdBarrier xbar = xcd_barrier_post((unsigned*)(p.ws + OFF_BAR), (volatile LAS unsigned*)&xb_words);
    bf16_t* Rg = (bf16_t*)(p.ws + OFF_REGION);
    bf16_t* Hb = (bf16_t*)(p.ws + OFF_H);
#define PHASE(k, ...) if (ph_lo <= (k) && (k) < ph_hi) { __VA_ARGS__; if ((k) + 1 < ph_hi) { if ((k) == 0) grid.sync(); else xcd_barrier(xbar); } }
    unsigned* sbctr = (unsigned*)(p.ws + OFF_BAR + 14336);
    PHASE(0,
        transpose_convert(p.ab_w_in, (bf16_t*)(p.ws + OFF_WT_IN), 1024, AB_IN, AB_IN_PAD, smem);
        transpose_convert(p.ab_w_out, (bf16_t*)(p.ws + OFF_WT_OUT), 1024, 1024, 1024, smem);
        transpose_convert(p.c_w_in, (bf16_t*)(p.ws + OFF_WT_CIN), 1024, 4096, 4096, smem);
        transpose_convert(p.c_w_out, (bf16_t*)(p.ws + OFF_WT_COUT), 2048, 1024, 1024, smem);
        transpose_convert(p.peer_w_q, (bf16_t*)(p.ws + OFF_WT_Q), 1024, 2048, 2048, smem);
        transpose_convert(p.peer_w_q + (size_t)1024 * 2048, (bf16_t*)(p.ws + OFF_WT_Q) + (size_t)2048 * 1024, 1024, 2048, 2048, smem);
        convert_flat(p.peer_subkeys, (bf16_t*)(p.ws + OFF_SK), (size_t)2 * 8 * 2 * 128 * 128);
        rmsnorm_rows(p.x, p.norm_mix, Hb))
    PHASE(1, phase_gemm_in(p, smem))
    PHASE(2, gla_prep(p, smem))
    PHASE(3, gla_scan(p, smem); sb_fast(p, smem, sbctr); quantize_tables_queued(p, smem, sbctr + 1))
    PHASE(4, phase_gemm_resid(Rg + R_QSB, Rg + R_GG, 512, 512, (const bf16_t*)(p.ws + OFF_WT_OUT), 1024, p.x, p.out, smem))
    PHASE(5, rmsnorm_rows(p.out, p.norm_ffn, Hb))
    PHASE(6, peer_select_fast(p, 0, smem))
    PHASE(7, peer_gather(p, 0, p.norm_mix + 1024, false, smem))
    PHASE(8, phase_gemm_cin(p, smem))
    PHASE(9, spatial_fast(p, smem))
    PHASE(10, phase_gemm_resid(Rg, Rg, 2048, 2048, (const bf16_t*)(p.ws + OFF_WT_COUT), 2048, p.out, p.out, smem))
    PHASE(11, rmsnorm_rows(p.out, p.norm_ffn + 1024, Hb))
    PHASE(12, peer_select_fast(p, 1, smem))
    PHASE(13, peer_gather(p, 1, p.final_norm, true, smem))
}

extern "C" void kernel_launch(void* const* d_in, const int* in_sizes, int n_in, void* d_out, int out_size, void* d_ws, size_t ws_size, hipStream_t stream) {
    static int grid_blocks = 0;
    if (!grid_blocks) {
        int dev = 0, cus = 0, per_cu = 0;
        hipGetDevice(&dev);
        hipDeviceGetAttribute(&cus, hipDeviceAttributeMultiprocessorCount, dev);
        hipFuncSetAttribute((const void*)mega, hipFuncAttributeMaxDynamicSharedMemorySize, kDynLds);
        hipOccupancyMaxActiveBlocksPerMultiprocessor(&per_cu, mega, 256, kDynLds);
        if (per_cu < 1) per_cu = 1;
        if (per_cu > 2) per_cu = 2;
        grid_blocks = cus * per_cu;
        if (n_in != 18 || ws_size < WS_END) fprintf(stderr, "kernel_launch: unexpected n_in %d or ws_size %zu < %zu\n", n_in, ws_size, (size_t)WS_END);
    }
    Params p{};
    p.x = (const float*)d_in[0]; p.norm_mix = (const float*)d_in[1]; p.norm_ffn = (const float*)d_in[2]; p.ab_w_in = (const float*)d_in[3];
    p.ab_w_alpha2 = (const float*)d_in[4]; p.ab_b_alpha2 = (const float*)d_in[5]; p.ab_gla_norm = (const float*)d_in[6]; p.ab_w_out = (const float*)d_in[7];
    p.c_w_in = (const float*)d_in[8]; p.c_v_norm = (const float*)d_in[9]; p.c_w_spatial = (const float*)d_in[10]; p.c_b_spatial = (const float*)d_in[11];
    p.c_w_out = (const float*)d_in[12]; p.peer_w_q = (const float*)d_in[13]; p.peer_subkeys = (const float*)d_in[14]; p.peer_u = (const float*)d_in[15];
    p.peer_v = (const float*)d_in[16]; p.final_norm = (const float*)d_in[17];
    p.out = (float*)d_out; p.ws = (unsigned char*)d_ws;
    (void)hipMemsetAsync((char*)d_ws + OFF_BAR, 0, 16384, stream);
#if ONE_LAUNCH
    int lo = 0, hi = NPHASE;
    void* args[] = {&p, &lo, &hi};
    hipError_t e = hipLaunchCooperativeKernel((void*)mega, dim3(grid_blocks), dim3(256), args, kDynLds, stream);
    if (e != hipSuccess) fprintf(stderr, "cooperative launch failed: %s (grid %d)\n", hipGetErrorString(e), grid_blocks);
#else
    for (int ph = 0; ph < NPHASE; ++ph) hipLaunchKernelGGL(mega, dim3(grid_blocks), dim3(256), kDynLds, stream, p, ph, ph + 1);
#endif
}
```

```cpp
#include <hip/hip_runtime.h>
#include <hip/hip_cooperative_groups.h>
#include <cstdio>
#include <cstdint>
namespace cg = cooperative_groups;

#ifndef ONE_LAUNCH
#define ONE_LAUNCH 1
#endif

typedef unsigned short bf16_t;
typedef short bf16x8 __attribute__((ext_vector_type(8)));
typedef float f32x4 __attribute__((ext_vector_type(4)));
typedef unsigned u32x4 __attribute__((ext_vector_type(4)));
typedef __bf16 bf16x2_t __attribute__((ext_vector_type(2)));

constexpr int T = 32768, D = 1024, SEQ = 2048, NB = 16;
constexpr int AB_IN = 3088, AB_IN_PAD = 3200;
constexpr float EPS = 1e-6f;
constexpr int NEXP = 16384;

constexpr size_t SZ_WT_IN = (size_t)AB_IN_PAD * 1024 * 2;
constexpr size_t SZ_WT_OUT = (size_t)1024 * 1024 * 2;
constexpr size_t SZ_WT_CIN = (size_t)4096 * 1024 * 2;
constexpr size_t SZ_WT_COUT = (size_t)1024 * 2048 * 2;
constexpr size_t SZ_WT_Q = (size_t)2 * 2048 * 1024 * 2;
constexpr size_t SZ_SK = (size_t)2 * 8 * 2 * 128 * 128 * 2;
constexpr size_t SZ_TAB = (size_t)2 * NEXP * 1024;
constexpr size_t SZ_TSC = (size_t)2 * NEXP * 4;
constexpr size_t OFF_WT_IN = 0;
constexpr size_t OFF_WT_OUT = OFF_WT_IN + SZ_WT_IN;
constexpr size_t OFF_WT_CIN = OFF_WT_OUT + SZ_WT_OUT;
constexpr size_t OFF_WT_COUT = OFF_WT_CIN + SZ_WT_CIN;
constexpr size_t OFF_WT_Q = OFF_WT_COUT + SZ_WT_COUT;
constexpr size_t OFF_SK = OFF_WT_Q + SZ_WT_Q;
constexpr size_t OFF_UT = OFF_SK + SZ_SK;
constexpr size_t OFF_VT = OFF_UT + SZ_TAB;
constexpr size_t OFF_USC = OFF_VT + SZ_TAB;
constexpr size_t OFF_VSC = OFF_USC + SZ_TSC;
constexpr size_t OFF_H = OFF_VSC + SZ_TSC;
constexpr size_t OFF_IDX = OFF_H + (size_t)T * 1024 * 2;
constexpr size_t OFF_GATE = OFF_IDX + (size_t)T * 128 * 2;
constexpr size_t OFF_SSQ = OFF_GATE + (size_t)T * 128 * 4;
constexpr size_t OFF_REGION = OFF_SSQ + (size_t)T * 32 * 4;
constexpr size_t SZ_REGION = (size_t)256 << 20;
constexpr size_t OFF_BAR = OFF_REGION + SZ_REGION;
constexpr size_t WS_END = OFF_BAR + 16384;
constexpr size_t R_QSB = 0;
constexpr size_t R_KSB = R_QSB + (size_t)T * 512;
constexpr size_t R_VTSB = R_KSB + (size_t)T * 512;
constexpr size_t R_QG = R_VTSB + (size_t)T * 512;
constexpr size_t R_KG = R_QG + (size_t)T * 256;
constexpr size_t R_VTG = R_KG + (size_t)T * 256;
constexpr size_t R_GG = R_VTG + (size_t)T * 512;
constexpr size_t R_ALR = R_GG + (size_t)T * 512;
constexpr size_t R_KOT = R_ALR + (size_t)T * 32;
constexpr size_t R_DEC = R_KOT + (size_t)T * 256;

struct Params {
    const float* x; const float* norm_mix; const float* norm_ffn; const float* ab_w_in; const float* ab_w_alpha2; const float* ab_b_alpha2;
    const float* ab_gla_norm; const float* ab_w_out; const float* c_w_in; const float* c_v_norm; const float* c_w_spatial; const float* c_b_spatial;
    const float* c_w_out; const float* peer_w_q; const float* peer_subkeys; const float* peer_u; const float* peer_v; const float* final_norm;
    float* out; unsigned char* ws;
};

__device__ __forceinline__ float bf2f(bf16_t v) { return __uint_as_float(((unsigned)v) << 16); }
__device__ __forceinline__ bf16_t f2bf(float f) { unsigned u = __float_as_uint(f); u += 0x7fffu + ((u >> 16) & 1u); return (bf16_t)(u >> 16); }
__device__ __forceinline__ unsigned pack2(float lo, float hi) { return (unsigned)f2bf(lo) | ((unsigned)f2bf(hi) << 16); }
__device__ __forceinline__ float lo2f(unsigned w) { return __uint_as_float(w << 16); }
__device__ __forceinline__ float hi2f(unsigned w) { return __uint_as_float(w & 0xffff0000u); }
__device__ __forceinline__ float dot2(unsigned a, unsigned b, float acc) { return __builtin_amdgcn_fdot2_f32_bf16(__builtin_bit_cast(bf16x2_t, a), __builtin_bit_cast(bf16x2_t, b), acc, false); }
__device__ __forceinline__ float gelu_exact(float v) {
    const float av = fabsf(v);
    const float t = __builtin_amdgcn_rcpf(av * 0.2316418882f + 1.0f);
    float q = t * 0.5307027145f - 0.7265760135f; q = q * t + 0.7107068705f; q = q * t - 0.142248368f; q = q * t + 0.127414796f; q = q * t;
    const float e = __builtin_amdgcn_exp2f(v * v * -0.72134752044f);
    const float m = v * (q * e);
    return v < 0.f ? m : v - m;
}
__device__ __forceinline__ float wave_sum(float v) {
#pragma unroll
    for (int o = 32; o >= 1; o >>= 1) v += __shfl_xor(v, o);
    return v;
}

__device__ __forceinline__ void transpose_convert(const float* __restrict__ W, bf16_t* __restrict__ Wt, int K, int N, int Npad, char* smem) {
    float* tile = (float*)smem;
    const int tk = K / 64, tn = Npad / 64, ntile = tk * tn;
    const int tid = threadIdx.x;
    for (int tl = blockIdx.x; tl < ntile; tl += gridDim.x) {
        const int k0 = (tl % tk) * 64, n0 = (tl / tk) * 64;
        const int c = tid & 63, r0 = tid >> 6;
#pragma unroll
        for (int i = 0; i < 16; ++i) {
            const int r = r0 + 4 * i;
            const float v = (n0 + c < N) ? W[(size_t)(k0 + r) * N + n0 + c] : 0.f;
            tile[c * 65 + r] = v;
        }
        __syncthreads();
#pragma unroll
        for (int i = 0; i < 16; ++i) {
            const int n = r0 + 4 * i;
            Wt[(size_t)(n0 + n) * K + k0 + c] = f2bf(tile[n * 65 + c]);
        }
        __syncthreads();
    }
}
__device__ __forceinline__ void convert_flat(const float* __restrict__ src, bf16_t* __restrict__ dst, size_t n) {
    const size_t nv = n / 8;
    for (size_t i = (size_t)blockIdx.x * blockDim.x + threadIdx.x; i < nv; i += (size_t)gridDim.x * blockDim.x) {
        const float4 a = ((const float4*)src)[2 * i], b = ((const float4*)src)[2 * i + 1];
        uint4 o; o.x = pack2(a.x, a.y); o.y = pack2(a.z, a.w); o.z = pack2(b.x, b.y); o.w = pack2(b.z, b.w);
        ((uint4*)dst)[i] = o;
    }
}
__device__ __forceinline__ void quantize_tables_queued(const Params& p, char* smem, unsigned* ctr) {
    volatile unsigned* slot = (volatile unsigned*)(smem + 32800);
    const int lane = threadIdx.x & 63, wid = threadIdx.x >> 6;
    for (;;) {
        __syncthreads();
        if (threadIdx.x == 0) *slot = atomicAdd(ctr, 1u);
        __syncthreads();
        const unsigned task = *slot;
        if (task >= 512u) break;
        const bool isv = task >= 256u;
        const int r0 = (int)(task & 255u) * 128 + wid * 32;
        const float* src = isv ? p.peer_v : p.peer_u;
        unsigned char* recs = p.ws + OFF_UT;
        for (int rr = 0; rr < 32; ++rr) {
            const int r = r0 + rr;
            const float* xr = src + (size_t)r * 1024 + lane * 16;
            f32x4 v[4]; float aml = 0.f;
#pragma unroll
            for (int i = 0; i < 4; ++i) {
                v[i] = *(const f32x4*)(xr + i * 4);
                aml = fmaxf(aml, fmaxf(fmaxf(fabsf(v[i][0]), fabsf(v[i][1])), fmaxf(fabsf(v[i][2]), fabsf(v[i][3]))));
            }
            const float gs = fmaxf(aml, __shfl_xor(aml, 1)) * (1.002f / 7.5f);
            const _Float16 hs = (_Float16)gs;
            const float gsd = (float)hs, ginv = gsd > 0.f ? 1.0f / gsd : 0.f;
            unsigned wd[2];
#pragma unroll
            for (int dd = 0; dd < 2; ++dd) {
                unsigned wv = 0;
#pragma unroll
                for (int b = 0; b < 4; ++b) {
                    const int qa = min(15, max(0, __float2int_rn(v[2 * dd][b] * ginv + 7.5f)));
                    const int qb = min(15, max(0, __float2int_rn(v[2 * dd + 1][b] * ginv + 7.5f)));
                    wv |= ((unsigned)qa | ((unsigned)qb << 4)) << (8 * b);
                }
                wd[dd] = wv;
            }
            unsigned char* rec = recs + (size_t)r * 1152;
            *(uint2*)(rec + (isv ? 512 : 0) + lane * 8) = make_uint2(wd[0], wd[1]);
            if ((lane & 1) == 0) { const int g = lane >> 1; *(_Float16*)(rec + 1024 + (g & 15) * 8 + (isv ? 4 : 0) + (g >> 4) * 2) = hs; }
        }
    }
}
__device__ __forceinline__ void rmsnorm_rows(const float* __restrict__ X, const float* __restrict__ g, bf16_t* __restrict__ Hout) {
    const int lane = threadIdx.x & 63, wid = threadIdx.x >> 6;
    const int gw = blockIdx.x * 4 + wid, nw = gridDim.x * 4;
    for (int t = gw; t < T; t += nw) {
        const float* xr = X + (size_t)t * D;
        float4 v[4]; float ss = 0.f;
#pragma unroll
        for (int i = 0; i < 4; ++i) { v[i] = *(const float4*)(xr + i * 256 + lane * 4); ss += v[i].x * v[i].x + v[i].y * v[i].y + v[i].z * v[i].z + v[i].w * v[i].w; }
        ss = wave_sum(ss);
        const float rstd = rsqrtf(ss * (1.0f / D) + EPS);
#pragma unroll
        for (int i = 0; i < 4; ++i) {
            const float4 gg = *(const float4*)(g + i * 256 + lane * 4);
            uint2 o; o.x = pack2(v[i].x * rstd * gg.x, v[i].y * rstd * gg.y); o.y = pack2(v[i].z * rstd * gg.z, v[i].w * rstd * gg.w);
            *(uint2*)(Hout + (size_t)t * D + i * 256 + lane * 4) = o;
        }
    }
}

template <int MODE>
__device__ __forceinline__ void gemm_mainloop(const bf16_t* __restrict__ A0, const bf16_t* __restrict__ A1, int lda, int ksplit,
                                              const bf16_t* __restrict__ Bt, int K, int m0, int n0, f32x4 (&acc)[4][4], char* smem) {
    const int tid = threadIdx.x, lane = tid & 63, wid = tid >> 6, wm = wid >> 1, wn = wid & 1;
    const int lrow = tid >> 3, lch = tid & 7;
#pragma unroll
    for (int i = 0; i < 4; ++i)
#pragma unroll
        for (int j = 0; j < 4; ++j) acc[i][j] = (f32x4){0.f, 0.f, 0.f, 0.f};
    const int nk = K / 64;
    unsigned aoff[4], boff[4];
    {
        const int rr = lane >> 3, cc = ((lane & 7) ^ rr) * 8;
#pragma unroll
        for (int i = 0; i < 4; ++i) {
            aoff[i] = (unsigned)(((m0 + 32 * wid + 8 * i + rr) * lda + cc) * 2);
            boff[i] = (unsigned)(((n0 + 32 * wid + 8 * i + rr) * K + cc) * 2);
        }
    }
    auto stage = [&](int kt, int buf) {
        const int kb = kt * 64;
        const char* Ab; const char* Bb = (const char*)(Bt + kb);
        if (kb < ksplit) Ab = (const char*)(A0 + kb); else Ab = (const char*)(A1 + (kb - ksplit));
        char* sa = smem + buf * 32768 + wid * 4096 + lane * 16; char* sb = sa + 16384;
#pragma unroll
        for (int i = 0; i < 4; ++i) __builtin_amdgcn_global_load_lds((const unsigned*)(Ab + aoff[i]), (unsigned*)(sa + i * 1024), 16, 0, 0);
#pragma unroll
        for (int i = 0; i < 4; ++i) __builtin_amdgcn_global_load_lds((const unsigned*)(Bb + boff[i]), (unsigned*)(sb + i * 1024), 16, 0, 0);
    };
    auto compute = [&](int buf) {
        const char* sa = smem + buf * 32768; const char* sb = sa + 16384;
#pragma unroll
        for (int ks = 0; ks < 2; ++ks) {
            bf16x8 af[4], bfr[4];
            const int ch = ks * 4 + (lane >> 4);
#pragma unroll
            for (int i = 0; i < 4; ++i) { const int row = wm * 64 + i * 16 + (lane & 15); af[i] = *(const bf16x8*)(sa + row * 128 + ((ch ^ (row & 7)) << 4)); }
#pragma unroll
            for (int j = 0; j < 4; ++j) { const int row = wn * 64 + j * 16 + (lane & 15); bfr[j] = *(const bf16x8*)(sb + row * 128 + ((ch ^ (row & 7)) << 4)); }
            __builtin_amdgcn_s_setprio(1);
#pragma unroll
            for (int i = 0; i < 4; ++i)
#pragma unroll
                for (int j = 0; j < 4; ++j) {
                    if (MODE == 0) acc[i][j] = __builtin_amdgcn_mfma_f32_16x16x32_bf16(bfr[j], af[i], acc[i][j], 0, 0, 0);
                    else acc[i][j] = __builtin_amdgcn_mfma_f32_16x16x32_bf16(af[i], bfr[j], acc[i][j], 0, 0, 0);
                }
            __builtin_amdgcn_s_setprio(0);
        }
    };
    stage(0, 0);
    asm volatile("s_waitcnt vmcnt(0)" ::: "memory");
    __syncthreads();
    for (int kt = 0; kt < nk; ++kt) {
        if (kt + 1 < nk) stage(kt + 1, (kt + 1) & 1);
        compute(kt & 1);
        asm volatile("s_waitcnt vmcnt(0)" ::: "memory");
        __syncthreads();
    }
}
template <int MODE>
__device__ __forceinline__ void gemm_mainloop256(const bf16_t* __restrict__ A0, const bf16_t* __restrict__ A1, int lda, int ksplit,
                                                 const bf16_t* __restrict__ Bt, int K, int m0, int n0, f32x4 (&acc)[8][4], char* smem) {
    const int tid = threadIdx.x, lane = tid & 63, wid = tid >> 6, wm = wid >> 1, wn = wid & 1;
#pragma unroll
    for (int i = 0; i < 8; ++i)
#pragma unroll
        for (int j = 0; j < 4; ++j) acc[i][j] = (f32x4){0.f, 0.f, 0.f, 0.f};
    const int nk = K / 32;
    unsigned aoff[4], boff[2];
    {
        const int rr = lane >> 2, cc = ((lane & 3) ^ (3 * ((lane >> 5) & 1))) * 8;
#pragma unroll
        for (int i = 0; i < 4; ++i) aoff[i] = (unsigned)(((m0 + 64 * wid + 16 * i + rr) * lda + cc) * 2);
#pragma unroll
        for (int i = 0; i < 2; ++i) boff[i] = (unsigned)(((n0 + 32 * wid + 16 * i + rr) * K + cc) * 2);
    }
    auto stage = [&](int kt, int buf) {
        const int kb = kt * 32;
        const char* Ab; const char* Bb = (const char*)(Bt + kb);
        if (kb < ksplit) Ab = (const char*)(A0 + kb); else Ab = (const char*)(A1 + (kb - ksplit));
        char* sa = smem + buf * 24576 + wid * 4096 + lane * 16; char* sb = smem + buf * 24576 + 16384 + wid * 2048 + lane * 16;
#pragma unroll
        for (int i = 0; i < 4; ++i) __builtin_amdgcn_global_load_lds((const unsigned*)(Ab + aoff[i]), (unsigned*)(sa + i * 1024), 16, 0, 0);
#pragma unroll
        for (int i = 0; i < 2; ++i) __builtin_amdgcn_global_load_lds((const unsigned*)(Bb + boff[i]), (unsigned*)(sb + i * 1024), 16, 0, 0);
    };
    const int fpos = (((lane >> 4) ^ (3 * ((lane >> 3) & 1))) << 4) + (lane & 15) * 64;
    auto compute = [&](int buf) {
        const char* sa = smem + buf * 24576 + wm * 8192 + fpos; const char* sb = smem + buf * 24576 + 16384 + wn * 4096 + fpos;
        bf16x8 af[8], bfr[4];
#pragma unroll
        for (int i = 0; i < 8; ++i) af[i] = *(const bf16x8*)(sa + i * 1024);
#pragma unroll
        for (int j = 0; j < 4; ++j) bfr[j] = *(const bf16x8*)(sb + j * 1024);
        __builtin_amdgcn_s_setprio(1);
#pragma unroll
        for (int i = 0; i < 8; ++i)
#pragma unroll
            for (int j = 0; j < 4; ++j) {
                if (MODE == 0) acc[i][j] = __builtin_amdgcn_mfma_f32_16x16x32_bf16(bfr[j], af[i], acc[i][j], 0, 0, 0);
                else acc[i][j] = __builtin_amdgcn_mfma_f32_16x16x32_bf16(af[i], bfr[j], acc[i][j], 0, 0, 0);
            }
        __builtin_amdgcn_s_setprio(0);
    };
    stage(0, 0);
    asm volatile("s_waitcnt vmcnt(0)" ::: "memory");
    __syncthreads();
    for (int kt = 0; kt < nk; ++kt) {
        if (kt + 1 < nk) stage(kt + 1, (kt + 1) & 1);
        compute(kt & 1);
        asm volatile("s_waitcnt vmcnt(0)" ::: "memory");
        __syncthreads();
    }
}
__device__ __forceinline__ bool tile_sched(int it, int MT, int NT, int& mt, int& nt) {
    const int xg = blockIdx.x & 7, xi = blockIdx.x >> 3, nper = gridDim.x >> 3;
    const int li = xi + nper * it;
    if (li >= (MT >> 3) * NT) return false;
    const int band = li / (8 * NT), r = li - band * 8 * NT;
    nt = r >> 3; mt = xg * (MT >> 3) + band * 8 + (r & 7);
    return true;
}
__device__ __forceinline__ void store_bf16x4(bf16_t* p, f32x4 v) { uint2 o; o.x = pack2(v[0], v[1]); o.y = pack2(v[2], v[3]); *(uint2*)p = o; }

__device__ __forceinline__ void phase_gemm_in(const Params& p, char* smem) {
    const bf16_t* A = (const bf16_t*)(p.ws + OFF_H); const bf16_t* Bt = (const bf16_t*)(p.ws + OFF_WT_IN);
    bf16_t* R = (bf16_t*)(p.ws + OFF_REGION);
    const int lane = threadIdx.x & 63, wid = threadIdx.x >> 6, wm = wid >> 1, wn = wid & 1;
    constexpr int NT = AB_IN_PAD / 128, MT = T / 128;
    int mt_, nt_;
    for (int it = 0; tile_sched(it, MT, NT, mt_, nt_); ++it) {
        const int m0 = mt_ * 128, n0 = nt_ * 128;
        f32x4 acc[4][4];
        const bool tr = (n0 >= 1024 && n0 < 1536) || (n0 >= 2048 && n0 < 2560);
        if (!tr) {
            gemm_mainloop<0>(A, A, 1024, 1024, Bt, 1024, m0, n0, acc, smem);
#pragma unroll
            for (int i = 0; i < 4; ++i)
#pragma unroll
                for (int j = 0; j < 4; ++j) {
                    const int m = m0 + wm * 64 + i * 16 + (lane & 15), n = n0 + wn * 64 + j * 16 + 4 * (lane >> 4);
                    const f32x4 v = acc[i][j];
                    if (n < 512) store_bf16x4(R + R_QSB + (size_t)m * 512 + n, v * 0.125f);
                    else if (n < 1024) store_bf16x4(R + R_KSB + (size_t)m * 512 + (n - 512), v);
                    else if (n < 1792) store_bf16x4(R + R_QG + (size_t)m * 256 + (n - 1536), v);
                    else if (n < 2048) store_bf16x4(R + R_KG + (size_t)m * 256 + (n - 1792), v);
                    else if (n < 3072) store_bf16x4(R + R_GG + (size_t)m * 512 + (n - 2560), v);
                    else if (n < AB_IN) *(f32x4*)((float*)(R + R_ALR) + (size_t)m * 16 + (n - 3072)) = v;
                }
        } else {
            gemm_mainloop<1>(A, A, 1024, 1024, Bt, 1024, m0, n0, acc, smem);
#pragma unroll
            for (int i = 0; i < 4; ++i)
#pragma unroll
                for (int j = 0; j < 4; ++j) {
                    const int m = m0 + wm * 64 + i * 16 + 4 * (lane >> 4), n = n0 + wn * 64 + j * 16 + (lane & 15);
                    const int b = m >> 11, s = m & 2047;
                    if (n < 1536) { const int c = n - 1024, hh = c >> 6, e = c & 63; store_bf16x4(R + R_VTSB + ((size_t)((b * 8 + hh) * 64 + e)) * 2048 + s, acc[i][j]); }
                    else { const int c = n - 2048, hh = c >> 7, e = c & 127; store_bf16x4(R + R_VTG + ((size_t)((b * 4 + hh) * 128 + e)) * 2048 + s, acc[i][j]); }
                }
        }
    }
}
__device__ __forceinline__ void phase_gemm_resid(const bf16_t* A0, const bf16_t* A1, int lda, int ksplit, const bf16_t* Bt, int K, const float* Rs, float* O, char* smem) {
    const int lane = threadIdx.x & 63, wid = threadIdx.x >> 6, wm = wid >> 1, wn = wid & 1;
    constexpr int NT = 8, MT = T / 256;
    int mt_, nt_;
    for (int it = 0; tile_sched(it, MT, NT, mt_, nt_); ++it) {
        const int m0 = mt_ * 256, n0 = nt_ * 128;
        f32x4 acc[8][4];
        gemm_mainloop256<0>(A0, A1, lda, ksplit, Bt, K, m0, n0, acc, smem);
#pragma unroll
        for (int i = 0; i < 8; ++i)
#pragma unroll
            for (int j = 0; j < 4; ++j) {
                const int m = m0 + wm * 128 + i * 16 + (lane & 15), n = n0 + wn * 64 + j * 16 + 4 * (lane >> 4);
                const f32x4 r = *(const f32x4*)(Rs + (size_t)m * 1024 + n);
                *(f32x4*)(O + (size_t)m * 1024 + n) = r + acc[i][j];
            }
    }
}
__device__ __forceinline__ void phase_gemm_cin(const Params& p, char* smem) {
    const bf16_t* A = (const bf16_t*)(p.ws + OFF_H); const bf16_t* Bt = (const bf16_t*)(p.ws + OFF_WT_CIN);
    bf16_t* U = (bf16_t*)(p.ws + OFF_REGION); bf16_t* VT = U + (size_t)T * 2048; float* SSQ = (float*)(p.ws + OFF_SSQ);
    const int lane = threadIdx.x & 63, wid = threadIdx.x >> 6, wm = wid >> 1, wn = wid & 1;
    constexpr int NT = 32, MT = T / 128;
    int mt_, nt_;
    for (int it = 0; tile_sched(it, MT, NT, mt_, nt_); ++it) {
        const int m0 = mt_ * 128, n0 = nt_ * 128;
        f32x4 acc[4][4];
        if (n0 < 2048) {
            gemm_mainloop<0>(A, A, 1024, 1024, Bt, 1024, m0, n0, acc, smem);
#pragma unroll
            for (int i = 0; i < 4; ++i)
#pragma unroll
                for (int j = 0; j < 4; ++j) {
                    const int m = m0 + wm * 64 + i * 16 + (lane & 15), n = n0 + wn * 64 + j * 16 + 4 * (lane >> 4);
                    f32x4 v = acc[i][j];
#pragma unroll
                    for (int r = 0; r < 4; ++r) v[r] = gelu_exact(v[r]);
                    store_bf16x4(U + (size_t)m * 2048 + n, v);
                }
        } else {
            gemm_mainloop<1>(A, A, 1024, 1024, Bt, 1024, m0, n0, acc, smem);
#pragma unroll
            for (int i = 0; i < 4; ++i) {
                float ss[4] = {0.f, 0.f, 0.f, 0.f};
#pragma unroll
                for (int j = 0; j < 4; ++j) {
                    const int m = m0 + wm * 64 + i * 16 + 4 * (lane >> 4), n = n0 + wn * 64 + j * 16 + (lane & 15);
                    f32x4 v = acc[i][j];
#pragma unroll
                    for (int r = 0; r < 4; ++r) { v[r] = gelu_exact(v[r]); ss[r] += v[r] * v[r]; }
                    const int chunk = m >> 7, s = m & 127, c = n - 2048;
                    store_bf16x4(VT + ((size_t)chunk * 2048 + c) * 128 + s, v);
                }
#pragma unroll
                for (int r = 0; r < 4; ++r) {
                    float v = ss[r];
                    v += __shfl_xor(v, 1); v += __shfl_xor(v, 2); v += __shfl_xor(v, 4); v += __shfl_xor(v, 8);
                    if ((lane & 15) == 0) { const int m = m0 + wm * 64 + i * 16 + 4 * (lane >> 4) + r; SSQ[(size_t)m * 32 + ((n0 - 2048) >> 6) + wn] = v; }
                }
            }
        }
    }
}

typedef float f32x16 __attribute__((ext_vector_type(16)));
__device__ __forceinline__ void sb_fast(const Params& p, char* smem, unsigned* ctr) {
    bf16_t* R = (bf16_t*)(p.ws + OFF_REGION);
    char* KT = smem; char* VTt = smem + 8192;
    volatile int* flags = (volatile int*)(smem + 32768); volatile unsigned* slot = (volatile unsigned*)(smem + 32800);
    const int tid = threadIdx.x, lane = tid & 63, w = tid >> 6, r31 = lane & 31, h = lane >> 5;
    for (;;) {
        __syncthreads();
        if (tid == 0) *slot = atomicAdd(ctr, 1u);
        __syncthreads();
        const unsigned task = *slot;
        if (task >= 2048u) break;
        const int qblk = 15 - (int)(task >> 7), bh = task & 127, b = bh >> 3, hh = bh & 7;
        const int q0 = qblk * 128, qbase = q0 + 32 * w;
        bf16_t* qrow = R + R_QSB + (size_t)(b * 2048 + qbase + r31) * 512 + hh * 64;
        bf16x8 qf[4];
#pragma unroll
        for (int kk = 0; kk < 4; ++kk) qf[kk] = *(const bf16x8*)(qrow + 16 * kk + 8 * h);
        f32x16 oacc[2];
#pragma unroll
        for (int nt = 0; nt < 2; ++nt)
#pragma unroll
            for (int i = 0; i < 16; ++i) oacc[nt][i] = 0.f;
        float Rr = 1.0f;
        const int t = qbase + r31;
        for (int kt = q0 / 64 + 1; kt >= 0; --kt) {
            __syncthreads();
            { const int wd = __all(Rr == 0.f); if (lane == 0) flags[w] = wd; }
            __syncthreads();
            if (flags[0] & flags[1] & flags[2] & flags[3]) break;
            const int s_tile = kt * 64;
#pragma unroll
            for (int i = 0; i < 2; ++i) {
                const int c = tid + 256 * i, row = c >> 3, ch = c & 7;
                const u32x4 kv = *(const u32x4*)(R + R_KSB + (size_t)(b * 2048 + s_tile + row) * 512 + hh * 64 + ch * 8);
                const u32x4 vv = *(const u32x4*)(R + R_VTSB + ((size_t)((b * 8 + hh) * 64 + row)) * 2048 + s_tile + ch * 8);
                *(u32x4*)(KT + row * 128 + ((ch ^ (row & 7)) << 4)) = kv;
                *(uint2*)(VTt + row * 136 + ch * 16) = make_uint2(vv[0], vv[1]);
                *(uint2*)(VTt + row * 136 + ch * 16 + 8) = make_uint2(vv[2], vv[3]);
            }
            __syncthreads();
#pragma unroll
            for (int sbk = 1; sbk >= 0; --sbk) {
                const int key_lo = s_tile + 32 * sbk;
                if (key_lo >= qbase + 31) continue;
                if (__all(Rr == 0.f)) continue;
                f32x16 st;
#pragma unroll
                for (int i = 0; i < 16; ++i) st[i] = 0.f;
                const int krow = 32 * sbk + r31;
#pragma unroll
                for (int kk = 0; kk < 4; ++kk) {
                    const bf16x8 kf = *(const bf16x8*)(KT + krow * 128 + (((2 * kk + h) ^ (krow & 7)) << 4));
                    st = __builtin_amdgcn_mfma_f32_32x32x16_bf16(kf, qf[kk], st, 0, 0, 0);
                }
                float a[16], G[4];
#pragma unroll
                for (int g = 0; g < 4; ++g) {
                    float sg[4], m[4];
#pragma unroll
                    for (int i = 0; i < 4; ++i) {
                        const int s = key_lo + 8 * g + 4 * h + i;
                        const float z = fminf(fmaxf(st[4 * g + i], -80.f), 80.f);
                        const float ez = __expf(-z), sig = 1.0f / (1.0f + ez);
                        const bool valid = s < t;
                        sg[i] = valid ? sig : 0.f; m[i] = valid ? ez * sig : 1.0f;
                    }
                    const float x2 = m[3], x1 = x2 * m[2], x0 = x1 * m[1];
                    G[g] = x0 * m[0];
                    a[4 * g + 3] = sg[3]; a[4 * g + 2] = sg[2] * x2; a[4 * g + 1] = sg[1] * x1; a[4 * g] = sg[0] * x0;
                }
                float Go[4], P[4];
#pragma unroll
                for (int g = 0; g < 4; ++g) { Go[g] = __shfl_xor(G[g], 32); P[g] = G[g] * Go[g]; }
                const float c2 = P[3], c1 = c2 * P[2], c0 = c1 * P[1];
                float Tg[4];
                Tg[3] = Rr; Tg[2] = Rr * c2; Tg[1] = Rr * c1; Tg[0] = Rr * c0;
#pragma unroll
                for (int g = 0; g < 4; ++g) {
                    const float tg = (h == 0) ? Tg[g] * Go[g] : Tg[g];
                    a[4 * g] *= tg; a[4 * g + 1] *= tg; a[4 * g + 2] *= tg; a[4 * g + 3] *= tg;
                }
                Rr = Rr * c0 * P[0];
#pragma unroll
                for (int s2 = 0; s2 < 2; ++s2) {
                    union { bf16x8 v; unsigned u[4]; } af;
#pragma unroll
                    for (int j2 = 0; j2 < 4; ++j2) af.u[j2] = pack2(a[8 * s2 + 2 * j2], a[8 * s2 + 2 * j2 + 1]);
#pragma unroll
                    for (int nt = 0; nt < 2; ++nt) {
                        const char* vp = VTt + (32 * nt + r31) * 136 + 64 * sbk + 32 * s2 + 8 * h;
                        union { bf16x8 v; uint2 hh2[2]; } vf;
                        vf.hh2[0] = *(const uint2*)vp; vf.hh2[1] = *(const uint2*)(vp + 16);
                        oacc[nt] = __builtin_amdgcn_mfma_f32_32x32x16_bf16(af.v, vf.v, oacc[nt], 0, 0, 0);
                    }
                }
            }
        }
#pragma unroll
        for (int nt = 0; nt < 2; ++nt)
#pragma unroll
            for (int i = 0; i < 16; ++i) {
                const int qq = (i & 3) + 8 * (i >> 2) + 4 * h;
                R[R_QSB + (size_t)(b * 2048 + qbase + qq) * 512 + hh * 64 + 32 * nt + r31] = f2bf(oacc[nt][i]);
            }
    }
}
__device__ __forceinline__ float log_sigmoid(float x) { return fminf(x, 0.f) - log1pf(__expf(-fabsf(x))); }
__device__ __forceinline__ int swz(int row, int chunk) { return row * 128 + ((chunk ^ (row & 7)) << 4); }
__device__ __forceinline__ void gla_prep(const Params& p, char* smem) {
    bf16_t* R = (bf16_t*)(p.ws + OFF_REGION);
    const float* ALR = (const float*)(R + R_ALR);
    bf16_t* KOTg = R + R_KOT; float* DECg = (float*)(R + R_DEC);
    float* SEG = (float*)smem; float* ALRs = SEG + 256;
    const int tid = threadIdx.x, d = tid & 63, w = tid >> 6;
    for (int task = blockIdx.x; task < 2048; task += gridDim.x) {
        const int bh = task >> 5, c = task & 31, b = bh >> 2, hh = bh & 3;
        const size_t rowbase = (size_t)b * 2048 + c * 64;
        unsigned qr[16], kr[16];
#pragma unroll
        for (int i = 0; i < 16; ++i) { const size_t row = rowbase + w * 16 + i; qr[i] = R[R_QG + row * 256 + hh * 64 + d]; kr[i] = R[R_KG + row * 256 + hh * 64 + d]; }
        const f32x4 ar = *(const f32x4*)(ALR + rowbase * 16 + tid * 4);
        float w2r[16];
#pragma unroll
        for (int r = 0; r < 16; ++r) w2r[r] = p.ab_w_alpha2[r * 256 + hh * 64 + d];
        const float b2r = p.ab_b_alpha2[hh * 64 + d];
        __syncthreads();
        *(f32x4*)(ALRs + tid * 4) = ar;
        __syncthreads();
        float cs[16]; float run = 0.f;
#pragma unroll
        for (int i = 0; i < 16; ++i) {
            const float* al = ALRs + (w * 16 + i) * 16;
            float pre = b2r;
#pragma unroll
            for (int r = 0; r < 16; ++r) pre += al[r] * w2r[r];
            run += log_sigmoid(pre) * (1.0f / 16.0f);
            cs[i] = run;
        }
        SEG[w * 64 + d] = run;
        __syncthreads();
        float off = 0.f, tot = 0.f;
#pragma unroll
        for (int w2 = 0; w2 < 4; ++w2) { const float s = SEG[w2 * 64 + d]; tot += s; if (w2 < w) off += s; }
        unsigned kop[8];
#pragma unroll
        for (int i2 = 0; i2 < 8; ++i2) {
            float kov[2];
#pragma unroll
            for (int u = 0; u < 2; ++u) {
                const int i = 2 * i2 + u;
                const float bc = off + cs[i];
                const float kv = bf2f((bf16_t)kr[i]);
                const size_t row = rowbase + w * 16 + i;
                R[R_QG + row * 256 + hh * 64 + d] = f2bf(bf2f((bf16_t)qr[i]) * 0.125f * __expf(bc));
                R[R_KG + row * 256 + hh * 64 + d] = f2bf(kv * __expf(-bc));
                kov[u] = kv * __expf(tot - bc);
            }
            kop[i2] = pack2(kov[0], kov[1]);
        }
        bf16_t* kp = KOTg + ((size_t)task * 64 + d) * 64 + w * 16;
        *(uint4*)kp = make_uint4(kop[0], kop[1], kop[2], kop[3]);
        *(uint4*)(kp + 8) = make_uint4(kop[4], kop[5], kop[6], kop[7]);
        if (w == 0) DECg[(size_t)task * 64 + d] = __expf(tot);
    }
}
__device__ __forceinline__ void gla_scan(const Params& p, char* smem, bool dry = false) {
    bf16_t* R = (bf16_t*)(p.ws + OFF_REGION);
    const bf16_t* KOTg = R + R_KOT; const float* DECg = (const float*)(R + R_DEC);
    char* QS = smem; char* KS = smem + 8192; char* KOT = smem + 16384; char* VTs = smem + 24576; char* SPT = smem + 40960;
    float* DEC = (float*)(smem + 57344); float* GN = DEC + 64;
    const int tid = threadIdx.x, lane = tid & 63, w = tid >> 6, l15_ = lane & 15, q4 = lane >> 4;
    for (int task = blockIdx.x; task < 64; task += gridDim.x) {
        const int b = task >> 2, hh = task & 3;
        f32x4 Sacc[8];
#pragma unroll
        for (int nt = 0; nt < 8; ++nt) Sacc[nt] = (f32x4){0.f, 0.f, 0.f, 0.f};
        __syncthreads();
        for (int i = tid; i < 1024; i += 256) *(uint4*)(SPT + i * 16) = make_uint4(0, 0, 0, 0);
        if (tid < 128) GN[tid] = p.ab_gla_norm[hh * 128 + tid];
        const size_t rowbase = (size_t)b * 2048;
        const bf16_t* vbase = R + R_VTG + ((size_t)((b * 4 + hh) * 128)) * 2048;
        u32x4 tq[2], tk[2], tko[2], vr[4]; float td = 0.f;
        auto prefetch = [&](int c) {
            const int t0 = c * 64;
#pragma unroll
            for (int i = 0; i < 2; ++i) {
                const int cid = tid + 256 * i, row = cid >> 3, ch = cid & 7;
                tq[i] = *(const u32x4*)(R + R_QG + (rowbase + t0 + row) * 256 + hh * 64 + ch * 8);
                tk[i] = *(const u32x4*)(R + R_KG + (rowbase + t0 + row) * 256 + hh * 64 + ch * 8);
                tko[i] = *(const u32x4*)(KOTg + (((size_t)task * 32 + c) * 64 + row) * 64 + ch * 8);
            }
#pragma unroll
            for (int i = 0; i < 4; ++i) { const int cid = tid + 256 * i, e = cid >> 3, ch = cid & 7; vr[i] = *(const u32x4*)(vbase + (size_t)e * 2048 + t0 + ch * 8); }
            if (tid < 64) td = DECg[((size_t)task * 32 + c) * 64 + tid];
        };
        prefetch(0);
        for (int c = 0; c < 32; ++c) {
            int lz = 0; asm volatile("" : "+v"(lz));
            const int l15 = l15_ + lz;
            const int cx = (q4 ^ (l15 & 7)) << 4;
            const int rb0 = l15 * 128 + cx, rb1 = l15 * 128 + (cx ^ 64);
#pragma unroll
            for (int i = 0; i < 2; ++i) {
                const int cid = tid + 256 * i + lz, row = cid >> 3, ch = cid & 7;
                *(u32x4*)(QS + swz(row, ch)) = tq[i]; *(u32x4*)(KS + swz(row, ch)) = tk[i]; *(u32x4*)(KOT + swz(row, ch)) = tko[i];
            }
#pragma unroll
            for (int i = 0; i < 4; ++i) { const int cid = tid + 256 * i + lz, e = cid >> 3, ch = cid & 7; *(u32x4*)(VTs + swz(e, ch)) = vr[i]; }
            if (tid < 64) DEC[tid] = td;
            uint2 gr[8];
            const unsigned goff = (unsigned)((rowbase + c * 64 + 16 * w + l15) * 512 + hh * 128 + 4 * q4);
            bf16_t* const gbase = R + R_GG;
#pragma unroll
            for (int nt = 0; nt < 8; ++nt) gr[nt] = *(const uint2*)(gbase + (goff + 16 * nt));
            if (c + 1 < 32) prefetch(c + 1);
            __syncthreads();
            bf16x8 qf[2];
#pragma unroll
            for (int kk = 0; kk < 2; ++kk) qf[kk] = *(const bf16x8*)(QS + w * 2048 + (kk ? rb1 : rb0));
            f32x4 sT[4];
#pragma unroll
            for (int st = 0; st < 4; ++st) {
                sT[st] = (f32x4){0.f, 0.f, 0.f, 0.f};
                if (st <= w) {
#pragma unroll
                    for (int kk = 0; kk < 2; ++kk) { const bf16x8 kf = *(const bf16x8*)(KS + st * 2048 + (kk ? rb1 : rb0)); sT[st] = __builtin_amdgcn_mfma_f32_16x16x32_bf16(kf, qf[kk], sT[st], 0, 0, 0); }
#pragma unroll
                    for (int r = 0; r < 4; ++r) if (16 * st + 4 * q4 + r > 16 * w + l15) sT[st][r] = 0.f;
                }
            }
            bf16x8 af[2];
#pragma unroll
            for (int ks2 = 0; ks2 < 2; ++ks2) {
                union { bf16x8 v; unsigned u[4]; } cv;
                cv.u[0] = pack2(sT[2 * ks2][0], sT[2 * ks2][1]); cv.u[1] = pack2(sT[2 * ks2][2], sT[2 * ks2][3]);
                cv.u[2] = pack2(sT[2 * ks2 + 1][0], sT[2 * ks2 + 1][1]); cv.u[3] = pack2(sT[2 * ks2 + 1][2], sT[2 * ks2 + 1][3]);
                af[ks2] = cv.v;
            }
            const int vb = l15 * 128 + ((((q4 >> 1) ^ (l15 & 7)) << 4) | ((q4 & 1) * 8));
            f32x4 o[8];
#pragma unroll
            for (int nt = 0; nt < 8; ++nt) {
                o[nt] = (f32x4){0.f, 0.f, 0.f, 0.f};
                const int e = 16 * nt + l15;
#pragma unroll
                for (int kk = 0; kk < 2; ++kk) { const bf16x8 sf = *(const bf16x8*)(SPT + nt * 2048 + (kk ? rb1 : rb0)); o[nt] = __builtin_amdgcn_mfma_f32_16x16x32_bf16(sf, qf[kk], o[nt], 0, 0, 0); }
#pragma unroll
                for (int ks2 = 0; ks2 < 2; ++ks2) {
                    if (2 * ks2 <= w) {
                        union { bf16x8 v; uint2 h[2]; } cv;
                        cv.h[0] = *(const uint2*)(VTs + nt * 2048 + (vb ^ (ks2 * 64)));
                        cv.h[1] = *(const uint2*)(VTs + nt * 2048 + (vb ^ (ks2 * 64) ^ 32));
                        o[nt] = __builtin_amdgcn_mfma_f32_16x16x32_bf16(cv.v, af[ks2], o[nt], 0, 0, 0);
                    }
                }
            }
            {
                const float4 dc = *(const float4*)(DEC + 16 * w + 4 * q4);
                bf16x8 kof[2];
#pragma unroll
                for (int kk = 0; kk < 2; ++kk) kof[kk] = *(const bf16x8*)(KOT + w * 2048 + (kk ? rb1 : rb0));
#pragma unroll
                for (int nt = 0; nt < 8; ++nt) {
                    Sacc[nt][0] *= dc.x; Sacc[nt][1] *= dc.y; Sacc[nt][2] *= dc.z; Sacc[nt][3] *= dc.w;
#pragma unroll
                    for (int kk = 0; kk < 2; ++kk) { const bf16x8 vf = *(const bf16x8*)(VTs + nt * 2048 + (kk ? rb1 : rb0)); Sacc[nt] = __builtin_amdgcn_mfma_f32_16x16x32_bf16(kof[kk], vf, Sacc[nt], 0, 0, 0); }
                }
            }
            __syncthreads();
#pragma unroll
            for (int nt = 0; nt < 8; ++nt) {
                const int e = 16 * nt + l15;
                uint2 pk; pk.x = pack2(Sacc[nt][0], Sacc[nt][1]); pk.y = pack2(Sacc[nt][2], Sacc[nt][3]);
                *(uint2*)(SPT + nt * 2048 + l15 * 128 + (((2 * w + (q4 >> 1)) ^ (l15 & 7)) << 4) + (q4 & 1) * 8) = pk;
            }
            float ssq = 0.f;
#pragma unroll
            for (int nt = 0; nt < 8; ++nt) ssq += (o[nt][0] * o[nt][0] + o[nt][1] * o[nt][1]) + (o[nt][2] * o[nt][2] + o[nt][3] * o[nt][3]);
            ssq += __shfl_xor(ssq, 16); ssq += __shfl_xor(ssq, 32);
            const float rsd = rsqrtf(ssq * (1.0f / 128.0f) + EPS);
#pragma unroll
            for (int nt = 0; nt < 8; ++nt) {
                asm volatile("" ::: "memory");
                const f32x4 gn = *(const f32x4*)(GN + 16 * nt + 4 * q4);
                const float g0 = lo2f(gr[nt].x), g1 = hi2f(gr[nt].x), g2 = lo2f(gr[nt].y), g3 = hi2f(gr[nt].y);
                uint2 ov;
                ov.x = pack2(o[nt][0] * rsd * gn[0] * (g0 / (1.0f + __expf(-g0))), o[nt][1] * rsd * gn[1] * (g1 / (1.0f + __expf(-g1))));
                ov.y = pack2(o[nt][2] * rsd * gn[2] * (g2 / (1.0f + __expf(-g2))), o[nt][3] * rsd * gn[3] * (g3 / (1.0f + __expf(-g3))));
                if (!dry || ov.x == 0x7fc17fc1u) *(uint2*)(gbase + (goff + 16 * nt)) = ov;
            }
        }
    }
}

__device__ __forceinline__ unsigned ord_key(float f) { const unsigned u = __float_as_uint(f); return (u & 0x80000000u) ? ~u : (u | 0x80000000u); }
__device__ __forceinline__ float unord_key(unsigned k) { return __uint_as_float((k & 0x80000000u) ? (k & 0x7fffffffu) : ~k); }
__device__ __forceinline__ void ce_desc(unsigned& a, unsigned& b) { const unsigned hi = max(a, b), lo = min(a, b); a = hi; b = lo; }
__device__ __forceinline__ void bitonic_sort16_desc(unsigned (&a)[16]) {
#pragma unroll
    for (int k = 2; k <= 16; k <<= 1)
#pragma unroll
        for (int j = k >> 1; j > 0; j >>= 1)
#pragma unroll
            for (int i = 0; i < 16; ++i) { const int l = i ^ j; if (l > i) { if ((i & k) == 0) ce_desc(a[i], a[l]); else ce_desc(a[l], a[i]); } }
}
__device__ __forceinline__ void merge_top16(unsigned (&L)[16], const unsigned (&B)[16]) {
#pragma unroll
    for (int i = 0; i < 16; ++i) L[i] = max(L[i], B[15 - i]);
#pragma unroll
    for (int j = 8; j > 0; j >>= 1)
#pragma unroll
        for (int i = 0; i < 16; ++i) { const int l = i ^ j; if (l > i) ce_desc(L[i], L[l]); }
}
__device__ constexpr int cand_i(int n) { int c = 0; for (int i = 0; i < 16; ++i) for (int j = 0; j < 16; ++j) if ((i + 1) * (j + 1) <= 16) { if (c == n) return i; ++c; } return -1; }
__device__ constexpr int cand_j(int n) { int c = 0; for (int i = 0; i < 16; ++i) for (int j = 0; j < 16; ++j) if ((i + 1) * (j + 1) <= 16) { if (c == n) return j; ++c; } return -1; }
template <int N> struct CandTab { int i[N], j[N]; constexpr CandTab() : i(), j() { for (int n = 0; n < N; ++n) { i[n] = cand_i(n); j[n] = cand_j(n); } } };
__device__ __forceinline__ void peer_select_fast(const Params& p, int layer, char* smem) {
    const bf16_t* A = (const bf16_t*)(p.ws + OFF_H);
    const bf16_t* Bt = (const bf16_t*)(p.ws + OFF_WT_Q) + (size_t)layer * 2048 * 1024;
    const bf16_t* SK = (const bf16_t*)(p.ws + OFF_SK) + (size_t)layer * 8 * 2 * 128 * 128;
    unsigned short* IDX = (unsigned short*)(p.ws + OFF_IDX); float* GATE = (float*)(p.ws + OFF_GATE);
    const int tid_ = threadIdx.x;
    float* SC = (float*)smem; unsigned* XCH = (unsigned*)smem;
    int mt_, hh;
    for (int it = 0; tile_sched(it, T / 128, 8, mt_, hh); ++it) {
        const int m0 = mt_ * 128;
        unsigned L0[16], L1[16];
#pragma unroll
        for (int pp = 0; pp < 2; ++pp) {
            f32x4 acc[4][4];
            gemm_mainloop<0>(A, A, 1024, 1024, Bt, 1024, m0, hh * 256 + pp * 128, acc, smem);
            int lz = 0; asm volatile("" : "+v"(lz));
            const int tid = tid_ + lz, lane = tid & 63, wid = tid >> 6, wm = wid >> 1, wn = wid & 1, l15 = lane & 15, q4 = lane >> 4, token = tid & 127, half = tid >> 7;
#pragma unroll
            for (int i = 0; i < 4; ++i)
#pragma unroll
                for (int j = 0; j < 4; ++j) {
                    const int row = wm * 64 + i * 16 + l15, chunk = 2 * j + (q4 >> 1);
                    uint2 o; o.x = pack2(acc[i][j][0], acc[i][j][1]); o.y = pack2(acc[i][j][2], acc[i][j][3]);
                    *(uint2*)(smem + wn * 32768 + row * 128 + ((chunk ^ (row & 7)) << 4) + (q4 & 1) * 8) = o;
                }
            const bf16_t* SKp = SK + (size_t)((hh * 2 + pp) * 128) * 128;
#pragma unroll
            for (int i = 0; i < 8; ++i) {
                const int c = tid + 256 * i, row = c >> 4, ch16 = c & 15, ks = ch16 >> 3, ch = ch16 & 7;
                *(uint4*)(smem + ks * 32768 + 16384 + row * 128 + ((ch ^ (row & 7)) << 4)) = *(const uint4*)(SKp + (size_t)row * 128 + ch16 * 8);
            }
            __syncthreads();
#pragma unroll
            for (int i = 0; i < 4; ++i)
#pragma unroll
                for (int j = 0; j < 4; ++j) acc[i][j] = (f32x4){0.f, 0.f, 0.f, 0.f};
#pragma unroll
            for (int kt = 0; kt < 2; ++kt) {
                const char* sa = smem + kt * 32768; const char* sb = sa + 16384;
#pragma unroll
                for (int ks = 0; ks < 2; ++ks) {
                    bf16x8 af[4], bfr[4];
                    const int ch = ks * 4 + q4;
#pragma unroll
                    for (int i = 0; i < 4; ++i) { const int row = wm * 64 + i * 16 + l15; af[i] = *(const bf16x8*)(sa + row * 128 + ((ch ^ (row & 7)) << 4)); }
#pragma unroll
                    for (int j = 0; j < 4; ++j) { const int row = wn * 64 + j * 16 + l15; bfr[j] = *(const bf16x8*)(sb + row * 128 + ((ch ^ (row & 7)) << 4)); }
#pragma unroll
                    for (int i = 0; i < 4; ++i)
#pragma unroll
                        for (int j = 0; j < 4; ++j) acc[i][j] = __builtin_amdgcn_mfma_f32_16x16x32_bf16(bfr[j], af[i], acc[i][j], 0, 0, 0);
                }
            }
            __syncthreads();
#pragma unroll
            for (int i = 0; i < 4; ++i)
#pragma unroll
                for (int j = 0; j < 4; ++j) {
                    const int m = wm * 64 + i * 16 + l15, n = wn * 64 + j * 16 + 4 * q4;
#pragma unroll
                    for (int r = 0; r < 4; ++r) SC[m * 128 + ((n + r) ^ (m & 31))] = acc[i][j][r];
                }
            __syncthreads();
            unsigned L[16];
            {
                const float* srow = SC + token * 128 + half * 64; const int x = token & 31;
#pragma unroll
                for (int ch = 0; ch < 4; ++ch) {
                    unsigned Cc[16];
#pragma unroll
                    for (int i = 0; i < 16; ++i) { const int c = ch * 16 + i; Cc[i] = (ord_key(srow[c ^ x]) & ~127u) | (unsigned)(127 - (half * 64 + c)); }
                    bitonic_sort16_desc(Cc);
                    if (ch == 0) {
#pragma unroll
                        for (int i = 0; i < 16; ++i) L[i] = Cc[i];
                    } else merge_top16(L, Cc);
                }
            }
            __syncthreads();
            if (half == 1) {
#pragma unroll
                for (int i = 0; i < 16; ++i) XCH[token * 17 + i] = L[i];
            }
            __syncthreads();
            if (half == 0) {
                unsigned Xc[16];
#pragma unroll
                for (int i = 0; i < 16; ++i) Xc[i] = XCH[token * 17 + i];
                merge_top16(L, Xc);
            }
#pragma unroll
            for (int i = 0; i < 16; ++i) { if (pp == 0) L0[i] = L[i]; else L1[i] = L[i]; }
            __syncthreads();
        }
        unsigned* NIDX = (unsigned*)smem;
        const int token = tid_ & 127, half = tid_ >> 7;
        if (half == 0) {
            float s0[16], s1[16];
#pragma unroll
            for (int i = 0; i < 16; ++i) { s0[i] = unord_key(L0[i] & ~127u); s1[i] = unord_key(L1[i] & ~127u); }
            constexpr CandTab<64> ct{};
            unsigned C[16];
#pragma unroll
            for (int ch = 0; ch < 4; ++ch) {
                unsigned Cc[16];
#pragma unroll
                for (int i = 0; i < 16; ++i) {
                    const int n = ch * 16 + i;
                    if (ct.i[n] >= 0) Cc[i] = (ord_key(s0[ct.i[n] < 0 ? 0 : ct.i[n]] + s1[ct.j[n] < 0 ? 0 : ct.j[n]]) & ~255u) | (unsigned)(255 - (ct.i[n] * 16 + ct.j[n]));
                    else Cc[i] = 0u;
                }
                bitonic_sort16_desc(Cc);
                if (ch == 0) {
#pragma unroll
                    for (int i = 0; i < 16; ++i) C[i] = Cc[i];
                } else merge_top16(C, Cc);
            }
#pragma unroll
            for (int i = 0; i < 16; ++i) { NIDX[token * 33 + i] = 127u - (L0[i] & 127u); NIDX[token * 33 + 16 + i] = 127u - (L1[i] & 127u); }
            const float mx = unord_key(C[0] & ~255u);
            float e[16]; float sum = 0.f;
#pragma unroll
            for (int r = 0; r < 16; ++r) { e[r] = __expf(unord_key(C[r] & ~255u) - mx); sum += e[r]; }
            const float inv = 1.0f / sum;
            const size_t ob = (size_t)(m0 + token) * 128 + hh * 16;
#pragma unroll
            for (int r = 0; r < 16; ++r) {
                const unsigned code = 255u - (C[r] & 255u);
                const unsigned e0 = NIDX[token * 33 + (code >> 4)], e1 = NIDX[token * 33 + 16 + (code & 15)];
                IDX[ob + r] = (unsigned short)(e0 * 128 + e1);
                GATE[ob + r] = e[r] * inv;
            }
        }
        __syncthreads();
    }
}

__device__ __forceinline__ float ub0(unsigned w) { float f; asm("v_cvt_f32_ubyte0 %0, %1" : "=v"(f) : "v"(w)); return f; }
__device__ __forceinline__ float ub1(unsigned w) { float f; asm("v_cvt_f32_ubyte1 %0, %1" : "=v"(f) : "v"(w)); return f; }
__device__ __forceinline__ float ub2(unsigned w) { float f; asm("v_cvt_f32_ubyte2 %0, %1" : "=v"(f) : "v"(w)); return f; }
__device__ __forceinline__ float ub3(unsigned w) { float f; asm("v_cvt_f32_ubyte3 %0, %1" : "=v"(f) : "v"(w)); return f; }
typedef _Float16 f16x2 __attribute__((ext_vector_type(2)));
__device__ __forceinline__ float row16_sum(float v) {
    v += __builtin_bit_cast(float, __builtin_amdgcn_update_dpp(0, __builtin_bit_cast(int, v), 0x128, 0xf, 0xf, false));
    v += __builtin_bit_cast(float, __builtin_amdgcn_update_dpp(0, __builtin_bit_cast(int, v), 0x124, 0xf, 0xf, false));
    v += __builtin_bit_cast(float, __builtin_amdgcn_update_dpp(0, __builtin_bit_cast(int, v), 0x122, 0xf, 0xf, false));
    v += __builtin_bit_cast(float, __builtin_amdgcn_update_dpp(0, __builtin_bit_cast(int, v), 0x121, 0xf, 0xf, false));
    return v;
}
__device__ __forceinline__ void glds16(const void* gsrc, unsigned lds_dst) {
    unsigned keep; const unsigned d = (unsigned)__builtin_amdgcn_readfirstlane((int)lds_dst);
    asm volatile("s_mov_b32 %0, m0\n\ts_mov_b32 m0, %2\n\ts_nop 0\n\tglobal_load_lds_dwordx4 %1, off\n\ts_mov_b32 m0, %0" : "=&s"(keep) : "v"(gsrc), "s"(d) : "memory");
}
__device__ __forceinline__ void peer_gather(const Params& p, int layer, const float* __restrict__ gnext, bool final_out, char* smem) {
    const unsigned char* REC = p.ws + OFF_UT + (size_t)layer * NEXP * 1152;
    bf16_t* H = (bf16_t*)(p.ws + OFF_H);
    const unsigned short* IDX = (const unsigned short*)(p.ws + OFF_IDX); const float* GATE = (const float*)(p.ws + OFF_GATE);
    float* X = p.out;
    const int lane = threadIdx.x & 63, wid = threadIdx.x >> 6, sub = lane >> 4, li = lane & 15;
    char* wbase = smem + wid * 19456;
    unsigned short* sIdx = (unsigned short*)wbase; float* sGate = (float*)(wbase + 256);
    const char* ring = wbase + 1024; const unsigned ringb = (unsigned)(size_t)ring;
    const int gw = blockIdx.x * 4 + wid, nw = gridDim.x * 4;
    for (int t = gw; t < T; t += nw) {
        {
            int lz = 0; asm volatile("" : "+v"(lz));
            const int l2 = 2 * (lane + lz);
            const unsigned idp = *(const unsigned*)(IDX + (size_t)t * 128 + l2);
            const float2 g2 = *(const float2*)(GATE + (size_t)t * 128 + l2);
            *(unsigned*)(sIdx + l2) = idp; *(float2*)(sGate + l2) = g2;
        }
        int xq[2][8]; float sx; float xg[2];
        {
            u32x4 xr[8]; float am = 0.f;
#pragma unroll
            for (int k = 0; k < 8; ++k) {
                xr[k] = *(const u32x4*)(H + (size_t)t * 1024 + (16 * (k >> 2) + li) * 32 + (k & 3) * 8);
#pragma unroll
                for (int c = 0; c < 4; ++c) am = fmaxf(am, fmaxf(fabsf(lo2f(xr[k][c])), fabsf(hi2f(xr[k][c]))));
            }
            am = fmaxf(am, __shfl_xor(am, 1)); am = fmaxf(am, __shfl_xor(am, 2)); am = fmaxf(am, __shfl_xor(am, 4)); am = fmaxf(am, __shfl_xor(am, 8));
            const float inv = am > 0.f ? 127.0f / am : 0.f;
            sx = am * (1.0f / 127.0f);
#pragma unroll
            for (int j = 0; j < 2; ++j) {
                int xs = 0;
#pragma unroll
                for (int d = 0; d < 8; ++d) {
                    const unsigned w0 = xr[j * 4 + (d >> 1)][(d & 1) * 2], w1 = xr[j * 4 + (d >> 1)][(d & 1) * 2 + 1];
                    const int q0 = __float2int_rn(lo2f(w0) * inv), q1 = __float2int_rn(hi2f(w0) * inv), q2 = __float2int_rn(lo2f(w1) * inv), q3 = __float2int_rn(hi2f(w1) * inv);
                    xq[j][d] = (q0 & 0xff) | ((q1 & 0xff) << 8) | ((q2 & 0xff) << 16) | ((q3 & 0xff) << 24);
                    xs += (q0 + q1) + (q2 + q3);
                }
                xg[j] = -7.5f * (float)xs;
            }
        }
        f16x2 accp[2][16];
#pragma unroll
        for (int j = 0; j < 2; ++j)
#pragma unroll
            for (int c = 0; c < 16; ++c) accp[j][c] = (f16x2){(_Float16)0.f, (_Float16)0.f};
        float wsg[2] = {0.f, 0.f};
        auto issue = [&](int sg) {
            const unsigned e_ = sIdx[sg * 4 + sub];
            const unsigned char* rec = REC + (size_t)e_ * 1152 + li * 16;
            const unsigned dst = ringb + (unsigned)(sg & 3) * 4608u;
            glds16(rec, dst); glds16(rec + 256, dst + 1024u); glds16(rec + 512, dst + 2048u); glds16(rec + 768, dst + 3072u);
            if (lane < 32) {
                const unsigned e2 = sIdx[sg * 4 + (lane >> 3)];
                glds16(REC + (size_t)e2 * 1152 + 1024 + (lane & 7) * 16, dst + 4096u);
            }
        };
        auto compute = [&](int sg) {
            const char* sl = ring + (sg & 3) * 4608;
            const u32x4 du0 = *(const u32x4*)(sl + lane * 16), du1 = *(const u32x4*)(sl + 1024 + lane * 16);
            const u32x4 dv0 = *(const u32x4*)(sl + 2048 + lane * 16), dv1 = *(const u32x4*)(sl + 3072 + lane * 16);
            const uint2 sc = *(const uint2*)(sl + 4096 + sub * 128 + li * 8);
            const float gt = sGate[sg * 4 + sub];
            const f16x2 us = __builtin_bit_cast(f16x2, sc.x), vs = __builtin_bit_cast(f16x2, sc.y);
            float pa = 0.f;
#pragma unroll
            for (int j = 0; j < 2; ++j) {
                int ia = 0;
#pragma unroll
                for (int d = 0; d < 4; ++d) {
                    const unsigned w = j ? du1[d] : du0[d];
                    ia = __builtin_amdgcn_sdot4((int)(w & 0x0f0f0f0fu), xq[j][2 * d], ia, false);
                    ia = __builtin_amdgcn_sdot4((int)((w >> 4) & 0x0f0f0f0fu), xq[j][2 * d + 1], ia, false);
                }
                pa += (float)us[j] * ((float)ia + xg[j]);
            }
            pa = row16_sum(pa);
            const float ww = gt * gelu_exact(pa * sx);
#pragma unroll
            for (int j = 0; j < 2; ++j) {
                const float wg = ww * (float)vs[j];
                wsg[j] += wg;
                const _Float16 wh = (_Float16)fminf(fmaxf(wg * 65536.0f, -65504.0f), 65504.0f);
                const f16x2 w2 = {wh, wh};
#pragma unroll
                for (int d = 0; d < 4; ++d) {
                    const unsigned wv = j ? dv1[d] : dv0[d];
                    const f16x2 c0 = __builtin_bit_cast(f16x2, (wv << 4) & 0x00f000f0u), c1 = __builtin_bit_cast(f16x2, wv & 0x00f000f0u);
                    const f16x2 c2 = __builtin_bit_cast(f16x2, (wv >> 4) & 0x00f000f0u), c3 = __builtin_bit_cast(f16x2, (wv >> 8) & 0x00f000f0u);
                    accp[j][4 * d + 0] = __builtin_elementwise_fma(c0, w2, accp[j][4 * d + 0]); accp[j][4 * d + 1] = __builtin_elementwise_fma(c1, w2, accp[j][4 * d + 1]);
                    accp[j][4 * d + 2] = __builtin_elementwise_fma(c2, w2, accp[j][4 * d + 2]); accp[j][4 * d + 3] = __builtin_elementwise_fma(c3, w2, accp[j][4 * d + 3]);
                }
            }
        };
        asm volatile("s_waitcnt vmcnt(0)" ::: "memory");
        issue(0); issue(1); issue(2);
#pragma unroll 1
        for (int sg = 0; sg < 29; ++sg) {
            issue(sg + 3);
            asm volatile("s_waitcnt vmcnt(15)" ::: "memory");
            compute(sg);
        }
        asm volatile("s_waitcnt vmcnt(10)" ::: "memory");
        compute(29);
        asm volatile("s_waitcnt vmcnt(5)" ::: "memory");
        compute(30);
        asm volatile("s_waitcnt vmcnt(0)" ::: "memory");
        compute(31);
        float acc[2][32];
#pragma unroll
        for (int j = 0; j < 2; ++j)
#pragma unroll
            for (int d = 0; d < 4; ++d) {
                acc[j][8 * d + 0] = 16.0f * (float)accp[j][4 * d + 0][0]; acc[j][8 * d + 2] = 16.0f * (float)accp[j][4 * d + 0][1];
                acc[j][8 * d + 4] = 16.0f * (float)accp[j][4 * d + 1][0]; acc[j][8 * d + 6] = 16.0f * (float)accp[j][4 * d + 1][1];
                acc[j][8 * d + 1] = 16.0f * (float)accp[j][4 * d + 2][0]; acc[j][8 * d + 3] = 16.0f * (float)accp[j][4 * d + 2][1];
                acc[j][8 * d + 5] = 16.0f * (float)accp[j][4 * d + 3][0]; acc[j][8 * d + 7] = 16.0f * (float)accp[j][4 * d + 3][1];
            }
        const bool up2 = (sub & 2) != 0, up1 = (sub & 1) != 0;
        float wsum = (up2 ? wsg[1] : wsg[0]) + __shfl_xor(up2 ? wsg[0] : wsg[1], 32);
        wsum += __shfl_xor(wsum, 16);
        float r1[32];
#pragma unroll
        for (int c = 0; c < 32; ++c) r1[c] = (up2 ? acc[1][c] : acc[0][c]) + __shfl_xor(up2 ? acc[0][c] : acc[1][c], 32);
        float r2[16];
#pragma unroll
        for (int c = 0; c < 16; ++c) r2[c] = (up1 ? r1[16 + c] : r1[c]) + __shfl_xor(up1 ? r1[c] : r1[16 + c], 16);
        const int col0 = (16 * (sub >> 1) + li) * 32 + (sub & 1) * 16;
        float ss = 0.f;
        float* xrow = X + (size_t)t * 1024 + col0;
#pragma unroll
        for (int c4 = 0; c4 < 4; ++c4) {
            const f32x4 a = *(const f32x4*)(xrow + c4 * 4);
#pragma unroll
            for (int c = 0; c < 4; ++c) { r2[c4 * 4 + c] = r2[c4 * 4 + c] - 7.5f * wsum + a[c]; ss += r2[c4 * 4 + c] * r2[c4 * 4 + c]; }
        }
        ss = wave_sum(ss);
        const float rstd = rsqrtf(ss * (1.0f / D) + EPS);
        const float* gp = gnext + col0;
        if (final_out) {
#pragma unroll
            for (int c4 = 0; c4 < 4; ++c4) {
                const f32x4 g = *(const f32x4*)(gp + c4 * 4);
                *(f32x4*)(xrow + c4 * 4) = (f32x4){r2[c4 * 4] * rstd * g[0], r2[c4 * 4 + 1] * rstd * g[1], r2[c4 * 4 + 2] * rstd * g[2], r2[c4 * 4 + 3] * rstd * g[3]};
            }
        } else {
            u32x4 o[2];
#pragma unroll
            for (int c4 = 0; c4 < 4; ++c4) {
                const f32x4 g = *(const f32x4*)(gp + c4 * 4);
                *(f32x4*)(xrow + c4 * 4) = (f32x4){r2[c4 * 4], r2[c4 * 4 + 1], r2[c4 * 4 + 2], r2[c4 * 4 + 3]};
                o[c4 >> 1][(c4 & 1) * 2] = pack2(r2[c4 * 4] * rstd * g[0], r2[c4 * 4 + 1] * rstd * g[1]);
                o[c4 >> 1][(c4 & 1) * 2 + 1] = pack2(r2[c4 * 4 + 2] * rstd * g[2], r2[c4 * 4 + 3] * rstd * g[3]);
            }
            bf16_t* hp = H + (size_t)t * 1024 + col0;
            *(u32x4*)hp = o[0]; *(u32x4*)(hp + 8) = o[1];
        }
    }
}

__device__ __forceinline__ void spatial_fast(const Params& p, char* smem) {
    bf16_t* U = (bf16_t*)(p.ws + OFF_REGION); const bf16_t* VT = U + (size_t)T * 2048; const float* SSQ = (const float*)(p.ws + OFF_SSQ);
    const int tid_ = threadIdx.x;
    for (int task = blockIdx.x; task < 2048; task += gridDim.x) {
        const int chunk = task >> 3, g = task & 7;
        int lz = 0; asm volatile("" : "+v"(lz));
        const int tid = tid_ + lz, lane = tid & 63, wid = tid >> 6, wm = wid >> 1, wn = wid & 1, l15 = lane & 15, q4 = lane >> 4;
        float* rs = (float*)(smem + 16384);
        if (tid < 128) {
            const float* sp = SSQ + (size_t)(chunk * 128 + tid) * 32;
            float s = 0.f;
#pragma unroll
            for (int i = 0; i < 8; ++i) { const f32x4 v = *(const f32x4*)(sp + 4 * i); s += (v[0] + v[1]) + (v[2] + v[3]); }
            rs[tid] = rsqrtf(s * (1.0f / 2048.0f) + EPS);
        }
        __syncthreads();
#pragma unroll
        for (int i = 0; i < 8; ++i) {
            const int c = tid + 256 * i, row = c >> 4, ch16 = c & 15, ks = ch16 >> 3, ch = ch16 & 7, s0 = ch16 * 8;
            const float* wp = p.c_w_spatial + ((size_t)(g * 128 + row)) * 128 + s0;
            const f32x4 w0 = *(const f32x4*)wp, w1 = *(const f32x4*)(wp + 4);
            const f32x4 r0 = *(const f32x4*)(rs + s0), r1 = *(const f32x4*)(rs + s0 + 4);
            float v[8];
#pragma unroll
            for (int j = 0; j < 4; ++j) { v[j] = (s0 + j <= row) ? w0[j] * r0[j] : 0.f; v[4 + j] = (s0 + 4 + j <= row) ? w1[j] * r1[j] : 0.f; }
            *(uint4*)(smem + ks * 32768 + row * 128 + ((ch ^ (row & 7)) << 4)) = make_uint4(pack2(v[0], v[1]), pack2(v[2], v[3]), pack2(v[4], v[5]), pack2(v[6], v[7]));
        }
        __syncthreads();
#pragma unroll 1
        for (int nh = 0; nh < 2; ++nh) {
            const int chan0 = g * 256 + nh * 128;
#pragma unroll
            for (int i = 0; i < 8; ++i) {
                const int c = tid + 256 * i, row = c >> 4, ch16 = c & 15, ks = ch16 >> 3, ch = ch16 & 7;
                *(uint4*)(smem + ks * 32768 + 16384 + row * 128 + ((ch ^ (row & 7)) << 4)) = *(const uint4*)(VT + ((size_t)chunk * 2048 + chan0 + row) * 128 + ch16 * 8);
            }
            __syncthreads();
            f32x4 acc[4][4];
#pragma unroll
            for (int i = 0; i < 4; ++i)
#pragma unroll
                for (int j = 0; j < 4; ++j) acc[i][j] = (f32x4){0.f, 0.f, 0.f, 0.f};
#pragma unroll
            for (int kt = 0; kt < 2; ++kt) {
                if (kt == 1 && wm == 0) continue;
                const char* sa = smem + kt * 32768; const char* sb = sa + 16384;
#pragma unroll
                for (int ks = 0; ks < 2; ++ks) {
                    bf16x8 af[4], bfr[4];
                    const int ch = ks * 4 + q4;
#pragma unroll
                    for (int i = 0; i < 4; ++i) { const int row = wm * 64 + i * 16 + l15; af[i] = *(const bf16x8*)(sa + row * 128 + ((ch ^ (row & 7)) << 4)); }
#pragma unroll
                    for (int j = 0; j < 4; ++j) { const int row = wn * 64 + j * 16 + l15; bfr[j] = *(const bf16x8*)(sb + row * 128 + ((ch ^ (row & 7)) << 4)); }
#pragma unroll
                    for (int i = 0; i < 4; ++i)
#pragma unroll
                        for (int j = 0; j < 4; ++j) acc[i][j] = __builtin_amdgcn_mfma_f32_16x16x32_bf16(bfr[j], af[i], acc[i][j], 0, 0, 0);
                }
            }
            __syncthreads();
#pragma unroll
            for (int i = 0; i < 4; ++i) {
                const int m = wm * 64 + i * 16 + l15;
                const float bias = p.c_b_spatial[g * 128 + m];
#pragma unroll
                for (int j = 0; j < 4; ++j) {
                    const int chan = chan0 + wn * 64 + j * 16 + 4 * q4;
                    const f32x4 vn = *(const f32x4*)(p.c_v_norm + chan);
                    bf16_t* up = U + (size_t)(chunk * 128 + m) * 2048 + chan;
                    const uint2 uu = *(const uint2*)up;
                    uint2 o;
                    o.x = pack2(lo2f(uu.x) * (vn[0] * acc[i][j][0] + bias), hi2f(uu.x) * (vn[1] * acc[i][j][1] + bias));
                    o.y = pack2(lo2f(uu.y) * (vn[2] * acc[i][j][2] + bias), hi2f(uu.y) * (vn[3] * acc[i][j][3] + bias));
                    *(uint2*)up = o;
                }
            }
        }
    }
}

#define XB_TMO      128
#define XB_XCNT(j)  (256  + 64 * (j))
#define XB_XSUB(j)  (1280 + 64 * (j))
#define XB_XGEN(j)  (2304 + 64 * (j))
#define XB_TOP      3328
#define XB_TOPGEN   3392
#define XCD_BAR_WORDS 3456
#define XB_SPIN_CAP (1u << 22)
#define LAS __attribute__((address_space(3)))
__device__ __forceinline__ unsigned xb_ld(unsigned* p)              { return __hip_atomic_load(p, __ATOMIC_RELAXED, __HIP_MEMORY_SCOPE_AGENT); }
__device__ __forceinline__ unsigned xb_add(unsigned* p, unsigned v) { return __hip_atomic_fetch_add(p, v, __ATOMIC_RELAXED, __HIP_MEMORY_SCOPE_AGENT); }
__device__ __forceinline__ unsigned xb_xcc_id() { return (unsigned)__builtin_amdgcn_s_getreg((3 << 11) | 20) & 0xFu; }
#define XB_SPIN(cond, bar) do { unsigned _sp = 0; while (cond) { __builtin_amdgcn_s_sleep(1); \
    if ((++_sp & 255u) == 0u) { if (xb_ld(&(bar)[XB_TMO])) break; if (_sp > XB_SPIN_CAP) { atomicAdd(&(bar)[XB_TMO], 1u); break; } } } } while (0)
struct XcdBarrier { unsigned* bar; unsigned x; volatile LAS unsigned* st; };
__device__ __forceinline__ XcdBarrier xcd_barrier_post(unsigned* bar, volatile LAS unsigned* st) {
    XcdBarrier b; b.bar = bar; b.x = xb_xcc_id(); b.st = st;
    if (threadIdx.x == 0) (void)xb_add(&bar[XB_XCNT(b.x)], 1u);
    return b;
}
__device__ __forceinline__ void xcd_barrier_complete(unsigned* bar, unsigned x, unsigned& nloc, unsigned& nx) {
    const unsigned G = gridDim.x * gridDim.y * gridDim.z;
    unsigned sum, cnt, mine, sp = 0u;
    for (;;) {
        sum = 0u; cnt = 0u; mine = 0u;
#pragma unroll
        for (unsigned j = 0; j < 16; ++j) { const unsigned c = xb_ld(&bar[XB_XCNT(j)]); sum += c; cnt += (c > 0u) ? 1u : 0u; mine = (j == x) ? c : mine; }
        if (sum == G) break;
        __builtin_amdgcn_s_sleep(1);
        if ((++sp & 255u) == 0u) { if (xb_ld(&bar[XB_TMO])) break; if (sp > XB_SPIN_CAP) { atomicAdd(&bar[XB_TMO], 1u); break; } }
    }
    nloc = mine > 0u ? mine : 1u; nx = cnt > 0u ? cnt : 1u;
}
__device__ __forceinline__ void xcd_barrier(const XcdBarrier& b) {
    asm volatile("s_waitcnt vmcnt(0)" ::: "memory");
    __syncthreads();
    if (threadIdx.x == 0) {
        unsigned* bar = b.bar;
        __builtin_amdgcn_s_waitcnt(0);
        unsigned nloc = b.st[0], nx = b.st[1];
        if (nloc == 0u) { xcd_barrier_complete(bar, b.x, nloc, nx); b.st[0] = nloc; b.st[1] = nx; }
        const unsigned old = xb_add(&bar[XB_XSUB(b.x)], 1u);
        const unsigned gen = old / nloc;
        if (old + 1u == (gen + 1u) * nloc) {
            __builtin_amdgcn_fence(__ATOMIC_RELEASE, "agent");
            asm volatile("s_waitcnt vmcnt(0)" ::: "memory");
            const unsigned og = xb_add(&bar[XB_TOP], 1u);
            const unsigned tg = og / nx;
            if (og + 1u == (tg + 1u) * nx) xb_add(&bar[XB_TOPGEN], 1u);
            else XB_SPIN(xb_ld(&bar[XB_TOPGEN]) == tg, bar);
            __builtin_amdgcn_fence(__ATOMIC_ACQUIRE, "agent");
            xb_add(&bar[XB_XGEN(b.x)], 1u);
            asm volatile("s_waitcnt vmcnt(0)" ::: "memory");
        } else {
            XB_SPIN(xb_ld(&bar[XB_XGEN(b.x)]) == gen, bar);
            __builtin_amdgcn_fence(__ATOMIC_ACQUIRE, "agent");
            asm volatile("s_waitcnt vmcnt(0)" ::: "memory");
        }
    }
    __syncthreads();
}

constexpr int NPHASE = 14;
constexpr int kDynLds = 81920;
__global__ void __launch_bounds__(256, 2) mega(Params p, int ph_lo, int ph_hi) {
    extern __shared__ __attribute__((aligned(16))) char smem[];
    cg::grid_group grid = cg::this_grid();
    uint4& xb_words = *(uint4*)(smem + kDynLds - 16);
    if (threadIdx.x == 0) xb_words = make_uint4(0u, 0u, 0u, 0u);
    __syncthreads();
    const XcdBarrier xbar = xcd_barrier_post((unsigned*)(p.ws + OFF_BAR), (volatile LAS unsigned*)&xb_words);
    bf16_t* Rg = (bf16_t*)(p.ws + OFF_REGION);
    bf16_t* Hb = (bf16_t*)(p.ws + OFF_H);
#define PHASE(k, ...) if (ph_lo <= (k) && (k) < ph_hi) { __VA_ARGS__; if ((k) + 1 < ph_hi) { if ((k) == 0) grid.sync(); else xcd_barrier(xbar); } }
    unsigned* sbctr = (unsigned*)(p.ws + OFF_BAR + 14336);
    PHASE(0,
        transpose_convert(p.ab_w_in, (bf16_t*)(p.ws + OFF_WT_IN), 1024, AB_IN, AB_IN_PAD, smem);
        rmsnorm_rows(p.x, p.norm_mix, Hb))
    PHASE(1, phase_gemm_in(p, smem))
    PHASE(2, gla_prep(p, smem))
    PHASE(3, gla_scan(p, smem); sb_fast(p, smem, sbctr); quantize_tables_queued(p, smem, sbctr + 1);
        transpose_convert(p.ab_w_out, (bf16_t*)(p.ws + OFF_WT_OUT), 1024, 1024, 1024, smem);
        transpose_convert(p.c_w_in, (bf16_t*)(p.ws + OFF_WT_CIN), 1024, 4096, 4096, smem);
        transpose_convert(p.c_w_out, (bf16_t*)(p.ws + OFF_WT_COUT), 2048, 1024, 1024, smem);
        transpose_convert(p.peer_w_q, (bf16_t*)(p.ws + OFF_WT_Q), 1024, 2048, 2048, smem);
        transpose_convert(p.peer_w_q + (size_t)1024 * 2048, (bf16_t*)(p.ws + OFF_WT_Q) + (size_t)2048 * 1024, 1024, 2048, 2048, smem);
        convert_flat(p.peer_subkeys, (bf16_t*)(p.ws + OFF_SK), (size_t)2 * 8 * 2 * 128 * 128))
    PHASE(4, phase_gemm_resid(Rg + R_QSB, Rg + R_GG, 512, 512, (const bf16_t*)(p.ws + OFF_WT_OUT), 1024, p.x, p.out, smem))
    PHASE(5, rmsnorm_rows(p.out, p.norm_ffn, Hb))
    PHASE(6, peer_select_fast(p, 0, smem))
    PHASE(7, peer_gather(p, 0, p.norm_mix + 1024, false, smem))
    PHASE(8, phase_gemm_cin(p, smem))
    PHASE(9, spatial_fast(p, smem))
    PHASE(10, phase_gemm_resid(Rg, Rg, 2048, 2048, (const bf16_t*)(p.ws + OFF_WT_COUT), 2048, p.out, p.out, smem))
    PHASE(11, rmsnorm_rows(p.out, p.norm_ffn + 1024, Hb))
    PHASE(12, peer_select_fast(p, 1, smem))
    PHASE(13, peer_gather(p, 1, p.final_norm, true, smem))
}

extern "C" void kernel_launch(void* const* d_in, const int* in_sizes, int n_in, void* d_out, int out_size, void* d_ws, size_t ws_size, hipStream_t stream) {
    static int grid_blocks = 0;
    if (!grid_blocks) {
        int dev = 0, cus = 0, per_cu = 0;
        hipGetDevice(&dev);
        hipDeviceGetAttribute(&cus, hipDeviceAttributeMultiprocessorCount, dev);
        hipFuncSetAttribute((const void*)mega, hipFuncAttributeMaxDynamicSharedMemorySize, kDynLds);
        hipOccupancyMaxActiveBlocksPerMultiprocessor(&per_cu, mega, 256, kDynLds);
        if (per_cu < 1) per_cu = 1;
        if (per_cu > 2) per_cu = 2;
        grid_blocks = cus * per_cu;
        if (n_in != 18 || ws_size < WS_END) fprintf(stderr, "kernel_launch: unexpected n_in %d or ws_size %zu < %zu\n", n_in, ws_size, (size_t)WS_END);
    }
    Params p{};
    p.x = (const float*)d_in[0]; p.norm_mix = (const float*)d_in[1]; p.norm_ffn = (const float*)d_in[2]; p.ab_w_in = (const float*)d_in[3];
    p.ab_w_alpha2 = (const float*)d_in[4]; p.ab_b_alpha2 = (const float*)d_in[5]; p.ab_gla_norm = (const float*)d_in[6]; p.ab_w_out = (const float*)d_in[7];
    p.c_w_in = (const float*)d_in[8]; p.c_v_norm = (const float*)d_in[9]; p.c_w_spatial = (const float*)d_in[10]; p.c_b_spatial = (const float*)d_in[11];
    p.c_w_out = (const float*)d_in[12]; p.peer_w_q = (const float*)d_in[13]; p.peer_subkeys = (const float*)d_in[14]; p.peer_u = (const float*)d_in[15];
    p.peer_v = (const float*)d_in[16]; p.final_norm = (const float*)d_in[17];
    p.out = (float*)d_out; p.ws = (unsigned char*)d_ws;
    (void)hipMemsetAsync((char*)d_ws + OFF_BAR, 0, 16384, stream);
#if ONE_LAUNCH
    int lo = 0, hi = NPHASE;
    void* args[] = {&p, &lo, &hi};
    hipError_t e = hipLaunchCooperativeKernel((void*)mega, dim3(grid_blocks), dim3(256), args, kDynLds, stream);
    if (e != hipSuccess) fprintf(stderr, "cooperative launch failed: %s (grid %d)\n", hipGetErrorString(e), grid_blocks);
#else
    for (int ph = 0; ph < NPHASE; ++ph) hipLaunchKernelGGL(mega, dim3(grid_blocks), dim3(256), kDynLds, stream, p, ph, ph + 1);
#endif
}
```

```cpp
#include <hip/hip_runtime.h>
#include <hip/hip_cooperative_groups.h>
#include <cstdio>
#include <cstdint>
namespace cg = cooperative_groups;

#ifndef ONE_LAUNCH
#define ONE_LAUNCH 1
#endif


#define VTID ((int)(threadIdx.x & 255))
#define VBID ((int)(blockIdx.x * 2 + (threadIdx.x >> 8)))
#define VGRID ((int)(gridDim.x * 2))
typedef unsigned short bf16_t;
typedef short bf16x8 __attribute__((ext_vector_type(8)));
typedef float f32x4 __attribute__((ext_vector_type(4)));
typedef unsigned u32x4 __attribute__((ext_vector_type(4)));
typedef __bf16 bf16x2_t __attribute__((ext_vector_type(2)));

constexpr int T = 32768, D = 1024, SEQ = 2048, NB = 16;
constexpr int AB_IN = 3088, AB_IN_PAD = 3200;
constexpr float EPS = 1e-6f;
constexpr int NEXP = 16384;

constexpr size_t SZ_WT_IN = (size_t)AB_IN_PAD * 1024 * 2;
constexpr size_t SZ_WT_OUT = (size_t)1024 * 1024 * 2;
constexpr size_t SZ_WT_CIN = (size_t)4096 * 1024 * 2;
constexpr size_t SZ_WT_COUT = (size_t)1024 * 2048 * 2;
constexpr size_t SZ_WT_Q = (size_t)2 * 2048 * 1024 * 2;
constexpr size_t SZ_SK = (size_t)2 * 8 * 2 * 128 * 128 * 2;
constexpr size_t SZ_TAB = (size_t)2 * NEXP * 1024;
constexpr size_t SZ_TSC = (size_t)2 * NEXP * 4;
constexpr size_t OFF_WT_IN = 0;
constexpr size_t OFF_WT_OUT = OFF_WT_IN + SZ_WT_IN;
constexpr size_t OFF_WT_CIN = OFF_WT_OUT + SZ_WT_OUT;
constexpr size_t OFF_WT_COUT = OFF_WT_CIN + SZ_WT_CIN;
constexpr size_t OFF_WT_Q = OFF_WT_COUT + SZ_WT_COUT;
constexpr size_t OFF_SK = OFF_WT_Q + SZ_WT_Q;
constexpr size_t OFF_UT = OFF_SK + SZ_SK;
constexpr size_t OFF_VT = OFF_UT + SZ_TAB;
constexpr size_t OFF_USC = OFF_VT + SZ_TAB;
constexpr size_t OFF_VSC = OFF_USC + SZ_TSC;
constexpr size_t OFF_H = OFF_VSC + SZ_TSC;
constexpr size_t OFF_IDX = OFF_H + (size_t)T * 1024 * 2;
constexpr size_t OFF_GATE = OFF_IDX + (size_t)T * 128 * 2;
constexpr size_t OFF_SSQ = OFF_GATE + (size_t)T * 128 * 4;
constexpr size_t OFF_REGION = OFF_SSQ + (size_t)T * 32 * 4;
constexpr size_t SZ_REGION = (size_t)256 << 20;
constexpr size_t OFF_BAR = OFF_REGION + SZ_REGION;
constexpr size_t WS_END = OFF_BAR + 16384;
constexpr size_t R_QSB = 0;
constexpr size_t R_KSB = R_QSB + (size_t)T * 512;
constexpr size_t R_VTSB = R_KSB + (size_t)T * 512;
constexpr size_t R_QG = R_VTSB + (size_t)T * 512;
constexpr size_t R_KG = R_QG + (size_t)T * 256;
constexpr size_t R_VTG = R_KG + (size_t)T * 256;
constexpr size_t R_GG = R_VTG + (size_t)T * 512;
constexpr size_t R_ALR = R_GG + (size_t)T * 512;
constexpr size_t R_KOT = R_ALR + (size_t)T * 32;
constexpr size_t R_DEC = R_KOT + (size_t)T * 256;

struct Params {
    const float* x; const float* norm_mix; const float* norm_ffn; const float* ab_w_in; const float* ab_w_alpha2; const float* ab_b_alpha2;
    const float* ab_gla_norm; const float* ab_w_out; const float* c_w_in; const float* c_v_norm; const float* c_w_spatial; const float* c_b_spatial;
    const float* c_w_out; const float* peer_w_q; const float* peer_subkeys; const float* peer_u; const float* peer_v; const float* final_norm;
    float* out; unsigned char* ws;
};

__device__ __forceinline__ float bf2f(bf16_t v) { return __uint_as_float(((unsigned)v) << 16); }
__device__ __forceinline__ bf16_t f2bf(float f) { unsigned u = __float_as_uint(f); u += 0x7fffu + ((u >> 16) & 1u); return (bf16_t)(u >> 16); }
__device__ __forceinline__ unsigned pack2(float lo, float hi) { return (unsigned)f2bf(lo) | ((unsigned)f2bf(hi) << 16); }
__device__ __forceinline__ float lo2f(unsigned w) { return __uint_as_float(w << 16); }
__device__ __forceinline__ float hi2f(unsigned w) { return __uint_as_float(w & 0xffff0000u); }
__device__ __forceinline__ float dot2(unsigned a, unsigned b, float acc) { return __builtin_amdgcn_fdot2_f32_bf16(__builtin_bit_cast(bf16x2_t, a), __builtin_bit_cast(bf16x2_t, b), acc, false); }
__device__ __forceinline__ float gelu_exact(float v) {
    const float av = fabsf(v);
    const float t = __builtin_amdgcn_rcpf(av * 0.2316418882f + 1.0f);
    float q = t * 0.5307027145f - 0.7265760135f; q = q * t + 0.7107068705f; q = q * t - 0.142248368f; q = q * t + 0.127414796f; q = q * t;
    const float e = __builtin_amdgcn_exp2f(v * v * -0.72134752044f);
    const float m = v * (q * e);
    return v < 0.f ? m : v - m;
}
__device__ __forceinline__ float row16_sum(float v) {
    v += __builtin_bit_cast(float, __builtin_amdgcn_update_dpp(0, __builtin_bit_cast(int, v), 0x128, 0xf, 0xf, false));
    v += __builtin_bit_cast(float, __builtin_amdgcn_update_dpp(0, __builtin_bit_cast(int, v), 0x124, 0xf, 0xf, false));
    v += __builtin_bit_cast(float, __builtin_amdgcn_update_dpp(0, __builtin_bit_cast(int, v), 0x122, 0xf, 0xf, false));
    v += __builtin_bit_cast(float, __builtin_amdgcn_update_dpp(0, __builtin_bit_cast(int, v), 0x121, 0xf, 0xf, false));
    return v;
}
__device__ __forceinline__ float wave_sum(float v) {
#pragma unroll
    for (int o = 32; o >= 1; o >>= 1) v += __shfl_xor(v, o);
    return v;
}

template <bool PERM_IN = false>
__device__ __forceinline__ void transpose_convert(const float* __restrict__ W, bf16_t* __restrict__ Wt, int K, int N, int Npad, char* smem) {
    float* tile = (float*)smem;
    const int tk = K / 64, tn = Npad / 64, ntile = tk * tn;
    const int tid = VTID;
    for (int tl = VBID; tl < ntile; tl += VGRID) {
        const int k0 = (tl % tk) * 64, n0 = (tl / tk) * 64;
        const int c = tid & 63, r0 = tid >> 6;
        int nd = n0;
        if (PERM_IN) { if (n0 >= 1024 && n0 < 1536) nd = n0 + 1024; else if (n0 >= 1536 && n0 < 2048) nd = n0 - 512; else if (n0 >= 2048 && n0 < 2560) nd = n0 + 512; else if (n0 >= 2560 && n0 < 3072) nd = n0 - 1024; }
#pragma unroll
        for (int i = 0; i < 16; ++i) {
            const int r = r0 + 4 * i;
            const float v = (n0 + c < N) ? W[(size_t)(k0 + r) * N + n0 + c] : 0.f;
            tile[c * 65 + r] = v;
        }
        __syncthreads();
#pragma unroll
        for (int i = 0; i < 16; ++i) {
            const int n = r0 + 4 * i;
            Wt[(size_t)(nd + n) * K + k0 + c] = f2bf(tile[n * 65 + c]);
        }
        __syncthreads();
    }
}
__device__ __forceinline__ void convert_flat(const float* __restrict__ src, bf16_t* __restrict__ dst, size_t n) {
    const size_t nv = n / 8;
    for (size_t i = (size_t)VBID * 256 + VTID; i < nv; i += (size_t)VGRID * 256) {
        const float4 a = ((const float4*)src)[2 * i], b = ((const float4*)src)[2 * i + 1];
        uint4 o; o.x = pack2(a.x, a.y); o.y = pack2(a.z, a.w); o.z = pack2(b.x, b.y); o.w = pack2(b.z, b.w);
        ((uint4*)dst)[i] = o;
    }
}
__device__ __forceinline__ void quantize_tables_static(const Params& p) {
    const int lane = VTID & 63, wid = VTID >> 6;
    for (unsigned task = (unsigned)VBID; task < 512u; task += (unsigned)VGRID) {
        const bool isv = task >= 256u;
        const int r0 = (int)(task & 255u) * 128 + wid * 32;
        const float* src = isv ? p.peer_v : p.peer_u;
        unsigned char* recs = p.ws + OFF_UT;
        for (int rr = 0; rr < 32; ++rr) {
            const int r = r0 + rr;
            const float* xr = src + (size_t)r * 1024 + lane * 16;
            f32x4 v[4]; float aml = 0.f;
#pragma unroll
            for (int i = 0; i < 4; ++i) {
                v[i] = *(const f32x4*)(xr + i * 4);
                aml = fmaxf(aml, fmaxf(fmaxf(fabsf(v[i][0]), fabsf(v[i][1])), fmaxf(fabsf(v[i][2]), fabsf(v[i][3]))));
            }
            const float gs = fmaxf(aml, __shfl_xor(aml, 1)) * (1.002f / 7.5f);
            const _Float16 hs = (_Float16)gs;
            const float gsd = (float)hs, ginv = gsd > 0.f ? 1.0f / gsd : 0.f;
            unsigned wd[2];
#pragma unroll
            for (int dd = 0; dd < 2; ++dd) {
                unsigned wv = 0;
#pragma unroll
                for (int b = 0; b < 4; ++b) {
                    const int qa = min(15, max(0, __float2int_rn(v[2 * dd][b] * ginv + 7.5f)));
                    const int qb = min(15, max(0, __float2int_rn(v[2 * dd + 1][b] * ginv + 7.5f)));
                    wv |= ((unsigned)qa | ((unsigned)qb << 4)) << (8 * b);
                }
                wd[dd] = wv;
            }
            unsigned char* rec = recs + (size_t)r * 1152;
            *(uint2*)(rec + (isv ? 512 : 0) + lane * 8) = make_uint2(wd[0], wd[1]);
            if ((lane & 1) == 0) { const int g = lane >> 1; *(_Float16*)(rec + 1024 + (g & 15) * 8 + (isv ? 4 : 0) + (g >> 4) * 2) = hs; }
        }
    }
}
__device__ __forceinline__ void rmsnorm_rows(const float* __restrict__ X, const float* __restrict__ g, bf16_t* __restrict__ Hout) {
    const int lane = VTID & 63, wid = VTID >> 6;
    const int gw = VBID * 4 + wid, nw = VGRID * 4;
    for (int t = gw; t < T; t += nw) {
        const float* xr = X + (size_t)t * D;
        float4 v[4]; float ss = 0.f;
#pragma unroll
        for (int i = 0; i < 4; ++i) { v[i] = *(const float4*)(xr + i * 256 + lane * 4); ss += v[i].x * v[i].x + v[i].y * v[i].y + v[i].z * v[i].z + v[i].w * v[i].w; }
        ss = wave_sum(ss);
        const float rstd = rsqrtf(ss * (1.0f / D) + EPS);
#pragma unroll
        for (int i = 0; i < 4; ++i) {
            const float4 gg = *(const float4*)(g + i * 256 + lane * 4);
            uint2 o; o.x = pack2(v[i].x * rstd * gg.x, v[i].y * rstd * gg.y); o.y = pack2(v[i].z * rstd * gg.z, v[i].w * rstd * gg.w);
            *(uint2*)(Hout + (size_t)t * D + i * 256 + lane * 4) = o;
        }
    }
}

template <int MODE>
__device__ __forceinline__ void gemm_mainloop(const bf16_t* __restrict__ A0, const bf16_t* __restrict__ A1, int lda, int ksplit,
                                              const bf16_t* __restrict__ Bt, int K, int m0, int n0, f32x4 (&acc)[4][4], char* smem) {
    const int tid = VTID, lane = tid & 63, wid = tid >> 6, wm = wid >> 1, wn = wid & 1;
    const int lrow = tid >> 3, lch = tid & 7;
#pragma unroll
    for (int i = 0; i < 4; ++i)
#pragma unroll
        for (int j = 0; j < 4; ++j) acc[i][j] = (f32x4){0.f, 0.f, 0.f, 0.f};
    const int nk = K / 64;
    unsigned aoff[4], boff[4];
    {
        const int rr = lane >> 3, cc = ((lane & 7) ^ rr) * 8;
#pragma unroll
        for (int i = 0; i < 4; ++i) {
            aoff[i] = (unsigned)(((m0 + 32 * wid + 8 * i + rr) * lda + cc) * 2);
            boff[i] = (unsigned)(((n0 + 32 * wid + 8 * i + rr) * K + cc) * 2);
        }
    }
    auto stage = [&](int kt, int buf) {
        const int kb = kt * 64;
        const char* Ab; const char* Bb = (const char*)(Bt + kb);
        if (kb < ksplit) Ab = (const char*)(A0 + kb); else Ab = (const char*)(A1 + (kb - ksplit));
        char* sa = smem + buf * 32768 + wid * 4096 + lane * 16; char* sb = sa + 16384;
#pragma unroll
        for (int i = 0; i < 4; ++i) __builtin_amdgcn_global_load_lds((const unsigned*)(Ab + aoff[i]), (unsigned*)(sa + i * 1024), 16, 0, 0);
#pragma unroll
        for (int i = 0; i < 4; ++i) __builtin_amdgcn_global_load_lds((const unsigned*)(Bb + boff[i]), (unsigned*)(sb + i * 1024), 16, 0, 0);
    };
    auto compute = [&](int buf) {
        const char* sa = smem + buf * 32768; const char* sb = sa + 16384;
#pragma unroll
        for (int ks = 0; ks < 2; ++ks) {
            bf16x8 af[4], bfr[4];
            const int ch = ks * 4 + (lane >> 4);
#pragma unroll
            for (int i = 0; i < 4; ++i) { const int row = wm * 64 + i * 16 + (lane & 15); af[i] = *(const bf16x8*)(sa + row * 128 + ((ch ^ (row & 7)) << 4)); }
#pragma unroll
            for (int j = 0; j < 4; ++j) { const int row = wn * 64 + j * 16 + (lane & 15); bfr[j] = *(const bf16x8*)(sb + row * 128 + ((ch ^ (row & 7)) << 4)); }
            __builtin_amdgcn_s_setprio(1);
#pragma unroll
            for (int i = 0; i < 4; ++i)
#pragma unroll
                for (int j = 0; j < 4; ++j) {
                    if (MODE == 0) acc[i][j] = __builtin_amdgcn_mfma_f32_16x16x32_bf16(bfr[j], af[i], acc[i][j], 0, 0, 0);
                    else acc[i][j] = __builtin_amdgcn_mfma_f32_16x16x32_bf16(af[i], bfr[j], acc[i][j], 0, 0, 0);
                }
            __builtin_amdgcn_s_setprio(0);
        }
    };
    stage(0, 0);
    asm volatile("s_waitcnt vmcnt(0)" ::: "memory");
    __syncthreads();
    for (int kt = 0; kt < nk; ++kt) {
        if (kt + 1 < nk) stage(kt + 1, (kt + 1) & 1);
        compute(kt & 1);
        asm volatile("s_waitcnt vmcnt(0)" ::: "memory");
        __syncthreads();
    }
}
template <int MODE>
__device__ __forceinline__ void gemm_mainloop256(const bf16_t* __restrict__ A0, const bf16_t* __restrict__ A1, int lda, int ksplit,
                                                 const bf16_t* __restrict__ Bt, int K, int m0, int n0, f32x4 (&acc)[8][4], char* smem) {
    const int tid = VTID, lane = tid & 63, wid = tid >> 6, wm = wid >> 1, wn = wid & 1;
#pragma unroll
    for (int i = 0; i < 8; ++i)
#pragma unroll
        for (int j = 0; j < 4; ++j) acc[i][j] = (f32x4){0.f, 0.f, 0.f, 0.f};
    const int nk = K / 32;
    unsigned aoff[4], boff[2];
    {
        const int rr = lane >> 2, cc = ((lane & 3) ^ (3 * ((lane >> 5) & 1))) * 8;
#pragma unroll
        for (int i = 0; i < 4; ++i) aoff[i] = (unsigned)(((m0 + 64 * wid + 16 * i + rr) * lda + cc) * 2);
#pragma unroll
        for (int i = 0; i < 2; ++i) boff[i] = (unsigned)(((n0 + 32 * wid + 16 * i + rr) * K + cc) * 2);
    }
    auto stage = [&](int kt, int buf) {
        const int kb = kt * 32;
        const char* Ab; const char* Bb = (const char*)(Bt + kb);
        if (kb < ksplit) Ab = (const char*)(A0 + kb); else Ab = (const char*)(A1 + (kb - ksplit));
        char* sa = smem + buf * 24576 + wid * 4096 + lane * 16; char* sb = smem + buf * 24576 + 16384 + wid * 2048 + lane * 16;
#pragma unroll
        for (int i = 0; i < 4; ++i) __builtin_amdgcn_global_load_lds((const unsigned*)(Ab + aoff[i]), (unsigned*)(sa + i * 1024), 16, 0, 0);
#pragma unroll
        for (int i = 0; i < 2; ++i) __builtin_amdgcn_global_load_lds((const unsigned*)(Bb + boff[i]), (unsigned*)(sb + i * 1024), 16, 0, 0);
    };
    const int fpos = (((lane >> 4) ^ (3 * ((lane >> 3) & 1))) << 4) + (lane & 15) * 64;
    auto compute = [&](int buf) {
        const char* sa = smem + buf * 24576 + wm * 8192 + fpos; const char* sb = smem + buf * 24576 + 16384 + wn * 4096 + fpos;
        bf16x8 af[8], bfr[4];
#pragma unroll
        for (int i = 0; i < 8; ++i) af[i] = *(const bf16x8*)(sa + i * 1024);
#pragma unroll
        for (int j = 0; j < 4; ++j) bfr[j] = *(const bf16x8*)(sb + j * 1024);
        __builtin_amdgcn_s_setprio(1);
#pragma unroll
        for (int i = 0; i < 8; ++i)
#pragma unroll
            for (int j = 0; j < 4; ++j) {
                if (MODE == 0) acc[i][j] = __builtin_amdgcn_mfma_f32_16x16x32_bf16(bfr[j], af[i], acc[i][j], 0, 0, 0);
                else acc[i][j] = __builtin_amdgcn_mfma_f32_16x16x32_bf16(af[i], bfr[j], acc[i][j], 0, 0, 0);
            }
        __builtin_amdgcn_s_setprio(0);
    };
    stage(0, 0);
    asm volatile("s_waitcnt vmcnt(0)" ::: "memory");
    __syncthreads();
    for (int kt = 0; kt < nk; ++kt) {
        if (kt + 1 < nk) stage(kt + 1, (kt + 1) & 1);
        compute(kt & 1);
        asm volatile("s_waitcnt vmcnt(0)" ::: "memory");
        __syncthreads();
    }
}
__device__ __forceinline__ bool tile_sched(int it, int MT, int NT, int& mt, int& nt) {
    const int xg = blockIdx.x & 7, xi = (int)(blockIdx.x >> 3) * 2 + (int)(threadIdx.x >> 8), nper = (int)(gridDim.x >> 3) * 2;
    const int li = xi + nper * it;
    if (li >= (MT >> 3) * NT) return false;
    const int band = li / (8 * NT), r = li - band * 8 * NT;
    nt = r >> 3; mt = xg * (MT >> 3) + band * 8 + (r & 7);
    return true;
}
__device__ __forceinline__ void store_bf16x4(bf16_t* p, f32x4 v) { uint2 o; o.x = pack2(v[0], v[1]); o.y = pack2(v[2], v[3]); *(uint2*)p = o; }

#define G8_LAS __attribute__((address_space(3)))
namespace g8 {
constexpr int BM = 256, BK = 64, HALF = 128, HTB = HALF * BK * 2, NXCD = 8, WGM = 8;
__device__ __forceinline__ int lds_byte(int r, int c) { const int st = (r >> 4) * 2 + (c >> 5), rr = r & 15, cc = c & 31, ob = rr * 64 + cc * 2; return st * 1024 + (ob ^ (((ob >> 9) & 1) << 5)); }
__device__ __forceinline__ void stage_rc(int b, int& R, int& C) { const int st = b / 1024, sb = b % 1024, swz = sb ^ (((sb >> 9) & 1) << 5); R = (st >> 1) * 16 + swz / 64; C = (st & 1) * 32 + (swz % 64) / 2; }
__device__ __forceinline__ int perm32(int rho) { const int n = rho >> 4, i = rho & 15; return 8 * (i >> 2) + 4 * n + (i & 3); }
struct Unit { int pm, pn; };
struct Gemm { const bf16_t* A0; const bf16_t* A1; int lda, ksplit; const bf16_t* Bt; int M, N, K; };
struct StaticOrder {
    int nM, nN, nwg, G, c;
    __device__ __forceinline__ void init(int M, int N, int G_, int c_) { nM = M / BM; nN = N / BM; nwg = nM * nN; G = G_; c = c_; }
    __device__ __forceinline__ bool next(int i, Unit& u) const {
        const int L = i * G + c; if (L >= nwg) return false;
        int wgid = L; { const int q = nwg / NXCD, r = nwg % NXCD, xcd = wgid % NXCD, off = wgid / NXCD; wgid = (xcd < r ? xcd * (q + 1) : r * (q + 1) + (xcd - r) * q) + off; }
        const int nig = WGM * nN, gid = wgid / nig, fm = gid * WGM, gsz = (nM - fm) < WGM ? (nM - fm) : WGM;
        u.pm = fm + ((wgid % nig) % gsz); u.pn = (wgid % nig) / gsz; return true;
    }
};
template <class Epi>
__device__ __forceinline__ void gemm_phase(G8_LAS unsigned char* lds, const Gemm g, const StaticOrder& S, const Epi& E) {
    const int tid = threadIdx.x, wid = __builtin_amdgcn_readfirstlane(tid >> 6), lane = tid & 63, wr = wid >> 2, wc = wid & 3, fr = lane & 15, fq = lane >> 4;
    const int K = g.K, nt = K / BK, lda = g.lda;
    unsigned voffA[2], voffB[2];
#pragma unroll
    for (int i = 0; i < 2; ++i) { int R, C; stage_rc(tid * 16 + i * 8192, R, C); const int Rb = (R & ~31) + perm32(R & 31);
        voffA[i] = (unsigned)(R * lda + C) * 2u; voffB[i] = (unsigned)(Rb * K + C) * 2u; }
    const size_t hstepA = (size_t)HALF * lda * 2, hstepB = (size_t)HALF * K * 2;
    const unsigned ldsw = (unsigned)wid * 1024u;
    const int aoff = lds_byte(wr * 64 + fr, fq * 8), boff = lds_byte(wc * 32 + fr, fq * 8);
    auto aptr = [&](int pm, int kt) -> const char* { const int kb = kt * BK; const bf16_t* b = kb < g.ksplit ? g.A0 + kb : g.A1 + (kb - g.ksplit); return (const char*)b + (size_t)pm * 2 * hstepA; };
    auto bptr = [&](int pn, int kt) -> const char* { return (const char*)(g.Bt + kt * BK) + (size_t)pn * 2 * hstepB; };
#define G8_SA(b, h) (((b) * 2 + (h)) * HTB)
#define G8_SB(b, h) ((4 + (b) * 2 + (h)) * HTB)
#define G8_STAGE(bufoff, gbase, voff) do { _Pragma("unroll") for (int _i = 0; _i < 2; ++_i) \
        __builtin_amdgcn_global_load_lds((const unsigned*)((const char*)(gbase) + (voff)[_i]), (G8_LAS unsigned*)(lds + (bufoff) + ldsw + _i * 8192), 16, 0, 0); } while (0)
#define G8_LDA(dst, b, h) do { _Pragma("unroll") for (int m = 0; m < 4; ++m) _Pragma("unroll") for (int k = 0; k < 2; ++k) dst[m][k] = *(const G8_LAS bf16x8*)(lds + G8_SA(b, h) + aoff + m * 2048 + k * 1024); } while (0)
#define G8_LDB(dst, b, h) do { _Pragma("unroll") for (int n = 0; n < 2; ++n) _Pragma("unroll") for (int k = 0; k < 2; ++k) dst[n][k] = *(const G8_LAS bf16x8*)(lds + G8_SB(b, h) + boff + n * 2048 + k * 1024); } while (0)
#define G8_MMA(ai, bj, At, Bt) do { __builtin_amdgcn_s_setprio(1); _Pragma("unroll") for (int m = 0; m < 4; ++m) _Pragma("unroll") for (int n = 0; n < 2; ++n) _Pragma("unroll") for (int k = 0; k < 2; ++k) \
        acc[ai][bj][m][n] = __builtin_amdgcn_mfma_f32_16x16x32_bf16(Bt[n][k], At[m][k], acc[ai][bj][m][n], 0, 0, 0); __builtin_amdgcn_s_setprio(0); } while (0)
#define G8_WAIT_V(n) asm volatile("s_waitcnt vmcnt(" #n ")" ::: "memory")
#define G8_WAIT_L(n) asm volatile("s_waitcnt lgkmcnt(" #n ")" ::: "memory")
#define G8_BAR __builtin_amdgcn_s_barrier()
#define G8_SCHED __builtin_amdgcn_sched_barrier(0)
    Unit cur, nxt; int ui = 0;
    if (!S.next(0, cur)) return;
    f32x4 acc[2][2][4][2];
#pragma unroll
    for (int a = 0; a < 2; ++a)
#pragma unroll
        for (int b = 0; b < 2; ++b)
#pragma unroll
            for (int m = 0; m < 4; ++m)
#pragma unroll
                for (int n = 0; n < 2; ++n) acc[a][b][m][n] = (f32x4){0.f, 0.f, 0.f, 0.f};
    bf16x8 At[4][2], B0[2][2], B1[2][2];
    {
        const char* cA = aptr(cur.pm, 0); const char* cB = bptr(cur.pn, 0); const char* cA1 = aptr(cur.pm, 1); const char* cB1 = bptr(cur.pn, 1);
        G8_STAGE(G8_SB(0, 0), cB, voffB); G8_STAGE(G8_SB(0, 1), cB + hstepB, voffB); G8_STAGE(G8_SA(0, 0), cA, voffA); G8_STAGE(G8_SA(0, 1), cA + hstepA, voffA);
        if (wr == 1) G8_BAR;
        G8_WAIT_V(2); G8_BAR;
        G8_STAGE(G8_SB(1, 0), cB1, voffB); G8_STAGE(G8_SA(1, 0), cA1, voffA); G8_STAGE(G8_SB(1, 1), cB1 + hstepB, voffB);
        G8_WAIT_V(6); G8_BAR;
    }
    for (;;) {
        const bool has_next = S.next(ui + 1, nxt);
        const int npm = has_next ? nxt.pm : cur.pm, npn = has_next ? nxt.pn : cur.pn;
        for (int t = 0; t < nt; t += 2) {
            const bool last = (t == nt - 2);
            const char* a1 = aptr(cur.pm, t + 1);
            const char* a2 = last ? aptr(npm, 0) : aptr(cur.pm, t + 2); const char* b2 = last ? bptr(npn, 0) : bptr(cur.pn, t + 2);
            const char* a3 = last ? aptr(npm, 1) : aptr(cur.pm, t + 3); const char* b3 = last ? bptr(npn, 1) : bptr(cur.pn, t + 3);
            G8_LDB(B0, 0, 0); G8_LDB(B1, 0, 1); G8_SCHED; G8_LDA(At, 0, 0); G8_STAGE(G8_SA(1, 1), a1 + hstepA, voffA);
            G8_WAIT_V(8); G8_WAIT_L(0); G8_BAR; G8_MMA(0, 0, At, B0); G8_MMA(0, 1, At, B1); G8_BAR; G8_SCHED;
            G8_LDA(At, 0, 1); G8_STAGE(G8_SB(0, 0), b2, voffB); G8_STAGE(G8_SB(0, 1), b2 + hstepB, voffB); G8_STAGE(G8_SA(0, 0), a2, voffA);
            G8_WAIT_V(8); G8_WAIT_L(0); G8_BAR; G8_MMA(1, 0, At, B0); G8_MMA(1, 1, At, B1); G8_BAR; G8_SCHED;
            G8_LDB(B0, 1, 0); G8_LDB(B1, 1, 1); G8_SCHED; G8_LDA(At, 1, 0); G8_STAGE(G8_SA(0, 1), a2 + hstepA, voffA);
            G8_WAIT_V(8); G8_WAIT_L(0); G8_BAR; G8_MMA(0, 0, At, B0); G8_MMA(0, 1, At, B1); G8_BAR; G8_SCHED;
            G8_LDA(At, 1, 1); G8_STAGE(G8_SB(1, 0), b3, voffB); G8_STAGE(G8_SB(1, 1), b3 + hstepB, voffB); G8_STAGE(G8_SA(1, 0), a3, voffA);
            G8_WAIT_V(8); G8_WAIT_L(0); G8_BAR; G8_MMA(1, 0, At, B0); G8_MMA(1, 1, At, B1); G8_BAR; G8_SCHED;
        }
        if (wr == 0) G8_BAR;
        E(acc, cur, wr, wc, fr, fq);
        if (!has_next) break;
#pragma unroll
        for (int a = 0; a < 2; ++a)
#pragma unroll
            for (int b = 0; b < 2; ++b)
#pragma unroll
                for (int m = 0; m < 4; ++m)
#pragma unroll
                    for (int n = 0; n < 2; ++n) acc[a][b][m][n] = (f32x4){0.f, 0.f, 0.f, 0.f};
        cur = nxt; ++ui;
        if (wr == 1) G8_BAR;
    }
    G8_WAIT_V(0);
    G8_BAR;
#undef G8_SA
#undef G8_SB
#undef G8_STAGE
#undef G8_LDA
#undef G8_LDB
#undef G8_MMA
#undef G8_WAIT_V
#undef G8_WAIT_L
#undef G8_BAR
#undef G8_SCHED
}
struct EpiResid {
    const float* Rs; float* O;
    __device__ __forceinline__ void operator()(const f32x4 (&acc)[2][2][4][2], const Unit& u, int wr, int wc, int fr, int fq) const {
#pragma unroll
        for (int ai = 0; ai < 2; ++ai)
#pragma unroll
            for (int m = 0; m < 4; ++m) {
                const size_t o = (size_t)(u.pm * 256 + ai * 128 + wr * 64 + m * 16 + fr) * 1024 + u.pn * 256 + wc * 32 + fq * 8;
#pragma unroll
                for (int bj = 0; bj < 2; ++bj)
#pragma unroll
                    for (int n = 0; n < 2; ++n) {
                        const f32x4 r = *(const f32x4*)(Rs + o + bj * 128 + n * 4);
                        *(f32x4*)(O + o + bj * 128 + n * 4) = r + acc[ai][bj][m][n];
                    }
            }
    }
};
struct EpiCinU {
    bf16_t* U;
    __device__ __forceinline__ void operator()(const f32x4 (&acc)[2][2][4][2], const Unit& u, int wr, int wc, int fr, int fq) const {
#pragma unroll
        for (int ai = 0; ai < 2; ++ai)
#pragma unroll
            for (int m = 0; m < 4; ++m) {
                bf16_t* rp = U + (size_t)(u.pm * 256 + ai * 128 + wr * 64 + m * 16 + fr) * 2048 + u.pn * 256 + wc * 32 + fq * 8;
#pragma unroll
                for (int bj = 0; bj < 2; ++bj) {
                    const f32x4 a = acc[ai][bj][m][0], b = acc[ai][bj][m][1];
                    uint4 o; o.x = pack2(gelu_exact(a[0]), gelu_exact(a[1])); o.y = pack2(gelu_exact(a[2]), gelu_exact(a[3]));
                    o.z = pack2(gelu_exact(b[0]), gelu_exact(b[1])); o.w = pack2(gelu_exact(b[2]), gelu_exact(b[3]));
                    *(uint4*)(rp + bj * 128) = o;
                }
            }
    }
};
struct EpiCinV {
    bf16_t* VT; float* SSQ;
    __device__ __forceinline__ void operator()(const f32x4 (&acc)[2][2][4][2], const Unit& u, int wr, int wc, int fr, int fq) const {
#pragma unroll
        for (int ai = 0; ai < 2; ++ai) {
            float ss[16];
#pragma unroll
            for (int i = 0; i < 16; ++i) ss[i] = 0.f;
#pragma unroll
            for (int m = 0; m < 4; ++m) {
                const int c = u.pm * 256 + ai * 128 + wr * 64 + m * 16 + fr;
#pragma unroll
                for (int bj = 0; bj < 2; ++bj) {
                    float g[8];
#pragma unroll
                    for (int n = 0; n < 2; ++n)
#pragma unroll
                        for (int r = 0; r < 4; ++r) { const float x = gelu_exact(acc[ai][bj][m][n][r]); g[n * 4 + r] = x; ss[bj * 8 + n * 4 + r] += x * x; }
                    uint4 o; o.x = pack2(g[0], g[1]); o.y = pack2(g[2], g[3]); o.z = pack2(g[4], g[5]); o.w = pack2(g[6], g[7]);
                    *(uint4*)(VT + ((size_t)(u.pn * 2 + bj) * 2048 + c) * 128 + wc * 32 + fq * 8) = o;
                }
            }
            float mine = 0.f;
#pragma unroll
            for (int i = 0; i < 16; ++i) { const float s = row16_sum(ss[i]); mine = (fr == i) ? s : mine; }
            const int tok = u.pn * 256 + (fr >> 3) * 128 + wc * 32 + fq * 8 + (fr & 7);
            SSQ[(size_t)tok * 32 + u.pm * 4 + ai * 2 + wr] = mine;
        }
    }
};
struct EpiInN {
    bf16_t* R;
    __device__ __forceinline__ void operator()(const f32x4 (&acc)[2][2][4][2], const Unit& u, int wr, int wc, int fr, int fq) const {
        bf16_t* base; int pitch; float sc = 1.0f;
        if (u.pn < 2) { base = R + R_QSB + u.pn * 256; pitch = 512; sc = 0.125f; }
        else if (u.pn < 4) { base = R + R_KSB + (u.pn - 2) * 256; pitch = 512; }
        else if (u.pn == 4) { base = R + R_QG; pitch = 256; }
        else if (u.pn == 5) { base = R + R_KG; pitch = 256; }
        else { base = R + R_GG + (u.pn - 6) * 256; pitch = 512; }
#pragma unroll
        for (int ai = 0; ai < 2; ++ai)
#pragma unroll
            for (int m = 0; m < 4; ++m) {
                bf16_t* rp = base + (size_t)(u.pm * 256 + ai * 128 + wr * 64 + m * 16 + fr) * pitch + wc * 32 + fq * 8;
#pragma unroll
                for (int bj = 0; bj < 2; ++bj) {
                    const f32x4 a = acc[ai][bj][m][0] * sc, b = acc[ai][bj][m][1] * sc;
                    uint4 o; o.x = pack2(a[0], a[1]); o.y = pack2(a[2], a[3]); o.z = pack2(b[0], b[1]); o.w = pack2(b[2], b[3]);
                    *(uint4*)(rp + bj * 128) = o;
                }
            }
    }
};
struct EpiInT {
    bf16_t* R;
    __device__ __forceinline__ void operator()(const f32x4 (&acc)[2][2][4][2], const Unit& u, int wr, int wc, int fr, int fq) const {
#pragma unroll
        for (int ai = 0; ai < 2; ++ai)
#pragma unroll
            for (int m = 0; m < 4; ++m) {
                const int c = u.pm * 256 + ai * 128 + wr * 64 + m * 16 + fr;
#pragma unroll
                for (int bj = 0; bj < 2; ++bj) {
                    const int t = u.pn * 256 + bj * 128 + wc * 32 + fq * 8, b = t >> 11, s = t & 2047;
                    bf16_t* dst;
                    if (c < 512) dst = R + R_VTSB + ((size_t)((b * 8 + (c >> 6)) * 64 + (c & 63))) * 2048 + s;
                    else { const int c2 = c - 512; dst = R + R_VTG + ((size_t)((b * 4 + (c2 >> 7)) * 128 + (c2 & 127))) * 2048 + s; }
                    const f32x4 a = acc[ai][bj][m][0], bb = acc[ai][bj][m][1];
                    uint4 o; o.x = pack2(a[0], a[1]); o.y = pack2(a[2], a[3]); o.z = pack2(bb[0], bb[1]); o.w = pack2(bb[2], bb[3]);
                    *(uint4*)dst = o;
                }
            }
    }
};
}
__device__ __forceinline__ void phase_gemm_resid8(const bf16_t* A0, const bf16_t* A1, int lda, int ksplit, const bf16_t* Bt, int K, const float* Rs, float* O, char* smem_phys) {
    g8::Gemm g{A0, A1, lda, ksplit, Bt, T, 1024, K};
    g8::StaticOrder S; S.init(T, 1024, (int)gridDim.x, (int)blockIdx.x);
    g8::EpiResid E{Rs, O};
    g8::gemm_phase<g8::EpiResid>((G8_LAS unsigned char*)smem_phys, g, S, E);
}

__device__ __forceinline__ void phase_gemm_cin8(const Params& p, char* smem_phys) {
    const bf16_t* H = (const bf16_t*)(p.ws + OFF_H); const bf16_t* W = (const bf16_t*)(p.ws + OFF_WT_CIN);
    bf16_t* U = (bf16_t*)(p.ws + OFF_REGION); bf16_t* VT = U + (size_t)T * 2048; float* SSQ = (float*)(p.ws + OFF_SSQ);
    {
        g8::Gemm g{H, H, 1024, 1024, W, T, 2048, 1024};
        g8::StaticOrder S; S.init(T, 2048, (int)gridDim.x, (int)blockIdx.x);
        g8::EpiCinU E{U};
        g8::gemm_phase<g8::EpiCinU>((G8_LAS unsigned char*)smem_phys, g, S, E);
    }
    {
        const bf16_t* Wv = W + (size_t)2048 * 1024;
        g8::Gemm g{Wv, Wv, 1024, 1024, H, 2048, T, 1024};
        g8::StaticOrder S; S.init(2048, T, (int)gridDim.x, (int)blockIdx.x);
        g8::EpiCinV E{VT, SSQ};
        g8::gemm_phase<g8::EpiCinV>((G8_LAS unsigned char*)smem_phys, g, S, E);
    }
}
__device__ __forceinline__ void phase_gemm_in8(const Params& p, char* smem_phys) {
    const bf16_t* H = (const bf16_t*)(p.ws + OFF_H); const bf16_t* W = (const bf16_t*)(p.ws + OFF_WT_IN);
    bf16_t* R = (bf16_t*)(p.ws + OFF_REGION);
    {
        g8::Gemm g{H, H, 1024, 1024, W, T, 2048, 1024};
        g8::StaticOrder S; S.init(T, 2048, (int)gridDim.x, (int)blockIdx.x);
        g8::EpiInN E{R};
        g8::gemm_phase<g8::EpiInN>((G8_LAS unsigned char*)smem_phys, g, S, E);
    }
    {
        const bf16_t* Wv = W + (size_t)2048 * 1024;
        g8::Gemm g{Wv, Wv, 1024, 1024, H, 1024, T, 1024};
        g8::StaticOrder S; S.init(1024, T, (int)gridDim.x, (int)blockIdx.x);
        g8::EpiInT E{R};
        g8::gemm_phase<g8::EpiInT>((G8_LAS unsigned char*)smem_phys, g, S, E);
    }
    {
        const int lane = threadIdx.x & 63, wid = threadIdx.x >> 6, fr = lane & 15, fq = lane >> 4;
        float* ALR = (float*)(R + R_ALR);
        for (int task = (int)blockIdx.x * 8 + wid; task < T / 16; task += (int)gridDim.x * 8) {
            const bf16_t* a = H + (size_t)(task * 16 + fr) * 1024 + fq * 8; const bf16_t* w = W + (size_t)(3072 + fr) * 1024 + fq * 8;
            f32x4 acc = (f32x4){0.f, 0.f, 0.f, 0.f};
#pragma unroll 8
            for (int kk = 0; kk < 32; ++kk) {
                const bf16x8 af = *(const bf16x8*)(a + kk * 32), wf = *(const bf16x8*)(w + kk * 32);
                acc = __builtin_amdgcn_mfma_f32_16x16x32_bf16(wf, af, acc, 0, 0, 0);
            }
            *(f32x4*)(ALR + (size_t)(task * 16 + fr) * 16 + fq * 4) = acc;
        }
    }
}

__device__ __forceinline__ void phase_gemm_in(const Params& p, char* smem) {
    const bf16_t* A = (const bf16_t*)(p.ws + OFF_H); const bf16_t* Bt = (const bf16_t*)(p.ws + OFF_WT_IN);
    bf16_t* R = (bf16_t*)(p.ws + OFF_REGION);
    const int lane = VTID & 63, wid = VTID >> 6, wm = wid >> 1, wn = wid & 1;
    constexpr int NT = AB_IN_PAD / 128, MT = T / 128;
    int mt_, nt_;
    for (int it = 0; tile_sched(it, MT, NT, mt_, nt_); ++it) {
        const int m0 = mt_ * 128, n0 = nt_ * 128;
        f32x4 acc[4][4];
        const bool tr = (n0 >= 1024 && n0 < 1536) || (n0 >= 2048 && n0 < 2560);
        if (!tr) {
            gemm_mainloop<0>(A, A, 1024, 1024, Bt, 1024, m0, n0, acc, smem);
#pragma unroll
            for (int i = 0; i < 4; ++i)
#pragma unroll
                for (int j = 0; j < 4; ++j) {
                    const int m = m0 + wm * 64 + i * 16 + (lane & 15), n = n0 + wn * 64 + j * 16 + 4 * (lane >> 4);
                    const f32x4 v = acc[i][j];
                    if (n < 512) store_bf16x4(R + R_QSB + (size_t)m * 512 + n, v * 0.125f);
                    else if (n < 1024) store_bf16x4(R + R_KSB + (size_t)m * 512 + (n - 512), v);
                    else if (n < 1792) store_bf16x4(R + R_QG + (size_t)m * 256 + (n - 1536), v);
                    else if (n < 2048) store_bf16x4(R + R_KG + (size_t)m * 256 + (n - 1792), v);
                    else if (n < 3072) store_bf16x4(R + R_GG + (size_t)m * 512 + (n - 2560), v);
                    else if (n < AB_IN) *(f32x4*)((float*)(R + R_ALR) + (size_t)m * 16 + (n - 3072)) = v;
                }
        } else {
            gemm_mainloop<1>(A, A, 1024, 1024, Bt, 1024, m0, n0, acc, smem);
#pragma unroll
            for (int i = 0; i < 4; ++i)
#pragma unroll
                for (int j = 0; j < 4; ++j) {
                    const int m = m0 + wm * 64 + i * 16 + 4 * (lane >> 4), n = n0 + wn * 64 + j * 16 + (lane & 15);
                    const int b = m >> 11, s = m & 2047;
                    if (n < 1536) { const int c = n - 1024, hh = c >> 6, e = c & 63; store_bf16x4(R + R_VTSB + ((size_t)((b * 8 + hh) * 64 + e)) * 2048 + s, acc[i][j]); }
                    else { const int c = n - 2048, hh = c >> 7, e = c & 127; store_bf16x4(R + R_VTG + ((size_t)((b * 4 + hh) * 128 + e)) * 2048 + s, acc[i][j]); }
                }
        }
    }
}
__device__ __forceinline__ void phase_gemm_resid(const bf16_t* A0, const bf16_t* A1, int lda, int ksplit, const bf16_t* Bt, int K, const float* Rs, float* O, char* smem) {
    const int lane = VTID & 63, wid = VTID >> 6, wm = wid >> 1, wn = wid & 1;
    constexpr int NT = 8, MT = T / 256;
    int mt_, nt_;
    for (int it = 0; tile_sched(it, MT, NT, mt_, nt_); ++it) {
        const int m0 = mt_ * 256, n0 = nt_ * 128;
        f32x4 acc[8][4];
        gemm_mainloop256<0>(A0, A1, lda, ksplit, Bt, K, m0, n0, acc, smem);
#pragma unroll
        for (int i = 0; i < 8; ++i)
#pragma unroll
            for (int j = 0; j < 4; ++j) {
                const int m = m0 + wm * 128 + i * 16 + (lane & 15), n = n0 + wn * 64 + j * 16 + 4 * (lane >> 4);
                const f32x4 r = *(const f32x4*)(Rs + (size_t)m * 1024 + n);
                *(f32x4*)(O + (size_t)m * 1024 + n) = r + acc[i][j];
            }
    }
}
__device__ __forceinline__ void phase_gemm_cin(const Params& p, char* smem) {
    const bf16_t* A = (const bf16_t*)(p.ws + OFF_H); const bf16_t* Bt = (const bf16_t*)(p.ws + OFF_WT_CIN);
    bf16_t* U = (bf16_t*)(p.ws + OFF_REGION); bf16_t* VT = U + (size_t)T * 2048; float* SSQ = (float*)(p.ws + OFF_SSQ);
    const int lane = VTID & 63, wid = VTID >> 6, wm = wid >> 1, wn = wid & 1;
    constexpr int NT = 32, MT = T / 128;
    int mt_, nt_;
    for (int it = 0; tile_sched(it, MT, NT, mt_, nt_); ++it) {
        const int m0 = mt_ * 128, n0 = nt_ * 128;
        f32x4 acc[4][4];
        if (n0 < 2048) {
            gemm_mainloop<0>(A, A, 1024, 1024, Bt, 1024, m0, n0, acc, smem);
#pragma unroll
            for (int i = 0; i < 4; ++i)
#pragma unroll
                for (int j = 0; j < 4; ++j) {
                    const int m = m0 + wm * 64 + i * 16 + (lane & 15), n = n0 + wn * 64 + j * 16 + 4 * (lane >> 4);
                    f32x4 v = acc[i][j];
#pragma unroll
                    for (int r = 0; r < 4; ++r) v[r] = gelu_exact(v[r]);
                    store_bf16x4(U + (size_t)m * 2048 + n, v);
                }
        } else {
            gemm_mainloop<1>(A, A, 1024, 1024, Bt, 1024, m0, n0, acc, smem);
#pragma unroll
            for (int i = 0; i < 4; ++i) {
                float ss[4] = {0.f, 0.f, 0.f, 0.f};
#pragma unroll
                for (int j = 0; j < 4; ++j) {
                    const int m = m0 + wm * 64 + i * 16 + 4 * (lane >> 4), n = n0 + wn * 64 + j * 16 + (lane & 15);
                    f32x4 v = acc[i][j];
#pragma unroll
                    for (int r = 0; r < 4; ++r) { v[r] = gelu_exact(v[r]); ss[r] += v[r] * v[r]; }
                    const int chunk = m >> 7, s = m & 127, c = n - 2048;
                    store_bf16x4(VT + ((size_t)chunk * 2048 + c) * 128 + s, v);
                }
#pragma unroll
                for (int r = 0; r < 4; ++r) {
                    float v = ss[r];
                    v += __shfl_xor(v, 1); v += __shfl_xor(v, 2); v += __shfl_xor(v, 4); v += __shfl_xor(v, 8);
                    if ((lane & 15) == 0) { const int m = m0 + wm * 64 + i * 16 + 4 * (lane >> 4) + r; SSQ[(size_t)m * 32 + ((n0 - 2048) >> 6) + wn] = v; }
                }
            }
        }
    }
}

typedef float f32x16 __attribute__((ext_vector_type(16)));
__device__ __forceinline__ void sb_fast(const Params& p, char* smem, unsigned* ctr) {
    bf16_t* R = (bf16_t*)(p.ws + OFF_REGION);
    char* KT = smem; char* VTt = smem + 8192;
    volatile int* flags = (volatile int*)(smem + 32768); volatile unsigned* slot = (volatile unsigned*)(smem + 32832);
    const int tid = threadIdx.x, lane = tid & 63, w = tid >> 6, r31 = lane & 31, h = lane >> 5;
    for (;;) {
        __syncthreads();
        if (tid == 0) *slot = atomicAdd(ctr, 1u);
        __syncthreads();
        const unsigned task = *slot;
        if (task >= 1024u) break;
        const int qblk = 7 - (int)(task >> 7), bh = task & 127, b = bh >> 3, hh = bh & 7;
        const int q0 = qblk * 256, qbase = q0 + 32 * w;
        bf16_t* qrow = R + R_QSB + (size_t)(b * 2048 + qbase + r31) * 512 + hh * 64;
        bf16x8 qf[4];
#pragma unroll
        for (int kk = 0; kk < 4; ++kk) qf[kk] = *(const bf16x8*)(qrow + 16 * kk + 8 * h);
        f32x16 oacc[2];
#pragma unroll
        for (int nt = 0; nt < 2; ++nt)
#pragma unroll
            for (int i = 0; i < 16; ++i) oacc[nt][i] = 0.f;
        float Rr = 1.0f;
        const int t = qbase + r31;
        for (int kt = q0 / 64 + 3; kt >= 0; --kt) {
            __syncthreads();
            { const int wd = __all(Rr == 0.f); if (lane == 0) flags[w] = wd; }
            __syncthreads();
            if (flags[0] & flags[1] & flags[2] & flags[3] & flags[4] & flags[5] & flags[6] & flags[7]) break;
            const int s_tile = kt * 64;
            {
                const int c = tid, row = c >> 3, ch = c & 7;
                const u32x4 kv = *(const u32x4*)(R + R_KSB + (size_t)(b * 2048 + s_tile + row) * 512 + hh * 64 + ch * 8);
                const u32x4 vv = *(const u32x4*)(R + R_VTSB + ((size_t)((b * 8 + hh) * 64 + row)) * 2048 + s_tile + ch * 8);
                *(u32x4*)(KT + row * 128 + ((ch ^ (row & 7)) << 4)) = kv;
                *(uint2*)(VTt + row * 136 + ch * 16) = make_uint2(vv[0], vv[1]);
                *(uint2*)(VTt + row * 136 + ch * 16 + 8) = make_uint2(vv[2], vv[3]);
            }
            __syncthreads();
#pragma unroll
            for (int sbk = 1; sbk >= 0; --sbk) {
                const int key_lo = s_tile + 32 * sbk;
                if (key_lo >= qbase + 31) continue;
                if (__all(Rr == 0.f)) continue;
                f32x16 st;
#pragma unroll
                for (int i = 0; i < 16; ++i) st[i] = 0.f;
                const int krow = 32 * sbk + r31;
#pragma unroll
                for (int kk = 0; kk < 4; ++kk) {
                    const bf16x8 kf = *(const bf16x8*)(KT + krow * 128 + (((2 * kk + h) ^ (krow & 7)) << 4));
                    st = __builtin_amdgcn_mfma_f32_32x32x16_bf16(kf, qf[kk], st, 0, 0, 0);
                }
                float a[16], G[4];
#pragma unroll
                for (int g = 0; g < 4; ++g) {
                    float sg[4], m[4];
#pragma unroll
                    for (int i = 0; i < 4; ++i) {
                        const int s = key_lo + 8 * g + 4 * h + i;
                        const float z = fminf(fmaxf(st[4 * g + i], -80.f), 80.f);
                        const float ez = __expf(-z), sig = 1.0f / (1.0f + ez);
                        const bool valid = s < t;
                        sg[i] = valid ? sig : 0.f; m[i] = valid ? ez * sig : 1.0f;
                    }
                    const float x2 = m[3], x1 = x2 * m[2], x0 = x1 * m[1];
                    G[g] = x0 * m[0];
                    a[4 * g + 3] = sg[3]; a[4 * g + 2] = sg[2] * x2; a[4 * g + 1] = sg[1] * x1; a[4 * g] = sg[0] * x0;
                }
                float Go[4], P[4];
#pragma unroll
                for (int g = 0; g < 4; ++g) { Go[g] = __shfl_xor(G[g], 32); P[g] = G[g] * Go[g]; }
                const float c2 = P[3], c1 = c2 * P[2], c0 = c1 * P[1];
                float Tg[4];
                Tg[3] = Rr; Tg[2] = Rr * c2; Tg[1] = Rr * c1; Tg[0] = Rr * c0;
#pragma unroll
                for (int g = 0; g < 4; ++g) {
                    const float tg = (h == 0) ? Tg[g] * Go[g] : Tg[g];
                    a[4 * g] *= tg; a[4 * g + 1] *= tg; a[4 * g + 2] *= tg; a[4 * g + 3] *= tg;
                }
                Rr = Rr * c0 * P[0];
#pragma unroll
                for (int s2 = 0; s2 < 2; ++s2) {
                    union { bf16x8 v; unsigned u[4]; } af;
#pragma unroll
                    for (int j2 = 0; j2 < 4; ++j2) af.u[j2] = pack2(a[8 * s2 + 2 * j2], a[8 * s2 + 2 * j2 + 1]);
#pragma unroll
                    for (int nt = 0; nt < 2; ++nt) {
                        const char* vp = VTt + (32 * nt + r31) * 136 + 64 * sbk + 32 * s2 + 8 * h;
                        union { bf16x8 v; uint2 hh2[2]; } vf;
                        vf.hh2[0] = *(const uint2*)vp; vf.hh2[1] = *(const uint2*)(vp + 16);
                        oacc[nt] = __builtin_amdgcn_mfma_f32_32x32x16_bf16(af.v, vf.v, oacc[nt], 0, 0, 0);
                    }
                }
            }
        }
#pragma unroll
        for (int nt = 0; nt < 2; ++nt)
#pragma unroll
            for (int i = 0; i < 16; ++i) {
                const int qq = (i & 3) + 8 * (i >> 2) + 4 * h;
                R[R_QSB + (size_t)(b * 2048 + qbase + qq) * 512 + hh * 64 + 32 * nt + r31] = f2bf(oacc[nt][i]);
            }
    }
}
__device__ __forceinline__ float log_sigmoid(float x) { return fminf(x, 0.f) - log1pf(__expf(-fabsf(x))); }
__device__ __forceinline__ int swz(int row, int chunk) { return row * 128 + ((chunk ^ (row & 7)) << 4); }
__device__ __forceinline__ void gla_prep(const Params& p, char* smem) {
    bf16_t* R = (bf16_t*)(p.ws + OFF_REGION);
    const float* ALR = (const float*)(R + R_ALR);
    bf16_t* KOTg = R + R_KOT; float* DECg = (float*)(R + R_DEC);
    float* SEG = (float*)smem; float* ALRs = SEG + 256;
    const int tid = VTID, d = tid & 63, w = tid >> 6;
    for (int task = VBID; task < 2048; task += VGRID) {
        const int bh = task >> 5, c = task & 31, b = bh >> 2, hh = bh & 3;
        const size_t rowbase = (size_t)b * 2048 + c * 64;
        unsigned qr[16], kr[16];
#pragma unroll
        for (int i = 0; i < 16; ++i) { const size_t row = rowbase + w * 16 + i; qr[i] = R[R_QG + row * 256 + hh * 64 + d]; kr[i] = R[R_KG + row * 256 + hh * 64 + d]; }
        const f32x4 ar = *(const f32x4*)(ALR + rowbase * 16 + tid * 4);
        float w2r[16];
#pragma unroll
        for (int r = 0; r < 16; ++r) w2r[r] = p.ab_w_alpha2[r * 256 + hh * 64 + d];
        const float b2r = p.ab_b_alpha2[hh * 64 + d];
        __syncthreads();
        *(f32x4*)(ALRs + tid * 4) = ar;
        __syncthreads();
        float cs[16]; float run = 0.f;
#pragma unroll
        for (int i = 0; i < 16; ++i) {
            const float* al = ALRs + (w * 16 + i) * 16;
            float pre = b2r;
#pragma unroll
            for (int r = 0; r < 16; ++r) pre += al[r] * w2r[r];
            run += log_sigmoid(pre) * (1.0f / 16.0f);
            cs[i] = run;
        }
        SEG[w * 64 + d] = run;
        __syncthreads();
        float off = 0.f, tot = 0.f;
#pragma unroll
        for (int w2 = 0; w2 < 4; ++w2) { const float s = SEG[w2 * 64 + d]; tot += s; if (w2 < w) off += s; }
        unsigned kop[8];
#pragma unroll
        for (int i2 = 0; i2 < 8; ++i2) {
            float kov[2];
#pragma unroll
            for (int u = 0; u < 2; ++u) {
                const int i = 2 * i2 + u;
                const float bc = off + cs[i];
                const float kv = bf2f((bf16_t)kr[i]);
                const size_t row = rowbase + w * 16 + i;
                R[R_QG + row * 256 + hh * 64 + d] = f2bf(bf2f((bf16_t)qr[i]) * 0.125f * __expf(bc));
                R[R_KG + row * 256 + hh * 64 + d] = f2bf(kv * __expf(-bc));
                kov[u] = kv * __expf(tot - bc);
            }
            kop[i2] = pack2(kov[0], kov[1]);
        }
        bf16_t* kp = KOTg + ((size_t)task * 64 + d) * 64 + w * 16;
        *(uint4*)kp = make_uint4(kop[0], kop[1], kop[2], kop[3]);
        *(uint4*)(kp + 8) = make_uint4(kop[4], kop[5], kop[6], kop[7]);
        if (w == 0) DECg[(size_t)task * 64 + d] = __expf(tot);
    }
}
__device__ __forceinline__ void gla_scan(const Params& p, char* smem, bool dry = false) {
    bf16_t* R = (bf16_t*)(p.ws + OFF_REGION);
    const bf16_t* KOTg = R + R_KOT; const float* DECg = (const float*)(R + R_DEC);
    char* QS = smem; char* KS = smem + 8192; char* KOT = smem + 16384; char* VTs = smem + 24576; char* SPT = smem + 40960;
    float* DEC = (float*)(smem + 57344); float* GN = DEC + 64;
    const int tid = VTID, lane = tid & 63, w = tid >> 6, l15_ = lane & 15, q4 = lane >> 4;
    for (int task = VBID; task < 64; task += VGRID) {
        const int b = task >> 2, hh = task & 3;
        f32x4 Sacc[8];
#pragma unroll
        for (int nt = 0; nt < 8; ++nt) Sacc[nt] = (f32x4){0.f, 0.f, 0.f, 0.f};
        __syncthreads();
        for (int i = tid; i < 1024; i += 256) *(uint4*)(SPT + i * 16) = make_uint4(0, 0, 0, 0);
        if (tid < 128) GN[tid] = p.ab_gla_norm[hh * 128 + tid];
        const size_t rowbase = (size_t)b * 2048;
        const bf16_t* vbase = R + R_VTG + ((size_t)((b * 4 + hh) * 128)) * 2048;
        u32x4 tq[2], tk[2], tko[2], vr[4]; float td = 0.f;
        auto prefetch = [&](int c) {
            const int t0 = c * 64;
#pragma unroll
            for (int i = 0; i < 2; ++i) {
                const int cid = tid + 256 * i, row = cid >> 3, ch = cid & 7;
                tq[i] = *(const u32x4*)(R + R_QG + (rowbase + t0 + row) * 256 + hh * 64 + ch * 8);
                tk[i] = *(const u32x4*)(R + R_KG + (rowbase + t0 + row) * 256 + hh * 64 + ch * 8);
                tko[i] = *(const u32x4*)(KOTg + (((size_t)task * 32 + c) * 64 + row) * 64 + ch * 8);
            }
#pragma unroll
            for (int i = 0; i < 4; ++i) { const int cid = tid + 256 * i, e = cid >> 3, ch = cid & 7; vr[i] = *(const u32x4*)(vbase + (size_t)e * 2048 + t0 + ch * 8); }
            if (tid < 64) td = DECg[((size_t)task * 32 + c) * 64 + tid];
        };
        prefetch(0);
        for (int c = 0; c < 32; ++c) {
            int lz = 0; asm volatile("" : "+v"(lz));
            const int l15 = l15_ + lz;
            const int cx = (q4 ^ (l15 & 7)) << 4;
            const int rb0 = l15 * 128 + cx, rb1 = l15 * 128 + (cx ^ 64);
#pragma unroll
            for (int i = 0; i < 2; ++i) {
                const int cid = tid + 256 * i + lz, row = cid >> 3, ch = cid & 7;
                *(u32x4*)(QS + swz(row, ch)) = tq[i]; *(u32x4*)(KS + swz(row, ch)) = tk[i]; *(u32x4*)(KOT + swz(row, ch)) = tko[i];
            }
#pragma unroll
            for (int i = 0; i < 4; ++i) { const int cid = tid + 256 * i + lz, e = cid >> 3, ch = cid & 7; *(u32x4*)(VTs + swz(e, ch)) = vr[i]; }
            if (tid < 64) DEC[tid] = td;
            uint2 gr[8];
            const unsigned goff = (unsigned)((rowbase + c * 64 + 16 * w + l15) * 512 + hh * 128 + 4 * q4);
            bf16_t* const gbase = R + R_GG;
#pragma unroll
            for (int nt = 0; nt < 8; ++nt) gr[nt] = *(const uint2*)(gbase + (goff + 16 * nt));
            if (c + 1 < 32) prefetch(c + 1);
            __syncthreads();
            bf16x8 qf[2];
#pragma unroll
            for (int kk = 0; kk < 2; ++kk) qf[kk] = *(const bf16x8*)(QS + w * 2048 + (kk ? rb1 : rb0));
            f32x4 sT[4];
#pragma unroll
            for (int st = 0; st < 4; ++st) {
                sT[st] = (f32x4){0.f, 0.f, 0.f, 0.f};
                if (st <= w) {
#pragma unroll
                    for (int kk = 0; kk < 2; ++kk) { const bf16x8 kf = *(const bf16x8*)(KS + st * 2048 + (kk ? rb1 : rb0)); sT[st] = __builtin_amdgcn_mfma_f32_16x16x32_bf16(kf, qf[kk], sT[st], 0, 0, 0); }
#pragma unroll
                    for (int r = 0; r < 4; ++r) if (16 * st + 4 * q4 + r > 16 * w + l15) sT[st][r] = 0.f;
                }
            }
            bf16x8 af[2];
#pragma unroll
            for (int ks2 = 0; ks2 < 2; ++ks2) {
                union { bf16x8 v; unsigned u[4]; } cv;
                cv.u[0] = pack2(sT[2 * ks2][0], sT[2 * ks2][1]); cv.u[1] = pack2(sT[2 * ks2][2], sT[2 * ks2][3]);
                cv.u[2] = pack2(sT[2 * ks2 + 1][0], sT[2 * ks2 + 1][1]); cv.u[3] = pack2(sT[2 * ks2 + 1][2], sT[2 * ks2 + 1][3]);
                af[ks2] = cv.v;
            }
            const int vb = l15 * 128 + ((((q4 >> 1) ^ (l15 & 7)) << 4) | ((q4 & 1) * 8));
            f32x4 o[8];
#pragma unroll
            for (int nt = 0; nt < 8; ++nt) {
                o[nt] = (f32x4){0.f, 0.f, 0.f, 0.f};
                const int e = 16 * nt + l15;
#pragma unroll
                for (int kk = 0; kk < 2; ++kk) { const bf16x8 sf = *(const bf16x8*)(SPT + nt * 2048 + (kk ? rb1 : rb0)); o[nt] = __builtin_amdgcn_mfma_f32_16x16x32_bf16(sf, qf[kk], o[nt], 0, 0, 0); }
#pragma unroll
                for (int ks2 = 0; ks2 < 2; ++ks2) {
                    if (2 * ks2 <= w) {
                        union { bf16x8 v; uint2 h[2]; } cv;
                        cv.h[0] = *(const uint2*)(VTs + nt * 2048 + (vb ^ (ks2 * 64)));
                        cv.h[1] = *(const uint2*)(VTs + nt * 2048 + (vb ^ (ks2 * 64) ^ 32));
                        o[nt] = __builtin_amdgcn_mfma_f32_16x16x32_bf16(cv.v, af[ks2], o[nt], 0, 0, 0);
                    }
                }
            }
            {
                const float4 dc = *(const float4*)(DEC + 16 * w + 4 * q4);
                bf16x8 kof[2];
#pragma unroll
                for (int kk = 0; kk < 2; ++kk) kof[kk] = *(const bf16x8*)(KOT + w * 2048 + (kk ? rb1 : rb0));
#pragma unroll
                for (int nt = 0; nt < 8; ++nt) {
                    Sacc[nt][0] *= dc.x; Sacc[nt][1] *= dc.y; Sacc[nt][2] *= dc.z; Sacc[nt][3] *= dc.w;
#pragma unroll
                    for (int kk = 0; kk < 2; ++kk) { const bf16x8 vf = *(const bf16x8*)(VTs + nt * 2048 + (kk ? rb1 : rb0)); Sacc[nt] = __builtin_amdgcn_mfma_f32_16x16x32_bf16(kof[kk], vf, Sacc[nt], 0, 0, 0); }
                }
            }
            __syncthreads();
#pragma unroll
            for (int nt = 0; nt < 8; ++nt) {
                const int e = 16 * nt + l15;
                uint2 pk; pk.x = pack2(Sacc[nt][0], Sacc[nt][1]); pk.y = pack2(Sacc[nt][2], Sacc[nt][3]);
                *(uint2*)(SPT + nt * 2048 + l15 * 128 + (((2 * w + (q4 >> 1)) ^ (l15 & 7)) << 4) + (q4 & 1) * 8) = pk;
            }
            float ssq = 0.f;
#pragma unroll
            for (int nt = 0; nt < 8; ++nt) ssq += (o[nt][0] * o[nt][0] + o[nt][1] * o[nt][1]) + (o[nt][2] * o[nt][2] + o[nt][3] * o[nt][3]);
            ssq += __shfl_xor(ssq, 16); ssq += __shfl_xor(ssq, 32);
            const float rsd = rsqrtf(ssq * (1.0f / 128.0f) + EPS);
#pragma unroll
            for (int nt = 0; nt < 8; ++nt) {
                asm volatile("" ::: "memory");
                const f32x4 gn = *(const f32x4*)(GN + 16 * nt + 4 * q4);
                const float g0 = lo2f(gr[nt].x), g1 = hi2f(gr[nt].x), g2 = lo2f(gr[nt].y), g3 = hi2f(gr[nt].y);
                uint2 ov;
                ov.x = pack2(o[nt][0] * rsd * gn[0] * (g0 / (1.0f + __expf(-g0))), o[nt][1] * rsd * gn[1] * (g1 / (1.0f + __expf(-g1))));
                ov.y = pack2(o[nt][2] * rsd * gn[2] * (g2 / (1.0f + __expf(-g2))), o[nt][3] * rsd * gn[3] * (g3 / (1.0f + __expf(-g3))));
                if (!dry || ov.x == 0x7fc17fc1u) *(uint2*)(gbase + (goff + 16 * nt)) = ov;
            }
        }
    }
}

__device__ __forceinline__ unsigned ord_key(float f) { const unsigned u = __float_as_uint(f); return (u & 0x80000000u) ? ~u : (u | 0x80000000u); }
__device__ __forceinline__ float unord_key(unsigned k) { return __uint_as_float((k & 0x80000000u) ? (k & 0x7fffffffu) : ~k); }
__device__ __forceinline__ void ce_desc(unsigned& a, unsigned& b) { const unsigned hi = max(a, b), lo = min(a, b); a = hi; b = lo; }
__device__ __forceinline__ void bitonic_sort16_desc(unsigned (&a)[16]) {
#pragma unroll
    for (int k = 2; k <= 16; k <<= 1)
#pragma unroll
        for (int j = k >> 1; j > 0; j >>= 1)
#pragma unroll
            for (int i = 0; i < 16; ++i) { const int l = i ^ j; if (l > i) { if ((i & k) == 0) ce_desc(a[i], a[l]); else ce_desc(a[l], a[i]); } }
}
__device__ __forceinline__ void merge_top16(unsigned (&L)[16], const unsigned (&B)[16]) {
#pragma unroll
    for (int i = 0; i < 16; ++i) L[i] = max(L[i], B[15 - i]);
#pragma unroll
    for (int j = 8; j > 0; j >>= 1)
#pragma unroll
        for (int i = 0; i < 16; ++i) { const int l = i ^ j; if (l > i) ce_desc(L[i], L[l]); }
}
__device__ constexpr int cand_i(int n) { int c = 0; for (int i = 0; i < 16; ++i) for (int j = 0; j < 16; ++j) if ((i + 1) * (j + 1) <= 16) { if (c == n) return i; ++c; } return -1; }
__device__ constexpr int cand_j(int n) { int c = 0; for (int i = 0; i < 16; ++i) for (int j = 0; j < 16; ++j) if ((i + 1) * (j + 1) <= 16) { if (c == n) return j; ++c; } return -1; }
template <int N> struct CandTab { int i[N], j[N]; constexpr CandTab() : i(), j() { for (int n = 0; n < N; ++n) { i[n] = cand_i(n); j[n] = cand_j(n); } } };
__device__ __forceinline__ void peer_select_fast(const Params& p, int layer, char* smem) {
    const bf16_t* A = (const bf16_t*)(p.ws + OFF_H);
    const bf16_t* Bt = (const bf16_t*)(p.ws + OFF_WT_Q) + (size_t)layer * 2048 * 1024;
    const bf16_t* SK = (const bf16_t*)(p.ws + OFF_SK) + (size_t)layer * 8 * 2 * 128 * 128;
    unsigned short* IDX = (unsigned short*)(p.ws + OFF_IDX); float* GATE = (float*)(p.ws + OFF_GATE);
    const int tid_ = VTID;
    float* SC = (float*)smem; unsigned* XCH = (unsigned*)smem;
    int mt_, hh;
    for (int it = 0; tile_sched(it, T / 128, 8, mt_, hh); ++it) {
        const int m0 = mt_ * 128;
        unsigned L0[16], L1[16];
#pragma unroll
        for (int pp = 0; pp < 2; ++pp) {
            f32x4 acc[4][4];
            gemm_mainloop<0>(A, A, 1024, 1024, Bt, 1024, m0, hh * 256 + pp * 128, acc, smem);
            int lz = 0; asm volatile("" : "+v"(lz));
            const int tid = tid_ + lz, lane = tid & 63, wid = tid >> 6, wm = wid >> 1, wn = wid & 1, l15 = lane & 15, q4 = lane >> 4, token = tid & 127, half = tid >> 7;
#pragma unroll
            for (int i = 0; i < 4; ++i)
#pragma unroll
                for (int j = 0; j < 4; ++j) {
                    const int row = wm * 64 + i * 16 + l15, chunk = 2 * j + (q4 >> 1);
                    uint2 o; o.x = pack2(acc[i][j][0], acc[i][j][1]); o.y = pack2(acc[i][j][2], acc[i][j][3]);
                    *(uint2*)(smem + wn * 32768 + row * 128 + ((chunk ^ (row & 7)) << 4) + (q4 & 1) * 8) = o;
                }
            const bf16_t* SKp = SK + (size_t)((hh * 2 + pp) * 128) * 128;
#pragma unroll
            for (int i = 0; i < 8; ++i) {
                const int c = tid + 256 * i, row = c >> 4, ch16 = c & 15, ks = ch16 >> 3, ch = ch16 & 7;
                *(uint4*)(smem + ks * 32768 + 16384 + row * 128 + ((ch ^ (row & 7)) << 4)) = *(const uint4*)(SKp + (size_t)row * 128 + ch16 * 8);
            }
            __syncthreads();
#pragma unroll
            for (int i = 0; i < 4; ++i)
#pragma unroll
                for (int j = 0; j < 4; ++j) acc[i][j] = (f32x4){0.f, 0.f, 0.f, 0.f};
#pragma unroll
            for (int kt = 0; kt < 2; ++kt) {
                const char* sa = smem + kt * 32768; const char* sb = sa + 16384;
#pragma unroll
                for (int ks = 0; ks < 2; ++ks) {
                    bf16x8 af[4], bfr[4];
                    const int ch = ks * 4 + q4;
#pragma unroll
                    for (int i = 0; i < 4; ++i) { const int row = wm * 64 + i * 16 + l15; af[i] = *(const bf16x8*)(sa + row * 128 + ((ch ^ (row & 7)) << 4)); }
#pragma unroll
                    for (int j = 0; j < 4; ++j) { const int row = wn * 64 + j * 16 + l15; bfr[j] = *(const bf16x8*)(sb + row * 128 + ((ch ^ (row & 7)) << 4)); }
#pragma unroll
                    for (int i = 0; i < 4; ++i)
#pragma unroll
                        for (int j = 0; j < 4; ++j) acc[i][j] = __builtin_amdgcn_mfma_f32_16x16x32_bf16(bfr[j], af[i], acc[i][j], 0, 0, 0);
                }
            }
            __syncthreads();
#pragma unroll
            for (int i = 0; i < 4; ++i)
#pragma unroll
                for (int j = 0; j < 4; ++j) {
                    const int m = wm * 64 + i * 16 + l15, n = wn * 64 + j * 16 + 4 * q4;
#pragma unroll
                    for (int r = 0; r < 4; ++r) SC[m * 128 + ((n + r) ^ (m & 31))] = acc[i][j][r];
                }
            __syncthreads();
            unsigned L[16];
            {
                const float* srow = SC + token * 128 + half * 64; const int x = token & 31;
#pragma unroll
                for (int ch = 0; ch < 4; ++ch) {
                    unsigned Cc[16];
#pragma unroll
                    for (int i = 0; i < 16; ++i) { const int c = ch * 16 + i; Cc[i] = (ord_key(srow[c ^ x]) & ~127u) | (unsigned)(127 - (half * 64 + c)); }
                    bitonic_sort16_desc(Cc);
                    if (ch == 0) {
#pragma unroll
                        for (int i = 0; i < 16; ++i) L[i] = Cc[i];
                    } else merge_top16(L, Cc);
                }
            }
            __syncthreads();
            if (half == 1) {
#pragma unroll
                for (int i = 0; i < 16; ++i) XCH[token * 17 + i] = L[i];
            }
            __syncthreads();
            if (half == 0) {
                unsigned Xc[16];
#pragma unroll
                for (int i = 0; i < 16; ++i) Xc[i] = XCH[token * 17 + i];
                merge_top16(L, Xc);
            }
#pragma unroll
            for (int i = 0; i < 16; ++i) { if (pp == 0) L0[i] = L[i]; else L1[i] = L[i]; }
            __syncthreads();
        }
        unsigned* NIDX = (unsigned*)smem;
        const int token = tid_ & 127, half = tid_ >> 7;
        if (half == 0) {
            float s0[16], s1[16];
#pragma unroll
            for (int i = 0; i < 16; ++i) { s0[i] = unord_key(L0[i] & ~127u); s1[i] = unord_key(L1[i] & ~127u); }
            constexpr CandTab<64> ct{};
            unsigned C[16];
#pragma unroll
            for (int ch = 0; ch < 4; ++ch) {
                unsigned Cc[16];
#pragma unroll
                for (int i = 0; i < 16; ++i) {
                    const int n = ch * 16 + i;
                    if (ct.i[n] >= 0) Cc[i] = (ord_key(s0[ct.i[n] < 0 ? 0 : ct.i[n]] + s1[ct.j[n] < 0 ? 0 : ct.j[n]]) & ~255u) | (unsigned)(255 - (ct.i[n] * 16 + ct.j[n]));
                    else Cc[i] = 0u;
                }
                bitonic_sort16_desc(Cc);
                if (ch == 0) {
#pragma unroll
                    for (int i = 0; i < 16; ++i) C[i] = Cc[i];
                } else merge_top16(C, Cc);
            }
#pragma unroll
            for (int i = 0; i < 16; ++i) { NIDX[token * 33 + i] = 127u - (L0[i] & 127u); NIDX[token * 33 + 16 + i] = 127u - (L1[i] & 127u); }
            const float mx = unord_key(C[0] & ~255u);
            float e[16]; float sum = 0.f;
#pragma unroll
            for (int r = 0; r < 16; ++r) { e[r] = __expf(unord_key(C[r] & ~255u) - mx); sum += e[r]; }
            const float inv = 1.0f / sum;
            const size_t ob = (size_t)(m0 + token) * 128 + hh * 16;
#pragma unroll
            for (int r = 0; r < 16; ++r) {
                const unsigned code = 255u - (C[r] & 255u);
                const unsigned e0 = NIDX[token * 33 + (code >> 4)], e1 = NIDX[token * 33 + 16 + (code & 15)];
                IDX[ob + r] = (unsigned short)(e0 * 128 + e1);
                GATE[ob + r] = e[r] * inv;
            }
        }
        __syncthreads();
    }
}

__device__ __forceinline__ float ub0(unsigned w) { float f; asm("v_cvt_f32_ubyte0 %0, %1" : "=v"(f) : "v"(w)); return f; }
__device__ __forceinline__ float ub1(unsigned w) { float f; asm("v_cvt_f32_ubyte1 %0, %1" : "=v"(f) : "v"(w)); return f; }
__device__ __forceinline__ float ub2(unsigned w) { float f; asm("v_cvt_f32_ubyte2 %0, %1" : "=v"(f) : "v"(w)); return f; }
__device__ __forceinline__ float ub3(unsigned w) { float f; asm("v_cvt_f32_ubyte3 %0, %1" : "=v"(f) : "v"(w)); return f; }
typedef _Float16 f16x2 __attribute__((ext_vector_type(2)));
__device__ __forceinline__ void glds16(const void* gsrc, unsigned lds_dst) {
    unsigned keep; const unsigned d = (unsigned)__builtin_amdgcn_readfirstlane((int)lds_dst);
    asm volatile("s_mov_b32 %0, m0\n\ts_mov_b32 m0, %2\n\ts_nop 0\n\tglobal_load_lds_dwordx4 %1, off\n\ts_mov_b32 m0, %0" : "=&s"(keep) : "v"(gsrc), "s"(d) : "memory");
}
__device__ __forceinline__ void peer_gather(const Params& p, int layer, const float* __restrict__ gnext, bool final_out, char* smem) {
    const unsigned char* REC = p.ws + OFF_UT + (size_t)layer * NEXP * 1152;
    bf16_t* H = (bf16_t*)(p.ws + OFF_H);
    const unsigned short* IDX = (const unsigned short*)(p.ws + OFF_IDX); const float* GATE = (const float*)(p.ws + OFF_GATE);
    float* X = p.out;
    const int lane = VTID & 63, wid = VTID >> 6, sub = lane >> 4, li = lane & 15;
    char* wbase = smem + (int)(threadIdx.x >> 6) * 19456;
    unsigned short* sIdx = (unsigned short*)wbase; float* sGate = (float*)(wbase + 256);
    const char* ring = wbase + 1024; const unsigned ringb = (unsigned)(size_t)ring;
    const int gw = VBID * 4 + wid, nw = VGRID * 4;
    for (int t = gw; t < T; t += nw) {
        {
            int lz = 0; asm volatile("" : "+v"(lz));
            const int l2 = 2 * (lane + lz);
            const unsigned idp = *(const unsigned*)(IDX + (size_t)t * 128 + l2);
            const float2 g2 = *(const float2*)(GATE + (size_t)t * 128 + l2);
            *(unsigned*)(sIdx + l2) = idp; *(float2*)(sGate + l2) = g2;
        }
        int xq[2][8]; float sx; float xg[2];
        {
            u32x4 xr[8]; float am = 0.f;
#pragma unroll
            for (int k = 0; k < 8; ++k) {
                xr[k] = *(const u32x4*)(H + (size_t)t * 1024 + (16 * (k >> 2) + li) * 32 + (k & 3) * 8);
#pragma unroll
                for (int c = 0; c < 4; ++c) am = fmaxf(am, fmaxf(fabsf(lo2f(xr[k][c])), fabsf(hi2f(xr[k][c]))));
            }
            am = fmaxf(am, __shfl_xor(am, 1)); am = fmaxf(am, __shfl_xor(am, 2)); am = fmaxf(am, __shfl_xor(am, 4)); am = fmaxf(am, __shfl_xor(am, 8));
            const float inv = am > 0.f ? 127.0f / am : 0.f;
            sx = am * (1.0f / 127.0f);
#pragma unroll
            for (int j = 0; j < 2; ++j) {
                int xs = 0;
#pragma unroll
                for (int d = 0; d < 8; ++d) {
                    const unsigned w0 = xr[j * 4 + (d >> 1)][(d & 1) * 2], w1 = xr[j * 4 + (d >> 1)][(d & 1) * 2 + 1];
                    const int q0 = __float2int_rn(lo2f(w0) * inv), q1 = __float2int_rn(hi2f(w0) * inv), q2 = __float2int_rn(lo2f(w1) * inv), q3 = __float2int_rn(hi2f(w1) * inv);
                    xq[j][d] = (q0 & 0xff) | ((q1 & 0xff) << 8) | ((q2 & 0xff) << 16) | ((q3 & 0xff) << 24);
                    xs += (q0 + q1) + (q2 + q3);
                }
                xg[j] = -7.5f * (float)xs;
            }
        }
        f16x2 accp[2][16];
#pragma unroll
        for (int j = 0; j < 2; ++j)
#pragma unroll
            for (int c = 0; c < 16; ++c) accp[j][c] = (f16x2){(_Float16)0.f, (_Float16)0.f};
        float wsg[2] = {0.f, 0.f};
        auto issue = [&](int sg) {
            const unsigned e_ = sIdx[sg * 4 + sub];
            const unsigned char* rec = REC + (size_t)e_ * 1152 + li * 16;
            const unsigned dst = ringb + (unsigned)(sg & 3) * 4608u;
            glds16(rec, dst); glds16(rec + 256, dst + 1024u); glds16(rec + 512, dst + 2048u); glds16(rec + 768, dst + 3072u);
            if (lane < 32) {
                const unsigned e2 = sIdx[sg * 4 + (lane >> 3)];
                glds16(REC + (size_t)e2 * 1152 + 1024 + (lane & 7) * 16, dst + 4096u);
            }
        };
        auto compute = [&](int sg) {
            const char* sl = ring + (sg & 3) * 4608;
            const u32x4 du0 = *(const u32x4*)(sl + lane * 16), du1 = *(const u32x4*)(sl + 1024 + lane * 16);
            const u32x4 dv0 = *(const u32x4*)(sl + 2048 + lane * 16), dv1 = *(const u32x4*)(sl + 3072 + lane * 16);
            const uint2 sc = *(const uint2*)(sl + 4096 + sub * 128 + li * 8);
            const float gt = sGate[sg * 4 + sub];
            const f16x2 us = __builtin_bit_cast(f16x2, sc.x), vs = __builtin_bit_cast(f16x2, sc.y);
            float pa = 0.f;
#pragma unroll
            for (int j = 0; j < 2; ++j) {
                int ia = 0;
#pragma unroll
                for (int d = 0; d < 4; ++d) {
                    const unsigned w = j ? du1[d] : du0[d];
                    ia = __builtin_amdgcn_sdot4((int)(w & 0x0f0f0f0fu), xq[j][2 * d], ia, false);
                    ia = __builtin_amdgcn_sdot4((int)((w >> 4) & 0x0f0f0f0fu), xq[j][2 * d + 1], ia, false);
                }
                pa += (float)us[j] * ((float)ia + xg[j]);
            }
            pa = row16_sum(pa);
            const float ww = gt * gelu_exact(pa * sx);
#pragma unroll
            for (int j = 0; j < 2; ++j) {
                const float wg = ww * (float)vs[j];
                wsg[j] += wg;
                const _Float16 wh = (_Float16)fminf(fmaxf(wg * 65536.0f, -65504.0f), 65504.0f);
                const f16x2 w2 = {wh, wh};
#pragma unroll
                for (int d = 0; d < 4; ++d) {
                    const unsigned wv = j ? dv1[d] : dv0[d];
                    const f16x2 c0 = __builtin_bit_cast(f16x2, (wv << 4) & 0x00f000f0u), c1 = __builtin_bit_cast(f16x2, wv & 0x00f000f0u);
                    const f16x2 c2 = __builtin_bit_cast(f16x2, (wv >> 4) & 0x00f000f0u), c3 = __builtin_bit_cast(f16x2, (wv >> 8) & 0x00f000f0u);
                    accp[j][4 * d + 0] = __builtin_elementwise_fma(c0, w2, accp[j][4 * d + 0]); accp[j][4 * d + 1] = __builtin_elementwise_fma(c1, w2, accp[j][4 * d + 1]);
                    accp[j][4 * d + 2] = __builtin_elementwise_fma(c2, w2, accp[j][4 * d + 2]); accp[j][4 * d + 3] = __builtin_elementwise_fma(c3, w2, accp[j][4 * d + 3]);
                }
            }
        };
        asm volatile("s_waitcnt vmcnt(0)" ::: "memory");
        issue(0); issue(1); issue(2);
#pragma unroll 1
        for (int sg = 0; sg < 29; ++sg) {
            issue(sg + 3);
            asm volatile("s_waitcnt vmcnt(15)" ::: "memory");
            compute(sg);
        }
        asm volatile("s_waitcnt vmcnt(10)" ::: "memory");
        compute(29);
        asm volatile("s_waitcnt vmcnt(5)" ::: "memory");
        compute(30);
        asm volatile("s_waitcnt vmcnt(0)" ::: "memory");
        compute(31);
        float acc[2][32];
#pragma unroll
        for (int j = 0; j < 2; ++j)
#pragma unroll
            for (int d = 0; d < 4; ++d) {
                acc[j][8 * d + 0] = 16.0f * (float)accp[j][4 * d + 0][0]; acc[j][8 * d + 2] = 16.0f * (float)accp[j][4 * d + 0][1];
                acc[j][8 * d + 4] = 16.0f * (float)accp[j][4 * d + 1][0]; acc[j][8 * d + 6] = 16.0f * (float)accp[j][4 * d + 1][1];
                acc[j][8 * d + 1] = 16.0f * (float)accp[j][4 * d + 2][0]; acc[j][8 * d + 3] = 16.0f * (float)accp[j][4 * d + 2][1];
                acc[j][8 * d + 5] = 16.0f * (float)accp[j][4 * d + 3][0]; acc[j][8 * d + 7] = 16.0f * (float)accp[j][4 * d + 3][1];
            }
        const bool up2 = (sub & 2) != 0, up1 = (sub & 1) != 0;
        float wsum = (up2 ? wsg[1] : wsg[0]) + __shfl_xor(up2 ? wsg[0] : wsg[1], 32);
        wsum += __shfl_xor(wsum, 16);
        float r1[32];
#pragma unroll
        for (int c = 0; c < 32; ++c) r1[c] = (up2 ? acc[1][c] : acc[0][c]) + __shfl_xor(up2 ? acc[0][c] : acc[1][c], 32);
        float r2[16];
#pragma unroll
        for (int c = 0; c < 16; ++c) r2[c] = (up1 ? r1[16 + c] : r1[c]) + __shfl_xor(up1 ? r1[c] : r1[16 + c], 16);
        const int col0 = (16 * (sub >> 1) + li) * 32 + (sub & 1) * 16;
        float ss = 0.f;
        float* xrow = X + (size_t)t * 1024 + col0;
#pragma unroll
        for (int c4 = 0; c4 < 4; ++c4) {
            const f32x4 a = *(const f32x4*)(xrow + c4 * 4);
#pragma unroll
            for (int c = 0; c < 4; ++c) { r2[c4 * 4 + c] = r2[c4 * 4 + c] - 7.5f * wsum + a[c]; ss += r2[c4 * 4 + c] * r2[c4 * 4 + c]; }
        }
        ss = wave_sum(ss);
        const float rstd = rsqrtf(ss * (1.0f / D) + EPS);
        const float* gp = gnext + col0;
        if (final_out) {
#pragma unroll
            for (int c4 = 0; c4 < 4; ++c4) {
                const f32x4 g = *(const f32x4*)(gp + c4 * 4);
                *(f32x4*)(xrow + c4 * 4) = (f32x4){r2[c4 * 4] * rstd * g[0], r2[c4 * 4 + 1] * rstd * g[1], r2[c4 * 4 + 2] * rstd * g[2], r2[c4 * 4 + 3] * rstd * g[3]};
            }
        } else {
            u32x4 o[2];
#pragma unroll
            for (int c4 = 0; c4 < 4; ++c4) {
                const f32x4 g = *(const f32x4*)(gp + c4 * 4);
                *(f32x4*)(xrow + c4 * 4) = (f32x4){r2[c4 * 4], r2[c4 * 4 + 1], r2[c4 * 4 + 2], r2[c4 * 4 + 3]};
                o[c4 >> 1][(c4 & 1) * 2] = pack2(r2[c4 * 4] * rstd * g[0], r2[c4 * 4 + 1] * rstd * g[1]);
                o[c4 >> 1][(c4 & 1) * 2 + 1] = pack2(r2[c4 * 4 + 2] * rstd * g[2], r2[c4 * 4 + 3] * rstd * g[3]);
            }
            bf16_t* hp = H + (size_t)t * 1024 + col0;
            *(u32x4*)hp = o[0]; *(u32x4*)(hp + 8) = o[1];
        }
    }
}

__device__ __forceinline__ void spatial_fast(const Params& p, char* smem) {
    bf16_t* U = (bf16_t*)(p.ws + OFF_REGION); const bf16_t* VT = U + (size_t)T * 2048; const float* SSQ = (const float*)(p.ws + OFF_SSQ);
    const int tid_ = VTID;
    for (int task = VBID; task < 2048; task += VGRID) {
        const int chunk = task >> 3, g = task & 7;
        int lz = 0; asm volatile("" : "+v"(lz));
        const int tid = tid_ + lz, lane = tid & 63, wid = tid >> 6, wm = wid >> 1, wn = wid & 1, l15 = lane & 15, q4 = lane >> 4;
        float* rs = (float*)(smem + 16384);
        if (tid < 128) {
            const float* sp = SSQ + (size_t)(chunk * 128 + tid) * 32;
            float s = 0.f;
#pragma unroll
            for (int i = 0; i < 8; ++i) { const f32x4 v = *(const f32x4*)(sp + 4 * i); s += (v[0] + v[1]) + (v[2] + v[3]); }
            rs[tid] = rsqrtf(s * (1.0f / 2048.0f) + EPS);
        }
        __syncthreads();
#pragma unroll
        for (int i = 0; i < 8; ++i) {
            const int c = tid + 256 * i, row = c >> 4, ch16 = c & 15, ks = ch16 >> 3, ch = ch16 & 7, s0 = ch16 * 8;
            const float* wp = p.c_w_spatial + ((size_t)(g * 128 + row)) * 128 + s0;
            const f32x4 w0 = *(const f32x4*)wp, w1 = *(const f32x4*)(wp + 4);
            const f32x4 r0 = *(const f32x4*)(rs + s0), r1 = *(const f32x4*)(rs + s0 + 4);
            float v[8];
#pragma unroll
            for (int j = 0; j < 4; ++j) { v[j] = (s0 + j <= row) ? w0[j] * r0[j] : 0.f; v[4 + j] = (s0 + 4 + j <= row) ? w1[j] * r1[j] : 0.f; }
            *(uint4*)(smem + ks * 32768 + row * 128 + ((ch ^ (row & 7)) << 4)) = make_uint4(pack2(v[0], v[1]), pack2(v[2], v[3]), pack2(v[4], v[5]), pack2(v[6], v[7]));
        }
        __syncthreads();
#pragma unroll 1
        for (int nh = 0; nh < 2; ++nh) {
            const int chan0 = g * 256 + nh * 128;
#pragma unroll
            for (int i = 0; i < 8; ++i) {
                const int c = tid + 256 * i, row = c >> 4, ch16 = c & 15, ks = ch16 >> 3, ch = ch16 & 7;
                *(uint4*)(smem + ks * 32768 + 16384 + row * 128 + ((ch ^ (row & 7)) << 4)) = *(const uint4*)(VT + ((size_t)chunk * 2048 + chan0 + row) * 128 + ch16 * 8);
            }
            __syncthreads();
            f32x4 acc[4][4];
#pragma unroll
            for (int i = 0; i < 4; ++i)
#pragma unroll
                for (int j = 0; j < 4; ++j) acc[i][j] = (f32x4){0.f, 0.f, 0.f, 0.f};
#pragma unroll
            for (int kt = 0; kt < 2; ++kt) {
                if (kt == 1 && wm == 0) continue;
                const char* sa = smem + kt * 32768; const char* sb = sa + 16384;
#pragma unroll
                for (int ks = 0; ks < 2; ++ks) {
                    bf16x8 af[4], bfr[4];
                    const int ch = ks * 4 + q4;
#pragma unroll
                    for (int i = 0; i < 4; ++i) { const int row = wm * 64 + i * 16 + l15; af[i] = *(const bf16x8*)(sa + row * 128 + ((ch ^ (row & 7)) << 4)); }
#pragma unroll
                    for (int j = 0; j < 4; ++j) { const int row = wn * 64 + j * 16 + l15; bfr[j] = *(const bf16x8*)(sb + row * 128 + ((ch ^ (row & 7)) << 4)); }
#pragma unroll
                    for (int i = 0; i < 4; ++i)
#pragma unroll
                        for (int j = 0; j < 4; ++j) acc[i][j] = __builtin_amdgcn_mfma_f32_16x16x32_bf16(bfr[j], af[i], acc[i][j], 0, 0, 0);
                }
            }
            __syncthreads();
#pragma unroll
            for (int i = 0; i < 4; ++i) {
                const int m = wm * 64 + i * 16 + l15;
                const float bias = p.c_b_spatial[g * 128 + m];
#pragma unroll
                for (int j = 0; j < 4; ++j) {
                    const int chan = chan0 + wn * 64 + j * 16 + 4 * q4;
                    const f32x4 vn = *(const f32x4*)(p.c_v_norm + chan);
                    bf16_t* up = U + (size_t)(chunk * 128 + m) * 2048 + chan;
                    const uint2 uu = *(const uint2*)up;
                    uint2 o;
                    o.x = pack2(lo2f(uu.x) * (vn[0] * acc[i][j][0] + bias), hi2f(uu.x) * (vn[1] * acc[i][j][1] + bias));
                    o.y = pack2(lo2f(uu.y) * (vn[2] * acc[i][j][2] + bias), hi2f(uu.y) * (vn[3] * acc[i][j][3] + bias));
                    *(uint2*)up = o;
                }
            }
        }
    }
}

#define XB_TMO      128
#define XB_XCNT(j)  (256  + 64 * (j))
#define XB_XSUB(j)  (1280 + 64 * (j))
#define XB_XGEN(j)  (2304 + 64 * (j))
#define XB_TOP      3328
#define XB_TOPGEN   3392
#define XCD_BAR_WORDS 3456
#define XB_SPIN_CAP (1u << 22)
#define LAS __attribute__((address_space(3)))
__device__ __forceinline__ unsigned xb_ld(unsigned* p)              { return __hip_atomic_load(p, __ATOMIC_RELAXED, __HIP_MEMORY_SCOPE_AGENT); }
__device__ __forceinline__ unsigned xb_add(unsigned* p, unsigned v) { return __hip_atomic_fetch_add(p, v, __ATOMIC_RELAXED, __HIP_MEMORY_SCOPE_AGENT); }
__device__ __forceinline__ unsigned xb_xcc_id() { return (unsigned)__builtin_amdgcn_s_getreg((3 << 11) | 20) & 0xFu; }
#define XB_SPIN(cond, bar) do { unsigned _sp = 0; while (cond) { __builtin_amdgcn_s_sleep(1); \
    if ((++_sp & 255u) == 0u) { if (xb_ld(&(bar)[XB_TMO])) break; if (_sp > XB_SPIN_CAP) { atomicAdd(&(bar)[XB_TMO], 1u); break; } } } } while (0)
struct XcdBarrier { unsigned* bar; unsigned x; volatile LAS unsigned* st; };
__device__ __forceinline__ XcdBarrier xcd_barrier_post(unsigned* bar, volatile LAS unsigned* st) {
    XcdBarrier b; b.bar = bar; b.x = xb_xcc_id(); b.st = st;
    if (threadIdx.x == 0) (void)xb_add(&bar[XB_XCNT(b.x)], 1u);
    return b;
}
__device__ __forceinline__ void xcd_barrier_complete(unsigned* bar, unsigned x, unsigned& nloc, unsigned& nx) {
    const unsigned G = gridDim.x * gridDim.y * gridDim.z;
    unsigned sum, cnt, mine, sp = 0u;
    for (;;) {
        sum = 0u; cnt = 0u; mine = 0u;
#pragma unroll
        for (unsigned j = 0; j < 16; ++j) { const unsigned c = xb_ld(&bar[XB_XCNT(j)]); sum += c; cnt += (c > 0u) ? 1u : 0u; mine = (j == x) ? c : mine; }
        if (sum == G) break;
        __builtin_amdgcn_s_sleep(1);
        if ((++sp & 255u) == 0u) { if (xb_ld(&bar[XB_TMO])) break; if (sp > XB_SPIN_CAP) { atomicAdd(&bar[XB_TMO], 1u); break; } }
    }
    nloc = mine > 0u ? mine : 1u; nx = cnt > 0u ? cnt : 1u;
}
__device__ __forceinline__ void xcd_barrier(const XcdBarrier& b) {
    asm volatile("s_waitcnt vmcnt(0)" ::: "memory");
    __syncthreads();
    if (threadIdx.x == 0) {
        unsigned* bar = b.bar;
        __builtin_amdgcn_s_waitcnt(0);
        unsigned nloc = b.st[0], nx = b.st[1];
        if (nloc == 0u) { xcd_barrier_complete(bar, b.x, nloc, nx); b.st[0] = nloc; b.st[1] = nx; }
        const unsigned old = xb_add(&bar[XB_XSUB(b.x)], 1u);
        const unsigned gen = old / nloc;
        if (old + 1u == (gen + 1u) * nloc) {
            __builtin_amdgcn_fence(__ATOMIC_RELEASE, "agent");
            asm volatile("s_waitcnt vmcnt(0)" ::: "memory");
            const unsigned og = xb_add(&bar[XB_TOP], 1u);
            const unsigned tg = og / nx;
            if (og + 1u == (tg + 1u) * nx) xb_add(&bar[XB_TOPGEN], 1u);
            else XB_SPIN(xb_ld(&bar[XB_TOPGEN]) == tg, bar);
            __builtin_amdgcn_fence(__ATOMIC_ACQUIRE, "agent");
            xb_add(&bar[XB_XGEN(b.x)], 1u);
            asm volatile("s_waitcnt vmcnt(0)" ::: "memory");
        } else {
            XB_SPIN(xb_ld(&bar[XB_XGEN(b.x)]) == gen, bar);
            __builtin_amdgcn_fence(__ATOMIC_ACQUIRE, "agent");
            asm volatile("s_waitcnt vmcnt(0)" ::: "memory");
        }
    }
    __syncthreads();
}

constexpr int NPHASE = 14;
constexpr int kDynLds = 163840;
__global__ void __launch_bounds__(512, 2) mega(Params p, int ph_lo, int ph_hi) {
    extern __shared__ __attribute__((aligned(16))) char smem_phys[];
    cg::grid_group grid = cg::this_grid();
    uint4& xb_words = *(uint4*)(smem_phys + kDynLds - 16);
    if (threadIdx.x == 0) xb_words = make_uint4(0u, 0u, 0u, 0u);
    __syncthreads();
    const XcdBarrier xbar = xcd_barrier_post((unsigned*)(p.ws + OFF_BAR), (volatile LAS unsigned*)&xb_words);
    char* smem = smem_phys + (threadIdx.x >> 8) * 65536;
    bf16_t* Rg = (bf16_t*)(p.ws + OFF_REGION);
    bf16_t* Hb = (bf16_t*)(p.ws + OFF_H);
#define PHASE(k, ...) if (ph_lo <= (k) && (k) < ph_hi) { __VA_ARGS__; if ((k) + 1 < ph_hi) { if ((k) == 0) grid.sync(); else xcd_barrier(xbar); } }
    unsigned* sbctr = (unsigned*)(p.ws + OFF_BAR + 14336);
    PHASE(0,
        transpose_convert<true>(p.ab_w_in, (bf16_t*)(p.ws + OFF_WT_IN), 1024, AB_IN, AB_IN_PAD, smem);
        rmsnorm_rows(p.x, p.norm_mix, Hb))
    PHASE(1, phase_gemm_in8(p, smem_phys))
    PHASE(2, gla_prep(p, smem))
    PHASE(3, gla_scan(p, smem); sb_fast(p, smem_phys + 98304, sbctr); quantize_tables_static(p);
        transpose_convert(p.ab_w_out, (bf16_t*)(p.ws + OFF_WT_OUT), 1024, 1024, 1024, smem);
        transpose_convert(p.c_w_in, (bf16_t*)(p.ws + OFF_WT_CIN), 1024, 4096, 4096, smem);
        transpose_convert(p.c_w_out, (bf16_t*)(p.ws + OFF_WT_COUT), 2048, 1024, 1024, smem);
        transpose_convert(p.peer_w_q, (bf16_t*)(p.ws + OFF_WT_Q), 1024, 2048, 2048, smem);
        transpose_convert(p.peer_w_q + (size_t)1024 * 2048, (bf16_t*)(p.ws + OFF_WT_Q) + (size_t)2048 * 1024, 1024, 2048, 2048, smem);
        convert_flat(p.peer_subkeys, (bf16_t*)(p.ws + OFF_SK), (size_t)2 * 8 * 2 * 128 * 128))
    PHASE(4, phase_gemm_resid8(Rg + R_QSB, Rg + R_GG, 512, 512, (const bf16_t*)(p.ws + OFF_WT_OUT), 1024, p.x, p.out, smem_phys))
    PHASE(5, rmsnorm_rows(p.out, p.norm_ffn, Hb))
    PHASE(6, peer_select_fast(p, 0, smem))
    PHASE(7, peer_gather(p, 0, p.norm_mix + 1024, false, smem_phys))
    PHASE(8, phase_gemm_cin8(p, smem_phys))
    PHASE(9, spatial_fast(p, smem))
    PHASE(10, phase_gemm_resid8(Rg, Rg, 2048, 2048, (const bf16_t*)(p.ws + OFF_WT_COUT), 2048, p.out, p.out, smem_phys))
    PHASE(11, rmsnorm_rows(p.out, p.norm_ffn + 1024, Hb))
    PHASE(12, peer_select_fast(p, 1, smem))
    PHASE(13, peer_gather(p, 1, p.final_norm, true, smem_phys))
}

extern "C" void kernel_launch(void* const* d_in, const int* in_sizes, int n_in, void* d_out, int out_size, void* d_ws, size_t ws_size, hipStream_t stream) {
    static int grid_blocks = 0;
    if (!grid_blocks) {
        int dev = 0, cus = 0, per_cu = 0;
        hipGetDevice(&dev);
        hipDeviceGetAttribute(&cus, hipDeviceAttributeMultiprocessorCount, dev);
        hipFuncSetAttribute((const void*)mega, hipFuncAttributeMaxDynamicSharedMemorySize, kDynLds);
        hipOccupancyMaxActiveBlocksPerMultiprocessor(&per_cu, mega, 512, kDynLds);
        if (per_cu < 1) per_cu = 1;
        if (per_cu > 1) per_cu = 1;
        grid_blocks = cus * per_cu;
        if (n_in != 18 || ws_size < WS_END) fprintf(stderr, "kernel_launch: unexpected n_in %d or ws_size %zu < %zu\n", n_in, ws_size, (size_t)WS_END);
    }
    Params p{};
    p.x = (const float*)d_in[0]; p.norm_mix = (const float*)d_in[1]; p.norm_ffn = (const float*)d_in[2]; p.ab_w_in = (const float*)d_in[3];
    p.ab_w_alpha2 = (const float*)d_in[4]; p.ab_b_alpha2 = (const float*)d_in[5]; p.ab_gla_norm = (const float*)d_in[6]; p.ab_w_out = (const float*)d_in[7];
    p.c_w_in = (const float*)d_in[8]; p.c_v_norm = (const float*)d_in[9]; p.c_w_spatial = (const float*)d_in[10]; p.c_b_spatial = (const float*)d_in[11];
    p.c_w_out = (const float*)d_in[12]; p.peer_w_q = (const float*)d_in[13]; p.peer_subkeys = (const float*)d_in[14]; p.peer_u = (const float*)d_in[15];
    p.peer_v = (const float*)d_in[16]; p.final_norm = (const float*)d_in[17];
    p.out = (float*)d_out; p.ws = (unsigned char*)d_ws;
    (void)hipMemsetAsync((char*)d_ws + OFF_BAR, 0, 16384, stream);
#if ONE_LAUNCH
    int lo = 0, hi = NPHASE;
    void* args[] = {&p, &lo, &hi};
    hipError_t e = hipLaunchCooperativeKernel((void*)mega, dim3(grid_blocks), dim3(512), args, kDynLds, stream);
    if (e != hipSuccess) fprintf(stderr, "cooperative launch failed: %s (grid %d)\n", hipGetErrorString(e), grid_blocks);
#else
    for (int ph = 0; ph < NPHASE; ++ph) hipLaunchKernelGGL(mega, dim3(grid_blocks), dim3(512), kDynLds, stream, p, ph, ph + 1);
#endif
}
```

```cpp
#include <hip/hip_runtime.h>
#include <hip/hip_cooperative_groups.h>
#include <cstdio>
#include <cstdint>
namespace cg = cooperative_groups;

#ifndef ONE_LAUNCH
#define ONE_LAUNCH 1
#endif


#define VTID ((int)(threadIdx.x & 255))
#define VBID ((int)(blockIdx.x * 2 + (threadIdx.x >> 8)))
#define VGRID ((int)(gridDim.x * 2))
typedef unsigned short bf16_t;
typedef short bf16x8 __attribute__((ext_vector_type(8)));
typedef float f32x4 __attribute__((ext_vector_type(4)));
typedef unsigned u32x4 __attribute__((ext_vector_type(4)));
typedef __bf16 bf16x2_t __attribute__((ext_vector_type(2)));

constexpr int T = 32768, D = 1024, SEQ = 2048, NB = 16;
constexpr int AB_IN = 3088, AB_IN_PAD = 3200;
constexpr float EPS = 1e-6f;
constexpr int NEXP = 16384;

constexpr size_t SZ_WT_IN = (size_t)AB_IN_PAD * 1024 * 2;
constexpr size_t SZ_WT_OUT = (size_t)1024 * 1024 * 2;
constexpr size_t SZ_WT_CIN = (size_t)4096 * 1024 * 2;
constexpr size_t SZ_WT_COUT = (size_t)1024 * 2048 * 2;
constexpr size_t SZ_WT_Q = (size_t)2 * 2048 * 1024 * 2;
constexpr size_t SZ_SK = (size_t)2 * 8 * 2 * 128 * 128 * 2;
constexpr size_t SZ_TAB = (size_t)2 * NEXP * 1024;
constexpr size_t SZ_TSC = (size_t)2 * NEXP * 4;
constexpr size_t OFF_WT_IN = 0;
constexpr size_t OFF_WT_OUT = OFF_WT_IN + SZ_WT_IN;
constexpr size_t OFF_WT_CIN = OFF_WT_OUT + SZ_WT_OUT;
constexpr size_t OFF_WT_COUT = OFF_WT_CIN + SZ_WT_CIN;
constexpr size_t OFF_WT_Q = OFF_WT_COUT + SZ_WT_COUT;
constexpr size_t OFF_SK = OFF_WT_Q + SZ_WT_Q;
constexpr size_t OFF_UT = OFF_SK + SZ_SK;
constexpr size_t OFF_VT = OFF_UT + SZ_TAB;
constexpr size_t OFF_USC = OFF_VT + SZ_TAB;
constexpr size_t OFF_VSC = OFF_USC + SZ_TSC;
constexpr size_t OFF_H = OFF_VSC + SZ_TSC;
constexpr size_t OFF_IDX = OFF_H + (size_t)T * 1024 * 2;
constexpr size_t OFF_GATE = OFF_IDX + (size_t)T * 128 * 2;
constexpr size_t OFF_SSQ = OFF_GATE + (size_t)T * 128 * 4;
constexpr size_t OFF_REGION = OFF_SSQ + (size_t)T * 32 * 4;
constexpr size_t SZ_REGION = (size_t)256 << 20;
constexpr size_t OFF_BAR = OFF_REGION + SZ_REGION;
constexpr size_t WS_END = OFF_BAR + 16384;
constexpr size_t R_QSB = 0;
constexpr size_t R_KSB = R_QSB + (size_t)T * 512;
constexpr size_t R_VTSB = R_KSB + (size_t)T * 512;
constexpr size_t R_QG = R_VTSB + (size_t)T * 512;
constexpr size_t R_KG = R_QG + (size_t)T * 256;
constexpr size_t R_VTG = R_KG + (size_t)T * 256;
constexpr size_t R_GG = R_VTG + (size_t)T * 512;
constexpr size_t R_ALR = R_GG + (size_t)T * 512;
constexpr size_t R_KOT = R_ALR + (size_t)T * 32;
constexpr size_t R_DEC = R_KOT + (size_t)T * 256;

struct Params {
    const float* x; const float* norm_mix; const float* norm_ffn; const float* ab_w_in; const float* ab_w_alpha2; const float* ab_b_alpha2;
    const float* ab_gla_norm; const float* ab_w_out; const float* c_w_in; const float* c_v_norm; const float* c_w_spatial; const float* c_b_spatial;
    const float* c_w_out; const float* peer_w_q; const float* peer_subkeys; const float* peer_u; const float* peer_v; const float* final_norm;
    float* out; unsigned char* ws;
};

__device__ __forceinline__ float bf2f(bf16_t v) { return __uint_as_float(((unsigned)v) << 16); }
__device__ __forceinline__ bf16_t f2bf(float f) { unsigned u = __float_as_uint(f); u += 0x7fffu + ((u >> 16) & 1u); return (bf16_t)(u >> 16); }
__device__ __forceinline__ unsigned pack2(float lo, float hi) { return (unsigned)f2bf(lo) | ((unsigned)f2bf(hi) << 16); }
__device__ __forceinline__ float lo2f(unsigned w) { return __uint_as_float(w << 16); }
__device__ __forceinline__ float hi2f(unsigned w) { return __uint_as_float(w & 0xffff0000u); }
__device__ __forceinline__ float dot2(unsigned a, unsigned b, float acc) { return __builtin_amdgcn_fdot2_f32_bf16(__builtin_bit_cast(bf16x2_t, a), __builtin_bit_cast(bf16x2_t, b), acc, false); }
__device__ __forceinline__ float gelu_exact(float v) {
    const float av = fabsf(v);
    const float t = __builtin_amdgcn_rcpf(av * 0.2316418882f + 1.0f);
    float q = t * 0.5307027145f - 0.7265760135f; q = q * t + 0.7107068705f; q = q * t - 0.142248368f; q = q * t + 0.127414796f; q = q * t;
    const float e = __builtin_amdgcn_exp2f(v * v * -0.72134752044f);
    const float m = v * (q * e);
    return v < 0.f ? m : v - m;
}
__device__ __forceinline__ float row16_sum(float v) {
    v += __builtin_bit_cast(float, __builtin_amdgcn_update_dpp(0, __builtin_bit_cast(int, v), 0x128, 0xf, 0xf, false));
    v += __builtin_bit_cast(float, __builtin_amdgcn_update_dpp(0, __builtin_bit_cast(int, v), 0x124, 0xf, 0xf, false));
    v += __builtin_bit_cast(float, __builtin_amdgcn_update_dpp(0, __builtin_bit_cast(int, v), 0x122, 0xf, 0xf, false));
    v += __builtin_bit_cast(float, __builtin_amdgcn_update_dpp(0, __builtin_bit_cast(int, v), 0x121, 0xf, 0xf, false));
    return v;
}
__device__ __forceinline__ float wave_sum(float v) {
#pragma unroll
    for (int o = 32; o >= 1; o >>= 1) v += __shfl_xor(v, o);
    return v;
}

template <bool PERM_IN = false>
__device__ __forceinline__ void transpose_convert(const float* __restrict__ W, bf16_t* __restrict__ Wt, int K, int N, int Npad, char* smem) {
    float* tile = (float*)smem;
    const int tk = K / 64, tn = Npad / 64, ntile = tk * tn;
    const int tid = VTID;
    for (int tl = VBID; tl < ntile; tl += VGRID) {
        const int k0 = (tl % tk) * 64, n0 = (tl / tk) * 64;
        const int c = tid & 63, r0 = tid >> 6;
        int nd = n0;
        if (PERM_IN) { if (n0 >= 1024 && n0 < 1536) nd = n0 + 1024; else if (n0 >= 1536 && n0 < 2048) nd = n0 - 512; else if (n0 >= 2048 && n0 < 2560) nd = n0 + 512; else if (n0 >= 2560 && n0 < 3072) nd = n0 - 1024; }
#pragma unroll
        for (int i = 0; i < 16; ++i) {
            const int r = r0 + 4 * i;
            const float v = (n0 + c < N) ? W[(size_t)(k0 + r) * N + n0 + c] : 0.f;
            tile[c * 65 + r] = v;
        }
        __syncthreads();
#pragma unroll
        for (int i = 0; i < 16; ++i) {
            const int n = r0 + 4 * i;
            Wt[(size_t)(nd + n) * K + k0 + c] = f2bf(tile[n * 65 + c]);
        }
        __syncthreads();
    }
}
__device__ __forceinline__ void convert_flat(const float* __restrict__ src, bf16_t* __restrict__ dst, size_t n) {
    const size_t nv = n / 8;
    for (size_t i = (size_t)VBID * 256 + VTID; i < nv; i += (size_t)VGRID * 256) {
        const float4 a = ((const float4*)src)[2 * i], b = ((const float4*)src)[2 * i + 1];
        uint4 o; o.x = pack2(a.x, a.y); o.y = pack2(a.z, a.w); o.z = pack2(b.x, b.y); o.w = pack2(b.z, b.w);
        ((uint4*)dst)[i] = o;
    }
}
__device__ __forceinline__ void quantize_tables_static(const Params& p) {
    const int lane = VTID & 63, wid = VTID >> 6;
    for (unsigned task = (unsigned)VBID; task < 512u; task += (unsigned)VGRID) {
        const bool isv = task >= 256u;
        const int r0 = (int)(task & 255u) * 128 + wid * 32;
        const float* src = isv ? p.peer_v : p.peer_u;
        unsigned char* recs = p.ws + OFF_UT;
        for (int rr = 0; rr < 32; ++rr) {
            const int r = r0 + rr;
            const float* xr = src + (size_t)r * 1024 + lane * 16;
            f32x4 v[4]; float aml = 0.f;
#pragma unroll
            for (int i = 0; i < 4; ++i) {
                v[i] = *(const f32x4*)(xr + i * 4);
                aml = fmaxf(aml, fmaxf(fmaxf(fabsf(v[i][0]), fabsf(v[i][1])), fmaxf(fabsf(v[i][2]), fabsf(v[i][3]))));
            }
            const float gs = fmaxf(aml, __shfl_xor(aml, 1)) * (1.002f / 7.5f);
            const _Float16 hs = (_Float16)gs;
            const float gsd = (float)hs, ginv = gsd > 0.f ? 1.0f / gsd : 0.f;
            unsigned wd[2];
#pragma unroll
            for (int dd = 0; dd < 2; ++dd) {
                unsigned wv = 0;
#pragma unroll
                for (int b = 0; b < 4; ++b) {
                    const int qa = min(15, max(0, __float2int_rn(v[2 * dd][b] * ginv + 7.5f)));
                    const int qb = min(15, max(0, __float2int_rn(v[2 * dd + 1][b] * ginv + 7.5f)));
                    wv |= ((unsigned)qa | ((unsigned)qb << 4)) << (8 * b);
                }
                wd[dd] = wv;
            }
            unsigned char* rec = recs + (size_t)r * 1152;
            *(uint2*)(rec + (isv ? 512 : 0) + lane * 8) = make_uint2(wd[0], wd[1]);
            if ((lane & 1) == 0) { const int g = lane >> 1; *(_Float16*)(rec + 1024 + (g & 15) * 8 + (isv ? 4 : 0) + (g >> 4) * 2) = hs; }
        }
    }
}
__device__ __forceinline__ void rmsnorm_rows(const float* __restrict__ X, const float* __restrict__ g, bf16_t* __restrict__ Hout) {
    const int lane = VTID & 63, wid = VTID >> 6;
    const int gw = VBID * 4 + wid, nw = VGRID * 4;
    for (int t = gw; t < T; t += nw) {
        const float* xr = X + (size_t)t * D;
        float4 v[4]; float ss = 0.f;
#pragma unroll
        for (int i = 0; i < 4; ++i) { v[i] = *(const float4*)(xr + i * 256 + lane * 4); ss += v[i].x * v[i].x + v[i].y * v[i].y + v[i].z * v[i].z + v[i].w * v[i].w; }
        ss = wave_sum(ss);
        const float rstd = rsqrtf(ss * (1.0f / D) + EPS);
#pragma unroll
        for (int i = 0; i < 4; ++i) {
            const float4 gg = *(const float4*)(g + i * 256 + lane * 4);
            uint2 o; o.x = pack2(v[i].x * rstd * gg.x, v[i].y * rstd * gg.y); o.y = pack2(v[i].z * rstd * gg.z, v[i].w * rstd * gg.w);
            *(uint2*)(Hout + (size_t)t * D + i * 256 + lane * 4) = o;
        }
    }
}

template <int MODE>
__device__ __forceinline__ void gemm_mainloop(const bf16_t* __restrict__ A0, const bf16_t* __restrict__ A1, int lda, int ksplit,
                                              const bf16_t* __restrict__ Bt, int K, int m0, int n0, f32x4 (&acc)[4][4], char* smem) {
    const int tid = VTID, lane = tid & 63, wid = tid >> 6, wm = wid >> 1, wn = wid & 1;
    const int lrow = tid >> 3, lch = tid & 7;
#pragma unroll
    for (int i = 0; i < 4; ++i)
#pragma unroll
        for (int j = 0; j < 4; ++j) acc[i][j] = (f32x4){0.f, 0.f, 0.f, 0.f};
    const int nk = K / 64;
    unsigned aoff[4], boff[4];
    {
        const int rr = lane >> 3, cc = ((lane & 7) ^ rr) * 8;
#pragma unroll
        for (int i = 0; i < 4; ++i) {
            aoff[i] = (unsigned)(((m0 + 32 * wid + 8 * i + rr) * lda + cc) * 2);
            boff[i] = (unsigned)(((n0 + 32 * wid + 8 * i + rr) * K + cc) * 2);
        }
    }
    auto stage = [&](int kt, int buf) {
        const int kb = kt * 64;
        const char* Ab; const char* Bb = (const char*)(Bt + kb);
        if (kb < ksplit) Ab = (const char*)(A0 + kb); else Ab = (const char*)(A1 + (kb - ksplit));
        char* sa = smem + buf * 32768 + wid * 4096 + lane * 16; char* sb = sa + 16384;
#pragma unroll
        for (int i = 0; i < 4; ++i) __builtin_amdgcn_global_load_lds((const unsigned*)(Ab + aoff[i]), (unsigned*)(sa + i * 1024), 16, 0, 0);
#pragma unroll
        for (int i = 0; i < 4; ++i) __builtin_amdgcn_global_load_lds((const unsigned*)(Bb + boff[i]), (unsigned*)(sb + i * 1024), 16, 0, 0);
    };
    auto compute = [&](int buf) {
        const char* sa = smem + buf * 32768; const char* sb = sa + 16384;
#pragma unroll
        for (int ks = 0; ks < 2; ++ks) {
            bf16x8 af[4], bfr[4];
            const int ch = ks * 4 + (lane >> 4);
#pragma unroll
            for (int i = 0; i < 4; ++i) { const int row = wm * 64 + i * 16 + (lane & 15); af[i] = *(const bf16x8*)(sa + row * 128 + ((ch ^ (row & 7)) << 4)); }
#pragma unroll
            for (int j = 0; j < 4; ++j) { const int row = wn * 64 + j * 16 + (lane & 15); bfr[j] = *(const bf16x8*)(sb + row * 128 + ((ch ^ (row & 7)) << 4)); }
            __builtin_amdgcn_s_setprio(1);
#pragma unroll
            for (int i = 0; i < 4; ++i)
#pragma unroll
                for (int j = 0; j < 4; ++j) {
                    if (MODE == 0) acc[i][j] = __builtin_amdgcn_mfma_f32_16x16x32_bf16(bfr[j], af[i], acc[i][j], 0, 0, 0);
                    else acc[i][j] = __builtin_amdgcn_mfma_f32_16x16x32_bf16(af[i], bfr[j], acc[i][j], 0, 0, 0);
                }
            __builtin_amdgcn_s_setprio(0);
        }
    };
    stage(0, 0);
    asm volatile("s_waitcnt vmcnt(0)" ::: "memory");
    __syncthreads();
    for (int kt = 0; kt < nk; ++kt) {
        if (kt + 1 < nk) stage(kt + 1, (kt + 1) & 1);
        compute(kt & 1);
        asm volatile("s_waitcnt vmcnt(0)" ::: "memory");
        __syncthreads();
    }
}
template <int MODE>
__device__ __forceinline__ void gemm_mainloop256(const bf16_t* __restrict__ A0, const bf16_t* __restrict__ A1, int lda, int ksplit,
                                                 const bf16_t* __restrict__ Bt, int K, int m0, int n0, f32x4 (&acc)[8][4], char* smem) {
    const int tid = VTID, lane = tid & 63, wid = tid >> 6, wm = wid >> 1, wn = wid & 1;
#pragma unroll
    for (int i = 0; i < 8; ++i)
#pragma unroll
        for (int j = 0; j < 4; ++j) acc[i][j] = (f32x4){0.f, 0.f, 0.f, 0.f};
    const int nk = K / 32;
    unsigned aoff[4], boff[2];
    {
        const int rr = lane >> 2, cc = ((lane & 3) ^ (3 * ((lane >> 5) & 1))) * 8;
#pragma unroll
        for (int i = 0; i < 4; ++i) aoff[i] = (unsigned)(((m0 + 64 * wid + 16 * i + rr) * lda + cc) * 2);
#pragma unroll
        for (int i = 0; i < 2; ++i) boff[i] = (unsigned)(((n0 + 32 * wid + 16 * i + rr) * K + cc) * 2);
    }
    auto stage = [&](int kt, int buf) {
        const int kb = kt * 32;
        const char* Ab; const char* Bb = (const char*)(Bt + kb);
        if (kb < ksplit) Ab = (const char*)(A0 + kb); else Ab = (const char*)(A1 + (kb - ksplit));
        char* sa = smem + buf * 24576 + wid * 4096 + lane * 16; char* sb = smem + buf * 24576 + 16384 + wid * 2048 + lane * 16;
#pragma unroll
        for (int i = 0; i < 4; ++i) __builtin_amdgcn_global_load_lds((const unsigned*)(Ab + aoff[i]), (unsigned*)(sa + i * 1024), 16, 0, 0);
#pragma unroll
        for (int i = 0; i < 2; ++i) __builtin_amdgcn_global_load_lds((const unsigned*)(Bb + boff[i]), (unsigned*)(sb + i * 1024), 16, 0, 0);
    };
    const int fpos = (((lane >> 4) ^ (3 * ((lane >> 3) & 1))) << 4) + (lane & 15) * 64;
    auto compute = [&](int buf) {
        const char* sa = smem + buf * 24576 + wm * 8192 + fpos; const char* sb = smem + buf * 24576 + 16384 + wn * 4096 + fpos;
        bf16x8 af[8], bfr[4];
#pragma unroll
        for (int i = 0; i < 8; ++i) af[i] = *(const bf16x8*)(sa + i * 1024);
#pragma unroll
        for (int j = 0; j < 4; ++j) bfr[j] = *(const bf16x8*)(sb + j * 1024);
        __builtin_amdgcn_s_setprio(1);
#pragma unroll
        for (int i = 0; i < 8; ++i)
#pragma unroll
            for (int j = 0; j < 4; ++j) {
                if (MODE == 0) acc[i][j] = __builtin_amdgcn_mfma_f32_16x16x32_bf16(bfr[j], af[i], acc[i][j], 0, 0, 0);
                else acc[i][j] = __builtin_amdgcn_mfma_f32_16x16x32_bf16(af[i], bfr[j], acc[i][j], 0, 0, 0);
            }
        __builtin_amdgcn_s_setprio(0);
    };
    stage(0, 0);
    asm volatile("s_waitcnt vmcnt(0)" ::: "memory");
    __syncthreads();
    for (int kt = 0; kt < nk; ++kt) {
        if (kt + 1 < nk) stage(kt + 1, (kt + 1) & 1);
        compute(kt & 1);
        asm volatile("s_waitcnt vmcnt(0)" ::: "memory");
        __syncthreads();
    }
}
__device__ __forceinline__ bool tile_sched(int it, int MT, int NT, int& mt, int& nt) {
    const int xg = blockIdx.x & 7, xi = (int)(blockIdx.x >> 3) * 2 + (int)(threadIdx.x >> 8), nper = (int)(gridDim.x >> 3) * 2;
    const int li = xi + nper * it;
    if (li >= (MT >> 3) * NT) return false;
    const int band = li / (8 * NT), r = li - band * 8 * NT;
    nt = r >> 3; mt = xg * (MT >> 3) + band * 8 + (r & 7);
    return true;
}
__device__ __forceinline__ void store_bf16x4(bf16_t* p, f32x4 v) { uint2 o; o.x = pack2(v[0], v[1]); o.y = pack2(v[2], v[3]); *(uint2*)p = o; }

#define G8_LAS __attribute__((address_space(3)))
namespace g8 {
constexpr int BM = 256, BK = 64, HALF = 128, HTB = HALF * BK * 2, NXCD = 8, WGM = 8;
__device__ __forceinline__ int lds_byte(int r, int c) { const int st = (r >> 4) * 2 + (c >> 5), rr = r & 15, cc = c & 31, ob = rr * 64 + cc * 2; return st * 1024 + (ob ^ (((ob >> 9) & 1) << 5)); }
__device__ __forceinline__ void stage_rc(int b, int& R, int& C) { const int st = b / 1024, sb = b % 1024, swz = sb ^ (((sb >> 9) & 1) << 5); R = (st >> 1) * 16 + swz / 64; C = (st & 1) * 32 + (swz % 64) / 2; }
__device__ __forceinline__ int perm32(int rho) { const int n = rho >> 4, i = rho & 15; return 8 * (i >> 2) + 4 * n + (i & 3); }
struct Unit { int pm, pn; };
struct Gemm { const bf16_t* A0; const bf16_t* A1; int lda, ksplit; const bf16_t* Bt; int M, N, K; };
struct StaticOrder {
    int nM, nN, nwg, G, c;
    __device__ __forceinline__ void init(int M, int N, int G_, int c_) { nM = M / BM; nN = N / BM; nwg = nM * nN; G = G_; c = c_; }
    __device__ __forceinline__ bool next(int i, Unit& u) const {
        const int L = i * G + c; if (L >= nwg) return false;
        int wgid = L; { const int q = nwg / NXCD, r = nwg % NXCD, xcd = wgid % NXCD, off = wgid / NXCD; wgid = (xcd < r ? xcd * (q + 1) : r * (q + 1) + (xcd - r) * q) + off; }
        const int nig = WGM * nN, gid = wgid / nig, fm = gid * WGM, gsz = (nM - fm) < WGM ? (nM - fm) : WGM;
        u.pm = fm + ((wgid % nig) % gsz); u.pn = (wgid % nig) / gsz; return true;
    }
};
template <class Epi>
__device__ __forceinline__ void gemm_phase(G8_LAS unsigned char* lds, const Gemm g, const StaticOrder& S, const Epi& E) {
    const int tid = threadIdx.x, wid = __builtin_amdgcn_readfirstlane(tid >> 6), lane = tid & 63, wr = wid >> 2, wc = wid & 3, fr = lane & 15, fq = lane >> 4;
    const int K = g.K, nt = K / BK, lda = g.lda;
    unsigned voffA[2], voffB[2];
#pragma unroll
    for (int i = 0; i < 2; ++i) { int R, C; stage_rc(tid * 16 + i * 8192, R, C); const int Rb = (R & ~31) + perm32(R & 31);
        voffA[i] = (unsigned)(R * lda + C) * 2u; voffB[i] = (unsigned)(Rb * K + C) * 2u; }
    const size_t hstepA = (size_t)HALF * lda * 2, hstepB = (size_t)HALF * K * 2;
    const unsigned ldsw = (unsigned)wid * 1024u;
    const int aoff = lds_byte(wr * 64 + fr, fq * 8), boff = lds_byte(wc * 32 + fr, fq * 8);
    auto aptr = [&](int pm, int kt) -> const char* { const int kb = kt * BK; const bf16_t* b = kb < g.ksplit ? g.A0 + kb : g.A1 + (kb - g.ksplit); return (const char*)b + (size_t)pm * 2 * hstepA; };
    auto bptr = [&](int pn, int kt) -> const char* { return (const char*)(g.Bt + kt * BK) + (size_t)pn * 2 * hstepB; };
#define G8_SA(b, h) (((b) * 2 + (h)) * HTB)
#define G8_SB(b, h) ((4 + (b) * 2 + (h)) * HTB)
#define G8_STAGE(bufoff, gbase, voff) do { _Pragma("unroll") for (int _i = 0; _i < 2; ++_i) \
        __builtin_amdgcn_global_load_lds((const unsigned*)((const char*)(gbase) + (voff)[_i]), (G8_LAS unsigned*)(lds + (bufoff) + ldsw + _i * 8192), 16, 0, 0); } while (0)
#define G8_LDA(dst, b, h) do { _Pragma("unroll") for (int m = 0; m < 4; ++m) _Pragma("unroll") for (int k = 0; k < 2; ++k) dst[m][k] = *(const G8_LAS bf16x8*)(lds + G8_SA(b, h) + aoff + m * 2048 + k * 1024); } while (0)
#define G8_LDB(dst, b, h) do { _Pragma("unroll") for (int n = 0; n < 2; ++n) _Pragma("unroll") for (int k = 0; k < 2; ++k) dst[n][k] = *(const G8_LAS bf16x8*)(lds + G8_SB(b, h) + boff + n * 2048 + k * 1024); } while (0)
#define G8_MMA(ai, bj, At, Bt) do { __builtin_amdgcn_s_setprio(1); _Pragma("unroll") for (int m = 0; m < 4; ++m) _Pragma("unroll") for (int n = 0; n < 2; ++n) _Pragma("unroll") for (int k = 0; k < 2; ++k) \
        acc[ai][bj][m][n] = __builtin_amdgcn_mfma_f32_16x16x32_bf16(Bt[n][k], At[m][k], acc[ai][bj][m][n], 0, 0, 0); __builtin_amdgcn_s_setprio(0); } while (0)
#define G8_WAIT_V(n) asm volatile("s_waitcnt vmcnt(" #n ")" ::: "memory")
#define G8_WAIT_L(n) asm volatile("s_waitcnt lgkmcnt(" #n ")" ::: "memory")
#define G8_BAR __builtin_amdgcn_s_barrier()
#define G8_SCHED __builtin_amdgcn_sched_barrier(0)
    Unit cur, nxt; int ui = 0;
    if (!S.next(0, cur)) return;
    f32x4 acc[2][2][4][2];
#pragma unroll
    for (int a = 0; a < 2; ++a)
#pragma unroll
        for (int b = 0; b < 2; ++b)
#pragma unroll
            for (int m = 0; m < 4; ++m)
#pragma unroll
                for (int n = 0; n < 2; ++n) acc[a][b][m][n] = (f32x4){0.f, 0.f, 0.f, 0.f};
    bf16x8 At[4][2], B0[2][2], B1[2][2];
    {
        const char* cA = aptr(cur.pm, 0); const char* cB = bptr(cur.pn, 0); const char* cA1 = aptr(cur.pm, 1); const char* cB1 = bptr(cur.pn, 1);
        G8_STAGE(G8_SB(0, 0), cB, voffB); G8_STAGE(G8_SB(0, 1), cB + hstepB, voffB); G8_STAGE(G8_SA(0, 0), cA, voffA); G8_STAGE(G8_SA(0, 1), cA + hstepA, voffA);
        if (wr == 1) G8_BAR;
        G8_WAIT_V(2); G8_BAR;
        G8_STAGE(G8_SB(1, 0), cB1, voffB); G8_STAGE(G8_SA(1, 0), cA1, voffA); G8_STAGE(G8_SB(1, 1), cB1 + hstepB, voffB);
        G8_WAIT_V(6); G8_BAR;
    }
    for (;;) {
        const bool has_next = S.next(ui + 1, nxt);
        const int npm = has_next ? nxt.pm : cur.pm, npn = has_next ? nxt.pn : cur.pn;
        for (int t = 0; t < nt; t += 2) {
            const bool last = (t == nt - 2);
            const char* a1 = aptr(cur.pm, t + 1);
            const char* a2 = last ? aptr(npm, 0) : aptr(cur.pm, t + 2); const char* b2 = last ? bptr(npn, 0) : bptr(cur.pn, t + 2);
            const char* a3 = last ? aptr(npm, 1) : aptr(cur.pm, t + 3); const char* b3 = last ? bptr(npn, 1) : bptr(cur.pn, t + 3);
            G8_LDB(B0, 0, 0); G8_LDB(B1, 0, 1); G8_SCHED; G8_LDA(At, 0, 0); G8_STAGE(G8_SA(1, 1), a1 + hstepA, voffA);
            G8_WAIT_V(8); G8_WAIT_L(0); G8_BAR; G8_MMA(0, 0, At, B0); G8_MMA(0, 1, At, B1); G8_BAR; G8_SCHED;
            G8_LDA(At, 0, 1); G8_STAGE(G8_SB(0, 0), b2, voffB); G8_STAGE(G8_SB(0, 1), b2 + hstepB, voffB); G8_STAGE(G8_SA(0, 0), a2, voffA);
            G8_WAIT_V(8); G8_WAIT_L(0); G8_BAR; G8_MMA(1, 0, At, B0); G8_MMA(1, 1, At, B1); G8_BAR; G8_SCHED;
            G8_LDB(B0, 1, 0); G8_LDB(B1, 1, 1); G8_SCHED; G8_LDA(At, 1, 0); G8_STAGE(G8_SA(0, 1), a2 + hstepA, voffA);
            G8_WAIT_V(8); G8_WAIT_L(0); G8_BAR; G8_MMA(0, 0, At, B0); G8_MMA(0, 1, At, B1); G8_BAR; G8_SCHED;
            G8_LDA(At, 1, 1); G8_STAGE(G8_SB(1, 0), b3, voffB); G8_STAGE(G8_SB(1, 1), b3 + hstepB, voffB); G8_STAGE(G8_SA(1, 0), a3, voffA);
            G8_WAIT_V(8); G8_WAIT_L(0); G8_BAR; G8_MMA(1, 0, At, B0); G8_MMA(1, 1, At, B1); G8_BAR; G8_SCHED;
        }
        if (wr == 0) G8_BAR;
        E(acc, cur, wr, wc, fr, fq);
        if (!has_next) break;
#pragma unroll
        for (int a = 0; a < 2; ++a)
#pragma unroll
            for (int b = 0; b < 2; ++b)
#pragma unroll
                for (int m = 0; m < 4; ++m)
#pragma unroll
                    for (int n = 0; n < 2; ++n) acc[a][b][m][n] = (f32x4){0.f, 0.f, 0.f, 0.f};
        cur = nxt; ++ui;
        if (wr == 1) G8_BAR;
    }
    G8_WAIT_V(0);
    G8_BAR;
#undef G8_SA
#undef G8_SB
#undef G8_STAGE
#undef G8_LDA
#undef G8_LDB
#undef G8_MMA
#undef G8_WAIT_V
#undef G8_WAIT_L
#undef G8_BAR
#undef G8_SCHED
}
struct EpiResid {
    const float* Rs; float* O;
    __device__ __forceinline__ void operator()(const f32x4 (&acc)[2][2][4][2], const Unit& u, int wr, int wc, int fr, int fq) const {
#pragma unroll
        for (int ai = 0; ai < 2; ++ai)
#pragma unroll
            for (int m = 0; m < 4; ++m) {
                const size_t o = (size_t)(u.pm * 256 + ai * 128 + wr * 64 + m * 16 + fr) * 1024 + u.pn * 256 + wc * 32 + fq * 8;
#pragma unroll
                for (int bj = 0; bj < 2; ++bj)
#pragma unroll
                    for (int n = 0; n < 2; ++n) {
                        const f32x4 r = *(const f32x4*)(Rs + o + bj * 128 + n * 4);
                        *(f32x4*)(O + o + bj * 128 + n * 4) = r + acc[ai][bj][m][n];
                    }
            }
    }
};
struct EpiCinU {
    bf16_t* U;
    __device__ __forceinline__ void operator()(const f32x4 (&acc)[2][2][4][2], const Unit& u, int wr, int wc, int fr, int fq) const {
#pragma unroll
        for (int ai = 0; ai < 2; ++ai)
#pragma unroll
            for (int m = 0; m < 4; ++m) {
                bf16_t* rp = U + (size_t)(u.pm * 256 + ai * 128 + wr * 64 + m * 16 + fr) * 2048 + u.pn * 256 + wc * 32 + fq * 8;
#pragma unroll
                for (int bj = 0; bj < 2; ++bj) {
                    const f32x4 a = acc[ai][bj][m][0], b = acc[ai][bj][m][1];
                    uint4 o; o.x = pack2(gelu_exact(a[0]), gelu_exact(a[1])); o.y = pack2(gelu_exact(a[2]), gelu_exact(a[3]));
                    o.z = pack2(gelu_exact(b[0]), gelu_exact(b[1])); o.w = pack2(gelu_exact(b[2]), gelu_exact(b[3]));
                    *(uint4*)(rp + bj * 128) = o;
                }
            }
    }
};
struct EpiCinV {
    bf16_t* VT; float* SSQ;
    __device__ __forceinline__ void operator()(const f32x4 (&acc)[2][2][4][2], const Unit& u, int wr, int wc, int fr, int fq) const {
#pragma unroll
        for (int ai = 0; ai < 2; ++ai) {
            float ss[16];
#pragma unroll
            for (int i = 0; i < 16; ++i) ss[i] = 0.f;
#pragma unroll
            for (int m = 0; m < 4; ++m) {
                const int c = u.pm * 256 + ai * 128 + wr * 64 + m * 16 + fr;
#pragma unroll
                for (int bj = 0; bj < 2; ++bj) {
                    float g[8];
#pragma unroll
                    for (int n = 0; n < 2; ++n)
#pragma unroll
                        for (int r = 0; r < 4; ++r) { const float x = gelu_exact(acc[ai][bj][m][n][r]); g[n * 4 + r] = x; ss[bj * 8 + n * 4 + r] += x * x; }
                    uint4 o; o.x = pack2(g[0], g[1]); o.y = pack2(g[2], g[3]); o.z = pack2(g[4], g[5]); o.w = pack2(g[6], g[7]);
                    *(uint4*)(VT + ((size_t)(u.pn * 2 + bj) * 2048 + c) * 128 + wc * 32 + fq * 8) = o;
                }
            }
            float mine = 0.f;
#pragma unroll
            for (int i = 0; i < 16; ++i) { const float s = row16_sum(ss[i]); mine = (fr == i) ? s : mine; }
            const int tok = u.pn * 256 + (fr >> 3) * 128 + wc * 32 + fq * 8 + (fr & 7);
            SSQ[(size_t)tok * 32 + u.pm * 4 + ai * 2 + wr] = mine;
        }
    }
};
struct EpiInN {
    bf16_t* R;
    __device__ __forceinline__ void operator()(const f32x4 (&acc)[2][2][4][2], const Unit& u, int wr, int wc, int fr, int fq) const {
        bf16_t* base; int pitch; float sc = 1.0f;
        if (u.pn < 2) { base = R + R_QSB + u.pn * 256; pitch = 512; sc = 0.125f; }
        else if (u.pn < 4) { base = R + R_KSB + (u.pn - 2) * 256; pitch = 512; }
        else if (u.pn == 4) { base = R + R_QG; pitch = 256; }
        else if (u.pn == 5) { base = R + R_KG; pitch = 256; }
        else { base = R + R_GG + (u.pn - 6) * 256; pitch = 512; }
#pragma unroll
        for (int ai = 0; ai < 2; ++ai)
#pragma unroll
            for (int m = 0; m < 4; ++m) {
                bf16_t* rp = base + (size_t)(u.pm * 256 + ai * 128 + wr * 64 + m * 16 + fr) * pitch + wc * 32 + fq * 8;
#pragma unroll
                for (int bj = 0; bj < 2; ++bj) {
                    const f32x4 a = acc[ai][bj][m][0] * sc, b = acc[ai][bj][m][1] * sc;
                    uint4 o; o.x = pack2(a[0], a[1]); o.y = pack2(a[2], a[3]); o.z = pack2(b[0], b[1]); o.w = pack2(b[2], b[3]);
                    *(uint4*)(rp + bj * 128) = o;
                }
            }
    }
};
struct EpiInT {
    bf16_t* R;
    __device__ __forceinline__ void operator()(const f32x4 (&acc)[2][2][4][2], const Unit& u, int wr, int wc, int fr, int fq) const {
#pragma unroll
        for (int ai = 0; ai < 2; ++ai)
#pragma unroll
            for (int m = 0; m < 4; ++m) {
                const int c = u.pm * 256 + ai * 128 + wr * 64 + m * 16 + fr;
#pragma unroll
                for (int bj = 0; bj < 2; ++bj) {
                    const int t = u.pn * 256 + bj * 128 + wc * 32 + fq * 8, b = t >> 11, s = t & 2047;
                    bf16_t* dst;
                    if (c < 512) dst = R + R_VTSB + ((size_t)((b * 8 + (c >> 6)) * 64 + (c & 63))) * 2048 + s;
                    else { const int c2 = c - 512; dst = R + R_VTG + ((size_t)((b * 4 + (c2 >> 7)) * 128 + (c2 & 127))) * 2048 + s; }
                    const f32x4 a = acc[ai][bj][m][0], bb = acc[ai][bj][m][1];
                    uint4 o; o.x = pack2(a[0], a[1]); o.y = pack2(a[2], a[3]); o.z = pack2(bb[0], bb[1]); o.w = pack2(bb[2], bb[3]);
                    *(uint4*)dst = o;
                }
            }
    }
};
}
__device__ __forceinline__ void phase_gemm_resid8(const bf16_t* A0, const bf16_t* A1, int lda, int ksplit, const bf16_t* Bt, int K, const float* Rs, float* O, char* smem_phys) {
    g8::Gemm g{A0, A1, lda, ksplit, Bt, T, 1024, K};
    g8::StaticOrder S; S.init(T, 1024, (int)gridDim.x, (int)blockIdx.x);
    g8::EpiResid E{Rs, O};
    g8::gemm_phase<g8::EpiResid>((G8_LAS unsigned char*)smem_phys, g, S, E);
}

__device__ __forceinline__ void phase_gemm_cin8(const Params& p, char* smem_phys) {
    const bf16_t* H = (const bf16_t*)(p.ws + OFF_H); const bf16_t* W = (const bf16_t*)(p.ws + OFF_WT_CIN);
    bf16_t* U = (bf16_t*)(p.ws + OFF_REGION); bf16_t* VT = U + (size_t)T * 2048; float* SSQ = (float*)(p.ws + OFF_SSQ);
    {
        g8::Gemm g{H, H, 1024, 1024, W, T, 2048, 1024};
        g8::StaticOrder S; S.init(T, 2048, (int)gridDim.x, (int)blockIdx.x);
        g8::EpiCinU E{U};
        g8::gemm_phase<g8::EpiCinU>((G8_LAS unsigned char*)smem_phys, g, S, E);
    }
    {
        const bf16_t* Wv = W + (size_t)2048 * 1024;
        g8::Gemm g{Wv, Wv, 1024, 1024, H, 2048, T, 1024};
        g8::StaticOrder S; S.init(2048, T, (int)gridDim.x, (int)blockIdx.x);
        g8::EpiCinV E{VT, SSQ};
        g8::gemm_phase<g8::EpiCinV>((G8_LAS unsigned char*)smem_phys, g, S, E);
    }
}
__device__ __forceinline__ void phase_gemm_in8(const Params& p, char* smem_phys) {
    const bf16_t* H = (const bf16_t*)(p.ws + OFF_H); const bf16_t* W = (const bf16_t*)(p.ws + OFF_WT_IN);
    bf16_t* R = (bf16_t*)(p.ws + OFF_REGION);
    {
        g8::Gemm g{H, H, 1024, 1024, W, T, 2048, 1024};
        g8::StaticOrder S; S.init(T, 2048, (int)gridDim.x, (int)blockIdx.x);
        g8::EpiInN E{R};
        g8::gemm_phase<g8::EpiInN>((G8_LAS unsigned char*)smem_phys, g, S, E);
    }
    {
        const bf16_t* Wv = W + (size_t)2048 * 1024;
        g8::Gemm g{Wv, Wv, 1024, 1024, H, 1024, T, 1024};
        g8::StaticOrder S; S.init(1024, T, (int)gridDim.x, (int)blockIdx.x);
        g8::EpiInT E{R};
        g8::gemm_phase<g8::EpiInT>((G8_LAS unsigned char*)smem_phys, g, S, E);
    }
    {
        const int lane = threadIdx.x & 63, wid = threadIdx.x >> 6, fr = lane & 15, fq = lane >> 4;
        float* ALR = (float*)(R + R_ALR);
        for (int task = (int)blockIdx.x * 8 + wid; task < T / 16; task += (int)gridDim.x * 8) {
            const bf16_t* a = H + (size_t)(task * 16 + fr) * 1024 + fq * 8; const bf16_t* w = W + (size_t)(3072 + fr) * 1024 + fq * 8;
            f32x4 acc = (f32x4){0.f, 0.f, 0.f, 0.f};
#pragma unroll 8
            for (int kk = 0; kk < 32; ++kk) {
                const bf16x8 af = *(const bf16x8*)(a + kk * 32), wf = *(const bf16x8*)(w + kk * 32);
                acc = __builtin_amdgcn_mfma_f32_16x16x32_bf16(wf, af, acc, 0, 0, 0);
            }
            *(f32x4*)(ALR + (size_t)(task * 16 + fr) * 16 + fq * 4) = acc;
        }
    }
}

__device__ __forceinline__ void phase_gemm_in(const Params& p, char* smem) {
    const bf16_t* A = (const bf16_t*)(p.ws + OFF_H); const bf16_t* Bt = (const bf16_t*)(p.ws + OFF_WT_IN);
    bf16_t* R = (bf16_t*)(p.ws + OFF_REGION);
    const int lane = VTID & 63, wid = VTID >> 6, wm = wid >> 1, wn = wid & 1;
    constexpr int NT = AB_IN_PAD / 128, MT = T / 128;
    int mt_, nt_;
    for (int it = 0; tile_sched(it, MT, NT, mt_, nt_); ++it) {
        const int m0 = mt_ * 128, n0 = nt_ * 128;
        f32x4 acc[4][4];
        const bool tr = (n0 >= 1024 && n0 < 1536) || (n0 >= 2048 && n0 < 2560);
        if (!tr) {
            gemm_mainloop<0>(A, A, 1024, 1024, Bt, 1024, m0, n0, acc, smem);
#pragma unroll
            for (int i = 0; i < 4; ++i)
#pragma unroll
                for (int j = 0; j < 4; ++j) {
                    const int m = m0 + wm * 64 + i * 16 + (lane & 15), n = n0 + wn * 64 + j * 16 + 4 * (lane >> 4);
                    const f32x4 v = acc[i][j];
                    if (n < 512) store_bf16x4(R + R_QSB + (size_t)m * 512 + n, v * 0.125f);
                    else if (n < 1024) store_bf16x4(R + R_KSB + (size_t)m * 512 + (n - 512), v);
                    else if (n < 1792) store_bf16x4(R + R_QG + (size_t)m * 256 + (n - 1536), v);
                    else if (n < 2048) store_bf16x4(R + R_KG + (size_t)m * 256 + (n - 1792), v);
                    else if (n < 3072) store_bf16x4(R + R_GG + (size_t)m * 512 + (n - 2560), v);
                    else if (n < AB_IN) *(f32x4*)((float*)(R + R_ALR) + (size_t)m * 16 + (n - 3072)) = v;
                }
        } else {
            gemm_mainloop<1>(A, A, 1024, 1024, Bt, 1024, m0, n0, acc, smem);
#pragma unroll
            for (int i = 0; i < 4; ++i)
#pragma unroll
                for (int j = 0; j < 4; ++j) {
                    const int m = m0 + wm * 64 + i * 16 + 4 * (lane >> 4), n = n0 + wn * 64 + j * 16 + (lane & 15);
                    const int b = m >> 11, s = m & 2047;
                    if (n < 1536) { const int c = n - 1024, hh = c >> 6, e = c & 63; store_bf16x4(R + R_VTSB + ((size_t)((b * 8 + hh) * 64 + e)) * 2048 + s, acc[i][j]); }
                    else { const int c = n - 2048, hh = c >> 7, e = c & 127; store_bf16x4(R + R_VTG + ((size_t)((b * 4 + hh) * 128 + e)) * 2048 + s, acc[i][j]); }
                }
        }
    }
}
__device__ __forceinline__ void phase_gemm_resid(const bf16_t* A0, const bf16_t* A1, int lda, int ksplit, const bf16_t* Bt, int K, const float* Rs, float* O, char* smem) {
    const int lane = VTID & 63, wid = VTID >> 6, wm = wid >> 1, wn = wid & 1;
    constexpr int NT = 8, MT = T / 256;
    int mt_, nt_;
    for (int it = 0; tile_sched(it, MT, NT, mt_, nt_); ++it) {
        const int m0 = mt_ * 256, n0 = nt_ * 128;
        f32x4 acc[8][4];
        gemm_mainloop256<0>(A0, A1, lda, ksplit, Bt, K, m0, n0, acc, smem);
#pragma unroll
        for (int i = 0; i < 8; ++i)
#pragma unroll
            for (int j = 0; j < 4; ++j) {
                const int m = m0 + wm * 128 + i * 16 + (lane & 15), n = n0 + wn * 64 + j * 16 + 4 * (lane >> 4);
                const f32x4 r = *(const f32x4*)(Rs + (size_t)m * 1024 + n);
                *(f32x4*)(O + (size_t)m * 1024 + n) = r + acc[i][j];
            }
    }
}
__device__ __forceinline__ void phase_gemm_cin(const Params& p, char* smem) {
    const bf16_t* A = (const bf16_t*)(p.ws + OFF_H); const bf16_t* Bt = (const bf16_t*)(p.ws + OFF_WT_CIN);
    bf16_t* U = (bf16_t*)(p.ws + OFF_REGION); bf16_t* VT = U + (size_t)T * 2048; float* SSQ = (float*)(p.ws + OFF_SSQ);
    const int lane = VTID & 63, wid = VTID >> 6, wm = wid >> 1, wn = wid & 1;
    constexpr int NT = 32, MT = T / 128;
    int mt_, nt_;
    for (int it = 0; tile_sched(it, MT, NT, mt_, nt_); ++it) {
        const int m0 = mt_ * 128, n0 = nt_ * 128;
        f32x4 acc[4][4];
        if (n0 < 2048) {
            gemm_mainloop<0>(A, A, 1024, 1024, Bt, 1024, m0, n0, acc, smem);
#pragma unroll
            for (int i = 0; i < 4; ++i)
#pragma unroll
                for (int j = 0; j < 4; ++j) {
                    const int m = m0 + wm * 64 + i * 16 + (lane & 15), n = n0 + wn * 64 + j * 16 + 4 * (lane >> 4);
                    f32x4 v = acc[i][j];
#pragma unroll
                    for (int r = 0; r < 4; ++r) v[r] = gelu_exact(v[r]);
                    store_bf16x4(U + (size_t)m * 2048 + n, v);
                }
        } else {
            gemm_mainloop<1>(A, A, 1024, 1024, Bt, 1024, m0, n0, acc, smem);
#pragma unroll
            for (int i = 0; i < 4; ++i) {
                float ss[4] = {0.f, 0.f, 0.f, 0.f};
#pragma unroll
                for (int j = 0; j < 4; ++j) {
                    const int m = m0 + wm * 64 + i * 16 + 4 * (lane >> 4), n = n0 + wn * 64 + j * 16 + (lane & 15);
                    f32x4 v = acc[i][j];
#pragma unroll
                    for (int r = 0; r < 4; ++r) { v[r] = gelu_exact(v[r]); ss[r] += v[r] * v[r]; }
                    const int chunk = m >> 7, s = m & 127, c = n - 2048;
                    store_bf16x4(VT + ((size_t)chunk * 2048 + c) * 128 + s, v);
                }
#pragma unroll
                for (int r = 0; r < 4; ++r) {
                    float v = ss[r];
                    v += __shfl_xor(v, 1); v += __shfl_xor(v, 2); v += __shfl_xor(v, 4); v += __shfl_xor(v, 8);
                    if ((lane & 15) == 0) { const int m = m0 + wm * 64 + i * 16 + 4 * (lane >> 4) + r; SSQ[(size_t)m * 32 + ((n0 - 2048) >> 6) + wn] = v; }
                }
            }
        }
    }
}

typedef float f32x16 __attribute__((ext_vector_type(16)));
__device__ __forceinline__ void sb_fast(const Params& p, char* smem, unsigned* ctr) {
    bf16_t* R = (bf16_t*)(p.ws + OFF_REGION);
    char* KT = smem; char* VTt = smem + 8192;
    volatile int* flags = (volatile int*)(smem + 32768); volatile unsigned* slot = (volatile unsigned*)(smem + 32832);
    const int tid = threadIdx.x, lane = tid & 63, w = tid >> 6, r31 = lane & 31, h = lane >> 5;
    for (;;) {
        __syncthreads();
        if (tid == 0) *slot = atomicAdd(ctr, 1u);
        __syncthreads();
        const unsigned task = *slot;
        if (task >= 1024u) break;
        const int qblk = 7 - (int)(task >> 7), bh = task & 127, b = bh >> 3, hh = bh & 7;
        const int q0 = qblk * 256, qbase = q0 + 32 * w;
        bf16_t* qrow = R + R_QSB + (size_t)(b * 2048 + qbase + r31) * 512 + hh * 64;
        bf16x8 qf[4];
#pragma unroll
        for (int kk = 0; kk < 4; ++kk) qf[kk] = *(const bf16x8*)(qrow + 16 * kk + 8 * h);
        f32x16 oacc[2];
#pragma unroll
        for (int nt = 0; nt < 2; ++nt)
#pragma unroll
            for (int i = 0; i < 16; ++i) oacc[nt][i] = 0.f;
        float Rr = 1.0f;
        const int t = qbase + r31;
        for (int kt = q0 / 64 + 3; kt >= 0; --kt) {
            __syncthreads();
            { const int wd = __all(Rr == 0.f); if (lane == 0) flags[w] = wd; }
            __syncthreads();
            if (flags[0] & flags[1] & flags[2] & flags[3] & flags[4] & flags[5] & flags[6] & flags[7]) break;
            const int s_tile = kt * 64;
            {
                const int c = tid, row = c >> 3, ch = c & 7;
                const u32x4 kv = *(const u32x4*)(R + R_KSB + (size_t)(b * 2048 + s_tile + row) * 512 + hh * 64 + ch * 8);
                const u32x4 vv = *(const u32x4*)(R + R_VTSB + ((size_t)((b * 8 + hh) * 64 + row)) * 2048 + s_tile + ch * 8);
                *(u32x4*)(KT + row * 128 + ((ch ^ (row & 7)) << 4)) = kv;
                *(uint2*)(VTt + row * 136 + ch * 16) = make_uint2(vv[0], vv[1]);
                *(uint2*)(VTt + row * 136 + ch * 16 + 8) = make_uint2(vv[2], vv[3]);
            }
            __syncthreads();
#pragma unroll
            for (int sbk = 1; sbk >= 0; --sbk) {
                const int key_lo = s_tile + 32 * sbk;
                if (key_lo >= qbase + 31) continue;
                if (__all(Rr == 0.f)) continue;
                f32x16 st;
#pragma unroll
                for (int i = 0; i < 16; ++i) st[i] = 0.f;
                const int krow = 32 * sbk + r31;
#pragma unroll
                for (int kk = 0; kk < 4; ++kk) {
                    const bf16x8 kf = *(const bf16x8*)(KT + krow * 128 + (((2 * kk + h) ^ (krow & 7)) << 4));
                    st = __builtin_amdgcn_mfma_f32_32x32x16_bf16(kf, qf[kk], st, 0, 0, 0);
                }
                float a[16], G[4];
#pragma unroll
                for (int g = 0; g < 4; ++g) {
                    float sg[4], m[4];
#pragma unroll
                    for (int i = 0; i < 4; ++i) {
                        const int s = key_lo + 8 * g + 4 * h + i;
                        const float z = fminf(fmaxf(st[4 * g + i], -80.f), 80.f);
                        const float ez = __expf(-z), sig = 1.0f / (1.0f + ez);
                        const bool valid = s < t;
                        sg[i] = valid ? sig : 0.f; m[i] = valid ? ez * sig : 1.0f;
                    }
                    const float x2 = m[3], x1 = x2 * m[2], x0 = x1 * m[1];
                    G[g] = x0 * m[0];
                    a[4 * g + 3] = sg[3]; a[4 * g + 2] = sg[2] * x2; a[4 * g + 1] = sg[1] * x1; a[4 * g] = sg[0] * x0;
                }
                float Go[4], P[4];
#pragma unroll
                for (int g = 0; g < 4; ++g) { Go[g] = __shfl_xor(G[g], 32); P[g] = G[g] * Go[g]; }
                const float c2 = P[3], c1 = c2 * P[2], c0 = c1 * P[1];
                float Tg[4];
                Tg[3] = Rr; Tg[2] = Rr * c2; Tg[1] = Rr * c1; Tg[0] = Rr * c0;
#pragma unroll
                for (int g = 0; g < 4; ++g) {
                    const float tg = (h == 0) ? Tg[g] * Go[g] : Tg[g];
                    a[4 * g] *= tg; a[4 * g + 1] *= tg; a[4 * g + 2] *= tg; a[4 * g + 3] *= tg;
                }
                Rr = Rr * c0 * P[0];
#pragma unroll
                for (int s2 = 0; s2 < 2; ++s2) {
                    union { bf16x8 v; unsigned u[4]; } af;
#pragma unroll
                    for (int j2 = 0; j2 < 4; ++j2) af.u[j2] = pack2(a[8 * s2 + 2 * j2], a[8 * s2 + 2 * j2 + 1]);
#pragma unroll
                    for (int nt = 0; nt < 2; ++nt) {
                        const char* vp = VTt + (32 * nt + r31) * 136 + 64 * sbk + 32 * s2 + 8 * h;
                        union { bf16x8 v; uint2 hh2[2]; } vf;
                        vf.hh2[0] = *(const uint2*)vp; vf.hh2[1] = *(const uint2*)(vp + 16);
                        oacc[nt] = __builtin_amdgcn_mfma_f32_32x32x16_bf16(af.v, vf.v, oacc[nt], 0, 0, 0);
                    }
                }
            }
        }
#pragma unroll
        for (int nt = 0; nt < 2; ++nt)
#pragma unroll
            for (int i = 0; i < 16; ++i) {
                const int qq = (i & 3) + 8 * (i >> 2) + 4 * h;
                R[R_QSB + (size_t)(b * 2048 + qbase + qq) * 512 + hh * 64 + 32 * nt + r31] = f2bf(oacc[nt][i]);
            }
    }
}
__device__ __forceinline__ float log_sigmoid(float x) { return fminf(x, 0.f) - log1pf(__expf(-fabsf(x))); }
__device__ __forceinline__ int swz(int row, int chunk) { return row * 128 + ((chunk ^ (row & 7)) << 4); }
__device__ __forceinline__ void gla_prep(const Params& p, char* smem) {
    bf16_t* R = (bf16_t*)(p.ws + OFF_REGION);
    const float* ALR = (const float*)(R + R_ALR);
    bf16_t* KOTg = R + R_KOT; float* DECg = (float*)(R + R_DEC);
    float* SEG = (float*)smem; float* ALRs = SEG + 256;
    const int tid = VTID, d = tid & 63, w = tid >> 6;
    for (int task = VBID; task < 2048; task += VGRID) {
        const int bh = task >> 5, c = task & 31, b = bh >> 2, hh = bh & 3;
        const size_t rowbase = (size_t)b * 2048 + c * 64;
        unsigned qr[16], kr[16];
#pragma unroll
        for (int i = 0; i < 16; ++i) { const size_t row = rowbase + w * 16 + i; qr[i] = R[R_QG + row * 256 + hh * 64 + d]; kr[i] = R[R_KG + row * 256 + hh * 64 + d]; }
        const f32x4 ar = *(const f32x4*)(ALR + rowbase * 16 + tid * 4);
        float w2r[16];
#pragma unroll
        for (int r = 0; r < 16; ++r) w2r[r] = p.ab_w_alpha2[r * 256 + hh * 64 + d];
        const float b2r = p.ab_b_alpha2[hh * 64 + d];
        __syncthreads();
        *(f32x4*)(ALRs + tid * 4) = ar;
        __syncthreads();
        float cs[16]; float run = 0.f;
#pragma unroll
        for (int i = 0; i < 16; ++i) {
            const float* al = ALRs + (w * 16 + i) * 16;
            float pre = b2r;
#pragma unroll
            for (int r = 0; r < 16; ++r) pre += al[r] * w2r[r];
            run += log_sigmoid(pre) * (1.0f / 16.0f);
            cs[i] = run;
        }
        SEG[w * 64 + d] = run;
        __syncthreads();
        float off = 0.f, tot = 0.f;
#pragma unroll
        for (int w2 = 0; w2 < 4; ++w2) { const float s = SEG[w2 * 64 + d]; tot += s; if (w2 < w) off += s; }
        unsigned kop[8];
#pragma unroll
        for (int i2 = 0; i2 < 8; ++i2) {
            float kov[2];
#pragma unroll
            for (int u = 0; u < 2; ++u) {
                const int i = 2 * i2 + u;
                const float bc = off + cs[i];
                const float kv = bf2f((bf16_t)kr[i]);
                const size_t row = rowbase + w * 16 + i;
                R[R_QG + row * 256 + hh * 64 + d] = f2bf(bf2f((bf16_t)qr[i]) * 0.125f * __expf(bc));
                R[R_KG + row * 256 + hh * 64 + d] = f2bf(kv * __expf(-bc));
                kov[u] = kv * __expf(tot - bc);
            }
            kop[i2] = pack2(kov[0], kov[1]);
        }
        bf16_t* kp = KOTg + ((size_t)task * 64 + d) * 64 + w * 16;
        *(uint4*)kp = make_uint4(kop[0], kop[1], kop[2], kop[3]);
        *(uint4*)(kp + 8) = make_uint4(kop[4], kop[5], kop[6], kop[7]);
        if (w == 0) DECg[(size_t)task * 64 + d] = __expf(tot);
    }
}
__device__ __forceinline__ void gla_scan(const Params& p, char* smem, bool dry = false) {
    bf16_t* R = (bf16_t*)(p.ws + OFF_REGION);
    const bf16_t* KOTg = R + R_KOT; const float* DECg = (const float*)(R + R_DEC);
    char* QS = smem; char* KS = smem + 8192; char* KOT = smem + 16384; char* VTs = smem + 24576; char* SPT = smem + 40960;
    float* DEC = (float*)(smem + 57344); float* GN = DEC + 64;
    const int tid = VTID, lane = tid & 63, w = tid >> 6, l15_ = lane & 15, q4 = lane >> 4;
    for (int task = VBID; task < 64; task += VGRID) {
        const int b = task >> 2, hh = task & 3;
        f32x4 Sacc[8];
#pragma unroll
        for (int nt = 0; nt < 8; ++nt) Sacc[nt] = (f32x4){0.f, 0.f, 0.f, 0.f};
        __syncthreads();
        for (int i = tid; i < 1024; i += 256) *(uint4*)(SPT + i * 16) = make_uint4(0, 0, 0, 0);
        if (tid < 128) GN[tid] = p.ab_gla_norm[hh * 128 + tid];
        const size_t rowbase = (size_t)b * 2048;
        const bf16_t* vbase = R + R_VTG + ((size_t)((b * 4 + hh) * 128)) * 2048;
        u32x4 tq[2], tk[2], tko[2], vr[4]; float td = 0.f;
        auto prefetch = [&](int c) {
            const int t0 = c * 64;
#pragma unroll
            for (int i = 0; i < 2; ++i) {
                const int cid = tid + 256 * i, row = cid >> 3, ch = cid & 7;
                tq[i] = *(const u32x4*)(R + R_QG + (rowbase + t0 + row) * 256 + hh * 64 + ch * 8);
                tk[i] = *(const u32x4*)(R + R_KG + (rowbase + t0 + row) * 256 + hh * 64 + ch * 8);
                tko[i] = *(const u32x4*)(KOTg + (((size_t)task * 32 + c) * 64 + row) * 64 + ch * 8);
            }
#pragma unroll
            for (int i = 0; i < 4; ++i) { const int cid = tid + 256 * i, e = cid >> 3, ch = cid & 7; vr[i] = *(const u32x4*)(vbase + (size_t)e * 2048 + t0 + ch * 8); }
            if (tid < 64) td = DECg[((size_t)task * 32 + c) * 64 + tid];
        };
        prefetch(0);
        for (int c = 0; c < 32; ++c) {
            int lz = 0; asm volatile("" : "+v"(lz));
            const int l15 = l15_ + lz;
            const int cx = (q4 ^ (l15 & 7)) << 4;
            const int rb0 = l15 * 128 + cx, rb1 = l15 * 128 + (cx ^ 64);
#pragma unroll
            for (int i = 0; i < 2; ++i) {
                const int cid = tid + 256 * i + lz, row = cid >> 3, ch = cid & 7;
                *(u32x4*)(QS + swz(row, ch)) = tq[i]; *(u32x4*)(KS + swz(row, ch)) = tk[i]; *(u32x4*)(KOT + swz(row, ch)) = tko[i];
            }
#pragma unroll
            for (int i = 0; i < 4; ++i) { const int cid = tid + 256 * i + lz, e = cid >> 3, ch = cid & 7; *(u32x4*)(VTs + swz(e, ch)) = vr[i]; }
            if (tid < 64) DEC[tid] = td;
            uint2 gr[8];
            const unsigned goff = (unsigned)((rowbase + c * 64 + 16 * w + l15) * 512 + hh * 128 + 4 * q4);
            bf16_t* const gbase = R + R_GG;
#pragma unroll
            for (int nt = 0; nt < 8; ++nt) gr[nt] = *(const uint2*)(gbase + (goff + 16 * nt));
            if (c + 1 < 32) prefetch(c + 1);
            __syncthreads();
            bf16x8 qf[2];
#pragma unroll
            for (int kk = 0; kk < 2; ++kk) qf[kk] = *(const bf16x8*)(QS + w * 2048 + (kk ? rb1 : rb0));
            f32x4 sT[4];
#pragma unroll
            for (int st = 0; st < 4; ++st) {
                sT[st] = (f32x4){0.f, 0.f, 0.f, 0.f};
                if (st <= w) {
#pragma unroll
                    for (int kk = 0; kk < 2; ++kk) { const bf16x8 kf = *(const bf16x8*)(KS + st * 2048 + (kk ? rb1 : rb0)); sT[st] = __builtin_amdgcn_mfma_f32_16x16x32_bf16(kf, qf[kk], sT[st], 0, 0, 0); }
#pragma unroll
                    for (int r = 0; r < 4; ++r) if (16 * st + 4 * q4 + r > 16 * w + l15) sT[st][r] = 0.f;
                }
            }
            bf16x8 af[2];
#pragma unroll
            for (int ks2 = 0; ks2 < 2; ++ks2) {
                union { bf16x8 v; unsigned u[4]; } cv;
                cv.u[0] = pack2(sT[2 * ks2][0], sT[2 * ks2][1]); cv.u[1] = pack2(sT[2 * ks2][2], sT[2 * ks2][3]);
                cv.u[2] = pack2(sT[2 * ks2 + 1][0], sT[2 * ks2 + 1][1]); cv.u[3] = pack2(sT[2 * ks2 + 1][2], sT[2 * ks2 + 1][3]);
                af[ks2] = cv.v;
            }
            const int vb = l15 * 128 + ((((q4 >> 1) ^ (l15 & 7)) << 4) | ((q4 & 1) * 8));
            f32x4 o[8];
#pragma unroll
            for (int nt = 0; nt < 8; ++nt) {
                o[nt] = (f32x4){0.f, 0.f, 0.f, 0.f};
                const int e = 16 * nt + l15;
#pragma unroll
                for (int kk = 0; kk < 2; ++kk) { const bf16x8 sf = *(const bf16x8*)(SPT + nt * 2048 + (kk ? rb1 : rb0)); o[nt] = __builtin_amdgcn_mfma_f32_16x16x32_bf16(sf, qf[kk], o[nt], 0, 0, 0); }
#pragma unroll
                for (int ks2 = 0; ks2 < 2; ++ks2) {
                    if (2 * ks2 <= w) {
                        union { bf16x8 v; uint2 h[2]; } cv;
                        cv.h[0] = *(const uint2*)(VTs + nt * 2048 + (vb ^ (ks2 * 64)));
                        cv.h[1] = *(const uint2*)(VTs + nt * 2048 + (vb ^ (ks2 * 64) ^ 32));
                        o[nt] = __builtin_amdgcn_mfma_f32_16x16x32_bf16(cv.v, af[ks2], o[nt], 0, 0, 0);
                    }
                }
            }
            {
                const float4 dc = *(const float4*)(DEC + 16 * w + 4 * q4);
                bf16x8 kof[2];
#pragma unroll
                for (int kk = 0; kk < 2; ++kk) kof[kk] = *(const bf16x8*)(KOT + w * 2048 + (kk ? rb1 : rb0));
#pragma unroll
                for (int nt = 0; nt < 8; ++nt) {
                    Sacc[nt][0] *= dc.x; Sacc[nt][1] *= dc.y; Sacc[nt][2] *= dc.z; Sacc[nt][3] *= dc.w;
#pragma unroll
                    for (int kk = 0; kk < 2; ++kk) { const bf16x8 vf = *(const bf16x8*)(VTs + nt * 2048 + (kk ? rb1 : rb0)); Sacc[nt] = __builtin_amdgcn_mfma_f32_16x16x32_bf16(kof[kk], vf, Sacc[nt], 0, 0, 0); }
                }
            }
            __syncthreads();
#pragma unroll
            for (int nt = 0; nt < 8; ++nt) {
                const int e = 16 * nt + l15;
                uint2 pk; pk.x = pack2(Sacc[nt][0], Sacc[nt][1]); pk.y = pack2(Sacc[nt][2], Sacc[nt][3]);
                *(uint2*)(SPT + nt * 2048 + l15 * 128 + (((2 * w + (q4 >> 1)) ^ (l15 & 7)) << 4) + (q4 & 1) * 8) = pk;
            }
            float ssq = 0.f;
#pragma unroll
            for (int nt = 0; nt < 8; ++nt) ssq += (o[nt][0] * o[nt][0] + o[nt][1] * o[nt][1]) + (o[nt][2] * o[nt][2] + o[nt][3] * o[nt][3]);
            ssq += __shfl_xor(ssq, 16); ssq += __shfl_xor(ssq, 32);
            const float rsd = rsqrtf(ssq * (1.0f / 128.0f) + EPS);
#pragma unroll
            for (int nt = 0; nt < 8; ++nt) {
                asm volatile("" ::: "memory");
                const f32x4 gn = *(const f32x4*)(GN + 16 * nt + 4 * q4);
                const float g0 = lo2f(gr[nt].x), g1 = hi2f(gr[nt].x), g2 = lo2f(gr[nt].y), g3 = hi2f(gr[nt].y);
                uint2 ov;
                ov.x = pack2(o[nt][0] * rsd * gn[0] * (g0 / (1.0f + __expf(-g0))), o[nt][1] * rsd * gn[1] * (g1 / (1.0f + __expf(-g1))));
                ov.y = pack2(o[nt][2] * rsd * gn[2] * (g2 / (1.0f + __expf(-g2))), o[nt][3] * rsd * gn[3] * (g3 / (1.0f + __expf(-g3))));
                if (!dry || ov.x == 0x7fc17fc1u) *(uint2*)(gbase + (goff + 16 * nt)) = ov;
            }
        }
    }
}

__device__ __forceinline__ unsigned ord_key(float f) { const unsigned u = __float_as_uint(f); return (u & 0x80000000u) ? ~u : (u | 0x80000000u); }
__device__ __forceinline__ float unord_key(unsigned k) { return __uint_as_float((k & 0x80000000u) ? (k & 0x7fffffffu) : ~k); }
__device__ __forceinline__ void ce_desc(unsigned& a, unsigned& b) { const unsigned hi = max(a, b), lo = min(a, b); a = hi; b = lo; }
__device__ __forceinline__ void bitonic_sort16_desc(unsigned (&a)[16]) {
#pragma unroll
    for (int k = 2; k <= 16; k <<= 1)
#pragma unroll
        for (int j = k >> 1; j > 0; j >>= 1)
#pragma unroll
            for (int i = 0; i < 16; ++i) { const int l = i ^ j; if (l > i) { if ((i & k) == 0) ce_desc(a[i], a[l]); else ce_desc(a[l], a[i]); } }
}
__device__ __forceinline__ void merge_top16(unsigned (&L)[16], const unsigned (&B)[16]) {
#pragma unroll
    for (int i = 0; i < 16; ++i) L[i] = max(L[i], B[15 - i]);
#pragma unroll
    for (int j = 8; j > 0; j >>= 1)
#pragma unroll
        for (int i = 0; i < 16; ++i) { const int l = i ^ j; if (l > i) ce_desc(L[i], L[l]); }
}
__device__ constexpr int cand_i(int n) { int c = 0; for (int i = 0; i < 16; ++i) for (int j = 0; j < 16; ++j) if ((i + 1) * (j + 1) <= 16) { if (c == n) return i; ++c; } return -1; }
__device__ constexpr int cand_j(int n) { int c = 0; for (int i = 0; i < 16; ++i) for (int j = 0; j < 16; ++j) if ((i + 1) * (j + 1) <= 16) { if (c == n) return j; ++c; } return -1; }
template <int N> struct CandTab { int i[N], j[N]; constexpr CandTab() : i(), j() { for (int n = 0; n < N; ++n) { i[n] = cand_i(n); j[n] = cand_j(n); } } };
__device__ __forceinline__ void peer_select_fast(const Params& p, int layer, char* smem) {
    const bf16_t* A = (const bf16_t*)(p.ws + OFF_H);
    const bf16_t* Bt = (const bf16_t*)(p.ws + OFF_WT_Q) + (size_t)layer * 2048 * 1024;
    const bf16_t* SK = (const bf16_t*)(p.ws + OFF_SK) + (size_t)layer * 8 * 2 * 128 * 128;
    unsigned short* IDX = (unsigned short*)(p.ws + OFF_IDX); float* GATE = (float*)(p.ws + OFF_GATE);
    const int tid_ = VTID;
    float* SC = (float*)smem; unsigned* XCH = (unsigned*)smem;
    int mt_, hh;
    for (int it = 0; tile_sched(it, T / 128, 8, mt_, hh); ++it) {
        const int m0 = mt_ * 128;
        unsigned L0[16], L1[16];
#pragma unroll
        for (int pp = 0; pp < 2; ++pp) {
            f32x4 acc[4][4];
            gemm_mainloop<0>(A, A, 1024, 1024, Bt, 1024, m0, hh * 256 + pp * 128, acc, smem);
            int lz = 0; asm volatile("" : "+v"(lz));
            const int tid = tid_ + lz, lane = tid & 63, wid = tid >> 6, wm = wid >> 1, wn = wid & 1, l15 = lane & 15, q4 = lane >> 4, token = tid & 127, half = tid >> 7;
#pragma unroll
            for (int i = 0; i < 4; ++i)
#pragma unroll
                for (int j = 0; j < 4; ++j) {
                    const int row = wm * 64 + i * 16 + l15, chunk = 2 * j + (q4 >> 1);
                    uint2 o; o.x = pack2(acc[i][j][0], acc[i][j][1]); o.y = pack2(acc[i][j][2], acc[i][j][3]);
                    *(uint2*)(smem + wn * 32768 + row * 128 + ((chunk ^ (row & 7)) << 4) + (q4 & 1) * 8) = o;
                }
            const bf16_t* SKp = SK + (size_t)((hh * 2 + pp) * 128) * 128;
#pragma unroll
            for (int i = 0; i < 8; ++i) {
                const int c = tid + 256 * i, row = c >> 4, ch16 = c & 15, ks = ch16 >> 3, ch = ch16 & 7;
                *(uint4*)(smem + ks * 32768 + 16384 + row * 128 + ((ch ^ (row & 7)) << 4)) = *(const uint4*)(SKp + (size_t)row * 128 + ch16 * 8);
            }
            __syncthreads();
#pragma unroll
            for (int i = 0; i < 4; ++i)
#pragma unroll
                for (int j = 0; j < 4; ++j) acc[i][j] = (f32x4){0.f, 0.f, 0.f, 0.f};
#pragma unroll
            for (int kt = 0; kt < 2; ++kt) {
                const char* sa = smem + kt * 32768; const char* sb = sa + 16384;
#pragma unroll
                for (int ks = 0; ks < 2; ++ks) {
                    bf16x8 af[4], bfr[4];
                    const int ch = ks * 4 + q4;
#pragma unroll
                    for (int i = 0; i < 4; ++i) { const int row = wm * 64 + i * 16 + l15; af[i] = *(const bf16x8*)(sa + row * 128 + ((ch ^ (row & 7)) << 4)); }
#pragma unroll
                    for (int j = 0; j < 4; ++j) { const int row = wn * 64 + j * 16 + l15; bfr[j] = *(const bf16x8*)(sb + row * 128 + ((ch ^ (row & 7)) << 4)); }
#pragma unroll
                    for (int i = 0; i < 4; ++i)
#pragma unroll
                        for (int j = 0; j < 4; ++j) acc[i][j] = __builtin_amdgcn_mfma_f32_16x16x32_bf16(bfr[j], af[i], acc[i][j], 0, 0, 0);
                }
            }
            __syncthreads();
#pragma unroll
            for (int i = 0; i < 4; ++i)
#pragma unroll
                for (int j = 0; j < 4; ++j) {
                    const int m = wm * 64 + i * 16 + l15, n = wn * 64 + j * 16 + 4 * q4;
#pragma unroll
                    for (int r = 0; r < 4; ++r) SC[m * 128 + ((n + r) ^ (m & 31))] = acc[i][j][r];
                }
            __syncthreads();
            unsigned L[16];
            {
                const float* srow = SC + token * 128 + half * 64; const int x = token & 31;
#pragma unroll
                for (int ch = 0; ch < 4; ++ch) {
                    unsigned Cc[16];
#pragma unroll
                    for (int i = 0; i < 16; ++i) { const int c = ch * 16 + i; Cc[i] = (ord_key(srow[c ^ x]) & ~127u) | (unsigned)(127 - (half * 64 + c)); }
                    bitonic_sort16_desc(Cc);
                    if (ch == 0) {
#pragma unroll
                        for (int i = 0; i < 16; ++i) L[i] = Cc[i];
                    } else merge_top16(L, Cc);
                }
            }
            __syncthreads();
            if (half == 1) {
#pragma unroll
                for (int i = 0; i < 16; ++i) XCH[token * 17 + i] = L[i];
            }
            __syncthreads();
            if (half == 0) {
                unsigned Xc[16];
#pragma unroll
                for (int i = 0; i < 16; ++i) Xc[i] = XCH[token * 17 + i];
                merge_top16(L, Xc);
            }
#pragma unroll
            for (int i = 0; i < 16; ++i) { if (pp == 0) L0[i] = L[i]; else L1[i] = L[i]; }
            __syncthreads();
        }
        unsigned* NIDX = (unsigned*)smem;
        const int token = tid_ & 127, half = tid_ >> 7;
        if (half == 0) {
            float s0[16], s1[16];
#pragma unroll
            for (int i = 0; i < 16; ++i) { s0[i] = unord_key(L0[i] & ~127u); s1[i] = unord_key(L1[i] & ~127u); }
            constexpr CandTab<64> ct{};
            unsigned C[16];
#pragma unroll
            for (int ch = 0; ch < 4; ++ch) {
                unsigned Cc[16];
#pragma unroll
                for (int i = 0; i < 16; ++i) {
                    const int n = ch * 16 + i;
                    if (ct.i[n] >= 0) Cc[i] = (ord_key(s0[ct.i[n] < 0 ? 0 : ct.i[n]] + s1[ct.j[n] < 0 ? 0 : ct.j[n]]) & ~255u) | (unsigned)(255 - (ct.i[n] * 16 + ct.j[n]));
                    else Cc[i] = 0u;
                }
                bitonic_sort16_desc(Cc);
                if (ch == 0) {
#pragma unroll
                    for (int i = 0; i < 16; ++i) C[i] = Cc[i];
                } else merge_top16(C, Cc);
            }
#pragma unroll
            for (int i = 0; i < 16; ++i) { NIDX[token * 33 + i] = 127u - (L0[i] & 127u); NIDX[token * 33 + 16 + i] = 127u - (L1[i] & 127u); }
            const float mx = unord_key(C[0] & ~255u);
            float e[16]; float sum = 0.f;
#pragma unroll
            for (int r = 0; r < 16; ++r) { e[r] = __expf(unord_key(C[r] & ~255u) - mx); sum += e[r]; }
            const float inv = 1.0f / sum;
            const size_t ob = (size_t)(m0 + token) * 128 + hh * 16;
#pragma unroll
            for (int r = 0; r < 16; ++r) {
                const unsigned code = 255u - (C[r] & 255u);
                const unsigned e0 = NIDX[token * 33 + (code >> 4)], e1 = NIDX[token * 33 + 16 + (code & 15)];
                IDX[ob + r] = (unsigned short)(e0 * 128 + e1);
                GATE[ob + r] = e[r] * inv;
            }
        }
        __syncthreads();
    }
}

__device__ __forceinline__ bf16x8 pack8(const float4 a, const float4 b) {
    u32x4 t; t.x = pack2(a.x, a.y); t.y = pack2(a.z, a.w); t.z = pack2(b.x, b.y); t.w = pack2(b.z, b.w);
    return __builtin_bit_cast(bf16x8, t);
}
__device__ __forceinline__ void fold_query_weights(const Params& p) {
    const int lane = VTID & 63, wid = VTID >> 6, fr = lane & 15, fq = lane >> 4;
    bf16_t* Wf = (bf16_t*)(p.ws + OFF_WT_Q);
    for (int task = VBID; task < 512; task += VGRID) {
        const int kb = task & 15, pp = (task >> 4) & 1, h = (task >> 5) & 7, layer = task >> 8;
        const float* wq = p.peer_w_q + (size_t)layer * 1024 * 2048 + (size_t)(kb * 64 + fr) * 2048 + h * 256 + pp * 128 + fq * 8;
        const float* sk = p.peer_subkeys + ((size_t)((layer * 8 + h) * 2 + pp) * 128 + wid * 32 + fr) * 128 + fq * 8;
        f32x4 acc[4][2];
#pragma unroll
        for (int kt = 0; kt < 4; ++kt)
#pragma unroll
            for (int jt = 0; jt < 2; ++jt) acc[kt][jt] = (f32x4){0.f, 0.f, 0.f, 0.f};
#pragma unroll
        for (int s = 0; s < 4; ++s) {
            bf16x8 a[4], b[2];
#pragma unroll
            for (int kt = 0; kt < 4; ++kt) { const float* q = wq + (size_t)(kt * 16) * 2048 + s * 32; a[kt] = pack8(*(const float4*)q, *(const float4*)(q + 4)); }
#pragma unroll
            for (int jt = 0; jt < 2; ++jt) { const float* q = sk + (size_t)(jt * 16) * 128 + s * 32; b[jt] = pack8(*(const float4*)q, *(const float4*)(q + 4)); }
#pragma unroll
            for (int kt = 0; kt < 4; ++kt)
#pragma unroll
                for (int jt = 0; jt < 2; ++jt) acc[kt][jt] = __builtin_amdgcn_mfma_f32_16x16x32_bf16(a[kt], b[jt], acc[kt][jt], 0, 0, 0);
        }
#pragma unroll
        for (int jt = 0; jt < 2; ++jt) {
            const int key = wid * 32 + jt * 16 + fr, cu = 128 * ((key >> 5) & 1) + 32 * (2 * pp + (key >> 6)) + (key & 31);
            bf16_t* row = Wf + ((size_t)layer * 2048 + h * 256 + cu) * 1024 + kb * 64 + 4 * fq;
#pragma unroll
            for (int kt = 0; kt < 4; ++kt) store_bf16x4(row + kt * 16, acc[kt][jt]);
        }
    }
}
struct EpiSelect {
    unsigned short* IDX; float* GATE; G8_LAS unsigned* X;
    __device__ __forceinline__ void operator()(const f32x4 (&acc)[2][2][4][2], const g8::Unit& u, int wr, int wc, int fr, int fq) const {
        const int pp = wc >> 1, wid = wr * 4 + wc; const bool odd = (wc & 1) != 0;
        const unsigned kb = 127u - (unsigned)((wc & 1) * 64 + fq * 8);
#pragma unroll
        for (int ai = 0; ai < 2; ++ai) {
            unsigned Lst[4][16];
#pragma unroll
            for (int m = 0; m < 4; ++m) {
                unsigned C[16], Xc[16];
#pragma unroll
                for (int bj = 0; bj < 2; ++bj)
#pragma unroll
                    for (int n = 0; n < 2; ++n)
#pragma unroll
                        for (int r = 0; r < 4; ++r) C[bj * 8 + n * 4 + r] = (ord_key(acc[ai][bj][m][n][r]) & ~127u) | (kb - (unsigned)(bj * 32 + n * 4 + r));
                bitonic_sort16_desc(C);
#pragma unroll
                for (int i = 0; i < 16; ++i) Xc[i] = (unsigned)__shfl_xor((int)C[i], 16);
                merge_top16(C, Xc);
#pragma unroll
                for (int i = 0; i < 16; ++i) Xc[i] = (unsigned)__shfl_xor((int)C[i], 32);
                merge_top16(C, Xc);
                if (odd) {
                    if (fq == 0) {
#pragma unroll
                        for (int i = 0; i < 16; ++i) X[((wr * 2 + pp) * 4 + m) * 272 + i * 16 + fr] = C[i];
                    }
                }
#pragma unroll
                for (int i = 0; i < 16; ++i) Lst[m][i] = C[i];
            }
            __syncthreads();
            if (!odd) {
#pragma unroll
                for (int m = 0; m < 4; ++m) {
                    unsigned Xc[16];
                    G8_LAS unsigned* xs = X + ((wr * 2 + pp) * 4 + m) * 272 + fr;
#pragma unroll
                    for (int i = 0; i < 16; ++i) Xc[i] = xs[i * 16];
                    merge_top16(Lst[m], Xc);
                    if (fq == 0) {
#pragma unroll
                        for (int i = 0; i < 16; ++i) xs[i * 16] = Lst[m][i];
                    }
                }
            }
            __syncthreads();
            if (wid < 2) {
                G8_LAS unsigned* x0 = X + ((wid * 2 + 0) * 4 + fq) * 272 + fr; G8_LAS unsigned* x1 = X + ((wid * 2 + 1) * 4 + fq) * 272 + fr;
                float s0[16], s1[16];
#pragma unroll
                for (int i = 0; i < 16; ++i) { s0[i] = unord_key(x0[i * 16] & ~127u); s1[i] = unord_key(x1[i * 16] & ~127u); }
                constexpr CandTab<64> ct{};
                unsigned C[16];
#pragma unroll
                for (int ch = 0; ch < 4; ++ch) {
                    unsigned Cc[16];
#pragma unroll
                    for (int i = 0; i < 16; ++i) {
                        const int n = ch * 16 + i;
                        if (ct.i[n] >= 0) Cc[i] = (ord_key(s0[ct.i[n] < 0 ? 0 : ct.i[n]] + s1[ct.j[n] < 0 ? 0 : ct.j[n]]) & ~255u) | (unsigned)(255 - (ct.i[n] * 16 + ct.j[n]));
                        else Cc[i] = 0u;
                    }
                    bitonic_sort16_desc(Cc);
                    if (ch == 0) {
#pragma unroll
                        for (int i = 0; i < 16; ++i) C[i] = Cc[i];
                    } else merge_top16(C, Cc);
                }
                const float mx = unord_key(C[0] & ~255u);
                float e[16]; float sum = 0.f;
#pragma unroll
                for (int r = 0; r < 16; ++r) { e[r] = __expf(unord_key(C[r] & ~255u) - mx); sum += e[r]; }
                const float inv = 1.0f / sum;
                const size_t ob = (size_t)(u.pm * 256 + ai * 128 + wid * 64 + fq * 16 + fr) * 128 + u.pn * 16;
                unsigned iw[8];
#pragma unroll
                for (int r = 0; r < 16; ++r) {
                    const unsigned code = 255u - (C[r] & 255u);
                    const unsigned e0 = 127u - (x0[(code >> 4) * 16] & 127u), e1 = 127u - (x1[(code & 15) * 16] & 127u);
                    const unsigned id = e0 * 128u + e1;
                    if (r & 1) iw[r >> 1] |= id << 16; else iw[r >> 1] = id;
                    e[r] *= inv;
                }
                *(uint4*)(IDX + ob) = make_uint4(iw[0], iw[1], iw[2], iw[3]); *(uint4*)(IDX + ob + 8) = make_uint4(iw[4], iw[5], iw[6], iw[7]);
#pragma unroll
                for (int r = 0; r < 4; ++r) *(float4*)(GATE + ob + r * 4) = make_float4(e[4 * r], e[4 * r + 1], e[4 * r + 2], e[4 * r + 3]);
            }
            __syncthreads();
        }
    }
};
__device__ __forceinline__ void phase_select8(const Params& p, int layer, char* smem_phys) {
    const bf16_t* H = (const bf16_t*)(p.ws + OFF_H); const bf16_t* Wf = (const bf16_t*)(p.ws + OFF_WT_Q) + (size_t)layer * 2048 * 1024;
    g8::Gemm g{H, H, 1024, 1024, Wf, T, 2048, 1024};
    g8::StaticOrder S; S.init(T, 2048, (int)gridDim.x, (int)blockIdx.x);
    EpiSelect E{(unsigned short*)(p.ws + OFF_IDX), (float*)(p.ws + OFF_GATE), (G8_LAS unsigned*)(smem_phys + 131072)};
    g8::gemm_phase<EpiSelect>((G8_LAS unsigned char*)smem_phys, g, S, E);
}

__device__ __forceinline__ float ub0(unsigned w) { float f; asm("v_cvt_f32_ubyte0 %0, %1" : "=v"(f) : "v"(w)); return f; }
__device__ __forceinline__ float ub1(unsigned w) { float f; asm("v_cvt_f32_ubyte1 %0, %1" : "=v"(f) : "v"(w)); return f; }
__device__ __forceinline__ float ub2(unsigned w) { float f; asm("v_cvt_f32_ubyte2 %0, %1" : "=v"(f) : "v"(w)); return f; }
__device__ __forceinline__ float ub3(unsigned w) { float f; asm("v_cvt_f32_ubyte3 %0, %1" : "=v"(f) : "v"(w)); return f; }
typedef _Float16 f16x2 __attribute__((ext_vector_type(2)));
__device__ __forceinline__ void glds16(const void* gsrc, unsigned lds_dst) {
    unsigned keep; const unsigned d = (unsigned)__builtin_amdgcn_readfirstlane((int)lds_dst);
    asm volatile("s_mov_b32 %0, m0\n\ts_mov_b32 m0, %2\n\ts_nop 0\n\tglobal_load_lds_dwordx4 %1, off\n\ts_mov_b32 m0, %0" : "=&s"(keep) : "v"(gsrc), "s"(d) : "memory");
}
__device__ __forceinline__ void peer_gather(const Params& p, int layer, const float* __restrict__ gnext, bool final_out, char* smem) {
    const unsigned char* REC = p.ws + OFF_UT + (size_t)layer * NEXP * 1152;
    bf16_t* H = (bf16_t*)(p.ws + OFF_H);
    const unsigned short* IDX = (const unsigned short*)(p.ws + OFF_IDX); const float* GATE = (const float*)(p.ws + OFF_GATE);
    float* X = p.out;
    const int lane = VTID & 63, wid = VTID >> 6, sub = lane >> 4, li = lane & 15;
    char* wbase = smem + (int)(threadIdx.x >> 6) * 19456;
    unsigned short* sIdx = (unsigned short*)wbase; float* sGate = (float*)(wbase + 256);
    const char* ring = wbase + 1024; const unsigned ringb = (unsigned)(size_t)ring;
    const int gw = VBID * 4 + wid, nw = VGRID * 4;
    for (int t = gw; t < T; t += nw) {
        {
            int lz = 0; asm volatile("" : "+v"(lz));
            const int l2 = 2 * (lane + lz);
            const unsigned idp = *(const unsigned*)(IDX + (size_t)t * 128 + l2);
            const float2 g2 = *(const float2*)(GATE + (size_t)t * 128 + l2);
            *(unsigned*)(sIdx + l2) = idp; *(float2*)(sGate + l2) = g2;
        }
        int xq[2][8]; float sx; float xg[2];
        {
            u32x4 xr[8]; float am = 0.f;
#pragma unroll
            for (int k = 0; k < 8; ++k) {
                xr[k] = *(const u32x4*)(H + (size_t)t * 1024 + (16 * (k >> 2) + li) * 32 + (k & 3) * 8);
#pragma unroll
                for (int c = 0; c < 4; ++c) am = fmaxf(am, fmaxf(fabsf(lo2f(xr[k][c])), fabsf(hi2f(xr[k][c]))));
            }
            am = fmaxf(am, __shfl_xor(am, 1)); am = fmaxf(am, __shfl_xor(am, 2)); am = fmaxf(am, __shfl_xor(am, 4)); am = fmaxf(am, __shfl_xor(am, 8));
            const float inv = am > 0.f ? 127.0f / am : 0.f;
            sx = am * (1.0f / 127.0f);
#pragma unroll
            for (int j = 0; j < 2; ++j) {
                int xs = 0;
#pragma unroll
                for (int d = 0; d < 8; ++d) {
                    const unsigned w0 = xr[j * 4 + (d >> 1)][(d & 1) * 2], w1 = xr[j * 4 + (d >> 1)][(d & 1) * 2 + 1];
                    const int q0 = __float2int_rn(lo2f(w0) * inv), q1 = __float2int_rn(hi2f(w0) * inv), q2 = __float2int_rn(lo2f(w1) * inv), q3 = __float2int_rn(hi2f(w1) * inv);
                    xq[j][d] = (q0 & 0xff) | ((q1 & 0xff) << 8) | ((q2 & 0xff) << 16) | ((q3 & 0xff) << 24);
                    xs += (q0 + q1) + (q2 + q3);
                }
                xg[j] = -7.5f * (float)xs;
            }
        }
        f16x2 accp[2][16];
#pragma unroll
        for (int j = 0; j < 2; ++j)
#pragma unroll
            for (int c = 0; c < 16; ++c) accp[j][c] = (f16x2){(_Float16)0.f, (_Float16)0.f};
        float wsg[2] = {0.f, 0.f};
        auto issue = [&](int sg) {
            const unsigned e_ = sIdx[sg * 4 + sub];
            const unsigned char* rec = REC + (size_t)e_ * 1152 + li * 16;
            const unsigned dst = ringb + (unsigned)(sg & 3) * 4608u;
            glds16(rec, dst); glds16(rec + 256, dst + 1024u); glds16(rec + 512, dst + 2048u); glds16(rec + 768, dst + 3072u);
            if (lane < 32) {
                const unsigned e2 = sIdx[sg * 4 + (lane >> 3)];
                glds16(REC + (size_t)e2 * 1152 + 1024 + (lane & 7) * 16, dst + 4096u);
            }
        };
        auto compute = [&](int sg) {
            const char* sl = ring + (sg & 3) * 4608;
            const u32x4 du0 = *(const u32x4*)(sl + lane * 16), du1 = *(const u32x4*)(sl + 1024 + lane * 16);
            const u32x4 dv0 = *(const u32x4*)(sl + 2048 + lane * 16), dv1 = *(const u32x4*)(sl + 3072 + lane * 16);
            const uint2 sc = *(const uint2*)(sl + 4096 + sub * 128 + li * 8);
            const float gt = sGate[sg * 4 + sub];
            const f16x2 us = __builtin_bit_cast(f16x2, sc.x), vs = __builtin_bit_cast(f16x2, sc.y);
            float pa = 0.f;
#pragma unroll
            for (int j = 0; j < 2; ++j) {
                int ia = 0;
#pragma unroll
                for (int d = 0; d < 4; ++d) {
                    const unsigned w = j ? du1[d] : du0[d];
                    ia = __builtin_amdgcn_sdot4((int)(w & 0x0f0f0f0fu), xq[j][2 * d], ia, false);
                    ia = __builtin_amdgcn_sdot4((int)((w >> 4) & 0x0f0f0f0fu), xq[j][2 * d + 1], ia, false);
                }
                pa += (float)us[j] * ((float)ia + xg[j]);
            }
            pa = row16_sum(pa);
            const float ww = gt * gelu_exact(pa * sx);
#pragma unroll
            for (int j = 0; j < 2; ++j) {
                const float wg = ww * (float)vs[j];
                wsg[j] += wg;
                const _Float16 wh = (_Float16)fminf(fmaxf(wg * 65536.0f, -65504.0f), 65504.0f);
                const f16x2 w2 = {wh, wh};
#pragma unroll
                for (int d = 0; d < 4; ++d) {
                    const unsigned wv = j ? dv1[d] : dv0[d];
                    const f16x2 c0 = __builtin_bit_cast(f16x2, (wv << 4) & 0x00f000f0u), c1 = __builtin_bit_cast(f16x2, wv & 0x00f000f0u);
                    const f16x2 c2 = __builtin_bit_cast(f16x2, (wv >> 4) & 0x00f000f0u), c3 = __builtin_bit_cast(f16x2, (wv >> 8) & 0x00f000f0u);
                    accp[j][4 * d + 0] = __builtin_elementwise_fma(c0, w2, accp[j][4 * d + 0]); accp[j][4 * d + 1] = __builtin_elementwise_fma(c1, w2, accp[j][4 * d + 1]);
                    accp[j][4 * d + 2] = __builtin_elementwise_fma(c2, w2, accp[j][4 * d + 2]); accp[j][4 * d + 3] = __builtin_elementwise_fma(c3, w2, accp[j][4 * d + 3]);
                }
            }
        };
        asm volatile("s_waitcnt vmcnt(0)" ::: "memory");
        issue(0); issue(1); issue(2);
#pragma unroll 1
        for (int sg = 0; sg < 29; ++sg) {
            issue(sg + 3);
            asm volatile("s_waitcnt vmcnt(15)" ::: "memory");
            compute(sg);
        }
        asm volatile("s_waitcnt vmcnt(10)" ::: "memory");
        compute(29);
        asm volatile("s_waitcnt vmcnt(5)" ::: "memory");
        compute(30);
        asm volatile("s_waitcnt vmcnt(0)" ::: "memory");
        compute(31);
        float acc[2][32];
#pragma unroll
        for (int j = 0; j < 2; ++j)
#pragma unroll
            for (int d = 0; d < 4; ++d) {
                acc[j][8 * d + 0] = 16.0f * (float)accp[j][4 * d + 0][0]; acc[j][8 * d + 2] = 16.0f * (float)accp[j][4 * d + 0][1];
                acc[j][8 * d + 4] = 16.0f * (float)accp[j][4 * d + 1][0]; acc[j][8 * d + 6] = 16.0f * (float)accp[j][4 * d + 1][1];
                acc[j][8 * d + 1] = 16.0f * (float)accp[j][4 * d + 2][0]; acc[j][8 * d + 3] = 16.0f * (float)accp[j][4 * d + 2][1];
                acc[j][8 * d + 5] = 16.0f * (float)accp[j][4 * d + 3][0]; acc[j][8 * d + 7] = 16.0f * (float)accp[j][4 * d + 3][1];
            }
        const bool up2 = (sub & 2) != 0, up1 = (sub & 1) != 0;
        float wsum = (up2 ? wsg[1] : wsg[0]) + __shfl_xor(up2 ? wsg[0] : wsg[1], 32);
        wsum += __shfl_xor(wsum, 16);
        float r1[32];
#pragma unroll
        for (int c = 0; c < 32; ++c) r1[c] = (up2 ? acc[1][c] : acc[0][c]) + __shfl_xor(up2 ? acc[0][c] : acc[1][c], 32);
        float r2[16];
#pragma unroll
        for (int c = 0; c < 16; ++c) r2[c] = (up1 ? r1[16 + c] : r1[c]) + __shfl_xor(up1 ? r1[c] : r1[16 + c], 16);
        const int col0 = (16 * (sub >> 1) + li) * 32 + (sub & 1) * 16;
        float ss = 0.f;
        float* xrow = X + (size_t)t * 1024 + col0;
#pragma unroll
        for (int c4 = 0; c4 < 4; ++c4) {
            const f32x4 a = *(const f32x4*)(xrow + c4 * 4);
#pragma unroll
            for (int c = 0; c < 4; ++c) { r2[c4 * 4 + c] = r2[c4 * 4 + c] - 7.5f * wsum + a[c]; ss += r2[c4 * 4 + c] * r2[c4 * 4 + c]; }
        }
        ss = wave_sum(ss);
        const float rstd = rsqrtf(ss * (1.0f / D) + EPS);
        const float* gp = gnext + col0;
        if (final_out) {
#pragma unroll
            for (int c4 = 0; c4 < 4; ++c4) {
                const f32x4 g = *(const f32x4*)(gp + c4 * 4);
                *(f32x4*)(xrow + c4 * 4) = (f32x4){r2[c4 * 4] * rstd * g[0], r2[c4 * 4 + 1] * rstd * g[1], r2[c4 * 4 + 2] * rstd * g[2], r2[c4 * 4 + 3] * rstd * g[3]};
            }
        } else {
            u32x4 o[2];
#pragma unroll
            for (int c4 = 0; c4 < 4; ++c4) {
                const f32x4 g = *(const f32x4*)(gp + c4 * 4);
                *(f32x4*)(xrow + c4 * 4) = (f32x4){r2[c4 * 4], r2[c4 * 4 + 1], r2[c4 * 4 + 2], r2[c4 * 4 + 3]};
                o[c4 >> 1][(c4 & 1) * 2] = pack2(r2[c4 * 4] * rstd * g[0], r2[c4 * 4 + 1] * rstd * g[1]);
                o[c4 >> 1][(c4 & 1) * 2 + 1] = pack2(r2[c4 * 4 + 2] * rstd * g[2], r2[c4 * 4 + 3] * rstd * g[3]);
            }
            bf16_t* hp = H + (size_t)t * 1024 + col0;
            *(u32x4*)hp = o[0]; *(u32x4*)(hp + 8) = o[1];
        }
    }
}

__device__ __forceinline__ void spatial_fast(const Params& p, char* smem) {
    bf16_t* U = (bf16_t*)(p.ws + OFF_REGION); const bf16_t* VT = U + (size_t)T * 2048; const float* SSQ = (const float*)(p.ws + OFF_SSQ);
    const int tid_ = VTID;
    for (int task = VBID; task < 2048; task += VGRID) {
        const int chunk = task >> 3, g = task & 7;
        int lz = 0; asm volatile("" : "+v"(lz));
        const int tid = tid_ + lz, lane = tid & 63, wid = tid >> 6, wm = wid >> 1, wn = wid & 1, l15 = lane & 15, q4 = lane >> 4;
        float* rs = (float*)(smem + 16384);
        if (tid < 128) {
            const float* sp = SSQ + (size_t)(chunk * 128 + tid) * 32;
            float s = 0.f;
#pragma unroll
            for (int i = 0; i < 8; ++i) { const f32x4 v = *(const f32x4*)(sp + 4 * i); s += (v[0] + v[1]) + (v[2] + v[3]); }
            rs[tid] = rsqrtf(s * (1.0f / 2048.0f) + EPS);
        }
        __syncthreads();
#pragma unroll
        for (int i = 0; i < 8; ++i) {
            const int c = tid + 256 * i, row = c >> 4, ch16 = c & 15, ks = ch16 >> 3, ch = ch16 & 7, s0 = ch16 * 8;
            const float* wp = p.c_w_spatial + ((size_t)(g * 128 + row)) * 128 + s0;
            const f32x4 w0 = *(const f32x4*)wp, w1 = *(const f32x4*)(wp + 4);
            const f32x4 r0 = *(const f32x4*)(rs + s0), r1 = *(const f32x4*)(rs + s0 + 4);
            float v[8];
#pragma unroll
            for (int j = 0; j < 4; ++j) { v[j] = (s0 + j <= row) ? w0[j] * r0[j] : 0.f; v[4 + j] = (s0 + 4 + j <= row) ? w1[j] * r1[j] : 0.f; }
            *(uint4*)(smem + ks * 32768 + row * 128 + ((ch ^ (row & 7)) << 4)) = make_uint4(pack2(v[0], v[1]), pack2(v[2], v[3]), pack2(v[4], v[5]), pack2(v[6], v[7]));
        }
        __syncthreads();
#pragma unroll 1
        for (int nh = 0; nh < 2; ++nh) {
            const int chan0 = g * 256 + nh * 128;
#pragma unroll
            for (int i = 0; i < 8; ++i) {
                const int c = tid + 256 * i, row = c >> 4, ch16 = c & 15, ks = ch16 >> 3, ch = ch16 & 7;
                *(uint4*)(smem + ks * 32768 + 16384 + row * 128 + ((ch ^ (row & 7)) << 4)) = *(const uint4*)(VT + ((size_t)chunk * 2048 + chan0 + row) * 128 + ch16 * 8);
            }
            __syncthreads();
            f32x4 acc[4][4];
#pragma unroll
            for (int i = 0; i < 4; ++i)
#pragma unroll
                for (int j = 0; j < 4; ++j) acc[i][j] = (f32x4){0.f, 0.f, 0.f, 0.f};
#pragma unroll
            for (int kt = 0; kt < 2; ++kt) {
                if (kt == 1 && wm == 0) continue;
                const char* sa = smem + kt * 32768; const char* sb = sa + 16384;
#pragma unroll
                for (int ks = 0; ks < 2; ++ks) {
                    bf16x8 af[4], bfr[4];
                    const int ch = ks * 4 + q4;
#pragma unroll
                    for (int i = 0; i < 4; ++i) { const int row = wm * 64 + i * 16 + l15; af[i] = *(const bf16x8*)(sa + row * 128 + ((ch ^ (row & 7)) << 4)); }
#pragma unroll
                    for (int j = 0; j < 4; ++j) { const int row = wn * 64 + j * 16 + l15; bfr[j] = *(const bf16x8*)(sb + row * 128 + ((ch ^ (row & 7)) << 4)); }
#pragma unroll
                    for (int i = 0; i < 4; ++i)
#pragma unroll
                        for (int j = 0; j < 4; ++j) acc[i][j] = __builtin_amdgcn_mfma_f32_16x16x32_bf16(bfr[j], af[i], acc[i][j], 0, 0, 0);
                }
            }
            __syncthreads();
#pragma unroll
            for (int i = 0; i < 4; ++i) {
                const int m = wm * 64 + i * 16 + l15;
                const float bias = p.c_b_spatial[g * 128 + m];
#pragma unroll
                for (int j = 0; j < 4; ++j) {
                    const int chan = chan0 + wn * 64 + j * 16 + 4 * q4;
                    const f32x4 vn = *(const f32x4*)(p.c_v_norm + chan);
                    bf16_t* up = U + (size_t)(chunk * 128 + m) * 2048 + chan;
                    const uint2 uu = *(const uint2*)up;
                    uint2 o;
                    o.x = pack2(lo2f(uu.x) * (vn[0] * acc[i][j][0] + bias), hi2f(uu.x) * (vn[1] * acc[i][j][1] + bias));
                    o.y = pack2(lo2f(uu.y) * (vn[2] * acc[i][j][2] + bias), hi2f(uu.y) * (vn[3] * acc[i][j][3] + bias));
                    *(uint2*)up = o;
                }
            }
        }
    }
}

#define XB_TMO      128
#define XB_XCNT(j)  (256  + 64 * (j))
#define XB_XSUB(j)  (1280 + 64 * (j))
#define XB_XGEN(j)  (2304 + 64 * (j))
#define XB_TOP      3328
#define XB_TOPGEN   3392
#define XCD_BAR_WORDS 3456
#define XB_SPIN_CAP (1u << 22)
#define LAS __attribute__((address_space(3)))
__device__ __forceinline__ unsigned xb_ld(unsigned* p)              { return __hip_atomic_load(p, __ATOMIC_RELAXED, __HIP_MEMORY_SCOPE_AGENT); }
__device__ __forceinline__ unsigned xb_add(unsigned* p, unsigned v) { return __hip_atomic_fetch_add(p, v, __ATOMIC_RELAXED, __HIP_MEMORY_SCOPE_AGENT); }
__device__ __forceinline__ unsigned xb_xcc_id() { return (unsigned)__builtin_amdgcn_s_getreg((3 << 11) | 20) & 0xFu; }
#define XB_SPIN(cond, bar) do { unsigned _sp = 0; while (cond) { __builtin_amdgcn_s_sleep(1); \
    if ((++_sp & 255u) == 0u) { if (xb_ld(&(bar)[XB_TMO])) break; if (_sp > XB_SPIN_CAP) { atomicAdd(&(bar)[XB_TMO], 1u); break; } } } } while (0)
struct XcdBarrier { unsigned* bar; unsigned x; volatile LAS unsigned* st; };
__device__ __forceinline__ XcdBarrier xcd_barrier_post(unsigned* bar, volatile LAS unsigned* st) {
    XcdBarrier b; b.bar = bar; b.x = xb_xcc_id(); b.st = st;
    if (threadIdx.x == 0) (void)xb_add(&bar[XB_XCNT(b.x)], 1u);
    return b;
}
__device__ __forceinline__ void xcd_barrier_complete(unsigned* bar, unsigned x, unsigned& nloc, unsigned& nx) {
    const unsigned G = gridDim.x * gridDim.y * gridDim.z;
    unsigned sum, cnt, mine, sp = 0u;
    for (;;) {
        sum = 0u; cnt = 0u; mine = 0u;
#pragma unroll
        for (unsigned j = 0; j < 16; ++j) { const unsigned c = xb_ld(&bar[XB_XCNT(j)]); sum += c; cnt += (c > 0u) ? 1u : 0u; mine = (j == x) ? c : mine; }
        if (sum == G) break;
        __builtin_amdgcn_s_sleep(1);
        if ((++sp & 255u) == 0u) { if (xb_ld(&bar[XB_TMO])) break; if (sp > XB_SPIN_CAP) { atomicAdd(&bar[XB_TMO], 1u); break; } }
    }
    nloc = mine > 0u ? mine : 1u; nx = cnt > 0u ? cnt : 1u;
}
__device__ __forceinline__ void xcd_barrier(const XcdBarrier& b) {
    asm volatile("s_waitcnt vmcnt(0)" ::: "memory");
    __syncthreads();
    if (threadIdx.x == 0) {
        unsigned* bar = b.bar;
        __builtin_amdgcn_s_waitcnt(0);
        unsigned nloc = b.st[0], nx = b.st[1];
        if (nloc == 0u) { xcd_barrier_complete(bar, b.x, nloc, nx); b.st[0] = nloc; b.st[1] = nx; }
        const unsigned old = xb_add(&bar[XB_XSUB(b.x)], 1u);
        const unsigned gen = old / nloc;
        if (old + 1u == (gen + 1u) * nloc) {
            __builtin_amdgcn_fence(__ATOMIC_RELEASE, "agent");
            asm volatile("s_waitcnt vmcnt(0)" ::: "memory");
            const unsigned og = xb_add(&bar[XB_TOP], 1u);
            const unsigned tg = og / nx;
            if (og + 1u == (tg + 1u) * nx) xb_add(&bar[XB_TOPGEN], 1u);
            else XB_SPIN(xb_ld(&bar[XB_TOPGEN]) == tg, bar);
            __builtin_amdgcn_fence(__ATOMIC_ACQUIRE, "agent");
            xb_add(&bar[XB_XGEN(b.x)], 1u);
            asm volatile("s_waitcnt vmcnt(0)" ::: "memory");
        } else {
            XB_SPIN(xb_ld(&bar[XB_XGEN(b.x)]) == gen, bar);
            __builtin_amdgcn_fence(__ATOMIC_ACQUIRE, "agent");
            asm volatile("s_waitcnt vmcnt(0)" ::: "memory");
        }
    }
    __syncthreads();
}

constexpr int NPHASE = 14;
constexpr int kDynLds = 163840;
__global__ void __launch_bounds__(512, 2) mega(Params p, int ph_lo, int ph_hi) {
    extern __shared__ __attribute__((aligned(16))) char smem_phys[];
    cg::grid_group grid = cg::this_grid();
    uint4& xb_words = *(uint4*)(smem_phys + kDynLds - 16);
    if (threadIdx.x == 0) xb_words = make_uint4(0u, 0u, 0u, 0u);
    __syncthreads();
    const XcdBarrier xbar = xcd_barrier_post((unsigned*)(p.ws + OFF_BAR), (volatile LAS unsigned*)&xb_words);
    char* smem = smem_phys + (threadIdx.x >> 8) * 65536;
    bf16_t* Rg = (bf16_t*)(p.ws + OFF_REGION);
    bf16_t* Hb = (bf16_t*)(p.ws + OFF_H);
#define PHASE(k, ...) if (ph_lo <= (k) && (k) < ph_hi) { __VA_ARGS__; if ((k) + 1 < ph_hi) { if ((k) == 0) grid.sync(); else xcd_barrier(xbar); } }
    unsigned* sbctr = (unsigned*)(p.ws + OFF_BAR + 14336);
    PHASE(0,
        transpose_convert<true>(p.ab_w_in, (bf16_t*)(p.ws + OFF_WT_IN), 1024, AB_IN, AB_IN_PAD, smem);
        rmsnorm_rows(p.x, p.norm_mix, Hb))
    PHASE(1, phase_gemm_in8(p, smem_phys))
    PHASE(2, gla_prep(p, smem))
    PHASE(3, gla_scan(p, smem); sb_fast(p, smem_phys + 98304, sbctr); quantize_tables_static(p);
        transpose_convert(p.ab_w_out, (bf16_t*)(p.ws + OFF_WT_OUT), 1024, 1024, 1024, smem);
        transpose_convert(p.c_w_in, (bf16_t*)(p.ws + OFF_WT_CIN), 1024, 4096, 4096, smem);
        transpose_convert(p.c_w_out, (bf16_t*)(p.ws + OFF_WT_COUT), 2048, 1024, 1024, smem);
        fold_query_weights(p))
    PHASE(4, phase_gemm_resid8(Rg + R_QSB, Rg + R_GG, 512, 512, (const bf16_t*)(p.ws + OFF_WT_OUT), 1024, p.x, p.out, smem_phys))
    PHASE(5, rmsnorm_rows(p.out, p.norm_ffn, Hb))
    PHASE(6, phase_select8(p, 0, smem_phys))
    PHASE(7, peer_gather(p, 0, p.norm_mix + 1024, false, smem_phys))
    PHASE(8, phase_gemm_cin8(p, smem_phys))
    PHASE(9, spatial_fast(p, smem))
    PHASE(10, phase_gemm_resid8(Rg, Rg, 2048, 2048, (const bf16_t*)(p.ws + OFF_WT_COUT), 2048, p.out, p.out, smem_phys))
    PHASE(11, rmsnorm_rows(p.out, p.norm_ffn + 1024, Hb))
    PHASE(12, phase_select8(p, 1, smem_phys))
    PHASE(13, peer_gather(p, 1, p.final_norm, true, smem_phys))
}

extern "C" void kernel_launch(void* const* d_in, const int* in_sizes, int n_in, void* d_out, int out_size, void* d_ws, size_t ws_size, hipStream_t stream) {
    static int grid_blocks = 0;
    if (!grid_blocks) {
        int dev = 0, cus = 0, per_cu = 0;
        hipGetDevice(&dev);
        hipDeviceGetAttribute(&cus, hipDeviceAttributeMultiprocessorCount, dev);
        hipFuncSetAttribute((const void*)mega, hipFuncAttributeMaxDynamicSharedMemorySize, kDynLds);
        hipOccupancyMaxActiveBlocksPerMultiprocessor(&per_cu, mega, 512, kDynLds);
        if (per_cu < 1) per_cu = 1;
        if (per_cu > 1) per_cu = 1;
        grid_blocks = cus * per_cu;
        if (n_in != 18 || ws_size < WS_END) fprintf(stderr, "kernel_launch: unexpected n_in %d or ws_size %zu < %zu\n", n_in, ws_size, (size_t)WS_END);
    }
    Params p{};
    p.x = (const float*)d_in[0]; p.norm_mix = (const float*)d_in[1]; p.norm_ffn = (const float*)d_in[2]; p.ab_w_in = (const float*)d_in[3];
    p.ab_w_alpha2 = (const float*)d_in[4]; p.ab_b_alpha2 = (const float*)d_in[5]; p.ab_gla_norm = (const float*)d_in[6]; p.ab_w_out = (const float*)d_in[7];
    p.c_w_in = (const float*)d_in[8]; p.c_v_norm = (const float*)d_in[9]; p.c_w_spatial = (const float*)d_in[10]; p.c_b_spatial = (const float*)d_in[11];
    p.c_w_out = (const float*)d_in[12]; p.peer_w_q = (const float*)d_in[13]; p.peer_subkeys = (const float*)d_in[14]; p.peer_u = (const float*)d_in[15];
    p.peer_v = (const float*)d_in[16]; p.final_norm = (const float*)d_in[17];
    p.out = (float*)d_out; p.ws = (unsigned char*)d_ws;
    (void)hipMemsetAsync((char*)d_ws + OFF_BAR, 0, 16384, stream);
#if ONE_LAUNCH
    int lo = 0, hi = NPHASE;
    void* args[] = {&p, &lo, &hi};
    hipError_t e = hipLaunchCooperativeKernel((void*)mega, dim3(grid_blocks), dim3(512), args, kDynLds, stream);
    if (e != hipSuccess) fprintf(stderr, "cooperative launch failed: %s (grid %d)\n", hipGetErrorString(e), grid_blocks);
#else
    for (int ph = 0; ph < NPHASE; ++ph) hipLaunchKernelGGL(mega, dim3(grid_blocks), dim3(512), kDynLds, stream, p, ph, ph + 1);
#endif
}
```

```cpp
#include <hip/hip_runtime.h>
#include <hip/hip_cooperative_groups.h>
#include <cstdio>
#include <cstdint>
namespace cg = cooperative_groups;

#ifndef ONE_LAUNCH
#define ONE_LAUNCH 1
#endif


#define VTID ((int)(threadIdx.x & 255))
#define VBID ((int)(blockIdx.x * 2 + (threadIdx.x >> 8)))
#define VGRID ((int)(gridDim.x * 2))
typedef unsigned short bf16_t;
typedef short bf16x8 __attribute__((ext_vector_type(8)));
typedef float f32x4 __attribute__((ext_vector_type(4)));
typedef unsigned u32x4 __attribute__((ext_vector_type(4)));
typedef __bf16 bf16x2_t __attribute__((ext_vector_type(2)));

constexpr int T = 32768, D = 1024, SEQ = 2048, NB = 16;
constexpr int AB_IN = 3088, AB_IN_PAD = 3200;
constexpr float EPS = 1e-6f;
constexpr int NEXP = 16384;

constexpr size_t SZ_WT_IN = (size_t)AB_IN_PAD * 1024 * 2;
constexpr size_t SZ_WT_OUT = (size_t)1024 * 1024 * 2;
constexpr size_t SZ_WT_CIN = (size_t)4096 * 1024 * 2;
constexpr size_t SZ_WT_COUT = (size_t)1024 * 2048 * 2;
constexpr size_t SZ_WT_Q = (size_t)2 * 2048 * 1024 * 2;
constexpr size_t SZ_SK = (size_t)2 * 8 * 2 * 128 * 128 * 2;
constexpr size_t SZ_TAB = (size_t)2 * NEXP * 1024;
constexpr size_t SZ_TSC = (size_t)2 * NEXP * 4;
constexpr size_t OFF_WT_IN = 0;
constexpr size_t OFF_WT_OUT = OFF_WT_IN + SZ_WT_IN;
constexpr size_t OFF_WT_CIN = OFF_WT_OUT + SZ_WT_OUT;
constexpr size_t OFF_WT_COUT = OFF_WT_CIN + SZ_WT_CIN;
constexpr size_t OFF_WT_Q = OFF_WT_COUT + SZ_WT_COUT;
constexpr size_t OFF_SK = OFF_WT_Q + SZ_WT_Q;
constexpr size_t OFF_UT = OFF_SK + SZ_SK;
constexpr size_t OFF_VT = OFF_UT + SZ_TAB;
constexpr size_t OFF_USC = OFF_VT + SZ_TAB;
constexpr size_t OFF_VSC = OFF_USC + SZ_TSC;
constexpr size_t OFF_H = OFF_VSC + SZ_TSC;
constexpr size_t OFF_IDX = OFF_H + (size_t)T * 1024 * 2;
constexpr size_t OFF_GATE = OFF_IDX + (size_t)T * 128 * 2;
constexpr size_t OFF_SSQ = OFF_GATE + (size_t)T * 128 * 4;
constexpr size_t OFF_REGION = OFF_SSQ + (size_t)T * 32 * 4;
constexpr size_t SZ_REGION = (size_t)256 << 20;
constexpr size_t OFF_BAR = OFF_REGION + SZ_REGION;
constexpr size_t WS_END = OFF_BAR + 16384;
constexpr size_t R_QSB = 0;
constexpr size_t R_KSB = R_QSB + (size_t)T * 512;
constexpr size_t R_VTSB = R_KSB + (size_t)T * 512;
constexpr size_t R_QG = R_VTSB + (size_t)T * 512;
constexpr size_t R_KG = R_QG + (size_t)T * 256;
constexpr size_t R_VTG = R_KG + (size_t)T * 256;
constexpr size_t R_GG = R_VTG + (size_t)T * 512;
constexpr size_t R_ALR = R_GG + (size_t)T * 512;
constexpr size_t R_KOT = R_ALR + (size_t)T * 32;
constexpr size_t R_DEC = R_KOT + (size_t)T * 256;

struct Params {
    const float* x; const float* norm_mix; const float* norm_ffn; const float* ab_w_in; const float* ab_w_alpha2; const float* ab_b_alpha2;
    const float* ab_gla_norm; const float* ab_w_out; const float* c_w_in; const float* c_v_norm; const float* c_w_spatial; const float* c_b_spatial;
    const float* c_w_out; const float* peer_w_q; const float* peer_subkeys; const float* peer_u; const float* peer_v; const float* final_norm;
    float* out; unsigned char* ws;
};

__device__ __forceinline__ float bf2f(bf16_t v) { return __uint_as_float(((unsigned)v) << 16); }
__device__ __forceinline__ bf16_t f2bf(float f) { unsigned u = __float_as_uint(f); u += 0x7fffu + ((u >> 16) & 1u); return (bf16_t)(u >> 16); }
__device__ __forceinline__ unsigned pack2(float lo, float hi) { return (unsigned)f2bf(lo) | ((unsigned)f2bf(hi) << 16); }
__device__ __forceinline__ float lo2f(unsigned w) { return __uint_as_float(w << 16); }
__device__ __forceinline__ float hi2f(unsigned w) { return __uint_as_float(w & 0xffff0000u); }
__device__ __forceinline__ float dot2(unsigned a, unsigned b, float acc) { return __builtin_amdgcn_fdot2_f32_bf16(__builtin_bit_cast(bf16x2_t, a), __builtin_bit_cast(bf16x2_t, b), acc, false); }
__device__ __forceinline__ float gelu_exact(float v) {
    const float av = fabsf(v);
    const float t = __builtin_amdgcn_rcpf(av * 0.2316418882f + 1.0f);
    float q = t * 0.5307027145f - 0.7265760135f; q = q * t + 0.7107068705f; q = q * t - 0.142248368f; q = q * t + 0.127414796f; q = q * t;
    const float e = __builtin_amdgcn_exp2f(v * v * -0.72134752044f);
    const float m = v * (q * e);
    return v < 0.f ? m : v - m;
}
__device__ __forceinline__ float row16_sum(float v) {
    v += __builtin_bit_cast(float, __builtin_amdgcn_update_dpp(0, __builtin_bit_cast(int, v), 0x128, 0xf, 0xf, false));
    v += __builtin_bit_cast(float, __builtin_amdgcn_update_dpp(0, __builtin_bit_cast(int, v), 0x124, 0xf, 0xf, false));
    v += __builtin_bit_cast(float, __builtin_amdgcn_update_dpp(0, __builtin_bit_cast(int, v), 0x122, 0xf, 0xf, false));
    v += __builtin_bit_cast(float, __builtin_amdgcn_update_dpp(0, __builtin_bit_cast(int, v), 0x121, 0xf, 0xf, false));
    return v;
}
__device__ __forceinline__ float wave_sum(float v) {
#pragma unroll
    for (int o = 32; o >= 1; o >>= 1) v += __shfl_xor(v, o);
    return v;
}

template <bool PERM_IN = false>
__device__ __forceinline__ void transpose_convert(const float* __restrict__ W, bf16_t* __restrict__ Wt, int K, int N, int Npad, char* smem) {
    float* tile = (float*)smem;
    const int tk = K / 64, tn = Npad / 64, ntile = tk * tn;
    const int tid = VTID;
    for (int tl = VBID; tl < ntile; tl += VGRID) {
        const int k0 = (tl % tk) * 64, n0 = (tl / tk) * 64;
        const int c = tid & 63, r0 = tid >> 6;
        int nd = n0;
        if (PERM_IN) { if (n0 >= 1024 && n0 < 1536) nd = n0 + 1024; else if (n0 >= 1536 && n0 < 2048) nd = n0 - 512; else if (n0 >= 2048 && n0 < 2560) nd = n0 + 512; else if (n0 >= 2560 && n0 < 3072) nd = n0 - 1024; }
#pragma unroll
        for (int i = 0; i < 16; ++i) {
            const int r = r0 + 4 * i;
            const float v = (n0 + c < N) ? W[(size_t)(k0 + r) * N + n0 + c] : 0.f;
            tile[c * 65 + r] = v;
        }
        __syncthreads();
#pragma unroll
        for (int i = 0; i < 16; ++i) {
            const int n = r0 + 4 * i;
            Wt[(size_t)(nd + n) * K + k0 + c] = f2bf(tile[n * 65 + c]);
        }
        __syncthreads();
    }
}
__device__ __forceinline__ void convert_flat(const float* __restrict__ src, bf16_t* __restrict__ dst, size_t n) {
    const size_t nv = n / 8;
    for (size_t i = (size_t)VBID * 256 + VTID; i < nv; i += (size_t)VGRID * 256) {
        const float4 a = ((const float4*)src)[2 * i], b = ((const float4*)src)[2 * i + 1];
        uint4 o; o.x = pack2(a.x, a.y); o.y = pack2(a.z, a.w); o.z = pack2(b.x, b.y); o.w = pack2(b.z, b.w);
        ((uint4*)dst)[i] = o;
    }
}
__device__ __forceinline__ void quantize_tables_static(const Params& p) {
    const int lane = VTID & 63, wid = VTID >> 6;
    for (unsigned task = (unsigned)VBID; task < 512u; task += (unsigned)VGRID) {
        const bool isv = task >= 256u;
        const int r0 = (int)(task & 255u) * 128 + wid * 32;
        const float* src = isv ? p.peer_v : p.peer_u;
        unsigned char* recs = p.ws + OFF_UT;
        for (int rr = 0; rr < 32; ++rr) {
            const int r = r0 + rr;
            const float* xr = src + (size_t)r * 1024 + lane * 16;
            f32x4 v[4]; float aml = 0.f;
#pragma unroll
            for (int i = 0; i < 4; ++i) {
                v[i] = *(const f32x4*)(xr + i * 4);
                aml = fmaxf(aml, fmaxf(fmaxf(fabsf(v[i][0]), fabsf(v[i][1])), fmaxf(fabsf(v[i][2]), fabsf(v[i][3]))));
            }
            const float gs = fmaxf(aml, __shfl_xor(aml, 1)) * (1.002f / 7.5f);
            const _Float16 hs = (_Float16)gs;
            const float gsd = (float)hs, ginv = gsd > 0.f ? 1.0f / gsd : 0.f;
            unsigned wd[2];
#pragma unroll
            for (int dd = 0; dd < 2; ++dd) {
                unsigned wv = 0;
#pragma unroll
                for (int b = 0; b < 4; ++b) {
                    const int qa = min(15, max(0, __float2int_rn(v[2 * dd][b] * ginv + 7.5f)));
                    const int qb = min(15, max(0, __float2int_rn(v[2 * dd + 1][b] * ginv + 7.5f)));
                    wv |= ((unsigned)qa | ((unsigned)qb << 4)) << (8 * b);
                }
                wd[dd] = wv;
            }
            unsigned char* rec = recs + (size_t)r * 1152;
            *(uint2*)(rec + (isv ? 512 : 0) + lane * 8) = make_uint2(wd[0], wd[1]);
            if ((lane & 1) == 0) { const int g = lane >> 1; *(_Float16*)(rec + 1024 + (g & 15) * 8 + (isv ? 4 : 0) + (g >> 4) * 2) = hs; }
        }
    }
}
__device__ __forceinline__ void rmsnorm_rows(const float* __restrict__ X, const float* __restrict__ g, bf16_t* __restrict__ Hout) {
    const int lane = VTID & 63, wid = VTID >> 6;
    const int gw = VBID * 4 + wid, nw = VGRID * 4;
    for (int t = gw; t < T; t += nw) {
        const float* xr = X + (size_t)t * D;
        float4 v[4]; float ss = 0.f;
#pragma unroll
        for (int i = 0; i < 4; ++i) { v[i] = *(const float4*)(xr + i * 256 + lane * 4); ss += v[i].x * v[i].x + v[i].y * v[i].y + v[i].z * v[i].z + v[i].w * v[i].w; }
        ss = wave_sum(ss);
        const float rstd = rsqrtf(ss * (1.0f / D) + EPS);
#pragma unroll
        for (int i = 0; i < 4; ++i) {
            const float4 gg = *(const float4*)(g + i * 256 + lane * 4);
            uint2 o; o.x = pack2(v[i].x * rstd * gg.x, v[i].y * rstd * gg.y); o.y = pack2(v[i].z * rstd * gg.z, v[i].w * rstd * gg.w);
            *(uint2*)(Hout + (size_t)t * D + i * 256 + lane * 4) = o;
        }
    }
}

template <int MODE>
__device__ __forceinline__ void gemm_mainloop(const bf16_t* __restrict__ A0, const bf16_t* __restrict__ A1, int lda, int ksplit,
                                              const bf16_t* __restrict__ Bt, int K, int m0, int n0, f32x4 (&acc)[4][4], char* smem) {
    const int tid = VTID, lane = tid & 63, wid = tid >> 6, wm = wid >> 1, wn = wid & 1;
    const int lrow = tid >> 3, lch = tid & 7;
#pragma unroll
    for (int i = 0; i < 4; ++i)
#pragma unroll
        for (int j = 0; j < 4; ++j) acc[i][j] = (f32x4){0.f, 0.f, 0.f, 0.f};
    const int nk = K / 64;
    unsigned aoff[4], boff[4];
    {
        const int rr = lane >> 3, cc = ((lane & 7) ^ rr) * 8;
#pragma unroll
        for (int i = 0; i < 4; ++i) {
            aoff[i] = (unsigned)(((m0 + 32 * wid + 8 * i + rr) * lda + cc) * 2);
            boff[i] = (unsigned)(((n0 + 32 * wid + 8 * i + rr) * K + cc) * 2);
        }
    }
    auto stage = [&](int kt, int buf) {
        const int kb = kt * 64;
        const char* Ab; const char* Bb = (const char*)(Bt + kb);
        if (kb < ksplit) Ab = (const char*)(A0 + kb); else Ab = (const char*)(A1 + (kb - ksplit));
        char* sa = smem + buf * 32768 + wid * 4096 + lane * 16; char* sb = sa + 16384;
#pragma unroll
        for (int i = 0; i < 4; ++i) __builtin_amdgcn_global_load_lds((const unsigned*)(Ab + aoff[i]), (unsigned*)(sa + i * 1024), 16, 0, 0);
#pragma unroll
        for (int i = 0; i < 4; ++i) __builtin_amdgcn_global_load_lds((const unsigned*)(Bb + boff[i]), (unsigned*)(sb + i * 1024), 16, 0, 0);
    };
    auto compute = [&](int buf) {
        const char* sa = smem + buf * 32768; const char* sb = sa + 16384;
#pragma unroll
        for (int ks = 0; ks < 2; ++ks) {
            bf16x8 af[4], bfr[4];
            const int ch = ks * 4 + (lane >> 4);
#pragma unroll
            for (int i = 0; i < 4; ++i) { const int row = wm * 64 + i * 16 + (lane & 15); af[i] = *(const bf16x8*)(sa + row * 128 + ((ch ^ (row & 7)) << 4)); }
#pragma unroll
            for (int j = 0; j < 4; ++j) { const int row = wn * 64 + j * 16 + (lane & 15); bfr[j] = *(const bf16x8*)(sb + row * 128 + ((ch ^ (row & 7)) << 4)); }
            __builtin_amdgcn_s_setprio(1);
#pragma unroll
            for (int i = 0; i < 4; ++i)
#pragma unroll
                for (int j = 0; j < 4; ++j) {
                    if (MODE == 0) acc[i][j] = __builtin_amdgcn_mfma_f32_16x16x32_bf16(bfr[j], af[i], acc[i][j], 0, 0, 0);
                    else acc[i][j] = __builtin_amdgcn_mfma_f32_16x16x32_bf16(af[i], bfr[j], acc[i][j], 0, 0, 0);
                }
            __builtin_amdgcn_s_setprio(0);
        }
    };
    stage(0, 0);
    asm volatile("s_waitcnt vmcnt(0)" ::: "memory");
    __syncthreads();
    for (int kt = 0; kt < nk; ++kt) {
        if (kt + 1 < nk) stage(kt + 1, (kt + 1) & 1);
        compute(kt & 1);
        asm volatile("s_waitcnt vmcnt(0)" ::: "memory");
        __syncthreads();
    }
}
template <int MODE>
__device__ __forceinline__ void gemm_mainloop256(const bf16_t* __restrict__ A0, const bf16_t* __restrict__ A1, int lda, int ksplit,
                                                 const bf16_t* __restrict__ Bt, int K, int m0, int n0, f32x4 (&acc)[8][4], char* smem) {
    const int tid = VTID, lane = tid & 63, wid = tid >> 6, wm = wid >> 1, wn = wid & 1;
#pragma unroll
    for (int i = 0; i < 8; ++i)
#pragma unroll
        for (int j = 0; j < 4; ++j) acc[i][j] = (f32x4){0.f, 0.f, 0.f, 0.f};
    const int nk = K / 32;
    unsigned aoff[4], boff[2];
    {
        const int rr = lane >> 2, cc = ((lane & 3) ^ (3 * ((lane >> 5) & 1))) * 8;
#pragma unroll
        for (int i = 0; i < 4; ++i) aoff[i] = (unsigned)(((m0 + 64 * wid + 16 * i + rr) * lda + cc) * 2);
#pragma unroll
        for (int i = 0; i < 2; ++i) boff[i] = (unsigned)(((n0 + 32 * wid + 16 * i + rr) * K + cc) * 2);
    }
    auto stage = [&](int kt, int buf) {
        const int kb = kt * 32;
        const char* Ab; const char* Bb = (const char*)(Bt + kb);
        if (kb < ksplit) Ab = (const char*)(A0 + kb); else Ab = (const char*)(A1 + (kb - ksplit));
        char* sa = smem + buf * 24576 + wid * 4096 + lane * 16; char* sb = smem + buf * 24576 + 16384 + wid * 2048 + lane * 16;
#pragma unroll
        for (int i = 0; i < 4; ++i) __builtin_amdgcn_global_load_lds((const unsigned*)(Ab + aoff[i]), (unsigned*)(sa + i * 1024), 16, 0, 0);
#pragma unroll
        for (int i = 0; i < 2; ++i) __builtin_amdgcn_global_load_lds((const unsigned*)(Bb + boff[i]), (unsigned*)(sb + i * 1024), 16, 0, 0);
    };
    const int fpos = (((lane >> 4) ^ (3 * ((lane >> 3) & 1))) << 4) + (lane & 15) * 64;
    auto compute = [&](int buf) {
        const char* sa = smem + buf * 24576 + wm * 8192 + fpos; const char* sb = smem + buf * 24576 + 16384 + wn * 4096 + fpos;
        bf16x8 af[8], bfr[4];
#pragma unroll
        for (int i = 0; i < 8; ++i) af[i] = *(const bf16x8*)(sa + i * 1024);
#pragma unroll
        for (int j = 0; j < 4; ++j) bfr[j] = *(const bf16x8*)(sb + j * 1024);
        __builtin_amdgcn_s_setprio(1);
#pragma unroll
        for (int i = 0; i < 8; ++i)
#pragma unroll
            for (int j = 0; j < 4; ++j) {
                if (MODE == 0) acc[i][j] = __builtin_amdgcn_mfma_f32_16x16x32_bf16(bfr[j], af[i], acc[i][j], 0, 0, 0);
                else acc[i][j] = __builtin_amdgcn_mfma_f32_16x16x32_bf16(af[i], bfr[j], acc[i][j], 0, 0, 0);
            }
        __builtin_amdgcn_s_setprio(0);
    };
    stage(0, 0);
    asm volatile("s_waitcnt vmcnt(0)" ::: "memory");
    __syncthreads();
    for (int kt = 0; kt < nk; ++kt) {
        if (kt + 1 < nk) stage(kt + 1, (kt + 1) & 1);
        compute(kt & 1);
        asm volatile("s_waitcnt vmcnt(0)" ::: "memory");
        __syncthreads();
    }
}
__device__ __forceinline__ bool tile_sched(int it, int MT, int NT, int& mt, int& nt) {
    const int xg = blockIdx.x & 7, xi = (int)(blockIdx.x >> 3) * 2 + (int)(threadIdx.x >> 8), nper = (int)(gridDim.x >> 3) * 2;
    const int li = xi + nper * it;
    if (li >= (MT >> 3) * NT) return false;
    const int band = li / (8 * NT), r = li - band * 8 * NT;
    nt = r >> 3; mt = xg * (MT >> 3) + band * 8 + (r & 7);
    return true;
}
__device__ __forceinline__ void store_bf16x4(bf16_t* p, f32x4 v) { uint2 o; o.x = pack2(v[0], v[1]); o.y = pack2(v[2], v[3]); *(uint2*)p = o; }

#define G8_LAS __attribute__((address_space(3)))
namespace g8 {
constexpr int BM = 256, BK = 64, HALF = 128, HTB = HALF * BK * 2, NXCD = 8, WGM = 8;
__device__ __forceinline__ int lds_byte(int r, int c) { const int st = (r >> 4) * 2 + (c >> 5), rr = r & 15, cc = c & 31, ob = rr * 64 + cc * 2; return st * 1024 + (ob ^ (((ob >> 9) & 1) << 5)); }
__device__ __forceinline__ void stage_rc(int b, int& R, int& C) { const int st = b / 1024, sb = b % 1024, swz = sb ^ (((sb >> 9) & 1) << 5); R = (st >> 1) * 16 + swz / 64; C = (st & 1) * 32 + (swz % 64) / 2; }
__device__ __forceinline__ int perm32(int rho) { const int n = rho >> 4, i = rho & 15; return 8 * (i >> 2) + 4 * n + (i & 3); }
struct Unit { int pm, pn; };
struct Gemm { const bf16_t* A0; const bf16_t* A1; int lda, ksplit; const bf16_t* Bt; int M, N, K; };
struct StaticOrder {
    int nM, nN, nwg, G, c;
    __device__ __forceinline__ void init(int M, int N, int G_, int c_) { nM = M / BM; nN = N / BM; nwg = nM * nN; G = G_; c = c_; }
    __device__ __forceinline__ bool next(int i, Unit& u) const {
        const int L = i * G + c; if (L >= nwg) return false;
        int wgid = L; { const int q = nwg / NXCD, r = nwg % NXCD, xcd = wgid % NXCD, off = wgid / NXCD; wgid = (xcd < r ? xcd * (q + 1) : r * (q + 1) + (xcd - r) * q) + off; }
        const int nig = WGM * nN, gid = wgid / nig, fm = gid * WGM, gsz = (nM - fm) < WGM ? (nM - fm) : WGM;
        u.pm = fm + ((wgid % nig) % gsz); u.pn = (wgid % nig) / gsz; return true;
    }
};
template <class Epi>
__device__ __forceinline__ void gemm_phase(G8_LAS unsigned char* lds, const Gemm g, const StaticOrder& S, const Epi& E) {
    const int tid = threadIdx.x, wid = __builtin_amdgcn_readfirstlane(tid >> 6), lane = tid & 63, wr = wid >> 2, wc = wid & 3, fr = lane & 15, fq = lane >> 4;
    const int K = g.K, nt = K / BK, lda = g.lda;
    unsigned voffA[2], voffB[2];
#pragma unroll
    for (int i = 0; i < 2; ++i) { int R, C; stage_rc(tid * 16 + i * 8192, R, C); const int Rb = (R & ~31) + perm32(R & 31);
        voffA[i] = (unsigned)(R * lda + C) * 2u; voffB[i] = (unsigned)(Rb * K + C) * 2u; }
    const size_t hstepA = (size_t)HALF * lda * 2, hstepB = (size_t)HALF * K * 2;
    const unsigned ldsw = (unsigned)wid * 1024u;
    const int aoff = lds_byte(wr * 64 + fr, fq * 8), boff = lds_byte(wc * 32 + fr, fq * 8);
    auto aptr = [&](int pm, int kt) -> const char* { const int kb = kt * BK; const bf16_t* b = kb < g.ksplit ? g.A0 + kb : g.A1 + (kb - g.ksplit); return (const char*)b + (size_t)pm * 2 * hstepA; };
    auto bptr = [&](int pn, int kt) -> const char* { return (const char*)(g.Bt + kt * BK) + (size_t)pn * 2 * hstepB; };
#define G8_SA(b, h) (((b) * 2 + (h)) * HTB)
#define G8_SB(b, h) ((4 + (b) * 2 + (h)) * HTB)
#define G8_STAGE(bufoff, gbase, voff) do { _Pragma("unroll") for (int _i = 0; _i < 2; ++_i) \
        __builtin_amdgcn_global_load_lds((const unsigned*)((const char*)(gbase) + (voff)[_i]), (G8_LAS unsigned*)(lds + (bufoff) + ldsw + _i * 8192), 16, 0, 0); } while (0)
#define G8_LDA(dst, b, h) do { _Pragma("unroll") for (int m = 0; m < 4; ++m) _Pragma("unroll") for (int k = 0; k < 2; ++k) dst[m][k] = *(const G8_LAS bf16x8*)(lds + G8_SA(b, h) + aoff + m * 2048 + k * 1024); } while (0)
#define G8_LDB(dst, b, h) do { _Pragma("unroll") for (int n = 0; n < 2; ++n) _Pragma("unroll") for (int k = 0; k < 2; ++k) dst[n][k] = *(const G8_LAS bf16x8*)(lds + G8_SB(b, h) + boff + n * 2048 + k * 1024); } while (0)
#define G8_MMA(ai, bj, At, Bt) do { __builtin_amdgcn_s_setprio(1); _Pragma("unroll") for (int m = 0; m < 4; ++m) _Pragma("unroll") for (int n = 0; n < 2; ++n) _Pragma("unroll") for (int k = 0; k < 2; ++k) \
        acc[ai][bj][m][n] = __builtin_amdgcn_mfma_f32_16x16x32_bf16(Bt[n][k], At[m][k], acc[ai][bj][m][n], 0, 0, 0); __builtin_amdgcn_s_setprio(0); } while (0)
#define G8_WAIT_V(n) asm volatile("s_waitcnt vmcnt(" #n ")" ::: "memory")
#define G8_WAIT_L(n) asm volatile("s_waitcnt lgkmcnt(" #n ")" ::: "memory")
#define G8_BAR __builtin_amdgcn_s_barrier()
#define G8_SCHED __builtin_amdgcn_sched_barrier(0)
    Unit cur, nxt; int ui = 0;
    if (!S.next(0, cur)) return;
    f32x4 acc[2][2][4][2];
#pragma unroll
    for (int a = 0; a < 2; ++a)
#pragma unroll
        for (int b = 0; b < 2; ++b)
#pragma unroll
            for (int m = 0; m < 4; ++m)
#pragma unroll
                for (int n = 0; n < 2; ++n) acc[a][b][m][n] = (f32x4){0.f, 0.f, 0.f, 0.f};
    bf16x8 At[4][2], B0[2][2], B1[2][2];
    {
        const char* cA = aptr(cur.pm, 0); const char* cB = bptr(cur.pn, 0); const char* cA1 = aptr(cur.pm, 1); const char* cB1 = bptr(cur.pn, 1);
        G8_STAGE(G8_SB(0, 0), cB, voffB); G8_STAGE(G8_SB(0, 1), cB + hstepB, voffB); G8_STAGE(G8_SA(0, 0), cA, voffA); G8_STAGE(G8_SA(0, 1), cA + hstepA, voffA);
        if (wr == 1) G8_BAR;
        G8_WAIT_V(2); G8_BAR;
        G8_STAGE(G8_SB(1, 0), cB1, voffB); G8_STAGE(G8_SA(1, 0), cA1, voffA); G8_STAGE(G8_SB(1, 1), cB1 + hstepB, voffB);
        G8_WAIT_V(6); G8_BAR;
    }
    for (;;) {
        const bool has_next = S.next(ui + 1, nxt);
        const int npm = has_next ? nxt.pm : cur.pm, npn = has_next ? nxt.pn : cur.pn;
        for (int t = 0; t < nt; t += 2) {
            const bool last = (t == nt - 2);
            const char* a1 = aptr(cur.pm, t + 1);
            const char* a2 = last ? aptr(npm, 0) : aptr(cur.pm, t + 2); const char* b2 = last ? bptr(npn, 0) : bptr(cur.pn, t + 2);
            const char* a3 = last ? aptr(npm, 1) : aptr(cur.pm, t + 3); const char* b3 = last ? bptr(npn, 1) : bptr(cur.pn, t + 3);
            G8_LDB(B0, 0, 0); G8_LDB(B1, 0, 1); G8_SCHED; G8_LDA(At, 0, 0); G8_STAGE(G8_SA(1, 1), a1 + hstepA, voffA);
            G8_WAIT_V(8); G8_WAIT_L(0); G8_BAR; G8_MMA(0, 0, At, B0); G8_MMA(0, 1, At, B1); G8_BAR; G8_SCHED;
            G8_LDA(At, 0, 1); G8_STAGE(G8_SB(0, 0), b2, voffB); G8_STAGE(G8_SB(0, 1), b2 + hstepB, voffB); G8_STAGE(G8_SA(0, 0), a2, voffA);
            G8_WAIT_V(8); G8_WAIT_L(0); G8_BAR; G8_MMA(1, 0, At, B0); G8_MMA(1, 1, At, B1); G8_BAR; G8_SCHED;
            G8_LDB(B0, 1, 0); G8_LDB(B1, 1, 1); G8_SCHED; G8_LDA(At, 1, 0); G8_STAGE(G8_SA(0, 1), a2 + hstepA, voffA);
            G8_WAIT_V(8); G8_WAIT_L(0); G8_BAR; G8_MMA(0, 0, At, B0); G8_MMA(0, 1, At, B1); G8_BAR; G8_SCHED;
            G8_LDA(At, 1, 1); G8_STAGE(G8_SB(1, 0), b3, voffB); G8_STAGE(G8_SB(1, 1), b3 + hstepB, voffB); G8_STAGE(G8_SA(1, 0), a3, voffA);
            G8_WAIT_V(8); G8_WAIT_L(0); G8_BAR; G8_MMA(1, 0, At, B0); G8_MMA(1, 1, At, B1); G8_BAR; G8_SCHED;
        }
        if (wr == 0) G8_BAR;
        E(acc, cur, wr, wc, fr, fq);
        if (!has_next) break;
#pragma unroll
        for (int a = 0; a < 2; ++a)
#pragma unroll
            for (int b = 0; b < 2; ++b)
#pragma unroll
                for (int m = 0; m < 4; ++m)
#pragma unroll
                    for (int n = 0; n < 2; ++n) acc[a][b][m][n] = (f32x4){0.f, 0.f, 0.f, 0.f};
        cur = nxt; ++ui;
        if (wr == 1) G8_BAR;
    }
    G8_WAIT_V(0);
    G8_BAR;
#undef G8_SA
#undef G8_SB
#undef G8_STAGE
#undef G8_LDA
#undef G8_LDB
#undef G8_MMA
#undef G8_WAIT_V
#undef G8_WAIT_L
#undef G8_BAR
#undef G8_SCHED
}
struct EpiResid {
    const float* Rs; float* O;
    __device__ __forceinline__ void operator()(const f32x4 (&acc)[2][2][4][2], const Unit& u, int wr, int wc, int fr, int fq) const {
#pragma unroll
        for (int ai = 0; ai < 2; ++ai)
#pragma unroll
            for (int m = 0; m < 4; ++m) {
                const size_t o = (size_t)(u.pm * 256 + ai * 128 + wr * 64 + m * 16 + fr) * 1024 + u.pn * 256 + wc * 32 + fq * 8;
#pragma unroll
                for (int bj = 0; bj < 2; ++bj)
#pragma unroll
                    for (int n = 0; n < 2; ++n) {
                        const f32x4 r = *(const f32x4*)(Rs + o + bj * 128 + n * 4);
                        *(f32x4*)(O + o + bj * 128 + n * 4) = r + acc[ai][bj][m][n];
                    }
            }
    }
};
struct EpiCinU {
    bf16_t* U;
    __device__ __forceinline__ void operator()(const f32x4 (&acc)[2][2][4][2], const Unit& u, int wr, int wc, int fr, int fq) const {
#pragma unroll
        for (int ai = 0; ai < 2; ++ai)
#pragma unroll
            for (int m = 0; m < 4; ++m) {
                bf16_t* rp = U + (size_t)(u.pm * 256 + ai * 128 + wr * 64 + m * 16 + fr) * 2048 + u.pn * 256 + wc * 32 + fq * 8;
#pragma unroll
                for (int bj = 0; bj < 2; ++bj) {
                    const f32x4 a = acc[ai][bj][m][0], b = acc[ai][bj][m][1];
                    uint4 o; o.x = pack2(gelu_exact(a[0]), gelu_exact(a[1])); o.y = pack2(gelu_exact(a[2]), gelu_exact(a[3]));
                    o.z = pack2(gelu_exact(b[0]), gelu_exact(b[1])); o.w = pack2(gelu_exact(b[2]), gelu_exact(b[3]));
                    *(uint4*)(rp + bj * 128) = o;
                }
            }
    }
};
struct EpiCinV {
    bf16_t* VT; float* SSQ;
    __device__ __forceinline__ void operator()(const f32x4 (&acc)[2][2][4][2], const Unit& u, int wr, int wc, int fr, int fq) const {
#pragma unroll
        for (int ai = 0; ai < 2; ++ai) {
            float ss[16];
#pragma unroll
            for (int i = 0; i < 16; ++i) ss[i] = 0.f;
#pragma unroll
            for (int m = 0; m < 4; ++m) {
                const int c = u.pm * 256 + ai * 128 + wr * 64 + m * 16 + fr;
#pragma unroll
                for (int bj = 0; bj < 2; ++bj) {
                    float g[8];
#pragma unroll
                    for (int n = 0; n < 2; ++n)
#pragma unroll
                        for (int r = 0; r < 4; ++r) { const float x = gelu_exact(acc[ai][bj][m][n][r]); g[n * 4 + r] = x; ss[bj * 8 + n * 4 + r] += x * x; }
                    uint4 o; o.x = pack2(g[0], g[1]); o.y = pack2(g[2], g[3]); o.z = pack2(g[4], g[5]); o.w = pack2(g[6], g[7]);
                    *(uint4*)(VT + ((size_t)(u.pn * 2 + bj) * 2048 + c) * 128 + wc * 32 + fq * 8) = o;
                }
            }
            float mine = 0.f;
#pragma unroll
            for (int i = 0; i < 16; ++i) { const float s = row16_sum(ss[i]); mine = (fr == i) ? s : mine; }
            const int tok = u.pn * 256 + (fr >> 3) * 128 + wc * 32 + fq * 8 + (fr & 7);
            SSQ[(size_t)tok * 32 + u.pm * 4 + ai * 2 + wr] = mine;
        }
    }
};
struct EpiInN {
    bf16_t* R;
    __device__ __forceinline__ void operator()(const f32x4 (&acc)[2][2][4][2], const Unit& u, int wr, int wc, int fr, int fq) const {
        bf16_t* base; int pitch; float sc = 1.0f;
        if (u.pn < 2) { base = R + R_QSB + u.pn * 256; pitch = 512; sc = 0.125f; }
        else if (u.pn < 4) { base = R + R_KSB + (u.pn - 2) * 256; pitch = 512; }
        else if (u.pn == 4) { base = R + R_QG; pitch = 256; }
        else if (u.pn == 5) { base = R + R_KG; pitch = 256; }
        else { base = R + R_GG + (u.pn - 6) * 256; pitch = 512; }
#pragma unroll
        for (int ai = 0; ai < 2; ++ai)
#pragma unroll
            for (int m = 0; m < 4; ++m) {
                bf16_t* rp = base + (size_t)(u.pm * 256 + ai * 128 + wr * 64 + m * 16 + fr) * pitch + wc * 32 + fq * 8;
#pragma unroll
                for (int bj = 0; bj < 2; ++bj) {
                    const f32x4 a = acc[ai][bj][m][0] * sc, b = acc[ai][bj][m][1] * sc;
                    uint4 o; o.x = pack2(a[0], a[1]); o.y = pack2(a[2], a[3]); o.z = pack2(b[0], b[1]); o.w = pack2(b[2], b[3]);
                    *(uint4*)(rp + bj * 128) = o;
                }
            }
    }
};
struct EpiInT {
    bf16_t* R;
    __device__ __forceinline__ void operator()(const f32x4 (&acc)[2][2][4][2], const Unit& u, int wr, int wc, int fr, int fq) const {
#pragma unroll
        for (int ai = 0; ai < 2; ++ai)
#pragma unroll
            for (int m = 0; m < 4; ++m) {
                const int c = u.pm * 256 + ai * 128 + wr * 64 + m * 16 + fr;
#pragma unroll
                for (int bj = 0; bj < 2; ++bj) {
                    const int t = u.pn * 256 + bj * 128 + wc * 32 + fq * 8, b = t >> 11, s = t & 2047;
                    bf16_t* dst;
                    if (c < 512) dst = R + R_VTSB + ((size_t)((b * 8 + (c >> 6)) * 64 + (c & 63))) * 2048 + s;
                    else { const int c2 = c - 512; dst = R + R_VTG + ((size_t)((b * 4 + (c2 >> 7)) * 128 + (c2 & 127))) * 2048 + s; }
                    const f32x4 a = acc[ai][bj][m][0], bb = acc[ai][bj][m][1];
                    uint4 o; o.x = pack2(a[0], a[1]); o.y = pack2(a[2], a[3]); o.z = pack2(bb[0], bb[1]); o.w = pack2(bb[2], bb[3]);
                    *(uint4*)dst = o;
                }
            }
    }
};
}
__device__ __forceinline__ void phase_gemm_resid8(const bf16_t* A0, const bf16_t* A1, int lda, int ksplit, const bf16_t* Bt, int K, const float* Rs, float* O, char* smem_phys) {
    g8::Gemm g{A0, A1, lda, ksplit, Bt, T, 1024, K};
    g8::StaticOrder S; S.init(T, 1024, (int)gridDim.x, (int)blockIdx.x);
    g8::EpiResid E{Rs, O};
    g8::gemm_phase<g8::EpiResid>((G8_LAS unsigned char*)smem_phys, g, S, E);
}

__device__ __forceinline__ void phase_gemm_cin8(const Params& p, char* smem_phys) {
    const bf16_t* H = (const bf16_t*)(p.ws + OFF_H); const bf16_t* W = (const bf16_t*)(p.ws + OFF_WT_CIN);
    bf16_t* U = (bf16_t*)(p.ws + OFF_REGION); bf16_t* VT = U + (size_t)T * 2048; float* SSQ = (float*)(p.ws + OFF_SSQ);
    {
        g8::Gemm g{H, H, 1024, 1024, W, T, 2048, 1024};
        g8::StaticOrder S; S.init(T, 2048, (int)gridDim.x, (int)blockIdx.x);
        g8::EpiCinU E{U};
        g8::gemm_phase<g8::EpiCinU>((G8_LAS unsigned char*)smem_phys, g, S, E);
    }
    {
        const bf16_t* Wv = W + (size_t)2048 * 1024;
        g8::Gemm g{Wv, Wv, 1024, 1024, H, 2048, T, 1024};
        g8::StaticOrder S; S.init(2048, T, (int)gridDim.x, (int)blockIdx.x);
        g8::EpiCinV E{VT, SSQ};
        g8::gemm_phase<g8::EpiCinV>((G8_LAS unsigned char*)smem_phys, g, S, E);
    }
}
__device__ __forceinline__ void phase_gemm_in8(const Params& p, char* smem_phys) {
    const bf16_t* H = (const bf16_t*)(p.ws + OFF_H); const bf16_t* W = (const bf16_t*)(p.ws + OFF_WT_IN);
    bf16_t* R = (bf16_t*)(p.ws + OFF_REGION);
    {
        g8::Gemm g{H, H, 1024, 1024, W, T, 2048, 1024};
        g8::StaticOrder S; S.init(T, 2048, (int)gridDim.x, (int)blockIdx.x);
        g8::EpiInN E{R};
        g8::gemm_phase<g8::EpiInN>((G8_LAS unsigned char*)smem_phys, g, S, E);
    }
    {
        const bf16_t* Wv = W + (size_t)2048 * 1024;
        g8::Gemm g{Wv, Wv, 1024, 1024, H, 1024, T, 1024};
        g8::StaticOrder S; S.init(1024, T, (int)gridDim.x, (int)blockIdx.x);
        g8::EpiInT E{R};
        g8::gemm_phase<g8::EpiInT>((G8_LAS unsigned char*)smem_phys, g, S, E);
    }
    {
        const int lane = threadIdx.x & 63, wid = threadIdx.x >> 6, fr = lane & 15, fq = lane >> 4;
        float* ALR = (float*)(R + R_ALR);
        for (int task = (int)blockIdx.x * 8 + wid; task < T / 16; task += (int)gridDim.x * 8) {
            const bf16_t* a = H + (size_t)(task * 16 + fr) * 1024 + fq * 8; const bf16_t* w = W + (size_t)(3072 + fr) * 1024 + fq * 8;
            f32x4 acc = (f32x4){0.f, 0.f, 0.f, 0.f};
#pragma unroll 8
            for (int kk = 0; kk < 32; ++kk) {
                const bf16x8 af = *(const bf16x8*)(a + kk * 32), wf = *(const bf16x8*)(w + kk * 32);
                acc = __builtin_amdgcn_mfma_f32_16x16x32_bf16(wf, af, acc, 0, 0, 0);
            }
            *(f32x4*)(ALR + (size_t)(task * 16 + fr) * 16 + fq * 4) = acc;
        }
    }
}

__device__ __forceinline__ void phase_gemm_in(const Params& p, char* smem) {
    const bf16_t* A = (const bf16_t*)(p.ws + OFF_H); const bf16_t* Bt = (const bf16_t*)(p.ws + OFF_WT_IN);
    bf16_t* R = (bf16_t*)(p.ws + OFF_REGION);
    const int lane = VTID & 63, wid = VTID >> 6, wm = wid >> 1, wn = wid & 1;
    constexpr int NT = AB_IN_PAD / 128, MT = T / 128;
    int mt_, nt_;
    for (int it = 0; tile_sched(it, MT, NT, mt_, nt_); ++it) {
        const int m0 = mt_ * 128, n0 = nt_ * 128;
        f32x4 acc[4][4];
        const bool tr = (n0 >= 1024 && n0 < 1536) || (n0 >= 2048 && n0 < 2560);
        if (!tr) {
            gemm_mainloop<0>(A, A, 1024, 1024, Bt, 1024, m0, n0, acc, smem);
#pragma unroll
            for (int i = 0; i < 4; ++i)
#pragma unroll
                for (int j = 0; j < 4; ++j) {
                    const int m = m0 + wm * 64 + i * 16 + (lane & 15), n = n0 + wn * 64 + j * 16 + 4 * (lane >> 4);
                    const f32x4 v = acc[i][j];
                    if (n < 512) store_bf16x4(R + R_QSB + (size_t)m * 512 + n, v * 0.125f);
                    else if (n < 1024) store_bf16x4(R + R_KSB + (size_t)m * 512 + (n - 512), v);
                    else if (n < 1792) store_bf16x4(R + R_QG + (size_t)m * 256 + (n - 1536), v);
                    else if (n < 2048) store_bf16x4(R + R_KG + (size_t)m * 256 + (n - 1792), v);
                    else if (n < 3072) store_bf16x4(R + R_GG + (size_t)m * 512 + (n - 2560), v);
                    else if (n < AB_IN) *(f32x4*)((float*)(R + R_ALR) + (size_t)m * 16 + (n - 3072)) = v;
                }
        } else {
            gemm_mainloop<1>(A, A, 1024, 1024, Bt, 1024, m0, n0, acc, smem);
#pragma unroll
            for (int i = 0; i < 4; ++i)
#pragma unroll
                for (int j = 0; j < 4; ++j) {
                    const int m = m0 + wm * 64 + i * 16 + 4 * (lane >> 4), n = n0 + wn * 64 + j * 16 + (lane & 15);
                    const int b = m >> 11, s = m & 2047;
                    if (n < 1536) { const int c = n - 1024, hh = c >> 6, e = c & 63; store_bf16x4(R + R_VTSB + ((size_t)((b * 8 + hh) * 64 + e)) * 2048 + s, acc[i][j]); }
                    else { const int c = n - 2048, hh = c >> 7, e = c & 127; store_bf16x4(R + R_VTG + ((size_t)((b * 4 + hh) * 128 + e)) * 2048 + s, acc[i][j]); }
                }
        }
    }
}
__device__ __forceinline__ void phase_gemm_resid(const bf16_t* A0, const bf16_t* A1, int lda, int ksplit, const bf16_t* Bt, int K, const float* Rs, float* O, char* smem) {
    const int lane = VTID & 63, wid = VTID >> 6, wm = wid >> 1, wn = wid & 1;
    constexpr int NT = 8, MT = T / 256;
    int mt_, nt_;
    for (int it = 0; tile_sched(it, MT, NT, mt_, nt_); ++it) {
        const int m0 = mt_ * 256, n0 = nt_ * 128;
        f32x4 acc[8][4];
        gemm_mainloop256<0>(A0, A1, lda, ksplit, Bt, K, m0, n0, acc, smem);
#pragma unroll
        for (int i = 0; i < 8; ++i)
#pragma unroll
            for (int j = 0; j < 4; ++j) {
                const int m = m0 + wm * 128 + i * 16 + (lane & 15), n = n0 + wn * 64 + j * 16 + 4 * (lane >> 4);
                const f32x4 r = *(const f32x4*)(Rs + (size_t)m * 1024 + n);
                *(f32x4*)(O + (size_t)m * 1024 + n) = r + acc[i][j];
            }
    }
}
__device__ __forceinline__ void phase_gemm_cin(const Params& p, char* smem) {
    const bf16_t* A = (const bf16_t*)(p.ws + OFF_H); const bf16_t* Bt = (const bf16_t*)(p.ws + OFF_WT_CIN);
    bf16_t* U = (bf16_t*)(p.ws + OFF_REGION); bf16_t* VT = U + (size_t)T * 2048; float* SSQ = (float*)(p.ws + OFF_SSQ);
    const int lane = VTID & 63, wid = VTID >> 6, wm = wid >> 1, wn = wid & 1;
    constexpr int NT = 32, MT = T / 128;
    int mt_, nt_;
    for (int it = 0; tile_sched(it, MT, NT, mt_, nt_); ++it) {
        const int m0 = mt_ * 128, n0 = nt_ * 128;
        f32x4 acc[4][4];
        if (n0 < 2048) {
            gemm_mainloop<0>(A, A, 1024, 1024, Bt, 1024, m0, n0, acc, smem);
#pragma unroll
            for (int i = 0; i < 4; ++i)
#pragma unroll
                for (int j = 0; j < 4; ++j) {
                    const int m = m0 + wm * 64 + i * 16 + (lane & 15), n = n0 + wn * 64 + j * 16 + 4 * (lane >> 4);
                    f32x4 v = acc[i][j];
#pragma unroll
                    for (int r = 0; r < 4; ++r) v[r] = gelu_exact(v[r]);
                    store_bf16x4(U + (size_t)m * 2048 + n, v);
                }
        } else {
            gemm_mainloop<1>(A, A, 1024, 1024, Bt, 1024, m0, n0, acc, smem);
#pragma unroll
            for (int i = 0; i < 4; ++i) {
                float ss[4] = {0.f, 0.f, 0.f, 0.f};
#pragma unroll
                for (int j = 0; j < 4; ++j) {
                    const int m = m0 + wm * 64 + i * 16 + 4 * (lane >> 4), n = n0 + wn * 64 + j * 16 + (lane & 15);
                    f32x4 v = acc[i][j];
#pragma unroll
                    for (int r = 0; r < 4; ++r) { v[r] = gelu_exact(v[r]); ss[r] += v[r] * v[r]; }
                    const int chunk = m >> 7, s = m & 127, c = n - 2048;
                    store_bf16x4(VT + ((size_t)chunk * 2048 + c) * 128 + s, v);
                }
#pragma unroll
                for (int r = 0; r < 4; ++r) {
                    float v = ss[r];
                    v += __shfl_xor(v, 1); v += __shfl_xor(v, 2); v += __shfl_xor(v, 4); v += __shfl_xor(v, 8);
                    if ((lane & 15) == 0) { const int m = m0 + wm * 64 + i * 16 + 4 * (lane >> 4) + r; SSQ[(size_t)m * 32 + ((n0 - 2048) >> 6) + wn] = v; }
                }
            }
        }
    }
}

typedef float f32x16 __attribute__((ext_vector_type(16)));
__device__ __forceinline__ void sb_fast(const Params& p, char* smem, unsigned* ctr) {
    bf16_t* R = (bf16_t*)(p.ws + OFF_REGION);
    char* KT = smem; char* VTt = smem + 8192;
    volatile int* flags = (volatile int*)(smem + 32768); volatile unsigned* slot = (volatile unsigned*)(smem + 32832);
    const int tid = threadIdx.x, lane = tid & 63, w = tid >> 6, r31 = lane & 31, h = lane >> 5;
    for (;;) {
        __syncthreads();
        if (tid == 0) *slot = atomicAdd(ctr, 1u);
        __syncthreads();
        const unsigned task = *slot;
        if (task >= 1024u) break;
        const int qblk = 7 - (int)(task >> 7), bh = task & 127, b = bh >> 3, hh = bh & 7;
        const int q0 = qblk * 256, qbase = q0 + 32 * w;
        bf16_t* qrow = R + R_QSB + (size_t)(b * 2048 + qbase + r31) * 512 + hh * 64;
        bf16x8 qf[4];
#pragma unroll
        for (int kk = 0; kk < 4; ++kk) qf[kk] = *(const bf16x8*)(qrow + 16 * kk + 8 * h);
        f32x16 oacc[2];
#pragma unroll
        for (int nt = 0; nt < 2; ++nt)
#pragma unroll
            for (int i = 0; i < 16; ++i) oacc[nt][i] = 0.f;
        float Rr = 1.0f;
        const int t = qbase + r31;
        for (int kt = q0 / 64 + 3; kt >= 0; --kt) {
            __syncthreads();
            { const int wd = __all(Rr == 0.f); if (lane == 0) flags[w] = wd; }
            __syncthreads();
            if (flags[0] & flags[1] & flags[2] & flags[3] & flags[4] & flags[5] & flags[6] & flags[7]) break;
            const int s_tile = kt * 64;
            {
                const int c = tid, row = c >> 3, ch = c & 7;
                const u32x4 kv = *(const u32x4*)(R + R_KSB + (size_t)(b * 2048 + s_tile + row) * 512 + hh * 64 + ch * 8);
                const u32x4 vv = *(const u32x4*)(R + R_VTSB + ((size_t)((b * 8 + hh) * 64 + row)) * 2048 + s_tile + ch * 8);
                *(u32x4*)(KT + row * 128 + ((ch ^ (row & 7)) << 4)) = kv;
                *(uint2*)(VTt + row * 136 + ch * 16) = make_uint2(vv[0], vv[1]);
                *(uint2*)(VTt + row * 136 + ch * 16 + 8) = make_uint2(vv[2], vv[3]);
            }
            __syncthreads();
#pragma unroll
            for (int sbk = 1; sbk >= 0; --sbk) {
                const int key_lo = s_tile + 32 * sbk;
                if (key_lo >= qbase + 31) continue;
                if (__all(Rr == 0.f)) continue;
                f32x16 st;
#pragma unroll
                for (int i = 0; i < 16; ++i) st[i] = 0.f;
                const int krow = 32 * sbk + r31;
#pragma unroll
                for (int kk = 0; kk < 4; ++kk) {
                    const bf16x8 kf = *(const bf16x8*)(KT + krow * 128 + (((2 * kk + h) ^ (krow & 7)) << 4));
                    st = __builtin_amdgcn_mfma_f32_32x32x16_bf16(kf, qf[kk], st, 0, 0, 0);
                }
                float a[16], G[4];
#pragma unroll
                for (int g = 0; g < 4; ++g) {
                    float sg[4], m[4];
#pragma unroll
                    for (int i = 0; i < 4; ++i) {
                        const int s = key_lo + 8 * g + 4 * h + i;
                        const float z = fminf(fmaxf(st[4 * g + i], -80.f), 80.f);
                        const float ez = __expf(-z), sig = 1.0f / (1.0f + ez);
                        const bool valid = s < t;
                        sg[i] = valid ? sig : 0.f; m[i] = valid ? ez * sig : 1.0f;
                    }
                    const float x2 = m[3], x1 = x2 * m[2], x0 = x1 * m[1];
                    G[g] = x0 * m[0];
                    a[4 * g + 3] = sg[3]; a[4 * g + 2] = sg[2] * x2; a[4 * g + 1] = sg[1] * x1; a[4 * g] = sg[0] * x0;
                }
                float Go[4], P[4];
#pragma unroll
                for (int g = 0; g < 4; ++g) { Go[g] = __shfl_xor(G[g], 32); P[g] = G[g] * Go[g]; }
                const float c2 = P[3], c1 = c2 * P[2], c0 = c1 * P[1];
                float Tg[4];
                Tg[3] = Rr; Tg[2] = Rr * c2; Tg[1] = Rr * c1; Tg[0] = Rr * c0;
#pragma unroll
                for (int g = 0; g < 4; ++g) {
                    const float tg = (h == 0) ? Tg[g] * Go[g] : Tg[g];
                    a[4 * g] *= tg; a[4 * g + 1] *= tg; a[4 * g + 2] *= tg; a[4 * g + 3] *= tg;
                }
                Rr = Rr * c0 * P[0];
#pragma unroll
                for (int s2 = 0; s2 < 2; ++s2) {
                    union { bf16x8 v; unsigned u[4]; } af;
#pragma unroll
                    for (int j2 = 0; j2 < 4; ++j2) af.u[j2] = pack2(a[8 * s2 + 2 * j2], a[8 * s2 + 2 * j2 + 1]);
#pragma unroll
                    for (int nt = 0; nt < 2; ++nt) {
                        const char* vp = VTt + (32 * nt + r31) * 136 + 64 * sbk + 32 * s2 + 8 * h;
                        union { bf16x8 v; uint2 hh2[2]; } vf;
                        vf.hh2[0] = *(const uint2*)vp; vf.hh2[1] = *(const uint2*)(vp + 16);
                        oacc[nt] = __builtin_amdgcn_mfma_f32_32x32x16_bf16(af.v, vf.v, oacc[nt], 0, 0, 0);
                    }
                }
            }
        }
#pragma unroll
        for (int nt = 0; nt < 2; ++nt)
#pragma unroll
            for (int i = 0; i < 16; ++i) {
                const int qq = (i & 3) + 8 * (i >> 2) + 4 * h;
                R[R_QSB + (size_t)(b * 2048 + qbase + qq) * 512 + hh * 64 + 32 * nt + r31] = f2bf(oacc[nt][i]);
            }
    }
}
__device__ __forceinline__ float log_sigmoid(float x) { return fminf(x, 0.f) - log1pf(__expf(-fabsf(x))); }
__device__ __forceinline__ int swz(int row, int chunk) { return row * 128 + ((chunk ^ (row & 7)) << 4); }
__device__ __forceinline__ void gla_prep(const Params& p, char* smem) {
    bf16_t* R = (bf16_t*)(p.ws + OFF_REGION);
    const float* ALR = (const float*)(R + R_ALR);
    bf16_t* KOTg = R + R_KOT; float* DECg = (float*)(R + R_DEC);
    float* SEG = (float*)smem; float* ALRs = SEG + 256;
    const int tid = VTID, d = tid & 63, w = tid >> 6;
    for (int task = VBID; task < 2048; task += VGRID) {
        const int bh = task >> 5, c = task & 31, b = bh >> 2, hh = bh & 3;
        const size_t rowbase = (size_t)b * 2048 + c * 64;
        unsigned qr[16], kr[16];
#pragma unroll
        for (int i = 0; i < 16; ++i) { const size_t row = rowbase + w * 16 + i; qr[i] = R[R_QG + row * 256 + hh * 64 + d]; kr[i] = R[R_KG + row * 256 + hh * 64 + d]; }
        const f32x4 ar = *(const f32x4*)(ALR + rowbase * 16 + tid * 4);
        float w2r[16];
#pragma unroll
        for (int r = 0; r < 16; ++r) w2r[r] = p.ab_w_alpha2[r * 256 + hh * 64 + d];
        const float b2r = p.ab_b_alpha2[hh * 64 + d];
        __syncthreads();
        *(f32x4*)(ALRs + tid * 4) = ar;
        __syncthreads();
        float cs[16]; float run = 0.f;
#pragma unroll
        for (int i = 0; i < 16; ++i) {
            const float* al = ALRs + (w * 16 + i) * 16;
            float pre = b2r;
#pragma unroll
            for (int r = 0; r < 16; ++r) pre += al[r] * w2r[r];
            run += log_sigmoid(pre) * (1.0f / 16.0f);
            cs[i] = run;
        }
        SEG[w * 64 + d] = run;
        __syncthreads();
        float off = 0.f, tot = 0.f;
#pragma unroll
        for (int w2 = 0; w2 < 4; ++w2) { const float s = SEG[w2 * 64 + d]; tot += s; if (w2 < w) off += s; }
        unsigned kop[8];
#pragma unroll
        for (int i2 = 0; i2 < 8; ++i2) {
            float kov[2];
#pragma unroll
            for (int u = 0; u < 2; ++u) {
                const int i = 2 * i2 + u;
                const float bc = off + cs[i];
                const float kv = bf2f((bf16_t)kr[i]);
                const size_t row = rowbase + w * 16 + i;
                R[R_QG + row * 256 + hh * 64 + d] = f2bf(bf2f((bf16_t)qr[i]) * 0.125f * __expf(bc));
                R[R_KG + row * 256 + hh * 64 + d] = f2bf(kv * __expf(-bc));
                kov[u] = kv * __expf(tot - bc);
            }
            kop[i2] = pack2(kov[0], kov[1]);
        }
        bf16_t* kp = KOTg + ((size_t)task * 64 + d) * 64 + w * 16;
        *(uint4*)kp = make_uint4(kop[0], kop[1], kop[2], kop[3]);
        *(uint4*)(kp + 8) = make_uint4(kop[4], kop[5], kop[6], kop[7]);
        if (w == 0) DECg[(size_t)task * 64 + d] = __expf(tot);
    }
}
__device__ __forceinline__ void gla_scan(const Params& p, char* smem, bool dry = false) {
    bf16_t* R = (bf16_t*)(p.ws + OFF_REGION);
    const bf16_t* KOTg = R + R_KOT; const float* DECg = (const float*)(R + R_DEC);
    char* QS = smem; char* KS = smem + 8192; char* KOT = smem + 16384; char* VTs = smem + 24576; char* SPT = smem + 40960;
    float* DEC = (float*)(smem + 57344); float* GN = DEC + 64;
    const int tid = VTID, lane = tid & 63, w = tid >> 6, l15_ = lane & 15, q4 = lane >> 4;
    for (int task = VBID; task < 64; task += VGRID) {
        const int b = task >> 2, hh = task & 3;
        f32x4 Sacc[8];
#pragma unroll
        for (int nt = 0; nt < 8; ++nt) Sacc[nt] = (f32x4){0.f, 0.f, 0.f, 0.f};
        __syncthreads();
        for (int i = tid; i < 1024; i += 256) *(uint4*)(SPT + i * 16) = make_uint4(0, 0, 0, 0);
        if (tid < 128) GN[tid] = p.ab_gla_norm[hh * 128 + tid];
        const size_t rowbase = (size_t)b * 2048;
        const bf16_t* vbase = R + R_VTG + ((size_t)((b * 4 + hh) * 128)) * 2048;
        u32x4 tq[2], tk[2], tko[2], vr[4]; float td = 0.f;
        auto prefetch = [&](int c) {
            const int t0 = c * 64;
#pragma unroll
            for (int i = 0; i < 2; ++i) {
                const int cid = tid + 256 * i, row = cid >> 3, ch = cid & 7;
                tq[i] = *(const u32x4*)(R + R_QG + (rowbase + t0 + row) * 256 + hh * 64 + ch * 8);
                tk[i] = *(const u32x4*)(R + R_KG + (rowbase + t0 + row) * 256 + hh * 64 + ch * 8);
                tko[i] = *(const u32x4*)(KOTg + (((size_t)task * 32 + c) * 64 + row) * 64 + ch * 8);
            }
#pragma unroll
            for (int i = 0; i < 4; ++i) { const int cid = tid + 256 * i, e = cid >> 3, ch = cid & 7; vr[i] = *(const u32x4*)(vbase + (size_t)e * 2048 + t0 + ch * 8); }
            if (tid < 64) td = DECg[((size_t)task * 32 + c) * 64 + tid];
        };
        prefetch(0);
        for (int c = 0; c < 32; ++c) {
            int lz = 0; asm volatile("" : "+v"(lz));
            const int l15 = l15_ + lz;
            const int cx = (q4 ^ (l15 & 7)) << 4;
            const int rb0 = l15 * 128 + cx, rb1 = l15 * 128 + (cx ^ 64);
#pragma unroll
            for (int i = 0; i < 2; ++i) {
                const int cid = tid + 256 * i + lz, row = cid >> 3, ch = cid & 7;
                *(u32x4*)(QS + swz(row, ch)) = tq[i]; *(u32x4*)(KS + swz(row, ch)) = tk[i]; *(u32x4*)(KOT + swz(row, ch)) = tko[i];
            }
#pragma unroll
            for (int i = 0; i < 4; ++i) { const int cid = tid + 256 * i + lz, e = cid >> 3, ch = cid & 7; *(u32x4*)(VTs + swz(e, ch)) = vr[i]; }
            if (tid < 64) DEC[tid] = td;
            uint2 gr[8];
            const unsigned goff = (unsigned)((rowbase + c * 64 + 16 * w + l15) * 512 + hh * 128 + 4 * q4);
            bf16_t* const gbase = R + R_GG;
#pragma unroll
            for (int nt = 0; nt < 8; ++nt) gr[nt] = *(const uint2*)(gbase + (goff + 16 * nt));
            if (c + 1 < 32) prefetch(c + 1);
            __syncthreads();
            bf16x8 qf[2];
#pragma unroll
            for (int kk = 0; kk < 2; ++kk) qf[kk] = *(const bf16x8*)(QS + w * 2048 + (kk ? rb1 : rb0));
            f32x4 sT[4];
#pragma unroll
            for (int st = 0; st < 4; ++st) {
                sT[st] = (f32x4){0.f, 0.f, 0.f, 0.f};
                if (st <= w) {
#pragma unroll
                    for (int kk = 0; kk < 2; ++kk) { const bf16x8 kf = *(const bf16x8*)(KS + st * 2048 + (kk ? rb1 : rb0)); sT[st] = __builtin_amdgcn_mfma_f32_16x16x32_bf16(kf, qf[kk], sT[st], 0, 0, 0); }
#pragma unroll
                    for (int r = 0; r < 4; ++r) if (16 * st + 4 * q4 + r > 16 * w + l15) sT[st][r] = 0.f;
                }
            }
            bf16x8 af[2];
#pragma unroll
            for (int ks2 = 0; ks2 < 2; ++ks2) {
                union { bf16x8 v; unsigned u[4]; } cv;
                cv.u[0] = pack2(sT[2 * ks2][0], sT[2 * ks2][1]); cv.u[1] = pack2(sT[2 * ks2][2], sT[2 * ks2][3]);
                cv.u[2] = pack2(sT[2 * ks2 + 1][0], sT[2 * ks2 + 1][1]); cv.u[3] = pack2(sT[2 * ks2 + 1][2], sT[2 * ks2 + 1][3]);
                af[ks2] = cv.v;
            }
            const int vb = l15 * 128 + ((((q4 >> 1) ^ (l15 & 7)) << 4) | ((q4 & 1) * 8));
            f32x4 o[8];
#pragma unroll
            for (int nt = 0; nt < 8; ++nt) {
                o[nt] = (f32x4){0.f, 0.f, 0.f, 0.f};
                const int e = 16 * nt + l15;
#pragma unroll
                for (int kk = 0; kk < 2; ++kk) { const bf16x8 sf = *(const bf16x8*)(SPT + nt * 2048 + (kk ? rb1 : rb0)); o[nt] = __builtin_amdgcn_mfma_f32_16x16x32_bf16(sf, qf[kk], o[nt], 0, 0, 0); }
#pragma unroll
                for (int ks2 = 0; ks2 < 2; ++ks2) {
                    if (2 * ks2 <= w) {
                        union { bf16x8 v; uint2 h[2]; } cv;
                        cv.h[0] = *(const uint2*)(VTs + nt * 2048 + (vb ^ (ks2 * 64)));
                        cv.h[1] = *(const uint2*)(VTs + nt * 2048 + (vb ^ (ks2 * 64) ^ 32));
                        o[nt] = __builtin_amdgcn_mfma_f32_16x16x32_bf16(cv.v, af[ks2], o[nt], 0, 0, 0);
                    }
                }
            }
            {
                const float4 dc = *(const float4*)(DEC + 16 * w + 4 * q4);
                bf16x8 kof[2];
#pragma unroll
                for (int kk = 0; kk < 2; ++kk) kof[kk] = *(const bf16x8*)(KOT + w * 2048 + (kk ? rb1 : rb0));
#pragma unroll
                for (int nt = 0; nt < 8; ++nt) {
                    Sacc[nt][0] *= dc.x; Sacc[nt][1] *= dc.y; Sacc[nt][2] *= dc.z; Sacc[nt][3] *= dc.w;
#pragma unroll
                    for (int kk = 0; kk < 2; ++kk) { const bf16x8 vf = *(const bf16x8*)(VTs + nt * 2048 + (kk ? rb1 : rb0)); Sacc[nt] = __builtin_amdgcn_mfma_f32_16x16x32_bf16(kof[kk], vf, Sacc[nt], 0, 0, 0); }
                }
            }
            __syncthreads();
#pragma unroll
            for (int nt = 0; nt < 8; ++nt) {
                const int e = 16 * nt + l15;
                uint2 pk; pk.x = pack2(Sacc[nt][0], Sacc[nt][1]); pk.y = pack2(Sacc[nt][2], Sacc[nt][3]);
                *(uint2*)(SPT + nt * 2048 + l15 * 128 + (((2 * w + (q4 >> 1)) ^ (l15 & 7)) << 4) + (q4 & 1) * 8) = pk;
            }
            float ssq = 0.f;
#pragma unroll
            for (int nt = 0; nt < 8; ++nt) ssq += (o[nt][0] * o[nt][0] + o[nt][1] * o[nt][1]) + (o[nt][2] * o[nt][2] + o[nt][3] * o[nt][3]);
            ssq += __shfl_xor(ssq, 16); ssq += __shfl_xor(ssq, 32);
            const float rsd = rsqrtf(ssq * (1.0f / 128.0f) + EPS);
#pragma unroll
            for (int nt = 0; nt < 8; ++nt) {
                asm volatile("" ::: "memory");
                const f32x4 gn = *(const f32x4*)(GN + 16 * nt + 4 * q4);
                const float g0 = lo2f(gr[nt].x), g1 = hi2f(gr[nt].x), g2 = lo2f(gr[nt].y), g3 = hi2f(gr[nt].y);
                uint2 ov;
                ov.x = pack2(o[nt][0] * rsd * gn[0] * (g0 / (1.0f + __expf(-g0))), o[nt][1] * rsd * gn[1] * (g1 / (1.0f + __expf(-g1))));
                ov.y = pack2(o[nt][2] * rsd * gn[2] * (g2 / (1.0f + __expf(-g2))), o[nt][3] * rsd * gn[3] * (g3 / (1.0f + __expf(-g3))));
                if (!dry || ov.x == 0x7fc17fc1u) *(uint2*)(gbase + (goff + 16 * nt)) = ov;
            }
        }
    }
}

__device__ __forceinline__ unsigned ord_key(float f) { const unsigned u = __float_as_uint(f); return (u & 0x80000000u) ? ~u : (u | 0x80000000u); }
__device__ __forceinline__ float unord_key(unsigned k) { return __uint_as_float((k & 0x80000000u) ? (k & 0x7fffffffu) : ~k); }
__device__ __forceinline__ void ce_desc(unsigned& a, unsigned& b) { const unsigned hi = max(a, b), lo = min(a, b); a = hi; b = lo; }
__device__ __forceinline__ void bitonic_sort16_desc(unsigned (&a)[16]) {
#pragma unroll
    for (int k = 2; k <= 16; k <<= 1)
#pragma unroll
        for (int j = k >> 1; j > 0; j >>= 1)
#pragma unroll
            for (int i = 0; i < 16; ++i) { const int l = i ^ j; if (l > i) { if ((i & k) == 0) ce_desc(a[i], a[l]); else ce_desc(a[l], a[i]); } }
}
__device__ __forceinline__ void merge_top16(unsigned (&L)[16], const unsigned (&B)[16]) {
#pragma unroll
    for (int i = 0; i < 16; ++i) L[i] = max(L[i], B[15 - i]);
#pragma unroll
    for (int j = 8; j > 0; j >>= 1)
#pragma unroll
        for (int i = 0; i < 16; ++i) { const int l = i ^ j; if (l > i) ce_desc(L[i], L[l]); }
}
__device__ constexpr int cand_i(int n) { int c = 0; for (int i = 0; i < 16; ++i) for (int j = 0; j < 16; ++j) if ((i + 1) * (j + 1) <= 16) { if (c == n) return i; ++c; } return -1; }
__device__ constexpr int cand_j(int n) { int c = 0; for (int i = 0; i < 16; ++i) for (int j = 0; j < 16; ++j) if ((i + 1) * (j + 1) <= 16) { if (c == n) return j; ++c; } return -1; }
template <int N> struct CandTab { int i[N], j[N]; constexpr CandTab() : i(), j() { for (int n = 0; n < N; ++n) { i[n] = cand_i(n); j[n] = cand_j(n); } } };
__device__ __forceinline__ void peer_select_fast(const Params& p, int layer, char* smem) {
    const bf16_t* A = (const bf16_t*)(p.ws + OFF_H);
    const bf16_t* Bt = (const bf16_t*)(p.ws + OFF_WT_Q) + (size_t)layer * 2048 * 1024;
    const bf16_t* SK = (const bf16_t*)(p.ws + OFF_SK) + (size_t)layer * 8 * 2 * 128 * 128;
    unsigned short* IDX = (unsigned short*)(p.ws + OFF_IDX); float* GATE = (float*)(p.ws + OFF_GATE);
    const int tid_ = VTID;
    float* SC = (float*)smem; unsigned* XCH = (unsigned*)smem;
    int mt_, hh;
    for (int it = 0; tile_sched(it, T / 128, 8, mt_, hh); ++it) {
        const int m0 = mt_ * 128;
        unsigned L0[16], L1[16];
#pragma unroll
        for (int pp = 0; pp < 2; ++pp) {
            f32x4 acc[4][4];
            gemm_mainloop<0>(A, A, 1024, 1024, Bt, 1024, m0, hh * 256 + pp * 128, acc, smem);
            int lz = 0; asm volatile("" : "+v"(lz));
            const int tid = tid_ + lz, lane = tid & 63, wid = tid >> 6, wm = wid >> 1, wn = wid & 1, l15 = lane & 15, q4 = lane >> 4, token = tid & 127, half = tid >> 7;
#pragma unroll
            for (int i = 0; i < 4; ++i)
#pragma unroll
                for (int j = 0; j < 4; ++j) {
                    const int row = wm * 64 + i * 16 + l15, chunk = 2 * j + (q4 >> 1);
                    uint2 o; o.x = pack2(acc[i][j][0], acc[i][j][1]); o.y = pack2(acc[i][j][2], acc[i][j][3]);
                    *(uint2*)(smem + wn * 32768 + row * 128 + ((chunk ^ (row & 7)) << 4) + (q4 & 1) * 8) = o;
                }
            const bf16_t* SKp = SK + (size_t)((hh * 2 + pp) * 128) * 128;
#pragma unroll
            for (int i = 0; i < 8; ++i) {
                const int c = tid + 256 * i, row = c >> 4, ch16 = c & 15, ks = ch16 >> 3, ch = ch16 & 7;
                *(uint4*)(smem + ks * 32768 + 16384 + row * 128 + ((ch ^ (row & 7)) << 4)) = *(const uint4*)(SKp + (size_t)row * 128 + ch16 * 8);
            }
            __syncthreads();
#pragma unroll
            for (int i = 0; i < 4; ++i)
#pragma unroll
                for (int j = 0; j < 4; ++j) acc[i][j] = (f32x4){0.f, 0.f, 0.f, 0.f};
#pragma unroll
            for (int kt = 0; kt < 2; ++kt) {
                const char* sa = smem + kt * 32768; const char* sb = sa + 16384;
#pragma unroll
                for (int ks = 0; ks < 2; ++ks) {
                    bf16x8 af[4], bfr[4];
                    const int ch = ks * 4 + q4;
#pragma unroll
                    for (int i = 0; i < 4; ++i) { const int row = wm * 64 + i * 16 + l15; af[i] = *(const bf16x8*)(sa + row * 128 + ((ch ^ (row & 7)) << 4)); }
#pragma unroll
                    for (int j = 0; j < 4; ++j) { const int row = wn * 64 + j * 16 + l15; bfr[j] = *(const bf16x8*)(sb + row * 128 + ((ch ^ (row & 7)) << 4)); }
#pragma unroll
                    for (int i = 0; i < 4; ++i)
#pragma unroll
                        for (int j = 0; j < 4; ++j) acc[i][j] = __builtin_amdgcn_mfma_f32_16x16x32_bf16(bfr[j], af[i], acc[i][j], 0, 0, 0);
                }
            }
            __syncthreads();
#pragma unroll
            for (int i = 0; i < 4; ++i)
#pragma unroll
                for (int j = 0; j < 4; ++j) {
                    const int m = wm * 64 + i * 16 + l15, n = wn * 64 + j * 16 + 4 * q4;
#pragma unroll
                    for (int r = 0; r < 4; ++r) SC[m * 128 + ((n + r) ^ (m & 31))] = acc[i][j][r];
                }
            __syncthreads();
            unsigned L[16];
            {
                const float* srow = SC + token * 128 + half * 64; const int x = token & 31;
#pragma unroll
                for (int ch = 0; ch < 4; ++ch) {
                    unsigned Cc[16];
#pragma unroll
                    for (int i = 0; i < 16; ++i) { const int c = ch * 16 + i; Cc[i] = (ord_key(srow[c ^ x]) & ~127u) | (unsigned)(127 - (half * 64 + c)); }
                    bitonic_sort16_desc(Cc);
                    if (ch == 0) {
#pragma unroll
                        for (int i = 0; i < 16; ++i) L[i] = Cc[i];
                    } else merge_top16(L, Cc);
                }
            }
            __syncthreads();
            if (half == 1) {
#pragma unroll
                for (int i = 0; i < 16; ++i) XCH[token * 17 + i] = L[i];
            }
            __syncthreads();
            if (half == 0) {
                unsigned Xc[16];
#pragma unroll
                for (int i = 0; i < 16; ++i) Xc[i] = XCH[token * 17 + i];
                merge_top16(L, Xc);
            }
#pragma unroll
            for (int i = 0; i < 16; ++i) { if (pp == 0) L0[i] = L[i]; else L1[i] = L[i]; }
            __syncthreads();
        }
        unsigned* NIDX = (unsigned*)smem;
        const int token = tid_ & 127, half = tid_ >> 7;
        if (half == 0) {
            float s0[16], s1[16];
#pragma unroll
            for (int i = 0; i < 16; ++i) { s0[i] = unord_key(L0[i] & ~127u); s1[i] = unord_key(L1[i] & ~127u); }
            constexpr CandTab<64> ct{};
            unsigned C[16];
#pragma unroll
            for (int ch = 0; ch < 4; ++ch) {
                unsigned Cc[16];
#pragma unroll
                for (int i = 0; i < 16; ++i) {
                    const int n = ch * 16 + i;
                    if (ct.i[n] >= 0) Cc[i] = (ord_key(s0[ct.i[n] < 0 ? 0 : ct.i[n]] + s1[ct.j[n] < 0 ? 0 : ct.j[n]]) & ~255u) | (unsigned)(255 - (ct.i[n] * 16 + ct.j[n]));
                    else Cc[i] = 0u;
                }
                bitonic_sort16_desc(Cc);
                if (ch == 0) {
#pragma unroll
                    for (int i = 0; i < 16; ++i) C[i] = Cc[i];
                } else merge_top16(C, Cc);
            }
#pragma unroll
            for (int i = 0; i < 16; ++i) { NIDX[token * 33 + i] = 127u - (L0[i] & 127u); NIDX[token * 33 + 16 + i] = 127u - (L1[i] & 127u); }
            const float mx = unord_key(C[0] & ~255u);
            float e[16]; float sum = 0.f;
#pragma unroll
            for (int r = 0; r < 16; ++r) { e[r] = __expf(unord_key(C[r] & ~255u) - mx); sum += e[r]; }
            const float inv = 1.0f / sum;
            const size_t ob = (size_t)(m0 + token) * 128 + hh * 16;
#pragma unroll
            for (int r = 0; r < 16; ++r) {
                const unsigned code = 255u - (C[r] & 255u);
                const unsigned e0 = NIDX[token * 33 + (code >> 4)], e1 = NIDX[token * 33 + 16 + (code & 15)];
                IDX[ob + r] = (unsigned short)(e0 * 128 + e1);
                GATE[ob + r] = e[r] * inv;
            }
        }
        __syncthreads();
    }
}

__device__ __forceinline__ bf16x8 pack8(const float4 a, const float4 b) {
    u32x4 t; t.x = pack2(a.x, a.y); t.y = pack2(a.z, a.w); t.z = pack2(b.x, b.y); t.w = pack2(b.z, b.w);
    return __builtin_bit_cast(bf16x8, t);
}
__device__ __forceinline__ void fold_query_weights(const Params& p) {
    const int lane = VTID & 63, wid = VTID >> 6, fr = lane & 15, fq = lane >> 4;
    bf16_t* Wf = (bf16_t*)(p.ws + OFF_WT_Q);
    for (int task = VBID; task < 512; task += VGRID) {
        const int kb = task & 15, pp = (task >> 4) & 1, h = (task >> 5) & 7, layer = task >> 8;
        const float* wq = p.peer_w_q + (size_t)layer * 1024 * 2048 + (size_t)(kb * 64 + fr) * 2048 + h * 256 + pp * 128 + fq * 8;
        const float* sk = p.peer_subkeys + ((size_t)((layer * 8 + h) * 2 + pp) * 128 + wid * 32 + fr) * 128 + fq * 8;
        f32x4 acc[4][2];
#pragma unroll
        for (int kt = 0; kt < 4; ++kt)
#pragma unroll
            for (int jt = 0; jt < 2; ++jt) acc[kt][jt] = (f32x4){0.f, 0.f, 0.f, 0.f};
#pragma unroll
        for (int s = 0; s < 4; ++s) {
            bf16x8 a[4], b[2];
#pragma unroll
            for (int kt = 0; kt < 4; ++kt) { const float* q = wq + (size_t)(kt * 16) * 2048 + s * 32; a[kt] = pack8(*(const float4*)q, *(const float4*)(q + 4)); }
#pragma unroll
            for (int jt = 0; jt < 2; ++jt) { const float* q = sk + (size_t)(jt * 16) * 128 + s * 32; b[jt] = pack8(*(const float4*)q, *(const float4*)(q + 4)); }
#pragma unroll
            for (int kt = 0; kt < 4; ++kt)
#pragma unroll
                for (int jt = 0; jt < 2; ++jt) acc[kt][jt] = __builtin_amdgcn_mfma_f32_16x16x32_bf16(a[kt], b[jt], acc[kt][jt], 0, 0, 0);
        }
#pragma unroll
        for (int jt = 0; jt < 2; ++jt) {
            const int key = wid * 32 + jt * 16 + fr, cu = 128 * ((key >> 5) & 1) + 32 * (2 * pp + (key >> 6)) + (key & 31);
            bf16_t* row = Wf + ((size_t)layer * 2048 + h * 256 + cu) * 1024 + kb * 64 + 4 * fq;
#pragma unroll
            for (int kt = 0; kt < 4; ++kt) store_bf16x4(row + kt * 16, acc[kt][jt]);
        }
    }
}
struct EpiSelect {
    unsigned short* IDX; float* GATE; G8_LAS unsigned* X;
    __device__ __forceinline__ void operator()(const f32x4 (&acc)[2][2][4][2], const g8::Unit& u, int wr, int wc, int fr, int fq) const {
        const int pp = wc >> 1, wid = wr * 4 + wc; const bool odd = (wc & 1) != 0;
        const unsigned kb = 127u - (unsigned)((wc & 1) * 64 + fq * 8);
#pragma unroll
        for (int ai = 0; ai < 2; ++ai) {
            unsigned Lst[4][16];
#pragma unroll
            for (int m = 0; m < 4; ++m) {
                unsigned C[16], Xc[16];
#pragma unroll
                for (int bj = 0; bj < 2; ++bj)
#pragma unroll
                    for (int n = 0; n < 2; ++n)
#pragma unroll
                        for (int r = 0; r < 4; ++r) C[bj * 8 + n * 4 + r] = (ord_key(acc[ai][bj][m][n][r]) & ~127u) | (kb - (unsigned)(bj * 32 + n * 4 + r));
                bitonic_sort16_desc(C);
#pragma unroll
                for (int i = 0; i < 16; ++i) Xc[i] = (unsigned)__shfl_xor((int)C[i], 16);
                merge_top16(C, Xc);
#pragma unroll
                for (int i = 0; i < 16; ++i) Xc[i] = (unsigned)__shfl_xor((int)C[i], 32);
                merge_top16(C, Xc);
                if (odd) {
                    if (fq == 0) {
#pragma unroll
                        for (int i = 0; i < 16; ++i) X[((wr * 2 + pp) * 4 + m) * 272 + i * 16 + fr] = C[i];
                    }
                }
#pragma unroll
                for (int i = 0; i < 16; ++i) Lst[m][i] = C[i];
            }
            __syncthreads();
            if (!odd) {
#pragma unroll
                for (int m = 0; m < 4; ++m) {
                    unsigned Xc[16];
                    G8_LAS unsigned* xs = X + ((wr * 2 + pp) * 4 + m) * 272 + fr;
#pragma unroll
                    for (int i = 0; i < 16; ++i) Xc[i] = xs[i * 16];
                    merge_top16(Lst[m], Xc);
                    if (fq == 0) {
#pragma unroll
                        for (int i = 0; i < 16; ++i) xs[i * 16] = Lst[m][i];
                    }
                }
            }
            __syncthreads();
            if (wid < 2) {
                G8_LAS unsigned* x0 = X + ((wid * 2 + 0) * 4 + fq) * 272 + fr; G8_LAS unsigned* x1 = X + ((wid * 2 + 1) * 4 + fq) * 272 + fr;
                float s0[16], s1[16];
#pragma unroll
                for (int i = 0; i < 16; ++i) { s0[i] = unord_key(x0[i * 16] & ~127u); s1[i] = unord_key(x1[i * 16] & ~127u); }
                constexpr CandTab<64> ct{};
                unsigned C[16];
#pragma unroll
                for (int ch = 0; ch < 4; ++ch) {
                    unsigned Cc[16];
#pragma unroll
                    for (int i = 0; i < 16; ++i) {
                        const int n = ch * 16 + i;
                        if (ct.i[n] >= 0) Cc[i] = (ord_key(s0[ct.i[n] < 0 ? 0 : ct.i[n]] + s1[ct.j[n] < 0 ? 0 : ct.j[n]]) & ~255u) | (unsigned)(255 - (ct.i[n] * 16 + ct.j[n]));
                        else Cc[i] = 0u;
                    }
                    bitonic_sort16_desc(Cc);
                    if (ch == 0) {
#pragma unroll
                        for (int i = 0; i < 16; ++i) C[i] = Cc[i];
                    } else merge_top16(C, Cc);
                }
                const float mx = unord_key(C[0] & ~255u);
                float e[16]; float sum = 0.f;
#pragma unroll
                for (int r = 0; r < 16; ++r) { e[r] = __expf(unord_key(C[r] & ~255u) - mx); sum += e[r]; }
                const float inv = 1.0f / sum;
                const size_t ob = (size_t)(u.pm * 256 + ai * 128 + wid * 64 + fq * 16 + fr) * 128 + u.pn * 16;
                unsigned iw[8];
#pragma unroll
                for (int r = 0; r < 16; ++r) {
                    const unsigned code = 255u - (C[r] & 255u);
                    const unsigned e0 = 127u - (x0[(code >> 4) * 16] & 127u), e1 = 127u - (x1[(code & 15) * 16] & 127u);
                    const unsigned id = e0 * 128u + e1;
                    if (r & 1) iw[r >> 1] |= id << 16; else iw[r >> 1] = id;
                    e[r] *= inv;
                }
                *(uint4*)(IDX + ob) = make_uint4(iw[0], iw[1], iw[2], iw[3]); *(uint4*)(IDX + ob + 8) = make_uint4(iw[4], iw[5], iw[6], iw[7]);
#pragma unroll
                for (int r = 0; r < 4; ++r) *(float4*)(GATE + ob + r * 4) = make_float4(e[4 * r], e[4 * r + 1], e[4 * r + 2], e[4 * r + 3]);
            }
            __syncthreads();
        }
    }
};
__device__ __forceinline__ void phase_select8(const Params& p, int layer, char* smem_phys) {
    const bf16_t* H = (const bf16_t*)(p.ws + OFF_H); const bf16_t* Wf = (const bf16_t*)(p.ws + OFF_WT_Q) + (size_t)layer * 2048 * 1024;
    g8::Gemm g{H, H, 1024, 1024, Wf, T, 2048, 1024};
    g8::StaticOrder S; S.init(T, 2048, (int)gridDim.x, (int)blockIdx.x);
    EpiSelect E{(unsigned short*)(p.ws + OFF_IDX), (float*)(p.ws + OFF_GATE), (G8_LAS unsigned*)(smem_phys + 131072)};
    g8::gemm_phase<EpiSelect>((G8_LAS unsigned char*)smem_phys, g, S, E);
}

__device__ __forceinline__ float ub0(unsigned w) { float f; asm("v_cvt_f32_ubyte0 %0, %1" : "=v"(f) : "v"(w)); return f; }
__device__ __forceinline__ float ub1(unsigned w) { float f; asm("v_cvt_f32_ubyte1 %0, %1" : "=v"(f) : "v"(w)); return f; }
__device__ __forceinline__ float ub2(unsigned w) { float f; asm("v_cvt_f32_ubyte2 %0, %1" : "=v"(f) : "v"(w)); return f; }
__device__ __forceinline__ float ub3(unsigned w) { float f; asm("v_cvt_f32_ubyte3 %0, %1" : "=v"(f) : "v"(w)); return f; }
typedef _Float16 f16x2 __attribute__((ext_vector_type(2)));
__device__ __forceinline__ void glds16(const void* gsrc, unsigned lds_dst) {
    unsigned keep; const unsigned d = (unsigned)__builtin_amdgcn_readfirstlane((int)lds_dst);
    asm volatile("s_mov_b32 %0, m0\n\ts_mov_b32 m0, %2\n\ts_nop 0\n\tglobal_load_lds_dwordx4 %1, off\n\ts_mov_b32 m0, %0" : "=&s"(keep) : "v"(gsrc), "s"(d) : "memory");
}
__device__ __forceinline__ void peer_gather(const Params& p, int layer, const float* __restrict__ gnext, bool final_out, char* smem) {
    const unsigned char* REC = p.ws + OFF_UT + (size_t)layer * NEXP * 1152;
    bf16_t* H = (bf16_t*)(p.ws + OFF_H);
    const unsigned short* IDX = (const unsigned short*)(p.ws + OFF_IDX); const float* GATE = (const float*)(p.ws + OFF_GATE);
    float* X = p.out;
    const int lane = VTID & 63, wid = VTID >> 6, sub = lane >> 4, li = lane & 15;
    char* wbase = smem + (int)(threadIdx.x >> 6) * 19456;
    unsigned short* sIdx = (unsigned short*)wbase; float* sGate = (float*)(wbase + 256);
    const char* ring = wbase + 1024; const unsigned ringb = (unsigned)(size_t)ring;
    const int gw = VBID * 4 + wid, nw = VGRID * 4;
    for (int t = gw; t < T; t += nw) {
        {
            int lz = 0; asm volatile("" : "+v"(lz));
            const int l2 = 2 * (lane + lz);
            const unsigned idp = *(const unsigned*)(IDX + (size_t)t * 128 + l2);
            const float2 g2 = *(const float2*)(GATE + (size_t)t * 128 + l2);
            *(unsigned*)(sIdx + l2) = idp; *(float2*)(sGate + l2) = g2;
        }
        int xq[2][8]; float sx; float xg[2];
        {
            u32x4 xr[8]; float am = 0.f;
#pragma unroll
            for (int k = 0; k < 8; ++k) {
                xr[k] = *(const u32x4*)(H + (size_t)t * 1024 + (16 * (k >> 2) + li) * 32 + (k & 3) * 8);
#pragma unroll
                for (int c = 0; c < 4; ++c) am = fmaxf(am, fmaxf(fabsf(lo2f(xr[k][c])), fabsf(hi2f(xr[k][c]))));
            }
            am = fmaxf(am, __shfl_xor(am, 1)); am = fmaxf(am, __shfl_xor(am, 2)); am = fmaxf(am, __shfl_xor(am, 4)); am = fmaxf(am, __shfl_xor(am, 8));
            const float inv = am > 0.f ? 127.0f / am : 0.f;
            sx = am * (1.0f / 127.0f);
#pragma unroll
            for (int j = 0; j < 2; ++j) {
                int xs = 0;
#pragma unroll
                for (int d = 0; d < 8; ++d) {
                    const unsigned w0 = xr[j * 4 + (d >> 1)][(d & 1) * 2], w1 = xr[j * 4 + (d >> 1)][(d & 1) * 2 + 1];
                    const int q0 = __float2int_rn(lo2f(w0) * inv), q1 = __float2int_rn(hi2f(w0) * inv), q2 = __float2int_rn(lo2f(w1) * inv), q3 = __float2int_rn(hi2f(w1) * inv);
                    xq[j][d] = (q0 & 0xff) | ((q1 & 0xff) << 8) | ((q2 & 0xff) << 16) | ((q3 & 0xff) << 24);
                    xs += (q0 + q1) + (q2 + q3);
                }
                xg[j] = -7.5f * (float)xs;
            }
        }
        f16x2 accp[2][16];
#pragma unroll
        for (int j = 0; j < 2; ++j)
#pragma unroll
            for (int c = 0; c < 16; ++c) accp[j][c] = (f16x2){(_Float16)0.f, (_Float16)0.f};
        float wsg[2] = {0.f, 0.f};
        auto issue = [&](int sg) {
            const unsigned e_ = sIdx[sg * 4 + sub];
            const unsigned char* rec = REC + (size_t)e_ * 1152 + li * 16;
            const unsigned dst = ringb + (unsigned)(sg & 3) * 4608u;
            glds16(rec, dst); glds16(rec + 256, dst + 1024u); glds16(rec + 512, dst + 2048u); glds16(rec + 768, dst + 3072u);
            if (lane < 32) {
                const unsigned e2 = sIdx[sg * 4 + (lane >> 3)];
                glds16(REC + (size_t)e2 * 1152 + 1024 + (lane & 7) * 16, dst + 4096u);
            }
        };
        auto compute = [&](int sg) {
            const char* sl = ring + (sg & 3) * 4608;
            const u32x4 du0 = *(const u32x4*)(sl + lane * 16), du1 = *(const u32x4*)(sl + 1024 + lane * 16);
            const u32x4 dv0 = *(const u32x4*)(sl + 2048 + lane * 16), dv1 = *(const u32x4*)(sl + 3072 + lane * 16);
            const uint2 sc = *(const uint2*)(sl + 4096 + sub * 128 + li * 8);
            const float gt = sGate[sg * 4 + sub];
            const f16x2 us = __builtin_bit_cast(f16x2, sc.x), vs = __builtin_bit_cast(f16x2, sc.y);
            float pa = 0.f;
#pragma unroll
            for (int j = 0; j < 2; ++j) {
                int ia = 0;
#pragma unroll
                for (int d = 0; d < 4; ++d) {
                    const unsigned w = j ? du1[d] : du0[d];
                    ia = __builtin_amdgcn_sdot4((int)(w & 0x0f0f0f0fu), xq[j][2 * d], ia, false);
                    ia = __builtin_amdgcn_sdot4((int)((w >> 4) & 0x0f0f0f0fu), xq[j][2 * d + 1], ia, false);
                }
                pa += (float)us[j] * ((float)ia + xg[j]);
            }
            pa = row16_sum(pa);
            const float ww = gt * gelu_exact(pa * sx);
#pragma unroll
            for (int j = 0; j < 2; ++j) {
                const float wg = ww * (float)vs[j];
                wsg[j] += wg;
                const _Float16 wh = (_Float16)fminf(fmaxf(wg * 65536.0f, -65504.0f), 65504.0f);
                const f16x2 w2 = {wh, wh};
#pragma unroll
                for (int d = 0; d < 4; ++d) {
                    const unsigned wv = j ? dv1[d] : dv0[d];
                    const f16x2 c0 = __builtin_bit_cast(f16x2, (wv << 4) & 0x00f000f0u), c1 = __builtin_bit_cast(f16x2, wv & 0x00f000f0u);
                    const f16x2 c2 = __builtin_bit_cast(f16x2, (wv >> 4) & 0x00f000f0u), c3 = __builtin_bit_cast(f16x2, (wv >> 8) & 0x00f000f0u);
                    accp[j][4 * d + 0] = __builtin_elementwise_fma(c0, w2, accp[j][4 * d + 0]); accp[j][4 * d + 1] = __builtin_elementwise_fma(c1, w2, accp[j][4 * d + 1]);
                    accp[j][4 * d + 2] = __builtin_elementwise_fma(c2, w2, accp[j][4 * d + 2]); accp[j][4 * d + 3] = __builtin_elementwise_fma(c3, w2, accp[j][4 * d + 3]);
                }
            }
        };
        asm volatile("s_waitcnt vmcnt(0)" ::: "memory");
        issue(0); issue(1); issue(2);
#pragma unroll 1
        for (int sg = 0; sg < 29; ++sg) {
            issue(sg + 3);
            asm volatile("s_waitcnt vmcnt(15)" ::: "memory");
            compute(sg);
        }
        asm volatile("s_waitcnt vmcnt(10)" ::: "memory");
        compute(29);
        asm volatile("s_waitcnt vmcnt(5)" ::: "memory");
        compute(30);
        asm volatile("s_waitcnt vmcnt(0)" ::: "memory");
        compute(31);
        float acc[2][32];
#pragma unroll
        for (int j = 0; j < 2; ++j)
#pragma unroll
            for (int d = 0; d < 4; ++d) {
                acc[j][8 * d + 0] = 16.0f * (float)accp[j][4 * d + 0][0]; acc[j][8 * d + 2] = 16.0f * (float)accp[j][4 * d + 0][1];
                acc[j][8 * d + 4] = 16.0f * (float)accp[j][4 * d + 1][0]; acc[j][8 * d + 6] = 16.0f * (float)accp[j][4 * d + 1][1];
                acc[j][8 * d + 1] = 16.0f * (float)accp[j][4 * d + 2][0]; acc[j][8 * d + 3] = 16.0f * (float)accp[j][4 * d + 2][1];
                acc[j][8 * d + 5] = 16.0f * (float)accp[j][4 * d + 3][0]; acc[j][8 * d + 7] = 16.0f * (float)accp[j][4 * d + 3][1];
            }
        const bool up2 = (sub & 2) != 0, up1 = (sub & 1) != 0;
        float wsum = (up2 ? wsg[1] : wsg[0]) + __shfl_xor(up2 ? wsg[0] : wsg[1], 32);
        wsum += __shfl_xor(wsum, 16);
        float r1[32];
#pragma unroll
        for (int c = 0; c < 32; ++c) r1[c] = (up2 ? acc[1][c] : acc[0][c]) + __shfl_xor(up2 ? acc[0][c] : acc[1][c], 32);
        float r2[16];
#pragma unroll
        for (int c = 0; c < 16; ++c) r2[c] = (up1 ? r1[16 + c] : r1[c]) + __shfl_xor(up1 ? r1[c] : r1[16 + c], 16);
        const int col0 = (16 * (sub >> 1) + li) * 32 + (sub & 1) * 16;
        float ss = 0.f;
        float* xrow = X + (size_t)t * 1024 + col0;
#pragma unroll
        for (int c4 = 0; c4 < 4; ++c4) {
            const f32x4 a = *(const f32x4*)(xrow + c4 * 4);
#pragma unroll
            for (int c = 0; c < 4; ++c) { r2[c4 * 4 + c] = r2[c4 * 4 + c] - 7.5f * wsum + a[c]; ss += r2[c4 * 4 + c] * r2[c4 * 4 + c]; }
        }
        ss = wave_sum(ss);
        const float rstd = rsqrtf(ss * (1.0f / D) + EPS);
        const float* gp = gnext + col0;
        if (final_out) {
#pragma unroll
            for (int c4 = 0; c4 < 4; ++c4) {
                const f32x4 g = *(const f32x4*)(gp + c4 * 4);
                *(f32x4*)(xrow + c4 * 4) = (f32x4){r2[c4 * 4] * rstd * g[0], r2[c4 * 4 + 1] * rstd * g[1], r2[c4 * 4 + 2] * rstd * g[2], r2[c4 * 4 + 3] * rstd * g[3]};
            }
        } else {
            u32x4 o[2];
#pragma unroll
            for (int c4 = 0; c4 < 4; ++c4) {
                const f32x4 g = *(const f32x4*)(gp + c4 * 4);
                *(f32x4*)(xrow + c4 * 4) = (f32x4){r2[c4 * 4], r2[c4 * 4 + 1], r2[c4 * 4 + 2], r2[c4 * 4 + 3]};
                o[c4 >> 1][(c4 & 1) * 2] = pack2(r2[c4 * 4] * rstd * g[0], r2[c4 * 4 + 1] * rstd * g[1]);
                o[c4 >> 1][(c4 & 1) * 2 + 1] = pack2(r2[c4 * 4 + 2] * rstd * g[2], r2[c4 * 4 + 3] * rstd * g[3]);
            }
            bf16_t* hp = H + (size_t)t * 1024 + col0;
            *(u32x4*)hp = o[0]; *(u32x4*)(hp + 8) = o[1];
        }
    }
}

__device__ __forceinline__ void spatial_fast(const Params& p, char* smem) {
    bf16_t* U = (bf16_t*)(p.ws + OFF_REGION); const bf16_t* VT = U + (size_t)T * 2048; const float* SSQ = (const float*)(p.ws + OFF_SSQ);
    const int tid_ = VTID;
    for (int task = VBID; task < 2048; task += VGRID) {
        const int chunk = task >> 3, g = task & 7;
        int lz = 0; asm volatile("" : "+v"(lz));
        const int tid = tid_ + lz, lane = tid & 63, wid = tid >> 6, wm = wid >> 1, wn = wid & 1, l15 = lane & 15, q4 = lane >> 4;
        float* rs = (float*)(smem + 16384);
        if (tid < 128) {
            const float* sp = SSQ + (size_t)(chunk * 128 + tid) * 32;
            float s = 0.f;
#pragma unroll
            for (int i = 0; i < 8; ++i) { const f32x4 v = *(const f32x4*)(sp + 4 * i); s += (v[0] + v[1]) + (v[2] + v[3]); }
            rs[tid] = rsqrtf(s * (1.0f / 2048.0f) + EPS);
        }
        __syncthreads();
#pragma unroll
        for (int i = 0; i < 8; ++i) {
            const int c = tid + 256 * i, row = c >> 4, ch16 = c & 15, ks = ch16 >> 3, ch = ch16 & 7, s0 = ch16 * 8;
            const float* wp = p.c_w_spatial + ((size_t)(g * 128 + row)) * 128 + s0;
            const f32x4 w0 = *(const f32x4*)wp, w1 = *(const f32x4*)(wp + 4);
            const f32x4 r0 = *(const f32x4*)(rs + s0), r1 = *(const f32x4*)(rs + s0 + 4);
            float v[8];
#pragma unroll
            for (int j = 0; j < 4; ++j) { v[j] = (s0 + j <= row) ? w0[j] * r0[j] : 0.f; v[4 + j] = (s0 + 4 + j <= row) ? w1[j] * r1[j] : 0.f; }
            *(uint4*)(smem + ks * 32768 + row * 128 + ((ch ^ (row & 7)) << 4)) = make_uint4(pack2(v[0], v[1]), pack2(v[2], v[3]), pack2(v[4], v[5]), pack2(v[6], v[7]));
        }
        __syncthreads();
#pragma unroll 1
        for (int nh = 0; nh < 2; ++nh) {
            const int chan0 = g * 256 + nh * 128;
#pragma unroll
            for (int i = 0; i < 8; ++i) {
                const int c = tid + 256 * i, row = c >> 4, ch16 = c & 15, ks = ch16 >> 3, ch = ch16 & 7;
                *(uint4*)(smem + ks * 32768 + 16384 + row * 128 + ((ch ^ (row & 7)) << 4)) = *(const uint4*)(VT + ((size_t)chunk * 2048 + chan0 + row) * 128 + ch16 * 8);
            }
            __syncthreads();
            f32x4 acc[4][4];
#pragma unroll
            for (int i = 0; i < 4; ++i)
#pragma unroll
                for (int j = 0; j < 4; ++j) acc[i][j] = (f32x4){0.f, 0.f, 0.f, 0.f};
#pragma unroll
            for (int kt = 0; kt < 2; ++kt) {
                if (kt == 1 && wm == 0) continue;
                const char* sa = smem + kt * 32768; const char* sb = sa + 16384;
#pragma unroll
                for (int ks = 0; ks < 2; ++ks) {
                    bf16x8 af[4], bfr[4];
                    const int ch = ks * 4 + q4;
#pragma unroll
                    for (int i = 0; i < 4; ++i) { const int row = wm * 64 + i * 16 + l15; af[i] = *(const bf16x8*)(sa + row * 128 + ((ch ^ (row & 7)) << 4)); }
#pragma unroll
                    for (int j = 0; j < 4; ++j) { const int row = wn * 64 + j * 16 + l15; bfr[j] = *(const bf16x8*)(sb + row * 128 + ((ch ^ (row & 7)) << 4)); }
#pragma unroll
                    for (int i = 0; i < 4; ++i)
#pragma unroll
                        for (int j = 0; j < 4; ++j) acc[i][j] = __builtin_amdgcn_mfma_f32_16x16x32_bf16(bfr[j], af[i], acc[i][j], 0, 0, 0);
                }
            }
            __syncthreads();
#pragma unroll
            for (int i = 0; i < 4; ++i) {
                const int m = wm * 64 + i * 16 + l15;
                const float bias = p.c_b_spatial[g * 128 + m];
#pragma unroll
                for (int j = 0; j < 4; ++j) {
                    const int chan = chan0 + wn * 64 + j * 16 + 4 * q4;
                    const f32x4 vn = *(const f32x4*)(p.c_v_norm + chan);
                    bf16_t* up = U + (size_t)(chunk * 128 + m) * 2048 + chan;
                    const uint2 uu = *(const uint2*)up;
                    uint2 o;
                    o.x = pack2(lo2f(uu.x) * (vn[0] * acc[i][j][0] + bias), hi2f(uu.x) * (vn[1] * acc[i][j][1] + bias));
                    o.y = pack2(lo2f(uu.y) * (vn[2] * acc[i][j][2] + bias), hi2f(uu.y) * (vn[3] * acc[i][j][3] + bias));
                    *(uint2*)up = o;
                }
            }
        }
    }
}

#define XB_TMO      128
#define XB_XCNT(j)  (256  + 64 * (j))
#define XB_XSUB(j)  (1280 + 64 * (j))
#define XB_XGEN(j)  (2304 + 64 * (j))
#define XB_TOP      3328
#define XB_TOPGEN   3392
#define XCD_BAR_WORDS 3456
#define XB_SPIN_CAP (1u << 22)
#define LAS __attribute__((address_space(3)))
__device__ __forceinline__ unsigned xb_ld(unsigned* p)              { return __hip_atomic_load(p, __ATOMIC_RELAXED, __HIP_MEMORY_SCOPE_AGENT); }
__device__ __forceinline__ unsigned xb_add(unsigned* p, unsigned v) { return __hip_atomic_fetch_add(p, v, __ATOMIC_RELAXED, __HIP_MEMORY_SCOPE_AGENT); }
__device__ __forceinline__ unsigned xb_xcc_id() { return (unsigned)__builtin_amdgcn_s_getreg((3 << 11) | 20) & 0xFu; }
#define XB_SPIN(cond, bar) do { unsigned _sp = 0; while (cond) { __builtin_amdgcn_s_sleep(1); \
    if ((++_sp & 255u) == 0u) { if (xb_ld(&(bar)[XB_TMO])) break; if (_sp > XB_SPIN_CAP) { atomicAdd(&(bar)[XB_TMO], 1u); break; } } } } while (0)
struct XcdBarrier { unsigned* bar; unsigned x; volatile LAS unsigned* st; };
__device__ __forceinline__ XcdBarrier xcd_barrier_post(unsigned* bar, volatile LAS unsigned* st) {
    XcdBarrier b; b.bar = bar; b.x = xb_xcc_id(); b.st = st;
    if (threadIdx.x == 0) (void)xb_add(&bar[XB_XCNT(b.x)], 1u);
    return b;
}
__device__ __forceinline__ void xcd_barrier_complete(unsigned* bar, unsigned x, unsigned& nloc, unsigned& nx) {
    const unsigned G = gridDim.x * gridDim.y * gridDim.z;
    unsigned sum, cnt, mine, sp = 0u;
    for (;;) {
        sum = 0u; cnt = 0u; mine = 0u;
#pragma unroll
        for (unsigned j = 0; j < 16; ++j) { const unsigned c = xb_ld(&bar[XB_XCNT(j)]); sum += c; cnt += (c > 0u) ? 1u : 0u; mine = (j == x) ? c : mine; }
        if (sum == G) break;
        __builtin_amdgcn_s_sleep(1);
        if ((++sp & 255u) == 0u) { if (xb_ld(&bar[XB_TMO])) break; if (sp > XB_SPIN_CAP) { atomicAdd(&bar[XB_TMO], 1u); break; } }
    }
    nloc = mine > 0u ? mine : 1u; nx = cnt > 0u ? cnt : 1u;
}
__device__ __forceinline__ void xcd_barrier(const XcdBarrier& b) {
    asm volatile("s_waitcnt vmcnt(0)" ::: "memory");
    __syncthreads();
    if (threadIdx.x == 0) {
        unsigned* bar = b.bar;
        __builtin_amdgcn_s_waitcnt(0);
        unsigned nloc = b.st[0], nx = b.st[1];
        if (nloc == 0u) { xcd_barrier_complete(bar, b.x, nloc, nx); b.st[0] = nloc; b.st[1] = nx; }
        const unsigned old = xb_add(&bar[XB_XSUB(b.x)], 1u);
        const unsigned gen = old / nloc;
        if (old + 1u == (gen + 1u) * nloc) {
            __builtin_amdgcn_fence(__ATOMIC_RELEASE, "agent");
            asm volatile("s_waitcnt vmcnt(0)" ::: "memory");
            const unsigned og = xb_add(&bar[XB_TOP], 1u);
            const unsigned tg = og / nx;
            if (og + 1u == (tg + 1u) * nx) xb_add(&bar[XB_TOPGEN], 1u);
            else XB_SPIN(xb_ld(&bar[XB_TOPGEN]) == tg, bar);
            __builtin_amdgcn_fence(__ATOMIC_ACQUIRE, "agent");
            xb_add(&bar[XB_XGEN(b.x)], 1u);
            asm volatile("s_waitcnt vmcnt(0)" ::: "memory");
        } else {
            XB_SPIN(xb_ld(&bar[XB_XGEN(b.x)]) == gen, bar);
            __builtin_amdgcn_fence(__ATOMIC_ACQUIRE, "agent");
            asm volatile("s_waitcnt vmcnt(0)" ::: "memory");
        }
    }
    __syncthreads();
}

constexpr int NPHASE = 14;
constexpr int kDynLds = 163840;
__global__ void __launch_bounds__(512, 2) mega(Params p, int ph_lo, int ph_hi) {
    extern __shared__ __attribute__((aligned(16))) char smem_phys[];
    uint4& xb_words = *(uint4*)(smem_phys + kDynLds - 16);
    if (threadIdx.x == 0) xb_words = make_uint4(0u, 0u, 0u, 0u);
    __syncthreads();
    const XcdBarrier xbar = xcd_barrier_post((unsigned*)(p.ws + OFF_BAR), (volatile LAS unsigned*)&xb_words);
    char* smem = smem_phys + (threadIdx.x >> 8) * 65536;
    bf16_t* Rg = (bf16_t*)(p.ws + OFF_REGION);
    bf16_t* Hb = (bf16_t*)(p.ws + OFF_H);
#define PHASE(k, ...) if (ph_lo <= (k) && (k) < ph_hi) { __VA_ARGS__; if ((k) + 1 < ph_hi) xcd_barrier(xbar); }
    unsigned* sbctr = (unsigned*)(p.ws + OFF_BAR + 14336);
    PHASE(0,
        transpose_convert<true>(p.ab_w_in, (bf16_t*)(p.ws + OFF_WT_IN), 1024, AB_IN, AB_IN_PAD, smem);
        rmsnorm_rows(p.x, p.norm_mix, Hb))
    PHASE(1, phase_gemm_in8(p, smem_phys))
    PHASE(2, gla_prep(p, smem))
    PHASE(3, gla_scan(p, smem); sb_fast(p, smem_phys + 98304, sbctr); quantize_tables_static(p);
        transpose_convert(p.ab_w_out, (bf16_t*)(p.ws + OFF_WT_OUT), 1024, 1024, 1024, smem);
        transpose_convert(p.c_w_in, (bf16_t*)(p.ws + OFF_WT_CIN), 1024, 4096, 4096, smem);
        transpose_convert(p.c_w_out, (bf16_t*)(p.ws + OFF_WT_COUT), 2048, 1024, 1024, smem);
        fold_query_weights(p))
    PHASE(4, phase_gemm_resid8(Rg + R_QSB, Rg + R_GG, 512, 512, (const bf16_t*)(p.ws + OFF_WT_OUT), 1024, p.x, p.out, smem_phys))
    PHASE(5, rmsnorm_rows(p.out, p.norm_ffn, Hb))
    PHASE(6, phase_select8(p, 0, smem_phys))
    PHASE(7, peer_gather(p, 0, p.norm_mix + 1024, false, smem_phys))
    PHASE(8, phase_gemm_cin8(p, smem_phys))
    PHASE(9, spatial_fast(p, smem))
    PHASE(10, phase_gemm_resid8(Rg, Rg, 2048, 2048, (const bf16_t*)(p.ws + OFF_WT_COUT), 2048, p.out, p.out, smem_phys))
    PHASE(11, rmsnorm_rows(p.out, p.norm_ffn + 1024, Hb))
    PHASE(12, phase_select8(p, 1, smem_phys))
    PHASE(13, peer_gather(p, 1, p.final_norm, true, smem_phys))
}

extern "C" void kernel_launch(void* const* d_in, const int* in_sizes, int n_in, void* d_out, int out_size, void* d_ws, size_t ws_size, hipStream_t stream) {
    static int grid_blocks = 0;
    if (!grid_blocks) {
        int dev = 0, cus = 0, per_cu = 0;
        hipGetDevice(&dev);
        hipDeviceGetAttribute(&cus, hipDeviceAttributeMultiprocessorCount, dev);
        hipFuncSetAttribute((const void*)mega, hipFuncAttributeMaxDynamicSharedMemorySize, kDynLds);
        hipOccupancyMaxActiveBlocksPerMultiprocessor(&per_cu, mega, 512, kDynLds);
        if (per_cu < 1) per_cu = 1;
        if (per_cu > 1) per_cu = 1;
        grid_blocks = cus * per_cu;
        if (n_in != 18 || ws_size < WS_END) fprintf(stderr, "kernel_launch: unexpected n_in %d or ws_size %zu < %zu\n", n_in, ws_size, (size_t)WS_END);
    }
    Params p{};
    p.x = (const float*)d_in[0]; p.norm_mix = (const float*)d_in[1]; p.norm_ffn = (const float*)d_in[2]; p.ab_w_in = (const float*)d_in[3];
    p.ab_w_alpha2 = (const float*)d_in[4]; p.ab_b_alpha2 = (const float*)d_in[5]; p.ab_gla_norm = (const float*)d_in[6]; p.ab_w_out = (const float*)d_in[7];
    p.c_w_in = (const float*)d_in[8]; p.c_v_norm = (const float*)d_in[9]; p.c_w_spatial = (const float*)d_in[10]; p.c_b_spatial = (const float*)d_in[11];
    p.c_w_out = (const float*)d_in[12]; p.peer_w_q = (const float*)d_in[13]; p.peer_subkeys = (const float*)d_in[14]; p.peer_u = (const float*)d_in[15];
    p.peer_v = (const float*)d_in[16]; p.final_norm = (const float*)d_in[17];
    p.out = (float*)d_out; p.ws = (unsigned char*)d_ws;
    (void)hipMemsetAsync((char*)d_ws + OFF_BAR, 0, 16384, stream);
#if ONE_LAUNCH
    int lo = 0, hi = NPHASE;
    void* args[] = {&p, &lo, &hi};
    hipError_t e = hipLaunchCooperativeKernel((void*)mega, dim3(grid_blocks), dim3(512), args, kDynLds, stream);
    if (e != hipSuccess) fprintf(stderr, "cooperative launch failed: %s (grid %d)\n", hipGetErrorString(e), grid_blocks);
#else
    for (int ph = 0; ph < NPHASE; ++ph) hipLaunchKernelGGL(mega, dim3(grid_blocks), dim3(512), kDynLds, stream, p, ph, ph + 1);
#endif
}
```

```cpp
#include <hip/hip_runtime.h>
#include <hip/hip_cooperative_groups.h>
#include <cstdio>
#include <cstdint>
namespace cg = cooperative_groups;

#ifndef ONE_LAUNCH
#define ONE_LAUNCH 1
#endif


#define VTID ((int)(threadIdx.x & 255))
#define VBID ((int)(blockIdx.x * 2 + (threadIdx.x >> 8)))
#define VGRID ((int)(gridDim.x * 2))
typedef unsigned short bf16_t;
typedef short bf16x8 __attribute__((ext_vector_type(8)));
typedef float f32x4 __attribute__((ext_vector_type(4)));
typedef unsigned u32x4 __attribute__((ext_vector_type(4)));
typedef __bf16 bf16x2_t __attribute__((ext_vector_type(2)));

constexpr int T = 32768, D = 1024, SEQ = 2048, NB = 16;
constexpr int AB_IN = 3088, AB_IN_PAD = 3200;
constexpr float EPS = 1e-6f;
constexpr int NEXP = 16384;
constexpr int kDynLds = 163840;

constexpr size_t SZ_WT_IN = (size_t)AB_IN_PAD * 1024 * 2;
constexpr size_t SZ_WT_OUT = (size_t)1024 * 1024 * 2;
constexpr size_t SZ_WT_CIN = (size_t)4096 * 1024 * 2;
constexpr size_t SZ_WT_COUT = (size_t)1024 * 2048 * 2;
constexpr size_t SZ_WT_Q = (size_t)2 * 2048 * 1024 * 2;
constexpr size_t SZ_SK = (size_t)2 * 8 * 2 * 128 * 128 * 2;
constexpr size_t SZ_TAB = (size_t)2 * NEXP * 1024;
constexpr size_t SZ_TSC = (size_t)2 * NEXP * 4;
constexpr size_t OFF_WT_IN = 0;
constexpr size_t OFF_WT_OUT = OFF_WT_IN + SZ_WT_IN;
constexpr size_t OFF_WT_CIN = OFF_WT_OUT + SZ_WT_OUT;
constexpr size_t OFF_WT_COUT = OFF_WT_CIN + SZ_WT_CIN;
constexpr size_t OFF_WT_Q = OFF_WT_COUT + SZ_WT_COUT;
constexpr size_t OFF_SK = OFF_WT_Q + SZ_WT_Q;
constexpr size_t OFF_UT = OFF_SK + SZ_SK;
constexpr size_t OFF_VT = OFF_UT + SZ_TAB;
constexpr size_t OFF_USC = OFF_VT + SZ_TAB;
constexpr size_t OFF_VSC = OFF_USC + SZ_TSC;
constexpr size_t OFF_H = OFF_VSC + SZ_TSC;
constexpr size_t OFF_IDX = OFF_H + (size_t)T * 1024 * 2;
constexpr size_t OFF_GATE = OFF_IDX + (size_t)T * 128 * 2;
constexpr size_t OFF_SSQ = OFF_GATE + (size_t)T * 128 * 4;
constexpr size_t OFF_REGION = OFF_SSQ + (size_t)T * 32 * 4;
constexpr size_t SZ_REGION = (size_t)256 << 20;
constexpr size_t OFF_BAR = OFF_REGION + SZ_REGION;
constexpr size_t WS_END = OFF_BAR + 16384;
constexpr size_t R_QSB = 0;
constexpr size_t R_KSB = R_QSB + (size_t)T * 512;
constexpr size_t R_VTSB = R_KSB + (size_t)T * 512;
constexpr size_t R_QG = R_VTSB + (size_t)T * 512;
constexpr size_t R_KG = R_QG + (size_t)T * 256;
constexpr size_t R_VTG = R_KG + (size_t)T * 256;
constexpr size_t R_GG = R_VTG + (size_t)T * 512;
constexpr size_t R_ALR = R_GG + (size_t)T * 512;
constexpr size_t R_KOT = R_ALR + (size_t)T * 32;
constexpr size_t R_DEC = R_KOT + (size_t)T * 256;

struct Params {
    const float* x; const float* norm_mix; const float* norm_ffn; const float* ab_w_in; const float* ab_w_alpha2; const float* ab_b_alpha2;
    const float* ab_gla_norm; const float* ab_w_out; const float* c_w_in; const float* c_v_norm; const float* c_w_spatial; const float* c_b_spatial;
    const float* c_w_out; const float* peer_w_q; const float* peer_subkeys; const float* peer_u; const float* peer_v; const float* final_norm;
    float* out; unsigned char* ws;
};

__device__ __forceinline__ float bf2f(bf16_t v) { return __uint_as_float(((unsigned)v) << 16); }
__device__ __forceinline__ bf16_t f2bf(float f) { unsigned u = __float_as_uint(f); u += 0x7fffu + ((u >> 16) & 1u); return (bf16_t)(u >> 16); }
__device__ __forceinline__ unsigned pack2(float lo, float hi) { return (unsigned)f2bf(lo) | ((unsigned)f2bf(hi) << 16); }
__device__ __forceinline__ float lo2f(unsigned w) { return __uint_as_float(w << 16); }
__device__ __forceinline__ float hi2f(unsigned w) { return __uint_as_float(w & 0xffff0000u); }
__device__ __forceinline__ float dot2(unsigned a, unsigned b, float acc) { return __builtin_amdgcn_fdot2_f32_bf16(__builtin_bit_cast(bf16x2_t, a), __builtin_bit_cast(bf16x2_t, b), acc, false); }
__device__ __forceinline__ float gelu_exact(float v) {
    const float av = fabsf(v);
    const float t = __builtin_amdgcn_rcpf(av * 0.2316418882f + 1.0f);
    float q = t * 0.5307027145f - 0.7265760135f; q = q * t + 0.7107068705f; q = q * t - 0.142248368f; q = q * t + 0.127414796f; q = q * t;
    const float e = __builtin_amdgcn_exp2f(v * v * -0.72134752044f);
    const float m = v * (q * e);
    return v < 0.f ? m : v - m;
}
__device__ __forceinline__ float row16_sum(float v) {
    v += __builtin_bit_cast(float, __builtin_amdgcn_update_dpp(0, __builtin_bit_cast(int, v), 0x128, 0xf, 0xf, false));
    v += __builtin_bit_cast(float, __builtin_amdgcn_update_dpp(0, __builtin_bit_cast(int, v), 0x124, 0xf, 0xf, false));
    v += __builtin_bit_cast(float, __builtin_amdgcn_update_dpp(0, __builtin_bit_cast(int, v), 0x122, 0xf, 0xf, false));
    v += __builtin_bit_cast(float, __builtin_amdgcn_update_dpp(0, __builtin_bit_cast(int, v), 0x121, 0xf, 0xf, false));
    return v;
}
__device__ __forceinline__ float wave_sum(float v) {
#pragma unroll
    for (int o = 32; o >= 1; o >>= 1) v += __shfl_xor(v, o);
    return v;
}

template <bool PERM_IN = false>
__device__ __forceinline__ void transpose_convert(const float* __restrict__ W, bf16_t* __restrict__ Wt, int K, int N, int Npad, char* smem, int vb0 = 0) {
    float* tile = (float*)smem;
    const int tk = K / 64, tn = Npad / 64, ntile = tk * tn;
    const int tid = VTID;
    if (VBID < vb0) return;
    for (int tl = VBID - vb0; tl < ntile; tl += VGRID - vb0) {
        const int k0 = (tl % tk) * 64, n0 = (tl / tk) * 64;
        const int c = tid & 63, r0 = tid >> 6;
        int nd = n0;
        if (PERM_IN) { if (n0 >= 1024 && n0 < 1536) nd = n0 + 1024; else if (n0 >= 1536 && n0 < 2048) nd = n0 - 512; else if (n0 >= 2048 && n0 < 2560) nd = n0 + 512; else if (n0 >= 2560 && n0 < 3072) nd = n0 - 1024; }
#pragma unroll
        for (int i = 0; i < 16; ++i) {
            const int r = r0 + 4 * i;
            const float v = (n0 + c < N) ? W[(size_t)(k0 + r) * N + n0 + c] : 0.f;
            tile[c * 65 + r] = v;
        }
        __syncthreads();
#pragma unroll
        for (int i = 0; i < 16; ++i) {
            const int n = r0 + 4 * i;
            Wt[(size_t)(nd + n) * K + k0 + c] = f2bf(tile[n * 65 + c]);
        }
        __syncthreads();
    }
}
__device__ __forceinline__ void convert_flat(const float* __restrict__ src, bf16_t* __restrict__ dst, size_t n) {
    const size_t nv = n / 8;
    for (size_t i = (size_t)VBID * 256 + VTID; i < nv; i += (size_t)VGRID * 256) {
        const float4 a = ((const float4*)src)[2 * i], b = ((const float4*)src)[2 * i + 1];
        uint4 o; o.x = pack2(a.x, a.y); o.y = pack2(a.z, a.w); o.z = pack2(b.x, b.y); o.w = pack2(b.z, b.w);
        ((uint4*)dst)[i] = o;
    }
}
__device__ __forceinline__ void quantize_tables_static(const Params& p, int vb0 = 0) {
    const int lane = VTID & 63, wid = VTID >> 6;
    if (VBID < vb0) return;
    for (unsigned task = (unsigned)(VBID - vb0); task < 512u; task += (unsigned)(VGRID - vb0)) {
        const bool isv = task >= 256u;
        const int r0 = (int)(task & 255u) * 128 + wid * 32;
        const float* src = isv ? p.peer_v : p.peer_u;
        unsigned char* recs = p.ws + OFF_UT;
        for (int rr = 0; rr < 32; ++rr) {
            const int r = r0 + rr;
            const float* xr = src + (size_t)r * 1024 + lane * 16;
            f32x4 v[4]; float aml = 0.f;
#pragma unroll
            for (int i = 0; i < 4; ++i) {
                v[i] = *(const f32x4*)(xr + i * 4);
                aml = fmaxf(aml, fmaxf(fmaxf(fabsf(v[i][0]), fabsf(v[i][1])), fmaxf(fabsf(v[i][2]), fabsf(v[i][3]))));
            }
            const float gs = fmaxf(aml, __shfl_xor(aml, 1)) * (1.002f / 7.5f);
            const _Float16 hs = (_Float16)gs;
            const float gsd = (float)hs, ginv = gsd > 0.f ? 1.0f / gsd : 0.f;
            unsigned wd[2];
#pragma unroll
            for (int dd = 0; dd < 2; ++dd) {
                unsigned wv = 0;
#pragma unroll
                for (int b = 0; b < 4; ++b) {
                    const int qa = min(15, max(0, __float2int_rn(v[2 * dd][b] * ginv + 7.5f)));
                    const int qb = min(15, max(0, __float2int_rn(v[2 * dd + 1][b] * ginv + 7.5f)));
                    wv |= ((unsigned)qa | ((unsigned)qb << 4)) << (8 * b);
                }
                wd[dd] = wv;
            }
            unsigned char* rec = recs + (size_t)r * 1152;
            *(uint2*)(rec + (isv ? 512 : 0) + lane * 8) = make_uint2(wd[0], wd[1]);
            if ((lane & 1) == 0) { const int g = lane >> 1; *(_Float16*)(rec + 1024 + (g & 15) * 8 + (isv ? 4 : 0) + (g >> 4) * 2) = hs; }
        }
    }
}
__device__ __forceinline__ void rmsnorm_rows(const float* __restrict__ X, const float* __restrict__ g, bf16_t* __restrict__ Hout) {
    const int lane = VTID & 63, wid = VTID >> 6;
    const int gw = VBID * 4 + wid, nw = VGRID * 4;
    for (int t = gw; t < T; t += nw) {
        const float* xr = X + (size_t)t * D;
        float4 v[4]; float ss = 0.f;
#pragma unroll
        for (int i = 0; i < 4; ++i) { v[i] = *(const float4*)(xr + i * 256 + lane * 4); ss += v[i].x * v[i].x + v[i].y * v[i].y + v[i].z * v[i].z + v[i].w * v[i].w; }
        ss = wave_sum(ss);
        const float rstd = rsqrtf(ss * (1.0f / D) + EPS);
#pragma unroll
        for (int i = 0; i < 4; ++i) {
            const float4 gg = *(const float4*)(g + i * 256 + lane * 4);
            uint2 o; o.x = pack2(v[i].x * rstd * gg.x, v[i].y * rstd * gg.y); o.y = pack2(v[i].z * rstd * gg.z, v[i].w * rstd * gg.w);
            *(uint2*)(Hout + (size_t)t * D + i * 256 + lane * 4) = o;
        }
    }
}

template <int MODE>
__device__ __forceinline__ void gemm_mainloop(const bf16_t* __restrict__ A0, const bf16_t* __restrict__ A1, int lda, int ksplit,
                                              const bf16_t* __restrict__ Bt, int K, int m0, int n0, f32x4 (&acc)[4][4], char* smem) {
    const int tid = VTID, lane = tid & 63, wid = tid >> 6, wm = wid >> 1, wn = wid & 1;
    const int lrow = tid >> 3, lch = tid & 7;
#pragma unroll
    for (int i = 0; i < 4; ++i)
#pragma unroll
        for (int j = 0; j < 4; ++j) acc[i][j] = (f32x4){0.f, 0.f, 0.f, 0.f};
    const int nk = K / 64;
    unsigned aoff[4], boff[4];
    {
        const int rr = lane >> 3, cc = ((lane & 7) ^ rr) * 8;
#pragma unroll
        for (int i = 0; i < 4; ++i) {
            aoff[i] = (unsigned)(((m0 + 32 * wid + 8 * i + rr) * lda + cc) * 2);
            boff[i] = (unsigned)(((n0 + 32 * wid + 8 * i + rr) * K + cc) * 2);
        }
    }
    auto stage = [&](int kt, int buf) {
        const int kb = kt * 64;
        const char* Ab; const char* Bb = (const char*)(Bt + kb);
        if (kb < ksplit) Ab = (const char*)(A0 + kb); else Ab = (const char*)(A1 + (kb - ksplit));
        char* sa = smem + buf * 32768 + wid * 4096 + lane * 16; char* sb = sa + 16384;
#pragma unroll
        for (int i = 0; i < 4; ++i) __builtin_amdgcn_global_load_lds((const unsigned*)(Ab + aoff[i]), (unsigned*)(sa + i * 1024), 16, 0, 0);
#pragma unroll
        for (int i = 0; i < 4; ++i) __builtin_amdgcn_global_load_lds((const unsigned*)(Bb + boff[i]), (unsigned*)(sb + i * 1024), 16, 0, 0);
    };
    auto compute = [&](int buf) {
        const char* sa = smem + buf * 32768; const char* sb = sa + 16384;
#pragma unroll
        for (int ks = 0; ks < 2; ++ks) {
            bf16x8 af[4], bfr[4];
            const int ch = ks * 4 + (lane >> 4);
#pragma unroll
            for (int i = 0; i < 4; ++i) { const int row = wm * 64 + i * 16 + (lane & 15); af[i] = *(const bf16x8*)(sa + row * 128 + ((ch ^ (row & 7)) << 4)); }
#pragma unroll
            for (int j = 0; j < 4; ++j) { const int row = wn * 64 + j * 16 + (lane & 15); bfr[j] = *(const bf16x8*)(sb + row * 128 + ((ch ^ (row & 7)) << 4)); }
            __builtin_amdgcn_s_setprio(1);
#pragma unroll
            for (int i = 0; i < 4; ++i)
#pragma unroll
                for (int j = 0; j < 4; ++j) {
                    if (MODE == 0) acc[i][j] = __builtin_amdgcn_mfma_f32_16x16x32_bf16(bfr[j], af[i], acc[i][j], 0, 0, 0);
                    else acc[i][j] = __builtin_amdgcn_mfma_f32_16x16x32_bf16(af[i], bfr[j], acc[i][j], 0, 0, 0);
                }
            __builtin_amdgcn_s_setprio(0);
        }
    };
    stage(0, 0);
    asm volatile("s_waitcnt vmcnt(0)" ::: "memory");
    __syncthreads();
    for (int kt = 0; kt < nk; ++kt) {
        if (kt + 1 < nk) stage(kt + 1, (kt + 1) & 1);
        compute(kt & 1);
        asm volatile("s_waitcnt vmcnt(0)" ::: "memory");
        __syncthreads();
    }
}
template <int MODE>
__device__ __forceinline__ void gemm_mainloop256(const bf16_t* __restrict__ A0, const bf16_t* __restrict__ A1, int lda, int ksplit,
                                                 const bf16_t* __restrict__ Bt, int K, int m0, int n0, f32x4 (&acc)[8][4], char* smem) {
    const int tid = VTID, lane = tid & 63, wid = tid >> 6, wm = wid >> 1, wn = wid & 1;
#pragma unroll
    for (int i = 0; i < 8; ++i)
#pragma unroll
        for (int j = 0; j < 4; ++j) acc[i][j] = (f32x4){0.f, 0.f, 0.f, 0.f};
    const int nk = K / 32;
    unsigned aoff[4], boff[2];
    {
        const int rr = lane >> 2, cc = ((lane & 3) ^ (3 * ((lane >> 5) & 1))) * 8;
#pragma unroll
        for (int i = 0; i < 4; ++i) aoff[i] = (unsigned)(((m0 + 64 * wid + 16 * i + rr) * lda + cc) * 2);
#pragma unroll
        for (int i = 0; i < 2; ++i) boff[i] = (unsigned)(((n0 + 32 * wid + 16 * i + rr) * K + cc) * 2);
    }
    auto stage = [&](int kt, int buf) {
        const int kb = kt * 32;
        const char* Ab; const char* Bb = (const char*)(Bt + kb);
        if (kb < ksplit) Ab = (const char*)(A0 + kb); else Ab = (const char*)(A1 + (kb - ksplit));
        char* sa = smem + buf * 24576 + wid * 4096 + lane * 16; char* sb = smem + buf * 24576 + 16384 + wid * 2048 + lane * 16;
#pragma unroll
        for (int i = 0; i < 4; ++i) __builtin_amdgcn_global_load_lds((const unsigned*)(Ab + aoff[i]), (unsigned*)(sa + i * 1024), 16, 0, 0);
#pragma unroll
        for (int i = 0; i < 2; ++i) __builtin_amdgcn_global_load_lds((const unsigned*)(Bb + boff[i]), (unsigned*)(sb + i * 1024), 16, 0, 0);
    };
    const int fpos = (((lane >> 4) ^ (3 * ((lane >> 3) & 1))) << 4) + (lane & 15) * 64;
    auto compute = [&](int buf) {
        const char* sa = smem + buf * 24576 + wm * 8192 + fpos; const char* sb = smem + buf * 24576 + 16384 + wn * 4096 + fpos;
        bf16x8 af[8], bfr[4];
#pragma unroll
        for (int i = 0; i < 8; ++i) af[i] = *(const bf16x8*)(sa + i * 1024);
#pragma unroll
        for (int j = 0; j < 4; ++j) bfr[j] = *(const bf16x8*)(sb + j * 1024);
        __builtin_amdgcn_s_setprio(1);
#pragma unroll
        for (int i = 0; i < 8; ++i)
#pragma unroll
            for (int j = 0; j < 4; ++j) {
                if (MODE == 0) acc[i][j] = __builtin_amdgcn_mfma_f32_16x16x32_bf16(bfr[j], af[i], acc[i][j], 0, 0, 0);
                else acc[i][j] = __builtin_amdgcn_mfma_f32_16x16x32_bf16(af[i], bfr[j], acc[i][j], 0, 0, 0);
            }
        __builtin_amdgcn_s_setprio(0);
    };
    stage(0, 0);
    asm volatile("s_waitcnt vmcnt(0)" ::: "memory");
    __syncthreads();
    for (int kt = 0; kt < nk; ++kt) {
        if (kt + 1 < nk) stage(kt + 1, (kt + 1) & 1);
        compute(kt & 1);
        asm volatile("s_waitcnt vmcnt(0)" ::: "memory");
        __syncthreads();
    }
}
__device__ __forceinline__ bool tile_sched(int it, int MT, int NT, int& mt, int& nt) {
    const int xg = blockIdx.x & 7, xi = (int)(blockIdx.x >> 3) * 2 + (int)(threadIdx.x >> 8), nper = (int)(gridDim.x >> 3) * 2;
    const int li = xi + nper * it;
    if (li >= (MT >> 3) * NT) return false;
    const int band = li / (8 * NT), r = li - band * 8 * NT;
    nt = r >> 3; mt = xg * (MT >> 3) + band * 8 + (r & 7);
    return true;
}
__device__ __forceinline__ void store_bf16x4(bf16_t* p, f32x4 v) { uint2 o; o.x = pack2(v[0], v[1]); o.y = pack2(v[2], v[3]); *(uint2*)p = o; }

#define G8_LAS __attribute__((address_space(3)))
namespace g8 {
constexpr int BM = 256, BK = 64, HALF = 128, HTB = HALF * BK * 2, NXCD = 8, WGM = 8;
__device__ __forceinline__ int lds_byte(int r, int c) { const int st = (r >> 4) * 2 + (c >> 5), rr = r & 15, cc = c & 31, ob = rr * 64 + cc * 2; return st * 1024 + (ob ^ (((ob >> 9) & 1) << 5)); }
__device__ __forceinline__ void stage_rc(int b, int& R, int& C) { const int st = b / 1024, sb = b % 1024, swz = sb ^ (((sb >> 9) & 1) << 5); R = (st >> 1) * 16 + swz / 64; C = (st & 1) * 32 + (swz % 64) / 2; }
__device__ __forceinline__ int perm32(int rho) { const int n = rho >> 4, i = rho & 15; return 8 * (i >> 2) + 4 * n + (i & 3); }
struct Unit { int pm, pn; };
struct Gemm { const bf16_t* A0; const bf16_t* A1; int lda, ksplit; const bf16_t* Bt; int M, N, K; };
struct StaticOrder {
    int nM, nN, nwg, G, c;
    __device__ __forceinline__ void init(int M, int N, int G_, int c_) { nM = M / BM; nN = N / BM; nwg = nM * nN; G = G_; c = c_; }
    __device__ __forceinline__ bool next(int i, Unit& u) const {
        const int L = i * G + c; if (L >= nwg) return false;
        int wgid = L; { const int q = nwg / NXCD, r = nwg % NXCD, xcd = wgid % NXCD, off = wgid / NXCD; wgid = (xcd < r ? xcd * (q + 1) : r * (q + 1) + (xcd - r) * q) + off; }
        const int nig = WGM * nN, gid = wgid / nig, fm = gid * WGM, gsz = (nM - fm) < WGM ? (nM - fm) : WGM;
        u.pm = fm + ((wgid % nig) % gsz); u.pn = (wgid % nig) / gsz; return true;
    }
};
template <class Epi>
__device__ __forceinline__ void gemm_phase(G8_LAS unsigned char* lds, const Gemm g, const StaticOrder& S, const Epi& E) {
    const int tid = threadIdx.x, wid = __builtin_amdgcn_readfirstlane(tid >> 6), lane = tid & 63, wr = wid >> 2, wc = wid & 3, fr = lane & 15, fq = lane >> 4;
    const int K = g.K, nt = K / BK, lda = g.lda;
    unsigned voffA[2], voffB[2];
#pragma unroll
    for (int i = 0; i < 2; ++i) { int R, C; stage_rc(tid * 16 + i * 8192, R, C); const int Rb = (R & ~31) + perm32(R & 31);
        voffA[i] = (unsigned)(R * lda + C) * 2u; voffB[i] = (unsigned)(Rb * K + C) * 2u; }
    const size_t hstepA = (size_t)HALF * lda * 2, hstepB = (size_t)HALF * K * 2;
    const unsigned ldsw = (unsigned)wid * 1024u;
    const int aoff = lds_byte(wr * 64 + fr, fq * 8), boff = lds_byte(wc * 32 + fr, fq * 8);
    auto aptr = [&](int pm, int kt) -> const char* { const int kb = kt * BK; const bf16_t* b = kb < g.ksplit ? g.A0 + kb : g.A1 + (kb - g.ksplit); return (const char*)b + (size_t)pm * 2 * hstepA; };
    auto bptr = [&](int pn, int kt) -> const char* { return (const char*)(g.Bt + kt * BK) + (size_t)pn * 2 * hstepB; };
#define G8_SA(b, h) (((b) * 2 + (h)) * HTB)
#define G8_SB(b, h) ((4 + (b) * 2 + (h)) * HTB)
#define G8_STAGE(bufoff, gbase, voff) do { _Pragma("unroll") for (int _i = 0; _i < 2; ++_i) \
        __builtin_amdgcn_global_load_lds((const unsigned*)((const char*)(gbase) + (voff)[_i]), (G8_LAS unsigned*)(lds + (bufoff) + ldsw + _i * 8192), 16, 0, 0); } while (0)
#define G8_LDA(dst, b, h) do { _Pragma("unroll") for (int m = 0; m < 4; ++m) _Pragma("unroll") for (int k = 0; k < 2; ++k) dst[m][k] = *(const G8_LAS bf16x8*)(lds + G8_SA(b, h) + aoff + m * 2048 + k * 1024); } while (0)
#define G8_LDB(dst, b, h) do { _Pragma("unroll") for (int n = 0; n < 2; ++n) _Pragma("unroll") for (int k = 0; k < 2; ++k) dst[n][k] = *(const G8_LAS bf16x8*)(lds + G8_SB(b, h) + boff + n * 2048 + k * 1024); } while (0)
#define G8_MMA(ai, bj, At, Bt) do { __builtin_amdgcn_s_setprio(1); _Pragma("unroll") for (int m = 0; m < 4; ++m) _Pragma("unroll") for (int n = 0; n < 2; ++n) _Pragma("unroll") for (int k = 0; k < 2; ++k) \
        acc[ai][bj][m][n] = __builtin_amdgcn_mfma_f32_16x16x32_bf16(Bt[n][k], At[m][k], acc[ai][bj][m][n], 0, 0, 0); __builtin_amdgcn_s_setprio(0); } while (0)
#define G8_WAIT_V(n) asm volatile("s_waitcnt vmcnt(" #n ")" ::: "memory")
#define G8_WAIT_L(n) asm volatile("s_waitcnt lgkmcnt(" #n ")" ::: "memory")
#define G8_BAR __builtin_amdgcn_s_barrier()
#define G8_SCHED __builtin_amdgcn_sched_barrier(0)
    Unit cur, nxt; int ui = 0;
    if (!S.next(0, cur)) return;
    f32x4 acc[2][2][4][2];
#pragma unroll
    for (int a = 0; a < 2; ++a)
#pragma unroll
        for (int b = 0; b < 2; ++b)
#pragma unroll
            for (int m = 0; m < 4; ++m)
#pragma unroll
                for (int n = 0; n < 2; ++n) acc[a][b][m][n] = (f32x4){0.f, 0.f, 0.f, 0.f};
    bf16x8 At[4][2], B0[2][2], B1[2][2];
    {
        const char* cA = aptr(cur.pm, 0); const char* cB = bptr(cur.pn, 0); const char* cA1 = aptr(cur.pm, 1); const char* cB1 = bptr(cur.pn, 1);
        G8_STAGE(G8_SB(0, 0), cB, voffB); G8_STAGE(G8_SB(0, 1), cB + hstepB, voffB); G8_STAGE(G8_SA(0, 0), cA, voffA); G8_STAGE(G8_SA(0, 1), cA + hstepA, voffA);
        if (wr == 1) G8_BAR;
        G8_WAIT_V(2); G8_BAR;
        G8_STAGE(G8_SB(1, 0), cB1, voffB); G8_STAGE(G8_SA(1, 0), cA1, voffA); G8_STAGE(G8_SB(1, 1), cB1 + hstepB, voffB);
        G8_WAIT_V(6); G8_BAR;
    }
    for (;;) {
        const bool has_next = S.next(ui + 1, nxt);
        const int npm = has_next ? nxt.pm : cur.pm, npn = has_next ? nxt.pn : cur.pn;
        for (int t = 0; t < nt; t += 2) {
            const bool last = (t == nt - 2);
            const char* a1 = aptr(cur.pm, t + 1);
            const char* a2 = last ? aptr(npm, 0) : aptr(cur.pm, t + 2); const char* b2 = last ? bptr(npn, 0) : bptr(cur.pn, t + 2);
            const char* a3 = last ? aptr(npm, 1) : aptr(cur.pm, t + 3); const char* b3 = last ? bptr(npn, 1) : bptr(cur.pn, t + 3);
            G8_LDB(B0, 0, 0); G8_LDB(B1, 0, 1); G8_SCHED; G8_LDA(At, 0, 0); G8_STAGE(G8_SA(1, 1), a1 + hstepA, voffA);
            G8_WAIT_V(8); G8_WAIT_L(0); G8_BAR; G8_MMA(0, 0, At, B0); G8_MMA(0, 1, At, B1); G8_BAR; G8_SCHED;
            G8_LDA(At, 0, 1); G8_STAGE(G8_SB(0, 0), b2, voffB); G8_STAGE(G8_SB(0, 1), b2 + hstepB, voffB); G8_STAGE(G8_SA(0, 0), a2, voffA);
            G8_WAIT_V(8); G8_WAIT_L(0); G8_BAR; G8_MMA(1, 0, At, B0); G8_MMA(1, 1, At, B1); G8_BAR; G8_SCHED;
            G8_LDB(B0, 1, 0); G8_LDB(B1, 1, 1); G8_SCHED; G8_LDA(At, 1, 0); G8_STAGE(G8_SA(0, 1), a2 + hstepA, voffA);
            G8_WAIT_V(8); G8_WAIT_L(0); G8_BAR; G8_MMA(0, 0, At, B0); G8_MMA(0, 1, At, B1); G8_BAR; G8_SCHED;
            G8_LDA(At, 1, 1); G8_STAGE(G8_SB(1, 0), b3, voffB); G8_STAGE(G8_SB(1, 1), b3 + hstepB, voffB); G8_STAGE(G8_SA(1, 0), a3, voffA);
            G8_WAIT_V(8); G8_WAIT_L(0); G8_BAR; G8_MMA(1, 0, At, B0); G8_MMA(1, 1, At, B1); G8_BAR; G8_SCHED;
        }
        if (wr == 0) G8_BAR;
        E(acc, cur, wr, wc, fr, fq);
        if (!has_next) break;
#pragma unroll
        for (int a = 0; a < 2; ++a)
#pragma unroll
            for (int b = 0; b < 2; ++b)
#pragma unroll
                for (int m = 0; m < 4; ++m)
#pragma unroll
                    for (int n = 0; n < 2; ++n) acc[a][b][m][n] = (f32x4){0.f, 0.f, 0.f, 0.f};
        cur = nxt; ++ui;
        if (wr == 1) G8_BAR;
    }
    G8_WAIT_V(0);
    G8_BAR;
#undef G8_SA
#undef G8_SB
#undef G8_STAGE
#undef G8_LDA
#undef G8_LDB
#undef G8_MMA
#undef G8_WAIT_V
#undef G8_WAIT_L
#undef G8_BAR
#undef G8_SCHED
}
struct EpiResid {
    const float* Rs; float* O; bf16_t* XB; float* SSQP; const float* gain;
    __device__ __forceinline__ void operator()(const f32x4 (&acc)[2][2][4][2], const Unit& u, int wr, int wc, int fr, int fq) const {
        f32x4 gn[2][2];
#pragma unroll
        for (int bj = 0; bj < 2; ++bj) { gn[bj][0] = *(const f32x4*)(gain + u.pn * 256 + bj * 128 + wc * 32 + fq * 8); gn[bj][1] = *(const f32x4*)(gain + u.pn * 256 + bj * 128 + wc * 32 + fq * 8 + 4); }
#pragma unroll
        for (int ai = 0; ai < 2; ++ai)
#pragma unroll
            for (int m = 0; m < 4; ++m) {
                const int row = u.pm * 256 + ai * 128 + wr * 64 + m * 16 + fr;
                const size_t o = (size_t)row * 1024 + u.pn * 256 + wc * 32 + fq * 8;
                float ss = 0.f;
#pragma unroll
                for (int bj = 0; bj < 2; ++bj) {
                    const f32x4 a = *(const f32x4*)(Rs + o + bj * 128) + acc[ai][bj][m][0], b = *(const f32x4*)(Rs + o + bj * 128 + 4) + acc[ai][bj][m][1];
                    *(f32x4*)(O + o + bj * 128) = a; *(f32x4*)(O + o + bj * 128 + 4) = b;
                    ss += a[0] * a[0] + a[1] * a[1] + a[2] * a[2] + a[3] * a[3] + b[0] * b[0] + b[1] * b[1] + b[2] * b[2] + b[3] * b[3];
                    const f32x4 ag = a * gn[bj][0], bg = b * gn[bj][1];
                    uint4 w; w.x = pack2(ag[0], ag[1]); w.y = pack2(ag[2], ag[3]); w.z = pack2(bg[0], bg[1]); w.w = pack2(bg[2], bg[3]);
                    *(uint4*)(XB + o + bj * 128) = w;
                }
                ss += __shfl_xor(ss, 16); ss += __shfl_xor(ss, 32);
                if (fq == 0) SSQP[(size_t)row * 32 + u.pn * 4 + wc] = ss;
            }
    }
};
struct EpiCinU {
    bf16_t* U;
    __device__ __forceinline__ void operator()(const f32x4 (&acc)[2][2][4][2], const Unit& u, int wr, int wc, int fr, int fq) const {
#pragma unroll
        for (int ai = 0; ai < 2; ++ai)
#pragma unroll
            for (int m = 0; m < 4; ++m) {
                bf16_t* rp = U + (size_t)(u.pm * 256 + ai * 128 + wr * 64 + m * 16 + fr) * 2048 + u.pn * 256 + wc * 32 + fq * 8;
#pragma unroll
                for (int bj = 0; bj < 2; ++bj) {
                    const f32x4 a = acc[ai][bj][m][0], b = acc[ai][bj][m][1];
                    uint4 o; o.x = pack2(gelu_exact(a[0]), gelu_exact(a[1])); o.y = pack2(gelu_exact(a[2]), gelu_exact(a[3]));
                    o.z = pack2(gelu_exact(b[0]), gelu_exact(b[1])); o.w = pack2(gelu_exact(b[2]), gelu_exact(b[3]));
                    *(uint4*)(rp + bj * 128) = o;
                }
            }
    }
};
struct EpiCinV {
    bf16_t* VT; float* SSQ;
    __device__ __forceinline__ void operator()(const f32x4 (&acc)[2][2][4][2], const Unit& u, int wr, int wc, int fr, int fq) const {
#pragma unroll
        for (int ai = 0; ai < 2; ++ai) {
            float ss[16];
#pragma unroll
            for (int i = 0; i < 16; ++i) ss[i] = 0.f;
#pragma unroll
            for (int m = 0; m < 4; ++m) {
                const int c = u.pm * 256 + ai * 128 + wr * 64 + m * 16 + fr;
#pragma unroll
                for (int bj = 0; bj < 2; ++bj) {
                    float g[8];
#pragma unroll
                    for (int n = 0; n < 2; ++n)
#pragma unroll
                        for (int r = 0; r < 4; ++r) { const float x = gelu_exact(acc[ai][bj][m][n][r]); g[n * 4 + r] = x; ss[bj * 8 + n * 4 + r] += x * x; }
                    uint4 o; o.x = pack2(g[0], g[1]); o.y = pack2(g[2], g[3]); o.z = pack2(g[4], g[5]); o.w = pack2(g[6], g[7]);
                    *(uint4*)(VT + ((size_t)(u.pn * 2 + bj) * 2048 + c) * 128 + wc * 32 + fq * 8) = o;
                }
            }
            float mine = 0.f;
#pragma unroll
            for (int i = 0; i < 16; ++i) { const float s = row16_sum(ss[i]); mine = (fr == i) ? s : mine; }
            const int tok = u.pn * 256 + (fr >> 3) * 128 + wc * 32 + fq * 8 + (fr & 7);
            SSQ[(size_t)tok * 32 + u.pm * 4 + ai * 2 + wr] = mine;
        }
    }
};
struct EpiInN {
    bf16_t* R;
    __device__ __forceinline__ void operator()(const f32x4 (&acc)[2][2][4][2], const Unit& u, int wr, int wc, int fr, int fq) const {
        bf16_t* base; int pitch; float sc = 1.0f;
        if (u.pn < 2) { base = R + R_QSB + u.pn * 256; pitch = 512; sc = 0.125f; }
        else if (u.pn < 4) { base = R + R_KSB + (u.pn - 2) * 256; pitch = 512; }
        else if (u.pn == 4) { base = R + R_QG; pitch = 256; }
        else if (u.pn == 5) { base = R + R_KG; pitch = 256; }
        else { base = R + R_GG + (u.pn - 6) * 256; pitch = 512; }
#pragma unroll
        for (int ai = 0; ai < 2; ++ai)
#pragma unroll
            for (int m = 0; m < 4; ++m) {
                bf16_t* rp = base + (size_t)(u.pm * 256 + ai * 128 + wr * 64 + m * 16 + fr) * pitch + wc * 32 + fq * 8;
#pragma unroll
                for (int bj = 0; bj < 2; ++bj) {
                    const f32x4 a = acc[ai][bj][m][0] * sc, b = acc[ai][bj][m][1] * sc;
                    uint4 o; o.x = pack2(a[0], a[1]); o.y = pack2(a[2], a[3]); o.z = pack2(b[0], b[1]); o.w = pack2(b[2], b[3]);
                    *(uint4*)(rp + bj * 128) = o;
                }
            }
    }
};
struct EpiInT {
    bf16_t* R;
    __device__ __forceinline__ void operator()(const f32x4 (&acc)[2][2][4][2], const Unit& u, int wr, int wc, int fr, int fq) const {
#pragma unroll
        for (int ai = 0; ai < 2; ++ai)
#pragma unroll
            for (int m = 0; m < 4; ++m) {
                const int c = u.pm * 256 + ai * 128 + wr * 64 + m * 16 + fr;
#pragma unroll
                for (int bj = 0; bj < 2; ++bj) {
                    const int t = u.pn * 256 + bj * 128 + wc * 32 + fq * 8, b = t >> 11, s = t & 2047;
                    bf16_t* dst;
                    if (c < 512) dst = R + R_VTSB + ((size_t)((b * 8 + (c >> 6)) * 64 + (c & 63))) * 2048 + s;
                    else { const int c2 = c - 512; dst = R + R_VTG + ((size_t)((b * 4 + (c2 >> 7)) * 128 + (c2 & 127))) * 2048 + s; }
                    const f32x4 a = acc[ai][bj][m][0], bb = acc[ai][bj][m][1];
                    uint4 o; o.x = pack2(a[0], a[1]); o.y = pack2(a[2], a[3]); o.z = pack2(bb[0], bb[1]); o.w = pack2(bb[2], bb[3]);
                    *(uint4*)dst = o;
                }
            }
    }
};
}
__device__ __forceinline__ void phase_gemm_resid8(const bf16_t* A0, const bf16_t* A1, int lda, int ksplit, const bf16_t* Bt, int K, const float* Rs, float* O, bf16_t* XB, float* SSQP, const float* gain, char* smem_phys) {
    g8::Gemm g{A0, A1, lda, ksplit, Bt, T, 1024, K};
    g8::StaticOrder S; S.init(T, 1024, (int)gridDim.x, (int)blockIdx.x);
    g8::EpiResid E{Rs, O, XB, SSQP, gain};
    g8::gemm_phase<g8::EpiResid>((G8_LAS unsigned char*)smem_phys, g, S, E);
}

__device__ __forceinline__ void phase_gemm_cin8(const Params& p, char* smem_phys) {
    const bf16_t* H = (const bf16_t*)(p.ws + OFF_H); const bf16_t* W = (const bf16_t*)(p.ws + OFF_WT_CIN);
    bf16_t* U = (bf16_t*)(p.ws + OFF_REGION); bf16_t* VT = U + (size_t)T * 2048; float* SSQ = (float*)(p.ws + OFF_SSQ);
    {
        g8::Gemm g{H, H, 1024, 1024, W, T, 2048, 1024};
        g8::StaticOrder S; S.init(T, 2048, (int)gridDim.x, (int)blockIdx.x);
        g8::EpiCinU E{U};
        g8::gemm_phase<g8::EpiCinU>((G8_LAS unsigned char*)smem_phys, g, S, E);
    }
    {
        const bf16_t* Wv = W + (size_t)2048 * 1024;
        g8::Gemm g{Wv, Wv, 1024, 1024, H, 2048, T, 1024};
        g8::StaticOrder S; S.init(2048, T, (int)gridDim.x, (int)blockIdx.x);
        g8::EpiCinV E{VT, SSQ};
        g8::gemm_phase<g8::EpiCinV>((G8_LAS unsigned char*)smem_phys, g, S, E);
    }
}
__device__ __forceinline__ void phase_gemm_in8(const Params& p, char* smem_phys) {
    const bf16_t* H = (const bf16_t*)(p.ws + OFF_H); const bf16_t* W = (const bf16_t*)(p.ws + OFF_WT_IN);
    bf16_t* R = (bf16_t*)(p.ws + OFF_REGION);
    {
        g8::Gemm g{H, H, 1024, 1024, W, T, 2048, 1024};
        g8::StaticOrder S; S.init(T, 2048, (int)gridDim.x, (int)blockIdx.x);
        g8::EpiInN E{R};
        g8::gemm_phase<g8::EpiInN>((G8_LAS unsigned char*)smem_phys, g, S, E);
    }
    {
        const bf16_t* Wv = W + (size_t)2048 * 1024;
        g8::Gemm g{Wv, Wv, 1024, 1024, H, 1024, T, 1024};
        g8::StaticOrder S; S.init(1024, T, (int)gridDim.x, (int)blockIdx.x);
        g8::EpiInT E{R};
        g8::gemm_phase<g8::EpiInT>((G8_LAS unsigned char*)smem_phys, g, S, E);
    }
    {
        const int lane = threadIdx.x & 63, wid = threadIdx.x >> 6, fr = lane & 15, fq = lane >> 4;
        float* ALR = (float*)(R + R_ALR);
        for (int task = (int)blockIdx.x * 8 + wid; task < T / 16; task += (int)gridDim.x * 8) {
            const bf16_t* a = H + (size_t)(task * 16 + fr) * 1024 + fq * 8; const bf16_t* w = W + (size_t)(3072 + fr) * 1024 + fq * 8;
            f32x4 acc = (f32x4){0.f, 0.f, 0.f, 0.f};
#pragma unroll 8
            for (int kk = 0; kk < 32; ++kk) {
                const bf16x8 af = *(const bf16x8*)(a + kk * 32), wf = *(const bf16x8*)(w + kk * 32);
                acc = __builtin_amdgcn_mfma_f32_16x16x32_bf16(wf, af, acc, 0, 0, 0);
            }
            *(f32x4*)(ALR + (size_t)(task * 16 + fr) * 16 + fq * 4) = acc;
        }
    }
}

__device__ __forceinline__ void phase_gemm_in(const Params& p, char* smem) {
    const bf16_t* A = (const bf16_t*)(p.ws + OFF_H); const bf16_t* Bt = (const bf16_t*)(p.ws + OFF_WT_IN);
    bf16_t* R = (bf16_t*)(p.ws + OFF_REGION);
    const int lane = VTID & 63, wid = VTID >> 6, wm = wid >> 1, wn = wid & 1;
    constexpr int NT = AB_IN_PAD / 128, MT = T / 128;
    int mt_, nt_;
    for (int it = 0; tile_sched(it, MT, NT, mt_, nt_); ++it) {
        const int m0 = mt_ * 128, n0 = nt_ * 128;
        f32x4 acc[4][4];
        const bool tr = (n0 >= 1024 && n0 < 1536) || (n0 >= 2048 && n0 < 2560);
        if (!tr) {
            gemm_mainloop<0>(A, A, 1024, 1024, Bt, 1024, m0, n0, acc, smem);
#pragma unroll
            for (int i = 0; i < 4; ++i)
#pragma unroll
                for (int j = 0; j < 4; ++j) {
                    const int m = m0 + wm * 64 + i * 16 + (lane & 15), n = n0 + wn * 64 + j * 16 + 4 * (lane >> 4);
                    const f32x4 v = acc[i][j];
                    if (n < 512) store_bf16x4(R + R_QSB + (size_t)m * 512 + n, v * 0.125f);
                    else if (n < 1024) store_bf16x4(R + R_KSB + (size_t)m * 512 + (n - 512), v);
                    else if (n < 1792) store_bf16x4(R + R_QG + (size_t)m * 256 + (n - 1536), v);
                    else if (n < 2048) store_bf16x4(R + R_KG + (size_t)m * 256 + (n - 1792), v);
                    else if (n < 3072) store_bf16x4(R + R_GG + (size_t)m * 512 + (n - 2560), v);
                    else if (n < AB_IN) *(f32x4*)((float*)(R + R_ALR) + (size_t)m * 16 + (n - 3072)) = v;
                }
        } else {
            gemm_mainloop<1>(A, A, 1024, 1024, Bt, 1024, m0, n0, acc, smem);
#pragma unroll
            for (int i = 0; i < 4; ++i)
#pragma unroll
                for (int j = 0; j < 4; ++j) {
                    const int m = m0 + wm * 64 + i * 16 + 4 * (lane >> 4), n = n0 + wn * 64 + j * 16 + (lane & 15);
                    const int b = m >> 11, s = m & 2047;
                    if (n < 1536) { const int c = n - 1024, hh = c >> 6, e = c & 63; store_bf16x4(R + R_VTSB + ((size_t)((b * 8 + hh) * 64 + e)) * 2048 + s, acc[i][j]); }
                    else { const int c = n - 2048, hh = c >> 7, e = c & 127; store_bf16x4(R + R_VTG + ((size_t)((b * 4 + hh) * 128 + e)) * 2048 + s, acc[i][j]); }
                }
        }
    }
}
__device__ __forceinline__ void phase_gemm_resid(const bf16_t* A0, const bf16_t* A1, int lda, int ksplit, const bf16_t* Bt, int K, const float* Rs, float* O, char* smem) {
    const int lane = VTID & 63, wid = VTID >> 6, wm = wid >> 1, wn = wid & 1;
    constexpr int NT = 8, MT = T / 256;
    int mt_, nt_;
    for (int it = 0; tile_sched(it, MT, NT, mt_, nt_); ++it) {
        const int m0 = mt_ * 256, n0 = nt_ * 128;
        f32x4 acc[8][4];
        gemm_mainloop256<0>(A0, A1, lda, ksplit, Bt, K, m0, n0, acc, smem);
#pragma unroll
        for (int i = 0; i < 8; ++i)
#pragma unroll
            for (int j = 0; j < 4; ++j) {
                const int m = m0 + wm * 128 + i * 16 + (lane & 15), n = n0 + wn * 64 + j * 16 + 4 * (lane >> 4);
                const f32x4 r = *(const f32x4*)(Rs + (size_t)m * 1024 + n);
                *(f32x4*)(O + (size_t)m * 1024 + n) = r + acc[i][j];
            }
    }
}
__device__ __forceinline__ void phase_gemm_cin(const Params& p, char* smem) {
    const bf16_t* A = (const bf16_t*)(p.ws + OFF_H); const bf16_t* Bt = (const bf16_t*)(p.ws + OFF_WT_CIN);
    bf16_t* U = (bf16_t*)(p.ws + OFF_REGION); bf16_t* VT = U + (size_t)T * 2048; float* SSQ = (float*)(p.ws + OFF_SSQ);
    const int lane = VTID & 63, wid = VTID >> 6, wm = wid >> 1, wn = wid & 1;
    constexpr int NT = 32, MT = T / 128;
    int mt_, nt_;
    for (int it = 0; tile_sched(it, MT, NT, mt_, nt_); ++it) {
        const int m0 = mt_ * 128, n0 = nt_ * 128;
        f32x4 acc[4][4];
        if (n0 < 2048) {
            gemm_mainloop<0>(A, A, 1024, 1024, Bt, 1024, m0, n0, acc, smem);
#pragma unroll
            for (int i = 0; i < 4; ++i)
#pragma unroll
                for (int j = 0; j < 4; ++j) {
                    const int m = m0 + wm * 64 + i * 16 + (lane & 15), n = n0 + wn * 64 + j * 16 + 4 * (lane >> 4);
                    f32x4 v = acc[i][j];
#pragma unroll
                    for (int r = 0; r < 4; ++r) v[r] = gelu_exact(v[r]);
                    store_bf16x4(U + (size_t)m * 2048 + n, v);
                }
        } else {
            gemm_mainloop<1>(A, A, 1024, 1024, Bt, 1024, m0, n0, acc, smem);
#pragma unroll
            for (int i = 0; i < 4; ++i) {
                float ss[4] = {0.f, 0.f, 0.f, 0.f};
#pragma unroll
                for (int j = 0; j < 4; ++j) {
                    const int m = m0 + wm * 64 + i * 16 + 4 * (lane >> 4), n = n0 + wn * 64 + j * 16 + (lane & 15);
                    f32x4 v = acc[i][j];
#pragma unroll
                    for (int r = 0; r < 4; ++r) { v[r] = gelu_exact(v[r]); ss[r] += v[r] * v[r]; }
                    const int chunk = m >> 7, s = m & 127, c = n - 2048;
                    store_bf16x4(VT + ((size_t)chunk * 2048 + c) * 128 + s, v);
                }
#pragma unroll
                for (int r = 0; r < 4; ++r) {
                    float v = ss[r];
                    v += __shfl_xor(v, 1); v += __shfl_xor(v, 2); v += __shfl_xor(v, 4); v += __shfl_xor(v, 8);
                    if ((lane & 15) == 0) { const int m = m0 + wm * 64 + i * 16 + 4 * (lane >> 4) + r; SSQ[(size_t)m * 32 + ((n0 - 2048) >> 6) + wn] = v; }
                }
            }
        }
    }
}

typedef float f32x16 __attribute__((ext_vector_type(16)));
__device__ __forceinline__ void sb_fast(const Params& p, char* smem, unsigned* ctr) {
    bf16_t* R = (bf16_t*)(p.ws + OFF_REGION);
    char* KT = smem; char* VTt = smem + 8192;
    volatile int* flags = (volatile int*)(smem + 32768); volatile unsigned* slot = (volatile unsigned*)(smem + 32832);
    const int tid = threadIdx.x, lane = tid & 63, w = tid >> 6, r31 = lane & 31, h = lane >> 5;
    for (;;) {
        __syncthreads();
        if (tid == 0) *slot = atomicAdd(ctr, 1u);
        __syncthreads();
        const unsigned task = *slot;
        if (task >= 1024u) break;
        const int qblk = 7 - (int)(task >> 7), bh = task & 127, b = bh >> 3, hh = bh & 7;
        const int q0 = qblk * 256, qbase = q0 + 32 * w;
        bf16_t* qrow = R + R_QSB + (size_t)(b * 2048 + qbase + r31) * 512 + hh * 64;
        bf16x8 qf[4];
#pragma unroll
        for (int kk = 0; kk < 4; ++kk) qf[kk] = *(const bf16x8*)(qrow + 16 * kk + 8 * h);
        f32x16 oacc[2];
#pragma unroll
        for (int nt = 0; nt < 2; ++nt)
#pragma unroll
            for (int i = 0; i < 16; ++i) oacc[nt][i] = 0.f;
        float Rr = 1.0f;
        const int t = qbase + r31;
        for (int kt = q0 / 64 + 3; kt >= 0; --kt) {
            __syncthreads();
            { const int wd = __all(Rr == 0.f); if (lane == 0) flags[w] = wd; }
            __syncthreads();
            if (flags[0] & flags[1] & flags[2] & flags[3] & flags[4] & flags[5] & flags[6] & flags[7]) break;
            const int s_tile = kt * 64;
            {
                const int c = tid, row = c >> 3, ch = c & 7;
                const u32x4 kv = *(const u32x4*)(R + R_KSB + (size_t)(b * 2048 + s_tile + row) * 512 + hh * 64 + ch * 8);
                const u32x4 vv = *(const u32x4*)(R + R_VTSB + ((size_t)((b * 8 + hh) * 64 + row)) * 2048 + s_tile + ch * 8);
                *(u32x4*)(KT + row * 128 + ((ch ^ (row & 7)) << 4)) = kv;
                *(uint2*)(VTt + row * 136 + ch * 16) = make_uint2(vv[0], vv[1]);
                *(uint2*)(VTt + row * 136 + ch * 16 + 8) = make_uint2(vv[2], vv[3]);
            }
            __syncthreads();
#pragma unroll
            for (int sbk = 1; sbk >= 0; --sbk) {
                const int key_lo = s_tile + 32 * sbk;
                if (key_lo >= qbase + 31) continue;
                if (__all(Rr == 0.f)) continue;
                f32x16 st;
#pragma unroll
                for (int i = 0; i < 16; ++i) st[i] = 0.f;
                const int krow = 32 * sbk + r31;
#pragma unroll
                for (int kk = 0; kk < 4; ++kk) {
                    const bf16x8 kf = *(const bf16x8*)(KT + krow * 128 + (((2 * kk + h) ^ (krow & 7)) << 4));
                    st = __builtin_amdgcn_mfma_f32_32x32x16_bf16(kf, qf[kk], st, 0, 0, 0);
                }
                float a[16], G[4];
#pragma unroll
                for (int g = 0; g < 4; ++g) {
                    float sg[4], m[4];
#pragma unroll
                    for (int i = 0; i < 4; ++i) {
                        const int s = key_lo + 8 * g + 4 * h + i;
                        const float z = fminf(fmaxf(st[4 * g + i], -80.f), 80.f);
                        const float ez = __expf(-z), sig = 1.0f / (1.0f + ez);
                        const bool valid = s < t;
                        sg[i] = valid ? sig : 0.f; m[i] = valid ? ez * sig : 1.0f;
                    }
                    const float x2 = m[3], x1 = x2 * m[2], x0 = x1 * m[1];
                    G[g] = x0 * m[0];
                    a[4 * g + 3] = sg[3]; a[4 * g + 2] = sg[2] * x2; a[4 * g + 1] = sg[1] * x1; a[4 * g] = sg[0] * x0;
                }
                float Go[4], P[4];
#pragma unroll
                for (int g = 0; g < 4; ++g) { Go[g] = __shfl_xor(G[g], 32); P[g] = G[g] * Go[g]; }
                const float c2 = P[3], c1 = c2 * P[2], c0 = c1 * P[1];
                float Tg[4];
                Tg[3] = Rr; Tg[2] = Rr * c2; Tg[1] = Rr * c1; Tg[0] = Rr * c0;
#pragma unroll
                for (int g = 0; g < 4; ++g) {
                    const float tg = (h == 0) ? Tg[g] * Go[g] : Tg[g];
                    a[4 * g] *= tg; a[4 * g + 1] *= tg; a[4 * g + 2] *= tg; a[4 * g + 3] *= tg;
                }
                Rr = Rr * c0 * P[0];
#pragma unroll
                for (int s2 = 0; s2 < 2; ++s2) {
                    union { bf16x8 v; unsigned u[4]; } af;
#pragma unroll
                    for (int j2 = 0; j2 < 4; ++j2) af.u[j2] = pack2(a[8 * s2 + 2 * j2], a[8 * s2 + 2 * j2 + 1]);
#pragma unroll
                    for (int nt = 0; nt < 2; ++nt) {
                        const char* vp = VTt + (32 * nt + r31) * 136 + 64 * sbk + 32 * s2 + 8 * h;
                        union { bf16x8 v; uint2 hh2[2]; } vf;
                        vf.hh2[0] = *(const uint2*)vp; vf.hh2[1] = *(const uint2*)(vp + 16);
                        oacc[nt] = __builtin_amdgcn_mfma_f32_32x32x16_bf16(af.v, vf.v, oacc[nt], 0, 0, 0);
                    }
                }
            }
        }
#pragma unroll
        for (int nt = 0; nt < 2; ++nt)
#pragma unroll
            for (int i = 0; i < 16; ++i) {
                const int qq = (i & 3) + 8 * (i >> 2) + 4 * h;
                R[R_QSB + (size_t)(b * 2048 + qbase + qq) * 512 + hh * 64 + 32 * nt + r31] = f2bf(oacc[nt][i]);
            }
    }
}
__device__ __forceinline__ float log_sigmoid(float x) { return fminf(x, 0.f) - log1pf(__expf(-fabsf(x))); }
__device__ __forceinline__ int swz(int row, int chunk) { return row * 128 + ((chunk ^ (row & 7)) << 4); }
__device__ __forceinline__ void gla_prep(const Params& p, char* smem) {
    bf16_t* R = (bf16_t*)(p.ws + OFF_REGION);
    const float* ALR = (const float*)(R + R_ALR);
    bf16_t* KOTg = R + R_KOT; float* DECg = (float*)(R + R_DEC);
    float* SEG = (float*)smem; float* ALRs = SEG + 256;
    const int tid = VTID, d = tid & 63, w = tid >> 6;
    for (int task = VBID; task < 2048; task += VGRID) {
        const int bh = task >> 5, c = task & 31, b = bh >> 2, hh = bh & 3;
        const size_t rowbase = (size_t)b * 2048 + c * 64;
        unsigned qr[16], kr[16];
#pragma unroll
        for (int i = 0; i < 16; ++i) { const size_t row = rowbase + w * 16 + i; qr[i] = R[R_QG + row * 256 + hh * 64 + d]; kr[i] = R[R_KG + row * 256 + hh * 64 + d]; }
        const f32x4 ar = *(const f32x4*)(ALR + rowbase * 16 + tid * 4);
        float w2r[16];
#pragma unroll
        for (int r = 0; r < 16; ++r) w2r[r] = p.ab_w_alpha2[r * 256 + hh * 64 + d];
        const float b2r = p.ab_b_alpha2[hh * 64 + d];
        __syncthreads();
        *(f32x4*)(ALRs + tid * 4) = ar;
        __syncthreads();
        float cs[16]; float run = 0.f;
#pragma unroll
        for (int i = 0; i < 16; ++i) {
            const float* al = ALRs + (w * 16 + i) * 16;
            float pre = b2r;
#pragma unroll
            for (int r = 0; r < 16; ++r) pre += al[r] * w2r[r];
            run += log_sigmoid(pre) * (1.0f / 16.0f);
            cs[i] = run;
        }
        SEG[w * 64 + d] = run;
        __syncthreads();
        float off = 0.f, tot = 0.f;
#pragma unroll
        for (int w2 = 0; w2 < 4; ++w2) { const float s = SEG[w2 * 64 + d]; tot += s; if (w2 < w) off += s; }
        unsigned kop[8];
#pragma unroll
        for (int i2 = 0; i2 < 8; ++i2) {
            float kov[2];
#pragma unroll
            for (int u = 0; u < 2; ++u) {
                const int i = 2 * i2 + u;
                const float bc = off + cs[i];
                const float kv = bf2f((bf16_t)kr[i]);
                const size_t row = rowbase + w * 16 + i;
                R[R_QG + row * 256 + hh * 64 + d] = f2bf(bf2f((bf16_t)qr[i]) * 0.125f * __expf(bc));
                R[R_KG + row * 256 + hh * 64 + d] = f2bf(kv * __expf(-bc));
                kov[u] = kv * __expf(tot - bc);
            }
            kop[i2] = pack2(kov[0], kov[1]);
        }
        bf16_t* kp = KOTg + ((size_t)task * 64 + d) * 64 + w * 16;
        *(uint4*)kp = make_uint4(kop[0], kop[1], kop[2], kop[3]);
        *(uint4*)(kp + 8) = make_uint4(kop[4], kop[5], kop[6], kop[7]);
        if (w == 0) DECg[(size_t)task * 64 + d] = __expf(tot);
    }
}
__device__ __forceinline__ void gla_scan(const Params& p, char* smem, bool dry = false) {
    bf16_t* R = (bf16_t*)(p.ws + OFF_REGION);
    const bf16_t* KOTg = R + R_KOT; const float* DECg = (const float*)(R + R_DEC);
    char* QS = smem; char* KS = smem + 8192; char* KOT = smem + 16384; char* VTs = smem + 24576; char* SPT = smem + 40960;
    float* DEC = (float*)(smem + 57344); float* GN = DEC + 64;
    const int tid = VTID, lane = tid & 63, w = tid >> 6, l15_ = lane & 15, q4 = lane >> 4;
    for (int task = VBID; task < 64; task += VGRID) {
        const int b = task >> 2, hh = task & 3;
        f32x4 Sacc[8];
#pragma unroll
        for (int nt = 0; nt < 8; ++nt) Sacc[nt] = (f32x4){0.f, 0.f, 0.f, 0.f};
        __syncthreads();
        for (int i = tid; i < 1024; i += 256) *(uint4*)(SPT + i * 16) = make_uint4(0, 0, 0, 0);
        if (tid < 128) GN[tid] = p.ab_gla_norm[hh * 128 + tid];
        const size_t rowbase = (size_t)b * 2048;
        const bf16_t* vbase = R + R_VTG + ((size_t)((b * 4 + hh) * 128)) * 2048;
        u32x4 tq[2], tk[2], tko[2], vr[4]; float td = 0.f;
        auto prefetch = [&](int c) {
            const int t0 = c * 64;
#pragma unroll
            for (int i = 0; i < 2; ++i) {
                const int cid = tid + 256 * i, row = cid >> 3, ch = cid & 7;
                tq[i] = *(const u32x4*)(R + R_QG + (rowbase + t0 + row) * 256 + hh * 64 + ch * 8);
                tk[i] = *(const u32x4*)(R + R_KG + (rowbase + t0 + row) * 256 + hh * 64 + ch * 8);
                tko[i] = *(const u32x4*)(KOTg + (((size_t)task * 32 + c) * 64 + row) * 64 + ch * 8);
            }
#pragma unroll
            for (int i = 0; i < 4; ++i) { const int cid = tid + 256 * i, e = cid >> 3, ch = cid & 7; vr[i] = *(const u32x4*)(vbase + (size_t)e * 2048 + t0 + ch * 8); }
            if (tid < 64) td = DECg[((size_t)task * 32 + c) * 64 + tid];
        };
        prefetch(0);
        for (int c = 0; c < 32; ++c) {
            int lz = 0; asm volatile("" : "+v"(lz));
            const int l15 = l15_ + lz;
            const int cx = (q4 ^ (l15 & 7)) << 4;
            const int rb0 = l15 * 128 + cx, rb1 = l15 * 128 + (cx ^ 64);
#pragma unroll
            for (int i = 0; i < 2; ++i) {
                const int cid = tid + 256 * i + lz, row = cid >> 3, ch = cid & 7;
                *(u32x4*)(QS + swz(row, ch)) = tq[i]; *(u32x4*)(KS + swz(row, ch)) = tk[i]; *(u32x4*)(KOT + swz(row, ch)) = tko[i];
            }
#pragma unroll
            for (int i = 0; i < 4; ++i) { const int cid = tid + 256 * i + lz, e = cid >> 3, ch = cid & 7; *(u32x4*)(VTs + swz(e, ch)) = vr[i]; }
            if (tid < 64) DEC[tid] = td;
            uint2 gr[8];
            const unsigned goff = (unsigned)((rowbase + c * 64 + 16 * w + l15) * 512 + hh * 128 + 4 * q4);
            bf16_t* const gbase = R + R_GG;
#pragma unroll
            for (int nt = 0; nt < 8; ++nt) gr[nt] = *(const uint2*)(gbase + (goff + 16 * nt));
            if (c + 1 < 32) prefetch(c + 1);
            __syncthreads();
            bf16x8 qf[2];
#pragma unroll
            for (int kk = 0; kk < 2; ++kk) qf[kk] = *(const bf16x8*)(QS + w * 2048 + (kk ? rb1 : rb0));
            f32x4 sT[4];
#pragma unroll
            for (int st = 0; st < 4; ++st) {
                sT[st] = (f32x4){0.f, 0.f, 0.f, 0.f};
                if (st <= w) {
#pragma unroll
                    for (int kk = 0; kk < 2; ++kk) { const bf16x8 kf = *(const bf16x8*)(KS + st * 2048 + (kk ? rb1 : rb0)); sT[st] = __builtin_amdgcn_mfma_f32_16x16x32_bf16(kf, qf[kk], sT[st], 0, 0, 0); }
#pragma unroll
                    for (int r = 0; r < 4; ++r) if (16 * st + 4 * q4 + r > 16 * w + l15) sT[st][r] = 0.f;
                }
            }
            bf16x8 af[2];
#pragma unroll
            for (int ks2 = 0; ks2 < 2; ++ks2) {
                union { bf16x8 v; unsigned u[4]; } cv;
                cv.u[0] = pack2(sT[2 * ks2][0], sT[2 * ks2][1]); cv.u[1] = pack2(sT[2 * ks2][2], sT[2 * ks2][3]);
                cv.u[2] = pack2(sT[2 * ks2 + 1][0], sT[2 * ks2 + 1][1]); cv.u[3] = pack2(sT[2 * ks2 + 1][2], sT[2 * ks2 + 1][3]);
                af[ks2] = cv.v;
            }
            const int vb = l15 * 128 + ((((q4 >> 1) ^ (l15 & 7)) << 4) | ((q4 & 1) * 8));
            f32x4 o[8];
#pragma unroll
            for (int nt = 0; nt < 8; ++nt) {
                o[nt] = (f32x4){0.f, 0.f, 0.f, 0.f};
                const int e = 16 * nt + l15;
#pragma unroll
                for (int kk = 0; kk < 2; ++kk) { const bf16x8 sf = *(const bf16x8*)(SPT + nt * 2048 + (kk ? rb1 : rb0)); o[nt] = __builtin_amdgcn_mfma_f32_16x16x32_bf16(sf, qf[kk], o[nt], 0, 0, 0); }
#pragma unroll
                for (int ks2 = 0; ks2 < 2; ++ks2) {
                    if (2 * ks2 <= w) {
                        union { bf16x8 v; uint2 h[2]; } cv;
                        cv.h[0] = *(const uint2*)(VTs + nt * 2048 + (vb ^ (ks2 * 64)));
                        cv.h[1] = *(const uint2*)(VTs + nt * 2048 + (vb ^ (ks2 * 64) ^ 32));
                        o[nt] = __builtin_amdgcn_mfma_f32_16x16x32_bf16(cv.v, af[ks2], o[nt], 0, 0, 0);
                    }
                }
            }
            {
                const float4 dc = *(const float4*)(DEC + 16 * w + 4 * q4);
                bf16x8 kof[2];
#pragma unroll
                for (int kk = 0; kk < 2; ++kk) kof[kk] = *(const bf16x8*)(KOT + w * 2048 + (kk ? rb1 : rb0));
#pragma unroll
                for (int nt = 0; nt < 8; ++nt) {
                    Sacc[nt][0] *= dc.x; Sacc[nt][1] *= dc.y; Sacc[nt][2] *= dc.z; Sacc[nt][3] *= dc.w;
#pragma unroll
                    for (int kk = 0; kk < 2; ++kk) { const bf16x8 vf = *(const bf16x8*)(VTs + nt * 2048 + (kk ? rb1 : rb0)); Sacc[nt] = __builtin_amdgcn_mfma_f32_16x16x32_bf16(kof[kk], vf, Sacc[nt], 0, 0, 0); }
                }
            }
            __syncthreads();
#pragma unroll
            for (int nt = 0; nt < 8; ++nt) {
                const int e = 16 * nt + l15;
                uint2 pk; pk.x = pack2(Sacc[nt][0], Sacc[nt][1]); pk.y = pack2(Sacc[nt][2], Sacc[nt][3]);
                *(uint2*)(SPT + nt * 2048 + l15 * 128 + (((2 * w + (q4 >> 1)) ^ (l15 & 7)) << 4) + (q4 & 1) * 8) = pk;
            }
            float ssq = 0.f;
#pragma unroll
            for (int nt = 0; nt < 8; ++nt) ssq += (o[nt][0] * o[nt][0] + o[nt][1] * o[nt][1]) + (o[nt][2] * o[nt][2] + o[nt][3] * o[nt][3]);
            ssq += __shfl_xor(ssq, 16); ssq += __shfl_xor(ssq, 32);
            const float rsd = rsqrtf(ssq * (1.0f / 128.0f) + EPS);
#pragma unroll
            for (int nt = 0; nt < 8; ++nt) {
                asm volatile("" ::: "memory");
                const f32x4 gn = *(const f32x4*)(GN + 16 * nt + 4 * q4);
                const float g0 = lo2f(gr[nt].x), g1 = hi2f(gr[nt].x), g2 = lo2f(gr[nt].y), g3 = hi2f(gr[nt].y);
                uint2 ov;
                ov.x = pack2(o[nt][0] * rsd * gn[0] * (g0 / (1.0f + __expf(-g0))), o[nt][1] * rsd * gn[1] * (g1 / (1.0f + __expf(-g1))));
                ov.y = pack2(o[nt][2] * rsd * gn[2] * (g2 / (1.0f + __expf(-g2))), o[nt][3] * rsd * gn[3] * (g3 / (1.0f + __expf(-g3))));
                if (!dry || ov.x == 0x7fc17fc1u) *(uint2*)(gbase + (goff + 16 * nt)) = ov;
            }
        }
    }
}

__device__ __forceinline__ unsigned ord_key(float f) { const unsigned u = __float_as_uint(f); return (u & 0x80000000u) ? ~u : (u | 0x80000000u); }
__device__ __forceinline__ float unord_key(unsigned k) { return __uint_as_float((k & 0x80000000u) ? (k & 0x7fffffffu) : ~k); }
__device__ __forceinline__ void ce_desc(unsigned& a, unsigned& b) { const unsigned hi = max(a, b), lo = min(a, b); a = hi; b = lo; }
__device__ __forceinline__ void bitonic_sort16_desc(unsigned (&a)[16]) {
#pragma unroll
    for (int k = 2; k <= 16; k <<= 1)
#pragma unroll
        for (int j = k >> 1; j > 0; j >>= 1)
#pragma unroll
            for (int i = 0; i < 16; ++i) { const int l = i ^ j; if (l > i) { if ((i & k) == 0) ce_desc(a[i], a[l]); else ce_desc(a[l], a[i]); } }
}
__device__ __forceinline__ void merge_top16(unsigned (&L)[16], const unsigned (&B)[16]) {
#pragma unroll
    for (int i = 0; i < 16; ++i) L[i] = max(L[i], B[15 - i]);
#pragma unroll
    for (int j = 8; j > 0; j >>= 1)
#pragma unroll
        for (int i = 0; i < 16; ++i) { const int l = i ^ j; if (l > i) ce_desc(L[i], L[l]); }
}
__device__ constexpr int cand_i(int n) { int c = 0; for (int i = 0; i < 16; ++i) for (int j = 0; j < 16; ++j) if ((i + 1) * (j + 1) <= 16) { if (c == n) return i; ++c; } return -1; }
__device__ constexpr int cand_j(int n) { int c = 0; for (int i = 0; i < 16; ++i) for (int j = 0; j < 16; ++j) if ((i + 1) * (j + 1) <= 16) { if (c == n) return j; ++c; } return -1; }
template <int N> struct CandTab { int i[N], j[N]; constexpr CandTab() : i(), j() { for (int n = 0; n < N; ++n) { i[n] = cand_i(n); j[n] = cand_j(n); } } };
__device__ __forceinline__ void peer_select_fast(const Params& p, int layer, char* smem) {
    const bf16_t* A = (const bf16_t*)(p.ws + OFF_H);
    const bf16_t* Bt = (const bf16_t*)(p.ws + OFF_WT_Q) + (size_t)layer * 2048 * 1024;
    const bf16_t* SK = (const bf16_t*)(p.ws + OFF_SK) + (size_t)layer * 8 * 2 * 128 * 128;
    unsigned short* IDX = (unsigned short*)(p.ws + OFF_IDX); float* GATE = (float*)(p.ws + OFF_GATE);
    const int tid_ = VTID;
    float* SC = (float*)smem; unsigned* XCH = (unsigned*)smem;
    int mt_, hh;
    for (int it = 0; tile_sched(it, T / 128, 8, mt_, hh); ++it) {
        const int m0 = mt_ * 128;
        unsigned L0[16], L1[16];
#pragma unroll
        for (int pp = 0; pp < 2; ++pp) {
            f32x4 acc[4][4];
            gemm_mainloop<0>(A, A, 1024, 1024, Bt, 1024, m0, hh * 256 + pp * 128, acc, smem);
            int lz = 0; asm volatile("" : "+v"(lz));
            const int tid = tid_ + lz, lane = tid & 63, wid = tid >> 6, wm = wid >> 1, wn = wid & 1, l15 = lane & 15, q4 = lane >> 4, token = tid & 127, half = tid >> 7;
#pragma unroll
            for (int i = 0; i < 4; ++i)
#pragma unroll
                for (int j = 0; j < 4; ++j) {
                    const int row = wm * 64 + i * 16 + l15, chunk = 2 * j + (q4 >> 1);
                    uint2 o; o.x = pack2(acc[i][j][0], acc[i][j][1]); o.y = pack2(acc[i][j][2], acc[i][j][3]);
                    *(uint2*)(smem + wn * 32768 + row * 128 + ((chunk ^ (row & 7)) << 4) + (q4 & 1) * 8) = o;
                }
            const bf16_t* SKp = SK + (size_t)((hh * 2 + pp) * 128) * 128;
#pragma unroll
            for (int i = 0; i < 8; ++i) {
                const int c = tid + 256 * i, row = c >> 4, ch16 = c & 15, ks = ch16 >> 3, ch = ch16 & 7;
                *(uint4*)(smem + ks * 32768 + 16384 + row * 128 + ((ch ^ (row & 7)) << 4)) = *(const uint4*)(SKp + (size_t)row * 128 + ch16 * 8);
            }
            __syncthreads();
#pragma unroll
            for (int i = 0; i < 4; ++i)
#pragma unroll
                for (int j = 0; j < 4; ++j) acc[i][j] = (f32x4){0.f, 0.f, 0.f, 0.f};
#pragma unroll
            for (int kt = 0; kt < 2; ++kt) {
                const char* sa = smem + kt * 32768; const char* sb = sa + 16384;
#pragma unroll
                for (int ks = 0; ks < 2; ++ks) {
                    bf16x8 af[4], bfr[4];
                    const int ch = ks * 4 + q4;
#pragma unroll
                    for (int i = 0; i < 4; ++i) { const int row = wm * 64 + i * 16 + l15; af[i] = *(const bf16x8*)(sa + row * 128 + ((ch ^ (row & 7)) << 4)); }
#pragma unroll
                    for (int j = 0; j < 4; ++j) { const int row = wn * 64 + j * 16 + l15; bfr[j] = *(const bf16x8*)(sb + row * 128 + ((ch ^ (row & 7)) << 4)); }
#pragma unroll
                    for (int i = 0; i < 4; ++i)
#pragma unroll
                        for (int j = 0; j < 4; ++j) acc[i][j] = __builtin_amdgcn_mfma_f32_16x16x32_bf16(bfr[j], af[i], acc[i][j], 0, 0, 0);
                }
            }
            __syncthreads();
#pragma unroll
            for (int i = 0; i < 4; ++i)
#pragma unroll
                for (int j = 0; j < 4; ++j) {
                    const int m = wm * 64 + i * 16 + l15, n = wn * 64 + j * 16 + 4 * q4;
#pragma unroll
                    for (int r = 0; r < 4; ++r) SC[m * 128 + ((n + r) ^ (m & 31))] = acc[i][j][r];
                }
            __syncthreads();
            unsigned L[16];
            {
                const float* srow = SC + token * 128 + half * 64; const int x = token & 31;
#pragma unroll
                for (int ch = 0; ch < 4; ++ch) {
                    unsigned Cc[16];
#pragma unroll
                    for (int i = 0; i < 16; ++i) { const int c = ch * 16 + i; Cc[i] = (ord_key(srow[c ^ x]) & ~127u) | (unsigned)(127 - (half * 64 + c)); }
                    bitonic_sort16_desc(Cc);
                    if (ch == 0) {
#pragma unroll
                        for (int i = 0; i < 16; ++i) L[i] = Cc[i];
                    } else merge_top16(L, Cc);
                }
            }
            __syncthreads();
            if (half == 1) {
#pragma unroll
                for (int i = 0; i < 16; ++i) XCH[token * 17 + i] = L[i];
            }
            __syncthreads();
            if (half == 0) {
                unsigned Xc[16];
#pragma unroll
                for (int i = 0; i < 16; ++i) Xc[i] = XCH[token * 17 + i];
                merge_top16(L, Xc);
            }
#pragma unroll
            for (int i = 0; i < 16; ++i) { if (pp == 0) L0[i] = L[i]; else L1[i] = L[i]; }
            __syncthreads();
        }
        unsigned* NIDX = (unsigned*)smem;
        const int token = tid_ & 127, half = tid_ >> 7;
        if (half == 0) {
            float s0[16], s1[16];
#pragma unroll
            for (int i = 0; i < 16; ++i) { s0[i] = unord_key(L0[i] & ~127u); s1[i] = unord_key(L1[i] & ~127u); }
            constexpr CandTab<64> ct{};
            unsigned C[16];
#pragma unroll
            for (int ch = 0; ch < 4; ++ch) {
                unsigned Cc[16];
#pragma unroll
                for (int i = 0; i < 16; ++i) {
                    const int n = ch * 16 + i;
                    if (ct.i[n] >= 0) Cc[i] = (ord_key(s0[ct.i[n] < 0 ? 0 : ct.i[n]] + s1[ct.j[n] < 0 ? 0 : ct.j[n]]) & ~255u) | (unsigned)(255 - (ct.i[n] * 16 + ct.j[n]));
                    else Cc[i] = 0u;
                }
                bitonic_sort16_desc(Cc);
                if (ch == 0) {
#pragma unroll
                    for (int i = 0; i < 16; ++i) C[i] = Cc[i];
                } else merge_top16(C, Cc);
            }
#pragma unroll
            for (int i = 0; i < 16; ++i) { NIDX[token * 33 + i] = 127u - (L0[i] & 127u); NIDX[token * 33 + 16 + i] = 127u - (L1[i] & 127u); }
            const float mx = unord_key(C[0] & ~255u);
            float e[16]; float sum = 0.f;
#pragma unroll
            for (int r = 0; r < 16; ++r) { e[r] = __expf(unord_key(C[r] & ~255u) - mx); sum += e[r]; }
            const float inv = 1.0f / sum;
            const size_t ob = (size_t)(m0 + token) * 128 + hh * 16;
#pragma unroll
            for (int r = 0; r < 16; ++r) {
                const unsigned code = 255u - (C[r] & 255u);
                const unsigned e0 = NIDX[token * 33 + (code >> 4)], e1 = NIDX[token * 33 + 16 + (code & 15)];
                IDX[ob + r] = (unsigned short)(e0 * 128 + e1);
                GATE[ob + r] = e[r] * inv;
            }
        }
        __syncthreads();
    }
}

__device__ __forceinline__ bf16x8 pack8(const float4 a, const float4 b) {
    u32x4 t; t.x = pack2(a.x, a.y); t.y = pack2(a.z, a.w); t.z = pack2(b.x, b.y); t.w = pack2(b.z, b.w);
    return __builtin_bit_cast(bf16x8, t);
}
__device__ __forceinline__ void fold_query_weights(const Params& p, int vb0 = 0) {
    int lz = 0; asm volatile("" : "+v"(lz));
    const int lane = (VTID & 63) + lz, wid = VTID >> 6, fr = lane & 15, fq = lane >> 4;
    bf16_t* Wf = (bf16_t*)(p.ws + OFF_WT_Q);
    if (VBID < vb0) return;
    for (int task = VBID - vb0; task < 512; task += VGRID - vb0) {
        const int kb = task & 15, pp = (task >> 4) & 1, h = (task >> 5) & 7, layer = task >> 8;
        const float* wq = p.peer_w_q + (size_t)layer * 1024 * 2048 + (size_t)(kb * 64 + fr) * 2048 + h * 256 + pp * 128 + fq * 8;
        const float* sk = p.peer_subkeys + ((size_t)((layer * 8 + h) * 2 + pp) * 128 + wid * 32 + fr) * 128 + fq * 8;
        f32x4 acc[4][2];
#pragma unroll
        for (int kt = 0; kt < 4; ++kt)
#pragma unroll
            for (int jt = 0; jt < 2; ++jt) acc[kt][jt] = (f32x4){0.f, 0.f, 0.f, 0.f};
#pragma unroll 1
        for (int s = 0; s < 4; ++s) {
            bf16x8 a[4], b[2];
#pragma unroll
            for (int kt = 0; kt < 4; ++kt) { const float* q = wq + (size_t)(kt * 16) * 2048 + s * 32; a[kt] = pack8(*(const float4*)q, *(const float4*)(q + 4)); }
#pragma unroll
            for (int jt = 0; jt < 2; ++jt) { const float* q = sk + (size_t)(jt * 16) * 128 + s * 32; b[jt] = pack8(*(const float4*)q, *(const float4*)(q + 4)); }
#pragma unroll
            for (int kt = 0; kt < 4; ++kt)
#pragma unroll
                for (int jt = 0; jt < 2; ++jt) acc[kt][jt] = __builtin_amdgcn_mfma_f32_16x16x32_bf16(a[kt], b[jt], acc[kt][jt], 0, 0, 0);
        }
#pragma unroll
        for (int jt = 0; jt < 2; ++jt) {
            const int key = wid * 32 + jt * 16 + fr, cu = 128 * ((key >> 5) & 1) + 32 * (2 * pp + (key >> 6)) + (key & 31);
            bf16_t* row = Wf + ((size_t)layer * 2048 + h * 256 + cu) * 1024 + kb * 64 + 4 * fq;
#pragma unroll
            for (int kt = 0; kt < 4; ++kt) store_bf16x4(row + kt * 16, acc[kt][jt]);
        }
    }
}
__device__ __forceinline__ void bitonic_merge16_desc(unsigned (&L)[16]) {
#pragma unroll
    for (int j = 8; j > 0; j >>= 1)
#pragma unroll
        for (int i = 0; i < 16; ++i) { const int l = i ^ j; if (l > i) ce_desc(L[i], L[l]); }
}
__device__ __forceinline__ void bitonic_sort8_desc(unsigned (&a)[8]) {
#pragma unroll
    for (int k = 2; k <= 8; k <<= 1)
#pragma unroll
        for (int j = k >> 1; j > 0; j >>= 1)
#pragma unroll
            for (int i = 0; i < 8; ++i) { const int l = i ^ j; if (l > i) { if ((i & k) == 0) ce_desc(a[i], a[l]); else ce_desc(a[l], a[i]); } }
}
struct EpiSelect {
    unsigned short* IDX; float* GATE; G8_LAS unsigned* X; const float* SSQP;
    __device__ __forceinline__ void operator()(const f32x4 (&acc)[2][2][4][2], const g8::Unit& u, int wr, int wc, int fr, int fq) const {
        const int pp = wc >> 1, half = wc & 1, wid = wr * 4 + wc;
        const unsigned kb = 127u - (unsigned)(half * 64 + fq * 8);
        unsigned Lst[4][16];
#pragma unroll
        for (int ai = 0; ai < 2; ++ai)
#pragma unroll
            for (int m = 0; m < 4; ++m) {
                unsigned C[16], Xc[16];
#pragma unroll
                for (int bj = 0; bj < 2; ++bj)
#pragma unroll
                    for (int n = 0; n < 2; ++n)
#pragma unroll
                        for (int r = 0; r < 4; ++r) C[bj * 8 + n * 4 + r] = (ord_key(acc[ai][bj][m][n][r]) & ~127u) | (kb - (unsigned)(bj * 32 + n * 4 + r));
                bitonic_sort16_desc(C);
#pragma unroll
                for (int i = 0; i < 16; ++i) Xc[i] = (unsigned)__shfl_xor((int)C[i], 16);
                merge_top16(C, Xc);
#pragma unroll
                for (int i = 0; i < 16; ++i) Xc[i] = (unsigned)__shfl_xor((int)C[i], 32);
                merge_top16(C, Xc);
                if ((m >> 1) == half) {
#pragma unroll
                    for (int i = 0; i < 16; ++i) Lst[ai * 2 + (m & 1)][i] = C[i];
                } else if (fq == 0) {
                    G8_LAS unsigned* xs = X + (((ai * 2 + wr) * 2 + pp) * 4 + m) * 256 + fr;
#pragma unroll
                    for (int i = 0; i < 16; ++i) xs[(i ^ m) << 4] = C[i];
                }
            }
        __syncthreads();
#pragma unroll
        for (int ai = 0; ai < 2; ++ai)
#pragma unroll
            for (int e = 0; e < 2; ++e) {
                const int m = half * 2 + e;
                unsigned Xc[16];
                G8_LAS unsigned* xs = X + (((ai * 2 + wr) * 2 + pp) * 4 + m) * 256 + fr;
#pragma unroll
                for (int i = 0; i < 16; ++i) Xc[i] = xs[(i ^ m) << 4];
                merge_top16(Lst[ai * 2 + e], Xc);
                if (fq == 0) {
#pragma unroll
                    for (int i = 0; i < 16; ++i) xs[(i ^ m) << 4] = Lst[ai * 2 + e][i];
                }
            }
        __syncthreads();
        if (wid < 4) {
            G8_LAS unsigned* x0 = X + ((wid * 2 + 0) * 4 + fq) * 256 + fr; G8_LAS unsigned* x1 = X + ((wid * 2 + 1) * 4 + fq) * 256 + fr;
            float s0[16], s1[16];
#pragma unroll
            for (int i = 0; i < 16; ++i) { s0[i] = unord_key(x0[(i ^ fq) << 4] & ~127u); s1[i] = unord_key(x1[(i ^ fq) << 4] & ~127u); }
#define SEL_CAND(i, j) ((ord_key(s0[i] + s1[j]) & ~255u) | (unsigned)(255 - ((i) * 16 + (j))))
            unsigned C[16], B[16], M2[16], M3[8];
#pragma unroll
            for (int j = 0; j < 16; ++j) C[j] = SEL_CAND(0, j);
#pragma unroll
            for (int k = 0; k < 15; ++k) B[k] = SEL_CAND(k + 1, 0);
            B[15] = 0u;
            merge_top16(C, B);
#pragma unroll
            for (int j = 0; j < 7; ++j) M2[j] = SEL_CAND(1, j + 1);
            M2[7] = 0u; M2[8] = 0u; M2[9] = 0u;
#pragma unroll
            for (int k = 0; k < 6; ++k) M2[15 - k] = SEL_CAND(k + 2, 1);
            bitonic_merge16_desc(M2);
            M3[0] = SEL_CAND(2, 2); M3[1] = SEL_CAND(2, 3); M3[2] = SEL_CAND(2, 4); M3[3] = SEL_CAND(3, 2); M3[4] = SEL_CAND(4, 2); M3[5] = SEL_CAND(3, 3); M3[6] = 0u; M3[7] = 0u;
            bitonic_sort8_desc(M3);
#pragma unroll
            for (int i = 0; i < 8; ++i) B[i] = M3[i];
#pragma unroll
            for (int i = 8; i < 16; ++i) B[i] = 0u;
            merge_top16(M2, B);
            merge_top16(C, M2);
#undef SEL_CAND
            const int tok = u.pm * 256 + (wid >> 1) * 128 + (wid & 1) * 64 + fq * 16 + fr;
            float rstd;
            {
                const f32x4 q0 = *(const f32x4*)(SSQP + (size_t)tok * 32), q1 = *(const f32x4*)(SSQP + (size_t)tok * 32 + 4), q2 = *(const f32x4*)(SSQP + (size_t)tok * 32 + 8), q3 = *(const f32x4*)(SSQP + (size_t)tok * 32 + 12);
                const f32x4 q = (q0 + q1) + (q2 + q3);
                rstd = rsqrtf(((q[0] + q[1]) + (q[2] + q[3])) * (1.0f / D) + EPS);
            }
            const float mx = unord_key(C[0] & ~255u);
            float e[16]; float sum = 0.f;
#pragma unroll
            for (int r = 0; r < 16; ++r) { e[r] = __expf((unord_key(C[r] & ~255u) - mx) * rstd); sum += e[r]; }
            const float inv = 1.0f / sum;
            const size_t ob = (size_t)tok * 128 + u.pn * 16;
            unsigned iw[8];
#pragma unroll
            for (int r = 0; r < 16; ++r) {
                const unsigned code = 255u - (C[r] & 255u);
                const unsigned e0 = 127u - (x0[((code >> 4) ^ (unsigned)fq) << 4] & 127u), e1 = 127u - (x1[((code & 15u) ^ (unsigned)fq) << 4] & 127u);
                const unsigned id = e0 * 128u + e1;
                if (r & 1) iw[r >> 1] |= id << 16; else iw[r >> 1] = id;
                e[r] *= inv;
            }
            *(uint4*)(IDX + ob) = make_uint4(iw[0], iw[1], iw[2], iw[3]); *(uint4*)(IDX + ob + 8) = make_uint4(iw[4], iw[5], iw[6], iw[7]);
#pragma unroll
            for (int r = 0; r < 4; ++r) *(float4*)(GATE + ob + r * 4) = make_float4(e[4 * r], e[4 * r + 1], e[4 * r + 2], e[4 * r + 3]);
        }
        __syncthreads();
    }
};
__device__ __forceinline__ void phase_select8(const Params& p, int layer, char* smem_phys) {
    const bf16_t* H = (const bf16_t*)(p.ws + OFF_H); const bf16_t* Wf = (const bf16_t*)(p.ws + OFF_WT_Q) + (size_t)layer * 2048 * 1024;
    g8::Gemm g{H, H, 1024, 1024, Wf, T, 2048, 1024};
    g8::StaticOrder S; S.init(T, 2048, (int)gridDim.x, (int)blockIdx.x);
    EpiSelect E{(unsigned short*)(p.ws + OFF_IDX), (float*)(p.ws + OFF_GATE), (G8_LAS unsigned*)(smem_phys + 131072), (const float*)(p.ws + OFF_SSQ)};
    g8::gemm_phase<EpiSelect>((G8_LAS unsigned char*)smem_phys, g, S, E);
    __syncthreads();
    if (threadIdx.x == 0) *(uint4*)(smem_phys + kDynLds - 16) = make_uint4(0u, 0u, 0u, 0u);
    __syncthreads();
}

__device__ __forceinline__ float ub0(unsigned w) { float f; asm("v_cvt_f32_ubyte0 %0, %1" : "=v"(f) : "v"(w)); return f; }
__device__ __forceinline__ float ub1(unsigned w) { float f; asm("v_cvt_f32_ubyte1 %0, %1" : "=v"(f) : "v"(w)); return f; }
__device__ __forceinline__ float ub2(unsigned w) { float f; asm("v_cvt_f32_ubyte2 %0, %1" : "=v"(f) : "v"(w)); return f; }
__device__ __forceinline__ float ub3(unsigned w) { float f; asm("v_cvt_f32_ubyte3 %0, %1" : "=v"(f) : "v"(w)); return f; }
typedef _Float16 f16x2 __attribute__((ext_vector_type(2)));
__device__ __forceinline__ void glds16(const void* gsrc, unsigned lds_dst) {
    unsigned keep; const unsigned d = (unsigned)__builtin_amdgcn_readfirstlane((int)lds_dst);
    asm volatile("s_mov_b32 %0, m0\n\ts_mov_b32 m0, %2\n\ts_nop 0\n\tglobal_load_lds_dwordx4 %1, off\n\ts_mov_b32 m0, %0" : "=&s"(keep) : "v"(gsrc), "s"(d) : "memory");
}
__device__ __forceinline__ void peer_gather(const Params& p, int layer, const float* __restrict__ gnext, bool final_out, char* smem) {
    const unsigned char* REC = p.ws + OFF_UT + (size_t)layer * NEXP * 1152;
    bf16_t* H = (bf16_t*)(p.ws + OFF_H);
    const unsigned short* IDX = (const unsigned short*)(p.ws + OFF_IDX); const float* GATE = (const float*)(p.ws + OFF_GATE);
    float* X = p.out;
    const int lane = VTID & 63, wid = VTID >> 6, sub = lane >> 4, li = lane & 15;
    char* wbase = smem + (int)(threadIdx.x >> 6) * 19456;
    unsigned short* sIdx = (unsigned short*)wbase; float* sGate = (float*)(wbase + 256);
    const char* ring = wbase + 1024; const unsigned ringb = (unsigned)(size_t)ring;
    const int gw = VBID * 4 + wid, nw = VGRID * 4;
    for (int t = gw; t < T; t += nw) {
        {
            int lz = 0; asm volatile("" : "+v"(lz));
            const int l2 = 2 * (lane + lz);
            const unsigned idp = *(const unsigned*)(IDX + (size_t)t * 128 + l2);
            const float2 g2 = *(const float2*)(GATE + (size_t)t * 128 + l2);
            *(unsigned*)(sIdx + l2) = idp; *(float2*)(sGate + l2) = g2;
        }
        int xq[2][8]; float sx; float xg[2];
        {
            u32x4 xr[8]; float am = 0.f;
#pragma unroll
            for (int k = 0; k < 8; ++k) {
                xr[k] = *(const u32x4*)(H + (size_t)t * 1024 + (16 * (k >> 2) + li) * 32 + (k & 3) * 8);
#pragma unroll
                for (int c = 0; c < 4; ++c) am = fmaxf(am, fmaxf(fabsf(lo2f(xr[k][c])), fabsf(hi2f(xr[k][c]))));
            }
            const float* sq = (const float*)(p.ws + OFF_SSQ) + (size_t)t * 32;
            const f32x4 qs = (*(const f32x4*)sq + *(const f32x4*)(sq + 4)) + (*(const f32x4*)(sq + 8) + *(const f32x4*)(sq + 12));
            am = fmaxf(am, __shfl_xor(am, 1)); am = fmaxf(am, __shfl_xor(am, 2)); am = fmaxf(am, __shfl_xor(am, 4)); am = fmaxf(am, __shfl_xor(am, 8));
            const float inv = am > 0.f ? 127.0f / am : 0.f;
            sx = am * (1.0f / 127.0f) * rsqrtf(((qs[0] + qs[1]) + (qs[2] + qs[3])) * (1.0f / D) + EPS);
#pragma unroll
            for (int j = 0; j < 2; ++j) {
                int xs = 0;
#pragma unroll
                for (int d = 0; d < 8; ++d) {
                    const unsigned w0 = xr[j * 4 + (d >> 1)][(d & 1) * 2], w1 = xr[j * 4 + (d >> 1)][(d & 1) * 2 + 1];
                    const int q0 = __float2int_rn(lo2f(w0) * inv), q1 = __float2int_rn(hi2f(w0) * inv), q2 = __float2int_rn(lo2f(w1) * inv), q3 = __float2int_rn(hi2f(w1) * inv);
                    xq[j][d] = (q0 & 0xff) | ((q1 & 0xff) << 8) | ((q2 & 0xff) << 16) | ((q3 & 0xff) << 24);
                    xs += (q0 + q1) + (q2 + q3);
                }
                xg[j] = -7.5f * (float)xs;
            }
        }
        f16x2 accp[2][16];
#pragma unroll
        for (int j = 0; j < 2; ++j)
#pragma unroll
            for (int c = 0; c < 16; ++c) accp[j][c] = (f16x2){(_Float16)0.f, (_Float16)0.f};
        float wsg[2] = {0.f, 0.f};
        auto issue = [&](int sg) {
            const unsigned e_ = sIdx[sg * 4 + sub];
            const unsigned char* rec = REC + (size_t)e_ * 1152 + li * 16;
            const unsigned dst = ringb + (unsigned)(sg & 3) * 4608u;
            glds16(rec, dst); glds16(rec + 256, dst + 1024u); glds16(rec + 512, dst + 2048u); glds16(rec + 768, dst + 3072u);
            if (lane < 32) {
                const unsigned e2 = sIdx[sg * 4 + (lane >> 3)];
                glds16(REC + (size_t)e2 * 1152 + 1024 + (lane & 7) * 16, dst + 4096u);
            }
        };
        auto compute = [&](int sg) {
            const char* sl = ring + (sg & 3) * 4608;
            const u32x4 du0 = *(const u32x4*)(sl + lane * 16), du1 = *(const u32x4*)(sl + 1024 + lane * 16);
            const u32x4 dv0 = *(const u32x4*)(sl + 2048 + lane * 16), dv1 = *(const u32x4*)(sl + 3072 + lane * 16);
            const uint2 sc = *(const uint2*)(sl + 4096 + sub * 128 + li * 8);
            const float gt = sGate[sg * 4 + sub];
            const f16x2 us = __builtin_bit_cast(f16x2, sc.x), vs = __builtin_bit_cast(f16x2, sc.y);
            float pa = 0.f;
#pragma unroll
            for (int j = 0; j < 2; ++j) {
                int ia = 0;
#pragma unroll
                for (int d = 0; d < 4; ++d) {
                    const unsigned w = j ? du1[d] : du0[d];
                    ia = __builtin_amdgcn_sdot4((int)(w & 0x0f0f0f0fu), xq[j][2 * d], ia, false);
                    ia = __builtin_amdgcn_sdot4((int)((w >> 4) & 0x0f0f0f0fu), xq[j][2 * d + 1], ia, false);
                }
                pa += (float)us[j] * ((float)ia + xg[j]);
            }
            pa = row16_sum(pa);
            const float ww = gt * gelu_exact(pa * sx);
#pragma unroll
            for (int j = 0; j < 2; ++j) {
                const float wg = ww * (float)vs[j];
                wsg[j] += wg;
                const _Float16 wh = (_Float16)fminf(fmaxf(wg * 65536.0f, -65504.0f), 65504.0f);
                const f16x2 w2 = {wh, wh};
#pragma unroll
                for (int d = 0; d < 4; ++d) {
                    const unsigned wv = j ? dv1[d] : dv0[d];
                    const f16x2 c0 = __builtin_bit_cast(f16x2, (wv << 4) & 0x00f000f0u), c1 = __builtin_bit_cast(f16x2, wv & 0x00f000f0u);
                    const f16x2 c2 = __builtin_bit_cast(f16x2, (wv >> 4) & 0x00f000f0u), c3 = __builtin_bit_cast(f16x2, (wv >> 8) & 0x00f000f0u);
                    accp[j][4 * d + 0] = __builtin_elementwise_fma(c0, w2, accp[j][4 * d + 0]); accp[j][4 * d + 1] = __builtin_elementwise_fma(c1, w2, accp[j][4 * d + 1]);
                    accp[j][4 * d + 2] = __builtin_elementwise_fma(c2, w2, accp[j][4 * d + 2]); accp[j][4 * d + 3] = __builtin_elementwise_fma(c3, w2, accp[j][4 * d + 3]);
                }
            }
        };
        asm volatile("s_waitcnt vmcnt(0)" ::: "memory");
        issue(0); issue(1); issue(2);
#pragma unroll 1
        for (int sg = 0; sg < 29; ++sg) {
            issue(sg + 3);
            asm volatile("s_waitcnt vmcnt(15)" ::: "memory");
            compute(sg);
        }
        asm volatile("s_waitcnt vmcnt(10)" ::: "memory");
        compute(29);
        asm volatile("s_waitcnt vmcnt(5)" ::: "memory");
        compute(30);
        asm volatile("s_waitcnt vmcnt(0)" ::: "memory");
        compute(31);
        float acc[2][32];
#pragma unroll
        for (int j = 0; j < 2; ++j)
#pragma unroll
            for (int d = 0; d < 4; ++d) {
                acc[j][8 * d + 0] = 16.0f * (float)accp[j][4 * d + 0][0]; acc[j][8 * d + 2] = 16.0f * (float)accp[j][4 * d + 0][1];
                acc[j][8 * d + 4] = 16.0f * (float)accp[j][4 * d + 1][0]; acc[j][8 * d + 6] = 16.0f * (float)accp[j][4 * d + 1][1];
                acc[j][8 * d + 1] = 16.0f * (float)accp[j][4 * d + 2][0]; acc[j][8 * d + 3] = 16.0f * (float)accp[j][4 * d + 2][1];
                acc[j][8 * d + 5] = 16.0f * (float)accp[j][4 * d + 3][0]; acc[j][8 * d + 7] = 16.0f * (float)accp[j][4 * d + 3][1];
            }
        const bool up2 = (sub & 2) != 0, up1 = (sub & 1) != 0;
        float wsum = (up2 ? wsg[1] : wsg[0]) + __shfl_xor(up2 ? wsg[0] : wsg[1], 32);
        wsum += __shfl_xor(wsum, 16);
        float r1[32];
#pragma unroll
        for (int c = 0; c < 32; ++c) r1[c] = (up2 ? acc[1][c] : acc[0][c]) + __shfl_xor(up2 ? acc[0][c] : acc[1][c], 32);
        float r2[16];
#pragma unroll
        for (int c = 0; c < 16; ++c) r2[c] = (up1 ? r1[16 + c] : r1[c]) + __shfl_xor(up1 ? r1[c] : r1[16 + c], 16);
        const int col0 = (16 * (sub >> 1) + li) * 32 + (sub & 1) * 16;
        float ss = 0.f;
        float* xrow = X + (size_t)t * 1024 + col0;
#pragma unroll
        for (int c4 = 0; c4 < 4; ++c4) {
            const f32x4 a = *(const f32x4*)(xrow + c4 * 4);
#pragma unroll
            for (int c = 0; c < 4; ++c) { r2[c4 * 4 + c] = r2[c4 * 4 + c] - 7.5f * wsum + a[c]; ss += r2[c4 * 4 + c] * r2[c4 * 4 + c]; }
        }
        ss = wave_sum(ss);
        const float rstd = rsqrtf(ss * (1.0f / D) + EPS);
        const float* gp = gnext + col0;
        if (final_out) {
#pragma unroll
            for (int c4 = 0; c4 < 4; ++c4) {
                const f32x4 g = *(const f32x4*)(gp + c4 * 4);
                *(f32x4*)(xrow + c4 * 4) = (f32x4){r2[c4 * 4] * rstd * g[0], r2[c4 * 4 + 1] * rstd * g[1], r2[c4 * 4 + 2] * rstd * g[2], r2[c4 * 4 + 3] * rstd * g[3]};
            }
        } else {
            u32x4 o[2];
#pragma unroll
            for (int c4 = 0; c4 < 4; ++c4) {
                const f32x4 g = *(const f32x4*)(gp + c4 * 4);
                *(f32x4*)(xrow + c4 * 4) = (f32x4){r2[c4 * 4], r2[c4 * 4 + 1], r2[c4 * 4 + 2], r2[c4 * 4 + 3]};
                o[c4 >> 1][(c4 & 1) * 2] = pack2(r2[c4 * 4] * rstd * g[0], r2[c4 * 4 + 1] * rstd * g[1]);
                o[c4 >> 1][(c4 & 1) * 2 + 1] = pack2(r2[c4 * 4 + 2] * rstd * g[2], r2[c4 * 4 + 3] * rstd * g[3]);
            }
            bf16_t* hp = H + (size_t)t * 1024 + col0;
            *(u32x4*)hp = o[0]; *(u32x4*)(hp + 8) = o[1];
        }
    }
}

__device__ __forceinline__ void spatial_fast(const Params& p, char* smem) {
    bf16_t* U = (bf16_t*)(p.ws + OFF_REGION); const bf16_t* VT = U + (size_t)T * 2048; const float* SSQ = (const float*)(p.ws + OFF_SSQ);
    const int tid_ = VTID;
    for (int task = VBID; task < 2048; task += VGRID) {
        const int chunk = task >> 3, g = task & 7;
        int lz = 0; asm volatile("" : "+v"(lz));
        const int tid = tid_ + lz, lane = tid & 63, wid = tid >> 6, wm = wid >> 1, wn = wid & 1, l15 = lane & 15, q4 = lane >> 4;
        float* rs = (float*)(smem + 16384);
        if (tid < 128) {
            const float* sp = SSQ + (size_t)(chunk * 128 + tid) * 32;
            float s = 0.f;
#pragma unroll
            for (int i = 0; i < 8; ++i) { const f32x4 v = *(const f32x4*)(sp + 4 * i); s += (v[0] + v[1]) + (v[2] + v[3]); }
            rs[tid] = rsqrtf(s * (1.0f / 2048.0f) + EPS);
        }
        __syncthreads();
#pragma unroll
        for (int i = 0; i < 8; ++i) {
            const int c = tid + 256 * i, row = c >> 4, ch16 = c & 15, ks = ch16 >> 3, ch = ch16 & 7, s0 = ch16 * 8;
            const float* wp = p.c_w_spatial + ((size_t)(g * 128 + row)) * 128 + s0;
            const f32x4 w0 = *(const f32x4*)wp, w1 = *(const f32x4*)(wp + 4);
            const f32x4 r0 = *(const f32x4*)(rs + s0), r1 = *(const f32x4*)(rs + s0 + 4);
            float v[8];
#pragma unroll
            for (int j = 0; j < 4; ++j) { v[j] = (s0 + j <= row) ? w0[j] * r0[j] : 0.f; v[4 + j] = (s0 + 4 + j <= row) ? w1[j] * r1[j] : 0.f; }
            *(uint4*)(smem + ks * 32768 + row * 128 + ((ch ^ (row & 7)) << 4)) = make_uint4(pack2(v[0], v[1]), pack2(v[2], v[3]), pack2(v[4], v[5]), pack2(v[6], v[7]));
        }
        __syncthreads();
#pragma unroll 1
        for (int nh = 0; nh < 2; ++nh) {
            const int chan0 = g * 256 + nh * 128;
#pragma unroll
            for (int i = 0; i < 8; ++i) {
                const int c = tid + 256 * i, row = c >> 4, ch16 = c & 15, ks = ch16 >> 3, ch = ch16 & 7;
                *(uint4*)(smem + ks * 32768 + 16384 + row * 128 + ((ch ^ (row & 7)) << 4)) = *(const uint4*)(VT + ((size_t)chunk * 2048 + chan0 + row) * 128 + ch16 * 8);
            }
            __syncthreads();
            f32x4 acc[4][4];
#pragma unroll
            for (int i = 0; i < 4; ++i)
#pragma unroll
                for (int j = 0; j < 4; ++j) acc[i][j] = (f32x4){0.f, 0.f, 0.f, 0.f};
#pragma unroll
            for (int kt = 0; kt < 2; ++kt) {
                if (kt == 1 && wm == 0) continue;
                const char* sa = smem + kt * 32768; const char* sb = sa + 16384;
#pragma unroll
                for (int ks = 0; ks < 2; ++ks) {
                    bf16x8 af[4], bfr[4];
                    const int ch = ks * 4 + q4;
#pragma unroll
                    for (int i = 0; i < 4; ++i) { const int row = wm * 64 + i * 16 + l15; af[i] = *(const bf16x8*)(sa + row * 128 + ((ch ^ (row & 7)) << 4)); }
#pragma unroll
                    for (int j = 0; j < 4; ++j) { const int row = wn * 64 + j * 16 + l15; bfr[j] = *(const bf16x8*)(sb + row * 128 + ((ch ^ (row & 7)) << 4)); }
#pragma unroll
                    for (int i = 0; i < 4; ++i)
#pragma unroll
                        for (int j = 0; j < 4; ++j) acc[i][j] = __builtin_amdgcn_mfma_f32_16x16x32_bf16(bfr[j], af[i], acc[i][j], 0, 0, 0);
                }
            }
            __syncthreads();
#pragma unroll
            for (int i = 0; i < 4; ++i) {
                const int m = wm * 64 + i * 16 + l15;
                const float bias = p.c_b_spatial[g * 128 + m];
#pragma unroll
                for (int j = 0; j < 4; ++j) {
                    const int chan = chan0 + wn * 64 + j * 16 + 4 * q4;
                    const f32x4 vn = *(const f32x4*)(p.c_v_norm + chan);
                    bf16_t* up = U + (size_t)(chunk * 128 + m) * 2048 + chan;
                    const uint2 uu = *(const uint2*)up;
                    uint2 o;
                    o.x = pack2(lo2f(uu.x) * (vn[0] * acc[i][j][0] + bias), hi2f(uu.x) * (vn[1] * acc[i][j][1] + bias));
                    o.y = pack2(lo2f(uu.y) * (vn[2] * acc[i][j][2] + bias), hi2f(uu.y) * (vn[3] * acc[i][j][3] + bias));
                    *(uint2*)up = o;
                }
            }
        }
    }
}

#define XB_TMO      128
#define XB_XCNT(j)  (256  + 64 * (j))
#define XB_XSUB(j)  (1280 + 64 * (j))
#define XB_XGEN(j)  (2304 + 64 * (j))
#define XB_TOP      3328
#define XB_TOPGEN   3392
#define XCD_BAR_WORDS 3456
#define XB_SPIN_CAP (1u << 22)
#define LAS __attribute__((address_space(3)))
__device__ __forceinline__ unsigned xb_ld(unsigned* p)              { return __hip_atomic_load(p, __ATOMIC_RELAXED, __HIP_MEMORY_SCOPE_AGENT); }
__device__ __forceinline__ unsigned xb_add(unsigned* p, unsigned v) { return __hip_atomic_fetch_add(p, v, __ATOMIC_RELAXED, __HIP_MEMORY_SCOPE_AGENT); }
__device__ __forceinline__ unsigned xb_xcc_id() { return (unsigned)__builtin_amdgcn_s_getreg((3 << 11) | 20) & 0xFu; }
#define XB_SPIN(cond, bar) do { unsigned _sp = 0; while (cond) { __builtin_amdgcn_s_sleep(1); \
    if ((++_sp & 255u) == 0u) { if (xb_ld(&(bar)[XB_TMO])) break; if (_sp > XB_SPIN_CAP) { atomicAdd(&(bar)[XB_TMO], 1u); break; } } } } while (0)
struct XcdBarrier { unsigned* bar; unsigned x; volatile LAS unsigned* st; };
__device__ __forceinline__ XcdBarrier xcd_barrier_post(unsigned* bar, volatile LAS unsigned* st) {
    XcdBarrier b; b.bar = bar; b.x = xb_xcc_id(); b.st = st;
    if (threadIdx.x == 0) (void)xb_add(&bar[XB_XCNT(b.x)], 1u);
    return b;
}
__device__ __forceinline__ void xcd_barrier_complete(unsigned* bar, unsigned x, unsigned& nloc, unsigned& nx) {
    const unsigned G = gridDim.x * gridDim.y * gridDim.z;
    unsigned sum, cnt, mine, sp = 0u;
    for (;;) {
        sum = 0u; cnt = 0u; mine = 0u;
#pragma unroll
        for (unsigned j = 0; j < 16; ++j) { const unsigned c = xb_ld(&bar[XB_XCNT(j)]); sum += c; cnt += (c > 0u) ? 1u : 0u; mine = (j == x) ? c : mine; }
        if (sum == G) break;
        __builtin_amdgcn_s_sleep(1);
        if ((++sp & 255u) == 0u) { if (xb_ld(&bar[XB_TMO])) break; if (sp > XB_SPIN_CAP) { atomicAdd(&bar[XB_TMO], 1u); break; } }
    }
    nloc = mine > 0u ? mine : 1u; nx = cnt > 0u ? cnt : 1u;
}
__device__ __forceinline__ void xcd_barrier(const XcdBarrier& b) {
    asm volatile("s_waitcnt vmcnt(0)" ::: "memory");
    __syncthreads();
    if (threadIdx.x == 0) {
        unsigned* bar = b.bar;
        __builtin_amdgcn_s_waitcnt(0);
        unsigned nloc = b.st[0], nx = b.st[1];
        if (nloc == 0u) { xcd_barrier_complete(bar, b.x, nloc, nx); b.st[0] = nloc; b.st[1] = nx; }
        const unsigned old = xb_add(&bar[XB_XSUB(b.x)], 1u);
        const unsigned gen = old / nloc;
        if (old + 1u == (gen + 1u) * nloc) {
            __builtin_amdgcn_fence(__ATOMIC_RELEASE, "agent");
            asm volatile("s_waitcnt vmcnt(0)" ::: "memory");
            const unsigned og = xb_add(&bar[XB_TOP], 1u);
            const unsigned tg = og / nx;
            if (og + 1u == (tg + 1u) * nx) xb_add(&bar[XB_TOPGEN], 1u);
            else XB_SPIN(xb_ld(&bar[XB_TOPGEN]) == tg, bar);
            __builtin_amdgcn_fence(__ATOMIC_ACQUIRE, "agent");
            xb_add(&bar[XB_XGEN(b.x)], 1u);
            asm volatile("s_waitcnt vmcnt(0)" ::: "memory");
        } else {
            XB_SPIN(xb_ld(&bar[XB_XGEN(b.x)]) == gen, bar);
            __builtin_amdgcn_fence(__ATOMIC_ACQUIRE, "agent");
            asm volatile("s_waitcnt vmcnt(0)" ::: "memory");
        }
    }
    __syncthreads();
}

constexpr int NPHASE = 12;
__global__ void __launch_bounds__(512, 2) mega(Params p, int ph_lo, int ph_hi) {
    extern __shared__ __attribute__((aligned(16))) char smem_phys[];
    uint4& xb_words = *(uint4*)(smem_phys + kDynLds - 16);
    if (threadIdx.x == 0) xb_words = make_uint4(0u, 0u, 0u, 0u);
    __syncthreads();
    const XcdBarrier xbar = xcd_barrier_post((unsigned*)(p.ws + OFF_BAR), (volatile LAS unsigned*)&xb_words);
    char* smem = smem_phys + (threadIdx.x >> 8) * 65536;
    bf16_t* Rg = (bf16_t*)(p.ws + OFF_REGION);
    bf16_t* Hb = (bf16_t*)(p.ws + OFF_H);
#define PHASE(k, ...) if (ph_lo <= (k) && (k) < ph_hi) { __VA_ARGS__; if ((k) + 1 < ph_hi) xcd_barrier(xbar); }
    unsigned* sbctr = (unsigned*)(p.ws + OFF_BAR + 14336);
    PHASE(0,
        transpose_convert<true>(p.ab_w_in, (bf16_t*)(p.ws + OFF_WT_IN), 1024, AB_IN, AB_IN_PAD, smem);
        rmsnorm_rows(p.x, p.norm_mix, Hb))
    PHASE(1, phase_gemm_in8(p, smem_phys))
    PHASE(2, gla_prep(p, smem))
    PHASE(3, gla_scan(p, smem); sb_fast(p, smem_phys + 98304, sbctr);
        quantize_tables_static(p, 64);
        transpose_convert(p.ab_w_out, (bf16_t*)(p.ws + OFF_WT_OUT), 1024, 1024, 1024, smem, 64);
        transpose_convert(p.c_w_in, (bf16_t*)(p.ws + OFF_WT_CIN), 1024, 4096, 4096, smem, 64);
        transpose_convert(p.c_w_out, (bf16_t*)(p.ws + OFF_WT_COUT), 2048, 1024, 1024, smem, 64);
        fold_query_weights(p, 64))
    PHASE(4, phase_gemm_resid8(Rg + R_QSB, Rg + R_GG, 512, 512, (const bf16_t*)(p.ws + OFF_WT_OUT), 1024, p.x, p.out, Hb, (float*)(p.ws + OFF_SSQ), p.norm_ffn, smem_phys))
    PHASE(5, phase_select8(p, 0, smem_phys))
    PHASE(6, peer_gather(p, 0, p.norm_mix + 1024, false, smem_phys))
    PHASE(7, phase_gemm_cin8(p, smem_phys))
    PHASE(8, spatial_fast(p, smem))
    PHASE(9, phase_gemm_resid8(Rg, Rg, 2048, 2048, (const bf16_t*)(p.ws + OFF_WT_COUT), 2048, p.out, p.out, Hb, (float*)(p.ws + OFF_SSQ), p.norm_ffn + 1024, smem_phys))
    PHASE(10, phase_select8(p, 1, smem_phys))
    PHASE(11, peer_gather(p, 1, p.final_norm, true, smem_phys))
}

extern "C" void kernel_launch(void* const* d_in, const int* in_sizes, int n_in, void* d_out, int out_size, void* d_ws, size_t ws_size, hipStream_t stream) {
    static int grid_blocks = 0;
    if (!grid_blocks) {
        int dev = 0, cus = 0, per_cu = 0;
        hipGetDevice(&dev);
        hipDeviceGetAttribute(&cus, hipDeviceAttributeMultiprocessorCount, dev);
        hipFuncSetAttribute((const void*)mega, hipFuncAttributeMaxDynamicSharedMemorySize, kDynLds);
        hipOccupancyMaxActiveBlocksPerMultiprocessor(&per_cu, mega, 512, kDynLds);
        if (per_cu < 1) per_cu = 1;
        if (per_cu > 1) per_cu = 1;
        grid_blocks = cus * per_cu;
        if (n_in != 18 || ws_size < WS_END) fprintf(stderr, "kernel_launch: unexpected n_in %d or ws_size %zu < %zu\n", n_in, ws_size, (size_t)WS_END);
    }
    Params p{};
    p.x = (const float*)d_in[0]; p.norm_mix = (const float*)d_in[1]; p.norm_ffn = (const float*)d_in[2]; p.ab_w_in = (const float*)d_in[3];
    p.ab_w_alpha2 = (const float*)d_in[4]; p.ab_b_alpha2 = (const float*)d_in[5]; p.ab_gla_norm = (const float*)d_in[6]; p.ab_w_out = (const float*)d_in[7];
    p.c_w_in = (const float*)d_in[8]; p.c_v_norm = (const float*)d_in[9]; p.c_w_spatial = (const float*)d_in[10]; p.c_b_spatial = (const float*)d_in[11];
    p.c_w_out = (const float*)d_in[12]; p.peer_w_q = (const float*)d_in[13]; p.peer_subkeys = (const float*)d_in[14]; p.peer_u = (const float*)d_in[15];
    p.peer_v = (const float*)d_in[16]; p.final_norm = (const float*)d_in[17];
    p.out = (float*)d_out; p.ws = (unsigned char*)d_ws;
    (void)hipMemsetAsync((char*)d_ws + OFF_BAR, 0, 16384, stream);
#if ONE_LAUNCH
    int lo = 0, hi = NPHASE;
    void* args[] = {&p, &lo, &hi};
    hipError_t e = hipLaunchCooperativeKernel((void*)mega, dim3(grid_blocks), dim3(512), args, kDynLds, stream);
    if (e != hipSuccess) fprintf(stderr, "cooperative launch failed: %s (grid %d)\n", hipGetErrorString(e), grid_blocks);
#else
    for (int ph = 0; ph < NPHASE; ++ph) hipLaunchKernelGGL(mega, dim3(grid_blocks), dim3(512), kDynLds, stream, p, ph, ph + 1);
#endif
}
```

```cpp
#include <hip/hip_runtime.h>
#include <hip/hip_cooperative_groups.h>
#include <cstdio>
#include <cstdint>
namespace cg = cooperative_groups;

#ifndef ONE_LAUNCH
#define ONE_LAUNCH 1
#endif


#define VTID ((int)(threadIdx.x & 255))
#define VBID ((int)(blockIdx.x * 2 + (threadIdx.x >> 8)))
#define VGRID ((int)(gridDim.x * 2))
typedef unsigned short bf16_t;
typedef short bf16x8 __attribute__((ext_vector_type(8)));
typedef float f32x4 __attribute__((ext_vector_type(4)));
typedef unsigned u32x4 __attribute__((ext_vector_type(4)));
typedef __bf16 bf16x2_t __attribute__((ext_vector_type(2)));

constexpr int T = 32768, D = 1024, SEQ = 2048, NB = 16;
constexpr int AB_IN = 3088, AB_IN_PAD = 3200;
constexpr float EPS = 1e-6f;
constexpr int NEXP = 16384;
constexpr int kDynLds = 163840;

constexpr size_t SZ_WT_IN = (size_t)AB_IN_PAD * 1024 * 2;
constexpr size_t SZ_WT_OUT = (size_t)1024 * 1024 * 2;
constexpr size_t SZ_WT_CIN = (size_t)4096 * 1024 * 2;
constexpr size_t SZ_WT_COUT = (size_t)1024 * 2048 * 2;
constexpr size_t SZ_WT_Q = (size_t)2 * 2048 * 1024 * 2;
constexpr size_t SZ_SK = (size_t)2 * 8 * 2 * 128 * 128 * 2;
constexpr size_t SZ_TAB = (size_t)2 * NEXP * 1024;
constexpr size_t SZ_TSC = (size_t)2 * NEXP * 4;
constexpr size_t OFF_WT_IN = 0;
constexpr size_t OFF_WT_OUT = OFF_WT_IN + SZ_WT_IN;
constexpr size_t OFF_WT_CIN = OFF_WT_OUT + SZ_WT_OUT;
constexpr size_t OFF_WT_COUT = OFF_WT_CIN + SZ_WT_CIN;
constexpr size_t OFF_WT_Q = OFF_WT_COUT + SZ_WT_COUT;
constexpr size_t OFF_SK = OFF_WT_Q + SZ_WT_Q;
constexpr size_t OFF_UT = OFF_SK + SZ_SK;
constexpr size_t OFF_VT = OFF_UT + SZ_TAB;
constexpr size_t OFF_USC = OFF_VT + SZ_TAB;
constexpr size_t OFF_VSC = OFF_USC + SZ_TSC;
constexpr size_t OFF_H = OFF_VSC + SZ_TSC;
constexpr size_t OFF_IDX = OFF_H + (size_t)T * 1024 * 2;
constexpr size_t OFF_GATE = OFF_IDX + (size_t)T * 128 * 4;
constexpr size_t OFF_SSQ = OFF_GATE + (size_t)T * 128 * 4;
constexpr size_t OFF_REGION = OFF_SSQ + (size_t)T * 32 * 4;
constexpr size_t SZ_REGION = (size_t)256 << 20;
constexpr size_t OFF_BAR = OFF_REGION + SZ_REGION;
constexpr size_t WS_END = OFF_BAR + 16384;
constexpr size_t R_QSB = 0;
constexpr size_t R_KSB = R_QSB + (size_t)T * 512;
constexpr size_t R_VTSB = R_KSB + (size_t)T * 512;
constexpr size_t R_QG = R_VTSB + (size_t)T * 512;
constexpr size_t R_KG = R_QG + (size_t)T * 256;
constexpr size_t R_VTG = R_KG + (size_t)T * 256;
constexpr size_t R_GG = R_VTG + (size_t)T * 512;
constexpr size_t R_ALR = R_GG + (size_t)T * 512;
constexpr size_t R_KOT = R_ALR + (size_t)T * 32;
constexpr size_t R_DEC = R_KOT + (size_t)T * 256;

struct Params {
    const float* x; const float* norm_mix; const float* norm_ffn; const float* ab_w_in; const float* ab_w_alpha2; const float* ab_b_alpha2;
    const float* ab_gla_norm; const float* ab_w_out; const float* c_w_in; const float* c_v_norm; const float* c_w_spatial; const float* c_b_spatial;
    const float* c_w_out; const float* peer_w_q; const float* peer_subkeys; const float* peer_u; const float* peer_v; const float* final_norm;
    float* out; unsigned char* ws;
};

__device__ __forceinline__ float bf2f(bf16_t v) { return __uint_as_float(((unsigned)v) << 16); }
__device__ __forceinline__ bf16_t f2bf(float f) { unsigned u = __float_as_uint(f); u += 0x7fffu + ((u >> 16) & 1u); return (bf16_t)(u >> 16); }
__device__ __forceinline__ unsigned pack2(float lo, float hi) { return (unsigned)f2bf(lo) | ((unsigned)f2bf(hi) << 16); }
__device__ __forceinline__ float lo2f(unsigned w) { return __uint_as_float(w << 16); }
__device__ __forceinline__ float hi2f(unsigned w) { return __uint_as_float(w & 0xffff0000u); }
__device__ __forceinline__ float dot2(unsigned a, unsigned b, float acc) { return __builtin_amdgcn_fdot2_f32_bf16(__builtin_bit_cast(bf16x2_t, a), __builtin_bit_cast(bf16x2_t, b), acc, false); }
__device__ __forceinline__ float gelu_exact(float v) {
    const float av = fabsf(v);
    const float t = __builtin_amdgcn_rcpf(av * 0.2316418882f + 1.0f);
    float q = t * 0.5307027145f - 0.7265760135f; q = q * t + 0.7107068705f; q = q * t - 0.142248368f; q = q * t + 0.127414796f; q = q * t;
    const float e = __builtin_amdgcn_exp2f(v * v * -0.72134752044f);
    const float m = v * (q * e);
    return v < 0.f ? m : v - m;
}
__device__ __forceinline__ float row16_sum(float v) {
    v += __builtin_bit_cast(float, __builtin_amdgcn_update_dpp(0, __builtin_bit_cast(int, v), 0x128, 0xf, 0xf, false));
    v += __builtin_bit_cast(float, __builtin_amdgcn_update_dpp(0, __builtin_bit_cast(int, v), 0x124, 0xf, 0xf, false));
    v += __builtin_bit_cast(float, __builtin_amdgcn_update_dpp(0, __builtin_bit_cast(int, v), 0x122, 0xf, 0xf, false));
    v += __builtin_bit_cast(float, __builtin_amdgcn_update_dpp(0, __builtin_bit_cast(int, v), 0x121, 0xf, 0xf, false));
    return v;
}
__device__ __forceinline__ float wave_sum(float v) {
#pragma unroll
    for (int o = 32; o >= 1; o >>= 1) v += __shfl_xor(v, o);
    return v;
}

template <bool PERM_IN = false>
__device__ __forceinline__ void transpose_convert(const float* __restrict__ W, bf16_t* __restrict__ Wt, int K, int N, int Npad, char* smem, int vb0 = 0) {
    float* tile = (float*)smem;
    const int tk = K / 64, tn = Npad / 64, ntile = tk * tn;
    const int tid = VTID;
    if (VBID < vb0) return;
    for (int tl = VBID - vb0; tl < ntile; tl += VGRID - vb0) {
        const int k0 = (tl % tk) * 64, n0 = (tl / tk) * 64;
        const int c = tid & 63, r0 = tid >> 6;
        int nd = n0;
        if (PERM_IN) { if (n0 >= 1024 && n0 < 1536) nd = n0 + 1024; else if (n0 >= 1536 && n0 < 2048) nd = n0 - 512; else if (n0 >= 2048 && n0 < 2560) nd = n0 + 512; else if (n0 >= 2560 && n0 < 3072) nd = n0 - 1024; }
#pragma unroll
        for (int i = 0; i < 16; ++i) {
            const int r = r0 + 4 * i;
            const float v = (n0 + c < N) ? W[(size_t)(k0 + r) * N + n0 + c] : 0.f;
            tile[c * 65 + r] = v;
        }
        __syncthreads();
#pragma unroll
        for (int i = 0; i < 16; ++i) {
            const int n = r0 + 4 * i;
            Wt[(size_t)(nd + n) * K + k0 + c] = f2bf(tile[n * 65 + c]);
        }
        __syncthreads();
    }
}
__device__ __forceinline__ void convert_flat(const float* __restrict__ src, bf16_t* __restrict__ dst, size_t n) {
    const size_t nv = n / 8;
    for (size_t i = (size_t)VBID * 256 + VTID; i < nv; i += (size_t)VGRID * 256) {
        const float4 a = ((const float4*)src)[2 * i], b = ((const float4*)src)[2 * i + 1];
        uint4 o; o.x = pack2(a.x, a.y); o.y = pack2(a.z, a.w); o.z = pack2(b.x, b.y); o.w = pack2(b.z, b.w);
        ((uint4*)dst)[i] = o;
    }
}
__device__ __forceinline__ void quantize_tables_static(const Params& p, int vb0 = 0) {
    const int lane = VTID & 63, wid = VTID >> 6;
    if (VBID < vb0) return;
    for (unsigned task = (unsigned)(VBID - vb0); task < 512u; task += (unsigned)(VGRID - vb0)) {
        const bool isv = task >= 256u;
        const int r0 = (int)(task & 255u) * 128 + wid * 32;
        const float* src = isv ? p.peer_v : p.peer_u;
        unsigned char* recs = p.ws + OFF_UT;
        _Float16* sct = (_Float16*)(p.ws + OFF_USC);
        for (int rr = 0; rr < 32; ++rr) {
            const int r = r0 + rr;
            const float* xr = src + (size_t)r * 1024 + lane * 16;
            f32x4 v[4]; float aml = 0.f;
#pragma unroll
            for (int i = 0; i < 4; ++i) {
                v[i] = *(const f32x4*)(xr + i * 4);
                aml = fmaxf(aml, fmaxf(fmaxf(fabsf(v[i][0]), fabsf(v[i][1])), fmaxf(fabsf(v[i][2]), fabsf(v[i][3]))));
            }
#pragma unroll
            for (int o = 32; o >= 1; o >>= 1) aml = fmaxf(aml, __shfl_xor(aml, o));
            float gsd[3], ginv[3], err[3];
#pragma unroll
            for (int k = 0; k < 3; ++k) {
                const _Float16 hk = (_Float16)(aml * (1.002f / 7.5f) * (k == 0 ? 1.0f : (k == 1 ? 0.8f : 0.65f)));
                gsd[k] = (float)hk; ginv[k] = gsd[k] > 0.f ? 1.0f / gsd[k] : 0.f; err[k] = 0.f;
            }
#pragma unroll
            for (int i = 0; i < 4; ++i)
#pragma unroll
                for (int c = 0; c < 4; ++c)
#pragma unroll
                    for (int k = 0; k < 3; ++k) {
                        const float q = fminf(fmaxf(rintf(v[i][c] * ginv[k] + 7.5f), 0.f), 15.f);
                        const float d = (q - 7.5f) * gsd[k] - v[i][c];
                        err[k] += d * d;
                    }
#pragma unroll
            for (int k = 0; k < 3; ++k) err[k] = wave_sum(err[k]);
            const int kbest = (err[1] < err[0]) ? ((err[2] < err[1]) ? 2 : 1) : ((err[2] < err[0]) ? 2 : 0);
            const float gs_ = kbest == 0 ? gsd[0] : (kbest == 1 ? gsd[1] : gsd[2]), gi_ = kbest == 0 ? ginv[0] : (kbest == 1 ? ginv[1] : ginv[2]);
            unsigned wd[2];
#pragma unroll
            for (int dd = 0; dd < 2; ++dd) {
                unsigned wv = 0;
#pragma unroll
                for (int b = 0; b < 4; ++b) {
                    const int qa = min(15, max(0, __float2int_rn(v[2 * dd][b] * gi_ + 7.5f)));
                    const int qb = min(15, max(0, __float2int_rn(v[2 * dd + 1][b] * gi_ + 7.5f)));
                    wv |= ((unsigned)qa | ((unsigned)qb << 4)) << (8 * b);
                }
                wd[dd] = wv;
            }
            unsigned char* rec = recs + (size_t)r * 1024;
            *(uint2*)(rec + (isv ? 512 : 0) + lane * 8) = make_uint2(wd[0], wd[1]);
            if (lane == 0) sct[(size_t)r * 2 + (isv ? 1 : 0)] = (_Float16)gs_;
        }
    }
}
__device__ __forceinline__ void rmsnorm_rows(const float* __restrict__ X, const float* __restrict__ g, bf16_t* __restrict__ Hout) {
    const int lane = VTID & 63, wid = VTID >> 6;
    const int gw = VBID * 4 + wid, nw = VGRID * 4;
    for (int t = gw; t < T; t += nw) {
        const float* xr = X + (size_t)t * D;
        float4 v[4]; float ss = 0.f;
#pragma unroll
        for (int i = 0; i < 4; ++i) { v[i] = *(const float4*)(xr + i * 256 + lane * 4); ss += v[i].x * v[i].x + v[i].y * v[i].y + v[i].z * v[i].z + v[i].w * v[i].w; }
        ss = wave_sum(ss);
        const float rstd = rsqrtf(ss * (1.0f / D) + EPS);
#pragma unroll
        for (int i = 0; i < 4; ++i) {
            const float4 gg = *(const float4*)(g + i * 256 + lane * 4);
            uint2 o; o.x = pack2(v[i].x * rstd * gg.x, v[i].y * rstd * gg.y); o.y = pack2(v[i].z * rstd * gg.z, v[i].w * rstd * gg.w);
            *(uint2*)(Hout + (size_t)t * D + i * 256 + lane * 4) = o;
        }
    }
}

template <int MODE>
__device__ __forceinline__ void gemm_mainloop(const bf16_t* __restrict__ A0, const bf16_t* __restrict__ A1, int lda, int ksplit,
                                              const bf16_t* __restrict__ Bt, int K, int m0, int n0, f32x4 (&acc)[4][4], char* smem) {
    const int tid = VTID, lane = tid & 63, wid = tid >> 6, wm = wid >> 1, wn = wid & 1;
    const int lrow = tid >> 3, lch = tid & 7;
#pragma unroll
    for (int i = 0; i < 4; ++i)
#pragma unroll
        for (int j = 0; j < 4; ++j) acc[i][j] = (f32x4){0.f, 0.f, 0.f, 0.f};
    const int nk = K / 64;
    unsigned aoff[4], boff[4];
    {
        const int rr = lane >> 3, cc = ((lane & 7) ^ rr) * 8;
#pragma unroll
        for (int i = 0; i < 4; ++i) {
            aoff[i] = (unsigned)(((m0 + 32 * wid + 8 * i + rr) * lda + cc) * 2);
            boff[i] = (unsigned)(((n0 + 32 * wid + 8 * i + rr) * K + cc) * 2);
        }
    }
    auto stage = [&](int kt, int buf) {
        const int kb = kt * 64;
        const char* Ab; const char* Bb = (const char*)(Bt + kb);
        if (kb < ksplit) Ab = (const char*)(A0 + kb); else Ab = (const char*)(A1 + (kb - ksplit));
        char* sa = smem + buf * 32768 + wid * 4096 + lane * 16; char* sb = sa + 16384;
#pragma unroll
        for (int i = 0; i < 4; ++i) __builtin_amdgcn_global_load_lds((const unsigned*)(Ab + aoff[i]), (unsigned*)(sa + i * 1024), 16, 0, 0);
#pragma unroll
        for (int i = 0; i < 4; ++i) __builtin_amdgcn_global_load_lds((const unsigned*)(Bb + boff[i]), (unsigned*)(sb + i * 1024), 16, 0, 0);
    };
    auto compute = [&](int buf) {
        const char* sa = smem + buf * 32768; const char* sb = sa + 16384;
#pragma unroll
        for (int ks = 0; ks < 2; ++ks) {
            bf16x8 af[4], bfr[4];
            const int ch = ks * 4 + (lane >> 4);
#pragma unroll
            for (int i = 0; i < 4; ++i) { const int row = wm * 64 + i * 16 + (lane & 15); af[i] = *(const bf16x8*)(sa + row * 128 + ((ch ^ (row & 7)) << 4)); }
#pragma unroll
            for (int j = 0; j < 4; ++j) { const int row = wn * 64 + j * 16 + (lane & 15); bfr[j] = *(const bf16x8*)(sb + row * 128 + ((ch ^ (row & 7)) << 4)); }
            __builtin_amdgcn_s_setprio(1);
#pragma unroll
            for (int i = 0; i < 4; ++i)
#pragma unroll
                for (int j = 0; j < 4; ++j) {
                    if (MODE == 0) acc[i][j] = __builtin_amdgcn_mfma_f32_16x16x32_bf16(bfr[j], af[i], acc[i][j], 0, 0, 0);
                    else acc[i][j] = __builtin_amdgcn_mfma_f32_16x16x32_bf16(af[i], bfr[j], acc[i][j], 0, 0, 0);
                }
            __builtin_amdgcn_s_setprio(0);
        }
    };
    stage(0, 0);
    asm volatile("s_waitcnt vmcnt(0)" ::: "memory");
    __syncthreads();
    for (int kt = 0; kt < nk; ++kt) {
        if (kt + 1 < nk) stage(kt + 1, (kt + 1) & 1);
        compute(kt & 1);
        asm volatile("s_waitcnt vmcnt(0)" ::: "memory");
        __syncthreads();
    }
}
template <int MODE>
__device__ __forceinline__ void gemm_mainloop256(const bf16_t* __restrict__ A0, const bf16_t* __restrict__ A1, int lda, int ksplit,
                                                 const bf16_t* __restrict__ Bt, int K, int m0, int n0, f32x4 (&acc)[8][4], char* smem) {
    const int tid = VTID, lane = tid & 63, wid = tid >> 6, wm = wid >> 1, wn = wid & 1;
#pragma unroll
    for (int i = 0; i < 8; ++i)
#pragma unroll
        for (int j = 0; j < 4; ++j) acc[i][j] = (f32x4){0.f, 0.f, 0.f, 0.f};
    const int nk = K / 32;
    unsigned aoff[4], boff[2];
    {
        const int rr = lane >> 2, cc = ((lane & 3) ^ (3 * ((lane >> 5) & 1))) * 8;
#pragma unroll
        for (int i = 0; i < 4; ++i) aoff[i] = (unsigned)(((m0 + 64 * wid + 16 * i + rr) * lda + cc) * 2);
#pragma unroll
        for (int i = 0; i < 2; ++i) boff[i] = (unsigned)(((n0 + 32 * wid + 16 * i + rr) * K + cc) * 2);
    }
    auto stage = [&](int kt, int buf) {
        const int kb = kt * 32;
        const char* Ab; const char* Bb = (const char*)(Bt + kb);
        if (kb < ksplit) Ab = (const char*)(A0 + kb); else Ab = (const char*)(A1 + (kb - ksplit));
        char* sa = smem + buf * 24576 + wid * 4096 + lane * 16; char* sb = smem + buf * 24576 + 16384 + wid * 2048 + lane * 16;
#pragma unroll
        for (int i = 0; i < 4; ++i) __builtin_amdgcn_global_load_lds((const unsigned*)(Ab + aoff[i]), (unsigned*)(sa + i * 1024), 16, 0, 0);
#pragma unroll
        for (int i = 0; i < 2; ++i) __builtin_amdgcn_global_load_lds((const unsigned*)(Bb + boff[i]), (unsigned*)(sb + i * 1024), 16, 0, 0);
    };
    const int fpos = (((lane >> 4) ^ (3 * ((lane >> 3) & 1))) << 4) + (lane & 15) * 64;
    auto compute = [&](int buf) {
        const char* sa = smem + buf * 24576 + wm * 8192 + fpos; const char* sb = smem + buf * 24576 + 16384 + wn * 4096 + fpos;
        bf16x8 af[8], bfr[4];
#pragma unroll
        for (int i = 0; i < 8; ++i) af[i] = *(const bf16x8*)(sa + i * 1024);
#pragma unroll
        for (int j = 0; j < 4; ++j) bfr[j] = *(const bf16x8*)(sb + j * 1024);
        __builtin_amdgcn_s_setprio(1);
#pragma unroll
        for (int i = 0; i < 8; ++i)
#pragma unroll
            for (int j = 0; j < 4; ++j) {
                if (MODE == 0) acc[i][j] = __builtin_amdgcn_mfma_f32_16x16x32_bf16(bfr[j], af[i], acc[i][j], 0, 0, 0);
                else acc[i][j] = __builtin_amdgcn_mfma_f32_16x16x32_bf16(af[i], bfr[j], acc[i][j], 0, 0, 0);
            }
        __builtin_amdgcn_s_setprio(0);
    };
    stage(0, 0);
    asm volatile("s_waitcnt vmcnt(0)" ::: "memory");
    __syncthreads();
    for (int kt = 0; kt < nk; ++kt) {
        if (kt + 1 < nk) stage(kt + 1, (kt + 1) & 1);
        compute(kt & 1);
        asm volatile("s_waitcnt vmcnt(0)" ::: "memory");
        __syncthreads();
    }
}
__device__ __forceinline__ bool tile_sched(int it, int MT, int NT, int& mt, int& nt) {
    const int xg = blockIdx.x & 7, xi = (int)(blockIdx.x >> 3) * 2 + (int)(threadIdx.x >> 8), nper = (int)(gridDim.x >> 3) * 2;
    const int li = xi + nper * it;
    if (li >= (MT >> 3) * NT) return false;
    const int band = li / (8 * NT), r = li - band * 8 * NT;
    nt = r >> 3; mt = xg * (MT >> 3) + band * 8 + (r & 7);
    return true;
}
__device__ __forceinline__ void store_bf16x4(bf16_t* p, f32x4 v) { uint2 o; o.x = pack2(v[0], v[1]); o.y = pack2(v[2], v[3]); *(uint2*)p = o; }

#define G8_LAS __attribute__((address_space(3)))
namespace g8 {
constexpr int BM = 256, BK = 64, HALF = 128, HTB = HALF * BK * 2, NXCD = 8, WGM = 8;
__device__ __forceinline__ int lds_byte(int r, int c) { const int st = (r >> 4) * 2 + (c >> 5), rr = r & 15, cc = c & 31, ob = rr * 64 + cc * 2; return st * 1024 + (ob ^ (((ob >> 9) & 1) << 5)); }
__device__ __forceinline__ void stage_rc(int b, int& R, int& C) { const int st = b / 1024, sb = b % 1024, swz = sb ^ (((sb >> 9) & 1) << 5); R = (st >> 1) * 16 + swz / 64; C = (st & 1) * 32 + (swz % 64) / 2; }
__device__ __forceinline__ int perm32(int rho) { const int n = rho >> 4, i = rho & 15; return 8 * (i >> 2) + 4 * n + (i & 3); }
struct Unit { int pm, pn; };
struct Gemm { const bf16_t* A0; const bf16_t* A1; int lda, ksplit; const bf16_t* Bt; int M, N, K; };
struct StaticOrder {
    int nM, nN, nwg, G, c;
    __device__ __forceinline__ void init(int M, int N, int G_, int c_) { nM = M / BM; nN = N / BM; nwg = nM * nN; G = G_; c = c_; }
    __device__ __forceinline__ bool next(int i, Unit& u) const {
        const int L = i * G + c; if (L >= nwg) return false;
        int wgid = L; { const int q = nwg / NXCD, r = nwg % NXCD, xcd = wgid % NXCD, off = wgid / NXCD; wgid = (xcd < r ? xcd * (q + 1) : r * (q + 1) + (xcd - r) * q) + off; }
        const int nig = WGM * nN, gid = wgid / nig, fm = gid * WGM, gsz = (nM - fm) < WGM ? (nM - fm) : WGM;
        u.pm = fm + ((wgid % nig) % gsz); u.pn = (wgid % nig) / gsz; return true;
    }
};
template <class Epi>
__device__ __forceinline__ void gemm_phase(G8_LAS unsigned char* lds, const Gemm g, const StaticOrder& S, const Epi& E) {
    const int tid = threadIdx.x, wid = __builtin_amdgcn_readfirstlane(tid >> 6), lane = tid & 63, wr = wid >> 2, wc = wid & 3, fr = lane & 15, fq = lane >> 4;
    const int K = g.K, nt = K / BK, lda = g.lda;
    unsigned voffA[2], voffB[2];
#pragma unroll
    for (int i = 0; i < 2; ++i) { int R, C; stage_rc(tid * 16 + i * 8192, R, C); const int Rb = (R & ~31) + perm32(R & 31);
        voffA[i] = (unsigned)(R * lda + C) * 2u; voffB[i] = (unsigned)(Rb * K + C) * 2u; }
    const size_t hstepA = (size_t)HALF * lda * 2, hstepB = (size_t)HALF * K * 2;
    const unsigned ldsw = (unsigned)wid * 1024u;
    const int aoff = lds_byte(wr * 64 + fr, fq * 8), boff = lds_byte(wc * 32 + fr, fq * 8);
    auto aptr = [&](int pm, int kt) -> const char* { const int kb = kt * BK; const bf16_t* b = kb < g.ksplit ? g.A0 + kb : g.A1 + (kb - g.ksplit); return (const char*)b + (size_t)pm * 2 * hstepA; };
    auto bptr = [&](int pn, int kt) -> const char* { return (const char*)(g.Bt + kt * BK) + (size_t)pn * 2 * hstepB; };
#define G8_SA(b, h) (((b) * 2 + (h)) * HTB)
#define G8_SB(b, h) ((4 + (b) * 2 + (h)) * HTB)
#define G8_STAGE(bufoff, gbase, voff) do { _Pragma("unroll") for (int _i = 0; _i < 2; ++_i) \
        __builtin_amdgcn_global_load_lds((const unsigned*)((const char*)(gbase) + (voff)[_i]), (G8_LAS unsigned*)(lds + (bufoff) + ldsw + _i * 8192), 16, 0, 0); } while (0)
#define G8_LDA(dst, b, h) do { _Pragma("unroll") for (int m = 0; m < 4; ++m) _Pragma("unroll") for (int k = 0; k < 2; ++k) dst[m][k] = *(const G8_LAS bf16x8*)(lds + G8_SA(b, h) + aoff + m * 2048 + k * 1024); } while (0)
#define G8_LDB(dst, b, h) do { _Pragma("unroll") for (int n = 0; n < 2; ++n) _Pragma("unroll") for (int k = 0; k < 2; ++k) dst[n][k] = *(const G8_LAS bf16x8*)(lds + G8_SB(b, h) + boff + n * 2048 + k * 1024); } while (0)
#define G8_MMA(ai, bj, At, Bt) do { __builtin_amdgcn_s_setprio(1); _Pragma("unroll") for (int m = 0; m < 4; ++m) _Pragma("unroll") for (int n = 0; n < 2; ++n) _Pragma("unroll") for (int k = 0; k < 2; ++k) \
        acc[ai][bj][m][n] = __builtin_amdgcn_mfma_f32_16x16x32_bf16(Bt[n][k], At[m][k], acc[ai][bj][m][n], 0, 0, 0); __builtin_amdgcn_s_setprio(0); } while (0)
#define G8_WAIT_V(n) asm volatile("s_waitcnt vmcnt(" #n ")" ::: "memory")
#define G8_WAIT_L(n) asm volatile("s_waitcnt lgkmcnt(" #n ")" ::: "memory")
#define G8_BAR __builtin_amdgcn_s_barrier()
#define G8_SCHED __builtin_amdgcn_sched_barrier(0)
    Unit cur, nxt; int ui = 0;
    if (!S.next(0, cur)) return;
    f32x4 acc[2][2][4][2];
#pragma unroll
    for (int a = 0; a < 2; ++a)
#pragma unroll
        for (int b = 0; b < 2; ++b)
#pragma unroll
            for (int m = 0; m < 4; ++m)
#pragma unroll
                for (int n = 0; n < 2; ++n) acc[a][b][m][n] = (f32x4){0.f, 0.f, 0.f, 0.f};
    bf16x8 At[4][2], B0[2][2], B1[2][2];
    {
        const char* cA = aptr(cur.pm, 0); const char* cB = bptr(cur.pn, 0); const char* cA1 = aptr(cur.pm, 1); const char* cB1 = bptr(cur.pn, 1);
        G8_STAGE(G8_SB(0, 0), cB, voffB); G8_STAGE(G8_SB(0, 1), cB + hstepB, voffB); G8_STAGE(G8_SA(0, 0), cA, voffA); G8_STAGE(G8_SA(0, 1), cA + hstepA, voffA);
        if (wr == 1) G8_BAR;
        G8_WAIT_V(2); G8_BAR;
        G8_STAGE(G8_SB(1, 0), cB1, voffB); G8_STAGE(G8_SA(1, 0), cA1, voffA); G8_STAGE(G8_SB(1, 1), cB1 + hstepB, voffB);
        G8_WAIT_V(6); G8_BAR;
    }
    for (;;) {
        const bool has_next = S.next(ui + 1, nxt);
        const int npm = has_next ? nxt.pm : cur.pm, npn = has_next ? nxt.pn : cur.pn;
        for (int t = 0; t < nt; t += 2) {
            const bool last = (t == nt - 2);
            const char* a1 = aptr(cur.pm, t + 1);
            const char* a2 = last ? aptr(npm, 0) : aptr(cur.pm, t + 2); const char* b2 = last ? bptr(npn, 0) : bptr(cur.pn, t + 2);
            const char* a3 = last ? aptr(npm, 1) : aptr(cur.pm, t + 3); const char* b3 = last ? bptr(npn, 1) : bptr(cur.pn, t + 3);
            G8_LDB(B0, 0, 0); G8_LDB(B1, 0, 1); G8_SCHED; G8_LDA(At, 0, 0); G8_STAGE(G8_SA(1, 1), a1 + hstepA, voffA);
            G8_WAIT_V(8); G8_WAIT_L(0); G8_BAR; G8_MMA(0, 0, At, B0); G8_MMA(0, 1, At, B1); G8_BAR; G8_SCHED;
            G8_LDA(At, 0, 1); G8_STAGE(G8_SB(0, 0), b2, voffB); G8_STAGE(G8_SB(0, 1), b2 + hstepB, voffB); G8_STAGE(G8_SA(0, 0), a2, voffA);
            G8_WAIT_V(8); G8_WAIT_L(0); G8_BAR; G8_MMA(1, 0, At, B0); G8_MMA(1, 1, At, B1); G8_BAR; G8_SCHED;
            G8_LDB(B0, 1, 0); G8_LDB(B1, 1, 1); G8_SCHED; G8_LDA(At, 1, 0); G8_STAGE(G8_SA(0, 1), a2 + hstepA, voffA);
            G8_WAIT_V(8); G8_WAIT_L(0); G8_BAR; G8_MMA(0, 0, At, B0); G8_MMA(0, 1, At, B1); G8_BAR; G8_SCHED;
            G8_LDA(At, 1, 1); G8_STAGE(G8_SB(1, 0), b3, voffB); G8_STAGE(G8_SB(1, 1), b3 + hstepB, voffB); G8_STAGE(G8_SA(1, 0), a3, voffA);
            G8_WAIT_V(8); G8_WAIT_L(0); G8_BAR; G8_MMA(1, 0, At, B0); G8_MMA(1, 1, At, B1); G8_BAR; G8_SCHED;
        }
        if (wr == 0) G8_BAR;
        E(acc, cur, wr, wc, fr, fq);
        if (!has_next) break;
#pragma unroll
        for (int a = 0; a < 2; ++a)
#pragma unroll
            for (int b = 0; b < 2; ++b)
#pragma unroll
                for (int m = 0; m < 4; ++m)
#pragma unroll
                    for (int n = 0; n < 2; ++n) acc[a][b][m][n] = (f32x4){0.f, 0.f, 0.f, 0.f};
        cur = nxt; ++ui;
        if (wr == 1) G8_BAR;
    }
    G8_WAIT_V(0);
    G8_BAR;
#undef G8_SA
#undef G8_SB
#undef G8_STAGE
#undef G8_LDA
#undef G8_LDB
#undef G8_MMA
#undef G8_WAIT_V
#undef G8_WAIT_L
#undef G8_BAR
#undef G8_SCHED
}
struct EpiResid {
    const float* Rs; float* O; bf16_t* XB; float* SSQP; const float* gain;
    __device__ __forceinline__ void operator()(const f32x4 (&acc)[2][2][4][2], const Unit& u, int wr, int wc, int fr, int fq) const {
        f32x4 gn[2][2];
#pragma unroll
        for (int bj = 0; bj < 2; ++bj) { gn[bj][0] = *(const f32x4*)(gain + u.pn * 256 + bj * 128 + wc * 32 + fq * 8); gn[bj][1] = *(const f32x4*)(gain + u.pn * 256 + bj * 128 + wc * 32 + fq * 8 + 4); }
#pragma unroll
        for (int ai = 0; ai < 2; ++ai)
#pragma unroll
            for (int m = 0; m < 4; ++m) {
                const int row = u.pm * 256 + ai * 128 + wr * 64 + m * 16 + fr;
                const size_t o = (size_t)row * 1024 + u.pn * 256 + wc * 32 + fq * 8;
                float ss = 0.f;
#pragma unroll
                for (int bj = 0; bj < 2; ++bj) {
                    const f32x4 a = *(const f32x4*)(Rs + o + bj * 128) + acc[ai][bj][m][0], b = *(const f32x4*)(Rs + o + bj * 128 + 4) + acc[ai][bj][m][1];
                    *(f32x4*)(O + o + bj * 128) = a; *(f32x4*)(O + o + bj * 128 + 4) = b;
                    ss += a[0] * a[0] + a[1] * a[1] + a[2] * a[2] + a[3] * a[3] + b[0] * b[0] + b[1] * b[1] + b[2] * b[2] + b[3] * b[3];
                    const f32x4 ag = a * gn[bj][0], bg = b * gn[bj][1];
                    uint4 w; w.x = pack2(ag[0], ag[1]); w.y = pack2(ag[2], ag[3]); w.z = pack2(bg[0], bg[1]); w.w = pack2(bg[2], bg[3]);
                    *(uint4*)(XB + o + bj * 128) = w;
                }
                ss += __shfl_xor(ss, 16); ss += __shfl_xor(ss, 32);
                if (fq == 0) SSQP[(size_t)row * 32 + u.pn * 4 + wc] = ss;
            }
    }
};
struct EpiCinU {
    bf16_t* U;
    __device__ __forceinline__ void operator()(const f32x4 (&acc)[2][2][4][2], const Unit& u, int wr, int wc, int fr, int fq) const {
#pragma unroll
        for (int ai = 0; ai < 2; ++ai)
#pragma unroll
            for (int m = 0; m < 4; ++m) {
                bf16_t* rp = U + (size_t)(u.pm * 256 + ai * 128 + wr * 64 + m * 16 + fr) * 2048 + u.pn * 256 + wc * 32 + fq * 8;
#pragma unroll
                for (int bj = 0; bj < 2; ++bj) {
                    const f32x4 a = acc[ai][bj][m][0], b = acc[ai][bj][m][1];
                    uint4 o; o.x = pack2(gelu_exact(a[0]), gelu_exact(a[1])); o.y = pack2(gelu_exact(a[2]), gelu_exact(a[3]));
                    o.z = pack2(gelu_exact(b[0]), gelu_exact(b[1])); o.w = pack2(gelu_exact(b[2]), gelu_exact(b[3]));
                    *(uint4*)(rp + bj * 128) = o;
                }
            }
    }
};
struct EpiCinV {
    bf16_t* VT; float* SSQ;
    __device__ __forceinline__ void operator()(const f32x4 (&acc)[2][2][4][2], const Unit& u, int wr, int wc, int fr, int fq) const {
#pragma unroll
        for (int ai = 0; ai < 2; ++ai) {
            float ss[16];
#pragma unroll
            for (int i = 0; i < 16; ++i) ss[i] = 0.f;
#pragma unroll
            for (int m = 0; m < 4; ++m) {
                const int c = u.pm * 256 + ai * 128 + wr * 64 + m * 16 + fr;
#pragma unroll
                for (int bj = 0; bj < 2; ++bj) {
                    float g[8];
#pragma unroll
                    for (int n = 0; n < 2; ++n)
#pragma unroll
                        for (int r = 0; r < 4; ++r) { const float x = gelu_exact(acc[ai][bj][m][n][r]); g[n * 4 + r] = x; ss[bj * 8 + n * 4 + r] += x * x; }
                    uint4 o; o.x = pack2(g[0], g[1]); o.y = pack2(g[2], g[3]); o.z = pack2(g[4], g[5]); o.w = pack2(g[6], g[7]);
                    *(uint4*)(VT + ((size_t)(u.pn * 2 + bj) * 2048 + c) * 128 + wc * 32 + fq * 8) = o;
                }
            }
            float mine = 0.f;
#pragma unroll
            for (int i = 0; i < 16; ++i) { const float s = row16_sum(ss[i]); mine = (fr == i) ? s : mine; }
            const int tok = u.pn * 256 + (fr >> 3) * 128 + wc * 32 + fq * 8 + (fr & 7);
            SSQ[(size_t)tok * 32 + u.pm * 4 + ai * 2 + wr] = mine;
        }
    }
};
struct EpiInN {
    bf16_t* R;
    __device__ __forceinline__ void operator()(const f32x4 (&acc)[2][2][4][2], const Unit& u, int wr, int wc, int fr, int fq) const {
        bf16_t* base; int pitch; float sc = 1.0f;
        if (u.pn < 2) { base = R + R_QSB + u.pn * 256; pitch = 512; sc = 0.125f; }
        else if (u.pn < 4) { base = R + R_KSB + (u.pn - 2) * 256; pitch = 512; }
        else if (u.pn == 4) { base = R + R_QG; pitch = 256; }
        else if (u.pn == 5) { base = R + R_KG; pitch = 256; }
        else { base = R + R_GG + (u.pn - 6) * 256; pitch = 512; }
#pragma unroll
        for (int ai = 0; ai < 2; ++ai)
#pragma unroll
            for (int m = 0; m < 4; ++m) {
                bf16_t* rp = base + (size_t)(u.pm * 256 + ai * 128 + wr * 64 + m * 16 + fr) * pitch + wc * 32 + fq * 8;
#pragma unroll
                for (int bj = 0; bj < 2; ++bj) {
                    const f32x4 a = acc[ai][bj][m][0] * sc, b = acc[ai][bj][m][1] * sc;
                    uint4 o; o.x = pack2(a[0], a[1]); o.y = pack2(a[2], a[3]); o.z = pack2(b[0], b[1]); o.w = pack2(b[2], b[3]);
                    *(uint4*)(rp + bj * 128) = o;
                }
            }
    }
};
struct EpiInT {
    bf16_t* R;
    __device__ __forceinline__ void operator()(const f32x4 (&acc)[2][2][4][2], const Unit& u, int wr, int wc, int fr, int fq) const {
#pragma unroll
        for (int ai = 0; ai < 2; ++ai)
#pragma unroll
            for (int m = 0; m < 4; ++m) {
                const int c = u.pm * 256 + ai * 128 + wr * 64 + m * 16 + fr;
#pragma unroll
                for (int bj = 0; bj < 2; ++bj) {
                    const int t = u.pn * 256 + bj * 128 + wc * 32 + fq * 8, b = t >> 11, s = t & 2047;
                    bf16_t* dst;
                    if (c < 512) dst = R + R_VTSB + ((size_t)((b * 8 + (c >> 6)) * 64 + (c & 63))) * 2048 + s;
                    else { const int c2 = c - 512; dst = R + R_VTG + ((size_t)((b * 4 + (c2 >> 7)) * 128 + (c2 & 127))) * 2048 + s; }
                    const f32x4 a = acc[ai][bj][m][0], bb = acc[ai][bj][m][1];
                    uint4 o; o.x = pack2(a[0], a[1]); o.y = pack2(a[2], a[3]); o.z = pack2(bb[0], bb[1]); o.w = pack2(bb[2], bb[3]);
                    *(uint4*)dst = o;
                }
            }
    }
};
}
__device__ __forceinline__ void phase_gemm_resid8(const bf16_t* A0, const bf16_t* A1, int lda, int ksplit, const bf16_t* Bt, int K, const float* Rs, float* O, bf16_t* XB, float* SSQP, const float* gain, char* smem_phys) {
    g8::Gemm g{A0, A1, lda, ksplit, Bt, T, 1024, K};
    g8::StaticOrder S; S.init(T, 1024, (int)gridDim.x, (int)blockIdx.x);
    g8::EpiResid E{Rs, O, XB, SSQP, gain};
    g8::gemm_phase<g8::EpiResid>((G8_LAS unsigned char*)smem_phys, g, S, E);
}

__device__ __forceinline__ void phase_gemm_cin8(const Params& p, char* smem_phys) {
    const bf16_t* H = (const bf16_t*)(p.ws + OFF_H); const bf16_t* W = (const bf16_t*)(p.ws + OFF_WT_CIN);
    bf16_t* U = (bf16_t*)(p.ws + OFF_REGION); bf16_t* VT = U + (size_t)T * 2048; float* SSQ = (float*)(p.ws + OFF_SSQ);
    {
        g8::Gemm g{H, H, 1024, 1024, W, T, 2048, 1024};
        g8::StaticOrder S; S.init(T, 2048, (int)gridDim.x, (int)blockIdx.x);
        g8::EpiCinU E{U};
        g8::gemm_phase<g8::EpiCinU>((G8_LAS unsigned char*)smem_phys, g, S, E);
    }
    {
        const bf16_t* Wv = W + (size_t)2048 * 1024;
        g8::Gemm g{Wv, Wv, 1024, 1024, H, 2048, T, 1024};
        g8::StaticOrder S; S.init(2048, T, (int)gridDim.x, (int)blockIdx.x);
        g8::EpiCinV E{VT, SSQ};
        g8::gemm_phase<g8::EpiCinV>((G8_LAS unsigned char*)smem_phys, g, S, E);
    }
}
__device__ __forceinline__ void phase_gemm_in8(const Params& p, char* smem_phys) {
    const bf16_t* H = (const bf16_t*)(p.ws + OFF_H); const bf16_t* W = (const bf16_t*)(p.ws + OFF_WT_IN);
    bf16_t* R = (bf16_t*)(p.ws + OFF_REGION);
    {
        g8::Gemm g{H, H, 1024, 1024, W, T, 2048, 1024};
        g8::StaticOrder S; S.init(T, 2048, (int)gridDim.x, (int)blockIdx.x);
        g8::EpiInN E{R};
        g8::gemm_phase<g8::EpiInN>((G8_LAS unsigned char*)smem_phys, g, S, E);
    }
    {
        const bf16_t* Wv = W + (size_t)2048 * 1024;
        g8::Gemm g{Wv, Wv, 1024, 1024, H, 1024, T, 1024};
        g8::StaticOrder S; S.init(1024, T, (int)gridDim.x, (int)blockIdx.x);
        g8::EpiInT E{R};
        g8::gemm_phase<g8::EpiInT>((G8_LAS unsigned char*)smem_phys, g, S, E);
    }
    {
        const int lane = threadIdx.x & 63, wid = threadIdx.x >> 6, fr = lane & 15, fq = lane >> 4;
        float* ALR = (float*)(R + R_ALR);
        for (int task = (int)blockIdx.x * 8 + wid; task < T / 16; task += (int)gridDim.x * 8) {
            const bf16_t* a = H + (size_t)(task * 16 + fr) * 1024 + fq * 8; const bf16_t* w = W + (size_t)(3072 + fr) * 1024 + fq * 8;
            f32x4 acc = (f32x4){0.f, 0.f, 0.f, 0.f};
#pragma unroll 8
            for (int kk = 0; kk < 32; ++kk) {
                const bf16x8 af = *(const bf16x8*)(a + kk * 32), wf = *(const bf16x8*)(w + kk * 32);
                acc = __builtin_amdgcn_mfma_f32_16x16x32_bf16(wf, af, acc, 0, 0, 0);
            }
            *(f32x4*)(ALR + (size_t)(task * 16 + fr) * 16 + fq * 4) = acc;
        }
    }
}

__device__ __forceinline__ void phase_gemm_in(const Params& p, char* smem) {
    const bf16_t* A = (const bf16_t*)(p.ws + OFF_H); const bf16_t* Bt = (const bf16_t*)(p.ws + OFF_WT_IN);
    bf16_t* R = (bf16_t*)(p.ws + OFF_REGION);
    const int lane = VTID & 63, wid = VTID >> 6, wm = wid >> 1, wn = wid & 1;
    constexpr int NT = AB_IN_PAD / 128, MT = T / 128;
    int mt_, nt_;
    for (int it = 0; tile_sched(it, MT, NT, mt_, nt_); ++it) {
        const int m0 = mt_ * 128, n0 = nt_ * 128;
        f32x4 acc[4][4];
        const bool tr = (n0 >= 1024 && n0 < 1536) || (n0 >= 2048 && n0 < 2560);
        if (!tr) {
            gemm_mainloop<0>(A, A, 1024, 1024, Bt, 1024, m0, n0, acc, smem);
#pragma unroll
            for (int i = 0; i < 4; ++i)
#pragma unroll
                for (int j = 0; j < 4; ++j) {
                    const int m = m0 + wm * 64 + i * 16 + (lane & 15), n = n0 + wn * 64 + j * 16 + 4 * (lane >> 4);
                    const f32x4 v = acc[i][j];
                    if (n < 512) store_bf16x4(R + R_QSB + (size_t)m * 512 + n, v * 0.125f);
                    else if (n < 1024) store_bf16x4(R + R_KSB + (size_t)m * 512 + (n - 512), v);
                    else if (n < 1792) store_bf16x4(R + R_QG + (size_t)m * 256 + (n - 1536), v);
                    else if (n < 2048) store_bf16x4(R + R_KG + (size_t)m * 256 + (n - 1792), v);
                    else if (n < 3072) store_bf16x4(R + R_GG + (size_t)m * 512 + (n - 2560), v);
                    else if (n < AB_IN) *(f32x4*)((float*)(R + R_ALR) + (size_t)m * 16 + (n - 3072)) = v;
                }
        } else {
            gemm_mainloop<1>(A, A, 1024, 1024, Bt, 1024, m0, n0, acc, smem);
#pragma unroll
            for (int i = 0; i < 4; ++i)
#pragma unroll
                for (int j = 0; j < 4; ++j) {
                    const int m = m0 + wm * 64 + i * 16 + 4 * (lane >> 4), n = n0 + wn * 64 + j * 16 + (lane & 15);
                    const int b = m >> 11, s = m & 2047;
                    if (n < 1536) { const int c = n - 1024, hh = c >> 6, e = c & 63; store_bf16x4(R + R_VTSB + ((size_t)((b * 8 + hh) * 64 + e)) * 2048 + s, acc[i][j]); }
                    else { const int c = n - 2048, hh = c >> 7, e = c & 127; store_bf16x4(R + R_VTG + ((size_t)((b * 4 + hh) * 128 + e)) * 2048 + s, acc[i][j]); }
                }
        }
    }
}
__device__ __forceinline__ void phase_gemm_resid(const bf16_t* A0, const bf16_t* A1, int lda, int ksplit, const bf16_t* Bt, int K, const float* Rs, float* O, char* smem) {
    const int lane = VTID & 63, wid = VTID >> 6, wm = wid >> 1, wn = wid & 1;
    constexpr int NT = 8, MT = T / 256;
    int mt_, nt_;
    for (int it = 0; tile_sched(it, MT, NT, mt_, nt_); ++it) {
        const int m0 = mt_ * 256, n0 = nt_ * 128;
        f32x4 acc[8][4];
        gemm_mainloop256<0>(A0, A1, lda, ksplit, Bt, K, m0, n0, acc, smem);
#pragma unroll
        for (int i = 0; i < 8; ++i)
#pragma unroll
            for (int j = 0; j < 4; ++j) {
                const int m = m0 + wm * 128 + i * 16 + (lane & 15), n = n0 + wn * 64 + j * 16 + 4 * (lane >> 4);
                const f32x4 r = *(const f32x4*)(Rs + (size_t)m * 1024 + n);
                *(f32x4*)(O + (size_t)m * 1024 + n) = r + acc[i][j];
            }
    }
}
__device__ __forceinline__ void phase_gemm_cin(const Params& p, char* smem) {
    const bf16_t* A = (const bf16_t*)(p.ws + OFF_H); const bf16_t* Bt = (const bf16_t*)(p.ws + OFF_WT_CIN);
    bf16_t* U = (bf16_t*)(p.ws + OFF_REGION); bf16_t* VT = U + (size_t)T * 2048; float* SSQ = (float*)(p.ws + OFF_SSQ);
    const int lane = VTID & 63, wid = VTID >> 6, wm = wid >> 1, wn = wid & 1;
    constexpr int NT = 32, MT = T / 128;
    int mt_, nt_;
    for (int it = 0; tile_sched(it, MT, NT, mt_, nt_); ++it) {
        const int m0 = mt_ * 128, n0 = nt_ * 128;
        f32x4 acc[4][4];
        if (n0 < 2048) {
            gemm_mainloop<0>(A, A, 1024, 1024, Bt, 1024, m0, n0, acc, smem);
#pragma unroll
            for (int i = 0; i < 4; ++i)
#pragma unroll
                for (int j = 0; j < 4; ++j) {
                    const int m = m0 + wm * 64 + i * 16 + (lane & 15), n = n0 + wn * 64 + j * 16 + 4 * (lane >> 4);
                    f32x4 v = acc[i][j];
#pragma unroll
                    for (int r = 0; r < 4; ++r) v[r] = gelu_exact(v[r]);
                    store_bf16x4(U + (size_t)m * 2048 + n, v);
                }
        } else {
            gemm_mainloop<1>(A, A, 1024, 1024, Bt, 1024, m0, n0, acc, smem);
#pragma unroll
            for (int i = 0; i < 4; ++i) {
                float ss[4] = {0.f, 0.f, 0.f, 0.f};
#pragma unroll
                for (int j = 0; j < 4; ++j) {
                    const int m = m0 + wm * 64 + i * 16 + 4 * (lane >> 4), n = n0 + wn * 64 + j * 16 + (lane & 15);
                    f32x4 v = acc[i][j];
#pragma unroll
                    for (int r = 0; r < 4; ++r) { v[r] = gelu_exact(v[r]); ss[r] += v[r] * v[r]; }
                    const int chunk = m >> 7, s = m & 127, c = n - 2048;
                    store_bf16x4(VT + ((size_t)chunk * 2048 + c) * 128 + s, v);
                }
#pragma unroll
                for (int r = 0; r < 4; ++r) {
                    float v = ss[r];
                    v += __shfl_xor(v, 1); v += __shfl_xor(v, 2); v += __shfl_xor(v, 4); v += __shfl_xor(v, 8);
                    if ((lane & 15) == 0) { const int m = m0 + wm * 64 + i * 16 + 4 * (lane >> 4) + r; SSQ[(size_t)m * 32 + ((n0 - 2048) >> 6) + wn] = v; }
                }
            }
        }
    }
}

typedef float f32x16 __attribute__((ext_vector_type(16)));
__device__ __forceinline__ void sb_fast(const Params& p, char* smem, unsigned* ctr) {
    bf16_t* R = (bf16_t*)(p.ws + OFF_REGION);
    char* KT = smem; char* VTt = smem + 8192;
    volatile int* flags = (volatile int*)(smem + 32768); volatile unsigned* slot = (volatile unsigned*)(smem + 32832);
    const int tid = threadIdx.x, lane = tid & 63, w = tid >> 6, r31 = lane & 31, h = lane >> 5;
    for (;;) {
        __syncthreads();
        if (tid == 0) *slot = atomicAdd(ctr, 1u);
        __syncthreads();
        const unsigned task = *slot;
        if (task >= 1024u) break;
        const int qblk = 7 - (int)(task >> 7), bh = task & 127, b = bh >> 3, hh = bh & 7;
        const int q0 = qblk * 256, qbase = q0 + 32 * w;
        bf16_t* qrow = R + R_QSB + (size_t)(b * 2048 + qbase + r31) * 512 + hh * 64;
        bf16x8 qf[4];
#pragma unroll
        for (int kk = 0; kk < 4; ++kk) qf[kk] = *(const bf16x8*)(qrow + 16 * kk + 8 * h);
        f32x16 oacc[2];
#pragma unroll
        for (int nt = 0; nt < 2; ++nt)
#pragma unroll
            for (int i = 0; i < 16; ++i) oacc[nt][i] = 0.f;
        float Rr = 1.0f;
        const int t = qbase + r31;
        for (int kt = q0 / 64 + 3; kt >= 0; --kt) {
            __syncthreads();
            { const int wd = __all(Rr == 0.f); if (lane == 0) flags[w] = wd; }
            __syncthreads();
            if (flags[0] & flags[1] & flags[2] & flags[3] & flags[4] & flags[5] & flags[6] & flags[7]) break;
            const int s_tile = kt * 64;
            {
                const int c = tid, row = c >> 3, ch = c & 7;
                const u32x4 kv = *(const u32x4*)(R + R_KSB + (size_t)(b * 2048 + s_tile + row) * 512 + hh * 64 + ch * 8);
                const u32x4 vv = *(const u32x4*)(R + R_VTSB + ((size_t)((b * 8 + hh) * 64 + row)) * 2048 + s_tile + ch * 8);
                *(u32x4*)(KT + row * 128 + ((ch ^ (row & 7)) << 4)) = kv;
                *(uint2*)(VTt + row * 136 + ch * 16) = make_uint2(vv[0], vv[1]);
                *(uint2*)(VTt + row * 136 + ch * 16 + 8) = make_uint2(vv[2], vv[3]);
            }
            __syncthreads();
#pragma unroll
            for (int sbk = 1; sbk >= 0; --sbk) {
                const int key_lo = s_tile + 32 * sbk;
                if (key_lo >= qbase + 31) continue;
                if (__all(Rr == 0.f)) continue;
                f32x16 st;
#pragma unroll
                for (int i = 0; i < 16; ++i) st[i] = 0.f;
                const int krow = 32 * sbk + r31;
#pragma unroll
                for (int kk = 0; kk < 4; ++kk) {
                    const bf16x8 kf = *(const bf16x8*)(KT + krow * 128 + (((2 * kk + h) ^ (krow & 7)) << 4));
                    st = __builtin_amdgcn_mfma_f32_32x32x16_bf16(kf, qf[kk], st, 0, 0, 0);
                }
                float a[16], G[4];
#pragma unroll
                for (int g = 0; g < 4; ++g) {
                    float sg[4], m[4];
#pragma unroll
                    for (int i = 0; i < 4; ++i) {
                        const int s = key_lo + 8 * g + 4 * h + i;
                        const float z = fminf(fmaxf(st[4 * g + i], -80.f), 80.f);
                        const float ez = __expf(-z), sig = 1.0f / (1.0f + ez);
                        const bool valid = s < t;
                        sg[i] = valid ? sig : 0.f; m[i] = valid ? ez * sig : 1.0f;
                    }
                    const float x2 = m[3], x1 = x2 * m[2], x0 = x1 * m[1];
                    G[g] = x0 * m[0];
                    a[4 * g + 3] = sg[3]; a[4 * g + 2] = sg[2] * x2; a[4 * g + 1] = sg[1] * x1; a[4 * g] = sg[0] * x0;
                }
                float Go[4], P[4];
#pragma unroll
                for (int g = 0; g < 4; ++g) { Go[g] = __shfl_xor(G[g], 32); P[g] = G[g] * Go[g]; }
                const float c2 = P[3], c1 = c2 * P[2], c0 = c1 * P[1];
                float Tg[4];
                Tg[3] = Rr; Tg[2] = Rr * c2; Tg[1] = Rr * c1; Tg[0] = Rr * c0;
#pragma unroll
                for (int g = 0; g < 4; ++g) {
                    const float tg = (h == 0) ? Tg[g] * Go[g] : Tg[g];
                    a[4 * g] *= tg; a[4 * g + 1] *= tg; a[4 * g + 2] *= tg; a[4 * g + 3] *= tg;
                }
                Rr = Rr * c0 * P[0];
#pragma unroll
                for (int s2 = 0; s2 < 2; ++s2) {
                    union { bf16x8 v; unsigned u[4]; } af;
#pragma unroll
                    for (int j2 = 0; j2 < 4; ++j2) af.u[j2] = pack2(a[8 * s2 + 2 * j2], a[8 * s2 + 2 * j2 + 1]);
#pragma unroll
                    for (int nt = 0; nt < 2; ++nt) {
                        const char* vp = VTt + (32 * nt + r31) * 136 + 64 * sbk + 32 * s2 + 8 * h;
                        union { bf16x8 v; uint2 hh2[2]; } vf;
                        vf.hh2[0] = *(const uint2*)vp; vf.hh2[1] = *(const uint2*)(vp + 16);
                        oacc[nt] = __builtin_amdgcn_mfma_f32_32x32x16_bf16(af.v, vf.v, oacc[nt], 0, 0, 0);
                    }
                }
            }
        }
#pragma unroll
        for (int nt = 0; nt < 2; ++nt)
#pragma unroll
            for (int i = 0; i < 16; ++i) {
                const int qq = (i & 3) + 8 * (i >> 2) + 4 * h;
                R[R_QSB + (size_t)(b * 2048 + qbase + qq) * 512 + hh * 64 + 32 * nt + r31] = f2bf(oacc[nt][i]);
            }
    }
}
__device__ __forceinline__ float log_sigmoid(float x) { return fminf(x, 0.f) - log1pf(__expf(-fabsf(x))); }
__device__ __forceinline__ int swz(int row, int chunk) { return row * 128 + ((chunk ^ (row & 7)) << 4); }
__device__ __forceinline__ void gla_prep(const Params& p, char* smem) {
    bf16_t* R = (bf16_t*)(p.ws + OFF_REGION);
    const float* ALR = (const float*)(R + R_ALR);
    bf16_t* KOTg = R + R_KOT; float* DECg = (float*)(R + R_DEC);
    float* SEG = (float*)smem; float* ALRs = SEG + 256;
    const int tid = VTID, d = tid & 63, w = tid >> 6;
    for (int task = VBID; task < 2048; task += VGRID) {
        const int bh = task >> 5, c = task & 31, b = bh >> 2, hh = bh & 3;
        const size_t rowbase = (size_t)b * 2048 + c * 64;
        unsigned qr[16], kr[16];
#pragma unroll
        for (int i = 0; i < 16; ++i) { const size_t row = rowbase + w * 16 + i; qr[i] = R[R_QG + row * 256 + hh * 64 + d]; kr[i] = R[R_KG + row * 256 + hh * 64 + d]; }
        const f32x4 ar = *(const f32x4*)(ALR + rowbase * 16 + tid * 4);
        float w2r[16];
#pragma unroll
        for (int r = 0; r < 16; ++r) w2r[r] = p.ab_w_alpha2[r * 256 + hh * 64 + d];
        const float b2r = p.ab_b_alpha2[hh * 64 + d];
        __syncthreads();
        *(f32x4*)(ALRs + tid * 4) = ar;
        __syncthreads();
        float cs[16]; float run = 0.f;
#pragma unroll
        for (int i = 0; i < 16; ++i) {
            const float* al = ALRs + (w * 16 + i) * 16;
            float pre = b2r;
#pragma unroll
            for (int r = 0; r < 16; ++r) pre += al[r] * w2r[r];
            run += log_sigmoid(pre) * (1.0f / 16.0f);
            cs[i] = run;
        }
        SEG[w * 64 + d] = run;
        __syncthreads();
        float off = 0.f, tot = 0.f;
#pragma unroll
        for (int w2 = 0; w2 < 4; ++w2) { const float s = SEG[w2 * 64 + d]; tot += s; if (w2 < w) off += s; }
        unsigned kop[8];
#pragma unroll
        for (int i2 = 0; i2 < 8; ++i2) {
            float kov[2];
#pragma unroll
            for (int u = 0; u < 2; ++u) {
                const int i = 2 * i2 + u;
                const float bc = off + cs[i];
                const float kv = bf2f((bf16_t)kr[i]);
                const size_t row = rowbase + w * 16 + i;
                R[R_QG + row * 256 + hh * 64 + d] = f2bf(bf2f((bf16_t)qr[i]) * 0.125f * __expf(bc));
                R[R_KG + row * 256 + hh * 64 + d] = f2bf(kv * __expf(-bc));
                kov[u] = kv * __expf(tot - bc);
            }
            kop[i2] = pack2(kov[0], kov[1]);
        }
        bf16_t* kp = KOTg + ((size_t)task * 64 + d) * 64 + w * 16;
        *(uint4*)kp = make_uint4(kop[0], kop[1], kop[2], kop[3]);
        *(uint4*)(kp + 8) = make_uint4(kop[4], kop[5], kop[6], kop[7]);
        if (w == 0) DECg[(size_t)task * 64 + d] = __expf(tot);
    }
}
__device__ __forceinline__ void gla_scan(const Params& p, char* smem, bool dry = false) {
    bf16_t* R = (bf16_t*)(p.ws + OFF_REGION);
    const bf16_t* KOTg = R + R_KOT; const float* DECg = (const float*)(R + R_DEC);
    char* QS = smem; char* KS = smem + 8192; char* KOT = smem + 16384; char* VTs = smem + 24576; char* SPT = smem + 40960;
    float* DEC = (float*)(smem + 57344); float* GN = DEC + 64;
    const int tid = VTID, lane = tid & 63, w = tid >> 6, l15_ = lane & 15, q4 = lane >> 4;
    for (int task = VBID; task < 64; task += VGRID) {
        const int b = task >> 2, hh = task & 3;
        f32x4 Sacc[8];
#pragma unroll
        for (int nt = 0; nt < 8; ++nt) Sacc[nt] = (f32x4){0.f, 0.f, 0.f, 0.f};
        __syncthreads();
        for (int i = tid; i < 1024; i += 256) *(uint4*)(SPT + i * 16) = make_uint4(0, 0, 0, 0);
        if (tid < 128) GN[tid] = p.ab_gla_norm[hh * 128 + tid];
        const size_t rowbase = (size_t)b * 2048;
        const bf16_t* vbase = R + R_VTG + ((size_t)((b * 4 + hh) * 128)) * 2048;
        u32x4 tq[2], tk[2], tko[2], vr[4]; float td = 0.f;
        auto prefetch = [&](int c) {
            const int t0 = c * 64;
#pragma unroll
            for (int i = 0; i < 2; ++i) {
                const int cid = tid + 256 * i, row = cid >> 3, ch = cid & 7;
                tq[i] = *(const u32x4*)(R + R_QG + (rowbase + t0 + row) * 256 + hh * 64 + ch * 8);
                tk[i] = *(const u32x4*)(R + R_KG + (rowbase + t0 + row) * 256 + hh * 64 + ch * 8);
                tko[i] = *(const u32x4*)(KOTg + (((size_t)task * 32 + c) * 64 + row) * 64 + ch * 8);
            }
#pragma unroll
            for (int i = 0; i < 4; ++i) { const int cid = tid + 256 * i, e = cid >> 3, ch = cid & 7; vr[i] = *(const u32x4*)(vbase + (size_t)e * 2048 + t0 + ch * 8); }
            if (tid < 64) td = DECg[((size_t)task * 32 + c) * 64 + tid];
        };
        prefetch(0);
        for (int c = 0; c < 32; ++c) {
            int lz = 0; asm volatile("" : "+v"(lz));
            const int l15 = l15_ + lz;
            const int cx = (q4 ^ (l15 & 7)) << 4;
            const int rb0 = l15 * 128 + cx, rb1 = l15 * 128 + (cx ^ 64);
#pragma unroll
            for (int i = 0; i < 2; ++i) {
                const int cid = tid + 256 * i + lz, row = cid >> 3, ch = cid & 7;
                *(u32x4*)(QS + swz(row, ch)) = tq[i]; *(u32x4*)(KS + swz(row, ch)) = tk[i]; *(u32x4*)(KOT + swz(row, ch)) = tko[i];
            }
#pragma unroll
            for (int i = 0; i < 4; ++i) { const int cid = tid + 256 * i + lz, e = cid >> 3, ch = cid & 7; *(u32x4*)(VTs + swz(e, ch)) = vr[i]; }
            if (tid < 64) DEC[tid] = td;
            uint2 gr[8];
            const unsigned goff = (unsigned)((rowbase + c * 64 + 16 * w + l15) * 512 + hh * 128 + 4 * q4);
            bf16_t* const gbase = R + R_GG;
#pragma unroll
            for (int nt = 0; nt < 8; ++nt) gr[nt] = *(const uint2*)(gbase + (goff + 16 * nt));
            if (c + 1 < 32) prefetch(c + 1);
            __syncthreads();
            bf16x8 qf[2];
#pragma unroll
            for (int kk = 0; kk < 2; ++kk) qf[kk] = *(const bf16x8*)(QS + w * 2048 + (kk ? rb1 : rb0));
            f32x4 sT[4];
#pragma unroll
            for (int st = 0; st < 4; ++st) {
                sT[st] = (f32x4){0.f, 0.f, 0.f, 0.f};
                if (st <= w) {
#pragma unroll
                    for (int kk = 0; kk < 2; ++kk) { const bf16x8 kf = *(const bf16x8*)(KS + st * 2048 + (kk ? rb1 : rb0)); sT[st] = __builtin_amdgcn_mfma_f32_16x16x32_bf16(kf, qf[kk], sT[st], 0, 0, 0); }
#pragma unroll
                    for (int r = 0; r < 4; ++r) if (16 * st + 4 * q4 + r > 16 * w + l15) sT[st][r] = 0.f;
                }
            }
            bf16x8 af[2];
#pragma unroll
            for (int ks2 = 0; ks2 < 2; ++ks2) {
                union { bf16x8 v; unsigned u[4]; } cv;
                cv.u[0] = pack2(sT[2 * ks2][0], sT[2 * ks2][1]); cv.u[1] = pack2(sT[2 * ks2][2], sT[2 * ks2][3]);
                cv.u[2] = pack2(sT[2 * ks2 + 1][0], sT[2 * ks2 + 1][1]); cv.u[3] = pack2(sT[2 * ks2 + 1][2], sT[2 * ks2 + 1][3]);
                af[ks2] = cv.v;
            }
            const int vb = l15 * 128 + ((((q4 >> 1) ^ (l15 & 7)) << 4) | ((q4 & 1) * 8));
            f32x4 o[8];
#pragma unroll
            for (int nt = 0; nt < 8; ++nt) {
                o[nt] = (f32x4){0.f, 0.f, 0.f, 0.f};
                const int e = 16 * nt + l15;
#pragma unroll
                for (int kk = 0; kk < 2; ++kk) { const bf16x8 sf = *(const bf16x8*)(SPT + nt * 2048 + (kk ? rb1 : rb0)); o[nt] = __builtin_amdgcn_mfma_f32_16x16x32_bf16(sf, qf[kk], o[nt], 0, 0, 0); }
#pragma unroll
                for (int ks2 = 0; ks2 < 2; ++ks2) {
                    if (2 * ks2 <= w) {
                        union { bf16x8 v; uint2 h[2]; } cv;
                        cv.h[0] = *(const uint2*)(VTs + nt * 2048 + (vb ^ (ks2 * 64)));
                        cv.h[1] = *(const uint2*)(VTs + nt * 2048 + (vb ^ (ks2 * 64) ^ 32));
                        o[nt] = __builtin_amdgcn_mfma_f32_16x16x32_bf16(cv.v, af[ks2], o[nt], 0, 0, 0);
                    }
                }
            }
            {
                const float4 dc = *(const float4*)(DEC + 16 * w + 4 * q4);
                bf16x8 kof[2];
#pragma unroll
                for (int kk = 0; kk < 2; ++kk) kof[kk] = *(const bf16x8*)(KOT + w * 2048 + (kk ? rb1 : rb0));
#pragma unroll
                for (int nt = 0; nt < 8; ++nt) {
                    Sacc[nt][0] *= dc.x; Sacc[nt][1] *= dc.y; Sacc[nt][2] *= dc.z; Sacc[nt][3] *= dc.w;
#pragma unroll
                    for (int kk = 0; kk < 2; ++kk) { const bf16x8 vf = *(const bf16x8*)(VTs + nt * 2048 + (kk ? rb1 : rb0)); Sacc[nt] = __builtin_amdgcn_mfma_f32_16x16x32_bf16(kof[kk], vf, Sacc[nt], 0, 0, 0); }
                }
            }
            __syncthreads();
#pragma unroll
            for (int nt = 0; nt < 8; ++nt) {
                const int e = 16 * nt + l15;
                uint2 pk; pk.x = pack2(Sacc[nt][0], Sacc[nt][1]); pk.y = pack2(Sacc[nt][2], Sacc[nt][3]);
                *(uint2*)(SPT + nt * 2048 + l15 * 128 + (((2 * w + (q4 >> 1)) ^ (l15 & 7)) << 4) + (q4 & 1) * 8) = pk;
            }
            float ssq = 0.f;
#pragma unroll
            for (int nt = 0; nt < 8; ++nt) ssq += (o[nt][0] * o[nt][0] + o[nt][1] * o[nt][1]) + (o[nt][2] * o[nt][2] + o[nt][3] * o[nt][3]);
            ssq += __shfl_xor(ssq, 16); ssq += __shfl_xor(ssq, 32);
            const float rsd = rsqrtf(ssq * (1.0f / 128.0f) + EPS);
#pragma unroll
            for (int nt = 0; nt < 8; ++nt) {
                asm volatile("" ::: "memory");
                const f32x4 gn = *(const f32x4*)(GN + 16 * nt + 4 * q4);
                const float g0 = lo2f(gr[nt].x), g1 = hi2f(gr[nt].x), g2 = lo2f(gr[nt].y), g3 = hi2f(gr[nt].y);
                uint2 ov;
                ov.x = pack2(o[nt][0] * rsd * gn[0] * (g0 / (1.0f + __expf(-g0))), o[nt][1] * rsd * gn[1] * (g1 / (1.0f + __expf(-g1))));
                ov.y = pack2(o[nt][2] * rsd * gn[2] * (g2 / (1.0f + __expf(-g2))), o[nt][3] * rsd * gn[3] * (g3 / (1.0f + __expf(-g3))));
                if (!dry || ov.x == 0x7fc17fc1u) *(uint2*)(gbase + (goff + 16 * nt)) = ov;
            }
        }
    }
}

__device__ __forceinline__ unsigned ord_key(float f) { const unsigned u = __float_as_uint(f); return (u & 0x80000000u) ? ~u : (u | 0x80000000u); }
__device__ __forceinline__ float unord_key(unsigned k) { return __uint_as_float((k & 0x80000000u) ? (k & 0x7fffffffu) : ~k); }
__device__ __forceinline__ void ce_desc(unsigned& a, unsigned& b) { const unsigned hi = max(a, b), lo = min(a, b); a = hi; b = lo; }
__device__ __forceinline__ void bitonic_sort16_desc(unsigned (&a)[16]) {
#pragma unroll
    for (int k = 2; k <= 16; k <<= 1)
#pragma unroll
        for (int j = k >> 1; j > 0; j >>= 1)
#pragma unroll
            for (int i = 0; i < 16; ++i) { const int l = i ^ j; if (l > i) { if ((i & k) == 0) ce_desc(a[i], a[l]); else ce_desc(a[l], a[i]); } }
}
__device__ __forceinline__ void merge_top16(unsigned (&L)[16], const unsigned (&B)[16]) {
#pragma unroll
    for (int i = 0; i < 16; ++i) L[i] = max(L[i], B[15 - i]);
#pragma unroll
    for (int j = 8; j > 0; j >>= 1)
#pragma unroll
        for (int i = 0; i < 16; ++i) { const int l = i ^ j; if (l > i) ce_desc(L[i], L[l]); }
}
__device__ constexpr int cand_i(int n) { int c = 0; for (int i = 0; i < 16; ++i) for (int j = 0; j < 16; ++j) if ((i + 1) * (j + 1) <= 16) { if (c == n) return i; ++c; } return -1; }
__device__ constexpr int cand_j(int n) { int c = 0; for (int i = 0; i < 16; ++i) for (int j = 0; j < 16; ++j) if ((i + 1) * (j + 1) <= 16) { if (c == n) return j; ++c; } return -1; }
template <int N> struct CandTab { int i[N], j[N]; constexpr CandTab() : i(), j() { for (int n = 0; n < N; ++n) { i[n] = cand_i(n); j[n] = cand_j(n); } } };
__device__ __forceinline__ void peer_select_fast(const Params& p, int layer, char* smem) {
    const bf16_t* A = (const bf16_t*)(p.ws + OFF_H);
    const bf16_t* Bt = (const bf16_t*)(p.ws + OFF_WT_Q) + (size_t)layer * 2048 * 1024;
    const bf16_t* SK = (const bf16_t*)(p.ws + OFF_SK) + (size_t)layer * 8 * 2 * 128 * 128;
    unsigned short* IDX = (unsigned short*)(p.ws + OFF_IDX); float* GATE = (float*)(p.ws + OFF_GATE);
    const int tid_ = VTID;
    float* SC = (float*)smem; unsigned* XCH = (unsigned*)smem;
    int mt_, hh;
    for (int it = 0; tile_sched(it, T / 128, 8, mt_, hh); ++it) {
        const int m0 = mt_ * 128;
        unsigned L0[16], L1[16];
#pragma unroll
        for (int pp = 0; pp < 2; ++pp) {
            f32x4 acc[4][4];
            gemm_mainloop<0>(A, A, 1024, 1024, Bt, 1024, m0, hh * 256 + pp * 128, acc, smem);
            int lz = 0; asm volatile("" : "+v"(lz));
            const int tid = tid_ + lz, lane = tid & 63, wid = tid >> 6, wm = wid >> 1, wn = wid & 1, l15 = lane & 15, q4 = lane >> 4, token = tid & 127, half = tid >> 7;
#pragma unroll
            for (int i = 0; i < 4; ++i)
#pragma unroll
                for (int j = 0; j < 4; ++j) {
                    const int row = wm * 64 + i * 16 + l15, chunk = 2 * j + (q4 >> 1);
                    uint2 o; o.x = pack2(acc[i][j][0], acc[i][j][1]); o.y = pack2(acc[i][j][2], acc[i][j][3]);
                    *(uint2*)(smem + wn * 32768 + row * 128 + ((chunk ^ (row & 7)) << 4) + (q4 & 1) * 8) = o;
                }
            const bf16_t* SKp = SK + (size_t)((hh * 2 + pp) * 128) * 128;
#pragma unroll
            for (int i = 0; i < 8; ++i) {
                const int c = tid + 256 * i, row = c >> 4, ch16 = c & 15, ks = ch16 >> 3, ch = ch16 & 7;
                *(uint4*)(smem + ks * 32768 + 16384 + row * 128 + ((ch ^ (row & 7)) << 4)) = *(const uint4*)(SKp + (size_t)row * 128 + ch16 * 8);
            }
            __syncthreads();
#pragma unroll
            for (int i = 0; i < 4; ++i)
#pragma unroll
                for (int j = 0; j < 4; ++j) acc[i][j] = (f32x4){0.f, 0.f, 0.f, 0.f};
#pragma unroll
            for (int kt = 0; kt < 2; ++kt) {
                const char* sa = smem + kt * 32768; const char* sb = sa + 16384;
#pragma unroll
                for (int ks = 0; ks < 2; ++ks) {
                    bf16x8 af[4], bfr[4];
                    const int ch = ks * 4 + q4;
#pragma unroll
                    for (int i = 0; i < 4; ++i) { const int row = wm * 64 + i * 16 + l15; af[i] = *(const bf16x8*)(sa + row * 128 + ((ch ^ (row & 7)) << 4)); }
#pragma unroll
                    for (int j = 0; j < 4; ++j) { const int row = wn * 64 + j * 16 + l15; bfr[j] = *(const bf16x8*)(sb + row * 128 + ((ch ^ (row & 7)) << 4)); }
#pragma unroll
                    for (int i = 0; i < 4; ++i)
#pragma unroll
                        for (int j = 0; j < 4; ++j) acc[i][j] = __builtin_amdgcn_mfma_f32_16x16x32_bf16(bfr[j], af[i], acc[i][j], 0, 0, 0);
                }
            }
            __syncthreads();
#pragma unroll
            for (int i = 0; i < 4; ++i)
#pragma unroll
                for (int j = 0; j < 4; ++j) {
                    const int m = wm * 64 + i * 16 + l15, n = wn * 64 + j * 16 + 4 * q4;
#pragma unroll
                    for (int r = 0; r < 4; ++r) SC[m * 128 + ((n + r) ^ (m & 31))] = acc[i][j][r];
                }
            __syncthreads();
            unsigned L[16];
            {
                const float* srow = SC + token * 128 + half * 64; const int x = token & 31;
#pragma unroll
                for (int ch = 0; ch < 4; ++ch) {
                    unsigned Cc[16];
#pragma unroll
                    for (int i = 0; i < 16; ++i) { const int c = ch * 16 + i; Cc[i] = (ord_key(srow[c ^ x]) & ~127u) | (unsigned)(127 - (half * 64 + c)); }
                    bitonic_sort16_desc(Cc);
                    if (ch == 0) {
#pragma unroll
                        for (int i = 0; i < 16; ++i) L[i] = Cc[i];
                    } else merge_top16(L, Cc);
                }
            }
            __syncthreads();
            if (half == 1) {
#pragma unroll
                for (int i = 0; i < 16; ++i) XCH[token * 17 + i] = L[i];
            }
            __syncthreads();
            if (half == 0) {
                unsigned Xc[16];
#pragma unroll
                for (int i = 0; i < 16; ++i) Xc[i] = XCH[token * 17 + i];
                merge_top16(L, Xc);
            }
#pragma unroll
            for (int i = 0; i < 16; ++i) { if (pp == 0) L0[i] = L[i]; else L1[i] = L[i]; }
            __syncthreads();
        }
        unsigned* NIDX = (unsigned*)smem;
        const int token = tid_ & 127, half = tid_ >> 7;
        if (half == 0) {
            float s0[16], s1[16];
#pragma unroll
            for (int i = 0; i < 16; ++i) { s0[i] = unord_key(L0[i] & ~127u); s1[i] = unord_key(L1[i] & ~127u); }
            constexpr CandTab<64> ct{};
            unsigned C[16];
#pragma unroll
            for (int ch = 0; ch < 4; ++ch) {
                unsigned Cc[16];
#pragma unroll
                for (int i = 0; i < 16; ++i) {
                    const int n = ch * 16 + i;
                    if (ct.i[n] >= 0) Cc[i] = (ord_key(s0[ct.i[n] < 0 ? 0 : ct.i[n]] + s1[ct.j[n] < 0 ? 0 : ct.j[n]]) & ~255u) | (unsigned)(255 - (ct.i[n] * 16 + ct.j[n]));
                    else Cc[i] = 0u;
                }
                bitonic_sort16_desc(Cc);
                if (ch == 0) {
#pragma unroll
                    for (int i = 0; i < 16; ++i) C[i] = Cc[i];
                } else merge_top16(C, Cc);
            }
#pragma unroll
            for (int i = 0; i < 16; ++i) { NIDX[token * 33 + i] = 127u - (L0[i] & 127u); NIDX[token * 33 + 16 + i] = 127u - (L1[i] & 127u); }
            const float mx = unord_key(C[0] & ~255u);
            float e[16]; float sum = 0.f;
#pragma unroll
            for (int r = 0; r < 16; ++r) { e[r] = __expf(unord_key(C[r] & ~255u) - mx); sum += e[r]; }
            const float inv = 1.0f / sum;
            const size_t ob = (size_t)(m0 + token) * 128 + hh * 16;
#pragma unroll
            for (int r = 0; r < 16; ++r) {
                const unsigned code = 255u - (C[r] & 255u);
                const unsigned e0 = NIDX[token * 33 + (code >> 4)], e1 = NIDX[token * 33 + 16 + (code & 15)];
                IDX[ob + r] = (unsigned short)(e0 * 128 + e1);
                GATE[ob + r] = e[r] * inv;
            }
        }
        __syncthreads();
    }
}

__device__ __forceinline__ bf16x8 pack8(const float4 a, const float4 b) {
    u32x4 t; t.x = pack2(a.x, a.y); t.y = pack2(a.z, a.w); t.z = pack2(b.x, b.y); t.w = pack2(b.z, b.w);
    return __builtin_bit_cast(bf16x8, t);
}
__device__ __forceinline__ void fold_query_weights(const Params& p, int vb0 = 0) {
    int lz = 0; asm volatile("" : "+v"(lz));
    const int lane = (VTID & 63) + lz, wid = VTID >> 6, fr = lane & 15, fq = lane >> 4;
    bf16_t* Wf = (bf16_t*)(p.ws + OFF_WT_Q);
    if (VBID < vb0) return;
    for (int task = VBID - vb0; task < 512; task += VGRID - vb0) {
        const int kb = task & 15, pp = (task >> 4) & 1, h = (task >> 5) & 7, layer = task >> 8;
        const float* wq = p.peer_w_q + (size_t)layer * 1024 * 2048 + (size_t)(kb * 64 + fr) * 2048 + h * 256 + pp * 128 + fq * 8;
        const float* sk = p.peer_subkeys + ((size_t)((layer * 8 + h) * 2 + pp) * 128 + wid * 32 + fr) * 128 + fq * 8;
        f32x4 acc[4][2];
#pragma unroll
        for (int kt = 0; kt < 4; ++kt)
#pragma unroll
            for (int jt = 0; jt < 2; ++jt) acc[kt][jt] = (f32x4){0.f, 0.f, 0.f, 0.f};
#pragma unroll 1
        for (int s = 0; s < 4; ++s) {
            bf16x8 a[4], b[2];
#pragma unroll
            for (int kt = 0; kt < 4; ++kt) { const float* q = wq + (size_t)(kt * 16) * 2048 + s * 32; a[kt] = pack8(*(const float4*)q, *(const float4*)(q + 4)); }
#pragma unroll
            for (int jt = 0; jt < 2; ++jt) { const float* q = sk + (size_t)(jt * 16) * 128 + s * 32; b[jt] = pack8(*(const float4*)q, *(const float4*)(q + 4)); }
#pragma unroll
            for (int kt = 0; kt < 4; ++kt)
#pragma unroll
                for (int jt = 0; jt < 2; ++jt) acc[kt][jt] = __builtin_amdgcn_mfma_f32_16x16x32_bf16(a[kt], b[jt], acc[kt][jt], 0, 0, 0);
        }
#pragma unroll
        for (int jt = 0; jt < 2; ++jt) {
            const int key = wid * 32 + jt * 16 + fr, cu = 128 * ((key >> 5) & 1) + 32 * (2 * pp + (key >> 6)) + (key & 31);
            bf16_t* row = Wf + ((size_t)layer * 2048 + h * 256 + cu) * 1024 + kb * 64 + 4 * fq;
#pragma unroll
            for (int kt = 0; kt < 4; ++kt) store_bf16x4(row + kt * 16, acc[kt][jt]);
        }
    }
}
__device__ __forceinline__ void bitonic_merge16_desc(unsigned (&L)[16]) {
#pragma unroll
    for (int j = 8; j > 0; j >>= 1)
#pragma unroll
        for (int i = 0; i < 16; ++i) { const int l = i ^ j; if (l > i) ce_desc(L[i], L[l]); }
}
__device__ __forceinline__ void bitonic_sort8_desc(unsigned (&a)[8]) {
#pragma unroll
    for (int k = 2; k <= 8; k <<= 1)
#pragma unroll
        for (int j = k >> 1; j > 0; j >>= 1)
#pragma unroll
            for (int i = 0; i < 8; ++i) { const int l = i ^ j; if (l > i) { if ((i & k) == 0) ce_desc(a[i], a[l]); else ce_desc(a[l], a[i]); } }
}
struct EpiSelect {
    unsigned* IDX; float* GATE; G8_LAS unsigned* X; const float* SSQP; const unsigned* SCT;
    __device__ __forceinline__ void operator()(const f32x4 (&acc)[2][2][4][2], const g8::Unit& u, int wr, int wc, int fr, int fq) const {
        const int pp = wc >> 1, half = wc & 1, wid = wr * 4 + wc;
        const unsigned kb = 127u - (unsigned)(half * 64 + fq * 8);
        unsigned Lst[4][16];
#pragma unroll
        for (int ai = 0; ai < 2; ++ai)
#pragma unroll
            for (int m = 0; m < 4; ++m) {
                unsigned C[16], Xc[16];
#pragma unroll
                for (int bj = 0; bj < 2; ++bj)
#pragma unroll
                    for (int n = 0; n < 2; ++n)
#pragma unroll
                        for (int r = 0; r < 4; ++r) C[bj * 8 + n * 4 + r] = (ord_key(acc[ai][bj][m][n][r]) & ~127u) | (kb - (unsigned)(bj * 32 + n * 4 + r));
                bitonic_sort16_desc(C);
#pragma unroll
                for (int i = 0; i < 16; ++i) Xc[i] = (unsigned)__shfl_xor((int)C[i], 16);
                merge_top16(C, Xc);
#pragma unroll
                for (int i = 0; i < 16; ++i) Xc[i] = (unsigned)__shfl_xor((int)C[i], 32);
                merge_top16(C, Xc);
                if ((m >> 1) == half) {
#pragma unroll
                    for (int i = 0; i < 16; ++i) Lst[ai * 2 + (m & 1)][i] = C[i];
                } else if (fq == 0) {
                    G8_LAS unsigned* xs = X + (((ai * 2 + wr) * 2 + pp) * 4 + m) * 256 + fr;
#pragma unroll
                    for (int i = 0; i < 16; ++i) xs[(i ^ m) << 4] = C[i];
                }
            }
        __syncthreads();
#pragma unroll
        for (int ai = 0; ai < 2; ++ai)
#pragma unroll
            for (int e = 0; e < 2; ++e) {
                const int m = half * 2 + e;
                unsigned Xc[16];
                G8_LAS unsigned* xs = X + (((ai * 2 + wr) * 2 + pp) * 4 + m) * 256 + fr;
#pragma unroll
                for (int i = 0; i < 16; ++i) Xc[i] = xs[(i ^ m) << 4];
                merge_top16(Lst[ai * 2 + e], Xc);
                if (fq == 0) {
#pragma unroll
                    for (int i = 0; i < 16; ++i) xs[(i ^ m) << 4] = Lst[ai * 2 + e][i];
                }
            }
        __syncthreads();
        if (wid < 4) {
            G8_LAS unsigned* x0 = X + ((wid * 2 + 0) * 4 + fq) * 256 + fr; G8_LAS unsigned* x1 = X + ((wid * 2 + 1) * 4 + fq) * 256 + fr;
            float s0[16], s1[16];
#pragma unroll
            for (int i = 0; i < 16; ++i) { s0[i] = unord_key(x0[(i ^ fq) << 4] & ~127u); s1[i] = unord_key(x1[(i ^ fq) << 4] & ~127u); }
#define SEL_CAND(i, j) ((ord_key(s0[i] + s1[j]) & ~255u) | (unsigned)(255 - ((i) * 16 + (j))))
            unsigned C[16], B[16], M2[16], M3[8];
#pragma unroll
            for (int j = 0; j < 16; ++j) C[j] = SEL_CAND(0, j);
#pragma unroll
            for (int k = 0; k < 15; ++k) B[k] = SEL_CAND(k + 1, 0);
            B[15] = 0u;
            merge_top16(C, B);
#pragma unroll
            for (int j = 0; j < 7; ++j) M2[j] = SEL_CAND(1, j + 1);
            M2[7] = 0u; M2[8] = 0u; M2[9] = 0u;
#pragma unroll
            for (int k = 0; k < 6; ++k) M2[15 - k] = SEL_CAND(k + 2, 1);
            bitonic_merge16_desc(M2);
            M3[0] = SEL_CAND(2, 2); M3[1] = SEL_CAND(2, 3); M3[2] = SEL_CAND(2, 4); M3[3] = SEL_CAND(3, 2); M3[4] = SEL_CAND(4, 2); M3[5] = SEL_CAND(3, 3); M3[6] = 0u; M3[7] = 0u;
            bitonic_sort8_desc(M3);
#pragma unroll
            for (int i = 0; i < 8; ++i) B[i] = M3[i];
#pragma unroll
            for (int i = 8; i < 16; ++i) B[i] = 0u;
            merge_top16(M2, B);
            merge_top16(C, M2);
#undef SEL_CAND
            const int tok = u.pm * 256 + (wid >> 1) * 128 + (wid & 1) * 64 + fq * 16 + fr;
            float rstd;
            {
                const f32x4 q0 = *(const f32x4*)(SSQP + (size_t)tok * 32), q1 = *(const f32x4*)(SSQP + (size_t)tok * 32 + 4), q2 = *(const f32x4*)(SSQP + (size_t)tok * 32 + 8), q3 = *(const f32x4*)(SSQP + (size_t)tok * 32 + 12);
                const f32x4 q = (q0 + q1) + (q2 + q3);
                rstd = rsqrtf(((q[0] + q[1]) + (q[2] + q[3])) * (1.0f / D) + EPS);
            }
            const float mx = unord_key(C[0] & ~255u);
            float e[16]; float sum = 0.f;
#pragma unroll
            for (int r = 0; r < 16; ++r) { e[r] = __expf((unord_key(C[r] & ~255u) - mx) * rstd); sum += e[r]; }
            const float inv = 1.0f / sum;
            const size_t ob = (size_t)tok * 128 + u.pn * 16;
            unsigned iw[16];
#pragma unroll
            for (int r = 0; r < 16; ++r) {
                const unsigned code = 255u - (C[r] & 255u);
                const unsigned e0 = 127u - (x0[((code >> 4) ^ (unsigned)fq) << 4] & 127u), e1 = 127u - (x1[((code & 15u) ^ (unsigned)fq) << 4] & 127u);
                iw[r] = e0 * 128u + e1;
            }
            unsigned sc[16];
#pragma unroll
            for (int r = 0; r < 16; ++r) sc[r] = SCT[iw[r]];
#pragma unroll
            for (int r = 0; r < 16; ++r) {
                iw[r] |= sc[r] << 16;
                e[r] *= inv * (float)__builtin_bit_cast(_Float16, (unsigned short)(sc[r] >> 16));
            }
#pragma unroll
            for (int r = 0; r < 4; ++r) *(uint4*)(IDX + ob + r * 4) = make_uint4(iw[4 * r], iw[4 * r + 1], iw[4 * r + 2], iw[4 * r + 3]);
#pragma unroll
            for (int r = 0; r < 4; ++r) *(float4*)(GATE + ob + r * 4) = make_float4(e[4 * r], e[4 * r + 1], e[4 * r + 2], e[4 * r + 3]);
        }
        __syncthreads();
    }
};
__device__ __forceinline__ void phase_select8(const Params& p, int layer, char* smem_phys) {
    const bf16_t* H = (const bf16_t*)(p.ws + OFF_H); const bf16_t* Wf = (const bf16_t*)(p.ws + OFF_WT_Q) + (size_t)layer * 2048 * 1024;
    g8::Gemm g{H, H, 1024, 1024, Wf, T, 2048, 1024};
    g8::StaticOrder S; S.init(T, 2048, (int)gridDim.x, (int)blockIdx.x);
    EpiSelect E{(unsigned*)(p.ws + OFF_IDX), (float*)(p.ws + OFF_GATE), (G8_LAS unsigned*)(smem_phys + 131072), (const float*)(p.ws + OFF_SSQ), (const unsigned*)(p.ws + OFF_USC) + (size_t)layer * NEXP};
    g8::gemm_phase<EpiSelect>((G8_LAS unsigned char*)smem_phys, g, S, E);
    __syncthreads();
    if (threadIdx.x == 0) *(uint4*)(smem_phys + kDynLds - 16) = make_uint4(0u, 0u, 0u, 0u);
    __syncthreads();
}

__device__ __forceinline__ float ub0(unsigned w) { float f; asm("v_cvt_f32_ubyte0 %0, %1" : "=v"(f) : "v"(w)); return f; }
__device__ __forceinline__ float ub1(unsigned w) { float f; asm("v_cvt_f32_ubyte1 %0, %1" : "=v"(f) : "v"(w)); return f; }
__device__ __forceinline__ float ub2(unsigned w) { float f; asm("v_cvt_f32_ubyte2 %0, %1" : "=v"(f) : "v"(w)); return f; }
__device__ __forceinline__ float ub3(unsigned w) { float f; asm("v_cvt_f32_ubyte3 %0, %1" : "=v"(f) : "v"(w)); return f; }
typedef _Float16 f16x2 __attribute__((ext_vector_type(2)));
__device__ __forceinline__ void glds16(const void* gsrc, unsigned lds_dst) {
    unsigned keep; const unsigned d = (unsigned)__builtin_amdgcn_readfirstlane((int)lds_dst);
    asm volatile("s_mov_b32 %0, m0\n\ts_mov_b32 m0, %2\n\ts_nop 0\n\tglobal_load_lds_dwordx4 %1, off\n\ts_mov_b32 m0, %0" : "=&s"(keep) : "v"(gsrc), "s"(d) : "memory");
}
__device__ __forceinline__ void peer_gather(const Params& p, int layer, const float* __restrict__ gnext, bool final_out, char* smem) {
    const unsigned char* REC = p.ws + OFF_UT + (size_t)layer * NEXP * 1024;
    bf16_t* H = (bf16_t*)(p.ws + OFF_H);
    const unsigned* IDX = (const unsigned*)(p.ws + OFF_IDX); const float* GATE = (const float*)(p.ws + OFF_GATE);
    float* X = p.out;
    const int lane = VTID & 63, wid = VTID >> 6, sub = lane >> 4, li = lane & 15;
    char* wbase = smem + (int)(threadIdx.x >> 6) * 17408;
    unsigned* sIdx = (unsigned*)wbase; float* sGate = (float*)(wbase + 512);
    const char* ring = wbase + 1024; const unsigned ringb = (unsigned)(size_t)ring;
    const int gw = VBID * 4 + wid, nw = VGRID * 4;
    for (int t = gw; t < T; t += nw) {
        {
            int lz = 0; asm volatile("" : "+v"(lz));
            const int l2 = 2 * (lane + lz);
            const uint2 idp = *(const uint2*)(IDX + (size_t)t * 128 + l2);
            const float2 g2 = *(const float2*)(GATE + (size_t)t * 128 + l2);
            *(uint2*)(sIdx + l2) = idp; *(float2*)(sGate + l2) = g2;
        }
        int xq[2][8]; float sx; float xg = 0.f;
        {
            u32x4 xr[8]; float am = 0.f;
#pragma unroll
            for (int k = 0; k < 8; ++k) {
                xr[k] = *(const u32x4*)(H + (size_t)t * 1024 + (16 * (k >> 2) + li) * 32 + (k & 3) * 8);
#pragma unroll
                for (int c = 0; c < 4; ++c) am = fmaxf(am, fmaxf(fabsf(lo2f(xr[k][c])), fabsf(hi2f(xr[k][c]))));
            }
            const float* sq = (const float*)(p.ws + OFF_SSQ) + (size_t)t * 32;
            const f32x4 qs = (*(const f32x4*)sq + *(const f32x4*)(sq + 4)) + (*(const f32x4*)(sq + 8) + *(const f32x4*)(sq + 12));
            am = fmaxf(am, __shfl_xor(am, 1)); am = fmaxf(am, __shfl_xor(am, 2)); am = fmaxf(am, __shfl_xor(am, 4)); am = fmaxf(am, __shfl_xor(am, 8));
            const float inv = am > 0.f ? 127.0f / am : 0.f;
            sx = am * (1.0f / 127.0f) * rsqrtf(((qs[0] + qs[1]) + (qs[2] + qs[3])) * (1.0f / D) + EPS);
#pragma unroll
            for (int j = 0; j < 2; ++j) {
                int xs = 0;
#pragma unroll
                for (int d = 0; d < 8; ++d) {
                    const unsigned w0 = xr[j * 4 + (d >> 1)][(d & 1) * 2], w1 = xr[j * 4 + (d >> 1)][(d & 1) * 2 + 1];
                    const int q0 = __float2int_rn(lo2f(w0) * inv), q1 = __float2int_rn(hi2f(w0) * inv), q2 = __float2int_rn(lo2f(w1) * inv), q3 = __float2int_rn(hi2f(w1) * inv);
                    xq[j][d] = (q0 & 0xff) | ((q1 & 0xff) << 8) | ((q2 & 0xff) << 16) | ((q3 & 0xff) << 24);
                    xs += (q0 + q1) + (q2 + q3);
                }
                xg += -7.5f * (float)xs;
            }
        }
        f16x2 accp[2][16];
#pragma unroll
        for (int j = 0; j < 2; ++j)
#pragma unroll
            for (int c = 0; c < 16; ++c) accp[j][c] = (f16x2){(_Float16)0.f, (_Float16)0.f};
        float wsg = 0.f;
        auto issue = [&](int sg) {
            const unsigned e_ = sIdx[sg * 4 + sub] & 0xffffu;
            const unsigned char* rec = REC + (size_t)e_ * 1024 + li * 16;
            const unsigned dst = ringb + (unsigned)(sg & 3) * 4096u;
            glds16(rec, dst); glds16(rec + 256, dst + 1024u); glds16(rec + 512, dst + 2048u); glds16(rec + 768, dst + 3072u);
        };
        auto compute = [&](int sg) {
            const char* sl = ring + (sg & 3) * 4096;
            const u32x4 du0 = *(const u32x4*)(sl + lane * 16), du1 = *(const u32x4*)(sl + 1024 + lane * 16);
            const u32x4 dv0 = *(const u32x4*)(sl + 2048 + lane * 16), dv1 = *(const u32x4*)(sl + 3072 + lane * 16);
            const float us = (float)__builtin_bit_cast(_Float16, (unsigned short)(sIdx[sg * 4 + sub] >> 16));
            const float gt = sGate[sg * 4 + sub];
            int ia = 0;
#pragma unroll
            for (int j = 0; j < 2; ++j) {
#pragma unroll
                for (int d = 0; d < 4; ++d) {
                    const unsigned w = j ? du1[d] : du0[d];
                    ia = __builtin_amdgcn_sdot4((int)(w & 0x0f0f0f0fu), xq[j][2 * d], ia, false);
                    ia = __builtin_amdgcn_sdot4((int)((w >> 4) & 0x0f0f0f0fu), xq[j][2 * d + 1], ia, false);
                }
            }
            float pa = us * ((float)ia + xg);
            pa = row16_sum(pa);
            const float ww = gt * gelu_exact(pa * sx);
            wsg += ww;
            const _Float16 wh = (_Float16)fminf(fmaxf(ww * 65536.0f, -65504.0f), 65504.0f);
            const f16x2 w2 = {wh, wh};
#pragma unroll
            for (int j = 0; j < 2; ++j) {
#pragma unroll
                for (int d = 0; d < 4; ++d) {
                    const unsigned wv = j ? dv1[d] : dv0[d];
                    const f16x2 c0 = __builtin_bit_cast(f16x2, (wv << 4) & 0x00f000f0u), c1 = __builtin_bit_cast(f16x2, wv & 0x00f000f0u);
                    const f16x2 c2 = __builtin_bit_cast(f16x2, (wv >> 4) & 0x00f000f0u), c3 = __builtin_bit_cast(f16x2, (wv >> 8) & 0x00f000f0u);
                    accp[j][4 * d + 0] = __builtin_elementwise_fma(c0, w2, accp[j][4 * d + 0]); accp[j][4 * d + 1] = __builtin_elementwise_fma(c1, w2, accp[j][4 * d + 1]);
                    accp[j][4 * d + 2] = __builtin_elementwise_fma(c2, w2, accp[j][4 * d + 2]); accp[j][4 * d + 3] = __builtin_elementwise_fma(c3, w2, accp[j][4 * d + 3]);
                }
            }
        };
        asm volatile("s_waitcnt vmcnt(0)" ::: "memory");
        issue(0); issue(1); issue(2);
#pragma unroll 1
        for (int sg = 0; sg < 29; ++sg) {
            issue(sg + 3);
            asm volatile("s_waitcnt vmcnt(12)" ::: "memory");
            compute(sg);
        }
        asm volatile("s_waitcnt vmcnt(8)" ::: "memory");
        compute(29);
        asm volatile("s_waitcnt vmcnt(4)" ::: "memory");
        compute(30);
        asm volatile("s_waitcnt vmcnt(0)" ::: "memory");
        compute(31);
        float acc[2][32];
#pragma unroll
        for (int j = 0; j < 2; ++j)
#pragma unroll
            for (int d = 0; d < 4; ++d) {
                acc[j][8 * d + 0] = 16.0f * (float)accp[j][4 * d + 0][0]; acc[j][8 * d + 2] = 16.0f * (float)accp[j][4 * d + 0][1];
                acc[j][8 * d + 4] = 16.0f * (float)accp[j][4 * d + 1][0]; acc[j][8 * d + 6] = 16.0f * (float)accp[j][4 * d + 1][1];
                acc[j][8 * d + 1] = 16.0f * (float)accp[j][4 * d + 2][0]; acc[j][8 * d + 3] = 16.0f * (float)accp[j][4 * d + 2][1];
                acc[j][8 * d + 5] = 16.0f * (float)accp[j][4 * d + 3][0]; acc[j][8 * d + 7] = 16.0f * (float)accp[j][4 * d + 3][1];
            }
        const bool up2 = (sub & 2) != 0, up1 = (sub & 1) != 0;
        float wsum = wsg + __shfl_xor(wsg, 32);
        wsum += __shfl_xor(wsum, 16);
        float r1[32];
#pragma unroll
        for (int c = 0; c < 32; ++c) r1[c] = (up2 ? acc[1][c] : acc[0][c]) + __shfl_xor(up2 ? acc[0][c] : acc[1][c], 32);
        float r2[16];
#pragma unroll
        for (int c = 0; c < 16; ++c) r2[c] = (up1 ? r1[16 + c] : r1[c]) + __shfl_xor(up1 ? r1[c] : r1[16 + c], 16);
        const int col0 = (16 * (sub >> 1) + li) * 32 + (sub & 1) * 16;
        float ss = 0.f;
        float* xrow = X + (size_t)t * 1024 + col0;
#pragma unroll
        for (int c4 = 0; c4 < 4; ++c4) {
            const f32x4 a = *(const f32x4*)(xrow + c4 * 4);
#pragma unroll
            for (int c = 0; c < 4; ++c) { r2[c4 * 4 + c] = r2[c4 * 4 + c] - 7.5f * wsum + a[c]; ss += r2[c4 * 4 + c] * r2[c4 * 4 + c]; }
        }
        ss = wave_sum(ss);
        const float rstd = rsqrtf(ss * (1.0f / D) + EPS);
        const float* gp = gnext + col0;
        if (final_out) {
#pragma unroll
            for (int c4 = 0; c4 < 4; ++c4) {
                const f32x4 g = *(const f32x4*)(gp + c4 * 4);
                *(f32x4*)(xrow + c4 * 4) = (f32x4){r2[c4 * 4] * rstd * g[0], r2[c4 * 4 + 1] * rstd * g[1], r2[c4 * 4 + 2] * rstd * g[2], r2[c4 * 4 + 3] * rstd * g[3]};
            }
        } else {
            u32x4 o[2];
#pragma unroll
            for (int c4 = 0; c4 < 4; ++c4) {
                const f32x4 g = *(const f32x4*)(gp + c4 * 4);
                *(f32x4*)(xrow + c4 * 4) = (f32x4){r2[c4 * 4], r2[c4 * 4 + 1], r2[c4 * 4 + 2], r2[c4 * 4 + 3]};
                o[c4 >> 1][(c4 & 1) * 2] = pack2(r2[c4 * 4] * rstd * g[0], r2[c4 * 4 + 1] * rstd * g[1]);
                o[c4 >> 1][(c4 & 1) * 2 + 1] = pack2(r2[c4 * 4 + 2] * rstd * g[2], r2[c4 * 4 + 3] * rstd * g[3]);
            }
            bf16_t* hp = H + (size_t)t * 1024 + col0;
            *(u32x4*)hp = o[0]; *(u32x4*)(hp + 8) = o[1];
        }
    }
}

__device__ __forceinline__ void spatial_fast(const Params& p, char* smem) {
    bf16_t* U = (bf16_t*)(p.ws + OFF_REGION); const bf16_t* VT = U + (size_t)T * 2048; const float* SSQ = (const float*)(p.ws + OFF_SSQ);
    const int tid_ = VTID;
    for (int task = VBID; task < 2048; task += VGRID) {
        const int chunk = task >> 3, g = task & 7;
        int lz = 0; asm volatile("" : "+v"(lz));
        const int tid = tid_ + lz, lane = tid & 63, wid = tid >> 6, wm = wid >> 1, wn = wid & 1, l15 = lane & 15, q4 = lane >> 4;
        float* rs = (float*)(smem + 16384);
        if (tid < 128) {
            const float* sp = SSQ + (size_t)(chunk * 128 + tid) * 32;
            float s = 0.f;
#pragma unroll
            for (int i = 0; i < 8; ++i) { const f32x4 v = *(const f32x4*)(sp + 4 * i); s += (v[0] + v[1]) + (v[2] + v[3]); }
            rs[tid] = rsqrtf(s * (1.0f / 2048.0f) + EPS);
        }
        __syncthreads();
#pragma unroll
        for (int i = 0; i < 8; ++i) {
            const int c = tid + 256 * i, row = c >> 4, ch16 = c & 15, ks = ch16 >> 3, ch = ch16 & 7, s0 = ch16 * 8;
            const float* wp = p.c_w_spatial + ((size_t)(g * 128 + row)) * 128 + s0;
            const f32x4 w0 = *(const f32x4*)wp, w1 = *(const f32x4*)(wp + 4);
            const f32x4 r0 = *(const f32x4*)(rs + s0), r1 = *(const f32x4*)(rs + s0 + 4);
            float v[8];
#pragma unroll
            for (int j = 0; j < 4; ++j) { v[j] = (s0 + j <= row) ? w0[j] * r0[j] : 0.f; v[4 + j] = (s0 + 4 + j <= row) ? w1[j] * r1[j] : 0.f; }
            *(uint4*)(smem + ks * 32768 + row * 128 + ((ch ^ (row & 7)) << 4)) = make_uint4(pack2(v[0], v[1]), pack2(v[2], v[3]), pack2(v[4], v[5]), pack2(v[6], v[7]));
        }
        __syncthreads();
#pragma unroll 1
        for (int nh = 0; nh < 2; ++nh) {
            const int chan0 = g * 256 + nh * 128;
#pragma unroll
            for (int i = 0; i < 8; ++i) {
                const int c = tid + 256 * i, row = c >> 4, ch16 = c & 15, ks = ch16 >> 3, ch = ch16 & 7;
                *(uint4*)(smem + ks * 32768 + 16384 + row * 128 + ((ch ^ (row & 7)) << 4)) = *(const uint4*)(VT + ((size_t)chunk * 2048 + chan0 + row) * 128 + ch16 * 8);
            }
            __syncthreads();
            f32x4 acc[4][4];
#pragma unroll
            for (int i = 0; i < 4; ++i)
#pragma unroll
                for (int j = 0; j < 4; ++j) acc[i][j] = (f32x4){0.f, 0.f, 0.f, 0.f};
#pragma unroll
            for (int kt = 0; kt < 2; ++kt) {
                if (kt == 1 && wm == 0) continue;
                const char* sa = smem + kt * 32768; const char* sb = sa + 16384;
#pragma unroll
                for (int ks = 0; ks < 2; ++ks) {
                    bf16x8 af[4], bfr[4];
                    const int ch = ks * 4 + q4;
#pragma unroll
                    for (int i = 0; i < 4; ++i) { const int row = wm * 64 + i * 16 + l15; af[i] = *(const bf16x8*)(sa + row * 128 + ((ch ^ (row & 7)) << 4)); }
#pragma unroll
                    for (int j = 0; j < 4; ++j) { const int row = wn * 64 + j * 16 + l15; bfr[j] = *(const bf16x8*)(sb + row * 128 + ((ch ^ (row & 7)) << 4)); }
#pragma unroll
                    for (int i = 0; i < 4; ++i)
#pragma unroll
                        for (int j = 0; j < 4; ++j) acc[i][j] = __builtin_amdgcn_mfma_f32_16x16x32_bf16(bfr[j], af[i], acc[i][j], 0, 0, 0);
                }
            }
            __syncthreads();
#pragma unroll
            for (int i = 0; i < 4; ++i) {
                const int m = wm * 64 + i * 16 + l15;
                const float bias = p.c_b_spatial[g * 128 + m];
#pragma unroll
                for (int j = 0; j < 4; ++j) {
                    const int chan = chan0 + wn * 64 + j * 16 + 4 * q4;
                    const f32x4 vn = *(const f32x4*)(p.c_v_norm + chan);
                    bf16_t* up = U + (size_t)(chunk * 128 + m) * 2048 + chan;
                    const uint2 uu = *(const uint2*)up;
                    uint2 o;
                    o.x = pack2(lo2f(uu.x) * (vn[0] * acc[i][j][0] + bias), hi2f(uu.x) * (vn[1] * acc[i][j][1] + bias));
                    o.y = pack2(lo2f(uu.y) * (vn[2] * acc[i][j][2] + bias), hi2f(uu.y) * (vn[3] * acc[i][j][3] + bias));
                    *(uint2*)up = o;
                }
            }
        }
    }
}

#define XB_TMO      128
#define XB_XCNT(j)  (256  + 64 * (j))
#define XB_XSUB(j)  (1280 + 64 * (j))
#define XB_XGEN(j)  (2304 + 64 * (j))
#define XB_TOP      3328
#define XB_TOPGEN   3392
#define XCD_BAR_WORDS 3456
#define XB_SPIN_CAP (1u << 22)
#define LAS __attribute__((address_space(3)))
__device__ __forceinline__ unsigned xb_ld(unsigned* p)              { return __hip_atomic_load(p, __ATOMIC_RELAXED, __HIP_MEMORY_SCOPE_AGENT); }
__device__ __forceinline__ unsigned xb_add(unsigned* p, unsigned v) { return __hip_atomic_fetch_add(p, v, __ATOMIC_RELAXED, __HIP_MEMORY_SCOPE_AGENT); }
__device__ __forceinline__ unsigned xb_xcc_id() { return (unsigned)__builtin_amdgcn_s_getreg((3 << 11) | 20) & 0xFu; }
#define XB_SPIN(cond, bar) do { unsigned _sp = 0; while (cond) { __builtin_amdgcn_s_sleep(1); \
    if ((++_sp & 255u) == 0u) { if (xb_ld(&(bar)[XB_TMO])) break; if (_sp > XB_SPIN_CAP) { atomicAdd(&(bar)[XB_TMO], 1u); break; } } } } while (0)
struct XcdBarrier { unsigned* bar; unsigned x; volatile LAS unsigned* st; };
__device__ __forceinline__ XcdBarrier xcd_barrier_post(unsigned* bar, volatile LAS unsigned* st) {
    XcdBarrier b; b.bar = bar; b.x = xb_xcc_id(); b.st = st;
    if (threadIdx.x == 0) (void)xb_add(&bar[XB_XCNT(b.x)], 1u);
    return b;
}
__device__ __forceinline__ void xcd_barrier_complete(unsigned* bar, unsigned x, unsigned& nloc, unsigned& nx) {
    const unsigned G = gridDim.x * gridDim.y * gridDim.z;
    unsigned sum, cnt, mine, sp = 0u;
    for (;;) {
        sum = 0u; cnt = 0u; mine = 0u;
#pragma unroll
        for (unsigned j = 0; j < 16; ++j) { const unsigned c = xb_ld(&bar[XB_XCNT(j)]); sum += c; cnt += (c > 0u) ? 1u : 0u; mine = (j == x) ? c : mine; }
        if (sum == G) break;
        __builtin_amdgcn_s_sleep(1);
        if ((++sp & 255u) == 0u) { if (xb_ld(&bar[XB_TMO])) break; if (sp > XB_SPIN_CAP) { atomicAdd(&bar[XB_TMO], 1u); break; } }
    }
    nloc = mine > 0u ? mine : 1u; nx = cnt > 0u ? cnt : 1u;
}
__device__ __forceinline__ void xcd_barrier(const XcdBarrier& b) {
    asm volatile("s_waitcnt vmcnt(0)" ::: "memory");
    __syncthreads();
    if (threadIdx.x == 0) {
        unsigned* bar = b.bar;
        __builtin_amdgcn_s_waitcnt(0);
        unsigned nloc = b.st[0], nx = b.st[1];
        if (nloc == 0u) { xcd_barrier_complete(bar, b.x, nloc, nx); b.st[0] = nloc; b.st[1] = nx; }
        const unsigned old = xb_add(&bar[XB_XSUB(b.x)], 1u);
        const unsigned gen = old / nloc;
        if (old + 1u == (gen + 1u) * nloc) {
            __builtin_amdgcn_fence(__ATOMIC_RELEASE, "agent");
            asm volatile("s_waitcnt vmcnt(0)" ::: "memory");
            const unsigned og = xb_add(&bar[XB_TOP], 1u);
            const unsigned tg = og / nx;
            if (og + 1u == (tg + 1u) * nx) xb_add(&bar[XB_TOPGEN], 1u);
            else XB_SPIN(xb_ld(&bar[XB_TOPGEN]) == tg, bar);
            __builtin_amdgcn_fence(__ATOMIC_ACQUIRE, "agent");
            xb_add(&bar[XB_XGEN(b.x)], 1u);
            asm volatile("s_waitcnt vmcnt(0)" ::: "memory");
        } else {
            XB_SPIN(xb_ld(&bar[XB_XGEN(b.x)]) == gen, bar);
            __builtin_amdgcn_fence(__ATOMIC_ACQUIRE, "agent");
            asm volatile("s_waitcnt vmcnt(0)" ::: "memory");
        }
    }
    __syncthreads();
}

constexpr int NPHASE = 12;
__global__ void __launch_bounds__(512, 2) mega(Params p, int ph_lo, int ph_hi) {
    extern __shared__ __attribute__((aligned(16))) char smem_phys[];
    uint4& xb_words = *(uint4*)(smem_phys + kDynLds - 16);
    if (threadIdx.x == 0) xb_words = make_uint4(0u, 0u, 0u, 0u);
    __syncthreads();
    const XcdBarrier xbar = xcd_barrier_post((unsigned*)(p.ws + OFF_BAR), (volatile LAS unsigned*)&xb_words);
    char* smem = smem_phys + (threadIdx.x >> 8) * 65536;
    bf16_t* Rg = (bf16_t*)(p.ws + OFF_REGION);
    bf16_t* Hb = (bf16_t*)(p.ws + OFF_H);
#define PHASE(k, ...) if (ph_lo <= (k) && (k) < ph_hi) { __VA_ARGS__; if ((k) + 1 < ph_hi) xcd_barrier(xbar); }
    unsigned* sbctr = (unsigned*)(p.ws + OFF_BAR + 14336);
    PHASE(0,
        transpose_convert<true>(p.ab_w_in, (bf16_t*)(p.ws + OFF_WT_IN), 1024, AB_IN, AB_IN_PAD, smem);
        rmsnorm_rows(p.x, p.norm_mix, Hb))
    PHASE(1, phase_gemm_in8(p, smem_phys))
    PHASE(2, gla_prep(p, smem))
    PHASE(3, gla_scan(p, smem); sb_fast(p, smem_phys + 98304, sbctr);
        quantize_tables_static(p, 64);
        transpose_convert(p.ab_w_out, (bf16_t*)(p.ws + OFF_WT_OUT), 1024, 1024, 1024, smem, 64);
        transpose_convert(p.c_w_in, (bf16_t*)(p.ws + OFF_WT_CIN), 1024, 4096, 4096, smem, 64);
        transpose_convert(p.c_w_out, (bf16_t*)(p.ws + OFF_WT_COUT), 2048, 1024, 1024, smem, 64);
        fold_query_weights(p, 64))
    PHASE(4, phase_gemm_resid8(Rg + R_QSB, Rg + R_GG, 512, 512, (const bf16_t*)(p.ws + OFF_WT_OUT), 1024, p.x, p.out, Hb, (float*)(p.ws + OFF_SSQ), p.norm_ffn, smem_phys))
    PHASE(5, phase_select8(p, 0, smem_phys))
    PHASE(6, peer_gather(p, 0, p.norm_mix + 1024, false, smem_phys))
    PHASE(7, phase_gemm_cin8(p, smem_phys))
    PHASE(8, spatial_fast(p, smem))
    PHASE(9, phase_gemm_resid8(Rg, Rg, 2048, 2048, (const bf16_t*)(p.ws + OFF_WT_COUT), 2048, p.out, p.out, Hb, (float*)(p.ws + OFF_SSQ), p.norm_ffn + 1024, smem_phys))
    PHASE(10, phase_select8(p, 1, smem_phys))
    PHASE(11, peer_gather(p, 1, p.final_norm, true, smem_phys))
}

extern "C" void kernel_launch(void* const* d_in, const int* in_sizes, int n_in, void* d_out, int out_size, void* d_ws, size_t ws_size, hipStream_t stream) {
    static int grid_blocks = 0;
    if (!grid_blocks) {
        int dev = 0, cus = 0, per_cu = 0;
        hipGetDevice(&dev);
        hipDeviceGetAttribute(&cus, hipDeviceAttributeMultiprocessorCount, dev);
        hipFuncSetAttribute((const void*)mega, hipFuncAttributeMaxDynamicSharedMemorySize, kDynLds);
        hipOccupancyMaxActiveBlocksPerMultiprocessor(&per_cu, mega, 512, kDynLds);
        if (per_cu < 1) per_cu = 1;
        if (per_cu > 1) per_cu = 1;
        grid_blocks = cus * per_cu;
        if (n_in != 18 || ws_size < WS_END) fprintf(stderr, "kernel_launch: unexpected n_in %d or ws_size %zu < %zu\n", n_in, ws_size, (size_t)WS_END);
    }
    Params p{};
    p.x = (const float*)d_in[0]; p.norm_mix = (const float*)d_in[1]; p.norm_ffn = (const float*)d_in[2]; p.ab_w_in = (const float*)d_in[3];
    p.ab_w_alpha2 = (const float*)d_in[4]; p.ab_b_alpha2 = (const float*)d_in[5]; p.ab_gla_norm = (const float*)d_in[6]; p.ab_w_out = (const float*)d_in[7];
    p.c_w_in = (const float*)d_in[8]; p.c_v_norm = (const float*)d_in[9]; p.c_w_spatial = (const float*)d_in[10]; p.c_b_spatial = (const float*)d_in[11];
    p.c_w_out = (const float*)d_in[12]; p.peer_w_q = (const float*)d_in[13]; p.peer_subkeys = (const float*)d_in[14]; p.peer_u = (const float*)d_in[15];
    p.peer_v = (const float*)d_in[16]; p.final_norm = (const float*)d_in[17];
    p.out = (float*)d_out; p.ws = (unsigned char*)d_ws;
    (void)hipMemsetAsync((char*)d_ws + OFF_BAR, 0, 16384, stream);
#if ONE_LAUNCH
    int lo = 0, hi = NPHASE;
    void* args[] = {&p, &lo, &hi};
    hipError_t e = hipLaunchCooperativeKernel((void*)mega, dim3(grid_blocks), dim3(512), args, kDynLds, stream);
    if (e != hipSuccess) fprintf(stderr, "cooperative launch failed: %s (grid %d)\n", hipGetErrorString(e), grid_blocks);
#else
    for (int ph = 0; ph < NPHASE; ++ph) hipLaunchKernelGGL(mega, dim3(grid_blocks), dim3(512), kDynLds, stream, p, ph, ph + 1);
#endif
}
```

```cpp
#include <hip/hip_runtime.h>
#include <hip/hip_cooperative_groups.h>
#include <cstdio>
#include <cstdint>
namespace cg = cooperative_groups;

#ifndef ONE_LAUNCH
#define ONE_LAUNCH 1
#endif


#define VTID ((int)(threadIdx.x & 255))
#define VBID ((int)(blockIdx.x * 2 + (threadIdx.x >> 8)))
#define VGRID ((int)(gridDim.x * 2))
typedef unsigned short bf16_t;
typedef short bf16x8 __attribute__((ext_vector_type(8)));
typedef float f32x4 __attribute__((ext_vector_type(4)));
typedef unsigned u32x4 __attribute__((ext_vector_type(4)));
typedef __bf16 bf16x2_t __attribute__((ext_vector_type(2)));

constexpr int T = 32768, D = 1024, SEQ = 2048, NB = 16;
constexpr int AB_IN = 3088, AB_IN_PAD = 3200;
constexpr float EPS = 1e-6f;
constexpr int NEXP = 16384;
constexpr int kDynLds = 163840;

constexpr size_t SZ_WT_IN = (size_t)AB_IN_PAD * 1024 * 2;
constexpr size_t SZ_WT_OUT = (size_t)1024 * 1024 * 2;
constexpr size_t SZ_WT_CIN = (size_t)4096 * 1024 * 2;
constexpr size_t SZ_WT_COUT = (size_t)1024 * 2048 * 2;
constexpr size_t SZ_WT_Q = (size_t)2 * 2048 * 1024 * 2;
constexpr size_t SZ_SK = (size_t)2 * 8 * 2 * 128 * 128 * 2;
constexpr size_t SZ_TAB = (size_t)2 * NEXP * 1024;
constexpr size_t SZ_TSC = (size_t)2 * NEXP * 4;
constexpr size_t OFF_WT_IN = 0;
constexpr size_t OFF_WT_OUT = OFF_WT_IN + SZ_WT_IN;
constexpr size_t OFF_WT_CIN = OFF_WT_OUT + SZ_WT_OUT;
constexpr size_t OFF_WT_COUT = OFF_WT_CIN + SZ_WT_CIN;
constexpr size_t OFF_WT_Q = OFF_WT_COUT + SZ_WT_COUT;
constexpr size_t OFF_SK = OFF_WT_Q + SZ_WT_Q;
constexpr size_t OFF_UT = OFF_SK + SZ_SK;
constexpr size_t OFF_VT = OFF_UT + SZ_TAB;
constexpr size_t OFF_USC = OFF_VT + SZ_TAB;
constexpr size_t OFF_VSC = OFF_USC + SZ_TSC;
constexpr size_t OFF_H = OFF_VSC + SZ_TSC;
constexpr size_t OFF_IDX = OFF_H + (size_t)T * 1024 * 2;
constexpr size_t OFF_GATE = OFF_IDX + (size_t)T * 128 * 4;
constexpr size_t OFF_SSQ = OFF_GATE + (size_t)T * 128 * 4;
constexpr size_t OFF_REGION = OFF_SSQ + (size_t)T * 32 * 4;
constexpr size_t SZ_REGION = (size_t)256 << 20;
constexpr size_t OFF_BAR = OFF_REGION + SZ_REGION;
constexpr size_t WS_END = OFF_BAR + 16384;
constexpr size_t R_QSB = 0;
constexpr size_t R_KSB = R_QSB + (size_t)T * 512;
constexpr size_t R_VTSB = R_KSB + (size_t)T * 512;
constexpr size_t R_QG = R_VTSB + (size_t)T * 512;
constexpr size_t R_KG = R_QG + (size_t)T * 256;
constexpr size_t R_VTG = R_KG + (size_t)T * 256;
constexpr size_t R_GG = R_VTG + (size_t)T * 512;
constexpr size_t R_ALR = R_GG + (size_t)T * 512;
constexpr size_t R_KOT = R_ALR + (size_t)T * 32;
constexpr size_t R_DEC = R_KOT + (size_t)T * 256;

struct Params {
    const float* x; const float* norm_mix; const float* norm_ffn; const float* ab_w_in; const float* ab_w_alpha2; const float* ab_b_alpha2;
    const float* ab_gla_norm; const float* ab_w_out; const float* c_w_in; const float* c_v_norm; const float* c_w_spatial; const float* c_b_spatial;
    const float* c_w_out; const float* peer_w_q; const float* peer_subkeys; const float* peer_u; const float* peer_v; const float* final_norm;
    float* out; unsigned char* ws;
};

__device__ __forceinline__ float bf2f(bf16_t v) { return __uint_as_float(((unsigned)v) << 16); }
__device__ __forceinline__ bf16_t f2bf(float f) { unsigned u = __float_as_uint(f); u += 0x7fffu + ((u >> 16) & 1u); return (bf16_t)(u >> 16); }
__device__ __forceinline__ unsigned pack2(float lo, float hi) { return (unsigned)f2bf(lo) | ((unsigned)f2bf(hi) << 16); }
__device__ __forceinline__ float lo2f(unsigned w) { return __uint_as_float(w << 16); }
__device__ __forceinline__ float hi2f(unsigned w) { return __uint_as_float(w & 0xffff0000u); }
__device__ __forceinline__ float dot2(unsigned a, unsigned b, float acc) { return __builtin_amdgcn_fdot2_f32_bf16(__builtin_bit_cast(bf16x2_t, a), __builtin_bit_cast(bf16x2_t, b), acc, false); }
__device__ __forceinline__ float gelu_exact(float v) {
    const float av = fabsf(v);
    const float t = __builtin_amdgcn_rcpf(av * 0.2316418882f + 1.0f);
    float q = t * 0.5307027145f - 0.7265760135f; q = q * t + 0.7107068705f; q = q * t - 0.142248368f; q = q * t + 0.127414796f; q = q * t;
    const float e = __builtin_amdgcn_exp2f(v * v * -0.72134752044f);
    const float m = v * (q * e);
    return v < 0.f ? m : v - m;
}
__device__ __forceinline__ float row16_sum(float v) {
    v += __builtin_bit_cast(float, __builtin_amdgcn_update_dpp(0, __builtin_bit_cast(int, v), 0x128, 0xf, 0xf, false));
    v += __builtin_bit_cast(float, __builtin_amdgcn_update_dpp(0, __builtin_bit_cast(int, v), 0x124, 0xf, 0xf, false));
    v += __builtin_bit_cast(float, __builtin_amdgcn_update_dpp(0, __builtin_bit_cast(int, v), 0x122, 0xf, 0xf, false));
    v += __builtin_bit_cast(float, __builtin_amdgcn_update_dpp(0, __builtin_bit_cast(int, v), 0x121, 0xf, 0xf, false));
    return v;
}
__device__ __forceinline__ float wave_sum(float v) {
#pragma unroll
    for (int o = 32; o >= 1; o >>= 1) v += __shfl_xor(v, o);
    return v;
}

template <bool PERM_IN = false>
__device__ __forceinline__ void transpose_convert(const float* __restrict__ W, bf16_t* __restrict__ Wt, int K, int N, int Npad, char* smem, int vb0 = 0) {
    float* tile = (float*)smem;
    const int tk = K / 64, tn = Npad / 64, ntile = tk * tn;
    const int tid = VTID;
    if (VBID < vb0) return;
    for (int tl = VBID - vb0; tl < ntile; tl += VGRID - vb0) {
        const int k0 = (tl % tk) * 64, n0 = (tl / tk) * 64;
        const int c = tid & 63, r0 = tid >> 6;
        int nd = n0;
        if (PERM_IN) { if (n0 >= 1024 && n0 < 1536) nd = n0 + 1024; else if (n0 >= 1536 && n0 < 2048) nd = n0 - 512; else if (n0 >= 2048 && n0 < 2560) nd = n0 + 512; else if (n0 >= 2560 && n0 < 3072) nd = n0 - 1024; }
#pragma unroll
        for (int i = 0; i < 16; ++i) {
            const int r = r0 + 4 * i;
            const float v = (n0 + c < N) ? W[(size_t)(k0 + r) * N + n0 + c] : 0.f;
            tile[c * 65 + r] = v;
        }
        __syncthreads();
#pragma unroll
        for (int i = 0; i < 16; ++i) {
            const int n = r0 + 4 * i;
            Wt[(size_t)(nd + n) * K + k0 + c] = f2bf(tile[n * 65 + c]);
        }
        __syncthreads();
    }
}
__device__ __forceinline__ void convert_flat(const float* __restrict__ src, bf16_t* __restrict__ dst, size_t n) {
    const size_t nv = n / 8;
    for (size_t i = (size_t)VBID * 256 + VTID; i < nv; i += (size_t)VGRID * 256) {
        const float4 a = ((const float4*)src)[2 * i], b = ((const float4*)src)[2 * i + 1];
        uint4 o; o.x = pack2(a.x, a.y); o.y = pack2(a.z, a.w); o.z = pack2(b.x, b.y); o.w = pack2(b.z, b.w);
        ((uint4*)dst)[i] = o;
    }
}
__device__ __forceinline__ void quantize_tables_static(const Params& p, int vb0 = 0) {
    const int lane = VTID & 63, wid = VTID >> 6;
    if (VBID < vb0) return;
    for (unsigned task = (unsigned)(VBID - vb0); task < 512u; task += (unsigned)(VGRID - vb0)) {
        const bool isv = task >= 256u;
        const int r0 = (int)(task & 255u) * 128 + wid * 32;
        const float* src = isv ? p.peer_v : p.peer_u;
        unsigned char* recs = p.ws + OFF_UT;
        _Float16* sct = (_Float16*)(p.ws + OFF_USC);
        for (int rr = 0; rr < 32; ++rr) {
            const int r = r0 + rr;
            const float* xr = src + (size_t)r * 1024 + lane * 16;
            f32x4 v[4]; float aml = 0.f;
#pragma unroll
            for (int i = 0; i < 4; ++i) {
                v[i] = *(const f32x4*)(xr + i * 4);
                aml = fmaxf(aml, fmaxf(fmaxf(fabsf(v[i][0]), fabsf(v[i][1])), fmaxf(fabsf(v[i][2]), fabsf(v[i][3]))));
            }
#pragma unroll
            for (int o = 32; o >= 1; o >>= 1) aml = fmaxf(aml, __shfl_xor(aml, o));
            float ssq = 0.f;
#pragma unroll
            for (int i = 0; i < 4; ++i) ssq += (v[i][0] * v[i][0] + v[i][1] * v[i][1]) + (v[i][2] * v[i][2] + v[i][3] * v[i][3]);
            ssq = wave_sum(ssq);
            const float gmax = aml * (1.002f / 7.5f);
            const _Float16 hs = (_Float16)fminf(fmaxf(0.34f * sqrtf(ssq * (1.0f / 1024.0f)), 0.5f * gmax), gmax);
            const float gs_ = (float)hs, gi_ = gs_ > 0.f ? 1.0f / gs_ : 0.f;
            unsigned wd[2]; const int sgn = isv ? 0 : 8;
#pragma unroll
            for (int dd = 0; dd < 2; ++dd) {
                unsigned wv = 0;
#pragma unroll
                for (int b = 0; b < 4; ++b) {
                    const int qa = min(15, max(0, __float2int_rn(v[2 * dd][b] * gi_ + 7.5f)));
                    const int qb = min(15, max(0, __float2int_rn(v[2 * dd + 1][b] * gi_ + 7.5f)));
                    wv |= ((unsigned)(qa ^ sgn) | ((unsigned)(qb ^ sgn) << 4)) << (8 * b);
                }
                wd[dd] = wv;
            }
            unsigned char* rec = recs + (size_t)r * 1024;
            *(uint2*)(rec + (isv ? 512 : 0) + lane * 8) = make_uint2(wd[0], wd[1]);
            if (lane == 0) sct[(size_t)r * 2 + (isv ? 1 : 0)] = (_Float16)gs_;
        }
    }
}
__device__ __forceinline__ void rmsnorm_rows(const float* __restrict__ X, const float* __restrict__ g, bf16_t* __restrict__ Hout) {
    const int lane = VTID & 63, wid = VTID >> 6;
    const int gw = VBID * 4 + wid, nw = VGRID * 4;
    for (int t = gw; t < T; t += nw) {
        const float* xr = X + (size_t)t * D;
        float4 v[4]; float ss = 0.f;
#pragma unroll
        for (int i = 0; i < 4; ++i) { v[i] = *(const float4*)(xr + i * 256 + lane * 4); ss += v[i].x * v[i].x + v[i].y * v[i].y + v[i].z * v[i].z + v[i].w * v[i].w; }
        ss = wave_sum(ss);
        const float rstd = rsqrtf(ss * (1.0f / D) + EPS);
#pragma unroll
        for (int i = 0; i < 4; ++i) {
            const float4 gg = *(const float4*)(g + i * 256 + lane * 4);
            uint2 o; o.x = pack2(v[i].x * rstd * gg.x, v[i].y * rstd * gg.y); o.y = pack2(v[i].z * rstd * gg.z, v[i].w * rstd * gg.w);
            *(uint2*)(Hout + (size_t)t * D + i * 256 + lane * 4) = o;
        }
    }
}

template <int MODE>
__device__ __forceinline__ void gemm_mainloop(const bf16_t* __restrict__ A0, const bf16_t* __restrict__ A1, int lda, int ksplit,
                                              const bf16_t* __restrict__ Bt, int K, int m0, int n0, f32x4 (&acc)[4][4], char* smem) {
    const int tid = VTID, lane = tid & 63, wid = tid >> 6, wm = wid >> 1, wn = wid & 1;
    const int lrow = tid >> 3, lch = tid & 7;
#pragma unroll
    for (int i = 0; i < 4; ++i)
#pragma unroll
        for (int j = 0; j < 4; ++j) acc[i][j] = (f32x4){0.f, 0.f, 0.f, 0.f};
    const int nk = K / 64;
    unsigned aoff[4], boff[4];
    {
        const int rr = lane >> 3, cc = ((lane & 7) ^ rr) * 8;
#pragma unroll
        for (int i = 0; i < 4; ++i) {
            aoff[i] = (unsigned)(((m0 + 32 * wid + 8 * i + rr) * lda + cc) * 2);
            boff[i] = (unsigned)(((n0 + 32 * wid + 8 * i + rr) * K + cc) * 2);
        }
    }
    auto stage = [&](int kt, int buf) {
        const int kb = kt * 64;
        const char* Ab; const char* Bb = (const char*)(Bt + kb);
        if (kb < ksplit) Ab = (const char*)(A0 + kb); else Ab = (const char*)(A1 + (kb - ksplit));
        char* sa = smem + buf * 32768 + wid * 4096 + lane * 16; char* sb = sa + 16384;
#pragma unroll
        for (int i = 0; i < 4; ++i) __builtin_amdgcn_global_load_lds((const unsigned*)(Ab + aoff[i]), (unsigned*)(sa + i * 1024), 16, 0, 0);
#pragma unroll
        for (int i = 0; i < 4; ++i) __builtin_amdgcn_global_load_lds((const unsigned*)(Bb + boff[i]), (unsigned*)(sb + i * 1024), 16, 0, 0);
    };
    auto compute = [&](int buf) {
        const char* sa = smem + buf * 32768; const char* sb = sa + 16384;
#pragma unroll
        for (int ks = 0; ks < 2; ++ks) {
            bf16x8 af[4], bfr[4];
            const int ch = ks * 4 + (lane >> 4);
#pragma unroll
            for (int i = 0; i < 4; ++i) { const int row = wm * 64 + i * 16 + (lane & 15); af[i] = *(const bf16x8*)(sa + row * 128 + ((ch ^ (row & 7)) << 4)); }
#pragma unroll
            for (int j = 0; j < 4; ++j) { const int row = wn * 64 + j * 16 + (lane & 15); bfr[j] = *(const bf16x8*)(sb + row * 128 + ((ch ^ (row & 7)) << 4)); }
            __builtin_amdgcn_s_setprio(1);
#pragma unroll
            for (int i = 0; i < 4; ++i)
#pragma unroll
                for (int j = 0; j < 4; ++j) {
                    if (MODE == 0) acc[i][j] = __builtin_amdgcn_mfma_f32_16x16x32_bf16(bfr[j], af[i], acc[i][j], 0, 0, 0);
                    else acc[i][j] = __builtin_amdgcn_mfma_f32_16x16x32_bf16(af[i], bfr[j], acc[i][j], 0, 0, 0);
                }
            __builtin_amdgcn_s_setprio(0);
        }
    };
    stage(0, 0);
    asm volatile("s_waitcnt vmcnt(0)" ::: "memory");
    __syncthreads();
    for (int kt = 0; kt < nk; ++kt) {
        if (kt + 1 < nk) stage(kt + 1, (kt + 1) & 1);
        compute(kt & 1);
        asm volatile("s_waitcnt vmcnt(0)" ::: "memory");
        __syncthreads();
    }
}
template <int MODE>
__device__ __forceinline__ void gemm_mainloop256(const bf16_t* __restrict__ A0, const bf16_t* __restrict__ A1, int lda, int ksplit,
                                                 const bf16_t* __restrict__ Bt, int K, int m0, int n0, f32x4 (&acc)[8][4], char* smem) {
    const int tid = VTID, lane = tid & 63, wid = tid >> 6, wm = wid >> 1, wn = wid & 1;
#pragma unroll
    for (int i = 0; i < 8; ++i)
#pragma unroll
        for (int j = 0; j < 4; ++j) acc[i][j] = (f32x4){0.f, 0.f, 0.f, 0.f};
    const int nk = K / 32;
    unsigned aoff[4], boff[2];
    {
        const int rr = lane >> 2, cc = ((lane & 3) ^ (3 * ((lane >> 5) & 1))) * 8;
#pragma unroll
        for (int i = 0; i < 4; ++i) aoff[i] = (unsigned)(((m0 + 64 * wid + 16 * i + rr) * lda + cc) * 2);
#pragma unroll
        for (int i = 0; i < 2; ++i) boff[i] = (unsigned)(((n0 + 32 * wid + 16 * i + rr) * K + cc) * 2);
    }
    auto stage = [&](int kt, int buf) {
        const int kb = kt * 32;
        const char* Ab; const char* Bb = (const char*)(Bt + kb);
        if (kb < ksplit) Ab = (const char*)(A0 + kb); else Ab = (const char*)(A1 + (kb - ksplit));
        char* sa = smem + buf * 24576 + wid * 4096 + lane * 16; char* sb = smem + buf * 24576 + 16384 + wid * 2048 + lane * 16;
#pragma unroll
        for (int i = 0; i < 4; ++i) __builtin_amdgcn_global_load_lds((const unsigned*)(Ab + aoff[i]), (unsigned*)(sa + i * 1024), 16, 0, 0);
#pragma unroll
        for (int i = 0; i < 2; ++i) __builtin_amdgcn_global_load_lds((const unsigned*)(Bb + boff[i]), (unsigned*)(sb + i * 1024), 16, 0, 0);
    };
    const int fpos = (((lane >> 4) ^ (3 * ((lane >> 3) & 1))) << 4) + (lane & 15) * 64;
    auto compute = [&](int buf) {
        const char* sa = smem + buf * 24576 + wm * 8192 + fpos; const char* sb = smem + buf * 24576 + 16384 + wn * 4096 + fpos;
        bf16x8 af[8], bfr[4];
#pragma unroll
        for (int i = 0; i < 8; ++i) af[i] = *(const bf16x8*)(sa + i * 1024);
#pragma unroll
        for (int j = 0; j < 4; ++j) bfr[j] = *(const bf16x8*)(sb + j * 1024);
        __builtin_amdgcn_s_setprio(1);
#pragma unroll
        for (int i = 0; i < 8; ++i)
#pragma unroll
            for (int j = 0; j < 4; ++j) {
                if (MODE == 0) acc[i][j] = __builtin_amdgcn_mfma_f32_16x16x32_bf16(bfr[j], af[i], acc[i][j], 0, 0, 0);
                else acc[i][j] = __builtin_amdgcn_mfma_f32_16x16x32_bf16(af[i], bfr[j], acc[i][j], 0, 0, 0);
            }
        __builtin_amdgcn_s_setprio(0);
    };
    stage(0, 0);
    asm volatile("s_waitcnt vmcnt(0)" ::: "memory");
    __syncthreads();
    for (int kt = 0; kt < nk; ++kt) {
        if (kt + 1 < nk) stage(kt + 1, (kt + 1) & 1);
        compute(kt & 1);
        asm volatile("s_waitcnt vmcnt(0)" ::: "memory");
        __syncthreads();
    }
}
__device__ __forceinline__ bool tile_sched(int it, int MT, int NT, int& mt, int& nt) {
    const int xg = blockIdx.x & 7, xi = (int)(blockIdx.x >> 3) * 2 + (int)(threadIdx.x >> 8), nper = (int)(gridDim.x >> 3) * 2;
    const int li = xi + nper * it;
    if (li >= (MT >> 3) * NT) return false;
    const int band = li / (8 * NT), r = li - band * 8 * NT;
    nt = r >> 3; mt = xg * (MT >> 3) + band * 8 + (r & 7);
    return true;
}
__device__ __forceinline__ void store_bf16x4(bf16_t* p, f32x4 v) { uint2 o; o.x = pack2(v[0], v[1]); o.y = pack2(v[2], v[3]); *(uint2*)p = o; }

#define G8_LAS __attribute__((address_space(3)))
namespace g8 {
constexpr int BM = 256, BK = 64, HALF = 128, HTB = HALF * BK * 2, NXCD = 8, WGM = 8;
__device__ __forceinline__ int lds_byte(int r, int c) { const int st = (r >> 4) * 2 + (c >> 5), rr = r & 15, cc = c & 31, ob = rr * 64 + cc * 2; return st * 1024 + (ob ^ (((ob >> 9) & 1) << 5)); }
__device__ __forceinline__ void stage_rc(int b, int& R, int& C) { const int st = b / 1024, sb = b % 1024, swz = sb ^ (((sb >> 9) & 1) << 5); R = (st >> 1) * 16 + swz / 64; C = (st & 1) * 32 + (swz % 64) / 2; }
__device__ __forceinline__ int perm32(int rho) { const int n = rho >> 4, i = rho & 15; return 8 * (i >> 2) + 4 * n + (i & 3); }
struct Unit { int pm, pn; };
struct Gemm { const bf16_t* A0; const bf16_t* A1; int lda, ksplit; const bf16_t* Bt; int M, N, K; };
struct StaticOrder {
    int nM, nN, nwg, G, c;
    __device__ __forceinline__ void init(int M, int N, int G_, int c_) { nM = M / BM; nN = N / BM; nwg = nM * nN; G = G_; c = c_; }
    __device__ __forceinline__ bool next(int i, Unit& u) const {
        const int L = i * G + c; if (L >= nwg) return false;
        int wgid = L; { const int q = nwg / NXCD, r = nwg % NXCD, xcd = wgid % NXCD, off = wgid / NXCD; wgid = (xcd < r ? xcd * (q + 1) : r * (q + 1) + (xcd - r) * q) + off; }
        const int nig = WGM * nN, gid = wgid / nig, fm = gid * WGM, gsz = (nM - fm) < WGM ? (nM - fm) : WGM;
        u.pm = fm + ((wgid % nig) % gsz); u.pn = (wgid % nig) / gsz; return true;
    }
};
template <class Epi>
__device__ __forceinline__ void gemm_phase(G8_LAS unsigned char* lds, const Gemm g, const StaticOrder& S, const Epi& E) {
    const int tid = threadIdx.x, wid = __builtin_amdgcn_readfirstlane(tid >> 6), lane = tid & 63, wr = wid >> 2, wc = wid & 3, fr = lane & 15, fq = lane >> 4;
    const int K = g.K, nt = K / BK, lda = g.lda;
    unsigned voffA[2], voffB[2];
#pragma unroll
    for (int i = 0; i < 2; ++i) { int R, C; stage_rc(tid * 16 + i * 8192, R, C); const int Rb = (R & ~31) + perm32(R & 31);
        voffA[i] = (unsigned)(R * lda + C) * 2u; voffB[i] = (unsigned)(Rb * K + C) * 2u; }
    const size_t hstepA = (size_t)HALF * lda * 2, hstepB = (size_t)HALF * K * 2;
    const unsigned ldsw = (unsigned)wid * 1024u;
    const int aoff = lds_byte(wr * 64 + fr, fq * 8), boff = lds_byte(wc * 32 + fr, fq * 8);
    auto aptr = [&](int pm, int kt) -> const char* { const int kb = kt * BK; const bf16_t* b = kb < g.ksplit ? g.A0 + kb : g.A1 + (kb - g.ksplit); return (const char*)b + (size_t)pm * 2 * hstepA; };
    auto bptr = [&](int pn, int kt) -> const char* { return (const char*)(g.Bt + kt * BK) + (size_t)pn * 2 * hstepB; };
#define G8_SA(b, h) (((b) * 2 + (h)) * HTB)
#define G8_SB(b, h) ((4 + (b) * 2 + (h)) * HTB)
#define G8_STAGE(bufoff, gbase, voff) do { _Pragma("unroll") for (int _i = 0; _i < 2; ++_i) \
        __builtin_amdgcn_global_load_lds((const unsigned*)((const char*)(gbase) + (voff)[_i]), (G8_LAS unsigned*)(lds + (bufoff) + ldsw + _i * 8192), 16, 0, 0); } while (0)
#define G8_LDA(dst, b, h) do { _Pragma("unroll") for (int m = 0; m < 4; ++m) _Pragma("unroll") for (int k = 0; k < 2; ++k) dst[m][k] = *(const G8_LAS bf16x8*)(lds + G8_SA(b, h) + aoff + m * 2048 + k * 1024); } while (0)
#define G8_LDB(dst, b, h) do { _Pragma("unroll") for (int n = 0; n < 2; ++n) _Pragma("unroll") for (int k = 0; k < 2; ++k) dst[n][k] = *(const G8_LAS bf16x8*)(lds + G8_SB(b, h) + boff + n * 2048 + k * 1024); } while (0)
#define G8_MMA(ai, bj, At, Bt) do { __builtin_amdgcn_s_setprio(1); _Pragma("unroll") for (int m = 0; m < 4; ++m) _Pragma("unroll") for (int n = 0; n < 2; ++n) _Pragma("unroll") for (int k = 0; k < 2; ++k) \
        acc[ai][bj][m][n] = __builtin_amdgcn_mfma_f32_16x16x32_bf16(Bt[n][k], At[m][k], acc[ai][bj][m][n], 0, 0, 0); __builtin_amdgcn_s_setprio(0); } while (0)
#define G8_WAIT_V(n) asm volatile("s_waitcnt vmcnt(" #n ")" ::: "memory")
#define G8_WAIT_L(n) asm volatile("s_waitcnt lgkmcnt(" #n ")" ::: "memory")
#define G8_BAR __builtin_amdgcn_s_barrier()
#define G8_SCHED __builtin_amdgcn_sched_barrier(0)
    Unit cur, nxt; int ui = 0;
    if (!S.next(0, cur)) return;
    f32x4 acc[2][2][4][2];
#pragma unroll
    for (int a = 0; a < 2; ++a)
#pragma unroll
        for (int b = 0; b < 2; ++b)
#pragma unroll
            for (int m = 0; m < 4; ++m)
#pragma unroll
                for (int n = 0; n < 2; ++n) acc[a][b][m][n] = (f32x4){0.f, 0.f, 0.f, 0.f};
    bf16x8 At[4][2], B0[2][2], B1[2][2];
    {
        const char* cA = aptr(cur.pm, 0); const char* cB = bptr(cur.pn, 0); const char* cA1 = aptr(cur.pm, 1); const char* cB1 = bptr(cur.pn, 1);
        G8_STAGE(G8_SB(0, 0), cB, voffB); G8_STAGE(G8_SB(0, 1), cB + hstepB, voffB); G8_STAGE(G8_SA(0, 0), cA, voffA); G8_STAGE(G8_SA(0, 1), cA + hstepA, voffA);
        if (wr == 1) G8_BAR;
        G8_WAIT_V(2); G8_BAR;
        G8_STAGE(G8_SB(1, 0), cB1, voffB); G8_STAGE(G8_SA(1, 0), cA1, voffA); G8_STAGE(G8_SB(1, 1), cB1 + hstepB, voffB);
        G8_WAIT_V(6); G8_BAR;
    }
    for (;;) {
        const bool has_next = S.next(ui + 1, nxt);
        const int npm = has_next ? nxt.pm : cur.pm, npn = has_next ? nxt.pn : cur.pn;
        for (int t = 0; t < nt; t += 2) {
            const bool last = (t == nt - 2);
            const char* a1 = aptr(cur.pm, t + 1);
            const char* a2 = last ? aptr(npm, 0) : aptr(cur.pm, t + 2); const char* b2 = last ? bptr(npn, 0) : bptr(cur.pn, t + 2);
            const char* a3 = last ? aptr(npm, 1) : aptr(cur.pm, t + 3); const char* b3 = last ? bptr(npn, 1) : bptr(cur.pn, t + 3);
            G8_LDB(B0, 0, 0); G8_LDB(B1, 0, 1); G8_SCHED; G8_LDA(At, 0, 0); G8_STAGE(G8_SA(1, 1), a1 + hstepA, voffA);
            G8_WAIT_V(8); G8_WAIT_L(0); G8_BAR; G8_MMA(0, 0, At, B0); G8_MMA(0, 1, At, B1); G8_BAR; G8_SCHED;
            G8_LDA(At, 0, 1); G8_STAGE(G8_SB(0, 0), b2, voffB); G8_STAGE(G8_SB(0, 1), b2 + hstepB, voffB); G8_STAGE(G8_SA(0, 0), a2, voffA);
            G8_WAIT_V(8); G8_WAIT_L(0); G8_BAR; G8_MMA(1, 0, At, B0); G8_MMA(1, 1, At, B1); G8_BAR; G8_SCHED;
            G8_LDB(B0, 1, 0); G8_LDB(B1, 1, 1); G8_SCHED; G8_LDA(At, 1, 0); G8_STAGE(G8_SA(0, 1), a2 + hstepA, voffA);
            G8_WAIT_V(8); G8_WAIT_L(0); G8_BAR; G8_MMA(0, 0, At, B0); G8_MMA(0, 1, At, B1); G8_BAR; G8_SCHED;
            G8_LDA(At, 1, 1); G8_STAGE(G8_SB(1, 0), b3, voffB); G8_STAGE(G8_SB(1, 1), b3 + hstepB, voffB); G8_STAGE(G8_SA(1, 0), a3, voffA);
            G8_WAIT_V(8); G8_WAIT_L(0); G8_BAR; G8_MMA(1, 0, At, B0); G8_MMA(1, 1, At, B1); G8_BAR; G8_SCHED;
        }
        if (wr == 0) G8_BAR;
        E(acc, cur, wr, wc, fr, fq);
        if (!has_next) break;
#pragma unroll
        for (int a = 0; a < 2; ++a)
#pragma unroll
            for (int b = 0; b < 2; ++b)
#pragma unroll
                for (int m = 0; m < 4; ++m)
#pragma unroll
                    for (int n = 0; n < 2; ++n) acc[a][b][m][n] = (f32x4){0.f, 0.f, 0.f, 0.f};
        cur = nxt; ++ui;
        if (wr == 1) G8_BAR;
    }
    G8_WAIT_V(0);
    G8_BAR;
#undef G8_SA
#undef G8_SB
#undef G8_STAGE
#undef G8_LDA
#undef G8_LDB
#undef G8_MMA
#undef G8_WAIT_V
#undef G8_WAIT_L
#undef G8_BAR
#undef G8_SCHED
}
struct EpiResid {
    const float* Rs; float* O; bf16_t* XB; float* SSQP; const float* gain;
    __device__ __forceinline__ void operator()(const f32x4 (&acc)[2][2][4][2], const Unit& u, int wr, int wc, int fr, int fq) const {
        f32x4 gn[2][2];
#pragma unroll
        for (int bj = 0; bj < 2; ++bj) { gn[bj][0] = *(const f32x4*)(gain + u.pn * 256 + bj * 128 + wc * 32 + fq * 8); gn[bj][1] = *(const f32x4*)(gain + u.pn * 256 + bj * 128 + wc * 32 + fq * 8 + 4); }
#pragma unroll
        for (int ai = 0; ai < 2; ++ai)
#pragma unroll
            for (int m = 0; m < 4; ++m) {
                const int row = u.pm * 256 + ai * 128 + wr * 64 + m * 16 + fr;
                const size_t o = (size_t)row * 1024 + u.pn * 256 + wc * 32 + fq * 8;
                float ss = 0.f;
#pragma unroll
                for (int bj = 0; bj < 2; ++bj) {
                    const f32x4 a = *(const f32x4*)(Rs + o + bj * 128) + acc[ai][bj][m][0], b = *(const f32x4*)(Rs + o + bj * 128 + 4) + acc[ai][bj][m][1];
                    *(f32x4*)(O + o + bj * 128) = a; *(f32x4*)(O + o + bj * 128 + 4) = b;
                    ss += a[0] * a[0] + a[1] * a[1] + a[2] * a[2] + a[3] * a[3] + b[0] * b[0] + b[1] * b[1] + b[2] * b[2] + b[3] * b[3];
                    const f32x4 ag = a * gn[bj][0], bg = b * gn[bj][1];
                    uint4 w; w.x = pack2(ag[0], ag[1]); w.y = pack2(ag[2], ag[3]); w.z = pack2(bg[0], bg[1]); w.w = pack2(bg[2], bg[3]);
                    *(uint4*)(XB + o + bj * 128) = w;
                }
                ss += __shfl_xor(ss, 16); ss += __shfl_xor(ss, 32);
                if (fq == 0) SSQP[(size_t)row * 32 + u.pn * 4 + wc] = ss;
            }
    }
};
struct EpiCinU {
    bf16_t* U;
    __device__ __forceinline__ void operator()(const f32x4 (&acc)[2][2][4][2], const Unit& u, int wr, int wc, int fr, int fq) const {
#pragma unroll
        for (int ai = 0; ai < 2; ++ai)
#pragma unroll
            for (int m = 0; m < 4; ++m) {
                bf16_t* rp = U + (size_t)(u.pm * 256 + ai * 128 + wr * 64 + m * 16 + fr) * 2048 + u.pn * 256 + wc * 32 + fq * 8;
#pragma unroll
                for (int bj = 0; bj < 2; ++bj) {
                    const f32x4 a = acc[ai][bj][m][0], b = acc[ai][bj][m][1];
                    uint4 o; o.x = pack2(gelu_exact(a[0]), gelu_exact(a[1])); o.y = pack2(gelu_exact(a[2]), gelu_exact(a[3]));
                    o.z = pack2(gelu_exact(b[0]), gelu_exact(b[1])); o.w = pack2(gelu_exact(b[2]), gelu_exact(b[3]));
                    *(uint4*)(rp + bj * 128) = o;
                }
            }
    }
};
struct EpiCinV {
    bf16_t* VT; float* SSQ;
    __device__ __forceinline__ void operator()(const f32x4 (&acc)[2][2][4][2], const Unit& u, int wr, int wc, int fr, int fq) const {
#pragma unroll
        for (int ai = 0; ai < 2; ++ai) {
            float ss[16];
#pragma unroll
            for (int i = 0; i < 16; ++i) ss[i] = 0.f;
#pragma unroll
            for (int m = 0; m < 4; ++m) {
                const int c = u.pm * 256 + ai * 128 + wr * 64 + m * 16 + fr;
#pragma unroll
                for (int bj = 0; bj < 2; ++bj) {
                    float g[8];
#pragma unroll
                    for (int n = 0; n < 2; ++n)
#pragma unroll
                        for (int r = 0; r < 4; ++r) { const float x = gelu_exact(acc[ai][bj][m][n][r]); g[n * 4 + r] = x; ss[bj * 8 + n * 4 + r] += x * x; }
                    uint4 o; o.x = pack2(g[0], g[1]); o.y = pack2(g[2], g[3]); o.z = pack2(g[4], g[5]); o.w = pack2(g[6], g[7]);
                    *(uint4*)(VT + ((size_t)(u.pn * 2 + bj) * 2048 + c) * 128 + wc * 32 + fq * 8) = o;
                }
            }
            float mine = 0.f;
#pragma unroll
            for (int i = 0; i < 16; ++i) { const float s = row16_sum(ss[i]); mine = (fr == i) ? s : mine; }
            const int tok = u.pn * 256 + (fr >> 3) * 128 + wc * 32 + fq * 8 + (fr & 7);
            SSQ[(size_t)tok * 32 + u.pm * 4 + ai * 2 + wr] = mine;
        }
    }
};
struct EpiInN {
    bf16_t* R;
    __device__ __forceinline__ void operator()(const f32x4 (&acc)[2][2][4][2], const Unit& u, int wr, int wc, int fr, int fq) const {
        bf16_t* base; int pitch; float sc = 1.0f;
        if (u.pn < 2) { base = R + R_QSB + u.pn * 256; pitch = 512; sc = 0.125f; }
        else if (u.pn < 4) { base = R + R_KSB + (u.pn - 2) * 256; pitch = 512; }
        else if (u.pn == 4) { base = R + R_QG; pitch = 256; }
        else if (u.pn == 5) { base = R + R_KG; pitch = 256; }
        else { base = R + R_GG + (u.pn - 6) * 256; pitch = 512; }
#pragma unroll
        for (int ai = 0; ai < 2; ++ai)
#pragma unroll
            for (int m = 0; m < 4; ++m) {
                bf16_t* rp = base + (size_t)(u.pm * 256 + ai * 128 + wr * 64 + m * 16 + fr) * pitch + wc * 32 + fq * 8;
#pragma unroll
                for (int bj = 0; bj < 2; ++bj) {
                    const f32x4 a = acc[ai][bj][m][0] * sc, b = acc[ai][bj][m][1] * sc;
                    uint4 o; o.x = pack2(a[0], a[1]); o.y = pack2(a[2], a[3]); o.z = pack2(b[0], b[1]); o.w = pack2(b[2], b[3]);
                    *(uint4*)(rp + bj * 128) = o;
                }
            }
    }
};
struct EpiInT {
    bf16_t* R;
    __device__ __forceinline__ void operator()(const f32x4 (&acc)[2][2][4][2], const Unit& u, int wr, int wc, int fr, int fq) const {
#pragma unroll
        for (int ai = 0; ai < 2; ++ai)
#pragma unroll
            for (int m = 0; m < 4; ++m) {
                const int c = u.pm * 256 + ai * 128 + wr * 64 + m * 16 + fr;
#pragma unroll
                for (int bj = 0; bj < 2; ++bj) {
                    const int t = u.pn * 256 + bj * 128 + wc * 32 + fq * 8, b = t >> 11, s = t & 2047;
                    bf16_t* dst;
                    if (c < 512) dst = R + R_VTSB + ((size_t)((b * 8 + (c >> 6)) * 64 + (c & 63))) * 2048 + s;
                    else { const int c2 = c - 512; dst = R + R_VTG + ((size_t)((b * 4 + (c2 >> 7)) * 128 + (c2 & 127))) * 2048 + s; }
                    const f32x4 a = acc[ai][bj][m][0], bb = acc[ai][bj][m][1];
                    uint4 o; o.x = pack2(a[0], a[1]); o.y = pack2(a[2], a[3]); o.z = pack2(bb[0], bb[1]); o.w = pack2(bb[2], bb[3]);
                    *(uint4*)dst = o;
                }
            }
    }
};
}
__device__ __forceinline__ void phase_gemm_resid8(const bf16_t* A0, const bf16_t* A1, int lda, int ksplit, const bf16_t* Bt, int K, const float* Rs, float* O, bf16_t* XB, float* SSQP, const float* gain, char* smem_phys) {
    g8::Gemm g{A0, A1, lda, ksplit, Bt, T, 1024, K};
    g8::StaticOrder S; S.init(T, 1024, (int)gridDim.x, (int)blockIdx.x);
    g8::EpiResid E{Rs, O, XB, SSQP, gain};
    g8::gemm_phase<g8::EpiResid>((G8_LAS unsigned char*)smem_phys, g, S, E);
}

__device__ __forceinline__ void phase_gemm_cin8(const Params& p, char* smem_phys) {
    const bf16_t* H = (const bf16_t*)(p.ws + OFF_H); const bf16_t* W = (const bf16_t*)(p.ws + OFF_WT_CIN);
    bf16_t* U = (bf16_t*)(p.ws + OFF_REGION); bf16_t* VT = U + (size_t)T * 2048; float* SSQ = (float*)(p.ws + OFF_SSQ);
    {
        g8::Gemm g{H, H, 1024, 1024, W, T, 2048, 1024};
        g8::StaticOrder S; S.init(T, 2048, (int)gridDim.x, (int)blockIdx.x);
        g8::EpiCinU E{U};
        g8::gemm_phase<g8::EpiCinU>((G8_LAS unsigned char*)smem_phys, g, S, E);
    }
    {
        const bf16_t* Wv = W + (size_t)2048 * 1024;
        g8::Gemm g{Wv, Wv, 1024, 1024, H, 2048, T, 1024};
        g8::StaticOrder S; S.init(2048, T, (int)gridDim.x, (int)blockIdx.x);
        g8::EpiCinV E{VT, SSQ};
        g8::gemm_phase<g8::EpiCinV>((G8_LAS unsigned char*)smem_phys, g, S, E);
    }
}
__device__ __forceinline__ void phase_gemm_in8(const Params& p, char* smem_phys) {
    const bf16_t* H = (const bf16_t*)(p.ws + OFF_H); const bf16_t* W = (const bf16_t*)(p.ws + OFF_WT_IN);
    bf16_t* R = (bf16_t*)(p.ws + OFF_REGION);
    {
        g8::Gemm g{H, H, 1024, 1024, W, T, 2048, 1024};
        g8::StaticOrder S; S.init(T, 2048, (int)gridDim.x, (int)blockIdx.x);
        g8::EpiInN E{R};
        g8::gemm_phase<g8::EpiInN>((G8_LAS unsigned char*)smem_phys, g, S, E);
    }
    {
        const bf16_t* Wv = W + (size_t)2048 * 1024;
        g8::Gemm g{Wv, Wv, 1024, 1024, H, 1024, T, 1024};
        g8::StaticOrder S; S.init(1024, T, (int)gridDim.x, (int)blockIdx.x);
        g8::EpiInT E{R};
        g8::gemm_phase<g8::EpiInT>((G8_LAS unsigned char*)smem_phys, g, S, E);
    }
    {
        const int lane = threadIdx.x & 63, wid = threadIdx.x >> 6, fr = lane & 15, fq = lane >> 4;
        float* ALR = (float*)(R + R_ALR);
        for (int task = (int)blockIdx.x * 8 + wid; task < T / 16; task += (int)gridDim.x * 8) {
            const bf16_t* a = H + (size_t)(task * 16 + fr) * 1024 + fq * 8; const bf16_t* w = W + (size_t)(3072 + fr) * 1024 + fq * 8;
            f32x4 acc = (f32x4){0.f, 0.f, 0.f, 0.f};
#pragma unroll 8
            for (int kk = 0; kk < 32; ++kk) {
                const bf16x8 af = *(const bf16x8*)(a + kk * 32), wf = *(const bf16x8*)(w + kk * 32);
                acc = __builtin_amdgcn_mfma_f32_16x16x32_bf16(wf, af, acc, 0, 0, 0);
            }
            *(f32x4*)(ALR + (size_t)(task * 16 + fr) * 16 + fq * 4) = acc;
        }
    }
}

__device__ __forceinline__ void phase_gemm_in(const Params& p, char* smem) {
    const bf16_t* A = (const bf16_t*)(p.ws + OFF_H); const bf16_t* Bt = (const bf16_t*)(p.ws + OFF_WT_IN);
    bf16_t* R = (bf16_t*)(p.ws + OFF_REGION);
    const int lane = VTID & 63, wid = VTID >> 6, wm = wid >> 1, wn = wid & 1;
    constexpr int NT = AB_IN_PAD / 128, MT = T / 128;
    int mt_, nt_;
    for (int it = 0; tile_sched(it, MT, NT, mt_, nt_); ++it) {
        const int m0 = mt_ * 128, n0 = nt_ * 128;
        f32x4 acc[4][4];
        const bool tr = (n0 >= 1024 && n0 < 1536) || (n0 >= 2048 && n0 < 2560);
        if (!tr) {
            gemm_mainloop<0>(A, A, 1024, 1024, Bt, 1024, m0, n0, acc, smem);
#pragma unroll
            for (int i = 0; i < 4; ++i)
#pragma unroll
                for (int j = 0; j < 4; ++j) {
                    const int m = m0 + wm * 64 + i * 16 + (lane & 15), n = n0 + wn * 64 + j * 16 + 4 * (lane >> 4);
                    const f32x4 v = acc[i][j];
                    if (n < 512) store_bf16x4(R + R_QSB + (size_t)m * 512 + n, v * 0.125f);
                    else if (n < 1024) store_bf16x4(R + R_KSB + (size_t)m * 512 + (n - 512), v);
                    else if (n < 1792) store_bf16x4(R + R_QG + (size_t)m * 256 + (n - 1536), v);
                    else if (n < 2048) store_bf16x4(R + R_KG + (size_t)m * 256 + (n - 1792), v);
                    else if (n < 3072) store_bf16x4(R + R_GG + (size_t)m * 512 + (n - 2560), v);
                    else if (n < AB_IN) *(f32x4*)((float*)(R + R_ALR) + (size_t)m * 16 + (n - 3072)) = v;
                }
        } else {
            gemm_mainloop<1>(A, A, 1024, 1024, Bt, 1024, m0, n0, acc, smem);
#pragma unroll
            for (int i = 0; i < 4; ++i)
#pragma unroll
                for (int j = 0; j < 4; ++j) {
                    const int m = m0 + wm * 64 + i * 16 + 4 * (lane >> 4), n = n0 + wn * 64 + j * 16 + (lane & 15);
                    const int b = m >> 11, s = m & 2047;
                    if (n < 1536) { const int c = n - 1024, hh = c >> 6, e = c & 63; store_bf16x4(R + R_VTSB + ((size_t)((b * 8 + hh) * 64 + e)) * 2048 + s, acc[i][j]); }
                    else { const int c = n - 2048, hh = c >> 7, e = c & 127; store_bf16x4(R + R_VTG + ((size_t)((b * 4 + hh) * 128 + e)) * 2048 + s, acc[i][j]); }
                }
        }
    }
}
__device__ __forceinline__ void phase_gemm_resid(const bf16_t* A0, const bf16_t* A1, int lda, int ksplit, const bf16_t* Bt, int K, const float* Rs, float* O, char* smem) {
    const int lane = VTID & 63, wid = VTID >> 6, wm = wid >> 1, wn = wid & 1;
    constexpr int NT = 8, MT = T / 256;
    int mt_, nt_;
    for (int it = 0; tile_sched(it, MT, NT, mt_, nt_); ++it) {
        const int m0 = mt_ * 256, n0 = nt_ * 128;
        f32x4 acc[8][4];
        gemm_mainloop256<0>(A0, A1, lda, ksplit, Bt, K, m0, n0, acc, smem);
#pragma unroll
        for (int i = 0; i < 8; ++i)
#pragma unroll
            for (int j = 0; j < 4; ++j) {
                const int m = m0 + wm * 128 + i * 16 + (lane & 15), n = n0 + wn * 64 + j * 16 + 4 * (lane >> 4);
                const f32x4 r = *(const f32x4*)(Rs + (size_t)m * 1024 + n);
                *(f32x4*)(O + (size_t)m * 1024 + n) = r + acc[i][j];
            }
    }
}
__device__ __forceinline__ void phase_gemm_cin(const Params& p, char* smem) {
    const bf16_t* A = (const bf16_t*)(p.ws + OFF_H); const bf16_t* Bt = (const bf16_t*)(p.ws + OFF_WT_CIN);
    bf16_t* U = (bf16_t*)(p.ws + OFF_REGION); bf16_t* VT = U + (size_t)T * 2048; float* SSQ = (float*)(p.ws + OFF_SSQ);
    const int lane = VTID & 63, wid = VTID >> 6, wm = wid >> 1, wn = wid & 1;
    constexpr int NT = 32, MT = T / 128;
    int mt_, nt_;
    for (int it = 0; tile_sched(it, MT, NT, mt_, nt_); ++it) {
        const int m0 = mt_ * 128, n0 = nt_ * 128;
        f32x4 acc[4][4];
        if (n0 < 2048) {
            gemm_mainloop<0>(A, A, 1024, 1024, Bt, 1024, m0, n0, acc, smem);
#pragma unroll
            for (int i = 0; i < 4; ++i)
#pragma unroll
                for (int j = 0; j < 4; ++j) {
                    const int m = m0 + wm * 64 + i * 16 + (lane & 15), n = n0 + wn * 64 + j * 16 + 4 * (lane >> 4);
                    f32x4 v = acc[i][j];
#pragma unroll
                    for (int r = 0; r < 4; ++r) v[r] = gelu_exact(v[r]);
                    store_bf16x4(U + (size_t)m * 2048 + n, v);
                }
        } else {
            gemm_mainloop<1>(A, A, 1024, 1024, Bt, 1024, m0, n0, acc, smem);
#pragma unroll
            for (int i = 0; i < 4; ++i) {
                float ss[4] = {0.f, 0.f, 0.f, 0.f};
#pragma unroll
                for (int j = 0; j < 4; ++j) {
                    const int m = m0 + wm * 64 + i * 16 + 4 * (lane >> 4), n = n0 + wn * 64 + j * 16 + (lane & 15);
                    f32x4 v = acc[i][j];
#pragma unroll
                    for (int r = 0; r < 4; ++r) { v[r] = gelu_exact(v[r]); ss[r] += v[r] * v[r]; }
                    const int chunk = m >> 7, s = m & 127, c = n - 2048;
                    store_bf16x4(VT + ((size_t)chunk * 2048 + c) * 128 + s, v);
                }
#pragma unroll
                for (int r = 0; r < 4; ++r) {
                    float v = ss[r];
                    v += __shfl_xor(v, 1); v += __shfl_xor(v, 2); v += __shfl_xor(v, 4); v += __shfl_xor(v, 8);
                    if ((lane & 15) == 0) { const int m = m0 + wm * 64 + i * 16 + 4 * (lane >> 4) + r; SSQ[(size_t)m * 32 + ((n0 - 2048) >> 6) + wn] = v; }
                }
            }
        }
    }
}

typedef float f32x16 __attribute__((ext_vector_type(16)));
__device__ __forceinline__ void sb_fast(const Params& p, char* smem, unsigned* ctr) {
    bf16_t* R = (bf16_t*)(p.ws + OFF_REGION);
    char* KT = smem; char* VTt = smem + 8192;
    volatile int* flags = (volatile int*)(smem + 32768); volatile unsigned* slot = (volatile unsigned*)(smem + 32832);
    const int tid = threadIdx.x, lane = tid & 63, w = tid >> 6, r31 = lane & 31, h = lane >> 5;
    for (;;) {
        __syncthreads();
        if (tid == 0) *slot = atomicAdd(ctr, 1u);
        __syncthreads();
        const unsigned task = *slot;
        if (task >= 1024u) break;
        const int qblk = 7 - (int)(task >> 7), bh = task & 127, b = bh >> 3, hh = bh & 7;
        const int q0 = qblk * 256, qbase = q0 + 32 * w;
        bf16_t* qrow = R + R_QSB + (size_t)(b * 2048 + qbase + r31) * 512 + hh * 64;
        bf16x8 qf[4];
#pragma unroll
        for (int kk = 0; kk < 4; ++kk) qf[kk] = *(const bf16x8*)(qrow + 16 * kk + 8 * h);
        f32x16 oacc[2];
#pragma unroll
        for (int nt = 0; nt < 2; ++nt)
#pragma unroll
            for (int i = 0; i < 16; ++i) oacc[nt][i] = 0.f;
        float Rr = 1.0f;
        const int t = qbase + r31;
        for (int kt = q0 / 64 + 3; kt >= 0; --kt) {
            __syncthreads();
            { const int wd = __all(Rr == 0.f); if (lane == 0) flags[w] = wd; }
            __syncthreads();
            if (flags[0] & flags[1] & flags[2] & flags[3] & flags[4] & flags[5] & flags[6] & flags[7]) break;
            const int s_tile = kt * 64;
            {
                const int c = tid, row = c >> 3, ch = c & 7;
                const u32x4 kv = *(const u32x4*)(R + R_KSB + (size_t)(b * 2048 + s_tile + row) * 512 + hh * 64 + ch * 8);
                const u32x4 vv = *(const u32x4*)(R + R_VTSB + ((size_t)((b * 8 + hh) * 64 + row)) * 2048 + s_tile + ch * 8);
                *(u32x4*)(KT + row * 128 + ((ch ^ (row & 7)) << 4)) = kv;
                *(uint2*)(VTt + row * 136 + ch * 16) = make_uint2(vv[0], vv[1]);
                *(uint2*)(VTt + row * 136 + ch * 16 + 8) = make_uint2(vv[2], vv[3]);
            }
            __syncthreads();
#pragma unroll
            for (int sbk = 1; sbk >= 0; --sbk) {
                const int key_lo = s_tile + 32 * sbk;
                if (key_lo >= qbase + 31) continue;
                if (__all(Rr == 0.f)) continue;
                f32x16 st;
#pragma unroll
                for (int i = 0; i < 16; ++i) st[i] = 0.f;
                const int krow = 32 * sbk + r31;
#pragma unroll
                for (int kk = 0; kk < 4; ++kk) {
                    const bf16x8 kf = *(const bf16x8*)(KT + krow * 128 + (((2 * kk + h) ^ (krow & 7)) << 4));
                    st = __builtin_amdgcn_mfma_f32_32x32x16_bf16(kf, qf[kk], st, 0, 0, 0);
                }
                float a[16], G[4];
#pragma unroll
                for (int g = 0; g < 4; ++g) {
                    float sg[4], m[4];
#pragma unroll
                    for (int i = 0; i < 4; ++i) {
                        const int s = key_lo + 8 * g + 4 * h + i;
                        const float z = fminf(fmaxf(st[4 * g + i], -80.f), 80.f);
                        const float ez = __expf(-z), sig = 1.0f / (1.0f + ez);
                        const bool valid = s < t;
                        sg[i] = valid ? sig : 0.f; m[i] = valid ? ez * sig : 1.0f;
                    }
                    const float x2 = m[3], x1 = x2 * m[2], x0 = x1 * m[1];
                    G[g] = x0 * m[0];
                    a[4 * g + 3] = sg[3]; a[4 * g + 2] = sg[2] * x2; a[4 * g + 1] = sg[1] * x1; a[4 * g] = sg[0] * x0;
                }
                float Go[4], P[4];
#pragma unroll
                for (int g = 0; g < 4; ++g) { Go[g] = __shfl_xor(G[g], 32); P[g] = G[g] * Go[g]; }
                const float c2 = P[3], c1 = c2 * P[2], c0 = c1 * P[1];
                float Tg[4];
                Tg[3] = Rr; Tg[2] = Rr * c2; Tg[1] = Rr * c1; Tg[0] = Rr * c0;
#pragma unroll
                for (int g = 0; g < 4; ++g) {
                    const float tg = (h == 0) ? Tg[g] * Go[g] : Tg[g];
                    a[4 * g] *= tg; a[4 * g + 1] *= tg; a[4 * g + 2] *= tg; a[4 * g + 3] *= tg;
                }
                Rr = Rr * c0 * P[0];
#pragma unroll
                for (int s2 = 0; s2 < 2; ++s2) {
                    union { bf16x8 v; unsigned u[4]; } af;
#pragma unroll
                    for (int j2 = 0; j2 < 4; ++j2) af.u[j2] = pack2(a[8 * s2 + 2 * j2], a[8 * s2 + 2 * j2 + 1]);
#pragma unroll
                    for (int nt = 0; nt < 2; ++nt) {
                        const char* vp = VTt + (32 * nt + r31) * 136 + 64 * sbk + 32 * s2 + 8 * h;
                        union { bf16x8 v; uint2 hh2[2]; } vf;
                        vf.hh2[0] = *(const uint2*)vp; vf.hh2[1] = *(const uint2*)(vp + 16);
                        oacc[nt] = __builtin_amdgcn_mfma_f32_32x32x16_bf16(af.v, vf.v, oacc[nt], 0, 0, 0);
                    }
                }
            }
        }
#pragma unroll
        for (int nt = 0; nt < 2; ++nt)
#pragma unroll
            for (int i = 0; i < 16; ++i) {
                const int qq = (i & 3) + 8 * (i >> 2) + 4 * h;
                R[R_QSB + (size_t)(b * 2048 + qbase + qq) * 512 + hh * 64 + 32 * nt + r31] = f2bf(oacc[nt][i]);
            }
    }
}
__device__ __forceinline__ float log_sigmoid(float x) { return fminf(x, 0.f) - log1pf(__expf(-fabsf(x))); }
__device__ __forceinline__ int swz(int row, int chunk) { return row * 128 + ((chunk ^ (row & 7)) << 4); }
__device__ __forceinline__ void gla_prep(const Params& p, char* smem) {
    bf16_t* R = (bf16_t*)(p.ws + OFF_REGION);
    const float* ALR = (const float*)(R + R_ALR);
    bf16_t* KOTg = R + R_KOT; float* DECg = (float*)(R + R_DEC);
    float* SEG = (float*)smem; float* ALRs = SEG + 256;
    const int tid = VTID, d = tid & 63, w = tid >> 6;
    for (int task = VBID; task < 2048; task += VGRID) {
        const int bh = task >> 5, c = task & 31, b = bh >> 2, hh = bh & 3;
        const size_t rowbase = (size_t)b * 2048 + c * 64;
        unsigned qr[16], kr[16];
#pragma unroll
        for (int i = 0; i < 16; ++i) { const size_t row = rowbase + w * 16 + i; qr[i] = R[R_QG + row * 256 + hh * 64 + d]; kr[i] = R[R_KG + row * 256 + hh * 64 + d]; }
        const f32x4 ar = *(const f32x4*)(ALR + rowbase * 16 + tid * 4);
        float w2r[16];
#pragma unroll
        for (int r = 0; r < 16; ++r) w2r[r] = p.ab_w_alpha2[r * 256 + hh * 64 + d];
        const float b2r = p.ab_b_alpha2[hh * 64 + d];
        __syncthreads();
        *(f32x4*)(ALRs + tid * 4) = ar;
        __syncthreads();
        float cs[16]; float run = 0.f;
#pragma unroll
        for (int i = 0; i < 16; ++i) {
            const float* al = ALRs + (w * 16 + i) * 16;
            float pre = b2r;
#pragma unroll
            for (int r = 0; r < 16; ++r) pre += al[r] * w2r[r];
            run += log_sigmoid(pre) * (1.0f / 16.0f);
            cs[i] = run;
        }
        SEG[w * 64 + d] = run;
        __syncthreads();
        float off = 0.f, tot = 0.f;
#pragma unroll
        for (int w2 = 0; w2 < 4; ++w2) { const float s = SEG[w2 * 64 + d]; tot += s; if (w2 < w) off += s; }
        unsigned kop[8];
#pragma unroll
        for (int i2 = 0; i2 < 8; ++i2) {
            float kov[2];
#pragma unroll
            for (int u = 0; u < 2; ++u) {
                const int i = 2 * i2 + u;
                const float bc = off + cs[i];
                const float kv = bf2f((bf16_t)kr[i]);
                const size_t row = rowbase + w * 16 + i;
                R[R_QG + row * 256 + hh * 64 + d] = f2bf(bf2f((bf16_t)qr[i]) * 0.125f * __expf(bc));
                R[R_KG + row * 256 + hh * 64 + d] = f2bf(kv * __expf(-bc));
                kov[u] = kv * __expf(tot - bc);
            }
            kop[i2] = pack2(kov[0], kov[1]);
        }
        bf16_t* kp = KOTg + ((size_t)task * 64 + d) * 64 + w * 16;
        *(uint4*)kp = make_uint4(kop[0], kop[1], kop[2], kop[3]);
        *(uint4*)(kp + 8) = make_uint4(kop[4], kop[5], kop[6], kop[7]);
        if (w == 0) DECg[(size_t)task * 64 + d] = __expf(tot);
    }
}
__device__ __forceinline__ void gla_scan(const Params& p, char* smem, bool dry = false) {
    bf16_t* R = (bf16_t*)(p.ws + OFF_REGION);
    const bf16_t* KOTg = R + R_KOT; const float* DECg = (const float*)(R + R_DEC);
    char* QS = smem; char* KS = smem + 8192; char* KOT = smem + 16384; char* VTs = smem + 24576; char* SPT = smem + 40960;
    float* DEC = (float*)(smem + 57344); float* GN = DEC + 64;
    const int tid = VTID, lane = tid & 63, w = tid >> 6, l15_ = lane & 15, q4 = lane >> 4;
    for (int task = VBID; task < 64; task += VGRID) {
        const int b = task >> 2, hh = task & 3;
        f32x4 Sacc[8];
#pragma unroll
        for (int nt = 0; nt < 8; ++nt) Sacc[nt] = (f32x4){0.f, 0.f, 0.f, 0.f};
        __syncthreads();
        for (int i = tid; i < 1024; i += 256) *(uint4*)(SPT + i * 16) = make_uint4(0, 0, 0, 0);
        if (tid < 128) GN[tid] = p.ab_gla_norm[hh * 128 + tid];
        const size_t rowbase = (size_t)b * 2048;
        const bf16_t* vbase = R + R_VTG + ((size_t)((b * 4 + hh) * 128)) * 2048;
        u32x4 tq[2], tk[2], tko[2], vr[4]; float td = 0.f;
        auto prefetch = [&](int c) {
            const int t0 = c * 64;
#pragma unroll
            for (int i = 0; i < 2; ++i) {
                const int cid = tid + 256 * i, row = cid >> 3, ch = cid & 7;
                tq[i] = *(const u32x4*)(R + R_QG + (rowbase + t0 + row) * 256 + hh * 64 + ch * 8);
                tk[i] = *(const u32x4*)(R + R_KG + (rowbase + t0 + row) * 256 + hh * 64 + ch * 8);
                tko[i] = *(const u32x4*)(KOTg + (((size_t)task * 32 + c) * 64 + row) * 64 + ch * 8);
            }
#pragma unroll
            for (int i = 0; i < 4; ++i) { const int cid = tid + 256 * i, e = cid >> 3, ch = cid & 7; vr[i] = *(const u32x4*)(vbase + (size_t)e * 2048 + t0 + ch * 8); }
            if (tid < 64) td = DECg[((size_t)task * 32 + c) * 64 + tid];
        };
        prefetch(0);
        for (int c = 0; c < 32; ++c) {
            int lz = 0; asm volatile("" : "+v"(lz));
            const int l15 = l15_ + lz;
            const int cx = (q4 ^ (l15 & 7)) << 4;
            const int rb0 = l15 * 128 + cx, rb1 = l15 * 128 + (cx ^ 64);
#pragma unroll
            for (int i = 0; i < 2; ++i) {
                const int cid = tid + 256 * i + lz, row = cid >> 3, ch = cid & 7;
                *(u32x4*)(QS + swz(row, ch)) = tq[i]; *(u32x4*)(KS + swz(row, ch)) = tk[i]; *(u32x4*)(KOT + swz(row, ch)) = tko[i];
            }
#pragma unroll
            for (int i = 0; i < 4; ++i) { const int cid = tid + 256 * i + lz, e = cid >> 3, ch = cid & 7; *(u32x4*)(VTs + swz(e, ch)) = vr[i]; }
            if (tid < 64) DEC[tid] = td;
            uint2 gr[8];
            const unsigned goff = (unsigned)((rowbase + c * 64 + 16 * w + l15) * 512 + hh * 128 + 4 * q4);
            bf16_t* const gbase = R + R_GG;
#pragma unroll
            for (int nt = 0; nt < 8; ++nt) gr[nt] = *(const uint2*)(gbase + (goff + 16 * nt));
            if (c + 1 < 32) prefetch(c + 1);
            __syncthreads();
            bf16x8 qf[2];
#pragma unroll
            for (int kk = 0; kk < 2; ++kk) qf[kk] = *(const bf16x8*)(QS + w * 2048 + (kk ? rb1 : rb0));
            f32x4 sT[4];
#pragma unroll
            for (int st = 0; st < 4; ++st) {
                sT[st] = (f32x4){0.f, 0.f, 0.f, 0.f};
                if (st <= w) {
#pragma unroll
                    for (int kk = 0; kk < 2; ++kk) { const bf16x8 kf = *(const bf16x8*)(KS + st * 2048 + (kk ? rb1 : rb0)); sT[st] = __builtin_amdgcn_mfma_f32_16x16x32_bf16(kf, qf[kk], sT[st], 0, 0, 0); }
#pragma unroll
                    for (int r = 0; r < 4; ++r) if (16 * st + 4 * q4 + r > 16 * w + l15) sT[st][r] = 0.f;
                }
            }
            bf16x8 af[2];
#pragma unroll
            for (int ks2 = 0; ks2 < 2; ++ks2) {
                union { bf16x8 v; unsigned u[4]; } cv;
                cv.u[0] = pack2(sT[2 * ks2][0], sT[2 * ks2][1]); cv.u[1] = pack2(sT[2 * ks2][2], sT[2 * ks2][3]);
                cv.u[2] = pack2(sT[2 * ks2 + 1][0], sT[2 * ks2 + 1][1]); cv.u[3] = pack2(sT[2 * ks2 + 1][2], sT[2 * ks2 + 1][3]);
                af[ks2] = cv.v;
            }
            const int vb = l15 * 128 + ((((q4 >> 1) ^ (l15 & 7)) << 4) | ((q4 & 1) * 8));
            f32x4 o[8];
#pragma unroll
            for (int nt = 0; nt < 8; ++nt) {
                o[nt] = (f32x4){0.f, 0.f, 0.f, 0.f};
                const int e = 16 * nt + l15;
#pragma unroll
                for (int kk = 0; kk < 2; ++kk) { const bf16x8 sf = *(const bf16x8*)(SPT + nt * 2048 + (kk ? rb1 : rb0)); o[nt] = __builtin_amdgcn_mfma_f32_16x16x32_bf16(sf, qf[kk], o[nt], 0, 0, 0); }
#pragma unroll
                for (int ks2 = 0; ks2 < 2; ++ks2) {
                    if (2 * ks2 <= w) {
                        union { bf16x8 v; uint2 h[2]; } cv;
                        cv.h[0] = *(const uint2*)(VTs + nt * 2048 + (vb ^ (ks2 * 64)));
                        cv.h[1] = *(const uint2*)(VTs + nt * 2048 + (vb ^ (ks2 * 64) ^ 32));
                        o[nt] = __builtin_amdgcn_mfma_f32_16x16x32_bf16(cv.v, af[ks2], o[nt], 0, 0, 0);
                    }
                }
            }
            {
                const float4 dc = *(const float4*)(DEC + 16 * w + 4 * q4);
                bf16x8 kof[2];
#pragma unroll
                for (int kk = 0; kk < 2; ++kk) kof[kk] = *(const bf16x8*)(KOT + w * 2048 + (kk ? rb1 : rb0));
#pragma unroll
                for (int nt = 0; nt < 8; ++nt) {
                    Sacc[nt][0] *= dc.x; Sacc[nt][1] *= dc.y; Sacc[nt][2] *= dc.z; Sacc[nt][3] *= dc.w;
#pragma unroll
                    for (int kk = 0; kk < 2; ++kk) { const bf16x8 vf = *(const bf16x8*)(VTs + nt * 2048 + (kk ? rb1 : rb0)); Sacc[nt] = __builtin_amdgcn_mfma_f32_16x16x32_bf16(kof[kk], vf, Sacc[nt], 0, 0, 0); }
                }
            }
            __syncthreads();
#pragma unroll
            for (int nt = 0; nt < 8; ++nt) {
                const int e = 16 * nt + l15;
                uint2 pk; pk.x = pack2(Sacc[nt][0], Sacc[nt][1]); pk.y = pack2(Sacc[nt][2], Sacc[nt][3]);
                *(uint2*)(SPT + nt * 2048 + l15 * 128 + (((2 * w + (q4 >> 1)) ^ (l15 & 7)) << 4) + (q4 & 1) * 8) = pk;
            }
            float ssq = 0.f;
#pragma unroll
            for (int nt = 0; nt < 8; ++nt) ssq += (o[nt][0] * o[nt][0] + o[nt][1] * o[nt][1]) + (o[nt][2] * o[nt][2] + o[nt][3] * o[nt][3]);
            ssq += __shfl_xor(ssq, 16); ssq += __shfl_xor(ssq, 32);
            const float rsd = rsqrtf(ssq * (1.0f / 128.0f) + EPS);
#pragma unroll
            for (int nt = 0; nt < 8; ++nt) {
                asm volatile("" ::: "memory");
                const f32x4 gn = *(const f32x4*)(GN + 16 * nt + 4 * q4);
                const float g0 = lo2f(gr[nt].x), g1 = hi2f(gr[nt].x), g2 = lo2f(gr[nt].y), g3 = hi2f(gr[nt].y);
                uint2 ov;
                ov.x = pack2(o[nt][0] * rsd * gn[0] * (g0 / (1.0f + __expf(-g0))), o[nt][1] * rsd * gn[1] * (g1 / (1.0f + __expf(-g1))));
                ov.y = pack2(o[nt][2] * rsd * gn[2] * (g2 / (1.0f + __expf(-g2))), o[nt][3] * rsd * gn[3] * (g3 / (1.0f + __expf(-g3))));
                if (!dry || ov.x == 0x7fc17fc1u) *(uint2*)(gbase + (goff + 16 * nt)) = ov;
            }
        }
    }
}

__device__ __forceinline__ unsigned ord_key(float f) { const unsigned u = __float_as_uint(f); return (u & 0x80000000u) ? ~u : (u | 0x80000000u); }
__device__ __forceinline__ float unord_key(unsigned k) { return __uint_as_float((k & 0x80000000u) ? (k & 0x7fffffffu) : ~k); }
__device__ __forceinline__ void ce_desc(unsigned& a, unsigned& b) { const unsigned hi = max(a, b), lo = min(a, b); a = hi; b = lo; }
__device__ __forceinline__ void bitonic_sort16_desc(unsigned (&a)[16]) {
#pragma unroll
    for (int k = 2; k <= 16; k <<= 1)
#pragma unroll
        for (int j = k >> 1; j > 0; j >>= 1)
#pragma unroll
            for (int i = 0; i < 16; ++i) { const int l = i ^ j; if (l > i) { if ((i & k) == 0) ce_desc(a[i], a[l]); else ce_desc(a[l], a[i]); } }
}
__device__ __forceinline__ void merge_top16(unsigned (&L)[16], const unsigned (&B)[16]) {
#pragma unroll
    for (int i = 0; i < 16; ++i) L[i] = max(L[i], B[15 - i]);
#pragma unroll
    for (int j = 8; j > 0; j >>= 1)
#pragma unroll
        for (int i = 0; i < 16; ++i) { const int l = i ^ j; if (l > i) ce_desc(L[i], L[l]); }
}
__device__ constexpr int cand_i(int n) { int c = 0; for (int i = 0; i < 16; ++i) for (int j = 0; j < 16; ++j) if ((i + 1) * (j + 1) <= 16) { if (c == n) return i; ++c; } return -1; }
__device__ constexpr int cand_j(int n) { int c = 0; for (int i = 0; i < 16; ++i) for (int j = 0; j < 16; ++j) if ((i + 1) * (j + 1) <= 16) { if (c == n) return j; ++c; } return -1; }
template <int N> struct CandTab { int i[N], j[N]; constexpr CandTab() : i(), j() { for (int n = 0; n < N; ++n) { i[n] = cand_i(n); j[n] = cand_j(n); } } };
__device__ __forceinline__ void peer_select_fast(const Params& p, int layer, char* smem) {
    const bf16_t* A = (const bf16_t*)(p.ws + OFF_H);
    const bf16_t* Bt = (const bf16_t*)(p.ws + OFF_WT_Q) + (size_t)layer * 2048 * 1024;
    const bf16_t* SK = (const bf16_t*)(p.ws + OFF_SK) + (size_t)layer * 8 * 2 * 128 * 128;
    unsigned short* IDX = (unsigned short*)(p.ws + OFF_IDX); float* GATE = (float*)(p.ws + OFF_GATE);
    const int tid_ = VTID;
    float* SC = (float*)smem; unsigned* XCH = (unsigned*)smem;
    int mt_, hh;
    for (int it = 0; tile_sched(it, T / 128, 8, mt_, hh); ++it) {
        const int m0 = mt_ * 128;
        unsigned L0[16], L1[16];
#pragma unroll
        for (int pp = 0; pp < 2; ++pp) {
            f32x4 acc[4][4];
            gemm_mainloop<0>(A, A, 1024, 1024, Bt, 1024, m0, hh * 256 + pp * 128, acc, smem);
            int lz = 0; asm volatile("" : "+v"(lz));
            const int tid = tid_ + lz, lane = tid & 63, wid = tid >> 6, wm = wid >> 1, wn = wid & 1, l15 = lane & 15, q4 = lane >> 4, token = tid & 127, half = tid >> 7;
#pragma unroll
            for (int i = 0; i < 4; ++i)
#pragma unroll
                for (int j = 0; j < 4; ++j) {
                    const int row = wm * 64 + i * 16 + l15, chunk = 2 * j + (q4 >> 1);
                    uint2 o; o.x = pack2(acc[i][j][0], acc[i][j][1]); o.y = pack2(acc[i][j][2], acc[i][j][3]);
                    *(uint2*)(smem + wn * 32768 + row * 128 + ((chunk ^ (row & 7)) << 4) + (q4 & 1) * 8) = o;
                }
            const bf16_t* SKp = SK + (size_t)((hh * 2 + pp) * 128) * 128;
#pragma unroll
            for (int i = 0; i < 8; ++i) {
                const int c = tid + 256 * i, row = c >> 4, ch16 = c & 15, ks = ch16 >> 3, ch = ch16 & 7;
                *(uint4*)(smem + ks * 32768 + 16384 + row * 128 + ((ch ^ (row & 7)) << 4)) = *(const uint4*)(SKp + (size_t)row * 128 + ch16 * 8);
            }
            __syncthreads();
#pragma unroll
            for (int i = 0; i < 4; ++i)
#pragma unroll
                for (int j = 0; j < 4; ++j) acc[i][j] = (f32x4){0.f, 0.f, 0.f, 0.f};
#pragma unroll
            for (int kt = 0; kt < 2; ++kt) {
                const char* sa = smem + kt * 32768; const char* sb = sa + 16384;
#pragma unroll
                for (int ks = 0; ks < 2; ++ks) {
                    bf16x8 af[4], bfr[4];
                    const int ch = ks * 4 + q4;
#pragma unroll
                    for (int i = 0; i < 4; ++i) { const int row = wm * 64 + i * 16 + l15; af[i] = *(const bf16x8*)(sa + row * 128 + ((ch ^ (row & 7)) << 4)); }
#pragma unroll
                    for (int j = 0; j < 4; ++j) { const int row = wn * 64 + j * 16 + l15; bfr[j] = *(const bf16x8*)(sb + row * 128 + ((ch ^ (row & 7)) << 4)); }
#pragma unroll
                    for (int i = 0; i < 4; ++i)
#pragma unroll
                        for (int j = 0; j < 4; ++j) acc[i][j] = __builtin_amdgcn_mfma_f32_16x16x32_bf16(bfr[j], af[i], acc[i][j], 0, 0, 0);
                }
            }
            __syncthreads();
#pragma unroll
            for (int i = 0; i < 4; ++i)
#pragma unroll
                for (int j = 0; j < 4; ++j) {
                    const int m = wm * 64 + i * 16 + l15, n = wn * 64 + j * 16 + 4 * q4;
#pragma unroll
                    for (int r = 0; r < 4; ++r) SC[m * 128 + ((n + r) ^ (m & 31))] = acc[i][j][r];
                }
            __syncthreads();
            unsigned L[16];
            {
                const float* srow = SC + token * 128 + half * 64; const int x = token & 31;
#pragma unroll
                for (int ch = 0; ch < 4; ++ch) {
                    unsigned Cc[16];
#pragma unroll
                    for (int i = 0; i < 16; ++i) { const int c = ch * 16 + i; Cc[i] = (ord_key(srow[c ^ x]) & ~127u) | (unsigned)(127 - (half * 64 + c)); }
                    bitonic_sort16_desc(Cc);
                    if (ch == 0) {
#pragma unroll
                        for (int i = 0; i < 16; ++i) L[i] = Cc[i];
                    } else merge_top16(L, Cc);
                }
            }
            __syncthreads();
            if (half == 1) {
#pragma unroll
                for (int i = 0; i < 16; ++i) XCH[token * 17 + i] = L[i];
            }
            __syncthreads();
            if (half == 0) {
                unsigned Xc[16];
#pragma unroll
                for (int i = 0; i < 16; ++i) Xc[i] = XCH[token * 17 + i];
                merge_top16(L, Xc);
            }
#pragma unroll
            for (int i = 0; i < 16; ++i) { if (pp == 0) L0[i] = L[i]; else L1[i] = L[i]; }
            __syncthreads();
        }
        unsigned* NIDX = (unsigned*)smem;
        const int token = tid_ & 127, half = tid_ >> 7;
        if (half == 0) {
            float s0[16], s1[16];
#pragma unroll
            for (int i = 0; i < 16; ++i) { s0[i] = unord_key(L0[i] & ~127u); s1[i] = unord_key(L1[i] & ~127u); }
            constexpr CandTab<64> ct{};
            unsigned C[16];
#pragma unroll
            for (int ch = 0; ch < 4; ++ch) {
                unsigned Cc[16];
#pragma unroll
                for (int i = 0; i < 16; ++i) {
                    const int n = ch * 16 + i;
                    if (ct.i[n] >= 0) Cc[i] = (ord_key(s0[ct.i[n] < 0 ? 0 : ct.i[n]] + s1[ct.j[n] < 0 ? 0 : ct.j[n]]) & ~255u) | (unsigned)(255 - (ct.i[n] * 16 + ct.j[n]));
                    else Cc[i] = 0u;
                }
                bitonic_sort16_desc(Cc);
                if (ch == 0) {
#pragma unroll
                    for (int i = 0; i < 16; ++i) C[i] = Cc[i];
                } else merge_top16(C, Cc);
            }
#pragma unroll
            for (int i = 0; i < 16; ++i) { NIDX[token * 33 + i] = 127u - (L0[i] & 127u); NIDX[token * 33 + 16 + i] = 127u - (L1[i] & 127u); }
            const float mx = unord_key(C[0] & ~255u);
            float e[16]; float sum = 0.f;
#pragma unroll
            for (int r = 0; r < 16; ++r) { e[r] = __expf(unord_key(C[r] & ~255u) - mx); sum += e[r]; }
            const float inv = 1.0f / sum;
            const size_t ob = (size_t)(m0 + token) * 128 + hh * 16;
#pragma unroll
            for (int r = 0; r < 16; ++r) {
                const unsigned code = 255u - (C[r] & 255u);
                const unsigned e0 = NIDX[token * 33 + (code >> 4)], e1 = NIDX[token * 33 + 16 + (code & 15)];
                IDX[ob + r] = (unsigned short)(e0 * 128 + e1);
                GATE[ob + r] = e[r] * inv;
            }
        }
        __syncthreads();
    }
}

__device__ __forceinline__ bf16x8 pack8(const float4 a, const float4 b) {
    u32x4 t; t.x = pack2(a.x, a.y); t.y = pack2(a.z, a.w); t.z = pack2(b.x, b.y); t.w = pack2(b.z, b.w);
    return __builtin_bit_cast(bf16x8, t);
}
__device__ __forceinline__ void fold_query_weights(const Params& p, int vb0 = 0) {
    int lz = 0; asm volatile("" : "+v"(lz));
    const int lane = (VTID & 63) + lz, wid = VTID >> 6, fr = lane & 15, fq = lane >> 4;
    bf16_t* Wf = (bf16_t*)(p.ws + OFF_WT_Q);
    if (VBID < vb0) return;
    for (int task = VBID - vb0; task < 512; task += VGRID - vb0) {
        const int kb = task & 15, pp = (task >> 4) & 1, h = (task >> 5) & 7, layer = task >> 8;
        const float* wq = p.peer_w_q + (size_t)layer * 1024 * 2048 + (size_t)(kb * 64 + fr) * 2048 + h * 256 + pp * 128 + fq * 8;
        const float* sk = p.peer_subkeys + ((size_t)((layer * 8 + h) * 2 + pp) * 128 + wid * 32 + fr) * 128 + fq * 8;
        f32x4 acc[4][2];
#pragma unroll
        for (int kt = 0; kt < 4; ++kt)
#pragma unroll
            for (int jt = 0; jt < 2; ++jt) acc[kt][jt] = (f32x4){0.f, 0.f, 0.f, 0.f};
#pragma unroll 1
        for (int s = 0; s < 4; ++s) {
            bf16x8 a[4], b[2];
#pragma unroll
            for (int kt = 0; kt < 4; ++kt) { const float* q = wq + (size_t)(kt * 16) * 2048 + s * 32; a[kt] = pack8(*(const float4*)q, *(const float4*)(q + 4)); }
#pragma unroll
            for (int jt = 0; jt < 2; ++jt) { const float* q = sk + (size_t)(jt * 16) * 128 + s * 32; b[jt] = pack8(*(const float4*)q, *(const float4*)(q + 4)); }
#pragma unroll
            for (int kt = 0; kt < 4; ++kt)
#pragma unroll
                for (int jt = 0; jt < 2; ++jt) acc[kt][jt] = __builtin_amdgcn_mfma_f32_16x16x32_bf16(a[kt], b[jt], acc[kt][jt], 0, 0, 0);
        }
#pragma unroll
        for (int jt = 0; jt < 2; ++jt) {
            const int key = wid * 32 + jt * 16 + fr, cu = 128 * ((key >> 5) & 1) + 32 * (2 * pp + (key >> 6)) + (key & 31);
            bf16_t* row = Wf + ((size_t)layer * 2048 + h * 256 + cu) * 1024 + kb * 64 + 4 * fq;
#pragma unroll
            for (int kt = 0; kt < 4; ++kt) store_bf16x4(row + kt * 16, acc[kt][jt]);
        }
    }
}
__device__ __forceinline__ void bitonic_merge16_desc(unsigned (&L)[16]) {
#pragma unroll
    for (int j = 8; j > 0; j >>= 1)
#pragma unroll
        for (int i = 0; i < 16; ++i) { const int l = i ^ j; if (l > i) ce_desc(L[i], L[l]); }
}
__device__ __forceinline__ void bitonic_sort8_desc(unsigned (&a)[8]) {
#pragma unroll
    for (int k = 2; k <= 8; k <<= 1)
#pragma unroll
        for (int j = k >> 1; j > 0; j >>= 1)
#pragma unroll
            for (int i = 0; i < 8; ++i) { const int l = i ^ j; if (l > i) { if ((i & k) == 0) ce_desc(a[i], a[l]); else ce_desc(a[l], a[i]); } }
}
struct EpiSelect {
    unsigned* IDX; float* GATE; G8_LAS unsigned* X; const float* SSQP; const unsigned* SCT;
    __device__ __forceinline__ void operator()(const f32x4 (&acc)[2][2][4][2], const g8::Unit& u, int wr, int wc, int fr, int fq) const {
        const int pp = wc >> 1, half = wc & 1, wid = wr * 4 + wc;
        const unsigned kb = 127u - (unsigned)(half * 64 + fq * 8);
        unsigned Lst[4][16];
#pragma unroll
        for (int ai = 0; ai < 2; ++ai)
#pragma unroll
            for (int m = 0; m < 4; ++m) {
                unsigned C[16], Xc[16];
#pragma unroll
                for (int bj = 0; bj < 2; ++bj)
#pragma unroll
                    for (int n = 0; n < 2; ++n)
#pragma unroll
                        for (int r = 0; r < 4; ++r) C[bj * 8 + n * 4 + r] = (ord_key(acc[ai][bj][m][n][r]) & ~127u) | (kb - (unsigned)(bj * 32 + n * 4 + r));
                bitonic_sort16_desc(C);
#pragma unroll
                for (int i = 0; i < 16; ++i) Xc[i] = (unsigned)__shfl_xor((int)C[i], 16);
                merge_top16(C, Xc);
#pragma unroll
                for (int i = 0; i < 16; ++i) Xc[i] = (unsigned)__shfl_xor((int)C[i], 32);
                merge_top16(C, Xc);
                if ((m >> 1) == half) {
#pragma unroll
                    for (int i = 0; i < 16; ++i) Lst[ai * 2 + (m & 1)][i] = C[i];
                } else if (fq == 0) {
                    G8_LAS unsigned* xs = X + (((ai * 2 + wr) * 2 + pp) * 4 + m) * 256 + fr;
#pragma unroll
                    for (int i = 0; i < 16; ++i) xs[(i ^ m) << 4] = C[i];
                }
            }
        __syncthreads();
#pragma unroll
        for (int ai = 0; ai < 2; ++ai)
#pragma unroll
            for (int e = 0; e < 2; ++e) {
                const int m = half * 2 + e;
                unsigned Xc[16];
                G8_LAS unsigned* xs = X + (((ai * 2 + wr) * 2 + pp) * 4 + m) * 256 + fr;
#pragma unroll
                for (int i = 0; i < 16; ++i) Xc[i] = xs[(i ^ m) << 4];
                merge_top16(Lst[ai * 2 + e], Xc);
                if (fq == 0) {
#pragma unroll
                    for (int i = 0; i < 16; ++i) xs[(i ^ m) << 4] = Lst[ai * 2 + e][i];
                }
            }
        __syncthreads();
        if (wid < 4) {
            G8_LAS unsigned* x0 = X + ((wid * 2 + 0) * 4 + fq) * 256 + fr; G8_LAS unsigned* x1 = X + ((wid * 2 + 1) * 4 + fq) * 256 + fr;
            float s0[16], s1[16];
#pragma unroll
            for (int i = 0; i < 16; ++i) { s0[i] = unord_key(x0[(i ^ fq) << 4] & ~127u); s1[i] = unord_key(x1[(i ^ fq) << 4] & ~127u); }
#define SEL_CAND(i, j) ((ord_key(s0[i] + s1[j]) & ~255u) | (unsigned)(255 - ((i) * 16 + (j))))
            unsigned C[16], B[16], M2[16], M3[8];
#pragma unroll
            for (int j = 0; j < 16; ++j) C[j] = SEL_CAND(0, j);
#pragma unroll
            for (int k = 0; k < 15; ++k) B[k] = SEL_CAND(k + 1, 0);
            B[15] = 0u;
            merge_top16(C, B);
#pragma unroll
            for (int j = 0; j < 7; ++j) M2[j] = SEL_CAND(1, j + 1);
            M2[7] = 0u; M2[8] = 0u; M2[9] = 0u;
#pragma unroll
            for (int k = 0; k < 6; ++k) M2[15 - k] = SEL_CAND(k + 2, 1);
            bitonic_merge16_desc(M2);
            M3[0] = SEL_CAND(2, 2); M3[1] = SEL_CAND(2, 3); M3[2] = SEL_CAND(2, 4); M3[3] = SEL_CAND(3, 2); M3[4] = SEL_CAND(4, 2); M3[5] = SEL_CAND(3, 3); M3[6] = 0u; M3[7] = 0u;
            bitonic_sort8_desc(M3);
#pragma unroll
            for (int i = 0; i < 8; ++i) B[i] = M3[i];
#pragma unroll
            for (int i = 8; i < 16; ++i) B[i] = 0u;
            merge_top16(M2, B);
            merge_top16(C, M2);
#undef SEL_CAND
            const int tok = u.pm * 256 + (wid >> 1) * 128 + (wid & 1) * 64 + fq * 16 + fr;
            float rstd;
            {
                const f32x4 q0 = *(const f32x4*)(SSQP + (size_t)tok * 32), q1 = *(const f32x4*)(SSQP + (size_t)tok * 32 + 4), q2 = *(const f32x4*)(SSQP + (size_t)tok * 32 + 8), q3 = *(const f32x4*)(SSQP + (size_t)tok * 32 + 12);
                const f32x4 q = (q0 + q1) + (q2 + q3);
                rstd = rsqrtf(((q[0] + q[1]) + (q[2] + q[3])) * (1.0f / D) + EPS);
            }
            const float mx = unord_key(C[0] & ~255u);
            float e[16]; float sum = 0.f;
#pragma unroll
            for (int r = 0; r < 16; ++r) { e[r] = __expf((unord_key(C[r] & ~255u) - mx) * rstd); sum += e[r]; }
            const float inv = 1.0f / sum;
            const size_t ob = (size_t)tok * 128 + u.pn * 16;
            unsigned iw[16];
#pragma unroll
            for (int r = 0; r < 16; ++r) {
                const unsigned code = 255u - (C[r] & 255u);
                const unsigned e0 = 127u - (x0[((code >> 4) ^ (unsigned)fq) << 4] & 127u), e1 = 127u - (x1[((code & 15u) ^ (unsigned)fq) << 4] & 127u);
                iw[r] = e0 * 128u + e1;
            }
            unsigned sc[16];
#pragma unroll
            for (int r = 0; r < 16; ++r) sc[r] = SCT[iw[r]];
#pragma unroll
            for (int r = 0; r < 16; ++r) {
                iw[r] |= sc[r] << 16;
                e[r] *= inv * (float)__builtin_bit_cast(_Float16, (unsigned short)(sc[r] >> 16));
            }
#pragma unroll
            for (int r = 0; r < 4; ++r) *(uint4*)(IDX + ob + r * 4) = make_uint4(iw[4 * r], iw[4 * r + 1], iw[4 * r + 2], iw[4 * r + 3]);
#pragma unroll
            for (int r = 0; r < 4; ++r) *(float4*)(GATE + ob + r * 4) = make_float4(e[4 * r], e[4 * r + 1], e[4 * r + 2], e[4 * r + 3]);
        }
        __syncthreads();
    }
};
__device__ __forceinline__ void phase_select8(const Params& p, int layer, char* smem_phys) {
    const bf16_t* H = (const bf16_t*)(p.ws + OFF_H); const bf16_t* Wf = (const bf16_t*)(p.ws + OFF_WT_Q) + (size_t)layer * 2048 * 1024;
    g8::Gemm g{H, H, 1024, 1024, Wf, T, 2048, 1024};
    g8::StaticOrder S; S.init(T, 2048, (int)gridDim.x, (int)blockIdx.x);
    EpiSelect E{(unsigned*)(p.ws + OFF_IDX), (float*)(p.ws + OFF_GATE), (G8_LAS unsigned*)(smem_phys + 131072), (const float*)(p.ws + OFF_SSQ), (const unsigned*)(p.ws + OFF_USC) + (size_t)layer * NEXP};
    g8::gemm_phase<EpiSelect>((G8_LAS unsigned char*)smem_phys, g, S, E);
    __syncthreads();
    if (threadIdx.x == 0) *(uint4*)(smem_phys + kDynLds - 16) = make_uint4(0u, 0u, 0u, 0u);
    __syncthreads();
}

__device__ __forceinline__ float ub0(unsigned w) { float f; asm("v_cvt_f32_ubyte0 %0, %1" : "=v"(f) : "v"(w)); return f; }
__device__ __forceinline__ float ub1(unsigned w) { float f; asm("v_cvt_f32_ubyte1 %0, %1" : "=v"(f) : "v"(w)); return f; }
__device__ __forceinline__ float ub2(unsigned w) { float f; asm("v_cvt_f32_ubyte2 %0, %1" : "=v"(f) : "v"(w)); return f; }
__device__ __forceinline__ float ub3(unsigned w) { float f; asm("v_cvt_f32_ubyte3 %0, %1" : "=v"(f) : "v"(w)); return f; }
typedef _Float16 f16x2 __attribute__((ext_vector_type(2)));
__device__ __forceinline__ void glds16(const void* gsrc, unsigned lds_dst) {
    unsigned keep; const unsigned d = (unsigned)__builtin_amdgcn_readfirstlane((int)lds_dst);
    asm volatile("s_mov_b32 %0, m0\n\ts_mov_b32 m0, %2\n\ts_nop 0\n\tglobal_load_lds_dwordx4 %1, off\n\ts_mov_b32 m0, %0" : "=&s"(keep) : "v"(gsrc), "s"(d) : "memory");
}
__device__ __forceinline__ void peer_gather(const Params& p, int layer, const float* __restrict__ gnext, bool final_out, char* smem) {
    const unsigned char* REC = p.ws + OFF_UT + (size_t)layer * NEXP * 1024;
    bf16_t* H = (bf16_t*)(p.ws + OFF_H);
    const unsigned* IDX = (const unsigned*)(p.ws + OFF_IDX); const float* GATE = (const float*)(p.ws + OFF_GATE);
    float* X = p.out;
    const int lane = VTID & 63, wid = VTID >> 6, sub = lane >> 4, li = lane & 15;
    char* wbase = smem + (int)(threadIdx.x >> 6) * 17408;
    unsigned* sIdx = (unsigned*)wbase; float* sGate = (float*)(wbase + 512);
    const char* ring = wbase + 1024; const unsigned ringb = (unsigned)(size_t)ring;
    const int gw = VBID * 4 + wid, nw = VGRID * 4;
    for (int t = gw; t < T; t += nw) {
        {
            int lz = 0; asm volatile("" : "+v"(lz));
            const int l2 = 2 * (lane + lz);
            const uint2 idp = *(const uint2*)(IDX + (size_t)t * 128 + l2);
            const float2 g2 = *(const float2*)(GATE + (size_t)t * 128 + l2);
            *(uint2*)(sIdx + l2) = idp; *(float2*)(sGate + l2) = g2;
        }
        int XH[2][4], XL[2][4]; float sx; float xg;
        {
            u32x4 xr[8]; float am = 0.f;
#pragma unroll
            for (int k = 0; k < 8; ++k) {
                xr[k] = *(const u32x4*)(H + (size_t)t * 1024 + (16 * (k >> 2) + li) * 32 + (k & 3) * 8);
#pragma unroll
                for (int c = 0; c < 4; ++c) am = fmaxf(am, fmaxf(fabsf(lo2f(xr[k][c])), fabsf(hi2f(xr[k][c]))));
            }
            const float* sq = (const float*)(p.ws + OFF_SSQ) + (size_t)t * 32;
            const f32x4 qs = (*(const f32x4*)sq + *(const f32x4*)(sq + 4)) + (*(const f32x4*)(sq + 8) + *(const f32x4*)(sq + 12));
            am = fmaxf(am, __shfl_xor(am, 1)); am = fmaxf(am, __shfl_xor(am, 2)); am = fmaxf(am, __shfl_xor(am, 4)); am = fmaxf(am, __shfl_xor(am, 8));
            const float inv = am > 0.f ? 119.0f / am : 0.f;
            sx = am * (1.0f / 119.0f) * rsqrtf(((qs[0] + qs[1]) + (qs[2] + qs[3])) * (1.0f / D) + EPS);
            int xs = 0;
#pragma unroll
            for (int j = 0; j < 2; ++j)
#pragma unroll
                for (int d = 0; d < 4; ++d) {
                    const u32x4 raw = xr[j * 4 + d];
                    unsigned lo = 0u, hi = 0u;
#pragma unroll
                    for (int i = 0; i < 8; ++i) {
                        const unsigned wsrc = raw[i >> 1];
                        const int q = __float2int_rn(((i & 1) ? hi2f(wsrc) : lo2f(wsrc)) * inv);
                        const int sh = (i & 3) * 8 + (i >> 2) * 4;
                        lo |= ((unsigned)q & 15u) << sh; hi |= ((unsigned)((q + 8) >> 4) & 15u) << sh;
                        xs += q;
                    }
                    XL[j][d] = (int)lo; XH[j][d] = (int)hi;
                }
            xg = 0.5f * (float)xs;
        }
        f16x2 accp[2][16];
#pragma unroll
        for (int j = 0; j < 2; ++j)
#pragma unroll
            for (int c = 0; c < 16; ++c) accp[j][c] = (f16x2){(_Float16)0.f, (_Float16)0.f};
        float wsg = 0.f;
        auto issue = [&](int sg) {
            const unsigned e_ = sIdx[sg * 4 + sub] & 0xffffu;
            const unsigned char* rec = REC + (size_t)e_ * 1024 + li * 16;
            const unsigned dst = ringb + (unsigned)(sg & 3) * 4096u;
            glds16(rec, dst); glds16(rec + 256, dst + 1024u); glds16(rec + 512, dst + 2048u); glds16(rec + 768, dst + 3072u);
        };
        auto compute = [&](int sg, bool refill) {
            const char* sl = ring + (sg & 3) * 4096;
            const u32x4 du0 = *(const u32x4*)(sl + lane * 16), du1 = *(const u32x4*)(sl + 1024 + lane * 16);
            const u32x4 dv0 = *(const u32x4*)(sl + 2048 + lane * 16), dv1 = *(const u32x4*)(sl + 3072 + lane * 16);
            const float us = (float)__builtin_bit_cast(_Float16, (unsigned short)(sIdx[sg * 4 + sub] >> 16));
            const float gt = sGate[sg * 4 + sub];
            if (refill) { asm volatile("s_waitcnt lgkmcnt(0)" ::: "memory"); issue(sg + 4); }
            int iah = 0, ial = 0;
#pragma unroll
            for (int j = 0; j < 2; ++j) {
#pragma unroll
                for (int d = 0; d < 4; ++d) {
                    const int w = (int)(j ? du1[d] : du0[d]);
                    iah = __builtin_amdgcn_sdot8(w, XH[j][d], iah, false);
                    ial = __builtin_amdgcn_sdot8(w, XL[j][d], ial, false);
                }
            }
            float pa = us * ((float)(16 * iah + ial) + xg);
            pa = row16_sum(pa);
            const float ww = gt * gelu_exact(pa * sx);
            wsg += ww;
            const float wc = fminf(fmaxf(ww * 65536.0f, -65504.0f), 65504.0f);
            const _Float16 wha = (_Float16)wc, whb = (_Float16)(wc * 0.0625f);
            const f16x2 wa = {wha, wha}, wb = {whb, whb};
#pragma unroll
            for (int j = 0; j < 2; ++j) {
#pragma unroll
                for (int d = 0; d < 4; ++d) {
                    const unsigned wv = j ? dv1[d] : dv0[d], wt = wv >> 8;
                    const f16x2 c0 = __builtin_bit_cast(f16x2, wv & 0x000f000fu), c1 = __builtin_bit_cast(f16x2, wv & 0x00f000f0u);
                    const f16x2 c2 = __builtin_bit_cast(f16x2, wt & 0x000f000fu), c3 = __builtin_bit_cast(f16x2, wt & 0x00f000f0u);
                    accp[j][4 * d + 0] = __builtin_elementwise_fma(c0, wa, accp[j][4 * d + 0]); accp[j][4 * d + 1] = __builtin_elementwise_fma(c1, wb, accp[j][4 * d + 1]);
                    accp[j][4 * d + 2] = __builtin_elementwise_fma(c2, wa, accp[j][4 * d + 2]); accp[j][4 * d + 3] = __builtin_elementwise_fma(c3, wb, accp[j][4 * d + 3]);
                }
            }
        };
        asm volatile("s_waitcnt vmcnt(0)" ::: "memory");
        issue(0); issue(1); issue(2); issue(3);
#pragma unroll 1
        for (int sg = 0; sg < 28; ++sg) {
            asm volatile("s_waitcnt vmcnt(12)" ::: "memory");
            compute(sg, true);
        }
        asm volatile("s_waitcnt vmcnt(12)" ::: "memory");
        compute(28, false);
        asm volatile("s_waitcnt vmcnt(8)" ::: "memory");
        compute(29, false);
        asm volatile("s_waitcnt vmcnt(4)" ::: "memory");
        compute(30, false);
        asm volatile("s_waitcnt vmcnt(0)" ::: "memory");
        compute(31, false);
        float acc[2][32];
#pragma unroll
        for (int j = 0; j < 2; ++j)
#pragma unroll
            for (int d = 0; d < 4; ++d) {
                acc[j][8 * d + 0] = 256.0f * (float)accp[j][4 * d + 0][0]; acc[j][8 * d + 2] = 256.0f * (float)accp[j][4 * d + 0][1];
                acc[j][8 * d + 4] = 256.0f * (float)accp[j][4 * d + 1][0]; acc[j][8 * d + 6] = 256.0f * (float)accp[j][4 * d + 1][1];
                acc[j][8 * d + 1] = 256.0f * (float)accp[j][4 * d + 2][0]; acc[j][8 * d + 3] = 256.0f * (float)accp[j][4 * d + 2][1];
                acc[j][8 * d + 5] = 256.0f * (float)accp[j][4 * d + 3][0]; acc[j][8 * d + 7] = 256.0f * (float)accp[j][4 * d + 3][1];
            }
        const bool up2 = (sub & 2) != 0, up1 = (sub & 1) != 0;
        float wsum = wsg + __shfl_xor(wsg, 32);
        wsum += __shfl_xor(wsum, 16);
        float r1[32];
#pragma unroll
        for (int c = 0; c < 32; ++c) r1[c] = (up2 ? acc[1][c] : acc[0][c]) + __shfl_xor(up2 ? acc[0][c] : acc[1][c], 32);
        float r2[16];
#pragma unroll
        for (int c = 0; c < 16; ++c) r2[c] = (up1 ? r1[16 + c] : r1[c]) + __shfl_xor(up1 ? r1[c] : r1[16 + c], 16);
        const int col0 = (16 * (sub >> 1) + li) * 32 + (sub & 1) * 16;
        float ss = 0.f;
        float* xrow = X + (size_t)t * 1024 + col0;
#pragma unroll
        for (int c4 = 0; c4 < 4; ++c4) {
            const f32x4 a = *(const f32x4*)(xrow + c4 * 4);
#pragma unroll
            for (int c = 0; c < 4; ++c) { r2[c4 * 4 + c] = r2[c4 * 4 + c] - 7.5f * wsum + a[c]; ss += r2[c4 * 4 + c] * r2[c4 * 4 + c]; }
        }
        ss = wave_sum(ss);
        const float rstd = rsqrtf(ss * (1.0f / D) + EPS);
        const float* gp = gnext + col0;
        if (final_out) {
#pragma unroll
            for (int c4 = 0; c4 < 4; ++c4) {
                const f32x4 g = *(const f32x4*)(gp + c4 * 4);
                *(f32x4*)(xrow + c4 * 4) = (f32x4){r2[c4 * 4] * rstd * g[0], r2[c4 * 4 + 1] * rstd * g[1], r2[c4 * 4 + 2] * rstd * g[2], r2[c4 * 4 + 3] * rstd * g[3]};
            }
        } else {
            u32x4 o[2];
#pragma unroll
            for (int c4 = 0; c4 < 4; ++c4) {
                const f32x4 g = *(const f32x4*)(gp + c4 * 4);
                *(f32x4*)(xrow + c4 * 4) = (f32x4){r2[c4 * 4], r2[c4 * 4 + 1], r2[c4 * 4 + 2], r2[c4 * 4 + 3]};
                o[c4 >> 1][(c4 & 1) * 2] = pack2(r2[c4 * 4] * rstd * g[0], r2[c4 * 4 + 1] * rstd * g[1]);
                o[c4 >> 1][(c4 & 1) * 2 + 1] = pack2(r2[c4 * 4 + 2] * rstd * g[2], r2[c4 * 4 + 3] * rstd * g[3]);
            }
            bf16_t* hp = H + (size_t)t * 1024 + col0;
            *(u32x4*)hp = o[0]; *(u32x4*)(hp + 8) = o[1];
        }
    }
}

__device__ __forceinline__ void spatial_fast(const Params& p, char* smem) {
    bf16_t* U = (bf16_t*)(p.ws + OFF_REGION); const bf16_t* VT = U + (size_t)T * 2048; const float* SSQ = (const float*)(p.ws + OFF_SSQ);
    const int tid_ = VTID;
    for (int task = VBID; task < 2048; task += VGRID) {
        const int chunk = task >> 3, g = task & 7;
        int lz = 0; asm volatile("" : "+v"(lz));
        const int tid = tid_ + lz, lane = tid & 63, wid = tid >> 6, wm = wid >> 1, wn = wid & 1, l15 = lane & 15, q4 = lane >> 4;
        float* rs = (float*)(smem + 16384);
        if (tid < 128) {
            const float* sp = SSQ + (size_t)(chunk * 128 + tid) * 32;
            float s = 0.f;
#pragma unroll
            for (int i = 0; i < 8; ++i) { const f32x4 v = *(const f32x4*)(sp + 4 * i); s += (v[0] + v[1]) + (v[2] + v[3]); }
            rs[tid] = rsqrtf(s * (1.0f / 2048.0f) + EPS);
        }
        __syncthreads();
#pragma unroll
        for (int i = 0; i < 8; ++i) {
            const int c = tid + 256 * i, row = c >> 4, ch16 = c & 15, ks = ch16 >> 3, ch = ch16 & 7, s0 = ch16 * 8;
            const float* wp = p.c_w_spatial + ((size_t)(g * 128 + row)) * 128 + s0;
            const f32x4 w0 = *(const f32x4*)wp, w1 = *(const f32x4*)(wp + 4);
            const f32x4 r0 = *(const f32x4*)(rs + s0), r1 = *(const f32x4*)(rs + s0 + 4);
            float v[8];
#pragma unroll
            for (int j = 0; j < 4; ++j) { v[j] = (s0 + j <= row) ? w0[j] * r0[j] : 0.f; v[4 + j] = (s0 + 4 + j <= row) ? w1[j] * r1[j] : 0.f; }
            *(uint4*)(smem + ks * 32768 + row * 128 + ((ch ^ (row & 7)) << 4)) = make_uint4(pack2(v[0], v[1]), pack2(v[2], v[3]), pack2(v[4], v[5]), pack2(v[6], v[7]));
        }
        __syncthreads();
#pragma unroll 1
        for (int nh = 0; nh < 2; ++nh) {
            const int chan0 = g * 256 + nh * 128;
#pragma unroll
            for (int i = 0; i < 8; ++i) {
                const int c = tid + 256 * i, row = c >> 4, ch16 = c & 15, ks = ch16 >> 3, ch = ch16 & 7;
                *(uint4*)(smem + ks * 32768 + 16384 + row * 128 + ((ch ^ (row & 7)) << 4)) = *(const uint4*)(VT + ((size_t)chunk * 2048 + chan0 + row) * 128 + ch16 * 8);
            }
            __syncthreads();
            f32x4 acc[4][4];
#pragma unroll
            for (int i = 0; i < 4; ++i)
#pragma unroll
                for (int j = 0; j < 4; ++j) acc[i][j] = (f32x4){0.f, 0.f, 0.f, 0.f};
#pragma unroll
            for (int kt = 0; kt < 2; ++kt) {
                if (kt == 1 && wm == 0) continue;
                const char* sa = smem + kt * 32768; const char* sb = sa + 16384;
#pragma unroll
                for (int ks = 0; ks < 2; ++ks) {
                    bf16x8 af[4], bfr[4];
                    const int ch = ks * 4 + q4;
#pragma unroll
                    for (int i = 0; i < 4; ++i) { const int row = wm * 64 + i * 16 + l15; af[i] = *(const bf16x8*)(sa + row * 128 + ((ch ^ (row & 7)) << 4)); }
#pragma unroll
                    for (int j = 0; j < 4; ++j) { const int row = wn * 64 + j * 16 + l15; bfr[j] = *(const bf16x8*)(sb + row * 128 + ((ch ^ (row & 7)) << 4)); }
#pragma unroll
                    for (int i = 0; i < 4; ++i)
#pragma unroll
                        for (int j = 0; j < 4; ++j) acc[i][j] = __builtin_amdgcn_mfma_f32_16x16x32_bf16(bfr[j], af[i], acc[i][j], 0, 0, 0);
                }
            }
            __syncthreads();
#pragma unroll
            for (int i = 0; i < 4; ++i) {
                const int m = wm * 64 + i * 16 + l15;
                const float bias = p.c_b_spatial[g * 128 + m];
#pragma unroll
                for (int j = 0; j < 4; ++j) {
                    const int chan = chan0 + wn * 64 + j * 16 + 4 * q4;
                    const f32x4 vn = *(const f32x4*)(p.c_v_norm + chan);
                    bf16_t* up = U + (size_t)(chunk * 128 + m) * 2048 + chan;
                    const uint2 uu = *(const uint2*)up;
                    uint2 o;
                    o.x = pack2(lo2f(uu.x) * (vn[0] * acc[i][j][0] + bias), hi2f(uu.x) * (vn[1] * acc[i][j][1] + bias));
                    o.y = pack2(lo2f(uu.y) * (vn[2] * acc[i][j][2] + bias), hi2f(uu.y) * (vn[3] * acc[i][j][3] + bias));
                    *(uint2*)up = o;
                }
            }
        }
    }
}

#define XB_TMO      128
#define XB_XCNT(j)  (256  + 64 * (j))
#define XB_XSUB(j)  (1280 + 64 * (j))
#define XB_XGEN(j)  (2304 + 64 * (j))
#define XB_TOP      3328
#define XB_TOPGEN   3392
#define XCD_BAR_WORDS 3456
#define XB_SPIN_CAP (1u << 22)
#define LAS __attribute__((address_space(3)))
__device__ __forceinline__ unsigned xb_ld(unsigned* p)              { return __hip_atomic_load(p, __ATOMIC_RELAXED, __HIP_MEMORY_SCOPE_AGENT); }
__device__ __forceinline__ unsigned xb_add(unsigned* p, unsigned v) { return __hip_atomic_fetch_add(p, v, __ATOMIC_RELAXED, __HIP_MEMORY_SCOPE_AGENT); }
__device__ __forceinline__ unsigned xb_xcc_id() { return (unsigned)__builtin_amdgcn_s_getreg((3 << 11) | 20) & 0xFu; }
#define XB_SPIN(cond, bar) do { unsigned _sp = 0; while (cond) { __builtin_amdgcn_s_sleep(1); \
    if ((++_sp & 255u) == 0u) { if (xb_ld(&(bar)[XB_TMO])) break; if (_sp > XB_SPIN_CAP) { atomicAdd(&(bar)[XB_TMO], 1u); break; } } } } while (0)
struct XcdBarrier { unsigned* bar; unsigned x; volatile LAS unsigned* st; };
__device__ __forceinline__ XcdBarrier xcd_barrier_post(unsigned* bar, volatile LAS unsigned* st) {
    XcdBarrier b; b.bar = bar; b.x = xb_xcc_id(); b.st = st;
    if (threadIdx.x == 0) (void)xb_add(&bar[XB_XCNT(b.x)], 1u);
    return b;
}
__device__ __forceinline__ void xcd_barrier_complete(unsigned* bar, unsigned x, unsigned& nloc, unsigned& nx) {
    const unsigned G = gridDim.x * gridDim.y * gridDim.z;
    unsigned sum, cnt, mine, sp = 0u;
    for (;;) {
        sum = 0u; cnt = 0u; mine = 0u;
#pragma unroll
        for (unsigned j = 0; j < 16; ++j) { const unsigned c = xb_ld(&bar[XB_XCNT(j)]); sum += c; cnt += (c > 0u) ? 1u : 0u; mine = (j == x) ? c : mine; }
        if (sum == G) break;
        __builtin_amdgcn_s_sleep(1);
        if ((++sp & 255u) == 0u) { if (xb_ld(&bar[XB_TMO])) break; if (sp > XB_SPIN_CAP) { atomicAdd(&bar[XB_TMO], 1u); break; } }
    }
    nloc = mine > 0u ? mine : 1u; nx = cnt > 0u ? cnt : 1u;
}
__device__ __forceinline__ void xcd_barrier(const XcdBarrier& b) {
    asm volatile("s_waitcnt vmcnt(0)" ::: "memory");
    __syncthreads();
    if (threadIdx.x == 0) {
        unsigned* bar = b.bar;
        __builtin_amdgcn_s_waitcnt(0);
        unsigned nloc = b.st[0], nx = b.st[1];
        if (nloc == 0u) { xcd_barrier_complete(bar, b.x, nloc, nx); b.st[0] = nloc; b.st[1] = nx; }
        const unsigned old = xb_add(&bar[XB_XSUB(b.x)], 1u);
        const unsigned gen = old / nloc;
        if (old + 1u == (gen + 1u) * nloc) {
            __builtin_amdgcn_fence(__ATOMIC_RELEASE, "agent");
            asm volatile("s_waitcnt vmcnt(0)" ::: "memory");
            const unsigned og = xb_add(&bar[XB_TOP], 1u);
            const unsigned tg = og / nx;
            if (og + 1u == (tg + 1u) * nx) xb_add(&bar[XB_TOPGEN], 1u);
            else XB_SPIN(xb_ld(&bar[XB_TOPGEN]) == tg, bar);
            __builtin_amdgcn_fence(__ATOMIC_ACQUIRE, "agent");
            xb_add(&bar[XB_XGEN(b.x)], 1u);
            asm volatile("s_waitcnt vmcnt(0)" ::: "memory");
        } else {
            XB_SPIN(xb_ld(&bar[XB_XGEN(b.x)]) == gen, bar);
            __builtin_amdgcn_fence(__ATOMIC_ACQUIRE, "agent");
            asm volatile("s_waitcnt vmcnt(0)" ::: "memory");
        }
    }
    __syncthreads();
}

constexpr int NPHASE = 12;
__global__ void __launch_bounds__(512, 2) mega(Params p, int ph_lo, int ph_hi) {
    extern __shared__ __attribute__((aligned(16))) char smem_phys[];
    uint4& xb_words = *(uint4*)(smem_phys + kDynLds - 16);
    if (threadIdx.x == 0) xb_words = make_uint4(0u, 0u, 0u, 0u);
    __syncthreads();
    const XcdBarrier xbar = xcd_barrier_post((unsigned*)(p.ws + OFF_BAR), (volatile LAS unsigned*)&xb_words);
    char* smem = smem_phys + (threadIdx.x >> 8) * 65536;
    bf16_t* Rg = (bf16_t*)(p.ws + OFF_REGION);
    bf16_t* Hb = (bf16_t*)(p.ws + OFF_H);
#define PHASE(k, ...) if (ph_lo <= (k) && (k) < ph_hi) { __VA_ARGS__; if ((k) + 1 < ph_hi) xcd_barrier(xbar); }
    unsigned* sbctr = (unsigned*)(p.ws + OFF_BAR + 14336);
    PHASE(0,
        transpose_convert<true>(p.ab_w_in, (bf16_t*)(p.ws + OFF_WT_IN), 1024, AB_IN, AB_IN_PAD, smem);
        rmsnorm_rows(p.x, p.norm_mix, Hb))
    PHASE(1, phase_gemm_in8(p, smem_phys))
    PHASE(2, gla_prep(p, smem))
    PHASE(3, gla_scan(p, smem); sb_fast(p, smem_phys + 98304, sbctr);
        quantize_tables_static(p, 64);
        transpose_convert(p.ab_w_out, (bf16_t*)(p.ws + OFF_WT_OUT), 1024, 1024, 1024, smem, 64);
        transpose_convert(p.c_w_in, (bf16_t*)(p.ws + OFF_WT_CIN), 1024, 4096, 4096, smem, 64);
        transpose_convert(p.c_w_out, (bf16_t*)(p.ws + OFF_WT_COUT), 2048, 1024, 1024, smem, 64);
        fold_query_weights(p, 64))
    PHASE(4, phase_gemm_resid8(Rg + R_QSB, Rg + R_GG, 512, 512, (const bf16_t*)(p.ws + OFF_WT_OUT), 1024, p.x, p.out, Hb, (float*)(p.ws + OFF_SSQ), p.norm_ffn, smem_phys))
    PHASE(5, phase_select8(p, 0, smem_phys))
    PHASE(6, peer_gather(p, 0, p.norm_mix + 1024, false, smem_phys))
    PHASE(7, phase_gemm_cin8(p, smem_phys))
    PHASE(8, spatial_fast(p, smem))
    PHASE(9, phase_gemm_resid8(Rg, Rg, 2048, 2048, (const bf16_t*)(p.ws + OFF_WT_COUT), 2048, p.out, p.out, Hb, (float*)(p.ws + OFF_SSQ), p.norm_ffn + 1024, smem_phys))
    PHASE(10, phase_select8(p, 1, smem_phys))
    PHASE(11, peer_gather(p, 1, p.final_norm, true, smem_phys))
}

extern "C" void kernel_launch(void* const* d_in, const int* in_sizes, int n_in, void* d_out, int out_size, void* d_ws, size_t ws_size, hipStream_t stream) {
    static int grid_blocks = 0;
    if (!grid_blocks) {
        int dev = 0, cus = 0, per_cu = 0;
        hipGetDevice(&dev);
        hipDeviceGetAttribute(&cus, hipDeviceAttributeMultiprocessorCount, dev);
        hipFuncSetAttribute((const void*)mega, hipFuncAttributeMaxDynamicSharedMemorySize, kDynLds);
        hipOccupancyMaxActiveBlocksPerMultiprocessor(&per_cu, mega, 512, kDynLds);
        if (per_cu < 1) per_cu = 1;
        if (per_cu > 1) per_cu = 1;
        grid_blocks = cus * per_cu;
        if (n_in != 18 || ws_size < WS_END) fprintf(stderr, "kernel_launch: unexpected n_in %d or ws_size %zu < %zu\n", n_in, ws_size, (size_t)WS_END);
    }
    Params p{};
    p.x = (const float*)d_in[0]; p.norm_mix = (const float*)d_in[1]; p.norm_ffn = (const float*)d_in[2]; p.ab_w_in = (const float*)d_in[3];
    p.ab_w_alpha2 = (const float*)d_in[4]; p.ab_b_alpha2 = (const float*)d_in[5]; p.ab_gla_norm = (const float*)d_in[6]; p.ab_w_out = (const float*)d_in[7];
    p.c_w_in = (const float*)d_in[8]; p.c_v_norm = (const float*)d_in[9]; p.c_w_spatial = (const float*)d_in[10]; p.c_b_spatial = (const float*)d_in[11];
    p.c_w_out = (const float*)d_in[12]; p.peer_w_q = (const float*)d_in[13]; p.peer_subkeys = (const float*)d_in[14]; p.peer_u = (const float*)d_in[15];
    p.peer_v = (const float*)d_in[16]; p.final_norm = (const float*)d_in[17];
    p.out = (float*)d_out; p.ws = (unsigned char*)d_ws;
    (void)hipMemsetAsync((char*)d_ws + OFF_BAR, 0, 16384, stream);
#if ONE_LAUNCH
    int lo = 0, hi = NPHASE;
    void* args[] = {&p, &lo, &hi};
    hipError_t e = hipLaunchCooperativeKernel((void*)mega, dim3(grid_blocks), dim3(512), args, kDynLds, stream);
    if (e != hipSuccess) fprintf(stderr, "cooperative launch failed: %s (grid %d)\n", hipGetErrorString(e), grid_blocks);
#else
    for (int ph = 0; ph < NPHASE; ++ph) hipLaunchKernelGGL(mega, dim3(grid_blocks), dim3(512), kDynLds, stream, p, ph, ph + 1);
#endif
}
```

```cpp
#include <hip/hip_runtime.h>
#include <hip/hip_cooperative_groups.h>
#include <cstdio>
#include <cstdint>
namespace cg = cooperative_groups;

#ifndef ONE_LAUNCH
#define ONE_LAUNCH 1
#endif


#define VTID ((int)(threadIdx.x & 255))
#define VBID ((int)(blockIdx.x * 2 + (threadIdx.x >> 8)))
#define VGRID ((int)(gridDim.x * 2))
typedef unsigned short bf16_t;
typedef short bf16x8 __attribute__((ext_vector_type(8)));
typedef float f32x4 __attribute__((ext_vector_type(4)));
typedef unsigned u32x4 __attribute__((ext_vector_type(4)));
typedef __bf16 bf16x2_t __attribute__((ext_vector_type(2)));

constexpr int T = 32768, D = 1024, SEQ = 2048, NB = 16;
constexpr int AB_IN = 3088, AB_IN_PAD = 3200;
constexpr float EPS = 1e-6f;
constexpr int NEXP = 16384;
constexpr int kDynLds = 163840;

constexpr size_t SZ_WT_IN = (size_t)AB_IN_PAD * 1024 * 2;
constexpr size_t SZ_WT_OUT = (size_t)1024 * 1024 * 2;
constexpr size_t SZ_WT_CIN = (size_t)4096 * 1024 * 2;
constexpr size_t SZ_WT_COUT = (size_t)1024 * 2048 * 2;
constexpr size_t SZ_WT_Q = (size_t)2 * 2048 * 1024 * 2;
constexpr size_t SZ_SK = (size_t)2 * 8 * 2 * 128 * 128 * 2;
constexpr size_t SZ_TAB = (size_t)2 * NEXP * 1024;
constexpr size_t SZ_TSC = (size_t)2 * NEXP * 4;
constexpr size_t OFF_WT_IN = 0;
constexpr size_t OFF_WT_OUT = OFF_WT_IN + SZ_WT_IN;
constexpr size_t OFF_WT_CIN = OFF_WT_OUT + SZ_WT_OUT;
constexpr size_t OFF_WT_COUT = OFF_WT_CIN + SZ_WT_CIN;
constexpr size_t OFF_WT_Q = OFF_WT_COUT + SZ_WT_COUT;
constexpr size_t OFF_SK = OFF_WT_Q + SZ_WT_Q;
constexpr size_t OFF_UT = OFF_SK + SZ_SK;
constexpr size_t OFF_VT = OFF_UT + SZ_TAB;
constexpr size_t OFF_USC = OFF_VT + SZ_TAB;
constexpr size_t OFF_VSC = OFF_USC + SZ_TSC;
constexpr size_t OFF_H = OFF_VSC + SZ_TSC;
constexpr size_t OFF_IDX = OFF_H + (size_t)T * 1024 * 2;
constexpr size_t OFF_GATE = OFF_IDX + (size_t)T * 128 * 4;
constexpr size_t OFF_SSQ = OFF_GATE + (size_t)T * 128 * 4;
constexpr size_t OFF_REGION = OFF_SSQ + (size_t)T * 32 * 4;
constexpr size_t SZ_REGION = (size_t)256 << 20;
constexpr size_t OFF_BAR = OFF_REGION + SZ_REGION;
constexpr size_t WS_END = OFF_BAR + 16384;
constexpr size_t R_QSB = 0;
constexpr size_t R_KSB = R_QSB + (size_t)T * 512;
constexpr size_t R_VTSB = R_KSB + (size_t)T * 512;
constexpr size_t R_QG = R_VTSB + (size_t)T * 512;
constexpr size_t R_KG = R_QG + (size_t)T * 256;
constexpr size_t R_VTG = R_KG + (size_t)T * 256;
constexpr size_t R_GG = R_VTG + (size_t)T * 512;
constexpr size_t R_ALR = R_GG + (size_t)T * 512;
constexpr size_t R_KOT = R_ALR + (size_t)T * 32;
constexpr size_t R_DEC = R_KOT + (size_t)T * 256;

struct Params {
    const float* x; const float* norm_mix; const float* norm_ffn; const float* ab_w_in; const float* ab_w_alpha2; const float* ab_b_alpha2;
    const float* ab_gla_norm; const float* ab_w_out; const float* c_w_in; const float* c_v_norm; const float* c_w_spatial; const float* c_b_spatial;
    const float* c_w_out; const float* peer_w_q; const float* peer_subkeys; const float* peer_u; const float* peer_v; const float* final_norm;
    float* out; unsigned char* ws;
};

__device__ __forceinline__ float bf2f(bf16_t v) { return __uint_as_float(((unsigned)v) << 16); }
__device__ __forceinline__ bf16_t f2bf(float f) { unsigned r; asm("v_cvt_pk_bf16_f32 %0, %1, %1" : "=v"(r) : "v"(f)); return (bf16_t)r; }
__device__ __forceinline__ unsigned pack2(float lo, float hi) { unsigned r; asm("v_cvt_pk_bf16_f32 %0, %1, %2" : "=v"(r) : "v"(lo), "v"(hi)); return r; }
__device__ __forceinline__ float lo2f(unsigned w) { return __uint_as_float(w << 16); }
__device__ __forceinline__ float hi2f(unsigned w) { return __uint_as_float(w & 0xffff0000u); }
__device__ __forceinline__ float dot2(unsigned a, unsigned b, float acc) { return __builtin_amdgcn_fdot2_f32_bf16(__builtin_bit_cast(bf16x2_t, a), __builtin_bit_cast(bf16x2_t, b), acc, false); }
#define GELU_C0 -1.0001451969146729f
#define GELU_C1 -1.1498452425003052f
#define GELU_C2 -0.46162763237953186f
#define GELU_C3 -0.051034148782491684f
#define GELU_C4 0.007168652955442667f
#define GELU_C5 -0.0006095620337873697f
#define GELU_C6 2.30170971917687e-05f
__device__ __forceinline__ float gelu_exact(float v) {
    const float a = fminf(fabsf(v), 6.0f);
    float q = GELU_C6 * a + GELU_C5; q = q * a + GELU_C4; q = q * a + GELU_C3; q = q * a + GELU_C2; q = q * a + GELU_C1; q = q * a + GELU_C0;
    return fmaxf(v, 0.f) - fabsf(v) * __builtin_amdgcn_exp2f(q);
}
typedef float f32x2 __attribute__((ext_vector_type(2)));
__device__ __forceinline__ f32x2 gelu_exact2(f32x2 v) {
    const f32x2 av = __builtin_elementwise_abs(v), a = __builtin_elementwise_min(av, (f32x2){6.0f, 6.0f});
    f32x2 q = (f32x2){GELU_C6, GELU_C6} * a + (f32x2){GELU_C5, GELU_C5};
    q = q * a + (f32x2){GELU_C4, GELU_C4}; q = q * a + (f32x2){GELU_C3, GELU_C3}; q = q * a + (f32x2){GELU_C2, GELU_C2};
    q = q * a + (f32x2){GELU_C1, GELU_C1}; q = q * a + (f32x2){GELU_C0, GELU_C0};
    const f32x2 e = {__builtin_amdgcn_exp2f(q[0]), __builtin_amdgcn_exp2f(q[1])};
    return __builtin_elementwise_max(v, (f32x2){0.f, 0.f}) - av * e;
}
__device__ __forceinline__ float row16_sum(float v) {
    v += __builtin_bit_cast(float, __builtin_amdgcn_update_dpp(0, __builtin_bit_cast(int, v), 0x128, 0xf, 0xf, false));
    v += __builtin_bit_cast(float, __builtin_amdgcn_update_dpp(0, __builtin_bit_cast(int, v), 0x124, 0xf, 0xf, false));
    v += __builtin_bit_cast(float, __builtin_amdgcn_update_dpp(0, __builtin_bit_cast(int, v), 0x122, 0xf, 0xf, false));
    v += __builtin_bit_cast(float, __builtin_amdgcn_update_dpp(0, __builtin_bit_cast(int, v), 0x121, 0xf, 0xf, false));
    return v;
}
__device__ __forceinline__ float wave_sum(float v) {
#pragma unroll
    for (int o = 32; o >= 1; o >>= 1) v += __shfl_xor(v, o);
    return v;
}

template <bool PERM_IN = false>
__device__ __forceinline__ void transpose_convert(const float* __restrict__ W, bf16_t* __restrict__ Wt, int K, int N, int Npad, char* smem, int vb0 = 0) {
    float* tile = (float*)smem;
    const int tk = K / 64, tn = Npad / 64, ntile = tk * tn;
    const int tid = VTID;
    if (VBID < vb0) return;
    for (int tl = VBID - vb0; tl < ntile; tl += VGRID - vb0) {
        const int k0 = (tl % tk) * 64, n0 = (tl / tk) * 64;
        const int c = tid & 63, r0 = tid >> 6;
        int nd = n0;
        if (PERM_IN) { if (n0 >= 1024 && n0 < 1536) nd = n0 + 1024; else if (n0 >= 1536 && n0 < 2048) nd = n0 - 512; else if (n0 >= 2048 && n0 < 2560) nd = n0 + 512; else if (n0 >= 2560 && n0 < 3072) nd = n0 - 1024; }
#pragma unroll
        for (int i = 0; i < 16; ++i) {
            const int r = r0 + 4 * i;
            const float v = (n0 + c < N) ? W[(size_t)(k0 + r) * N + n0 + c] : 0.f;
            tile[c * 65 + r] = v;
        }
        __syncthreads();
#pragma unroll
        for (int i = 0; i < 16; ++i) {
            const int n = r0 + 4 * i;
            Wt[(size_t)(nd + n) * K + k0 + c] = f2bf(tile[n * 65 + c]);
        }
        __syncthreads();
    }
}
__device__ __forceinline__ void convert_flat(const float* __restrict__ src, bf16_t* __restrict__ dst, size_t n) {
    const size_t nv = n / 8;
    for (size_t i = (size_t)VBID * 256 + VTID; i < nv; i += (size_t)VGRID * 256) {
        const float4 a = ((const float4*)src)[2 * i], b = ((const float4*)src)[2 * i + 1];
        uint4 o; o.x = pack2(a.x, a.y); o.y = pack2(a.z, a.w); o.z = pack2(b.x, b.y); o.w = pack2(b.z, b.w);
        ((uint4*)dst)[i] = o;
    }
}
__device__ __forceinline__ void quantize_tables_static(const Params& p, int vb0 = 0) {
    const int lane = VTID & 63, wid = VTID >> 6;
    if (VBID < vb0) return;
    for (unsigned task = (unsigned)(VBID - vb0); task < 512u; task += (unsigned)(VGRID - vb0)) {
        const bool isv = task >= 256u;
        const int r0 = (int)(task & 255u) * 128 + wid * 32;
        const float* src = isv ? p.peer_v : p.peer_u;
        unsigned char* recs = p.ws + OFF_UT;
        _Float16* sct = (_Float16*)(p.ws + OFF_USC);
        for (int rr = 0; rr < 32; ++rr) {
            const int r = r0 + rr;
            const float* xr = src + (size_t)r * 1024 + lane * 16;
            f32x4 v[4]; float aml = 0.f;
#pragma unroll
            for (int i = 0; i < 4; ++i) {
                v[i] = *(const f32x4*)(xr + i * 4);
                aml = fmaxf(aml, fmaxf(fmaxf(fabsf(v[i][0]), fabsf(v[i][1])), fmaxf(fabsf(v[i][2]), fabsf(v[i][3]))));
            }
#pragma unroll
            for (int o = 32; o >= 1; o >>= 1) aml = fmaxf(aml, __shfl_xor(aml, o));
            float ssq = 0.f;
#pragma unroll
            for (int i = 0; i < 4; ++i) ssq += (v[i][0] * v[i][0] + v[i][1] * v[i][1]) + (v[i][2] * v[i][2] + v[i][3] * v[i][3]);
            ssq = wave_sum(ssq);
            const float gmax = aml * (1.002f / 7.5f);
            const _Float16 hs = (_Float16)fminf(fmaxf(0.34f * sqrtf(ssq * (1.0f / 1024.0f)), 0.5f * gmax), gmax);
            const float gs_ = (float)hs, gi_ = gs_ > 0.f ? 1.0f / gs_ : 0.f;
            unsigned wd[2]; const int sgn = isv ? 0 : 8;
#pragma unroll
            for (int dd = 0; dd < 2; ++dd) {
                unsigned wv = 0;
#pragma unroll
                for (int b = 0; b < 4; ++b) {
                    const int qa = min(15, max(0, __float2int_rn(v[2 * dd][b] * gi_ + 7.5f)));
                    const int qb = min(15, max(0, __float2int_rn(v[2 * dd + 1][b] * gi_ + 7.5f)));
                    wv |= ((unsigned)(qa ^ sgn) | ((unsigned)(qb ^ sgn) << 4)) << (8 * b);
                }
                wd[dd] = wv;
            }
            unsigned char* rec = recs + (size_t)r * 1024;
            *(uint2*)(rec + (isv ? 512 : 0) + lane * 8) = make_uint2(wd[0], wd[1]);
            if (lane == 0) sct[(size_t)r * 2 + (isv ? 1 : 0)] = (_Float16)gs_;
        }
    }
}
__device__ __forceinline__ void rmsnorm_rows(const float* __restrict__ X, const float* __restrict__ g, bf16_t* __restrict__ Hout) {
    const int lane = VTID & 63, wid = VTID >> 6;
    const int gw = VBID * 4 + wid, nw = VGRID * 4;
    for (int t = gw; t < T; t += nw) {
        const float* xr = X + (size_t)t * D;
        float4 v[4]; float ss = 0.f;
#pragma unroll
        for (int i = 0; i < 4; ++i) { v[i] = *(const float4*)(xr + i * 256 + lane * 4); ss += v[i].x * v[i].x + v[i].y * v[i].y + v[i].z * v[i].z + v[i].w * v[i].w; }
        ss = wave_sum(ss);
        const float rstd = rsqrtf(ss * (1.0f / D) + EPS);
#pragma unroll
        for (int i = 0; i < 4; ++i) {
            const float4 gg = *(const float4*)(g + i * 256 + lane * 4);
            uint2 o; o.x = pack2(v[i].x * rstd * gg.x, v[i].y * rstd * gg.y); o.y = pack2(v[i].z * rstd * gg.z, v[i].w * rstd * gg.w);
            *(uint2*)(Hout + (size_t)t * D + i * 256 + lane * 4) = o;
        }
    }
}

template <int MODE>
__device__ __forceinline__ void gemm_mainloop(const bf16_t* __restrict__ A0, const bf16_t* __restrict__ A1, int lda, int ksplit,
                                              const bf16_t* __restrict__ Bt, int K, int m0, int n0, f32x4 (&acc)[4][4], char* smem) {
    const int tid = VTID, lane = tid & 63, wid = tid >> 6, wm = wid >> 1, wn = wid & 1;
    const int lrow = tid >> 3, lch = tid & 7;
#pragma unroll
    for (int i = 0; i < 4; ++i)
#pragma unroll
        for (int j = 0; j < 4; ++j) acc[i][j] = (f32x4){0.f, 0.f, 0.f, 0.f};
    const int nk = K / 64;
    unsigned aoff[4], boff[4];
    {
        const int rr = lane >> 3, cc = ((lane & 7) ^ rr) * 8;
#pragma unroll
        for (int i = 0; i < 4; ++i) {
            aoff[i] = (unsigned)(((m0 + 32 * wid + 8 * i + rr) * lda + cc) * 2);
            boff[i] = (unsigned)(((n0 + 32 * wid + 8 * i + rr) * K + cc) * 2);
        }
    }
    auto stage = [&](int kt, int buf) {
        const int kb = kt * 64;
        const char* Ab; const char* Bb = (const char*)(Bt + kb);
        if (kb < ksplit) Ab = (const char*)(A0 + kb); else Ab = (const char*)(A1 + (kb - ksplit));
        char* sa = smem + buf * 32768 + wid * 4096 + lane * 16; char* sb = sa + 16384;
#pragma unroll
        for (int i = 0; i < 4; ++i) __builtin_amdgcn_global_load_lds((const unsigned*)(Ab + aoff[i]), (unsigned*)(sa + i * 1024), 16, 0, 0);
#pragma unroll
        for (int i = 0; i < 4; ++i) __builtin_amdgcn_global_load_lds((const unsigned*)(Bb + boff[i]), (unsigned*)(sb + i * 1024), 16, 0, 0);
    };
    auto compute = [&](int buf) {
        const char* sa = smem + buf * 32768; const char* sb = sa + 16384;
#pragma unroll
        for (int ks = 0; ks < 2; ++ks) {
            bf16x8 af[4], bfr[4];
            const int ch = ks * 4 + (lane >> 4);
#pragma unroll
            for (int i = 0; i < 4; ++i) { const int row = wm * 64 + i * 16 + (lane & 15); af[i] = *(const bf16x8*)(sa + row * 128 + ((ch ^ (row & 7)) << 4)); }
#pragma unroll
            for (int j = 0; j < 4; ++j) { const int row = wn * 64 + j * 16 + (lane & 15); bfr[j] = *(const bf16x8*)(sb + row * 128 + ((ch ^ (row & 7)) << 4)); }
            __builtin_amdgcn_s_setprio(1);
#pragma unroll
            for (int i = 0; i < 4; ++i)
#pragma unroll
                for (int j = 0; j < 4; ++j) {
                    if (MODE == 0) acc[i][j] = __builtin_amdgcn_mfma_f32_16x16x32_bf16(bfr[j], af[i], acc[i][j], 0, 0, 0);
                    else acc[i][j] = __builtin_amdgcn_mfma_f32_16x16x32_bf16(af[i], bfr[j], acc[i][j], 0, 0, 0);
                }
            __builtin_amdgcn_s_setprio(0);
        }
    };
    stage(0, 0);
    asm volatile("s_waitcnt vmcnt(0)" ::: "memory");
    __syncthreads();
    for (int kt = 0; kt < nk; ++kt) {
        if (kt + 1 < nk) stage(kt + 1, (kt + 1) & 1);
        compute(kt & 1);
        asm volatile("s_waitcnt vmcnt(0)" ::: "memory");
        __syncthreads();
    }
}
template <int MODE>
__device__ __forceinline__ void gemm_mainloop256(const bf16_t* __restrict__ A0, const bf16_t* __restrict__ A1, int lda, int ksplit,
                                                 const bf16_t* __restrict__ Bt, int K, int m0, int n0, f32x4 (&acc)[8][4], char* smem) {
    const int tid = VTID, lane = tid & 63, wid = tid >> 6, wm = wid >> 1, wn = wid & 1;
#pragma unroll
    for (int i = 0; i < 8; ++i)
#pragma unroll
        for (int j = 0; j < 4; ++j) acc[i][j] = (f32x4){0.f, 0.f, 0.f, 0.f};
    const int nk = K / 32;
    unsigned aoff[4], boff[2];
    {
        const int rr = lane >> 2, cc = ((lane & 3) ^ (3 * ((lane >> 5) & 1))) * 8;
#pragma unroll
        for (int i = 0; i < 4; ++i) aoff[i] = (unsigned)(((m0 + 64 * wid + 16 * i + rr) * lda + cc) * 2);
#pragma unroll
        for (int i = 0; i < 2; ++i) boff[i] = (unsigned)(((n0 + 32 * wid + 16 * i + rr) * K + cc) * 2);
    }
    auto stage = [&](int kt, int buf) {
        const int kb = kt * 32;
        const char* Ab; const char* Bb = (const char*)(Bt + kb);
        if (kb < ksplit) Ab = (const char*)(A0 + kb); else Ab = (const char*)(A1 + (kb - ksplit));
        char* sa = smem + buf * 24576 + wid * 4096 + lane * 16; char* sb = smem + buf * 24576 + 16384 + wid * 2048 + lane * 16;
#pragma unroll
        for (int i = 0; i < 4; ++i) __builtin_amdgcn_global_load_lds((const unsigned*)(Ab + aoff[i]), (unsigned*)(sa + i * 1024), 16, 0, 0);
#pragma unroll
        for (int i = 0; i < 2; ++i) __builtin_amdgcn_global_load_lds((const unsigned*)(Bb + boff[i]), (unsigned*)(sb + i * 1024), 16, 0, 0);
    };
    const int fpos = (((lane >> 4) ^ (3 * ((lane >> 3) & 1))) << 4) + (lane & 15) * 64;
    auto compute = [&](int buf) {
        const char* sa = smem + buf * 24576 + wm * 8192 + fpos; const char* sb = smem + buf * 24576 + 16384 + wn * 4096 + fpos;
        bf16x8 af[8], bfr[4];
#pragma unroll
        for (int i = 0; i < 8; ++i) af[i] = *(const bf16x8*)(sa + i * 1024);
#pragma unroll
        for (int j = 0; j < 4; ++j) bfr[j] = *(const bf16x8*)(sb + j * 1024);
        __builtin_amdgcn_s_setprio(1);
#pragma unroll
        for (int i = 0; i < 8; ++i)
#pragma unroll
            for (int j = 0; j < 4; ++j) {
                if (MODE == 0) acc[i][j] = __builtin_amdgcn_mfma_f32_16x16x32_bf16(bfr[j], af[i], acc[i][j], 0, 0, 0);
                else acc[i][j] = __builtin_amdgcn_mfma_f32_16x16x32_bf16(af[i], bfr[j], acc[i][j], 0, 0, 0);
            }
        __builtin_amdgcn_s_setprio(0);
    };
    stage(0, 0);
    asm volatile("s_waitcnt vmcnt(0)" ::: "memory");
    __syncthreads();
    for (int kt = 0; kt < nk; ++kt) {
        if (kt + 1 < nk) stage(kt + 1, (kt + 1) & 1);
        compute(kt & 1);
        asm volatile("s_waitcnt vmcnt(0)" ::: "memory");
        __syncthreads();
    }
}
__device__ __forceinline__ bool tile_sched(int it, int MT, int NT, int& mt, int& nt) {
    const int xg = blockIdx.x & 7, xi = (int)(blockIdx.x >> 3) * 2 + (int)(threadIdx.x >> 8), nper = (int)(gridDim.x >> 3) * 2;
    const int li = xi + nper * it;
    if (li >= (MT >> 3) * NT) return false;
    const int band = li / (8 * NT), r = li - band * 8 * NT;
    nt = r >> 3; mt = xg * (MT >> 3) + band * 8 + (r & 7);
    return true;
}
__device__ __forceinline__ void store_bf16x4(bf16_t* p, f32x4 v) { uint2 o; o.x = pack2(v[0], v[1]); o.y = pack2(v[2], v[3]); *(uint2*)p = o; }

#define G8_LAS __attribute__((address_space(3)))
namespace g8 {
constexpr int BM = 256, BK = 64, HALF = 128, HTB = HALF * BK * 2, NXCD = 8, WGM = 8;
__device__ __forceinline__ int lds_byte(int r, int c) { const int st = (r >> 4) * 2 + (c >> 5), rr = r & 15, cc = c & 31, ob = rr * 64 + cc * 2; return st * 1024 + (ob ^ (((ob >> 9) & 1) << 5)); }
__device__ __forceinline__ void stage_rc(int b, int& R, int& C) { const int st = b / 1024, sb = b % 1024, swz = sb ^ (((sb >> 9) & 1) << 5); R = (st >> 1) * 16 + swz / 64; C = (st & 1) * 32 + (swz % 64) / 2; }
__device__ __forceinline__ int perm32(int rho) { const int n = rho >> 4, i = rho & 15; return 8 * (i >> 2) + 4 * n + (i & 3); }
struct Unit { int pm, pn; };
struct Gemm { const bf16_t* A0; const bf16_t* A1; int lda, ksplit; const bf16_t* Bt; int M, N, K; };
struct StaticOrder {
    int nM, nN, nwg, G, c;
    __device__ __forceinline__ void init(int M, int N, int G_, int c_) { nM = M / BM; nN = N / BM; nwg = nM * nN; G = G_; c = c_; }
    __device__ __forceinline__ bool next(int i, Unit& u) const {
        const int L = i * G + c; if (L >= nwg) return false;
        int wgid = L; { const int q = nwg / NXCD, r = nwg % NXCD, xcd = wgid % NXCD, off = wgid / NXCD; wgid = (xcd < r ? xcd * (q + 1) : r * (q + 1) + (xcd - r) * q) + off; }
        const int nig = WGM * nN, gid = wgid / nig, fm = gid * WGM, gsz = (nM - fm) < WGM ? (nM - fm) : WGM;
        u.pm = fm + ((wgid % nig) % gsz); u.pn = (wgid % nig) / gsz; return true;
    }
};
template <class Epi>
__device__ __forceinline__ void gemm_phase(G8_LAS unsigned char* lds, const Gemm g, const StaticOrder& S, const Epi& E) {
    const int tid = threadIdx.x, wid = __builtin_amdgcn_readfirstlane(tid >> 6), lane = tid & 63, wr = wid >> 2, wc = wid & 3, fr = lane & 15, fq = lane >> 4;
    const int K = g.K, nt = K / BK, lda = g.lda;
    unsigned voffA[2], voffB[2];
#pragma unroll
    for (int i = 0; i < 2; ++i) { int R, C; stage_rc(tid * 16 + i * 8192, R, C); const int Rb = (R & ~31) + perm32(R & 31);
        voffA[i] = (unsigned)(R * lda + C) * 2u; voffB[i] = (unsigned)(Rb * K + C) * 2u; }
    const size_t hstepA = (size_t)HALF * lda * 2, hstepB = (size_t)HALF * K * 2;
    const unsigned ldsw = (unsigned)wid * 1024u;
    const int aoff = lds_byte(wr * 64 + fr, fq * 8), boff = lds_byte(wc * 32 + fr, fq * 8);
    auto aptr = [&](int pm, int kt) -> const char* { const int kb = kt * BK; const bf16_t* b = kb < g.ksplit ? g.A0 + kb : g.A1 + (kb - g.ksplit); return (const char*)b + (size_t)pm * 2 * hstepA; };
    auto bptr = [&](int pn, int kt) -> const char* { return (const char*)(g.Bt + kt * BK) + (size_t)pn * 2 * hstepB; };
#define G8_SA(b, h) (((b) * 2 + (h)) * HTB)
#define G8_SB(b, h) ((4 + (b) * 2 + (h)) * HTB)
#define G8_STAGE(bufoff, gbase, voff) do { _Pragma("unroll") for (int _i = 0; _i < 2; ++_i) \
        __builtin_amdgcn_global_load_lds((const unsigned*)((const char*)(gbase) + (voff)[_i]), (G8_LAS unsigned*)(lds + (bufoff) + ldsw + _i * 8192), 16, 0, 0); } while (0)
#define G8_LDA(dst, b, h) do { _Pragma("unroll") for (int m = 0; m < 4; ++m) _Pragma("unroll") for (int k = 0; k < 2; ++k) dst[m][k] = *(const G8_LAS bf16x8*)(lds + G8_SA(b, h) + aoff + m * 2048 + k * 1024); } while (0)
#define G8_LDB(dst, b, h) do { _Pragma("unroll") for (int n = 0; n < 2; ++n) _Pragma("unroll") for (int k = 0; k < 2; ++k) dst[n][k] = *(const G8_LAS bf16x8*)(lds + G8_SB(b, h) + boff + n * 2048 + k * 1024); } while (0)
#define G8_MMA(ai, bj, At, Bt) do { __builtin_amdgcn_s_setprio(1); _Pragma("unroll") for (int m = 0; m < 4; ++m) _Pragma("unroll") for (int n = 0; n < 2; ++n) _Pragma("unroll") for (int k = 0; k < 2; ++k) \
        acc[ai][bj][m][n] = __builtin_amdgcn_mfma_f32_16x16x32_bf16(Bt[n][k], At[m][k], acc[ai][bj][m][n], 0, 0, 0); __builtin_amdgcn_s_setprio(0); } while (0)
#define G8_WAIT_V(n) asm volatile("s_waitcnt vmcnt(" #n ")" ::: "memory")
#define G8_WAIT_L(n) asm volatile("s_waitcnt lgkmcnt(" #n ")" ::: "memory")
#define G8_BAR __builtin_amdgcn_s_barrier()
#define G8_SCHED __builtin_amdgcn_sched_barrier(0)
    Unit cur, nxt; int ui = 0;
    if (!S.next(0, cur)) return;
    f32x4 acc[2][2][4][2];
#pragma unroll
    for (int a = 0; a < 2; ++a)
#pragma unroll
        for (int b = 0; b < 2; ++b)
#pragma unroll
            for (int m = 0; m < 4; ++m)
#pragma unroll
                for (int n = 0; n < 2; ++n) acc[a][b][m][n] = (f32x4){0.f, 0.f, 0.f, 0.f};
    bf16x8 At[4][2], B0[2][2], B1[2][2];
    {
        const char* cA = aptr(cur.pm, 0); const char* cB = bptr(cur.pn, 0); const char* cA1 = aptr(cur.pm, 1); const char* cB1 = bptr(cur.pn, 1);
        G8_STAGE(G8_SB(0, 0), cB, voffB); G8_STAGE(G8_SB(0, 1), cB + hstepB, voffB); G8_STAGE(G8_SA(0, 0), cA, voffA); G8_STAGE(G8_SA(0, 1), cA + hstepA, voffA);
        if (wr == 1) G8_BAR;
        G8_WAIT_V(2); G8_BAR;
        G8_STAGE(G8_SB(1, 0), cB1, voffB); G8_STAGE(G8_SA(1, 0), cA1, voffA); G8_STAGE(G8_SB(1, 1), cB1 + hstepB, voffB);
        G8_WAIT_V(6); G8_BAR;
    }
    for (;;) {
        const bool has_next = S.next(ui + 1, nxt);
        const int npm = has_next ? nxt.pm : cur.pm, npn = has_next ? nxt.pn : cur.pn;
        for (int t = 0; t < nt; t += 2) {
            const bool last = (t == nt - 2);
            const char* a1 = aptr(cur.pm, t + 1);
            const char* a2 = last ? aptr(npm, 0) : aptr(cur.pm, t + 2); const char* b2 = last ? bptr(npn, 0) : bptr(cur.pn, t + 2);
            const char* a3 = last ? aptr(npm, 1) : aptr(cur.pm, t + 3); const char* b3 = last ? bptr(npn, 1) : bptr(cur.pn, t + 3);
            G8_LDB(B0, 0, 0); G8_LDB(B1, 0, 1); G8_SCHED; G8_LDA(At, 0, 0); G8_STAGE(G8_SA(1, 1), a1 + hstepA, voffA);
            G8_WAIT_V(8); G8_WAIT_L(0); G8_BAR; G8_MMA(0, 0, At, B0); G8_MMA(0, 1, At, B1); G8_BAR; G8_SCHED;
            G8_LDA(At, 0, 1); G8_STAGE(G8_SB(0, 0), b2, voffB); G8_STAGE(G8_SB(0, 1), b2 + hstepB, voffB); G8_STAGE(G8_SA(0, 0), a2, voffA);
            G8_WAIT_V(8); G8_WAIT_L(0); G8_BAR; G8_MMA(1, 0, At, B0); G8_MMA(1, 1, At, B1); G8_BAR; G8_SCHED;
            G8_LDB(B0, 1, 0); G8_LDB(B1, 1, 1); G8_SCHED; G8_LDA(At, 1, 0); G8_STAGE(G8_SA(0, 1), a2 + hstepA, voffA);
            G8_WAIT_V(8); G8_WAIT_L(0); G8_BAR; G8_MMA(0, 0, At, B0); G8_MMA(0, 1, At, B1); G8_BAR; G8_SCHED;
            G8_LDA(At, 1, 1); G8_STAGE(G8_SB(1, 0), b3, voffB); G8_STAGE(G8_SB(1, 1), b3 + hstepB, voffB); G8_STAGE(G8_SA(1, 0), a3, voffA);
            G8_WAIT_V(8); G8_WAIT_L(0); G8_BAR; G8_MMA(1, 0, At, B0); G8_MMA(1, 1, At, B1); G8_BAR; G8_SCHED;
        }
        if (wr == 0) G8_BAR;
        E(acc, cur, wr, wc, fr, fq);
        if (!has_next) break;
#pragma unroll
        for (int a = 0; a < 2; ++a)
#pragma unroll
            for (int b = 0; b < 2; ++b)
#pragma unroll
                for (int m = 0; m < 4; ++m)
#pragma unroll
                    for (int n = 0; n < 2; ++n) acc[a][b][m][n] = (f32x4){0.f, 0.f, 0.f, 0.f};
        cur = nxt; ++ui;
        if (wr == 1) G8_BAR;
    }
    G8_WAIT_V(0);
    G8_BAR;
#undef G8_SA
#undef G8_SB
#undef G8_STAGE
#undef G8_LDA
#undef G8_LDB
#undef G8_MMA
#undef G8_WAIT_V
#undef G8_WAIT_L
#undef G8_BAR
#undef G8_SCHED
}
struct EpiResid {
    const float* Rs; float* O; bf16_t* XB; float* SSQP; const float* gain;
    __device__ __forceinline__ void operator()(const f32x4 (&acc)[2][2][4][2], const Unit& u, int wr, int wc, int fr, int fq) const {
        f32x4 gn[2][2];
#pragma unroll
        for (int bj = 0; bj < 2; ++bj) { gn[bj][0] = *(const f32x4*)(gain + u.pn * 256 + bj * 128 + wc * 32 + fq * 8); gn[bj][1] = *(const f32x4*)(gain + u.pn * 256 + bj * 128 + wc * 32 + fq * 8 + 4); }
#pragma unroll
        for (int ai = 0; ai < 2; ++ai)
#pragma unroll
            for (int m = 0; m < 4; ++m) {
                const int row = u.pm * 256 + ai * 128 + wr * 64 + m * 16 + fr;
                const size_t o = (size_t)row * 1024 + u.pn * 256 + wc * 32 + fq * 8;
                float ss = 0.f;
#pragma unroll
                for (int bj = 0; bj < 2; ++bj) {
                    const f32x4 a = *(const f32x4*)(Rs + o + bj * 128) + acc[ai][bj][m][0], b = *(const f32x4*)(Rs + o + bj * 128 + 4) + acc[ai][bj][m][1];
                    *(f32x4*)(O + o + bj * 128) = a; *(f32x4*)(O + o + bj * 128 + 4) = b;
                    ss += a[0] * a[0] + a[1] * a[1] + a[2] * a[2] + a[3] * a[3] + b[0] * b[0] + b[1] * b[1] + b[2] * b[2] + b[3] * b[3];
                    const f32x4 ag = a * gn[bj][0], bg = b * gn[bj][1];
                    uint4 w; w.x = pack2(ag[0], ag[1]); w.y = pack2(ag[2], ag[3]); w.z = pack2(bg[0], bg[1]); w.w = pack2(bg[2], bg[3]);
                    *(uint4*)(XB + o + bj * 128) = w;
                }
                ss += __shfl_xor(ss, 16); ss += __shfl_xor(ss, 32);
                if (fq == 0) SSQP[(size_t)row * 32 + u.pn * 4 + wc] = ss;
            }
    }
};
struct EpiCinU {
    bf16_t* U;
    __device__ __forceinline__ void operator()(const f32x4 (&acc)[2][2][4][2], const Unit& u, int wr, int wc, int fr, int fq) const {
#pragma unroll
        for (int ai = 0; ai < 2; ++ai)
#pragma unroll
            for (int m = 0; m < 4; ++m) {
                bf16_t* rp = U + (size_t)(u.pm * 256 + ai * 128 + wr * 64 + m * 16 + fr) * 2048 + u.pn * 256 + wc * 32 + fq * 8;
#pragma unroll
                for (int bj = 0; bj < 2; ++bj) {
                    const f32x4 a = acc[ai][bj][m][0], b = acc[ai][bj][m][1];
                    const f32x2 g0 = gelu_exact2((f32x2){a[0], a[1]}), g1 = gelu_exact2((f32x2){a[2], a[3]}), g2 = gelu_exact2((f32x2){b[0], b[1]}), g3 = gelu_exact2((f32x2){b[2], b[3]});
                    uint4 o; o.x = pack2(g0[0], g0[1]); o.y = pack2(g1[0], g1[1]); o.z = pack2(g2[0], g2[1]); o.w = pack2(g3[0], g3[1]);
                    *(uint4*)(rp + bj * 128) = o;
                }
            }
    }
};
struct EpiCinV {
    bf16_t* VT; float* SSQ;
    __device__ __forceinline__ void operator()(const f32x4 (&acc)[2][2][4][2], const Unit& u, int wr, int wc, int fr, int fq) const {
#pragma unroll
        for (int ai = 0; ai < 2; ++ai) {
            float ss[16];
#pragma unroll
            for (int i = 0; i < 16; ++i) ss[i] = 0.f;
#pragma unroll
            for (int m = 0; m < 4; ++m) {
                const int c = u.pm * 256 + ai * 128 + wr * 64 + m * 16 + fr;
#pragma unroll
                for (int bj = 0; bj < 2; ++bj) {
                    float g[8];
#pragma unroll
                    for (int n = 0; n < 2; ++n)
#pragma unroll
                        for (int r = 0; r < 4; r += 2) {
                            const f32x2 x = gelu_exact2((f32x2){acc[ai][bj][m][n][r], acc[ai][bj][m][n][r + 1]});
                            g[n * 4 + r] = x[0]; g[n * 4 + r + 1] = x[1]; ss[bj * 8 + n * 4 + r] += x[0] * x[0]; ss[bj * 8 + n * 4 + r + 1] += x[1] * x[1];
                        }
                    uint4 o; o.x = pack2(g[0], g[1]); o.y = pack2(g[2], g[3]); o.z = pack2(g[4], g[5]); o.w = pack2(g[6], g[7]);
                    *(uint4*)(VT + ((size_t)(u.pn * 2 + bj) * 2048 + c) * 128 + wc * 32 + fq * 8) = o;
                }
            }
            float mine = 0.f;
#pragma unroll
            for (int i = 0; i < 16; ++i) { const float s = row16_sum(ss[i]); mine = (fr == i) ? s : mine; }
            const int tok = u.pn * 256 + (fr >> 3) * 128 + wc * 32 + fq * 8 + (fr & 7);
            SSQ[(size_t)tok * 32 + u.pm * 4 + ai * 2 + wr] = mine;
        }
    }
};
struct EpiInN {
    bf16_t* R;
    __device__ __forceinline__ void operator()(const f32x4 (&acc)[2][2][4][2], const Unit& u, int wr, int wc, int fr, int fq) const {
        bf16_t* base; int pitch; float sc = 1.0f;
        if (u.pn < 2) { base = R + R_QSB + u.pn * 256; pitch = 512; sc = 0.125f; }
        else if (u.pn < 4) { base = R + R_KSB + (u.pn - 2) * 256; pitch = 512; }
        else if (u.pn == 4) { base = R + R_QG; pitch = 256; }
        else if (u.pn == 5) { base = R + R_KG; pitch = 256; }
        else { base = R + R_GG + (u.pn - 6) * 256; pitch = 512; }
#pragma unroll
        for (int ai = 0; ai < 2; ++ai)
#pragma unroll
            for (int m = 0; m < 4; ++m) {
                bf16_t* rp = base + (size_t)(u.pm * 256 + ai * 128 + wr * 64 + m * 16 + fr) * pitch + wc * 32 + fq * 8;
#pragma unroll
                for (int bj = 0; bj < 2; ++bj) {
                    const f32x4 a = acc[ai][bj][m][0] * sc, b = acc[ai][bj][m][1] * sc;
                    uint4 o; o.x = pack2(a[0], a[1]); o.y = pack2(a[2], a[3]); o.z = pack2(b[0], b[1]); o.w = pack2(b[2], b[3]);
                    *(uint4*)(rp + bj * 128) = o;
                }
            }
    }
};
struct EpiInT {
    bf16_t* R;
    __device__ __forceinline__ void operator()(const f32x4 (&acc)[2][2][4][2], const Unit& u, int wr, int wc, int fr, int fq) const {
#pragma unroll
        for (int ai = 0; ai < 2; ++ai)
#pragma unroll
            for (int m = 0; m < 4; ++m) {
                const int c = u.pm * 256 + ai * 128 + wr * 64 + m * 16 + fr;
#pragma unroll
                for (int bj = 0; bj < 2; ++bj) {
                    const int t = u.pn * 256 + bj * 128 + wc * 32 + fq * 8, b = t >> 11, s = t & 2047;
                    bf16_t* dst;
                    if (c < 512) dst = R + R_VTSB + ((size_t)((b * 8 + (c >> 6)) * 64 + (c & 63))) * 2048 + s;
                    else { const int c2 = c - 512; dst = R + R_VTG + ((size_t)((b * 4 + (c2 >> 7)) * 128 + (c2 & 127))) * 2048 + s; }
                    const f32x4 a = acc[ai][bj][m][0], bb = acc[ai][bj][m][1];
                    uint4 o; o.x = pack2(a[0], a[1]); o.y = pack2(a[2], a[3]); o.z = pack2(bb[0], bb[1]); o.w = pack2(bb[2], bb[3]);
                    *(uint4*)dst = o;
                }
            }
    }
};
}
__device__ __forceinline__ void phase_gemm_resid8(const bf16_t* A0, const bf16_t* A1, int lda, int ksplit, const bf16_t* Bt, int K, const float* Rs, float* O, bf16_t* XB, float* SSQP, const float* gain, char* smem_phys) {
    g8::Gemm g{A0, A1, lda, ksplit, Bt, T, 1024, K};
    g8::StaticOrder S; S.init(T, 1024, (int)gridDim.x, (int)blockIdx.x);
    g8::EpiResid E{Rs, O, XB, SSQP, gain};
    g8::gemm_phase<g8::EpiResid>((G8_LAS unsigned char*)smem_phys, g, S, E);
}

__device__ __forceinline__ void phase_gemm_cin8(const Params& p, char* smem_phys) {
    const bf16_t* H = (const bf16_t*)(p.ws + OFF_H); const bf16_t* W = (const bf16_t*)(p.ws + OFF_WT_CIN);
    bf16_t* U = (bf16_t*)(p.ws + OFF_REGION); bf16_t* VT = U + (size_t)T * 2048; float* SSQ = (float*)(p.ws + OFF_SSQ);
    {
        g8::Gemm g{H, H, 1024, 1024, W, T, 2048, 1024};
        g8::StaticOrder S; S.init(T, 2048, (int)gridDim.x, (int)blockIdx.x);
        g8::EpiCinU E{U};
        g8::gemm_phase<g8::EpiCinU>((G8_LAS unsigned char*)smem_phys, g, S, E);
    }
    {
        const bf16_t* Wv = W + (size_t)2048 * 1024;
        g8::Gemm g{Wv, Wv, 1024, 1024, H, 2048, T, 1024};
        g8::StaticOrder S; S.init(2048, T, (int)gridDim.x, (int)blockIdx.x);
        g8::EpiCinV E{VT, SSQ};
        g8::gemm_phase<g8::EpiCinV>((G8_LAS unsigned char*)smem_phys, g, S, E);
    }
}
__device__ __forceinline__ void phase_gemm_in8(const Params& p, char* smem_phys) {
    const bf16_t* H = (const bf16_t*)(p.ws + OFF_H); const bf16_t* W = (const bf16_t*)(p.ws + OFF_WT_IN);
    bf16_t* R = (bf16_t*)(p.ws + OFF_REGION);
    {
        g8::Gemm g{H, H, 1024, 1024, W, T, 2048, 1024};
        g8::StaticOrder S; S.init(T, 2048, (int)gridDim.x, (int)blockIdx.x);
        g8::EpiInN E{R};
        g8::gemm_phase<g8::EpiInN>((G8_LAS unsigned char*)smem_phys, g, S, E);
    }
    {
        const bf16_t* Wv = W + (size_t)2048 * 1024;
        g8::Gemm g{Wv, Wv, 1024, 1024, H, 1024, T, 1024};
        g8::StaticOrder S; S.init(1024, T, (int)gridDim.x, (int)blockIdx.x);
        g8::EpiInT E{R};
        g8::gemm_phase<g8::EpiInT>((G8_LAS unsigned char*)smem_phys, g, S, E);
    }
    {
        const int lane = threadIdx.x & 63, wid = threadIdx.x >> 6, fr = lane & 15, fq = lane >> 4;
        float* ALR = (float*)(R + R_ALR);
        for (int task = (int)blockIdx.x * 8 + wid; task < T / 16; task += (int)gridDim.x * 8) {
            const bf16_t* a = H + (size_t)(task * 16 + fr) * 1024 + fq * 8; const bf16_t* w = W + (size_t)(3072 + fr) * 1024 + fq * 8;
            f32x4 acc = (f32x4){0.f, 0.f, 0.f, 0.f};
#pragma unroll 8
            for (int kk = 0; kk < 32; ++kk) {
                const bf16x8 af = *(const bf16x8*)(a + kk * 32), wf = *(const bf16x8*)(w + kk * 32);
                acc = __builtin_amdgcn_mfma_f32_16x16x32_bf16(wf, af, acc, 0, 0, 0);
            }
            *(f32x4*)(ALR + (size_t)(task * 16 + fr) * 16 + fq * 4) = acc;
        }
    }
}

__device__ __forceinline__ void phase_gemm_in(const Params& p, char* smem) {
    const bf16_t* A = (const bf16_t*)(p.ws + OFF_H); const bf16_t* Bt = (const bf16_t*)(p.ws + OFF_WT_IN);
    bf16_t* R = (bf16_t*)(p.ws + OFF_REGION);
    const int lane = VTID & 63, wid = VTID >> 6, wm = wid >> 1, wn = wid & 1;
    constexpr int NT = AB_IN_PAD / 128, MT = T / 128;
    int mt_, nt_;
    for (int it = 0; tile_sched(it, MT, NT, mt_, nt_); ++it) {
        const int m0 = mt_ * 128, n0 = nt_ * 128;
        f32x4 acc[4][4];
        const bool tr = (n0 >= 1024 && n0 < 1536) || (n0 >= 2048 && n0 < 2560);
        if (!tr) {
            gemm_mainloop<0>(A, A, 1024, 1024, Bt, 1024, m0, n0, acc, smem);
#pragma unroll
            for (int i = 0; i < 4; ++i)
#pragma unroll
                for (int j = 0; j < 4; ++j) {
                    const int m = m0 + wm * 64 + i * 16 + (lane & 15), n = n0 + wn * 64 + j * 16 + 4 * (lane >> 4);
                    const f32x4 v = acc[i][j];
                    if (n < 512) store_bf16x4(R + R_QSB + (size_t)m * 512 + n, v * 0.125f);
                    else if (n < 1024) store_bf16x4(R + R_KSB + (size_t)m * 512 + (n - 512), v);
                    else if (n < 1792) store_bf16x4(R + R_QG + (size_t)m * 256 + (n - 1536), v);
                    else if (n < 2048) store_bf16x4(R + R_KG + (size_t)m * 256 + (n - 1792), v);
                    else if (n < 3072) store_bf16x4(R + R_GG + (size_t)m * 512 + (n - 2560), v);
                    else if (n < AB_IN) *(f32x4*)((float*)(R + R_ALR) + (size_t)m * 16 + (n - 3072)) = v;
                }
        } else {
            gemm_mainloop<1>(A, A, 1024, 1024, Bt, 1024, m0, n0, acc, smem);
#pragma unroll
            for (int i = 0; i < 4; ++i)
#pragma unroll
                for (int j = 0; j < 4; ++j) {
                    const int m = m0 + wm * 64 + i * 16 + 4 * (lane >> 4), n = n0 + wn * 64 + j * 16 + (lane & 15);
                    const int b = m >> 11, s = m & 2047;
                    if (n < 1536) { const int c = n - 1024, hh = c >> 6, e = c & 63; store_bf16x4(R + R_VTSB + ((size_t)((b * 8 + hh) * 64 + e)) * 2048 + s, acc[i][j]); }
                    else { const int c = n - 2048, hh = c >> 7, e = c & 127; store_bf16x4(R + R_VTG + ((size_t)((b * 4 + hh) * 128 + e)) * 2048 + s, acc[i][j]); }
                }
        }
    }
}
__device__ __forceinline__ void phase_gemm_resid(const bf16_t* A0, const bf16_t* A1, int lda, int ksplit, const bf16_t* Bt, int K, const float* Rs, float* O, char* smem) {
    const int lane = VTID & 63, wid = VTID >> 6, wm = wid >> 1, wn = wid & 1;
    constexpr int NT = 8, MT = T / 256;
    int mt_, nt_;
    for (int it = 0; tile_sched(it, MT, NT, mt_, nt_); ++it) {
        const int m0 = mt_ * 256, n0 = nt_ * 128;
        f32x4 acc[8][4];
        gemm_mainloop256<0>(A0, A1, lda, ksplit, Bt, K, m0, n0, acc, smem);
#pragma unroll
        for (int i = 0; i < 8; ++i)
#pragma unroll
            for (int j = 0; j < 4; ++j) {
                const int m = m0 + wm * 128 + i * 16 + (lane & 15), n = n0 + wn * 64 + j * 16 + 4 * (lane >> 4);
                const f32x4 r = *(const f32x4*)(Rs + (size_t)m * 1024 + n);
                *(f32x4*)(O + (size_t)m * 1024 + n) = r + acc[i][j];
            }
    }
}
__device__ __forceinline__ void phase_gemm_cin(const Params& p, char* smem) {
    const bf16_t* A = (const bf16_t*)(p.ws + OFF_H); const bf16_t* Bt = (const bf16_t*)(p.ws + OFF_WT_CIN);
    bf16_t* U = (bf16_t*)(p.ws + OFF_REGION); bf16_t* VT = U + (size_t)T * 2048; float* SSQ = (float*)(p.ws + OFF_SSQ);
    const int lane = VTID & 63, wid = VTID >> 6, wm = wid >> 1, wn = wid & 1;
    constexpr int NT = 32, MT = T / 128;
    int mt_, nt_;
    for (int it = 0; tile_sched(it, MT, NT, mt_, nt_); ++it) {
        const int m0 = mt_ * 128, n0 = nt_ * 128;
        f32x4 acc[4][4];
        if (n0 < 2048) {
            gemm_mainloop<0>(A, A, 1024, 1024, Bt, 1024, m0, n0, acc, smem);
#pragma unroll
            for (int i = 0; i < 4; ++i)
#pragma unroll
                for (int j = 0; j < 4; ++j) {
                    const int m = m0 + wm * 64 + i * 16 + (lane & 15), n = n0 + wn * 64 + j * 16 + 4 * (lane >> 4);
                    f32x4 v = acc[i][j];
#pragma unroll
                    for (int r = 0; r < 4; ++r) v[r] = gelu_exact(v[r]);
                    store_bf16x4(U + (size_t)m * 2048 + n, v);
                }
        } else {
            gemm_mainloop<1>(A, A, 1024, 1024, Bt, 1024, m0, n0, acc, smem);
#pragma unroll
            for (int i = 0; i < 4; ++i) {
                float ss[4] = {0.f, 0.f, 0.f, 0.f};
#pragma unroll
                for (int j = 0; j < 4; ++j) {
                    const int m = m0 + wm * 64 + i * 16 + 4 * (lane >> 4), n = n0 + wn * 64 + j * 16 + (lane & 15);
                    f32x4 v = acc[i][j];
#pragma unroll
                    for (int r = 0; r < 4; ++r) { v[r] = gelu_exact(v[r]); ss[r] += v[r] * v[r]; }
                    const int chunk = m >> 7, s = m & 127, c = n - 2048;
                    store_bf16x4(VT + ((size_t)chunk * 2048 + c) * 128 + s, v);
                }
#pragma unroll
                for (int r = 0; r < 4; ++r) {
                    float v = ss[r];
                    v += __shfl_xor(v, 1); v += __shfl_xor(v, 2); v += __shfl_xor(v, 4); v += __shfl_xor(v, 8);
                    if ((lane & 15) == 0) { const int m = m0 + wm * 64 + i * 16 + 4 * (lane >> 4) + r; SSQ[(size_t)m * 32 + ((n0 - 2048) >> 6) + wn] = v; }
                }
            }
        }
    }
}

typedef float f32x16 __attribute__((ext_vector_type(16)));
__device__ __forceinline__ void sb_fast(const Params& p, char* smem, unsigned* ctr) {
    bf16_t* R = (bf16_t*)(p.ws + OFF_REGION);
    char* KT = smem; char* VTt = smem + 8192;
    volatile int* flags = (volatile int*)(smem + 32768); volatile unsigned* slot = (volatile unsigned*)(smem + 32832);
    const int tid = threadIdx.x, lane = tid & 63, w = tid >> 6, r31 = lane & 31, h = lane >> 5;
    for (;;) {
        __syncthreads();
        if (tid == 0) *slot = atomicAdd(ctr, 1u);
        __syncthreads();
        const unsigned task = *slot;
        if (task >= 1024u) break;
        const int qblk = 7 - (int)(task >> 7), bh = task & 127, b = bh >> 3, hh = bh & 7;
        const int q0 = qblk * 256, qbase = q0 + 32 * w;
        bf16_t* qrow = R + R_QSB + (size_t)(b * 2048 + qbase + r31) * 512 + hh * 64;
        bf16x8 qf[4];
#pragma unroll
        for (int kk = 0; kk < 4; ++kk) qf[kk] = *(const bf16x8*)(qrow + 16 * kk + 8 * h);
        f32x16 oacc[2];
#pragma unroll
        for (int nt = 0; nt < 2; ++nt)
#pragma unroll
            for (int i = 0; i < 16; ++i) oacc[nt][i] = 0.f;
        float Rr = 1.0f;
        const int t = qbase + r31;
        for (int kt = q0 / 64 + 3; kt >= 0; --kt) {
            __syncthreads();
            { const int wd = __all(Rr == 0.f); if (lane == 0) flags[w] = wd; }
            __syncthreads();
            if (flags[0] & flags[1] & flags[2] & flags[3] & flags[4] & flags[5] & flags[6] & flags[7]) break;
            const int s_tile = kt * 64;
            {
                const int c = tid, row = c >> 3, ch = c & 7;
                const u32x4 kv = *(const u32x4*)(R + R_KSB + (size_t)(b * 2048 + s_tile + row) * 512 + hh * 64 + ch * 8);
                const u32x4 vv = *(const u32x4*)(R + R_VTSB + ((size_t)((b * 8 + hh) * 64 + row)) * 2048 + s_tile + ch * 8);
                *(u32x4*)(KT + row * 128 + ((ch ^ (row & 7)) << 4)) = kv;
                *(uint2*)(VTt + row * 136 + ch * 16) = make_uint2(vv[0], vv[1]);
                *(uint2*)(VTt + row * 136 + ch * 16 + 8) = make_uint2(vv[2], vv[3]);
            }
            __syncthreads();
#pragma unroll
            for (int sbk = 1; sbk >= 0; --sbk) {
                const int key_lo = s_tile + 32 * sbk;
                if (key_lo >= qbase + 31) continue;
                if (__all(Rr == 0.f)) continue;
                f32x16 st;
#pragma unroll
                for (int i = 0; i < 16; ++i) st[i] = 0.f;
                const int krow = 32 * sbk + r31;
#pragma unroll
                for (int kk = 0; kk < 4; ++kk) {
                    const bf16x8 kf = *(const bf16x8*)(KT + krow * 128 + (((2 * kk + h) ^ (krow & 7)) << 4));
                    st = __builtin_amdgcn_mfma_f32_32x32x16_bf16(kf, qf[kk], st, 0, 0, 0);
                }
                float a[16], G[4];
#pragma unroll
                for (int g = 0; g < 4; ++g) {
                    float sg[4], m[4];
#pragma unroll
                    for (int i = 0; i < 4; ++i) {
                        const int s = key_lo + 8 * g + 4 * h + i;
                        const float z = fminf(fmaxf(st[4 * g + i], -80.f), 80.f);
                        const float ez = __expf(-z), sig = __builtin_amdgcn_rcpf(1.0f + ez);
                        const bool valid = s < t;
                        sg[i] = valid ? sig : 0.f; m[i] = valid ? ez * sig : 1.0f;
                    }
                    const float x2 = m[3], x1 = x2 * m[2], x0 = x1 * m[1];
                    G[g] = x0 * m[0];
                    a[4 * g + 3] = sg[3]; a[4 * g + 2] = sg[2] * x2; a[4 * g + 1] = sg[1] * x1; a[4 * g] = sg[0] * x0;
                }
                float Go[4], P[4];
#pragma unroll
                for (int g = 0; g < 4; ++g) { Go[g] = __shfl_xor(G[g], 32); P[g] = G[g] * Go[g]; }
                const float c2 = P[3], c1 = c2 * P[2], c0 = c1 * P[1];
                float Tg[4];
                Tg[3] = Rr; Tg[2] = Rr * c2; Tg[1] = Rr * c1; Tg[0] = Rr * c0;
#pragma unroll
                for (int g = 0; g < 4; ++g) {
                    const float tg = (h == 0) ? Tg[g] * Go[g] : Tg[g];
                    a[4 * g] *= tg; a[4 * g + 1] *= tg; a[4 * g + 2] *= tg; a[4 * g + 3] *= tg;
                }
                Rr = Rr * c0 * P[0];
#pragma unroll
                for (int s2 = 0; s2 < 2; ++s2) {
                    union { bf16x8 v; unsigned u[4]; } af;
#pragma unroll
                    for (int j2 = 0; j2 < 4; ++j2) af.u[j2] = pack2(a[8 * s2 + 2 * j2], a[8 * s2 + 2 * j2 + 1]);
#pragma unroll
                    for (int nt = 0; nt < 2; ++nt) {
                        const char* vp = VTt + (32 * nt + r31) * 136 + 64 * sbk + 32 * s2 + 8 * h;
                        union { bf16x8 v; uint2 hh2[2]; } vf;
                        vf.hh2[0] = *(const uint2*)vp; vf.hh2[1] = *(const uint2*)(vp + 16);
                        oacc[nt] = __builtin_amdgcn_mfma_f32_32x32x16_bf16(af.v, vf.v, oacc[nt], 0, 0, 0);
                    }
                }
            }
        }
#pragma unroll
        for (int nt = 0; nt < 2; ++nt)
#pragma unroll
            for (int i = 0; i < 16; ++i) {
                const int qq = (i & 3) + 8 * (i >> 2) + 4 * h;
                R[R_QSB + (size_t)(b * 2048 + qbase + qq) * 512 + hh * 64 + 32 * nt + r31] = f2bf(oacc[nt][i]);
            }
    }
}
__device__ __forceinline__ float log_sigmoid(float x) { return fminf(x, 0.f) - log1pf(__expf(-fabsf(x))); }
__device__ __forceinline__ int swz(int row, int chunk) { return row * 128 + ((chunk ^ (row & 7)) << 4); }
__device__ __forceinline__ void gla_prep(const Params& p, char* smem) {
    bf16_t* R = (bf16_t*)(p.ws + OFF_REGION);
    const float* ALR = (const float*)(R + R_ALR);
    bf16_t* KOTg = R + R_KOT; float* DECg = (float*)(R + R_DEC);
    float* SEG = (float*)smem; float* ALRs = SEG + 256;
    const int tid = VTID, d = tid & 63, w = tid >> 6;
    for (int task = VBID; task < 2048; task += VGRID) {
        const int bh = task >> 5, c = task & 31, b = bh >> 2, hh = bh & 3;
        const size_t rowbase = (size_t)b * 2048 + c * 64;
        unsigned qr[16], kr[16];
#pragma unroll
        for (int i = 0; i < 16; ++i) { const size_t row = rowbase + w * 16 + i; qr[i] = R[R_QG + row * 256 + hh * 64 + d]; kr[i] = R[R_KG + row * 256 + hh * 64 + d]; }
        const f32x4 ar = *(const f32x4*)(ALR + rowbase * 16 + tid * 4);
        float w2r[16];
#pragma unroll
        for (int r = 0; r < 16; ++r) w2r[r] = p.ab_w_alpha2[r * 256 + hh * 64 + d];
        const float b2r = p.ab_b_alpha2[hh * 64 + d];
        __syncthreads();
        *(f32x4*)(ALRs + tid * 4) = ar;
        __syncthreads();
        float cs[16]; float run = 0.f;
#pragma unroll
        for (int i = 0; i < 16; ++i) {
            const float* al = ALRs + (w * 16 + i) * 16;
            float pre = b2r;
#pragma unroll
            for (int r = 0; r < 16; ++r) pre += al[r] * w2r[r];
            run += log_sigmoid(pre) * (1.0f / 16.0f);
            cs[i] = run;
        }
        SEG[w * 64 + d] = run;
        __syncthreads();
        float off = 0.f, tot = 0.f;
#pragma unroll
        for (int w2 = 0; w2 < 4; ++w2) { const float s = SEG[w2 * 64 + d]; tot += s; if (w2 < w) off += s; }
        unsigned kop[8];
#pragma unroll
        for (int i2 = 0; i2 < 8; ++i2) {
            float kov[2];
#pragma unroll
            for (int u = 0; u < 2; ++u) {
                const int i = 2 * i2 + u;
                const float bc = off + cs[i];
                const float kv = bf2f((bf16_t)kr[i]);
                const size_t row = rowbase + w * 16 + i;
                R[R_QG + row * 256 + hh * 64 + d] = f2bf(bf2f((bf16_t)qr[i]) * 0.125f * __expf(bc));
                R[R_KG + row * 256 + hh * 64 + d] = f2bf(kv * __expf(-bc));
                kov[u] = kv * __expf(tot - bc);
            }
            kop[i2] = pack2(kov[0], kov[1]);
        }
        bf16_t* kp = KOTg + ((size_t)task * 64 + d) * 64 + w * 16;
        *(uint4*)kp = make_uint4(kop[0], kop[1], kop[2], kop[3]);
        *(uint4*)(kp + 8) = make_uint4(kop[4], kop[5], kop[6], kop[7]);
        if (w == 0) DECg[(size_t)task * 64 + d] = __expf(tot);
    }
}
__device__ __forceinline__ void gla_scan(const Params& p, char* smem, bool dry = false) {
    bf16_t* R = (bf16_t*)(p.ws + OFF_REGION);
    const bf16_t* KOTg = R + R_KOT; const float* DECg = (const float*)(R + R_DEC);
    char* QS = smem; char* KS = smem + 8192; char* KOT = smem + 16384; char* VTs = smem + 24576; char* SPT = smem + 40960;
    float* DEC = (float*)(smem + 57344); float* GN = DEC + 64;
    const int tid = VTID, lane = tid & 63, w = tid >> 6, l15_ = lane & 15, q4 = lane >> 4;
    for (int task = VBID; task < 64; task += VGRID) {
        const int b = task >> 2, hh = task & 3;
        f32x4 Sacc[8];
#pragma unroll
        for (int nt = 0; nt < 8; ++nt) Sacc[nt] = (f32x4){0.f, 0.f, 0.f, 0.f};
        __syncthreads();
        for (int i = tid; i < 1024; i += 256) *(uint4*)(SPT + i * 16) = make_uint4(0, 0, 0, 0);
        if (tid < 128) GN[tid] = p.ab_gla_norm[hh * 128 + tid];
        const size_t rowbase = (size_t)b * 2048;
        const bf16_t* vbase = R + R_VTG + ((size_t)((b * 4 + hh) * 128)) * 2048;
        u32x4 tq[2], tk[2], tko[2], vr[4]; float td = 0.f;
        auto prefetch = [&](int c) {
            const int t0 = c * 64;
#pragma unroll
            for (int i = 0; i < 2; ++i) {
                const int cid = tid + 256 * i, row = cid >> 3, ch = cid & 7;
                tq[i] = *(const u32x4*)(R + R_QG + (rowbase + t0 + row) * 256 + hh * 64 + ch * 8);
                tk[i] = *(const u32x4*)(R + R_KG + (rowbase + t0 + row) * 256 + hh * 64 + ch * 8);
                tko[i] = *(const u32x4*)(KOTg + (((size_t)task * 32 + c) * 64 + row) * 64 + ch * 8);
            }
#pragma unroll
            for (int i = 0; i < 4; ++i) { const int cid = tid + 256 * i, e = cid >> 3, ch = cid & 7; vr[i] = *(const u32x4*)(vbase + (size_t)e * 2048 + t0 + ch * 8); }
            if (tid < 64) td = DECg[((size_t)task * 32 + c) * 64 + tid];
        };
        prefetch(0);
        for (int c = 0; c < 32; ++c) {
            int lz = 0; asm volatile("" : "+v"(lz));
            const int l15 = l15_ + lz;
            const int cx = (q4 ^ (l15 & 7)) << 4;
            const int rb0 = l15 * 128 + cx, rb1 = l15 * 128 + (cx ^ 64);
#pragma unroll
            for (int i = 0; i < 2; ++i) {
                const int cid = tid + 256 * i + lz, row = cid >> 3, ch = cid & 7;
                *(u32x4*)(QS + swz(row, ch)) = tq[i]; *(u32x4*)(KS + swz(row, ch)) = tk[i]; *(u32x4*)(KOT + swz(row, ch)) = tko[i];
            }
#pragma unroll
            for (int i = 0; i < 4; ++i) { const int cid = tid + 256 * i + lz, e = cid >> 3, ch = cid & 7; *(u32x4*)(VTs + swz(e, ch)) = vr[i]; }
            if (tid < 64) DEC[tid] = td;
            uint2 gr[8];
            const unsigned goff = (unsigned)((rowbase + c * 64 + 16 * w + l15) * 512 + hh * 128 + 4 * q4);
            bf16_t* const gbase = R + R_GG;
#pragma unroll
            for (int nt = 0; nt < 8; ++nt) gr[nt] = *(const uint2*)(gbase + (goff + 16 * nt));
            if (c + 1 < 32) prefetch(c + 1);
            __syncthreads();
            bf16x8 qf[2];
#pragma unroll
            for (int kk = 0; kk < 2; ++kk) qf[kk] = *(const bf16x8*)(QS + w * 2048 + (kk ? rb1 : rb0));
            f32x4 sT[4];
#pragma unroll
            for (int st = 0; st < 4; ++st) {
                sT[st] = (f32x4){0.f, 0.f, 0.f, 0.f};
                if (st <= w) {
#pragma unroll
                    for (int kk = 0; kk < 2; ++kk) { const bf16x8 kf = *(const bf16x8*)(KS + st * 2048 + (kk ? rb1 : rb0)); sT[st] = __builtin_amdgcn_mfma_f32_16x16x32_bf16(kf, qf[kk], sT[st], 0, 0, 0); }
#pragma unroll
                    for (int r = 0; r < 4; ++r) if (16 * st + 4 * q4 + r > 16 * w + l15) sT[st][r] = 0.f;
                }
            }
            bf16x8 af[2];
#pragma unroll
            for (int ks2 = 0; ks2 < 2; ++ks2) {
                union { bf16x8 v; unsigned u[4]; } cv;
                cv.u[0] = pack2(sT[2 * ks2][0], sT[2 * ks2][1]); cv.u[1] = pack2(sT[2 * ks2][2], sT[2 * ks2][3]);
                cv.u[2] = pack2(sT[2 * ks2 + 1][0], sT[2 * ks2 + 1][1]); cv.u[3] = pack2(sT[2 * ks2 + 1][2], sT[2 * ks2 + 1][3]);
                af[ks2] = cv.v;
            }
            const int vb = l15 * 128 + ((((q4 >> 1) ^ (l15 & 7)) << 4) | ((q4 & 1) * 8));
            f32x4 o[8];
#pragma unroll
            for (int nt = 0; nt < 8; ++nt) {
                o[nt] = (f32x4){0.f, 0.f, 0.f, 0.f};
                const int e = 16 * nt + l15;
#pragma unroll
                for (int kk = 0; kk < 2; ++kk) { const bf16x8 sf = *(const bf16x8*)(SPT + nt * 2048 + (kk ? rb1 : rb0)); o[nt] = __builtin_amdgcn_mfma_f32_16x16x32_bf16(sf, qf[kk], o[nt], 0, 0, 0); }
#pragma unroll
                for (int ks2 = 0; ks2 < 2; ++ks2) {
                    if (2 * ks2 <= w) {
                        union { bf16x8 v; uint2 h[2]; } cv;
                        cv.h[0] = *(const uint2*)(VTs + nt * 2048 + (vb ^ (ks2 * 64)));
                        cv.h[1] = *(const uint2*)(VTs + nt * 2048 + (vb ^ (ks2 * 64) ^ 32));
                        o[nt] = __builtin_amdgcn_mfma_f32_16x16x32_bf16(cv.v, af[ks2], o[nt], 0, 0, 0);
                    }
                }
            }
            {
                const float4 dc = *(const float4*)(DEC + 16 * w + 4 * q4);
                bf16x8 kof[2];
#pragma unroll
                for (int kk = 0; kk < 2; ++kk) kof[kk] = *(const bf16x8*)(KOT + w * 2048 + (kk ? rb1 : rb0));
#pragma unroll
                for (int nt = 0; nt < 8; ++nt) {
                    Sacc[nt][0] *= dc.x; Sacc[nt][1] *= dc.y; Sacc[nt][2] *= dc.z; Sacc[nt][3] *= dc.w;
#pragma unroll
                    for (int kk = 0; kk < 2; ++kk) { const bf16x8 vf = *(const bf16x8*)(VTs + nt * 2048 + (kk ? rb1 : rb0)); Sacc[nt] = __builtin_amdgcn_mfma_f32_16x16x32_bf16(kof[kk], vf, Sacc[nt], 0, 0, 0); }
                }
            }
            __syncthreads();
#pragma unroll
            for (int nt = 0; nt < 8; ++nt) {
                const int e = 16 * nt + l15;
                uint2 pk; pk.x = pack2(Sacc[nt][0], Sacc[nt][1]); pk.y = pack2(Sacc[nt][2], Sacc[nt][3]);
                *(uint2*)(SPT + nt * 2048 + l15 * 128 + (((2 * w + (q4 >> 1)) ^ (l15 & 7)) << 4) + (q4 & 1) * 8) = pk;
            }
            float ssq = 0.f;
#pragma unroll
            for (int nt = 0; nt < 8; ++nt) ssq += (o[nt][0] * o[nt][0] + o[nt][1] * o[nt][1]) + (o[nt][2] * o[nt][2] + o[nt][3] * o[nt][3]);
            ssq += __shfl_xor(ssq, 16); ssq += __shfl_xor(ssq, 32);
            const float rsd = rsqrtf(ssq * (1.0f / 128.0f) + EPS);
#pragma unroll
            for (int nt = 0; nt < 8; ++nt) {
                asm volatile("" ::: "memory");
                const f32x4 gn = *(const f32x4*)(GN + 16 * nt + 4 * q4);
                const float g0 = lo2f(gr[nt].x), g1 = hi2f(gr[nt].x), g2 = lo2f(gr[nt].y), g3 = hi2f(gr[nt].y);
                uint2 ov;
                ov.x = pack2(o[nt][0] * rsd * gn[0] * (g0 / (1.0f + __expf(-g0))), o[nt][1] * rsd * gn[1] * (g1 / (1.0f + __expf(-g1))));
                ov.y = pack2(o[nt][2] * rsd * gn[2] * (g2 / (1.0f + __expf(-g2))), o[nt][3] * rsd * gn[3] * (g3 / (1.0f + __expf(-g3))));
                if (!dry || ov.x == 0x7fc17fc1u) *(uint2*)(gbase + (goff + 16 * nt)) = ov;
            }
        }
    }
}

__device__ __forceinline__ unsigned ord_key(float f) { const unsigned u = __float_as_uint(f); return (u & 0x80000000u) ? ~u : (u | 0x80000000u); }
__device__ __forceinline__ float unord_key(unsigned k) { return __uint_as_float((k & 0x80000000u) ? (k & 0x7fffffffu) : ~k); }
__device__ __forceinline__ void ce_desc(unsigned& a, unsigned& b) { const unsigned hi = max(a, b), lo = min(a, b); a = hi; b = lo; }
__device__ __forceinline__ void bitonic_sort16_desc(unsigned (&a)[16]) {
#pragma unroll
    for (int k = 2; k <= 16; k <<= 1)
#pragma unroll
        for (int j = k >> 1; j > 0; j >>= 1)
#pragma unroll
            for (int i = 0; i < 16; ++i) { const int l = i ^ j; if (l > i) { if ((i & k) == 0) ce_desc(a[i], a[l]); else ce_desc(a[l], a[i]); } }
}
__device__ __forceinline__ void merge_top16(unsigned (&L)[16], const unsigned (&B)[16]) {
#pragma unroll
    for (int i = 0; i < 16; ++i) L[i] = max(L[i], B[15 - i]);
#pragma unroll
    for (int j = 8; j > 0; j >>= 1)
#pragma unroll
        for (int i = 0; i < 16; ++i) { const int l = i ^ j; if (l > i) ce_desc(L[i], L[l]); }
}
__device__ constexpr int cand_i(int n) { int c = 0; for (int i = 0; i < 16; ++i) for (int j = 0; j < 16; ++j) if ((i + 1) * (j + 1) <= 16) { if (c == n) return i; ++c; } return -1; }
__device__ constexpr int cand_j(int n) { int c = 0; for (int i = 0; i < 16; ++i) for (int j = 0; j < 16; ++j) if ((i + 1) * (j + 1) <= 16) { if (c == n) return j; ++c; } return -1; }
template <int N> struct CandTab { int i[N], j[N]; constexpr CandTab() : i(), j() { for (int n = 0; n < N; ++n) { i[n] = cand_i(n); j[n] = cand_j(n); } } };
__device__ __forceinline__ void peer_select_fast(const Params& p, int layer, char* smem) {
    const bf16_t* A = (const bf16_t*)(p.ws + OFF_H);
    const bf16_t* Bt = (const bf16_t*)(p.ws + OFF_WT_Q) + (size_t)layer * 2048 * 1024;
    const bf16_t* SK = (const bf16_t*)(p.ws + OFF_SK) + (size_t)layer * 8 * 2 * 128 * 128;
    unsigned short* IDX = (unsigned short*)(p.ws + OFF_IDX); float* GATE = (float*)(p.ws + OFF_GATE);
    const int tid_ = VTID;
    float* SC = (float*)smem; unsigned* XCH = (unsigned*)smem;
    int mt_, hh;
    for (int it = 0; tile_sched(it, T / 128, 8, mt_, hh); ++it) {
        const int m0 = mt_ * 128;
        unsigned L0[16], L1[16];
#pragma unroll
        for (int pp = 0; pp < 2; ++pp) {
            f32x4 acc[4][4];
            gemm_mainloop<0>(A, A, 1024, 1024, Bt, 1024, m0, hh * 256 + pp * 128, acc, smem);
            int lz = 0; asm volatile("" : "+v"(lz));
            const int tid = tid_ + lz, lane = tid & 63, wid = tid >> 6, wm = wid >> 1, wn = wid & 1, l15 = lane & 15, q4 = lane >> 4, token = tid & 127, half = tid >> 7;
#pragma unroll
            for (int i = 0; i < 4; ++i)
#pragma unroll
                for (int j = 0; j < 4; ++j) {
                    const int row = wm * 64 + i * 16 + l15, chunk = 2 * j + (q4 >> 1);
                    uint2 o; o.x = pack2(acc[i][j][0], acc[i][j][1]); o.y = pack2(acc[i][j][2], acc[i][j][3]);
                    *(uint2*)(smem + wn * 32768 + row * 128 + ((chunk ^ (row & 7)) << 4) + (q4 & 1) * 8) = o;
                }
            const bf16_t* SKp = SK + (size_t)((hh * 2 + pp) * 128) * 128;
#pragma unroll
            for (int i = 0; i < 8; ++i) {
                const int c = tid + 256 * i, row = c >> 4, ch16 = c & 15, ks = ch16 >> 3, ch = ch16 & 7;
                *(uint4*)(smem + ks * 32768 + 16384 + row * 128 + ((ch ^ (row & 7)) << 4)) = *(const uint4*)(SKp + (size_t)row * 128 + ch16 * 8);
            }
            __syncthreads();
#pragma unroll
            for (int i = 0; i < 4; ++i)
#pragma unroll
                for (int j = 0; j < 4; ++j) acc[i][j] = (f32x4){0.f, 0.f, 0.f, 0.f};
#pragma unroll
            for (int kt = 0; kt < 2; ++kt) {
                const char* sa = smem + kt * 32768; const char* sb = sa + 16384;
#pragma unroll
                for (int ks = 0; ks < 2; ++ks) {
                    bf16x8 af[4], bfr[4];
                    const int ch = ks * 4 + q4;
#pragma unroll
                    for (int i = 0; i < 4; ++i) { const int row = wm * 64 + i * 16 + l15; af[i] = *(const bf16x8*)(sa + row * 128 + ((ch ^ (row & 7)) << 4)); }
#pragma unroll
                    for (int j = 0; j < 4; ++j) { const int row = wn * 64 + j * 16 + l15; bfr[j] = *(const bf16x8*)(sb + row * 128 + ((ch ^ (row & 7)) << 4)); }
#pragma unroll
                    for (int i = 0; i < 4; ++i)
#pragma unroll
                        for (int j = 0; j < 4; ++j) acc[i][j] = __builtin_amdgcn_mfma_f32_16x16x32_bf16(bfr[j], af[i], acc[i][j], 0, 0, 0);
                }
            }
            __syncthreads();
#pragma unroll
            for (int i = 0; i < 4; ++i)
#pragma unroll
                for (int j = 0; j < 4; ++j) {
                    const int m = wm * 64 + i * 16 + l15, n = wn * 64 + j * 16 + 4 * q4;
#pragma unroll
                    for (int r = 0; r < 4; ++r) SC[m * 128 + ((n + r) ^ (m & 31))] = acc[i][j][r];
                }
            __syncthreads();
            unsigned L[16];
            {
                const float* srow = SC + token * 128 + half * 64; const int x = token & 31;
#pragma unroll
                for (int ch = 0; ch < 4; ++ch) {
                    unsigned Cc[16];
#pragma unroll
                    for (int i = 0; i < 16; ++i) { const int c = ch * 16 + i; Cc[i] = (ord_key(srow[c ^ x]) & ~127u) | (unsigned)(127 - (half * 64 + c)); }
                    bitonic_sort16_desc(Cc);
                    if (ch == 0) {
#pragma unroll
                        for (int i = 0; i < 16; ++i) L[i] = Cc[i];
                    } else merge_top16(L, Cc);
                }
            }
            __syncthreads();
            if (half == 1) {
#pragma unroll
                for (int i = 0; i < 16; ++i) XCH[token * 17 + i] = L[i];
            }
            __syncthreads();
            if (half == 0) {
                unsigned Xc[16];
#pragma unroll
                for (int i = 0; i < 16; ++i) Xc[i] = XCH[token * 17 + i];
                merge_top16(L, Xc);
            }
#pragma unroll
            for (int i = 0; i < 16; ++i) { if (pp == 0) L0[i] = L[i]; else L1[i] = L[i]; }
            __syncthreads();
        }
        unsigned* NIDX = (unsigned*)smem;
        const int token = tid_ & 127, half = tid_ >> 7;
        if (half == 0) {
            float s0[16], s1[16];
#pragma unroll
            for (int i = 0; i < 16; ++i) { s0[i] = unord_key(L0[i] & ~127u); s1[i] = unord_key(L1[i] & ~127u); }
            constexpr CandTab<64> ct{};
            unsigned C[16];
#pragma unroll
            for (int ch = 0; ch < 4; ++ch) {
                unsigned Cc[16];
#pragma unroll
                for (int i = 0; i < 16; ++i) {
                    const int n = ch * 16 + i;
                    if (ct.i[n] >= 0) Cc[i] = (ord_key(s0[ct.i[n] < 0 ? 0 : ct.i[n]] + s1[ct.j[n] < 0 ? 0 : ct.j[n]]) & ~255u) | (unsigned)(255 - (ct.i[n] * 16 + ct.j[n]));
                    else Cc[i] = 0u;
                }
                bitonic_sort16_desc(Cc);
                if (ch == 0) {
#pragma unroll
                    for (int i = 0; i < 16; ++i) C[i] = Cc[i];
                } else merge_top16(C, Cc);
            }
#pragma unroll
            for (int i = 0; i < 16; ++i) { NIDX[token * 33 + i] = 127u - (L0[i] & 127u); NIDX[token * 33 + 16 + i] = 127u - (L1[i] & 127u); }
            const float mx = unord_key(C[0] & ~255u);
            float e[16]; float sum = 0.f;
#pragma unroll
            for (int r = 0; r < 16; ++r) { e[r] = __expf(unord_key(C[r] & ~255u) - mx); sum += e[r]; }
            const float inv = 1.0f / sum;
            const size_t ob = (size_t)(m0 + token) * 128 + hh * 16;
#pragma unroll
            for (int r = 0; r < 16; ++r) {
                const unsigned code = 255u - (C[r] & 255u);
                const unsigned e0 = NIDX[token * 33 + (code >> 4)], e1 = NIDX[token * 33 + 16 + (code & 15)];
                IDX[ob + r] = (unsigned short)(e0 * 128 + e1);
                GATE[ob + r] = e[r] * inv;
            }
        }
        __syncthreads();
    }
}

__device__ __forceinline__ bf16x8 pack8(const float4 a, const float4 b) {
    u32x4 t; t.x = pack2(a.x, a.y); t.y = pack2(a.z, a.w); t.z = pack2(b.x, b.y); t.w = pack2(b.z, b.w);
    return __builtin_bit_cast(bf16x8, t);
}
__device__ __forceinline__ void fold_query_weights(const Params& p, int vb0 = 0) {
    int lz = 0; asm volatile("" : "+v"(lz));
    const int lane = (VTID & 63) + lz, wid = VTID >> 6, fr = lane & 15, fq = lane >> 4;
    bf16_t* Wf = (bf16_t*)(p.ws + OFF_WT_Q);
    if (VBID < vb0) return;
    for (int task = VBID - vb0; task < 512; task += VGRID - vb0) {
        const int kb = task & 15, pp = (task >> 4) & 1, h = (task >> 5) & 7, layer = task >> 8;
        const float* wq = p.peer_w_q + (size_t)layer * 1024 * 2048 + (size_t)(kb * 64 + fr) * 2048 + h * 256 + pp * 128 + fq * 8;
        const float* sk = p.peer_subkeys + ((size_t)((layer * 8 + h) * 2 + pp) * 128 + wid * 32 + fr) * 128 + fq * 8;
        f32x4 acc[4][2];
#pragma unroll
        for (int kt = 0; kt < 4; ++kt)
#pragma unroll
            for (int jt = 0; jt < 2; ++jt) acc[kt][jt] = (f32x4){0.f, 0.f, 0.f, 0.f};
#pragma unroll 1
        for (int s = 0; s < 4; ++s) {
            bf16x8 a[4], b[2];
#pragma unroll
            for (int kt = 0; kt < 4; ++kt) { const float* q = wq + (size_t)(kt * 16) * 2048 + s * 32; a[kt] = pack8(*(const float4*)q, *(const float4*)(q + 4)); }
#pragma unroll
            for (int jt = 0; jt < 2; ++jt) { const float* q = sk + (size_t)(jt * 16) * 128 + s * 32; b[jt] = pack8(*(const float4*)q, *(const float4*)(q + 4)); }
#pragma unroll
            for (int kt = 0; kt < 4; ++kt)
#pragma unroll
                for (int jt = 0; jt < 2; ++jt) acc[kt][jt] = __builtin_amdgcn_mfma_f32_16x16x32_bf16(a[kt], b[jt], acc[kt][jt], 0, 0, 0);
        }
#pragma unroll
        for (int jt = 0; jt < 2; ++jt) {
            const int key = wid * 32 + jt * 16 + fr, cu = 128 * ((key >> 5) & 1) + 32 * (2 * pp + (key >> 6)) + (key & 31);
            bf16_t* row = Wf + ((size_t)layer * 2048 + h * 256 + cu) * 1024 + kb * 64 + 4 * fq;
#pragma unroll
            for (int kt = 0; kt < 4; ++kt) store_bf16x4(row + kt * 16, acc[kt][jt]);
        }
    }
}
__device__ __forceinline__ void bitonic_merge16_desc(unsigned (&L)[16]) {
#pragma unroll
    for (int j = 8; j > 0; j >>= 1)
#pragma unroll
        for (int i = 0; i < 16; ++i) { const int l = i ^ j; if (l > i) ce_desc(L[i], L[l]); }
}
__device__ __forceinline__ void bitonic_sort8_desc(unsigned (&a)[8]) {
#pragma unroll
    for (int k = 2; k <= 8; k <<= 1)
#pragma unroll
        for (int j = k >> 1; j > 0; j >>= 1)
#pragma unroll
            for (int i = 0; i < 8; ++i) { const int l = i ^ j; if (l > i) { if ((i & k) == 0) ce_desc(a[i], a[l]); else ce_desc(a[l], a[i]); } }
}
struct EpiSelect {
    unsigned* IDX; float* GATE; G8_LAS unsigned* X; const float* SSQP; const unsigned* SCT;
    __device__ __forceinline__ void operator()(const f32x4 (&acc)[2][2][4][2], const g8::Unit& u, int wr, int wc, int fr, int fq) const {
        const int pp = wc >> 1, half = wc & 1, wid = wr * 4 + wc;
        const unsigned kb = 127u - (unsigned)(half * 64 + fq * 8);
        unsigned Lst[4][16];
#pragma unroll
        for (int ai = 0; ai < 2; ++ai)
#pragma unroll
            for (int m = 0; m < 4; ++m) {
                unsigned C[16], Xc[16];
#pragma unroll
                for (int bj = 0; bj < 2; ++bj)
#pragma unroll
                    for (int n = 0; n < 2; ++n)
#pragma unroll
                        for (int r = 0; r < 4; ++r) C[bj * 8 + n * 4 + r] = (ord_key(acc[ai][bj][m][n][r]) & ~127u) | (kb - (unsigned)(bj * 32 + n * 4 + r));
                bitonic_sort16_desc(C);
#pragma unroll
                for (int i = 0; i < 16; ++i) Xc[i] = (unsigned)__shfl_xor((int)C[i], 16);
                merge_top16(C, Xc);
#pragma unroll
                for (int i = 0; i < 16; ++i) Xc[i] = (unsigned)__shfl_xor((int)C[i], 32);
                merge_top16(C, Xc);
                if ((m >> 1) == half) {
#pragma unroll
                    for (int i = 0; i < 16; ++i) Lst[ai * 2 + (m & 1)][i] = C[i];
                } else if (fq == 0) {
                    G8_LAS unsigned* xs = X + (((ai * 2 + wr) * 2 + pp) * 4 + m) * 256 + fr;
#pragma unroll
                    for (int i = 0; i < 16; ++i) xs[(i ^ m) << 4] = C[i];
                }
            }
        __syncthreads();
#pragma unroll
        for (int ai = 0; ai < 2; ++ai)
#pragma unroll
            for (int e = 0; e < 2; ++e) {
                const int m = half * 2 + e;
                unsigned Xc[16];
                G8_LAS unsigned* xs = X + (((ai * 2 + wr) * 2 + pp) * 4 + m) * 256 + fr;
#pragma unroll
                for (int i = 0; i < 16; ++i) Xc[i] = xs[(i ^ m) << 4];
                merge_top16(Lst[ai * 2 + e], Xc);
                if (fq == 0) {
#pragma unroll
                    for (int i = 0; i < 16; ++i) xs[(i ^ m) << 4] = Lst[ai * 2 + e][i];
                }
            }
        __syncthreads();
        if (wid < 4) {
            G8_LAS unsigned* x0 = X + ((wid * 2 + 0) * 4 + fq) * 256 + fr; G8_LAS unsigned* x1 = X + ((wid * 2 + 1) * 4 + fq) * 256 + fr;
            float s0[16], s1[16];
#pragma unroll
            for (int i = 0; i < 16; ++i) { s0[i] = unord_key(x0[(i ^ fq) << 4] & ~127u); s1[i] = unord_key(x1[(i ^ fq) << 4] & ~127u); }
#define SEL_CAND(i, j) ((ord_key(s0[i] + s1[j]) & ~255u) | (unsigned)(255 - ((i) * 16 + (j))))
            unsigned C[16], B[16], M2[16], M3[8];
#pragma unroll
            for (int j = 0; j < 16; ++j) C[j] = SEL_CAND(0, j);
#pragma unroll
            for (int k = 0; k < 15; ++k) B[k] = SEL_CAND(k + 1, 0);
            B[15] = 0u;
            merge_top16(C, B);
#pragma unroll
            for (int j = 0; j < 7; ++j) M2[j] = SEL_CAND(1, j + 1);
            M2[7] = 0u; M2[8] = 0u; M2[9] = 0u;
#pragma unroll
            for (int k = 0; k < 6; ++k) M2[15 - k] = SEL_CAND(k + 2, 1);
            bitonic_merge16_desc(M2);
            M3[0] = SEL_CAND(2, 2); M3[1] = SEL_CAND(2, 3); M3[2] = SEL_CAND(2, 4); M3[3] = SEL_CAND(3, 2); M3[4] = SEL_CAND(4, 2); M3[5] = SEL_CAND(3, 3); M3[6] = 0u; M3[7] = 0u;
            bitonic_sort8_desc(M3);
#pragma unroll
            for (int i = 0; i < 8; ++i) B[i] = M3[i];
#pragma unroll
            for (int i = 8; i < 16; ++i) B[i] = 0u;
            merge_top16(M2, B);
            merge_top16(C, M2);
#undef SEL_CAND
            const int tok = u.pm * 256 + (wid >> 1) * 128 + (wid & 1) * 64 + fq * 16 + fr;
            float rstd;
            {
                const f32x4 q0 = *(const f32x4*)(SSQP + (size_t)tok * 32), q1 = *(const f32x4*)(SSQP + (size_t)tok * 32 + 4), q2 = *(const f32x4*)(SSQP + (size_t)tok * 32 + 8), q3 = *(const f32x4*)(SSQP + (size_t)tok * 32 + 12);
                const f32x4 q = (q0 + q1) + (q2 + q3);
                rstd = rsqrtf(((q[0] + q[1]) + (q[2] + q[3])) * (1.0f / D) + EPS);
            }
            const float mx = unord_key(C[0] & ~255u);
            float e[16]; float sum = 0.f;
#pragma unroll
            for (int r = 0; r < 16; ++r) { e[r] = __expf((unord_key(C[r] & ~255u) - mx) * rstd); sum += e[r]; }
            const float inv = 1.0f / sum;
            const size_t ob = (size_t)tok * 128 + u.pn * 16;
            unsigned iw[16];
#pragma unroll
            for (int r = 0; r < 16; ++r) {
                const unsigned code = 255u - (C[r] & 255u);
                const unsigned e0 = 127u - (x0[((code >> 4) ^ (unsigned)fq) << 4] & 127u), e1 = 127u - (x1[((code & 15u) ^ (unsigned)fq) << 4] & 127u);
                iw[r] = e0 * 128u + e1;
            }
            unsigned sc[16];
#pragma unroll
            for (int r = 0; r < 16; ++r) sc[r] = SCT[iw[r]];
#pragma unroll
            for (int r = 0; r < 16; ++r) {
                iw[r] |= sc[r] << 16;
                e[r] *= inv * (float)__builtin_bit_cast(_Float16, (unsigned short)(sc[r] >> 16));
            }
#pragma unroll
            for (int r = 0; r < 4; ++r) *(uint4*)(IDX + ob + r * 4) = make_uint4(iw[4 * r], iw[4 * r + 1], iw[4 * r + 2], iw[4 * r + 3]);
#pragma unroll
            for (int r = 0; r < 4; ++r) *(float4*)(GATE + ob + r * 4) = make_float4(e[4 * r], e[4 * r + 1], e[4 * r + 2], e[4 * r + 3]);
        }
        __syncthreads();
    }
};
__device__ __forceinline__ void phase_select8(const Params& p, int layer, char* smem_phys) {
    const bf16_t* H = (const bf16_t*)(p.ws + OFF_H); const bf16_t* Wf = (const bf16_t*)(p.ws + OFF_WT_Q) + (size_t)layer * 2048 * 1024;
    g8::Gemm g{H, H, 1024, 1024, Wf, T, 2048, 1024};
    g8::StaticOrder S; S.init(T, 2048, (int)gridDim.x, (int)blockIdx.x);
    EpiSelect E{(unsigned*)(p.ws + OFF_IDX), (float*)(p.ws + OFF_GATE), (G8_LAS unsigned*)(smem_phys + 131072), (const float*)(p.ws + OFF_SSQ), (const unsigned*)(p.ws + OFF_USC) + (size_t)layer * NEXP};
    g8::gemm_phase<EpiSelect>((G8_LAS unsigned char*)smem_phys, g, S, E);
    __syncthreads();
    if (threadIdx.x == 0) *(uint4*)(smem_phys + kDynLds - 16) = make_uint4(0u, 0u, 0u, 0u);
    __syncthreads();
}

__device__ __forceinline__ float ub0(unsigned w) { float f; asm("v_cvt_f32_ubyte0 %0, %1" : "=v"(f) : "v"(w)); return f; }
__device__ __forceinline__ float ub1(unsigned w) { float f; asm("v_cvt_f32_ubyte1 %0, %1" : "=v"(f) : "v"(w)); return f; }
__device__ __forceinline__ float ub2(unsigned w) { float f; asm("v_cvt_f32_ubyte2 %0, %1" : "=v"(f) : "v"(w)); return f; }
__device__ __forceinline__ float ub3(unsigned w) { float f; asm("v_cvt_f32_ubyte3 %0, %1" : "=v"(f) : "v"(w)); return f; }
typedef _Float16 f16x2 __attribute__((ext_vector_type(2)));
__device__ __forceinline__ void glds16(const void* gsrc, unsigned lds_dst) {
    unsigned keep; const unsigned d = (unsigned)__builtin_amdgcn_readfirstlane((int)lds_dst);
    asm volatile("s_mov_b32 %0, m0\n\ts_mov_b32 m0, %2\n\ts_nop 0\n\tglobal_load_lds_dwordx4 %1, off\n\ts_mov_b32 m0, %0" : "=&s"(keep) : "v"(gsrc), "s"(d) : "memory");
}
__device__ __forceinline__ void peer_gather(const Params& p, int layer, const float* __restrict__ gnext, bool final_out, char* smem) {
    const unsigned char* REC = p.ws + OFF_UT + (size_t)layer * NEXP * 1024;
    bf16_t* H = (bf16_t*)(p.ws + OFF_H);
    const unsigned* IDX = (const unsigned*)(p.ws + OFF_IDX); const float* GATE = (const float*)(p.ws + OFF_GATE);
    float* X = p.out;
    const int lane = VTID & 63, wid = VTID >> 6, sub = lane >> 4, li = lane & 15;
    char* wbase = smem + (int)(threadIdx.x >> 6) * 17408;
    unsigned* sIdx = (unsigned*)wbase; float* sGate = (float*)(wbase + 512);
    const char* ring = wbase + 1024; const unsigned ringb = (unsigned)(size_t)ring;
    const int gw = VBID * 4 + wid, nw = VGRID * 4;
    for (int t = gw; t < T; t += nw) {
        {
            int lz = 0; asm volatile("" : "+v"(lz));
            const int l2 = 2 * (lane + lz);
            const uint2 idp = *(const uint2*)(IDX + (size_t)t * 128 + l2);
            const float2 g2 = *(const float2*)(GATE + (size_t)t * 128 + l2);
            *(uint2*)(sIdx + l2) = idp; *(float2*)(sGate + l2) = g2;
        }
        int XH[2][4], XL[2][4]; float sx; float xg;
        {
            u32x4 xr[8]; float am = 0.f;
#pragma unroll
            for (int k = 0; k < 8; ++k) {
                xr[k] = *(const u32x4*)(H + (size_t)t * 1024 + (16 * (k >> 2) + li) * 32 + (k & 3) * 8);
#pragma unroll
                for (int c = 0; c < 4; ++c) am = fmaxf(am, fmaxf(fabsf(lo2f(xr[k][c])), fabsf(hi2f(xr[k][c]))));
            }
            const float* sq = (const float*)(p.ws + OFF_SSQ) + (size_t)t * 32;
            const f32x4 qs = (*(const f32x4*)sq + *(const f32x4*)(sq + 4)) + (*(const f32x4*)(sq + 8) + *(const f32x4*)(sq + 12));
            am = fmaxf(am, __shfl_xor(am, 1)); am = fmaxf(am, __shfl_xor(am, 2)); am = fmaxf(am, __shfl_xor(am, 4)); am = fmaxf(am, __shfl_xor(am, 8));
            const float inv = am > 0.f ? 119.0f / am : 0.f;
            sx = am * (1.0f / 119.0f) * rsqrtf(((qs[0] + qs[1]) + (qs[2] + qs[3])) * (1.0f / D) + EPS);
            int xs = 0;
#pragma unroll
            for (int j = 0; j < 2; ++j)
#pragma unroll
                for (int d = 0; d < 4; ++d) {
                    const u32x4 raw = xr[j * 4 + d];
                    unsigned lo = 0u, hi = 0u;
#pragma unroll
                    for (int i = 0; i < 8; ++i) {
                        const unsigned wsrc = raw[i >> 1];
                        const int q = __float2int_rn(((i & 1) ? hi2f(wsrc) : lo2f(wsrc)) * inv);
                        const int sh = (i & 3) * 8 + (i >> 2) * 4;
                        lo |= ((unsigned)q & 15u) << sh; hi |= ((unsigned)((q + 8) >> 4) & 15u) << sh;
                        xs += q;
                    }
                    XL[j][d] = (int)lo; XH[j][d] = (int)hi;
                }
            xg = 0.5f * (float)xs;
        }
        f16x2 accp[2][16];
#pragma unroll
        for (int j = 0; j < 2; ++j)
#pragma unroll
            for (int c = 0; c < 16; ++c) accp[j][c] = (f16x2){(_Float16)0.f, (_Float16)0.f};
        float wsg = 0.f;
        auto issue = [&](int sg) {
            const unsigned e_ = sIdx[sg * 4 + sub] & 0xffffu;
            const unsigned char* rec = REC + (size_t)e_ * 1024 + li * 16;
            const unsigned dst = ringb + (unsigned)(sg & 3) * 4096u;
            glds16(rec, dst); glds16(rec + 256, dst + 1024u); glds16(rec + 512, dst + 2048u); glds16(rec + 768, dst + 3072u);
        };
        auto compute = [&](int sg, bool refill) {
            const char* sl = ring + (sg & 3) * 4096;
            const u32x4 du0 = *(const u32x4*)(sl + lane * 16), du1 = *(const u32x4*)(sl + 1024 + lane * 16);
            const u32x4 dv0 = *(const u32x4*)(sl + 2048 + lane * 16), dv1 = *(const u32x4*)(sl + 3072 + lane * 16);
            const float us = (float)__builtin_bit_cast(_Float16, (unsigned short)(sIdx[sg * 4 + sub] >> 16));
            const float gt = sGate[sg * 4 + sub];
            if (refill) { asm volatile("s_waitcnt lgkmcnt(0)" ::: "memory"); issue(sg + 4); }
            int iah = 0, ial = 0;
#pragma unroll
            for (int j = 0; j < 2; ++j) {
#pragma unroll
                for (int d = 0; d < 4; ++d) {
                    const int w = (int)(j ? du1[d] : du0[d]);
                    iah = __builtin_amdgcn_sdot8(w, XH[j][d], iah, false);
                    ial = __builtin_amdgcn_sdot8(w, XL[j][d], ial, false);
                }
            }
            float pa = us * ((float)(16 * iah + ial) + xg);
            pa = row16_sum(pa);
            const float ww = gt * gelu_exact(pa * sx);
            wsg += ww;
            const float wc = fminf(fmaxf(ww * 65536.0f, -65504.0f), 65504.0f);
            const _Float16 wha = (_Float16)wc, whb = (_Float16)(wc * 0.0625f);
            const f16x2 wa = {wha, wha}, wb = {whb, whb};
#pragma unroll
            for (int j = 0; j < 2; ++j) {
#pragma unroll
                for (int d = 0; d < 4; ++d) {
                    const unsigned wv = j ? dv1[d] : dv0[d], wt = wv >> 8;
                    const f16x2 c0 = __builtin_bit_cast(f16x2, wv & 0x000f000fu), c1 = __builtin_bit_cast(f16x2, wv & 0x00f000f0u);
                    const f16x2 c2 = __builtin_bit_cast(f16x2, wt & 0x000f000fu), c3 = __builtin_bit_cast(f16x2, wt & 0x00f000f0u);
                    accp[j][4 * d + 0] = __builtin_elementwise_fma(c0, wa, accp[j][4 * d + 0]); accp[j][4 * d + 1] = __builtin_elementwise_fma(c1, wb, accp[j][4 * d + 1]);
                    accp[j][4 * d + 2] = __builtin_elementwise_fma(c2, wa, accp[j][4 * d + 2]); accp[j][4 * d + 3] = __builtin_elementwise_fma(c3, wb, accp[j][4 * d + 3]);
                }
            }
        };
        asm volatile("s_waitcnt vmcnt(0)" ::: "memory");
        issue(0); issue(1); issue(2); issue(3);
#pragma unroll 1
        for (int sg = 0; sg < 28; ++sg) {
            asm volatile("s_waitcnt vmcnt(12)" ::: "memory");
            compute(sg, true);
        }
        asm volatile("s_waitcnt vmcnt(12)" ::: "memory");
        compute(28, false);
        asm volatile("s_waitcnt vmcnt(8)" ::: "memory");
        compute(29, false);
        asm volatile("s_waitcnt vmcnt(4)" ::: "memory");
        compute(30, false);
        asm volatile("s_waitcnt vmcnt(0)" ::: "memory");
        compute(31, false);
        float acc[2][32];
#pragma unroll
        for (int j = 0; j < 2; ++j)
#pragma unroll
            for (int d = 0; d < 4; ++d) {
                acc[j][8 * d + 0] = 256.0f * (float)accp[j][4 * d + 0][0]; acc[j][8 * d + 2] = 256.0f * (float)accp[j][4 * d + 0][1];
                acc[j][8 * d + 4] = 256.0f * (float)accp[j][4 * d + 1][0]; acc[j][8 * d + 6] = 256.0f * (float)accp[j][4 * d + 1][1];
                acc[j][8 * d + 1] = 256.0f * (float)accp[j][4 * d + 2][0]; acc[j][8 * d + 3] = 256.0f * (float)accp[j][4 * d + 2][1];
                acc[j][8 * d + 5] = 256.0f * (float)accp[j][4 * d + 3][0]; acc[j][8 * d + 7] = 256.0f * (float)accp[j][4 * d + 3][1];
            }
        const bool up2 = (sub & 2) != 0, up1 = (sub & 1) != 0;
        float wsum = wsg + __shfl_xor(wsg, 32);
        wsum += __shfl_xor(wsum, 16);
        float r1[32];
#pragma unroll
        for (int c = 0; c < 32; ++c) r1[c] = (up2 ? acc[1][c] : acc[0][c]) + __shfl_xor(up2 ? acc[0][c] : acc[1][c], 32);
        float r2[16];
#pragma unroll
        for (int c = 0; c < 16; ++c) r2[c] = (up1 ? r1[16 + c] : r1[c]) + __shfl_xor(up1 ? r1[c] : r1[16 + c], 16);
        const int col0 = (16 * (sub >> 1) + li) * 32 + (sub & 1) * 16;
        float ss = 0.f;
        float* xrow = X + (size_t)t * 1024 + col0;
#pragma unroll
        for (int c4 = 0; c4 < 4; ++c4) {
            const f32x4 a = *(const f32x4*)(xrow + c4 * 4);
#pragma unroll
            for (int c = 0; c < 4; ++c) { r2[c4 * 4 + c] = r2[c4 * 4 + c] - 7.5f * wsum + a[c]; ss += r2[c4 * 4 + c] * r2[c4 * 4 + c]; }
        }
        ss = wave_sum(ss);
        const float rstd = rsqrtf(ss * (1.0f / D) + EPS);
        const float* gp = gnext + col0;
        if (final_out) {
#pragma unroll
            for (int c4 = 0; c4 < 4; ++c4) {
                const f32x4 g = *(const f32x4*)(gp + c4 * 4);
                *(f32x4*)(xrow + c4 * 4) = (f32x4){r2[c4 * 4] * rstd * g[0], r2[c4 * 4 + 1] * rstd * g[1], r2[c4 * 4 + 2] * rstd * g[2], r2[c4 * 4 + 3] * rstd * g[3]};
            }
        } else {
            u32x4 o[2];
#pragma unroll
            for (int c4 = 0; c4 < 4; ++c4) {
                const f32x4 g = *(const f32x4*)(gp + c4 * 4);
                *(f32x4*)(xrow + c4 * 4) = (f32x4){r2[c4 * 4], r2[c4 * 4 + 1], r2[c4 * 4 + 2], r2[c4 * 4 + 3]};
                o[c4 >> 1][(c4 & 1) * 2] = pack2(r2[c4 * 4] * rstd * g[0], r2[c4 * 4 + 1] * rstd * g[1]);
                o[c4 >> 1][(c4 & 1) * 2 + 1] = pack2(r2[c4 * 4 + 2] * rstd * g[2], r2[c4 * 4 + 3] * rstd * g[3]);
            }
            bf16_t* hp = H + (size_t)t * 1024 + col0;
            *(u32x4*)hp = o[0]; *(u32x4*)(hp + 8) = o[1];
        }
    }
}

__device__ __forceinline__ void spatial_fast(const Params& p, char* smem) {
    bf16_t* U = (bf16_t*)(p.ws + OFF_REGION); const bf16_t* VT = U + (size_t)T * 2048; const float* SSQ = (const float*)(p.ws + OFF_SSQ);
    const int tid_ = VTID;
    for (int task = VBID; task < 2048; task += VGRID) {
        const int chunk = task >> 3, g = task & 7;
        int lz = 0; asm volatile("" : "+v"(lz));
        const int tid = tid_ + lz, lane = tid & 63, wid = tid >> 6, wm = wid >> 1, wn = wid & 1, l15 = lane & 15, q4 = lane >> 4;
        float* rs = (float*)(smem + 16384);
        if (tid < 128) {
            const float* sp = SSQ + (size_t)(chunk * 128 + tid) * 32;
            float s = 0.f;
#pragma unroll
            for (int i = 0; i < 8; ++i) { const f32x4 v = *(const f32x4*)(sp + 4 * i); s += (v[0] + v[1]) + (v[2] + v[3]); }
            rs[tid] = rsqrtf(s * (1.0f / 2048.0f) + EPS);
        }
        __syncthreads();
#pragma unroll
        for (int i = 0; i < 8; ++i) {
            const int c = tid + 256 * i, row = c >> 4, ch16 = c & 15, ks = ch16 >> 3, ch = ch16 & 7, s0 = ch16 * 8;
            const float* wp = p.c_w_spatial + ((size_t)(g * 128 + row)) * 128 + s0;
            const f32x4 w0 = *(const f32x4*)wp, w1 = *(const f32x4*)(wp + 4);
            const f32x4 r0 = *(const f32x4*)(rs + s0), r1 = *(const f32x4*)(rs + s0 + 4);
            float v[8];
#pragma unroll
            for (int j = 0; j < 4; ++j) { v[j] = (s0 + j <= row) ? w0[j] * r0[j] : 0.f; v[4 + j] = (s0 + 4 + j <= row) ? w1[j] * r1[j] : 0.f; }
            *(uint4*)(smem + ks * 32768 + row * 128 + ((ch ^ (row & 7)) << 4)) = make_uint4(pack2(v[0], v[1]), pack2(v[2], v[3]), pack2(v[4], v[5]), pack2(v[6], v[7]));
        }
        __syncthreads();
#pragma unroll 1
        for (int nh = 0; nh < 2; ++nh) {
            const int chan0 = g * 256 + nh * 128;
#pragma unroll
            for (int i = 0; i < 8; ++i) {
                const int c = tid + 256 * i, row = c >> 4, ch16 = c & 15, ks = ch16 >> 3, ch = ch16 & 7;
                *(uint4*)(smem + ks * 32768 + 16384 + row * 128 + ((ch ^ (row & 7)) << 4)) = *(const uint4*)(VT + ((size_t)chunk * 2048 + chan0 + row) * 128 + ch16 * 8);
            }
            __syncthreads();
            f32x4 acc[4][4];
#pragma unroll
            for (int i = 0; i < 4; ++i)
#pragma unroll
                for (int j = 0; j < 4; ++j) acc[i][j] = (f32x4){0.f, 0.f, 0.f, 0.f};
#pragma unroll
            for (int kt = 0; kt < 2; ++kt) {
                if (kt == 1 && wm == 0) continue;
                const char* sa = smem + kt * 32768; const char* sb = sa + 16384;
#pragma unroll
                for (int ks = 0; ks < 2; ++ks) {
                    bf16x8 af[4], bfr[4];
                    const int ch = ks * 4 + q4;
#pragma unroll
                    for (int i = 0; i < 4; ++i) { const int row = wm * 64 + i * 16 + l15; af[i] = *(const bf16x8*)(sa + row * 128 + ((ch ^ (row & 7)) << 4)); }
#pragma unroll
                    for (int j = 0; j < 4; ++j) { const int row = wn * 64 + j * 16 + l15; bfr[j] = *(const bf16x8*)(sb + row * 128 + ((ch ^ (row & 7)) << 4)); }
#pragma unroll
                    for (int i = 0; i < 4; ++i)
#pragma unroll
                        for (int j = 0; j < 4; ++j) acc[i][j] = __builtin_amdgcn_mfma_f32_16x16x32_bf16(bfr[j], af[i], acc[i][j], 0, 0, 0);
                }
            }
            __syncthreads();
#pragma unroll
            for (int i = 0; i < 4; ++i) {
                const int m = wm * 64 + i * 16 + l15;
                const float bias = p.c_b_spatial[g * 128 + m];
#pragma unroll
                for (int j = 0; j < 4; ++j) {
                    const int chan = chan0 + wn * 64 + j * 16 + 4 * q4;
                    const f32x4 vn = *(const f32x4*)(p.c_v_norm + chan);
                    bf16_t* up = U + (size_t)(chunk * 128 + m) * 2048 + chan;
                    const uint2 uu = *(const uint2*)up;
                    uint2 o;
                    o.x = pack2(lo2f(uu.x) * (vn[0] * acc[i][j][0] + bias), hi2f(uu.x) * (vn[1] * acc[i][j][1] + bias));
                    o.y = pack2(lo2f(uu.y) * (vn[2] * acc[i][j][2] + bias), hi2f(uu.y) * (vn[3] * acc[i][j][3] + bias));
                    *(uint2*)up = o;
                }
            }
        }
    }
}

#define XB_TMO      128
#define XB_XCNT(j)  (256  + 64 * (j))
#define XB_XSUB(j)  (1280 + 64 * (j))
#define XB_XGEN(j)  (2304 + 64 * (j))
#define XB_TOP      3328
#define XB_TOPGEN   3392
#define XCD_BAR_WORDS 3456
#define XB_SPIN_CAP (1u << 22)
#define LAS __attribute__((address_space(3)))
__device__ __forceinline__ unsigned xb_ld(unsigned* p)              { return __hip_atomic_load(p, __ATOMIC_RELAXED, __HIP_MEMORY_SCOPE_AGENT); }
__device__ __forceinline__ unsigned xb_add(unsigned* p, unsigned v) { return __hip_atomic_fetch_add(p, v, __ATOMIC_RELAXED, __HIP_MEMORY_SCOPE_AGENT); }
__device__ __forceinline__ unsigned xb_xcc_id() { return (unsigned)__builtin_amdgcn_s_getreg((3 << 11) | 20) & 0xFu; }
#define XB_SPIN(cond, bar) do { unsigned _sp = 0; while (cond) { __builtin_amdgcn_s_sleep(1); \
    if ((++_sp & 255u) == 0u) { if (xb_ld(&(bar)[XB_TMO])) break; if (_sp > XB_SPIN_CAP) { atomicAdd(&(bar)[XB_TMO], 1u); break; } } } } while (0)
struct XcdBarrier { unsigned* bar; unsigned x; volatile LAS unsigned* st; };
__device__ __forceinline__ XcdBarrier xcd_barrier_post(unsigned* bar, volatile LAS unsigned* st) {
    XcdBarrier b; b.bar = bar; b.x = xb_xcc_id(); b.st = st;
    if (threadIdx.x == 0) (void)xb_add(&bar[XB_XCNT(b.x)], 1u);
    return b;
}
__device__ __forceinline__ void xcd_barrier_complete(unsigned* bar, unsigned x, unsigned& nloc, unsigned& nx) {
    const unsigned G = gridDim.x * gridDim.y * gridDim.z;
    unsigned sum, cnt, mine, sp = 0u;
    for (;;) {
        sum = 0u; cnt = 0u; mine = 0u;
#pragma unroll
        for (unsigned j = 0; j < 16; ++j) { const unsigned c = xb_ld(&bar[XB_XCNT(j)]); sum += c; cnt += (c > 0u) ? 1u : 0u; mine = (j == x) ? c : mine; }
        if (sum == G) break;
        __builtin_amdgcn_s_sleep(1);
        if ((++sp & 255u) == 0u) { if (xb_ld(&bar[XB_TMO])) break; if (sp > XB_SPIN_CAP) { atomicAdd(&bar[XB_TMO], 1u); break; } }
    }
    nloc = mine > 0u ? mine : 1u; nx = cnt > 0u ? cnt : 1u;
}
__device__ __forceinline__ void xcd_barrier(const XcdBarrier& b) {
    asm volatile("s_waitcnt vmcnt(0)" ::: "memory");
    __syncthreads();
    if (threadIdx.x == 0) {
        unsigned* bar = b.bar;
        __builtin_amdgcn_s_waitcnt(0);
        unsigned nloc = b.st[0], nx = b.st[1];
        if (nloc == 0u) { xcd_barrier_complete(bar, b.x, nloc, nx); b.st[0] = nloc; b.st[1] = nx; }
        const unsigned old = xb_add(&bar[XB_XSUB(b.x)], 1u);
        const unsigned gen = old / nloc;
        if (old + 1u == (gen + 1u) * nloc) {
            __builtin_amdgcn_fence(__ATOMIC_RELEASE, "agent");
            asm volatile("s_waitcnt vmcnt(0)" ::: "memory");
            const unsigned og = xb_add(&bar[XB_TOP], 1u);
            const unsigned tg = og / nx;
            if (og + 1u == (tg + 1u) * nx) xb_add(&bar[XB_TOPGEN], 1u);
            else XB_SPIN(xb_ld(&bar[XB_TOPGEN]) == tg, bar);
            __builtin_amdgcn_fence(__ATOMIC_ACQUIRE, "agent");
            xb_add(&bar[XB_XGEN(b.x)], 1u);
            asm volatile("s_waitcnt vmcnt(0)" ::: "memory");
        } else {
            XB_SPIN(xb_ld(&bar[XB_XGEN(b.x)]) == gen, bar);
            __builtin_amdgcn_fence(__ATOMIC_ACQUIRE, "agent");
            asm volatile("s_waitcnt vmcnt(0)" ::: "memory");
        }
    }
    __syncthreads();
}

constexpr int NPHASE = 12;
__global__ void __launch_bounds__(512, 2) mega(Params p, int ph_lo, int ph_hi) {
    extern __shared__ __attribute__((aligned(16))) char smem_phys[];
    uint4& xb_words = *(uint4*)(smem_phys + kDynLds - 16);
    if (threadIdx.x == 0) xb_words = make_uint4(0u, 0u, 0u, 0u);
    __syncthreads();
    const XcdBarrier xbar = xcd_barrier_post((unsigned*)(p.ws + OFF_BAR), (volatile LAS unsigned*)&xb_words);
    char* smem = smem_phys + (threadIdx.x >> 8) * 65536;
    bf16_t* Rg = (bf16_t*)(p.ws + OFF_REGION);
    bf16_t* Hb = (bf16_t*)(p.ws + OFF_H);
#define PHASE(k, ...) if (ph_lo <= (k) && (k) < ph_hi) { __VA_ARGS__; if ((k) + 1 < ph_hi) xcd_barrier(xbar); }
    unsigned* sbctr = (unsigned*)(p.ws + OFF_BAR + 14336);
    PHASE(0,
        transpose_convert<true>(p.ab_w_in, (bf16_t*)(p.ws + OFF_WT_IN), 1024, AB_IN, AB_IN_PAD, smem);
        rmsnorm_rows(p.x, p.norm_mix, Hb))
    PHASE(1, phase_gemm_in8(p, smem_phys))
    PHASE(2, gla_prep(p, smem))
    PHASE(3, gla_scan(p, smem); sb_fast(p, smem_phys + 98304, sbctr);
        quantize_tables_static(p, 64);
        transpose_convert(p.ab_w_out, (bf16_t*)(p.ws + OFF_WT_OUT), 1024, 1024, 1024, smem, 64);
        transpose_convert(p.c_w_in, (bf16_t*)(p.ws + OFF_WT_CIN), 1024, 4096, 4096, smem, 64);
        transpose_convert(p.c_w_out, (bf16_t*)(p.ws + OFF_WT_COUT), 2048, 1024, 1024, smem, 64);
        fold_query_weights(p, 64))
    PHASE(4, phase_gemm_resid8(Rg + R_QSB, Rg + R_GG, 512, 512, (const bf16_t*)(p.ws + OFF_WT_OUT), 1024, p.x, p.out, Hb, (float*)(p.ws + OFF_SSQ), p.norm_ffn, smem_phys))
    PHASE(5, phase_select8(p, 0, smem_phys))
    PHASE(6, peer_gather(p, 0, p.norm_mix + 1024, false, smem_phys))
    PHASE(7, phase_gemm_cin8(p, smem_phys))
    PHASE(8, spatial_fast(p, smem))
    PHASE(9, phase_gemm_resid8(Rg, Rg, 2048, 2048, (const bf16_t*)(p.ws + OFF_WT_COUT), 2048, p.out, p.out, Hb, (float*)(p.ws + OFF_SSQ), p.norm_ffn + 1024, smem_phys))
    PHASE(10, phase_select8(p, 1, smem_phys))
    PHASE(11, peer_gather(p, 1, p.final_norm, true, smem_phys))
}

extern "C" void kernel_launch(void* const* d_in, const int* in_sizes, int n_in, void* d_out, int out_size, void* d_ws, size_t ws_size, hipStream_t stream) {
    static int grid_blocks = 0;
    if (!grid_blocks) {
        int dev = 0, cus = 0, per_cu = 0;
        hipGetDevice(&dev);
        hipDeviceGetAttribute(&cus, hipDeviceAttributeMultiprocessorCount, dev);
        hipFuncSetAttribute((const void*)mega, hipFuncAttributeMaxDynamicSharedMemorySize, kDynLds);
        hipOccupancyMaxActiveBlocksPerMultiprocessor(&per_cu, mega, 512, kDynLds);
        if (per_cu < 1) per_cu = 1;
        if (per_cu > 1) per_cu = 1;
        grid_blocks = cus * per_cu;
        if (n_in != 18 || ws_size < WS_END) fprintf(stderr, "kernel_launch: unexpected n_in %d or ws_size %zu < %zu\n", n_in, ws_size, (size_t)WS_END);
    }
    Params p{};
    p.x = (const float*)d_in[0]; p.norm_mix = (const float*)d_in[1]; p.norm_ffn = (const float*)d_in[2]; p.ab_w_in = (const float*)d_in[3];
    p.ab_w_alpha2 = (const float*)d_in[4]; p.ab_b_alpha2 = (const float*)d_in[5]; p.ab_gla_norm = (const float*)d_in[6]; p.ab_w_out = (const float*)d_in[7];
    p.c_w_in = (const float*)d_in[8]; p.c_v_norm = (const float*)d_in[9]; p.c_w_spatial = (const float*)d_in[10]; p.c_b_spatial = (const float*)d_in[11];
    p.c_w_out = (const float*)d_in[12]; p.peer_w_q = (const float*)d_in[13]; p.peer_subkeys = (const float*)d_in[14]; p.peer_u = (const float*)d_in[15];
    p.peer_v = (const float*)d_in[16]; p.final_norm = (const float*)d_in[17];
    p.out = (float*)d_out; p.ws = (unsigned char*)d_ws;
    (void)hipMemsetAsync((char*)d_ws + OFF_BAR, 0, 16384, stream);
#if ONE_LAUNCH
    int lo = 0, hi = NPHASE;
    void* args[] = {&p, &lo, &hi};
    hipError_t e = hipLaunchCooperativeKernel((void*)mega, dim3(grid_blocks), dim3(512), args, kDynLds, stream);
    if (e != hipSuccess) fprintf(stderr, "cooperative launch failed: %s (grid %d)\n", hipGetErrorString(e), grid_blocks);
#else
    for (int ph = 0; ph < NPHASE; ++ph) hipLaunchKernelGGL(mega, dim3(grid_blocks), dim3(512), kDynLds, stream, p, ph, ph + 1);
#endif
}
```

```cpp
#include <hip/hip_runtime.h>
#include <hip/hip_cooperative_groups.h>
#include <cstdio>
#include <cstdint>
namespace cg = cooperative_groups;

#ifndef ONE_LAUNCH
#define ONE_LAUNCH 1
#endif


#define VTID ((int)(threadIdx.x & 255))
#define VBID ((int)(blockIdx.x * 2 + (threadIdx.x >> 8)))
#define VGRID ((int)(gridDim.x * 2))
typedef unsigned short bf16_t;
typedef short bf16x8 __attribute__((ext_vector_type(8)));
typedef float f32x4 __attribute__((ext_vector_type(4)));
typedef unsigned u32x4 __attribute__((ext_vector_type(4)));
typedef __bf16 bf16x2_t __attribute__((ext_vector_type(2)));

constexpr int T = 32768, D = 1024, SEQ = 2048, NB = 16;
constexpr int AB_IN = 3088, AB_IN_PAD = 3200;
constexpr float EPS = 1e-6f;
constexpr int NEXP = 16384;
constexpr int kDynLds = 163840;

constexpr size_t SZ_WT_IN = (size_t)AB_IN_PAD * 1024 * 2;
constexpr size_t SZ_WT_OUT = (size_t)1024 * 1024 * 2;
constexpr size_t SZ_WT_CIN = (size_t)4096 * 1024 * 2;
constexpr size_t SZ_WT_COUT = (size_t)1024 * 2048 * 2;
constexpr size_t SZ_WT_Q = (size_t)2 * 2048 * 1024 * 2;
constexpr size_t SZ_SK = (size_t)2 * 8 * 2 * 128 * 128 * 2;
constexpr size_t SZ_TAB = (size_t)2 * NEXP * 1024;
constexpr size_t SZ_TSC = (size_t)2 * NEXP * 4;
constexpr size_t OFF_WT_IN = 0;
constexpr size_t OFF_WT_OUT = OFF_WT_IN + SZ_WT_IN;
constexpr size_t OFF_WT_CIN = OFF_WT_OUT + SZ_WT_OUT;
constexpr size_t OFF_WT_COUT = OFF_WT_CIN + SZ_WT_CIN;
constexpr size_t OFF_WT_Q = OFF_WT_COUT + SZ_WT_COUT;
constexpr size_t OFF_SK = OFF_WT_Q + SZ_WT_Q;
constexpr size_t OFF_UT = OFF_SK + SZ_SK;
constexpr size_t OFF_VT = OFF_UT + SZ_TAB;
constexpr size_t OFF_USC = OFF_VT + SZ_TAB;
constexpr size_t OFF_VSC = OFF_USC + SZ_TSC;
constexpr size_t OFF_H = OFF_VSC + SZ_TSC;
constexpr size_t OFF_IDX = OFF_H + (size_t)T * 1024 * 2;
constexpr size_t OFF_GATE = OFF_IDX + (size_t)T * 128 * 4;
constexpr size_t OFF_SSQ = OFF_GATE + (size_t)T * 128 * 4;
constexpr size_t OFF_REGION = OFF_SSQ + (size_t)T * 32 * 4;
constexpr size_t SZ_REGION = (size_t)256 << 20;
constexpr size_t OFF_BAR = OFF_REGION + SZ_REGION;
constexpr size_t WS_END = OFF_BAR + 16384;
constexpr size_t R_QSB = 0;
constexpr size_t R_KSB = R_QSB + (size_t)T * 512;
constexpr size_t R_VTSB = R_KSB + (size_t)T * 512;
constexpr size_t R_QG = R_VTSB + (size_t)T * 512;
constexpr size_t R_KG = R_QG + (size_t)T * 256;
constexpr size_t R_VTG = R_KG + (size_t)T * 256;
constexpr size_t R_GG = R_VTG + (size_t)T * 512;
constexpr size_t R_ALR = R_GG + (size_t)T * 512;
constexpr size_t R_KOT = R_ALR + (size_t)T * 32;
constexpr size_t R_DEC = R_KOT + (size_t)T * 256;

struct Params {
    const float* x; const float* norm_mix; const float* norm_ffn; const float* ab_w_in; const float* ab_w_alpha2; const float* ab_b_alpha2;
    const float* ab_gla_norm; const float* ab_w_out; const float* c_w_in; const float* c_v_norm; const float* c_w_spatial; const float* c_b_spatial;
    const float* c_w_out; const float* peer_w_q; const float* peer_subkeys; const float* peer_u; const float* peer_v; const float* final_norm;
    float* out; unsigned char* ws;
};

__device__ __forceinline__ float bf2f(bf16_t v) { return __uint_as_float(((unsigned)v) << 16); }
__device__ __forceinline__ bf16_t f2bf(float f) { unsigned r; asm("v_cvt_pk_bf16_f32 %0, %1, %1" : "=v"(r) : "v"(f)); return (bf16_t)r; }
__device__ __forceinline__ unsigned pack2(float lo, float hi) { unsigned r; asm("v_cvt_pk_bf16_f32 %0, %1, %2" : "=v"(r) : "v"(lo), "v"(hi)); return r; }
__device__ __forceinline__ float lo2f(unsigned w) { return __uint_as_float(w << 16); }
__device__ __forceinline__ float hi2f(unsigned w) { return __uint_as_float(w & 0xffff0000u); }
__device__ __forceinline__ float dot2(unsigned a, unsigned b, float acc) { return __builtin_amdgcn_fdot2_f32_bf16(__builtin_bit_cast(bf16x2_t, a), __builtin_bit_cast(bf16x2_t, b), acc, false); }
#define GELU_C0 -1.0001451969146729f
#define GELU_C1 -1.1498452425003052f
#define GELU_C2 -0.46162763237953186f
#define GELU_C3 -0.051034148782491684f
#define GELU_C4 0.007168652955442667f
#define GELU_C5 -0.0006095620337873697f
#define GELU_C6 2.30170971917687e-05f
__device__ __forceinline__ float gelu_exact(float v) {
    const float a = fminf(fabsf(v), 6.0f);
    float q = GELU_C6 * a + GELU_C5; q = q * a + GELU_C4; q = q * a + GELU_C3; q = q * a + GELU_C2; q = q * a + GELU_C1; q = q * a + GELU_C0;
    return fmaxf(v, 0.f) - fabsf(v) * __builtin_amdgcn_exp2f(q);
}
typedef float f32x2 __attribute__((ext_vector_type(2)));
__device__ __forceinline__ f32x2 gelu_exact2(f32x2 v) {
    const f32x2 av = __builtin_elementwise_abs(v), a = __builtin_elementwise_min(av, (f32x2){6.0f, 6.0f});
    f32x2 q = (f32x2){GELU_C6, GELU_C6} * a + (f32x2){GELU_C5, GELU_C5};
    q = q * a + (f32x2){GELU_C4, GELU_C4}; q = q * a + (f32x2){GELU_C3, GELU_C3}; q = q * a + (f32x2){GELU_C2, GELU_C2};
    q = q * a + (f32x2){GELU_C1, GELU_C1}; q = q * a + (f32x2){GELU_C0, GELU_C0};
    const f32x2 e = {__builtin_amdgcn_exp2f(q[0]), __builtin_amdgcn_exp2f(q[1])};
    return __builtin_elementwise_max(v, (f32x2){0.f, 0.f}) - av * e;
}
__device__ __forceinline__ float row16_sum(float v) {
    v += __builtin_bit_cast(float, __builtin_amdgcn_update_dpp(0, __builtin_bit_cast(int, v), 0x128, 0xf, 0xf, false));
    v += __builtin_bit_cast(float, __builtin_amdgcn_update_dpp(0, __builtin_bit_cast(int, v), 0x124, 0xf, 0xf, false));
    v += __builtin_bit_cast(float, __builtin_amdgcn_update_dpp(0, __builtin_bit_cast(int, v), 0x122, 0xf, 0xf, false));
    v += __builtin_bit_cast(float, __builtin_amdgcn_update_dpp(0, __builtin_bit_cast(int, v), 0x121, 0xf, 0xf, false));
    return v;
}
__device__ __forceinline__ float wave_sum(float v) {
#pragma unroll
    for (int o = 32; o >= 1; o >>= 1) v += __shfl_xor(v, o);
    return v;
}

template <bool PERM_IN = false>
__device__ __forceinline__ void transpose_convert(const float* __restrict__ W, bf16_t* __restrict__ Wt, int K, int N, int Npad, char* smem, int vb0 = 0) {
    float* tile = (float*)smem;
    const int tk = K / 64, tn = Npad / 64, ntile = tk * tn;
    const int tid = VTID;
    if (VBID < vb0) return;
    for (int tl = VBID - vb0; tl < ntile; tl += VGRID - vb0) {
        const int k0 = (tl % tk) * 64, n0 = (tl / tk) * 64;
        const int c = tid & 63, r0 = tid >> 6;
        int nd = n0;
        if (PERM_IN) { if (n0 >= 1024 && n0 < 1536) nd = n0 + 1024; else if (n0 >= 1536 && n0 < 2048) nd = n0 - 512; else if (n0 >= 2048 && n0 < 2560) nd = n0 + 512; else if (n0 >= 2560 && n0 < 3072) nd = n0 - 1024; }
#pragma unroll
        for (int i = 0; i < 16; ++i) {
            const int r = r0 + 4 * i;
            const float v = (n0 + c < N) ? W[(size_t)(k0 + r) * N + n0 + c] : 0.f;
            tile[c * 65 + r] = v;
        }
        __syncthreads();
#pragma unroll
        for (int i = 0; i < 16; ++i) {
            const int n = r0 + 4 * i;
            Wt[(size_t)(nd + n) * K + k0 + c] = f2bf(tile[n * 65 + c]);
        }
        __syncthreads();
    }
}
__device__ __forceinline__ void convert_flat(const float* __restrict__ src, bf16_t* __restrict__ dst, size_t n) {
    const size_t nv = n / 8;
    for (size_t i = (size_t)VBID * 256 + VTID; i < nv; i += (size_t)VGRID * 256) {
        const float4 a = ((const float4*)src)[2 * i], b = ((const float4*)src)[2 * i + 1];
        uint4 o; o.x = pack2(a.x, a.y); o.y = pack2(a.z, a.w); o.z = pack2(b.x, b.y); o.w = pack2(b.z, b.w);
        ((uint4*)dst)[i] = o;
    }
}
__device__ __forceinline__ void quantize_tables_static(const Params& p, int vb0 = 0) {
    const int lane = VTID & 63, wid = VTID >> 6;
    if (VBID < vb0) return;
    for (unsigned task = (unsigned)(VBID - vb0); task < 512u; task += (unsigned)(VGRID - vb0)) {
        const bool isv = task >= 256u;
        const int r0 = (int)(task & 255u) * 128 + wid * 32;
        const float* src = isv ? p.peer_v : p.peer_u;
        unsigned char* recs = p.ws + OFF_UT;
        _Float16* sct = (_Float16*)(p.ws + OFF_USC);
        for (int rr = 0; rr < 32; ++rr) {
            const int r = r0 + rr;
            const float* xr = src + (size_t)r * 1024 + lane * 16;
            f32x4 v[4]; float aml = 0.f;
#pragma unroll
            for (int i = 0; i < 4; ++i) {
                v[i] = *(const f32x4*)(xr + i * 4);
                aml = fmaxf(aml, fmaxf(fmaxf(fabsf(v[i][0]), fabsf(v[i][1])), fmaxf(fabsf(v[i][2]), fabsf(v[i][3]))));
            }
#pragma unroll
            for (int o = 32; o >= 1; o >>= 1) aml = fmaxf(aml, __shfl_xor(aml, o));
            float ssq = 0.f;
#pragma unroll
            for (int i = 0; i < 4; ++i) ssq += (v[i][0] * v[i][0] + v[i][1] * v[i][1]) + (v[i][2] * v[i][2] + v[i][3] * v[i][3]);
            ssq = wave_sum(ssq);
            const float gmax = aml * (1.002f / 7.5f);
            const _Float16 hs = (_Float16)fminf(fmaxf(0.34f * sqrtf(ssq * (1.0f / 1024.0f)), 0.5f * gmax), gmax);
            const float gs_ = (float)hs, gi_ = gs_ > 0.f ? 1.0f / gs_ : 0.f;
            unsigned wd[2]; const int sgn = isv ? 0 : 8;
#pragma unroll
            for (int dd = 0; dd < 2; ++dd) {
                unsigned wv = 0;
#pragma unroll
                for (int b = 0; b < 4; ++b) {
                    const int qa = min(15, max(0, __float2int_rn(v[2 * dd][b] * gi_ + 7.5f)));
                    const int qb = min(15, max(0, __float2int_rn(v[2 * dd + 1][b] * gi_ + 7.5f)));
                    wv |= ((unsigned)(qa ^ sgn) | ((unsigned)(qb ^ sgn) << 4)) << (8 * b);
                }
                wd[dd] = wv;
            }
            unsigned char* rec = recs + (size_t)r * 1024;
            *(uint2*)(rec + (isv ? 512 : 0) + lane * 8) = make_uint2(wd[0], wd[1]);
            if (lane == 0) sct[(size_t)r * 2 + (isv ? 1 : 0)] = (_Float16)gs_;
        }
    }
}
__device__ __forceinline__ void rmsnorm_rows(const float* __restrict__ X, const float* __restrict__ g, bf16_t* __restrict__ Hout) {
    const int lane = VTID & 63, wid = VTID >> 6;
    const int gw = VBID * 4 + wid, nw = VGRID * 4;
    for (int t = gw; t < T; t += nw) {
        const float* xr = X + (size_t)t * D;
        float4 v[4]; float ss = 0.f;
#pragma unroll
        for (int i = 0; i < 4; ++i) { v[i] = *(const float4*)(xr + i * 256 + lane * 4); ss += v[i].x * v[i].x + v[i].y * v[i].y + v[i].z * v[i].z + v[i].w * v[i].w; }
        ss = wave_sum(ss);
        const float rstd = rsqrtf(ss * (1.0f / D) + EPS);
#pragma unroll
        for (int i = 0; i < 4; ++i) {
            const float4 gg = *(const float4*)(g + i * 256 + lane * 4);
            uint2 o; o.x = pack2(v[i].x * rstd * gg.x, v[i].y * rstd * gg.y); o.y = pack2(v[i].z * rstd * gg.z, v[i].w * rstd * gg.w);
            *(uint2*)(Hout + (size_t)t * D + i * 256 + lane * 4) = o;
        }
    }
}

template <int MODE>
__device__ __forceinline__ void gemm_mainloop(const bf16_t* __restrict__ A0, const bf16_t* __restrict__ A1, int lda, int ksplit,
                                              const bf16_t* __restrict__ Bt, int K, int m0, int n0, f32x4 (&acc)[4][4], char* smem) {
    const int tid = VTID, lane = tid & 63, wid = tid >> 6, wm = wid >> 1, wn = wid & 1;
    const int lrow = tid >> 3, lch = tid & 7;
#pragma unroll
    for (int i = 0; i < 4; ++i)
#pragma unroll
        for (int j = 0; j < 4; ++j) acc[i][j] = (f32x4){0.f, 0.f, 0.f, 0.f};
    const int nk = K / 64;
    unsigned aoff[4], boff[4];
    {
        const int rr = lane >> 3, cc = ((lane & 7) ^ rr) * 8;
#pragma unroll
        for (int i = 0; i < 4; ++i) {
            aoff[i] = (unsigned)(((m0 + 32 * wid + 8 * i + rr) * lda + cc) * 2);
            boff[i] = (unsigned)(((n0 + 32 * wid + 8 * i + rr) * K + cc) * 2);
        }
    }
    auto stage = [&](int kt, int buf) {
        const int kb = kt * 64;
        const char* Ab; const char* Bb = (const char*)(Bt + kb);
        if (kb < ksplit) Ab = (const char*)(A0 + kb); else Ab = (const char*)(A1 + (kb - ksplit));
        char* sa = smem + buf * 32768 + wid * 4096 + lane * 16; char* sb = sa + 16384;
#pragma unroll
        for (int i = 0; i < 4; ++i) __builtin_amdgcn_global_load_lds((const unsigned*)(Ab + aoff[i]), (unsigned*)(sa + i * 1024), 16, 0, 0);
#pragma unroll
        for (int i = 0; i < 4; ++i) __builtin_amdgcn_global_load_lds((const unsigned*)(Bb + boff[i]), (unsigned*)(sb + i * 1024), 16, 0, 0);
    };
    auto compute = [&](int buf) {
        const char* sa = smem + buf * 32768; const char* sb = sa + 16384;
#pragma unroll
        for (int ks = 0; ks < 2; ++ks) {
            bf16x8 af[4], bfr[4];
            const int ch = ks * 4 + (lane >> 4);
#pragma unroll
            for (int i = 0; i < 4; ++i) { const int row = wm * 64 + i * 16 + (lane & 15); af[i] = *(const bf16x8*)(sa + row * 128 + ((ch ^ (row & 7)) << 4)); }
#pragma unroll
            for (int j = 0; j < 4; ++j) { const int row = wn * 64 + j * 16 + (lane & 15); bfr[j] = *(const bf16x8*)(sb + row * 128 + ((ch ^ (row & 7)) << 4)); }
            __builtin_amdgcn_s_setprio(1);
#pragma unroll
            for (int i = 0; i < 4; ++i)
#pragma unroll
                for (int j = 0; j < 4; ++j) {
                    if (MODE == 0) acc[i][j] = __builtin_amdgcn_mfma_f32_16x16x32_bf16(bfr[j], af[i], acc[i][j], 0, 0, 0);
                    else acc[i][j] = __builtin_amdgcn_mfma_f32_16x16x32_bf16(af[i], bfr[j], acc[i][j], 0, 0, 0);
                }
            __builtin_amdgcn_s_setprio(0);
        }
    };
    stage(0, 0);
    asm volatile("s_waitcnt vmcnt(0)" ::: "memory");
    __syncthreads();
    for (int kt = 0; kt < nk; ++kt) {
        if (kt + 1 < nk) stage(kt + 1, (kt + 1) & 1);
        compute(kt & 1);
        asm volatile("s_waitcnt vmcnt(0)" ::: "memory");
        __syncthreads();
    }
}
template <int MODE>
__device__ __forceinline__ void gemm_mainloop256(const bf16_t* __restrict__ A0, const bf16_t* __restrict__ A1, int lda, int ksplit,
                                                 const bf16_t* __restrict__ Bt, int K, int m0, int n0, f32x4 (&acc)[8][4], char* smem) {
    const int tid = VTID, lane = tid & 63, wid = tid >> 6, wm = wid >> 1, wn = wid & 1;
#pragma unroll
    for (int i = 0; i < 8; ++i)
#pragma unroll
        for (int j = 0; j < 4; ++j) acc[i][j] = (f32x4){0.f, 0.f, 0.f, 0.f};
    const int nk = K / 32;
    unsigned aoff[4], boff[2];
    {
        const int rr = lane >> 2, cc = ((lane & 3) ^ (3 * ((lane >> 5) & 1))) * 8;
#pragma unroll
        for (int i = 0; i < 4; ++i) aoff[i] = (unsigned)(((m0 + 64 * wid + 16 * i + rr) * lda + cc) * 2);
#pragma unroll
        for (int i = 0; i < 2; ++i) boff[i] = (unsigned)(((n0 + 32 * wid + 16 * i + rr) * K + cc) * 2);
    }
    auto stage = [&](int kt, int buf) {
        const int kb = kt * 32;
        const char* Ab; const char* Bb = (const char*)(Bt + kb);
        if (kb < ksplit) Ab = (const char*)(A0 + kb); else Ab = (const char*)(A1 + (kb - ksplit));
        char* sa = smem + buf * 24576 + wid * 4096 + lane * 16; char* sb = smem + buf * 24576 + 16384 + wid * 2048 + lane * 16;
#pragma unroll
        for (int i = 0; i < 4; ++i) __builtin_amdgcn_global_load_lds((const unsigned*)(Ab + aoff[i]), (unsigned*)(sa + i * 1024), 16, 0, 0);
#pragma unroll
        for (int i = 0; i < 2; ++i) __builtin_amdgcn_global_load_lds((const unsigned*)(Bb + boff[i]), (unsigned*)(sb + i * 1024), 16, 0, 0);
    };
    const int fpos = (((lane >> 4) ^ (3 * ((lane >> 3) & 1))) << 4) + (lane & 15) * 64;
    auto compute = [&](int buf) {
        const char* sa = smem + buf * 24576 + wm * 8192 + fpos; const char* sb = smem + buf * 24576 + 16384 + wn * 4096 + fpos;
        bf16x8 af[8], bfr[4];
#pragma unroll
        for (int i = 0; i < 8; ++i) af[i] = *(const bf16x8*)(sa + i * 1024);
#pragma unroll
        for (int j = 0; j < 4; ++j) bfr[j] = *(const bf16x8*)(sb + j * 1024);
        __builtin_amdgcn_s_setprio(1);
#pragma unroll
        for (int i = 0; i < 8; ++i)
#pragma unroll
            for (int j = 0; j < 4; ++j) {
                if (MODE == 0) acc[i][j] = __builtin_amdgcn_mfma_f32_16x16x32_bf16(bfr[j], af[i], acc[i][j], 0, 0, 0);
                else acc[i][j] = __builtin_amdgcn_mfma_f32_16x16x32_bf16(af[i], bfr[j], acc[i][j], 0, 0, 0);
            }
        __builtin_amdgcn_s_setprio(0);
    };
    stage(0, 0);
    asm volatile("s_waitcnt vmcnt(0)" ::: "memory");
    __syncthreads();
    for (int kt = 0; kt < nk; ++kt) {
        if (kt + 1 < nk) stage(kt + 1, (kt + 1) & 1);
        compute(kt & 1);
        asm volatile("s_waitcnt vmcnt(0)" ::: "memory");
        __syncthreads();
    }
}
__device__ __forceinline__ bool tile_sched(int it, int MT, int NT, int& mt, int& nt) {
    const int xg = blockIdx.x & 7, xi = (int)(blockIdx.x >> 3) * 2 + (int)(threadIdx.x >> 8), nper = (int)(gridDim.x >> 3) * 2;
    const int li = xi + nper * it;
    if (li >= (MT >> 3) * NT) return false;
    const int band = li / (8 * NT), r = li - band * 8 * NT;
    nt = r >> 3; mt = xg * (MT >> 3) + band * 8 + (r & 7);
    return true;
}
__device__ __forceinline__ void store_bf16x4(bf16_t* p, f32x4 v) { uint2 o; o.x = pack2(v[0], v[1]); o.y = pack2(v[2], v[3]); *(uint2*)p = o; }

#define G8_LAS __attribute__((address_space(3)))
namespace g8 {
constexpr int BM = 256, BK = 64, HALF = 128, HTB = HALF * BK * 2, NXCD = 8, WGM = 8;
__device__ __forceinline__ int lds_byte(int r, int c) { const int st = (r >> 4) * 2 + (c >> 5), rr = r & 15, cc = c & 31, ob = rr * 64 + cc * 2; return st * 1024 + (ob ^ (((ob >> 9) & 1) << 5)); }
__device__ __forceinline__ void stage_rc(int b, int& R, int& C) { const int st = b / 1024, sb = b % 1024, swz = sb ^ (((sb >> 9) & 1) << 5); R = (st >> 1) * 16 + swz / 64; C = (st & 1) * 32 + (swz % 64) / 2; }
__device__ __forceinline__ int perm32(int rho) { const int n = rho >> 4, i = rho & 15; return 8 * (i >> 2) + 4 * n + (i & 3); }
struct Unit { int pm, pn; };
struct Gemm { const bf16_t* A0; const bf16_t* A1; int lda, ksplit; const bf16_t* Bt; int M, N, K; };
struct StaticOrder {
    int nM, nN, nwg, G, c;
    __device__ __forceinline__ void init(int M, int N, int G_, int c_) { nM = M / BM; nN = N / BM; nwg = nM * nN; G = G_; c = c_; }
    __device__ __forceinline__ bool next(int i, Unit& u) const {
        const int L = i * G + c; if (L >= nwg) return false;
        int wgid = L; { const int q = nwg / NXCD, r = nwg % NXCD, xcd = wgid % NXCD, off = wgid / NXCD; wgid = (xcd < r ? xcd * (q + 1) : r * (q + 1) + (xcd - r) * q) + off; }
        const int nig = WGM * nN, gid = wgid / nig, fm = gid * WGM, gsz = (nM - fm) < WGM ? (nM - fm) : WGM;
        u.pm = fm + ((wgid % nig) % gsz); u.pn = (wgid % nig) / gsz; return true;
    }
};
template <class Epi>
__device__ __forceinline__ void gemm_phase(G8_LAS unsigned char* lds, const Gemm g, const StaticOrder& S, const Epi& E) {
    const int tid = threadIdx.x, wid = __builtin_amdgcn_readfirstlane(tid >> 6), lane = tid & 63, wr = wid >> 2, wc = wid & 3, fr = lane & 15, fq = lane >> 4;
    const int K = g.K, nt = K / BK, lda = g.lda;
    unsigned voffA[2], voffB[2];
#pragma unroll
    for (int i = 0; i < 2; ++i) { int R, C; stage_rc(tid * 16 + i * 8192, R, C); const int Rb = (R & ~31) + perm32(R & 31);
        voffA[i] = (unsigned)(R * lda + C) * 2u; voffB[i] = (unsigned)(Rb * K + C) * 2u; }
    const size_t hstepA = (size_t)HALF * lda * 2, hstepB = (size_t)HALF * K * 2;
    const unsigned ldsw = (unsigned)wid * 1024u;
    const int aoff = lds_byte(wr * 64 + fr, fq * 8), boff = lds_byte(wc * 32 + fr, fq * 8);
    auto aptr = [&](int pm, int kt) -> const char* { const int kb = kt * BK; const bf16_t* b = kb < g.ksplit ? g.A0 + kb : g.A1 + (kb - g.ksplit); return (const char*)b + (size_t)pm * 2 * hstepA; };
    auto bptr = [&](int pn, int kt) -> const char* { return (const char*)(g.Bt + kt * BK) + (size_t)pn * 2 * hstepB; };
#define G8_SA(b, h) (((b) * 2 + (h)) * HTB)
#define G8_SB(b, h) ((4 + (b) * 2 + (h)) * HTB)
#define G8_STAGE(bufoff, gbase, voff) do { _Pragma("unroll") for (int _i = 0; _i < 2; ++_i) \
        __builtin_amdgcn_global_load_lds((const unsigned*)((const char*)(gbase) + (voff)[_i]), (G8_LAS unsigned*)(lds + (bufoff) + ldsw + _i * 8192), 16, 0, 0); } while (0)
#define G8_LDA(dst, b, h) do { _Pragma("unroll") for (int m = 0; m < 4; ++m) _Pragma("unroll") for (int k = 0; k < 2; ++k) dst[m][k] = *(const G8_LAS bf16x8*)(lds + G8_SA(b, h) + aoff + m * 2048 + k * 1024); } while (0)
#define G8_LDB(dst, b, h) do { _Pragma("unroll") for (int n = 0; n < 2; ++n) _Pragma("unroll") for (int k = 0; k < 2; ++k) dst[n][k] = *(const G8_LAS bf16x8*)(lds + G8_SB(b, h) + boff + n * 2048 + k * 1024); } while (0)
#define G8_MMA(ai, bj, At, Bt) do { __builtin_amdgcn_s_setprio(1); _Pragma("unroll") for (int m = 0; m < 4; ++m) _Pragma("unroll") for (int n = 0; n < 2; ++n) _Pragma("unroll") for (int k = 0; k < 2; ++k) \
        acc[ai][bj][m][n] = __builtin_amdgcn_mfma_f32_16x16x32_bf16(Bt[n][k], At[m][k], acc[ai][bj][m][n], 0, 0, 0); __builtin_amdgcn_s_setprio(0); } while (0)
#define G8_WAIT_V(n) asm volatile("s_waitcnt vmcnt(" #n ")" ::: "memory")
#define G8_WAIT_L(n) asm volatile("s_waitcnt lgkmcnt(" #n ")" ::: "memory")
#define G8_BAR __builtin_amdgcn_s_barrier()
#define G8_SCHED __builtin_amdgcn_sched_barrier(0)
    Unit cur, nxt; int ui = 0;
    if (!S.next(0, cur)) return;
    f32x4 acc[2][2][4][2];
#pragma unroll
    for (int a = 0; a < 2; ++a)
#pragma unroll
        for (int b = 0; b < 2; ++b)
#pragma unroll
            for (int m = 0; m < 4; ++m)
#pragma unroll
                for (int n = 0; n < 2; ++n) acc[a][b][m][n] = (f32x4){0.f, 0.f, 0.f, 0.f};
    bf16x8 At[4][2], B0[2][2], B1[2][2];
    {
        const char* cA = aptr(cur.pm, 0); const char* cB = bptr(cur.pn, 0); const char* cA1 = aptr(cur.pm, 1); const char* cB1 = bptr(cur.pn, 1);
        G8_STAGE(G8_SB(0, 0), cB, voffB); G8_STAGE(G8_SB(0, 1), cB + hstepB, voffB); G8_STAGE(G8_SA(0, 0), cA, voffA); G8_STAGE(G8_SA(0, 1), cA + hstepA, voffA);
        if (wr == 1) G8_BAR;
        G8_WAIT_V(2); G8_BAR;
        G8_STAGE(G8_SB(1, 0), cB1, voffB); G8_STAGE(G8_SA(1, 0), cA1, voffA); G8_STAGE(G8_SB(1, 1), cB1 + hstepB, voffB);
        G8_WAIT_V(6); G8_BAR;
    }
    for (;;) {
        const bool has_next = S.next(ui + 1, nxt);
        const int npm = has_next ? nxt.pm : cur.pm, npn = has_next ? nxt.pn : cur.pn;
        for (int t = 0; t < nt; t += 2) {
            const bool last = (t == nt - 2);
            const char* a1 = aptr(cur.pm, t + 1);
            const char* a2 = last ? aptr(npm, 0) : aptr(cur.pm, t + 2); const char* b2 = last ? bptr(npn, 0) : bptr(cur.pn, t + 2);
            const char* a3 = last ? aptr(npm, 1) : aptr(cur.pm, t + 3); const char* b3 = last ? bptr(npn, 1) : bptr(cur.pn, t + 3);
            G8_LDB(B0, 0, 0); G8_LDB(B1, 0, 1); G8_SCHED; G8_LDA(At, 0, 0); G8_STAGE(G8_SA(1, 1), a1 + hstepA, voffA);
            G8_WAIT_V(8); G8_WAIT_L(0); G8_BAR; G8_MMA(0, 0, At, B0); G8_MMA(0, 1, At, B1); G8_BAR; G8_SCHED;
            G8_LDA(At, 0, 1); G8_STAGE(G8_SB(0, 0), b2, voffB); G8_STAGE(G8_SB(0, 1), b2 + hstepB, voffB); G8_STAGE(G8_SA(0, 0), a2, voffA);
            G8_WAIT_V(8); G8_WAIT_L(0); G8_BAR; G8_MMA(1, 0, At, B0); G8_MMA(1, 1, At, B1); G8_BAR; G8_SCHED;
            G8_LDB(B0, 1, 0); G8_LDB(B1, 1, 1); G8_SCHED; G8_LDA(At, 1, 0); G8_STAGE(G8_SA(0, 1), a2 + hstepA, voffA);
            G8_WAIT_V(8); G8_WAIT_L(0); G8_BAR; G8_MMA(0, 0, At, B0); G8_MMA(0, 1, At, B1); G8_BAR; G8_SCHED;
            G8_LDA(At, 1, 1); G8_STAGE(G8_SB(1, 0), b3, voffB); G8_STAGE(G8_SB(1, 1), b3 + hstepB, voffB); G8_STAGE(G8_SA(1, 0), a3, voffA);
            G8_WAIT_V(8); G8_WAIT_L(0); G8_BAR; G8_MMA(1, 0, At, B0); G8_MMA(1, 1, At, B1); G8_BAR; G8_SCHED;
        }
        if (wr == 0) G8_BAR;
        E(acc, cur, wr, wc, fr, fq);
        if (!has_next) break;
#pragma unroll
        for (int a = 0; a < 2; ++a)
#pragma unroll
            for (int b = 0; b < 2; ++b)
#pragma unroll
                for (int m = 0; m < 4; ++m)
#pragma unroll
                    for (int n = 0; n < 2; ++n) acc[a][b][m][n] = (f32x4){0.f, 0.f, 0.f, 0.f};
        cur = nxt; ++ui;
        if (wr == 1) G8_BAR;
    }
    G8_WAIT_V(0);
    G8_BAR;
#undef G8_SA
#undef G8_SB
#undef G8_STAGE
#undef G8_LDA
#undef G8_LDB
#undef G8_MMA
#undef G8_WAIT_V
#undef G8_WAIT_L
#undef G8_BAR
#undef G8_SCHED
}
struct EpiResid {
    const float* Rs; float* O; bf16_t* XB; float* SSQP; const float* gain;
    __device__ __forceinline__ void operator()(const f32x4 (&acc)[2][2][4][2], const Unit& u, int wr, int wc, int fr, int fq) const {
        f32x4 gn[2][2];
#pragma unroll
        for (int bj = 0; bj < 2; ++bj) { gn[bj][0] = *(const f32x4*)(gain + u.pn * 256 + bj * 128 + wc * 32 + fq * 8); gn[bj][1] = *(const f32x4*)(gain + u.pn * 256 + bj * 128 + wc * 32 + fq * 8 + 4); }
#pragma unroll
        for (int ai = 0; ai < 2; ++ai)
#pragma unroll
            for (int m = 0; m < 4; ++m) {
                const int row = u.pm * 256 + ai * 128 + wr * 64 + m * 16 + fr;
                const size_t o = (size_t)row * 1024 + u.pn * 256 + wc * 32 + fq * 8;
                float ss = 0.f;
#pragma unroll
                for (int bj = 0; bj < 2; ++bj) {
                    const f32x4 a = *(const f32x4*)(Rs + o + bj * 128) + acc[ai][bj][m][0], b = *(const f32x4*)(Rs + o + bj * 128 + 4) + acc[ai][bj][m][1];
                    *(f32x4*)(O + o + bj * 128) = a; *(f32x4*)(O + o + bj * 128 + 4) = b;
                    ss += a[0] * a[0] + a[1] * a[1] + a[2] * a[2] + a[3] * a[3] + b[0] * b[0] + b[1] * b[1] + b[2] * b[2] + b[3] * b[3];
                    const f32x4 ag = a * gn[bj][0], bg = b * gn[bj][1];
                    uint4 w; w.x = pack2(ag[0], ag[1]); w.y = pack2(ag[2], ag[3]); w.z = pack2(bg[0], bg[1]); w.w = pack2(bg[2], bg[3]);
                    *(uint4*)(XB + o + bj * 128) = w;
                }
                ss += __shfl_xor(ss, 16); ss += __shfl_xor(ss, 32);
                if (fq == 0) SSQP[(size_t)row * 32 + u.pn * 4 + wc] = ss;
            }
    }
};
struct EpiCinU {
    bf16_t* U;
    __device__ __forceinline__ void operator()(const f32x4 (&acc)[2][2][4][2], const Unit& u, int wr, int wc, int fr, int fq) const {
#pragma unroll
        for (int ai = 0; ai < 2; ++ai)
#pragma unroll
            for (int m = 0; m < 4; ++m) {
                bf16_t* rp = U + (size_t)(u.pm * 256 + ai * 128 + wr * 64 + m * 16 + fr) * 2048 + u.pn * 256 + wc * 32 + fq * 8;
#pragma unroll
                for (int bj = 0; bj < 2; ++bj) {
                    const f32x4 a = acc[ai][bj][m][0], b = acc[ai][bj][m][1];
                    const f32x2 g0 = gelu_exact2((f32x2){a[0], a[1]}), g1 = gelu_exact2((f32x2){a[2], a[3]}), g2 = gelu_exact2((f32x2){b[0], b[1]}), g3 = gelu_exact2((f32x2){b[2], b[3]});
                    uint4 o; o.x = pack2(g0[0], g0[1]); o.y = pack2(g1[0], g1[1]); o.z = pack2(g2[0], g2[1]); o.w = pack2(g3[0], g3[1]);
                    *(uint4*)(rp + bj * 128) = o;
                }
            }
    }
};
struct EpiCinUS {
    bf16_t* U; const bf16_t* VT; const float* SSQ; const float* Wsp; const float* bsp; const float* vnorm; G8_LAS unsigned char* L;
    __device__ __forceinline__ void operator()(const f32x4 (&acc)[2][2][4][2], const Unit& u, int wr, int wc, int fr, int fq) const {
        const int tid = threadIdx.x, g = u.pn;
        G8_LAS float* RS = (G8_LAS float*)(L + 24576);
        unsigned gu[2][2][4][4];
#pragma unroll
        for (int ai = 0; ai < 2; ++ai)
#pragma unroll
            for (int bj = 0; bj < 2; ++bj)
#pragma unroll
                for (int m = 0; m < 4; ++m) {
                    const f32x4 a = acc[ai][bj][m][0], b = acc[ai][bj][m][1];
                    const f32x2 g0 = gelu_exact2((f32x2){a[0], a[1]}), g1 = gelu_exact2((f32x2){a[2], a[3]}), g2 = gelu_exact2((f32x2){b[0], b[1]}), g3 = gelu_exact2((f32x2){b[2], b[3]});
                    gu[ai][bj][m][0] = pack2(g0[0], g0[1]); gu[ai][bj][m][1] = pack2(g1[0], g1[1]); gu[ai][bj][m][2] = pack2(g2[0], g2[1]); gu[ai][bj][m][3] = pack2(g3[0], g3[1]);
                }
        if (tid < 256) {
            const float* sp = SSQ + (size_t)(u.pm * 256 + tid) * 32;
            f32x4 s4 = *(const f32x4*)sp;
#pragma unroll
            for (int i = 1; i < 8; ++i) s4 += *(const f32x4*)(sp + 4 * i);
            RS[tid] = rsqrtf(((s4[0] + s4[1]) + (s4[2] + s4[3])) * (1.0f / 2048.0f) + EPS);
        }
        __syncthreads();
#pragma unroll
        for (int ai = 0; ai < 2; ++ai) {
            const int chunk = u.pm * 2 + ai;
            {
                const int t1 = tid >> 3, c1 = tid & 7;
#pragma unroll
                for (int part = 0; part < 3; ++part) {
                    const int t = part == 0 ? t1 : 64 + ((tid + (part - 1) * 512) >> 4), ch = part == 0 ? c1 : ((tid + (part - 1) * 512) & 15), s0 = ch * 8;
                    const float* wp = Wsp + (size_t)(g * 128 + t) * 128 + s0;
                    const f32x4 w0 = *(const f32x4*)wp, w1 = *(const f32x4*)(wp + 4);
                    const f32x4 r0 = *(const G8_LAS f32x4*)(RS + ai * 128 + s0), r1 = *(const G8_LAS f32x4*)(RS + ai * 128 + s0 + 4);
                    float v[8];
#pragma unroll
                    for (int j = 0; j < 4; ++j) { v[j] = (s0 + j <= t) ? w0[j] * r0[j] : 0.f; v[4 + j] = (s0 + 4 + j <= t) ? w1[j] * r1[j] : 0.f; }
                    u32x4 o; o.x = pack2(v[0], v[1]); o.y = pack2(v[2], v[3]); o.z = pack2(v[4], v[5]); o.w = pack2(v[6], v[7]);
                    const int off = part == 0 ? t * 128 + ((ch ^ (t & 7)) << 4) : 8192 + (t - 64) * 256 + ((ch ^ (t & 7)) << 4);
                    *(G8_LAS u32x4*)(L + off) = o;
                }
            }
            __syncthreads();
            float bias[4];
#pragma unroll
            for (int m = 0; m < 4; ++m) bias[m] = bsp[g * 128 + wr * 64 + m * 16 + fr];
#pragma unroll
            for (int bj = 0; bj < 2; ++bj) {
                f32x4 mac[4][2];
#pragma unroll
                for (int m = 0; m < 4; ++m)
#pragma unroll
                    for (int n = 0; n < 2; ++n) mac[m][n] = (f32x4){0.f, 0.f, 0.f, 0.f};
                const int cb = u.pn * 256 + bj * 128 + wc * 32;
                const bf16_t* vrow0 = VT + ((size_t)chunk * 2048 + cb + perm32(fr)) * 128 + fq * 8;
                const bf16_t* vrow1 = VT + ((size_t)chunk * 2048 + cb + perm32(16 + fr)) * 128 + fq * 8;
                bf16x8 bf0[4], bf1[4];
#pragma unroll
                for (int kk = 0; kk < 4; ++kk) { if (kk < 2 || wr == 1) { bf0[kk] = *(const bf16x8*)(vrow0 + kk * 32); bf1[kk] = *(const bf16x8*)(vrow1 + kk * 32); } }
#pragma unroll
                for (int kk = 0; kk < 4; ++kk) {
                    if (kk < 2 || wr == 1) {
                        bf16x8 af[4];
#pragma unroll
                        for (int m = 0; m < 4; ++m) {
                            const int t = wr * 64 + m * 16 + fr, chn = kk * 4 + fq;
                            const int off = wr == 0 ? t * 128 + ((chn ^ (t & 7)) << 4) : 8192 + (t - 64) * 256 + ((chn ^ (t & 7)) << 4);
                            af[m] = *(const G8_LAS bf16x8*)(L + off);
                        }
#pragma unroll
                        for (int m = 0; m < 4; ++m) {
                            mac[m][0] = __builtin_amdgcn_mfma_f32_16x16x32_bf16(bf0[kk], af[m], mac[m][0], 0, 0, 0);
                            mac[m][1] = __builtin_amdgcn_mfma_f32_16x16x32_bf16(bf1[kk], af[m], mac[m][1], 0, 0, 0);
                        }
                    }
                }
                const f32x4 vn0 = *(const f32x4*)(vnorm + cb + fq * 8), vn1 = *(const f32x4*)(vnorm + cb + fq * 8 + 4);
#pragma unroll
                for (int m = 0; m < 4; ++m) {
                    const f32x4 x0 = vn0 * mac[m][0] + bias[m], x1 = vn1 * mac[m][1] + bias[m];
                    const unsigned q0 = gu[ai][bj][m][0], q1 = gu[ai][bj][m][1], q2 = gu[ai][bj][m][2], q3 = gu[ai][bj][m][3];
                    uint4 o; o.x = pack2(lo2f(q0) * x0[0], hi2f(q0) * x0[1]); o.y = pack2(lo2f(q1) * x0[2], hi2f(q1) * x0[3]); o.z = pack2(lo2f(q2) * x1[0], hi2f(q2) * x1[1]); o.w = pack2(lo2f(q3) * x1[2], hi2f(q3) * x1[3]);
                    *(uint4*)(U + (size_t)(u.pm * 256 + ai * 128 + wr * 64 + m * 16 + fr) * 2048 + cb + fq * 8) = o;
                }
            }
            __syncthreads();
        }
    }
};
struct EpiCinV {
    bf16_t* VT; float* SSQ;
    __device__ __forceinline__ void operator()(const f32x4 (&acc)[2][2][4][2], const Unit& u, int wr, int wc, int fr, int fq) const {
#pragma unroll
        for (int ai = 0; ai < 2; ++ai) {
            float ss[16];
#pragma unroll
            for (int i = 0; i < 16; ++i) ss[i] = 0.f;
#pragma unroll
            for (int m = 0; m < 4; ++m) {
                const int c = u.pm * 256 + ai * 128 + wr * 64 + m * 16 + fr;
#pragma unroll
                for (int bj = 0; bj < 2; ++bj) {
                    float g[8];
#pragma unroll
                    for (int n = 0; n < 2; ++n)
#pragma unroll
                        for (int r = 0; r < 4; r += 2) {
                            const f32x2 x = gelu_exact2((f32x2){acc[ai][bj][m][n][r], acc[ai][bj][m][n][r + 1]});
                            g[n * 4 + r] = x[0]; g[n * 4 + r + 1] = x[1]; ss[bj * 8 + n * 4 + r] += x[0] * x[0]; ss[bj * 8 + n * 4 + r + 1] += x[1] * x[1];
                        }
                    uint4 o; o.x = pack2(g[0], g[1]); o.y = pack2(g[2], g[3]); o.z = pack2(g[4], g[5]); o.w = pack2(g[6], g[7]);
                    *(uint4*)(VT + ((size_t)(u.pn * 2 + bj) * 2048 + c) * 128 + wc * 32 + fq * 8) = o;
                }
            }
            float mine = 0.f;
#pragma unroll
            for (int i = 0; i < 16; ++i) { const float s = row16_sum(ss[i]); mine = (fr == i) ? s : mine; }
            const int tok = u.pn * 256 + (fr >> 3) * 128 + wc * 32 + fq * 8 + (fr & 7);
            SSQ[(size_t)tok * 32 + u.pm * 4 + ai * 2 + wr] = mine;
        }
    }
};
struct EpiInN {
    bf16_t* R;
    __device__ __forceinline__ void operator()(const f32x4 (&acc)[2][2][4][2], const Unit& u, int wr, int wc, int fr, int fq) const {
        bf16_t* base; int pitch; float sc = 1.0f;
        if (u.pn < 2) { base = R + R_QSB + u.pn * 256; pitch = 512; sc = 0.125f; }
        else if (u.pn < 4) { base = R + R_KSB + (u.pn - 2) * 256; pitch = 512; }
        else if (u.pn == 4) { base = R + R_QG; pitch = 256; }
        else if (u.pn == 5) { base = R + R_KG; pitch = 256; }
        else { base = R + R_GG + (u.pn - 6) * 256; pitch = 512; }
#pragma unroll
        for (int ai = 0; ai < 2; ++ai)
#pragma unroll
            for (int m = 0; m < 4; ++m) {
                bf16_t* rp = base + (size_t)(u.pm * 256 + ai * 128 + wr * 64 + m * 16 + fr) * pitch + wc * 32 + fq * 8;
#pragma unroll
                for (int bj = 0; bj < 2; ++bj) {
                    const f32x4 a = acc[ai][bj][m][0] * sc, b = acc[ai][bj][m][1] * sc;
                    uint4 o; o.x = pack2(a[0], a[1]); o.y = pack2(a[2], a[3]); o.z = pack2(b[0], b[1]); o.w = pack2(b[2], b[3]);
                    *(uint4*)(rp + bj * 128) = o;
                }
            }
    }
};
struct EpiInT {
    bf16_t* R;
    __device__ __forceinline__ void operator()(const f32x4 (&acc)[2][2][4][2], const Unit& u, int wr, int wc, int fr, int fq) const {
#pragma unroll
        for (int ai = 0; ai < 2; ++ai)
#pragma unroll
            for (int m = 0; m < 4; ++m) {
                const int c = u.pm * 256 + ai * 128 + wr * 64 + m * 16 + fr;
#pragma unroll
                for (int bj = 0; bj < 2; ++bj) {
                    const int t = u.pn * 256 + bj * 128 + wc * 32 + fq * 8, b = t >> 11, s = t & 2047;
                    bf16_t* dst;
                    if (c < 512) dst = R + R_VTSB + ((size_t)((b * 8 + (c >> 6)) * 64 + (c & 63))) * 2048 + s;
                    else { const int c2 = c - 512; dst = R + R_VTG + ((size_t)((b * 4 + (c2 >> 7)) * 128 + (c2 & 127))) * 2048 + s; }
                    const f32x4 a = acc[ai][bj][m][0], bb = acc[ai][bj][m][1];
                    uint4 o; o.x = pack2(a[0], a[1]); o.y = pack2(a[2], a[3]); o.z = pack2(bb[0], bb[1]); o.w = pack2(bb[2], bb[3]);
                    *(uint4*)dst = o;
                }
            }
    }
};
}
__device__ __forceinline__ void phase_gemm_resid8(const bf16_t* A0, const bf16_t* A1, int lda, int ksplit, const bf16_t* Bt, int K, const float* Rs, float* O, bf16_t* XB, float* SSQP, const float* gain, char* smem_phys) {
    g8::Gemm g{A0, A1, lda, ksplit, Bt, T, 1024, K};
    g8::StaticOrder S; S.init(T, 1024, (int)gridDim.x, (int)blockIdx.x);
    g8::EpiResid E{Rs, O, XB, SSQP, gain};
    g8::gemm_phase<g8::EpiResid>((G8_LAS unsigned char*)smem_phys, g, S, E);
}

__device__ __forceinline__ void phase_gemm_cin8_v(const Params& p, char* smem_phys) {
    const bf16_t* H = (const bf16_t*)(p.ws + OFF_H); const bf16_t* W = (const bf16_t*)(p.ws + OFF_WT_CIN);
    bf16_t* U = (bf16_t*)(p.ws + OFF_REGION); bf16_t* VT = U + (size_t)T * 2048; float* SSQ = (float*)(p.ws + OFF_SSQ);
    const bf16_t* Wv = W + (size_t)2048 * 1024;
    g8::Gemm g{Wv, Wv, 1024, 1024, H, 2048, T, 1024};
    g8::StaticOrder S; S.init(2048, T, (int)gridDim.x, (int)blockIdx.x);
    g8::EpiCinV E{VT, SSQ};
    g8::gemm_phase<g8::EpiCinV>((G8_LAS unsigned char*)smem_phys, g, S, E);
}
__device__ __forceinline__ void phase_gemm_cin8_u(const Params& p, char* smem_phys) {
    const bf16_t* H = (const bf16_t*)(p.ws + OFF_H); const bf16_t* W = (const bf16_t*)(p.ws + OFF_WT_CIN);
    bf16_t* U = (bf16_t*)(p.ws + OFF_REGION); bf16_t* VT = U + (size_t)T * 2048; float* SSQ = (float*)(p.ws + OFF_SSQ);
    g8::Gemm g{H, H, 1024, 1024, W, T, 2048, 1024};
    g8::StaticOrder S; S.init(T, 2048, (int)gridDim.x, (int)blockIdx.x);
    g8::EpiCinUS E{U, VT, SSQ, p.c_w_spatial, p.c_b_spatial, p.c_v_norm, (G8_LAS unsigned char*)(smem_phys + 131072)};
    g8::gemm_phase<g8::EpiCinUS>((G8_LAS unsigned char*)smem_phys, g, S, E);
}
__device__ __forceinline__ void phase_gemm_in8(const Params& p, char* smem_phys) {
    const bf16_t* H = (const bf16_t*)(p.ws + OFF_H); const bf16_t* W = (const bf16_t*)(p.ws + OFF_WT_IN);
    bf16_t* R = (bf16_t*)(p.ws + OFF_REGION);
    {
        g8::Gemm g{H, H, 1024, 1024, W, T, 2048, 1024};
        g8::StaticOrder S; S.init(T, 2048, (int)gridDim.x, (int)blockIdx.x);
        g8::EpiInN E{R};
        g8::gemm_phase<g8::EpiInN>((G8_LAS unsigned char*)smem_phys, g, S, E);
    }
    {
        const bf16_t* Wv = W + (size_t)2048 * 1024;
        g8::Gemm g{Wv, Wv, 1024, 1024, H, 1024, T, 1024};
        g8::StaticOrder S; S.init(1024, T, (int)gridDim.x, (int)blockIdx.x);
        g8::EpiInT E{R};
        g8::gemm_phase<g8::EpiInT>((G8_LAS unsigned char*)smem_phys, g, S, E);
    }
    {
        const int lane = threadIdx.x & 63, wid = threadIdx.x >> 6, fr = lane & 15, fq = lane >> 4;
        float* ALR = (float*)(R + R_ALR);
        for (int task = (int)blockIdx.x * 8 + wid; task < T / 16; task += (int)gridDim.x * 8) {
            const bf16_t* a = H + (size_t)(task * 16 + fr) * 1024 + fq * 8; const bf16_t* w = W + (size_t)(3072 + fr) * 1024 + fq * 8;
            f32x4 acc = (f32x4){0.f, 0.f, 0.f, 0.f};
#pragma unroll 8
            for (int kk = 0; kk < 32; ++kk) {
                const bf16x8 af = *(const bf16x8*)(a + kk * 32), wf = *(const bf16x8*)(w + kk * 32);
                acc = __builtin_amdgcn_mfma_f32_16x16x32_bf16(wf, af, acc, 0, 0, 0);
            }
            *(f32x4*)(ALR + (size_t)(task * 16 + fr) * 16 + fq * 4) = acc;
        }
    }
}

__device__ __forceinline__ void phase_gemm_in(const Params& p, char* smem) {
    const bf16_t* A = (const bf16_t*)(p.ws + OFF_H); const bf16_t* Bt = (const bf16_t*)(p.ws + OFF_WT_IN);
    bf16_t* R = (bf16_t*)(p.ws + OFF_REGION);
    const int lane = VTID & 63, wid = VTID >> 6, wm = wid >> 1, wn = wid & 1;
    constexpr int NT = AB_IN_PAD / 128, MT = T / 128;
    int mt_, nt_;
    for (int it = 0; tile_sched(it, MT, NT, mt_, nt_); ++it) {
        const int m0 = mt_ * 128, n0 = nt_ * 128;
        f32x4 acc[4][4];
        const bool tr = (n0 >= 1024 && n0 < 1536) || (n0 >= 2048 && n0 < 2560);
        if (!tr) {
            gemm_mainloop<0>(A, A, 1024, 1024, Bt, 1024, m0, n0, acc, smem);
#pragma unroll
            for (int i = 0; i < 4; ++i)
#pragma unroll
                for (int j = 0; j < 4; ++j) {
                    const int m = m0 + wm * 64 + i * 16 + (lane & 15), n = n0 + wn * 64 + j * 16 + 4 * (lane >> 4);
                    const f32x4 v = acc[i][j];
                    if (n < 512) store_bf16x4(R + R_QSB + (size_t)m * 512 + n, v * 0.125f);
                    else if (n < 1024) store_bf16x4(R + R_KSB + (size_t)m * 512 + (n - 512), v);
                    else if (n < 1792) store_bf16x4(R + R_QG + (size_t)m * 256 + (n - 1536), v);
                    else if (n < 2048) store_bf16x4(R + R_KG + (size_t)m * 256 + (n - 1792), v);
                    else if (n < 3072) store_bf16x4(R + R_GG + (size_t)m * 512 + (n - 2560), v);
                    else if (n < AB_IN) *(f32x4*)((float*)(R + R_ALR) + (size_t)m * 16 + (n - 3072)) = v;
                }
        } else {
            gemm_mainloop<1>(A, A, 1024, 1024, Bt, 1024, m0, n0, acc, smem);
#pragma unroll
            for (int i = 0; i < 4; ++i)
#pragma unroll
                for (int j = 0; j < 4; ++j) {
                    const int m = m0 + wm * 64 + i * 16 + 4 * (lane >> 4), n = n0 + wn * 64 + j * 16 + (lane & 15);
                    const int b = m >> 11, s = m & 2047;
                    if (n < 1536) { const int c = n - 1024, hh = c >> 6, e = c & 63; store_bf16x4(R + R_VTSB + ((size_t)((b * 8 + hh) * 64 + e)) * 2048 + s, acc[i][j]); }
                    else { const int c = n - 2048, hh = c >> 7, e = c & 127; store_bf16x4(R + R_VTG + ((size_t)((b * 4 + hh) * 128 + e)) * 2048 + s, acc[i][j]); }
                }
        }
    }
}
__device__ __forceinline__ void phase_gemm_resid(const bf16_t* A0, const bf16_t* A1, int lda, int ksplit, const bf16_t* Bt, int K, const float* Rs, float* O, char* smem) {
    const int lane = VTID & 63, wid = VTID >> 6, wm = wid >> 1, wn = wid & 1;
    constexpr int NT = 8, MT = T / 256;
    int mt_, nt_;
    for (int it = 0; tile_sched(it, MT, NT, mt_, nt_); ++it) {
        const int m0 = mt_ * 256, n0 = nt_ * 128;
        f32x4 acc[8][4];
        gemm_mainloop256<0>(A0, A1, lda, ksplit, Bt, K, m0, n0, acc, smem);
#pragma unroll
        for (int i = 0; i < 8; ++i)
#pragma unroll
            for (int j = 0; j < 4; ++j) {
                const int m = m0 + wm * 128 + i * 16 + (lane & 15), n = n0 + wn * 64 + j * 16 + 4 * (lane >> 4);
                const f32x4 r = *(const f32x4*)(Rs + (size_t)m * 1024 + n);
                *(f32x4*)(O + (size_t)m * 1024 + n) = r + acc[i][j];
            }
    }
}
__device__ __forceinline__ void phase_gemm_cin(const Params& p, char* smem) {
    const bf16_t* A = (const bf16_t*)(p.ws + OFF_H); const bf16_t* Bt = (const bf16_t*)(p.ws + OFF_WT_CIN);
    bf16_t* U = (bf16_t*)(p.ws + OFF_REGION); bf16_t* VT = U + (size_t)T * 2048; float* SSQ = (float*)(p.ws + OFF_SSQ);
    const int lane = VTID & 63, wid = VTID >> 6, wm = wid >> 1, wn = wid & 1;
    constexpr int NT = 32, MT = T / 128;
    int mt_, nt_;
    for (int it = 0; tile_sched(it, MT, NT, mt_, nt_); ++it) {
        const int m0 = mt_ * 128, n0 = nt_ * 128;
        f32x4 acc[4][4];
        if (n0 < 2048) {
            gemm_mainloop<0>(A, A, 1024, 1024, Bt, 1024, m0, n0, acc, smem);
#pragma unroll
            for (int i = 0; i < 4; ++i)
#pragma unroll
                for (int j = 0; j < 4; ++j) {
                    const int m = m0 + wm * 64 + i * 16 + (lane & 15), n = n0 + wn * 64 + j * 16 + 4 * (lane >> 4);
                    f32x4 v = acc[i][j];
#pragma unroll
                    for (int r = 0; r < 4; ++r) v[r] = gelu_exact(v[r]);
                    store_bf16x4(U + (size_t)m * 2048 + n, v);
                }
        } else {
            gemm_mainloop<1>(A, A, 1024, 1024, Bt, 1024, m0, n0, acc, smem);
#pragma unroll
            for (int i = 0; i < 4; ++i) {
                float ss[4] = {0.f, 0.f, 0.f, 0.f};
#pragma unroll
                for (int j = 0; j < 4; ++j) {
                    const int m = m0 + wm * 64 + i * 16 + 4 * (lane >> 4), n = n0 + wn * 64 + j * 16 + (lane & 15);
                    f32x4 v = acc[i][j];
#pragma unroll
                    for (int r = 0; r < 4; ++r) { v[r] = gelu_exact(v[r]); ss[r] += v[r] * v[r]; }
                    const int chunk = m >> 7, s = m & 127, c = n - 2048;
                    store_bf16x4(VT + ((size_t)chunk * 2048 + c) * 128 + s, v);
                }
#pragma unroll
                for (int r = 0; r < 4; ++r) {
                    float v = ss[r];
                    v += __shfl_xor(v, 1); v += __shfl_xor(v, 2); v += __shfl_xor(v, 4); v += __shfl_xor(v, 8);
                    if ((lane & 15) == 0) { const int m = m0 + wm * 64 + i * 16 + 4 * (lane >> 4) + r; SSQ[(size_t)m * 32 + ((n0 - 2048) >> 6) + wn] = v; }
                }
            }
        }
    }
}

typedef float f32x16 __attribute__((ext_vector_type(16)));
__device__ __forceinline__ void sb_fast(const Params& p, char* smem, unsigned* ctr) {
    bf16_t* R = (bf16_t*)(p.ws + OFF_REGION);
    char* KT = smem; char* VTt = smem + 8192;
    volatile int* flags = (volatile int*)(smem + 32768); volatile unsigned* slot = (volatile unsigned*)(smem + 32832);
    const int tid = threadIdx.x, lane = tid & 63, w = tid >> 6, r31 = lane & 31, h = lane >> 5;
    for (;;) {
        __syncthreads();
        if (tid == 0) *slot = atomicAdd(ctr, 1u);
        __syncthreads();
        const unsigned task = *slot;
        if (task >= 1024u) break;
        const int qblk = 7 - (int)(task >> 7), bh = task & 127, b = bh >> 3, hh = bh & 7;
        const int q0 = qblk * 256, qbase = q0 + 32 * w;
        bf16_t* qrow = R + R_QSB + (size_t)(b * 2048 + qbase + r31) * 512 + hh * 64;
        bf16x8 qf[4];
#pragma unroll
        for (int kk = 0; kk < 4; ++kk) qf[kk] = *(const bf16x8*)(qrow + 16 * kk + 8 * h);
        f32x16 oacc[2];
#pragma unroll
        for (int nt = 0; nt < 2; ++nt)
#pragma unroll
            for (int i = 0; i < 16; ++i) oacc[nt][i] = 0.f;
        float Rr = 1.0f;
        const int t = qbase + r31;
        for (int kt = q0 / 64 + 3; kt >= 0; --kt) {
            __syncthreads();
            { const int wd = __all(Rr == 0.f); if (lane == 0) flags[w] = wd; }
            __syncthreads();
            if (flags[0] & flags[1] & flags[2] & flags[3] & flags[4] & flags[5] & flags[6] & flags[7]) break;
            const int s_tile = kt * 64;
            {
                const int c = tid, row = c >> 3, ch = c & 7;
                const u32x4 kv = *(const u32x4*)(R + R_KSB + (size_t)(b * 2048 + s_tile + row) * 512 + hh * 64 + ch * 8);
                const u32x4 vv = *(const u32x4*)(R + R_VTSB + ((size_t)((b * 8 + hh) * 64 + row)) * 2048 + s_tile + ch * 8);
                *(u32x4*)(KT + row * 128 + ((ch ^ (row & 7)) << 4)) = kv;
                *(uint2*)(VTt + row * 136 + ch * 16) = make_uint2(vv[0], vv[1]);
                *(uint2*)(VTt + row * 136 + ch * 16 + 8) = make_uint2(vv[2], vv[3]);
            }
            __syncthreads();
#pragma unroll
            for (int sbk = 1; sbk >= 0; --sbk) {
                const int key_lo = s_tile + 32 * sbk;
                if (key_lo >= qbase + 31) continue;
                if (__all(Rr == 0.f)) continue;
                f32x16 st;
#pragma unroll
                for (int i = 0; i < 16; ++i) st[i] = 0.f;
                const int krow = 32 * sbk + r31;
#pragma unroll
                for (int kk = 0; kk < 4; ++kk) {
                    const bf16x8 kf = *(const bf16x8*)(KT + krow * 128 + (((2 * kk + h) ^ (krow & 7)) << 4));
                    st = __builtin_amdgcn_mfma_f32_32x32x16_bf16(kf, qf[kk], st, 0, 0, 0);
                }
                float a[16], G[4];
                const bool diag = key_lo + 31 >= qbase;
#pragma unroll
                for (int g = 0; g < 4; ++g) {
                    float sg[4], m[4];
#pragma unroll
                    for (int i = 0; i < 4; ++i) {
                        const float z = fmaxf(st[4 * g + i], -80.f);
                        const float ez = __builtin_amdgcn_exp2f(z * -1.4426950409f), sig = __builtin_amdgcn_rcpf(1.0f + ez);
                        sg[i] = sig; m[i] = ez * sig;
                    }
                    if (diag) {
#pragma unroll
                        for (int i = 0; i < 4; ++i) { const bool valid = key_lo + 8 * g + 4 * h + i < t; sg[i] = valid ? sg[i] : 0.f; m[i] = valid ? m[i] : 1.0f; }
                    }
                    const float x2 = m[3], x1 = x2 * m[2], x0 = x1 * m[1];
                    G[g] = x0 * m[0];
                    a[4 * g + 3] = sg[3]; a[4 * g + 2] = sg[2] * x2; a[4 * g + 1] = sg[1] * x1; a[4 * g] = sg[0] * x0;
                }
                float Go[4], P[4];
#pragma unroll
                for (int g = 0; g < 4; ++g) { Go[g] = __shfl_xor(G[g], 32); P[g] = G[g] * Go[g]; }
                const float c2 = P[3], c1 = c2 * P[2], c0 = c1 * P[1];
                float Tg[4];
                Tg[3] = Rr; Tg[2] = Rr * c2; Tg[1] = Rr * c1; Tg[0] = Rr * c0;
#pragma unroll
                for (int g = 0; g < 4; ++g) {
                    const float tg = (h == 0) ? Tg[g] * Go[g] : Tg[g];
                    a[4 * g] *= tg; a[4 * g + 1] *= tg; a[4 * g + 2] *= tg; a[4 * g + 3] *= tg;
                }
                Rr = Rr * c0 * P[0];
#pragma unroll
                for (int s2 = 0; s2 < 2; ++s2) {
                    union { bf16x8 v; unsigned u[4]; } af;
#pragma unroll
                    for (int j2 = 0; j2 < 4; ++j2) af.u[j2] = pack2(a[8 * s2 + 2 * j2], a[8 * s2 + 2 * j2 + 1]);
#pragma unroll
                    for (int nt = 0; nt < 2; ++nt) {
                        const char* vp = VTt + (32 * nt + r31) * 136 + 64 * sbk + 32 * s2 + 8 * h;
                        union { bf16x8 v; uint2 hh2[2]; } vf;
                        vf.hh2[0] = *(const uint2*)vp; vf.hh2[1] = *(const uint2*)(vp + 16);
                        oacc[nt] = __builtin_amdgcn_mfma_f32_32x32x16_bf16(af.v, vf.v, oacc[nt], 0, 0, 0);
                    }
                }
            }
        }
#pragma unroll
        for (int nt = 0; nt < 2; ++nt)
#pragma unroll
            for (int i = 0; i < 16; ++i) {
                const int qq = (i & 3) + 8 * (i >> 2) + 4 * h;
                R[R_QSB + (size_t)(b * 2048 + qbase + qq) * 512 + hh * 64 + 32 * nt + r31] = f2bf(oacc[nt][i]);
            }
    }
}
__device__ __forceinline__ float log_sigmoid(float x) { return fminf(x, 0.f) - log1pf(__expf(-fabsf(x))); }
__device__ __forceinline__ int swz(int row, int chunk) { return row * 128 + ((chunk ^ (row & 7)) << 4); }
__device__ __forceinline__ void gla_prep(const Params& p, char* smem) {
    bf16_t* R = (bf16_t*)(p.ws + OFF_REGION);
    const float* ALR = (const float*)(R + R_ALR);
    bf16_t* KOTg = R + R_KOT; float* DECg = (float*)(R + R_DEC);
    float* SEG = (float*)smem; float* ALRs = SEG + 256;
    const int tid = VTID, d = tid & 63, w = tid >> 6;
    for (int task = VBID; task < 2048; task += VGRID) {
        const int bh = task >> 5, c = task & 31, b = bh >> 2, hh = bh & 3;
        const size_t rowbase = (size_t)b * 2048 + c * 64;
        unsigned qr[16], kr[16];
#pragma unroll
        for (int i = 0; i < 16; ++i) { const size_t row = rowbase + w * 16 + i; qr[i] = R[R_QG + row * 256 + hh * 64 + d]; kr[i] = R[R_KG + row * 256 + hh * 64 + d]; }
        const f32x4 ar = *(const f32x4*)(ALR + rowbase * 16 + tid * 4);
        float w2r[16];
#pragma unroll
        for (int r = 0; r < 16; ++r) w2r[r] = p.ab_w_alpha2[r * 256 + hh * 64 + d];
        const float b2r = p.ab_b_alpha2[hh * 64 + d];
        __syncthreads();
        *(f32x4*)(ALRs + tid * 4) = ar;
        __syncthreads();
        float cs[16]; float run = 0.f;
#pragma unroll
        for (int i = 0; i < 16; ++i) {
            const float* al = ALRs + (w * 16 + i) * 16;
            float pre = b2r;
#pragma unroll
            for (int r = 0; r < 16; ++r) pre += al[r] * w2r[r];
            run += log_sigmoid(pre) * (1.0f / 16.0f);
            cs[i] = run;
        }
        SEG[w * 64 + d] = run;
        __syncthreads();
        float off = 0.f, tot = 0.f;
#pragma unroll
        for (int w2 = 0; w2 < 4; ++w2) { const float s = SEG[w2 * 64 + d]; tot += s; if (w2 < w) off += s; }
        unsigned kop[8];
#pragma unroll
        for (int i2 = 0; i2 < 8; ++i2) {
            float kov[2];
#pragma unroll
            for (int u = 0; u < 2; ++u) {
                const int i = 2 * i2 + u;
                const float bc = off + cs[i];
                const float kv = bf2f((bf16_t)kr[i]);
                const size_t row = rowbase + w * 16 + i;
                R[R_QG + row * 256 + hh * 64 + d] = f2bf(bf2f((bf16_t)qr[i]) * 0.125f * __expf(bc));
                R[R_KG + row * 256 + hh * 64 + d] = f2bf(kv * __expf(-bc));
                kov[u] = kv * __expf(tot - bc);
            }
            kop[i2] = pack2(kov[0], kov[1]);
        }
        bf16_t* kp = KOTg + ((size_t)task * 64 + d) * 64 + w * 16;
        *(uint4*)kp = make_uint4(kop[0], kop[1], kop[2], kop[3]);
        *(uint4*)(kp + 8) = make_uint4(kop[4], kop[5], kop[6], kop[7]);
        if (w == 0) DECg[(size_t)task * 64 + d] = __expf(tot);
    }
}
__device__ __forceinline__ void gla_scan(const Params& p, char* smem, bool dry = false) {
    bf16_t* R = (bf16_t*)(p.ws + OFF_REGION);
    const bf16_t* KOTg = R + R_KOT; const float* DECg = (const float*)(R + R_DEC);
    char* QS = smem; char* KS = smem + 8192; char* KOT = smem + 16384; char* VTs = smem + 24576; char* SPT = smem + 40960;
    float* DEC = (float*)(smem + 57344); float* GN = DEC + 64;
    const int tid = VTID, lane = tid & 63, w = tid >> 6, l15_ = lane & 15, q4 = lane >> 4;
    for (int task = VBID; task < 64; task += VGRID) {
        const int b = task >> 2, hh = task & 3;
        f32x4 Sacc[8];
#pragma unroll
        for (int nt = 0; nt < 8; ++nt) Sacc[nt] = (f32x4){0.f, 0.f, 0.f, 0.f};
        __syncthreads();
        for (int i = tid; i < 1024; i += 256) *(uint4*)(SPT + i * 16) = make_uint4(0, 0, 0, 0);
        if (tid < 128) GN[tid] = p.ab_gla_norm[hh * 128 + tid];
        const size_t rowbase = (size_t)b * 2048;
        const bf16_t* vbase = R + R_VTG + ((size_t)((b * 4 + hh) * 128)) * 2048;
        u32x4 tq[2], tk[2], tko[2], vr[4]; float td = 0.f;
        auto prefetch = [&](int c) {
            const int t0 = c * 64;
#pragma unroll
            for (int i = 0; i < 2; ++i) {
                const int cid = tid + 256 * i, row = cid >> 3, ch = cid & 7;
                tq[i] = *(const u32x4*)(R + R_QG + (rowbase + t0 + row) * 256 + hh * 64 + ch * 8);
                tk[i] = *(const u32x4*)(R + R_KG + (rowbase + t0 + row) * 256 + hh * 64 + ch * 8);
                tko[i] = *(const u32x4*)(KOTg + (((size_t)task * 32 + c) * 64 + row) * 64 + ch * 8);
            }
#pragma unroll
            for (int i = 0; i < 4; ++i) { const int cid = tid + 256 * i, e = cid >> 3, ch = cid & 7; vr[i] = *(const u32x4*)(vbase + (size_t)e * 2048 + t0 + ch * 8); }
            if (tid < 64) td = DECg[((size_t)task * 32 + c) * 64 + tid];
        };
        prefetch(0);
        for (int c = 0; c < 32; ++c) {
            int lz = 0; asm volatile("" : "+v"(lz));
            const int l15 = l15_ + lz;
            const int cx = (q4 ^ (l15 & 7)) << 4;
            const int rb0 = l15 * 128 + cx, rb1 = l15 * 128 + (cx ^ 64);
#pragma unroll
            for (int i = 0; i < 2; ++i) {
                const int cid = tid + 256 * i + lz, row = cid >> 3, ch = cid & 7;
                *(u32x4*)(QS + swz(row, ch)) = tq[i]; *(u32x4*)(KS + swz(row, ch)) = tk[i]; *(u32x4*)(KOT + swz(row, ch)) = tko[i];
            }
#pragma unroll
            for (int i = 0; i < 4; ++i) { const int cid = tid + 256 * i + lz, e = cid >> 3, ch = cid & 7; *(u32x4*)(VTs + swz(e, ch)) = vr[i]; }
            if (tid < 64) DEC[tid] = td;
            uint2 gr[8];
            const unsigned goff = (unsigned)((rowbase + c * 64 + 16 * w + l15) * 512 + hh * 128 + 4 * q4);
            bf16_t* const gbase = R + R_GG;
#pragma unroll
            for (int nt = 0; nt < 8; ++nt) gr[nt] = *(const uint2*)(gbase + (goff + 16 * nt));
            if (c + 1 < 32) prefetch(c + 1);
            __syncthreads();
            bf16x8 qf[2];
#pragma unroll
            for (int kk = 0; kk < 2; ++kk) qf[kk] = *(const bf16x8*)(QS + w * 2048 + (kk ? rb1 : rb0));
            f32x4 sT[4];
#pragma unroll
            for (int st = 0; st < 4; ++st) {
                sT[st] = (f32x4){0.f, 0.f, 0.f, 0.f};
                if (st <= w) {
#pragma unroll
                    for (int kk = 0; kk < 2; ++kk) { const bf16x8 kf = *(const bf16x8*)(KS + st * 2048 + (kk ? rb1 : rb0)); sT[st] = __builtin_amdgcn_mfma_f32_16x16x32_bf16(kf, qf[kk], sT[st], 0, 0, 0); }
#pragma unroll
                    for (int r = 0; r < 4; ++r) if (16 * st + 4 * q4 + r > 16 * w + l15) sT[st][r] = 0.f;
                }
            }
            bf16x8 af[2];
#pragma unroll
            for (int ks2 = 0; ks2 < 2; ++ks2) {
                union { bf16x8 v; unsigned u[4]; } cv;
                cv.u[0] = pack2(sT[2 * ks2][0], sT[2 * ks2][1]); cv.u[1] = pack2(sT[2 * ks2][2], sT[2 * ks2][3]);
                cv.u[2] = pack2(sT[2 * ks2 + 1][0], sT[2 * ks2 + 1][1]); cv.u[3] = pack2(sT[2 * ks2 + 1][2], sT[2 * ks2 + 1][3]);
                af[ks2] = cv.v;
            }
            const int vb = l15 * 128 + ((((q4 >> 1) ^ (l15 & 7)) << 4) | ((q4 & 1) * 8));
            f32x4 o[8];
#pragma unroll
            for (int nt = 0; nt < 8; ++nt) {
                o[nt] = (f32x4){0.f, 0.f, 0.f, 0.f};
                const int e = 16 * nt + l15;
#pragma unroll
                for (int kk = 0; kk < 2; ++kk) { const bf16x8 sf = *(const bf16x8*)(SPT + nt * 2048 + (kk ? rb1 : rb0)); o[nt] = __builtin_amdgcn_mfma_f32_16x16x32_bf16(sf, qf[kk], o[nt], 0, 0, 0); }
#pragma unroll
                for (int ks2 = 0; ks2 < 2; ++ks2) {
                    if (2 * ks2 <= w) {
                        union { bf16x8 v; uint2 h[2]; } cv;
                        cv.h[0] = *(const uint2*)(VTs + nt * 2048 + (vb ^ (ks2 * 64)));
                        cv.h[1] = *(const uint2*)(VTs + nt * 2048 + (vb ^ (ks2 * 64) ^ 32));
                        o[nt] = __builtin_amdgcn_mfma_f32_16x16x32_bf16(cv.v, af[ks2], o[nt], 0, 0, 0);
                    }
                }
            }
            {
                const float4 dc = *(const float4*)(DEC + 16 * w + 4 * q4);
                bf16x8 kof[2];
#pragma unroll
                for (int kk = 0; kk < 2; ++kk) kof[kk] = *(const bf16x8*)(KOT + w * 2048 + (kk ? rb1 : rb0));
#pragma unroll
                for (int nt = 0; nt < 8; ++nt) {
                    Sacc[nt][0] *= dc.x; Sacc[nt][1] *= dc.y; Sacc[nt][2] *= dc.z; Sacc[nt][3] *= dc.w;
#pragma unroll
                    for (int kk = 0; kk < 2; ++kk) { const bf16x8 vf = *(const bf16x8*)(VTs + nt * 2048 + (kk ? rb1 : rb0)); Sacc[nt] = __builtin_amdgcn_mfma_f32_16x16x32_bf16(kof[kk], vf, Sacc[nt], 0, 0, 0); }
                }
            }
            __syncthreads();
#pragma unroll
            for (int nt = 0; nt < 8; ++nt) {
                const int e = 16 * nt + l15;
                uint2 pk; pk.x = pack2(Sacc[nt][0], Sacc[nt][1]); pk.y = pack2(Sacc[nt][2], Sacc[nt][3]);
                *(uint2*)(SPT + nt * 2048 + l15 * 128 + (((2 * w + (q4 >> 1)) ^ (l15 & 7)) << 4) + (q4 & 1) * 8) = pk;
            }
            float ssq = 0.f;
#pragma unroll
            for (int nt = 0; nt < 8; ++nt) ssq += (o[nt][0] * o[nt][0] + o[nt][1] * o[nt][1]) + (o[nt][2] * o[nt][2] + o[nt][3] * o[nt][3]);
            ssq += __shfl_xor(ssq, 16); ssq += __shfl_xor(ssq, 32);
            const float rsd = rsqrtf(ssq * (1.0f / 128.0f) + EPS);
#pragma unroll
            for (int nt = 0; nt < 8; ++nt) {
                asm volatile("" ::: "memory");
                const f32x4 gn = *(const f32x4*)(GN + 16 * nt + 4 * q4);
                const float g0 = lo2f(gr[nt].x), g1 = hi2f(gr[nt].x), g2 = lo2f(gr[nt].y), g3 = hi2f(gr[nt].y);
                uint2 ov;
                ov.x = pack2(o[nt][0] * rsd * gn[0] * (g0 * __builtin_amdgcn_rcpf(1.0f + __expf(-g0))), o[nt][1] * rsd * gn[1] * (g1 * __builtin_amdgcn_rcpf(1.0f + __expf(-g1))));
                ov.y = pack2(o[nt][2] * rsd * gn[2] * (g2 * __builtin_amdgcn_rcpf(1.0f + __expf(-g2))), o[nt][3] * rsd * gn[3] * (g3 * __builtin_amdgcn_rcpf(1.0f + __expf(-g3))));
                if (!dry || ov.x == 0x7fc17fc1u) *(uint2*)(gbase + (goff + 16 * nt)) = ov;
            }
        }
    }
}

__device__ __forceinline__ unsigned ord_key(float f) { const unsigned u = __float_as_uint(f); return (u & 0x80000000u) ? ~u : (u | 0x80000000u); }
__device__ __forceinline__ float unord_key(unsigned k) { return __uint_as_float((k & 0x80000000u) ? (k & 0x7fffffffu) : ~k); }
__device__ __forceinline__ void ce_desc(unsigned& a, unsigned& b) { const unsigned hi = max(a, b), lo = min(a, b); a = hi; b = lo; }
__device__ __forceinline__ void bitonic_sort16_desc(unsigned (&a)[16]) {
#pragma unroll
    for (int k = 2; k <= 16; k <<= 1)
#pragma unroll
        for (int j = k >> 1; j > 0; j >>= 1)
#pragma unroll
            for (int i = 0; i < 16; ++i) { const int l = i ^ j; if (l > i) { if ((i & k) == 0) ce_desc(a[i], a[l]); else ce_desc(a[l], a[i]); } }
}
__device__ __forceinline__ void merge_top16(unsigned (&L)[16], const unsigned (&B)[16]) {
#pragma unroll
    for (int i = 0; i < 16; ++i) L[i] = max(L[i], B[15 - i]);
#pragma unroll
    for (int j = 8; j > 0; j >>= 1)
#pragma unroll
        for (int i = 0; i < 16; ++i) { const int l = i ^ j; if (l > i) ce_desc(L[i], L[l]); }
}
__device__ constexpr int cand_i(int n) { int c = 0; for (int i = 0; i < 16; ++i) for (int j = 0; j < 16; ++j) if ((i + 1) * (j + 1) <= 16) { if (c == n) return i; ++c; } return -1; }
__device__ constexpr int cand_j(int n) { int c = 0; for (int i = 0; i < 16; ++i) for (int j = 0; j < 16; ++j) if ((i + 1) * (j + 1) <= 16) { if (c == n) return j; ++c; } return -1; }
template <int N> struct CandTab { int i[N], j[N]; constexpr CandTab() : i(), j() { for (int n = 0; n < N; ++n) { i[n] = cand_i(n); j[n] = cand_j(n); } } };
__device__ __forceinline__ void peer_select_fast(const Params& p, int layer, char* smem) {
    const bf16_t* A = (const bf16_t*)(p.ws + OFF_H);
    const bf16_t* Bt = (const bf16_t*)(p.ws + OFF_WT_Q) + (size_t)layer * 2048 * 1024;
    const bf16_t* SK = (const bf16_t*)(p.ws + OFF_SK) + (size_t)layer * 8 * 2 * 128 * 128;
    unsigned short* IDX = (unsigned short*)(p.ws + OFF_IDX); float* GATE = (float*)(p.ws + OFF_GATE);
    const int tid_ = VTID;
    float* SC = (float*)smem; unsigned* XCH = (unsigned*)smem;
    int mt_, hh;
    for (int it = 0; tile_sched(it, T / 128, 8, mt_, hh); ++it) {
        const int m0 = mt_ * 128;
        unsigned L0[16], L1[16];
#pragma unroll
        for (int pp = 0; pp < 2; ++pp) {
            f32x4 acc[4][4];
            gemm_mainloop<0>(A, A, 1024, 1024, Bt, 1024, m0, hh * 256 + pp * 128, acc, smem);
            int lz = 0; asm volatile("" : "+v"(lz));
            const int tid = tid_ + lz, lane = tid & 63, wid = tid >> 6, wm = wid >> 1, wn = wid & 1, l15 = lane & 15, q4 = lane >> 4, token = tid & 127, half = tid >> 7;
#pragma unroll
            for (int i = 0; i < 4; ++i)
#pragma unroll
                for (int j = 0; j < 4; ++j) {
                    const int row = wm * 64 + i * 16 + l15, chunk = 2 * j + (q4 >> 1);
                    uint2 o; o.x = pack2(acc[i][j][0], acc[i][j][1]); o.y = pack2(acc[i][j][2], acc[i][j][3]);
                    *(uint2*)(smem + wn * 32768 + row * 128 + ((chunk ^ (row & 7)) << 4) + (q4 & 1) * 8) = o;
                }
            const bf16_t* SKp = SK + (size_t)((hh * 2 + pp) * 128) * 128;
#pragma unroll
            for (int i = 0; i < 8; ++i) {
                const int c = tid + 256 * i, row = c >> 4, ch16 = c & 15, ks = ch16 >> 3, ch = ch16 & 7;
                *(uint4*)(smem + ks * 32768 + 16384 + row * 128 + ((ch ^ (row & 7)) << 4)) = *(const uint4*)(SKp + (size_t)row * 128 + ch16 * 8);
            }
            __syncthreads();
#pragma unroll
            for (int i = 0; i < 4; ++i)
#pragma unroll
                for (int j = 0; j < 4; ++j) acc[i][j] = (f32x4){0.f, 0.f, 0.f, 0.f};
#pragma unroll
            for (int kt = 0; kt < 2; ++kt) {
                const char* sa = smem + kt * 32768; const char* sb = sa + 16384;
#pragma unroll
                for (int ks = 0; ks < 2; ++ks) {
                    bf16x8 af[4], bfr[4];
                    const int ch = ks * 4 + q4;
#pragma unroll
                    for (int i = 0; i < 4; ++i) { const int row = wm * 64 + i * 16 + l15; af[i] = *(const bf16x8*)(sa + row * 128 + ((ch ^ (row & 7)) << 4)); }
#pragma unroll
                    for (int j = 0; j < 4; ++j) { const int row = wn * 64 + j * 16 + l15; bfr[j] = *(const bf16x8*)(sb + row * 128 + ((ch ^ (row & 7)) << 4)); }
#pragma unroll
                    for (int i = 0; i < 4; ++i)
#pragma unroll
                        for (int j = 0; j < 4; ++j) acc[i][j] = __builtin_amdgcn_mfma_f32_16x16x32_bf16(bfr[j], af[i], acc[i][j], 0, 0, 0);
                }
            }
            __syncthreads();
#pragma unroll
            for (int i = 0; i < 4; ++i)
#pragma unroll
                for (int j = 0; j < 4; ++j) {
                    const int m = wm * 64 + i * 16 + l15, n = wn * 64 + j * 16 + 4 * q4;
#pragma unroll
                    for (int r = 0; r < 4; ++r) SC[m * 128 + ((n + r) ^ (m & 31))] = acc[i][j][r];
                }
            __syncthreads();
            unsigned L[16];
            {
                const float* srow = SC + token * 128 + half * 64; const int x = token & 31;
#pragma unroll
                for (int ch = 0; ch < 4; ++ch) {
                    unsigned Cc[16];
#pragma unroll
                    for (int i = 0; i < 16; ++i) { const int c = ch * 16 + i; Cc[i] = (ord_key(srow[c ^ x]) & ~127u) | (unsigned)(127 - (half * 64 + c)); }
                    bitonic_sort16_desc(Cc);
                    if (ch == 0) {
#pragma unroll
                        for (int i = 0; i < 16; ++i) L[i] = Cc[i];
                    } else merge_top16(L, Cc);
                }
            }
            __syncthreads();
            if (half == 1) {
#pragma unroll
                for (int i = 0; i < 16; ++i) XCH[token * 17 + i] = L[i];
            }
            __syncthreads();
            if (half == 0) {
                unsigned Xc[16];
#pragma unroll
                for (int i = 0; i < 16; ++i) Xc[i] = XCH[token * 17 + i];
                merge_top16(L, Xc);
            }
#pragma unroll
            for (int i = 0; i < 16; ++i) { if (pp == 0) L0[i] = L[i]; else L1[i] = L[i]; }
            __syncthreads();
        }
        unsigned* NIDX = (unsigned*)smem;
        const int token = tid_ & 127, half = tid_ >> 7;
        if (half == 0) {
            float s0[16], s1[16];
#pragma unroll
            for (int i = 0; i < 16; ++i) { s0[i] = unord_key(L0[i] & ~127u); s1[i] = unord_key(L1[i] & ~127u); }
            constexpr CandTab<64> ct{};
            unsigned C[16];
#pragma unroll
            for (int ch = 0; ch < 4; ++ch) {
                unsigned Cc[16];
#pragma unroll
                for (int i = 0; i < 16; ++i) {
                    const int n = ch * 16 + i;
                    if (ct.i[n] >= 0) Cc[i] = (ord_key(s0[ct.i[n] < 0 ? 0 : ct.i[n]] + s1[ct.j[n] < 0 ? 0 : ct.j[n]]) & ~255u) | (unsigned)(255 - (ct.i[n] * 16 + ct.j[n]));
                    else Cc[i] = 0u;
                }
                bitonic_sort16_desc(Cc);
                if (ch == 0) {
#pragma unroll
                    for (int i = 0; i < 16; ++i) C[i] = Cc[i];
                } else merge_top16(C, Cc);
            }
#pragma unroll
            for (int i = 0; i < 16; ++i) { NIDX[token * 33 + i] = 127u - (L0[i] & 127u); NIDX[token * 33 + 16 + i] = 127u - (L1[i] & 127u); }
            const float mx = unord_key(C[0] & ~255u);
            float e[16]; float sum = 0.f;
#pragma unroll
            for (int r = 0; r < 16; ++r) { e[r] = __expf(unord_key(C[r] & ~255u) - mx); sum += e[r]; }
            const float inv = 1.0f / sum;
            const size_t ob = (size_t)(m0 + token) * 128 + hh * 16;
#pragma unroll
            for (int r = 0; r < 16; ++r) {
                const unsigned code = 255u - (C[r] & 255u);
                const unsigned e0 = NIDX[token * 33 + (code >> 4)], e1 = NIDX[token * 33 + 16 + (code & 15)];
                IDX[ob + r] = (unsigned short)(e0 * 128 + e1);
                GATE[ob + r] = e[r] * inv;
            }
        }
        __syncthreads();
    }
}

__device__ __forceinline__ bf16x8 pack8(const float4 a, const float4 b) {
    u32x4 t; t.x = pack2(a.x, a.y); t.y = pack2(a.z, a.w); t.z = pack2(b.x, b.y); t.w = pack2(b.z, b.w);
    return __builtin_bit_cast(bf16x8, t);
}
__device__ __forceinline__ void fold_query_weights(const Params& p, int vb0 = 0) {
    int lz = 0; asm volatile("" : "+v"(lz));
    const int lane = (VTID & 63) + lz, wid = VTID >> 6, fr = lane & 15, fq = lane >> 4;
    bf16_t* Wf = (bf16_t*)(p.ws + OFF_WT_Q);
    if (VBID < vb0) return;
    for (int task = VBID - vb0; task < 512; task += VGRID - vb0) {
        const int kb = task & 15, pp = (task >> 4) & 1, h = (task >> 5) & 7, layer = task >> 8;
        const float* wq = p.peer_w_q + (size_t)layer * 1024 * 2048 + (size_t)(kb * 64 + fr) * 2048 + h * 256 + pp * 128 + fq * 8;
        const float* sk = p.peer_subkeys + ((size_t)((layer * 8 + h) * 2 + pp) * 128 + wid * 32 + fr) * 128 + fq * 8;
        f32x4 acc[4][2];
#pragma unroll
        for (int kt = 0; kt < 4; ++kt)
#pragma unroll
            for (int jt = 0; jt < 2; ++jt) acc[kt][jt] = (f32x4){0.f, 0.f, 0.f, 0.f};
#pragma unroll 1
        for (int s = 0; s < 4; ++s) {
            bf16x8 a[4], b[2];
#pragma unroll
            for (int kt = 0; kt < 4; ++kt) { const float* q = wq + (size_t)(kt * 16) * 2048 + s * 32; a[kt] = pack8(*(const float4*)q, *(const float4*)(q + 4)); }
#pragma unroll
            for (int jt = 0; jt < 2; ++jt) { const float* q = sk + (size_t)(jt * 16) * 128 + s * 32; b[jt] = pack8(*(const float4*)q, *(const float4*)(q + 4)); }
#pragma unroll
            for (int kt = 0; kt < 4; ++kt)
#pragma unroll
                for (int jt = 0; jt < 2; ++jt) acc[kt][jt] = __builtin_amdgcn_mfma_f32_16x16x32_bf16(a[kt], b[jt], acc[kt][jt], 0, 0, 0);
        }
#pragma unroll
        for (int jt = 0; jt < 2; ++jt) {
            const int key = wid * 32 + jt * 16 + fr, cu = 128 * ((key >> 5) & 1) + 32 * (2 * pp + (key >> 6)) + (key & 31);
            bf16_t* row = Wf + ((size_t)layer * 2048 + h * 256 + cu) * 1024 + kb * 64 + 4 * fq;
#pragma unroll
            for (int kt = 0; kt < 4; ++kt) store_bf16x4(row + kt * 16, acc[kt][jt]);
        }
    }
}
__device__ __forceinline__ void bitonic_merge16_desc(unsigned (&L)[16]) {
#pragma unroll
    for (int j = 8; j > 0; j >>= 1)
#pragma unroll
        for (int i = 0; i < 16; ++i) { const int l = i ^ j; if (l > i) ce_desc(L[i], L[l]); }
}
__device__ __forceinline__ void bitonic_sort8_desc(unsigned (&a)[8]) {
#pragma unroll
    for (int k = 2; k <= 8; k <<= 1)
#pragma unroll
        for (int j = k >> 1; j > 0; j >>= 1)
#pragma unroll
            for (int i = 0; i < 8; ++i) { const int l = i ^ j; if (l > i) { if ((i & k) == 0) ce_desc(a[i], a[l]); else ce_desc(a[l], a[i]); } }
}
struct EpiSelect {
    unsigned* IDX; float* GATE; G8_LAS unsigned* X; const float* SSQP; const unsigned* SCT;
    __device__ __forceinline__ void operator()(const f32x4 (&acc)[2][2][4][2], const g8::Unit& u, int wr, int wc, int fr, int fq) const {
        const int pp = wc >> 1, half = wc & 1, wid = wr * 4 + wc;
        const unsigned kb = 127u - (unsigned)(half * 64 + fq * 8);
        unsigned Lst[4][16];
#pragma unroll
        for (int ai = 0; ai < 2; ++ai)
#pragma unroll
            for (int m = 0; m < 4; ++m) {
                unsigned C[16], Xc[16];
#pragma unroll
                for (int bj = 0; bj < 2; ++bj)
#pragma unroll
                    for (int n = 0; n < 2; ++n)
#pragma unroll
                        for (int r = 0; r < 4; ++r) C[bj * 8 + n * 4 + r] = (ord_key(acc[ai][bj][m][n][r]) & ~127u) | (kb - (unsigned)(bj * 32 + n * 4 + r));
                bitonic_sort16_desc(C);
#pragma unroll
                for (int i = 0; i < 16; ++i) Xc[i] = (unsigned)__shfl_xor((int)C[i], 16);
                merge_top16(C, Xc);
#pragma unroll
                for (int i = 0; i < 16; ++i) Xc[i] = (unsigned)__shfl_xor((int)C[i], 32);
                merge_top16(C, Xc);
                if ((m >> 1) == half) {
#pragma unroll
                    for (int i = 0; i < 16; ++i) Lst[ai * 2 + (m & 1)][i] = C[i];
                } else if (fq == 0) {
                    G8_LAS unsigned* xs = X + (((ai * 2 + wr) * 2 + pp) * 4 + m) * 256 + fr;
#pragma unroll
                    for (int i = 0; i < 16; ++i) xs[(i ^ m) << 4] = C[i];
                }
            }
        __syncthreads();
#pragma unroll
        for (int ai = 0; ai < 2; ++ai)
#pragma unroll
            for (int e = 0; e < 2; ++e) {
                const int m = half * 2 + e;
                unsigned Xc[16];
                G8_LAS unsigned* xs = X + (((ai * 2 + wr) * 2 + pp) * 4 + m) * 256 + fr;
#pragma unroll
                for (int i = 0; i < 16; ++i) Xc[i] = xs[(i ^ m) << 4];
                merge_top16(Lst[ai * 2 + e], Xc);
                if (fq == 0) {
#pragma unroll
                    for (int i = 0; i < 16; ++i) xs[(i ^ m) << 4] = Lst[ai * 2 + e][i];
                }
            }
        __syncthreads();
        if (wid < 4) {
            G8_LAS unsigned* x0 = X + ((wid * 2 + 0) * 4 + fq) * 256 + fr; G8_LAS unsigned* x1 = X + ((wid * 2 + 1) * 4 + fq) * 256 + fr;
            float s0[16], s1[16];
#pragma unroll
            for (int i = 0; i < 16; ++i) { s0[i] = unord_key(x0[(i ^ fq) << 4] & ~127u); s1[i] = unord_key(x1[(i ^ fq) << 4] & ~127u); }
#define SEL_CAND(i, j) ((ord_key(s0[i] + s1[j]) & ~255u) | (unsigned)(255 - ((i) * 16 + (j))))
            unsigned C[16], B[16], M2[16], M3[8];
#pragma unroll
            for (int j = 0; j < 16; ++j) C[j] = SEL_CAND(0, j);
#pragma unroll
            for (int k = 0; k < 15; ++k) B[k] = SEL_CAND(k + 1, 0);
            B[15] = 0u;
            merge_top16(C, B);
#pragma unroll
            for (int j = 0; j < 7; ++j) M2[j] = SEL_CAND(1, j + 1);
            M2[7] = 0u; M2[8] = 0u; M2[9] = 0u;
#pragma unroll
            for (int k = 0; k < 6; ++k) M2[15 - k] = SEL_CAND(k + 2, 1);
            bitonic_merge16_desc(M2);
            M3[0] = SEL_CAND(2, 2); M3[1] = SEL_CAND(2, 3); M3[2] = SEL_CAND(2, 4); M3[3] = SEL_CAND(3, 2); M3[4] = SEL_CAND(4, 2); M3[5] = SEL_CAND(3, 3); M3[6] = 0u; M3[7] = 0u;
            bitonic_sort8_desc(M3);
#pragma unroll
            for (int i = 0; i < 8; ++i) B[i] = M3[i];
#pragma unroll
            for (int i = 8; i < 16; ++i) B[i] = 0u;
            merge_top16(M2, B);
            merge_top16(C, M2);
#undef SEL_CAND
            const int tok = u.pm * 256 + (wid >> 1) * 128 + (wid & 1) * 64 + fq * 16 + fr;
            float rstd;
            {
                const f32x4 q0 = *(const f32x4*)(SSQP + (size_t)tok * 32), q1 = *(const f32x4*)(SSQP + (size_t)tok * 32 + 4), q2 = *(const f32x4*)(SSQP + (size_t)tok * 32 + 8), q3 = *(const f32x4*)(SSQP + (size_t)tok * 32 + 12);
                const f32x4 q = (q0 + q1) + (q2 + q3);
                rstd = rsqrtf(((q[0] + q[1]) + (q[2] + q[3])) * (1.0f / D) + EPS);
            }
            const float mx = unord_key(C[0] & ~255u);
            float e[16]; float sum = 0.f;
#pragma unroll
            for (int r = 0; r < 16; ++r) { e[r] = __expf((unord_key(C[r] & ~255u) - mx) * rstd); sum += e[r]; }
            const float inv = 1.0f / sum;
            const size_t ob = (size_t)tok * 128 + u.pn * 16;
            unsigned iw[16];
#pragma unroll
            for (int r = 0; r < 16; ++r) {
                const unsigned code = 255u - (C[r] & 255u);
                const unsigned e0 = 127u - (x0[((code >> 4) ^ (unsigned)fq) << 4] & 127u), e1 = 127u - (x1[((code & 15u) ^ (unsigned)fq) << 4] & 127u);
                iw[r] = e0 * 128u + e1;
            }
            unsigned sc[16];
#pragma unroll
            for (int r = 0; r < 16; ++r) sc[r] = SCT[iw[r]];
#pragma unroll
            for (int r = 0; r < 16; ++r) {
                iw[r] |= sc[r] << 16;
                e[r] *= inv * (float)__builtin_bit_cast(_Float16, (unsigned short)(sc[r] >> 16));
            }
#pragma unroll
            for (int r = 0; r < 4; ++r) *(uint4*)(IDX + ob + r * 4) = make_uint4(iw[4 * r], iw[4 * r + 1], iw[4 * r + 2], iw[4 * r + 3]);
#pragma unroll
            for (int r = 0; r < 4; ++r) *(float4*)(GATE + ob + r * 4) = make_float4(e[4 * r], e[4 * r + 1], e[4 * r + 2], e[4 * r + 3]);
        }
        __syncthreads();
    }
};
__device__ __forceinline__ void phase_select8(const Params& p, int layer, char* smem_phys) {
    const bf16_t* H = (const bf16_t*)(p.ws + OFF_H); const bf16_t* Wf = (const bf16_t*)(p.ws + OFF_WT_Q) + (size_t)layer * 2048 * 1024;
    g8::Gemm g{H, H, 1024, 1024, Wf, T, 2048, 1024};
    g8::StaticOrder S; S.init(T, 2048, (int)gridDim.x, (int)blockIdx.x);
    EpiSelect E{(unsigned*)(p.ws + OFF_IDX), (float*)(p.ws + OFF_GATE), (G8_LAS unsigned*)(smem_phys + 131072), (const float*)(p.ws + OFF_SSQ), (const unsigned*)(p.ws + OFF_USC) + (size_t)layer * NEXP};
    g8::gemm_phase<EpiSelect>((G8_LAS unsigned char*)smem_phys, g, S, E);
    __syncthreads();
    if (threadIdx.x == 0) *(uint4*)(smem_phys + kDynLds - 16) = make_uint4(0u, 0u, 0u, 0u);
    __syncthreads();
}

__device__ __forceinline__ float ub0(unsigned w) { float f; asm("v_cvt_f32_ubyte0 %0, %1" : "=v"(f) : "v"(w)); return f; }
__device__ __forceinline__ float ub1(unsigned w) { float f; asm("v_cvt_f32_ubyte1 %0, %1" : "=v"(f) : "v"(w)); return f; }
__device__ __forceinline__ float ub2(unsigned w) { float f; asm("v_cvt_f32_ubyte2 %0, %1" : "=v"(f) : "v"(w)); return f; }
__device__ __forceinline__ float ub3(unsigned w) { float f; asm("v_cvt_f32_ubyte3 %0, %1" : "=v"(f) : "v"(w)); return f; }
typedef _Float16 f16x2 __attribute__((ext_vector_type(2)));
__device__ __forceinline__ void glds16(const void* gsrc, unsigned lds_dst) {
    unsigned keep; const unsigned d = (unsigned)__builtin_amdgcn_readfirstlane((int)lds_dst);
    asm volatile("s_mov_b32 %0, m0\n\ts_mov_b32 m0, %2\n\ts_nop 0\n\tglobal_load_lds_dwordx4 %1, off\n\ts_mov_b32 m0, %0" : "=&s"(keep) : "v"(gsrc), "s"(d) : "memory");
}
__device__ __forceinline__ void peer_gather(const Params& p, int layer, const float* __restrict__ gnext, bool final_out, char* smem) {
    const unsigned char* REC = p.ws + OFF_UT + (size_t)layer * NEXP * 1024;
    bf16_t* H = (bf16_t*)(p.ws + OFF_H);
    const unsigned* IDX = (const unsigned*)(p.ws + OFF_IDX); const float* GATE = (const float*)(p.ws + OFF_GATE);
    float* X = p.out;
    const int lane = VTID & 63, wid = VTID >> 6, sub = lane >> 4, li = lane & 15;
    char* wbase = smem + (int)(threadIdx.x >> 6) * 17408;
    unsigned* sIdx = (unsigned*)wbase; float* sGate = (float*)(wbase + 512);
    const char* ring = wbase + 1024; const unsigned ringb = (unsigned)(size_t)ring;
    const int gw = VBID * 4 + wid, nw = VGRID * 4;
    for (int t = gw; t < T; t += nw) {
        {
            int lz = 0; asm volatile("" : "+v"(lz));
            const int l2 = 2 * (lane + lz);
            const uint2 idp = *(const uint2*)(IDX + (size_t)t * 128 + l2);
            const float2 g2 = *(const float2*)(GATE + (size_t)t * 128 + l2);
            *(uint2*)(sIdx + l2) = idp; *(float2*)(sGate + l2) = g2;
        }
        int XH[2][4], XL[2][4]; float sx; float xg;
        {
            u32x4 xr[8]; float am = 0.f;
#pragma unroll
            for (int k = 0; k < 8; ++k) {
                xr[k] = *(const u32x4*)(H + (size_t)t * 1024 + (16 * (k >> 2) + li) * 32 + (k & 3) * 8);
#pragma unroll
                for (int c = 0; c < 4; ++c) am = fmaxf(am, fmaxf(fabsf(lo2f(xr[k][c])), fabsf(hi2f(xr[k][c]))));
            }
            const float* sq = (const float*)(p.ws + OFF_SSQ) + (size_t)t * 32;
            const f32x4 qs = (*(const f32x4*)sq + *(const f32x4*)(sq + 4)) + (*(const f32x4*)(sq + 8) + *(const f32x4*)(sq + 12));
            am = fmaxf(am, __shfl_xor(am, 1)); am = fmaxf(am, __shfl_xor(am, 2)); am = fmaxf(am, __shfl_xor(am, 4)); am = fmaxf(am, __shfl_xor(am, 8));
            const float inv = am > 0.f ? 119.0f / am : 0.f;
            sx = am * (1.0f / 119.0f) * rsqrtf(((qs[0] + qs[1]) + (qs[2] + qs[3])) * (1.0f / D) + EPS);
            int xs = 0;
#pragma unroll
            for (int j = 0; j < 2; ++j)
#pragma unroll
                for (int d = 0; d < 4; ++d) {
                    const u32x4 raw = xr[j * 4 + d];
                    unsigned lo = 0u, hi = 0u;
#pragma unroll
                    for (int i = 0; i < 8; ++i) {
                        const unsigned wsrc = raw[i >> 1];
                        const int q = __float2int_rn(((i & 1) ? hi2f(wsrc) : lo2f(wsrc)) * inv);
                        const int sh = (i & 3) * 8 + (i >> 2) * 4;
                        lo |= ((unsigned)q & 15u) << sh; hi |= ((unsigned)((q + 8) >> 4) & 15u) << sh;
                        xs += q;
                    }
                    XL[j][d] = (int)lo; XH[j][d] = (int)hi;
                }
            xg = 0.5f * (float)xs;
        }
        f16x2 accp[2][16];
#pragma unroll
        for (int j = 0; j < 2; ++j)
#pragma unroll
            for (int c = 0; c < 16; ++c) accp[j][c] = (f16x2){(_Float16)0.f, (_Float16)0.f};
        float wsg = 0.f;
        auto issue = [&](int sg) {
            const unsigned e_ = sIdx[sg * 4 + sub] & 0xffffu;
            const unsigned char* rec = REC + (size_t)e_ * 1024 + li * 16;
            const unsigned dst = ringb + (unsigned)(sg & 3) * 4096u;
            glds16(rec, dst); glds16(rec + 256, dst + 1024u); glds16(rec + 512, dst + 2048u); glds16(rec + 768, dst + 3072u);
        };
        auto compute = [&](int sg, bool refill) {
            const char* sl = ring + (sg & 3) * 4096;
            const u32x4 du0 = *(const u32x4*)(sl + lane * 16), du1 = *(const u32x4*)(sl + 1024 + lane * 16);
            const u32x4 dv0 = *(const u32x4*)(sl + 2048 + lane * 16), dv1 = *(const u32x4*)(sl + 3072 + lane * 16);
            const float us = (float)__builtin_bit_cast(_Float16, (unsigned short)(sIdx[sg * 4 + sub] >> 16));
            const float gt = sGate[sg * 4 + sub];
            if (refill) { asm volatile("s_waitcnt lgkmcnt(0)" ::: "memory"); issue(sg + 4); }
            int iah = 0, ial = 0;
#pragma unroll
            for (int j = 0; j < 2; ++j) {
#pragma unroll
                for (int d = 0; d < 4; ++d) {
                    const int w = (int)(j ? du1[d] : du0[d]);
                    iah = __builtin_amdgcn_sdot8(w, XH[j][d], iah, false);
                    ial = __builtin_amdgcn_sdot8(w, XL[j][d], ial, false);
                }
            }
            float pa = us * ((float)(16 * iah + ial) + xg);
            pa = row16_sum(pa);
            const float ww = gt * gelu_exact(pa * sx);
            wsg += ww;
            const float wc = fminf(fmaxf(ww * 65536.0f, -65504.0f), 65504.0f);
            const _Float16 wha = (_Float16)wc, whb = (_Float16)(wc * 0.0625f);
            const f16x2 wa = {wha, wha}, wb = {whb, whb};
#pragma unroll
            for (int j = 0; j < 2; ++j) {
#pragma unroll
                for (int d = 0; d < 4; ++d) {
                    const unsigned wv = j ? dv1[d] : dv0[d], wt = wv >> 8;
                    const f16x2 c0 = __builtin_bit_cast(f16x2, wv & 0x000f000fu), c1 = __builtin_bit_cast(f16x2, wv & 0x00f000f0u);
                    const f16x2 c2 = __builtin_bit_cast(f16x2, wt & 0x000f000fu), c3 = __builtin_bit_cast(f16x2, wt & 0x00f000f0u);
                    accp[j][4 * d + 0] = __builtin_elementwise_fma(c0, wa, accp[j][4 * d + 0]); accp[j][4 * d + 1] = __builtin_elementwise_fma(c1, wb, accp[j][4 * d + 1]);
                    accp[j][4 * d + 2] = __builtin_elementwise_fma(c2, wa, accp[j][4 * d + 2]); accp[j][4 * d + 3] = __builtin_elementwise_fma(c3, wb, accp[j][4 * d + 3]);
                }
            }
        };
        asm volatile("s_waitcnt vmcnt(0)" ::: "memory");
        issue(0); issue(1); issue(2); issue(3);
#pragma unroll 1
        for (int sg = 0; sg < 28; ++sg) {
            asm volatile("s_waitcnt vmcnt(12)" ::: "memory");
            compute(sg, true);
        }
        asm volatile("s_waitcnt vmcnt(12)" ::: "memory");
        compute(28, false);
        asm volatile("s_waitcnt vmcnt(8)" ::: "memory");
        compute(29, false);
        asm volatile("s_waitcnt vmcnt(4)" ::: "memory");
        compute(30, false);
        asm volatile("s_waitcnt vmcnt(0)" ::: "memory");
        compute(31, false);
        float acc[2][32];
#pragma unroll
        for (int j = 0; j < 2; ++j)
#pragma unroll
            for (int d = 0; d < 4; ++d) {
                acc[j][8 * d + 0] = 256.0f * (float)accp[j][4 * d + 0][0]; acc[j][8 * d + 2] = 256.0f * (float)accp[j][4 * d + 0][1];
                acc[j][8 * d + 4] = 256.0f * (float)accp[j][4 * d + 1][0]; acc[j][8 * d + 6] = 256.0f * (float)accp[j][4 * d + 1][1];
                acc[j][8 * d + 1] = 256.0f * (float)accp[j][4 * d + 2][0]; acc[j][8 * d + 3] = 256.0f * (float)accp[j][4 * d + 2][1];
                acc[j][8 * d + 5] = 256.0f * (float)accp[j][4 * d + 3][0]; acc[j][8 * d + 7] = 256.0f * (float)accp[j][4 * d + 3][1];
            }
        const bool up2 = (sub & 2) != 0, up1 = (sub & 1) != 0;
        float wsum = wsg + __shfl_xor(wsg, 32);
        wsum += __shfl_xor(wsum, 16);
        float r1[32];
#pragma unroll
        for (int c = 0; c < 32; ++c) r1[c] = (up2 ? acc[1][c] : acc[0][c]) + __shfl_xor(up2 ? acc[0][c] : acc[1][c], 32);
        float r2[16];
#pragma unroll
        for (int c = 0; c < 16; ++c) r2[c] = (up1 ? r1[16 + c] : r1[c]) + __shfl_xor(up1 ? r1[c] : r1[16 + c], 16);
        const int col0 = (16 * (sub >> 1) + li) * 32 + (sub & 1) * 16;
        float ss = 0.f;
        float* xrow = X + (size_t)t * 1024 + col0;
#pragma unroll
        for (int c4 = 0; c4 < 4; ++c4) {
            const f32x4 a = *(const f32x4*)(xrow + c4 * 4);
#pragma unroll
            for (int c = 0; c < 4; ++c) { r2[c4 * 4 + c] = r2[c4 * 4 + c] - 7.5f * wsum + a[c]; ss += r2[c4 * 4 + c] * r2[c4 * 4 + c]; }
        }
        ss = wave_sum(ss);
        const float rstd = rsqrtf(ss * (1.0f / D) + EPS);
        const float* gp = gnext + col0;
        if (final_out) {
#pragma unroll
            for (int c4 = 0; c4 < 4; ++c4) {
                const f32x4 g = *(const f32x4*)(gp + c4 * 4);
                *(f32x4*)(xrow + c4 * 4) = (f32x4){r2[c4 * 4] * rstd * g[0], r2[c4 * 4 + 1] * rstd * g[1], r2[c4 * 4 + 2] * rstd * g[2], r2[c4 * 4 + 3] * rstd * g[3]};
            }
        } else {
            u32x4 o[2];
#pragma unroll
            for (int c4 = 0; c4 < 4; ++c4) {
                const f32x4 g = *(const f32x4*)(gp + c4 * 4);
                *(f32x4*)(xrow + c4 * 4) = (f32x4){r2[c4 * 4], r2[c4 * 4 + 1], r2[c4 * 4 + 2], r2[c4 * 4 + 3]};
                o[c4 >> 1][(c4 & 1) * 2] = pack2(r2[c4 * 4] * rstd * g[0], r2[c4 * 4 + 1] * rstd * g[1]);
                o[c4 >> 1][(c4 & 1) * 2 + 1] = pack2(r2[c4 * 4 + 2] * rstd * g[2], r2[c4 * 4 + 3] * rstd * g[3]);
            }
            bf16_t* hp = H + (size_t)t * 1024 + col0;
            *(u32x4*)hp = o[0]; *(u32x4*)(hp + 8) = o[1];
        }
    }
}

__device__ __forceinline__ void spatial_fast(const Params& p, char* smem) {
    bf16_t* U = (bf16_t*)(p.ws + OFF_REGION); const bf16_t* VT = U + (size_t)T * 2048; const float* SSQ = (const float*)(p.ws + OFF_SSQ);
    const int tid_ = VTID;
    for (int task = VBID; task < 2048; task += VGRID) {
        const int chunk = task >> 3, g = task & 7;
        int lz = 0; asm volatile("" : "+v"(lz));
        const int tid = tid_ + lz, lane = tid & 63, wid = tid >> 6, wm = wid >> 1, wn = wid & 1, l15 = lane & 15, q4 = lane >> 4;
        float* rs = (float*)(smem + 16384);
        if (tid < 128) {
            const float* sp = SSQ + (size_t)(chunk * 128 + tid) * 32;
            float s = 0.f;
#pragma unroll
            for (int i = 0; i < 8; ++i) { const f32x4 v = *(const f32x4*)(sp + 4 * i); s += (v[0] + v[1]) + (v[2] + v[3]); }
            rs[tid] = rsqrtf(s * (1.0f / 2048.0f) + EPS);
        }
        __syncthreads();
#pragma unroll
        for (int i = 0; i < 8; ++i) {
            const int c = tid + 256 * i, row = c >> 4, ch16 = c & 15, ks = ch16 >> 3, ch = ch16 & 7, s0 = ch16 * 8;
            const float* wp = p.c_w_spatial + ((size_t)(g * 128 + row)) * 128 + s0;
            const f32x4 w0 = *(const f32x4*)wp, w1 = *(const f32x4*)(wp + 4);
            const f32x4 r0 = *(const f32x4*)(rs + s0), r1 = *(const f32x4*)(rs + s0 + 4);
            float v[8];
#pragma unroll
            for (int j = 0; j < 4; ++j) { v[j] = (s0 + j <= row) ? w0[j] * r0[j] : 0.f; v[4 + j] = (s0 + 4 + j <= row) ? w1[j] * r1[j] : 0.f; }
            *(uint4*)(smem + ks * 32768 + row * 128 + ((ch ^ (row & 7)) << 4)) = make_uint4(pack2(v[0], v[1]), pack2(v[2], v[3]), pack2(v[4], v[5]), pack2(v[6], v[7]));
        }
        __syncthreads();
#pragma unroll 1
        for (int nh = 0; nh < 2; ++nh) {
            const int chan0 = g * 256 + nh * 128;
#pragma unroll
            for (int i = 0; i < 8; ++i) {
                const int c = tid + 256 * i, row = c >> 4, ch16 = c & 15, ks = ch16 >> 3, ch = ch16 & 7;
                *(uint4*)(smem + ks * 32768 + 16384 + row * 128 + ((ch ^ (row & 7)) << 4)) = *(const uint4*)(VT + ((size_t)chunk * 2048 + chan0 + row) * 128 + ch16 * 8);
            }
            __syncthreads();
            f32x4 acc[4][4];
#pragma unroll
            for (int i = 0; i < 4; ++i)
#pragma unroll
                for (int j = 0; j < 4; ++j) acc[i][j] = (f32x4){0.f, 0.f, 0.f, 0.f};
#pragma unroll
            for (int kt = 0; kt < 2; ++kt) {
                if (kt == 1 && wm == 0) continue;
                const char* sa = smem + kt * 32768; const char* sb = sa + 16384;
#pragma unroll
                for (int ks = 0; ks < 2; ++ks) {
                    bf16x8 af[4], bfr[4];
                    const int ch = ks * 4 + q4;
#pragma unroll
                    for (int i = 0; i < 4; ++i) { const int row = wm * 64 + i * 16 + l15; af[i] = *(const bf16x8*)(sa + row * 128 + ((ch ^ (row & 7)) << 4)); }
#pragma unroll
                    for (int j = 0; j < 4; ++j) { const int row = wn * 64 + j * 16 + l15; bfr[j] = *(const bf16x8*)(sb + row * 128 + ((ch ^ (row & 7)) << 4)); }
#pragma unroll
                    for (int i = 0; i < 4; ++i)
#pragma unroll
                        for (int j = 0; j < 4; ++j) acc[i][j] = __builtin_amdgcn_mfma_f32_16x16x32_bf16(bfr[j], af[i], acc[i][j], 0, 0, 0);
                }
            }
            __syncthreads();
#pragma unroll
            for (int i = 0; i < 4; ++i) {
                const int m = wm * 64 + i * 16 + l15;
                const float bias = p.c_b_spatial[g * 128 + m];
#pragma unroll
                for (int j = 0; j < 4; ++j) {
                    const int chan = chan0 + wn * 64 + j * 16 + 4 * q4;
                    const f32x4 vn = *(const f32x4*)(p.c_v_norm + chan);
                    bf16_t* up = U + (size_t)(chunk * 128 + m) * 2048 + chan;
                    const uint2 uu = *(const uint2*)up;
                    uint2 o;
                    o.x = pack2(lo2f(uu.x) * (vn[0] * acc[i][j][0] + bias), hi2f(uu.x) * (vn[1] * acc[i][j][1] + bias));
                    o.y = pack2(lo2f(uu.y) * (vn[2] * acc[i][j][2] + bias), hi2f(uu.y) * (vn[3] * acc[i][j][3] + bias));
                    *(uint2*)up = o;
                }
            }
        }
    }
}

#define XB_TMO      128
#define XB_XCNT(j)  (256  + 64 * (j))
#define XB_XSUB(j)  (1280 + 64 * (j))
#define XB_XGEN(j)  (2304 + 64 * (j))
#define XB_TOP      3328
#define XB_TOPGEN   3392
#define XCD_BAR_WORDS 3456
#define XB_SPIN_CAP (1u << 22)
#define LAS __attribute__((address_space(3)))
__device__ __forceinline__ unsigned xb_ld(unsigned* p)              { return __hip_atomic_load(p, __ATOMIC_RELAXED, __HIP_MEMORY_SCOPE_AGENT); }
__device__ __forceinline__ unsigned xb_add(unsigned* p, unsigned v) { return __hip_atomic_fetch_add(p, v, __ATOMIC_RELAXED, __HIP_MEMORY_SCOPE_AGENT); }
__device__ __forceinline__ unsigned xb_xcc_id() { return (unsigned)__builtin_amdgcn_s_getreg((3 << 11) | 20) & 0xFu; }
#define XB_SPIN(cond, bar) do { unsigned _sp = 0; while (cond) { __builtin_amdgcn_s_sleep(1); \
    if ((++_sp & 255u) == 0u) { if (xb_ld(&(bar)[XB_TMO])) break; if (_sp > XB_SPIN_CAP) { atomicAdd(&(bar)[XB_TMO], 1u); break; } } } } while (0)
struct XcdBarrier { unsigned* bar; unsigned x; volatile LAS unsigned* st; };
__device__ __forceinline__ XcdBarrier xcd_barrier_post(unsigned* bar, volatile LAS unsigned* st) {
    XcdBarrier b; b.bar = bar; b.x = xb_xcc_id(); b.st = st;
    if (threadIdx.x == 0) (void)xb_add(&bar[XB_XCNT(b.x)], 1u);
    return b;
}
__device__ __forceinline__ void xcd_barrier_complete(unsigned* bar, unsigned x, unsigned& nloc, unsigned& nx) {
    const unsigned G = gridDim.x * gridDim.y * gridDim.z;
    unsigned sum, cnt, mine, sp = 0u;
    for (;;) {
        sum = 0u; cnt = 0u; mine = 0u;
#pragma unroll
        for (unsigned j = 0; j < 16; ++j) { const unsigned c = xb_ld(&bar[XB_XCNT(j)]); sum += c; cnt += (c > 0u) ? 1u : 0u; mine = (j == x) ? c : mine; }
        if (sum == G) break;
        __builtin_amdgcn_s_sleep(1);
        if ((++sp & 255u) == 0u) { if (xb_ld(&bar[XB_TMO])) break; if (sp > XB_SPIN_CAP) { atomicAdd(&bar[XB_TMO], 1u); break; } }
    }
    nloc = mine > 0u ? mine : 1u; nx = cnt > 0u ? cnt : 1u;
}
__device__ __forceinline__ void xcd_barrier(const XcdBarrier& b) {
    asm volatile("s_waitcnt vmcnt(0)" ::: "memory");
    __syncthreads();
    if (threadIdx.x == 0) {
        unsigned* bar = b.bar;
        __builtin_amdgcn_s_waitcnt(0);
        unsigned nloc = b.st[0], nx = b.st[1];
        if (nloc == 0u) { xcd_barrier_complete(bar, b.x, nloc, nx); b.st[0] = nloc; b.st[1] = nx; }
        const unsigned old = xb_add(&bar[XB_XSUB(b.x)], 1u);
        const unsigned gen = old / nloc;
        if (old + 1u == (gen + 1u) * nloc) {
            __builtin_amdgcn_fence(__ATOMIC_RELEASE, "agent");
            asm volatile("s_waitcnt vmcnt(0)" ::: "memory");
            const unsigned og = xb_add(&bar[XB_TOP], 1u);
            const unsigned tg = og / nx;
            if (og + 1u == (tg + 1u) * nx) xb_add(&bar[XB_TOPGEN], 1u);
            else XB_SPIN(xb_ld(&bar[XB_TOPGEN]) == tg, bar);
            __builtin_amdgcn_fence(__ATOMIC_ACQUIRE, "agent");
            xb_add(&bar[XB_XGEN(b.x)], 1u);
            asm volatile("s_waitcnt vmcnt(0)" ::: "memory");
        } else {
            XB_SPIN(xb_ld(&bar[XB_XGEN(b.x)]) == gen, bar);
            __builtin_amdgcn_fence(__ATOMIC_ACQUIRE, "agent");
            asm volatile("s_waitcnt vmcnt(0)" ::: "memory");
        }
    }
    __syncthreads();
}

constexpr int NPHASE = 12;
__global__ void __launch_bounds__(512, 2) mega(Params p, int ph_lo, int ph_hi) {
    extern __shared__ __attribute__((aligned(16))) char smem_phys[];
    uint4& xb_words = *(uint4*)(smem_phys + kDynLds - 16);
    if (threadIdx.x == 0) xb_words = make_uint4(0u, 0u, 0u, 0u);
    __syncthreads();
    const XcdBarrier xbar = xcd_barrier_post((unsigned*)(p.ws + OFF_BAR), (volatile LAS unsigned*)&xb_words);
    char* smem = smem_phys + (threadIdx.x >> 8) * 65536;
    bf16_t* Rg = (bf16_t*)(p.ws + OFF_REGION);
    bf16_t* Hb = (bf16_t*)(p.ws + OFF_H);
#define PHASE(k, ...) if (ph_lo <= (k) && (k) < ph_hi) { __VA_ARGS__; if ((k) + 1 < ph_hi) xcd_barrier(xbar); }
    unsigned* sbctr = (unsigned*)(p.ws + OFF_BAR + 14336);
    PHASE(0,
        transpose_convert<true>(p.ab_w_in, (bf16_t*)(p.ws + OFF_WT_IN), 1024, AB_IN, AB_IN_PAD, smem);
        rmsnorm_rows(p.x, p.norm_mix, Hb))
    PHASE(1, phase_gemm_in8(p, smem_phys))
    PHASE(2, gla_prep(p, smem))
    PHASE(3, gla_scan(p, smem); sb_fast(p, smem_phys + 98304, sbctr);
        quantize_tables_static(p, 64);
        transpose_convert(p.ab_w_out, (bf16_t*)(p.ws + OFF_WT_OUT), 1024, 1024, 1024, smem, 64);
        transpose_convert(p.c_w_in, (bf16_t*)(p.ws + OFF_WT_CIN), 1024, 4096, 4096, smem, 64);
        transpose_convert(p.c_w_out, (bf16_t*)(p.ws + OFF_WT_COUT), 2048, 1024, 1024, smem, 64);
        fold_query_weights(p, 64))
    PHASE(4, phase_gemm_resid8(Rg + R_QSB, Rg + R_GG, 512, 512, (const bf16_t*)(p.ws + OFF_WT_OUT), 1024, p.x, p.out, Hb, (float*)(p.ws + OFF_SSQ), p.norm_ffn, smem_phys))
    PHASE(5, phase_select8(p, 0, smem_phys))
    PHASE(6, peer_gather(p, 0, p.norm_mix + 1024, false, smem_phys))
    PHASE(7, phase_gemm_cin8_v(p, smem_phys))
    PHASE(8, phase_gemm_cin8_u(p, smem_phys))
    PHASE(9, phase_gemm_resid8(Rg, Rg, 2048, 2048, (const bf16_t*)(p.ws + OFF_WT_COUT), 2048, p.out, p.out, Hb, (float*)(p.ws + OFF_SSQ), p.norm_ffn + 1024, smem_phys))
    PHASE(10, phase_select8(p, 1, smem_phys))
    PHASE(11, peer_gather(p, 1, p.final_norm, true, smem_phys))
}

extern "C" void kernel_launch(void* const* d_in, const int* in_sizes, int n_in, void* d_out, int out_size, void* d_ws, size_t ws_size, hipStream_t stream) {
    static int grid_blocks = 0;
    if (!grid_blocks) {
        int dev = 0, cus = 0, per_cu = 0;
        hipGetDevice(&dev);
        hipDeviceGetAttribute(&cus, hipDeviceAttributeMultiprocessorCount, dev);
        hipFuncSetAttribute((const void*)mega, hipFuncAttributeMaxDynamicSharedMemorySize, kDynLds);
        hipOccupancyMaxActiveBlocksPerMultiprocessor(&per_cu, mega, 512, kDynLds);
        if (per_cu < 1) per_cu = 1;
        if (per_cu > 1) per_cu = 1;
        grid_blocks = cus * per_cu;
        if (n_in != 18 || ws_size < WS_END) fprintf(stderr, "kernel_launch: unexpected n_in %d or ws_size %zu < %zu\n", n_in, ws_size, (size_t)WS_END);
    }
    Params p{};
    p.x = (const float*)d_in[0]; p.norm_mix = (const float*)d_in[1]; p.norm_ffn = (const float*)d_in[2]; p.ab_w_in = (const float*)d_in[3];
    p.ab_w_alpha2 = (const float*)d_in[4]; p.ab_b_alpha2 = (const float*)d_in[5]; p.ab_gla_norm = (const float*)d_in[6]; p.ab_w_out = (const float*)d_in[7];
    p.c_w_in = (const float*)d_in[8]; p.c_v_norm = (const float*)d_in[9]; p.c_w_spatial = (const float*)d_in[10]; p.c_b_spatial = (const float*)d_in[11];
    p.c_w_out = (const float*)d_in[12]; p.peer_w_q = (const float*)d_in[13]; p.peer_subkeys = (const float*)d_in[14]; p.peer_u = (const float*)d_in[15];
    p.peer_v = (const float*)d_in[16]; p.final_norm = (const float*)d_in[17];
    p.out = (float*)d_out; p.ws = (unsigned char*)d_ws;
    (void)hipMemsetAsync((char*)d_ws + OFF_BAR, 0, 16384, stream);
#if ONE_LAUNCH
    int lo = 0, hi = NPHASE;
    void* args[] = {&p, &lo, &hi};
    hipError_t e = hipLaunchCooperativeKernel((void*)mega, dim3(grid_blocks), dim3(512), args, kDynLds, stream);
    if (e != hipSuccess) fprintf(stderr, "cooperative launch failed: %s (grid %d)\n", hipGetErrorString(e), grid_blocks);
#else
    for (int ph = 0; ph < NPHASE; ++ph) hipLaunchKernelGGL(mega, dim3(grid_blocks), dim3(512), kDynLds, stream, p, ph, ph + 1);
#endif
}
```

```cpp
#include <hip/hip_runtime.h>
#include <hip/hip_cooperative_groups.h>
#include <cstdio>
#include <cstdint>
namespace cg = cooperative_groups;

#ifndef ONE_LAUNCH
#define ONE_LAUNCH 1
#endif


#define VTID ((int)(threadIdx.x & 255))
#define VBID ((int)(blockIdx.x * 2 + (threadIdx.x >> 8)))
#define VGRID ((int)(gridDim.x * 2))
typedef unsigned short bf16_t;
typedef short bf16x8 __attribute__((ext_vector_type(8)));
typedef float f32x4 __attribute__((ext_vector_type(4)));
typedef unsigned u32x4 __attribute__((ext_vector_type(4)));
typedef __bf16 bf16x2_t __attribute__((ext_vector_type(2)));

constexpr int T = 32768, D = 1024, SEQ = 2048, NB = 16;
constexpr int AB_IN = 3088, AB_IN_PAD = 3200;
constexpr float EPS = 1e-6f;
constexpr int NEXP = 16384;
constexpr int kDynLds = 163840;

constexpr size_t SZ_WT_IN = (size_t)AB_IN_PAD * 1024 * 2;
constexpr size_t SZ_WT_OUT = (size_t)1024 * 1024 * 2;
constexpr size_t SZ_WT_CIN = (size_t)4096 * 1024 * 2;
constexpr size_t SZ_WT_COUT = (size_t)1024 * 2048 * 2;
constexpr size_t SZ_WT_Q = (size_t)2 * 2048 * 1024 * 2;
constexpr size_t SZ_SK = (size_t)2 * 8 * 2 * 128 * 128 * 2;
constexpr size_t SZ_TAB = (size_t)2 * NEXP * 1024;
constexpr size_t SZ_TSC = (size_t)2 * NEXP * 4;
constexpr size_t OFF_WT_IN = 0;
constexpr size_t OFF_WT_OUT = OFF_WT_IN + SZ_WT_IN;
constexpr size_t OFF_WT_CIN = OFF_WT_OUT + SZ_WT_OUT;
constexpr size_t OFF_WT_COUT = OFF_WT_CIN + SZ_WT_CIN;
constexpr size_t OFF_WT_Q = OFF_WT_COUT + SZ_WT_COUT;
constexpr size_t OFF_SK = OFF_WT_Q + SZ_WT_Q;
constexpr size_t OFF_UT = OFF_SK;
constexpr size_t OFF_USC = OFF_UT + SZ_TAB;
constexpr size_t OFF_VSC = OFF_USC + SZ_TSC;
constexpr size_t OFF_H = OFF_VSC + SZ_TSC;
constexpr size_t OFF_IDX = OFF_H + (size_t)T * 1024 * 2;
constexpr size_t OFF_GATE = OFF_IDX + (size_t)T * 128 * 4;
constexpr size_t OFF_SSQ = OFF_GATE + (size_t)T * 128 * 4;
constexpr size_t OFF_REGION = OFF_SSQ + (size_t)T * 32 * 4;
constexpr size_t SZ_REGION = (size_t)256 << 20;
constexpr size_t OFF_S = OFF_REGION + SZ_REGION;
constexpr size_t OFF_BAR = OFF_S + (size_t)T * 1024 * 2;
constexpr size_t WS_END = OFF_BAR + 16384;
constexpr size_t R_QSB = 0;
constexpr size_t R_KSB = R_QSB + (size_t)T * 512;
constexpr size_t R_VTSB = R_KSB + (size_t)T * 512;
constexpr size_t R_QG = R_VTSB + (size_t)T * 512;
constexpr size_t R_KG = R_QG + (size_t)T * 256;
constexpr size_t R_VTG = R_KG + (size_t)T * 256;
constexpr size_t R_GG = R_VTG + (size_t)T * 512;
constexpr size_t R_ALR = R_GG + (size_t)T * 512;
constexpr size_t R_KOT = R_ALR + (size_t)T * 32;
constexpr size_t R_DEC = R_KOT + (size_t)T * 256;

struct Params {
    const float* x; const float* norm_mix; const float* norm_ffn; const float* ab_w_in; const float* ab_w_alpha2; const float* ab_b_alpha2;
    const float* ab_gla_norm; const float* ab_w_out; const float* c_w_in; const float* c_v_norm; const float* c_w_spatial; const float* c_b_spatial;
    const float* c_w_out; const float* peer_w_q; const float* peer_subkeys; const float* peer_u; const float* peer_v; const float* final_norm;
    float* out; unsigned char* ws;
};

__device__ __forceinline__ float bf2f(bf16_t v) { return __uint_as_float(((unsigned)v) << 16); }
__device__ __forceinline__ bf16_t f2bf(float f) { unsigned r; asm("v_cvt_pk_bf16_f32 %0, %1, %1" : "=v"(r) : "v"(f)); return (bf16_t)r; }
__device__ __forceinline__ unsigned pack2(float lo, float hi) { unsigned r; asm("v_cvt_pk_bf16_f32 %0, %1, %2" : "=v"(r) : "v"(lo), "v"(hi)); return r; }
__device__ __forceinline__ float lo2f(unsigned w) { return __uint_as_float(w << 16); }
__device__ __forceinline__ float hi2f(unsigned w) { return __uint_as_float(w & 0xffff0000u); }
__device__ __forceinline__ float dot2(unsigned a, unsigned b, float acc) { return __builtin_amdgcn_fdot2_f32_bf16(__builtin_bit_cast(bf16x2_t, a), __builtin_bit_cast(bf16x2_t, b), acc, false); }
#define GELU_C0 -1.0001451969146729f
#define GELU_C1 -1.1498452425003052f
#define GELU_C2 -0.46162763237953186f
#define GELU_C3 -0.051034148782491684f
#define GELU_C4 0.007168652955442667f
#define GELU_C5 -0.0006095620337873697f
#define GELU_C6 2.30170971917687e-05f
__device__ __forceinline__ float gelu_exact(float v) {
    const float a = fminf(fabsf(v), 6.0f);
    float q = GELU_C6 * a + GELU_C5; q = q * a + GELU_C4; q = q * a + GELU_C3; q = q * a + GELU_C2; q = q * a + GELU_C1; q = q * a + GELU_C0;
    return fmaxf(v, 0.f) - fabsf(v) * __builtin_amdgcn_exp2f(q);
}
typedef float f32x2 __attribute__((ext_vector_type(2)));
__device__ __forceinline__ f32x2 gelu_exact2(f32x2 v) {
    const f32x2 av = __builtin_elementwise_abs(v), a = __builtin_elementwise_min(av, (f32x2){6.0f, 6.0f});
    f32x2 q = (f32x2){GELU_C6, GELU_C6} * a + (f32x2){GELU_C5, GELU_C5};
    q = q * a + (f32x2){GELU_C4, GELU_C4}; q = q * a + (f32x2){GELU_C3, GELU_C3}; q = q * a + (f32x2){GELU_C2, GELU_C2};
    q = q * a + (f32x2){GELU_C1, GELU_C1}; q = q * a + (f32x2){GELU_C0, GELU_C0};
    const f32x2 e = {__builtin_amdgcn_exp2f(q[0]), __builtin_amdgcn_exp2f(q[1])};
    return __builtin_elementwise_max(v, (f32x2){0.f, 0.f}) - av * e;
}
__device__ __forceinline__ float row16_sum(float v) {
    v += __builtin_bit_cast(float, __builtin_amdgcn_update_dpp(0, __builtin_bit_cast(int, v), 0x128, 0xf, 0xf, false));
    v += __builtin_bit_cast(float, __builtin_amdgcn_update_dpp(0, __builtin_bit_cast(int, v), 0x124, 0xf, 0xf, false));
    v += __builtin_bit_cast(float, __builtin_amdgcn_update_dpp(0, __builtin_bit_cast(int, v), 0x122, 0xf, 0xf, false));
    v += __builtin_bit_cast(float, __builtin_amdgcn_update_dpp(0, __builtin_bit_cast(int, v), 0x121, 0xf, 0xf, false));
    return v;
}
__device__ __forceinline__ float wave_sum(float v) {
#pragma unroll
    for (int o = 32; o >= 1; o >>= 1) v += __shfl_xor(v, o);
    return v;
}

template <bool PERM_IN = false>
__device__ __forceinline__ void transpose_convert(const float* __restrict__ W, bf16_t* __restrict__ Wt, int K, int N, int Npad, char* smem, int vb0 = 0) {
    float* tile = (float*)smem;
    const int tk = K / 64, tn = Npad / 64, ntile = tk * tn;
    const int tid = VTID;
    if (VBID < vb0) return;
    for (int tl = VBID - vb0; tl < ntile; tl += VGRID - vb0) {
        const int k0 = (tl % tk) * 64, n0 = (tl / tk) * 64;
        const int c = tid & 63, r0 = tid >> 6;
        int nd = n0;
        if (PERM_IN) { if (n0 >= 1024 && n0 < 1536) nd = n0 + 1024; else if (n0 >= 1536 && n0 < 2048) nd = n0 - 512; else if (n0 >= 2048 && n0 < 2560) nd = n0 + 512; else if (n0 >= 2560 && n0 < 3072) nd = n0 - 1024; }
#pragma unroll
        for (int i = 0; i < 16; ++i) {
            const int r = r0 + 4 * i;
            const float v = (n0 + c < N) ? W[(size_t)(k0 + r) * N + n0 + c] : 0.f;
            tile[c * 65 + r] = v;
        }
        __syncthreads();
#pragma unroll
        for (int i = 0; i < 16; ++i) {
            const int n = r0 + 4 * i;
            Wt[(size_t)(nd + n) * K + k0 + c] = f2bf(tile[n * 65 + c]);
        }
        __syncthreads();
    }
}
__device__ __forceinline__ void quantize_tables_static(const Params& p, int vb0 = 0) {
    const int lane = VTID & 63, wid = VTID >> 6;
    if (VBID < vb0) return;
    for (unsigned task = (unsigned)(VBID - vb0); task < 512u; task += (unsigned)(VGRID - vb0)) {
        const bool isv = task >= 256u;
        const int r0 = (int)(task & 255u) * 128 + wid * 32;
        const float* src = isv ? p.peer_v : p.peer_u;
        unsigned char* recs = p.ws + OFF_UT;
        _Float16* sct = (_Float16*)(p.ws + OFF_USC);
        f32x4 vnx[4];
        {
            const float* x0 = src + (size_t)r0 * 1024 + lane * 16;
#pragma unroll
            for (int i = 0; i < 4; ++i) vnx[i] = *(const f32x4*)(x0 + i * 4);
        }
        for (int rr = 0; rr < 32; ++rr) {
            const int r = r0 + rr;
            f32x4 v[4]; float aml = 0.f;
#pragma unroll
            for (int i = 0; i < 4; ++i) {
                v[i] = vnx[i];
                aml = fmaxf(aml, fmaxf(fmaxf(fabsf(v[i][0]), fabsf(v[i][1])), fmaxf(fabsf(v[i][2]), fabsf(v[i][3]))));
            }
            if (rr + 1 < 32) {
                const float* xn = src + (size_t)(r + 1) * 1024 + lane * 16;
#pragma unroll
                for (int i = 0; i < 4; ++i) vnx[i] = *(const f32x4*)(xn + i * 4);
            }
#pragma unroll
            for (int o = 32; o >= 1; o >>= 1) aml = fmaxf(aml, __shfl_xor(aml, o));
            float ssq = 0.f;
#pragma unroll
            for (int i = 0; i < 4; ++i) ssq += (v[i][0] * v[i][0] + v[i][1] * v[i][1]) + (v[i][2] * v[i][2] + v[i][3] * v[i][3]);
            ssq = wave_sum(ssq);
            const float gmax = aml * (1.002f / 7.5f);
            const _Float16 hs = (_Float16)fminf(fmaxf(0.34f * sqrtf(ssq * (1.0f / 1024.0f)), 0.5f * gmax), gmax);
            const float gs_ = (float)hs, gi_ = gs_ > 0.f ? 1.0f / gs_ : 0.f;
            unsigned wd[2]; const int sgn = isv ? 0 : 8;
#pragma unroll
            for (int dd = 0; dd < 2; ++dd) {
                unsigned wv = 0;
#pragma unroll
                for (int b = 0; b < 4; ++b) {
                    const int qa = min(15, max(0, __float2int_rn(v[2 * dd][b] * gi_ + 7.5f)));
                    const int qb = min(15, max(0, __float2int_rn(v[2 * dd + 1][b] * gi_ + 7.5f)));
                    wv |= ((unsigned)(qa ^ sgn) | ((unsigned)(qb ^ sgn) << 4)) << (8 * b);
                }
                wd[dd] = wv;
            }
            unsigned char* rec = recs + (size_t)r * 1024;
            *(uint2*)(rec + (isv ? 512 : 0) + lane * 8) = make_uint2(wd[0], wd[1]);
            if (lane == 0) sct[(size_t)r * 2 + (isv ? 1 : 0)] = (_Float16)gs_;
        }
    }
}
__device__ __forceinline__ void rmsnorm_rows(const float* __restrict__ X, const float* __restrict__ g, bf16_t* __restrict__ Hout) {
    const int lane = VTID & 63, wid = VTID >> 6;
    const int gw = VBID * 4 + wid, nw = VGRID * 4;
    for (int t = gw; t < T; t += nw) {
        const float* xr = X + (size_t)t * D;
        float4 v[4]; float ss = 0.f;
#pragma unroll
        for (int i = 0; i < 4; ++i) { v[i] = *(const float4*)(xr + i * 256 + lane * 4); ss += v[i].x * v[i].x + v[i].y * v[i].y + v[i].z * v[i].z + v[i].w * v[i].w; }
        ss = wave_sum(ss);
        const float rstd = rsqrtf(ss * (1.0f / D) + EPS);
#pragma unroll
        for (int i = 0; i < 4; ++i) {
            const float4 gg = *(const float4*)(g + i * 256 + lane * 4);
            uint2 o; o.x = pack2(v[i].x * rstd * gg.x, v[i].y * rstd * gg.y); o.y = pack2(v[i].z * rstd * gg.z, v[i].w * rstd * gg.w);
            *(uint2*)(Hout + (size_t)t * D + i * 256 + lane * 4) = o;
        }
    }
}

__device__ __forceinline__ void store_bf16x4(bf16_t* p, f32x4 v) { uint2 o; o.x = pack2(v[0], v[1]); o.y = pack2(v[2], v[3]); *(uint2*)p = o; }

#define G8_LAS __attribute__((address_space(3)))
namespace g8 {
constexpr int BM = 256, BK = 64, HALF = 128, HTB = HALF * BK * 2, NXCD = 8, WGM = 8;
__device__ __forceinline__ int lds_byte(int r, int c) { const int st = (r >> 4) * 2 + (c >> 5), rr = r & 15, cc = c & 31, ob = rr * 64 + cc * 2; return st * 1024 + (ob ^ (((ob >> 9) & 1) << 5)); }
__device__ __forceinline__ void stage_rc(int b, int& R, int& C) { const int st = b / 1024, sb = b % 1024, swz = sb ^ (((sb >> 9) & 1) << 5); R = (st >> 1) * 16 + swz / 64; C = (st & 1) * 32 + (swz % 64) / 2; }
__device__ __forceinline__ int perm32(int rho) { const int n = rho >> 4, i = rho & 15; return 8 * (i >> 2) + 4 * n + (i & 3); }
struct Unit { int pm, pn; };
struct Gemm { const bf16_t* A0; const bf16_t* A1; int lda, ksplit; const bf16_t* Bt; int M, N, K; };
struct StaticOrder {
    int nM, nN, nwg, G, c;
    __device__ __forceinline__ void init(int M, int N, int G_, int c_) { nM = M / BM; nN = N / BM; nwg = nM * nN; G = G_; c = c_; }
    __device__ __forceinline__ bool next(int i, Unit& u) const {
        const int L = i * G + c; if (L >= nwg) return false;
        int wgid = L; { const int q = nwg / NXCD, r = nwg % NXCD, xcd = wgid % NXCD, off = wgid / NXCD; wgid = (xcd < r ? xcd * (q + 1) : r * (q + 1) + (xcd - r) * q) + off; }
        const int nig = WGM * nN, gid = wgid / nig, fm = gid * WGM, gsz = (nM - fm) < WGM ? (nM - fm) : WGM;
        u.pm = fm + ((wgid % nig) % gsz); u.pn = (wgid % nig) / gsz; return true;
    }
};
template <class Epi>
__device__ __forceinline__ void gemm_phase(G8_LAS unsigned char* lds, const Gemm g, const StaticOrder& S, const Epi& E) {
    const int tid = threadIdx.x, wid = __builtin_amdgcn_readfirstlane(tid >> 6), lane = tid & 63, wr = wid >> 2, wc = wid & 3, fr = lane & 15, fq = lane >> 4;
    const int K = g.K, nt = K / BK, lda = g.lda;
    unsigned voffA[2], voffB[2];
#pragma unroll
    for (int i = 0; i < 2; ++i) { int R, C; stage_rc(tid * 16 + i * 8192, R, C); const int Rb = (R & ~31) + perm32(R & 31);
        voffA[i] = (unsigned)(R * lda + C) * 2u; voffB[i] = (unsigned)(Rb * K + C) * 2u; }
    const size_t hstepA = (size_t)HALF * lda * 2, hstepB = (size_t)HALF * K * 2;
    const unsigned ldsw = (unsigned)wid * 1024u;
    const int aoff = lds_byte(wr * 64 + fr, fq * 8), boff = lds_byte(wc * 32 + fr, fq * 8);
    auto aptr = [&](int pm, int kt) -> const char* { const int kb = kt * BK; const bf16_t* b = kb < g.ksplit ? g.A0 + kb : g.A1 + (kb - g.ksplit); return (const char*)b + (size_t)pm * 2 * hstepA; };
    auto bptr = [&](int pn, int kt) -> const char* { return (const char*)(g.Bt + kt * BK) + (size_t)pn * 2 * hstepB; };
#define G8_SA(b, h) (((b) * 2 + (h)) * HTB)
#define G8_SB(b, h) ((4 + (b) * 2 + (h)) * HTB)
#define G8_STAGE(bufoff, gbase, voff) do { _Pragma("unroll") for (int _i = 0; _i < 2; ++_i) \
        __builtin_amdgcn_global_load_lds((const unsigned*)((const char*)(gbase) + (voff)[_i]), (G8_LAS unsigned*)(lds + (bufoff) + ldsw + _i * 8192), 16, 0, 0); } while (0)
#define G8_LDA(dst, b, h) do { _Pragma("unroll") for (int m = 0; m < 4; ++m) _Pragma("unroll") for (int k = 0; k < 2; ++k) dst[m][k] = *(const G8_LAS bf16x8*)(lds + G8_SA(b, h) + aoff + m * 2048 + k * 1024); } while (0)
#define G8_LDB(dst, b, h) do { _Pragma("unroll") for (int n = 0; n < 2; ++n) _Pragma("unroll") for (int k = 0; k < 2; ++k) dst[n][k] = *(const G8_LAS bf16x8*)(lds + G8_SB(b, h) + boff + n * 2048 + k * 1024); } while (0)
#define G8_MMA(ai, bj, At, Bt) do { __builtin_amdgcn_s_setprio(1); _Pragma("unroll") for (int m = 0; m < 4; ++m) _Pragma("unroll") for (int n = 0; n < 2; ++n) _Pragma("unroll") for (int k = 0; k < 2; ++k) \
        acc[ai][bj][m][n] = __builtin_amdgcn_mfma_f32_16x16x32_bf16(Bt[n][k], At[m][k], acc[ai][bj][m][n], 0, 0, 0); __builtin_amdgcn_s_setprio(0); } while (0)
#define G8_WAIT_V(n) asm volatile("s_waitcnt vmcnt(" #n ")" ::: "memory")
#define G8_WAIT_L(n) asm volatile("s_waitcnt lgkmcnt(" #n ")" ::: "memory")
#define G8_BAR __builtin_amdgcn_s_barrier()
#define G8_SCHED __builtin_amdgcn_sched_barrier(0)
    Unit cur, nxt; int ui = 0;
    if (!S.next(0, cur)) return;
    f32x4 acc[2][2][4][2];
#pragma unroll
    for (int a = 0; a < 2; ++a)
#pragma unroll
        for (int b = 0; b < 2; ++b)
#pragma unroll
            for (int m = 0; m < 4; ++m)
#pragma unroll
                for (int n = 0; n < 2; ++n) acc[a][b][m][n] = (f32x4){0.f, 0.f, 0.f, 0.f};
    bf16x8 At[4][2], B0[2][2], B1[2][2];
    {
        const char* cA = aptr(cur.pm, 0); const char* cB = bptr(cur.pn, 0); const char* cA1 = aptr(cur.pm, 1); const char* cB1 = bptr(cur.pn, 1);
        G8_STAGE(G8_SB(0, 0), cB, voffB); G8_STAGE(G8_SB(0, 1), cB + hstepB, voffB); G8_STAGE(G8_SA(0, 0), cA, voffA); G8_STAGE(G8_SA(0, 1), cA + hstepA, voffA);
        if (wr == 1) G8_BAR;
        G8_WAIT_V(2); G8_BAR;
        G8_STAGE(G8_SB(1, 0), cB1, voffB); G8_STAGE(G8_SA(1, 0), cA1, voffA); G8_STAGE(G8_SB(1, 1), cB1 + hstepB, voffB);
        G8_WAIT_V(6); G8_BAR;
    }
    for (;;) {
        const bool has_next = S.next(ui + 1, nxt);
        const int npm = has_next ? nxt.pm : cur.pm, npn = has_next ? nxt.pn : cur.pn;
        for (int t = 0; t < nt; t += 2) {
            const bool last = (t == nt - 2);
            const char* a1 = aptr(cur.pm, t + 1);
            const char* a2 = last ? aptr(npm, 0) : aptr(cur.pm, t + 2); const char* b2 = last ? bptr(npn, 0) : bptr(cur.pn, t + 2);
            const char* a3 = last ? aptr(npm, 1) : aptr(cur.pm, t + 3); const char* b3 = last ? bptr(npn, 1) : bptr(cur.pn, t + 3);
            G8_LDB(B0, 0, 0); G8_LDB(B1, 0, 1); G8_SCHED; G8_LDA(At, 0, 0); G8_STAGE(G8_SA(1, 1), a1 + hstepA, voffA);
            G8_WAIT_V(8); G8_WAIT_L(0); G8_BAR; G8_MMA(0, 0, At, B0); G8_MMA(0, 1, At, B1); G8_BAR; G8_SCHED;
            G8_LDA(At, 0, 1); G8_STAGE(G8_SB(0, 0), b2, voffB); G8_STAGE(G8_SB(0, 1), b2 + hstepB, voffB); G8_STAGE(G8_SA(0, 0), a2, voffA);
            G8_WAIT_V(8); G8_WAIT_L(0); G8_BAR; G8_MMA(1, 0, At, B0); G8_MMA(1, 1, At, B1); G8_BAR; G8_SCHED;
            G8_LDB(B0, 1, 0); G8_LDB(B1, 1, 1); G8_SCHED; G8_LDA(At, 1, 0); G8_STAGE(G8_SA(0, 1), a2 + hstepA, voffA);
            G8_WAIT_V(8); G8_WAIT_L(0); G8_BAR; G8_MMA(0, 0, At, B0); G8_MMA(0, 1, At, B1); G8_BAR; G8_SCHED;
            G8_LDA(At, 1, 1); G8_STAGE(G8_SB(1, 0), b3, voffB); G8_STAGE(G8_SB(1, 1), b3 + hstepB, voffB); G8_STAGE(G8_SA(1, 0), a3, voffA);
            G8_WAIT_V(8); G8_WAIT_L(0); G8_BAR; G8_MMA(1, 0, At, B0); G8_MMA(1, 1, At, B1); G8_BAR; G8_SCHED;
        }
        if (wr == 0) G8_BAR;
        E(acc, cur, wr, wc, fr, fq);
        if (!has_next) break;
#pragma unroll
        for (int a = 0; a < 2; ++a)
#pragma unroll
            for (int b = 0; b < 2; ++b)
#pragma unroll
                for (int m = 0; m < 4; ++m)
#pragma unroll
                    for (int n = 0; n < 2; ++n) acc[a][b][m][n] = (f32x4){0.f, 0.f, 0.f, 0.f};
        cur = nxt; ++ui;
        if (wr == 1) G8_BAR;
    }
    G8_WAIT_V(0);
    G8_BAR;
#undef G8_SA
#undef G8_SB
#undef G8_STAGE
#undef G8_LDA
#undef G8_LDB
#undef G8_MMA
#undef G8_WAIT_V
#undef G8_WAIT_L
#undef G8_BAR
#undef G8_SCHED
}
struct EpiResid {
    const float* R32; bf16_t* S; float* SSQP;
    __device__ __forceinline__ void operator()(const f32x4 (&acc)[2][2][4][2], const Unit& u, int wr, int wc, int fr, int fq) const {
#pragma unroll
        for (int ai = 0; ai < 2; ++ai)
#pragma unroll
            for (int m = 0; m < 4; ++m) {
                const int row = u.pm * 256 + ai * 128 + wr * 64 + m * 16 + fr;
                const size_t o = (size_t)row * 1024 + u.pn * 256 + wc * 32 + fq * 8;
                float ss = 0.f;
#pragma unroll
                for (int bj = 0; bj < 2; ++bj) {
                    f32x4 a, b;
                    if (R32) { a = *(const f32x4*)(R32 + o + bj * 128); b = *(const f32x4*)(R32 + o + bj * 128 + 4); }
                    else { const u32x4 r = *(const u32x4*)(S + o + bj * 128); a = (f32x4){lo2f(r[0]), hi2f(r[0]), lo2f(r[1]), hi2f(r[1])}; b = (f32x4){lo2f(r[2]), hi2f(r[2]), lo2f(r[3]), hi2f(r[3])}; }
                    a += acc[ai][bj][m][0]; b += acc[ai][bj][m][1];
                    ss += a[0] * a[0] + a[1] * a[1] + a[2] * a[2] + a[3] * a[3] + b[0] * b[0] + b[1] * b[1] + b[2] * b[2] + b[3] * b[3];
                    uint4 w; w.x = pack2(a[0], a[1]); w.y = pack2(a[2], a[3]); w.z = pack2(b[0], b[1]); w.w = pack2(b[2], b[3]);
                    *(uint4*)(S + o + bj * 128) = w;
                }
                ss += __shfl_xor(ss, 16); ss += __shfl_xor(ss, 32);
                if (fq == 0) SSQP[(size_t)row * 32 + u.pn * 4 + wc] = ss;
            }
    }
};
struct EpiCinUS {
    bf16_t* U; const bf16_t* VT; const float* SSQ; const float* Wsp; const float* bsp; const float* vnorm; G8_LAS unsigned char* L;
    __device__ __forceinline__ void operator()(const f32x4 (&acc)[2][2][4][2], const Unit& u, int wr, int wc, int fr, int fq) const {
        const int tid = threadIdx.x, g = u.pn;
        G8_LAS float* RS = (G8_LAS float*)(L + 24576);
        unsigned gu[2][2][4][4];
#pragma unroll
        for (int ai = 0; ai < 2; ++ai)
#pragma unroll
            for (int bj = 0; bj < 2; ++bj)
#pragma unroll
                for (int m = 0; m < 4; ++m) {
                    const f32x4 a = acc[ai][bj][m][0], b = acc[ai][bj][m][1];
                    const f32x2 g0 = gelu_exact2((f32x2){a[0], a[1]}), g1 = gelu_exact2((f32x2){a[2], a[3]}), g2 = gelu_exact2((f32x2){b[0], b[1]}), g3 = gelu_exact2((f32x2){b[2], b[3]});
                    gu[ai][bj][m][0] = pack2(g0[0], g0[1]); gu[ai][bj][m][1] = pack2(g1[0], g1[1]); gu[ai][bj][m][2] = pack2(g2[0], g2[1]); gu[ai][bj][m][3] = pack2(g3[0], g3[1]);
                }
        if (tid < 256) {
            const float* sp = SSQ + (size_t)(u.pm * 256 + tid) * 32;
            f32x4 s4 = *(const f32x4*)sp;
#pragma unroll
            for (int i = 1; i < 8; ++i) s4 += *(const f32x4*)(sp + 4 * i);
            RS[tid] = rsqrtf(((s4[0] + s4[1]) + (s4[2] + s4[3])) * (1.0f / 2048.0f) + EPS);
        }
        __syncthreads();
#pragma unroll
        for (int ai = 0; ai < 2; ++ai) {
            const int chunk = u.pm * 2 + ai;
            {
                const int t1 = tid >> 3, c1 = tid & 7;
#pragma unroll
                for (int part = 0; part < 3; ++part) {
                    const int t = part == 0 ? t1 : 64 + ((tid + (part - 1) * 512) >> 4), ch = part == 0 ? c1 : ((tid + (part - 1) * 512) & 15), s0 = ch * 8;
                    const float* wp = Wsp + (size_t)(g * 128 + t) * 128 + s0;
                    const f32x4 w0 = *(const f32x4*)wp, w1 = *(const f32x4*)(wp + 4);
                    const f32x4 r0 = *(const G8_LAS f32x4*)(RS + ai * 128 + s0), r1 = *(const G8_LAS f32x4*)(RS + ai * 128 + s0 + 4);
                    float v[8];
#pragma unroll
                    for (int j = 0; j < 4; ++j) { v[j] = (s0 + j <= t) ? w0[j] * r0[j] : 0.f; v[4 + j] = (s0 + 4 + j <= t) ? w1[j] * r1[j] : 0.f; }
                    u32x4 o; o.x = pack2(v[0], v[1]); o.y = pack2(v[2], v[3]); o.z = pack2(v[4], v[5]); o.w = pack2(v[6], v[7]);
                    const int off = part == 0 ? t * 128 + ((ch ^ (t & 7)) << 4) : 8192 + (t - 64) * 256 + ((ch ^ (t & 7)) << 4);
                    *(G8_LAS u32x4*)(L + off) = o;
                }
            }
            __syncthreads();
            float bias[4];
#pragma unroll
            for (int m = 0; m < 4; ++m) bias[m] = bsp[g * 128 + wr * 64 + m * 16 + fr];
#pragma unroll
            for (int bj = 0; bj < 2; ++bj) {
                f32x4 mac[4][2];
#pragma unroll
                for (int m = 0; m < 4; ++m)
#pragma unroll
                    for (int n = 0; n < 2; ++n) mac[m][n] = (f32x4){0.f, 0.f, 0.f, 0.f};
                const int cb = u.pn * 256 + bj * 128 + wc * 32;
                const bf16_t* vrow0 = VT + ((size_t)chunk * 2048 + cb + perm32(fr)) * 128 + fq * 8;
                const bf16_t* vrow1 = VT + ((size_t)chunk * 2048 + cb + perm32(16 + fr)) * 128 + fq * 8;
                bf16x8 bf0[4], bf1[4];
#pragma unroll
                for (int kk = 0; kk < 4; ++kk) { if (kk < 2 || wr == 1) { bf0[kk] = *(const bf16x8*)(vrow0 + kk * 32); bf1[kk] = *(const bf16x8*)(vrow1 + kk * 32); } }
#pragma unroll
                for (int kk = 0; kk < 4; ++kk) {
                    if (kk < 2 || wr == 1) {
                        bf16x8 af[4];
#pragma unroll
                        for (int m = 0; m < 4; ++m) {
                            const int t = wr * 64 + m * 16 + fr, chn = kk * 4 + fq;
                            const int off = wr == 0 ? t * 128 + ((chn ^ (t & 7)) << 4) : 8192 + (t - 64) * 256 + ((chn ^ (t & 7)) << 4);
                            af[m] = *(const G8_LAS bf16x8*)(L + off);
                        }
#pragma unroll
                        for (int m = 0; m < 4; ++m) {
                            mac[m][0] = __builtin_amdgcn_mfma_f32_16x16x32_bf16(bf0[kk], af[m], mac[m][0], 0, 0, 0);
                            mac[m][1] = __builtin_amdgcn_mfma_f32_16x16x32_bf16(bf1[kk], af[m], mac[m][1], 0, 0, 0);
                        }
                    }
                }
                const f32x4 vn0 = *(const f32x4*)(vnorm + cb + fq * 8), vn1 = *(const f32x4*)(vnorm + cb + fq * 8 + 4);
#pragma unroll
                for (int m = 0; m < 4; ++m) {
                    const f32x4 x0 = vn0 * mac[m][0] + bias[m], x1 = vn1 * mac[m][1] + bias[m];
                    const unsigned q0 = gu[ai][bj][m][0], q1 = gu[ai][bj][m][1], q2 = gu[ai][bj][m][2], q3 = gu[ai][bj][m][3];
                    uint4 o; o.x = pack2(lo2f(q0) * x0[0], hi2f(q0) * x0[1]); o.y = pack2(lo2f(q1) * x0[2], hi2f(q1) * x0[3]); o.z = pack2(lo2f(q2) * x1[0], hi2f(q2) * x1[1]); o.w = pack2(lo2f(q3) * x1[2], hi2f(q3) * x1[3]);
                    *(uint4*)(U + (size_t)(u.pm * 256 + ai * 128 + wr * 64 + m * 16 + fr) * 2048 + cb + fq * 8) = o;
                }
            }
            __syncthreads();
        }
    }
};
struct EpiCinV {
    bf16_t* VT; float* SSQ;
    __device__ __forceinline__ void operator()(const f32x4 (&acc)[2][2][4][2], const Unit& u, int wr, int wc, int fr, int fq) const {
#pragma unroll
        for (int ai = 0; ai < 2; ++ai) {
            float ss[16];
#pragma unroll
            for (int i = 0; i < 16; ++i) ss[i] = 0.f;
#pragma unroll
            for (int m = 0; m < 4; ++m) {
                const int c = u.pm * 256 + ai * 128 + wr * 64 + m * 16 + fr;
#pragma unroll
                for (int bj = 0; bj < 2; ++bj) {
                    float g[8];
#pragma unroll
                    for (int n = 0; n < 2; ++n)
#pragma unroll
                        for (int r = 0; r < 4; r += 2) {
                            const f32x2 x = gelu_exact2((f32x2){acc[ai][bj][m][n][r], acc[ai][bj][m][n][r + 1]});
                            g[n * 4 + r] = x[0]; g[n * 4 + r + 1] = x[1]; ss[bj * 8 + n * 4 + r] += x[0] * x[0]; ss[bj * 8 + n * 4 + r + 1] += x[1] * x[1];
                        }
                    uint4 o; o.x = pack2(g[0], g[1]); o.y = pack2(g[2], g[3]); o.z = pack2(g[4], g[5]); o.w = pack2(g[6], g[7]);
                    *(uint4*)(VT + ((size_t)(u.pn * 2 + bj) * 2048 + c) * 128 + wc * 32 + fq * 8) = o;
                }
            }
            float mine = 0.f;
#pragma unroll
            for (int i = 0; i < 16; ++i) { const float s = row16_sum(ss[i]); mine = (fr == i) ? s : mine; }
            const int tok = u.pn * 256 + (fr >> 3) * 128 + wc * 32 + fq * 8 + (fr & 7);
            SSQ[(size_t)tok * 32 + u.pm * 4 + ai * 2 + wr] = mine;
        }
    }
};
struct EpiInN {
    bf16_t* R;
    __device__ __forceinline__ void operator()(const f32x4 (&acc)[2][2][4][2], const Unit& u, int wr, int wc, int fr, int fq) const {
        bf16_t* base; int pitch; float sc = 1.0f;
        if (u.pn < 2) { base = R + R_QSB + u.pn * 256; pitch = 512; sc = 0.125f; }
        else if (u.pn < 4) { base = R + R_KSB + (u.pn - 2) * 256; pitch = 512; }
        else if (u.pn == 4) { base = R + R_QG; pitch = 256; }
        else if (u.pn == 5) { base = R + R_KG; pitch = 256; }
        else { base = R + R_GG + (u.pn - 6) * 256; pitch = 512; }
#pragma unroll
        for (int ai = 0; ai < 2; ++ai)
#pragma unroll
            for (int m = 0; m < 4; ++m) {
                bf16_t* rp = base + (size_t)(u.pm * 256 + ai * 128 + wr * 64 + m * 16 + fr) * pitch + wc * 32 + fq * 8;
#pragma unroll
                for (int bj = 0; bj < 2; ++bj) {
                    f32x4 a = acc[ai][bj][m][0] * sc, b = acc[ai][bj][m][1] * sc;
                    if (u.pn >= 6) {
#pragma unroll
                        for (int r = 0; r < 4; ++r) { a[r] = a[r] * __builtin_amdgcn_rcpf(1.0f + __expf(-a[r])); b[r] = b[r] * __builtin_amdgcn_rcpf(1.0f + __expf(-b[r])); }
                    }
                    uint4 o; o.x = pack2(a[0], a[1]); o.y = pack2(a[2], a[3]); o.z = pack2(b[0], b[1]); o.w = pack2(b[2], b[3]);
                    *(uint4*)(rp + bj * 128) = o;
                }
            }
    }
};
struct EpiInT {
    bf16_t* R;
    __device__ __forceinline__ void operator()(const f32x4 (&acc)[2][2][4][2], const Unit& u, int wr, int wc, int fr, int fq) const {
#pragma unroll
        for (int ai = 0; ai < 2; ++ai)
#pragma unroll
            for (int m = 0; m < 4; ++m) {
                const int c = u.pm * 256 + ai * 128 + wr * 64 + m * 16 + fr;
#pragma unroll
                for (int bj = 0; bj < 2; ++bj) {
                    const int t = u.pn * 256 + bj * 128 + wc * 32 + fq * 8, b = t >> 11, s = t & 2047;
                    bf16_t* dst;
                    if (c < 512) dst = R + R_VTSB + ((size_t)((b * 8 + (c >> 6)) * 64 + (c & 63))) * 2048 + s;
                    else { const int c2 = c - 512; dst = R + R_VTG + ((size_t)((b * 4 + (c2 >> 7)) * 128 + (c2 & 127))) * 2048 + s; }
                    const f32x4 a = acc[ai][bj][m][0], bb = acc[ai][bj][m][1];
                    uint4 o; o.x = pack2(a[0], a[1]); o.y = pack2(a[2], a[3]); o.z = pack2(bb[0], bb[1]); o.w = pack2(bb[2], bb[3]);
                    *(uint4*)dst = o;
                }
            }
    }
};
}
__device__ __forceinline__ void phase_gemm_resid8(const bf16_t* A0, const bf16_t* A1, int lda, int ksplit, const bf16_t* Bt, int K, const float* R32, bf16_t* Sres, float* SSQP, char* smem_phys) {
    g8::Gemm g{A0, A1, lda, ksplit, Bt, T, 1024, K};
    g8::StaticOrder S; S.init(T, 1024, (int)gridDim.x, (int)blockIdx.x);
    g8::EpiResid E{R32, Sres, SSQP};
    g8::gemm_phase<g8::EpiResid>((G8_LAS unsigned char*)smem_phys, g, S, E);
}

__device__ __forceinline__ void phase_gemm_cin8_v(const Params& p, char* smem_phys) {
    const bf16_t* H = (const bf16_t*)(p.ws + OFF_H); const bf16_t* W = (const bf16_t*)(p.ws + OFF_WT_CIN);
    bf16_t* U = (bf16_t*)(p.ws + OFF_REGION); bf16_t* VT = U + (size_t)T * 2048; float* SSQ = (float*)(p.ws + OFF_SSQ);
    const bf16_t* Wv = W + (size_t)2048 * 1024;
    g8::Gemm g{Wv, Wv, 1024, 1024, H, 2048, T, 1024};
    g8::StaticOrder S; S.init(2048, T, (int)gridDim.x, (int)blockIdx.x);
    g8::EpiCinV E{VT, SSQ};
    g8::gemm_phase<g8::EpiCinV>((G8_LAS unsigned char*)smem_phys, g, S, E);
}
__device__ __forceinline__ void phase_gemm_cin8_u(const Params& p, char* smem_phys) {
    const bf16_t* H = (const bf16_t*)(p.ws + OFF_H); const bf16_t* W = (const bf16_t*)(p.ws + OFF_WT_CIN);
    bf16_t* U = (bf16_t*)(p.ws + OFF_REGION); bf16_t* VT = U + (size_t)T * 2048; float* SSQ = (float*)(p.ws + OFF_SSQ);
    g8::Gemm g{H, H, 1024, 1024, W, T, 2048, 1024};
    g8::StaticOrder S; S.init(T, 2048, (int)gridDim.x, (int)blockIdx.x);
    g8::EpiCinUS E{U, VT, SSQ, p.c_w_spatial, p.c_b_spatial, p.c_v_norm, (G8_LAS unsigned char*)(smem_phys + 131072)};
    g8::gemm_phase<g8::EpiCinUS>((G8_LAS unsigned char*)smem_phys, g, S, E);
}
__device__ __forceinline__ void phase_gemm_in8(const Params& p, char* smem_phys) {
    const bf16_t* H = (const bf16_t*)(p.ws + OFF_H); const bf16_t* W = (const bf16_t*)(p.ws + OFF_WT_IN);
    bf16_t* R = (bf16_t*)(p.ws + OFF_REGION);
    {
        g8::Gemm g{H, H, 1024, 1024, W, T, 2048, 1024};
        g8::StaticOrder S; S.init(T, 2048, (int)gridDim.x, (int)blockIdx.x);
        g8::EpiInN E{R};
        g8::gemm_phase<g8::EpiInN>((G8_LAS unsigned char*)smem_phys, g, S, E);
    }
    {
        const bf16_t* Wv = W + (size_t)2048 * 1024;
        g8::Gemm g{Wv, Wv, 1024, 1024, H, 1024, T, 1024};
        g8::StaticOrder S; S.init(1024, T, (int)gridDim.x, (int)blockIdx.x);
        g8::EpiInT E{R};
        g8::gemm_phase<g8::EpiInT>((G8_LAS unsigned char*)smem_phys, g, S, E);
    }
    {
        const int lane = threadIdx.x & 63, wid = threadIdx.x >> 6, fr = lane & 15, fq = lane >> 4;
        float* ALR = (float*)(R + R_ALR);
        for (int task = (int)blockIdx.x * 8 + wid; task < T / 16; task += (int)gridDim.x * 8) {
            const bf16_t* a = H + (size_t)(task * 16 + fr) * 1024 + fq * 8; const bf16_t* w = W + (size_t)(3072 + fr) * 1024 + fq * 8;
            f32x4 acc = (f32x4){0.f, 0.f, 0.f, 0.f};
#pragma unroll 8
            for (int kk = 0; kk < 32; ++kk) {
                const bf16x8 af = *(const bf16x8*)(a + kk * 32), wf = *(const bf16x8*)(w + kk * 32);
                acc = __builtin_amdgcn_mfma_f32_16x16x32_bf16(wf, af, acc, 0, 0, 0);
            }
            *(f32x4*)(ALR + (size_t)(task * 16 + fr) * 16 + fq * 4) = acc;
        }
    }
}


typedef float f32x16 __attribute__((ext_vector_type(16)));
__device__ __forceinline__ void sb_fast(const Params& p, char* smem, unsigned* ctr) {
    bf16_t* R = (bf16_t*)(p.ws + OFF_REGION);
    char* KT = smem; char* VTt = smem + 8192;
    volatile int* flags = (volatile int*)(smem + 32768); volatile unsigned* slot = (volatile unsigned*)(smem + 32832);
    const int tid = threadIdx.x, lane = tid & 63, w = tid >> 6, r31 = lane & 31, h = lane >> 5;
    for (;;) {
        __syncthreads();
        if (tid == 0) *slot = atomicAdd(ctr, 1u);
        __syncthreads();
        const unsigned task = *slot;
        if (task >= 1024u) break;
        const int qblk = 7 - (int)(task >> 7), bh = task & 127, b = bh >> 3, hh = bh & 7;
        const int q0 = qblk * 256, qbase = q0 + 32 * w;
        bf16_t* qrow = R + R_QSB + (size_t)(b * 2048 + qbase + r31) * 512 + hh * 64;
        bf16x8 qf[4];
#pragma unroll
        for (int kk = 0; kk < 4; ++kk) qf[kk] = *(const bf16x8*)(qrow + 16 * kk + 8 * h);
        f32x16 oacc[2];
#pragma unroll
        for (int nt = 0; nt < 2; ++nt)
#pragma unroll
            for (int i = 0; i < 16; ++i) oacc[nt][i] = 0.f;
        float Rr = 1.0f;
        const int t = qbase + r31;
        for (int kt = q0 / 64 + 3; kt >= 0; --kt) {
            __syncthreads();
            { const int wd = __all(Rr == 0.f); if (lane == 0) flags[w] = wd; }
            __syncthreads();
            if (flags[0] & flags[1] & flags[2] & flags[3] & flags[4] & flags[5] & flags[6] & flags[7]) break;
            const int s_tile = kt * 64;
            {
                const int c = tid, row = c >> 3, ch = c & 7;
                const u32x4 kv = *(const u32x4*)(R + R_KSB + (size_t)(b * 2048 + s_tile + row) * 512 + hh * 64 + ch * 8);
                const u32x4 vv = *(const u32x4*)(R + R_VTSB + ((size_t)((b * 8 + hh) * 64 + row)) * 2048 + s_tile + ch * 8);
                *(u32x4*)(KT + row * 128 + ((ch ^ (row & 7)) << 4)) = kv;
                *(uint2*)(VTt + row * 136 + ch * 16) = make_uint2(vv[0], vv[1]);
                *(uint2*)(VTt + row * 136 + ch * 16 + 8) = make_uint2(vv[2], vv[3]);
            }
            __syncthreads();
#pragma unroll
            for (int sbk = 1; sbk >= 0; --sbk) {
                const int key_lo = s_tile + 32 * sbk;
                if (key_lo >= qbase + 31) continue;
                if (__all(Rr == 0.f)) continue;
                f32x16 st;
#pragma unroll
                for (int i = 0; i < 16; ++i) st[i] = 0.f;
                const int krow = 32 * sbk + r31;
#pragma unroll
                for (int kk = 0; kk < 4; ++kk) {
                    const bf16x8 kf = *(const bf16x8*)(KT + krow * 128 + (((2 * kk + h) ^ (krow & 7)) << 4));
                    st = __builtin_amdgcn_mfma_f32_32x32x16_bf16(kf, qf[kk], st, 0, 0, 0);
                }
                float a[16], G[4];
                const bool diag = key_lo + 31 >= qbase;
#pragma unroll
                for (int g = 0; g < 4; ++g) {
                    float sg[4], m[4];
#pragma unroll
                    for (int i = 0; i < 4; ++i) {
                        const float z = fmaxf(st[4 * g + i], -80.f);
                        const float ez = __builtin_amdgcn_exp2f(z * -1.4426950409f), sig = __builtin_amdgcn_rcpf(1.0f + ez);
                        sg[i] = sig; m[i] = ez * sig;
                    }
                    if (diag) {
#pragma unroll
                        for (int i = 0; i < 4; ++i) { const bool valid = key_lo + 8 * g + 4 * h + i < t; sg[i] = valid ? sg[i] : 0.f; m[i] = valid ? m[i] : 1.0f; }
                    }
                    const float x2 = m[3], x1 = x2 * m[2], x0 = x1 * m[1];
                    G[g] = x0 * m[0];
                    a[4 * g + 3] = sg[3]; a[4 * g + 2] = sg[2] * x2; a[4 * g + 1] = sg[1] * x1; a[4 * g] = sg[0] * x0;
                }
                float Go[4], P[4];
#pragma unroll
                for (int g = 0; g < 4; ++g) { Go[g] = __shfl_xor(G[g], 32); P[g] = G[g] * Go[g]; }
                const float c2 = P[3], c1 = c2 * P[2], c0 = c1 * P[1];
                float Tg[4];
                Tg[3] = Rr; Tg[2] = Rr * c2; Tg[1] = Rr * c1; Tg[0] = Rr * c0;
#pragma unroll
                for (int g = 0; g < 4; ++g) {
                    const float tg = (h == 0) ? Tg[g] * Go[g] : Tg[g];
                    a[4 * g] *= tg; a[4 * g + 1] *= tg; a[4 * g + 2] *= tg; a[4 * g + 3] *= tg;
                }
                Rr = Rr * c0 * P[0];
#pragma unroll
                for (int s2 = 0; s2 < 2; ++s2) {
                    union { bf16x8 v; unsigned u[4]; } af;
#pragma unroll
                    for (int j2 = 0; j2 < 4; ++j2) af.u[j2] = pack2(a[8 * s2 + 2 * j2], a[8 * s2 + 2 * j2 + 1]);
#pragma unroll
                    for (int nt = 0; nt < 2; ++nt) {
                        const char* vp = VTt + (32 * nt + r31) * 136 + 64 * sbk + 32 * s2 + 8 * h;
                        union { bf16x8 v; uint2 hh2[2]; } vf;
                        vf.hh2[0] = *(const uint2*)vp; vf.hh2[1] = *(const uint2*)(vp + 16);
                        oacc[nt] = __builtin_amdgcn_mfma_f32_32x32x16_bf16(af.v, vf.v, oacc[nt], 0, 0, 0);
                    }
                }
            }
        }
#pragma unroll
        for (int nt = 0; nt < 2; ++nt)
#pragma unroll
            for (int i = 0; i < 16; ++i) {
                const int qq = (i & 3) + 8 * (i >> 2) + 4 * h;
                R[R_QSB + (size_t)(b * 2048 + qbase + qq) * 512 + hh * 64 + 32 * nt + r31] = f2bf(oacc[nt][i]);
            }
    }
}
__device__ __forceinline__ float log_sigmoid(float x) { return fminf(x, 0.f) - log1pf(__expf(-fabsf(x))); }
__device__ __forceinline__ int swz(int row, int chunk) { return row * 128 + ((chunk ^ (row & 7)) << 4); }
__device__ __forceinline__ void gla_prep(const Params& p, char* smem) {
    bf16_t* R = (bf16_t*)(p.ws + OFF_REGION);
    const float* ALR = (const float*)(R + R_ALR);
    bf16_t* KOTg = R + R_KOT; float* DECg = (float*)(R + R_DEC);
    float* SEG = (float*)smem; float* ALRs = SEG + 256;
    const int tid = VTID, d = tid & 63, w = tid >> 6;
    for (int task = VBID; task < 2048; task += VGRID) {
        const int bh = task >> 5, c = task & 31, b = bh >> 2, hh = bh & 3;
        const size_t rowbase = (size_t)b * 2048 + c * 64;
        unsigned qr[16], kr[16];
#pragma unroll
        for (int i = 0; i < 16; ++i) { const size_t row = rowbase + w * 16 + i; qr[i] = R[R_QG + row * 256 + hh * 64 + d]; kr[i] = R[R_KG + row * 256 + hh * 64 + d]; }
        const f32x4 ar = *(const f32x4*)(ALR + rowbase * 16 + tid * 4);
        float w2r[16];
#pragma unroll
        for (int r = 0; r < 16; ++r) w2r[r] = p.ab_w_alpha2[r * 256 + hh * 64 + d];
        const float b2r = p.ab_b_alpha2[hh * 64 + d];
        __syncthreads();
        *(f32x4*)(ALRs + tid * 4) = ar;
        __syncthreads();
        float cs[16]; float run = 0.f;
#pragma unroll
        for (int i = 0; i < 16; ++i) {
            const float* al = ALRs + (w * 16 + i) * 16;
            float pre = b2r;
#pragma unroll
            for (int r = 0; r < 16; ++r) pre += al[r] * w2r[r];
            run += log_sigmoid(pre) * (1.0f / 16.0f);
            cs[i] = run;
        }
        SEG[w * 64 + d] = run;
        __syncthreads();
        float off = 0.f, tot = 0.f;
#pragma unroll
        for (int w2 = 0; w2 < 4; ++w2) { const float s = SEG[w2 * 64 + d]; tot += s; if (w2 < w) off += s; }
        unsigned kop[8];
#pragma unroll
        for (int i2 = 0; i2 < 8; ++i2) {
            float kov[2];
#pragma unroll
            for (int u = 0; u < 2; ++u) {
                const int i = 2 * i2 + u;
                const float bc = off + cs[i];
                const float kv = bf2f((bf16_t)kr[i]);
                const size_t row = rowbase + w * 16 + i;
                R[R_QG + row * 256 + hh * 64 + d] = f2bf(bf2f((bf16_t)qr[i]) * 0.125f * __expf(bc));
                R[R_KG + row * 256 + hh * 64 + d] = f2bf(kv * __expf(-bc));
                kov[u] = kv * __expf(tot - bc);
            }
            kop[i2] = pack2(kov[0], kov[1]);
        }
        bf16_t* kp = KOTg + ((size_t)task * 64 + d) * 64 + w * 16;
        *(uint4*)kp = make_uint4(kop[0], kop[1], kop[2], kop[3]);
        *(uint4*)(kp + 8) = make_uint4(kop[4], kop[5], kop[6], kop[7]);
        if (w == 0) DECg[(size_t)task * 64 + d] = __expf(tot);
    }
}
__device__ __forceinline__ void gla_scan(const Params& p, char* smem, bool dry = false) {
    bf16_t* R = (bf16_t*)(p.ws + OFF_REGION);
    const bf16_t* KOTg = R + R_KOT; const float* DECg = (const float*)(R + R_DEC);
    char* QS = smem; char* KS = smem + 8192; char* KOT = smem + 16384; char* VTs = smem + 24576; char* SPT = smem + 40960;
    float* DEC = (float*)(smem + 57344); float* GN = DEC + 64;
    const int tid = VTID, lane = tid & 63, w = tid >> 6, l15_ = lane & 15, q4 = lane >> 4;
    for (int task = VBID; task < 64; task += VGRID) {
        const int b = task >> 2, hh = task & 3;
        f32x4 Sacc[8];
#pragma unroll
        for (int nt = 0; nt < 8; ++nt) Sacc[nt] = (f32x4){0.f, 0.f, 0.f, 0.f};
        __syncthreads();
        for (int i = tid; i < 1024; i += 256) *(uint4*)(SPT + i * 16) = make_uint4(0, 0, 0, 0);
        if (tid < 128) GN[tid] = p.ab_gla_norm[hh * 128 + tid];
        const size_t rowbase = (size_t)b * 2048;
        const bf16_t* vbase = R + R_VTG + ((size_t)((b * 4 + hh) * 128)) * 2048;
        u32x4 tq[2], tk[2], tko[2], vr[4]; float td = 0.f;
        auto prefetch = [&](int c) {
            const int t0 = c * 64;
#pragma unroll
            for (int i = 0; i < 2; ++i) {
                const int cid = tid + 256 * i, row = cid >> 3, ch = cid & 7;
                tq[i] = *(const u32x4*)(R + R_QG + (rowbase + t0 + row) * 256 + hh * 64 + ch * 8);
                tk[i] = *(const u32x4*)(R + R_KG + (rowbase + t0 + row) * 256 + hh * 64 + ch * 8);
                tko[i] = *(const u32x4*)(KOTg + (((size_t)task * 32 + c) * 64 + row) * 64 + ch * 8);
            }
#pragma unroll
            for (int i = 0; i < 4; ++i) { const int cid = tid + 256 * i, e = cid >> 3, ch = cid & 7; vr[i] = *(const u32x4*)(vbase + (size_t)e * 2048 + t0 + ch * 8); }
            if (tid < 64) td = DECg[((size_t)task * 32 + c) * 64 + tid];
        };
        prefetch(0);
        for (int c = 0; c < 32; ++c) {
            int lz = 0; asm volatile("" : "+v"(lz));
            const int l15 = l15_ + lz;
            const int cx = (q4 ^ (l15 & 7)) << 4;
            const int rb0 = l15 * 128 + cx, rb1 = l15 * 128 + (cx ^ 64);
#pragma unroll
            for (int i = 0; i < 2; ++i) {
                const int cid = tid + 256 * i + lz, row = cid >> 3, ch = cid & 7;
                *(u32x4*)(QS + swz(row, ch)) = tq[i]; *(u32x4*)(KS + swz(row, ch)) = tk[i]; *(u32x4*)(KOT + swz(row, ch)) = tko[i];
            }
#pragma unroll
            for (int i = 0; i < 4; ++i) { const int cid = tid + 256 * i + lz, e = cid >> 3, ch = cid & 7; *(u32x4*)(VTs + swz(e, ch)) = vr[i]; }
            if (tid < 64) DEC[tid] = td;
            uint2 gr[8];
            const unsigned goff = (unsigned)((rowbase + c * 64 + 16 * w + l15) * 512 + hh * 128 + 4 * q4);
            bf16_t* const gbase = R + R_GG;
#pragma unroll
            for (int nt = 0; nt < 8; ++nt) gr[nt] = *(const uint2*)(gbase + (goff + 16 * nt));
            if (c + 1 < 32) prefetch(c + 1);
            __syncthreads();
            bf16x8 qf[2];
#pragma unroll
            for (int kk = 0; kk < 2; ++kk) qf[kk] = *(const bf16x8*)(QS + w * 2048 + (kk ? rb1 : rb0));
            f32x4 sT[4];
#pragma unroll
            for (int st = 0; st < 4; ++st) {
                sT[st] = (f32x4){0.f, 0.f, 0.f, 0.f};
                if (st <= w) {
#pragma unroll
                    for (int kk = 0; kk < 2; ++kk) { const bf16x8 kf = *(const bf16x8*)(KS + st * 2048 + (kk ? rb1 : rb0)); sT[st] = __builtin_amdgcn_mfma_f32_16x16x32_bf16(kf, qf[kk], sT[st], 0, 0, 0); }
#pragma unroll
                    for (int r = 0; r < 4; ++r) if (16 * st + 4 * q4 + r > 16 * w + l15) sT[st][r] = 0.f;
                }
            }
            bf16x8 af[2];
#pragma unroll
            for (int ks2 = 0; ks2 < 2; ++ks2) {
                union { bf16x8 v; unsigned u[4]; } cv;
                cv.u[0] = pack2(sT[2 * ks2][0], sT[2 * ks2][1]); cv.u[1] = pack2(sT[2 * ks2][2], sT[2 * ks2][3]);
                cv.u[2] = pack2(sT[2 * ks2 + 1][0], sT[2 * ks2 + 1][1]); cv.u[3] = pack2(sT[2 * ks2 + 1][2], sT[2 * ks2 + 1][3]);
                af[ks2] = cv.v;
            }
            const int vb = l15 * 128 + ((((q4 >> 1) ^ (l15 & 7)) << 4) | ((q4 & 1) * 8));
            f32x4 o[8];
#pragma unroll
            for (int nt = 0; nt < 8; ++nt) {
                o[nt] = (f32x4){0.f, 0.f, 0.f, 0.f};
                const int e = 16 * nt + l15;
#pragma unroll
                for (int kk = 0; kk < 2; ++kk) { const bf16x8 sf = *(const bf16x8*)(SPT + nt * 2048 + (kk ? rb1 : rb0)); o[nt] = __builtin_amdgcn_mfma_f32_16x16x32_bf16(sf, qf[kk], o[nt], 0, 0, 0); }
#pragma unroll
                for (int ks2 = 0; ks2 < 2; ++ks2) {
                    if (2 * ks2 <= w) {
                        union { bf16x8 v; uint2 h[2]; } cv;
                        cv.h[0] = *(const uint2*)(VTs + nt * 2048 + (vb ^ (ks2 * 64)));
                        cv.h[1] = *(const uint2*)(VTs + nt * 2048 + (vb ^ (ks2 * 64) ^ 32));
                        o[nt] = __builtin_amdgcn_mfma_f32_16x16x32_bf16(cv.v, af[ks2], o[nt], 0, 0, 0);
                    }
                }
            }
            {
                const float4 dc = *(const float4*)(DEC + 16 * w + 4 * q4);
                bf16x8 kof[2];
#pragma unroll
                for (int kk = 0; kk < 2; ++kk) kof[kk] = *(const bf16x8*)(KOT + w * 2048 + (kk ? rb1 : rb0));
#pragma unroll
                for (int nt = 0; nt < 8; ++nt) {
                    Sacc[nt][0] *= dc.x; Sacc[nt][1] *= dc.y; Sacc[nt][2] *= dc.z; Sacc[nt][3] *= dc.w;
#pragma unroll
                    for (int kk = 0; kk < 2; ++kk) { const bf16x8 vf = *(const bf16x8*)(VTs + nt * 2048 + (kk ? rb1 : rb0)); Sacc[nt] = __builtin_amdgcn_mfma_f32_16x16x32_bf16(kof[kk], vf, Sacc[nt], 0, 0, 0); }
                }
            }
            __syncthreads();
#pragma unroll
            for (int nt = 0; nt < 8; ++nt) {
                const int e = 16 * nt + l15;
                uint2 pk; pk.x = pack2(Sacc[nt][0], Sacc[nt][1]); pk.y = pack2(Sacc[nt][2], Sacc[nt][3]);
                *(uint2*)(SPT + nt * 2048 + l15 * 128 + (((2 * w + (q4 >> 1)) ^ (l15 & 7)) << 4) + (q4 & 1) * 8) = pk;
            }
            float ssq = 0.f;
#pragma unroll
            for (int nt = 0; nt < 8; ++nt) ssq += (o[nt][0] * o[nt][0] + o[nt][1] * o[nt][1]) + (o[nt][2] * o[nt][2] + o[nt][3] * o[nt][3]);
            ssq += __shfl_xor(ssq, 16); ssq += __shfl_xor(ssq, 32);
            const float rsd = rsqrtf(ssq * (1.0f / 128.0f) + EPS);
#pragma unroll
            for (int nt = 0; nt < 8; ++nt) {
                asm volatile("" ::: "memory");
                const f32x4 gn = *(const f32x4*)(GN + 16 * nt + 4 * q4);
                const float g0 = lo2f(gr[nt].x), g1 = hi2f(gr[nt].x), g2 = lo2f(gr[nt].y), g3 = hi2f(gr[nt].y);
                uint2 ov;
                ov.x = pack2(o[nt][0] * rsd * gn[0] * g0, o[nt][1] * rsd * gn[1] * g1);
                ov.y = pack2(o[nt][2] * rsd * gn[2] * g2, o[nt][3] * rsd * gn[3] * g3);
                if (!dry || ov.x == 0x7fc17fc1u) *(uint2*)(gbase + (goff + 16 * nt)) = ov;
            }
        }
    }
}

__device__ __forceinline__ unsigned ord_key(float f) { const unsigned u = __float_as_uint(f); return (u & 0x80000000u) ? ~u : (u | 0x80000000u); }
__device__ __forceinline__ float unord_key(unsigned k) { return __uint_as_float((k & 0x80000000u) ? (k & 0x7fffffffu) : ~k); }
__device__ __forceinline__ void ce_desc(unsigned& a, unsigned& b) { const unsigned hi = max(a, b), lo = min(a, b); a = hi; b = lo; }
__device__ __forceinline__ void bitonic_sort16_desc(unsigned (&a)[16]) {
#pragma unroll
    for (int k = 2; k <= 16; k <<= 1)
#pragma unroll
        for (int j = k >> 1; j > 0; j >>= 1)
#pragma unroll
            for (int i = 0; i < 16; ++i) { const int l = i ^ j; if (l > i) { if ((i & k) == 0) ce_desc(a[i], a[l]); else ce_desc(a[l], a[i]); } }
}
__device__ __forceinline__ void merge_top16(unsigned (&L)[16], const unsigned (&B)[16]) {
#pragma unroll
    for (int i = 0; i < 16; ++i) L[i] = max(L[i], B[15 - i]);
#pragma unroll
    for (int j = 8; j > 0; j >>= 1)
#pragma unroll
        for (int i = 0; i < 16; ++i) { const int l = i ^ j; if (l > i) ce_desc(L[i], L[l]); }
}
__device__ constexpr int cand_i(int n) { int c = 0; for (int i = 0; i < 16; ++i) for (int j = 0; j < 16; ++j) if ((i + 1) * (j + 1) <= 16) { if (c == n) return i; ++c; } return -1; }
__device__ constexpr int cand_j(int n) { int c = 0; for (int i = 0; i < 16; ++i) for (int j = 0; j < 16; ++j) if ((i + 1) * (j + 1) <= 16) { if (c == n) return j; ++c; } return -1; }
template <int N> struct CandTab { int i[N], j[N]; constexpr CandTab() : i(), j() { for (int n = 0; n < N; ++n) { i[n] = cand_i(n); j[n] = cand_j(n); } } };

__device__ __forceinline__ bf16x8 pack8(const float4 a, const float4 b) {
    u32x4 t; t.x = pack2(a.x, a.y); t.y = pack2(a.z, a.w); t.z = pack2(b.x, b.y); t.w = pack2(b.z, b.w);
    return __builtin_bit_cast(bf16x8, t);
}
__device__ __forceinline__ void fold_query_weights(const Params& p, int vb0 = 0) {
    int lz = 0; asm volatile("" : "+v"(lz));
    const int lane = (VTID & 63) + lz, wid = VTID >> 6, fr = lane & 15, fq = lane >> 4;
    bf16_t* Wf = (bf16_t*)(p.ws + OFF_WT_Q);
    if (VBID < vb0) return;
    for (int task = VBID - vb0; task < 512; task += VGRID - vb0) {
        const int kb = task & 15, pp = (task >> 4) & 1, h = (task >> 5) & 7, layer = task >> 8;
        const float* wq = p.peer_w_q + (size_t)layer * 1024 * 2048 + (size_t)(kb * 64 + fr) * 2048 + h * 256 + pp * 128 + fq * 8;
        const float* sk = p.peer_subkeys + ((size_t)((layer * 8 + h) * 2 + pp) * 128 + wid * 32 + fr) * 128 + fq * 8;
        f32x4 acc[4][2];
#pragma unroll
        for (int kt = 0; kt < 4; ++kt)
#pragma unroll
            for (int jt = 0; jt < 2; ++jt) acc[kt][jt] = (f32x4){0.f, 0.f, 0.f, 0.f};
#pragma unroll 1
        for (int s = 0; s < 4; ++s) {
            bf16x8 a[4], b[2];
#pragma unroll
            for (int kt = 0; kt < 4; ++kt) { const float* q = wq + (size_t)(kt * 16) * 2048 + s * 32; a[kt] = pack8(*(const float4*)q, *(const float4*)(q + 4)); }
#pragma unroll
            for (int jt = 0; jt < 2; ++jt) { const float* q = sk + (size_t)(jt * 16) * 128 + s * 32; b[jt] = pack8(*(const float4*)q, *(const float4*)(q + 4)); }
#pragma unroll
            for (int kt = 0; kt < 4; ++kt)
#pragma unroll
                for (int jt = 0; jt < 2; ++jt) acc[kt][jt] = __builtin_amdgcn_mfma_f32_16x16x32_bf16(a[kt], b[jt], acc[kt][jt], 0, 0, 0);
        }
#pragma unroll
        for (int jt = 0; jt < 2; ++jt) {
            const int key = wid * 32 + jt * 16 + fr, cu = 128 * ((key >> 5) & 1) + 32 * (2 * pp + (key >> 6)) + (key & 31);
            bf16_t* row = Wf + ((size_t)layer * 2048 + h * 256 + cu) * 1024 + kb * 64 + 4 * fq;
#pragma unroll
            for (int kt = 0; kt < 4; ++kt) store_bf16x4(row + kt * 16, acc[kt][jt] * *(const f32x4*)(p.norm_ffn + layer * 1024 + kb * 64 + kt * 16 + 4 * fq));
        }
    }
}
__device__ __forceinline__ void bitonic_merge16_desc(unsigned (&L)[16]) {
#pragma unroll
    for (int j = 8; j > 0; j >>= 1)
#pragma unroll
        for (int i = 0; i < 16; ++i) { const int l = i ^ j; if (l > i) ce_desc(L[i], L[l]); }
}
__device__ __forceinline__ void bitonic_sort8_desc(unsigned (&a)[8]) {
#pragma unroll
    for (int k = 2; k <= 8; k <<= 1)
#pragma unroll
        for (int j = k >> 1; j > 0; j >>= 1)
#pragma unroll
            for (int i = 0; i < 8; ++i) { const int l = i ^ j; if (l > i) { if ((i & k) == 0) ce_desc(a[i], a[l]); else ce_desc(a[l], a[i]); } }
}
__device__ __forceinline__ void sort16_desc(unsigned (&a)[16]) {
#define CE_(i, j) ce_desc(a[i], a[j])
    CE_(0,13); CE_(1,12); CE_(2,15); CE_(3,14); CE_(4,8); CE_(5,6); CE_(7,11); CE_(9,10);
    CE_(0,5); CE_(1,7); CE_(2,9); CE_(3,4); CE_(6,13); CE_(8,14); CE_(10,15); CE_(11,12);
    CE_(0,1); CE_(2,3); CE_(4,5); CE_(6,8); CE_(7,9); CE_(10,11); CE_(12,13); CE_(14,15);
    CE_(0,2); CE_(1,3); CE_(4,10); CE_(5,11); CE_(6,7); CE_(8,9); CE_(12,14); CE_(13,15);
    CE_(1,2); CE_(3,12); CE_(4,6); CE_(5,7); CE_(8,10); CE_(9,11); CE_(13,14);
    CE_(1,4); CE_(2,6); CE_(5,8); CE_(7,10); CE_(9,13); CE_(11,14);
    CE_(2,4); CE_(3,6); CE_(9,12); CE_(11,13);
    CE_(3,5); CE_(6,8); CE_(7,9); CE_(10,12);
    CE_(3,4); CE_(5,6); CE_(7,8); CE_(9,10); CE_(11,12);
    CE_(6,7); CE_(8,9);
#undef CE_
}
struct EpiSelect {
    unsigned* IDX; float* GATE; G8_LAS unsigned* X; const float* SSQP; const unsigned* SCT;
    __device__ __forceinline__ void operator()(const f32x4 (&acc)[2][2][4][2], const g8::Unit& u, int wr, int wc, int fr, int fq) const {
        const int pp = wc >> 1, half = wc & 1, wid = wr * 4 + wc;
        const unsigned kb = 127u - (unsigned)(half * 64 + fq * 8);
        unsigned Lst[4][16];
#pragma unroll
        for (int ai = 0; ai < 2; ++ai)
#pragma unroll
            for (int m = 0; m < 4; ++m) {
                unsigned C[16], Xc[16];
#pragma unroll
                for (int bj = 0; bj < 2; ++bj)
#pragma unroll
                    for (int n = 0; n < 2; ++n)
#pragma unroll
                        for (int r = 0; r < 4; ++r) C[bj * 8 + n * 4 + r] = (ord_key(acc[ai][bj][m][n][r]) & ~127u) | (kb - (unsigned)(bj * 32 + n * 4 + r));
                sort16_desc(C);
#pragma unroll
                for (int i = 0; i < 16; ++i) Xc[i] = (unsigned)__shfl_xor((int)C[i], 16);
                merge_top16(C, Xc);
#pragma unroll
                for (int i = 0; i < 16; ++i) Xc[i] = (unsigned)__shfl_xor((int)C[i], 32);
                merge_top16(C, Xc);
                if ((m >> 1) == half) {
#pragma unroll
                    for (int i = 0; i < 16; ++i) Lst[ai * 2 + (m & 1)][i] = C[i];
                } else if (fq == 0) {
                    G8_LAS unsigned* xs = X + (((ai * 2 + wr) * 2 + pp) * 4 + m) * 256 + fr;
#pragma unroll
                    for (int i = 0; i < 16; ++i) xs[(i ^ m) << 4] = C[i];
                }
            }
        __syncthreads();
#pragma unroll
        for (int ai = 0; ai < 2; ++ai)
#pragma unroll
            for (int e = 0; e < 2; ++e) {
                const int m = half * 2 + e;
                unsigned Xc[16];
                G8_LAS unsigned* xs = X + (((ai * 2 + wr) * 2 + pp) * 4 + m) * 256 + fr;
#pragma unroll
                for (int i = 0; i < 16; ++i) Xc[i] = xs[(i ^ m) << 4];
                merge_top16(Lst[ai * 2 + e], Xc);
                if (fq == 0) {
#pragma unroll
                    for (int i = 0; i < 16; ++i) xs[(i ^ m) << 4] = Lst[ai * 2 + e][i];
                }
            }
        __syncthreads();
        if (wid < 4) {
            G8_LAS unsigned* x0 = X + ((wid * 2 + 0) * 4 + fq) * 256 + fr; G8_LAS unsigned* x1 = X + ((wid * 2 + 1) * 4 + fq) * 256 + fr;
            float s0[16], s1[16];
#pragma unroll
            for (int i = 0; i < 16; ++i) { s0[i] = unord_key(x0[(i ^ fq) << 4] & ~127u); s1[i] = unord_key(x1[(i ^ fq) << 4] & ~127u); }
#define SEL_CAND(i, j) ((ord_key(s0[i] + s1[j]) & ~255u) | (unsigned)(255 - ((i) * 16 + (j))))
            unsigned C[16], B[16], M2[16], M3[8];
#pragma unroll
            for (int j = 0; j < 16; ++j) C[j] = SEL_CAND(0, j);
#pragma unroll
            for (int k = 0; k < 15; ++k) B[k] = SEL_CAND(k + 1, 0);
            B[15] = 0u;
            merge_top16(C, B);
#pragma unroll
            for (int j = 0; j < 7; ++j) M2[j] = SEL_CAND(1, j + 1);
            M2[7] = 0u; M2[8] = 0u; M2[9] = 0u;
#pragma unroll
            for (int k = 0; k < 6; ++k) M2[15 - k] = SEL_CAND(k + 2, 1);
            bitonic_merge16_desc(M2);
            M3[0] = SEL_CAND(2, 2); M3[1] = SEL_CAND(2, 3); M3[2] = SEL_CAND(2, 4); M3[3] = SEL_CAND(3, 2); M3[4] = SEL_CAND(4, 2); M3[5] = SEL_CAND(3, 3); M3[6] = 0u; M3[7] = 0u;
            bitonic_sort8_desc(M3);
#pragma unroll
            for (int i = 0; i < 8; ++i) B[i] = M3[i];
#pragma unroll
            for (int i = 8; i < 16; ++i) B[i] = 0u;
            merge_top16(M2, B);
            merge_top16(C, M2);
#undef SEL_CAND
            const int tok = u.pm * 256 + (wid >> 1) * 128 + (wid & 1) * 64 + fq * 16 + fr;
            float rstd;
            {
                const f32x4 q0 = *(const f32x4*)(SSQP + (size_t)tok * 32), q1 = *(const f32x4*)(SSQP + (size_t)tok * 32 + 4), q2 = *(const f32x4*)(SSQP + (size_t)tok * 32 + 8), q3 = *(const f32x4*)(SSQP + (size_t)tok * 32 + 12);
                const f32x4 q = (q0 + q1) + (q2 + q3);
                rstd = rsqrtf(((q[0] + q[1]) + (q[2] + q[3])) * (1.0f / D) + EPS);
            }
            const float mx = unord_key(C[0] & ~255u);
            float e[16]; float sum = 0.f;
#pragma unroll
            for (int r = 0; r < 16; ++r) { e[r] = __expf((unord_key(C[r] & ~255u) - mx) * rstd); sum += e[r]; }
            const float inv = 1.0f / sum;
            const size_t ob = (size_t)tok * 128 + u.pn * 16;
            unsigned iw[16];
#pragma unroll
            for (int r = 0; r < 16; ++r) {
                const unsigned code = 255u - (C[r] & 255u);
                const unsigned e0 = 127u - (x0[((code >> 4) ^ (unsigned)fq) << 4] & 127u), e1 = 127u - (x1[((code & 15u) ^ (unsigned)fq) << 4] & 127u);
                iw[r] = e0 * 128u + e1;
            }
            unsigned sc[16];
#pragma unroll
            for (int r = 0; r < 16; ++r) sc[r] = SCT[iw[r]];
#pragma unroll
            for (int r = 0; r < 16; ++r) {
                iw[r] |= sc[r] << 16;
                e[r] *= inv * (float)__builtin_bit_cast(_Float16, (unsigned short)(sc[r] >> 16));
            }
#pragma unroll
            for (int r = 0; r < 4; ++r) *(uint4*)(IDX + ob + r * 4) = make_uint4(iw[4 * r], iw[4 * r + 1], iw[4 * r + 2], iw[4 * r + 3]);
#pragma unroll
            for (int r = 0; r < 4; ++r) *(float4*)(GATE + ob + r * 4) = make_float4(e[4 * r], e[4 * r + 1], e[4 * r + 2], e[4 * r + 3]);
        }
        __syncthreads();
    }
};
__device__ __forceinline__ void phase_select8(const Params& p, int layer, char* smem_phys) {
    const bf16_t* H = (const bf16_t*)(p.ws + OFF_S); const bf16_t* Wf = (const bf16_t*)(p.ws + OFF_WT_Q) + (size_t)layer * 2048 * 1024;
    g8::Gemm g{H, H, 1024, 1024, Wf, T, 2048, 1024};
    g8::StaticOrder S; S.init(T, 2048, (int)gridDim.x, (int)blockIdx.x);
    EpiSelect E{(unsigned*)(p.ws + OFF_IDX), (float*)(p.ws + OFF_GATE), (G8_LAS unsigned*)(smem_phys + 131072), (const float*)(p.ws + OFF_SSQ), (const unsigned*)(p.ws + OFF_USC) + (size_t)layer * NEXP};
    g8::gemm_phase<EpiSelect>((G8_LAS unsigned char*)smem_phys, g, S, E);
    __syncthreads();
    if (threadIdx.x == 0) *(uint4*)(smem_phys + kDynLds - 16) = make_uint4(0u, 0u, 0u, 0u);
    __syncthreads();
}

__device__ __forceinline__ float ub0(unsigned w) { float f; asm("v_cvt_f32_ubyte0 %0, %1" : "=v"(f) : "v"(w)); return f; }
__device__ __forceinline__ float ub1(unsigned w) { float f; asm("v_cvt_f32_ubyte1 %0, %1" : "=v"(f) : "v"(w)); return f; }
__device__ __forceinline__ float ub2(unsigned w) { float f; asm("v_cvt_f32_ubyte2 %0, %1" : "=v"(f) : "v"(w)); return f; }
__device__ __forceinline__ float ub3(unsigned w) { float f; asm("v_cvt_f32_ubyte3 %0, %1" : "=v"(f) : "v"(w)); return f; }
typedef _Float16 f16x2 __attribute__((ext_vector_type(2)));
__device__ __forceinline__ void glds16(const void* gsrc, unsigned lds_dst) {
    unsigned keep; const unsigned d = (unsigned)__builtin_amdgcn_readfirstlane((int)lds_dst);
    asm volatile("s_mov_b32 %0, m0\n\ts_mov_b32 m0, %2\n\ts_nop 0\n\tglobal_load_lds_dwordx4 %1, off\n\ts_mov_b32 m0, %0" : "=&s"(keep) : "v"(gsrc), "s"(d) : "memory");
}
__device__ __forceinline__ void peer_gather(const Params& p, int layer, const float* __restrict__ gnext, bool final_out, char* smem) {
    const unsigned char* REC = p.ws + OFF_UT + (size_t)layer * NEXP * 1024;
    bf16_t* H = (bf16_t*)(p.ws + OFF_H);
    const unsigned* IDX = (const unsigned*)(p.ws + OFF_IDX); const float* GATE = (const float*)(p.ws + OFF_GATE);
    bf16_t* S = (bf16_t*)(p.ws + OFF_S);
    float* sGain = (float*)(smem + 139264);
    { int lz0 = 0; asm volatile("" : "+v"(lz0)); const int i = (int)threadIdx.x + lz0; if (i < 256) ((f32x4*)sGain)[i] = ((const f32x4*)(p.norm_ffn + layer * 1024))[i]; }
    __syncthreads();
    const int lane = VTID & 63, wid = VTID >> 6, sub = lane >> 4, li = lane & 15;
    char* wbase = smem + (int)(threadIdx.x >> 6) * 17408;
    unsigned* sIdx = (unsigned*)wbase; float* sGate = (float*)(wbase + 512);
    const char* ring = wbase + 1024; const unsigned ringb = (unsigned)(size_t)ring;
    const int gw = VBID * 4 + wid, nw = VGRID * 4;
    for (int t = gw; t < T; t += nw) {
        {
            int lz = 0; asm volatile("" : "+v"(lz));
            const int l2 = 2 * (lane + lz);
            const uint2 idp = *(const uint2*)(IDX + (size_t)t * 128 + l2);
            const float2 g2 = *(const float2*)(GATE + (size_t)t * 128 + l2);
            *(uint2*)(sIdx + l2) = idp; *(float2*)(sGate + l2) = g2;
        }
        int XH[2][4], XL[2][4]; float sx; float xg;
        {
            f32x4 xr[16]; float am = 0.f, ssx = 0.f;
#pragma unroll
            for (int k = 0; k < 8; ++k) {
                const int col = (16 * (k >> 2) + li) * 32 + (k & 3) * 8;
                const u32x4 raw = *(const u32x4*)(S + (size_t)t * 1024 + col);
                const f32x4 g0 = *(const f32x4*)(sGain + col), g1 = *(const f32x4*)(sGain + col + 4);
                const f32x4 x0 = (f32x4){lo2f(raw[0]), hi2f(raw[0]), lo2f(raw[1]), hi2f(raw[1])}, x1 = (f32x4){lo2f(raw[2]), hi2f(raw[2]), lo2f(raw[3]), hi2f(raw[3])};
                ssx += (x0[0] * x0[0] + x0[1] * x0[1]) + (x0[2] * x0[2] + x0[3] * x0[3]) + (x1[0] * x1[0] + x1[1] * x1[1]) + (x1[2] * x1[2] + x1[3] * x1[3]);
                xr[2 * k] = x0 * g0; xr[2 * k + 1] = x1 * g1;
#pragma unroll
                for (int c = 0; c < 4; ++c) am = fmaxf(am, fmaxf(fabsf(xr[2 * k][c]), fabsf(xr[2 * k + 1][c])));
            }
            am = fmaxf(am, __shfl_xor(am, 1)); am = fmaxf(am, __shfl_xor(am, 2)); am = fmaxf(am, __shfl_xor(am, 4)); am = fmaxf(am, __shfl_xor(am, 8));
            ssx = row16_sum(ssx);
            const float inv = am > 0.f ? 119.0f / am : 0.f;
            sx = am * (1.0f / 119.0f) * rsqrtf(ssx * (1.0f / D) + EPS);
            int xs = 0;
#pragma unroll
            for (int j = 0; j < 2; ++j)
#pragma unroll
                for (int d = 0; d < 4; ++d) {
                    unsigned lo = 0u, hi = 0u;
#pragma unroll
                    for (int i = 0; i < 8; ++i) {
                        const int q = __float2int_rn(xr[(j * 4 + d) * 2 + (i >> 2)][i & 3] * inv);
                        const int sh = (i & 3) * 8 + (i >> 2) * 4;
                        lo |= ((unsigned)q & 15u) << sh; hi |= ((unsigned)((q + 8) >> 4) & 15u) << sh;
                        xs += q;
                    }
                    XL[j][d] = (int)lo; XH[j][d] = (int)hi;
                }
            xg = 0.5f * (float)xs;
        }
        f16x2 accp[2][16];
#pragma unroll
        for (int j = 0; j < 2; ++j)
#pragma unroll
            for (int c = 0; c < 16; ++c) accp[j][c] = (f16x2){(_Float16)0.f, (_Float16)0.f};
        float wsg = 0.f;
        auto issue = [&](int sg) {
            const unsigned e_ = sIdx[sg * 4 + sub] & 0xffffu;
            const unsigned char* rec = REC + (size_t)e_ * 1024 + li * 16;
            const unsigned dst = ringb + (unsigned)(sg & 3) * 4096u;
            glds16(rec, dst); glds16(rec + 256, dst + 1024u); glds16(rec + 512, dst + 2048u); glds16(rec + 768, dst + 3072u);
        };
        auto compute = [&](int sg, bool refill) {
            const char* sl = ring + (sg & 3) * 4096;
            const u32x4 du0 = *(const u32x4*)(sl + lane * 16), du1 = *(const u32x4*)(sl + 1024 + lane * 16);
            const u32x4 dv0 = *(const u32x4*)(sl + 2048 + lane * 16), dv1 = *(const u32x4*)(sl + 3072 + lane * 16);
            const float us = (float)__builtin_bit_cast(_Float16, (unsigned short)(sIdx[sg * 4 + sub] >> 16));
            const float gt = sGate[sg * 4 + sub];
            if (refill) { asm volatile("s_waitcnt lgkmcnt(0)" ::: "memory"); issue(sg + 4); }
            int iah = 0, ial = 0;
#pragma unroll
            for (int j = 0; j < 2; ++j) {
#pragma unroll
                for (int d = 0; d < 4; ++d) {
                    const int w = (int)(j ? du1[d] : du0[d]);
                    iah = __builtin_amdgcn_sdot8(w, XH[j][d], iah, false);
                    ial = __builtin_amdgcn_sdot8(w, XL[j][d], ial, false);
                }
            }
            float pa = us * ((float)(16 * iah + ial) + xg);
            pa = row16_sum(pa);
            const float ww = gt * gelu_exact(pa * sx);
            wsg += ww;
            const float wc = fminf(fmaxf(ww * 65536.0f, -65504.0f), 65504.0f);
            const _Float16 wha = (_Float16)wc, whb = (_Float16)(wc * 0.0625f);
            const f16x2 wa = {wha, wha}, wb = {whb, whb};
#pragma unroll
            for (int j = 0; j < 2; ++j) {
#pragma unroll
                for (int d = 0; d < 4; ++d) {
                    const unsigned wv = j ? dv1[d] : dv0[d], wt = wv >> 8;
                    const f16x2 c0 = __builtin_bit_cast(f16x2, wv & 0x000f000fu), c1 = __builtin_bit_cast(f16x2, wv & 0x00f000f0u);
                    const f16x2 c2 = __builtin_bit_cast(f16x2, wt & 0x000f000fu), c3 = __builtin_bit_cast(f16x2, wt & 0x00f000f0u);
                    accp[j][4 * d + 0] = __builtin_elementwise_fma(c0, wa, accp[j][4 * d + 0]); accp[j][4 * d + 1] = __builtin_elementwise_fma(c1, wb, accp[j][4 * d + 1]);
                    accp[j][4 * d + 2] = __builtin_elementwise_fma(c2, wa, accp[j][4 * d + 2]); accp[j][4 * d + 3] = __builtin_elementwise_fma(c3, wb, accp[j][4 * d + 3]);
                }
            }
        };
        asm volatile("s_waitcnt vmcnt(0)" ::: "memory");
        issue(0); issue(1); issue(2); issue(3);
#pragma unroll 1
        for (int sg = 0; sg < 28; ++sg) {
            asm volatile("s_waitcnt vmcnt(12)" ::: "memory");
            compute(sg, true);
        }
        asm volatile("s_waitcnt vmcnt(12)" ::: "memory");
        compute(28, false);
        asm volatile("s_waitcnt vmcnt(8)" ::: "memory");
        compute(29, false);
        asm volatile("s_waitcnt vmcnt(4)" ::: "memory");
        compute(30, false);
        asm volatile("s_waitcnt vmcnt(0)" ::: "memory");
        compute(31, false);
        float acc[2][32];
#pragma unroll
        for (int j = 0; j < 2; ++j)
#pragma unroll
            for (int d = 0; d < 4; ++d) {
                acc[j][8 * d + 0] = 256.0f * (float)accp[j][4 * d + 0][0]; acc[j][8 * d + 2] = 256.0f * (float)accp[j][4 * d + 0][1];
                acc[j][8 * d + 4] = 256.0f * (float)accp[j][4 * d + 1][0]; acc[j][8 * d + 6] = 256.0f * (float)accp[j][4 * d + 1][1];
                acc[j][8 * d + 1] = 256.0f * (float)accp[j][4 * d + 2][0]; acc[j][8 * d + 3] = 256.0f * (float)accp[j][4 * d + 2][1];
                acc[j][8 * d + 5] = 256.0f * (float)accp[j][4 * d + 3][0]; acc[j][8 * d + 7] = 256.0f * (float)accp[j][4 * d + 3][1];
            }
        const bool up2 = (sub & 2) != 0, up1 = (sub & 1) != 0;
        float wsum = wsg + __shfl_xor(wsg, 32);
        wsum += __shfl_xor(wsum, 16);
        float r1[32];
#pragma unroll
        for (int c = 0; c < 32; ++c) r1[c] = (up2 ? acc[1][c] : acc[0][c]) + __shfl_xor(up2 ? acc[0][c] : acc[1][c], 32);
        float r2[16];
#pragma unroll
        for (int c = 0; c < 16; ++c) r2[c] = (up1 ? r1[16 + c] : r1[c]) + __shfl_xor(up1 ? r1[c] : r1[16 + c], 16);
        const int col0 = (16 * (sub >> 1) + li) * 32 + (sub & 1) * 16;
        float ss = 0.f;
        bf16_t* srow = S + (size_t)t * 1024 + col0;
        {
            const u32x4 b0 = *(const u32x4*)srow, b1 = *(const u32x4*)(srow + 8);
#pragma unroll
            for (int c = 0; c < 8; ++c) {
                const unsigned wsrc = c < 4 ? b0[c] : b1[c - 4];
                r2[2 * c] = r2[2 * c] - 7.5f * wsum + lo2f(wsrc); r2[2 * c + 1] = r2[2 * c + 1] - 7.5f * wsum + hi2f(wsrc);
                ss += r2[2 * c] * r2[2 * c] + r2[2 * c + 1] * r2[2 * c + 1];
            }
        }
        ss = wave_sum(ss);
        const float rstd = rsqrtf(ss * (1.0f / D) + EPS);
        const float* gp = gnext + col0;
        if (final_out) {
            float* orow = p.out + (size_t)t * 1024 + col0;
#pragma unroll
            for (int c4 = 0; c4 < 4; ++c4) {
                const f32x4 g = *(const f32x4*)(gp + c4 * 4);
                *(f32x4*)(orow + c4 * 4) = (f32x4){r2[c4 * 4] * rstd * g[0], r2[c4 * 4 + 1] * rstd * g[1], r2[c4 * 4 + 2] * rstd * g[2], r2[c4 * 4 + 3] * rstd * g[3]};
            }
        } else {
            u32x4 o[2], sv[2];
#pragma unroll
            for (int c4 = 0; c4 < 4; ++c4) {
                const f32x4 g = *(const f32x4*)(gp + c4 * 4);
                sv[c4 >> 1][(c4 & 1) * 2] = pack2(r2[c4 * 4], r2[c4 * 4 + 1]); sv[c4 >> 1][(c4 & 1) * 2 + 1] = pack2(r2[c4 * 4 + 2], r2[c4 * 4 + 3]);
                o[c4 >> 1][(c4 & 1) * 2] = pack2(r2[c4 * 4] * rstd * g[0], r2[c4 * 4 + 1] * rstd * g[1]);
                o[c4 >> 1][(c4 & 1) * 2 + 1] = pack2(r2[c4 * 4 + 2] * rstd * g[2], r2[c4 * 4 + 3] * rstd * g[3]);
            }
            *(u32x4*)srow = sv[0]; *(u32x4*)(srow + 8) = sv[1];
            bf16_t* hp = H + (size_t)t * 1024 + col0;
            *(u32x4*)hp = o[0]; *(u32x4*)(hp + 8) = o[1];
        }
    }
}


#define XB_TMO      128
#define XB_XCNT(j)  (256  + 64 * (j))
#define XB_XSUB(j)  (1280 + 64 * (j))
#define XB_XGEN(j)  (2304 + 64 * (j))
#define XB_TOP      3328
#define XB_TOPGEN   3392
#define XCD_BAR_WORDS 3456
#define XB_SPIN_CAP (1u << 22)
#define LAS __attribute__((address_space(3)))
__device__ __forceinline__ unsigned xb_ld(unsigned* p)              { return __hip_atomic_load(p, __ATOMIC_RELAXED, __HIP_MEMORY_SCOPE_AGENT); }
__device__ __forceinline__ unsigned xb_add(unsigned* p, unsigned v) { return __hip_atomic_fetch_add(p, v, __ATOMIC_RELAXED, __HIP_MEMORY_SCOPE_AGENT); }
__device__ __forceinline__ unsigned xb_xcc_id() { return (unsigned)__builtin_amdgcn_s_getreg((3 << 11) | 20) & 0xFu; }
#define XB_SPIN(cond, bar) do { unsigned _sp = 0; while (cond) { __builtin_amdgcn_s_sleep(1); \
    if ((++_sp & 255u) == 0u) { if (xb_ld(&(bar)[XB_TMO])) break; if (_sp > XB_SPIN_CAP) { atomicAdd(&(bar)[XB_TMO], 1u); break; } } } } while (0)
struct XcdBarrier { unsigned* bar; unsigned x; volatile LAS unsigned* st; };
__device__ __forceinline__ XcdBarrier xcd_barrier_post(unsigned* bar, volatile LAS unsigned* st) {
    XcdBarrier b; b.bar = bar; b.x = xb_xcc_id(); b.st = st;
    if (threadIdx.x == 0) (void)xb_add(&bar[XB_XCNT(b.x)], 1u);
    return b;
}
__device__ __forceinline__ void xcd_barrier_complete(unsigned* bar, unsigned x, unsigned& nloc, unsigned& nx) {
    const unsigned G = gridDim.x * gridDim.y * gridDim.z;
    unsigned sum, cnt, mine, sp = 0u;
    for (;;) {
        sum = 0u; cnt = 0u; mine = 0u;
#pragma unroll
        for (unsigned j = 0; j < 16; ++j) { const unsigned c = xb_ld(&bar[XB_XCNT(j)]); sum += c; cnt += (c > 0u) ? 1u : 0u; mine = (j == x) ? c : mine; }
        if (sum == G) break;
        __builtin_amdgcn_s_sleep(1);
        if ((++sp & 255u) == 0u) { if (xb_ld(&bar[XB_TMO])) break; if (sp > XB_SPIN_CAP) { atomicAdd(&bar[XB_TMO], 1u); break; } }
    }
    nloc = mine > 0u ? mine : 1u; nx = cnt > 0u ? cnt : 1u;
}
__device__ __forceinline__ void xcd_barrier(const XcdBarrier& b) {
    asm volatile("s_waitcnt vmcnt(0)" ::: "memory");
    __syncthreads();
    if (threadIdx.x == 0) {
        unsigned* bar = b.bar;
        __builtin_amdgcn_s_waitcnt(0);
        unsigned nloc = b.st[0], nx = b.st[1];
        if (nloc == 0u) { xcd_barrier_complete(bar, b.x, nloc, nx); b.st[0] = nloc; b.st[1] = nx; }
        const unsigned old = xb_add(&bar[XB_XSUB(b.x)], 1u);
        const unsigned gen = old / nloc;
        if (old + 1u == (gen + 1u) * nloc) {
            __builtin_amdgcn_fence(__ATOMIC_RELEASE, "agent");
            asm volatile("s_waitcnt vmcnt(0)" ::: "memory");
            const unsigned og = xb_add(&bar[XB_TOP], 1u);
            const unsigned tg = og / nx;
            if (og + 1u == (tg + 1u) * nx) xb_add(&bar[XB_TOPGEN], 1u);
            else XB_SPIN(xb_ld(&bar[XB_TOPGEN]) == tg, bar);
            __builtin_amdgcn_fence(__ATOMIC_ACQUIRE, "agent");
            xb_add(&bar[XB_XGEN(b.x)], 1u);
            asm volatile("s_waitcnt vmcnt(0)" ::: "memory");
        } else {
            XB_SPIN(xb_ld(&bar[XB_XGEN(b.x)]) == gen, bar);
            __builtin_amdgcn_fence(__ATOMIC_ACQUIRE, "agent");
            asm volatile("s_waitcnt vmcnt(0)" ::: "memory");
        }
    }
    __syncthreads();
}

constexpr int NPHASE = 12;
__global__ void __launch_bounds__(512, 2) mega(Params p, int ph_lo, int ph_hi) {
    extern __shared__ __attribute__((aligned(16))) char smem_phys[];
    uint4& xb_words = *(uint4*)(smem_phys + kDynLds - 16);
    if (threadIdx.x == 0) xb_words = make_uint4(0u, 0u, 0u, 0u);
    __syncthreads();
    const XcdBarrier xbar = xcd_barrier_post((unsigned*)(p.ws + OFF_BAR), (volatile LAS unsigned*)&xb_words);
    char* smem = smem_phys + (threadIdx.x >> 8) * 65536;
    bf16_t* Rg = (bf16_t*)(p.ws + OFF_REGION);
    bf16_t* Hb = (bf16_t*)(p.ws + OFF_H);
#define PHASE(k, ...) if (ph_lo <= (k) && (k) < ph_hi) { __VA_ARGS__; if ((k) + 1 < ph_hi) xcd_barrier(xbar); }
    unsigned* sbctr = (unsigned*)(p.ws + OFF_BAR + 14336);
    PHASE(0,
        transpose_convert<true>(p.ab_w_in, (bf16_t*)(p.ws + OFF_WT_IN), 1024, AB_IN, AB_IN_PAD, smem);
        rmsnorm_rows(p.x, p.norm_mix, Hb))
    PHASE(1, phase_gemm_in8(p, smem_phys))
    PHASE(2, gla_prep(p, smem))
    PHASE(3, gla_scan(p, smem); sb_fast(p, smem_phys + 98304, sbctr);
        quantize_tables_static(p, 64);
        transpose_convert(p.ab_w_out, (bf16_t*)(p.ws + OFF_WT_OUT), 1024, 1024, 1024, smem, 64);
        transpose_convert(p.c_w_in, (bf16_t*)(p.ws + OFF_WT_CIN), 1024, 4096, 4096, smem, 64);
        transpose_convert(p.c_w_out, (bf16_t*)(p.ws + OFF_WT_COUT), 2048, 1024, 1024, smem, 64);
        fold_query_weights(p, 64))
    PHASE(4, phase_gemm_resid8(Rg + R_QSB, Rg + R_GG, 512, 512, (const bf16_t*)(p.ws + OFF_WT_OUT), 1024, p.x, (bf16_t*)(p.ws + OFF_S), (float*)(p.ws + OFF_SSQ), smem_phys))
    PHASE(5, phase_select8(p, 0, smem_phys))
    PHASE(6, peer_gather(p, 0, p.norm_mix + 1024, false, smem_phys))
    PHASE(7, phase_gemm_cin8_v(p, smem_phys))
    PHASE(8, phase_gemm_cin8_u(p, smem_phys))
    PHASE(9, phase_gemm_resid8(Rg, Rg, 2048, 2048, (const bf16_t*)(p.ws + OFF_WT_COUT), 2048, nullptr, (bf16_t*)(p.ws + OFF_S), (float*)(p.ws + OFF_SSQ), smem_phys))
    PHASE(10, phase_select8(p, 1, smem_phys))
    PHASE(11, peer_gather(p, 1, p.final_norm, true, smem_phys))
}

extern "C" void kernel_launch(void* const* d_in, const int* in_sizes, int n_in, void* d_out, int out_size, void* d_ws, size_t ws_size, hipStream_t stream) {
    static int grid_blocks = 0;
    if (!grid_blocks) {
        int dev = 0, cus = 0, per_cu = 0;
        hipGetDevice(&dev);
        hipDeviceGetAttribute(&cus, hipDeviceAttributeMultiprocessorCount, dev);
        hipFuncSetAttribute((const void*)mega, hipFuncAttributeMaxDynamicSharedMemorySize, kDynLds);
        hipOccupancyMaxActiveBlocksPerMultiprocessor(&per_cu, mega, 512, kDynLds);
        if (per_cu < 1) per_cu = 1;
        if (per_cu > 1) per_cu = 1;
        grid_blocks = cus * per_cu;
        if (n_in != 18 || ws_size < WS_END) fprintf(stderr, "kernel_launch: unexpected n_in %d or ws_size %zu < %zu\n", n_in, ws_size, (size_t)WS_END);
    }
    Params p{};
    p.x = (const float*)d_in[0]; p.norm_mix = (const float*)d_in[1]; p.norm_ffn = (const float*)d_in[2]; p.ab_w_in = (const float*)d_in[3];
    p.ab_w_alpha2 = (const float*)d_in[4]; p.ab_b_alpha2 = (const float*)d_in[5]; p.ab_gla_norm = (const float*)d_in[6]; p.ab_w_out = (const float*)d_in[7];
    p.c_w_in = (const float*)d_in[8]; p.c_v_norm = (const float*)d_in[9]; p.c_w_spatial = (const float*)d_in[10]; p.c_b_spatial = (const float*)d_in[11];
    p.c_w_out = (const float*)d_in[12]; p.peer_w_q = (const float*)d_in[13]; p.peer_subkeys = (const float*)d_in[14]; p.peer_u = (const float*)d_in[15];
    p.peer_v = (const float*)d_in[16]; p.final_norm = (const float*)d_in[17];
    p.out = (float*)d_out; p.ws = (unsigned char*)d_ws;
    (void)hipMemsetAsync((char*)d_ws + OFF_BAR, 0, 16384, stream);
#if ONE_LAUNCH
    int lo = 0, hi = NPHASE;
    void* args[] = {&p, &lo, &hi};
    hipError_t e = hipLaunchCooperativeKernel((void*)mega, dim3(grid_blocks), dim3(512), args, kDynLds, stream);
    if (e != hipSuccess) fprintf(stderr, "cooperative launch failed: %s (grid %d)\n", hipGetErrorString(e), grid_blocks);
#else
    for (int ph = 0; ph < NPHASE; ++ph) hipLaunchKernelGGL(mega, dim3(grid_blocks), dim3(512), kDynLds, stream, p, ph, ph + 1);
#endif
}
```

```cpp
#include <hip/hip_runtime.h>
#include <cstdio>
#include <cstdint>

#ifndef ONE_LAUNCH
#define ONE_LAUNCH 1
#endif


#define VTID ((int)(threadIdx.x & 255))
#define VBID ((int)(blockIdx.x * 2 + (threadIdx.x >> 8)))
#define VGRID ((int)(gridDim.x * 2))
typedef unsigned short bf16_t;
typedef short bf16x8 __attribute__((ext_vector_type(8)));
typedef float f32x4 __attribute__((ext_vector_type(4)));
typedef unsigned u32x4 __attribute__((ext_vector_type(4)));
typedef __bf16 bf16x2_t __attribute__((ext_vector_type(2)));

constexpr int T = 32768, D = 1024, SEQ = 2048, NB = 16;
constexpr int AB_IN = 3088, AB_IN_PAD = 3200;
constexpr float EPS = 1e-6f;
constexpr int NEXP = 16384;
constexpr int kDynLds = 163840;

constexpr size_t SZ_WT_IN = (size_t)AB_IN_PAD * 1024 * 2;
constexpr size_t SZ_WT_OUT = (size_t)1024 * 1024 * 2;
constexpr size_t SZ_WT_CIN = (size_t)4096 * 1024 * 2;
constexpr size_t SZ_WT_COUT = (size_t)1024 * 2048 * 2;
constexpr size_t SZ_WT_Q = (size_t)2 * 2048 * 1024 * 2;
constexpr size_t SZ_SK = (size_t)2 * 8 * 2 * 128 * 128 * 2;
constexpr size_t SZ_TAB = (size_t)2 * NEXP * 1024;
constexpr size_t SZ_TSC = (size_t)2 * NEXP * 4;
constexpr size_t OFF_WT_IN = 0;
constexpr size_t OFF_WT_OUT = OFF_WT_IN + SZ_WT_IN;
constexpr size_t OFF_WT_CIN = OFF_WT_OUT + SZ_WT_OUT;
constexpr size_t OFF_WT_COUT = OFF_WT_CIN + SZ_WT_CIN;
constexpr size_t OFF_WT_Q = OFF_WT_COUT + SZ_WT_COUT;
constexpr size_t OFF_SK = OFF_WT_Q + SZ_WT_Q;
constexpr size_t OFF_UT = OFF_SK;
constexpr size_t OFF_USC = OFF_UT + SZ_TAB;
constexpr size_t OFF_VSC = OFF_USC + SZ_TSC;
constexpr size_t OFF_H = OFF_VSC + SZ_TSC;
constexpr size_t OFF_IDX = OFF_H + (size_t)T * 1024 * 2;
constexpr size_t OFF_GATE = OFF_IDX + (size_t)T * 128 * 4;
constexpr size_t OFF_SSQ = OFF_GATE + (size_t)T * 128 * 4;
constexpr size_t OFF_REGION = OFF_SSQ + (size_t)T * 32 * 4;
constexpr size_t SZ_REGION = (size_t)256 << 20;
constexpr size_t OFF_S = OFF_REGION + SZ_REGION;
constexpr size_t OFF_BAR = OFF_S + (size_t)T * 1024 * 2;
constexpr size_t WS_END = OFF_BAR + 16384;
constexpr size_t R_QSB = 0;
constexpr size_t R_KSB = R_QSB + (size_t)T * 512;
constexpr size_t R_VTSB = R_KSB + (size_t)T * 512;
constexpr size_t R_QG = R_VTSB + (size_t)T * 512;
constexpr size_t R_KG = R_QG + (size_t)T * 256;
constexpr size_t R_VTG = R_KG + (size_t)T * 256;
constexpr size_t R_GG = R_VTG + (size_t)T * 512;
constexpr size_t R_ALR = R_GG + (size_t)T * 512;
constexpr size_t R_KOT = R_ALR + (size_t)T * 32;
constexpr size_t R_DEC = R_KOT + (size_t)T * 256;

struct Params {
    const float* x; const float* norm_mix; const float* norm_ffn; const float* ab_w_in; const float* ab_w_alpha2; const float* ab_b_alpha2;
    const float* ab_gla_norm; const float* ab_w_out; const float* c_w_in; const float* c_v_norm; const float* c_w_spatial; const float* c_b_spatial;
    const float* c_w_out; const float* peer_w_q; const float* peer_subkeys; const float* peer_u; const float* peer_v; const float* final_norm;
    float* out; unsigned char* ws;
};

__device__ __forceinline__ float bf2f(bf16_t v) { return __uint_as_float(((unsigned)v) << 16); }
__device__ __forceinline__ bf16_t f2bf(float f) { unsigned r; asm("v_cvt_pk_bf16_f32 %0, %1, %1" : "=v"(r) : "v"(f)); return (bf16_t)r; }
__device__ __forceinline__ unsigned pack2(float lo, float hi) { unsigned r; asm("v_cvt_pk_bf16_f32 %0, %1, %2" : "=v"(r) : "v"(lo), "v"(hi)); return r; }
__device__ __forceinline__ float lo2f(unsigned w) { return __uint_as_float(w << 16); }
__device__ __forceinline__ float hi2f(unsigned w) { return __uint_as_float(w & 0xffff0000u); }
__device__ __forceinline__ float dot2(unsigned a, unsigned b, float acc) { return __builtin_amdgcn_fdot2_f32_bf16(__builtin_bit_cast(bf16x2_t, a), __builtin_bit_cast(bf16x2_t, b), acc, false); }
#define GELU_C0 -1.0001451969146729f
#define GELU_C1 -1.1498452425003052f
#define GELU_C2 -0.46162763237953186f
#define GELU_C3 -0.051034148782491684f
#define GELU_C4 0.007168652955442667f
#define GELU_C5 -0.0006095620337873697f
#define GELU_C6 2.30170971917687e-05f
__device__ __forceinline__ float gelu_exact(float v) {
    const float a = fminf(fabsf(v), 6.0f);
    float q = GELU_C6 * a + GELU_C5; q = q * a + GELU_C4; q = q * a + GELU_C3; q = q * a + GELU_C2; q = q * a + GELU_C1; q = q * a + GELU_C0;
    return fmaxf(v, 0.f) - fabsf(v) * __builtin_amdgcn_exp2f(q);
}
typedef float f32x2 __attribute__((ext_vector_type(2)));
__device__ __forceinline__ f32x2 gelu_exact2(f32x2 v) {
    const f32x2 av = __builtin_elementwise_abs(v), a = __builtin_elementwise_min(av, (f32x2){6.0f, 6.0f});
    f32x2 q = (f32x2){GELU_C6, GELU_C6} * a + (f32x2){GELU_C5, GELU_C5};
    q = q * a + (f32x2){GELU_C4, GELU_C4}; q = q * a + (f32x2){GELU_C3, GELU_C3}; q = q * a + (f32x2){GELU_C2, GELU_C2};
    q = q * a + (f32x2){GELU_C1, GELU_C1}; q = q * a + (f32x2){GELU_C0, GELU_C0};
    const f32x2 e = {__builtin_amdgcn_exp2f(q[0]), __builtin_amdgcn_exp2f(q[1])};
    return __builtin_elementwise_max(v, (f32x2){0.f, 0.f}) - av * e;
}
__device__ __forceinline__ float row16_sum(float v) {
    v += __builtin_bit_cast(float, __builtin_amdgcn_update_dpp(0, __builtin_bit_cast(int, v), 0x128, 0xf, 0xf, false));
    v += __builtin_bit_cast(float, __builtin_amdgcn_update_dpp(0, __builtin_bit_cast(int, v), 0x124, 0xf, 0xf, false));
    v += __builtin_bit_cast(float, __builtin_amdgcn_update_dpp(0, __builtin_bit_cast(int, v), 0x122, 0xf, 0xf, false));
    v += __builtin_bit_cast(float, __builtin_amdgcn_update_dpp(0, __builtin_bit_cast(int, v), 0x121, 0xf, 0xf, false));
    return v;
}
__device__ __forceinline__ float wave_sum(float v) {
#pragma unroll
    for (int o = 32; o >= 1; o >>= 1) v += __shfl_xor(v, o);
    return v;
}

template <bool PERM_IN = false>
__device__ __forceinline__ void transpose_convert(const float* __restrict__ W, bf16_t* __restrict__ Wt, int K, int N, int Npad, char* smem, int vb0 = 0, const float* __restrict__ kgain = nullptr) {
    float* tile = (float*)smem;
    const int tk = K / 64, tn = Npad / 64, ntile = tk * tn;
    const int tid = VTID;
    if (VBID < vb0) return;
    for (int tl = VBID - vb0; tl < ntile; tl += VGRID - vb0) {
        const int k0 = (tl % tk) * 64, n0 = (tl / tk) * 64;
        const int c = tid & 63, r0 = tid >> 6;
        int nd = n0;
        if (PERM_IN) { if (n0 >= 1024 && n0 < 1536) nd = n0 + 1024; else if (n0 >= 1536 && n0 < 2048) nd = n0 - 512; else if (n0 >= 2048 && n0 < 2560) nd = n0 + 512; else if (n0 >= 2560 && n0 < 3072) nd = n0 - 1024; }
#pragma unroll
        for (int i = 0; i < 16; ++i) {
            const int r = r0 + 4 * i;
            float v = (n0 + c < N) ? W[(size_t)(k0 + r) * N + n0 + c] : 0.f;
            if (kgain) v *= kgain[k0 + r];
            tile[c * 65 + r] = v;
        }
        __syncthreads();
#pragma unroll
        for (int i = 0; i < 16; ++i) {
            const int n = r0 + 4 * i;
            Wt[(size_t)(nd + n) * K + k0 + c] = f2bf(tile[n * 65 + c]);
        }
        __syncthreads();
    }
}
__device__ __forceinline__ void quantize_tables_static(const Params& p, int vb0 = 0) {
    const int lane = VTID & 63, wid = VTID >> 6;
    if (VBID < vb0) return;
    for (unsigned task = (unsigned)(VBID - vb0); task < 512u; task += (unsigned)(VGRID - vb0)) {
        const bool isv = task >= 256u;
        const int r0 = (int)(task & 255u) * 128 + wid * 32;
        const float* src = isv ? p.peer_v : p.peer_u;
        unsigned char* recs = p.ws + OFF_UT;
        _Float16* sct = (_Float16*)(p.ws + OFF_USC);
        f32x4 vnx[4];
        {
            const float* x0 = src + (size_t)r0 * 1024 + lane * 16;
#pragma unroll
            for (int i = 0; i < 4; ++i) vnx[i] = *(const f32x4*)(x0 + i * 4);
        }
        for (int rr = 0; rr < 32; ++rr) {
            const int r = r0 + rr;
            f32x4 v[4]; float aml = 0.f;
#pragma unroll
            for (int i = 0; i < 4; ++i) {
                v[i] = vnx[i];
                aml = fmaxf(aml, fmaxf(fmaxf(fabsf(v[i][0]), fabsf(v[i][1])), fmaxf(fabsf(v[i][2]), fabsf(v[i][3]))));
            }
            if (rr + 1 < 32) {
                const float* xn = src + (size_t)(r + 1) * 1024 + lane * 16;
#pragma unroll
                for (int i = 0; i < 4; ++i) vnx[i] = *(const f32x4*)(xn + i * 4);
            }
#pragma unroll
            for (int o = 32; o >= 1; o >>= 1) aml = fmaxf(aml, __shfl_xor(aml, o));
            float ssq = 0.f;
#pragma unroll
            for (int i = 0; i < 4; ++i) ssq += (v[i][0] * v[i][0] + v[i][1] * v[i][1]) + (v[i][2] * v[i][2] + v[i][3] * v[i][3]);
            ssq = wave_sum(ssq);
            const float gmax = aml * (1.002f / 7.5f);
            const _Float16 hs = (_Float16)fminf(fmaxf(0.34f * sqrtf(ssq * (1.0f / 1024.0f)), 0.5f * gmax), gmax);
            const float gs_ = (float)hs, gi_ = gs_ > 0.f ? 1.0f / gs_ : 0.f;
            unsigned wd[2]; const int sgn = isv ? 0 : 8;
#pragma unroll
            for (int dd = 0; dd < 2; ++dd) {
                unsigned wv = 0;
#pragma unroll
                for (int b = 0; b < 4; ++b) {
                    const int qa = min(15, max(0, __float2int_rn(v[2 * dd][b] * gi_ + 7.5f)));
                    const int qb = min(15, max(0, __float2int_rn(v[2 * dd + 1][b] * gi_ + 7.5f)));
                    wv |= ((unsigned)(qa ^ sgn) | ((unsigned)(qb ^ sgn) << 4)) << (8 * b);
                }
                wd[dd] = wv;
            }
            unsigned char* rec = recs + (size_t)r * 1024;
            *(uint2*)(rec + (isv ? 512 : 0) + lane * 8) = make_uint2(wd[0], wd[1]);
            if (lane == 0) sct[(size_t)r * 2 + (isv ? 1 : 0)] = (_Float16)gs_;
        }
    }
}
__device__ __forceinline__ void rmsnorm_rows(const float* __restrict__ X, const float* __restrict__ g, bf16_t* __restrict__ Hout) {
    const int lane = VTID & 63, wid = VTID >> 6;
    const int gw = VBID * 4 + wid, nw = VGRID * 4;
    for (int t = gw; t < T; t += nw) {
        const float* xr = X + (size_t)t * D;
        float4 v[4]; float ss = 0.f;
#pragma unroll
        for (int i = 0; i < 4; ++i) { v[i] = *(const float4*)(xr + i * 256 + lane * 4); ss += v[i].x * v[i].x + v[i].y * v[i].y + v[i].z * v[i].z + v[i].w * v[i].w; }
        ss = wave_sum(ss);
        const float rstd = rsqrtf(ss * (1.0f / D) + EPS);
#pragma unroll
        for (int i = 0; i < 4; ++i) {
            const float4 gg = *(const float4*)(g + i * 256 + lane * 4);
            uint2 o; o.x = pack2(v[i].x * rstd * gg.x, v[i].y * rstd * gg.y); o.y = pack2(v[i].z * rstd * gg.z, v[i].w * rstd * gg.w);
            *(uint2*)(Hout + (size_t)t * D + i * 256 + lane * 4) = o;
        }
    }
}

__device__ __forceinline__ void store_bf16x4(bf16_t* p, f32x4 v) { uint2 o; o.x = pack2(v[0], v[1]); o.y = pack2(v[2], v[3]); *(uint2*)p = o; }

#define G8_LAS __attribute__((address_space(3)))
namespace g8 {
constexpr int BM = 256, BK = 64, HALF = 128, HTB = HALF * BK * 2, NXCD = 8, WGM = 8;
__device__ __forceinline__ int lds_byte(int r, int c) { const int st = (r >> 4) * 2 + (c >> 5), rr = r & 15, cc = c & 31, ob = rr * 64 + cc * 2; return st * 1024 + (ob ^ (((ob >> 9) & 1) << 5)); }
__device__ __forceinline__ void stage_rc(int b, int& R, int& C) { const int st = b / 1024, sb = b % 1024, swz = sb ^ (((sb >> 9) & 1) << 5); R = (st >> 1) * 16 + swz / 64; C = (st & 1) * 32 + (swz % 64) / 2; }
__device__ __forceinline__ int perm32(int rho) { const int n = rho >> 4, i = rho & 15; return 8 * (i >> 2) + 4 * n + (i & 3); }
struct Unit { int pm, pn; };
struct Gemm { const bf16_t* A0; const bf16_t* A1; int lda, ksplit; const bf16_t* Bt; int M, N, K; };
struct StaticOrder {
    int nM, nN, nwg, G, c;
    __device__ __forceinline__ void init(int M, int N, int G_, int c_) { nM = M / BM; nN = N / BM; nwg = nM * nN; G = G_; c = c_; }
    __device__ __forceinline__ bool next(int i, Unit& u) const {
        const int L = i * G + c; if (L >= nwg) return false;
        int wgid = L; { const int q = nwg / NXCD, r = nwg % NXCD, xcd = wgid % NXCD, off = wgid / NXCD; wgid = (xcd < r ? xcd * (q + 1) : r * (q + 1) + (xcd - r) * q) + off; }
        const int nig = WGM * nN, gid = wgid / nig, fm = gid * WGM, gsz = (nM - fm) < WGM ? (nM - fm) : WGM;
        u.pm = fm + ((wgid % nig) % gsz); u.pn = (wgid % nig) / gsz; return true;
    }
};
template <class Epi>
__device__ __forceinline__ void gemm_phase(G8_LAS unsigned char* lds, const Gemm g, const StaticOrder& S, const Epi& E) {
    const int tid = threadIdx.x, wid = __builtin_amdgcn_readfirstlane(tid >> 6), lane = tid & 63, wr = wid >> 2, wc = wid & 3, fr = lane & 15, fq = lane >> 4;
    const int K = g.K, nt = K / BK, lda = g.lda;
    unsigned voffA[2], voffB[2];
#pragma unroll
    for (int i = 0; i < 2; ++i) { int R, C; stage_rc(tid * 16 + i * 8192, R, C); const int Rb = (R & ~31) + perm32(R & 31);
        voffA[i] = (unsigned)(R * lda + C) * 2u; voffB[i] = (unsigned)(Rb * K + C) * 2u; }
    const size_t hstepA = (size_t)HALF * lda * 2, hstepB = (size_t)HALF * K * 2;
    const unsigned ldsw = (unsigned)wid * 1024u;
    const int aoff = lds_byte(wr * 64 + fr, fq * 8), boff = lds_byte(wc * 32 + fr, fq * 8);
    auto aptr = [&](int pm, int kt) -> const char* { const int kb = kt * BK; const bf16_t* b = kb < g.ksplit ? g.A0 + kb : g.A1 + (kb - g.ksplit); return (const char*)b + (size_t)pm * 2 * hstepA; };
    auto bptr = [&](int pn, int kt) -> const char* { return (const char*)(g.Bt + kt * BK) + (size_t)pn * 2 * hstepB; };
#define G8_SA(b, h) (((b) * 2 + (h)) * HTB)
#define G8_SB(b, h) ((4 + (b) * 2 + (h)) * HTB)
#define G8_STAGE(bufoff, gbase, voff) do { _Pragma("unroll") for (int _i = 0; _i < 2; ++_i) \
        __builtin_amdgcn_global_load_lds((const unsigned*)((const char*)(gbase) + (voff)[_i]), (G8_LAS unsigned*)(lds + (bufoff) + ldsw + _i * 8192), 16, 0, 0); } while (0)
#define G8_LDA(dst, b, h) do { _Pragma("unroll") for (int m = 0; m < 4; ++m) _Pragma("unroll") for (int k = 0; k < 2; ++k) dst[m][k] = *(const G8_LAS bf16x8*)(lds + G8_SA(b, h) + aoff + m * 2048 + k * 1024); } while (0)
#define G8_LDB(dst, b, h) do { _Pragma("unroll") for (int n = 0; n < 2; ++n) _Pragma("unroll") for (int k = 0; k < 2; ++k) dst[n][k] = *(const G8_LAS bf16x8*)(lds + G8_SB(b, h) + boff + n * 2048 + k * 1024); } while (0)
#define G8_MMA(ai, bj, At, Bt) do { __builtin_amdgcn_s_setprio(1); _Pragma("unroll") for (int m = 0; m < 4; ++m) _Pragma("unroll") for (int n = 0; n < 2; ++n) _Pragma("unroll") for (int k = 0; k < 2; ++k) \
        acc[ai][bj][m][n] = __builtin_amdgcn_mfma_f32_16x16x32_bf16(Bt[n][k], At[m][k], acc[ai][bj][m][n], 0, 0, 0); __builtin_amdgcn_s_setprio(0); } while (0)
#define G8_WAIT_V(n) asm volatile("s_waitcnt vmcnt(" #n ")" ::: "memory")
#define G8_WAIT_L(n) asm volatile("s_waitcnt lgkmcnt(" #n ")" ::: "memory")
#define G8_BAR __builtin_amdgcn_s_barrier()
#define G8_SCHED __builtin_amdgcn_sched_barrier(0)
    Unit cur, nxt; int ui = 0;
    if (!S.next(0, cur)) return;
    f32x4 acc[2][2][4][2];
#pragma unroll
    for (int a = 0; a < 2; ++a)
#pragma unroll
        for (int b = 0; b < 2; ++b)
#pragma unroll
            for (int m = 0; m < 4; ++m)
#pragma unroll
                for (int n = 0; n < 2; ++n) acc[a][b][m][n] = (f32x4){0.f, 0.f, 0.f, 0.f};
    bf16x8 At[4][2], B0[2][2], B1[2][2];
    {
        const char* cA = aptr(cur.pm, 0); const char* cB = bptr(cur.pn, 0); const char* cA1 = aptr(cur.pm, 1); const char* cB1 = bptr(cur.pn, 1);
        G8_STAGE(G8_SB(0, 0), cB, voffB); G8_STAGE(G8_SB(0, 1), cB + hstepB, voffB); G8_STAGE(G8_SA(0, 0), cA, voffA); G8_STAGE(G8_SA(0, 1), cA + hstepA, voffA);
        if (wr == 1) G8_BAR;
        G8_WAIT_V(2); G8_BAR;
        G8_STAGE(G8_SB(1, 0), cB1, voffB); G8_STAGE(G8_SA(1, 0), cA1, voffA); G8_STAGE(G8_SB(1, 1), cB1 + hstepB, voffB);
        G8_WAIT_V(6); G8_BAR;
    }
    for (;;) {
        const bool has_next = S.next(ui + 1, nxt);
        const int npm = has_next ? nxt.pm : cur.pm, npn = has_next ? nxt.pn : cur.pn;
        for (int t = 0; t < nt; t += 2) {
            const bool last = (t == nt - 2);
            const char* a1 = aptr(cur.pm, t + 1);
            const char* a2 = last ? aptr(npm, 0) : aptr(cur.pm, t + 2); const char* b2 = last ? bptr(npn, 0) : bptr(cur.pn, t + 2);
            const char* a3 = last ? aptr(npm, 1) : aptr(cur.pm, t + 3); const char* b3 = last ? bptr(npn, 1) : bptr(cur.pn, t + 3);
            G8_LDB(B0, 0, 0); G8_LDB(B1, 0, 1); G8_SCHED; G8_LDA(At, 0, 0); G8_STAGE(G8_SA(1, 1), a1 + hstepA, voffA);
            G8_WAIT_V(8); G8_WAIT_L(0); G8_BAR; G8_MMA(0, 0, At, B0); G8_MMA(0, 1, At, B1); G8_BAR; G8_SCHED;
            G8_LDA(At, 0, 1); G8_STAGE(G8_SB(0, 0), b2, voffB); G8_STAGE(G8_SB(0, 1), b2 + hstepB, voffB); G8_STAGE(G8_SA(0, 0), a2, voffA);
            G8_WAIT_V(8); G8_WAIT_L(0); G8_BAR; G8_MMA(1, 0, At, B0); G8_MMA(1, 1, At, B1); G8_BAR; G8_SCHED;
            G8_LDB(B0, 1, 0); G8_LDB(B1, 1, 1); G8_SCHED; G8_LDA(At, 1, 0); G8_STAGE(G8_SA(0, 1), a2 + hstepA, voffA);
            G8_WAIT_V(8); G8_WAIT_L(0); G8_BAR; G8_MMA(0, 0, At, B0); G8_MMA(0, 1, At, B1); G8_BAR; G8_SCHED;
            G8_LDA(At, 1, 1); G8_STAGE(G8_SB(1, 0), b3, voffB); G8_STAGE(G8_SB(1, 1), b3 + hstepB, voffB); G8_STAGE(G8_SA(1, 0), a3, voffA);
            G8_WAIT_V(8); G8_WAIT_L(0); G8_BAR; G8_MMA(1, 0, At, B0); G8_MMA(1, 1, At, B1); G8_BAR; G8_SCHED;
        }
        if (wr == 0) G8_BAR;
        E(acc, cur, wr, wc, fr, fq);
        if (!has_next) break;
#pragma unroll
        for (int a = 0; a < 2; ++a)
#pragma unroll
            for (int b = 0; b < 2; ++b)
#pragma unroll
                for (int m = 0; m < 4; ++m)
#pragma unroll
                    for (int n = 0; n < 2; ++n) acc[a][b][m][n] = (f32x4){0.f, 0.f, 0.f, 0.f};
        cur = nxt; ++ui;
        if (wr == 1) G8_BAR;
    }
    G8_WAIT_V(0);
    G8_BAR;
#undef G8_SA
#undef G8_SB
#undef G8_STAGE
#undef G8_LDA
#undef G8_LDB
#undef G8_MMA
#undef G8_WAIT_V
#undef G8_WAIT_L
#undef G8_BAR
#undef G8_SCHED
}
struct EpiResid {
    const float* R32; bf16_t* S; float* SSQP;
    __device__ __forceinline__ void operator()(const f32x4 (&acc)[2][2][4][2], const Unit& u, int wr, int wc, int fr, int fq) const {
#pragma unroll
        for (int ai = 0; ai < 2; ++ai)
#pragma unroll
            for (int m = 0; m < 4; ++m) {
                const int row = u.pm * 256 + ai * 128 + wr * 64 + m * 16 + fr;
                const size_t o = (size_t)row * 1024 + u.pn * 256 + wc * 32 + fq * 8;
                float ss = 0.f;
#pragma unroll
                for (int bj = 0; bj < 2; ++bj) {
                    f32x4 a, b;
                    if (R32) { a = *(const f32x4*)(R32 + o + bj * 128); b = *(const f32x4*)(R32 + o + bj * 128 + 4); }
                    else { const u32x4 r = *(const u32x4*)(S + o + bj * 128); a = (f32x4){lo2f(r[0]), hi2f(r[0]), lo2f(r[1]), hi2f(r[1])}; b = (f32x4){lo2f(r[2]), hi2f(r[2]), lo2f(r[3]), hi2f(r[3])}; }
                    a += acc[ai][bj][m][0]; b += acc[ai][bj][m][1];
                    ss += a[0] * a[0] + a[1] * a[1] + a[2] * a[2] + a[3] * a[3] + b[0] * b[0] + b[1] * b[1] + b[2] * b[2] + b[3] * b[3];
                    uint4 w; w.x = pack2(a[0], a[1]); w.y = pack2(a[2], a[3]); w.z = pack2(b[0], b[1]); w.w = pack2(b[2], b[3]);
                    *(uint4*)(S + o + bj * 128) = w;
                }
                ss += __shfl_xor(ss, 16); ss += __shfl_xor(ss, 32);
                if (fq == 0) SSQP[(size_t)row * 32 + u.pn * 4 + wc] = ss;
            }
    }
};
struct EpiCinUS {
    bf16_t* U; const bf16_t* VT; const float* SSQ; const float* Wsp; const float* bsp; const float* vnorm; G8_LAS unsigned char* L; const float* RSTD;
    __device__ __forceinline__ void operator()(const f32x4 (&acc)[2][2][4][2], const Unit& u, int wr, int wc, int fr, int fq) const {
        const int tid = threadIdx.x, g = u.pn;
        G8_LAS float* RS = (G8_LAS float*)(L + 24576);
        unsigned gu[2][2][4][4];
#pragma unroll
        for (int ai = 0; ai < 2; ++ai)
#pragma unroll
            for (int bj = 0; bj < 2; ++bj)
#pragma unroll
                for (int m = 0; m < 4; ++m) {
                    const float rs = RSTD[u.pm * 256 + ai * 128 + wr * 64 + m * 16 + fr];
                    const f32x4 a = acc[ai][bj][m][0] * rs, b = acc[ai][bj][m][1] * rs;
                    const f32x2 g0 = gelu_exact2((f32x2){a[0], a[1]}), g1 = gelu_exact2((f32x2){a[2], a[3]}), g2 = gelu_exact2((f32x2){b[0], b[1]}), g3 = gelu_exact2((f32x2){b[2], b[3]});
                    gu[ai][bj][m][0] = pack2(g0[0], g0[1]); gu[ai][bj][m][1] = pack2(g1[0], g1[1]); gu[ai][bj][m][2] = pack2(g2[0], g2[1]); gu[ai][bj][m][3] = pack2(g3[0], g3[1]);
                }
        if (tid < 256) {
            const float* sp = SSQ + (size_t)(u.pm * 256 + tid) * 32;
            f32x4 s4 = *(const f32x4*)sp;
#pragma unroll
            for (int i = 1; i < 8; ++i) s4 += *(const f32x4*)(sp + 4 * i);
            RS[tid] = rsqrtf(((s4[0] + s4[1]) + (s4[2] + s4[3])) * (1.0f / 2048.0f) + EPS);
        }
        __syncthreads();
#pragma unroll
        for (int ai = 0; ai < 2; ++ai) {
            const int chunk = u.pm * 2 + ai;
            {
                const int t1 = tid >> 3, c1 = tid & 7;
#pragma unroll
                for (int part = 0; part < 3; ++part) {
                    const int t = part == 0 ? t1 : 64 + ((tid + (part - 1) * 512) >> 4), ch = part == 0 ? c1 : ((tid + (part - 1) * 512) & 15), s0 = ch * 8;
                    const float* wp = Wsp + (size_t)(g * 128 + t) * 128 + s0;
                    const f32x4 w0 = *(const f32x4*)wp, w1 = *(const f32x4*)(wp + 4);
                    const f32x4 r0 = *(const G8_LAS f32x4*)(RS + ai * 128 + s0), r1 = *(const G8_LAS f32x4*)(RS + ai * 128 + s0 + 4);
                    float v[8];
#pragma unroll
                    for (int j = 0; j < 4; ++j) { v[j] = (s0 + j <= t) ? w0[j] * r0[j] : 0.f; v[4 + j] = (s0 + 4 + j <= t) ? w1[j] * r1[j] : 0.f; }
                    u32x4 o; o.x = pack2(v[0], v[1]); o.y = pack2(v[2], v[3]); o.z = pack2(v[4], v[5]); o.w = pack2(v[6], v[7]);
                    const int off = part == 0 ? t * 128 + ((ch ^ (t & 7)) << 4) : 8192 + (t - 64) * 256 + ((ch ^ (t & 7)) << 4);
                    *(G8_LAS u32x4*)(L + off) = o;
                }
            }
            __syncthreads();
            float bias[4];
#pragma unroll
            for (int m = 0; m < 4; ++m) bias[m] = bsp[g * 128 + wr * 64 + m * 16 + fr];
#pragma unroll
            for (int bj = 0; bj < 2; ++bj) {
                f32x4 mac[4][2];
#pragma unroll
                for (int m = 0; m < 4; ++m)
#pragma unroll
                    for (int n = 0; n < 2; ++n) mac[m][n] = (f32x4){0.f, 0.f, 0.f, 0.f};
                const int cb = u.pn * 256 + bj * 128 + wc * 32;
                const bf16_t* vrow0 = VT + ((size_t)chunk * 2048 + cb + perm32(fr)) * 128 + fq * 8;
                const bf16_t* vrow1 = VT + ((size_t)chunk * 2048 + cb + perm32(16 + fr)) * 128 + fq * 8;
                bf16x8 bf0[4], bf1[4];
#pragma unroll
                for (int kk = 0; kk < 4; ++kk) { if (kk < 2 || wr == 1) { bf0[kk] = *(const bf16x8*)(vrow0 + kk * 32); bf1[kk] = *(const bf16x8*)(vrow1 + kk * 32); } }
#pragma unroll
                for (int kk = 0; kk < 4; ++kk) {
                    if (kk < 2 || wr == 1) {
                        bf16x8 af[4];
#pragma unroll
                        for (int m = 0; m < 4; ++m) {
                            const int t = wr * 64 + m * 16 + fr, chn = kk * 4 + fq;
                            const int off = wr == 0 ? t * 128 + ((chn ^ (t & 7)) << 4) : 8192 + (t - 64) * 256 + ((chn ^ (t & 7)) << 4);
                            af[m] = *(const G8_LAS bf16x8*)(L + off);
                        }
#pragma unroll
                        for (int m = 0; m < 4; ++m) {
                            mac[m][0] = __builtin_amdgcn_mfma_f32_16x16x32_bf16(bf0[kk], af[m], mac[m][0], 0, 0, 0);
                            mac[m][1] = __builtin_amdgcn_mfma_f32_16x16x32_bf16(bf1[kk], af[m], mac[m][1], 0, 0, 0);
                        }
                    }
                }
                const f32x4 vn0 = *(const f32x4*)(vnorm + cb + fq * 8), vn1 = *(const f32x4*)(vnorm + cb + fq * 8 + 4);
#pragma unroll
                for (int m = 0; m < 4; ++m) {
                    const f32x4 x0 = vn0 * mac[m][0] + bias[m], x1 = vn1 * mac[m][1] + bias[m];
                    const unsigned q0 = gu[ai][bj][m][0], q1 = gu[ai][bj][m][1], q2 = gu[ai][bj][m][2], q3 = gu[ai][bj][m][3];
                    uint4 o; o.x = pack2(lo2f(q0) * x0[0], hi2f(q0) * x0[1]); o.y = pack2(lo2f(q1) * x0[2], hi2f(q1) * x0[3]); o.z = pack2(lo2f(q2) * x1[0], hi2f(q2) * x1[1]); o.w = pack2(lo2f(q3) * x1[2], hi2f(q3) * x1[3]);
                    *(uint4*)(U + (size_t)(u.pm * 256 + ai * 128 + wr * 64 + m * 16 + fr) * 2048 + cb + fq * 8) = o;
                }
            }
            __syncthreads();
        }
    }
};
struct EpiCinV {
    bf16_t* VT; float* SSQ; const float* RSTD;
    __device__ __forceinline__ void operator()(const f32x4 (&acc)[2][2][4][2], const Unit& u, int wr, int wc, int fr, int fq) const {
        f32x4 rs[2][2];
#pragma unroll
        for (int bj = 0; bj < 2; ++bj)
#pragma unroll
            for (int n = 0; n < 2; ++n) rs[bj][n] = *(const f32x4*)(RSTD + u.pn * 256 + bj * 128 + wc * 32 + fq * 8 + n * 4);
#pragma unroll
        for (int ai = 0; ai < 2; ++ai) {
            float ss[16];
#pragma unroll
            for (int i = 0; i < 16; ++i) ss[i] = 0.f;
#pragma unroll
            for (int m = 0; m < 4; ++m) {
                const int c = u.pm * 256 + ai * 128 + wr * 64 + m * 16 + fr;
#pragma unroll
                for (int bj = 0; bj < 2; ++bj) {
                    float g[8];
#pragma unroll
                    for (int n = 0; n < 2; ++n)
#pragma unroll
                        for (int r = 0; r < 4; r += 2) {
                            const f32x2 x = gelu_exact2((f32x2){acc[ai][bj][m][n][r] * rs[bj][n][r], acc[ai][bj][m][n][r + 1] * rs[bj][n][r + 1]});
                            g[n * 4 + r] = x[0]; g[n * 4 + r + 1] = x[1]; ss[bj * 8 + n * 4 + r] += x[0] * x[0]; ss[bj * 8 + n * 4 + r + 1] += x[1] * x[1];
                        }
                    uint4 o; o.x = pack2(g[0], g[1]); o.y = pack2(g[2], g[3]); o.z = pack2(g[4], g[5]); o.w = pack2(g[6], g[7]);
                    *(uint4*)(VT + ((size_t)(u.pn * 2 + bj) * 2048 + c) * 128 + wc * 32 + fq * 8) = o;
                }
            }
            float mine = 0.f;
#pragma unroll
            for (int i = 0; i < 16; ++i) { const float s = row16_sum(ss[i]); mine = (fr == i) ? s : mine; }
            const int tok = u.pn * 256 + (fr >> 3) * 128 + wc * 32 + fq * 8 + (fr & 7);
            SSQ[(size_t)tok * 32 + u.pm * 4 + ai * 2 + wr] = mine;
        }
    }
};
struct EpiInN {
    bf16_t* R;
    __device__ __forceinline__ void operator()(const f32x4 (&acc)[2][2][4][2], const Unit& u, int wr, int wc, int fr, int fq) const {
        bf16_t* base; int pitch; float sc = 1.0f;
        if (u.pn < 2) { base = R + R_QSB + u.pn * 256; pitch = 512; sc = 0.125f; }
        else if (u.pn < 4) { base = R + R_KSB + (u.pn - 2) * 256; pitch = 512; }
        else if (u.pn == 4) { base = R + R_QG; pitch = 256; }
        else if (u.pn == 5) { base = R + R_KG; pitch = 256; }
        else { base = R + R_GG + (u.pn - 6) * 256; pitch = 512; }
#pragma unroll
        for (int ai = 0; ai < 2; ++ai)
#pragma unroll
            for (int m = 0; m < 4; ++m) {
                bf16_t* rp = base + (size_t)(u.pm * 256 + ai * 128 + wr * 64 + m * 16 + fr) * pitch + wc * 32 + fq * 8;
#pragma unroll
                for (int bj = 0; bj < 2; ++bj) {
                    f32x4 a = acc[ai][bj][m][0] * sc, b = acc[ai][bj][m][1] * sc;
                    if (u.pn >= 6) {
#pragma unroll
                        for (int r = 0; r < 4; ++r) { a[r] = a[r] * __builtin_amdgcn_rcpf(1.0f + __expf(-a[r])); b[r] = b[r] * __builtin_amdgcn_rcpf(1.0f + __expf(-b[r])); }
                    }
                    uint4 o; o.x = pack2(a[0], a[1]); o.y = pack2(a[2], a[3]); o.z = pack2(b[0], b[1]); o.w = pack2(b[2], b[3]);
                    *(uint4*)(rp + bj * 128) = o;
                }
            }
    }
};
struct EpiInT {
    bf16_t* R;
    __device__ __forceinline__ void operator()(const f32x4 (&acc)[2][2][4][2], const Unit& u, int wr, int wc, int fr, int fq) const {
#pragma unroll
        for (int ai = 0; ai < 2; ++ai)
#pragma unroll
            for (int m = 0; m < 4; ++m) {
                const int c = u.pm * 256 + ai * 128 + wr * 64 + m * 16 + fr;
#pragma unroll
                for (int bj = 0; bj < 2; ++bj) {
                    const int t = u.pn * 256 + bj * 128 + wc * 32 + fq * 8, b = t >> 11, s = t & 2047;
                    bf16_t* dst;
                    if (c < 512) dst = R + R_VTSB + ((size_t)((b * 8 + (c >> 6)) * 64 + (c & 63))) * 2048 + s;
                    else { const int c2 = c - 512; dst = R + R_VTG + ((size_t)((b * 4 + (c2 >> 7)) * 128 + (c2 & 127))) * 2048 + s; }
                    const f32x4 a = acc[ai][bj][m][0], bb = acc[ai][bj][m][1];
                    uint4 o; o.x = pack2(a[0], a[1]); o.y = pack2(a[2], a[3]); o.z = pack2(bb[0], bb[1]); o.w = pack2(bb[2], bb[3]);
                    *(uint4*)dst = o;
                }
            }
    }
};
}
__device__ __forceinline__ void phase_gemm_resid8(const bf16_t* A0, const bf16_t* A1, int lda, int ksplit, const bf16_t* Bt, int K, const float* R32, bf16_t* Sres, float* SSQP, char* smem_phys) {
    g8::Gemm g{A0, A1, lda, ksplit, Bt, T, 1024, K};
    g8::StaticOrder S; S.init(T, 1024, (int)gridDim.x, (int)blockIdx.x);
    g8::EpiResid E{R32, Sres, SSQP};
    g8::gemm_phase<g8::EpiResid>((G8_LAS unsigned char*)smem_phys, g, S, E);
}

__device__ __forceinline__ void phase_gemm_cin8_v(const Params& p, char* smem_phys) {
    const bf16_t* H = (const bf16_t*)(p.ws + OFF_S); const bf16_t* W = (const bf16_t*)(p.ws + OFF_WT_CIN);
    bf16_t* U = (bf16_t*)(p.ws + OFF_REGION); bf16_t* VT = U + (size_t)T * 2048; float* SSQ = (float*)(p.ws + OFF_SSQ);
    const bf16_t* Wv = W + (size_t)2048 * 1024;
    g8::Gemm g{Wv, Wv, 1024, 1024, H, 2048, T, 1024};
    g8::StaticOrder S; S.init(2048, T, (int)gridDim.x, (int)blockIdx.x);
    g8::EpiCinV E{VT, SSQ, (const float*)(p.ws + OFF_VSC)};
    g8::gemm_phase<g8::EpiCinV>((G8_LAS unsigned char*)smem_phys, g, S, E);
}
__device__ __forceinline__ void phase_gemm_cin8_u(const Params& p, char* smem_phys) {
    const bf16_t* H = (const bf16_t*)(p.ws + OFF_S); const bf16_t* W = (const bf16_t*)(p.ws + OFF_WT_CIN);
    bf16_t* U = (bf16_t*)(p.ws + OFF_REGION); bf16_t* VT = U + (size_t)T * 2048; float* SSQ = (float*)(p.ws + OFF_SSQ);
    g8::Gemm g{H, H, 1024, 1024, W, T, 2048, 1024};
    g8::StaticOrder S; S.init(T, 2048, (int)gridDim.x, (int)blockIdx.x);
    g8::EpiCinUS E{U, VT, SSQ, p.c_w_spatial, p.c_b_spatial, p.c_v_norm, (G8_LAS unsigned char*)(smem_phys + 131072), (const float*)(p.ws + OFF_VSC)};
    g8::gemm_phase<g8::EpiCinUS>((G8_LAS unsigned char*)smem_phys, g, S, E);
}
__device__ __forceinline__ void phase_gemm_in8(const Params& p, char* smem_phys) {
    const bf16_t* H = (const bf16_t*)(p.ws + OFF_H); const bf16_t* W = (const bf16_t*)(p.ws + OFF_WT_IN);
    bf16_t* R = (bf16_t*)(p.ws + OFF_REGION);
    {
        g8::Gemm g{H, H, 1024, 1024, W, T, 2048, 1024};
        g8::StaticOrder S; S.init(T, 2048, (int)gridDim.x, (int)blockIdx.x);
        g8::EpiInN E{R};
        g8::gemm_phase<g8::EpiInN>((G8_LAS unsigned char*)smem_phys, g, S, E);
    }
    {
        const bf16_t* Wv = W + (size_t)2048 * 1024;
        g8::Gemm g{Wv, Wv, 1024, 1024, H, 1024, T, 1024};
        g8::StaticOrder S; S.init(1024, T, (int)gridDim.x, (int)blockIdx.x);
        g8::EpiInT E{R};
        g8::gemm_phase<g8::EpiInT>((G8_LAS unsigned char*)smem_phys, g, S, E);
    }
    {
        const int lane = threadIdx.x & 63, wid = threadIdx.x >> 6, fr = lane & 15, fq = lane >> 4;
        float* ALR = (float*)(R + R_ALR);
        for (int task = (int)blockIdx.x * 8 + wid; task < T / 16; task += (int)gridDim.x * 8) {
            const bf16_t* a = H + (size_t)(task * 16 + fr) * 1024 + fq * 8; const bf16_t* w = W + (size_t)(3072 + fr) * 1024 + fq * 8;
            f32x4 acc = (f32x4){0.f, 0.f, 0.f, 0.f};
#pragma unroll 8
            for (int kk = 0; kk < 32; ++kk) {
                const bf16x8 af = *(const bf16x8*)(a + kk * 32), wf = *(const bf16x8*)(w + kk * 32);
                acc = __builtin_amdgcn_mfma_f32_16x16x32_bf16(wf, af, acc, 0, 0, 0);
            }
            *(f32x4*)(ALR + (size_t)(task * 16 + fr) * 16 + fq * 4) = acc;
        }
    }
}


typedef float f32x16 __attribute__((ext_vector_type(16)));
__device__ __forceinline__ void sb_fast(const Params& p, char* smem, unsigned* ctr) {
    bf16_t* R = (bf16_t*)(p.ws + OFF_REGION);
    char* KT = smem; char* VTt = smem + 8192;
    volatile int* flags = (volatile int*)(smem + 32768); volatile unsigned* slot = (volatile unsigned*)(smem + 32832);
    const int tid = threadIdx.x, lane = tid & 63, w = tid >> 6, r31 = lane & 31, h = lane >> 5;
    for (;;) {
        __syncthreads();
        if (tid == 0) *slot = atomicAdd(ctr, 1u);
        __syncthreads();
        const unsigned task = *slot;
        if (task >= 1024u) break;
        const int qblk = 7 - (int)(task >> 7), bh = task & 127, b = bh >> 3, hh = bh & 7;
        const int q0 = qblk * 256, qbase = q0 + 32 * w;
        bf16_t* qrow = R + R_QSB + (size_t)(b * 2048 + qbase + r31) * 512 + hh * 64;
        bf16x8 qf[4];
#pragma unroll
        for (int kk = 0; kk < 4; ++kk) qf[kk] = *(const bf16x8*)(qrow + 16 * kk + 8 * h);
        f32x16 oacc[2];
#pragma unroll
        for (int nt = 0; nt < 2; ++nt)
#pragma unroll
            for (int i = 0; i < 16; ++i) oacc[nt][i] = 0.f;
        float Rr = 1.0f;
        const int t = qbase + r31;
        for (int kt = q0 / 64 + 3; kt >= 0; --kt) {
            __syncthreads();
            { const int wd = __all(Rr == 0.f); if (lane == 0) flags[w] = wd; }
            __syncthreads();
            if (flags[0] & flags[1] & flags[2] & flags[3] & flags[4] & flags[5] & flags[6] & flags[7]) break;
            const int s_tile = kt * 64;
            {
                const int c = tid, row = c >> 3, ch = c & 7;
                const u32x4 kv = *(const u32x4*)(R + R_KSB + (size_t)(b * 2048 + s_tile + row) * 512 + hh * 64 + ch * 8);
                const u32x4 vv = *(const u32x4*)(R + R_VTSB + ((size_t)((b * 8 + hh) * 64 + row)) * 2048 + s_tile + ch * 8);
                *(u32x4*)(KT + row * 128 + ((ch ^ (row & 7)) << 4)) = kv;
                *(uint2*)(VTt + row * 136 + ch * 16) = make_uint2(vv[0], vv[1]);
                *(uint2*)(VTt + row * 136 + ch * 16 + 8) = make_uint2(vv[2], vv[3]);
            }
            __syncthreads();
#pragma unroll
            for (int sbk = 1; sbk >= 0; --sbk) {
                const int key_lo = s_tile + 32 * sbk;
                if (key_lo >= qbase + 31) continue;
                if (__all(Rr == 0.f)) continue;
                f32x16 st;
#pragma unroll
                for (int i = 0; i < 16; ++i) st[i] = 0.f;
                const int krow = 32 * sbk + r31;
#pragma unroll
                for (int kk = 0; kk < 4; ++kk) {
                    const bf16x8 kf = *(const bf16x8*)(KT + krow * 128 + (((2 * kk + h) ^ (krow & 7)) << 4));
                    st = __builtin_amdgcn_mfma_f32_32x32x16_bf16(kf, qf[kk], st, 0, 0, 0);
                }
                float a[16], G[4];
                const bool diag = key_lo + 31 >= qbase;
#pragma unroll
                for (int g = 0; g < 4; ++g) {
                    float sg[4], m[4];
#pragma unroll
                    for (int i = 0; i < 4; ++i) {
                        const float z = fmaxf(st[4 * g + i], -80.f);
                        const float ez = __builtin_amdgcn_exp2f(z * -1.4426950409f), sig = __builtin_amdgcn_rcpf(1.0f + ez);
                        sg[i] = sig; m[i] = ez * sig;
                    }
                    if (diag) {
#pragma unroll
                        for (int i = 0; i < 4; ++i) { const bool valid = key_lo + 8 * g + 4 * h + i < t; sg[i] = valid ? sg[i] : 0.f; m[i] = valid ? m[i] : 1.0f; }
                    }
                    const float x2 = m[3], x1 = x2 * m[2], x0 = x1 * m[1];
                    G[g] = x0 * m[0];
                    a[4 * g + 3] = sg[3]; a[4 * g + 2] = sg[2] * x2; a[4 * g + 1] = sg[1] * x1; a[4 * g] = sg[0] * x0;
                }
                float Go[4], P[4];
#pragma unroll
                for (int g = 0; g < 4; ++g) { Go[g] = __shfl_xor(G[g], 32); P[g] = G[g] * Go[g]; }
                const float c2 = P[3], c1 = c2 * P[2], c0 = c1 * P[1];
                float Tg[4];
                Tg[3] = Rr; Tg[2] = Rr * c2; Tg[1] = Rr * c1; Tg[0] = Rr * c0;
#pragma unroll
                for (int g = 0; g < 4; ++g) {
                    const float tg = (h == 0) ? Tg[g] * Go[g] : Tg[g];
                    a[4 * g] *= tg; a[4 * g + 1] *= tg; a[4 * g + 2] *= tg; a[4 * g + 3] *= tg;
                }
                Rr = Rr * c0 * P[0];
#pragma unroll
                for (int s2 = 0; s2 < 2; ++s2) {
                    union { bf16x8 v; unsigned u[4]; } af;
#pragma unroll
                    for (int j2 = 0; j2 < 4; ++j2) af.u[j2] = pack2(a[8 * s2 + 2 * j2], a[8 * s2 + 2 * j2 + 1]);
#pragma unroll
                    for (int nt = 0; nt < 2; ++nt) {
                        const char* vp = VTt + (32 * nt + r31) * 136 + 64 * sbk + 32 * s2 + 8 * h;
                        union { bf16x8 v; uint2 hh2[2]; } vf;
                        vf.hh2[0] = *(const uint2*)vp; vf.hh2[1] = *(const uint2*)(vp + 16);
                        oacc[nt] = __builtin_amdgcn_mfma_f32_32x32x16_bf16(af.v, vf.v, oacc[nt], 0, 0, 0);
                    }
                }
            }
        }
#pragma unroll
        for (int nt = 0; nt < 2; ++nt)
#pragma unroll
            for (int i = 0; i < 16; ++i) {
                const int qq = (i & 3) + 8 * (i >> 2) + 4 * h;
                R[R_QSB + (size_t)(b * 2048 + qbase + qq) * 512 + hh * 64 + 32 * nt + r31] = f2bf(oacc[nt][i]);
            }
    }
}
__device__ __forceinline__ float log_sigmoid(float x) { return fminf(x, 0.f) - __logf(1.0f + __expf(-fabsf(x))); }
__device__ __forceinline__ int swz(int row, int chunk) { return row * 128 + ((chunk ^ (row & 7)) << 4); }
__device__ __forceinline__ void gla_prep(const Params& p, char* smem) {
    bf16_t* R = (bf16_t*)(p.ws + OFF_REGION);
    const float* ALR = (const float*)(R + R_ALR);
    bf16_t* KOTg = R + R_KOT; float* DECg = (float*)(R + R_DEC);
    float* SEG = (float*)smem; float* ALRs = SEG + 256;
    const int tid = VTID, d = tid & 63, w = tid >> 6;
    for (int task = VBID; task < 2048; task += VGRID) {
        const int bh = task >> 5, c = task & 31, b = bh >> 2, hh = bh & 3;
        const size_t rowbase = (size_t)b * 2048 + c * 64;
        unsigned qr[16], kr[16];
#pragma unroll
        for (int i = 0; i < 16; ++i) { const size_t row = rowbase + w * 16 + i; qr[i] = R[R_QG + row * 256 + hh * 64 + d]; kr[i] = R[R_KG + row * 256 + hh * 64 + d]; }
        const f32x4 ar = *(const f32x4*)(ALR + rowbase * 16 + tid * 4);
        float w2r[16];
#pragma unroll
        for (int r = 0; r < 16; ++r) w2r[r] = p.ab_w_alpha2[r * 256 + hh * 64 + d];
        const float b2r = p.ab_b_alpha2[hh * 64 + d];
        __syncthreads();
        *(f32x4*)(ALRs + tid * 4) = ar;
        __syncthreads();
        float cs[16]; float run = 0.f;
#pragma unroll
        for (int i = 0; i < 16; ++i) {
            const float* al = ALRs + (w * 16 + i) * 16;
            float pre = b2r;
#pragma unroll
            for (int r = 0; r < 16; ++r) pre += al[r] * w2r[r];
            run += log_sigmoid(pre) * (1.0f / 16.0f);
            cs[i] = run;
        }
        SEG[w * 64 + d] = run;
        __syncthreads();
        float off = 0.f, tot = 0.f;
#pragma unroll
        for (int w2 = 0; w2 < 4; ++w2) { const float s = SEG[w2 * 64 + d]; tot += s; if (w2 < w) off += s; }
        unsigned kop[8];
#pragma unroll
        for (int i2 = 0; i2 < 8; ++i2) {
            float kov[2];
#pragma unroll
            for (int u = 0; u < 2; ++u) {
                const int i = 2 * i2 + u;
                const float bc = off + cs[i];
                const float kv = bf2f((bf16_t)kr[i]);
                const size_t row = rowbase + w * 16 + i;
                R[R_QG + row * 256 + hh * 64 + d] = f2bf(bf2f((bf16_t)qr[i]) * 0.125f * __expf(bc));
                R[R_KG + row * 256 + hh * 64 + d] = f2bf(kv * __expf(-bc));
                kov[u] = kv * __expf(tot - bc);
            }
            kop[i2] = pack2(kov[0], kov[1]);
        }
        bf16_t* kp = KOTg + ((size_t)task * 64 + d) * 64 + w * 16;
        *(uint4*)kp = make_uint4(kop[0], kop[1], kop[2], kop[3]);
        *(uint4*)(kp + 8) = make_uint4(kop[4], kop[5], kop[6], kop[7]);
        if (w == 0) DECg[(size_t)task * 64 + d] = __expf(tot);
    }
}
__device__ __forceinline__ void gla_scan(const Params& p, char* smem, bool dry = false) {
    bf16_t* R = (bf16_t*)(p.ws + OFF_REGION);
    const bf16_t* KOTg = R + R_KOT; const float* DECg = (const float*)(R + R_DEC);
    char* QS = smem; char* KS = smem + 8192; char* KOT = smem + 16384; char* VTs = smem + 24576; char* SPT = smem + 40960;
    float* DEC = (float*)(smem + 57344); float* GN = DEC + 64;
    const int tid = VTID, lane = tid & 63, w = tid >> 6, l15_ = lane & 15, q4 = lane >> 4;
    for (int task = VBID; task < 64; task += VGRID) {
        const int b = task >> 2, hh = task & 3;
        f32x4 Sacc[8];
#pragma unroll
        for (int nt = 0; nt < 8; ++nt) Sacc[nt] = (f32x4){0.f, 0.f, 0.f, 0.f};
        __syncthreads();
        for (int i = tid; i < 1024; i += 256) *(uint4*)(SPT + i * 16) = make_uint4(0, 0, 0, 0);
        if (tid < 128) GN[tid] = p.ab_gla_norm[hh * 128 + tid];
        const size_t rowbase = (size_t)b * 2048;
        const bf16_t* vbase = R + R_VTG + ((size_t)((b * 4 + hh) * 128)) * 2048;
        u32x4 tq[2], tk[2], tko[2], vr[4]; float td = 0.f;
        auto prefetch = [&](int c) {
            const int t0 = c * 64;
#pragma unroll
            for (int i = 0; i < 2; ++i) {
                const int cid = tid + 256 * i, row = cid >> 3, ch = cid & 7;
                tq[i] = *(const u32x4*)(R + R_QG + (rowbase + t0 + row) * 256 + hh * 64 + ch * 8);
                tk[i] = *(const u32x4*)(R + R_KG + (rowbase + t0 + row) * 256 + hh * 64 + ch * 8);
                tko[i] = *(const u32x4*)(KOTg + (((size_t)task * 32 + c) * 64 + row) * 64 + ch * 8);
            }
#pragma unroll
            for (int i = 0; i < 4; ++i) { const int cid = tid + 256 * i, e = cid >> 3, ch = cid & 7; vr[i] = *(const u32x4*)(vbase + (size_t)e * 2048 + t0 + ch * 8); }
            if (tid < 64) td = DECg[((size_t)task * 32 + c) * 64 + tid];
        };
        prefetch(0);
        for (int c = 0; c < 32; ++c) {
            int lz = 0; asm volatile("" : "+v"(lz));
            const int l15 = l15_ + lz;
            const int cx = (q4 ^ (l15 & 7)) << 4;
            const int rb0 = l15 * 128 + cx, rb1 = l15 * 128 + (cx ^ 64);
#pragma unroll
            for (int i = 0; i < 2; ++i) {
                const int cid = tid + 256 * i + lz, row = cid >> 3, ch = cid & 7;
                *(u32x4*)(QS + swz(row, ch)) = tq[i]; *(u32x4*)(KS + swz(row, ch)) = tk[i]; *(u32x4*)(KOT + swz(row, ch)) = tko[i];
            }
#pragma unroll
            for (int i = 0; i < 4; ++i) { const int cid = tid + 256 * i + lz, e = cid >> 3, ch = cid & 7; *(u32x4*)(VTs + swz(e, ch)) = vr[i]; }
            if (tid < 64) DEC[tid] = td;
            uint2 gr[8];
            const unsigned goff = (unsigned)((rowbase + c * 64 + 16 * w + l15) * 512 + hh * 128 + 4 * q4);
            bf16_t* const gbase = R + R_GG;
#pragma unroll
            for (int nt = 0; nt < 8; ++nt) gr[nt] = *(const uint2*)(gbase + (goff + 16 * nt));
            if (c + 1 < 32) prefetch(c + 1);
            __syncthreads();
            bf16x8 qf[2];
#pragma unroll
            for (int kk = 0; kk < 2; ++kk) qf[kk] = *(const bf16x8*)(QS + w * 2048 + (kk ? rb1 : rb0));
            f32x4 sT[4];
#pragma unroll
            for (int st = 0; st < 4; ++st) {
                sT[st] = (f32x4){0.f, 0.f, 0.f, 0.f};
                if (st <= w) {
#pragma unroll
                    for (int kk = 0; kk < 2; ++kk) { const bf16x8 kf = *(const bf16x8*)(KS + st * 2048 + (kk ? rb1 : rb0)); sT[st] = __builtin_amdgcn_mfma_f32_16x16x32_bf16(kf, qf[kk], sT[st], 0, 0, 0); }
#pragma unroll
                    for (int r = 0; r < 4; ++r) if (16 * st + 4 * q4 + r > 16 * w + l15) sT[st][r] = 0.f;
                }
            }
            bf16x8 af[2];
#pragma unroll
            for (int ks2 = 0; ks2 < 2; ++ks2) {
                union { bf16x8 v; unsigned u[4]; } cv;
                cv.u[0] = pack2(sT[2 * ks2][0], sT[2 * ks2][1]); cv.u[1] = pack2(sT[2 * ks2][2], sT[2 * ks2][3]);
                cv.u[2] = pack2(sT[2 * ks2 + 1][0], sT[2 * ks2 + 1][1]); cv.u[3] = pack2(sT[2 * ks2 + 1][2], sT[2 * ks2 + 1][3]);
                af[ks2] = cv.v;
            }
            const int vb = l15 * 128 + ((((q4 >> 1) ^ (l15 & 7)) << 4) | ((q4 & 1) * 8));
            f32x4 o[8];
#pragma unroll
            for (int nt = 0; nt < 8; ++nt) {
                o[nt] = (f32x4){0.f, 0.f, 0.f, 0.f};
                const int e = 16 * nt + l15;
#pragma unroll
                for (int kk = 0; kk < 2; ++kk) { const bf16x8 sf = *(const bf16x8*)(SPT + nt * 2048 + (kk ? rb1 : rb0)); o[nt] = __builtin_amdgcn_mfma_f32_16x16x32_bf16(sf, qf[kk], o[nt], 0, 0, 0); }
#pragma unroll
                for (int ks2 = 0; ks2 < 2; ++ks2) {
                    if (2 * ks2 <= w) {
                        union { bf16x8 v; uint2 h[2]; } cv;
                        cv.h[0] = *(const uint2*)(VTs + nt * 2048 + (vb ^ (ks2 * 64)));
                        cv.h[1] = *(const uint2*)(VTs + nt * 2048 + (vb ^ (ks2 * 64) ^ 32));
                        o[nt] = __builtin_amdgcn_mfma_f32_16x16x32_bf16(cv.v, af[ks2], o[nt], 0, 0, 0);
                    }
                }
            }
            {
                const float4 dc = *(const float4*)(DEC + 16 * w + 4 * q4);
                bf16x8 kof[2];
#pragma unroll
                for (int kk = 0; kk < 2; ++kk) kof[kk] = *(const bf16x8*)(KOT + w * 2048 + (kk ? rb1 : rb0));
#pragma unroll
                for (int nt = 0; nt < 8; ++nt) {
                    Sacc[nt][0] *= dc.x; Sacc[nt][1] *= dc.y; Sacc[nt][2] *= dc.z; Sacc[nt][3] *= dc.w;
#pragma unroll
                    for (int kk = 0; kk < 2; ++kk) { const bf16x8 vf = *(const bf16x8*)(VTs + nt * 2048 + (kk ? rb1 : rb0)); Sacc[nt] = __builtin_amdgcn_mfma_f32_16x16x32_bf16(kof[kk], vf, Sacc[nt], 0, 0, 0); }
                }
            }
            __syncthreads();
#pragma unroll
            for (int nt = 0; nt < 8; ++nt) {
                const int e = 16 * nt + l15;
                uint2 pk; pk.x = pack2(Sacc[nt][0], Sacc[nt][1]); pk.y = pack2(Sacc[nt][2], Sacc[nt][3]);
                *(uint2*)(SPT + nt * 2048 + l15 * 128 + (((2 * w + (q4 >> 1)) ^ (l15 & 7)) << 4) + (q4 & 1) * 8) = pk;
            }
            float ssq = 0.f;
#pragma unroll
            for (int nt = 0; nt < 8; ++nt) ssq += (o[nt][0] * o[nt][0] + o[nt][1] * o[nt][1]) + (o[nt][2] * o[nt][2] + o[nt][3] * o[nt][3]);
            ssq += __shfl_xor(ssq, 16); ssq += __shfl_xor(ssq, 32);
            const float rsd = rsqrtf(ssq * (1.0f / 128.0f) + EPS);
#pragma unroll
            for (int nt = 0; nt < 8; ++nt) {
                asm volatile("" ::: "memory");
                const f32x4 gn = *(const f32x4*)(GN + 16 * nt + 4 * q4);
                const float g0 = lo2f(gr[nt].x), g1 = hi2f(gr[nt].x), g2 = lo2f(gr[nt].y), g3 = hi2f(gr[nt].y);
                uint2 ov;
                ov.x = pack2(o[nt][0] * rsd * gn[0] * g0, o[nt][1] * rsd * gn[1] * g1);
                ov.y = pack2(o[nt][2] * rsd * gn[2] * g2, o[nt][3] * rsd * gn[3] * g3);
                if (!dry || ov.x == 0x7fc17fc1u) *(uint2*)(gbase + (goff + 16 * nt)) = ov;
            }
        }
    }
}

__device__ __forceinline__ unsigned ord_key(float f) { const unsigned u = __float_as_uint(f); return (u & 0x80000000u) ? ~u : (u | 0x80000000u); }
__device__ __forceinline__ float unord_key(unsigned k) { return __uint_as_float((k & 0x80000000u) ? (k & 0x7fffffffu) : ~k); }
__device__ __forceinline__ void ce_desc(unsigned& a, unsigned& b) { const unsigned hi = max(a, b), lo = min(a, b); a = hi; b = lo; }
__device__ __forceinline__ void bitonic_sort16_desc(unsigned (&a)[16]) {
#pragma unroll
    for (int k = 2; k <= 16; k <<= 1)
#pragma unroll
        for (int j = k >> 1; j > 0; j >>= 1)
#pragma unroll
            for (int i = 0; i < 16; ++i) { const int l = i ^ j; if (l > i) { if ((i & k) == 0) ce_desc(a[i], a[l]); else ce_desc(a[l], a[i]); } }
}
__device__ __forceinline__ void merge_top16(unsigned (&L)[16], const unsigned (&B)[16]) {
#pragma unroll
    for (int i = 0; i < 16; ++i) L[i] = max(L[i], B[15 - i]);
#pragma unroll
    for (int j = 8; j > 0; j >>= 1)
#pragma unroll
        for (int i = 0; i < 16; ++i) { const int l = i ^ j; if (l > i) ce_desc(L[i], L[l]); }
}
__device__ constexpr int cand_i(int n) { int c = 0; for (int i = 0; i < 16; ++i) for (int j = 0; j < 16; ++j) if ((i + 1) * (j + 1) <= 16) { if (c == n) return i; ++c; } return -1; }
__device__ constexpr int cand_j(int n) { int c = 0; for (int i = 0; i < 16; ++i) for (int j = 0; j < 16; ++j) if ((i + 1) * (j + 1) <= 16) { if (c == n) return j; ++c; } return -1; }
template <int N> struct CandTab { int i[N], j[N]; constexpr CandTab() : i(), j() { for (int n = 0; n < N; ++n) { i[n] = cand_i(n); j[n] = cand_j(n); } } };

__device__ __forceinline__ bf16x8 pack8(const float4 a, const float4 b) {
    u32x4 t; t.x = pack2(a.x, a.y); t.y = pack2(a.z, a.w); t.z = pack2(b.x, b.y); t.w = pack2(b.z, b.w);
    return __builtin_bit_cast(bf16x8, t);
}
__device__ __forceinline__ void fold_query_weights(const Params& p, int vb0 = 0) {
    int lz = 0; asm volatile("" : "+v"(lz));
    const int lane = (VTID & 63) + lz, wid = VTID >> 6, fr = lane & 15, fq = lane >> 4;
    bf16_t* Wf = (bf16_t*)(p.ws + OFF_WT_Q);
    if (VBID < vb0) return;
    for (int task = VBID - vb0; task < 512; task += VGRID - vb0) {
        const int kb = task & 15, pp = (task >> 4) & 1, h = (task >> 5) & 7, layer = task >> 8;
        const float* wq = p.peer_w_q + (size_t)layer * 1024 * 2048 + (size_t)(kb * 64 + fr) * 2048 + h * 256 + pp * 128 + fq * 8;
        const float* sk = p.peer_subkeys + ((size_t)((layer * 8 + h) * 2 + pp) * 128 + wid * 32 + fr) * 128 + fq * 8;
        f32x4 acc[4][2];
#pragma unroll
        for (int kt = 0; kt < 4; ++kt)
#pragma unroll
            for (int jt = 0; jt < 2; ++jt) acc[kt][jt] = (f32x4){0.f, 0.f, 0.f, 0.f};
#pragma unroll 1
        for (int s = 0; s < 4; ++s) {
            bf16x8 a[4], b[2];
#pragma unroll
            for (int kt = 0; kt < 4; ++kt) { const float* q = wq + (size_t)(kt * 16) * 2048 + s * 32; a[kt] = pack8(*(const float4*)q, *(const float4*)(q + 4)); }
#pragma unroll
            for (int jt = 0; jt < 2; ++jt) { const float* q = sk + (size_t)(jt * 16) * 128 + s * 32; b[jt] = pack8(*(const float4*)q, *(const float4*)(q + 4)); }
#pragma unroll
            for (int kt = 0; kt < 4; ++kt)
#pragma unroll
                for (int jt = 0; jt < 2; ++jt) acc[kt][jt] = __builtin_amdgcn_mfma_f32_16x16x32_bf16(a[kt], b[jt], acc[kt][jt], 0, 0, 0);
        }
#pragma unroll
        for (int jt = 0; jt < 2; ++jt) {
            const int key = wid * 32 + jt * 16 + fr, cu = 128 * ((key >> 5) & 1) + 32 * (2 * pp + (key >> 6)) + (key & 31);
            bf16_t* row = Wf + ((size_t)layer * 2048 + h * 256 + cu) * 1024 + kb * 64 + 4 * fq;
#pragma unroll
            for (int kt = 0; kt < 4; ++kt) store_bf16x4(row + kt * 16, acc[kt][jt] * *(const f32x4*)(p.norm_ffn + layer * 1024 + kb * 64 + kt * 16 + 4 * fq));
        }
    }
}
__device__ __forceinline__ void bitonic_merge16_desc(unsigned (&L)[16]) {
#pragma unroll
    for (int j = 8; j > 0; j >>= 1)
#pragma unroll
        for (int i = 0; i < 16; ++i) { const int l = i ^ j; if (l > i) ce_desc(L[i], L[l]); }
}
__device__ __forceinline__ void bitonic_sort8_desc(unsigned (&a)[8]) {
#pragma unroll
    for (int k = 2; k <= 8; k <<= 1)
#pragma unroll
        for (int j = k >> 1; j > 0; j >>= 1)
#pragma unroll
            for (int i = 0; i < 8; ++i) { const int l = i ^ j; if (l > i) { if ((i & k) == 0) ce_desc(a[i], a[l]); else ce_desc(a[l], a[i]); } }
}
__device__ __forceinline__ void sort16_desc(unsigned (&a)[16]) {
#define CE_(i, j) ce_desc(a[i], a[j])
    CE_(0,13); CE_(1,12); CE_(2,15); CE_(3,14); CE_(4,8); CE_(5,6); CE_(7,11); CE_(9,10);
    CE_(0,5); CE_(1,7); CE_(2,9); CE_(3,4); CE_(6,13); CE_(8,14); CE_(10,15); CE_(11,12);
    CE_(0,1); CE_(2,3); CE_(4,5); CE_(6,8); CE_(7,9); CE_(10,11); CE_(12,13); CE_(14,15);
    CE_(0,2); CE_(1,3); CE_(4,10); CE_(5,11); CE_(6,7); CE_(8,9); CE_(12,14); CE_(13,15);
    CE_(1,2); CE_(3,12); CE_(4,6); CE_(5,7); CE_(8,10); CE_(9,11); CE_(13,14);
    CE_(1,4); CE_(2,6); CE_(5,8); CE_(7,10); CE_(9,13); CE_(11,14);
    CE_(2,4); CE_(3,6); CE_(9,12); CE_(11,13);
    CE_(3,5); CE_(6,8); CE_(7,9); CE_(10,12);
    CE_(3,4); CE_(5,6); CE_(7,8); CE_(9,10); CE_(11,12);
    CE_(6,7); CE_(8,9);
#undef CE_
}
struct EpiSelect {
    unsigned* IDX; float* GATE; G8_LAS unsigned* X; const float* SSQP; const unsigned* SCT;
    __device__ __forceinline__ void operator()(const f32x4 (&acc)[2][2][4][2], const g8::Unit& u, int wr, int wc, int fr, int fq) const {
        const int pp = wc >> 1, half = wc & 1, wid = wr * 4 + wc;
        const unsigned kb = 127u - (unsigned)(half * 64 + fq * 8);
        unsigned Lst[4][16];
#pragma unroll
        for (int ai = 0; ai < 2; ++ai)
#pragma unroll
            for (int m = 0; m < 4; ++m) {
                unsigned C[16], Xc[16];
#pragma unroll
                for (int bj = 0; bj < 2; ++bj)
#pragma unroll
                    for (int n = 0; n < 2; ++n)
#pragma unroll
                        for (int r = 0; r < 4; ++r) C[bj * 8 + n * 4 + r] = (ord_key(acc[ai][bj][m][n][r]) & ~127u) | (kb - (unsigned)(bj * 32 + n * 4 + r));
                sort16_desc(C);
#pragma unroll
                for (int i = 0; i < 16; ++i) Xc[i] = (unsigned)__shfl_xor((int)C[i], 16);
                merge_top16(C, Xc);
#pragma unroll
                for (int i = 0; i < 16; ++i) Xc[i] = (unsigned)__shfl_xor((int)C[i], 32);
                merge_top16(C, Xc);
                if ((m >> 1) == half) {
#pragma unroll
                    for (int i = 0; i < 16; ++i) Lst[ai * 2 + (m & 1)][i] = C[i];
                } else if (fq == 0) {
                    G8_LAS unsigned* xs = X + (((ai * 2 + wr) * 2 + pp) * 4 + m) * 256 + fr;
#pragma unroll
                    for (int i = 0; i < 16; ++i) xs[(i ^ m) << 4] = C[i];
                }
            }
        __syncthreads();
#pragma unroll
        for (int ai = 0; ai < 2; ++ai)
#pragma unroll
            for (int e = 0; e < 2; ++e) {
                const int m = half * 2 + e;
                unsigned Xc[16];
                G8_LAS unsigned* xs = X + (((ai * 2 + wr) * 2 + pp) * 4 + m) * 256 + fr;
#pragma unroll
                for (int i = 0; i < 16; ++i) Xc[i] = xs[(i ^ m) << 4];
                merge_top16(Lst[ai * 2 + e], Xc);
                if (fq == 0) {
#pragma unroll
                    for (int i = 0; i < 16; ++i) xs[(i ^ m) << 4] = Lst[ai * 2 + e][i];
                }
            }
        __syncthreads();
        if (wid < 4) {
            G8_LAS unsigned* x0 = X + ((wid * 2 + 0) * 4 + fq) * 256 + fr; G8_LAS unsigned* x1 = X + ((wid * 2 + 1) * 4 + fq) * 256 + fr;
            float s0[16], s1[16];
#pragma unroll
            for (int i = 0; i < 16; ++i) { s0[i] = unord_key(x0[(i ^ fq) << 4] & ~127u); s1[i] = unord_key(x1[(i ^ fq) << 4] & ~127u); }
#define SEL_CAND(i, j) ((ord_key(s0[i] + s1[j]) & ~255u) | (unsigned)(255 - ((i) * 16 + (j))))
            unsigned C[16], B[16], M2[16], M3[8];
#pragma unroll
            for (int j = 0; j < 16; ++j) C[j] = SEL_CAND(0, j);
#pragma unroll
            for (int k = 0; k < 15; ++k) B[k] = SEL_CAND(k + 1, 0);
            B[15] = 0u;
            merge_top16(C, B);
#pragma unroll
            for (int j = 0; j < 7; ++j) M2[j] = SEL_CAND(1, j + 1);
            M2[7] = 0u; M2[8] = 0u; M2[9] = 0u;
#pragma unroll
            for (int k = 0; k < 6; ++k) M2[15 - k] = SEL_CAND(k + 2, 1);
            bitonic_merge16_desc(M2);
            M3[0] = SEL_CAND(2, 2); M3[1] = SEL_CAND(2, 3); M3[2] = SEL_CAND(2, 4); M3[3] = SEL_CAND(3, 2); M3[4] = SEL_CAND(4, 2); M3[5] = SEL_CAND(3, 3); M3[6] = 0u; M3[7] = 0u;
            bitonic_sort8_desc(M3);
#pragma unroll
            for (int i = 0; i < 8; ++i) B[i] = M3[i];
#pragma unroll
            for (int i = 8; i < 16; ++i) B[i] = 0u;
            merge_top16(M2, B);
            merge_top16(C, M2);
#undef SEL_CAND
            const int tok = u.pm * 256 + (wid >> 1) * 128 + (wid & 1) * 64 + fq * 16 + fr;
            float rstd;
            {
                const f32x4 q0 = *(const f32x4*)(SSQP + (size_t)tok * 32), q1 = *(const f32x4*)(SSQP + (size_t)tok * 32 + 4), q2 = *(const f32x4*)(SSQP + (size_t)tok * 32 + 8), q3 = *(const f32x4*)(SSQP + (size_t)tok * 32 + 12);
                const f32x4 q = (q0 + q1) + (q2 + q3);
                rstd = rsqrtf(((q[0] + q[1]) + (q[2] + q[3])) * (1.0f / D) + EPS);
            }
            const float mx = unord_key(C[0] & ~255u);
            float e[16]; float sum = 0.f;
#pragma unroll
            for (int r = 0; r < 16; ++r) { e[r] = __expf((unord_key(C[r] & ~255u) - mx) * rstd); sum += e[r]; }
            const float inv = 1.0f / sum;
            const size_t ob = (size_t)tok * 128 + u.pn * 16;
            unsigned iw[16];
#pragma unroll
            for (int r = 0; r < 16; ++r) {
                const unsigned code = 255u - (C[r] & 255u);
                const unsigned e0 = 127u - (x0[((code >> 4) ^ (unsigned)fq) << 4] & 127u), e1 = 127u - (x1[((code & 15u) ^ (unsigned)fq) << 4] & 127u);
                iw[r] = e0 * 128u + e1;
            }
            unsigned sc[16];
#pragma unroll
            for (int r = 0; r < 16; ++r) sc[r] = SCT[iw[r]];
#pragma unroll
            for (int r = 0; r < 16; ++r) {
                iw[r] |= sc[r] << 16;
                e[r] *= inv * (float)__builtin_bit_cast(_Float16, (unsigned short)(sc[r] >> 16));
            }
#pragma unroll
            for (int r = 0; r < 4; ++r) *(uint4*)(IDX + ob + r * 4) = make_uint4(iw[4 * r], iw[4 * r + 1], iw[4 * r + 2], iw[4 * r + 3]);
#pragma unroll
            for (int r = 0; r < 4; ++r) *(float4*)(GATE + ob + r * 4) = make_float4(e[4 * r], e[4 * r + 1], e[4 * r + 2], e[4 * r + 3]);
        }
        __syncthreads();
    }
};
__device__ __forceinline__ void phase_select8(const Params& p, int layer, char* smem_phys) {
    const bf16_t* H = (const bf16_t*)(p.ws + OFF_S); const bf16_t* Wf = (const bf16_t*)(p.ws + OFF_WT_Q) + (size_t)layer * 2048 * 1024;
    g8::Gemm g{H, H, 1024, 1024, Wf, T, 2048, 1024};
    g8::StaticOrder S; S.init(T, 2048, (int)gridDim.x, (int)blockIdx.x);
    EpiSelect E{(unsigned*)(p.ws + OFF_IDX), (float*)(p.ws + OFF_GATE), (G8_LAS unsigned*)(smem_phys + 131072), (const float*)(p.ws + OFF_SSQ), (const unsigned*)(p.ws + OFF_USC) + (size_t)layer * NEXP};
    g8::gemm_phase<EpiSelect>((G8_LAS unsigned char*)smem_phys, g, S, E);
    __syncthreads();
    if (threadIdx.x == 0) *(uint4*)(smem_phys + kDynLds - 16) = make_uint4(0u, 0u, 0u, 0u);
    __syncthreads();
}

__device__ __forceinline__ float ub0(unsigned w) { float f; asm("v_cvt_f32_ubyte0 %0, %1" : "=v"(f) : "v"(w)); return f; }
__device__ __forceinline__ float ub1(unsigned w) { float f; asm("v_cvt_f32_ubyte1 %0, %1" : "=v"(f) : "v"(w)); return f; }
__device__ __forceinline__ float ub2(unsigned w) { float f; asm("v_cvt_f32_ubyte2 %0, %1" : "=v"(f) : "v"(w)); return f; }
__device__ __forceinline__ float ub3(unsigned w) { float f; asm("v_cvt_f32_ubyte3 %0, %1" : "=v"(f) : "v"(w)); return f; }
typedef _Float16 f16x2 __attribute__((ext_vector_type(2)));
__device__ __forceinline__ void glds16(const void* gsrc, unsigned lds_dst) {
    unsigned keep; const unsigned d = (unsigned)__builtin_amdgcn_readfirstlane((int)lds_dst);
    asm volatile("s_mov_b32 %0, m0\n\ts_mov_b32 m0, %2\n\ts_nop 0\n\tglobal_load_lds_dwordx4 %1, off\n\ts_mov_b32 m0, %0" : "=&s"(keep) : "v"(gsrc), "s"(d) : "memory");
}
__device__ __forceinline__ void peer_gather(const Params& p, int layer, const float* __restrict__ gnext, bool final_out, char* smem) {
    const unsigned char* REC = p.ws + OFF_UT + (size_t)layer * NEXP * 1024;
    bf16_t* H = (bf16_t*)(p.ws + OFF_H);
    const unsigned* IDX = (const unsigned*)(p.ws + OFF_IDX); const float* GATE = (const float*)(p.ws + OFF_GATE);
    bf16_t* S = (bf16_t*)(p.ws + OFF_S);
    float* sGain = (float*)(smem + 139264);
    { int lz0 = 0; asm volatile("" : "+v"(lz0)); const int i = (int)threadIdx.x + lz0; if (i < 256) ((f32x4*)sGain)[i] = ((const f32x4*)(p.norm_ffn + layer * 1024))[i]; }
    __syncthreads();
    const int lane = VTID & 63, wid = VTID >> 6, sub = lane >> 4, li = lane & 15;
    char* wbase = smem + (int)(threadIdx.x >> 6) * 17408;
    unsigned* sIdx = (unsigned*)wbase; float* sGate = (float*)(wbase + 512);
    const char* ring = wbase + 1024; const unsigned ringb = (unsigned)(size_t)ring;
    const int gw = VBID * 4 + wid, nw = VGRID * 4;
    for (int t = gw; t < T; t += nw) {
        {
            int lz = 0; asm volatile("" : "+v"(lz));
            const int l2 = 2 * (lane + lz);
            const uint2 idp = *(const uint2*)(IDX + (size_t)t * 128 + l2);
            const float2 g2 = *(const float2*)(GATE + (size_t)t * 128 + l2);
            *(uint2*)(sIdx + l2) = idp; *(float2*)(sGate + l2) = g2;
        }
        int XH[2][4], XL[2][4]; float sx; float xg;
        {
            f32x4 xr[16]; float am = 0.f, ssx = 0.f;
#pragma unroll
            for (int k = 0; k < 8; ++k) {
                const int col = (16 * (k >> 2) + li) * 32 + (k & 3) * 8;
                const u32x4 raw = *(const u32x4*)(S + (size_t)t * 1024 + col);
                const f32x4 g0 = *(const f32x4*)(sGain + col), g1 = *(const f32x4*)(sGain + col + 4);
                const f32x4 x0 = (f32x4){lo2f(raw[0]), hi2f(raw[0]), lo2f(raw[1]), hi2f(raw[1])}, x1 = (f32x4){lo2f(raw[2]), hi2f(raw[2]), lo2f(raw[3]), hi2f(raw[3])};
                ssx += (x0[0] * x0[0] + x0[1] * x0[1]) + (x0[2] * x0[2] + x0[3] * x0[3]) + (x1[0] * x1[0] + x1[1] * x1[1]) + (x1[2] * x1[2] + x1[3] * x1[3]);
                xr[2 * k] = x0 * g0; xr[2 * k + 1] = x1 * g1;
#pragma unroll
                for (int c = 0; c < 4; ++c) am = fmaxf(am, fmaxf(fabsf(xr[2 * k][c]), fabsf(xr[2 * k + 1][c])));
            }
            am = fmaxf(am, __shfl_xor(am, 1)); am = fmaxf(am, __shfl_xor(am, 2)); am = fmaxf(am, __shfl_xor(am, 4)); am = fmaxf(am, __shfl_xor(am, 8));
            ssx = row16_sum(ssx);
            const float inv = am > 0.f ? 119.0f / am : 0.f;
            sx = am * (1.0f / 119.0f) * rsqrtf(ssx * (1.0f / D) + EPS);
            int xs = 0;
#pragma unroll
            for (int j = 0; j < 2; ++j)
#pragma unroll
                for (int d = 0; d < 4; ++d) {
                    unsigned lo = 0u, hi = 0u;
#pragma unroll
                    for (int i = 0; i < 8; ++i) {
                        const int q = __float2int_rn(xr[(j * 4 + d) * 2 + (i >> 2)][i & 3] * inv);
                        const int sh = (i & 3) * 8 + (i >> 2) * 4;
                        lo |= ((unsigned)q & 15u) << sh; hi |= ((unsigned)((q + 8) >> 4) & 15u) << sh;
                        xs += q;
                    }
                    XL[j][d] = (int)lo; XH[j][d] = (int)hi;
                }
            xg = 0.5f * (float)xs;
        }
        f16x2 accp[2][16];
#pragma unroll
        for (int j = 0; j < 2; ++j)
#pragma unroll
            for (int c = 0; c < 16; ++c) accp[j][c] = (f16x2){(_Float16)0.f, (_Float16)0.f};
        float wsg = 0.f;
        auto issue = [&](int sg) {
            const unsigned e_ = sIdx[sg * 4 + sub] & 0xffffu;
            const unsigned char* rec = REC + (size_t)e_ * 1024 + li * 16;
            const unsigned dst = ringb + (unsigned)(sg & 3) * 4096u;
            glds16(rec, dst); glds16(rec + 256, dst + 1024u); glds16(rec + 512, dst + 2048u); glds16(rec + 768, dst + 3072u);
        };
        auto compute = [&](int sg, bool refill) {
            const char* sl = ring + (sg & 3) * 4096;
            const u32x4 du0 = *(const u32x4*)(sl + lane * 16), du1 = *(const u32x4*)(sl + 1024 + lane * 16);
            const u32x4 dv0 = *(const u32x4*)(sl + 2048 + lane * 16), dv1 = *(const u32x4*)(sl + 3072 + lane * 16);
            const float us = (float)__builtin_bit_cast(_Float16, (unsigned short)(sIdx[sg * 4 + sub] >> 16));
            const float gt = sGate[sg * 4 + sub];
            if (refill) { asm volatile("s_waitcnt lgkmcnt(0)" ::: "memory"); issue(sg + 4); }
            int iah = 0, ial = 0;
#pragma unroll
            for (int j = 0; j < 2; ++j) {
#pragma unroll
                for (int d = 0; d < 4; ++d) {
                    const int w = (int)(j ? du1[d] : du0[d]);
                    iah = __builtin_amdgcn_sdot8(w, XH[j][d], iah, false);
                    ial = __builtin_amdgcn_sdot8(w, XL[j][d], ial, false);
                }
            }
            float pa = us * ((float)(16 * iah + ial) + xg);
            pa = row16_sum(pa);
            const float ww = gt * gelu_exact(pa * sx);
            wsg += ww;
            const float wc = fminf(fmaxf(ww * 65536.0f, -65504.0f), 65504.0f);
            const _Float16 wha = (_Float16)wc, whb = (_Float16)(wc * 0.0625f);
            const f16x2 wa = {wha, wha}, wb = {whb, whb};
#pragma unroll
            for (int j = 0; j < 2; ++j) {
#pragma unroll
                for (int d = 0; d < 4; ++d) {
                    const unsigned wv = j ? dv1[d] : dv0[d], wt = wv >> 8;
                    const f16x2 c0 = __builtin_bit_cast(f16x2, wv & 0x000f000fu), c1 = __builtin_bit_cast(f16x2, wv & 0x00f000f0u);
                    const f16x2 c2 = __builtin_bit_cast(f16x2, wt & 0x000f000fu), c3 = __builtin_bit_cast(f16x2, wt & 0x00f000f0u);
                    accp[j][4 * d + 0] = __builtin_elementwise_fma(c0, wa, accp[j][4 * d + 0]); accp[j][4 * d + 1] = __builtin_elementwise_fma(c1, wb, accp[j][4 * d + 1]);
                    accp[j][4 * d + 2] = __builtin_elementwise_fma(c2, wa, accp[j][4 * d + 2]); accp[j][4 * d + 3] = __builtin_elementwise_fma(c3, wb, accp[j][4 * d + 3]);
                }
            }
        };
        asm volatile("s_waitcnt vmcnt(0)" ::: "memory");
        issue(0); issue(1); issue(2); issue(3);
#pragma unroll 1
        for (int sg = 0; sg < 28; ++sg) {
            asm volatile("s_waitcnt vmcnt(12)" ::: "memory");
            compute(sg, true);
        }
        asm volatile("s_waitcnt vmcnt(12)" ::: "memory");
        compute(28, false);
        asm volatile("s_waitcnt vmcnt(8)" ::: "memory");
        compute(29, false);
        asm volatile("s_waitcnt vmcnt(4)" ::: "memory");
        compute(30, false);
        asm volatile("s_waitcnt vmcnt(0)" ::: "memory");
        compute(31, false);
        float acc[2][32];
#pragma unroll
        for (int j = 0; j < 2; ++j)
#pragma unroll
            for (int d = 0; d < 4; ++d) {
                acc[j][8 * d + 0] = 256.0f * (float)accp[j][4 * d + 0][0]; acc[j][8 * d + 2] = 256.0f * (float)accp[j][4 * d + 0][1];
                acc[j][8 * d + 4] = 256.0f * (float)accp[j][4 * d + 1][0]; acc[j][8 * d + 6] = 256.0f * (float)accp[j][4 * d + 1][1];
                acc[j][8 * d + 1] = 256.0f * (float)accp[j][4 * d + 2][0]; acc[j][8 * d + 3] = 256.0f * (float)accp[j][4 * d + 2][1];
                acc[j][8 * d + 5] = 256.0f * (float)accp[j][4 * d + 3][0]; acc[j][8 * d + 7] = 256.0f * (float)accp[j][4 * d + 3][1];
            }
        const bool up2 = (sub & 2) != 0, up1 = (sub & 1) != 0;
        float wsum = wsg + __shfl_xor(wsg, 32);
        wsum += __shfl_xor(wsum, 16);
        float r1[32];
#pragma unroll
        for (int c = 0; c < 32; ++c) r1[c] = (up2 ? acc[1][c] : acc[0][c]) + __shfl_xor(up2 ? acc[0][c] : acc[1][c], 32);
        float r2[16];
#pragma unroll
        for (int c = 0; c < 16; ++c) r2[c] = (up1 ? r1[16 + c] : r1[c]) + __shfl_xor(up1 ? r1[c] : r1[16 + c], 16);
        const int col0 = (16 * (sub >> 1) + li) * 32 + (sub & 1) * 16;
        float ss = 0.f;
        bf16_t* srow = S + (size_t)t * 1024 + col0;
        {
            const u32x4 b0 = *(const u32x4*)srow, b1 = *(const u32x4*)(srow + 8);
#pragma unroll
            for (int c = 0; c < 8; ++c) {
                const unsigned wsrc = c < 4 ? b0[c] : b1[c - 4];
                r2[2 * c] = r2[2 * c] - 7.5f * wsum + lo2f(wsrc); r2[2 * c + 1] = r2[2 * c + 1] - 7.5f * wsum + hi2f(wsrc);
                ss += r2[2 * c] * r2[2 * c] + r2[2 * c + 1] * r2[2 * c + 1];
            }
        }
        ss = wave_sum(ss);
        const float rstd = rsqrtf(ss * (1.0f / D) + EPS);
        const float* gp = gnext + col0;
        if (final_out) {
            float* orow = p.out + (size_t)t * 1024 + col0;
#pragma unroll
            for (int c4 = 0; c4 < 4; ++c4) {
                const f32x4 g = *(const f32x4*)(gp + c4 * 4);
                *(f32x4*)(orow + c4 * 4) = (f32x4){r2[c4 * 4] * rstd * g[0], r2[c4 * 4 + 1] * rstd * g[1], r2[c4 * 4 + 2] * rstd * g[2], r2[c4 * 4 + 3] * rstd * g[3]};
            }
        } else {
            u32x4 sv[2];
#pragma unroll
            for (int c4 = 0; c4 < 4; ++c4) { sv[c4 >> 1][(c4 & 1) * 2] = pack2(r2[c4 * 4], r2[c4 * 4 + 1]); sv[c4 >> 1][(c4 & 1) * 2 + 1] = pack2(r2[c4 * 4 + 2], r2[c4 * 4 + 3]); }
            *(u32x4*)srow = sv[0]; *(u32x4*)(srow + 8) = sv[1];
            if (lane == 0) ((float*)(p.ws + OFF_VSC))[t] = rstd;
        }
    }
}


#define XB_TMO      128
#define XB_XCNT(j)  (256  + 64 * (j))
#define XB_XSUB(j)  (1280 + 64 * (j))
#define XB_XGEN(j)  (2304 + 64 * (j))
#define XB_TOP      3328
#define XB_TOPGEN   3392
#define XCD_BAR_WORDS 3456
#define XB_SPIN_CAP (1u << 22)
#define LAS __attribute__((address_space(3)))
__device__ __forceinline__ unsigned xb_ld(unsigned* p)              { return __hip_atomic_load(p, __ATOMIC_RELAXED, __HIP_MEMORY_SCOPE_AGENT); }
__device__ __forceinline__ unsigned xb_add(unsigned* p, unsigned v) { return __hip_atomic_fetch_add(p, v, __ATOMIC_RELAXED, __HIP_MEMORY_SCOPE_AGENT); }
__device__ __forceinline__ unsigned xb_xcc_id() { return (unsigned)__builtin_amdgcn_s_getreg((3 << 11) | 20) & 0xFu; }
#define XB_SPIN(cond, bar) do { unsigned _sp = 0; while (cond) { __builtin_amdgcn_s_sleep(1); \
    if ((++_sp & 255u) == 0u) { if (xb_ld(&(bar)[XB_TMO])) break; if (_sp > XB_SPIN_CAP) { atomicAdd(&(bar)[XB_TMO], 1u); break; } } } } while (0)
struct XcdBarrier { unsigned* bar; unsigned x; volatile LAS unsigned* st; };
__device__ __forceinline__ XcdBarrier xcd_barrier_post(unsigned* bar, volatile LAS unsigned* st) {
    XcdBarrier b; b.bar = bar; b.x = xb_xcc_id(); b.st = st;
    if (threadIdx.x == 0) (void)xb_add(&bar[XB_XCNT(b.x)], 1u);
    return b;
}
__device__ __forceinline__ void xcd_barrier_complete(unsigned* bar, unsigned x, unsigned& nloc, unsigned& nx) {
    const unsigned G = gridDim.x * gridDim.y * gridDim.z;
    unsigned sum, cnt, mine, sp = 0u;
    for (;;) {
        sum = 0u; cnt = 0u; mine = 0u;
#pragma unroll
        for (unsigned j = 0; j < 16; ++j) { const unsigned c = xb_ld(&bar[XB_XCNT(j)]); sum += c; cnt += (c > 0u) ? 1u : 0u; mine = (j == x) ? c : mine; }
        if (sum == G) break;
        __builtin_amdgcn_s_sleep(1);
        if ((++sp & 255u) == 0u) { if (xb_ld(&bar[XB_TMO])) break; if (sp > XB_SPIN_CAP) { atomicAdd(&bar[XB_TMO], 1u); break; } }
    }
    nloc = mine > 0u ? mine : 1u; nx = cnt > 0u ? cnt : 1u;
}
__device__ __forceinline__ void xcd_barrier(const XcdBarrier& b) {
    asm volatile("s_waitcnt vmcnt(0)" ::: "memory");
    __syncthreads();
    if (threadIdx.x == 0) {
        unsigned* bar = b.bar;
        __builtin_amdgcn_s_waitcnt(0);
        unsigned nloc = b.st[0], nx = b.st[1];
        if (nloc == 0u) { xcd_barrier_complete(bar, b.x, nloc, nx); b.st[0] = nloc; b.st[1] = nx; }
        const unsigned old = xb_add(&bar[XB_XSUB(b.x)], 1u);
        const unsigned gen = old / nloc;
        if (old + 1u == (gen + 1u) * nloc) {
            __builtin_amdgcn_fence(__ATOMIC_RELEASE, "agent");
            asm volatile("s_waitcnt vmcnt(0)" ::: "memory");
            const unsigned og = xb_add(&bar[XB_TOP], 1u);
            const unsigned tg = og / nx;
            if (og + 1u == (tg + 1u) * nx) xb_add(&bar[XB_TOPGEN], 1u);
            else XB_SPIN(xb_ld(&bar[XB_TOPGEN]) == tg, bar);
            __builtin_amdgcn_fence(__ATOMIC_ACQUIRE, "agent");
            xb_add(&bar[XB_XGEN(b.x)], 1u);
            asm volatile("s_waitcnt vmcnt(0)" ::: "memory");
        } else {
            XB_SPIN(xb_ld(&bar[XB_XGEN(b.x)]) == gen, bar);
            __builtin_amdgcn_fence(__ATOMIC_ACQUIRE, "agent");
            asm volatile("s_waitcnt vmcnt(0)" ::: "memory");
        }
    }
    __syncthreads();
}

constexpr int NPHASE = 12;
__global__ void __launch_bounds__(512, 2) mega(Params p, int ph_lo, int ph_hi) {
    extern __shared__ __attribute__((aligned(16))) char smem_phys[];
    uint4& xb_words = *(uint4*)(smem_phys + kDynLds - 16);
    if (threadIdx.x == 0) xb_words = make_uint4(0u, 0u, 0u, 0u);
    __syncthreads();
    const XcdBarrier xbar = xcd_barrier_post((unsigned*)(p.ws + OFF_BAR), (volatile LAS unsigned*)&xb_words);
    char* smem = smem_phys + (threadIdx.x >> 8) * 65536;
    bf16_t* Rg = (bf16_t*)(p.ws + OFF_REGION);
    bf16_t* Hb = (bf16_t*)(p.ws + OFF_H);
#define PHASE(k, ...) if (ph_lo <= (k) && (k) < ph_hi) { __VA_ARGS__; if ((k) + 1 < ph_hi) xcd_barrier(xbar); }
    unsigned* sbctr = (unsigned*)(p.ws + OFF_BAR + 14336);
    PHASE(0,
        transpose_convert<true>(p.ab_w_in, (bf16_t*)(p.ws + OFF_WT_IN), 1024, AB_IN, AB_IN_PAD, smem);
        rmsnorm_rows(p.x, p.norm_mix, Hb))
    PHASE(1, phase_gemm_in8(p, smem_phys))
    PHASE(2, gla_prep(p, smem))
    PHASE(3, gla_scan(p, smem); sb_fast(p, smem_phys + 98304, sbctr);
        quantize_tables_static(p, 64);
        transpose_convert(p.ab_w_out, (bf16_t*)(p.ws + OFF_WT_OUT), 1024, 1024, 1024, smem, 64);
        transpose_convert(p.c_w_in, (bf16_t*)(p.ws + OFF_WT_CIN), 1024, 4096, 4096, smem, 64, p.norm_mix + 1024);
        transpose_convert(p.c_w_out, (bf16_t*)(p.ws + OFF_WT_COUT), 2048, 1024, 1024, smem, 64);
        fold_query_weights(p, 64))
    PHASE(4, phase_gemm_resid8(Rg + R_QSB, Rg + R_GG, 512, 512, (const bf16_t*)(p.ws + OFF_WT_OUT), 1024, p.x, (bf16_t*)(p.ws + OFF_S), (float*)(p.ws + OFF_SSQ), smem_phys))
    PHASE(5, phase_select8(p, 0, smem_phys))
    PHASE(6, peer_gather(p, 0, p.norm_mix + 1024, false, smem_phys))
    PHASE(7, phase_gemm_cin8_v(p, smem_phys))
    PHASE(8, phase_gemm_cin8_u(p, smem_phys))
    PHASE(9, phase_gemm_resid8(Rg, Rg, 2048, 2048, (const bf16_t*)(p.ws + OFF_WT_COUT), 2048, nullptr, (bf16_t*)(p.ws + OFF_S), (float*)(p.ws + OFF_SSQ), smem_phys))
    PHASE(10, phase_select8(p, 1, smem_phys))
    PHASE(11, peer_gather(p, 1, p.final_norm, true, smem_phys))
}

extern "C" void kernel_launch(void* const* d_in, const int* in_sizes, int n_in, void* d_out, int out_size, void* d_ws, size_t ws_size, hipStream_t stream) {
    static int grid_blocks = 0;
    if (!grid_blocks) {
        int dev = 0, cus = 0, per_cu = 0;
        hipGetDevice(&dev);
        hipDeviceGetAttribute(&cus, hipDeviceAttributeMultiprocessorCount, dev);
        hipFuncSetAttribute((const void*)mega, hipFuncAttributeMaxDynamicSharedMemorySize, kDynLds);
        hipOccupancyMaxActiveBlocksPerMultiprocessor(&per_cu, mega, 512, kDynLds);
        if (per_cu < 1) per_cu = 1;
        if (per_cu > 1) per_cu = 1;
        grid_blocks = cus * per_cu;
        if (n_in != 18 || ws_size < WS_END) fprintf(stderr, "kernel_launch: unexpected n_in %d or ws_size %zu < %zu\n", n_in, ws_size, (size_t)WS_END);
    }
    Params p{};
    p.x = (const float*)d_in[0]; p.norm_mix = (const float*)d_in[1]; p.norm_ffn = (const float*)d_in[2]; p.ab_w_in = (const float*)d_in[3];
    p.ab_w_alpha2 = (const float*)d_in[4]; p.ab_b_alpha2 = (const float*)d_in[5]; p.ab_gla_norm = (const float*)d_in[6]; p.ab_w_out = (const float*)d_in[7];
    p.c_w_in = (const float*)d_in[8]; p.c_v_norm = (const float*)d_in[9]; p.c_w_spatial = (const float*)d_in[10]; p.c_b_spatial = (const float*)d_in[11];
    p.c_w_out = (const float*)d_in[12]; p.peer_w_q = (const float*)d_in[13]; p.peer_subkeys = (const float*)d_in[14]; p.peer_u = (const float*)d_in[15];
    p.peer_v = (const float*)d_in[16]; p.final_norm = (const float*)d_in[17];
    p.out = (float*)d_out; p.ws = (unsigned char*)d_ws;
    (void)hipMemsetAsync((char*)d_ws + OFF_BAR, 0, 16384, stream);
#if ONE_LAUNCH
    int lo = 0, hi = NPHASE;
    void* args[] = {&p, &lo, &hi};
    hipError_t e = hipLaunchCooperativeKernel((void*)mega, dim3(grid_blocks), dim3(512), args, kDynLds, stream);
    if (e != hipSuccess) fprintf(stderr, "cooperative launch failed: %s (grid %d)\n", hipGetErrorString(e), grid_blocks);
#else
    for (int ph = 0; ph < NPHASE; ++ph) hipLaunchKernelGGL(mega, dim3(grid_blocks), dim3(512), kDynLds, stream, p, ph, ph + 1);
#endif
}
```

```cpp
#include <hip/hip_runtime.h>
#include <cstdio>
#include <cstdint>

#ifndef ONE_LAUNCH
#define ONE_LAUNCH 1
#endif


#define VTID ((int)(threadIdx.x & 255))
#define VBID ((int)(blockIdx.x * 2 + (threadIdx.x >> 8)))
#define VGRID ((int)(gridDim.x * 2))
typedef unsigned short bf16_t;
typedef short bf16x8 __attribute__((ext_vector_type(8)));
typedef float f32x4 __attribute__((ext_vector_type(4)));
typedef unsigned u32x4 __attribute__((ext_vector_type(4)));
typedef __bf16 bf16x2_t __attribute__((ext_vector_type(2)));

constexpr int T = 32768, D = 1024, SEQ = 2048, NB = 16;
constexpr int AB_IN = 3088, AB_IN_PAD = 3200;
constexpr float EPS = 1e-6f;
constexpr int NEXP = 16384;
constexpr int kDynLds = 163840;

constexpr size_t SZ_WT_IN = (size_t)AB_IN_PAD * 1024 * 2;
constexpr size_t SZ_WT_OUT = (size_t)1024 * 1024 * 2;
constexpr size_t SZ_WT_CIN = (size_t)4096 * 1024 * 2;
constexpr size_t SZ_WT_COUT = (size_t)1024 * 2048 * 2;
constexpr size_t SZ_WT_Q = (size_t)2 * 2048 * 1024 * 2;
constexpr size_t SZ_SK = (size_t)2 * 8 * 2 * 128 * 128 * 2;
constexpr size_t SZ_TAB = (size_t)2 * NEXP * 1024;
constexpr size_t SZ_TSC = (size_t)2 * NEXP * 4;
constexpr size_t OFF_WT_IN = 0;
constexpr size_t OFF_WT_OUT = OFF_WT_IN + SZ_WT_IN;
constexpr size_t OFF_WT_CIN = OFF_WT_OUT + SZ_WT_OUT;
constexpr size_t OFF_WT_COUT = OFF_WT_CIN + SZ_WT_CIN;
constexpr size_t OFF_WT_Q = OFF_WT_COUT + SZ_WT_COUT;
constexpr size_t OFF_SK = OFF_WT_Q + SZ_WT_Q;
constexpr size_t OFF_UT = OFF_SK;
constexpr size_t OFF_USC = OFF_UT + SZ_TAB;
constexpr size_t OFF_VSC = OFF_USC + SZ_TSC;
constexpr size_t OFF_H = OFF_VSC + SZ_TSC;
constexpr size_t OFF_IDX = OFF_H + (size_t)T * 1024 * 2;
constexpr size_t OFF_GATE = OFF_IDX + (size_t)T * 128 * 4;
constexpr size_t OFF_SSQ = OFF_GATE + (size_t)T * 128 * 4;
constexpr size_t OFF_REGION = OFF_SSQ + (size_t)T * 32 * 4;
constexpr size_t SZ_REGION = (size_t)256 << 20;
constexpr size_t OFF_S = OFF_REGION + SZ_REGION;
constexpr size_t OFF_BAR = OFF_S + (size_t)T * 1024 * 2;
constexpr size_t WS_END = OFF_BAR + 16384;
constexpr size_t R_QSB = 0;
constexpr size_t R_KSB = R_QSB + (size_t)T * 512;
constexpr size_t R_VTSB = R_KSB + (size_t)T * 512;
constexpr size_t R_QG = R_VTSB + (size_t)T * 512;
constexpr size_t R_KG = R_QG + (size_t)T * 256;
constexpr size_t R_VTG = R_KG + (size_t)T * 256;
constexpr size_t R_GG = R_VTG + (size_t)T * 512;
constexpr size_t R_ALR = R_GG + (size_t)T * 512;
constexpr size_t R_KOT = R_ALR + (size_t)T * 32;
constexpr size_t R_DEC = R_KOT + (size_t)T * 256;

struct Params {
    const float* x; const float* norm_mix; const float* norm_ffn; const float* ab_w_in; const float* ab_w_alpha2; const float* ab_b_alpha2;
    const float* ab_gla_norm; const float* ab_w_out; const float* c_w_in; const float* c_v_norm; const float* c_w_spatial; const float* c_b_spatial;
    const float* c_w_out; const float* peer_w_q; const float* peer_subkeys; const float* peer_u; const float* peer_v; const float* final_norm;
    float* out; unsigned char* ws;
};

__device__ __forceinline__ float bf2f(bf16_t v) { return __uint_as_float(((unsigned)v) << 16); }
__device__ __forceinline__ bf16_t f2bf(float f) { unsigned r; asm("v_cvt_pk_bf16_f32 %0, %1, %1" : "=v"(r) : "v"(f)); return (bf16_t)r; }
__device__ __forceinline__ unsigned pack2(float lo, float hi) { unsigned r; asm("v_cvt_pk_bf16_f32 %0, %1, %2" : "=v"(r) : "v"(lo), "v"(hi)); return r; }
__device__ __forceinline__ float lo2f(unsigned w) { return __uint_as_float(w << 16); }
__device__ __forceinline__ float hi2f(unsigned w) { return __uint_as_float(w & 0xffff0000u); }
__device__ __forceinline__ float dot2(unsigned a, unsigned b, float acc) { return __builtin_amdgcn_fdot2_f32_bf16(__builtin_bit_cast(bf16x2_t, a), __builtin_bit_cast(bf16x2_t, b), acc, false); }
#define GELU_C0 -1.0001451969146729f
#define GELU_C1 -1.1498452425003052f
#define GELU_C2 -0.46162763237953186f
#define GELU_C3 -0.051034148782491684f
#define GELU_C4 0.007168652955442667f
#define GELU_C5 -0.0006095620337873697f
#define GELU_C6 2.30170971917687e-05f
__device__ __forceinline__ float gelu_exact(float v) {
    const float a = fminf(fabsf(v), 6.0f);
    float q = GELU_C6 * a + GELU_C5; q = q * a + GELU_C4; q = q * a + GELU_C3; q = q * a + GELU_C2; q = q * a + GELU_C1; q = q * a + GELU_C0;
    return fmaxf(v, 0.f) - fabsf(v) * __builtin_amdgcn_exp2f(q);
}
typedef float f32x2 __attribute__((ext_vector_type(2)));
__device__ __forceinline__ f32x2 gelu_exact2(f32x2 v) {
    const f32x2 av = __builtin_elementwise_abs(v), a = __builtin_elementwise_min(av, (f32x2){6.0f, 6.0f});
    f32x2 q = (f32x2){GELU_C6, GELU_C6} * a + (f32x2){GELU_C5, GELU_C5};
    q = q * a + (f32x2){GELU_C4, GELU_C4}; q = q * a + (f32x2){GELU_C3, GELU_C3}; q = q * a + (f32x2){GELU_C2, GELU_C2};
    q = q * a + (f32x2){GELU_C1, GELU_C1}; q = q * a + (f32x2){GELU_C0, GELU_C0};
    const f32x2 e = {__builtin_amdgcn_exp2f(q[0]), __builtin_amdgcn_exp2f(q[1])};
    return __builtin_elementwise_max(v, (f32x2){0.f, 0.f}) - av * e;
}
__device__ __forceinline__ float row16_sum(float v) {
    v += __builtin_bit_cast(float, __builtin_amdgcn_update_dpp(0, __builtin_bit_cast(int, v), 0x128, 0xf, 0xf, false));
    v += __builtin_bit_cast(float, __builtin_amdgcn_update_dpp(0, __builtin_bit_cast(int, v), 0x124, 0xf, 0xf, false));
    v += __builtin_bit_cast(float, __builtin_amdgcn_update_dpp(0, __builtin_bit_cast(int, v), 0x122, 0xf, 0xf, false));
    v += __builtin_bit_cast(float, __builtin_amdgcn_update_dpp(0, __builtin_bit_cast(int, v), 0x121, 0xf, 0xf, false));
    return v;
}
__device__ __forceinline__ float wave_sum(float v) {
#pragma unroll
    for (int o = 32; o >= 1; o >>= 1) v += __shfl_xor(v, o);
    return v;
}

template <bool PERM_IN = false>
__device__ __forceinline__ void transpose_convert(const float* __restrict__ W, bf16_t* __restrict__ Wt, int K, int N, int Npad, char* smem, int vb0 = 0, const float* __restrict__ kgain = nullptr) {
    float* tile = (float*)smem;
    const int tk = K / 64, tn = Npad / 64, ntile = tk * tn;
    const int tid = VTID;
    if (VBID < vb0) return;
    for (int tl = VBID - vb0; tl < ntile; tl += VGRID - vb0) {
        const int k0 = (tl % tk) * 64, n0 = (tl / tk) * 64;
        const int c = tid & 63, r0 = tid >> 6;
        int nd = n0;
        if (PERM_IN) { if (n0 >= 1024 && n0 < 1536) nd = n0 + 1024; else if (n0 >= 1536 && n0 < 2048) nd = n0 - 512; else if (n0 >= 2048 && n0 < 2560) nd = n0 + 512; else if (n0 >= 2560 && n0 < 3072) nd = n0 - 1024; }
#pragma unroll
        for (int i = 0; i < 16; ++i) {
            const int r = r0 + 4 * i;
            float v = (n0 + c < N) ? W[(size_t)(k0 + r) * N + n0 + c] : 0.f;
            if (kgain) v *= kgain[k0 + r];
            tile[c * 65 + r] = v;
        }
        __syncthreads();
#pragma unroll
        for (int i = 0; i < 16; ++i) {
            const int n = r0 + 4 * i;
            Wt[(size_t)(nd + n) * K + k0 + c] = f2bf(tile[n * 65 + c]);
        }
        __syncthreads();
    }
}
__device__ __forceinline__ void quantize_tables_static(const Params& p, int vb0 = 0) {
    const int lane = VTID & 63, wid = VTID >> 6;
    if (VBID < vb0) return;
    for (unsigned task = (unsigned)(VBID - vb0); task < 512u; task += (unsigned)(VGRID - vb0)) {
        const bool isv = task >= 256u;
        const int r0 = (int)(task & 255u) * 128 + wid * 32;
        const float* src = isv ? p.peer_v : p.peer_u;
        unsigned char* recs = p.ws + OFF_UT;
        _Float16* sct = (_Float16*)(p.ws + OFF_USC);
        f32x4 vnx[4];
        {
            const float* x0 = src + (size_t)r0 * 1024 + lane * 16;
#pragma unroll
            for (int i = 0; i < 4; ++i) vnx[i] = *(const f32x4*)(x0 + i * 4);
        }
        for (int rr = 0; rr < 32; ++rr) {
            const int r = r0 + rr;
            f32x4 v[4]; float aml = 0.f;
#pragma unroll
            for (int i = 0; i < 4; ++i) {
                v[i] = vnx[i];
                aml = fmaxf(aml, fmaxf(fmaxf(fabsf(v[i][0]), fabsf(v[i][1])), fmaxf(fabsf(v[i][2]), fabsf(v[i][3]))));
            }
            if (rr + 1 < 32) {
                const float* xn = src + (size_t)(r + 1) * 1024 + lane * 16;
#pragma unroll
                for (int i = 0; i < 4; ++i) vnx[i] = *(const f32x4*)(xn + i * 4);
            }
#pragma unroll
            for (int o = 32; o >= 1; o >>= 1) aml = fmaxf(aml, __shfl_xor(aml, o));
            float ssq = 0.f;
#pragma unroll
            for (int i = 0; i < 4; ++i) ssq += (v[i][0] * v[i][0] + v[i][1] * v[i][1]) + (v[i][2] * v[i][2] + v[i][3] * v[i][3]);
            ssq = wave_sum(ssq);
            const float gmax = aml * (1.002f / 7.5f);
            const _Float16 hs = (_Float16)fminf(fmaxf(0.34f * sqrtf(ssq * (1.0f / 1024.0f)), 0.5f * gmax), gmax);
            const float gs_ = (float)hs, gi_ = gs_ > 0.f ? 1.0f / gs_ : 0.f;
            unsigned wd[2]; const int sgn = isv ? 0 : 8;
#pragma unroll
            for (int dd = 0; dd < 2; ++dd) {
                unsigned wv = 0;
#pragma unroll
                for (int b = 0; b < 4; ++b) {
                    const int qa = min(15, max(0, __float2int_rn(v[2 * dd][b] * gi_ + 7.5f)));
                    const int qb = min(15, max(0, __float2int_rn(v[2 * dd + 1][b] * gi_ + 7.5f)));
                    wv |= ((unsigned)(qa ^ sgn) | ((unsigned)(qb ^ sgn) << 4)) << (8 * b);
                }
                wd[dd] = wv;
            }
            unsigned char* rec = recs + (size_t)r * 1024;
            *(uint2*)(rec + (isv ? 512 : 0) + lane * 8) = make_uint2(wd[0], wd[1]);
            if (lane == 0) sct[(size_t)r * 2 + (isv ? 1 : 0)] = (_Float16)gs_;
        }
    }
}
__device__ __forceinline__ void rmsnorm_rows(const float* __restrict__ X, const float* __restrict__ g, bf16_t* __restrict__ Hout) {
    const int lane = VTID & 63, wid = VTID >> 6;
    const int gw = VBID * 4 + wid, nw = VGRID * 4;
    for (int t = gw; t < T; t += nw) {
        const float* xr = X + (size_t)t * D;
        float4 v[4]; float ss = 0.f;
#pragma unroll
        for (int i = 0; i < 4; ++i) { v[i] = *(const float4*)(xr + i * 256 + lane * 4); ss += v[i].x * v[i].x + v[i].y * v[i].y + v[i].z * v[i].z + v[i].w * v[i].w; }
        ss = wave_sum(ss);
        const float rstd = rsqrtf(ss * (1.0f / D) + EPS);
#pragma unroll
        for (int i = 0; i < 4; ++i) {
            const float4 gg = *(const float4*)(g + i * 256 + lane * 4);
            uint2 o; o.x = pack2(v[i].x * rstd * gg.x, v[i].y * rstd * gg.y); o.y = pack2(v[i].z * rstd * gg.z, v[i].w * rstd * gg.w);
            *(uint2*)(Hout + (size_t)t * D + i * 256 + lane * 4) = o;
        }
    }
}

__device__ __forceinline__ void store_bf16x4(bf16_t* p, f32x4 v) { uint2 o; o.x = pack2(v[0], v[1]); o.y = pack2(v[2], v[3]); *(uint2*)p = o; }

#define G8_LAS __attribute__((address_space(3)))
namespace g8 {
constexpr int BM = 256, BK = 64, HALF = 128, HTB = HALF * BK * 2, NXCD = 8, WGM = 8;
__device__ __forceinline__ int lds_byte(int r, int c) { const int st = (r >> 4) * 2 + (c >> 5), rr = r & 15, cc = c & 31, ob = rr * 64 + cc * 2; return st * 1024 + (ob ^ (((ob >> 9) & 1) << 5)); }
__device__ __forceinline__ void stage_rc(int b, int& R, int& C) { const int st = b / 1024, sb = b % 1024, swz = sb ^ (((sb >> 9) & 1) << 5); R = (st >> 1) * 16 + swz / 64; C = (st & 1) * 32 + (swz % 64) / 2; }
__device__ __forceinline__ int perm32(int rho) { const int n = rho >> 4, i = rho & 15; return 8 * (i >> 2) + 4 * n + (i & 3); }
struct Unit { int pm, pn; };
struct Gemm { const bf16_t* A0; const bf16_t* A1; int lda, ksplit; const bf16_t* Bt; int M, N, K; };
struct StaticOrder {
    int nM, nN, nwg, G, c;
    __device__ __forceinline__ void init(int M, int N, int G_, int c_) { nM = M / BM; nN = N / BM; nwg = nM * nN; G = G_; c = c_; }
    __device__ __forceinline__ bool next(int i, Unit& u) const {
        const int L = i * G + c; if (L >= nwg) return false;
        int wgid = L; { const int q = nwg / NXCD, r = nwg % NXCD, xcd = wgid % NXCD, off = wgid / NXCD; wgid = (xcd < r ? xcd * (q + 1) : r * (q + 1) + (xcd - r) * q) + off; }
        const int nig = WGM * nN, gid = wgid / nig, fm = gid * WGM, gsz = (nM - fm) < WGM ? (nM - fm) : WGM;
        u.pm = fm + ((wgid % nig) % gsz); u.pn = (wgid % nig) / gsz; return true;
    }
};
template <class Epi>
__device__ __forceinline__ void gemm_phase(G8_LAS unsigned char* lds, const Gemm g, const StaticOrder& S, const Epi& E) {
    const int tid = threadIdx.x, wid = __builtin_amdgcn_readfirstlane(tid >> 6), lane = tid & 63, wr = wid >> 2, wc = wid & 3, fr = lane & 15, fq = lane >> 4;
    const int K = g.K, nt = K / BK, lda = g.lda;
    unsigned voffA[2], voffB[2];
#pragma unroll
    for (int i = 0; i < 2; ++i) { int R, C; stage_rc(tid * 16 + i * 8192, R, C); const int Rb = (R & ~31) + perm32(R & 31);
        voffA[i] = (unsigned)(R * lda + C) * 2u; voffB[i] = (unsigned)(Rb * K + C) * 2u; }
    const size_t hstepA = (size_t)HALF * lda * 2, hstepB = (size_t)HALF * K * 2;
    const unsigned ldsw = (unsigned)wid * 1024u;
    const int aoff = lds_byte(wr * 64 + fr, fq * 8), boff = lds_byte(wc * 32 + fr, fq * 8);
    auto aptr = [&](int pm, int kt) -> const char* { const int kb = kt * BK; const bf16_t* b = kb < g.ksplit ? g.A0 + kb : g.A1 + (kb - g.ksplit); return (const char*)b + (size_t)pm * 2 * hstepA; };
    auto bptr = [&](int pn, int kt) -> const char* { return (const char*)(g.Bt + kt * BK) + (size_t)pn * 2 * hstepB; };
#define G8_SA(b, h) (((b) * 2 + (h)) * HTB)
#define G8_SB(b, h) ((4 + (b) * 2 + (h)) * HTB)
#define G8_STAGE(bufoff, gbase, voff) do { _Pragma("unroll") for (int _i = 0; _i < 2; ++_i) \
        __builtin_amdgcn_global_load_lds((const unsigned*)((const char*)(gbase) + (voff)[_i]), (G8_LAS unsigned*)(lds + (bufoff) + ldsw + _i * 8192), 16, 0, 0); } while (0)
#define G8_LDA(dst, b, h) do { _Pragma("unroll") for (int m = 0; m < 4; ++m) _Pragma("unroll") for (int k = 0; k < 2; ++k) dst[m][k] = *(const G8_LAS bf16x8*)(lds + G8_SA(b, h) + aoff + m * 2048 + k * 1024); } while (0)
#define G8_LDB(dst, b, h) do { _Pragma("unroll") for (int n = 0; n < 2; ++n) _Pragma("unroll") for (int k = 0; k < 2; ++k) dst[n][k] = *(const G8_LAS bf16x8*)(lds + G8_SB(b, h) + boff + n * 2048 + k * 1024); } while (0)
#define G8_MMA(ai, bj, At, Bt) do { __builtin_amdgcn_s_setprio(1); _Pragma("unroll") for (int m = 0; m < 4; ++m) _Pragma("unroll") for (int n = 0; n < 2; ++n) _Pragma("unroll") for (int k = 0; k < 2; ++k) \
        acc[ai][bj][m][n] = __builtin_amdgcn_mfma_f32_16x16x32_bf16(Bt[n][k], At[m][k], acc[ai][bj][m][n], 0, 0, 0); __builtin_amdgcn_s_setprio(0); } while (0)
#define G8_WAIT_V(n) asm volatile("s_waitcnt vmcnt(" #n ")" ::: "memory")
#define G8_WAIT_L(n) asm volatile("s_waitcnt lgkmcnt(" #n ")" ::: "memory")
#define G8_BAR __builtin_amdgcn_s_barrier()
#define G8_SCHED __builtin_amdgcn_sched_barrier(0)
    Unit cur, nxt; int ui = 0;
    if (!S.next(0, cur)) return;
    f32x4 acc[2][2][4][2];
#pragma unroll
    for (int a = 0; a < 2; ++a)
#pragma unroll
        for (int b = 0; b < 2; ++b)
#pragma unroll
            for (int m = 0; m < 4; ++m)
#pragma unroll
                for (int n = 0; n < 2; ++n) acc[a][b][m][n] = (f32x4){0.f, 0.f, 0.f, 0.f};
    bf16x8 At[4][2], B0[2][2], B1[2][2];
    {
        const char* cA = aptr(cur.pm, 0); const char* cB = bptr(cur.pn, 0); const char* cA1 = aptr(cur.pm, 1); const char* cB1 = bptr(cur.pn, 1);
        G8_STAGE(G8_SB(0, 0), cB, voffB); G8_STAGE(G8_SB(0, 1), cB + hstepB, voffB); G8_STAGE(G8_SA(0, 0), cA, voffA); G8_STAGE(G8_SA(0, 1), cA + hstepA, voffA);
        if (wr == 1) G8_BAR;
        G8_WAIT_V(2); G8_BAR;
        G8_STAGE(G8_SB(1, 0), cB1, voffB); G8_STAGE(G8_SA(1, 0), cA1, voffA); G8_STAGE(G8_SB(1, 1), cB1 + hstepB, voffB);
        G8_WAIT_V(6); G8_BAR;
    }
    for (;;) {
        const bool has_next = S.next(ui + 1, nxt);
        const int npm = has_next ? nxt.pm : cur.pm, npn = has_next ? nxt.pn : cur.pn;
        for (int t = 0; t < nt; t += 2) {
            const bool last = (t == nt - 2);
            const char* a1 = aptr(cur.pm, t + 1);
            const char* a2 = last ? aptr(npm, 0) : aptr(cur.pm, t + 2); const char* b2 = last ? bptr(npn, 0) : bptr(cur.pn, t + 2);
            const char* a3 = last ? aptr(npm, 1) : aptr(cur.pm, t + 3); const char* b3 = last ? bptr(npn, 1) : bptr(cur.pn, t + 3);
            G8_LDB(B0, 0, 0); G8_LDB(B1, 0, 1); G8_SCHED; G8_LDA(At, 0, 0); G8_STAGE(G8_SA(1, 1), a1 + hstepA, voffA);
            G8_WAIT_V(8); G8_WAIT_L(0); G8_BAR; G8_MMA(0, 0, At, B0); G8_MMA(0, 1, At, B1); G8_BAR; G8_SCHED;
            G8_LDA(At, 0, 1); G8_STAGE(G8_SB(0, 0), b2, voffB); G8_STAGE(G8_SB(0, 1), b2 + hstepB, voffB); G8_STAGE(G8_SA(0, 0), a2, voffA);
            G8_WAIT_V(8); G8_WAIT_L(0); G8_BAR; G8_MMA(1, 0, At, B0); G8_MMA(1, 1, At, B1); G8_BAR; G8_SCHED;
            G8_LDB(B0, 1, 0); G8_LDB(B1, 1, 1); G8_SCHED; G8_LDA(At, 1, 0); G8_STAGE(G8_SA(0, 1), a2 + hstepA, voffA);
            G8_WAIT_V(8); G8_WAIT_L(0); G8_BAR; G8_MMA(0, 0, At, B0); G8_MMA(0, 1, At, B1); G8_BAR; G8_SCHED;
            G8_LDA(At, 1, 1); G8_STAGE(G8_SB(1, 0), b3, voffB); G8_STAGE(G8_SB(1, 1), b3 + hstepB, voffB); G8_STAGE(G8_SA(1, 0), a3, voffA);
            G8_WAIT_V(8); G8_WAIT_L(0); G8_BAR; G8_MMA(1, 0, At, B0); G8_MMA(1, 1, At, B1); G8_BAR; G8_SCHED;
        }
        if (wr == 0) G8_BAR;
        E(acc, cur, wr, wc, fr, fq);
        if (!has_next) break;
#pragma unroll
        for (int a = 0; a < 2; ++a)
#pragma unroll
            for (int b = 0; b < 2; ++b)
#pragma unroll
                for (int m = 0; m < 4; ++m)
#pragma unroll
                    for (int n = 0; n < 2; ++n) acc[a][b][m][n] = (f32x4){0.f, 0.f, 0.f, 0.f};
        cur = nxt; ++ui;
        if (wr == 1) G8_BAR;
    }
    G8_WAIT_V(0);
    G8_BAR;
#undef G8_SA
#undef G8_SB
#undef G8_STAGE
#undef G8_LDA
#undef G8_LDB
#undef G8_MMA
#undef G8_WAIT_V
#undef G8_WAIT_L
#undef G8_BAR
#undef G8_SCHED
}
struct EpiResid {
    const float* R32; bf16_t* S; float* SSQP;
    __device__ __forceinline__ void operator()(const f32x4 (&acc)[2][2][4][2], const Unit& u, int wr, int wc, int fr, int fq) const {
#pragma unroll
        for (int ai = 0; ai < 2; ++ai)
#pragma unroll
            for (int m = 0; m < 4; ++m) {
                const int row = u.pm * 256 + ai * 128 + wr * 64 + m * 16 + fr;
                const size_t o = (size_t)row * 1024 + u.pn * 256 + wc * 32 + fq * 8;
                float ss = 0.f;
#pragma unroll
                for (int bj = 0; bj < 2; ++bj) {
                    f32x4 a, b;
                    if (R32) { a = *(const f32x4*)(R32 + o + bj * 128); b = *(const f32x4*)(R32 + o + bj * 128 + 4); }
                    else { const u32x4 r = *(const u32x4*)(S + o + bj * 128); a = (f32x4){lo2f(r[0]), hi2f(r[0]), lo2f(r[1]), hi2f(r[1])}; b = (f32x4){lo2f(r[2]), hi2f(r[2]), lo2f(r[3]), hi2f(r[3])}; }
                    a += acc[ai][bj][m][0]; b += acc[ai][bj][m][1];
                    ss += a[0] * a[0] + a[1] * a[1] + a[2] * a[2] + a[3] * a[3] + b[0] * b[0] + b[1] * b[1] + b[2] * b[2] + b[3] * b[3];
                    uint4 w; w.x = pack2(a[0], a[1]); w.y = pack2(a[2], a[3]); w.z = pack2(b[0], b[1]); w.w = pack2(b[2], b[3]);
                    *(uint4*)(S + o + bj * 128) = w;
                }
                ss += __shfl_xor(ss, 16); ss += __shfl_xor(ss, 32);
                if (fq == 0) SSQP[(size_t)row * 32 + u.pn * 4 + wc] = ss;
            }
    }
};
struct EpiCinUS {
    bf16_t* U; const bf16_t* VT; const float* SSQ; const float* Wsp; const float* bsp; const float* vnorm; G8_LAS unsigned char* L; const float* RSTD;
    __device__ __forceinline__ void operator()(const f32x4 (&acc)[2][2][4][2], const Unit& u, int wr, int wc, int fr, int fq) const {
        const int tid = threadIdx.x, g = u.pn;
        G8_LAS float* RS = (G8_LAS float*)(L + 24576);
        unsigned gu[2][2][4][4];
#pragma unroll
        for (int ai = 0; ai < 2; ++ai)
#pragma unroll
            for (int bj = 0; bj < 2; ++bj)
#pragma unroll
                for (int m = 0; m < 4; ++m) {
                    const float rs = RSTD[u.pm * 256 + ai * 128 + wr * 64 + m * 16 + fr];
                    const f32x4 a = acc[ai][bj][m][0] * rs, b = acc[ai][bj][m][1] * rs;
                    const f32x2 g0 = gelu_exact2((f32x2){a[0], a[1]}), g1 = gelu_exact2((f32x2){a[2], a[3]}), g2 = gelu_exact2((f32x2){b[0], b[1]}), g3 = gelu_exact2((f32x2){b[2], b[3]});
                    gu[ai][bj][m][0] = pack2(g0[0], g0[1]); gu[ai][bj][m][1] = pack2(g1[0], g1[1]); gu[ai][bj][m][2] = pack2(g2[0], g2[1]); gu[ai][bj][m][3] = pack2(g3[0], g3[1]);
                }
        if (tid < 256) {
            const float* sp = SSQ + (size_t)(u.pm * 256 + tid) * 32;
            f32x4 s4 = *(const f32x4*)sp;
#pragma unroll
            for (int i = 1; i < 8; ++i) s4 += *(const f32x4*)(sp + 4 * i);
            RS[tid] = rsqrtf(((s4[0] + s4[1]) + (s4[2] + s4[3])) * (1.0f / 2048.0f) + EPS);
        }
        __syncthreads();
#pragma unroll
        for (int ai = 0; ai < 2; ++ai) {
            const int chunk = u.pm * 2 + ai;
            {
                const int t1 = tid >> 3, c1 = tid & 7;
#pragma unroll
                for (int part = 0; part < 3; ++part) {
                    const int t = part == 0 ? t1 : 64 + ((tid + (part - 1) * 512) >> 4), ch = part == 0 ? c1 : ((tid + (part - 1) * 512) & 15), s0 = ch * 8;
                    const float* wp = Wsp + (size_t)(g * 128 + t) * 128 + s0;
                    const f32x4 w0 = *(const f32x4*)wp, w1 = *(const f32x4*)(wp + 4);
                    const f32x4 r0 = *(const G8_LAS f32x4*)(RS + ai * 128 + s0), r1 = *(const G8_LAS f32x4*)(RS + ai * 128 + s0 + 4);
                    float v[8];
#pragma unroll
                    for (int j = 0; j < 4; ++j) { v[j] = (s0 + j <= t) ? w0[j] * r0[j] : 0.f; v[4 + j] = (s0 + 4 + j <= t) ? w1[j] * r1[j] : 0.f; }
                    u32x4 o; o.x = pack2(v[0], v[1]); o.y = pack2(v[2], v[3]); o.z = pack2(v[4], v[5]); o.w = pack2(v[6], v[7]);
                    const int off = part == 0 ? t * 128 + ((ch ^ (t & 7)) << 4) : 8192 + (t - 64) * 256 + ((ch ^ (t & 7)) << 4);
                    *(G8_LAS u32x4*)(L + off) = o;
                }
            }
            __syncthreads();
            float bias[4];
#pragma unroll
            for (int m = 0; m < 4; ++m) bias[m] = bsp[g * 128 + wr * 64 + m * 16 + fr];
#pragma unroll
            for (int bj = 0; bj < 2; ++bj) {
                f32x4 mac[4][2];
#pragma unroll
                for (int m = 0; m < 4; ++m)
#pragma unroll
                    for (int n = 0; n < 2; ++n) mac[m][n] = (f32x4){0.f, 0.f, 0.f, 0.f};
                const int cb = u.pn * 256 + bj * 128 + wc * 32;
                const bf16_t* vrow0 = VT + ((size_t)chunk * 2048 + cb + perm32(fr)) * 128 + fq * 8;
                const bf16_t* vrow1 = VT + ((size_t)chunk * 2048 + cb + perm32(16 + fr)) * 128 + fq * 8;
                bf16x8 bf0[4], bf1[4];
#pragma unroll
                for (int kk = 0; kk < 4; ++kk) { if (kk < 2 || wr == 1) { bf0[kk] = *(const bf16x8*)(vrow0 + kk * 32); bf1[kk] = *(const bf16x8*)(vrow1 + kk * 32); } }
#pragma unroll
                for (int kk = 0; kk < 4; ++kk) {
                    if (kk < 2 || wr == 1) {
                        bf16x8 af[4];
#pragma unroll
                        for (int m = 0; m < 4; ++m) {
                            const int t = wr * 64 + m * 16 + fr, chn = kk * 4 + fq;
                            const int off = wr == 0 ? t * 128 + ((chn ^ (t & 7)) << 4) : 8192 + (t - 64) * 256 + ((chn ^ (t & 7)) << 4);
                            af[m] = *(const G8_LAS bf16x8*)(L + off);
                        }
#pragma unroll
                        for (int m = 0; m < 4; ++m) {
                            mac[m][0] = __builtin_amdgcn_mfma_f32_16x16x32_bf16(bf0[kk], af[m], mac[m][0], 0, 0, 0);
                            mac[m][1] = __builtin_amdgcn_mfma_f32_16x16x32_bf16(bf1[kk], af[m], mac[m][1], 0, 0, 0);
                        }
                    }
                }
                const f32x4 vn0 = *(const f32x4*)(vnorm + cb + fq * 8), vn1 = *(const f32x4*)(vnorm + cb + fq * 8 + 4);
#pragma unroll
                for (int m = 0; m < 4; ++m) {
                    const f32x4 x0 = vn0 * mac[m][0] + bias[m], x1 = vn1 * mac[m][1] + bias[m];
                    const unsigned q0 = gu[ai][bj][m][0], q1 = gu[ai][bj][m][1], q2 = gu[ai][bj][m][2], q3 = gu[ai][bj][m][3];
                    uint4 o; o.x = pack2(lo2f(q0) * x0[0], hi2f(q0) * x0[1]); o.y = pack2(lo2f(q1) * x0[2], hi2f(q1) * x0[3]); o.z = pack2(lo2f(q2) * x1[0], hi2f(q2) * x1[1]); o.w = pack2(lo2f(q3) * x1[2], hi2f(q3) * x1[3]);
                    *(uint4*)(U + (size_t)(u.pm * 256 + ai * 128 + wr * 64 + m * 16 + fr) * 2048 + cb + fq * 8) = o;
                }
            }
            __syncthreads();
        }
    }
};
struct EpiCinV {
    bf16_t* VT; float* SSQ; const float* RSTD;
    __device__ __forceinline__ void operator()(const f32x4 (&acc)[2][2][4][2], const Unit& u, int wr, int wc, int fr, int fq) const {
        f32x4 rs[2][2];
#pragma unroll
        for (int bj = 0; bj < 2; ++bj)
#pragma unroll
            for (int n = 0; n < 2; ++n) rs[bj][n] = *(const f32x4*)(RSTD + u.pn * 256 + bj * 128 + wc * 32 + fq * 8 + n * 4);
#pragma unroll
        for (int ai = 0; ai < 2; ++ai) {
            float ss[16];
#pragma unroll
            for (int i = 0; i < 16; ++i) ss[i] = 0.f;
#pragma unroll
            for (int m = 0; m < 4; ++m) {
                const int c = u.pm * 256 + ai * 128 + wr * 64 + m * 16 + fr;
#pragma unroll
                for (int bj = 0; bj < 2; ++bj) {
                    float g[8];
#pragma unroll
                    for (int n = 0; n < 2; ++n)
#pragma unroll
                        for (int r = 0; r < 4; r += 2) {
                            const f32x2 x = gelu_exact2((f32x2){acc[ai][bj][m][n][r] * rs[bj][n][r], acc[ai][bj][m][n][r + 1] * rs[bj][n][r + 1]});
                            g[n * 4 + r] = x[0]; g[n * 4 + r + 1] = x[1]; ss[bj * 8 + n * 4 + r] += x[0] * x[0]; ss[bj * 8 + n * 4 + r + 1] += x[1] * x[1];
                        }
                    uint4 o; o.x = pack2(g[0], g[1]); o.y = pack2(g[2], g[3]); o.z = pack2(g[4], g[5]); o.w = pack2(g[6], g[7]);
                    *(uint4*)(VT + ((size_t)(u.pn * 2 + bj) * 2048 + c) * 128 + wc * 32 + fq * 8) = o;
                }
            }
            float mine = 0.f;
#pragma unroll
            for (int i = 0; i < 16; ++i) { const float s = row16_sum(ss[i]); mine = (fr == i) ? s : mine; }
            const int tok = u.pn * 256 + (fr >> 3) * 128 + wc * 32 + fq * 8 + (fr & 7);
            SSQ[(size_t)tok * 32 + u.pm * 4 + ai * 2 + wr] = mine;
        }
    }
};
struct EpiInN {
    bf16_t* R;
    __device__ __forceinline__ void operator()(const f32x4 (&acc)[2][2][4][2], const Unit& u, int wr, int wc, int fr, int fq) const {
        bf16_t* base; int pitch; float sc = 1.0f;
        if (u.pn < 2) { base = R + R_QSB + u.pn * 256; pitch = 512; sc = 0.125f; }
        else if (u.pn < 4) { base = R + R_KSB + (u.pn - 2) * 256; pitch = 512; }
        else if (u.pn == 4) { base = R + R_QG; pitch = 256; }
        else if (u.pn == 5) { base = R + R_KG; pitch = 256; }
        else { base = R + R_GG + (u.pn - 6) * 256; pitch = 512; }
#pragma unroll
        for (int ai = 0; ai < 2; ++ai)
#pragma unroll
            for (int m = 0; m < 4; ++m) {
                bf16_t* rp = base + (size_t)(u.pm * 256 + ai * 128 + wr * 64 + m * 16 + fr) * pitch + wc * 32 + fq * 8;
#pragma unroll
                for (int bj = 0; bj < 2; ++bj) {
                    f32x4 a = acc[ai][bj][m][0] * sc, b = acc[ai][bj][m][1] * sc;
                    if (u.pn >= 6) {
#pragma unroll
                        for (int r = 0; r < 4; ++r) { a[r] = a[r] * __builtin_amdgcn_rcpf(1.0f + __expf(-a[r])); b[r] = b[r] * __builtin_amdgcn_rcpf(1.0f + __expf(-b[r])); }
                    }
                    uint4 o; o.x = pack2(a[0], a[1]); o.y = pack2(a[2], a[3]); o.z = pack2(b[0], b[1]); o.w = pack2(b[2], b[3]);
                    *(uint4*)(rp + bj * 128) = o;
                }
            }
    }
};
struct EpiInT {
    bf16_t* R;
    __device__ __forceinline__ void operator()(const f32x4 (&acc)[2][2][4][2], const Unit& u, int wr, int wc, int fr, int fq) const {
#pragma unroll
        for (int ai = 0; ai < 2; ++ai)
#pragma unroll
            for (int m = 0; m < 4; ++m) {
                const int c = u.pm * 256 + ai * 128 + wr * 64 + m * 16 + fr;
#pragma unroll
                for (int bj = 0; bj < 2; ++bj) {
                    const int t = u.pn * 256 + bj * 128 + wc * 32 + fq * 8, b = t >> 11, s = t & 2047;
                    bf16_t* dst;
                    if (c < 512) dst = R + R_VTSB + ((size_t)((b * 8 + (c >> 6)) * 64 + (c & 63))) * 2048 + s;
                    else { const int c2 = c - 512; dst = R + R_VTG + ((size_t)((b * 4 + (c2 >> 7)) * 128 + (c2 & 127))) * 2048 + s; }
                    const f32x4 a = acc[ai][bj][m][0], bb = acc[ai][bj][m][1];
                    uint4 o; o.x = pack2(a[0], a[1]); o.y = pack2(a[2], a[3]); o.z = pack2(bb[0], bb[1]); o.w = pack2(bb[2], bb[3]);
                    *(uint4*)dst = o;
                }
            }
    }
};
}
__device__ __forceinline__ void phase_gemm_resid8(const bf16_t* A0, const bf16_t* A1, int lda, int ksplit, const bf16_t* Bt, int K, const float* R32, bf16_t* Sres, float* SSQP, char* smem_phys) {
    g8::Gemm g{A0, A1, lda, ksplit, Bt, T, 1024, K};
    g8::StaticOrder S; S.init(T, 1024, (int)gridDim.x, (int)blockIdx.x);
    g8::EpiResid E{R32, Sres, SSQP};
    g8::gemm_phase<g8::EpiResid>((G8_LAS unsigned char*)smem_phys, g, S, E);
}

__device__ __forceinline__ void phase_gemm_cin8_v(const Params& p, char* smem_phys) {
    const bf16_t* H = (const bf16_t*)(p.ws + OFF_S); const bf16_t* W = (const bf16_t*)(p.ws + OFF_WT_CIN);
    bf16_t* U = (bf16_t*)(p.ws + OFF_REGION); bf16_t* VT = U + (size_t)T * 2048; float* SSQ = (float*)(p.ws + OFF_SSQ);
    const bf16_t* Wv = W + (size_t)2048 * 1024;
    g8::Gemm g{Wv, Wv, 1024, 1024, H, 2048, T, 1024};
    g8::StaticOrder S; S.init(2048, T, (int)gridDim.x, (int)blockIdx.x);
    g8::EpiCinV E{VT, SSQ, (const float*)(p.ws + OFF_VSC)};
    g8::gemm_phase<g8::EpiCinV>((G8_LAS unsigned char*)smem_phys, g, S, E);
}
__device__ __forceinline__ void phase_gemm_cin8_u(const Params& p, char* smem_phys) {
    const bf16_t* H = (const bf16_t*)(p.ws + OFF_S); const bf16_t* W = (const bf16_t*)(p.ws + OFF_WT_CIN);
    bf16_t* U = (bf16_t*)(p.ws + OFF_REGION); bf16_t* VT = U + (size_t)T * 2048; float* SSQ = (float*)(p.ws + OFF_SSQ);
    g8::Gemm g{H, H, 1024, 1024, W, T, 2048, 1024};
    g8::StaticOrder S; S.init(T, 2048, (int)gridDim.x, (int)blockIdx.x);
    g8::EpiCinUS E{U, VT, SSQ, p.c_w_spatial, p.c_b_spatial, p.c_v_norm, (G8_LAS unsigned char*)(smem_phys + 131072), (const float*)(p.ws + OFF_VSC)};
    g8::gemm_phase<g8::EpiCinUS>((G8_LAS unsigned char*)smem_phys, g, S, E);
}
__device__ __forceinline__ void phase_gemm_in8(const Params& p, char* smem_phys) {
    const bf16_t* H = (const bf16_t*)(p.ws + OFF_H); const bf16_t* W = (const bf16_t*)(p.ws + OFF_WT_IN);
    bf16_t* R = (bf16_t*)(p.ws + OFF_REGION);
    {
        g8::Gemm g{H, H, 1024, 1024, W, T, 2048, 1024};
        g8::StaticOrder S; S.init(T, 2048, (int)gridDim.x, (int)blockIdx.x);
        g8::EpiInN E{R};
        g8::gemm_phase<g8::EpiInN>((G8_LAS unsigned char*)smem_phys, g, S, E);
    }
    {
        const bf16_t* Wv = W + (size_t)2048 * 1024;
        g8::Gemm g{Wv, Wv, 1024, 1024, H, 1024, T, 1024};
        g8::StaticOrder S; S.init(1024, T, (int)gridDim.x, (int)blockIdx.x);
        g8::EpiInT E{R};
        g8::gemm_phase<g8::EpiInT>((G8_LAS unsigned char*)smem_phys, g, S, E);
    }
    {
        const int lane = threadIdx.x & 63, wid = threadIdx.x >> 6, fr = lane & 15, fq = lane >> 4;
        float* ALR = (float*)(R + R_ALR);
        for (int task = (int)blockIdx.x * 8 + wid; task < T / 16; task += (int)gridDim.x * 8) {
            const bf16_t* a = H + (size_t)(task * 16 + fr) * 1024 + fq * 8; const bf16_t* w = W + (size_t)(3072 + fr) * 1024 + fq * 8;
            f32x4 acc = (f32x4){0.f, 0.f, 0.f, 0.f};
#pragma unroll 8
            for (int kk = 0; kk < 32; ++kk) {
                const bf16x8 af = *(const bf16x8*)(a + kk * 32), wf = *(const bf16x8*)(w + kk * 32);
                acc = __builtin_amdgcn_mfma_f32_16x16x32_bf16(wf, af, acc, 0, 0, 0);
            }
            *(f32x4*)(ALR + (size_t)(task * 16 + fr) * 16 + fq * 4) = acc;
        }
    }
}


typedef float f32x16 __attribute__((ext_vector_type(16)));
__device__ __forceinline__ void sb_fast(const Params& p, char* smem, unsigned* ctr) {
    bf16_t* R = (bf16_t*)(p.ws + OFF_REGION);
    char* KT = smem; char* VTt = smem + 8192;
    volatile int* flags = (volatile int*)(smem + 32768); volatile unsigned* slot = (volatile unsigned*)(smem + 32832);
    const int tid = threadIdx.x, lane = tid & 63, w = tid >> 6, r31 = lane & 31, h = lane >> 5;
    for (;;) {
        __syncthreads();
        if (tid == 0) *slot = atomicAdd(ctr, 1u);
        __syncthreads();
        const unsigned task = *slot;
        if (task >= 1024u) break;
        const int qblk = 7 - (int)(task >> 7), bh = task & 127, b = bh >> 3, hh = bh & 7;
        const int q0 = qblk * 256, qbase = q0 + 32 * w;
        bf16_t* qrow = R + R_QSB + (size_t)(b * 2048 + qbase + r31) * 512 + hh * 64;
        bf16x8 qf[4];
#pragma unroll
        for (int kk = 0; kk < 4; ++kk) qf[kk] = *(const bf16x8*)(qrow + 16 * kk + 8 * h);
        f32x16 oacc[2];
#pragma unroll
        for (int nt = 0; nt < 2; ++nt)
#pragma unroll
            for (int i = 0; i < 16; ++i) oacc[nt][i] = 0.f;
        float Rr = 1.0f;
        const int t = qbase + r31;
        for (int kt = q0 / 64 + 3; kt >= 0; --kt) {
            __syncthreads();
            { const int wd = __all(Rr == 0.f); if (lane == 0) flags[w] = wd; }
            __syncthreads();
            if (flags[0] & flags[1] & flags[2] & flags[3] & flags[4] & flags[5] & flags[6] & flags[7]) break;
            const int s_tile = kt * 64;
            {
                const int c = tid, row = c >> 3, ch = c & 7;
                const u32x4 kv = *(const u32x4*)(R + R_KSB + (size_t)(b * 2048 + s_tile + row) * 512 + hh * 64 + ch * 8);
                const u32x4 vv = *(const u32x4*)(R + R_VTSB + ((size_t)((b * 8 + hh) * 64 + row)) * 2048 + s_tile + ch * 8);
                *(u32x4*)(KT + row * 128 + ((ch ^ (row & 7)) << 4)) = kv;
                *(uint2*)(VTt + row * 136 + ch * 16) = make_uint2(vv[0], vv[1]);
                *(uint2*)(VTt + row * 136 + ch * 16 + 8) = make_uint2(vv[2], vv[3]);
            }
            __syncthreads();
#pragma unroll
            for (int sbk = 1; sbk >= 0; --sbk) {
                const int key_lo = s_tile + 32 * sbk;
                if (key_lo >= qbase + 31) continue;
                if (__all(Rr == 0.f)) continue;
                f32x16 st;
#pragma unroll
                for (int i = 0; i < 16; ++i) st[i] = 0.f;
                const int krow = 32 * sbk + r31;
#pragma unroll
                for (int kk = 0; kk < 4; ++kk) {
                    const bf16x8 kf = *(const bf16x8*)(KT + krow * 128 + (((2 * kk + h) ^ (krow & 7)) << 4));
                    st = __builtin_amdgcn_mfma_f32_32x32x16_bf16(kf, qf[kk], st, 0, 0, 0);
                }
                float a[16], G[4];
                const bool diag = key_lo + 31 >= qbase;
#pragma unroll
                for (int g = 0; g < 4; ++g) {
                    float sg[4], m[4];
#pragma unroll
                    for (int i = 0; i < 4; ++i) {
                        const float z = fmaxf(st[4 * g + i], -80.f);
                        const float ez = __builtin_amdgcn_exp2f(z * -1.4426950409f), sig = __builtin_amdgcn_rcpf(1.0f + ez);
                        sg[i] = sig; m[i] = ez * sig;
                    }
                    if (diag) {
#pragma unroll
                        for (int i = 0; i < 4; ++i) { const bool valid = key_lo + 8 * g + 4 * h + i < t; sg[i] = valid ? sg[i] : 0.f; m[i] = valid ? m[i] : 1.0f; }
                    }
                    const float x2 = m[3], x1 = x2 * m[2], x0 = x1 * m[1];
                    G[g] = x0 * m[0];
                    a[4 * g + 3] = sg[3]; a[4 * g + 2] = sg[2] * x2; a[4 * g + 1] = sg[1] * x1; a[4 * g] = sg[0] * x0;
                }
                float Go[4], P[4];
#pragma unroll
                for (int g = 0; g < 4; ++g) { Go[g] = __shfl_xor(G[g], 32); P[g] = G[g] * Go[g]; }
                const float c2 = P[3], c1 = c2 * P[2], c0 = c1 * P[1];
                float Tg[4];
                Tg[3] = Rr; Tg[2] = Rr * c2; Tg[1] = Rr * c1; Tg[0] = Rr * c0;
#pragma unroll
                for (int g = 0; g < 4; ++g) {
                    const float tg = (h == 0) ? Tg[g] * Go[g] : Tg[g];
                    a[4 * g] *= tg; a[4 * g + 1] *= tg; a[4 * g + 2] *= tg; a[4 * g + 3] *= tg;
                }
                Rr = Rr * c0 * P[0];
#pragma unroll
                for (int s2 = 0; s2 < 2; ++s2) {
                    union { bf16x8 v; unsigned u[4]; } af;
#pragma unroll
                    for (int j2 = 0; j2 < 4; ++j2) af.u[j2] = pack2(a[8 * s2 + 2 * j2], a[8 * s2 + 2 * j2 + 1]);
#pragma unroll
                    for (int nt = 0; nt < 2; ++nt) {
                        const char* vp = VTt + (32 * nt + r31) * 136 + 64 * sbk + 32 * s2 + 8 * h;
                        union { bf16x8 v; uint2 hh2[2]; } vf;
                        vf.hh2[0] = *(const uint2*)vp; vf.hh2[1] = *(const uint2*)(vp + 16);
                        oacc[nt] = __builtin_amdgcn_mfma_f32_32x32x16_bf16(af.v, vf.v, oacc[nt], 0, 0, 0);
                    }
                }
            }
        }
#pragma unroll
        for (int nt = 0; nt < 2; ++nt)
#pragma unroll
            for (int i = 0; i < 16; ++i) {
                const int qq = (i & 3) + 8 * (i >> 2) + 4 * h;
                R[R_QSB + (size_t)(b * 2048 + qbase + qq) * 512 + hh * 64 + 32 * nt + r31] = f2bf(oacc[nt][i]);
            }
    }
}
__device__ __forceinline__ float log_sigmoid(float x) { return fminf(x, 0.f) - __logf(1.0f + __expf(-fabsf(x))); }
__device__ __forceinline__ int swz(int row, int chunk) { return row * 128 + ((chunk ^ (row & 7)) << 4); }
__device__ __forceinline__ void gla_prep(const Params& p, char* smem) {
    bf16_t* R = (bf16_t*)(p.ws + OFF_REGION);
    const float* ALR = (const float*)(R + R_ALR);
    bf16_t* KOTg = R + R_KOT; float* DECg = (float*)(R + R_DEC);
    float* SEG = (float*)smem; float* ALRs = SEG + 256;
    const int tid = VTID, d = tid & 63, w = tid >> 6;
    for (int task = VBID; task < 2048; task += VGRID) {
        const int bh = task >> 5, c = task & 31, b = bh >> 2, hh = bh & 3;
        const size_t rowbase = (size_t)b * 2048 + c * 64;
        unsigned qr[16], kr[16];
#pragma unroll
        for (int i = 0; i < 16; ++i) { const size_t row = rowbase + w * 16 + i; qr[i] = R[R_QG + row * 256 + hh * 64 + d]; kr[i] = R[R_KG + row * 256 + hh * 64 + d]; }
        const f32x4 ar = *(const f32x4*)(ALR + rowbase * 16 + tid * 4);
        float w2r[16];
#pragma unroll
        for (int r = 0; r < 16; ++r) w2r[r] = p.ab_w_alpha2[r * 256 + hh * 64 + d];
        const float b2r = p.ab_b_alpha2[hh * 64 + d];
        __syncthreads();
        *(f32x4*)(ALRs + tid * 4) = ar;
        __syncthreads();
        float cs[16]; float run = 0.f;
#pragma unroll
        for (int i = 0; i < 16; ++i) {
            const float* al = ALRs + (w * 16 + i) * 16;
            float pre = b2r;
#pragma unroll
            for (int r = 0; r < 16; ++r) pre += al[r] * w2r[r];
            run += log_sigmoid(pre) * (1.0f / 16.0f);
            cs[i] = run;
        }
        SEG[w * 64 + d] = run;
        __syncthreads();
        float off = 0.f, tot = 0.f;
#pragma unroll
        for (int w2 = 0; w2 < 4; ++w2) { const float s = SEG[w2 * 64 + d]; tot += s; if (w2 < w) off += s; }
        unsigned kop[8];
#pragma unroll
        for (int i2 = 0; i2 < 8; ++i2) {
            float kov[2];
#pragma unroll
            for (int u = 0; u < 2; ++u) {
                const int i = 2 * i2 + u;
                const float bc = off + cs[i];
                const float kv = bf2f((bf16_t)kr[i]);
                const size_t row = rowbase + w * 16 + i;
                R[R_QG + row * 256 + hh * 64 + d] = f2bf(bf2f((bf16_t)qr[i]) * 0.125f * __expf(bc));
                R[R_KG + row * 256 + hh * 64 + d] = f2bf(kv * __expf(-bc));
                kov[u] = kv * __expf(tot - bc);
            }
            kop[i2] = pack2(kov[0], kov[1]);
        }
        bf16_t* kp = KOTg + ((size_t)task * 64 + d) * 64 + w * 16;
        *(uint4*)kp = make_uint4(kop[0], kop[1], kop[2], kop[3]);
        *(uint4*)(kp + 8) = make_uint4(kop[4], kop[5], kop[6], kop[7]);
        if (w == 0) DECg[(size_t)task * 64 + d] = __expf(tot);
    }
}
__device__ __forceinline__ void gla_scan(const Params& p, char* smem, bool dry = false) {
    bf16_t* R = (bf16_t*)(p.ws + OFF_REGION);
    const bf16_t* KOTg = R + R_KOT; const float* DECg = (const float*)(R + R_DEC);
    char* QS = smem; char* KS = smem + 8192; char* KOT = smem + 16384; char* VTs = smem + 24576; char* SPT = smem + 40960;
    float* DEC = (float*)(smem + 57344); float* GN = DEC + 64;
    const int tid = VTID, lane = tid & 63, w = tid >> 6, l15_ = lane & 15, q4 = lane >> 4;
    for (int task = VBID; task < 64; task += VGRID) {
        const int b = task >> 2, hh = task & 3;
        f32x4 Sacc[8];
#pragma unroll
        for (int nt = 0; nt < 8; ++nt) Sacc[nt] = (f32x4){0.f, 0.f, 0.f, 0.f};
        __syncthreads();
        for (int i = tid; i < 1024; i += 256) *(uint4*)(SPT + i * 16) = make_uint4(0, 0, 0, 0);
        if (tid < 128) GN[tid] = p.ab_gla_norm[hh * 128 + tid];
        const size_t rowbase = (size_t)b * 2048;
        const bf16_t* vbase = R + R_VTG + ((size_t)((b * 4 + hh) * 128)) * 2048;
        u32x4 tq[2], tk[2], tko[2], vr[4]; float td = 0.f;
        auto prefetch = [&](int c) {
            const int t0 = c * 64;
#pragma unroll
            for (int i = 0; i < 2; ++i) {
                const int cid = tid + 256 * i, row = cid >> 3, ch = cid & 7;
                tq[i] = *(const u32x4*)(R + R_QG + (rowbase + t0 + row) * 256 + hh * 64 + ch * 8);
                tk[i] = *(const u32x4*)(R + R_KG + (rowbase + t0 + row) * 256 + hh * 64 + ch * 8);
                tko[i] = *(const u32x4*)(KOTg + (((size_t)task * 32 + c) * 64 + row) * 64 + ch * 8);
            }
#pragma unroll
            for (int i = 0; i < 4; ++i) { const int cid = tid + 256 * i, e = cid >> 3, ch = cid & 7; vr[i] = *(const u32x4*)(vbase + (size_t)e * 2048 + t0 + ch * 8); }
            if (tid < 64) td = DECg[((size_t)task * 32 + c) * 64 + tid];
        };
        prefetch(0);
        for (int c = 0; c < 32; ++c) {
            int lz = 0; asm volatile("" : "+v"(lz));
            const int l15 = l15_ + lz;
            const int cx = (q4 ^ (l15 & 7)) << 4;
            const int rb0 = l15 * 128 + cx, rb1 = l15 * 128 + (cx ^ 64);
#pragma unroll
            for (int i = 0; i < 2; ++i) {
                const int cid = tid + 256 * i + lz, row = cid >> 3, ch = cid & 7;
                *(u32x4*)(QS + swz(row, ch)) = tq[i]; *(u32x4*)(KS + swz(row, ch)) = tk[i]; *(u32x4*)(KOT + swz(row, ch)) = tko[i];
            }
#pragma unroll
            for (int i = 0; i < 4; ++i) { const int cid = tid + 256 * i + lz, e = cid >> 3, ch = cid & 7; *(u32x4*)(VTs + swz(e, ch)) = vr[i]; }
            if (tid < 64) DEC[tid] = td;
            uint2 gr[8];
            const unsigned goff = (unsigned)((rowbase + c * 64 + 16 * w + l15) * 512 + hh * 128 + 4 * q4);
            bf16_t* const gbase = R + R_GG;
#pragma unroll
            for (int nt = 0; nt < 8; ++nt) gr[nt] = *(const uint2*)(gbase + (goff + 16 * nt));
            if (c + 1 < 32) prefetch(c + 1);
            __syncthreads();
            bf16x8 qf[2];
#pragma unroll
            for (int kk = 0; kk < 2; ++kk) qf[kk] = *(const bf16x8*)(QS + w * 2048 + (kk ? rb1 : rb0));
            f32x4 sT[4];
#pragma unroll
            for (int st = 0; st < 4; ++st) {
                sT[st] = (f32x4){0.f, 0.f, 0.f, 0.f};
                if (st <= w) {
#pragma unroll
                    for (int kk = 0; kk < 2; ++kk) { const bf16x8 kf = *(const bf16x8*)(KS + st * 2048 + (kk ? rb1 : rb0)); sT[st] = __builtin_amdgcn_mfma_f32_16x16x32_bf16(kf, qf[kk], sT[st], 0, 0, 0); }
#pragma unroll
                    for (int r = 0; r < 4; ++r) if (16 * st + 4 * q4 + r > 16 * w + l15) sT[st][r] = 0.f;
                }
            }
            bf16x8 af[2];
#pragma unroll
            for (int ks2 = 0; ks2 < 2; ++ks2) {
                union { bf16x8 v; unsigned u[4]; } cv;
                cv.u[0] = pack2(sT[2 * ks2][0], sT[2 * ks2][1]); cv.u[1] = pack2(sT[2 * ks2][2], sT[2 * ks2][3]);
                cv.u[2] = pack2(sT[2 * ks2 + 1][0], sT[2 * ks2 + 1][1]); cv.u[3] = pack2(sT[2 * ks2 + 1][2], sT[2 * ks2 + 1][3]);
                af[ks2] = cv.v;
            }
            const int vb = l15 * 128 + ((((q4 >> 1) ^ (l15 & 7)) << 4) | ((q4 & 1) * 8));
            f32x4 o[8];
#pragma unroll
            for (int nt = 0; nt < 8; ++nt) {
                o[nt] = (f32x4){0.f, 0.f, 0.f, 0.f};
                const int e = 16 * nt + l15;
#pragma unroll
                for (int kk = 0; kk < 2; ++kk) { const bf16x8 sf = *(const bf16x8*)(SPT + nt * 2048 + (kk ? rb1 : rb0)); o[nt] = __builtin_amdgcn_mfma_f32_16x16x32_bf16(sf, qf[kk], o[nt], 0, 0, 0); }
#pragma unroll
                for (int ks2 = 0; ks2 < 2; ++ks2) {
                    if (2 * ks2 <= w) {
                        union { bf16x8 v; uint2 h[2]; } cv;
                        cv.h[0] = *(const uint2*)(VTs + nt * 2048 + (vb ^ (ks2 * 64)));
                        cv.h[1] = *(const uint2*)(VTs + nt * 2048 + (vb ^ (ks2 * 64) ^ 32));
                        o[nt] = __builtin_amdgcn_mfma_f32_16x16x32_bf16(cv.v, af[ks2], o[nt], 0, 0, 0);
                    }
                }
            }
            {
                const float4 dc = *(const float4*)(DEC + 16 * w + 4 * q4);
                bf16x8 kof[2];
#pragma unroll
                for (int kk = 0; kk < 2; ++kk) kof[kk] = *(const bf16x8*)(KOT + w * 2048 + (kk ? rb1 : rb0));
#pragma unroll
                for (int nt = 0; nt < 8; ++nt) {
                    Sacc[nt][0] *= dc.x; Sacc[nt][1] *= dc.y; Sacc[nt][2] *= dc.z; Sacc[nt][3] *= dc.w;
#pragma unroll
                    for (int kk = 0; kk < 2; ++kk) { const bf16x8 vf = *(const bf16x8*)(VTs + nt * 2048 + (kk ? rb1 : rb0)); Sacc[nt] = __builtin_amdgcn_mfma_f32_16x16x32_bf16(kof[kk], vf, Sacc[nt], 0, 0, 0); }
                }
            }
            __syncthreads();
#pragma unroll
            for (int nt = 0; nt < 8; ++nt) {
                const int e = 16 * nt + l15;
                uint2 pk; pk.x = pack2(Sacc[nt][0], Sacc[nt][1]); pk.y = pack2(Sacc[nt][2], Sacc[nt][3]);
                *(uint2*)(SPT + nt * 2048 + l15 * 128 + (((2 * w + (q4 >> 1)) ^ (l15 & 7)) << 4) + (q4 & 1) * 8) = pk;
            }
            float ssq = 0.f;
#pragma unroll
            for (int nt = 0; nt < 8; ++nt) ssq += (o[nt][0] * o[nt][0] + o[nt][1] * o[nt][1]) + (o[nt][2] * o[nt][2] + o[nt][3] * o[nt][3]);
            ssq += __shfl_xor(ssq, 16); ssq += __shfl_xor(ssq, 32);
            const float rsd = rsqrtf(ssq * (1.0f / 128.0f) + EPS);
#pragma unroll
            for (int nt = 0; nt < 8; ++nt) {
                asm volatile("" ::: "memory");
                const f32x4 gn = *(const f32x4*)(GN + 16 * nt + 4 * q4);
                const float g0 = lo2f(gr[nt].x), g1 = hi2f(gr[nt].x), g2 = lo2f(gr[nt].y), g3 = hi2f(gr[nt].y);
                uint2 ov;
                ov.x = pack2(o[nt][0] * rsd * gn[0] * g0, o[nt][1] * rsd * gn[1] * g1);
                ov.y = pack2(o[nt][2] * rsd * gn[2] * g2, o[nt][3] * rsd * gn[3] * g3);
                if (!dry || ov.x == 0x7fc17fc1u) *(uint2*)(gbase + (goff + 16 * nt)) = ov;
            }
        }
    }
}

__device__ __forceinline__ unsigned ord_key(float f) { const unsigned u = __float_as_uint(f); return (u & 0x80000000u) ? ~u : (u | 0x80000000u); }
__device__ __forceinline__ float unord_key(unsigned k) { return __uint_as_float((k & 0x80000000u) ? (k & 0x7fffffffu) : ~k); }
__device__ __forceinline__ void ce_desc(unsigned& a, unsigned& b) { const unsigned hi = max(a, b), lo = min(a, b); a = hi; b = lo; }
__device__ __forceinline__ void bitonic_sort16_desc(unsigned (&a)[16]) {
#pragma unroll
    for (int k = 2; k <= 16; k <<= 1)
#pragma unroll
        for (int j = k >> 1; j > 0; j >>= 1)
#pragma unroll
            for (int i = 0; i < 16; ++i) { const int l = i ^ j; if (l > i) { if ((i & k) == 0) ce_desc(a[i], a[l]); else ce_desc(a[l], a[i]); } }
}
__device__ __forceinline__ void merge_top16(unsigned (&L)[16], const unsigned (&B)[16]) {
#pragma unroll
    for (int i = 0; i < 16; ++i) L[i] = max(L[i], B[15 - i]);
#pragma unroll
    for (int j = 8; j > 0; j >>= 1)
#pragma unroll
        for (int i = 0; i < 16; ++i) { const int l = i ^ j; if (l > i) ce_desc(L[i], L[l]); }
}
__device__ constexpr int cand_i(int n) { int c = 0; for (int i = 0; i < 16; ++i) for (int j = 0; j < 16; ++j) if ((i + 1) * (j + 1) <= 16) { if (c == n) return i; ++c; } return -1; }
__device__ constexpr int cand_j(int n) { int c = 0; for (int i = 0; i < 16; ++i) for (int j = 0; j < 16; ++j) if ((i + 1) * (j + 1) <= 16) { if (c == n) return j; ++c; } return -1; }
template <int N> struct CandTab { int i[N], j[N]; constexpr CandTab() : i(), j() { for (int n = 0; n < N; ++n) { i[n] = cand_i(n); j[n] = cand_j(n); } } };

__device__ __forceinline__ bf16x8 pack8(const float4 a, const float4 b) {
    u32x4 t; t.x = pack2(a.x, a.y); t.y = pack2(a.z, a.w); t.z = pack2(b.x, b.y); t.w = pack2(b.z, b.w);
    return __builtin_bit_cast(bf16x8, t);
}
__device__ __forceinline__ void fold_query_weights(const Params& p, int vb0 = 0) {
    int lz = 0; asm volatile("" : "+v"(lz));
    const int lane = (VTID & 63) + lz, wid = VTID >> 6, fr = lane & 15, fq = lane >> 4;
    bf16_t* Wf = (bf16_t*)(p.ws + OFF_WT_Q);
    if (VBID < vb0) return;
    for (int task = VBID - vb0; task < 512; task += VGRID - vb0) {
        const int kb = task & 15, pp = (task >> 4) & 1, h = (task >> 5) & 7, layer = task >> 8;
        const float* wq = p.peer_w_q + (size_t)layer * 1024 * 2048 + (size_t)(kb * 64 + fr) * 2048 + h * 256 + pp * 128 + fq * 8;
        const float* sk = p.peer_subkeys + ((size_t)((layer * 8 + h) * 2 + pp) * 128 + wid * 32 + fr) * 128 + fq * 8;
        f32x4 acc[4][2];
#pragma unroll
        for (int kt = 0; kt < 4; ++kt)
#pragma unroll
            for (int jt = 0; jt < 2; ++jt) acc[kt][jt] = (f32x4){0.f, 0.f, 0.f, 0.f};
#pragma unroll 1
        for (int s = 0; s < 4; ++s) {
            bf16x8 a[4], b[2];
#pragma unroll
            for (int kt = 0; kt < 4; ++kt) { const float* q = wq + (size_t)(kt * 16) * 2048 + s * 32; a[kt] = pack8(*(const float4*)q, *(const float4*)(q + 4)); }
#pragma unroll
            for (int jt = 0; jt < 2; ++jt) { const float* q = sk + (size_t)(jt * 16) * 128 + s * 32; b[jt] = pack8(*(const float4*)q, *(const float4*)(q + 4)); }
#pragma unroll
            for (int kt = 0; kt < 4; ++kt)
#pragma unroll
                for (int jt = 0; jt < 2; ++jt) acc[kt][jt] = __builtin_amdgcn_mfma_f32_16x16x32_bf16(a[kt], b[jt], acc[kt][jt], 0, 0, 0);
        }
#pragma unroll
        for (int jt = 0; jt < 2; ++jt) {
            const int key = wid * 32 + jt * 16 + fr, cu = 128 * ((key >> 5) & 1) + 32 * (2 * pp + (key >> 6)) + (key & 31);
            bf16_t* row = Wf + ((size_t)layer * 2048 + h * 256 + cu) * 1024 + kb * 64 + 4 * fq;
#pragma unroll
            for (int kt = 0; kt < 4; ++kt) store_bf16x4(row + kt * 16, acc[kt][jt] * *(const f32x4*)(p.norm_ffn + layer * 1024 + kb * 64 + kt * 16 + 4 * fq));
        }
    }
}
__device__ __forceinline__ void bitonic_merge16_desc(unsigned (&L)[16]) {
#pragma unroll
    for (int j = 8; j > 0; j >>= 1)
#pragma unroll
        for (int i = 0; i < 16; ++i) { const int l = i ^ j; if (l > i) ce_desc(L[i], L[l]); }
}
__device__ __forceinline__ void bitonic_sort8_desc(unsigned (&a)[8]) {
#pragma unroll
    for (int k = 2; k <= 8; k <<= 1)
#pragma unroll
        for (int j = k >> 1; j > 0; j >>= 1)
#pragma unroll
            for (int i = 0; i < 8; ++i) { const int l = i ^ j; if (l > i) { if ((i & k) == 0) ce_desc(a[i], a[l]); else ce_desc(a[l], a[i]); } }
}
__device__ __forceinline__ void sort16_desc(unsigned (&a)[16]) {
#define CE_(i, j) ce_desc(a[i], a[j])
    CE_(0,13); CE_(1,12); CE_(2,15); CE_(3,14); CE_(4,8); CE_(5,6); CE_(7,11); CE_(9,10);
    CE_(0,5); CE_(1,7); CE_(2,9); CE_(3,4); CE_(6,13); CE_(8,14); CE_(10,15); CE_(11,12);
    CE_(0,1); CE_(2,3); CE_(4,5); CE_(6,8); CE_(7,9); CE_(10,11); CE_(12,13); CE_(14,15);
    CE_(0,2); CE_(1,3); CE_(4,10); CE_(5,11); CE_(6,7); CE_(8,9); CE_(12,14); CE_(13,15);
    CE_(1,2); CE_(3,12); CE_(4,6); CE_(5,7); CE_(8,10); CE_(9,11); CE_(13,14);
    CE_(1,4); CE_(2,6); CE_(5,8); CE_(7,10); CE_(9,13); CE_(11,14);
    CE_(2,4); CE_(3,6); CE_(9,12); CE_(11,13);
    CE_(3,5); CE_(6,8); CE_(7,9); CE_(10,12);
    CE_(3,4); CE_(5,6); CE_(7,8); CE_(9,10); CE_(11,12);
    CE_(6,7); CE_(8,9);
#undef CE_
}
struct EpiSelect {
    unsigned* IDX; float* GATE; G8_LAS unsigned* X; const float* SSQP; const unsigned* SCT;
    __device__ __forceinline__ void operator()(const f32x4 (&acc)[2][2][4][2], const g8::Unit& u, int wr, int wc, int fr, int fq) const {
        const int pp = wc >> 1, half = wc & 1, wid = wr * 4 + wc;
        const unsigned kb = 127u - (unsigned)(half * 64 + fq * 8);
        unsigned Lst[4][16];
#pragma unroll
        for (int ai = 0; ai < 2; ++ai)
#pragma unroll
            for (int m = 0; m < 4; ++m) {
                unsigned C[16], Xc[16];
#pragma unroll
                for (int bj = 0; bj < 2; ++bj)
#pragma unroll
                    for (int n = 0; n < 2; ++n)
#pragma unroll
                        for (int r = 0; r < 4; ++r) C[bj * 8 + n * 4 + r] = (ord_key(acc[ai][bj][m][n][r]) & ~127u) | (kb - (unsigned)(bj * 32 + n * 4 + r));
                sort16_desc(C);
#pragma unroll
                for (int i = 0; i < 16; ++i) Xc[i] = (unsigned)__shfl_xor((int)C[i], 16);
                merge_top16(C, Xc);
#pragma unroll
                for (int i = 0; i < 16; ++i) Xc[i] = (unsigned)__shfl_xor((int)C[i], 32);
                merge_top16(C, Xc);
                if ((m >> 1) == half) {
#pragma unroll
                    for (int i = 0; i < 16; ++i) Lst[ai * 2 + (m & 1)][i] = C[i];
                } else if (fq == 0) {
                    G8_LAS unsigned* xs = X + (((ai * 2 + wr) * 2 + pp) * 4 + m) * 256 + fr;
#pragma unroll
                    for (int i = 0; i < 16; ++i) xs[(i ^ m) << 4] = C[i];
                }
            }
        __syncthreads();
#pragma unroll
        for (int ai = 0; ai < 2; ++ai)
#pragma unroll
            for (int e = 0; e < 2; ++e) {
                const int m = half * 2 + e;
                unsigned Xc[16];
                G8_LAS unsigned* xs = X + (((ai * 2 + wr) * 2 + pp) * 4 + m) * 256 + fr;
#pragma unroll
                for (int i = 0; i < 16; ++i) Xc[i] = xs[(i ^ m) << 4];
                merge_top16(Lst[ai * 2 + e], Xc);
                if (fq == 0) {
#pragma unroll
                    for (int i = 0; i < 16; ++i) xs[(i ^ m) << 4] = Lst[ai * 2 + e][i];
                }
            }
        __syncthreads();
        if (wid < 4) {
            G8_LAS unsigned* x0 = X + ((wid * 2 + 0) * 4 + fq) * 256 + fr; G8_LAS unsigned* x1 = X + ((wid * 2 + 1) * 4 + fq) * 256 + fr;
            float s0[16], s1[16];
#pragma unroll
            for (int i = 0; i < 16; ++i) { s0[i] = unord_key(x0[(i ^ fq) << 4] & ~127u); s1[i] = unord_key(x1[(i ^ fq) << 4] & ~127u); }
#define SEL_CAND(i, j) ((ord_key(s0[i] + s1[j]) & ~255u) | (unsigned)(255 - ((i) * 16 + (j))))
            unsigned C[16], B[16], M2[16], M3[8];
#pragma unroll
            for (int j = 0; j < 16; ++j) C[j] = SEL_CAND(0, j);
#pragma unroll
            for (int k = 0; k < 15; ++k) B[k] = SEL_CAND(k + 1, 0);
            B[15] = 0u;
            merge_top16(C, B);
#pragma unroll
            for (int j = 0; j < 7; ++j) M2[j] = SEL_CAND(1, j + 1);
            M2[7] = 0u; M2[8] = 0u; M2[9] = 0u;
#pragma unroll
            for (int k = 0; k < 6; ++k) M2[15 - k] = SEL_CAND(k + 2, 1);
            bitonic_merge16_desc(M2);
            M3[0] = SEL_CAND(2, 2); M3[1] = SEL_CAND(2, 3); M3[2] = SEL_CAND(2, 4); M3[3] = SEL_CAND(3, 2); M3[4] = SEL_CAND(4, 2); M3[5] = SEL_CAND(3, 3); M3[6] = 0u; M3[7] = 0u;
            bitonic_sort8_desc(M3);
#pragma unroll
            for (int i = 0; i < 8; ++i) B[i] = M3[i];
#pragma unroll
            for (int i = 8; i < 16; ++i) B[i] = 0u;
            merge_top16(M2, B);
            merge_top16(C, M2);
#undef SEL_CAND
            const int tok = u.pm * 256 + (wid >> 1) * 128 + (wid & 1) * 64 + fq * 16 + fr;
            float rstd;
            {
                const f32x4 q0 = *(const f32x4*)(SSQP + (size_t)tok * 32), q1 = *(const f32x4*)(SSQP + (size_t)tok * 32 + 4), q2 = *(const f32x4*)(SSQP + (size_t)tok * 32 + 8), q3 = *(const f32x4*)(SSQP + (size_t)tok * 32 + 12);
                const f32x4 q = (q0 + q1) + (q2 + q3);
                rstd = rsqrtf(((q[0] + q[1]) + (q[2] + q[3])) * (1.0f / D) + EPS);
            }
            const float mx = unord_key(C[0] & ~255u);
            float e[16]; float sum = 0.f;
#pragma unroll
            for (int r = 0; r < 16; ++r) { e[r] = __expf((unord_key(C[r] & ~255u) - mx) * rstd); sum += e[r]; }
            const float inv = 1.0f / sum;
            const size_t ob = (size_t)tok * 128 + u.pn * 16;
            unsigned iw[16];
#pragma unroll
            for (int r = 0; r < 16; ++r) {
                const unsigned code = 255u - (C[r] & 255u);
                const unsigned e0 = 127u - (x0[((code >> 4) ^ (unsigned)fq) << 4] & 127u), e1 = 127u - (x1[((code & 15u) ^ (unsigned)fq) << 4] & 127u);
                iw[r] = e0 * 128u + e1;
            }
            unsigned sc[16];
#pragma unroll
            for (int r = 0; r < 16; ++r) sc[r] = SCT[iw[r]];
#pragma unroll
            for (int r = 0; r < 16; ++r) {
                iw[r] |= sc[r] << 16;
                e[r] *= inv * (float)__builtin_bit_cast(_Float16, (unsigned short)(sc[r] >> 16));
            }
#pragma unroll
            for (int r = 0; r < 4; ++r) *(uint4*)(IDX + ob + r * 4) = make_uint4(iw[4 * r], iw[4 * r + 1], iw[4 * r + 2], iw[4 * r + 3]);
#pragma unroll
            for (int r = 0; r < 4; ++r) *(float4*)(GATE + ob + r * 4) = make_float4(e[4 * r], e[4 * r + 1], e[4 * r + 2], e[4 * r + 3]);
        }
        __syncthreads();
    }
};
__device__ __forceinline__ void phase_select8(const Params& p, int layer, char* smem_phys) {
    const bf16_t* H = (const bf16_t*)(p.ws + OFF_S); const bf16_t* Wf = (const bf16_t*)(p.ws + OFF_WT_Q) + (size_t)layer * 2048 * 1024;
    g8::Gemm g{H, H, 1024, 1024, Wf, T, 2048, 1024};
    g8::StaticOrder S; S.init(T, 2048, (int)gridDim.x, (int)blockIdx.x);
    EpiSelect E{(unsigned*)(p.ws + OFF_IDX), (float*)(p.ws + OFF_GATE), (G8_LAS unsigned*)(smem_phys + 131072), (const float*)(p.ws + OFF_SSQ), (const unsigned*)(p.ws + OFF_USC) + (size_t)layer * NEXP};
    g8::gemm_phase<EpiSelect>((G8_LAS unsigned char*)smem_phys, g, S, E);
    __syncthreads();
    if (threadIdx.x == 0) *(uint4*)(smem_phys + kDynLds - 16) = make_uint4(0u, 0u, 0u, 0u);
    __syncthreads();
}

__device__ __forceinline__ float ub0(unsigned w) { float f; asm("v_cvt_f32_ubyte0 %0, %1" : "=v"(f) : "v"(w)); return f; }
__device__ __forceinline__ float ub1(unsigned w) { float f; asm("v_cvt_f32_ubyte1 %0, %1" : "=v"(f) : "v"(w)); return f; }
__device__ __forceinline__ float ub2(unsigned w) { float f; asm("v_cvt_f32_ubyte2 %0, %1" : "=v"(f) : "v"(w)); return f; }
__device__ __forceinline__ float ub3(unsigned w) { float f; asm("v_cvt_f32_ubyte3 %0, %1" : "=v"(f) : "v"(w)); return f; }
typedef _Float16 f16x2 __attribute__((ext_vector_type(2)));
__device__ __forceinline__ void glds16(const void* gsrc, unsigned lds_dst) {
    unsigned keep; const unsigned d = (unsigned)__builtin_amdgcn_readfirstlane((int)lds_dst);
    asm volatile("s_mov_b32 %0, m0\n\ts_mov_b32 m0, %2\n\ts_nop 0\n\tglobal_load_lds_dwordx4 %1, off\n\ts_mov_b32 m0, %0" : "=&s"(keep) : "v"(gsrc), "s"(d) : "memory");
}
__device__ __forceinline__ void peer_gather(const Params& p, int layer, const float* __restrict__ gnext, bool final_out, char* smem) {
    const unsigned char* REC = p.ws + OFF_UT + (size_t)layer * NEXP * 1024;
    bf16_t* H = (bf16_t*)(p.ws + OFF_H);
    const unsigned* IDX = (const unsigned*)(p.ws + OFF_IDX); const float* GATE = (const float*)(p.ws + OFF_GATE);
    bf16_t* S = (bf16_t*)(p.ws + OFF_S);
    float* sGain = (float*)(smem + 139264);
    { int lz0 = 0; asm volatile("" : "+v"(lz0)); const int i = (int)threadIdx.x + lz0; if (i < 256) ((f32x4*)sGain)[i] = ((const f32x4*)(p.norm_ffn + layer * 1024))[i]; }
    __syncthreads();
    const int lane = VTID & 63, wid = VTID >> 6, sub = lane >> 4, li = lane & 15;
    char* wbase = smem + (int)(threadIdx.x >> 6) * 17408;
    unsigned* sIdx = (unsigned*)wbase; float* sGate = (float*)(wbase + 512);
    const char* ring = wbase + 1024; const unsigned ringb = (unsigned)(size_t)ring;
    const int gw = VBID * 4 + wid, nw = VGRID * 4;
    for (int t = gw; t < T; t += nw) {
        {
            int lz = 0; asm volatile("" : "+v"(lz));
            const int l2 = 2 * (lane + lz);
            const uint2 idp = *(const uint2*)(IDX + (size_t)t * 128 + l2);
            const float2 g2 = *(const float2*)(GATE + (size_t)t * 128 + l2);
            *(uint2*)(sIdx + l2) = idp; *(float2*)(sGate + l2) = g2;
        }
        int XH[2][4], XL[2][4]; float sx; float xg;
        {
            const int jq = sub >> 1, dq = (sub & 1) * 2;
            f32x4 xr[4]; float am = 0.f, ssx = 0.f;
#pragma unroll
            for (int k = 0; k < 2; ++k) {
                const int col = (16 * jq + li) * 32 + (dq + k) * 8;
                const u32x4 raw = *(const u32x4*)(S + (size_t)t * 1024 + col);
                const f32x4 g0 = *(const f32x4*)(sGain + col), g1 = *(const f32x4*)(sGain + col + 4);
                const f32x4 x0 = (f32x4){lo2f(raw[0]), hi2f(raw[0]), lo2f(raw[1]), hi2f(raw[1])}, x1 = (f32x4){lo2f(raw[2]), hi2f(raw[2]), lo2f(raw[3]), hi2f(raw[3])};
                ssx += (x0[0] * x0[0] + x0[1] * x0[1]) + (x0[2] * x0[2] + x0[3] * x0[3]) + (x1[0] * x1[0] + x1[1] * x1[1]) + (x1[2] * x1[2] + x1[3] * x1[3]);
                xr[2 * k] = x0 * g0; xr[2 * k + 1] = x1 * g1;
#pragma unroll
                for (int c = 0; c < 4; ++c) am = fmaxf(am, fmaxf(fabsf(xr[2 * k][c]), fabsf(xr[2 * k + 1][c])));
            }
            am = fmaxf(am, __shfl_xor(am, 1)); am = fmaxf(am, __shfl_xor(am, 2)); am = fmaxf(am, __shfl_xor(am, 4)); am = fmaxf(am, __shfl_xor(am, 8));
            am = fmaxf(am, __shfl_xor(am, 16)); am = fmaxf(am, __shfl_xor(am, 32));
            ssx = row16_sum(ssx); ssx += __shfl_xor(ssx, 16); ssx += __shfl_xor(ssx, 32);
            const float inv = am > 0.f ? 119.0f / am : 0.f;
            sx = am * (1.0f / 119.0f) * rsqrtf(ssx * (1.0f / D) + EPS);
            int xs = 0; int myL[2], myH[2];
#pragma unroll
            for (int k = 0; k < 2; ++k) {
                unsigned lo = 0u, hi = 0u;
#pragma unroll
                for (int i = 0; i < 8; ++i) {
                    const int q = __float2int_rn(xr[k * 2 + (i >> 2)][i & 3] * inv);
                    const int sh = (i & 3) * 8 + (i >> 2) * 4;
                    lo |= ((unsigned)q & 15u) << sh; hi |= ((unsigned)((q + 8) >> 4) & 15u) << sh;
                    xs += q;
                }
                myL[k] = (int)lo; myH[k] = (int)hi;
            }
            xs += __shfl_xor(xs, 16); xs += __shfl_xor(xs, 32);
#pragma unroll
            for (int j = 0; j < 2; ++j)
#pragma unroll
                for (int d = 0; d < 4; ++d) { const int srcl = (2 * j + (d >> 1)) * 16 + li; XL[j][d] = __shfl(myL[d & 1], srcl); XH[j][d] = __shfl(myH[d & 1], srcl); }
            xg = 0.5f * (float)xs;
        }
        f16x2 accp[2][16];
#pragma unroll
        for (int j = 0; j < 2; ++j)
#pragma unroll
            for (int c = 0; c < 16; ++c) accp[j][c] = (f16x2){(_Float16)0.f, (_Float16)0.f};
        float wsg = 0.f;
        auto issue = [&](int sg) {
            const unsigned e_ = sIdx[sg * 4 + sub] & 0xffffu;
            const unsigned char* rec = REC + (size_t)e_ * 1024 + li * 16;
            const unsigned dst = ringb + (unsigned)(sg & 3) * 4096u;
            glds16(rec, dst); glds16(rec + 256, dst + 1024u); glds16(rec + 512, dst + 2048u); glds16(rec + 768, dst + 3072u);
        };
        auto compute = [&](int sg, bool refill) {
            const char* sl = ring + (sg & 3) * 4096;
            const u32x4 du0 = *(const u32x4*)(sl + lane * 16), du1 = *(const u32x4*)(sl + 1024 + lane * 16);
            const u32x4 dv0 = *(const u32x4*)(sl + 2048 + lane * 16), dv1 = *(const u32x4*)(sl + 3072 + lane * 16);
            const float us = (float)__builtin_bit_cast(_Float16, (unsigned short)(sIdx[sg * 4 + sub] >> 16));
            const float gt = sGate[sg * 4 + sub];
            if (refill) { asm volatile("s_waitcnt lgkmcnt(0)" ::: "memory"); issue(sg + 4); }
            int iah = 0, ial = 0;
#pragma unroll
            for (int j = 0; j < 2; ++j) {
#pragma unroll
                for (int d = 0; d < 4; ++d) {
                    const int w = (int)(j ? du1[d] : du0[d]);
                    iah = __builtin_amdgcn_sdot8(w, XH[j][d], iah, false);
                    ial = __builtin_amdgcn_sdot8(w, XL[j][d], ial, false);
                }
            }
            float pa = us * ((float)(16 * iah + ial) + xg);
            pa = row16_sum(pa);
            const float ww = gt * gelu_exact(pa * sx);
            wsg += ww;
            const float wc = fminf(fmaxf(ww * 65536.0f, -65504.0f), 65504.0f);
            const _Float16 wha = (_Float16)wc, whb = (_Float16)(wc * 0.0625f);
            const f16x2 wa = {wha, wha}, wb = {whb, whb};
#pragma unroll
            for (int j = 0; j < 2; ++j) {
#pragma unroll
                for (int d = 0; d < 4; ++d) {
                    const unsigned wv = j ? dv1[d] : dv0[d], wt = wv >> 8;
                    const f16x2 c0 = __builtin_bit_cast(f16x2, wv & 0x000f000fu), c1 = __builtin_bit_cast(f16x2, wv & 0x00f000f0u);
                    const f16x2 c2 = __builtin_bit_cast(f16x2, wt & 0x000f000fu), c3 = __builtin_bit_cast(f16x2, wt & 0x00f000f0u);
                    accp[j][4 * d + 0] = __builtin_elementwise_fma(c0, wa, accp[j][4 * d + 0]); accp[j][4 * d + 1] = __builtin_elementwise_fma(c1, wb, accp[j][4 * d + 1]);
                    accp[j][4 * d + 2] = __builtin_elementwise_fma(c2, wa, accp[j][4 * d + 2]); accp[j][4 * d + 3] = __builtin_elementwise_fma(c3, wb, accp[j][4 * d + 3]);
                }
            }
        };
        asm volatile("s_waitcnt vmcnt(0)" ::: "memory");
        issue(0); issue(1); issue(2); issue(3);
#pragma unroll 1
        for (int sg = 0; sg < 28; ++sg) {
            asm volatile("s_waitcnt vmcnt(12)" ::: "memory");
            compute(sg, true);
        }
        asm volatile("s_waitcnt vmcnt(12)" ::: "memory");
        compute(28, false);
        asm volatile("s_waitcnt vmcnt(8)" ::: "memory");
        compute(29, false);
        asm volatile("s_waitcnt vmcnt(4)" ::: "memory");
        compute(30, false);
        asm volatile("s_waitcnt vmcnt(0)" ::: "memory");
        compute(31, false);
        const bool up2 = (sub & 2) != 0, up1 = (sub & 1) != 0;
        float wsum = wsg + __shfl_xor(wsg, 32);
        wsum += __shfl_xor(wsum, 16);
        f16x2 r1p[16];
#pragma unroll
        for (int c = 0; c < 16; ++c) {
            const f16x2 keep = up2 ? accp[1][c] : accp[0][c], give = up2 ? accp[0][c] : accp[1][c];
            r1p[c] = keep + __builtin_bit_cast(f16x2, __shfl_xor(__builtin_bit_cast(int, give), 32));
        }
        f16x2 r2p[8];
#pragma unroll
        for (int c = 0; c < 8; ++c) {
            const f16x2 keep = up1 ? r1p[8 + c] : r1p[c], give = up1 ? r1p[c] : r1p[8 + c];
            r2p[c] = keep + __builtin_bit_cast(f16x2, __shfl_xor(__builtin_bit_cast(int, give), 16));
        }
        float r2[16];
#pragma unroll
        for (int dl = 0; dl < 2; ++dl) {
            r2[8 * dl + 0] = 256.0f * (float)r2p[4 * dl + 0][0]; r2[8 * dl + 2] = 256.0f * (float)r2p[4 * dl + 0][1];
            r2[8 * dl + 4] = 256.0f * (float)r2p[4 * dl + 1][0]; r2[8 * dl + 6] = 256.0f * (float)r2p[4 * dl + 1][1];
            r2[8 * dl + 1] = 256.0f * (float)r2p[4 * dl + 2][0]; r2[8 * dl + 3] = 256.0f * (float)r2p[4 * dl + 2][1];
            r2[8 * dl + 5] = 256.0f * (float)r2p[4 * dl + 3][0]; r2[8 * dl + 7] = 256.0f * (float)r2p[4 * dl + 3][1];
        }
        const int col0 = (16 * (sub >> 1) + li) * 32 + (sub & 1) * 16;
        float ss = 0.f;
        bf16_t* srow = S + (size_t)t * 1024 + col0;
        {
            const u32x4 b0 = *(const u32x4*)srow, b1 = *(const u32x4*)(srow + 8);
#pragma unroll
            for (int c = 0; c < 8; ++c) {
                const unsigned wsrc = c < 4 ? b0[c] : b1[c - 4];
                r2[2 * c] = r2[2 * c] - 7.5f * wsum + lo2f(wsrc); r2[2 * c + 1] = r2[2 * c + 1] - 7.5f * wsum + hi2f(wsrc);
                ss += r2[2 * c] * r2[2 * c] + r2[2 * c + 1] * r2[2 * c + 1];
            }
        }
        ss = wave_sum(ss);
        const float rstd = rsqrtf(ss * (1.0f / D) + EPS);
        const float* gp = gnext + col0;
        if (final_out) {
            float* orow = p.out + (size_t)t * 1024 + col0;
#pragma unroll
            for (int c4 = 0; c4 < 4; ++c4) {
                const f32x4 g = *(const f32x4*)(gp + c4 * 4);
                *(f32x4*)(orow + c4 * 4) = (f32x4){r2[c4 * 4] * rstd * g[0], r2[c4 * 4 + 1] * rstd * g[1], r2[c4 * 4 + 2] * rstd * g[2], r2[c4 * 4 + 3] * rstd * g[3]};
            }
        } else {
            u32x4 sv[2];
#pragma unroll
            for (int c4 = 0; c4 < 4; ++c4) { sv[c4 >> 1][(c4 & 1) * 2] = pack2(r2[c4 * 4], r2[c4 * 4 + 1]); sv[c4 >> 1][(c4 & 1) * 2 + 1] = pack2(r2[c4 * 4 + 2], r2[c4 * 4 + 3]); }
            *(u32x4*)srow = sv[0]; *(u32x4*)(srow + 8) = sv[1];
            if (lane == 0) ((float*)(p.ws + OFF_VSC))[t] = rstd;
        }
    }
}


#define XB_TMO      128
#define XB_XCNT(j)  (256  + 64 * (j))
#define XB_XSUB(j)  (1280 + 64 * (j))
#define XB_XGEN(j)  (2304 + 64 * (j))
#define XB_TOP      3328
#define XB_TOPGEN   3392
#define XCD_BAR_WORDS 3456
#define XB_SPIN_CAP (1u << 22)
#define LAS __attribute__((address_space(3)))
__device__ __forceinline__ unsigned xb_ld(unsigned* p)              { return __hip_atomic_load(p, __ATOMIC_RELAXED, __HIP_MEMORY_SCOPE_AGENT); }
__device__ __forceinline__ unsigned xb_add(unsigned* p, unsigned v) { return __hip_atomic_fetch_add(p, v, __ATOMIC_RELAXED, __HIP_MEMORY_SCOPE_AGENT); }
__device__ __forceinline__ unsigned xb_xcc_id() { return (unsigned)__builtin_amdgcn_s_getreg((3 << 11) | 20) & 0xFu; }
#define XB_SPIN(cond, bar) do { unsigned _sp = 0; while (cond) { __builtin_amdgcn_s_sleep(1); \
    if ((++_sp & 255u) == 0u) { if (xb_ld(&(bar)[XB_TMO])) break; if (_sp > XB_SPIN_CAP) { atomicAdd(&(bar)[XB_TMO], 1u); break; } } } } while (0)
struct XcdBarrier { unsigned* bar; unsigned x; volatile LAS unsigned* st; };
__device__ __forceinline__ XcdBarrier xcd_barrier_post(unsigned* bar, volatile LAS unsigned* st) {
    XcdBarrier b; b.bar = bar; b.x = xb_xcc_id(); b.st = st;
    if (threadIdx.x == 0) (void)xb_add(&bar[XB_XCNT(b.x)], 1u);
    return b;
}
__device__ __forceinline__ void xcd_barrier_complete(unsigned* bar, unsigned x, unsigned& nloc, unsigned& nx) {
    const unsigned G = gridDim.x * gridDim.y * gridDim.z;
    unsigned sum, cnt, mine, sp = 0u;
    for (;;) {
        sum = 0u; cnt = 0u; mine = 0u;
#pragma unroll
        for (unsigned j = 0; j < 16; ++j) { const unsigned c = xb_ld(&bar[XB_XCNT(j)]); sum += c; cnt += (c > 0u) ? 1u : 0u; mine = (j == x) ? c : mine; }
        if (sum == G) break;
        __builtin_amdgcn_s_sleep(1);
        if ((++sp & 255u) == 0u) { if (xb_ld(&bar[XB_TMO])) break; if (sp > XB_SPIN_CAP) { atomicAdd(&bar[XB_TMO], 1u); break; } }
    }
    nloc = mine > 0u ? mine : 1u; nx = cnt > 0u ? cnt : 1u;
}
__device__ __forceinline__ void xcd_barrier(const XcdBarrier& b) {
    asm volatile("s_waitcnt vmcnt(0)" ::: "memory");
    __syncthreads();
    if (threadIdx.x == 0) {
        unsigned* bar = b.bar;
        __builtin_amdgcn_s_waitcnt(0);
        unsigned nloc = b.st[0], nx = b.st[1];
        if (nloc == 0u) { xcd_barrier_complete(bar, b.x, nloc, nx); b.st[0] = nloc; b.st[1] = nx; }
        const unsigned old = xb_add(&bar[XB_XSUB(b.x)], 1u);
        const unsigned gen = old / nloc;
        if (old + 1u == (gen + 1u) * nloc) {
            __builtin_amdgcn_fence(__ATOMIC_RELEASE, "agent");
            asm volatile("s_waitcnt vmcnt(0)" ::: "memory");
            const unsigned og = xb_add(&bar[XB_TOP], 1u);
            const unsigned tg = og / nx;
            if (og + 1u == (tg + 1u) * nx) xb_add(&bar[XB_TOPGEN], 1u);
            else XB_SPIN(xb_ld(&bar[XB_TOPGEN]) == tg, bar);
            __builtin_amdgcn_fence(__ATOMIC_ACQUIRE, "agent");
            xb_add(&bar[XB_XGEN(b.x)], 1u);
            asm volatile("s_waitcnt vmcnt(0)" ::: "memory");
        } else {
            XB_SPIN(xb_ld(&bar[XB_XGEN(b.x)]) == gen, bar);
            __builtin_amdgcn_fence(__ATOMIC_ACQUIRE, "agent");
            asm volatile("s_waitcnt vmcnt(0)" ::: "memory");
        }
    }
    __syncthreads();
}

constexpr int NPHASE = 12;
__global__ void __launch_bounds__(512, 2) mega(Params p, int ph_lo, int ph_hi) {
    extern __shared__ __attribute__((aligned(16))) char smem_phys[];
    uint4& xb_words = *(uint4*)(smem_phys + kDynLds - 16);
    if (threadIdx.x == 0) xb_words = make_uint4(0u, 0u, 0u, 0u);
    __syncthreads();
    const XcdBarrier xbar = xcd_barrier_post((unsigned*)(p.ws + OFF_BAR), (volatile LAS unsigned*)&xb_words);
    char* smem = smem_phys + (threadIdx.x >> 8) * 65536;
    bf16_t* Rg = (bf16_t*)(p.ws + OFF_REGION);
    bf16_t* Hb = (bf16_t*)(p.ws + OFF_H);
#define PHASE(k, ...) if (ph_lo <= (k) && (k) < ph_hi) { __VA_ARGS__; if ((k) + 1 < ph_hi) xcd_barrier(xbar); }
    unsigned* sbctr = (unsigned*)(p.ws + OFF_BAR + 14336);
    PHASE(0,
        transpose_convert<true>(p.ab_w_in, (bf16_t*)(p.ws + OFF_WT_IN), 1024, AB_IN, AB_IN_PAD, smem);
        rmsnorm_rows(p.x, p.norm_mix, Hb))
    PHASE(1, phase_gemm_in8(p, smem_phys))
    PHASE(2, gla_prep(p, smem))
    PHASE(3, gla_scan(p, smem); sb_fast(p, smem_phys + 98304, sbctr);
        quantize_tables_static(p, 64);
        transpose_convert(p.ab_w_out, (bf16_t*)(p.ws + OFF_WT_OUT), 1024, 1024, 1024, smem, 64);
        transpose_convert(p.c_w_in, (bf16_t*)(p.ws + OFF_WT_CIN), 1024, 4096, 4096, smem, 64, p.norm_mix + 1024);
        transpose_convert(p.c_w_out, (bf16_t*)(p.ws + OFF_WT_COUT), 2048, 1024, 1024, smem, 64);
        fold_query_weights(p, 64))
    PHASE(4, phase_gemm_resid8(Rg + R_QSB, Rg + R_GG, 512, 512, (const bf16_t*)(p.ws + OFF_WT_OUT), 1024, p.x, (bf16_t*)(p.ws + OFF_S), (float*)(p.ws + OFF_SSQ), smem_phys))
    PHASE(5, phase_select8(p, 0, smem_phys))
    PHASE(6, peer_gather(p, 0, p.norm_mix + 1024, false, smem_phys))
    PHASE(7, phase_gemm_cin8_v(p, smem_phys))
    PHASE(8, phase_gemm_cin8_u(p, smem_phys))
    PHASE(9, phase_gemm_resid8(Rg, Rg, 2048, 2048, (const bf16_t*)(p.ws + OFF_WT_COUT), 2048, nullptr, (bf16_t*)(p.ws + OFF_S), (float*)(p.ws + OFF_SSQ), smem_phys))
    PHASE(10, phase_select8(p, 1, smem_phys))
    PHASE(11, peer_gather(p, 1, p.final_norm, true, smem_phys))
}

extern "C" void kernel_launch(void* const* d_in, const int* in_sizes, int n_in, void* d_out, int out_size, void* d_ws, size_t ws_size, hipStream_t stream) {
    static int grid_blocks = 0;
    if (!grid_blocks) {
        int dev = 0, cus = 0, per_cu = 0;
        hipGetDevice(&dev);
        hipDeviceGetAttribute(&cus, hipDeviceAttributeMultiprocessorCount, dev);
        hipFuncSetAttribute((const void*)mega, hipFuncAttributeMaxDynamicSharedMemorySize, kDynLds);
        hipOccupancyMaxActiveBlocksPerMultiprocessor(&per_cu, mega, 512, kDynLds);
        if (per_cu < 1) per_cu = 1;
        if (per_cu > 1) per_cu = 1;
        grid_blocks = cus * per_cu;
        if (n_in != 18 || ws_size < WS_END) fprintf(stderr, "kernel_launch: unexpected n_in %d or ws_size %zu < %zu\n", n_in, ws_size, (size_t)WS_END);
    }
    Params p{};
    p.x = (const float*)d_in[0]; p.norm_mix = (const float*)d_in[1]; p.norm_ffn = (const float*)d_in[2]; p.ab_w_in = (const float*)d_in[3];
    p.ab_w_alpha2 = (const float*)d_in[4]; p.ab_b_alpha2 = (const float*)d_in[5]; p.ab_gla_norm = (const float*)d_in[6]; p.ab_w_out = (const float*)d_in[7];
    p.c_w_in = (const float*)d_in[8]; p.c_v_norm = (const float*)d_in[9]; p.c_w_spatial = (const float*)d_in[10]; p.c_b_spatial = (const float*)d_in[11];
    p.c_w_out = (const float*)d_in[12]; p.peer_w_q = (const float*)d_in[13]; p.peer_subkeys = (const float*)d_in[14]; p.peer_u = (const float*)d_in[15];
    p.peer_v = (const float*)d_in[16]; p.final_norm = (const float*)d_in[17];
    p.out = (float*)d_out; p.ws = (unsigned char*)d_ws;
    (void)hipMemsetAsync((char*)d_ws + OFF_BAR, 0, 16384, stream);
#if ONE_LAUNCH
    int lo = 0, hi = NPHASE;
    void* args[] = {&p, &lo, &hi};
    hipError_t e = hipLaunchCooperativeKernel((void*)mega, dim3(grid_blocks), dim3(512), args, kDynLds, stream);
    if (e != hipSuccess) fprintf(stderr, "cooperative launch failed: %s (grid %d)\n", hipGetErrorString(e), grid_blocks);
#else
    for (int ph = 0; ph < NPHASE; ++ph) hipLaunchKernelGGL(mega, dim3(grid_blocks), dim3(512), kDynLds, stream, p, ph, ph + 1);
#endif
}
```

```cpp
#include <hip/hip_runtime.h>
#include <cstdio>
#include <cstdint>

#ifndef ONE_LAUNCH
#define ONE_LAUNCH 1
#endif


#define VTID ((int)(threadIdx.x & 255))
#define VBID ((int)(blockIdx.x * 2 + (threadIdx.x >> 8)))
#define VGRID ((int)(gridDim.x * 2))
typedef unsigned short bf16_t;
typedef short bf16x8 __attribute__((ext_vector_type(8)));
typedef float f32x4 __attribute__((ext_vector_type(4)));
typedef unsigned u32x4 __attribute__((ext_vector_type(4)));
typedef __bf16 bf16x2_t __attribute__((ext_vector_type(2)));

constexpr int T = 32768, D = 1024, SEQ = 2048, NB = 16;
constexpr int AB_IN = 3088, AB_IN_PAD = 3200;
constexpr float EPS = 1e-6f;
constexpr int NEXP = 16384;
constexpr int kDynLds = 163840;

constexpr size_t SZ_WT_IN = (size_t)AB_IN_PAD * 1024 * 2;
constexpr size_t SZ_WT_OUT = (size_t)1024 * 1024 * 2;
constexpr size_t SZ_WT_CIN = (size_t)4096 * 1024 * 2;
constexpr size_t SZ_WT_COUT = (size_t)1024 * 2048 * 2;
constexpr size_t SZ_WT_Q = (size_t)2 * 2048 * 1024 * 2;
constexpr size_t SZ_SK = (size_t)2 * 8 * 2 * 128 * 128 * 2;
constexpr size_t SZ_TAB = (size_t)2 * NEXP * 1024;
constexpr size_t SZ_TSC = (size_t)2 * NEXP * 4;
constexpr size_t OFF_WT_IN = 0;
constexpr size_t OFF_WT_OUT = OFF_WT_IN + SZ_WT_IN;
constexpr size_t OFF_WT_CIN = OFF_WT_OUT + SZ_WT_OUT;
constexpr size_t OFF_WT_COUT = OFF_WT_CIN + SZ_WT_CIN;
constexpr size_t OFF_WT_Q = OFF_WT_COUT + SZ_WT_COUT;
constexpr size_t OFF_SK = OFF_WT_Q + SZ_WT_Q;
constexpr size_t OFF_UT = OFF_SK;
constexpr size_t OFF_USC = OFF_UT + SZ_TAB;
constexpr size_t OFF_VSC = OFF_USC + SZ_TSC;
constexpr size_t OFF_H = OFF_VSC + SZ_TSC;
constexpr size_t OFF_IDX = OFF_H + (size_t)T * 1024 * 2;
constexpr size_t OFF_GATE = OFF_IDX + (size_t)T * 128 * 4;
constexpr size_t OFF_SSQ = OFF_GATE + (size_t)T * 128 * 4;
constexpr size_t OFF_REGION = OFF_SSQ + (size_t)T * 32 * 4;
constexpr size_t SZ_REGION = (size_t)256 << 20;
constexpr size_t OFF_S = OFF_REGION + SZ_REGION;
constexpr size_t OFF_BAR = OFF_S + (size_t)T * 1024 * 2;
constexpr size_t WS_END = OFF_BAR + 16384;
constexpr size_t R_QSB = 0;
constexpr size_t R_KSB = R_QSB + (size_t)T * 512;
constexpr size_t R_VTSB = R_KSB + (size_t)T * 512;
constexpr size_t R_QG = R_VTSB + (size_t)T * 512;
constexpr size_t R_KG = R_QG + (size_t)T * 256;
constexpr size_t R_VTG = R_KG + (size_t)T * 256;
constexpr size_t R_GG = R_VTG + (size_t)T * 512;
constexpr size_t R_ALR = R_GG + (size_t)T * 512;
constexpr size_t R_KOT = R_ALR + (size_t)T * 32;
constexpr size_t R_DEC = R_KOT + (size_t)T * 256;

struct Params {
    const float* x; const float* norm_mix; const float* norm_ffn; const float* ab_w_in; const float* ab_w_alpha2; const float* ab_b_alpha2;
    const float* ab_gla_norm; const float* ab_w_out; const float* c_w_in; const float* c_v_norm; const float* c_w_spatial; const float* c_b_spatial;
    const float* c_w_out; const float* peer_w_q; const float* peer_subkeys; const float* peer_u; const float* peer_v; const float* final_norm;
    float* out; unsigned char* ws;
};

__device__ __forceinline__ float bf2f(bf16_t v) { return __uint_as_float(((unsigned)v) << 16); }
__device__ __forceinline__ bf16_t f2bf(float f) { unsigned r; asm("v_cvt_pk_bf16_f32 %0, %1, %1" : "=v"(r) : "v"(f)); return (bf16_t)r; }
__device__ __forceinline__ unsigned pack2(float lo, float hi) { unsigned r; asm("v_cvt_pk_bf16_f32 %0, %1, %2" : "=v"(r) : "v"(lo), "v"(hi)); return r; }
__device__ __forceinline__ float lo2f(unsigned w) { return __uint_as_float(w << 16); }
__device__ __forceinline__ float hi2f(unsigned w) { return __uint_as_float(w & 0xffff0000u); }
__device__ __forceinline__ float dot2(unsigned a, unsigned b, float acc) { return __builtin_amdgcn_fdot2_f32_bf16(__builtin_bit_cast(bf16x2_t, a), __builtin_bit_cast(bf16x2_t, b), acc, false); }
#define GELU_C0 -1.0001451969146729f
#define GELU_C1 -1.1498452425003052f
#define GELU_C2 -0.46162763237953186f
#define GELU_C3 -0.051034148782491684f
#define GELU_C4 0.007168652955442667f
#define GELU_C5 -0.0006095620337873697f
#define GELU_C6 2.30170971917687e-05f
__device__ __forceinline__ float gelu_exact(float v) {
    const float a = fminf(fabsf(v), 6.0f);
    float q = GELU_C6 * a + GELU_C5; q = q * a + GELU_C4; q = q * a + GELU_C3; q = q * a + GELU_C2; q = q * a + GELU_C1; q = q * a + GELU_C0;
    return fmaxf(v, 0.f) - fabsf(v) * __builtin_amdgcn_exp2f(q);
}
typedef float f32x2 __attribute__((ext_vector_type(2)));
__device__ __forceinline__ f32x2 gelu_exact2(f32x2 v) {
    const f32x2 av = __builtin_elementwise_abs(v), a = __builtin_elementwise_min(av, (f32x2){6.0f, 6.0f});
    f32x2 q = (f32x2){GELU_C6, GELU_C6} * a + (f32x2){GELU_C5, GELU_C5};
    q = q * a + (f32x2){GELU_C4, GELU_C4}; q = q * a + (f32x2){GELU_C3, GELU_C3}; q = q * a + (f32x2){GELU_C2, GELU_C2};
    q = q * a + (f32x2){GELU_C1, GELU_C1}; q = q * a + (f32x2){GELU_C0, GELU_C0};
    const f32x2 e = {__builtin_amdgcn_exp2f(q[0]), __builtin_amdgcn_exp2f(q[1])};
    return __builtin_elementwise_max(v, (f32x2){0.f, 0.f}) - av * e;
}
__device__ __forceinline__ float row16_sum(float v) {
    v += __builtin_bit_cast(float, __builtin_amdgcn_update_dpp(0, __builtin_bit_cast(int, v), 0x128, 0xf, 0xf, false));
    v += __builtin_bit_cast(float, __builtin_amdgcn_update_dpp(0, __builtin_bit_cast(int, v), 0x124, 0xf, 0xf, false));
    v += __builtin_bit_cast(float, __builtin_amdgcn_update_dpp(0, __builtin_bit_cast(int, v), 0x122, 0xf, 0xf, false));
    v += __builtin_bit_cast(float, __builtin_amdgcn_update_dpp(0, __builtin_bit_cast(int, v), 0x121, 0xf, 0xf, false));
    return v;
}
__device__ __forceinline__ float wave_sum(float v) {
#pragma unroll
    for (int o = 32; o >= 1; o >>= 1) v += __shfl_xor(v, o);
    return v;
}

template <bool PERM_IN = false>
__device__ __forceinline__ void transpose_convert(const float* __restrict__ W, bf16_t* __restrict__ Wt, int K, int N, int Npad, char* smem, int vb0 = 0, const float* __restrict__ kgain = nullptr) {
    float* tile = (float*)smem;
    const int tk = K / 64, tn = Npad / 64, ntile = tk * tn;
    const int tid = VTID;
    if (VBID < vb0) return;
    for (int tl = VBID - vb0; tl < ntile; tl += VGRID - vb0) {
        const int k0 = (tl % tk) * 64, n0 = (tl / tk) * 64;
        const int c = tid & 63, r0 = tid >> 6;
        int nd = n0;
        if (PERM_IN) { if (n0 >= 1024 && n0 < 1536) nd = n0 + 1024; else if (n0 >= 1536 && n0 < 2048) nd = n0 - 512; else if (n0 >= 2048 && n0 < 2560) nd = n0 + 512; else if (n0 >= 2560 && n0 < 3072) nd = n0 - 1024; }
#pragma unroll
        for (int i = 0; i < 16; ++i) {
            const int r = r0 + 4 * i;
            float v = (n0 + c < N) ? W[(size_t)(k0 + r) * N + n0 + c] : 0.f;
            if (kgain) v *= kgain[k0 + r];
            tile[c * 65 + r] = v;
        }
        __syncthreads();
#pragma unroll
        for (int i = 0; i < 16; ++i) {
            const int n = r0 + 4 * i;
            Wt[(size_t)(nd + n) * K + k0 + c] = f2bf(tile[n * 65 + c]);
        }
        __syncthreads();
    }
}
__device__ __forceinline__ void quantize_tables_static(const Params& p, int vb0 = 0) {
    const int lane = VTID & 63, wid = VTID >> 6;
    if (VBID < vb0) return;
    for (unsigned task = (unsigned)(VBID - vb0); task < 512u; task += (unsigned)(VGRID - vb0)) {
        const bool isv = task >= 256u;
        const int r0 = (int)(task & 255u) * 128 + wid * 32;
        const float* src = isv ? p.peer_v : p.peer_u;
        unsigned char* recs = p.ws + OFF_UT;
        _Float16* sct = (_Float16*)(p.ws + OFF_USC);
        f32x4 vnx[4];
        {
            const float* x0 = src + (size_t)r0 * 1024 + lane * 16;
#pragma unroll
            for (int i = 0; i < 4; ++i) vnx[i] = *(const f32x4*)(x0 + i * 4);
        }
        for (int rr = 0; rr < 32; ++rr) {
            const int r = r0 + rr;
            f32x4 v[4]; float aml = 0.f;
#pragma unroll
            for (int i = 0; i < 4; ++i) {
                v[i] = vnx[i];
                aml = fmaxf(aml, fmaxf(fmaxf(fabsf(v[i][0]), fabsf(v[i][1])), fmaxf(fabsf(v[i][2]), fabsf(v[i][3]))));
            }
            if (rr + 1 < 32) {
                const float* xn = src + (size_t)(r + 1) * 1024 + lane * 16;
#pragma unroll
                for (int i = 0; i < 4; ++i) vnx[i] = *(const f32x4*)(xn + i * 4);
            }
#pragma unroll
            for (int o = 32; o >= 1; o >>= 1) aml = fmaxf(aml, __shfl_xor(aml, o));
            float ssq = 0.f;
#pragma unroll
            for (int i = 0; i < 4; ++i) ssq += (v[i][0] * v[i][0] + v[i][1] * v[i][1]) + (v[i][2] * v[i][2] + v[i][3] * v[i][3]);
            ssq = wave_sum(ssq);
            const float gmax = aml * (1.002f / 7.5f);
            const _Float16 hs = (_Float16)fminf(fmaxf(0.34f * sqrtf(ssq * (1.0f / 1024.0f)), 0.5f * gmax), gmax);
            const float gs_ = (float)hs, gi_ = gs_ > 0.f ? 1.0f / gs_ : 0.f;
            unsigned wd[2]; const int sgn = isv ? 0 : 8;
#pragma unroll
            for (int dd = 0; dd < 2; ++dd) {
                unsigned wv = 0;
#pragma unroll
                for (int b = 0; b < 4; ++b) {
                    const int qa = min(15, max(0, __float2int_rn(v[2 * dd][b] * gi_ + 7.5f)));
                    const int qb = min(15, max(0, __float2int_rn(v[2 * dd + 1][b] * gi_ + 7.5f)));
                    wv |= ((unsigned)(qa ^ sgn) | ((unsigned)(qb ^ sgn) << 4)) << (8 * b);
                }
                wd[dd] = wv;
            }
            unsigned char* rec = recs + (size_t)r * 1024;
            *(uint2*)(rec + (isv ? 512 : 0) + lane * 8) = make_uint2(wd[0], wd[1]);
            if (lane == 0) sct[(size_t)r * 2 + (isv ? 1 : 0)] = (_Float16)gs_;
        }
    }
}
__device__ __forceinline__ void rmsnorm_rows(const float* __restrict__ X, const float* __restrict__ g, bf16_t* __restrict__ Hout) {
    const int lane = VTID & 63, wid = VTID >> 6;
    const int gw = VBID * 4 + wid, nw = VGRID * 4;
    for (int t = gw; t < T; t += nw) {
        const float* xr = X + (size_t)t * D;
        float4 v[4]; float ss = 0.f;
#pragma unroll
        for (int i = 0; i < 4; ++i) { v[i] = *(const float4*)(xr + i * 256 + lane * 4); ss += v[i].x * v[i].x + v[i].y * v[i].y + v[i].z * v[i].z + v[i].w * v[i].w; }
        ss = wave_sum(ss);
        const float rstd = rsqrtf(ss * (1.0f / D) + EPS);
#pragma unroll
        for (int i = 0; i < 4; ++i) {
            const float4 gg = *(const float4*)(g + i * 256 + lane * 4);
            uint2 o; o.x = pack2(v[i].x * rstd * gg.x, v[i].y * rstd * gg.y); o.y = pack2(v[i].z * rstd * gg.z, v[i].w * rstd * gg.w);
            *(uint2*)(Hout + (size_t)t * D + i * 256 + lane * 4) = o;
        }
    }
}

__device__ __forceinline__ void store_bf16x4(bf16_t* p, f32x4 v) { uint2 o; o.x = pack2(v[0], v[1]); o.y = pack2(v[2], v[3]); *(uint2*)p = o; }

#define G8_LAS __attribute__((address_space(3)))
namespace g8 {
constexpr int BM = 256, BK = 64, HALF = 128, HTB = HALF * BK * 2, NXCD = 8, WGM = 8;
__device__ __forceinline__ int lds_byte(int r, int c) { const int st = (r >> 4) * 2 + (c >> 5), rr = r & 15, cc = c & 31, ob = rr * 64 + cc * 2; return st * 1024 + (ob ^ (((ob >> 9) & 1) << 5)); }
__device__ __forceinline__ void stage_rc(int b, int& R, int& C) { const int st = b / 1024, sb = b % 1024, swz = sb ^ (((sb >> 9) & 1) << 5); R = (st >> 1) * 16 + swz / 64; C = (st & 1) * 32 + (swz % 64) / 2; }
__device__ __forceinline__ int perm32(int rho) { const int n = rho >> 4, i = rho & 15; return 8 * (i >> 2) + 4 * n + (i & 3); }
struct Unit { int pm, pn; };
struct Gemm { const bf16_t* A0; const bf16_t* A1; int lda, ksplit; const bf16_t* Bt; int M, N, K; };
struct StaticOrder {
    int nM, nN, nwg, G, c;
    __device__ __forceinline__ void init(int M, int N, int G_, int c_) { nM = M / BM; nN = N / BM; nwg = nM * nN; G = G_; c = c_; }
    __device__ __forceinline__ bool next(int i, Unit& u) const {
        const int L = i * G + c; if (L >= nwg) return false;
        int wgid = L; { const int q = nwg / NXCD, r = nwg % NXCD, xcd = wgid % NXCD, off = wgid / NXCD; wgid = (xcd < r ? xcd * (q + 1) : r * (q + 1) + (xcd - r) * q) + off; }
        const int nig = WGM * nN, gid = wgid / nig, fm = gid * WGM, gsz = (nM - fm) < WGM ? (nM - fm) : WGM;
        u.pm = fm + ((wgid % nig) % gsz); u.pn = (wgid % nig) / gsz; return true;
    }
};
typedef int i32x4v __attribute__((ext_vector_type(4)));
typedef int i32x8v __attribute__((ext_vector_type(8)));
template <class Epi, bool F8 = false>
__device__ __forceinline__ void gemm_phase(G8_LAS unsigned char* lds, const Gemm g, const StaticOrder& S, const Epi& E) {
    const int tid = threadIdx.x, wid = __builtin_amdgcn_readfirstlane(tid >> 6), lane = tid & 63, wr = wid >> 2, wc = wid & 3, fr = lane & 15, fq = lane >> 4;
    const int K = g.K, nt = K / BK, lda = g.lda;
    unsigned voffA[2], voffB[2];
#pragma unroll
    for (int i = 0; i < 2; ++i) { int R, C; stage_rc(tid * 16 + i * 8192, R, C); const int Rb = (R & ~31) + perm32(R & 31);
        voffA[i] = (unsigned)(R * lda + C) * 2u; voffB[i] = (unsigned)(Rb * K + C) * 2u; }
    const size_t hstepA = (size_t)HALF * lda * 2, hstepB = (size_t)HALF * K * 2;
    const unsigned ldsw = (unsigned)wid * 1024u;
    const unsigned ldsbase = (unsigned)__builtin_amdgcn_readfirstlane((int)(unsigned)(__SIZE_TYPE__)lds);
    const int fcol = F8 ? 32 * (fq >> 1) + 24 * (fq & 1) : fq * 8;
    const int aoff = lds_byte(wr * 64 + fr, fcol), boff = lds_byte(wc * 32 + fr, fcol);
    const int aoff2 = F8 ? (aoff ^ 16) : aoff + 1024, boff2 = F8 ? (boff ^ 16) : boff + 1024;
    auto aptr = [&](int pm, int kt) -> const char* { const int kb = kt * BK; const bf16_t* b = kb < g.ksplit ? g.A0 + kb : g.A1 + (kb - g.ksplit); return (const char*)b + (size_t)pm * 2 * hstepA; };
    auto bptr = [&](int pn, int kt) -> const char* { return (const char*)(g.Bt + kt * BK) + (size_t)pn * 2 * hstepB; };
#define G8_SA(b, h) (((b) * 2 + (h)) * HTB)
#define G8_SB(b, h) ((4 + (b) * 2 + (h)) * HTB)
#define G8_STAGE(bufoff, gbase, voff) do { _Pragma("unroll") for (int _i = 0; _i < 2; ++_i) { \
        if constexpr (F8) { unsigned _keep; const unsigned _d = ldsbase + (unsigned)(bufoff) + ldsw + _i * 8192u; \
            const char* _gb = (const char*)(gbase) + (size_t)_i * ((voff) == voffA ? hstepA : hstepB) / 2;        \
            asm volatile("s_mov_b32 %0, m0\n\ts_mov_b32 m0, %3\n\ts_nop 0\n\tglobal_load_lds_dwordx4 %1, %2\n\ts_mov_b32 m0, %0" : "=&s"(_keep) : "v"((voff)[0]), "s"(_gb), "s"(_d) : "memory"); } \
        else __builtin_amdgcn_global_load_lds((const unsigned*)((const char*)(gbase) + (voff)[_i]), (G8_LAS unsigned*)(lds + (bufoff) + ldsw + _i * 8192), 16, 0, 0); } } while (0)
#define G8_LD1(d16, d32, addr0, addr1) do { if constexpr (F8) { const i32x4v _lo = *(const G8_LAS i32x4v*)(addr0), _hi = *(const G8_LAS i32x4v*)(addr1); \
            d32 = __builtin_shufflevector(_lo, _hi, 0, 1, 2, 3, 4, 5, 6, 7); } \
        else { d16[0] = *(const G8_LAS bf16x8*)(addr0); d16[1] = *(const G8_LAS bf16x8*)(addr1); } } while (0)
#define G8_LDA(dst, b, h) do { _Pragma("unroll") for (int m = 0; m < 4; ++m) G8_LD1(dst[m], dst##8[m], lds + G8_SA(b, h) + aoff + m * 2048, lds + G8_SA(b, h) + aoff2 + m * 2048); } while (0)
#define G8_LDB(dst, b, h) do { _Pragma("unroll") for (int n = 0; n < 2; ++n) G8_LD1(dst[n], dst##8[n], lds + G8_SB(b, h) + boff + n * 2048, lds + G8_SB(b, h) + boff2 + n * 2048); } while (0)
#define G8_MMA(ai, bj, At, Bt) do { __builtin_amdgcn_s_setprio(1); _Pragma("unroll") for (int m = 0; m < 4; ++m) _Pragma("unroll") for (int n = 0; n < 2; ++n) { \
        if constexpr (F8) acc[ai][bj][m][n] = __builtin_amdgcn_mfma_scale_f32_16x16x128_f8f6f4(Bt##8[n], At##8[m], acc[ai][bj][m][n], 0, 0, 0, sc1, 0, sc1); \
        else { _Pragma("unroll") for (int k = 0; k < 2; ++k) acc[ai][bj][m][n] = __builtin_amdgcn_mfma_f32_16x16x32_bf16(Bt[n][k], At[m][k], acc[ai][bj][m][n], 0, 0, 0); } } \
        __builtin_amdgcn_s_setprio(0); } while (0)
#define G8_WAIT_V(n) asm volatile("s_waitcnt vmcnt(" #n ")" ::: "memory")
#define G8_WAIT_L(n) asm volatile("s_waitcnt lgkmcnt(" #n ")" ::: "memory")
#define G8_BAR __builtin_amdgcn_s_barrier()
#define G8_SCHED __builtin_amdgcn_sched_barrier(0)
    Unit cur, nxt; int ui = 0;
    if (!S.next(0, cur)) return;
    int sc1 = 0x7f7f7f7f; asm volatile("" : "+v"(sc1));
    f32x4 acc[2][2][4][2];
#pragma unroll
    for (int a = 0; a < 2; ++a)
#pragma unroll
        for (int b = 0; b < 2; ++b)
#pragma unroll
            for (int m = 0; m < 4; ++m)
#pragma unroll
                for (int n = 0; n < 2; ++n) acc[a][b][m][n] = (f32x4){0.f, 0.f, 0.f, 0.f};
    bf16x8 At[4][2], B0[2][2], B1[2][2];
    i32x8v At8[4], B08[2], B18[2];
    {
        const char* cA = aptr(cur.pm, 0); const char* cB = bptr(cur.pn, 0); const char* cA1 = aptr(cur.pm, 1); const char* cB1 = bptr(cur.pn, 1);
        G8_STAGE(G8_SB(0, 0), cB, voffB); G8_STAGE(G8_SB(0, 1), cB + hstepB, voffB); G8_STAGE(G8_SA(0, 0), cA, voffA); G8_STAGE(G8_SA(0, 1), cA + hstepA, voffA);
        if (wr == 1) G8_BAR;
        G8_WAIT_V(2); G8_BAR;
        G8_STAGE(G8_SB(1, 0), cB1, voffB); G8_STAGE(G8_SA(1, 0), cA1, voffA); G8_STAGE(G8_SB(1, 1), cB1 + hstepB, voffB);
        G8_WAIT_V(6); G8_BAR;
    }
    for (;;) {
        const bool has_next = S.next(ui + 1, nxt);
        const int npm = has_next ? nxt.pm : cur.pm, npn = has_next ? nxt.pn : cur.pn;
#pragma unroll 1
        for (int t = 0; t < nt; t += 2) {
            const bool last = (t == nt - 2);
            const char* a1 = aptr(cur.pm, t + 1);
            const char* a2 = last ? aptr(npm, 0) : aptr(cur.pm, t + 2); const char* b2 = last ? bptr(npn, 0) : bptr(cur.pn, t + 2);
            const char* a3 = last ? aptr(npm, 1) : aptr(cur.pm, t + 3); const char* b3 = last ? bptr(npn, 1) : bptr(cur.pn, t + 3);
            G8_LDB(B0, 0, 0); G8_LDB(B1, 0, 1); G8_SCHED; G8_LDA(At, 0, 0); G8_STAGE(G8_SA(1, 1), a1 + hstepA, voffA);
            G8_WAIT_V(8); G8_WAIT_L(0); G8_BAR; G8_MMA(0, 0, At, B0); G8_MMA(0, 1, At, B1); G8_BAR; G8_SCHED;
            G8_LDA(At, 0, 1); G8_STAGE(G8_SB(0, 0), b2, voffB); G8_STAGE(G8_SB(0, 1), b2 + hstepB, voffB); G8_STAGE(G8_SA(0, 0), a2, voffA);
            G8_WAIT_V(8); G8_WAIT_L(0); G8_BAR; G8_MMA(1, 0, At, B0); G8_MMA(1, 1, At, B1); G8_BAR; G8_SCHED;
            G8_LDB(B0, 1, 0); G8_LDB(B1, 1, 1); G8_SCHED; G8_LDA(At, 1, 0); G8_STAGE(G8_SA(0, 1), a2 + hstepA, voffA);
            G8_WAIT_V(8); G8_WAIT_L(0); G8_BAR; G8_MMA(0, 0, At, B0); G8_MMA(0, 1, At, B1); G8_BAR; G8_SCHED;
            G8_LDA(At, 1, 1); G8_STAGE(G8_SB(1, 0), b3, voffB); G8_STAGE(G8_SB(1, 1), b3 + hstepB, voffB); G8_STAGE(G8_SA(1, 0), a3, voffA);
            G8_WAIT_V(8); G8_WAIT_L(0); G8_BAR; G8_MMA(1, 0, At, B0); G8_MMA(1, 1, At, B1); G8_BAR; G8_SCHED;
        }
        if (wr == 0) G8_BAR;
        E(acc, cur, wr, wc, fr, fq);
        if (!has_next) break;
#pragma unroll
        for (int a = 0; a < 2; ++a)
#pragma unroll
            for (int b = 0; b < 2; ++b)
#pragma unroll
                for (int m = 0; m < 4; ++m)
#pragma unroll
                    for (int n = 0; n < 2; ++n) acc[a][b][m][n] = (f32x4){0.f, 0.f, 0.f, 0.f};
        cur = nxt; ++ui;
        if (wr == 1) G8_BAR;
    }
    G8_WAIT_V(0);
    G8_BAR;
#undef G8_SA
#undef G8_SB
#undef G8_STAGE
#undef G8_LDA
#undef G8_LDB
#undef G8_MMA
#undef G8_LD1
#undef G8_WAIT_V
#undef G8_WAIT_L
#undef G8_BAR
#undef G8_SCHED
}
struct EpiResid {
    const float* R32; bf16_t* S; float* SSQP; unsigned char* S8;
    __device__ __forceinline__ void operator()(const f32x4 (&acc)[2][2][4][2], const Unit& u, int wr, int wc, int fr, int fq) const {
#pragma unroll
        for (int ai = 0; ai < 2; ++ai)
#pragma unroll
            for (int m = 0; m < 4; ++m) {
                const int row = u.pm * 256 + ai * 128 + wr * 64 + m * 16 + fr;
                const size_t o = (size_t)row * 1024 + u.pn * 256 + wc * 32 + fq * 8;
                float ss = 0.f;
#pragma unroll
                for (int bj = 0; bj < 2; ++bj) {
                    f32x4 a, b;
                    if (R32) { a = *(const f32x4*)(R32 + o + bj * 128); b = *(const f32x4*)(R32 + o + bj * 128 + 4); }
                    else { const u32x4 r = *(const u32x4*)(S + o + bj * 128); a = (f32x4){lo2f(r[0]), hi2f(r[0]), lo2f(r[1]), hi2f(r[1])}; b = (f32x4){lo2f(r[2]), hi2f(r[2]), lo2f(r[3]), hi2f(r[3])}; }
                    a += acc[ai][bj][m][0]; b += acc[ai][bj][m][1];
                    ss += a[0] * a[0] + a[1] * a[1] + a[2] * a[2] + a[3] * a[3] + b[0] * b[0] + b[1] * b[1] + b[2] * b[2] + b[3] * b[3];
                    uint4 w; w.x = pack2(a[0], a[1]); w.y = pack2(a[2], a[3]); w.z = pack2(b[0], b[1]); w.w = pack2(b[2], b[3]);
                    *(uint4*)(S + o + bj * 128) = w;
                    { int p0 = __builtin_amdgcn_cvt_pk_fp8_f32(a[0], a[1], 0, false); p0 = __builtin_amdgcn_cvt_pk_fp8_f32(a[2], a[3], p0, true);
                      int p1 = __builtin_amdgcn_cvt_pk_fp8_f32(b[0], b[1], 0, false); p1 = __builtin_amdgcn_cvt_pk_fp8_f32(b[2], b[3], p1, true);
                      *(uint2*)(S8 + o + bj * 128) = make_uint2((unsigned)p0, (unsigned)p1); }
                }
                ss += __shfl_xor(ss, 16); ss += __shfl_xor(ss, 32);
                if (fq == 0) SSQP[(size_t)row * 32 + u.pn * 4 + wc] = ss;
            }
    }
};
struct EpiCinUS {
    bf16_t* U; const bf16_t* VT; const float* SSQ; const float* Wsp; const float* bsp; const float* vnorm; G8_LAS unsigned char* L; const float* RSTD;
    __device__ __forceinline__ void operator()(const f32x4 (&acc)[2][2][4][2], const Unit& u, int wr, int wc, int fr, int fq) const {
        const int tid = threadIdx.x, g = u.pn;
        G8_LAS float* RS = (G8_LAS float*)(L + 24576);
        unsigned gu[2][2][4][4];
#pragma unroll
        for (int ai = 0; ai < 2; ++ai)
#pragma unroll
            for (int bj = 0; bj < 2; ++bj)
#pragma unroll
                for (int m = 0; m < 4; ++m) {
                    const float rs = RSTD[u.pm * 256 + ai * 128 + wr * 64 + m * 16 + fr];
                    const f32x4 a = acc[ai][bj][m][0] * rs, b = acc[ai][bj][m][1] * rs;
                    const f32x2 g0 = gelu_exact2((f32x2){a[0], a[1]}), g1 = gelu_exact2((f32x2){a[2], a[3]}), g2 = gelu_exact2((f32x2){b[0], b[1]}), g3 = gelu_exact2((f32x2){b[2], b[3]});
                    gu[ai][bj][m][0] = pack2(g0[0], g0[1]); gu[ai][bj][m][1] = pack2(g1[0], g1[1]); gu[ai][bj][m][2] = pack2(g2[0], g2[1]); gu[ai][bj][m][3] = pack2(g3[0], g3[1]);
                }
        if (tid < 256) {
            const float* sp = SSQ + (size_t)(u.pm * 256 + tid) * 32;
            f32x4 s4 = *(const f32x4*)sp;
#pragma unroll
            for (int i = 1; i < 8; ++i) s4 += *(const f32x4*)(sp + 4 * i);
            RS[tid] = rsqrtf(((s4[0] + s4[1]) + (s4[2] + s4[3])) * (1.0f / 2048.0f) + EPS);
        }
        __syncthreads();
#pragma unroll
        for (int ai = 0; ai < 2; ++ai) {
            const int chunk = u.pm * 2 + ai;
            {
                const int t1 = tid >> 3, c1 = tid & 7;
#pragma unroll
                for (int part = 0; part < 3; ++part) {
                    const int t = part == 0 ? t1 : 64 + ((tid + (part - 1) * 512) >> 4), ch = part == 0 ? c1 : ((tid + (part - 1) * 512) & 15), s0 = ch * 8;
                    const float* wp = Wsp + (size_t)(g * 128 + t) * 128 + s0;
                    const f32x4 w0 = *(const f32x4*)wp, w1 = *(const f32x4*)(wp + 4);
                    const f32x4 r0 = *(const G8_LAS f32x4*)(RS + ai * 128 + s0), r1 = *(const G8_LAS f32x4*)(RS + ai * 128 + s0 + 4);
                    float v[8];
#pragma unroll
                    for (int j = 0; j < 4; ++j) { v[j] = (s0 + j <= t) ? w0[j] * r0[j] : 0.f; v[4 + j] = (s0 + 4 + j <= t) ? w1[j] * r1[j] : 0.f; }
                    u32x4 o; o.x = pack2(v[0], v[1]); o.y = pack2(v[2], v[3]); o.z = pack2(v[4], v[5]); o.w = pack2(v[6], v[7]);
                    const int off = part == 0 ? t * 128 + ((ch ^ (t & 7)) << 4) : 8192 + (t - 64) * 256 + ((ch ^ (t & 7)) << 4);
                    *(G8_LAS u32x4*)(L + off) = o;
                }
            }
            __syncthreads();
            float bias[4];
#pragma unroll
            for (int m = 0; m < 4; ++m) bias[m] = bsp[g * 128 + wr * 64 + m * 16 + fr];
#pragma unroll
            for (int bj = 0; bj < 2; ++bj) {
                f32x4 mac[4][2];
#pragma unroll
                for (int m = 0; m < 4; ++m)
#pragma unroll
                    for (int n = 0; n < 2; ++n) mac[m][n] = (f32x4){0.f, 0.f, 0.f, 0.f};
                const int cb = u.pn * 256 + bj * 128 + wc * 32;
                const bf16_t* vrow0 = VT + ((size_t)chunk * 2048 + cb + perm32(fr)) * 128 + fq * 8;
                const bf16_t* vrow1 = VT + ((size_t)chunk * 2048 + cb + perm32(16 + fr)) * 128 + fq * 8;
                bf16x8 bf0[4], bf1[4];
#pragma unroll
                for (int kk = 0; kk < 4; ++kk) { if (kk < 2 || wr == 1) { bf0[kk] = *(const bf16x8*)(vrow0 + kk * 32); bf1[kk] = *(const bf16x8*)(vrow1 + kk * 32); } }
#pragma unroll
                for (int kk = 0; kk < 4; ++kk) {
                    if (kk < 2 || wr == 1) {
                        bf16x8 af[4];
#pragma unroll
                        for (int m = 0; m < 4; ++m) {
                            const int t = wr * 64 + m * 16 + fr, chn = kk * 4 + fq;
                            const int off = wr == 0 ? t * 128 + ((chn ^ (t & 7)) << 4) : 8192 + (t - 64) * 256 + ((chn ^ (t & 7)) << 4);
                            af[m] = *(const G8_LAS bf16x8*)(L + off);
                        }
#pragma unroll
                        for (int m = 0; m < 4; ++m) {
                            mac[m][0] = __builtin_amdgcn_mfma_f32_16x16x32_bf16(bf0[kk], af[m], mac[m][0], 0, 0, 0);
                            mac[m][1] = __builtin_amdgcn_mfma_f32_16x16x32_bf16(bf1[kk], af[m], mac[m][1], 0, 0, 0);
                        }
                    }
                }
                const f32x4 vn0 = *(const f32x4*)(vnorm + cb + fq * 8), vn1 = *(const f32x4*)(vnorm + cb + fq * 8 + 4);
#pragma unroll
                for (int m = 0; m < 4; ++m) {
                    const f32x4 x0 = vn0 * mac[m][0] + bias[m], x1 = vn1 * mac[m][1] + bias[m];
                    const unsigned q0 = gu[ai][bj][m][0], q1 = gu[ai][bj][m][1], q2 = gu[ai][bj][m][2], q3 = gu[ai][bj][m][3];
                    uint4 o; o.x = pack2(lo2f(q0) * x0[0], hi2f(q0) * x0[1]); o.y = pack2(lo2f(q1) * x0[2], hi2f(q1) * x0[3]); o.z = pack2(lo2f(q2) * x1[0], hi2f(q2) * x1[1]); o.w = pack2(lo2f(q3) * x1[2], hi2f(q3) * x1[3]);
                    *(uint4*)(U + (size_t)(u.pm * 256 + ai * 128 + wr * 64 + m * 16 + fr) * 2048 + cb + fq * 8) = o;
                }
            }
            __syncthreads();
        }
    }
};
struct EpiCinV {
    bf16_t* VT; float* SSQ; const float* RSTD;
    __device__ __forceinline__ void operator()(const f32x4 (&acc)[2][2][4][2], const Unit& u, int wr, int wc, int fr, int fq) const {
        f32x4 rs[2][2];
#pragma unroll
        for (int bj = 0; bj < 2; ++bj)
#pragma unroll
            for (int n = 0; n < 2; ++n) rs[bj][n] = *(const f32x4*)(RSTD + u.pn * 256 + bj * 128 + wc * 32 + fq * 8 + n * 4);
#pragma unroll
        for (int ai = 0; ai < 2; ++ai) {
            float ss[16];
#pragma unroll
            for (int i = 0; i < 16; ++i) ss[i] = 0.f;
#pragma unroll
            for (int m = 0; m < 4; ++m) {
                const int c = u.pm * 256 + ai * 128 + wr * 64 + m * 16 + fr;
#pragma unroll
                for (int bj = 0; bj < 2; ++bj) {
                    float g[8];
#pragma unroll
                    for (int n = 0; n < 2; ++n)
#pragma unroll
                        for (int r = 0; r < 4; r += 2) {
                            const f32x2 x = gelu_exact2((f32x2){acc[ai][bj][m][n][r] * rs[bj][n][r], acc[ai][bj][m][n][r + 1] * rs[bj][n][r + 1]});
                            g[n * 4 + r] = x[0]; g[n * 4 + r + 1] = x[1]; ss[bj * 8 + n * 4 + r] += x[0] * x[0]; ss[bj * 8 + n * 4 + r + 1] += x[1] * x[1];
                        }
                    uint4 o; o.x = pack2(g[0], g[1]); o.y = pack2(g[2], g[3]); o.z = pack2(g[4], g[5]); o.w = pack2(g[6], g[7]);
                    *(uint4*)(VT + ((size_t)(u.pn * 2 + bj) * 2048 + c) * 128 + wc * 32 + fq * 8) = o;
                }
            }
            float mine = 0.f;
#pragma unroll
            for (int i = 0; i < 16; ++i) { const float s = row16_sum(ss[i]); mine = (fr == i) ? s : mine; }
            const int tok = u.pn * 256 + (fr >> 3) * 128 + wc * 32 + fq * 8 + (fr & 7);
            SSQ[(size_t)tok * 32 + u.pm * 4 + ai * 2 + wr] = mine;
        }
    }
};
struct EpiInN {
    bf16_t* R;
    __device__ __forceinline__ void operator()(const f32x4 (&acc)[2][2][4][2], const Unit& u, int wr, int wc, int fr, int fq) const {
        bf16_t* base; int pitch; float sc = 1.0f;
        if (u.pn < 2) { base = R + R_QSB + u.pn * 256; pitch = 512; sc = 0.125f; }
        else if (u.pn < 4) { base = R + R_KSB + (u.pn - 2) * 256; pitch = 512; }
        else if (u.pn == 4) { base = R + R_QG; pitch = 256; }
        else if (u.pn == 5) { base = R + R_KG; pitch = 256; }
        else { base = R + R_GG + (u.pn - 6) * 256; pitch = 512; }
#pragma unroll
        for (int ai = 0; ai < 2; ++ai)
#pragma unroll
            for (int m = 0; m < 4; ++m) {
                bf16_t* rp = base + (size_t)(u.pm * 256 + ai * 128 + wr * 64 + m * 16 + fr) * pitch + wc * 32 + fq * 8;
#pragma unroll
                for (int bj = 0; bj < 2; ++bj) {
                    f32x4 a = acc[ai][bj][m][0] * sc, b = acc[ai][bj][m][1] * sc;
                    if (u.pn >= 6) {
#pragma unroll
                        for (int r = 0; r < 4; ++r) { a[r] = a[r] * __builtin_amdgcn_rcpf(1.0f + __expf(-a[r])); b[r] = b[r] * __builtin_amdgcn_rcpf(1.0f + __expf(-b[r])); }
                    }
                    uint4 o; o.x = pack2(a[0], a[1]); o.y = pack2(a[2], a[3]); o.z = pack2(b[0], b[1]); o.w = pack2(b[2], b[3]);
                    *(uint4*)(rp + bj * 128) = o;
                }
            }
    }
};
struct EpiInT {
    bf16_t* R;
    __device__ __forceinline__ void operator()(const f32x4 (&acc)[2][2][4][2], const Unit& u, int wr, int wc, int fr, int fq) const {
#pragma unroll
        for (int ai = 0; ai < 2; ++ai)
#pragma unroll
            for (int m = 0; m < 4; ++m) {
                const int c = u.pm * 256 + ai * 128 + wr * 64 + m * 16 + fr;
#pragma unroll
                for (int bj = 0; bj < 2; ++bj) {
                    const int t = u.pn * 256 + bj * 128 + wc * 32 + fq * 8, b = t >> 11, s = t & 2047;
                    bf16_t* dst;
                    if (c < 512) dst = R + R_VTSB + ((size_t)((b * 8 + (c >> 6)) * 64 + (c & 63))) * 2048 + s;
                    else { const int c2 = c - 512; dst = R + R_VTG + ((size_t)((b * 4 + (c2 >> 7)) * 128 + (c2 & 127))) * 2048 + s; }
                    const f32x4 a = acc[ai][bj][m][0], bb = acc[ai][bj][m][1];
                    uint4 o; o.x = pack2(a[0], a[1]); o.y = pack2(a[2], a[3]); o.z = pack2(bb[0], bb[1]); o.w = pack2(bb[2], bb[3]);
                    *(uint4*)dst = o;
                }
            }
    }
};
}
__device__ __forceinline__ void phase_gemm_resid8(const bf16_t* A0, const bf16_t* A1, int lda, int ksplit, const bf16_t* Bt, int K, const float* R32, bf16_t* Sres, float* SSQP, unsigned char* S8, char* smem_phys) {
    g8::Gemm g{A0, A1, lda, ksplit, Bt, T, 1024, K};
    g8::StaticOrder S; S.init(T, 1024, (int)gridDim.x, (int)blockIdx.x);
    g8::EpiResid E{R32, Sres, SSQP, S8};
    g8::gemm_phase<g8::EpiResid>((G8_LAS unsigned char*)smem_phys, g, S, E);
}

__device__ __forceinline__ void phase_gemm_cin8_v(const Params& p, char* smem_phys) {
    const bf16_t* H = (const bf16_t*)(p.ws + OFF_S); const bf16_t* W = (const bf16_t*)(p.ws + OFF_WT_CIN);
    bf16_t* U = (bf16_t*)(p.ws + OFF_REGION); bf16_t* VT = U + (size_t)T * 2048; float* SSQ = (float*)(p.ws + OFF_SSQ);
    const bf16_t* Wv = W + (size_t)2048 * 1024;
    g8::Gemm g{Wv, Wv, 1024, 1024, H, 2048, T, 1024};
    g8::StaticOrder S; S.init(2048, T, (int)gridDim.x, (int)blockIdx.x);
    g8::EpiCinV E{VT, SSQ, (const float*)(p.ws + OFF_VSC)};
    g8::gemm_phase<g8::EpiCinV>((G8_LAS unsigned char*)smem_phys, g, S, E);
}
__device__ __forceinline__ void phase_gemm_cin8_u(const Params& p, char* smem_phys) {
    const bf16_t* H = (const bf16_t*)(p.ws + OFF_S); const bf16_t* W = (const bf16_t*)(p.ws + OFF_WT_CIN);
    bf16_t* U = (bf16_t*)(p.ws + OFF_REGION); bf16_t* VT = U + (size_t)T * 2048; float* SSQ = (float*)(p.ws + OFF_SSQ);
    g8::Gemm g{H, H, 1024, 1024, W, T, 2048, 1024};
    g8::StaticOrder S; S.init(T, 2048, (int)gridDim.x, (int)blockIdx.x);
    g8::EpiCinUS E{U, VT, SSQ, p.c_w_spatial, p.c_b_spatial, p.c_v_norm, (G8_LAS unsigned char*)(smem_phys + 131072), (const float*)(p.ws + OFF_VSC)};
    g8::gemm_phase<g8::EpiCinUS>((G8_LAS unsigned char*)smem_phys, g, S, E);
}
__device__ __forceinline__ void phase_gemm_in8(const Params& p, char* smem_phys) {
    const bf16_t* H = (const bf16_t*)(p.ws + OFF_H); const bf16_t* W = (const bf16_t*)(p.ws + OFF_WT_IN);
    bf16_t* R = (bf16_t*)(p.ws + OFF_REGION);
    {
        g8::Gemm g{H, H, 1024, 1024, W, T, 2048, 1024};
        g8::StaticOrder S; S.init(T, 2048, (int)gridDim.x, (int)blockIdx.x);
        g8::EpiInN E{R};
        g8::gemm_phase<g8::EpiInN>((G8_LAS unsigned char*)smem_phys, g, S, E);
    }
    {
        const bf16_t* Wv = W + (size_t)2048 * 1024;
        g8::Gemm g{Wv, Wv, 1024, 1024, H, 1024, T, 1024};
        g8::StaticOrder S; S.init(1024, T, (int)gridDim.x, (int)blockIdx.x);
        g8::EpiInT E{R};
        g8::gemm_phase<g8::EpiInT>((G8_LAS unsigned char*)smem_phys, g, S, E);
    }
    {
        const int lane = threadIdx.x & 63, wid = threadIdx.x >> 6, fr = lane & 15, fq = lane >> 4;
        float* ALR = (float*)(R + R_ALR);
        for (int task = (int)blockIdx.x * 8 + wid; task < T / 16; task += (int)gridDim.x * 8) {
            const bf16_t* a = H + (size_t)(task * 16 + fr) * 1024 + fq * 8; const bf16_t* w = W + (size_t)(3072 + fr) * 1024 + fq * 8;
            f32x4 acc = (f32x4){0.f, 0.f, 0.f, 0.f};
#pragma unroll 8
            for (int kk = 0; kk < 32; ++kk) {
                const bf16x8 af = *(const bf16x8*)(a + kk * 32), wf = *(const bf16x8*)(w + kk * 32);
                acc = __builtin_amdgcn_mfma_f32_16x16x32_bf16(wf, af, acc, 0, 0, 0);
            }
            *(f32x4*)(ALR + (size_t)(task * 16 + fr) * 16 + fq * 4) = acc;
        }
    }
}


typedef float f32x16 __attribute__((ext_vector_type(16)));
__device__ __forceinline__ void sb_fast(const Params& p, char* smem, unsigned* ctr) {
    bf16_t* R = (bf16_t*)(p.ws + OFF_REGION);
    char* KT = smem; char* VTt = smem + 8192;
    volatile int* flags = (volatile int*)(smem + 32768); volatile unsigned* slot = (volatile unsigned*)(smem + 32832);
    const int tid = threadIdx.x, lane = tid & 63, w = tid >> 6, r31 = lane & 31, h = lane >> 5;
    for (;;) {
        __syncthreads();
        if (tid == 0) *slot = atomicAdd(ctr, 1u);
        __syncthreads();
        const unsigned task = *slot;
        if (task >= 1024u) break;
        const int qblk = 7 - (int)(task >> 7), bh = task & 127, b = bh >> 3, hh = bh & 7;
        const int q0 = qblk * 256, qbase = q0 + 32 * w;
        bf16_t* qrow = R + R_QSB + (size_t)(b * 2048 + qbase + r31) * 512 + hh * 64;
        bf16x8 qf[4];
#pragma unroll
        for (int kk = 0; kk < 4; ++kk) qf[kk] = *(const bf16x8*)(qrow + 16 * kk + 8 * h);
        f32x16 oacc[2];
#pragma unroll
        for (int nt = 0; nt < 2; ++nt)
#pragma unroll
            for (int i = 0; i < 16; ++i) oacc[nt][i] = 0.f;
        float Rr = 1.0f;
        const int t = qbase + r31;
        for (int kt = q0 / 64 + 3; kt >= 0; --kt) {
            __syncthreads();
            { const int wd = __all(Rr == 0.f); if (lane == 0) flags[w] = wd; }
            __syncthreads();
            if (flags[0] & flags[1] & flags[2] & flags[3] & flags[4] & flags[5] & flags[6] & flags[7]) break;
            const int s_tile = kt * 64;
            {
                const int c = tid, row = c >> 3, ch = c & 7;
                const u32x4 kv = *(const u32x4*)(R + R_KSB + (size_t)(b * 2048 + s_tile + row) * 512 + hh * 64 + ch * 8);
                const u32x4 vv = *(const u32x4*)(R + R_VTSB + ((size_t)((b * 8 + hh) * 64 + row)) * 2048 + s_tile + ch * 8);
                *(u32x4*)(KT + row * 128 + ((ch ^ (row & 7)) << 4)) = kv;
                *(uint2*)(VTt + row * 136 + ch * 16) = make_uint2(vv[0], vv[1]);
                *(uint2*)(VTt + row * 136 + ch * 16 + 8) = make_uint2(vv[2], vv[3]);
            }
            __syncthreads();
#pragma unroll
            for (int sbk = 1; sbk >= 0; --sbk) {
                const int key_lo = s_tile + 32 * sbk;
                if (key_lo >= qbase + 31) continue;
                if (__all(Rr == 0.f)) continue;
                f32x16 st;
#pragma unroll
                for (int i = 0; i < 16; ++i) st[i] = 0.f;
                const int krow = 32 * sbk + r31;
#pragma unroll
                for (int kk = 0; kk < 4; ++kk) {
                    const bf16x8 kf = *(const bf16x8*)(KT + krow * 128 + (((2 * kk + h) ^ (krow & 7)) << 4));
                    st = __builtin_amdgcn_mfma_f32_32x32x16_bf16(kf, qf[kk], st, 0, 0, 0);
                }
                float a[16], G[4];
                const bool diag = key_lo + 31 >= qbase;
#pragma unroll
                for (int g = 0; g < 4; ++g) {
                    float sg[4], m[4];
#pragma unroll
                    for (int i = 0; i < 4; ++i) {
                        const float z = fmaxf(st[4 * g + i], -80.f);
                        const float ez = __builtin_amdgcn_exp2f(z * -1.4426950409f), sig = __builtin_amdgcn_rcpf(1.0f + ez);
                        sg[i] = sig; m[i] = ez * sig;
                    }
                    if (diag) {
#pragma unroll
                        for (int i = 0; i < 4; ++i) { const bool valid = key_lo + 8 * g + 4 * h + i < t; sg[i] = valid ? sg[i] : 0.f; m[i] = valid ? m[i] : 1.0f; }
                    }
                    const float x2 = m[3], x1 = x2 * m[2], x0 = x1 * m[1];
                    G[g] = x0 * m[0];
                    a[4 * g + 3] = sg[3]; a[4 * g + 2] = sg[2] * x2; a[4 * g + 1] = sg[1] * x1; a[4 * g] = sg[0] * x0;
                }
                float Go[4], P[4];
#pragma unroll
                for (int g = 0; g < 4; ++g) { Go[g] = __shfl_xor(G[g], 32); P[g] = G[g] * Go[g]; }
                const float c2 = P[3], c1 = c2 * P[2], c0 = c1 * P[1];
                float Tg[4];
                Tg[3] = Rr; Tg[2] = Rr * c2; Tg[1] = Rr * c1; Tg[0] = Rr * c0;
#pragma unroll
                for (int g = 0; g < 4; ++g) {
                    const float tg = (h == 0) ? Tg[g] * Go[g] : Tg[g];
                    a[4 * g] *= tg; a[4 * g + 1] *= tg; a[4 * g + 2] *= tg; a[4 * g + 3] *= tg;
                }
                Rr = Rr * c0 * P[0];
#pragma unroll
                for (int s2 = 0; s2 < 2; ++s2) {
                    union { bf16x8 v; unsigned u[4]; } af;
#pragma unroll
                    for (int j2 = 0; j2 < 4; ++j2) af.u[j2] = pack2(a[8 * s2 + 2 * j2], a[8 * s2 + 2 * j2 + 1]);
#pragma unroll
                    for (int nt = 0; nt < 2; ++nt) {
                        const char* vp = VTt + (32 * nt + r31) * 136 + 64 * sbk + 32 * s2 + 8 * h;
                        union { bf16x8 v; uint2 hh2[2]; } vf;
                        vf.hh2[0] = *(const uint2*)vp; vf.hh2[1] = *(const uint2*)(vp + 16);
                        oacc[nt] = __builtin_amdgcn_mfma_f32_32x32x16_bf16(af.v, vf.v, oacc[nt], 0, 0, 0);
                    }
                }
            }
        }
#pragma unroll
        for (int nt = 0; nt < 2; ++nt)
#pragma unroll
            for (int i = 0; i < 16; ++i) {
                const int qq = (i & 3) + 8 * (i >> 2) + 4 * h;
                R[R_QSB + (size_t)(b * 2048 + qbase + qq) * 512 + hh * 64 + 32 * nt + r31] = f2bf(oacc[nt][i]);
            }
    }
}
__device__ __forceinline__ float log_sigmoid(float x) { return fminf(x, 0.f) - __logf(1.0f + __expf(-fabsf(x))); }
__device__ __forceinline__ int swz(int row, int chunk) { return row * 128 + ((chunk ^ (row & 7)) << 4); }
__device__ __forceinline__ void gla_prep(const Params& p, char* smem) {
    bf16_t* R = (bf16_t*)(p.ws + OFF_REGION);
    const float* ALR = (const float*)(R + R_ALR);
    bf16_t* KOTg = R + R_KOT; float* DECg = (float*)(R + R_DEC);
    float* SEG = (float*)smem; float* ALRs = SEG + 256;
    const int tid = VTID, d = tid & 63, w = tid >> 6;
    for (int task = VBID; task < 2048; task += VGRID) {
        const int bh = task >> 5, c = task & 31, b = bh >> 2, hh = bh & 3;
        const size_t rowbase = (size_t)b * 2048 + c * 64;
        unsigned qr[16], kr[16];
#pragma unroll
        for (int i = 0; i < 16; ++i) { const size_t row = rowbase + w * 16 + i; qr[i] = R[R_QG + row * 256 + hh * 64 + d]; kr[i] = R[R_KG + row * 256 + hh * 64 + d]; }
        const f32x4 ar = *(const f32x4*)(ALR + rowbase * 16 + tid * 4);
        float w2r[16];
#pragma unroll
        for (int r = 0; r < 16; ++r) w2r[r] = p.ab_w_alpha2[r * 256 + hh * 64 + d];
        const float b2r = p.ab_b_alpha2[hh * 64 + d];
        __syncthreads();
        *(f32x4*)(ALRs + tid * 4) = ar;
        __syncthreads();
        float cs[16]; float run = 0.f;
#pragma unroll
        for (int i = 0; i < 16; ++i) {
            const float* al = ALRs + (w * 16 + i) * 16;
            float pre = b2r;
#pragma unroll
            for (int r = 0; r < 16; ++r) pre += al[r] * w2r[r];
            run += log_sigmoid(pre) * (1.0f / 16.0f);
            cs[i] = run;
        }
        SEG[w * 64 + d] = run;
        __syncthreads();
        float off = 0.f, tot = 0.f;
#pragma unroll
        for (int w2 = 0; w2 < 4; ++w2) { const float s = SEG[w2 * 64 + d]; tot += s; if (w2 < w) off += s; }
        unsigned kop[8];
#pragma unroll
        for (int i2 = 0; i2 < 8; ++i2) {
            float kov[2];
#pragma unroll
            for (int u = 0; u < 2; ++u) {
                const int i = 2 * i2 + u;
                const float bc = off + cs[i];
                const float kv = bf2f((bf16_t)kr[i]);
                const size_t row = rowbase + w * 16 + i;
                R[R_QG + row * 256 + hh * 64 + d] = f2bf(bf2f((bf16_t)qr[i]) * 0.125f * __expf(bc));
                R[R_KG + row * 256 + hh * 64 + d] = f2bf(kv * __expf(-bc));
                kov[u] = kv * __expf(tot - bc);
            }
            kop[i2] = pack2(kov[0], kov[1]);
        }
        bf16_t* kp = KOTg + ((size_t)task * 64 + d) * 64 + w * 16;
        *(uint4*)kp = make_uint4(kop[0], kop[1], kop[2], kop[3]);
        *(uint4*)(kp + 8) = make_uint4(kop[4], kop[5], kop[6], kop[7]);
        if (w == 0) DECg[(size_t)task * 64 + d] = __expf(tot);
    }
}
__device__ __forceinline__ void gla_scan(const Params& p, char* smem, bool dry = false) {
    bf16_t* R = (bf16_t*)(p.ws + OFF_REGION);
    const bf16_t* KOTg = R + R_KOT; const float* DECg = (const float*)(R + R_DEC);
    char* QS = smem; char* KS = smem + 8192; char* KOT = smem + 16384; char* VTs = smem + 24576; char* SPT = smem + 40960;
    float* DEC = (float*)(smem + 57344); float* GN = DEC + 64;
    const int tid = VTID, lane = tid & 63, w = tid >> 6, l15_ = lane & 15, q4 = lane >> 4;
    for (int task = VBID; task < 64; task += VGRID) {
        const int b = task >> 2, hh = task & 3;
        f32x4 Sacc[8];
#pragma unroll
        for (int nt = 0; nt < 8; ++nt) Sacc[nt] = (f32x4){0.f, 0.f, 0.f, 0.f};
        __syncthreads();
        for (int i = tid; i < 1024; i += 256) *(uint4*)(SPT + i * 16) = make_uint4(0, 0, 0, 0);
        if (tid < 128) GN[tid] = p.ab_gla_norm[hh * 128 + tid];
        const size_t rowbase = (size_t)b * 2048;
        const bf16_t* vbase = R + R_VTG + ((size_t)((b * 4 + hh) * 128)) * 2048;
        u32x4 tq[2], tk[2], tko[2], vr[4]; float td = 0.f;
        auto prefetch = [&](int c) {
            const int t0 = c * 64;
#pragma unroll
            for (int i = 0; i < 2; ++i) {
                const int cid = tid + 256 * i, row = cid >> 3, ch = cid & 7;
                tq[i] = *(const u32x4*)(R + R_QG + (rowbase + t0 + row) * 256 + hh * 64 + ch * 8);
                tk[i] = *(const u32x4*)(R + R_KG + (rowbase + t0 + row) * 256 + hh * 64 + ch * 8);
                tko[i] = *(const u32x4*)(KOTg + (((size_t)task * 32 + c) * 64 + row) * 64 + ch * 8);
            }
#pragma unroll
            for (int i = 0; i < 4; ++i) { const int cid = tid + 256 * i, e = cid >> 3, ch = cid & 7; vr[i] = *(const u32x4*)(vbase + (size_t)e * 2048 + t0 + ch * 8); }
            if (tid < 64) td = DECg[((size_t)task * 32 + c) * 64 + tid];
        };
        prefetch(0);
        for (int c = 0; c < 32; ++c) {
            int lz = 0; asm volatile("" : "+v"(lz));
            const int l15 = l15_ + lz;
            const int cx = (q4 ^ (l15 & 7)) << 4;
            const int rb0 = l15 * 128 + cx, rb1 = l15 * 128 + (cx ^ 64);
#pragma unroll
            for (int i = 0; i < 2; ++i) {
                const int cid = tid + 256 * i + lz, row = cid >> 3, ch = cid & 7;
                *(u32x4*)(QS + swz(row, ch)) = tq[i]; *(u32x4*)(KS + swz(row, ch)) = tk[i]; *(u32x4*)(KOT + swz(row, ch)) = tko[i];
            }
#pragma unroll
            for (int i = 0; i < 4; ++i) { const int cid = tid + 256 * i + lz, e = cid >> 3, ch = cid & 7; *(u32x4*)(VTs + swz(e, ch)) = vr[i]; }
            if (tid < 64) DEC[tid] = td;
            uint2 gr[8];
            const unsigned goff = (unsigned)((rowbase + c * 64 + 16 * w + l15) * 512 + hh * 128 + 4 * q4);
            bf16_t* const gbase = R + R_GG;
#pragma unroll
            for (int nt = 0; nt < 8; ++nt) gr[nt] = *(const uint2*)(gbase + (goff + 16 * nt));
            if (c + 1 < 32) prefetch(c + 1);
            __syncthreads();
            bf16x8 qf[2];
#pragma unroll
            for (int kk = 0; kk < 2; ++kk) qf[kk] = *(const bf16x8*)(QS + w * 2048 + (kk ? rb1 : rb0));
            f32x4 sT[4];
#pragma unroll
            for (int st = 0; st < 4; ++st) {
                sT[st] = (f32x4){0.f, 0.f, 0.f, 0.f};
                if (st <= w) {
#pragma unroll
                    for (int kk = 0; kk < 2; ++kk) { const bf16x8 kf = *(const bf16x8*)(KS + st * 2048 + (kk ? rb1 : rb0)); sT[st] = __builtin_amdgcn_mfma_f32_16x16x32_bf16(kf, qf[kk], sT[st], 0, 0, 0); }
#pragma unroll
                    for (int r = 0; r < 4; ++r) if (16 * st + 4 * q4 + r > 16 * w + l15) sT[st][r] = 0.f;
                }
            }
            bf16x8 af[2];
#pragma unroll
            for (int ks2 = 0; ks2 < 2; ++ks2) {
                union { bf16x8 v; unsigned u[4]; } cv;
                cv.u[0] = pack2(sT[2 * ks2][0], sT[2 * ks2][1]); cv.u[1] = pack2(sT[2 * ks2][2], sT[2 * ks2][3]);
                cv.u[2] = pack2(sT[2 * ks2 + 1][0], sT[2 * ks2 + 1][1]); cv.u[3] = pack2(sT[2 * ks2 + 1][2], sT[2 * ks2 + 1][3]);
                af[ks2] = cv.v;
            }
            const int vb = l15 * 128 + ((((q4 >> 1) ^ (l15 & 7)) << 4) | ((q4 & 1) * 8));
            f32x4 o[8];
#pragma unroll
            for (int nt = 0; nt < 8; ++nt) {
                o[nt] = (f32x4){0.f, 0.f, 0.f, 0.f};
                const int e = 16 * nt + l15;
#pragma unroll
                for (int kk = 0; kk < 2; ++kk) { const bf16x8 sf = *(const bf16x8*)(SPT + nt * 2048 + (kk ? rb1 : rb0)); o[nt] = __builtin_amdgcn_mfma_f32_16x16x32_bf16(sf, qf[kk], o[nt], 0, 0, 0); }
#pragma unroll
                for (int ks2 = 0; ks2 < 2; ++ks2) {
                    if (2 * ks2 <= w) {
                        union { bf16x8 v; uint2 h[2]; } cv;
                        cv.h[0] = *(const uint2*)(VTs + nt * 2048 + (vb ^ (ks2 * 64)));
                        cv.h[1] = *(const uint2*)(VTs + nt * 2048 + (vb ^ (ks2 * 64) ^ 32));
                        o[nt] = __builtin_amdgcn_mfma_f32_16x16x32_bf16(cv.v, af[ks2], o[nt], 0, 0, 0);
                    }
                }
            }
            {
                const float4 dc = *(const float4*)(DEC + 16 * w + 4 * q4);
                bf16x8 kof[2];
#pragma unroll
                for (int kk = 0; kk < 2; ++kk) kof[kk] = *(const bf16x8*)(KOT + w * 2048 + (kk ? rb1 : rb0));
#pragma unroll
                for (int nt = 0; nt < 8; ++nt) {
                    Sacc[nt][0] *= dc.x; Sacc[nt][1] *= dc.y; Sacc[nt][2] *= dc.z; Sacc[nt][3] *= dc.w;
#pragma unroll
                    for (int kk = 0; kk < 2; ++kk) { const bf16x8 vf = *(const bf16x8*)(VTs + nt * 2048 + (kk ? rb1 : rb0)); Sacc[nt] = __builtin_amdgcn_mfma_f32_16x16x32_bf16(kof[kk], vf, Sacc[nt], 0, 0, 0); }
                }
            }
            __syncthreads();
#pragma unroll
            for (int nt = 0; nt < 8; ++nt) {
                const int e = 16 * nt + l15;
                uint2 pk; pk.x = pack2(Sacc[nt][0], Sacc[nt][1]); pk.y = pack2(Sacc[nt][2], Sacc[nt][3]);
                *(uint2*)(SPT + nt * 2048 + l15 * 128 + (((2 * w + (q4 >> 1)) ^ (l15 & 7)) << 4) + (q4 & 1) * 8) = pk;
            }
            float ssq = 0.f;
#pragma unroll
            for (int nt = 0; nt < 8; ++nt) ssq += (o[nt][0] * o[nt][0] + o[nt][1] * o[nt][1]) + (o[nt][2] * o[nt][2] + o[nt][3] * o[nt][3]);
            ssq += __shfl_xor(ssq, 16); ssq += __shfl_xor(ssq, 32);
            const float rsd = rsqrtf(ssq * (1.0f / 128.0f) + EPS);
#pragma unroll
            for (int nt = 0; nt < 8; ++nt) {
                asm volatile("" ::: "memory");
                const f32x4 gn = *(const f32x4*)(GN + 16 * nt + 4 * q4);
                const float g0 = lo2f(gr[nt].x), g1 = hi2f(gr[nt].x), g2 = lo2f(gr[nt].y), g3 = hi2f(gr[nt].y);
                uint2 ov;
                ov.x = pack2(o[nt][0] * rsd * gn[0] * g0, o[nt][1] * rsd * gn[1] * g1);
                ov.y = pack2(o[nt][2] * rsd * gn[2] * g2, o[nt][3] * rsd * gn[3] * g3);
                if (!dry || ov.x == 0x7fc17fc1u) *(uint2*)(gbase + (goff + 16 * nt)) = ov;
            }
        }
    }
}

__device__ __forceinline__ unsigned ord_key(float f) { const unsigned u = __float_as_uint(f); return (u & 0x80000000u) ? ~u : (u | 0x80000000u); }
__device__ __forceinline__ float unord_key(unsigned k) { return __uint_as_float((k & 0x80000000u) ? (k & 0x7fffffffu) : ~k); }
__device__ __forceinline__ void ce_desc(unsigned& a, unsigned& b) { const unsigned hi = max(a, b), lo = min(a, b); a = hi; b = lo; }
__device__ __forceinline__ void bitonic_sort16_desc(unsigned (&a)[16]) {
#pragma unroll
    for (int k = 2; k <= 16; k <<= 1)
#pragma unroll
        for (int j = k >> 1; j > 0; j >>= 1)
#pragma unroll
            for (int i = 0; i < 16; ++i) { const int l = i ^ j; if (l > i) { if ((i & k) == 0) ce_desc(a[i], a[l]); else ce_desc(a[l], a[i]); } }
}
__device__ __forceinline__ void merge_top16(unsigned (&L)[16], const unsigned (&B)[16]) {
#pragma unroll
    for (int i = 0; i < 16; ++i) L[i] = max(L[i], B[15 - i]);
#pragma unroll
    for (int j = 8; j > 0; j >>= 1)
#pragma unroll
        for (int i = 0; i < 16; ++i) { const int l = i ^ j; if (l > i) ce_desc(L[i], L[l]); }
}
__device__ constexpr int cand_i(int n) { int c = 0; for (int i = 0; i < 16; ++i) for (int j = 0; j < 16; ++j) if ((i + 1) * (j + 1) <= 16) { if (c == n) return i; ++c; } return -1; }
__device__ constexpr int cand_j(int n) { int c = 0; for (int i = 0; i < 16; ++i) for (int j = 0; j < 16; ++j) if ((i + 1) * (j + 1) <= 16) { if (c == n) return j; ++c; } return -1; }
template <int N> struct CandTab { int i[N], j[N]; constexpr CandTab() : i(), j() { for (int n = 0; n < N; ++n) { i[n] = cand_i(n); j[n] = cand_j(n); } } };

__device__ __forceinline__ bf16x8 pack8(const float4 a, const float4 b) {
    u32x4 t; t.x = pack2(a.x, a.y); t.y = pack2(a.z, a.w); t.z = pack2(b.x, b.y); t.w = pack2(b.z, b.w);
    return __builtin_bit_cast(bf16x8, t);
}
__device__ __forceinline__ void fold_query_weights(const Params& p, int vb0 = 0) {
    int lz = 0; asm volatile("" : "+v"(lz));
    const int lane = (VTID & 63) + lz, wid = VTID >> 6, fr = lane & 15, fq = lane >> 4;
    unsigned char* Wf = p.ws + OFF_WT_Q;
    if (VBID < vb0) return;
    for (int task = VBID - vb0; task < 512; task += VGRID - vb0) {
        const int kb = task & 15, pp = (task >> 4) & 1, h = (task >> 5) & 7, layer = task >> 8;
        const float* wq = p.peer_w_q + (size_t)layer * 1024 * 2048 + (size_t)(kb * 64 + fr) * 2048 + h * 256 + pp * 128 + fq * 8;
        const float* sk = p.peer_subkeys + ((size_t)((layer * 8 + h) * 2 + pp) * 128 + wid * 32 + fr) * 128 + fq * 8;
        f32x4 acc[4][2];
#pragma unroll
        for (int kt = 0; kt < 4; ++kt)
#pragma unroll
            for (int jt = 0; jt < 2; ++jt) acc[kt][jt] = (f32x4){0.f, 0.f, 0.f, 0.f};
#pragma unroll 1
        for (int s = 0; s < 4; ++s) {
            bf16x8 a[4], b[2];
#pragma unroll
            for (int kt = 0; kt < 4; ++kt) { const float* q = wq + (size_t)(kt * 16) * 2048 + s * 32; a[kt] = pack8(*(const float4*)q, *(const float4*)(q + 4)); }
#pragma unroll
            for (int jt = 0; jt < 2; ++jt) { const float* q = sk + (size_t)(jt * 16) * 128 + s * 32; b[jt] = pack8(*(const float4*)q, *(const float4*)(q + 4)); }
#pragma unroll
            for (int kt = 0; kt < 4; ++kt)
#pragma unroll
                for (int jt = 0; jt < 2; ++jt) acc[kt][jt] = __builtin_amdgcn_mfma_f32_16x16x32_bf16(a[kt], b[jt], acc[kt][jt], 0, 0, 0);
        }
#pragma unroll
        for (int jt = 0; jt < 2; ++jt) {
            const int key = wid * 32 + jt * 16 + fr, cu = 128 * ((key >> 5) & 1) + 32 * (2 * pp + (key >> 6)) + (key & 31);
            unsigned char* row = Wf + ((size_t)layer * 2048 + h * 256 + cu) * 1024 + kb * 64 + 4 * fq;
#pragma unroll
            for (int kt = 0; kt < 4; ++kt) {
                const f32x4 wv = acc[kt][jt] * *(const f32x4*)(p.norm_ffn + layer * 1024 + kb * 64 + kt * 16 + 4 * fq) * 64.0f;
                int pk = __builtin_amdgcn_cvt_pk_fp8_f32(wv[0], wv[1], 0, false); pk = __builtin_amdgcn_cvt_pk_fp8_f32(wv[2], wv[3], pk, true);
                *(int*)(row + kt * 16) = pk;
            }
        }
    }
}
__device__ __forceinline__ void bitonic_merge16_desc(unsigned (&L)[16]) {
#pragma unroll
    for (int j = 8; j > 0; j >>= 1)
#pragma unroll
        for (int i = 0; i < 16; ++i) { const int l = i ^ j; if (l > i) ce_desc(L[i], L[l]); }
}
__device__ __forceinline__ void bitonic_sort8_desc(unsigned (&a)[8]) {
#pragma unroll
    for (int k = 2; k <= 8; k <<= 1)
#pragma unroll
        for (int j = k >> 1; j > 0; j >>= 1)
#pragma unroll
            for (int i = 0; i < 8; ++i) { const int l = i ^ j; if (l > i) { if ((i & k) == 0) ce_desc(a[i], a[l]); else ce_desc(a[l], a[i]); } }
}
__device__ __forceinline__ void sort16_desc(unsigned (&a)[16]) {
#define CE_(i, j) ce_desc(a[i], a[j])
    CE_(0,13); CE_(1,12); CE_(2,15); CE_(3,14); CE_(4,8); CE_(5,6); CE_(7,11); CE_(9,10);
    CE_(0,5); CE_(1,7); CE_(2,9); CE_(3,4); CE_(6,13); CE_(8,14); CE_(10,15); CE_(11,12);
    CE_(0,1); CE_(2,3); CE_(4,5); CE_(6,8); CE_(7,9); CE_(10,11); CE_(12,13); CE_(14,15);
    CE_(0,2); CE_(1,3); CE_(4,10); CE_(5,11); CE_(6,7); CE_(8,9); CE_(12,14); CE_(13,15);
    CE_(1,2); CE_(3,12); CE_(4,6); CE_(5,7); CE_(8,10); CE_(9,11); CE_(13,14);
    CE_(1,4); CE_(2,6); CE_(5,8); CE_(7,10); CE_(9,13); CE_(11,14);
    CE_(2,4); CE_(3,6); CE_(9,12); CE_(11,13);
    CE_(3,5); CE_(6,8); CE_(7,9); CE_(10,12);
    CE_(3,4); CE_(5,6); CE_(7,8); CE_(9,10); CE_(11,12);
    CE_(6,7); CE_(8,9);
#undef CE_
}
struct EpiSelect {
    unsigned* IDX; float* GATE; G8_LAS unsigned* X; const float* SSQP; const unsigned* SCT;
    __device__ __forceinline__ void operator()(const f32x4 (&acc)[2][2][4][2], const g8::Unit& u, int wr, int wc, int fr_, int fq_) const {
        int lz = 0; asm volatile("" : "+v"(lz));
        const int lane_ = (int)(threadIdx.x & 63) + lz, fr = lane_ & 15, fq = lane_ >> 4; (void)fr_; (void)fq_;
        const int pp = wc >> 1, half = wc & 1, wid = wr * 4 + wc;
        const unsigned kb = 127u - (unsigned)(half * 64 + fq * 8);
        unsigned Lst[4][16];
#pragma unroll
        for (int ai = 0; ai < 2; ++ai)
#pragma unroll
            for (int m = 0; m < 4; ++m) {
                unsigned C[16], Xc[16];
#pragma unroll
                for (int bj = 0; bj < 2; ++bj)
#pragma unroll
                    for (int n = 0; n < 2; ++n)
#pragma unroll
                        for (int r = 0; r < 4; ++r) C[bj * 8 + n * 4 + r] = (ord_key(acc[ai][bj][m][n][r]) & ~127u) | (kb - (unsigned)(bj * 32 + n * 4 + r));
                sort16_desc(C);
#pragma unroll
                for (int i = 0; i < 16; ++i) Xc[i] = (unsigned)__shfl_xor((int)C[i], 16);
                merge_top16(C, Xc);
#pragma unroll
                for (int i = 0; i < 16; ++i) Xc[i] = (unsigned)__shfl_xor((int)C[i], 32);
                merge_top16(C, Xc);
                if ((m >> 1) == half) {
#pragma unroll
                    for (int i = 0; i < 16; ++i) Lst[ai * 2 + (m & 1)][i] = C[i];
                } else if (fq == 0) {
                    G8_LAS unsigned* xs = X + (((ai * 2 + wr) * 2 + pp) * 4 + m) * 256 + fr;
#pragma unroll
                    for (int i = 0; i < 16; ++i) xs[(i ^ m) << 4] = C[i];
                }
            }
        __syncthreads();
#pragma unroll
        for (int ai = 0; ai < 2; ++ai)
#pragma unroll
            for (int e = 0; e < 2; ++e) {
                const int m = half * 2 + e;
                unsigned Xc[16];
                G8_LAS unsigned* xs = X + (((ai * 2 + wr) * 2 + pp) * 4 + m) * 256 + fr;
#pragma unroll
                for (int i = 0; i < 16; ++i) Xc[i] = xs[(i ^ m) << 4];
                merge_top16(Lst[ai * 2 + e], Xc);
                if (fq == 0) {
#pragma unroll
                    for (int i = 0; i < 16; ++i) xs[(i ^ m) << 4] = Lst[ai * 2 + e][i];
                }
            }
        __syncthreads();
        if (wid < 4) {
            G8_LAS unsigned* x0 = X + ((wid * 2 + 0) * 4 + fq) * 256 + fr; G8_LAS unsigned* x1 = X + ((wid * 2 + 1) * 4 + fq) * 256 + fr;
            float s0[16], s1[16];
#pragma unroll
            for (int i = 0; i < 16; ++i) { s0[i] = unord_key(x0[(i ^ fq) << 4] & ~127u); s1[i] = unord_key(x1[(i ^ fq) << 4] & ~127u); }
#define SEL_CAND(i, j) ((ord_key(s0[i] + s1[j]) & ~255u) | (unsigned)(255 - ((i) * 16 + (j))))
            unsigned C[16], B[16], M2[16], M3[8];
#pragma unroll
            for (int j = 0; j < 16; ++j) C[j] = SEL_CAND(0, j);
#pragma unroll
            for (int k = 0; k < 15; ++k) B[k] = SEL_CAND(k + 1, 0);
            B[15] = 0u;
            merge_top16(C, B);
#pragma unroll
            for (int j = 0; j < 7; ++j) M2[j] = SEL_CAND(1, j + 1);
            M2[7] = 0u; M2[8] = 0u; M2[9] = 0u;
#pragma unroll
            for (int k = 0; k < 6; ++k) M2[15 - k] = SEL_CAND(k + 2, 1);
            bitonic_merge16_desc(M2);
            M3[0] = SEL_CAND(2, 2); M3[1] = SEL_CAND(2, 3); M3[2] = SEL_CAND(2, 4); M3[3] = SEL_CAND(3, 2); M3[4] = SEL_CAND(4, 2); M3[5] = SEL_CAND(3, 3); M3[6] = 0u; M3[7] = 0u;
            bitonic_sort8_desc(M3);
#pragma unroll
            for (int i = 0; i < 8; ++i) B[i] = M3[i];
#pragma unroll
            for (int i = 8; i < 16; ++i) B[i] = 0u;
            merge_top16(M2, B);
            merge_top16(C, M2);
#undef SEL_CAND
            const int tok = u.pm * 256 + (wid >> 1) * 128 + (wid & 1) * 64 + fq * 16 + fr;
            float rstd;
            {
                const f32x4 q0 = *(const f32x4*)(SSQP + (size_t)tok * 32), q1 = *(const f32x4*)(SSQP + (size_t)tok * 32 + 4), q2 = *(const f32x4*)(SSQP + (size_t)tok * 32 + 8), q3 = *(const f32x4*)(SSQP + (size_t)tok * 32 + 12);
                const f32x4 q = (q0 + q1) + (q2 + q3);
                rstd = rsqrtf(((q[0] + q[1]) + (q[2] + q[3])) * (1.0f / D) + EPS);
            }
            const float mx = unord_key(C[0] & ~255u);
            float e[16]; float sum = 0.f;
#pragma unroll
            for (int r = 0; r < 16; ++r) { e[r] = __expf((unord_key(C[r] & ~255u) - mx) * (rstd * (1.0f / 64.0f))); sum += e[r]; }
            const float inv = 1.0f / sum;
            const size_t ob = (size_t)tok * 128 + u.pn * 16;
            unsigned iw[16];
#pragma unroll
            for (int r = 0; r < 16; ++r) {
                const unsigned code = 255u - (C[r] & 255u);
                const unsigned e0 = 127u - (x0[((code >> 4) ^ (unsigned)fq) << 4] & 127u), e1 = 127u - (x1[((code & 15u) ^ (unsigned)fq) << 4] & 127u);
                iw[r] = e0 * 128u + e1;
            }
            unsigned sc[16];
#pragma unroll
            for (int r = 0; r < 16; ++r) sc[r] = SCT[iw[r]];
#pragma unroll
            for (int r = 0; r < 16; ++r) {
                iw[r] |= sc[r] << 16;
                e[r] *= inv * (float)__builtin_bit_cast(_Float16, (unsigned short)(sc[r] >> 16));
            }
#pragma unroll
            for (int r = 0; r < 4; ++r) *(uint4*)(IDX + ob + r * 4) = make_uint4(iw[4 * r], iw[4 * r + 1], iw[4 * r + 2], iw[4 * r + 3]);
#pragma unroll
            for (int r = 0; r < 4; ++r) *(float4*)(GATE + ob + r * 4) = make_float4(e[4 * r], e[4 * r + 1], e[4 * r + 2], e[4 * r + 3]);
        }
        __syncthreads();
    }
};
__device__ __forceinline__ void phase_select8(const Params& p, int layer, char* smem_phys) {
    const bf16_t* H = (const bf16_t*)(p.ws + OFF_H); const bf16_t* Wf = (const bf16_t*)(p.ws + OFF_WT_Q + (size_t)layer * 2048 * 1024);
    g8::Gemm g{H, H, 512, 512, Wf, T, 2048, 512};
    g8::StaticOrder S; S.init(T, 2048, (int)gridDim.x, (int)blockIdx.x);
    EpiSelect E{(unsigned*)(p.ws + OFF_IDX), (float*)(p.ws + OFF_GATE), (G8_LAS unsigned*)(smem_phys + 131072), (const float*)(p.ws + OFF_SSQ), (const unsigned*)(p.ws + OFF_USC) + (size_t)layer * NEXP};
    g8::gemm_phase<EpiSelect, true>((G8_LAS unsigned char*)smem_phys, g, S, E);
    __syncthreads();
    if (threadIdx.x == 0) *(uint4*)(smem_phys + kDynLds - 16) = make_uint4(0u, 0u, 0u, 0u);
    __syncthreads();
}

__device__ __forceinline__ float ub0(unsigned w) { float f; asm("v_cvt_f32_ubyte0 %0, %1" : "=v"(f) : "v"(w)); return f; }
__device__ __forceinline__ float ub1(unsigned w) { float f; asm("v_cvt_f32_ubyte1 %0, %1" : "=v"(f) : "v"(w)); return f; }
__device__ __forceinline__ float ub2(unsigned w) { float f; asm("v_cvt_f32_ubyte2 %0, %1" : "=v"(f) : "v"(w)); return f; }
__device__ __forceinline__ float ub3(unsigned w) { float f; asm("v_cvt_f32_ubyte3 %0, %1" : "=v"(f) : "v"(w)); return f; }
typedef _Float16 f16x2 __attribute__((ext_vector_type(2)));
__device__ __forceinline__ void glds16(const void* gsrc, unsigned lds_dst) {
    unsigned keep; const unsigned d = (unsigned)__builtin_amdgcn_readfirstlane((int)lds_dst);
    asm volatile("s_mov_b32 %0, m0\n\ts_mov_b32 m0, %2\n\ts_nop 0\n\tglobal_load_lds_dwordx4 %1, off\n\ts_mov_b32 m0, %0" : "=&s"(keep) : "v"(gsrc), "s"(d) : "memory");
}
__device__ __forceinline__ void peer_gather(const Params& p, int layer, const float* __restrict__ gnext, bool final_out, char* smem) {
    const unsigned char* REC = p.ws + OFF_UT + (size_t)layer * NEXP * 1024;
    bf16_t* H = (bf16_t*)(p.ws + OFF_H);
    const unsigned* IDX = (const unsigned*)(p.ws + OFF_IDX); const float* GATE = (const float*)(p.ws + OFF_GATE);
    bf16_t* S = (bf16_t*)(p.ws + OFF_S);
    float* sGain = (float*)(smem + 139264);
    { int lz0 = 0; asm volatile("" : "+v"(lz0)); const int i = (int)threadIdx.x + lz0; if (i < 256) ((f32x4*)sGain)[i] = ((const f32x4*)(p.norm_ffn + layer * 1024))[i]; }
    __syncthreads();
    const int lane = VTID & 63, wid = VTID >> 6, sub = lane >> 4, li = lane & 15;
    char* wbase = smem + (int)(threadIdx.x >> 6) * 17408;
    unsigned* sIdx = (unsigned*)wbase; float* sGate = (float*)(wbase + 512);
    const char* ring = wbase + 1024; const unsigned ringb = (unsigned)(size_t)ring;
    const int gw = VBID * 4 + wid, nw = VGRID * 4;
    for (int t = gw; t < T; t += nw) {
        {
            int lz = 0; asm volatile("" : "+v"(lz));
            const int l2 = 2 * (lane + lz);
            const uint2 idp = *(const uint2*)(IDX + (size_t)t * 128 + l2);
            const float2 g2 = *(const float2*)(GATE + (size_t)t * 128 + l2);
            *(uint2*)(sIdx + l2) = idp; *(float2*)(sGate + l2) = g2;
        }
        int XH[2][4], XL[2][4]; float sx; float xg;
        {
            const int jq = sub >> 1, dq = (sub & 1) * 2;
            f32x4 xr[4]; float am = 0.f, ssx = 0.f;
#pragma unroll
            for (int k = 0; k < 2; ++k) {
                const int col = (16 * jq + li) * 32 + (dq + k) * 8;
                const u32x4 raw = *(const u32x4*)(S + (size_t)t * 1024 + col);
                const f32x4 g0 = *(const f32x4*)(sGain + col), g1 = *(const f32x4*)(sGain + col + 4);
                const f32x4 x0 = (f32x4){lo2f(raw[0]), hi2f(raw[0]), lo2f(raw[1]), hi2f(raw[1])}, x1 = (f32x4){lo2f(raw[2]), hi2f(raw[2]), lo2f(raw[3]), hi2f(raw[3])};
                ssx += (x0[0] * x0[0] + x0[1] * x0[1]) + (x0[2] * x0[2] + x0[3] * x0[3]) + (x1[0] * x1[0] + x1[1] * x1[1]) + (x1[2] * x1[2] + x1[3] * x1[3]);
                xr[2 * k] = x0 * g0; xr[2 * k + 1] = x1 * g1;
#pragma unroll
                for (int c = 0; c < 4; ++c) am = fmaxf(am, fmaxf(fabsf(xr[2 * k][c]), fabsf(xr[2 * k + 1][c])));
            }
            am = fmaxf(am, __shfl_xor(am, 1)); am = fmaxf(am, __shfl_xor(am, 2)); am = fmaxf(am, __shfl_xor(am, 4)); am = fmaxf(am, __shfl_xor(am, 8));
            am = fmaxf(am, __shfl_xor(am, 16)); am = fmaxf(am, __shfl_xor(am, 32));
            ssx = row16_sum(ssx); ssx += __shfl_xor(ssx, 16); ssx += __shfl_xor(ssx, 32);
            const float inv = am > 0.f ? 119.0f / am : 0.f;
            sx = am * (1.0f / 119.0f) * rsqrtf(ssx * (1.0f / D) + EPS);
            int xs = 0; int myL[2], myH[2];
#pragma unroll
            for (int k = 0; k < 2; ++k) {
                unsigned lo = 0u, hi = 0u;
#pragma unroll
                for (int i = 0; i < 8; ++i) {
                    const int q = __float2int_rn(xr[k * 2 + (i >> 2)][i & 3] * inv);
                    const int sh = (i & 3) * 8 + (i >> 2) * 4;
                    lo |= ((unsigned)q & 15u) << sh; hi |= ((unsigned)((q + 8) >> 4) & 15u) << sh;
                    xs += q;
                }
                myL[k] = (int)lo; myH[k] = (int)hi;
            }
            xs += __shfl_xor(xs, 16); xs += __shfl_xor(xs, 32);
#pragma unroll
            for (int j = 0; j < 2; ++j)
#pragma unroll
                for (int d = 0; d < 4; ++d) { const int srcl = (2 * j + (d >> 1)) * 16 + li; XL[j][d] = __shfl(myL[d & 1], srcl); XH[j][d] = __shfl(myH[d & 1], srcl); }
            xg = 0.5f * (float)xs;
        }
        f16x2 accp[2][16];
#pragma unroll
        for (int j = 0; j < 2; ++j)
#pragma unroll
            for (int c = 0; c < 16; ++c) accp[j][c] = (f16x2){(_Float16)0.f, (_Float16)0.f};
        float wsg = 0.f;
        auto issue = [&](int sg) {
            const unsigned e_ = sIdx[sg * 4 + sub] & 0xffffu;
            const unsigned char* rec = REC + (size_t)e_ * 1024 + li * 16;
            const unsigned dst = ringb + (unsigned)(sg & 3) * 4096u;
            glds16(rec, dst); glds16(rec + 256, dst + 1024u); glds16(rec + 512, dst + 2048u); glds16(rec + 768, dst + 3072u);
        };
        auto compute = [&](int sg, bool refill) {
            const char* sl = ring + (sg & 3) * 4096;
            const u32x4 du0 = *(const u32x4*)(sl + lane * 16), du1 = *(const u32x4*)(sl + 1024 + lane * 16);
            const u32x4 dv0 = *(const u32x4*)(sl + 2048 + lane * 16), dv1 = *(const u32x4*)(sl + 3072 + lane * 16);
            const float us = (float)__builtin_bit_cast(_Float16, (unsigned short)(sIdx[sg * 4 + sub] >> 16));
            const float gt = sGate[sg * 4 + sub];
            if (refill) { asm volatile("s_waitcnt lgkmcnt(0)" ::: "memory"); issue(sg + 4); }
            int iah = 0, ial = 0;
#pragma unroll
            for (int j = 0; j < 2; ++j) {
#pragma unroll
                for (int d = 0; d < 4; ++d) {
                    const int w = (int)(j ? du1[d] : du0[d]);
                    iah = __builtin_amdgcn_sdot8(w, XH[j][d], iah, false);
                    ial = __builtin_amdgcn_sdot8(w, XL[j][d], ial, false);
                }
            }
            float pa = us * ((float)(16 * iah + ial) + xg);
            pa = row16_sum(pa);
            const float ww = gt * gelu_exact(pa * sx);
            wsg += ww;
            const float wc = fminf(fmaxf(ww * 65536.0f, -65504.0f), 65504.0f);
            const _Float16 wha = (_Float16)wc, whb = (_Float16)(wc * 0.0625f);
            const f16x2 wa = {wha, wha}, wb = {whb, whb};
#pragma unroll
            for (int j = 0; j < 2; ++j) {
#pragma unroll
                for (int d = 0; d < 4; ++d) {
                    const unsigned wv = j ? dv1[d] : dv0[d], wt = wv >> 8;
                    const f16x2 c0 = __builtin_bit_cast(f16x2, wv & 0x000f000fu), c1 = __builtin_bit_cast(f16x2, wv & 0x00f000f0u);
                    const f16x2 c2 = __builtin_bit_cast(f16x2, wt & 0x000f000fu), c3 = __builtin_bit_cast(f16x2, wt & 0x00f000f0u);
                    accp[j][4 * d + 0] = __builtin_elementwise_fma(c0, wa, accp[j][4 * d + 0]); accp[j][4 * d + 1] = __builtin_elementwise_fma(c1, wb, accp[j][4 * d + 1]);
                    accp[j][4 * d + 2] = __builtin_elementwise_fma(c2, wa, accp[j][4 * d + 2]); accp[j][4 * d + 3] = __builtin_elementwise_fma(c3, wb, accp[j][4 * d + 3]);
                }
            }
        };
        asm volatile("s_waitcnt vmcnt(0)" ::: "memory");
        issue(0); issue(1); issue(2); issue(3);
#pragma unroll 1
        for (int sg = 0; sg < 28; ++sg) {
            asm volatile("s_waitcnt vmcnt(12)" ::: "memory");
            compute(sg, true);
        }
        asm volatile("s_waitcnt vmcnt(12)" ::: "memory");
        compute(28, false);
        asm volatile("s_waitcnt vmcnt(8)" ::: "memory");
        compute(29, false);
        asm volatile("s_waitcnt vmcnt(4)" ::: "memory");
        compute(30, false);
        asm volatile("s_waitcnt vmcnt(0)" ::: "memory");
        compute(31, false);
        const bool up2 = (sub & 2) != 0, up1 = (sub & 1) != 0;
        float wsum = wsg + __shfl_xor(wsg, 32);
        wsum += __shfl_xor(wsum, 16);
        f16x2 r1p[16];
#pragma unroll
        for (int c = 0; c < 16; ++c) {
            const f16x2 keep = up2 ? accp[1][c] : accp[0][c], give = up2 ? accp[0][c] : accp[1][c];
            r1p[c] = keep + __builtin_bit_cast(f16x2, __shfl_xor(__builtin_bit_cast(int, give), 32));
        }
        f16x2 r2p[8];
#pragma unroll
        for (int c = 0; c < 8; ++c) {
            const f16x2 keep = up1 ? r1p[8 + c] : r1p[c], give = up1 ? r1p[c] : r1p[8 + c];
            r2p[c] = keep + __builtin_bit_cast(f16x2, __shfl_xor(__builtin_bit_cast(int, give), 16));
        }
        float r2[16];
#pragma unroll
        for (int dl = 0; dl < 2; ++dl) {
            r2[8 * dl + 0] = 256.0f * (float)r2p[4 * dl + 0][0]; r2[8 * dl + 2] = 256.0f * (float)r2p[4 * dl + 0][1];
            r2[8 * dl + 4] = 256.0f * (float)r2p[4 * dl + 1][0]; r2[8 * dl + 6] = 256.0f * (float)r2p[4 * dl + 1][1];
            r2[8 * dl + 1] = 256.0f * (float)r2p[4 * dl + 2][0]; r2[8 * dl + 3] = 256.0f * (float)r2p[4 * dl + 2][1];
            r2[8 * dl + 5] = 256.0f * (float)r2p[4 * dl + 3][0]; r2[8 * dl + 7] = 256.0f * (float)r2p[4 * dl + 3][1];
        }
        const int col0 = (16 * (sub >> 1) + li) * 32 + (sub & 1) * 16;
        float ss = 0.f;
        bf16_t* srow = S + (size_t)t * 1024 + col0;
        {
            const u32x4 b0 = *(const u32x4*)srow, b1 = *(const u32x4*)(srow + 8);
#pragma unroll
            for (int c = 0; c < 8; ++c) {
                const unsigned wsrc = c < 4 ? b0[c] : b1[c - 4];
                r2[2 * c] = r2[2 * c] - 7.5f * wsum + lo2f(wsrc); r2[2 * c + 1] = r2[2 * c + 1] - 7.5f * wsum + hi2f(wsrc);
                ss += r2[2 * c] * r2[2 * c] + r2[2 * c + 1] * r2[2 * c + 1];
            }
        }
        ss = wave_sum(ss);
        const float rstd = rsqrtf(ss * (1.0f / D) + EPS);
        const float* gp = gnext + col0;
        if (final_out) {
            float* orow = p.out + (size_t)t * 1024 + col0;
#pragma unroll
            for (int c4 = 0; c4 < 4; ++c4) {
                const f32x4 g = *(const f32x4*)(gp + c4 * 4);
                *(f32x4*)(orow + c4 * 4) = (f32x4){r2[c4 * 4] * rstd * g[0], r2[c4 * 4 + 1] * rstd * g[1], r2[c4 * 4 + 2] * rstd * g[2], r2[c4 * 4 + 3] * rstd * g[3]};
            }
        } else {
            u32x4 sv[2];
#pragma unroll
            for (int c4 = 0; c4 < 4; ++c4) { sv[c4 >> 1][(c4 & 1) * 2] = pack2(r2[c4 * 4], r2[c4 * 4 + 1]); sv[c4 >> 1][(c4 & 1) * 2 + 1] = pack2(r2[c4 * 4 + 2], r2[c4 * 4 + 3]); }
            *(u32x4*)srow = sv[0]; *(u32x4*)(srow + 8) = sv[1];
            if (lane == 0) ((float*)(p.ws + OFF_VSC))[t] = rstd;
        }
    }
}


#define XB_TMO      128
#define XB_XCNT(j)  (256  + 64 * (j))
#define XB_XSUB(j)  (1280 + 64 * (j))
#define XB_XGEN(j)  (2304 + 64 * (j))
#define XB_TOP      3328
#define XB_TOPGEN   3392
#define XCD_BAR_WORDS 3456
#define XB_SPIN_CAP (1u << 22)
#define LAS __attribute__((address_space(3)))
__device__ __forceinline__ unsigned xb_ld(unsigned* p)              { return __hip_atomic_load(p, __ATOMIC_RELAXED, __HIP_MEMORY_SCOPE_AGENT); }
__device__ __forceinline__ unsigned xb_add(unsigned* p, unsigned v) { return __hip_atomic_fetch_add(p, v, __ATOMIC_RELAXED, __HIP_MEMORY_SCOPE_AGENT); }
__device__ __forceinline__ unsigned xb_xcc_id() { return (unsigned)__builtin_amdgcn_s_getreg((3 << 11) | 20) & 0xFu; }
#define XB_SPIN(cond, bar) do { unsigned _sp = 0; while (cond) { __builtin_amdgcn_s_sleep(1); \
    if ((++_sp & 255u) == 0u) { if (xb_ld(&(bar)[XB_TMO])) break; if (_sp > XB_SPIN_CAP) { atomicAdd(&(bar)[XB_TMO], 1u); break; } } } } while (0)
struct XcdBarrier { unsigned* bar; unsigned x; volatile LAS unsigned* st; };
__device__ __forceinline__ XcdBarrier xcd_barrier_post(unsigned* bar, volatile LAS unsigned* st) {
    XcdBarrier b; b.bar = bar; b.x = xb_xcc_id(); b.st = st;
    if (threadIdx.x == 0) (void)xb_add(&bar[XB_XCNT(b.x)], 1u);
    return b;
}
__device__ __forceinline__ void xcd_barrier_complete(unsigned* bar, unsigned x, unsigned& nloc, unsigned& nx) {
    const unsigned G = gridDim.x * gridDim.y * gridDim.z;
    unsigned sum, cnt, mine, sp = 0u;
    for (;;) {
        sum = 0u; cnt = 0u; mine = 0u;
#pragma unroll
        for (unsigned j = 0; j < 16; ++j) { const unsigned c = xb_ld(&bar[XB_XCNT(j)]); sum += c; cnt += (c > 0u) ? 1u : 0u; mine = (j == x) ? c : mine; }
        if (sum == G) break;
        __builtin_amdgcn_s_sleep(1);
        if ((++sp & 255u) == 0u) { if (xb_ld(&bar[XB_TMO])) break; if (sp > XB_SPIN_CAP) { atomicAdd(&bar[XB_TMO], 1u); break; } }
    }
    nloc = mine > 0u ? mine : 1u; nx = cnt > 0u ? cnt : 1u;
}
__device__ __forceinline__ void xcd_barrier(const XcdBarrier& b) {
    asm volatile("s_waitcnt vmcnt(0)" ::: "memory");
    __syncthreads();
    if (threadIdx.x == 0) {
        unsigned* bar = b.bar;
        __builtin_amdgcn_s_waitcnt(0);
        unsigned nloc = b.st[0], nx = b.st[1];
        if (nloc == 0u) { xcd_barrier_complete(bar, b.x, nloc, nx); b.st[0] = nloc; b.st[1] = nx; }
        const unsigned old = xb_add(&bar[XB_XSUB(b.x)], 1u);
        const unsigned gen = old / nloc;
        if (old + 1u == (gen + 1u) * nloc) {
            __builtin_amdgcn_fence(__ATOMIC_RELEASE, "agent");
            asm volatile("s_waitcnt vmcnt(0)" ::: "memory");
            const unsigned og = xb_add(&bar[XB_TOP], 1u);
            const unsigned tg = og / nx;
            if (og + 1u == (tg + 1u) * nx) xb_add(&bar[XB_TOPGEN], 1u);
            else XB_SPIN(xb_ld(&bar[XB_TOPGEN]) == tg, bar);
            __builtin_amdgcn_fence(__ATOMIC_ACQUIRE, "agent");
            xb_add(&bar[XB_XGEN(b.x)], 1u);
            asm volatile("s_waitcnt vmcnt(0)" ::: "memory");
        } else {
            XB_SPIN(xb_ld(&bar[XB_XGEN(b.x)]) == gen, bar);
            __builtin_amdgcn_fence(__ATOMIC_ACQUIRE, "agent");
            asm volatile("s_waitcnt vmcnt(0)" ::: "memory");
        }
    }
    __syncthreads();
}

constexpr int NPHASE = 12;
__global__ void __launch_bounds__(512, 2) mega(Params p, int ph_lo, int ph_hi) {
    extern __shared__ __attribute__((aligned(16))) char smem_phys[];
    uint4& xb_words = *(uint4*)(smem_phys + kDynLds - 16);
    if (threadIdx.x == 0) xb_words = make_uint4(0u, 0u, 0u, 0u);
    __syncthreads();
    const XcdBarrier xbar = xcd_barrier_post((unsigned*)(p.ws + OFF_BAR), (volatile LAS unsigned*)&xb_words);
    char* smem = smem_phys + (threadIdx.x >> 8) * 65536;
    bf16_t* Rg = (bf16_t*)(p.ws + OFF_REGION);
    bf16_t* Hb = (bf16_t*)(p.ws + OFF_H);
#define PHASE(k, ...) if (ph_lo <= (k) && (k) < ph_hi) { __VA_ARGS__; if ((k) + 1 < ph_hi) xcd_barrier(xbar); }
    unsigned* sbctr = (unsigned*)(p.ws + OFF_BAR + 14336);
    PHASE(0,
        transpose_convert<true>(p.ab_w_in, (bf16_t*)(p.ws + OFF_WT_IN), 1024, AB_IN, AB_IN_PAD, smem);
        rmsnorm_rows(p.x, p.norm_mix, Hb))
    PHASE(1, phase_gemm_in8(p, smem_phys))
    PHASE(2, gla_prep(p, smem))
    PHASE(3, gla_scan(p, smem); sb_fast(p, smem_phys + 98304, sbctr);
        quantize_tables_static(p, 64);
        transpose_convert(p.ab_w_out, (bf16_t*)(p.ws + OFF_WT_OUT), 1024, 1024, 1024, smem, 64);
        transpose_convert(p.c_w_in, (bf16_t*)(p.ws + OFF_WT_CIN), 1024, 4096, 4096, smem, 64, p.norm_mix + 1024);
        transpose_convert(p.c_w_out, (bf16_t*)(p.ws + OFF_WT_COUT), 2048, 1024, 1024, smem, 64);
        fold_query_weights(p, 64))
    PHASE(4, phase_gemm_resid8(Rg + R_QSB, Rg + R_GG, 512, 512, (const bf16_t*)(p.ws + OFF_WT_OUT), 1024, p.x, (bf16_t*)(p.ws + OFF_S), (float*)(p.ws + OFF_SSQ), p.ws + OFF_H, smem_phys))
    PHASE(5, phase_select8(p, 0, smem_phys))
    PHASE(6, peer_gather(p, 0, p.norm_mix + 1024, false, smem_phys))
    PHASE(7, phase_gemm_cin8_v(p, smem_phys))
    PHASE(8, phase_gemm_cin8_u(p, smem_phys))
    PHASE(9, phase_gemm_resid8(Rg, Rg, 2048, 2048, (const bf16_t*)(p.ws + OFF_WT_COUT), 2048, nullptr, (bf16_t*)(p.ws + OFF_S), (float*)(p.ws + OFF_SSQ), p.ws + OFF_H, smem_phys))
    PHASE(10, phase_select8(p, 1, smem_phys))
    PHASE(11, peer_gather(p, 1, p.final_norm, true, smem_phys))
}

extern "C" void kernel_launch(void* const* d_in, const int* in_sizes, int n_in, void* d_out, int out_size, void* d_ws, size_t ws_size, hipStream_t stream) {
    static int grid_blocks = 0;
    if (!grid_blocks) {
        int dev = 0, cus = 0, per_cu = 0;
        hipGetDevice(&dev);
        hipDeviceGetAttribute(&cus, hipDeviceAttributeMultiprocessorCount, dev);
        hipFuncSetAttribute((const void*)mega, hipFuncAttributeMaxDynamicSharedMemorySize, kDynLds);
        hipOccupancyMaxActiveBlocksPerMultiprocessor(&per_cu, mega, 512, kDynLds);
        if (per_cu < 1) per_cu = 1;
        if (per_cu > 1) per_cu = 1;
        grid_blocks = cus * per_cu;
        if (n_in != 18 || ws_size < WS_END) fprintf(stderr, "kernel_launch: unexpected n_in %d or ws_size %zu < %zu\n", n_in, ws_size, (size_t)WS_END);
    }
    Params p{};
    p.x = (const float*)d_in[0]; p.norm_mix = (const float*)d_in[1]; p.norm_ffn = (const float*)d_in[2]; p.ab_w_in = (const float*)d_in[3];
    p.ab_w_alpha2 = (const float*)d_in[4]; p.ab_b_alpha2 = (const float*)d_in[5]; p.ab_gla_norm = (const float*)d_in[6]; p.ab_w_out = (const float*)d_in[7];
    p.c_w_in = (const float*)d_in[8]; p.c_v_norm = (const float*)d_in[9]; p.c_w_spatial = (const float*)d_in[10]; p.c_b_spatial = (const float*)d_in[11];
    p.c_w_out = (const float*)d_in[12]; p.peer_w_q = (const float*)d_in[13]; p.peer_subkeys = (const float*)d_in[14]; p.peer_u = (const float*)d_in[15];
    p.peer_v = (const float*)d_in[16]; p.final_norm = (const float*)d_in[17];
    p.out = (float*)d_out; p.ws = (unsigned char*)d_ws;
    (void)hipMemsetAsync((char*)d_ws + OFF_BAR, 0, 16384, stream);
#if ONE_LAUNCH
    int lo = 0, hi = NPHASE;
    void* args[] = {&p, &lo, &hi};
    hipError_t e = hipLaunchCooperativeKernel((void*)mega, dim3(grid_blocks), dim3(512), args, kDynLds, stream);
    if (e != hipSuccess) fprintf(stderr, "cooperative launch failed: %s (grid %d)\n", hipGetErrorString(e), grid_blocks);
#else
    for (int ph = 0; ph < NPHASE; ++ph) hipLaunchKernelGGL(mega, dim3(grid_blocks), dim3(512), kDynLds, stream, p, ph, ph + 1);
#endif
}
```

```cpp
#include <hip/hip_runtime.h>
#include <cstdio>
#include <cstdint>

#ifndef ONE_LAUNCH
#define ONE_LAUNCH 1
#endif


#define VTID ((int)(threadIdx.x & 255))
#define VBID ((int)(blockIdx.x * 2 + (threadIdx.x >> 8)))
#define VGRID ((int)(gridDim.x * 2))
typedef unsigned short bf16_t;
typedef short bf16x8 __attribute__((ext_vector_type(8)));
typedef float f32x4 __attribute__((ext_vector_type(4)));
typedef unsigned u32x4 __attribute__((ext_vector_type(4)));
typedef __bf16 bf16x2_t __attribute__((ext_vector_type(2)));

constexpr int T = 32768, D = 1024, SEQ = 2048, NB = 16;
constexpr int AB_IN = 3088, AB_IN_PAD = 3200;
constexpr float EPS = 1e-6f;
constexpr int NEXP = 16384;
constexpr int kDynLds = 163840;

constexpr size_t SZ_WT_IN = (size_t)AB_IN_PAD * 1024 * 2;
constexpr size_t SZ_WT_OUT = (size_t)1024 * 1024 * 2;
constexpr size_t SZ_WT_CIN = (size_t)4096 * 1024 * 2;
constexpr size_t SZ_WT_COUT = (size_t)1024 * 2048 * 2;
constexpr size_t SZ_WT_Q = (size_t)2 * 2048 * 1024 * 2;
constexpr size_t SZ_SK = (size_t)2 * 8 * 2 * 128 * 128 * 2;
constexpr size_t SZ_TAB = (size_t)2 * NEXP * 1024;
constexpr size_t SZ_TSC = (size_t)2 * NEXP * 4;
constexpr size_t OFF_WT_IN = 0;
constexpr size_t OFF_WT_OUT = OFF_WT_IN + SZ_WT_IN;
constexpr size_t OFF_WT_CIN = OFF_WT_OUT + SZ_WT_OUT;
constexpr size_t OFF_WT_COUT = OFF_WT_CIN + SZ_WT_CIN;
constexpr size_t OFF_WT_Q = OFF_WT_COUT + SZ_WT_COUT;
constexpr size_t OFF_SK = OFF_WT_Q + SZ_WT_Q;
constexpr size_t OFF_UT = OFF_SK;
constexpr size_t OFF_USC = OFF_UT + SZ_TAB;
constexpr size_t OFF_VSC = OFF_USC + SZ_TSC;
constexpr size_t OFF_H = OFF_VSC + SZ_TSC;
constexpr size_t OFF_IDX = OFF_H + (size_t)T * 1024 * 2;
constexpr size_t OFF_GATE = OFF_IDX + (size_t)T * 128 * 4;
constexpr size_t OFF_SSQ = OFF_GATE + (size_t)T * 128 * 4;
constexpr size_t OFF_REGION = OFF_SSQ + (size_t)T * 32 * 4;
constexpr size_t SZ_REGION = (size_t)256 << 20;
constexpr size_t OFF_S = OFF_REGION + SZ_REGION;
constexpr size_t OFF_SK_W8 = OFF_S + (size_t)T * 1024 * 2;
constexpr size_t OFF_BAR = OFF_SK_W8 + (size_t)2048 * 1024;
constexpr size_t WS_END = OFF_BAR + 16384;
constexpr size_t R_QSB = 0;
constexpr size_t R_KSB = R_QSB + (size_t)T * 512;
constexpr size_t R_VTSB = R_KSB + (size_t)T * 512;
constexpr size_t R_QG = R_VTSB + (size_t)T * 512;
constexpr size_t R_KG = R_QG + (size_t)T * 256;
constexpr size_t R_VTG = R_KG + (size_t)T * 256;
constexpr size_t R_GG = R_VTG + (size_t)T * 512;
constexpr size_t R_ALR = R_GG + (size_t)T * 512;
constexpr size_t R_KOT = R_ALR + (size_t)T * 32;
constexpr size_t R_DEC = R_KOT + (size_t)T * 256;

struct Params {
    const float* x; const float* norm_mix; const float* norm_ffn; const float* ab_w_in; const float* ab_w_alpha2; const float* ab_b_alpha2;
    const float* ab_gla_norm; const float* ab_w_out; const float* c_w_in; const float* c_v_norm; const float* c_w_spatial; const float* c_b_spatial;
    const float* c_w_out; const float* peer_w_q; const float* peer_subkeys; const float* peer_u; const float* peer_v; const float* final_norm;
    float* out; unsigned char* ws;
};

__device__ __forceinline__ float bf2f(bf16_t v) { return __uint_as_float(((unsigned)v) << 16); }
__device__ __forceinline__ bf16_t f2bf(float f) { unsigned r; asm("v_cvt_pk_bf16_f32 %0, %1, %1" : "=v"(r) : "v"(f)); return (bf16_t)r; }
__device__ __forceinline__ unsigned pack2(float lo, float hi) { unsigned r; asm("v_cvt_pk_bf16_f32 %0, %1, %2" : "=v"(r) : "v"(lo), "v"(hi)); return r; }
__device__ __forceinline__ float lo2f(unsigned w) { return __uint_as_float(w << 16); }
__device__ __forceinline__ float hi2f(unsigned w) { return __uint_as_float(w & 0xffff0000u); }
__device__ __forceinline__ float dot2(unsigned a, unsigned b, float acc) { return __builtin_amdgcn_fdot2_f32_bf16(__builtin_bit_cast(bf16x2_t, a), __builtin_bit_cast(bf16x2_t, b), acc, false); }
#define GELU_C0 -1.0001451969146729f
#define GELU_C1 -1.1498452425003052f
#define GELU_C2 -0.46162763237953186f
#define GELU_C3 -0.051034148782491684f
#define GELU_C4 0.007168652955442667f
#define GELU_C5 -0.0006095620337873697f
#define GELU_C6 2.30170971917687e-05f
__device__ __forceinline__ float gelu_exact(float v) {
    const float a = fminf(fabsf(v), 6.0f);
    float q = GELU_C6 * a + GELU_C5; q = q * a + GELU_C4; q = q * a + GELU_C3; q = q * a + GELU_C2; q = q * a + GELU_C1; q = q * a + GELU_C0;
    return fmaxf(v, 0.f) - fabsf(v) * __builtin_amdgcn_exp2f(q);
}
typedef float f32x2 __attribute__((ext_vector_type(2)));
__device__ __forceinline__ f32x2 gelu_exact2(f32x2 v) {
    const f32x2 av = __builtin_elementwise_abs(v), a = __builtin_elementwise_min(av, (f32x2){6.0f, 6.0f});
    f32x2 q = (f32x2){GELU_C6, GELU_C6} * a + (f32x2){GELU_C5, GELU_C5};
    q = q * a + (f32x2){GELU_C4, GELU_C4}; q = q * a + (f32x2){GELU_C3, GELU_C3}; q = q * a + (f32x2){GELU_C2, GELU_C2};
    q = q * a + (f32x2){GELU_C1, GELU_C1}; q = q * a + (f32x2){GELU_C0, GELU_C0};
    const f32x2 e = {__builtin_amdgcn_exp2f(q[0]), __builtin_amdgcn_exp2f(q[1])};
    return __builtin_elementwise_max(v, (f32x2){0.f, 0.f}) - av * e;
}
__device__ __forceinline__ float row16_sum(float v) {
    v += __builtin_bit_cast(float, __builtin_amdgcn_update_dpp(0, __builtin_bit_cast(int, v), 0x128, 0xf, 0xf, false));
    v += __builtin_bit_cast(float, __builtin_amdgcn_update_dpp(0, __builtin_bit_cast(int, v), 0x124, 0xf, 0xf, false));
    v += __builtin_bit_cast(float, __builtin_amdgcn_update_dpp(0, __builtin_bit_cast(int, v), 0x122, 0xf, 0xf, false));
    v += __builtin_bit_cast(float, __builtin_amdgcn_update_dpp(0, __builtin_bit_cast(int, v), 0x121, 0xf, 0xf, false));
    return v;
}
__device__ __forceinline__ float wave_sum(float v) {
#pragma unroll
    for (int o = 32; o >= 1; o >>= 1) v += __shfl_xor(v, o);
    return v;
}

template <bool PERM_IN = false>
__device__ __forceinline__ void transpose_convert(const float* __restrict__ W, bf16_t* __restrict__ Wt, int K, int N, int Npad, char* smem, int vb0 = 0, const float* __restrict__ kgain = nullptr, unsigned char* __restrict__ W8 = nullptr, int f8from = 0) {
    float* tile = (float*)smem;
    const int tk = K / 64, tn = Npad / 64, ntile = tk * tn;
    const int tid = VTID;
    if (VBID < vb0) return;
    for (int tl = VBID - vb0; tl < ntile; tl += VGRID - vb0) {
        const int k0 = (tl % tk) * 64, n0 = (tl / tk) * 64;
        const int c = tid & 63, r0 = tid >> 6;
        int nd = n0;
        if (PERM_IN) { if (n0 >= 1024 && n0 < 1536) nd = n0 + 1024; else if (n0 >= 1536 && n0 < 2048) nd = n0 - 512; else if (n0 >= 2048 && n0 < 2560) nd = n0 + 512; else if (n0 >= 2560 && n0 < 3072) nd = n0 - 1024; }
#pragma unroll
        for (int i = 0; i < 16; ++i) {
            const int r = r0 + 4 * i;
            float v = (n0 + c < N) ? W[(size_t)(k0 + r) * N + n0 + c] : 0.f;
            if (kgain) v *= kgain[k0 + r];
            tile[c * 65 + r] = v;
        }
        __syncthreads();
#pragma unroll
        for (int i = 0; i < 16; ++i) {
            const int n = r0 + 4 * i;
            Wt[(size_t)(nd + n) * K + k0 + c] = f2bf(tile[n * 65 + c]);
            if (W8 && nd >= f8from) { const float w64 = tile[n * 65 + c] * 64.0f; W8[(size_t)(nd + n - f8from) * K + k0 + c] = (unsigned char)__builtin_amdgcn_cvt_pk_fp8_f32(w64, w64, 0, false); }
        }
        __syncthreads();
    }
}
__device__ __forceinline__ void quantize_tables_static(const Params& p, int vb0 = 0) {
    const int lane = VTID & 63, wid = VTID >> 6;
    if (VBID < vb0) return;
    for (unsigned task = (unsigned)(VBID - vb0); task < 512u; task += (unsigned)(VGRID - vb0)) {
        const bool isv = task >= 256u;
        const int r0 = (int)(task & 255u) * 128 + wid * 32;
        const float* src = isv ? p.peer_v : p.peer_u;
        unsigned char* recs = p.ws + OFF_UT;
        _Float16* sct = (_Float16*)(p.ws + OFF_USC);
        f32x4 vnx[4];
        {
            const float* x0 = src + (size_t)r0 * 1024 + lane * 16;
#pragma unroll
            for (int i = 0; i < 4; ++i) vnx[i] = *(const f32x4*)(x0 + i * 4);
        }
        for (int rr = 0; rr < 32; ++rr) {
            const int r = r0 + rr;
            f32x4 v[4]; float aml = 0.f;
#pragma unroll
            for (int i = 0; i < 4; ++i) {
                v[i] = vnx[i];
                aml = fmaxf(aml, fmaxf(fmaxf(fabsf(v[i][0]), fabsf(v[i][1])), fmaxf(fabsf(v[i][2]), fabsf(v[i][3]))));
            }
            if (rr + 1 < 32) {
                const float* xn = src + (size_t)(r + 1) * 1024 + lane * 16;
#pragma unroll
                for (int i = 0; i < 4; ++i) vnx[i] = *(const f32x4*)(xn + i * 4);
            }
#pragma unroll
            for (int o = 32; o >= 1; o >>= 1) aml = fmaxf(aml, __shfl_xor(aml, o));
            float ssq = 0.f;
#pragma unroll
            for (int i = 0; i < 4; ++i) ssq += (v[i][0] * v[i][0] + v[i][1] * v[i][1]) + (v[i][2] * v[i][2] + v[i][3] * v[i][3]);
            ssq = wave_sum(ssq);
            const float gmax = aml * (1.002f / 7.5f);
            const _Float16 hs = (_Float16)fminf(fmaxf(0.34f * sqrtf(ssq * (1.0f / 1024.0f)), 0.5f * gmax), gmax);
            const float gs_ = (float)hs, gi_ = gs_ > 0.f ? 1.0f / gs_ : 0.f;
            unsigned wd[2]; const int sgn = isv ? 0 : 8;
#pragma unroll
            for (int dd = 0; dd < 2; ++dd) {
                unsigned wv = 0;
#pragma unroll
                for (int b = 0; b < 4; ++b) {
                    const int qa = min(15, max(0, __float2int_rn(v[2 * dd][b] * gi_ + 7.5f)));
                    const int qb = min(15, max(0, __float2int_rn(v[2 * dd + 1][b] * gi_ + 7.5f)));
                    wv |= ((unsigned)(qa ^ sgn) | ((unsigned)(qb ^ sgn) << 4)) << (8 * b);
                }
                wd[dd] = wv;
            }
            unsigned char* rec = recs + (size_t)r * 1024;
            *(uint2*)(rec + (isv ? 512 : 0) + lane * 8) = make_uint2(wd[0], wd[1]);
            if (lane == 0) sct[(size_t)r * 2 + (isv ? 1 : 0)] = (_Float16)gs_;
        }
    }
}
__device__ __forceinline__ void rmsnorm_rows(const float* __restrict__ X, const float* __restrict__ g, bf16_t* __restrict__ Hout) {
    const int lane = VTID & 63, wid = VTID >> 6;
    const int gw = VBID * 4 + wid, nw = VGRID * 4;
    for (int t = gw; t < T; t += nw) {
        const float* xr = X + (size_t)t * D;
        float4 v[4]; float ss = 0.f;
#pragma unroll
        for (int i = 0; i < 4; ++i) { v[i] = *(const float4*)(xr + i * 256 + lane * 4); ss += v[i].x * v[i].x + v[i].y * v[i].y + v[i].z * v[i].z + v[i].w * v[i].w; }
        ss = wave_sum(ss);
        const float rstd = rsqrtf(ss * (1.0f / D) + EPS);
#pragma unroll
        for (int i = 0; i < 4; ++i) {
            const float4 gg = *(const float4*)(g + i * 256 + lane * 4);
            uint2 o; o.x = pack2(v[i].x * rstd * gg.x, v[i].y * rstd * gg.y); o.y = pack2(v[i].z * rstd * gg.z, v[i].w * rstd * gg.w);
            *(uint2*)(Hout + (size_t)t * D + i * 256 + lane * 4) = o;
        }
    }
}

__device__ __forceinline__ void store_bf16x4(bf16_t* p, f32x4 v) { uint2 o; o.x = pack2(v[0], v[1]); o.y = pack2(v[2], v[3]); *(uint2*)p = o; }

#define G8_LAS __attribute__((address_space(3)))
namespace g8 {
constexpr int BM = 256, BK = 64, HALF = 128, HTB = HALF * BK * 2, NXCD = 8, WGM = 8;
__device__ __forceinline__ int lds_byte(int r, int c) { const int st = (r >> 4) * 2 + (c >> 5), rr = r & 15, cc = c & 31, ob = rr * 64 + cc * 2; return st * 1024 + (ob ^ (((ob >> 9) & 1) << 5)); }
__device__ __forceinline__ void stage_rc(int b, int& R, int& C) { const int st = b / 1024, sb = b % 1024, swz = sb ^ (((sb >> 9) & 1) << 5); R = (st >> 1) * 16 + swz / 64; C = (st & 1) * 32 + (swz % 64) / 2; }
__device__ __forceinline__ int perm32(int rho) { const int n = rho >> 4, i = rho & 15; return 8 * (i >> 2) + 4 * n + (i & 3); }
struct Unit { int pm, pn; };
struct Gemm { const bf16_t* A0; const bf16_t* A1; int lda, ksplit; const bf16_t* Bt; int M, N, K; };
struct StaticOrder {
    int nM, nN, nwg, G, c;
    __device__ __forceinline__ void init(int M, int N, int G_, int c_) { nM = M / BM; nN = N / BM; nwg = nM * nN; G = G_; c = c_; }
    __device__ __forceinline__ bool next(int i, Unit& u) const {
        const int L = i * G + c; if (L >= nwg) return false;
        int wgid = L; { const int q = nwg / NXCD, r = nwg % NXCD, xcd = wgid % NXCD, off = wgid / NXCD; wgid = (xcd < r ? xcd * (q + 1) : r * (q + 1) + (xcd - r) * q) + off; }
        const int nig = WGM * nN, gid = wgid / nig, fm = gid * WGM, gsz = (nM - fm) < WGM ? (nM - fm) : WGM;
        u.pm = fm + ((wgid % nig) % gsz); u.pn = (wgid % nig) / gsz; return true;
    }
};
typedef int i32x4v __attribute__((ext_vector_type(4)));
typedef int i32x8v __attribute__((ext_vector_type(8)));
template <class Epi, bool F8 = false>
__device__ __forceinline__ void gemm_phase(G8_LAS unsigned char* lds, const Gemm g, const StaticOrder& S, const Epi& E) {
    const int tid = threadIdx.x, wid = __builtin_amdgcn_readfirstlane(tid >> 6), lane = tid & 63, wr = wid >> 2, wc = wid & 3, fr = lane & 15, fq = lane >> 4;
    const int K = g.K, nt = K / BK, lda = g.lda;
    unsigned voffA[2], voffB[2];
#pragma unroll
    for (int i = 0; i < 2; ++i) { int R, C; stage_rc(tid * 16 + i * 8192, R, C); const int Rb = (R & ~31) + perm32(R & 31);
        voffA[i] = (unsigned)(R * lda + C) * 2u; voffB[i] = (unsigned)(Rb * K + C) * 2u; }
    const size_t hstepA = (size_t)HALF * lda * 2, hstepB = (size_t)HALF * K * 2;
    const unsigned ldsw = (unsigned)wid * 1024u;
    const unsigned ldsbase = (unsigned)__builtin_amdgcn_readfirstlane((int)(unsigned)(__SIZE_TYPE__)lds);
    const int fcol = F8 ? 32 * (fq >> 1) + 24 * (fq & 1) : fq * 8;
    const int aoff = lds_byte(wr * 64 + fr, fcol), boff = lds_byte(wc * 32 + fr, fcol);
    const int aoff2 = F8 ? (aoff ^ 16) : aoff + 1024, boff2 = F8 ? (boff ^ 16) : boff + 1024;
    auto aptr = [&](int pm, int kt) -> const char* { const int kb = kt * BK; const bf16_t* b = kb < g.ksplit ? g.A0 + kb : g.A1 + (kb - g.ksplit); return (const char*)b + (size_t)pm * 2 * hstepA; };
    auto bptr = [&](int pn, int kt) -> const char* { return (const char*)(g.Bt + kt * BK) + (size_t)pn * 2 * hstepB; };
#define G8_SA(b, h) (((b) * 2 + (h)) * HTB)
#define G8_SB(b, h) ((4 + (b) * 2 + (h)) * HTB)
#define G8_STAGE(bufoff, gbase, voff) do { _Pragma("unroll") for (int _i = 0; _i < 2; ++_i) { \
        if constexpr (F8) { unsigned _keep; const unsigned _d = ldsbase + (unsigned)(bufoff) + ldsw + _i * 8192u; \
            const char* _gb = (const char*)(gbase) + (size_t)_i * ((voff) == voffA ? hstepA : hstepB) / 2;        \
            asm volatile("s_mov_b32 %0, m0\n\ts_mov_b32 m0, %3\n\ts_nop 0\n\tglobal_load_lds_dwordx4 %1, %2\n\ts_mov_b32 m0, %0" : "=&s"(_keep) : "v"((voff)[0]), "s"(_gb), "s"(_d) : "memory"); } \
        else __builtin_amdgcn_global_load_lds((const unsigned*)((const char*)(gbase) + (voff)[_i]), (G8_LAS unsigned*)(lds + (bufoff) + ldsw + _i * 8192), 16, 0, 0); } } while (0)
#define G8_LD1(d16, d32, addr0, addr1) do { if constexpr (F8) { const i32x4v _lo = *(const G8_LAS i32x4v*)(addr0), _hi = *(const G8_LAS i32x4v*)(addr1); \
            d32 = __builtin_shufflevector(_lo, _hi, 0, 1, 2, 3, 4, 5, 6, 7); } \
        else { d16[0] = *(const G8_LAS bf16x8*)(addr0); d16[1] = *(const G8_LAS bf16x8*)(addr1); } } while (0)
#define G8_LDA(dst, b, h) do { _Pragma("unroll") for (int m = 0; m < 4; ++m) G8_LD1(dst[m], dst##8[m], lds + G8_SA(b, h) + aoff + m * 2048, lds + G8_SA(b, h) + aoff2 + m * 2048); } while (0)
#define G8_LDB(dst, b, h) do { _Pragma("unroll") for (int n = 0; n < 2; ++n) G8_LD1(dst[n], dst##8[n], lds + G8_SB(b, h) + boff + n * 2048, lds + G8_SB(b, h) + boff2 + n * 2048); } while (0)
#define G8_MMA(ai, bj, At, Bt) do { __builtin_amdgcn_s_setprio(1); _Pragma("unroll") for (int m = 0; m < 4; ++m) _Pragma("unroll") for (int n = 0; n < 2; ++n) { \
        if constexpr (F8) acc[ai][bj][m][n] = __builtin_amdgcn_mfma_scale_f32_16x16x128_f8f6f4(Bt##8[n], At##8[m], acc[ai][bj][m][n], 0, 0, 0, sc1, 0, sc1); \
        else { _Pragma("unroll") for (int k = 0; k < 2; ++k) acc[ai][bj][m][n] = __builtin_amdgcn_mfma_f32_16x16x32_bf16(Bt[n][k], At[m][k], acc[ai][bj][m][n], 0, 0, 0); } } \
        __builtin_amdgcn_s_setprio(0); } while (0)
#define G8_WAIT_V(n) asm volatile("s_waitcnt vmcnt(" #n ")" ::: "memory")
#define G8_WAIT_L(n) asm volatile("s_waitcnt lgkmcnt(" #n ")" ::: "memory")
#define G8_BAR __builtin_amdgcn_s_barrier()
#define G8_SCHED __builtin_amdgcn_sched_barrier(0)
    Unit cur, nxt; int ui = 0;
    if (!S.next(0, cur)) return;
    int sc1 = 0x7f7f7f7f; asm volatile("" : "+v"(sc1));
    f32x4 acc[2][2][4][2];
#pragma unroll
    for (int a = 0; a < 2; ++a)
#pragma unroll
        for (int b = 0; b < 2; ++b)
#pragma unroll
            for (int m = 0; m < 4; ++m)
#pragma unroll
                for (int n = 0; n < 2; ++n) acc[a][b][m][n] = (f32x4){0.f, 0.f, 0.f, 0.f};
    bf16x8 At[4][2], B0[2][2], B1[2][2];
    i32x8v At8[4], B08[2], B18[2];
    {
        const char* cA = aptr(cur.pm, 0); const char* cB = bptr(cur.pn, 0); const char* cA1 = aptr(cur.pm, 1); const char* cB1 = bptr(cur.pn, 1);
        G8_STAGE(G8_SB(0, 0), cB, voffB); G8_STAGE(G8_SB(0, 1), cB + hstepB, voffB); G8_STAGE(G8_SA(0, 0), cA, voffA); G8_STAGE(G8_SA(0, 1), cA + hstepA, voffA);
        if (wr == 1) G8_BAR;
        G8_WAIT_V(2); G8_BAR;
        G8_STAGE(G8_SB(1, 0), cB1, voffB); G8_STAGE(G8_SA(1, 0), cA1, voffA); G8_STAGE(G8_SB(1, 1), cB1 + hstepB, voffB);
        G8_WAIT_V(6); G8_BAR;
    }
    for (;;) {
        const bool has_next = S.next(ui + 1, nxt);
        const int npm = has_next ? nxt.pm : cur.pm, npn = has_next ? nxt.pn : cur.pn;
#pragma unroll 1
        for (int t = 0; t < nt; t += 2) {
            const bool last = (t == nt - 2);
            const char* a1 = aptr(cur.pm, t + 1);
            const char* a2 = last ? aptr(npm, 0) : aptr(cur.pm, t + 2); const char* b2 = last ? bptr(npn, 0) : bptr(cur.pn, t + 2);
            const char* a3 = last ? aptr(npm, 1) : aptr(cur.pm, t + 3); const char* b3 = last ? bptr(npn, 1) : bptr(cur.pn, t + 3);
            G8_LDB(B0, 0, 0); G8_LDB(B1, 0, 1); G8_SCHED; G8_LDA(At, 0, 0); G8_STAGE(G8_SA(1, 1), a1 + hstepA, voffA);
            G8_WAIT_V(8); G8_WAIT_L(0); G8_BAR; G8_MMA(0, 0, At, B0); G8_MMA(0, 1, At, B1); G8_BAR; G8_SCHED;
            G8_LDA(At, 0, 1); G8_STAGE(G8_SB(0, 0), b2, voffB); G8_STAGE(G8_SB(0, 1), b2 + hstepB, voffB); G8_STAGE(G8_SA(0, 0), a2, voffA);
            G8_WAIT_V(8); G8_WAIT_L(0); G8_BAR; G8_MMA(1, 0, At, B0); G8_MMA(1, 1, At, B1); G8_BAR; G8_SCHED;
            G8_LDB(B0, 1, 0); G8_LDB(B1, 1, 1); G8_SCHED; G8_LDA(At, 1, 0); G8_STAGE(G8_SA(0, 1), a2 + hstepA, voffA);
            G8_WAIT_V(8); G8_WAIT_L(0); G8_BAR; G8_MMA(0, 0, At, B0); G8_MMA(0, 1, At, B1); G8_BAR; G8_SCHED;
            G8_LDA(At, 1, 1); G8_STAGE(G8_SB(1, 0), b3, voffB); G8_STAGE(G8_SB(1, 1), b3 + hstepB, voffB); G8_STAGE(G8_SA(1, 0), a3, voffA);
            G8_WAIT_V(8); G8_WAIT_L(0); G8_BAR; G8_MMA(1, 0, At, B0); G8_MMA(1, 1, At, B1); G8_BAR; G8_SCHED;
        }
        if (wr == 0) G8_BAR;
        E(acc, cur, wr, wc, fr, fq);
        if (!has_next) break;
#pragma unroll
        for (int a = 0; a < 2; ++a)
#pragma unroll
            for (int b = 0; b < 2; ++b)
#pragma unroll
                for (int m = 0; m < 4; ++m)
#pragma unroll
                    for (int n = 0; n < 2; ++n) acc[a][b][m][n] = (f32x4){0.f, 0.f, 0.f, 0.f};
        cur = nxt; ++ui;
        if (wr == 1) G8_BAR;
    }
    G8_WAIT_V(0);
    G8_BAR;
#undef G8_SA
#undef G8_SB
#undef G8_STAGE
#undef G8_LDA
#undef G8_LDB
#undef G8_MMA
#undef G8_LD1
#undef G8_WAIT_V
#undef G8_WAIT_L
#undef G8_BAR
#undef G8_SCHED
}
struct EpiResid {
    const float* R32; bf16_t* S; float* SSQP; unsigned char* S8;
    __device__ __forceinline__ void operator()(const f32x4 (&acc)[2][2][4][2], const Unit& u, int wr, int wc, int fr, int fq) const {
#pragma unroll
        for (int ai = 0; ai < 2; ++ai)
#pragma unroll
            for (int m = 0; m < 4; ++m) {
                const int row = u.pm * 256 + ai * 128 + wr * 64 + m * 16 + fr;
                const size_t o = (size_t)row * 1024 + u.pn * 256 + wc * 32 + fq * 8;
                float ss = 0.f;
#pragma unroll
                for (int bj = 0; bj < 2; ++bj) {
                    f32x4 a, b;
                    if (R32) { a = *(const f32x4*)(R32 + o + bj * 128); b = *(const f32x4*)(R32 + o + bj * 128 + 4); }
                    else { const u32x4 r = *(const u32x4*)(S + o + bj * 128); a = (f32x4){lo2f(r[0]), hi2f(r[0]), lo2f(r[1]), hi2f(r[1])}; b = (f32x4){lo2f(r[2]), hi2f(r[2]), lo2f(r[3]), hi2f(r[3])}; }
                    a += acc[ai][bj][m][0]; b += acc[ai][bj][m][1];
                    ss += a[0] * a[0] + a[1] * a[1] + a[2] * a[2] + a[3] * a[3] + b[0] * b[0] + b[1] * b[1] + b[2] * b[2] + b[3] * b[3];
                    uint4 w; w.x = pack2(a[0], a[1]); w.y = pack2(a[2], a[3]); w.z = pack2(b[0], b[1]); w.w = pack2(b[2], b[3]);
                    *(uint4*)(S + o + bj * 128) = w;
                    { int p0 = __builtin_amdgcn_cvt_pk_fp8_f32(a[0], a[1], 0, false); p0 = __builtin_amdgcn_cvt_pk_fp8_f32(a[2], a[3], p0, true);
                      int p1 = __builtin_amdgcn_cvt_pk_fp8_f32(b[0], b[1], 0, false); p1 = __builtin_amdgcn_cvt_pk_fp8_f32(b[2], b[3], p1, true);
                      *(uint2*)(S8 + o + bj * 128) = make_uint2((unsigned)p0, (unsigned)p1); }
                }
                ss += __shfl_xor(ss, 16); ss += __shfl_xor(ss, 32);
                if (fq == 0) SSQP[(size_t)row * 32 + u.pn * 4 + wc] = ss;
            }
    }
};
struct EpiCinUS {
    bf16_t* U; const bf16_t* VT; const float* SSQ; const float* Wsp; const float* bsp; const float* vnorm; G8_LAS unsigned char* L; const float* RSTD;
    __device__ __forceinline__ void operator()(const f32x4 (&acc)[2][2][4][2], const Unit& u, int wr, int wc, int fr, int fq) const {
        const int tid = threadIdx.x, g = u.pn;
        G8_LAS float* RS = (G8_LAS float*)(L + 24576);
        unsigned gu[2][2][4][4];
#pragma unroll
        for (int ai = 0; ai < 2; ++ai)
#pragma unroll
            for (int bj = 0; bj < 2; ++bj)
#pragma unroll
                for (int m = 0; m < 4; ++m) {
                    const float rs = RSTD[u.pm * 256 + ai * 128 + wr * 64 + m * 16 + fr];
                    const f32x4 a = acc[ai][bj][m][0] * rs, b = acc[ai][bj][m][1] * rs;
                    const f32x2 g0 = gelu_exact2((f32x2){a[0], a[1]}), g1 = gelu_exact2((f32x2){a[2], a[3]}), g2 = gelu_exact2((f32x2){b[0], b[1]}), g3 = gelu_exact2((f32x2){b[2], b[3]});
                    gu[ai][bj][m][0] = pack2(g0[0], g0[1]); gu[ai][bj][m][1] = pack2(g1[0], g1[1]); gu[ai][bj][m][2] = pack2(g2[0], g2[1]); gu[ai][bj][m][3] = pack2(g3[0], g3[1]);
                }
        if (tid < 256) {
            const float* sp = SSQ + (size_t)(u.pm * 256 + tid) * 32;
            f32x4 s4 = *(const f32x4*)sp;
#pragma unroll
            for (int i = 1; i < 8; ++i) s4 += *(const f32x4*)(sp + 4 * i);
            RS[tid] = rsqrtf(((s4[0] + s4[1]) + (s4[2] + s4[3])) * (1.0f / 2048.0f) + EPS);
        }
        __syncthreads();
#pragma unroll
        for (int ai = 0; ai < 2; ++ai) {
            const int chunk = u.pm * 2 + ai;
            {
                const int t1 = tid >> 3, c1 = tid & 7;
#pragma unroll
                for (int part = 0; part < 3; ++part) {
                    const int t = part == 0 ? t1 : 64 + ((tid + (part - 1) * 512) >> 4), ch = part == 0 ? c1 : ((tid + (part - 1) * 512) & 15), s0 = ch * 8;
                    const float* wp = Wsp + (size_t)(g * 128 + t) * 128 + s0;
                    const f32x4 w0 = *(const f32x4*)wp, w1 = *(const f32x4*)(wp + 4);
                    const f32x4 r0 = *(const G8_LAS f32x4*)(RS + ai * 128 + s0), r1 = *(const G8_LAS f32x4*)(RS + ai * 128 + s0 + 4);
                    float v[8];
#pragma unroll
                    for (int j = 0; j < 4; ++j) { v[j] = (s0 + j <= t) ? w0[j] * r0[j] : 0.f; v[4 + j] = (s0 + 4 + j <= t) ? w1[j] * r1[j] : 0.f; }
                    u32x4 o; o.x = pack2(v[0], v[1]); o.y = pack2(v[2], v[3]); o.z = pack2(v[4], v[5]); o.w = pack2(v[6], v[7]);
                    const int off = part == 0 ? t * 128 + ((ch ^ (t & 7)) << 4) : 8192 + (t - 64) * 256 + ((ch ^ (t & 7)) << 4);
                    *(G8_LAS u32x4*)(L + off) = o;
                }
            }
            __syncthreads();
            float bias[4];
#pragma unroll
            for (int m = 0; m < 4; ++m) bias[m] = bsp[g * 128 + wr * 64 + m * 16 + fr];
#pragma unroll
            for (int bj = 0; bj < 2; ++bj) {
                f32x4 mac[4][2];
#pragma unroll
                for (int m = 0; m < 4; ++m)
#pragma unroll
                    for (int n = 0; n < 2; ++n) mac[m][n] = (f32x4){0.f, 0.f, 0.f, 0.f};
                const int cb = u.pn * 256 + bj * 128 + wc * 32;
                const bf16_t* vrow0 = VT + ((size_t)chunk * 2048 + cb + perm32(fr)) * 128 + fq * 8;
                const bf16_t* vrow1 = VT + ((size_t)chunk * 2048 + cb + perm32(16 + fr)) * 128 + fq * 8;
                bf16x8 bf0[4], bf1[4];
#pragma unroll
                for (int kk = 0; kk < 4; ++kk) { if (kk < 2 || wr == 1) { bf0[kk] = *(const bf16x8*)(vrow0 + kk * 32); bf1[kk] = *(const bf16x8*)(vrow1 + kk * 32); } }
#pragma unroll
                for (int kk = 0; kk < 4; ++kk) {
                    if (kk < 2 || wr == 1) {
                        bf16x8 af[4];
#pragma unroll
                        for (int m = 0; m < 4; ++m) {
                            const int t = wr * 64 + m * 16 + fr, chn = kk * 4 + fq;
                            const int off = wr == 0 ? t * 128 + ((chn ^ (t & 7)) << 4) : 8192 + (t - 64) * 256 + ((chn ^ (t & 7)) << 4);
                            af[m] = *(const G8_LAS bf16x8*)(L + off);
                        }
#pragma unroll
                        for (int m = 0; m < 4; ++m) {
                            mac[m][0] = __builtin_amdgcn_mfma_f32_16x16x32_bf16(bf0[kk], af[m], mac[m][0], 0, 0, 0);
                            mac[m][1] = __builtin_amdgcn_mfma_f32_16x16x32_bf16(bf1[kk], af[m], mac[m][1], 0, 0, 0);
                        }
                    }
                }
                const f32x4 vn0 = *(const f32x4*)(vnorm + cb + fq * 8), vn1 = *(const f32x4*)(vnorm + cb + fq * 8 + 4);
#pragma unroll
                for (int m = 0; m < 4; ++m) {
                    const f32x4 x0 = vn0 * mac[m][0] + bias[m], x1 = vn1 * mac[m][1] + bias[m];
                    const unsigned q0 = gu[ai][bj][m][0], q1 = gu[ai][bj][m][1], q2 = gu[ai][bj][m][2], q3 = gu[ai][bj][m][3];
                    uint4 o; o.x = pack2(lo2f(q0) * x0[0], hi2f(q0) * x0[1]); o.y = pack2(lo2f(q1) * x0[2], hi2f(q1) * x0[3]); o.z = pack2(lo2f(q2) * x1[0], hi2f(q2) * x1[1]); o.w = pack2(lo2f(q3) * x1[2], hi2f(q3) * x1[3]);
                    *(uint4*)(U + (size_t)(u.pm * 256 + ai * 128 + wr * 64 + m * 16 + fr) * 2048 + cb + fq * 8) = o;
                }
            }
            __syncthreads();
        }
    }
};
struct EpiCinV {
    bf16_t* VT; float* SSQ; const float* RSTD;
    __device__ __forceinline__ void operator()(const f32x4 (&acc)[2][2][4][2], const Unit& u, int wr, int wc, int fr_, int fq_) const {
        int lz = 0; asm volatile("" : "+v"(lz));
        const int lane_ = (int)(threadIdx.x & 63) + lz, fr = lane_ & 15, fq = lane_ >> 4; (void)fr_; (void)fq_;
        f32x4 rs[2][2];
#pragma unroll
        for (int bj = 0; bj < 2; ++bj)
#pragma unroll
            for (int n = 0; n < 2; ++n) rs[bj][n] = *(const f32x4*)(RSTD + u.pn * 256 + bj * 128 + wc * 32 + fq * 8 + n * 4) * (1.0f / 64.0f);
#pragma unroll
        for (int ai = 0; ai < 2; ++ai) {
            float ss[16];
#pragma unroll
            for (int i = 0; i < 16; ++i) ss[i] = 0.f;
#pragma unroll
            for (int m = 0; m < 4; ++m) {
                const int c = u.pm * 256 + ai * 128 + wr * 64 + m * 16 + fr;
#pragma unroll
                for (int bj = 0; bj < 2; ++bj) {
                    float g[8];
#pragma unroll
                    for (int n = 0; n < 2; ++n)
#pragma unroll
                        for (int r = 0; r < 4; r += 2) {
                            const f32x2 x = gelu_exact2((f32x2){acc[ai][bj][m][n][r] * rs[bj][n][r], acc[ai][bj][m][n][r + 1] * rs[bj][n][r + 1]});
                            g[n * 4 + r] = x[0]; g[n * 4 + r + 1] = x[1]; ss[bj * 8 + n * 4 + r] += x[0] * x[0]; ss[bj * 8 + n * 4 + r + 1] += x[1] * x[1];
                        }
                    uint4 o; o.x = pack2(g[0], g[1]); o.y = pack2(g[2], g[3]); o.z = pack2(g[4], g[5]); o.w = pack2(g[6], g[7]);
                    *(uint4*)(VT + ((size_t)(u.pn * 2 + bj) * 2048 + c) * 128 + wc * 32 + fq * 8) = o;
                }
            }
            float mine = 0.f;
#pragma unroll
            for (int i = 0; i < 16; ++i) { const float s = row16_sum(ss[i]); mine = (fr == i) ? s : mine; }
            const int tok = u.pn * 256 + (fr >> 3) * 128 + wc * 32 + fq * 8 + (fr & 7);
            SSQ[(size_t)tok * 32 + u.pm * 4 + ai * 2 + wr] = mine;
        }
    }
};
struct EpiInN {
    bf16_t* R;
    __device__ __forceinline__ void operator()(const f32x4 (&acc)[2][2][4][2], const Unit& u, int wr, int wc, int fr, int fq) const {
        bf16_t* base; int pitch; float sc = 1.0f;
        if (u.pn < 2) { base = R + R_QSB + u.pn * 256; pitch = 512; sc = 0.125f; }
        else if (u.pn < 4) { base = R + R_KSB + (u.pn - 2) * 256; pitch = 512; }
        else if (u.pn == 4) { base = R + R_QG; pitch = 256; }
        else if (u.pn == 5) { base = R + R_KG; pitch = 256; }
        else { base = R + R_GG + (u.pn - 6) * 256; pitch = 512; }
#pragma unroll
        for (int ai = 0; ai < 2; ++ai)
#pragma unroll
            for (int m = 0; m < 4; ++m) {
                bf16_t* rp = base + (size_t)(u.pm * 256 + ai * 128 + wr * 64 + m * 16 + fr) * pitch + wc * 32 + fq * 8;
#pragma unroll
                for (int bj = 0; bj < 2; ++bj) {
                    f32x4 a = acc[ai][bj][m][0] * sc, b = acc[ai][bj][m][1] * sc;
                    if (u.pn >= 6) {
#pragma unroll
                        for (int r = 0; r < 4; ++r) { a[r] = a[r] * __builtin_amdgcn_rcpf(1.0f + __expf(-a[r])); b[r] = b[r] * __builtin_amdgcn_rcpf(1.0f + __expf(-b[r])); }
                    }
                    uint4 o; o.x = pack2(a[0], a[1]); o.y = pack2(a[2], a[3]); o.z = pack2(b[0], b[1]); o.w = pack2(b[2], b[3]);
                    *(uint4*)(rp + bj * 128) = o;
                }
            }
    }
};
struct EpiInT {
    bf16_t* R;
    __device__ __forceinline__ void operator()(const f32x4 (&acc)[2][2][4][2], const Unit& u, int wr, int wc, int fr, int fq) const {
#pragma unroll
        for (int ai = 0; ai < 2; ++ai)
#pragma unroll
            for (int m = 0; m < 4; ++m) {
                const int c = u.pm * 256 + ai * 128 + wr * 64 + m * 16 + fr;
#pragma unroll
                for (int bj = 0; bj < 2; ++bj) {
                    const int t = u.pn * 256 + bj * 128 + wc * 32 + fq * 8, b = t >> 11, s = t & 2047;
                    bf16_t* dst;
                    if (c < 512) dst = R + R_VTSB + ((size_t)((b * 8 + (c >> 6)) * 64 + (c & 63))) * 2048 + s;
                    else { const int c2 = c - 512; dst = R + R_VTG + ((size_t)((b * 4 + (c2 >> 7)) * 128 + (c2 & 127))) * 2048 + s; }
                    const f32x4 a = acc[ai][bj][m][0], bb = acc[ai][bj][m][1];
                    uint4 o; o.x = pack2(a[0], a[1]); o.y = pack2(a[2], a[3]); o.z = pack2(bb[0], bb[1]); o.w = pack2(bb[2], bb[3]);
                    *(uint4*)dst = o;
                }
            }
    }
};
}
__device__ __forceinline__ void phase_gemm_resid8(const bf16_t* A0, const bf16_t* A1, int lda, int ksplit, const bf16_t* Bt, int K, const float* R32, bf16_t* Sres, float* SSQP, unsigned char* S8, char* smem_phys) {
    g8::Gemm g{A0, A1, lda, ksplit, Bt, T, 1024, K};
    g8::StaticOrder S; S.init(T, 1024, (int)gridDim.x, (int)blockIdx.x);
    g8::EpiResid E{R32, Sres, SSQP, S8};
    g8::gemm_phase<g8::EpiResid>((G8_LAS unsigned char*)smem_phys, g, S, E);
}

__device__ __forceinline__ void phase_gemm_cin8_v(const Params& p, char* smem_phys) {
    bf16_t* U = (bf16_t*)(p.ws + OFF_REGION); bf16_t* VT = U + (size_t)T * 2048; float* SSQ = (float*)(p.ws + OFF_SSQ);
    const bf16_t* Wv = (const bf16_t*)(p.ws + OFF_SK_W8); const bf16_t* H8 = (const bf16_t*)(p.ws + OFF_H + ((size_t)32 << 20));
    g8::Gemm g{Wv, Wv, 512, 512, H8, 2048, T, 512};
    g8::StaticOrder S; S.init(2048, T, (int)gridDim.x, (int)blockIdx.x);
    g8::EpiCinV E{VT, SSQ, (const float*)(p.ws + OFF_VSC)};
    g8::gemm_phase<g8::EpiCinV, true>((G8_LAS unsigned char*)smem_phys, g, S, E);
}
__device__ __forceinline__ void phase_gemm_cin8_u(const Params& p, char* smem_phys) {
    const bf16_t* H = (const bf16_t*)(p.ws + OFF_S); const bf16_t* W = (const bf16_t*)(p.ws + OFF_WT_CIN);
    bf16_t* U = (bf16_t*)(p.ws + OFF_REGION); bf16_t* VT = U + (size_t)T * 2048; float* SSQ = (float*)(p.ws + OFF_SSQ);
    g8::Gemm g{H, H, 1024, 1024, W, T, 2048, 1024};
    g8::StaticOrder S; S.init(T, 2048, (int)gridDim.x, (int)blockIdx.x);
    g8::EpiCinUS E{U, VT, SSQ, p.c_w_spatial, p.c_b_spatial, p.c_v_norm, (G8_LAS unsigned char*)(smem_phys + 131072), (const float*)(p.ws + OFF_VSC)};
    g8::gemm_phase<g8::EpiCinUS>((G8_LAS unsigned char*)smem_phys, g, S, E);
}
__device__ __forceinline__ void phase_gemm_in8(const Params& p, char* smem_phys) {
    const bf16_t* H = (const bf16_t*)(p.ws + OFF_H); const bf16_t* W = (const bf16_t*)(p.ws + OFF_WT_IN);
    bf16_t* R = (bf16_t*)(p.ws + OFF_REGION);
    {
        g8::Gemm g{H, H, 1024, 1024, W, T, 2048, 1024};
        g8::StaticOrder S; S.init(T, 2048, (int)gridDim.x, (int)blockIdx.x);
        g8::EpiInN E{R};
        g8::gemm_phase<g8::EpiInN>((G8_LAS unsigned char*)smem_phys, g, S, E);
    }
    {
        const bf16_t* Wv = W + (size_t)2048 * 1024;
        g8::Gemm g{Wv, Wv, 1024, 1024, H, 1024, T, 1024};
        g8::StaticOrder S; S.init(1024, T, (int)gridDim.x, (int)blockIdx.x);
        g8::EpiInT E{R};
        g8::gemm_phase<g8::EpiInT>((G8_LAS unsigned char*)smem_phys, g, S, E);
    }
    {
        const int lane = threadIdx.x & 63, wid = threadIdx.x >> 6, fr = lane & 15, fq = lane >> 4;
        float* ALR = (float*)(R + R_ALR);
        for (int task = (int)blockIdx.x * 8 + wid; task < T / 16; task += (int)gridDim.x * 8) {
            const bf16_t* a = H + (size_t)(task * 16 + fr) * 1024 + fq * 8; const bf16_t* w = W + (size_t)(3072 + fr) * 1024 + fq * 8;
            f32x4 acc = (f32x4){0.f, 0.f, 0.f, 0.f};
#pragma unroll 8
            for (int kk = 0; kk < 32; ++kk) {
                const bf16x8 af = *(const bf16x8*)(a + kk * 32), wf = *(const bf16x8*)(w + kk * 32);
                acc = __builtin_amdgcn_mfma_f32_16x16x32_bf16(wf, af, acc, 0, 0, 0);
            }
            *(f32x4*)(ALR + (size_t)(task * 16 + fr) * 16 + fq * 4) = acc;
        }
    }
}


typedef float f32x16 __attribute__((ext_vector_type(16)));
__device__ __forceinline__ void sb_fast(const Params& p, char* smem, unsigned* ctr) {
    bf16_t* R = (bf16_t*)(p.ws + OFF_REGION);
    char* KT = smem; char* VTt = smem + 8192;
    volatile int* flags = (volatile int*)(smem + 32768); volatile unsigned* slot = (volatile unsigned*)(smem + 32832);
    const int tid = threadIdx.x, lane = tid & 63, w = tid >> 6, r31 = lane & 31, h = lane >> 5;
    for (;;) {
        __syncthreads();
        if (tid == 0) *slot = atomicAdd(ctr, 1u);
        __syncthreads();
        const unsigned task = *slot;
        if (task >= 1024u) break;
        const int qblk = 7 - (int)(task >> 7), bh = task & 127, b = bh >> 3, hh = bh & 7;
        const int q0 = qblk * 256, qbase = q0 + 32 * w;
        bf16_t* qrow = R + R_QSB + (size_t)(b * 2048 + qbase + r31) * 512 + hh * 64;
        bf16x8 qf[4];
#pragma unroll
        for (int kk = 0; kk < 4; ++kk) qf[kk] = *(const bf16x8*)(qrow + 16 * kk + 8 * h);
        f32x16 oacc[2];
#pragma unroll
        for (int nt = 0; nt < 2; ++nt)
#pragma unroll
            for (int i = 0; i < 16; ++i) oacc[nt][i] = 0.f;
        float Rr = 1.0f;
        const int t = qbase + r31;
        for (int kt = q0 / 64 + 3; kt >= 0; --kt) {
            __syncthreads();
            { const int wd = __all(Rr == 0.f); if (lane == 0) flags[w] = wd; }
            __syncthreads();
            if (flags[0] & flags[1] & flags[2] & flags[3] & flags[4] & flags[5] & flags[6] & flags[7]) break;
            const int s_tile = kt * 64;
            {
                const int c = tid, row = c >> 3, ch = c & 7;
                const u32x4 kv = *(const u32x4*)(R + R_KSB + (size_t)(b * 2048 + s_tile + row) * 512 + hh * 64 + ch * 8);
                const u32x4 vv = *(const u32x4*)(R + R_VTSB + ((size_t)((b * 8 + hh) * 64 + row)) * 2048 + s_tile + ch * 8);
                *(u32x4*)(KT + row * 128 + ((ch ^ (row & 7)) << 4)) = kv;
                *(uint2*)(VTt + row * 136 + ch * 16) = make_uint2(vv[0], vv[1]);
                *(uint2*)(VTt + row * 136 + ch * 16 + 8) = make_uint2(vv[2], vv[3]);
            }
            __syncthreads();
#pragma unroll
            for (int sbk = 1; sbk >= 0; --sbk) {
                const int key_lo = s_tile + 32 * sbk;
                if (key_lo >= qbase + 31) continue;
                if (__all(Rr == 0.f)) continue;
                f32x16 st;
#pragma unroll
                for (int i = 0; i < 16; ++i) st[i] = 0.f;
                const int krow = 32 * sbk + r31;
#pragma unroll
                for (int kk = 0; kk < 4; ++kk) {
                    const bf16x8 kf = *(const bf16x8*)(KT + krow * 128 + (((2 * kk + h) ^ (krow & 7)) << 4));
                    st = __builtin_amdgcn_mfma_f32_32x32x16_bf16(kf, qf[kk], st, 0, 0, 0);
                }
                float a[16], G[4];
                const bool diag = key_lo + 31 >= qbase;
#pragma unroll
                for (int g = 0; g < 4; ++g) {
                    float sg[4], m[4];
#pragma unroll
                    for (int i = 0; i < 4; ++i) {
                        const float z = fmaxf(st[4 * g + i], -80.f);
                        const float ez = __builtin_amdgcn_exp2f(z * -1.4426950409f), sig = __builtin_amdgcn_rcpf(1.0f + ez);
                        sg[i] = sig; m[i] = ez * sig;
                    }
                    if (diag) {
#pragma unroll
                        for (int i = 0; i < 4; ++i) { const bool valid = key_lo + 8 * g + 4 * h + i < t; sg[i] = valid ? sg[i] : 0.f; m[i] = valid ? m[i] : 1.0f; }
                    }
                    const float x2 = m[3], x1 = x2 * m[2], x0 = x1 * m[1];
                    G[g] = x0 * m[0];
                    a[4 * g + 3] = sg[3]; a[4 * g + 2] = sg[2] * x2; a[4 * g + 1] = sg[1] * x1; a[4 * g] = sg[0] * x0;
                }
                float Go[4], P[4];
#pragma unroll
                for (int g = 0; g < 4; ++g) { Go[g] = __shfl_xor(G[g], 32); P[g] = G[g] * Go[g]; }
                const float c2 = P[3], c1 = c2 * P[2], c0 = c1 * P[1];
                float Tg[4];
                Tg[3] = Rr; Tg[2] = Rr * c2; Tg[1] = Rr * c1; Tg[0] = Rr * c0;
#pragma unroll
                for (int g = 0; g < 4; ++g) {
                    const float tg = (h == 0) ? Tg[g] * Go[g] : Tg[g];
                    a[4 * g] *= tg; a[4 * g + 1] *= tg; a[4 * g + 2] *= tg; a[4 * g + 3] *= tg;
                }
                Rr = Rr * c0 * P[0];
#pragma unroll
                for (int s2 = 0; s2 < 2; ++s2) {
                    union { bf16x8 v; unsigned u[4]; } af;
#pragma unroll
                    for (int j2 = 0; j2 < 4; ++j2) af.u[j2] = pack2(a[8 * s2 + 2 * j2], a[8 * s2 + 2 * j2 + 1]);
#pragma unroll
                    for (int nt = 0; nt < 2; ++nt) {
                        const char* vp = VTt + (32 * nt + r31) * 136 + 64 * sbk + 32 * s2 + 8 * h;
                        union { bf16x8 v; uint2 hh2[2]; } vf;
                        vf.hh2[0] = *(const uint2*)vp; vf.hh2[1] = *(const uint2*)(vp + 16);
                        oacc[nt] = __builtin_amdgcn_mfma_f32_32x32x16_bf16(af.v, vf.v, oacc[nt], 0, 0, 0);
                    }
                }
            }
        }
#pragma unroll
        for (int nt = 0; nt < 2; ++nt)
#pragma unroll
            for (int i = 0; i < 16; ++i) {
                const int qq = (i & 3) + 8 * (i >> 2) + 4 * h;
                R[R_QSB + (size_t)(b * 2048 + qbase + qq) * 512 + hh * 64 + 32 * nt + r31] = f2bf(oacc[nt][i]);
            }
    }
}
__device__ __forceinline__ float log_sigmoid(float x) { return fminf(x, 0.f) - __logf(1.0f + __expf(-fabsf(x))); }
__device__ __forceinline__ int swz(int row, int chunk) { return row * 128 + ((chunk ^ (row & 7)) << 4); }
__device__ __forceinline__ void gla_prep(const Params& p, char* smem) {
    bf16_t* R = (bf16_t*)(p.ws + OFF_REGION);
    const float* ALR = (const float*)(R + R_ALR);
    bf16_t* KOTg = R + R_KOT; float* DECg = (float*)(R + R_DEC);
    float* SEG = (float*)smem; float* ALRs = SEG + 256;
    const int tid = VTID, d = tid & 63, w = tid >> 6;
    for (int task = VBID; task < 2048; task += VGRID) {
        const int bh = task >> 5, c = task & 31, b = bh >> 2, hh = bh & 3;
        const size_t rowbase = (size_t)b * 2048 + c * 64;
        unsigned qr[16], kr[16];
#pragma unroll
        for (int i = 0; i < 16; ++i) { const size_t row = rowbase + w * 16 + i; qr[i] = R[R_QG + row * 256 + hh * 64 + d]; kr[i] = R[R_KG + row * 256 + hh * 64 + d]; }
        const f32x4 ar = *(const f32x4*)(ALR + rowbase * 16 + tid * 4);
        float w2r[16];
#pragma unroll
        for (int r = 0; r < 16; ++r) w2r[r] = p.ab_w_alpha2[r * 256 + hh * 64 + d];
        const float b2r = p.ab_b_alpha2[hh * 64 + d];
        __syncthreads();
        *(f32x4*)(ALRs + tid * 4) = ar;
        __syncthreads();
        float cs[16]; float run = 0.f;
#pragma unroll
        for (int i = 0; i < 16; ++i) {
            const float* al = ALRs + (w * 16 + i) * 16;
            float pre = b2r;
#pragma unroll
            for (int r = 0; r < 16; ++r) pre += al[r] * w2r[r];
            run += log_sigmoid(pre) * (1.0f / 16.0f);
            cs[i] = run;
        }
        SEG[w * 64 + d] = run;
        __syncthreads();
        float off = 0.f, tot = 0.f;
#pragma unroll
        for (int w2 = 0; w2 < 4; ++w2) { const float s = SEG[w2 * 64 + d]; tot += s; if (w2 < w) off += s; }
        unsigned kop[8];
#pragma unroll
        for (int i2 = 0; i2 < 8; ++i2) {
            float kov[2];
#pragma unroll
            for (int u = 0; u < 2; ++u) {
                const int i = 2 * i2 + u;
                const float bc = off + cs[i];
                const float kv = bf2f((bf16_t)kr[i]);
                const size_t row = rowbase + w * 16 + i;
                R[R_QG + row * 256 + hh * 64 + d] = f2bf(bf2f((bf16_t)qr[i]) * 0.125f * __expf(bc));
                R[R_KG + row * 256 + hh * 64 + d] = f2bf(kv * __expf(-bc));
                kov[u] = kv * __expf(tot - bc);
            }
            kop[i2] = pack2(kov[0], kov[1]);
        }
        bf16_t* kp = KOTg + ((size_t)task * 64 + d) * 64 + w * 16;
        *(uint4*)kp = make_uint4(kop[0], kop[1], kop[2], kop[3]);
        *(uint4*)(kp + 8) = make_uint4(kop[4], kop[5], kop[6], kop[7]);
        if (w == 0) DECg[(size_t)task * 64 + d] = __expf(tot);
    }
}
__device__ __forceinline__ void gla_scan(const Params& p, char* smem, bool dry = false) {
    bf16_t* R = (bf16_t*)(p.ws + OFF_REGION);
    const bf16_t* KOTg = R + R_KOT; const float* DECg = (const float*)(R + R_DEC);
    char* QS = smem; char* KS = smem + 8192; char* KOT = smem + 16384; char* VTs = smem + 24576; char* SPT = smem + 40960;
    float* DEC = (float*)(smem + 57344); float* GN = DEC + 64;
    const int tid = VTID, lane = tid & 63, w = tid >> 6, l15_ = lane & 15, q4 = lane >> 4;
    for (int task = VBID; task < 64; task += VGRID) {
        const int b = task >> 2, hh = task & 3;
        f32x4 Sacc[8];
#pragma unroll
        for (int nt = 0; nt < 8; ++nt) Sacc[nt] = (f32x4){0.f, 0.f, 0.f, 0.f};
        __syncthreads();
        for (int i = tid; i < 1024; i += 256) *(uint4*)(SPT + i * 16) = make_uint4(0, 0, 0, 0);
        if (tid < 128) GN[tid] = p.ab_gla_norm[hh * 128 + tid];
        const size_t rowbase = (size_t)b * 2048;
        const bf16_t* vbase = R + R_VTG + ((size_t)((b * 4 + hh) * 128)) * 2048;
        u32x4 tq[2], tk[2], tko[2], vr[4]; float td = 0.f;
        auto prefetch = [&](int c) {
            const int t0 = c * 64;
#pragma unroll
            for (int i = 0; i < 2; ++i) {
                const int cid = tid + 256 * i, row = cid >> 3, ch = cid & 7;
                tq[i] = *(const u32x4*)(R + R_QG + (rowbase + t0 + row) * 256 + hh * 64 + ch * 8);
                tk[i] = *(const u32x4*)(R + R_KG + (rowbase + t0 + row) * 256 + hh * 64 + ch * 8);
                tko[i] = *(const u32x4*)(KOTg + (((size_t)task * 32 + c) * 64 + row) * 64 + ch * 8);
            }
#pragma unroll
            for (int i = 0; i < 4; ++i) { const int cid = tid + 256 * i, e = cid >> 3, ch = cid & 7; vr[i] = *(const u32x4*)(vbase + (size_t)e * 2048 + t0 + ch * 8); }
            if (tid < 64) td = DECg[((size_t)task * 32 + c) * 64 + tid];
        };
        prefetch(0);
        for (int c = 0; c < 32; ++c) {
            int lz = 0; asm volatile("" : "+v"(lz));
            const int l15 = l15_ + lz;
            const int cx = (q4 ^ (l15 & 7)) << 4;
            const int rb0 = l15 * 128 + cx, rb1 = l15 * 128 + (cx ^ 64);
#pragma unroll
            for (int i = 0; i < 2; ++i) {
                const int cid = tid + 256 * i + lz, row = cid >> 3, ch = cid & 7;
                *(u32x4*)(QS + swz(row, ch)) = tq[i]; *(u32x4*)(KS + swz(row, ch)) = tk[i]; *(u32x4*)(KOT + swz(row, ch)) = tko[i];
            }
#pragma unroll
            for (int i = 0; i < 4; ++i) { const int cid = tid + 256 * i + lz, e = cid >> 3, ch = cid & 7; *(u32x4*)(VTs + swz(e, ch)) = vr[i]; }
            if (tid < 64) DEC[tid] = td;
            uint2 gr[8];
            const unsigned goff = (unsigned)((rowbase + c * 64 + 16 * w + l15) * 512 + hh * 128 + 4 * q4);
            bf16_t* const gbase = R + R_GG;
#pragma unroll
            for (int nt = 0; nt < 8; ++nt) gr[nt] = *(const uint2*)(gbase + (goff + 16 * nt));
            if (c + 1 < 32) prefetch(c + 1);
            __syncthreads();
            bf16x8 qf[2];
#pragma unroll
            for (int kk = 0; kk < 2; ++kk) qf[kk] = *(const bf16x8*)(QS + w * 2048 + (kk ? rb1 : rb0));
            f32x4 sT[4];
#pragma unroll
            for (int st = 0; st < 4; ++st) {
                sT[st] = (f32x4){0.f, 0.f, 0.f, 0.f};
                if (st <= w) {
#pragma unroll
                    for (int kk = 0; kk < 2; ++kk) { const bf16x8 kf = *(const bf16x8*)(KS + st * 2048 + (kk ? rb1 : rb0)); sT[st] = __builtin_amdgcn_mfma_f32_16x16x32_bf16(kf, qf[kk], sT[st], 0, 0, 0); }
#pragma unroll
                    for (int r = 0; r < 4; ++r) if (16 * st + 4 * q4 + r > 16 * w + l15) sT[st][r] = 0.f;
                }
            }
            bf16x8 af[2];
#pragma unroll
            for (int ks2 = 0; ks2 < 2; ++ks2) {
                union { bf16x8 v; unsigned u[4]; } cv;
                cv.u[0] = pack2(sT[2 * ks2][0], sT[2 * ks2][1]); cv.u[1] = pack2(sT[2 * ks2][2], sT[2 * ks2][3]);
                cv.u[2] = pack2(sT[2 * ks2 + 1][0], sT[2 * ks2 + 1][1]); cv.u[3] = pack2(sT[2 * ks2 + 1][2], sT[2 * ks2 + 1][3]);
                af[ks2] = cv.v;
            }
            const int vb = l15 * 128 + ((((q4 >> 1) ^ (l15 & 7)) << 4) | ((q4 & 1) * 8));
            f32x4 o[8];
#pragma unroll
            for (int nt = 0; nt < 8; ++nt) {
                o[nt] = (f32x4){0.f, 0.f, 0.f, 0.f};
                const int e = 16 * nt + l15;
#pragma unroll
                for (int kk = 0; kk < 2; ++kk) { const bf16x8 sf = *(const bf16x8*)(SPT + nt * 2048 + (kk ? rb1 : rb0)); o[nt] = __builtin_amdgcn_mfma_f32_16x16x32_bf16(sf, qf[kk], o[nt], 0, 0, 0); }
#pragma unroll
                for (int ks2 = 0; ks2 < 2; ++ks2) {
                    if (2 * ks2 <= w) {
                        union { bf16x8 v; uint2 h[2]; } cv;
                        cv.h[0] = *(const uint2*)(VTs + nt * 2048 + (vb ^ (ks2 * 64)));
                        cv.h[1] = *(const uint2*)(VTs + nt * 2048 + (vb ^ (ks2 * 64) ^ 32));
                        o[nt] = __builtin_amdgcn_mfma_f32_16x16x32_bf16(cv.v, af[ks2], o[nt], 0, 0, 0);
                    }
                }
            }
            {
                const float4 dc = *(const float4*)(DEC + 16 * w + 4 * q4);
                bf16x8 kof[2];
#pragma unroll
                for (int kk = 0; kk < 2; ++kk) kof[kk] = *(const bf16x8*)(KOT + w * 2048 + (kk ? rb1 : rb0));
#pragma unroll
                for (int nt = 0; nt < 8; ++nt) {
                    Sacc[nt][0] *= dc.x; Sacc[nt][1] *= dc.y; Sacc[nt][2] *= dc.z; Sacc[nt][3] *= dc.w;
#pragma unroll
                    for (int kk = 0; kk < 2; ++kk) { const bf16x8 vf = *(const bf16x8*)(VTs + nt * 2048 + (kk ? rb1 : rb0)); Sacc[nt] = __builtin_amdgcn_mfma_f32_16x16x32_bf16(kof[kk], vf, Sacc[nt], 0, 0, 0); }
                }
            }
            __syncthreads();
#pragma unroll
            for (int nt = 0; nt < 8; ++nt) {
                const int e = 16 * nt + l15;
                uint2 pk; pk.x = pack2(Sacc[nt][0], Sacc[nt][1]); pk.y = pack2(Sacc[nt][2], Sacc[nt][3]);
                *(uint2*)(SPT + nt * 2048 + l15 * 128 + (((2 * w + (q4 >> 1)) ^ (l15 & 7)) << 4) + (q4 & 1) * 8) = pk;
            }
            float ssq = 0.f;
#pragma unroll
            for (int nt = 0; nt < 8; ++nt) ssq += (o[nt][0] * o[nt][0] + o[nt][1] * o[nt][1]) + (o[nt][2] * o[nt][2] + o[nt][3] * o[nt][3]);
            ssq += __shfl_xor(ssq, 16); ssq += __shfl_xor(ssq, 32);
            const float rsd = rsqrtf(ssq * (1.0f / 128.0f) + EPS);
#pragma unroll
            for (int nt = 0; nt < 8; ++nt) {
                asm volatile("" ::: "memory");
                const f32x4 gn = *(const f32x4*)(GN + 16 * nt + 4 * q4);
                const float g0 = lo2f(gr[nt].x), g1 = hi2f(gr[nt].x), g2 = lo2f(gr[nt].y), g3 = hi2f(gr[nt].y);
                uint2 ov;
                ov.x = pack2(o[nt][0] * rsd * gn[0] * g0, o[nt][1] * rsd * gn[1] * g1);
                ov.y = pack2(o[nt][2] * rsd * gn[2] * g2, o[nt][3] * rsd * gn[3] * g3);
                if (!dry || ov.x == 0x7fc17fc1u) *(uint2*)(gbase + (goff + 16 * nt)) = ov;
            }
        }
    }
}

__device__ __forceinline__ unsigned ord_key(float f) { const unsigned u = __float_as_uint(f); return (u & 0x80000000u) ? ~u : (u | 0x80000000u); }
__device__ __forceinline__ float unord_key(unsigned k) { return __uint_as_float((k & 0x80000000u) ? (k & 0x7fffffffu) : ~k); }
__device__ __forceinline__ void ce_desc(unsigned& a, unsigned& b) { const unsigned hi = max(a, b), lo = min(a, b); a = hi; b = lo; }
__device__ __forceinline__ void bitonic_sort16_desc(unsigned (&a)[16]) {
#pragma unroll
    for (int k = 2; k <= 16; k <<= 1)
#pragma unroll
        for (int j = k >> 1; j > 0; j >>= 1)
#pragma unroll
            for (int i = 0; i < 16; ++i) { const int l = i ^ j; if (l > i) { if ((i & k) == 0) ce_desc(a[i], a[l]); else ce_desc(a[l], a[i]); } }
}
__device__ __forceinline__ void merge_top16(unsigned (&L)[16], const unsigned (&B)[16]) {
#pragma unroll
    for (int i = 0; i < 16; ++i) L[i] = max(L[i], B[15 - i]);
#pragma unroll
    for (int j = 8; j > 0; j >>= 1)
#pragma unroll
        for (int i = 0; i < 16; ++i) { const int l = i ^ j; if (l > i) ce_desc(L[i], L[l]); }
}
__device__ constexpr int cand_i(int n) { int c = 0; for (int i = 0; i < 16; ++i) for (int j = 0; j < 16; ++j) if ((i + 1) * (j + 1) <= 16) { if (c == n) return i; ++c; } return -1; }
__device__ constexpr int cand_j(int n) { int c = 0; for (int i = 0; i < 16; ++i) for (int j = 0; j < 16; ++j) if ((i + 1) * (j + 1) <= 16) { if (c == n) return j; ++c; } return -1; }
template <int N> struct CandTab { int i[N], j[N]; constexpr CandTab() : i(), j() { for (int n = 0; n < N; ++n) { i[n] = cand_i(n); j[n] = cand_j(n); } } };

__device__ __forceinline__ bf16x8 pack8(const float4 a, const float4 b) {
    u32x4 t; t.x = pack2(a.x, a.y); t.y = pack2(a.z, a.w); t.z = pack2(b.x, b.y); t.w = pack2(b.z, b.w);
    return __builtin_bit_cast(bf16x8, t);
}
__device__ __forceinline__ void fold_query_weights(const Params& p, int vb0 = 0) {
    int lz = 0; asm volatile("" : "+v"(lz));
    const int lane = (VTID & 63) + lz, wid = VTID >> 6, fr = lane & 15, fq = lane >> 4;
    unsigned char* Wf = p.ws + OFF_WT_Q;
    if (VBID < vb0) return;
    for (int task = VBID - vb0; task < 512; task += VGRID - vb0) {
        const int kb = task & 15, pp = (task >> 4) & 1, h = (task >> 5) & 7, layer = task >> 8;
        const float* wq = p.peer_w_q + (size_t)layer * 1024 * 2048 + (size_t)(kb * 64 + fr) * 2048 + h * 256 + pp * 128 + fq * 8;
        const float* sk = p.peer_subkeys + ((size_t)((layer * 8 + h) * 2 + pp) * 128 + wid * 32 + fr) * 128 + fq * 8;
        f32x4 acc[4][2];
#pragma unroll
        for (int kt = 0; kt < 4; ++kt)
#pragma unroll
            for (int jt = 0; jt < 2; ++jt) acc[kt][jt] = (f32x4){0.f, 0.f, 0.f, 0.f};
#pragma unroll 1
        for (int s = 0; s < 4; ++s) {
            bf16x8 a[4], b[2];
#pragma unroll
            for (int kt = 0; kt < 4; ++kt) { const float* q = wq + (size_t)(kt * 16) * 2048 + s * 32; a[kt] = pack8(*(const float4*)q, *(const float4*)(q + 4)); }
#pragma unroll
            for (int jt = 0; jt < 2; ++jt) { const float* q = sk + (size_t)(jt * 16) * 128 + s * 32; b[jt] = pack8(*(const float4*)q, *(const float4*)(q + 4)); }
#pragma unroll
            for (int kt = 0; kt < 4; ++kt)
#pragma unroll
                for (int jt = 0; jt < 2; ++jt) acc[kt][jt] = __builtin_amdgcn_mfma_f32_16x16x32_bf16(a[kt], b[jt], acc[kt][jt], 0, 0, 0);
        }
#pragma unroll
        for (int jt = 0; jt < 2; ++jt) {
            const int key = wid * 32 + jt * 16 + fr, cu = 128 * ((key >> 5) & 1) + 32 * (2 * pp + (key >> 6)) + (key & 31);
            unsigned char* row = Wf + ((size_t)layer * 2048 + h * 256 + cu) * 1024 + kb * 64 + 4 * fq;
#pragma unroll
            for (int kt = 0; kt < 4; ++kt) {
                const f32x4 wv = acc[kt][jt] * *(const f32x4*)(p.norm_ffn + layer * 1024 + kb * 64 + kt * 16 + 4 * fq) * 64.0f;
                int pk = __builtin_amdgcn_cvt_pk_fp8_f32(wv[0], wv[1], 0, false); pk = __builtin_amdgcn_cvt_pk_fp8_f32(wv[2], wv[3], pk, true);
                *(int*)(row + kt * 16) = pk;
            }
        }
    }
}
__device__ __forceinline__ void bitonic_merge16_desc(unsigned (&L)[16]) {
#pragma unroll
    for (int j = 8; j > 0; j >>= 1)
#pragma unroll
        for (int i = 0; i < 16; ++i) { const int l = i ^ j; if (l > i) ce_desc(L[i], L[l]); }
}
__device__ __forceinline__ void bitonic_sort8_desc(unsigned (&a)[8]) {
#pragma unroll
    for (int k = 2; k <= 8; k <<= 1)
#pragma unroll
        for (int j = k >> 1; j > 0; j >>= 1)
#pragma unroll
            for (int i = 0; i < 8; ++i) { const int l = i ^ j; if (l > i) { if ((i & k) == 0) ce_desc(a[i], a[l]); else ce_desc(a[l], a[i]); } }
}
__device__ __forceinline__ void sort16_desc(unsigned (&a)[16]) {
#define CE_(i, j) ce_desc(a[i], a[j])
    CE_(0,13); CE_(1,12); CE_(2,15); CE_(3,14); CE_(4,8); CE_(5,6); CE_(7,11); CE_(9,10);
    CE_(0,5); CE_(1,7); CE_(2,9); CE_(3,4); CE_(6,13); CE_(8,14); CE_(10,15); CE_(11,12);
    CE_(0,1); CE_(2,3); CE_(4,5); CE_(6,8); CE_(7,9); CE_(10,11); CE_(12,13); CE_(14,15);
    CE_(0,2); CE_(1,3); CE_(4,10); CE_(5,11); CE_(6,7); CE_(8,9); CE_(12,14); CE_(13,15);
    CE_(1,2); CE_(3,12); CE_(4,6); CE_(5,7); CE_(8,10); CE_(9,11); CE_(13,14);
    CE_(1,4); CE_(2,6); CE_(5,8); CE_(7,10); CE_(9,13); CE_(11,14);
    CE_(2,4); CE_(3,6); CE_(9,12); CE_(11,13);
    CE_(3,5); CE_(6,8); CE_(7,9); CE_(10,12);
    CE_(3,4); CE_(5,6); CE_(7,8); CE_(9,10); CE_(11,12);
    CE_(6,7); CE_(8,9);
#undef CE_
}
struct EpiSelect {
    unsigned* IDX; float* GATE; G8_LAS unsigned* X; const float* SSQP; const unsigned* SCT;
    __device__ __forceinline__ void operator()(const f32x4 (&acc)[2][2][4][2], const g8::Unit& u, int wr, int wc, int fr_, int fq_) const {
        int lz = 0; asm volatile("" : "+v"(lz));
        const int lane_ = (int)(threadIdx.x & 63) + lz, fr = lane_ & 15, fq = lane_ >> 4; (void)fr_; (void)fq_;
        const int pp = wc >> 1, half = wc & 1, wid = wr * 4 + wc;
        const unsigned kb = 127u - (unsigned)(half * 64 + fq * 8);
        unsigned Lst[4][16];
#pragma unroll
        for (int ai = 0; ai < 2; ++ai)
#pragma unroll
            for (int m = 0; m < 4; ++m) {
                unsigned C[16], Xc[16];
#pragma unroll
                for (int bj = 0; bj < 2; ++bj)
#pragma unroll
                    for (int n = 0; n < 2; ++n)
#pragma unroll
                        for (int r = 0; r < 4; ++r) C[bj * 8 + n * 4 + r] = (ord_key(acc[ai][bj][m][n][r]) & ~127u) | (kb - (unsigned)(bj * 32 + n * 4 + r));
                sort16_desc(C);
#pragma unroll
                for (int i = 0; i < 16; ++i) Xc[i] = (unsigned)__shfl_xor((int)C[i], 16);
                merge_top16(C, Xc);
#pragma unroll
                for (int i = 0; i < 16; ++i) Xc[i] = (unsigned)__shfl_xor((int)C[i], 32);
                merge_top16(C, Xc);
                if ((m >> 1) == half) {
#pragma unroll
                    for (int i = 0; i < 16; ++i) Lst[ai * 2 + (m & 1)][i] = C[i];
                } else if (fq == 0) {
                    G8_LAS unsigned* xs = X + (((ai * 2 + wr) * 2 + pp) * 4 + m) * 256 + fr;
#pragma unroll
                    for (int i = 0; i < 16; ++i) xs[(i ^ m) << 4] = C[i];
                }
            }
        __syncthreads();
#pragma unroll
        for (int ai = 0; ai < 2; ++ai)
#pragma unroll
            for (int e = 0; e < 2; ++e) {
                const int m = half * 2 + e;
                unsigned Xc[16];
                G8_LAS unsigned* xs = X + (((ai * 2 + wr) * 2 + pp) * 4 + m) * 256 + fr;
#pragma unroll
                for (int i = 0; i < 16; ++i) Xc[i] = xs[(i ^ m) << 4];
                merge_top16(Lst[ai * 2 + e], Xc);
                if (fq == 0) {
#pragma unroll
                    for (int i = 0; i < 16; ++i) xs[(i ^ m) << 4] = Lst[ai * 2 + e][i];
                }
            }
        __syncthreads();
        if (wid < 4) {
            G8_LAS unsigned* x0 = X + ((wid * 2 + 0) * 4 + fq) * 256 + fr; G8_LAS unsigned* x1 = X + ((wid * 2 + 1) * 4 + fq) * 256 + fr;
            float s0[16], s1[16];
#pragma unroll
            for (int i = 0; i < 16; ++i) { s0[i] = unord_key(x0[(i ^ fq) << 4] & ~127u); s1[i] = unord_key(x1[(i ^ fq) << 4] & ~127u); }
#define SEL_CAND(i, j) ((ord_key(s0[i] + s1[j]) & ~255u) | (unsigned)(255 - ((i) * 16 + (j))))
            unsigned C[16], B[16], M2[16], M3[8];
#pragma unroll
            for (int j = 0; j < 16; ++j) C[j] = SEL_CAND(0, j);
#pragma unroll
            for (int k = 0; k < 15; ++k) B[k] = SEL_CAND(k + 1, 0);
            B[15] = 0u;
            merge_top16(C, B);
#pragma unroll
            for (int j = 0; j < 7; ++j) M2[j] = SEL_CAND(1, j + 1);
            M2[7] = 0u; M2[8] = 0u; M2[9] = 0u;
#pragma unroll
            for (int k = 0; k < 6; ++k) M2[15 - k] = SEL_CAND(k + 2, 1);
            bitonic_merge16_desc(M2);
            M3[0] = SEL_CAND(2, 2); M3[1] = SEL_CAND(2, 3); M3[2] = SEL_CAND(2, 4); M3[3] = SEL_CAND(3, 2); M3[4] = SEL_CAND(4, 2); M3[5] = SEL_CAND(3, 3); M3[6] = 0u; M3[7] = 0u;
            bitonic_sort8_desc(M3);
#pragma unroll
            for (int i = 0; i < 8; ++i) B[i] = M3[i];
#pragma unroll
            for (int i = 8; i < 16; ++i) B[i] = 0u;
            merge_top16(M2, B);
            merge_top16(C, M2);
#undef SEL_CAND
            const int tok = u.pm * 256 + (wid >> 1) * 128 + (wid & 1) * 64 + fq * 16 + fr;
            float rstd;
            {
                const f32x4 q0 = *(const f32x4*)(SSQP + (size_t)tok * 32), q1 = *(const f32x4*)(SSQP + (size_t)tok * 32 + 4), q2 = *(const f32x4*)(SSQP + (size_t)tok * 32 + 8), q3 = *(const f32x4*)(SSQP + (size_t)tok * 32 + 12);
                const f32x4 q = (q0 + q1) + (q2 + q3);
                rstd = rsqrtf(((q[0] + q[1]) + (q[2] + q[3])) * (1.0f / D) + EPS);
            }
            const float mx = unord_key(C[0] & ~255u);
            float e[16]; float sum = 0.f;
#pragma unroll
            for (int r = 0; r < 16; ++r) { e[r] = __expf((unord_key(C[r] & ~255u) - mx) * (rstd * (1.0f / 64.0f))); sum += e[r]; }
            const float inv = 1.0f / sum;
            const size_t ob = (size_t)tok * 128 + u.pn * 16;
            unsigned iw[16];
#pragma unroll
            for (int r = 0; r < 16; ++r) {
                const unsigned code = 255u - (C[r] & 255u);
                const unsigned e0 = 127u - (x0[((code >> 4) ^ (unsigned)fq) << 4] & 127u), e1 = 127u - (x1[((code & 15u) ^ (unsigned)fq) << 4] & 127u);
                iw[r] = e0 * 128u + e1;
            }
            unsigned sc[16];
#pragma unroll
            for (int r = 0; r < 16; ++r) sc[r] = SCT[iw[r]];
#pragma unroll
            for (int r = 0; r < 16; ++r) {
                iw[r] |= sc[r] << 16;
                e[r] *= inv * (float)__builtin_bit_cast(_Float16, (unsigned short)(sc[r] >> 16));
            }
#pragma unroll
            for (int r = 0; r < 4; ++r) *(uint4*)(IDX + ob + r * 4) = make_uint4(iw[4 * r], iw[4 * r + 1], iw[4 * r + 2], iw[4 * r + 3]);
#pragma unroll
            for (int r = 0; r < 4; ++r) *(float4*)(GATE + ob + r * 4) = make_float4(e[4 * r], e[4 * r + 1], e[4 * r + 2], e[4 * r + 3]);
        }
        __syncthreads();
    }
};
__device__ __forceinline__ void phase_select8(const Params& p, int layer, char* smem_phys) {
    const bf16_t* H = (const bf16_t*)(p.ws + OFF_H); const bf16_t* Wf = (const bf16_t*)(p.ws + OFF_WT_Q + (size_t)layer * 2048 * 1024);
    g8::Gemm g{H, H, 512, 512, Wf, T, 2048, 512};
    g8::StaticOrder S; S.init(T, 2048, (int)gridDim.x, (int)blockIdx.x);
    EpiSelect E{(unsigned*)(p.ws + OFF_IDX), (float*)(p.ws + OFF_GATE), (G8_LAS unsigned*)(smem_phys + 131072), (const float*)(p.ws + OFF_SSQ), (const unsigned*)(p.ws + OFF_USC) + (size_t)layer * NEXP};
    g8::gemm_phase<EpiSelect, true>((G8_LAS unsigned char*)smem_phys, g, S, E);
    __syncthreads();
    if (threadIdx.x == 0) *(uint4*)(smem_phys + kDynLds - 16) = make_uint4(0u, 0u, 0u, 0u);
    __syncthreads();
}

__device__ __forceinline__ float ub0(unsigned w) { float f; asm("v_cvt_f32_ubyte0 %0, %1" : "=v"(f) : "v"(w)); return f; }
__device__ __forceinline__ float ub1(unsigned w) { float f; asm("v_cvt_f32_ubyte1 %0, %1" : "=v"(f) : "v"(w)); return f; }
__device__ __forceinline__ float ub2(unsigned w) { float f; asm("v_cvt_f32_ubyte2 %0, %1" : "=v"(f) : "v"(w)); return f; }
__device__ __forceinline__ float ub3(unsigned w) { float f; asm("v_cvt_f32_ubyte3 %0, %1" : "=v"(f) : "v"(w)); return f; }
typedef _Float16 f16x2 __attribute__((ext_vector_type(2)));
__device__ __forceinline__ void glds16(const void* gsrc, unsigned lds_dst) {
    unsigned keep; const unsigned d = (unsigned)__builtin_amdgcn_readfirstlane((int)lds_dst);
    asm volatile("s_mov_b32 %0, m0\n\ts_mov_b32 m0, %2\n\ts_nop 0\n\tglobal_load_lds_dwordx4 %1, off\n\ts_mov_b32 m0, %0" : "=&s"(keep) : "v"(gsrc), "s"(d) : "memory");
}
__device__ __forceinline__ void peer_gather(const Params& p, int layer, const float* __restrict__ gnext, bool final_out, char* smem) {
    const unsigned char* REC = p.ws + OFF_UT + (size_t)layer * NEXP * 1024;
    bf16_t* H = (bf16_t*)(p.ws + OFF_H);
    const unsigned* IDX = (const unsigned*)(p.ws + OFF_IDX); const float* GATE = (const float*)(p.ws + OFF_GATE);
    bf16_t* S = (bf16_t*)(p.ws + OFF_S);
    float* sGain = (float*)(smem + 139264);
    { int lz0 = 0; asm volatile("" : "+v"(lz0)); const int i = (int)threadIdx.x + lz0; if (i < 256) ((f32x4*)sGain)[i] = ((const f32x4*)(p.norm_ffn + layer * 1024))[i]; }
    __syncthreads();
    const int lane = VTID & 63, wid = VTID >> 6, sub = lane >> 4, li = lane & 15;
    char* wbase = smem + (int)(threadIdx.x >> 6) * 17408;
    unsigned* sIdx = (unsigned*)wbase; float* sGate = (float*)(wbase + 512);
    const char* ring = wbase + 1024; const unsigned ringb = (unsigned)(size_t)ring;
    const int gw = VBID * 4 + wid, nw = VGRID * 4;
    for (int t = gw; t < T; t += nw) {
        {
            int lz = 0; asm volatile("" : "+v"(lz));
            const int l2 = 2 * (lane + lz);
            const uint2 idp = *(const uint2*)(IDX + (size_t)t * 128 + l2);
            const float2 g2 = *(const float2*)(GATE + (size_t)t * 128 + l2);
            *(uint2*)(sIdx + l2) = idp; *(float2*)(sGate + l2) = g2;
        }
        int XH[2][4], XL[2][4]; float sx; float xg;
        {
            const int jq = sub >> 1, dq = (sub & 1) * 2;
            f32x4 xr[4]; float am = 0.f, ssx = 0.f;
#pragma unroll
            for (int k = 0; k < 2; ++k) {
                const int col = (16 * jq + li) * 32 + (dq + k) * 8;
                const u32x4 raw = *(const u32x4*)(S + (size_t)t * 1024 + col);
                const f32x4 g0 = *(const f32x4*)(sGain + col), g1 = *(const f32x4*)(sGain + col + 4);
                const f32x4 x0 = (f32x4){lo2f(raw[0]), hi2f(raw[0]), lo2f(raw[1]), hi2f(raw[1])}, x1 = (f32x4){lo2f(raw[2]), hi2f(raw[2]), lo2f(raw[3]), hi2f(raw[3])};
                ssx += (x0[0] * x0[0] + x0[1] * x0[1]) + (x0[2] * x0[2] + x0[3] * x0[3]) + (x1[0] * x1[0] + x1[1] * x1[1]) + (x1[2] * x1[2] + x1[3] * x1[3]);
                xr[2 * k] = x0 * g0; xr[2 * k + 1] = x1 * g1;
#pragma unroll
                for (int c = 0; c < 4; ++c) am = fmaxf(am, fmaxf(fabsf(xr[2 * k][c]), fabsf(xr[2 * k + 1][c])));
            }
            am = fmaxf(am, __shfl_xor(am, 1)); am = fmaxf(am, __shfl_xor(am, 2)); am = fmaxf(am, __shfl_xor(am, 4)); am = fmaxf(am, __shfl_xor(am, 8));
            am = fmaxf(am, __shfl_xor(am, 16)); am = fmaxf(am, __shfl_xor(am, 32));
            ssx = row16_sum(ssx); ssx += __shfl_xor(ssx, 16); ssx += __shfl_xor(ssx, 32);
            const float inv = am > 0.f ? 119.0f / am : 0.f;
            sx = am * (1.0f / 119.0f) * rsqrtf(ssx * (1.0f / D) + EPS);
            int xs = 0; int myL[2], myH[2];
#pragma unroll
            for (int k = 0; k < 2; ++k) {
                unsigned lo = 0u, hi = 0u;
#pragma unroll
                for (int i = 0; i < 8; ++i) {
                    const int q = __float2int_rn(xr[k * 2 + (i >> 2)][i & 3] * inv);
                    const int sh = (i & 3) * 8 + (i >> 2) * 4;
                    lo |= ((unsigned)q & 15u) << sh; hi |= ((unsigned)((q + 8) >> 4) & 15u) << sh;
                    xs += q;
                }
                myL[k] = (int)lo; myH[k] = (int)hi;
            }
            xs += __shfl_xor(xs, 16); xs += __shfl_xor(xs, 32);
#pragma unroll
            for (int j = 0; j < 2; ++j)
#pragma unroll
                for (int d = 0; d < 4; ++d) { const int srcl = (2 * j + (d >> 1)) * 16 + li; XL[j][d] = __shfl(myL[d & 1], srcl); XH[j][d] = __shfl(myH[d & 1], srcl); }
            xg = 0.5f * (float)xs;
        }
        f16x2 accp[2][16];
#pragma unroll
        for (int j = 0; j < 2; ++j)
#pragma unroll
            for (int c = 0; c < 16; ++c) accp[j][c] = (f16x2){(_Float16)0.f, (_Float16)0.f};
        float wsg = 0.f;
        auto issue = [&](int sg) {
            const unsigned e_ = sIdx[sg * 4 + sub] & 0xffffu;
            const unsigned char* rec = REC + (size_t)e_ * 1024 + li * 16;
            const unsigned dst = ringb + (unsigned)(sg & 3) * 4096u;
            glds16(rec, dst); glds16(rec + 256, dst + 1024u); glds16(rec + 512, dst + 2048u); glds16(rec + 768, dst + 3072u);
        };
        auto compute = [&](int sg, bool refill) {
            const char* sl = ring + (sg & 3) * 4096;
            const u32x4 du0 = *(const u32x4*)(sl + lane * 16), du1 = *(const u32x4*)(sl + 1024 + lane * 16);
            const u32x4 dv0 = *(const u32x4*)(sl + 2048 + lane * 16), dv1 = *(const u32x4*)(sl + 3072 + lane * 16);
            const float us = (float)__builtin_bit_cast(_Float16, (unsigned short)(sIdx[sg * 4 + sub] >> 16));
            const float gt = sGate[sg * 4 + sub];
            if (refill) { asm volatile("s_waitcnt lgkmcnt(0)" ::: "memory"); issue(sg + 4); }
            int iah = 0, ial = 0;
#pragma unroll
            for (int j = 0; j < 2; ++j) {
#pragma unroll
                for (int d = 0; d < 4; ++d) {
                    const int w = (int)(j ? du1[d] : du0[d]);
                    iah = __builtin_amdgcn_sdot8(w, XH[j][d], iah, false);
                    ial = __builtin_amdgcn_sdot8(w, XL[j][d], ial, false);
                }
            }
            float pa = us * ((float)(16 * iah + ial) + xg);
            pa = row16_sum(pa);
            const float ww = gt * gelu_exact(pa * sx);
            wsg += ww;
            const float wc = fminf(fmaxf(ww * 65536.0f, -65504.0f), 65504.0f);
            const _Float16 wha = (_Float16)wc, whb = (_Float16)(wc * 0.0625f);
            const f16x2 wa = {wha, wha}, wb = {whb, whb};
#pragma unroll
            for (int j = 0; j < 2; ++j) {
#pragma unroll
                for (int d = 0; d < 4; ++d) {
                    const unsigned wv = j ? dv1[d] : dv0[d], wt = wv >> 8;
                    const f16x2 c0 = __builtin_bit_cast(f16x2, wv & 0x000f000fu), c1 = __builtin_bit_cast(f16x2, wv & 0x00f000f0u);
                    const f16x2 c2 = __builtin_bit_cast(f16x2, wt & 0x000f000fu), c3 = __builtin_bit_cast(f16x2, wt & 0x00f000f0u);
                    accp[j][4 * d + 0] = __builtin_elementwise_fma(c0, wa, accp[j][4 * d + 0]); accp[j][4 * d + 1] = __builtin_elementwise_fma(c1, wb, accp[j][4 * d + 1]);
                    accp[j][4 * d + 2] = __builtin_elementwise_fma(c2, wa, accp[j][4 * d + 2]); accp[j][4 * d + 3] = __builtin_elementwise_fma(c3, wb, accp[j][4 * d + 3]);
                }
            }
        };
        asm volatile("s_waitcnt vmcnt(0)" ::: "memory");
        issue(0); issue(1); issue(2); issue(3);
#pragma unroll 1
        for (int sg = 0; sg < 28; ++sg) {
            asm volatile("s_waitcnt vmcnt(12)" ::: "memory");
            compute(sg, true);
        }
        asm volatile("s_waitcnt vmcnt(12)" ::: "memory");
        compute(28, false);
        asm volatile("s_waitcnt vmcnt(8)" ::: "memory");
        compute(29, false);
        asm volatile("s_waitcnt vmcnt(4)" ::: "memory");
        compute(30, false);
        asm volatile("s_waitcnt vmcnt(0)" ::: "memory");
        compute(31, false);
        const bool up2 = (sub & 2) != 0, up1 = (sub & 1) != 0;
        float wsum = wsg + __shfl_xor(wsg, 32);
        wsum += __shfl_xor(wsum, 16);
        f16x2 r1p[16];
#pragma unroll
        for (int c = 0; c < 16; ++c) {
            const f16x2 keep = up2 ? accp[1][c] : accp[0][c], give = up2 ? accp[0][c] : accp[1][c];
            r1p[c] = keep + __builtin_bit_cast(f16x2, __shfl_xor(__builtin_bit_cast(int, give), 32));
        }
        f16x2 r2p[8];
#pragma unroll
        for (int c = 0; c < 8; ++c) {
            const f16x2 keep = up1 ? r1p[8 + c] : r1p[c], give = up1 ? r1p[c] : r1p[8 + c];
            r2p[c] = keep + __builtin_bit_cast(f16x2, __shfl_xor(__builtin_bit_cast(int, give), 16));
        }
        float r2[16];
#pragma unroll
        for (int dl = 0; dl < 2; ++dl) {
            r2[8 * dl + 0] = 256.0f * (float)r2p[4 * dl + 0][0]; r2[8 * dl + 2] = 256.0f * (float)r2p[4 * dl + 0][1];
            r2[8 * dl + 4] = 256.0f * (float)r2p[4 * dl + 1][0]; r2[8 * dl + 6] = 256.0f * (float)r2p[4 * dl + 1][1];
            r2[8 * dl + 1] = 256.0f * (float)r2p[4 * dl + 2][0]; r2[8 * dl + 3] = 256.0f * (float)r2p[4 * dl + 2][1];
            r2[8 * dl + 5] = 256.0f * (float)r2p[4 * dl + 3][0]; r2[8 * dl + 7] = 256.0f * (float)r2p[4 * dl + 3][1];
        }
        const int col0 = (16 * (sub >> 1) + li) * 32 + (sub & 1) * 16;
        float ss = 0.f;
        bf16_t* srow = S + (size_t)t * 1024 + col0;
        {
            const u32x4 b0 = *(const u32x4*)srow, b1 = *(const u32x4*)(srow + 8);
#pragma unroll
            for (int c = 0; c < 8; ++c) {
                const unsigned wsrc = c < 4 ? b0[c] : b1[c - 4];
                r2[2 * c] = r2[2 * c] - 7.5f * wsum + lo2f(wsrc); r2[2 * c + 1] = r2[2 * c + 1] - 7.5f * wsum + hi2f(wsrc);
                ss += r2[2 * c] * r2[2 * c] + r2[2 * c + 1] * r2[2 * c + 1];
            }
        }
        ss = wave_sum(ss);
        const float rstd = rsqrtf(ss * (1.0f / D) + EPS);
        const float* gp = gnext + col0;
        if (final_out) {
            float* orow = p.out + (size_t)t * 1024 + col0;
#pragma unroll
            for (int c4 = 0; c4 < 4; ++c4) {
                const f32x4 g = *(const f32x4*)(gp + c4 * 4);
                *(f32x4*)(orow + c4 * 4) = (f32x4){r2[c4 * 4] * rstd * g[0], r2[c4 * 4 + 1] * rstd * g[1], r2[c4 * 4 + 2] * rstd * g[2], r2[c4 * 4 + 3] * rstd * g[3]};
            }
        } else {
            u32x4 sv[2];
#pragma unroll
            for (int c4 = 0; c4 < 4; ++c4) { sv[c4 >> 1][(c4 & 1) * 2] = pack2(r2[c4 * 4], r2[c4 * 4 + 1]); sv[c4 >> 1][(c4 & 1) * 2 + 1] = pack2(r2[c4 * 4 + 2], r2[c4 * 4 + 3]); }
            *(u32x4*)srow = sv[0]; *(u32x4*)(srow + 8) = sv[1];
            { u32x4 e8;
#pragma unroll
              for (int c = 0; c < 4; ++c) { int pk = __builtin_amdgcn_cvt_pk_fp8_f32(r2[4 * c], r2[4 * c + 1], 0, false); pk = __builtin_amdgcn_cvt_pk_fp8_f32(r2[4 * c + 2], r2[4 * c + 3], pk, true); e8[c] = (unsigned)pk; }
              *(u32x4*)(p.ws + OFF_H + ((size_t)32 << 20) + (size_t)t * 1024 + col0) = e8; }
            if (lane == 0) ((float*)(p.ws + OFF_VSC))[t] = rstd;
        }
    }
}


#define XB_TMO      128
#define XB_XCNT(j)  (256  + 64 * (j))
#define XB_XSUB(j)  (1280 + 64 * (j))
#define XB_XGEN(j)  (2304 + 64 * (j))
#define XB_TOP      3328
#define XB_TOPGEN   3392
#define XCD_BAR_WORDS 3456
#define XB_SPIN_CAP (1u << 22)
#define LAS __attribute__((address_space(3)))
__device__ __forceinline__ unsigned xb_ld(unsigned* p)              { return __hip_atomic_load(p, __ATOMIC_RELAXED, __HIP_MEMORY_SCOPE_AGENT); }
__device__ __forceinline__ unsigned xb_add(unsigned* p, unsigned v) { return __hip_atomic_fetch_add(p, v, __ATOMIC_RELAXED, __HIP_MEMORY_SCOPE_AGENT); }
__device__ __forceinline__ unsigned xb_xcc_id() { return (unsigned)__builtin_amdgcn_s_getreg((3 << 11) | 20) & 0xFu; }
#define XB_SPIN(cond, bar) do { unsigned _sp = 0; while (cond) { __builtin_amdgcn_s_sleep(1); \
    if ((++_sp & 255u) == 0u) { if (xb_ld(&(bar)[XB_TMO])) break; if (_sp > XB_SPIN_CAP) { atomicAdd(&(bar)[XB_TMO], 1u); break; } } } } while (0)
struct XcdBarrier { unsigned* bar; unsigned x; volatile LAS unsigned* st; };
__device__ __forceinline__ XcdBarrier xcd_barrier_post(unsigned* bar, volatile LAS unsigned* st) {
    XcdBarrier b; b.bar = bar; b.x = xb_xcc_id(); b.st = st;
    if (threadIdx.x == 0) (void)xb_add(&bar[XB_XCNT(b.x)], 1u);
    return b;
}
__device__ __forceinline__ void xcd_barrier_complete(unsigned* bar, unsigned x, unsigned& nloc, unsigned& nx) {
    const unsigned G = gridDim.x * gridDim.y * gridDim.z;
    unsigned sum, cnt, mine, sp = 0u;
    for (;;) {
        sum = 0u; cnt = 0u; mine = 0u;
#pragma unroll
        for (unsigned j = 0; j < 16; ++j) { const unsigned c = xb_ld(&bar[XB_XCNT(j)]); sum += c; cnt += (c > 0u) ? 1u : 0u; mine = (j == x) ? c : mine; }
        if (sum == G) break;
        __builtin_amdgcn_s_sleep(1);
        if ((++sp & 255u) == 0u) { if (xb_ld(&bar[XB_TMO])) break; if (sp > XB_SPIN_CAP) { atomicAdd(&bar[XB_TMO], 1u); break; } }
    }
    nloc = mine > 0u ? mine : 1u; nx = cnt > 0u ? cnt : 1u;
}
__device__ __forceinline__ void xcd_barrier(const XcdBarrier& b) {
    asm volatile("s_waitcnt vmcnt(0)" ::: "memory");
    __syncthreads();
    if (threadIdx.x == 0) {
        unsigned* bar = b.bar;
        __builtin_amdgcn_s_waitcnt(0);
        unsigned nloc = b.st[0], nx = b.st[1];
        if (nloc == 0u) { xcd_barrier_complete(bar, b.x, nloc, nx); b.st[0] = nloc; b.st[1] = nx; }
        const unsigned old = xb_add(&bar[XB_XSUB(b.x)], 1u);
        const unsigned gen = old / nloc;
        if (old + 1u == (gen + 1u) * nloc) {
            __builtin_amdgcn_fence(__ATOMIC_RELEASE, "agent");
            asm volatile("s_waitcnt vmcnt(0)" ::: "memory");
            const unsigned og = xb_add(&bar[XB_TOP], 1u);
            const unsigned tg = og / nx;
            if (og + 1u == (tg + 1u) * nx) xb_add(&bar[XB_TOPGEN], 1u);
            else XB_SPIN(xb_ld(&bar[XB_TOPGEN]) == tg, bar);
            __builtin_amdgcn_fence(__ATOMIC_ACQUIRE, "agent");
            xb_add(&bar[XB_XGEN(b.x)], 1u);
            asm volatile("s_waitcnt vmcnt(0)" ::: "memory");
        } else {
            XB_SPIN(xb_ld(&bar[XB_XGEN(b.x)]) == gen, bar);
            __builtin_amdgcn_fence(__ATOMIC_ACQUIRE, "agent");
            asm volatile("s_waitcnt vmcnt(0)" ::: "memory");
        }
    }
    __syncthreads();
}

constexpr int NPHASE = 12;
__global__ void __launch_bounds__(512, 2) mega(Params p, int ph_lo, int ph_hi) {
    extern __shared__ __attribute__((aligned(16))) char smem_phys[];
    uint4& xb_words = *(uint4*)(smem_phys + kDynLds - 16);
    if (threadIdx.x == 0) xb_words = make_uint4(0u, 0u, 0u, 0u);
    __syncthreads();
    const XcdBarrier xbar = xcd_barrier_post((unsigned*)(p.ws + OFF_BAR), (volatile LAS unsigned*)&xb_words);
    char* smem = smem_phys + (threadIdx.x >> 8) * 65536;
    bf16_t* Rg = (bf16_t*)(p.ws + OFF_REGION);
    bf16_t* Hb = (bf16_t*)(p.ws + OFF_H);
#define PHASE(k, ...) if (ph_lo <= (k) && (k) < ph_hi) { __VA_ARGS__; if ((k) + 1 < ph_hi) xcd_barrier(xbar); }
    unsigned* sbctr = (unsigned*)(p.ws + OFF_BAR + 14336);
    PHASE(0,
        transpose_convert<true>(p.ab_w_in, (bf16_t*)(p.ws + OFF_WT_IN), 1024, AB_IN, AB_IN_PAD, smem);
        rmsnorm_rows(p.x, p.norm_mix, Hb))
    PHASE(1, phase_gemm_in8(p, smem_phys))
    PHASE(2, gla_prep(p, smem))
    PHASE(3, gla_scan(p, smem); sb_fast(p, smem_phys + 98304, sbctr);
        quantize_tables_static(p, 64);
        transpose_convert(p.ab_w_out, (bf16_t*)(p.ws + OFF_WT_OUT), 1024, 1024, 1024, smem, 64);
        transpose_convert(p.c_w_in, (bf16_t*)(p.ws + OFF_WT_CIN), 1024, 4096, 4096, smem, 64, p.norm_mix + 1024, p.ws + OFF_SK_W8, 2048);
        transpose_convert(p.c_w_out, (bf16_t*)(p.ws + OFF_WT_COUT), 2048, 1024, 1024, smem, 64);
        fold_query_weights(p, 64))
    PHASE(4, phase_gemm_resid8(Rg + R_QSB, Rg + R_GG, 512, 512, (const bf16_t*)(p.ws + OFF_WT_OUT), 1024, p.x, (bf16_t*)(p.ws + OFF_S), (float*)(p.ws + OFF_SSQ), p.ws + OFF_H, smem_phys))
    PHASE(5, phase_select8(p, 0, smem_phys))
    PHASE(6, peer_gather(p, 0, p.norm_mix + 1024, false, smem_phys))
    PHASE(7, phase_gemm_cin8_v(p, smem_phys))
    PHASE(8, phase_gemm_cin8_u(p, smem_phys))
    PHASE(9, phase_gemm_resid8(Rg, Rg, 2048, 2048, (const bf16_t*)(p.ws + OFF_WT_COUT), 2048, nullptr, (bf16_t*)(p.ws + OFF_S), (float*)(p.ws + OFF_SSQ), p.ws + OFF_H, smem_phys))
    PHASE(10, phase_select8(p, 1, smem_phys))
    PHASE(11, peer_gather(p, 1, p.final_norm, true, smem_phys))
}

extern "C" void kernel_launch(void* const* d_in, const int* in_sizes, int n_in, void* d_out, int out_size, void* d_ws, size_t ws_size, hipStream_t stream) {
    static int grid_blocks = 0;
    if (!grid_blocks) {
        int dev = 0, cus = 0, per_cu = 0;
        hipGetDevice(&dev);
        hipDeviceGetAttribute(&cus, hipDeviceAttributeMultiprocessorCount, dev);
        hipFuncSetAttribute((const void*)mega, hipFuncAttributeMaxDynamicSharedMemorySize, kDynLds);
        hipOccupancyMaxActiveBlocksPerMultiprocessor(&per_cu, mega, 512, kDynLds);
        if (per_cu < 1) per_cu = 1;
        if (per_cu > 1) per_cu = 1;
        grid_blocks = cus * per_cu;
        if (n_in != 18 || ws_size < WS_END) fprintf(stderr, "kernel_launch: unexpected n_in %d or ws_size %zu < %zu\n", n_in, ws_size, (size_t)WS_END);
    }
    Params p{};
    p.x = (const float*)d_in[0]; p.norm_mix = (const float*)d_in[1]; p.norm_ffn = (const float*)d_in[2]; p.ab_w_in = (const float*)d_in[3];
    p.ab_w_alpha2 = (const float*)d_in[4]; p.ab_b_alpha2 = (const float*)d_in[5]; p.ab_gla_norm = (const float*)d_in[6]; p.ab_w_out = (const float*)d_in[7];
    p.c_w_in = (const float*)d_in[8]; p.c_v_norm = (const float*)d_in[9]; p.c_w_spatial = (const float*)d_in[10]; p.c_b_spatial = (const float*)d_in[11];
    p.c_w_out = (const float*)d_in[12]; p.peer_w_q = (const float*)d_in[13]; p.peer_subkeys = (const float*)d_in[14]; p.peer_u = (const float*)d_in[15];
    p.peer_v = (const float*)d_in[16]; p.final_norm = (const float*)d_in[17];
    p.out = (float*)d_out; p.ws = (unsigned char*)d_ws;
    (void)hipMemsetAsync((char*)d_ws + OFF_BAR, 0, 16384, stream);
#if ONE_LAUNCH
    int lo = 0, hi = NPHASE;
    void* args[] = {&p, &lo, &hi};
    hipError_t e = hipLaunchCooperativeKernel((void*)mega, dim3(grid_blocks), dim3(512), args, kDynLds, stream);
    if (e != hipSuccess) fprintf(stderr, "cooperative launch failed: %s (grid %d)\n", hipGetErrorString(e), grid_blocks);
#else
    for (int ph = 0; ph < NPHASE; ++ph) hipLaunchKernelGGL(mega, dim3(grid_blocks), dim3(512), kDynLds, stream, p, ph, ph + 1);
#endif
}
```

```cpp
#include <hip/hip_runtime.h>
#include <cstdio>
#include <cstdint>

#ifndef ONE_LAUNCH
#define ONE_LAUNCH 1
#endif


#define VTID ((int)(threadIdx.x & 255))
#define VBID ((int)(blockIdx.x * 2 + (threadIdx.x >> 8)))
#define VGRID ((int)(gridDim.x * 2))
typedef unsigned short bf16_t;
typedef short bf16x8 __attribute__((ext_vector_type(8)));
typedef float f32x4 __attribute__((ext_vector_type(4)));
typedef unsigned u32x4 __attribute__((ext_vector_type(4)));
typedef __bf16 bf16x2_t __attribute__((ext_vector_type(2)));

constexpr int T = 32768, D = 1024, SEQ = 2048, NB = 16;
constexpr int AB_IN = 3088, AB_IN_PAD = 3200;
constexpr float EPS = 1e-6f;
constexpr int NEXP = 16384;
constexpr int kDynLds = 163840;

constexpr size_t SZ_WT_IN = (size_t)AB_IN_PAD * 1024 * 2;
constexpr size_t SZ_WT_OUT = (size_t)1024 * 1024 * 2;
constexpr size_t SZ_WT_CIN = (size_t)4096 * 1024 * 2;
constexpr size_t SZ_WT_COUT = (size_t)1024 * 2048 * 2;
constexpr size_t SZ_WT_Q = (size_t)2 * 2048 * 1024 * 2;
constexpr size_t SZ_SK = (size_t)2 * 8 * 2 * 128 * 128 * 2;
constexpr size_t SZ_TAB = (size_t)2 * NEXP * 1024;
constexpr size_t SZ_TSC = (size_t)2 * NEXP * 4;
constexpr size_t OFF_WT_IN = 0;
constexpr size_t OFF_WT_OUT = OFF_WT_IN + SZ_WT_IN;
constexpr size_t OFF_WT_CIN = OFF_WT_OUT + SZ_WT_OUT;
constexpr size_t OFF_WT_COUT = OFF_WT_CIN + SZ_WT_CIN;
constexpr size_t OFF_WT_Q = OFF_WT_COUT + SZ_WT_COUT;
constexpr size_t OFF_SK = OFF_WT_Q + SZ_WT_Q;
constexpr size_t OFF_UT = OFF_SK;
constexpr size_t OFF_USC = OFF_UT + SZ_TAB;
constexpr size_t OFF_VSC = OFF_USC + SZ_TSC;
constexpr size_t OFF_H = OFF_VSC + SZ_TSC;
constexpr size_t OFF_IDX = OFF_H + (size_t)T * 1024 * 2;
constexpr size_t OFF_GATE = OFF_IDX + (size_t)T * 128 * 4;
constexpr size_t OFF_SSQ = OFF_GATE + (size_t)T * 128 * 4;
constexpr size_t OFF_REGION = OFF_SSQ + (size_t)T * 32 * 4;
constexpr size_t SZ_REGION = (size_t)256 << 20;
constexpr size_t OFF_S = OFF_REGION + SZ_REGION;
constexpr size_t OFF_SK_W8 = OFF_S + (size_t)T * 1024 * 2;
constexpr size_t OFF_BAR = OFF_SK_W8 + (size_t)2048 * 1024;
constexpr size_t WS_END = OFF_BAR + 16384;
constexpr size_t R_QSB = 0;
constexpr size_t R_KSB = R_QSB + (size_t)T * 512;
constexpr size_t R_VTSB = R_KSB + (size_t)T * 512;
constexpr size_t R_QG = R_VTSB + (size_t)T * 512;
constexpr size_t R_KG = R_QG + (size_t)T * 256;
constexpr size_t R_VTG = R_KG + (size_t)T * 256;
constexpr size_t R_GG = R_VTG + (size_t)T * 512;
constexpr size_t R_ALR = R_GG + (size_t)T * 512;
constexpr size_t R_KOT = R_ALR + (size_t)T * 32;
constexpr size_t R_DEC = R_KOT + (size_t)T * 256;

struct Params {
    const float* x; const float* norm_mix; const float* norm_ffn; const float* ab_w_in; const float* ab_w_alpha2; const float* ab_b_alpha2;
    const float* ab_gla_norm; const float* ab_w_out; const float* c_w_in; const float* c_v_norm; const float* c_w_spatial; const float* c_b_spatial;
    const float* c_w_out; const float* peer_w_q; const float* peer_subkeys; const float* peer_u; const float* peer_v; const float* final_norm;
    float* out; unsigned char* ws;
};

__device__ __forceinline__ float bf2f(bf16_t v) { return __uint_as_float(((unsigned)v) << 16); }
__device__ __forceinline__ bf16_t f2bf(float f) { unsigned r; asm("v_cvt_pk_bf16_f32 %0, %1, %1" : "=v"(r) : "v"(f)); return (bf16_t)r; }
__device__ __forceinline__ unsigned pack2(float lo, float hi) { unsigned r; asm("v_cvt_pk_bf16_f32 %0, %1, %2" : "=v"(r) : "v"(lo), "v"(hi)); return r; }
__device__ __forceinline__ float lo2f(unsigned w) { return __uint_as_float(w << 16); }
__device__ __forceinline__ float hi2f(unsigned w) { return __uint_as_float(w & 0xffff0000u); }
__device__ __forceinline__ float dot2(unsigned a, unsigned b, float acc) { return __builtin_amdgcn_fdot2_f32_bf16(__builtin_bit_cast(bf16x2_t, a), __builtin_bit_cast(bf16x2_t, b), acc, false); }
#define GELU_C0 -1.0001451969146729f
#define GELU_C1 -1.1498452425003052f
#define GELU_C2 -0.46162763237953186f
#define GELU_C3 -0.051034148782491684f
#define GELU_C4 0.007168652955442667f
#define GELU_C5 -0.0006095620337873697f
#define GELU_C6 2.30170971917687e-05f
__device__ __forceinline__ float gelu_exact(float v) {
    const float a = fminf(fabsf(v), 6.0f);
    float q = GELU_C6 * a + GELU_C5; q = q * a + GELU_C4; q = q * a + GELU_C3; q = q * a + GELU_C2; q = q * a + GELU_C1; q = q * a + GELU_C0;
    return fmaxf(v, 0.f) - fabsf(v) * __builtin_amdgcn_exp2f(q);
}
typedef float f32x2 __attribute__((ext_vector_type(2)));
__device__ __forceinline__ f32x2 gelu_exact2(f32x2 v) {
    const f32x2 av = __builtin_elementwise_abs(v), a = __builtin_elementwise_min(av, (f32x2){6.0f, 6.0f});
    f32x2 q = (f32x2){GELU_C6, GELU_C6} * a + (f32x2){GELU_C5, GELU_C5};
    q = q * a + (f32x2){GELU_C4, GELU_C4}; q = q * a + (f32x2){GELU_C3, GELU_C3}; q = q * a + (f32x2){GELU_C2, GELU_C2};
    q = q * a + (f32x2){GELU_C1, GELU_C1}; q = q * a + (f32x2){GELU_C0, GELU_C0};
    const f32x2 e = {__builtin_amdgcn_exp2f(q[0]), __builtin_amdgcn_exp2f(q[1])};
    return __builtin_elementwise_max(v, (f32x2){0.f, 0.f}) - av * e;
}
__device__ __forceinline__ float row16_sum(float v) {
    v += __builtin_bit_cast(float, __builtin_amdgcn_update_dpp(0, __builtin_bit_cast(int, v), 0x128, 0xf, 0xf, false));
    v += __builtin_bit_cast(float, __builtin_amdgcn_update_dpp(0, __builtin_bit_cast(int, v), 0x124, 0xf, 0xf, false));
    v += __builtin_bit_cast(float, __builtin_amdgcn_update_dpp(0, __builtin_bit_cast(int, v), 0x122, 0xf, 0xf, false));
    v += __builtin_bit_cast(float, __builtin_amdgcn_update_dpp(0, __builtin_bit_cast(int, v), 0x121, 0xf, 0xf, false));
    return v;
}
__device__ __forceinline__ float wave_sum(float v) {
#pragma unroll
    for (int o = 32; o >= 1; o >>= 1) v += __shfl_xor(v, o);
    return v;
}

template <bool PERM_IN = false>
__device__ __forceinline__ void transpose_convert(const float* __restrict__ W, bf16_t* __restrict__ Wt, int K, int N, int Npad, char* smem, int vb0 = 0, const float* __restrict__ kgain = nullptr, unsigned char* __restrict__ W8 = nullptr, int f8from = 0) {
    float* tile = (float*)smem;
    const int tk = K / 64, tn = Npad / 64, ntile = tk * tn;
    const int tid = VTID;
    if (VBID < vb0) return;
    for (int tl = VBID - vb0; tl < ntile; tl += VGRID - vb0) {
        const int k0 = (tl % tk) * 64, n0 = (tl / tk) * 64;
        const int c = tid & 63, r0 = tid >> 6;
        int nd = n0;
        if (PERM_IN) { if (n0 >= 1024 && n0 < 1536) nd = n0 + 1024; else if (n0 >= 1536 && n0 < 2048) nd = n0 - 512; else if (n0 >= 2048 && n0 < 2560) nd = n0 + 512; else if (n0 >= 2560 && n0 < 3072) nd = n0 - 1024; }
#pragma unroll
        for (int i = 0; i < 16; ++i) {
            const int r = r0 + 4 * i;
            float v = (n0 + c < N) ? W[(size_t)(k0 + r) * N + n0 + c] : 0.f;
            if (kgain) v *= kgain[k0 + r];
            tile[c * 65 + r] = v;
        }
        __syncthreads();
#pragma unroll
        for (int i = 0; i < 16; ++i) {
            const int n = r0 + 4 * i;
            Wt[(size_t)(nd + n) * K + k0 + c] = f2bf(tile[n * 65 + c]);
            if (W8 && nd >= f8from) { const float w64 = tile[n * 65 + c] * 64.0f; W8[(size_t)(nd + n - f8from) * K + k0 + c] = (unsigned char)__builtin_amdgcn_cvt_pk_fp8_f32(w64, w64, 0, false); }
        }
        __syncthreads();
    }
}
__device__ __forceinline__ void quantize_tables_static(const Params& p, int vb0 = 0) {
    const int lane = VTID & 63, wid = VTID >> 6;
    if (VBID < vb0) return;
    for (unsigned task = (unsigned)(VBID - vb0); task < 512u; task += (unsigned)(VGRID - vb0)) {
        const bool isv = task >= 256u;
        const int r0 = (int)(task & 255u) * 128 + wid * 32;
        const float* src = isv ? p.peer_v : p.peer_u;
        unsigned char* recs = p.ws + OFF_UT;
        _Float16* sct = (_Float16*)(p.ws + OFF_USC);
        f32x4 vnx[4];
        {
            const float* x0 = src + (size_t)r0 * 1024 + lane * 4;
#pragma unroll
            for (int i = 0; i < 4; ++i) vnx[i] = *(const f32x4*)(x0 + i * 256);
        }
        for (int rr = 0; rr < 32; ++rr) {
            const int r = r0 + rr;
            f32x4 v[4]; float aml = 0.f;
#pragma unroll
            for (int i = 0; i < 4; ++i) {
                v[i] = vnx[i];
                aml = fmaxf(aml, fmaxf(fmaxf(fabsf(v[i][0]), fabsf(v[i][1])), fmaxf(fabsf(v[i][2]), fabsf(v[i][3]))));
            }
            if (rr + 1 < 32) {
                const float* xn = src + (size_t)(r + 1) * 1024 + lane * 4;
#pragma unroll
                for (int i = 0; i < 4; ++i) vnx[i] = *(const f32x4*)(xn + i * 256);
            }
#pragma unroll
            for (int o = 32; o >= 1; o >>= 1) aml = fmaxf(aml, __shfl_xor(aml, o));
            float ssq = 0.f;
#pragma unroll
            for (int i = 0; i < 4; ++i) ssq += (v[i][0] * v[i][0] + v[i][1] * v[i][1]) + (v[i][2] * v[i][2] + v[i][3] * v[i][3]);
            ssq = wave_sum(ssq);
            const float gmax = aml * (1.002f / 7.5f);
            const _Float16 hs = (_Float16)fminf(fmaxf(0.34f * sqrtf(ssq * (1.0f / 1024.0f)), 0.5f * gmax), gmax);
            const float gs_ = (float)hs, gi_ = gs_ > 0.f ? 1.0f / gs_ : 0.f;
            const int sgn = isv ? 0 : 8;
            unsigned char* rec = recs + (size_t)r * 1024 + (isv ? 512 : 0);
#pragma unroll
            for (int i = 0; i < 4; ++i) {
                unsigned wv = 0;
#pragma unroll
                for (int j = 0; j < 4; ++j) wv |= (unsigned)(min(15, max(0, __float2int_rn(v[i][j] * gi_ + 7.5f))) ^ sgn) << (8 * j);
                wv <<= (lane & 1) * 4;
                wv |= (unsigned)__shfl_xor((int)wv, 1);
                if ((lane & 1) == 0) *(unsigned*)(rec + 128 * i + (lane >> 1) * 4) = wv;
            }
            if (lane == 0) sct[(size_t)r * 2 + (isv ? 1 : 0)] = (_Float16)gs_;
        }
    }
}
__device__ __forceinline__ void rmsnorm_rows(const float* __restrict__ X, const float* __restrict__ g, bf16_t* __restrict__ Hout) {
    const int lane = VTID & 63, wid = VTID >> 6;
    const int gw = VBID * 4 + wid, nw = VGRID * 4;
    for (int t = gw; t < T; t += nw) {
        const float* xr = X + (size_t)t * D;
        float4 v[4]; float ss = 0.f;
#pragma unroll
        for (int i = 0; i < 4; ++i) { v[i] = *(const float4*)(xr + i * 256 + lane * 4); ss += v[i].x * v[i].x + v[i].y * v[i].y + v[i].z * v[i].z + v[i].w * v[i].w; }
        ss = wave_sum(ss);
        const float rstd = rsqrtf(ss * (1.0f / D) + EPS);
#pragma unroll
        for (int i = 0; i < 4; ++i) {
            const float4 gg = *(const float4*)(g + i * 256 + lane * 4);
            uint2 o; o.x = pack2(v[i].x * rstd * gg.x, v[i].y * rstd * gg.y); o.y = pack2(v[i].z * rstd * gg.z, v[i].w * rstd * gg.w);
            *(uint2*)(Hout + (size_t)t * D + i * 256 + lane * 4) = o;
        }
    }
}

__device__ __forceinline__ void store_bf16x4(bf16_t* p, f32x4 v) { uint2 o; o.x = pack2(v[0], v[1]); o.y = pack2(v[2], v[3]); *(uint2*)p = o; }

#define G8_LAS __attribute__((address_space(3)))
namespace g8 {
constexpr int BM = 256, BK = 64, HALF = 128, HTB = HALF * BK * 2, NXCD = 8, WGM = 8;
__device__ __forceinline__ int lds_byte(int r, int c) { const int st = (r >> 4) * 2 + (c >> 5), rr = r & 15, cc = c & 31, ob = rr * 64 + cc * 2; return st * 1024 + (ob ^ (((ob >> 9) & 1) << 5)); }
__device__ __forceinline__ void stage_rc(int b, int& R, int& C) { const int st = b / 1024, sb = b % 1024, swz = sb ^ (((sb >> 9) & 1) << 5); R = (st >> 1) * 16 + swz / 64; C = (st & 1) * 32 + (swz % 64) / 2; }
__device__ __forceinline__ int perm32(int rho) { const int n = rho >> 4, i = rho & 15; return 8 * (i >> 2) + 4 * n + (i & 3); }
struct Unit { int pm, pn; };
struct Gemm { const bf16_t* A0; const bf16_t* A1; int lda, ksplit; const bf16_t* Bt; int M, N, K; };
struct StaticOrder {
    int nM, nN, nwg, G, c;
    __device__ __forceinline__ void init(int M, int N, int G_, int c_) { nM = M / BM; nN = N / BM; nwg = nM * nN; G = G_; c = c_; }
    __device__ __forceinline__ bool next(int i, Unit& u) const {
        const int L = i * G + c; if (L >= nwg) return false;
        int wgid = L; { const int q = nwg / NXCD, r = nwg % NXCD, xcd = wgid % NXCD, off = wgid / NXCD; wgid = (xcd < r ? xcd * (q + 1) : r * (q + 1) + (xcd - r) * q) + off; }
        const int nig = WGM * nN, gid = wgid / nig, fm = gid * WGM, gsz = (nM - fm) < WGM ? (nM - fm) : WGM;
        u.pm = fm + ((wgid % nig) % gsz); u.pn = (wgid % nig) / gsz; return true;
    }
};
typedef int i32x4v __attribute__((ext_vector_type(4)));
typedef int i32x8v __attribute__((ext_vector_type(8)));
template <class Epi, bool F8 = false>
__device__ __forceinline__ void gemm_phase(G8_LAS unsigned char* lds, const Gemm g, const StaticOrder& S, const Epi& E) {
    const int tid = threadIdx.x, wid = __builtin_amdgcn_readfirstlane(tid >> 6), lane = tid & 63, wr = wid >> 2, wc = wid & 3, fr = lane & 15, fq = lane >> 4;
    const int K = g.K, nt = K / BK, lda = g.lda;
    unsigned voffA[2], voffB[2];
#pragma unroll
    for (int i = 0; i < 2; ++i) { int R, C; stage_rc(tid * 16 + i * 8192, R, C); const int Rb = (R & ~31) + perm32(R & 31);
        voffA[i] = (unsigned)(R * lda + C) * 2u; voffB[i] = (unsigned)(Rb * K + C) * 2u; }
    const size_t hstepA = (size_t)HALF * lda * 2, hstepB = (size_t)HALF * K * 2;
    const unsigned ldsw = (unsigned)wid * 1024u;
    const unsigned ldsbase = (unsigned)__builtin_amdgcn_readfirstlane((int)(unsigned)(__SIZE_TYPE__)lds);
    const int fcol = F8 ? 32 * (fq >> 1) + 24 * (fq & 1) : fq * 8;
    const int aoff = lds_byte(wr * 64 + fr, fcol), boff = lds_byte(wc * 32 + fr, fcol);
    const int aoff2 = F8 ? (aoff ^ 16) : aoff + 1024, boff2 = F8 ? (boff ^ 16) : boff + 1024;
    auto aptr = [&](int pm, int kt) -> const char* { const int kb = kt * BK; const bf16_t* b = kb < g.ksplit ? g.A0 + kb : g.A1 + (kb - g.ksplit); return (const char*)b + (size_t)pm * 2 * hstepA; };
    auto bptr = [&](int pn, int kt) -> const char* { return (const char*)(g.Bt + kt * BK) + (size_t)pn * 2 * hstepB; };
#define G8_SA(b, h) (((b) * 2 + (h)) * HTB)
#define G8_SB(b, h) ((4 + (b) * 2 + (h)) * HTB)
#define G8_STAGE(bufoff, gbase, voff) do { _Pragma("unroll") for (int _i = 0; _i < 2; ++_i) { \
        if constexpr (F8) { unsigned _keep; const unsigned _d = ldsbase + (unsigned)(bufoff) + ldsw + _i * 8192u; \
            const char* _gb = (const char*)(gbase) + (size_t)_i * ((voff) == voffA ? hstepA : hstepB) / 2;        \
            asm volatile("s_mov_b32 %0, m0\n\ts_mov_b32 m0, %3\n\ts_nop 0\n\tglobal_load_lds_dwordx4 %1, %2\n\ts_mov_b32 m0, %0" : "=&s"(_keep) : "v"((voff)[0]), "s"(_gb), "s"(_d) : "memory"); } \
        else __builtin_amdgcn_global_load_lds((const unsigned*)((const char*)(gbase) + (voff)[_i]), (G8_LAS unsigned*)(lds + (bufoff) + ldsw + _i * 8192), 16, 0, 0); } } while (0)
#define G8_LD1(d16, d32, addr0, addr1) do { if constexpr (F8) { const i32x4v _lo = *(const G8_LAS i32x4v*)(addr0), _hi = *(const G8_LAS i32x4v*)(addr1); \
            d32 = __builtin_shufflevector(_lo, _hi, 0, 1, 2, 3, 4, 5, 6, 7); } \
        else { d16[0] = *(const G8_LAS bf16x8*)(addr0); d16[1] = *(const G8_LAS bf16x8*)(addr1); } } while (0)
#define G8_LDA(dst, b, h) do { _Pragma("unroll") for (int m = 0; m < 4; ++m) G8_LD1(dst[m], dst##8[m], lds + G8_SA(b, h) + aoff + m * 2048, lds + G8_SA(b, h) + aoff2 + m * 2048); } while (0)
#define G8_LDB(dst, b, h) do { _Pragma("unroll") for (int n = 0; n < 2; ++n) G8_LD1(dst[n], dst##8[n], lds + G8_SB(b, h) + boff + n * 2048, lds + G8_SB(b, h) + boff2 + n * 2048); } while (0)
#define G8_MMA(ai, bj, At, Bt) do { __builtin_amdgcn_s_setprio(1); _Pragma("unroll") for (int m = 0; m < 4; ++m) _Pragma("unroll") for (int n = 0; n < 2; ++n) { \
        if constexpr (F8) acc[ai][bj][m][n] = __builtin_amdgcn_mfma_scale_f32_16x16x128_f8f6f4(Bt##8[n], At##8[m], acc[ai][bj][m][n], 0, 0, 0, sc1, 0, sc1); \
        else { _Pragma("unroll") for (int k = 0; k < 2; ++k) acc[ai][bj][m][n] = __builtin_amdgcn_mfma_f32_16x16x32_bf16(Bt[n][k], At[m][k], acc[ai][bj][m][n], 0, 0, 0); } } \
        __builtin_amdgcn_s_setprio(0); } while (0)
#define G8_WAIT_V(n) asm volatile("s_waitcnt vmcnt(" #n ")" ::: "memory")
#define G8_WAIT_L(n) asm volatile("s_waitcnt lgkmcnt(" #n ")" ::: "memory")
#define G8_BAR __builtin_amdgcn_s_barrier()
#define G8_SCHED __builtin_amdgcn_sched_barrier(0)
    Unit cur, nxt; int ui = 0;
    if (!S.next(0, cur)) return;
    int sc1 = 0x7f7f7f7f; asm volatile("" : "+v"(sc1));
    f32x4 acc[2][2][4][2];
#pragma unroll
    for (int a = 0; a < 2; ++a)
#pragma unroll
        for (int b = 0; b < 2; ++b)
#pragma unroll
            for (int m = 0; m < 4; ++m)
#pragma unroll
                for (int n = 0; n < 2; ++n) acc[a][b][m][n] = (f32x4){0.f, 0.f, 0.f, 0.f};
    bf16x8 At[4][2], B0[2][2], B1[2][2];
    i32x8v At8[4], B08[2], B18[2];
    {
        const char* cA = aptr(cur.pm, 0); const char* cB = bptr(cur.pn, 0); const char* cA1 = aptr(cur.pm, 1); const char* cB1 = bptr(cur.pn, 1);
        G8_STAGE(G8_SB(0, 0), cB, voffB); G8_STAGE(G8_SB(0, 1), cB + hstepB, voffB); G8_STAGE(G8_SA(0, 0), cA, voffA); G8_STAGE(G8_SA(0, 1), cA + hstepA, voffA);
        if (wr == 1) G8_BAR;
        G8_WAIT_V(2); G8_BAR;
        G8_STAGE(G8_SB(1, 0), cB1, voffB); G8_STAGE(G8_SA(1, 0), cA1, voffA); G8_STAGE(G8_SB(1, 1), cB1 + hstepB, voffB);
        G8_WAIT_V(6); G8_BAR;
    }
    for (;;) {
        const bool has_next = S.next(ui + 1, nxt);
        const int npm = has_next ? nxt.pm : cur.pm, npn = has_next ? nxt.pn : cur.pn;
#pragma unroll 1
        for (int t = 0; t < nt; t += 2) {
            const bool last = (t == nt - 2);
            const char* a1 = aptr(cur.pm, t + 1);
            const char* a2 = last ? aptr(npm, 0) : aptr(cur.pm, t + 2); const char* b2 = last ? bptr(npn, 0) : bptr(cur.pn, t + 2);
            const char* a3 = last ? aptr(npm, 1) : aptr(cur.pm, t + 3); const char* b3 = last ? bptr(npn, 1) : bptr(cur.pn, t + 3);
            G8_LDB(B0, 0, 0); G8_LDB(B1, 0, 1); G8_SCHED; G8_LDA(At, 0, 0); G8_STAGE(G8_SA(1, 1), a1 + hstepA, voffA);
            G8_WAIT_V(8); G8_WAIT_L(0); G8_BAR; G8_MMA(0, 0, At, B0); G8_MMA(0, 1, At, B1); G8_BAR; G8_SCHED;
            G8_LDA(At, 0, 1); G8_STAGE(G8_SB(0, 0), b2, voffB); G8_STAGE(G8_SB(0, 1), b2 + hstepB, voffB); G8_STAGE(G8_SA(0, 0), a2, voffA);
            G8_WAIT_V(8); G8_WAIT_L(0); G8_BAR; G8_MMA(1, 0, At, B0); G8_MMA(1, 1, At, B1); G8_BAR; G8_SCHED;
            G8_LDB(B0, 1, 0); G8_LDB(B1, 1, 1); G8_SCHED; G8_LDA(At, 1, 0); G8_STAGE(G8_SA(0, 1), a2 + hstepA, voffA);
            G8_WAIT_V(8); G8_WAIT_L(0); G8_BAR; G8_MMA(0, 0, At, B0); G8_MMA(0, 1, At, B1); G8_BAR; G8_SCHED;
            G8_LDA(At, 1, 1); G8_STAGE(G8_SB(1, 0), b3, voffB); G8_STAGE(G8_SB(1, 1), b3 + hstepB, voffB); G8_STAGE(G8_SA(1, 0), a3, voffA);
            G8_WAIT_V(8); G8_WAIT_L(0); G8_BAR; G8_MMA(1, 0, At, B0); G8_MMA(1, 1, At, B1); G8_BAR; G8_SCHED;
        }
        if (wr == 0) G8_BAR;
        E(acc, cur, wr, wc, fr, fq);
        if (!has_next) break;
#pragma unroll
        for (int a = 0; a < 2; ++a)
#pragma unroll
            for (int b = 0; b < 2; ++b)
#pragma unroll
                for (int m = 0; m < 4; ++m)
#pragma unroll
                    for (int n = 0; n < 2; ++n) acc[a][b][m][n] = (f32x4){0.f, 0.f, 0.f, 0.f};
        cur = nxt; ++ui;
        if (wr == 1) G8_BAR;
    }
    G8_WAIT_V(0);
    G8_BAR;
#undef G8_SA
#undef G8_SB
#undef G8_STAGE
#undef G8_LDA
#undef G8_LDB
#undef G8_MMA
#undef G8_LD1
#undef G8_WAIT_V
#undef G8_WAIT_L
#undef G8_BAR
#undef G8_SCHED
}
struct EpiResid {
    const float* R32; bf16_t* S; float* SSQP; unsigned char* S8;
    __device__ __forceinline__ void operator()(const f32x4 (&acc)[2][2][4][2], const Unit& u, int wr, int wc, int fr, int fq) const {
#pragma unroll
        for (int ai = 0; ai < 2; ++ai)
#pragma unroll
            for (int m = 0; m < 4; ++m) {
                const int row = u.pm * 256 + ai * 128 + wr * 64 + m * 16 + fr;
                const size_t o = (size_t)row * 1024 + u.pn * 256 + wc * 32 + fq * 8;
                float ss = 0.f;
#pragma unroll
                for (int bj = 0; bj < 2; ++bj) {
                    f32x4 a, b;
                    if (R32) { a = *(const f32x4*)(R32 + o + bj * 128); b = *(const f32x4*)(R32 + o + bj * 128 + 4); }
                    else { const u32x4 r = *(const u32x4*)(S + o + bj * 128); a = (f32x4){lo2f(r[0]), hi2f(r[0]), lo2f(r[1]), hi2f(r[1])}; b = (f32x4){lo2f(r[2]), hi2f(r[2]), lo2f(r[3]), hi2f(r[3])}; }
                    a += acc[ai][bj][m][0]; b += acc[ai][bj][m][1];
                    ss += a[0] * a[0] + a[1] * a[1] + a[2] * a[2] + a[3] * a[3] + b[0] * b[0] + b[1] * b[1] + b[2] * b[2] + b[3] * b[3];
                    uint4 w; w.x = pack2(a[0], a[1]); w.y = pack2(a[2], a[3]); w.z = pack2(b[0], b[1]); w.w = pack2(b[2], b[3]);
                    *(uint4*)(S + o + bj * 128) = w;
                    { int p0 = __builtin_amdgcn_cvt_pk_fp8_f32(a[0], a[1], 0, false); p0 = __builtin_amdgcn_cvt_pk_fp8_f32(a[2], a[3], p0, true);
                      int p1 = __builtin_amdgcn_cvt_pk_fp8_f32(b[0], b[1], 0, false); p1 = __builtin_amdgcn_cvt_pk_fp8_f32(b[2], b[3], p1, true);
                      *(uint2*)(S8 + o + bj * 128) = make_uint2((unsigned)p0, (unsigned)p1); }
                }
                ss += __shfl_xor(ss, 16); ss += __shfl_xor(ss, 32);
                if (fq == 0) SSQP[(size_t)row * 32 + u.pn * 4 + wc] = ss;
            }
    }
};
struct EpiCinUS {
    bf16_t* U; const bf16_t* VT; const float* SSQ; const float* Wsp; const float* bsp; const float* vnorm; G8_LAS unsigned char* L; const float* RSTD;
    __device__ __forceinline__ void operator()(const f32x4 (&acc)[2][2][4][2], const Unit& u, int wr, int wc, int fr_, int fq_) const {
        int lz = 0; asm volatile("" : "+v"(lz));
        const int tid = (int)threadIdx.x + lz, fr = tid & 15, fq = (tid >> 4) & 3, g = u.pn; (void)fr_; (void)fq_;
        G8_LAS float* RS = (G8_LAS float*)(L + 24576);
        unsigned gu[2][2][4][4];
#pragma unroll
        for (int ai = 0; ai < 2; ++ai)
#pragma unroll
            for (int bj = 0; bj < 2; ++bj)
#pragma unroll
                for (int m = 0; m < 4; ++m) {
                    const float rs = RSTD[u.pm * 256 + ai * 128 + wr * 64 + m * 16 + fr];
                    const f32x4 a = acc[ai][bj][m][0] * rs, b = acc[ai][bj][m][1] * rs;
                    const f32x2 g0 = gelu_exact2((f32x2){a[0], a[1]}), g1 = gelu_exact2((f32x2){a[2], a[3]}), g2 = gelu_exact2((f32x2){b[0], b[1]}), g3 = gelu_exact2((f32x2){b[2], b[3]});
                    gu[ai][bj][m][0] = pack2(g0[0], g0[1]); gu[ai][bj][m][1] = pack2(g1[0], g1[1]); gu[ai][bj][m][2] = pack2(g2[0], g2[1]); gu[ai][bj][m][3] = pack2(g3[0], g3[1]);
                }
        if (tid < 256) {
            const float* sp = SSQ + (size_t)(u.pm * 256 + tid) * 32;
            f32x4 s4 = *(const f32x4*)sp;
#pragma unroll
            for (int i = 1; i < 8; ++i) s4 += *(const f32x4*)(sp + 4 * i);
            RS[tid] = rsqrtf(((s4[0] + s4[1]) + (s4[2] + s4[3])) * (1.0f / 2048.0f) + EPS);
        }
        __syncthreads();
#pragma unroll
        for (int ai = 0; ai < 2; ++ai) {
            const int chunk = u.pm * 2 + ai;
            {
                const int t1 = tid >> 3, c1 = tid & 7;
#pragma unroll
                for (int part = 0; part < 3; ++part) {
                    const int t = part == 0 ? t1 : 64 + ((tid + (part - 1) * 512) >> 4), ch = part == 0 ? c1 : ((tid + (part - 1) * 512) & 15), s0 = ch * 8;
                    const float* wp = Wsp + (size_t)(g * 128 + t) * 128 + s0;
                    const f32x4 w0 = *(const f32x4*)wp, w1 = *(const f32x4*)(wp + 4);
                    const f32x4 r0 = *(const G8_LAS f32x4*)(RS + ai * 128 + s0), r1 = *(const G8_LAS f32x4*)(RS + ai * 128 + s0 + 4);
                    float v[8];
#pragma unroll
                    for (int j = 0; j < 4; ++j) { v[j] = (s0 + j <= t) ? w0[j] * r0[j] : 0.f; v[4 + j] = (s0 + 4 + j <= t) ? w1[j] * r1[j] : 0.f; }
                    u32x4 o; o.x = pack2(v[0], v[1]); o.y = pack2(v[2], v[3]); o.z = pack2(v[4], v[5]); o.w = pack2(v[6], v[7]);
                    const int off = part == 0 ? t * 128 + ((ch ^ (t & 7)) << 4) : 8192 + (t - 64) * 256 + ((ch ^ (t & 7)) << 4);
                    *(G8_LAS u32x4*)(L + off) = o;
                }
            }
            __syncthreads();
            float bias[4];
#pragma unroll
            for (int m = 0; m < 4; ++m) bias[m] = bsp[g * 128 + wr * 64 + m * 16 + fr];
#pragma unroll
            for (int bj = 0; bj < 2; ++bj) {
                f32x4 mac[4][2];
#pragma unroll
                for (int m = 0; m < 4; ++m)
#pragma unroll
                    for (int n = 0; n < 2; ++n) mac[m][n] = (f32x4){0.f, 0.f, 0.f, 0.f};
                const int cb = u.pn * 256 + bj * 128 + wc * 32;
                const bf16_t* vrow0 = VT + ((size_t)chunk * 2048 + cb + perm32(fr)) * 128 + fq * 8;
                const bf16_t* vrow1 = VT + ((size_t)chunk * 2048 + cb + perm32(16 + fr)) * 128 + fq * 8;
                bf16x8 bf0[4], bf1[4];
#pragma unroll
                for (int kk = 0; kk < 4; ++kk) { if (kk < 2 || wr == 1) { bf0[kk] = *(const bf16x8*)(vrow0 + kk * 32); bf1[kk] = *(const bf16x8*)(vrow1 + kk * 32); } }
#pragma unroll
                for (int kk = 0; kk < 4; ++kk) {
                    if (kk < 2 || wr == 1) {
                        bf16x8 af[4];
#pragma unroll
                        for (int m = 0; m < 4; ++m) {
                            const int t = wr * 64 + m * 16 + fr, chn = kk * 4 + fq;
                            const int off = wr == 0 ? t * 128 + ((chn ^ (t & 7)) << 4) : 8192 + (t - 64) * 256 + ((chn ^ (t & 7)) << 4);
                            af[m] = *(const G8_LAS bf16x8*)(L + off);
                        }
#pragma unroll
                        for (int m = 0; m < 4; ++m) {
                            mac[m][0] = __builtin_amdgcn_mfma_f32_16x16x32_bf16(bf0[kk], af[m], mac[m][0], 0, 0, 0);
                            mac[m][1] = __builtin_amdgcn_mfma_f32_16x16x32_bf16(bf1[kk], af[m], mac[m][1], 0, 0, 0);
                        }
                    }
                }
                const f32x4 vn0 = *(const f32x4*)(vnorm + cb + fq * 8), vn1 = *(const f32x4*)(vnorm + cb + fq * 8 + 4);
#pragma unroll
                for (int m = 0; m < 4; ++m) {
                    const f32x4 x0 = vn0 * mac[m][0] + bias[m], x1 = vn1 * mac[m][1] + bias[m];
                    const unsigned q0 = gu[ai][bj][m][0], q1 = gu[ai][bj][m][1], q2 = gu[ai][bj][m][2], q3 = gu[ai][bj][m][3];
                    uint4 o; o.x = pack2(lo2f(q0) * x0[0], hi2f(q0) * x0[1]); o.y = pack2(lo2f(q1) * x0[2], hi2f(q1) * x0[3]); o.z = pack2(lo2f(q2) * x1[0], hi2f(q2) * x1[1]); o.w = pack2(lo2f(q3) * x1[2], hi2f(q3) * x1[3]);
                    *(uint4*)(U + (size_t)(u.pm * 256 + ai * 128 + wr * 64 + m * 16 + fr) * 2048 + cb + fq * 8) = o;
                }
            }
            __syncthreads();
        }
    }
};
struct EpiCinV {
    bf16_t* VT; float* SSQ; const float* RSTD;
    __device__ __forceinline__ void operator()(const f32x4 (&acc)[2][2][4][2], const Unit& u, int wr, int wc, int fr_, int fq_) const {
        int lz = 0; asm volatile("" : "+v"(lz));
        const int lane_ = (int)(threadIdx.x & 63) + lz, fr = lane_ & 15, fq = lane_ >> 4; (void)fr_; (void)fq_;
        f32x4 rs[2][2];
#pragma unroll
        for (int bj = 0; bj < 2; ++bj)
#pragma unroll
            for (int n = 0; n < 2; ++n) rs[bj][n] = *(const f32x4*)(RSTD + u.pn * 256 + bj * 128 + wc * 32 + fq * 8 + n * 4) * (1.0f / 64.0f);
#pragma unroll
        for (int ai = 0; ai < 2; ++ai) {
            float ss[16];
#pragma unroll
            for (int i = 0; i < 16; ++i) ss[i] = 0.f;
#pragma unroll
            for (int m = 0; m < 4; ++m) {
                const int c = u.pm * 256 + ai * 128 + wr * 64 + m * 16 + fr;
#pragma unroll
                for (int bj = 0; bj < 2; ++bj) {
                    float g[8];
#pragma unroll
                    for (int n = 0; n < 2; ++n)
#pragma unroll
                        for (int r = 0; r < 4; r += 2) {
                            const f32x2 x = gelu_exact2((f32x2){acc[ai][bj][m][n][r] * rs[bj][n][r], acc[ai][bj][m][n][r + 1] * rs[bj][n][r + 1]});
                            g[n * 4 + r] = x[0]; g[n * 4 + r + 1] = x[1]; ss[bj * 8 + n * 4 + r] += x[0] * x[0]; ss[bj * 8 + n * 4 + r + 1] += x[1] * x[1];
                        }
                    uint4 o; o.x = pack2(g[0], g[1]); o.y = pack2(g[2], g[3]); o.z = pack2(g[4], g[5]); o.w = pack2(g[6], g[7]);
                    *(uint4*)(VT + ((size_t)(u.pn * 2 + bj) * 2048 + c) * 128 + wc * 32 + fq * 8) = o;
                }
            }
            float mine = 0.f;
#pragma unroll
            for (int i = 0; i < 16; ++i) { const float s = row16_sum(ss[i]); mine = (fr == i) ? s : mine; }
            const int tok = u.pn * 256 + (fr >> 3) * 128 + wc * 32 + fq * 8 + (fr & 7);
            SSQ[(size_t)tok * 32 + u.pm * 4 + ai * 2 + wr] = mine;
        }
    }
};
struct EpiInN {
    bf16_t* R;
    __device__ __forceinline__ void operator()(const f32x4 (&acc)[2][2][4][2], const Unit& u, int wr, int wc, int fr, int fq) const {
        bf16_t* base; int pitch; float sc = 1.0f;
        if (u.pn < 2) { base = R + R_QSB + u.pn * 256; pitch = 512; sc = 0.125f; }
        else if (u.pn < 4) { base = R + R_KSB + (u.pn - 2) * 256; pitch = 512; }
        else if (u.pn == 4) { base = R + R_QG; pitch = 256; }
        else if (u.pn == 5) { base = R + R_KG; pitch = 256; }
        else { base = R + R_GG + (u.pn - 6) * 256; pitch = 512; }
#pragma unroll
        for (int ai = 0; ai < 2; ++ai)
#pragma unroll
            for (int m = 0; m < 4; ++m) {
                bf16_t* rp = base + (size_t)(u.pm * 256 + ai * 128 + wr * 64 + m * 16 + fr) * pitch + wc * 32 + fq * 8;
#pragma unroll
                for (int bj = 0; bj < 2; ++bj) {
                    f32x4 a = acc[ai][bj][m][0] * sc, b = acc[ai][bj][m][1] * sc;
                    if (u.pn >= 6) {
#pragma unroll
                        for (int r = 0; r < 4; ++r) { a[r] = a[r] * __builtin_amdgcn_rcpf(1.0f + __expf(-a[r])); b[r] = b[r] * __builtin_amdgcn_rcpf(1.0f + __expf(-b[r])); }
                    }
                    uint4 o; o.x = pack2(a[0], a[1]); o.y = pack2(a[2], a[3]); o.z = pack2(b[0], b[1]); o.w = pack2(b[2], b[3]);
                    *(uint4*)(rp + bj * 128) = o;
                }
            }
    }
};
struct EpiInT {
    bf16_t* R;
    __device__ __forceinline__ void operator()(const f32x4 (&acc)[2][2][4][2], const Unit& u, int wr, int wc, int fr, int fq) const {
#pragma unroll
        for (int ai = 0; ai < 2; ++ai)
#pragma unroll
            for (int m = 0; m < 4; ++m) {
                const int c = u.pm * 256 + ai * 128 + wr * 64 + m * 16 + fr;
#pragma unroll
                for (int bj = 0; bj < 2; ++bj) {
                    const int t = u.pn * 256 + bj * 128 + wc * 32 + fq * 8, b = t >> 11, s = t & 2047;
                    bf16_t* dst;
                    if (c < 512) dst = R + R_VTSB + ((size_t)((b * 8 + (c >> 6)) * 64 + (c & 63))) * 2048 + s;
                    else { const int c2 = c - 512; dst = R + R_VTG + ((size_t)((b * 4 + (c2 >> 7)) * 128 + (c2 & 127))) * 2048 + s; }
                    const f32x4 a = acc[ai][bj][m][0], bb = acc[ai][bj][m][1];
                    uint4 o; o.x = pack2(a[0], a[1]); o.y = pack2(a[2], a[3]); o.z = pack2(bb[0], bb[1]); o.w = pack2(bb[2], bb[3]);
                    *(uint4*)dst = o;
                }
            }
    }
};
}
__device__ __forceinline__ void phase_gemm_resid8(const bf16_t* A0, const bf16_t* A1, int lda, int ksplit, const bf16_t* Bt, int K, const float* R32, bf16_t* Sres, float* SSQP, unsigned char* S8, char* smem_phys) {
    g8::Gemm g{A0, A1, lda, ksplit, Bt, T, 1024, K};
    g8::StaticOrder S; S.init(T, 1024, (int)gridDim.x, (int)blockIdx.x);
    g8::EpiResid E{R32, Sres, SSQP, S8};
    g8::gemm_phase<g8::EpiResid>((G8_LAS unsigned char*)smem_phys, g, S, E);
}

__device__ __forceinline__ void phase_gemm_cin8_v(const Params& p, char* smem_phys) {
    bf16_t* U = (bf16_t*)(p.ws + OFF_REGION); bf16_t* VT = U + (size_t)T * 2048; float* SSQ = (float*)(p.ws + OFF_SSQ);
    const bf16_t* Wv = (const bf16_t*)(p.ws + OFF_SK_W8); const bf16_t* H8 = (const bf16_t*)(p.ws + OFF_H + ((size_t)32 << 20));
    g8::Gemm g{Wv, Wv, 512, 512, H8, 2048, T, 512};
    g8::StaticOrder S; S.init(2048, T, (int)gridDim.x, (int)blockIdx.x);
    g8::EpiCinV E{VT, SSQ, (const float*)(p.ws + OFF_VSC)};
    g8::gemm_phase<g8::EpiCinV, true>((G8_LAS unsigned char*)smem_phys, g, S, E);
}
__device__ __forceinline__ void phase_gemm_cin8_u(const Params& p, char* smem_phys) {
    const bf16_t* H = (const bf16_t*)(p.ws + OFF_S); const bf16_t* W = (const bf16_t*)(p.ws + OFF_WT_CIN);
    bf16_t* U = (bf16_t*)(p.ws + OFF_REGION); bf16_t* VT = U + (size_t)T * 2048; float* SSQ = (float*)(p.ws + OFF_SSQ);
    g8::Gemm g{H, H, 1024, 1024, W, T, 2048, 1024};
    g8::StaticOrder S; S.init(T, 2048, (int)gridDim.x, (int)blockIdx.x);
    g8::EpiCinUS E{U, VT, SSQ, p.c_w_spatial, p.c_b_spatial, p.c_v_norm, (G8_LAS unsigned char*)(smem_phys + 131072), (const float*)(p.ws + OFF_VSC)};
    g8::gemm_phase<g8::EpiCinUS>((G8_LAS unsigned char*)smem_phys, g, S, E);
}
__device__ __forceinline__ void phase_gemm_in8(const Params& p, char* smem_phys) {
    const bf16_t* H = (const bf16_t*)(p.ws + OFF_H); const bf16_t* W = (const bf16_t*)(p.ws + OFF_WT_IN);
    bf16_t* R = (bf16_t*)(p.ws + OFF_REGION);
    {
        g8::Gemm g{H, H, 1024, 1024, W, T, 2048, 1024};
        g8::StaticOrder S; S.init(T, 2048, (int)gridDim.x, (int)blockIdx.x);
        g8::EpiInN E{R};
        g8::gemm_phase<g8::EpiInN>((G8_LAS unsigned char*)smem_phys, g, S, E);
    }
    {
        const bf16_t* Wv = W + (size_t)2048 * 1024;
        g8::Gemm g{Wv, Wv, 1024, 1024, H, 1024, T, 1024};
        g8::StaticOrder S; S.init(1024, T, (int)gridDim.x, (int)blockIdx.x);
        g8::EpiInT E{R};
        g8::gemm_phase<g8::EpiInT>((G8_LAS unsigned char*)smem_phys, g, S, E);
    }
    {
        const int lane = threadIdx.x & 63, wid = threadIdx.x >> 6, fr = lane & 15, fq = lane >> 4;
        float* ALR = (float*)(R + R_ALR);
        for (int task = (int)blockIdx.x * 8 + wid; task < T / 16; task += (int)gridDim.x * 8) {
            const bf16_t* a = H + (size_t)(task * 16 + fr) * 1024 + fq * 8; const bf16_t* w = W + (size_t)(3072 + fr) * 1024 + fq * 8;
            f32x4 acc = (f32x4){0.f, 0.f, 0.f, 0.f};
#pragma unroll 8
            for (int kk = 0; kk < 32; ++kk) {
                const bf16x8 af = *(const bf16x8*)(a + kk * 32), wf = *(const bf16x8*)(w + kk * 32);
                acc = __builtin_amdgcn_mfma_f32_16x16x32_bf16(wf, af, acc, 0, 0, 0);
            }
            *(f32x4*)(ALR + (size_t)(task * 16 + fr) * 16 + fq * 4) = acc;
        }
    }
}


typedef float f32x16 __attribute__((ext_vector_type(16)));
__device__ __forceinline__ void sb_fast(const Params& p, char* smem, unsigned* ctr) {
    bf16_t* R = (bf16_t*)(p.ws + OFF_REGION);
    char* KT = smem; char* VTt = smem + 8192;
    volatile int* flags = (volatile int*)(smem + 32768); volatile unsigned* slot = (volatile unsigned*)(smem + 32832);
    const int tid = threadIdx.x, lane = tid & 63, w = tid >> 6, r31 = lane & 31, h = lane >> 5;
    for (;;) {
        __syncthreads();
        if (tid == 0) *slot = atomicAdd(ctr, 1u);
        __syncthreads();
        const unsigned task = *slot;
        if (task >= 1024u) break;
        const int qblk = 7 - (int)(task >> 7), bh = task & 127, b = bh >> 3, hh = bh & 7;
        const int q0 = qblk * 256, qbase = q0 + 32 * w;
        bf16_t* qrow = R + R_QSB + (size_t)(b * 2048 + qbase + r31) * 512 + hh * 64;
        bf16x8 qf[4];
#pragma unroll
        for (int kk = 0; kk < 4; ++kk) qf[kk] = *(const bf16x8*)(qrow + 16 * kk + 8 * h);
        f32x16 oacc[2];
#pragma unroll
        for (int nt = 0; nt < 2; ++nt)
#pragma unroll
            for (int i = 0; i < 16; ++i) oacc[nt][i] = 0.f;
        float Rr = 1.0f;
        const int t = qbase + r31;
        for (int kt = q0 / 64 + 3; kt >= 0; --kt) {
            __syncthreads();
            { const int wd = __all(Rr == 0.f); if (lane == 0) flags[w] = wd; }
            __syncthreads();
            if (flags[0] & flags[1] & flags[2] & flags[3] & flags[4] & flags[5] & flags[6] & flags[7]) break;
            const int s_tile = kt * 64;
            {
                const int c = tid, row = c >> 3, ch = c & 7;
                const u32x4 kv = *(const u32x4*)(R + R_KSB + (size_t)(b * 2048 + s_tile + row) * 512 + hh * 64 + ch * 8);
                const u32x4 vv = *(const u32x4*)(R + R_VTSB + ((size_t)((b * 8 + hh) * 64 + row)) * 2048 + s_tile + ch * 8);
                *(u32x4*)(KT + row * 128 + ((ch ^ (row & 7)) << 4)) = kv;
                *(uint2*)(VTt + row * 136 + ch * 16) = make_uint2(vv[0], vv[1]);
                *(uint2*)(VTt + row * 136 + ch * 16 + 8) = make_uint2(vv[2], vv[3]);
            }
            __syncthreads();
#pragma unroll
            for (int sbk = 1; sbk >= 0; --sbk) {
                const int key_lo = s_tile + 32 * sbk;
                if (key_lo >= qbase + 31) continue;
                if (__all(Rr == 0.f)) continue;
                f32x16 st;
#pragma unroll
                for (int i = 0; i < 16; ++i) st[i] = 0.f;
                const int krow = 32 * sbk + r31;
#pragma unroll
                for (int kk = 0; kk < 4; ++kk) {
                    const bf16x8 kf = *(const bf16x8*)(KT + krow * 128 + (((2 * kk + h) ^ (krow & 7)) << 4));
                    st = __builtin_amdgcn_mfma_f32_32x32x16_bf16(kf, qf[kk], st, 0, 0, 0);
                }
                float a[16], G[4];
                const bool diag = key_lo + 31 >= qbase;
#pragma unroll
                for (int g = 0; g < 4; ++g) {
                    float sg[4], m[4];
#pragma unroll
                    for (int i = 0; i < 4; ++i) {
                        const float z = fmaxf(st[4 * g + i], -80.f);
                        const float ez = __builtin_amdgcn_exp2f(z * -1.4426950409f), sig = __builtin_amdgcn_rcpf(1.0f + ez);
                        sg[i] = sig; m[i] = ez * sig;
                    }
                    if (diag) {
#pragma unroll
                        for (int i = 0; i < 4; ++i) { const bool valid = key_lo + 8 * g + 4 * h + i < t; sg[i] = valid ? sg[i] : 0.f; m[i] = valid ? m[i] : 1.0f; }
                    }
                    const float x2 = m[3], x1 = x2 * m[2], x0 = x1 * m[1];
                    G[g] = x0 * m[0];
                    a[4 * g + 3] = sg[3]; a[4 * g + 2] = sg[2] * x2; a[4 * g + 1] = sg[1] * x1; a[4 * g] = sg[0] * x0;
                }
                float Go[4], P[4];
#pragma unroll
                for (int g = 0; g < 4; ++g) { Go[g] = __shfl_xor(G[g], 32); P[g] = G[g] * Go[g]; }
                const float c2 = P[3], c1 = c2 * P[2], c0 = c1 * P[1];
                float Tg[4];
                Tg[3] = Rr; Tg[2] = Rr * c2; Tg[1] = Rr * c1; Tg[0] = Rr * c0;
#pragma unroll
                for (int g = 0; g < 4; ++g) {
                    const float tg = (h == 0) ? Tg[g] * Go[g] : Tg[g];
                    a[4 * g] *= tg; a[4 * g + 1] *= tg; a[4 * g + 2] *= tg; a[4 * g + 3] *= tg;
                }
                Rr = Rr * c0 * P[0];
#pragma unroll
                for (int s2 = 0; s2 < 2; ++s2) {
                    union { bf16x8 v; unsigned u[4]; } af;
#pragma unroll
                    for (int j2 = 0; j2 < 4; ++j2) af.u[j2] = pack2(a[8 * s2 + 2 * j2], a[8 * s2 + 2 * j2 + 1]);
#pragma unroll
                    for (int nt = 0; nt < 2; ++nt) {
                        const char* vp = VTt + (32 * nt + r31) * 136 + 64 * sbk + 32 * s2 + 8 * h;
                        union { bf16x8 v; uint2 hh2[2]; } vf;
                        vf.hh2[0] = *(const uint2*)vp; vf.hh2[1] = *(const uint2*)(vp + 16);
                        oacc[nt] = __builtin_amdgcn_mfma_f32_32x32x16_bf16(af.v, vf.v, oacc[nt], 0, 0, 0);
                    }
                }
            }
        }
#pragma unroll
        for (int nt = 0; nt < 2; ++nt)
#pragma unroll
            for (int i = 0; i < 16; ++i) {
                const int qq = (i & 3) + 8 * (i >> 2) + 4 * h;
                R[R_QSB + (size_t)(b * 2048 + qbase + qq) * 512 + hh * 64 + 32 * nt + r31] = f2bf(oacc[nt][i]);
            }
    }
}
__device__ __forceinline__ float log_sigmoid(float x) { return fminf(x, 0.f) - __logf(1.0f + __expf(-fabsf(x))); }
__device__ __forceinline__ int swz(int row, int chunk) { return row * 128 + ((chunk ^ (row & 7)) << 4); }
__device__ __forceinline__ void gla_prep(const Params& p, char* smem) {
    bf16_t* R = (bf16_t*)(p.ws + OFF_REGION);
    const float* ALR = (const float*)(R + R_ALR);
    bf16_t* KOTg = R + R_KOT; float* DECg = (float*)(R + R_DEC);
    float* SEG = (float*)smem; float* ALRs = SEG + 256;
    const int tid = VTID, d = tid & 63, w = tid >> 6;
    for (int task = VBID; task < 2048; task += VGRID) {
        const int bh = task >> 5, c = task & 31, b = bh >> 2, hh = bh & 3;
        const size_t rowbase = (size_t)b * 2048 + c * 64;
        unsigned qr[16], kr[16];
#pragma unroll
        for (int i = 0; i < 16; ++i) { const size_t row = rowbase + w * 16 + i; qr[i] = R[R_QG + row * 256 + hh * 64 + d]; kr[i] = R[R_KG + row * 256 + hh * 64 + d]; }
        const f32x4 ar = *(const f32x4*)(ALR + rowbase * 16 + tid * 4);
        float w2r[16];
#pragma unroll
        for (int r = 0; r < 16; ++r) w2r[r] = p.ab_w_alpha2[r * 256 + hh * 64 + d];
        const float b2r = p.ab_b_alpha2[hh * 64 + d];
        __syncthreads();
        *(f32x4*)(ALRs + tid * 4) = ar;
        __syncthreads();
        float cs[16]; float run = 0.f;
#pragma unroll
        for (int i = 0; i < 16; ++i) {
            const float* al = ALRs + (w * 16 + i) * 16;
            float pre = b2r;
#pragma unroll
            for (int r = 0; r < 16; ++r) pre += al[r] * w2r[r];
            run += log_sigmoid(pre) * (1.0f / 16.0f);
            cs[i] = run;
        }
        SEG[w * 64 + d] = run;
        __syncthreads();
        float off = 0.f, tot = 0.f;
#pragma unroll
        for (int w2 = 0; w2 < 4; ++w2) { const float s = SEG[w2 * 64 + d]; tot += s; if (w2 < w) off += s; }
        unsigned kop[8];
#pragma unroll
        for (int i2 = 0; i2 < 8; ++i2) {
            float kov[2];
#pragma unroll
            for (int u = 0; u < 2; ++u) {
                const int i = 2 * i2 + u;
                const float bc = off + cs[i];
                const float kv = bf2f((bf16_t)kr[i]);
                const size_t row = rowbase + w * 16 + i;
                R[R_QG + row * 256 + hh * 64 + d] = f2bf(bf2f((bf16_t)qr[i]) * 0.125f * __expf(bc));
                R[R_KG + row * 256 + hh * 64 + d] = f2bf(kv * __expf(-bc));
                kov[u] = kv * __expf(tot - bc);
            }
            kop[i2] = pack2(kov[0], kov[1]);
        }
        bf16_t* kp = KOTg + ((size_t)task * 64 + d) * 64 + w * 16;
        *(uint4*)kp = make_uint4(kop[0], kop[1], kop[2], kop[3]);
        *(uint4*)(kp + 8) = make_uint4(kop[4], kop[5], kop[6], kop[7]);
        if (w == 0) DECg[(size_t)task * 64 + d] = __expf(tot);
    }
}
__device__ __forceinline__ void gla_scan(const Params& p, char* smem, bool dry = false) {
    bf16_t* R = (bf16_t*)(p.ws + OFF_REGION);
    const bf16_t* KOTg = R + R_KOT; const float* DECg = (const float*)(R + R_DEC);
    char* QS = smem; char* KS = smem + 8192; char* KOT = smem + 16384; char* VTs = smem + 24576; char* SPT = smem + 40960;
    float* DEC = (float*)(smem + 57344); float* GN = DEC + 64;
    const int tid = VTID, lane = tid & 63, w = tid >> 6, l15_ = lane & 15, q4 = lane >> 4;
    for (int task = VBID; task < 64; task += VGRID) {
        const int b = task >> 2, hh = task & 3;
        f32x4 Sacc[8];
#pragma unroll
        for (int nt = 0; nt < 8; ++nt) Sacc[nt] = (f32x4){0.f, 0.f, 0.f, 0.f};
        __syncthreads();
        for (int i = tid; i < 1024; i += 256) *(uint4*)(SPT + i * 16) = make_uint4(0, 0, 0, 0);
        if (tid < 128) GN[tid] = p.ab_gla_norm[hh * 128 + tid];
        const size_t rowbase = (size_t)b * 2048;
        const bf16_t* vbase = R + R_VTG + ((size_t)((b * 4 + hh) * 128)) * 2048;
        u32x4 tq[2], tk[2], tko[2], vr[4]; float td = 0.f;
        auto prefetch = [&](int c) {
            const int t0 = c * 64;
#pragma unroll
            for (int i = 0; i < 2; ++i) {
                const int cid = tid + 256 * i, row = cid >> 3, ch = cid & 7;
                tq[i] = *(const u32x4*)(R + R_QG + (rowbase + t0 + row) * 256 + hh * 64 + ch * 8);
                tk[i] = *(const u32x4*)(R + R_KG + (rowbase + t0 + row) * 256 + hh * 64 + ch * 8);
                tko[i] = *(const u32x4*)(KOTg + (((size_t)task * 32 + c) * 64 + row) * 64 + ch * 8);
            }
#pragma unroll
            for (int i = 0; i < 4; ++i) { const int cid = tid + 256 * i, e = cid >> 3, ch = cid & 7; vr[i] = *(const u32x4*)(vbase + (size_t)e * 2048 + t0 + ch * 8); }
            if (tid < 64) td = DECg[((size_t)task * 32 + c) * 64 + tid];
        };
        prefetch(0);
        for (int c = 0; c < 32; ++c) {
            int lz = 0; asm volatile("" : "+v"(lz));
            const int l15 = l15_ + lz;
            const int cx = (q4 ^ (l15 & 7)) << 4;
            const int rb0 = l15 * 128 + cx, rb1 = l15 * 128 + (cx ^ 64);
#pragma unroll
            for (int i = 0; i < 2; ++i) {
                const int cid = tid + 256 * i + lz, row = cid >> 3, ch = cid & 7;
                *(u32x4*)(QS + swz(row, ch)) = tq[i]; *(u32x4*)(KS + swz(row, ch)) = tk[i]; *(u32x4*)(KOT + swz(row, ch)) = tko[i];
            }
#pragma unroll
            for (int i = 0; i < 4; ++i) { const int cid = tid + 256 * i + lz, e = cid >> 3, ch = cid & 7; *(u32x4*)(VTs + swz(e, ch)) = vr[i]; }
            if (tid < 64) DEC[tid] = td;
            uint2 gr[8];
            const unsigned goff = (unsigned)((rowbase + c * 64 + 16 * w + l15) * 512 + hh * 128 + 4 * q4);
            bf16_t* const gbase = R + R_GG;
#pragma unroll
            for (int nt = 0; nt < 8; ++nt) gr[nt] = *(const uint2*)(gbase + (goff + 16 * nt));
            if (c + 1 < 32) prefetch(c + 1);
            __syncthreads();
            bf16x8 qf[2];
#pragma unroll
            for (int kk = 0; kk < 2; ++kk) qf[kk] = *(const bf16x8*)(QS + w * 2048 + (kk ? rb1 : rb0));
            f32x4 sT[4];
#pragma unroll
            for (int st = 0; st < 4; ++st) {
                sT[st] = (f32x4){0.f, 0.f, 0.f, 0.f};
                if (st <= w) {
#pragma unroll
                    for (int kk = 0; kk < 2; ++kk) { const bf16x8 kf = *(const bf16x8*)(KS + st * 2048 + (kk ? rb1 : rb0)); sT[st] = __builtin_amdgcn_mfma_f32_16x16x32_bf16(kf, qf[kk], sT[st], 0, 0, 0); }
#pragma unroll
                    for (int r = 0; r < 4; ++r) if (16 * st + 4 * q4 + r > 16 * w + l15) sT[st][r] = 0.f;
                }
            }
            bf16x8 af[2];
#pragma unroll
            for (int ks2 = 0; ks2 < 2; ++ks2) {
                union { bf16x8 v; unsigned u[4]; } cv;
                cv.u[0] = pack2(sT[2 * ks2][0], sT[2 * ks2][1]); cv.u[1] = pack2(sT[2 * ks2][2], sT[2 * ks2][3]);
                cv.u[2] = pack2(sT[2 * ks2 + 1][0], sT[2 * ks2 + 1][1]); cv.u[3] = pack2(sT[2 * ks2 + 1][2], sT[2 * ks2 + 1][3]);
                af[ks2] = cv.v;
            }
            const int vb = l15 * 128 + ((((q4 >> 1) ^ (l15 & 7)) << 4) | ((q4 & 1) * 8));
            f32x4 o[8];
#pragma unroll
            for (int nt = 0; nt < 8; ++nt) {
                o[nt] = (f32x4){0.f, 0.f, 0.f, 0.f};
                const int e = 16 * nt + l15;
#pragma unroll
                for (int kk = 0; kk < 2; ++kk) { const bf16x8 sf = *(const bf16x8*)(SPT + nt * 2048 + (kk ? rb1 : rb0)); o[nt] = __builtin_amdgcn_mfma_f32_16x16x32_bf16(sf, qf[kk], o[nt], 0, 0, 0); }
#pragma unroll
                for (int ks2 = 0; ks2 < 2; ++ks2) {
                    if (2 * ks2 <= w) {
                        union { bf16x8 v; uint2 h[2]; } cv;
                        cv.h[0] = *(const uint2*)(VTs + nt * 2048 + (vb ^ (ks2 * 64)));
                        cv.h[1] = *(const uint2*)(VTs + nt * 2048 + (vb ^ (ks2 * 64) ^ 32));
                        o[nt] = __builtin_amdgcn_mfma_f32_16x16x32_bf16(cv.v, af[ks2], o[nt], 0, 0, 0);
                    }
                }
            }
            {
                const float4 dc = *(const float4*)(DEC + 16 * w + 4 * q4);
                bf16x8 kof[2];
#pragma unroll
                for (int kk = 0; kk < 2; ++kk) kof[kk] = *(const bf16x8*)(KOT + w * 2048 + (kk ? rb1 : rb0));
#pragma unroll
                for (int nt = 0; nt < 8; ++nt) {
                    Sacc[nt][0] *= dc.x; Sacc[nt][1] *= dc.y; Sacc[nt][2] *= dc.z; Sacc[nt][3] *= dc.w;
#pragma unroll
                    for (int kk = 0; kk < 2; ++kk) { const bf16x8 vf = *(const bf16x8*)(VTs + nt * 2048 + (kk ? rb1 : rb0)); Sacc[nt] = __builtin_amdgcn_mfma_f32_16x16x32_bf16(kof[kk], vf, Sacc[nt], 0, 0, 0); }
                }
            }
            __syncthreads();
#pragma unroll
            for (int nt = 0; nt < 8; ++nt) {
                const int e = 16 * nt + l15;
                uint2 pk; pk.x = pack2(Sacc[nt][0], Sacc[nt][1]); pk.y = pack2(Sacc[nt][2], Sacc[nt][3]);
                *(uint2*)(SPT + nt * 2048 + l15 * 128 + (((2 * w + (q4 >> 1)) ^ (l15 & 7)) << 4) + (q4 & 1) * 8) = pk;
            }
            float ssq = 0.f;
#pragma unroll
            for (int nt = 0; nt < 8; ++nt) ssq += (o[nt][0] * o[nt][0] + o[nt][1] * o[nt][1]) + (o[nt][2] * o[nt][2] + o[nt][3] * o[nt][3]);
            ssq += __shfl_xor(ssq, 16); ssq += __shfl_xor(ssq, 32);
            const float rsd = rsqrtf(ssq * (1.0f / 128.0f) + EPS);
#pragma unroll
            for (int nt = 0; nt < 8; ++nt) {
                asm volatile("" ::: "memory");
                const f32x4 gn = *(const f32x4*)(GN + 16 * nt + 4 * q4);
                const float g0 = lo2f(gr[nt].x), g1 = hi2f(gr[nt].x), g2 = lo2f(gr[nt].y), g3 = hi2f(gr[nt].y);
                uint2 ov;
                ov.x = pack2(o[nt][0] * rsd * gn[0] * g0, o[nt][1] * rsd * gn[1] * g1);
                ov.y = pack2(o[nt][2] * rsd * gn[2] * g2, o[nt][3] * rsd * gn[3] * g3);
                if (!dry || ov.x == 0x7fc17fc1u) *(uint2*)(gbase + (goff + 16 * nt)) = ov;
            }
        }
    }
}

__device__ __forceinline__ unsigned ord_key(float f) { const unsigned u = __float_as_uint(f); return (u & 0x80000000u) ? ~u : (u | 0x80000000u); }
__device__ __forceinline__ float unord_key(unsigned k) { return __uint_as_float((k & 0x80000000u) ? (k & 0x7fffffffu) : ~k); }
__device__ __forceinline__ void ce_desc(unsigned& a, unsigned& b) { const unsigned hi = max(a, b), lo = min(a, b); a = hi; b = lo; }
__device__ __forceinline__ void bitonic_sort16_desc(unsigned (&a)[16]) {
#pragma unroll
    for (int k = 2; k <= 16; k <<= 1)
#pragma unroll
        for (int j = k >> 1; j > 0; j >>= 1)
#pragma unroll
            for (int i = 0; i < 16; ++i) { const int l = i ^ j; if (l > i) { if ((i & k) == 0) ce_desc(a[i], a[l]); else ce_desc(a[l], a[i]); } }
}
__device__ __forceinline__ void merge_top16(unsigned (&L)[16], const unsigned (&B)[16]) {
#pragma unroll
    for (int i = 0; i < 16; ++i) L[i] = max(L[i], B[15 - i]);
#pragma unroll
    for (int j = 8; j > 0; j >>= 1)
#pragma unroll
        for (int i = 0; i < 16; ++i) { const int l = i ^ j; if (l > i) ce_desc(L[i], L[l]); }
}
__device__ constexpr int cand_i(int n) { int c = 0; for (int i = 0; i < 16; ++i) for (int j = 0; j < 16; ++j) if ((i + 1) * (j + 1) <= 16) { if (c == n) return i; ++c; } return -1; }
__device__ constexpr int cand_j(int n) { int c = 0; for (int i = 0; i < 16; ++i) for (int j = 0; j < 16; ++j) if ((i + 1) * (j + 1) <= 16) { if (c == n) return j; ++c; } return -1; }
template <int N> struct CandTab { int i[N], j[N]; constexpr CandTab() : i(), j() { for (int n = 0; n < N; ++n) { i[n] = cand_i(n); j[n] = cand_j(n); } } };

__device__ __forceinline__ bf16x8 pack8(const float4 a, const float4 b) {
    u32x4 t; t.x = pack2(a.x, a.y); t.y = pack2(a.z, a.w); t.z = pack2(b.x, b.y); t.w = pack2(b.z, b.w);
    return __builtin_bit_cast(bf16x8, t);
}
__device__ __forceinline__ void fold_query_weights(const Params& p, int vb0 = 0) {
    int lz = 0; asm volatile("" : "+v"(lz));
    const int lane = (VTID & 63) + lz, wid = VTID >> 6, fr = lane & 15, fq = lane >> 4;
    unsigned char* Wf = p.ws + OFF_WT_Q;
    if (VBID < vb0) return;
    for (int task = VBID - vb0; task < 512; task += VGRID - vb0) {
        const int kb = task & 15, pp = (task >> 4) & 1, h = (task >> 5) & 7, layer = task >> 8;
        const float* wq = p.peer_w_q + (size_t)layer * 1024 * 2048 + (size_t)(kb * 64 + fr) * 2048 + h * 256 + pp * 128 + fq * 8;
        const float* sk = p.peer_subkeys + ((size_t)((layer * 8 + h) * 2 + pp) * 128 + wid * 32 + fr) * 128 + fq * 8;
        f32x4 acc[4][2];
#pragma unroll
        for (int kt = 0; kt < 4; ++kt)
#pragma unroll
            for (int jt = 0; jt < 2; ++jt) acc[kt][jt] = (f32x4){0.f, 0.f, 0.f, 0.f};
#pragma unroll 1
        for (int s = 0; s < 4; ++s) {
            bf16x8 a[4], b[2];
#pragma unroll
            for (int kt = 0; kt < 4; ++kt) { const float* q = wq + (size_t)(kt * 16) * 2048 + s * 32; a[kt] = pack8(*(const float4*)q, *(const float4*)(q + 4)); }
#pragma unroll
            for (int jt = 0; jt < 2; ++jt) { const float* q = sk + (size_t)(jt * 16) * 128 + s * 32; b[jt] = pack8(*(const float4*)q, *(const float4*)(q + 4)); }
#pragma unroll
            for (int kt = 0; kt < 4; ++kt)
#pragma unroll
                for (int jt = 0; jt < 2; ++jt) acc[kt][jt] = __builtin_amdgcn_mfma_f32_16x16x32_bf16(a[kt], b[jt], acc[kt][jt], 0, 0, 0);
        }
#pragma unroll
        for (int jt = 0; jt < 2; ++jt) {
            const int key = wid * 32 + jt * 16 + fr, cu = 128 * ((key >> 5) & 1) + 32 * (2 * pp + (key >> 6)) + (key & 31);
            unsigned char* row = Wf + ((size_t)layer * 2048 + h * 256 + cu) * 1024 + kb * 64 + 4 * fq;
#pragma unroll
            for (int kt = 0; kt < 4; ++kt) {
                const f32x4 wv = acc[kt][jt] * *(const f32x4*)(p.norm_ffn + layer * 1024 + kb * 64 + kt * 16 + 4 * fq) * 64.0f;
                int pk = __builtin_amdgcn_cvt_pk_fp8_f32(wv[0], wv[1], 0, false); pk = __builtin_amdgcn_cvt_pk_fp8_f32(wv[2], wv[3], pk, true);
                *(int*)(row + kt * 16) = pk;
            }
        }
    }
}
__device__ __forceinline__ void bitonic_merge16_desc(unsigned (&L)[16]) {
#pragma unroll
    for (int j = 8; j > 0; j >>= 1)
#pragma unroll
        for (int i = 0; i < 16; ++i) { const int l = i ^ j; if (l > i) ce_desc(L[i], L[l]); }
}
__device__ __forceinline__ void bitonic_sort8_desc(unsigned (&a)[8]) {
#pragma unroll
    for (int k = 2; k <= 8; k <<= 1)
#pragma unroll
        for (int j = k >> 1; j > 0; j >>= 1)
#pragma unroll
            for (int i = 0; i < 8; ++i) { const int l = i ^ j; if (l > i) { if ((i & k) == 0) ce_desc(a[i], a[l]); else ce_desc(a[l], a[i]); } }
}
__device__ __forceinline__ void sort16_desc(unsigned (&a)[16]) {
#define CE_(i, j) ce_desc(a[i], a[j])
    CE_(0,13); CE_(1,12); CE_(2,15); CE_(3,14); CE_(4,8); CE_(5,6); CE_(7,11); CE_(9,10);
    CE_(0,5); CE_(1,7); CE_(2,9); CE_(3,4); CE_(6,13); CE_(8,14); CE_(10,15); CE_(11,12);
    CE_(0,1); CE_(2,3); CE_(4,5); CE_(6,8); CE_(7,9); CE_(10,11); CE_(12,13); CE_(14,15);
    CE_(0,2); CE_(1,3); CE_(4,10); CE_(5,11); CE_(6,7); CE_(8,9); CE_(12,14); CE_(13,15);
    CE_(1,2); CE_(3,12); CE_(4,6); CE_(5,7); CE_(8,10); CE_(9,11); CE_(13,14);
    CE_(1,4); CE_(2,6); CE_(5,8); CE_(7,10); CE_(9,13); CE_(11,14);
    CE_(2,4); CE_(3,6); CE_(9,12); CE_(11,13);
    CE_(3,5); CE_(6,8); CE_(7,9); CE_(10,12);
    CE_(3,4); CE_(5,6); CE_(7,8); CE_(9,10); CE_(11,12);
    CE_(6,7); CE_(8,9);
#undef CE_
}
struct EpiSelect {
    unsigned* IDX; float* GATE; G8_LAS unsigned* X; const float* SSQP; const unsigned* SCT;
    __device__ __forceinline__ void operator()(const f32x4 (&acc)[2][2][4][2], const g8::Unit& u, int wr, int wc, int fr_, int fq_) const {
        int lz = 0; asm volatile("" : "+v"(lz));
        const int lane_ = (int)(threadIdx.x & 63) + lz, fr = lane_ & 15, fq = lane_ >> 4; (void)fr_; (void)fq_;
        const int pp = wc >> 1, half = wc & 1, wid = wr * 4 + wc;
        const unsigned kb = 127u - (unsigned)(half * 64 + fq * 8);
        unsigned Lst[4][16];
#pragma unroll
        for (int ai = 0; ai < 2; ++ai)
#pragma unroll
            for (int m = 0; m < 4; ++m) {
                unsigned C[16], Xc[16];
#pragma unroll
                for (int bj = 0; bj < 2; ++bj)
#pragma unroll
                    for (int n = 0; n < 2; ++n)
#pragma unroll
                        for (int r = 0; r < 4; ++r) C[bj * 8 + n * 4 + r] = (ord_key(acc[ai][bj][m][n][r]) & ~127u) | (kb - (unsigned)(bj * 32 + n * 4 + r));
                sort16_desc(C);
#pragma unroll
                for (int i = 0; i < 16; ++i) Xc[i] = (unsigned)__shfl_xor((int)C[i], 16);
                merge_top16(C, Xc);
#pragma unroll
                for (int i = 0; i < 16; ++i) Xc[i] = (unsigned)__shfl_xor((int)C[i], 32);
                merge_top16(C, Xc);
                if ((m >> 1) == half) {
#pragma unroll
                    for (int i = 0; i < 16; ++i) Lst[ai * 2 + (m & 1)][i] = C[i];
                } else if (fq == 0) {
                    G8_LAS unsigned* xs = X + (((ai * 2 + wr) * 2 + pp) * 4 + m) * 256 + fr;
#pragma unroll
                    for (int i = 0; i < 16; ++i) xs[(i ^ m) << 4] = C[i];
                }
            }
        __syncthreads();
#pragma unroll
        for (int ai = 0; ai < 2; ++ai)
#pragma unroll
            for (int e = 0; e < 2; ++e) {
                const int m = half * 2 + e;
                unsigned Xc[16];
                G8_LAS unsigned* xs = X + (((ai * 2 + wr) * 2 + pp) * 4 + m) * 256 + fr;
#pragma unroll
                for (int i = 0; i < 16; ++i) Xc[i] = xs[(i ^ m) << 4];
                merge_top16(Lst[ai * 2 + e], Xc);
                if (fq == 0) {
#pragma unroll
                    for (int i = 0; i < 16; ++i) xs[(i ^ m) << 4] = Lst[ai * 2 + e][i];
                }
            }
        __syncthreads();
        if (wid < 4) {
            G8_LAS unsigned* x0 = X + ((wid * 2 + 0) * 4 + fq) * 256 + fr; G8_LAS unsigned* x1 = X + ((wid * 2 + 1) * 4 + fq) * 256 + fr;
            float s0[16], s1[16];
#pragma unroll
            for (int i = 0; i < 16; ++i) { s0[i] = unord_key(x0[(i ^ fq) << 4] & ~127u); s1[i] = unord_key(x1[(i ^ fq) << 4] & ~127u); }
#define SEL_CAND(i, j) ((ord_key(s0[i] + s1[j]) & ~255u) | (unsigned)(255 - ((i) * 16 + (j))))
            unsigned C[16], B[16], M2[16], M3[8];
#pragma unroll
            for (int j = 0; j < 16; ++j) C[j] = SEL_CAND(0, j);
#pragma unroll
            for (int k = 0; k < 15; ++k) B[k] = SEL_CAND(k + 1, 0);
            B[15] = 0u;
            merge_top16(C, B);
#pragma unroll
            for (int j = 0; j < 7; ++j) M2[j] = SEL_CAND(1, j + 1);
            M2[7] = 0u; M2[8] = 0u; M2[9] = 0u;
#pragma unroll
            for (int k = 0; k < 6; ++k) M2[15 - k] = SEL_CAND(k + 2, 1);
            bitonic_merge16_desc(M2);
            M3[0] = SEL_CAND(2, 2); M3[1] = SEL_CAND(2, 3); M3[2] = SEL_CAND(2, 4); M3[3] = SEL_CAND(3, 2); M3[4] = SEL_CAND(4, 2); M3[5] = SEL_CAND(3, 3); M3[6] = 0u; M3[7] = 0u;
            bitonic_sort8_desc(M3);
#pragma unroll
            for (int i = 0; i < 8; ++i) B[i] = M3[i];
#pragma unroll
            for (int i = 8; i < 16; ++i) B[i] = 0u;
            merge_top16(M2, B);
            merge_top16(C, M2);
#undef SEL_CAND
            const int tok = u.pm * 256 + (wid >> 1) * 128 + (wid & 1) * 64 + fq * 16 + fr;
            float rstd;
            {
                const f32x4 q0 = *(const f32x4*)(SSQP + (size_t)tok * 32), q1 = *(const f32x4*)(SSQP + (size_t)tok * 32 + 4), q2 = *(const f32x4*)(SSQP + (size_t)tok * 32 + 8), q3 = *(const f32x4*)(SSQP + (size_t)tok * 32 + 12);
                const f32x4 q = (q0 + q1) + (q2 + q3);
                rstd = rsqrtf(((q[0] + q[1]) + (q[2] + q[3])) * (1.0f / D) + EPS);
            }
            const float mx = unord_key(C[0] & ~255u);
            float e[16]; float sum = 0.f;
#pragma unroll
            for (int r = 0; r < 16; ++r) { e[r] = __expf((unord_key(C[r] & ~255u) - mx) * (rstd * (1.0f / 64.0f))); sum += e[r]; }
            const float inv = 1.0f / sum;
            const size_t ob = (size_t)tok * 128 + u.pn * 16;
            unsigned iw[16];
#pragma unroll
            for (int r = 0; r < 16; ++r) {
                const unsigned code = 255u - (C[r] & 255u);
                const unsigned e0 = 127u - (x0[((code >> 4) ^ (unsigned)fq) << 4] & 127u), e1 = 127u - (x1[((code & 15u) ^ (unsigned)fq) << 4] & 127u);
                iw[r] = e0 * 128u + e1;
            }
            unsigned sc[16];
#pragma unroll
            for (int r = 0; r < 16; ++r) sc[r] = SCT[iw[r]];
#pragma unroll
            for (int r = 0; r < 16; ++r) {
                iw[r] |= sc[r] << 16;
                e[r] *= inv * (float)__builtin_bit_cast(_Float16, (unsigned short)(sc[r] >> 16));
            }
#pragma unroll
            for (int r = 0; r < 4; ++r) *(uint4*)(IDX + ob + r * 4) = make_uint4(iw[4 * r], iw[4 * r + 1], iw[4 * r + 2], iw[4 * r + 3]);
#pragma unroll
            for (int r = 0; r < 4; ++r) *(float4*)(GATE + ob + r * 4) = make_float4(e[4 * r], e[4 * r + 1], e[4 * r + 2], e[4 * r + 3]);
        }
        __syncthreads();
    }
};
__device__ __forceinline__ void phase_select8(const Params& p, int layer, char* smem_phys) {
    const bf16_t* H = (const bf16_t*)(p.ws + OFF_H); const bf16_t* Wf = (const bf16_t*)(p.ws + OFF_WT_Q + (size_t)layer * 2048 * 1024);
    g8::Gemm g{H, H, 512, 512, Wf, T, 2048, 512};
    g8::StaticOrder S; S.init(T, 2048, (int)gridDim.x, (int)blockIdx.x);
    EpiSelect E{(unsigned*)(p.ws + OFF_IDX), (float*)(p.ws + OFF_GATE), (G8_LAS unsigned*)(smem_phys + 131072), (const float*)(p.ws + OFF_SSQ), (const unsigned*)(p.ws + OFF_USC) + (size_t)layer * NEXP};
    g8::gemm_phase<EpiSelect, true>((G8_LAS unsigned char*)smem_phys, g, S, E);
    __syncthreads();
    if (threadIdx.x == 0) *(uint4*)(smem_phys + kDynLds - 16) = make_uint4(0u, 0u, 0u, 0u);
    __syncthreads();
}

__device__ __forceinline__ float ub0(unsigned w) { float f; asm("v_cvt_f32_ubyte0 %0, %1" : "=v"(f) : "v"(w)); return f; }
__device__ __forceinline__ float ub1(unsigned w) { float f; asm("v_cvt_f32_ubyte1 %0, %1" : "=v"(f) : "v"(w)); return f; }
__device__ __forceinline__ float ub2(unsigned w) { float f; asm("v_cvt_f32_ubyte2 %0, %1" : "=v"(f) : "v"(w)); return f; }
__device__ __forceinline__ float ub3(unsigned w) { float f; asm("v_cvt_f32_ubyte3 %0, %1" : "=v"(f) : "v"(w)); return f; }
typedef _Float16 f16x2 __attribute__((ext_vector_type(2)));
__device__ __forceinline__ void glds16(const void* gsrc, unsigned lds_dst) {
    unsigned keep; const unsigned d = (unsigned)__builtin_amdgcn_readfirstlane((int)lds_dst);
    asm volatile("s_mov_b32 %0, m0\n\ts_mov_b32 m0, %2\n\ts_nop 0\n\tglobal_load_lds_dwordx4 %1, off\n\ts_mov_b32 m0, %0" : "=&s"(keep) : "v"(gsrc), "s"(d) : "memory");
}
__device__ __forceinline__ void peer_gather(const Params& p, int layer, const float* __restrict__ gnext, bool final_out, char* smem) {
    const unsigned char* REC = p.ws + OFF_UT + (size_t)layer * NEXP * 1024;
    bf16_t* H = (bf16_t*)(p.ws + OFF_H);
    const unsigned* IDX = (const unsigned*)(p.ws + OFF_IDX); const float* GATE = (const float*)(p.ws + OFF_GATE);
    bf16_t* S = (bf16_t*)(p.ws + OFF_S);
    float* sGain = (float*)(smem + 139264);
    { int lz0 = 0; asm volatile("" : "+v"(lz0)); const int i = (int)threadIdx.x + lz0; if (i < 256) ((f32x4*)sGain)[i] = ((const f32x4*)(p.norm_ffn + layer * 1024))[i]; }
    __syncthreads();
    const int lane = VTID & 63, wid = VTID >> 6, sub = lane >> 4, li = lane & 15;
    char* wbase = smem + (int)(threadIdx.x >> 6) * 17408;
    unsigned* sIdx = (unsigned*)wbase; float* sGate = (float*)(wbase + 512);
    const char* ring = wbase + 1024; const unsigned ringb = (unsigned)(size_t)ring;
    const int gw = VBID * 4 + wid, nw = VGRID * 4;
    for (int t = gw; t < T; t += nw) {
        {
            int lz = 0; asm volatile("" : "+v"(lz));
            const int l2 = 2 * (lane + lz);
            const uint2 idp = *(const uint2*)(IDX + (size_t)t * 128 + l2);
            const float2 g2 = *(const float2*)(GATE + (size_t)t * 128 + l2);
            *(uint2*)(sIdx + l2) = idp; *(float2*)(sGate + l2) = g2;
        }
        int XH[2][4], XL[2][4]; float sx; float xg;
        {
            const int jq = sub >> 1, dq = (sub & 1) * 2;
            f32x4 xr[4]; float am = 0.f, ssx = 0.f;
#pragma unroll
            for (int k = 0; k < 2; ++k) {
                const int col = (16 * jq + li) * 32 + (dq + k) * 8;
                const u32x4 raw = *(const u32x4*)(S + (size_t)t * 1024 + col);
                const f32x4 g0 = *(const f32x4*)(sGain + col), g1 = *(const f32x4*)(sGain + col + 4);
                const f32x4 x0 = (f32x4){lo2f(raw[0]), hi2f(raw[0]), lo2f(raw[1]), hi2f(raw[1])}, x1 = (f32x4){lo2f(raw[2]), hi2f(raw[2]), lo2f(raw[3]), hi2f(raw[3])};
                ssx += (x0[0] * x0[0] + x0[1] * x0[1]) + (x0[2] * x0[2] + x0[3] * x0[3]) + (x1[0] * x1[0] + x1[1] * x1[1]) + (x1[2] * x1[2] + x1[3] * x1[3]);
                xr[2 * k] = x0 * g0; xr[2 * k + 1] = x1 * g1;
#pragma unroll
                for (int c = 0; c < 4; ++c) am = fmaxf(am, fmaxf(fabsf(xr[2 * k][c]), fabsf(xr[2 * k + 1][c])));
            }
            am = fmaxf(am, __shfl_xor(am, 1)); am = fmaxf(am, __shfl_xor(am, 2)); am = fmaxf(am, __shfl_xor(am, 4)); am = fmaxf(am, __shfl_xor(am, 8));
            am = fmaxf(am, __shfl_xor(am, 16)); am = fmaxf(am, __shfl_xor(am, 32));
            ssx = row16_sum(ssx); ssx += __shfl_xor(ssx, 16); ssx += __shfl_xor(ssx, 32);
            const float inv = am > 0.f ? 119.0f / am : 0.f;
            sx = am * (1.0f / 119.0f) * rsqrtf(ssx * (1.0f / D) + EPS);
            int xs = 0; int myL[2], myH[2];
#pragma unroll
            for (int k = 0; k < 2; ++k) {
                unsigned lo = 0u, hi = 0u;
#pragma unroll
                for (int i = 0; i < 8; ++i) {
                    const int q = __float2int_rn(xr[k * 2 + (i >> 2)][i & 3] * inv);
                    const int sh = (i & 3) * 8 + (i >> 2) * 4;
                    lo |= ((unsigned)q & 15u) << sh; hi |= ((unsigned)((q + 8) >> 4) & 15u) << sh;
                    xs += q;
                }
                myL[k] = (int)lo; myH[k] = (int)hi;
            }
            xs += __shfl_xor(xs, 16); xs += __shfl_xor(xs, 32);
#pragma unroll
            for (int j = 0; j < 2; ++j)
#pragma unroll
                for (int d = 0; d < 4; ++d) { const int srcl = (2 * j + (d >> 1)) * 16 + li; XL[j][d] = __shfl(myL[d & 1], srcl); XH[j][d] = __shfl(myH[d & 1], srcl); }
            xg = 0.5f * (float)xs;
        }
        f16x2 accp[2][16];
#pragma unroll
        for (int j = 0; j < 2; ++j)
#pragma unroll
            for (int c = 0; c < 16; ++c) accp[j][c] = (f16x2){(_Float16)0.f, (_Float16)0.f};
        float wsg = 0.f;
        auto issue = [&](int sg) {
            const unsigned e_ = sIdx[sg * 4 + sub] & 0xffffu;
            const unsigned char* rec = REC + (size_t)e_ * 1024 + li * 16;
            const unsigned dst = ringb + (unsigned)(sg & 3) * 4096u;
            glds16(rec, dst); glds16(rec + 256, dst + 1024u); glds16(rec + 512, dst + 2048u); glds16(rec + 768, dst + 3072u);
        };
        auto compute = [&](int sg, bool refill) {
            const char* sl = ring + (sg & 3) * 4096;
            const u32x4 du0 = *(const u32x4*)(sl + lane * 16), du1 = *(const u32x4*)(sl + 1024 + lane * 16);
            const u32x4 dv0 = *(const u32x4*)(sl + 2048 + lane * 16), dv1 = *(const u32x4*)(sl + 3072 + lane * 16);
            const float us = (float)__builtin_bit_cast(_Float16, (unsigned short)(sIdx[sg * 4 + sub] >> 16));
            const float gt = sGate[sg * 4 + sub];
            if (refill) { asm volatile("s_waitcnt lgkmcnt(0)" ::: "memory"); issue(sg + 4); }
            int iah = 0, ial = 0;
#pragma unroll
            for (int j = 0; j < 2; ++j) {
#pragma unroll
                for (int d = 0; d < 4; ++d) {
                    const int w = (int)(j ? du1[d] : du0[d]);
                    iah = __builtin_amdgcn_sdot8(w, XH[j][d], iah, false);
                    ial = __builtin_amdgcn_sdot8(w, XL[j][d], ial, false);
                }
            }
            float pa = us * ((float)(16 * iah + ial) + xg);
            pa = row16_sum(pa);
            const float ww = gt * gelu_exact(pa * sx);
            wsg += ww;
            const float wc = fminf(fmaxf(ww * 65536.0f, -65504.0f), 65504.0f);
            const _Float16 wha = (_Float16)wc, whb = (_Float16)(wc * 0.0625f);
            const f16x2 wa = {wha, wha}, wb = {whb, whb};
#pragma unroll
            for (int j = 0; j < 2; ++j) {
#pragma unroll
                for (int d = 0; d < 4; ++d) {
                    const unsigned wv = j ? dv1[d] : dv0[d], wt = wv >> 8;
                    const f16x2 c0 = __builtin_bit_cast(f16x2, wv & 0x000f000fu), c1 = __builtin_bit_cast(f16x2, wv & 0x00f000f0u);
                    const f16x2 c2 = __builtin_bit_cast(f16x2, wt & 0x000f000fu), c3 = __builtin_bit_cast(f16x2, wt & 0x00f000f0u);
                    accp[j][4 * d + 0] = __builtin_elementwise_fma(c0, wa, accp[j][4 * d + 0]); accp[j][4 * d + 1] = __builtin_elementwise_fma(c1, wb, accp[j][4 * d + 1]);
                    accp[j][4 * d + 2] = __builtin_elementwise_fma(c2, wa, accp[j][4 * d + 2]); accp[j][4 * d + 3] = __builtin_elementwise_fma(c3, wb, accp[j][4 * d + 3]);
                }
            }
        };
        asm volatile("s_waitcnt vmcnt(0)" ::: "memory");
        issue(0); issue(1); issue(2); issue(3);
#pragma unroll 1
        for (int sg = 0; sg < 28; ++sg) {
            asm volatile("s_waitcnt vmcnt(12)" ::: "memory");
            compute(sg, true);
        }
        asm volatile("s_waitcnt vmcnt(12)" ::: "memory");
        compute(28, false);
        asm volatile("s_waitcnt vmcnt(8)" ::: "memory");
        compute(29, false);
        asm volatile("s_waitcnt vmcnt(4)" ::: "memory");
        compute(30, false);
        asm volatile("s_waitcnt vmcnt(0)" ::: "memory");
        compute(31, false);
        const bool up2 = (sub & 2) != 0, up1 = (sub & 1) != 0;
        float wsum = wsg + __shfl_xor(wsg, 32);
        wsum += __shfl_xor(wsum, 16);
        f16x2 r1p[16];
#pragma unroll
        for (int c = 0; c < 16; ++c) {
            const f16x2 keep = up2 ? accp[1][c] : accp[0][c], give = up2 ? accp[0][c] : accp[1][c];
            r1p[c] = keep + __builtin_bit_cast(f16x2, __shfl_xor(__builtin_bit_cast(int, give), 32));
        }
        f16x2 r2p[8];
#pragma unroll
        for (int c = 0; c < 8; ++c) {
            const f16x2 keep = up1 ? r1p[8 + c] : r1p[c], give = up1 ? r1p[c] : r1p[8 + c];
            r2p[c] = keep + __builtin_bit_cast(f16x2, __shfl_xor(__builtin_bit_cast(int, give), 16));
        }
        float r2[16];
#pragma unroll
        for (int dl = 0; dl < 2; ++dl) {
            r2[8 * dl + 0] = 256.0f * (float)r2p[4 * dl + 0][0]; r2[8 * dl + 2] = 256.0f * (float)r2p[4 * dl + 0][1];
            r2[8 * dl + 4] = 256.0f * (float)r2p[4 * dl + 1][0]; r2[8 * dl + 6] = 256.0f * (float)r2p[4 * dl + 1][1];
            r2[8 * dl + 1] = 256.0f * (float)r2p[4 * dl + 2][0]; r2[8 * dl + 3] = 256.0f * (float)r2p[4 * dl + 2][1];
            r2[8 * dl + 5] = 256.0f * (float)r2p[4 * dl + 3][0]; r2[8 * dl + 7] = 256.0f * (float)r2p[4 * dl + 3][1];
        }
        const int col0 = (16 * (sub >> 1) + li) * 32 + (sub & 1) * 16;
        float ss = 0.f;
        bf16_t* srow = S + (size_t)t * 1024 + col0;
        {
            const u32x4 b0 = *(const u32x4*)srow, b1 = *(const u32x4*)(srow + 8);
#pragma unroll
            for (int c = 0; c < 8; ++c) {
                const unsigned wsrc = c < 4 ? b0[c] : b1[c - 4];
                r2[2 * c] = r2[2 * c] - 7.5f * wsum + lo2f(wsrc); r2[2 * c + 1] = r2[2 * c + 1] - 7.5f * wsum + hi2f(wsrc);
                ss += r2[2 * c] * r2[2 * c] + r2[2 * c + 1] * r2[2 * c + 1];
            }
        }
        ss = wave_sum(ss);
        const float rstd = rsqrtf(ss * (1.0f / D) + EPS);
        const float* gp = gnext + col0;
        if (final_out) {
            float* orow = p.out + (size_t)t * 1024 + col0;
#pragma unroll
            for (int c4 = 0; c4 < 4; ++c4) {
                const f32x4 g = *(const f32x4*)(gp + c4 * 4);
                *(f32x4*)(orow + c4 * 4) = (f32x4){r2[c4 * 4] * rstd * g[0], r2[c4 * 4 + 1] * rstd * g[1], r2[c4 * 4 + 2] * rstd * g[2], r2[c4 * 4 + 3] * rstd * g[3]};
            }
        } else {
            u32x4 sv[2];
#pragma unroll
            for (int c4 = 0; c4 < 4; ++c4) { sv[c4 >> 1][(c4 & 1) * 2] = pack2(r2[c4 * 4], r2[c4 * 4 + 1]); sv[c4 >> 1][(c4 & 1) * 2 + 1] = pack2(r2[c4 * 4 + 2], r2[c4 * 4 + 3]); }
            *(u32x4*)srow = sv[0]; *(u32x4*)(srow + 8) = sv[1];
            { u32x4 e8;
#pragma unroll
              for (int c = 0; c < 4; ++c) { int pk = __builtin_amdgcn_cvt_pk_fp8_f32(r2[4 * c], r2[4 * c + 1], 0, false); pk = __builtin_amdgcn_cvt_pk_fp8_f32(r2[4 * c + 2], r2[4 * c + 3], pk, true); e8[c] = (unsigned)pk; }
              *(u32x4*)(p.ws + OFF_H + ((size_t)32 << 20) + (size_t)t * 1024 + col0) = e8; }
            if (lane == 0) ((float*)(p.ws + OFF_VSC))[t] = rstd;
        }
    }
}


#define XB_TMO      128
#define XB_XCNT(j)  (256  + 64 * (j))
#define XB_XSUB(j)  (1280 + 64 * (j))
#define XB_XGEN(j)  (2304 + 64 * (j))
#define XB_TOP      3328
#define XB_TOPGEN   3392
#define XCD_BAR_WORDS 3456
#define XB_SPIN_CAP (1u << 22)
#define LAS __attribute__((address_space(3)))
__device__ __forceinline__ unsigned xb_ld(unsigned* p)              { return __hip_atomic_load(p, __ATOMIC_RELAXED, __HIP_MEMORY_SCOPE_AGENT); }
__device__ __forceinline__ unsigned xb_add(unsigned* p, unsigned v) { return __hip_atomic_fetch_add(p, v, __ATOMIC_RELAXED, __HIP_MEMORY_SCOPE_AGENT); }
__device__ __forceinline__ unsigned xb_xcc_id() { return (unsigned)__builtin_amdgcn_s_getreg((3 << 11) | 20) & 0xFu; }
#define XB_SPIN(cond, bar) do { unsigned _sp = 0; while (cond) { __builtin_amdgcn_s_sleep(1); \
    if ((++_sp & 255u) == 0u) { if (xb_ld(&(bar)[XB_TMO])) break; if (_sp > XB_SPIN_CAP) { atomicAdd(&(bar)[XB_TMO], 1u); break; } } } } while (0)
struct XcdBarrier { unsigned* bar; unsigned x; volatile LAS unsigned* st; };
__device__ __forceinline__ XcdBarrier xcd_barrier_post(unsigned* bar, volatile LAS unsigned* st) {
    XcdBarrier b; b.bar = bar; b.x = xb_xcc_id(); b.st = st;
    if (threadIdx.x == 0) (void)xb_add(&bar[XB_XCNT(b.x)], 1u);
    return b;
}
__device__ __forceinline__ void xcd_barrier_complete(unsigned* bar, unsigned x, unsigned& nloc, unsigned& nx) {
    const unsigned G = gridDim.x * gridDim.y * gridDim.z;
    unsigned sum, cnt, mine, sp = 0u;
    for (;;) {
        sum = 0u; cnt = 0u; mine = 0u;
#pragma unroll
        for (unsigned j = 0; j < 16; ++j) { const unsigned c = xb_ld(&bar[XB_XCNT(j)]); sum += c; cnt += (c > 0u) ? 1u : 0u; mine = (j == x) ? c : mine; }
        if (sum == G) break;
        __builtin_amdgcn_s_sleep(1);
        if ((++sp & 255u) == 0u) { if (xb_ld(&bar[XB_TMO])) break; if (sp > XB_SPIN_CAP) { atomicAdd(&bar[XB_TMO], 1u); break; } }
    }
    nloc = mine > 0u ? mine : 1u; nx = cnt > 0u ? cnt : 1u;
}
__device__ __forceinline__ void xcd_barrier(const XcdBarrier& b) {
    asm volatile("s_waitcnt vmcnt(0)" ::: "memory");
    __syncthreads();
    if (threadIdx.x == 0) {
        unsigned* bar = b.bar;
        __builtin_amdgcn_s_waitcnt(0);
        unsigned nloc = b.st[0], nx = b.st[1];
        if (nloc == 0u) { xcd_barrier_complete(bar, b.x, nloc, nx); b.st[0] = nloc; b.st[1] = nx; }
        const unsigned old = xb_add(&bar[XB_XSUB(b.x)], 1u);
        const unsigned gen = old / nloc;
        if (old + 1u == (gen + 1u) * nloc) {
            __builtin_amdgcn_fence(__ATOMIC_RELEASE, "agent");
            asm volatile("s_waitcnt vmcnt(0)" ::: "memory");
            const unsigned og = xb_add(&bar[XB_TOP], 1u);
            const unsigned tg = og / nx;
            if (og + 1u == (tg + 1u) * nx) xb_add(&bar[XB_TOPGEN], 1u);
            else XB_SPIN(xb_ld(&bar[XB_TOPGEN]) == tg, bar);
            __builtin_amdgcn_fence(__ATOMIC_ACQUIRE, "agent");
            xb_add(&bar[XB_XGEN(b.x)], 1u);
            asm volatile("s_waitcnt vmcnt(0)" ::: "memory");
        } else {
            XB_SPIN(xb_ld(&bar[XB_XGEN(b.x)]) == gen, bar);
            __builtin_amdgcn_fence(__ATOMIC_ACQUIRE, "agent");
            asm volatile("s_waitcnt vmcnt(0)" ::: "memory");
        }
    }
    __syncthreads();
}

constexpr int NPHASE = 12;
__global__ void __launch_bounds__(512, 2) mega(Params p, int ph_lo, int ph_hi) {
    extern __shared__ __attribute__((aligned(16))) char smem_phys[];
    uint4& xb_words = *(uint4*)(smem_phys + kDynLds - 16);
    if (threadIdx.x == 0) xb_words = make_uint4(0u, 0u, 0u, 0u);
    __syncthreads();
    const XcdBarrier xbar = xcd_barrier_post((unsigned*)(p.ws + OFF_BAR), (volatile LAS unsigned*)&xb_words);
    char* smem = smem_phys + (threadIdx.x >> 8) * 65536;
    bf16_t* Rg = (bf16_t*)(p.ws + OFF_REGION);
    bf16_t* Hb = (bf16_t*)(p.ws + OFF_H);
#define PHASE(k, ...) if (ph_lo <= (k) && (k) < ph_hi) { __VA_ARGS__; if ((k) + 1 < ph_hi) xcd_barrier(xbar); }
    unsigned* sbctr = (unsigned*)(p.ws + OFF_BAR + 14336);
    PHASE(0,
        transpose_convert<true>(p.ab_w_in, (bf16_t*)(p.ws + OFF_WT_IN), 1024, AB_IN, AB_IN_PAD, smem);
        rmsnorm_rows(p.x, p.norm_mix, Hb))
    PHASE(1, phase_gemm_in8(p, smem_phys))
    PHASE(2, gla_prep(p, smem))
    PHASE(3, gla_scan(p, smem); sb_fast(p, smem_phys + 98304, sbctr);
        quantize_tables_static(p, 64);
        transpose_convert(p.ab_w_out, (bf16_t*)(p.ws + OFF_WT_OUT), 1024, 1024, 1024, smem, 64);
        transpose_convert(p.c_w_in, (bf16_t*)(p.ws + OFF_WT_CIN), 1024, 4096, 4096, smem, 64, p.norm_mix + 1024, p.ws + OFF_SK_W8, 2048);
        transpose_convert(p.c_w_out, (bf16_t*)(p.ws + OFF_WT_COUT), 2048, 1024, 1024, smem, 64);
        fold_query_weights(p, 64))
    PHASE(4, phase_gemm_resid8(Rg + R_QSB, Rg + R_GG, 512, 512, (const bf16_t*)(p.ws + OFF_WT_OUT), 1024, p.x, (bf16_t*)(p.ws + OFF_S), (float*)(p.ws + OFF_SSQ), p.ws + OFF_H, smem_phys))
    PHASE(5, phase_select8(p, 0, smem_phys))
    PHASE(6, peer_gather(p, 0, p.norm_mix + 1024, false, smem_phys))
    PHASE(7, phase_gemm_cin8_v(p, smem_phys))
    PHASE(8, phase_gemm_cin8_u(p, smem_phys))
    PHASE(9, phase_gemm_resid8(Rg, Rg, 2048, 2048, (const bf16_t*)(p.ws + OFF_WT_COUT), 2048, nullptr, (bf16_t*)(p.ws + OFF_S), (float*)(p.ws + OFF_SSQ), p.ws + OFF_H, smem_phys))
    PHASE(10, phase_select8(p, 1, smem_phys))
    PHASE(11, peer_gather(p, 1, p.final_norm, true, smem_phys))
}

extern "C" void kernel_launch(void* const* d_in, const int* in_sizes, int n_in, void* d_out, int out_size, void* d_ws, size_t ws_size, hipStream_t stream) {
    static int grid_blocks = 0;
    if (!grid_blocks) {
        int dev = 0, cus = 0, per_cu = 0;
        hipGetDevice(&dev);
        hipDeviceGetAttribute(&cus, hipDeviceAttributeMultiprocessorCount, dev);
        hipFuncSetAttribute((const void*)mega, hipFuncAttributeMaxDynamicSharedMemorySize, kDynLds);
        hipOccupancyMaxActiveBlocksPerMultiprocessor(&per_cu, mega, 512, kDynLds);
        if (per_cu < 1) per_cu = 1;
        if (per_cu > 1) per_cu = 1;
        grid_blocks = cus * per_cu;
        if (n_in != 18 || ws_size < WS_END) fprintf(stderr, "kernel_launch: unexpected n_in %d or ws_size %zu < %zu\n", n_in, ws_size, (size_t)WS_END);
    }
    Params p{};
    p.x = (const float*)d_in[0]; p.norm_mix = (const float*)d_in[1]; p.norm_ffn = (const float*)d_in[2]; p.ab_w_in = (const float*)d_in[3];
    p.ab_w_alpha2 = (const float*)d_in[4]; p.ab_b_alpha2 = (const float*)d_in[5]; p.ab_gla_norm = (const float*)d_in[6]; p.ab_w_out = (const float*)d_in[7];
    p.c_w_in = (const float*)d_in[8]; p.c_v_norm = (const float*)d_in[9]; p.c_w_spatial = (const float*)d_in[10]; p.c_b_spatial = (const float*)d_in[11];
    p.c_w_out = (const float*)d_in[12]; p.peer_w_q = (const float*)d_in[13]; p.peer_subkeys = (const float*)d_in[14]; p.peer_u = (const float*)d_in[15];
    p.peer_v = (const float*)d_in[16]; p.final_norm = (const float*)d_in[17];
    p.out = (float*)d_out; p.ws = (unsigned char*)d_ws;
    (void)hipMemsetAsync((char*)d_ws + OFF_BAR, 0, 16384, stream);
#if ONE_LAUNCH
    int lo = 0, hi = NPHASE;
    void* args[] = {&p, &lo, &hi};
    hipError_t e = hipLaunchCooperativeKernel((void*)mega, dim3(grid_blocks), dim3(512), args, kDynLds, stream);
    if (e != hipSuccess) fprintf(stderr, "cooperative launch failed: %s (grid %d)\n", hipGetErrorString(e), grid_blocks);
#else
    for (int ph = 0; ph < NPHASE; ++ph) hipLaunchKernelGGL(mega, dim3(grid_blocks), dim3(512), kDynLds, stream, p, ph, ph + 1);
#endif
}
```

```cpp
#include <hip/hip_runtime.h>
#include <cstdio>
#include <cstdint>

#ifndef ONE_LAUNCH
#define ONE_LAUNCH 1
#endif


#define VTID ((int)(threadIdx.x & 255))
#define VBID ((int)(blockIdx.x * 2 + (threadIdx.x >> 8)))
#define VGRID ((int)(gridDim.x * 2))
typedef unsigned short bf16_t;
typedef short bf16x8 __attribute__((ext_vector_type(8)));
typedef float f32x4 __attribute__((ext_vector_type(4)));
typedef unsigned u32x4 __attribute__((ext_vector_type(4)));
typedef __bf16 bf16x2_t __attribute__((ext_vector_type(2)));

constexpr int T = 32768, D = 1024, SEQ = 2048, NB = 16;
constexpr int AB_IN = 3088, AB_IN_PAD = 3200;
constexpr float EPS = 1e-6f;
constexpr int NEXP = 16384;
constexpr int kDynLds = 163840;

constexpr size_t SZ_WT_IN = (size_t)AB_IN_PAD * 1024 * 2;
constexpr size_t SZ_WT_OUT = (size_t)1024 * 1024 * 2;
constexpr size_t SZ_WT_CIN = (size_t)4096 * 1024 * 2;
constexpr size_t SZ_WT_COUT = (size_t)1024 * 2048 * 2;
constexpr size_t SZ_WT_Q = (size_t)2 * 2048 * 1024 * 2;
constexpr size_t SZ_SK = (size_t)2 * 8 * 2 * 128 * 128 * 2;
constexpr size_t SZ_TAB = (size_t)2 * NEXP * 1024;
constexpr size_t SZ_TSC = (size_t)2 * NEXP * 4;
constexpr size_t OFF_WT_IN = 0;
constexpr size_t OFF_WT_OUT = OFF_WT_IN + SZ_WT_IN;
constexpr size_t OFF_WT_CIN = OFF_WT_OUT + SZ_WT_OUT;
constexpr size_t OFF_WT_COUT = OFF_WT_CIN + SZ_WT_CIN;
constexpr size_t OFF_WT_Q = OFF_WT_COUT + SZ_WT_COUT;
constexpr size_t OFF_SK = OFF_WT_Q + SZ_WT_Q;
constexpr size_t OFF_UT = OFF_SK;
constexpr size_t OFF_USC = OFF_UT + SZ_TAB;
constexpr size_t OFF_VSC = OFF_USC + SZ_TSC;
constexpr size_t OFF_H = OFF_VSC + SZ_TSC;
constexpr size_t OFF_IDX = OFF_H + (size_t)T * 1024 * 2;
constexpr size_t OFF_GATE = OFF_IDX + (size_t)T * 128 * 4;
constexpr size_t OFF_SSQ = OFF_GATE + (size_t)T * 128 * 4;
constexpr size_t OFF_REGION = OFF_SSQ + (size_t)T * 32 * 4;
constexpr size_t SZ_REGION = (size_t)256 << 20;
constexpr size_t OFF_S = OFF_REGION + SZ_REGION;
constexpr size_t OFF_SK_W8 = OFF_S + (size_t)T * 1024 * 2;
constexpr size_t OFF_BAR = OFF_SK_W8 + (size_t)2048 * 1024;
constexpr size_t WS_END = OFF_BAR + 16384;
constexpr size_t R_QSB = 0;
constexpr size_t R_KSB = R_QSB + (size_t)T * 512;
constexpr size_t R_VTSB = R_KSB + (size_t)T * 512;
constexpr size_t R_QG = R_VTSB + (size_t)T * 512;
constexpr size_t R_KG = R_QG + (size_t)T * 256;
constexpr size_t R_VTG = R_KG + (size_t)T * 256;
constexpr size_t R_GG = R_VTG + (size_t)T * 512;
constexpr size_t R_ALR = R_GG + (size_t)T * 512;
constexpr size_t R_KOT = R_ALR + (size_t)T * 32;
constexpr size_t R_DEC = R_KOT + (size_t)T * 256;

struct Params {
    const float* x; const float* norm_mix; const float* norm_ffn; const float* ab_w_in; const float* ab_w_alpha2; const float* ab_b_alpha2;
    const float* ab_gla_norm; const float* ab_w_out; const float* c_w_in; const float* c_v_norm; const float* c_w_spatial; const float* c_b_spatial;
    const float* c_w_out; const float* peer_w_q; const float* peer_subkeys; const float* peer_u; const float* peer_v; const float* final_norm;
    float* out; unsigned char* ws;
};

__device__ __forceinline__ float bf2f(bf16_t v) { return __uint_as_float(((unsigned)v) << 16); }
__device__ __forceinline__ bf16_t f2bf(float f) { unsigned r; asm("v_cvt_pk_bf16_f32 %0, %1, %1" : "=v"(r) : "v"(f)); return (bf16_t)r; }
__device__ __forceinline__ unsigned pack2(float lo, float hi) { unsigned r; asm("v_cvt_pk_bf16_f32 %0, %1, %2" : "=v"(r) : "v"(lo), "v"(hi)); return r; }
__device__ __forceinline__ float lo2f(unsigned w) { return __uint_as_float(w << 16); }
__device__ __forceinline__ float hi2f(unsigned w) { return __uint_as_float(w & 0xffff0000u); }
__device__ __forceinline__ float dot2(unsigned a, unsigned b, float acc) { return __builtin_amdgcn_fdot2_f32_bf16(__builtin_bit_cast(bf16x2_t, a), __builtin_bit_cast(bf16x2_t, b), acc, false); }
#define GELU_C0 -1.0001451969146729f
#define GELU_C1 -1.1498452425003052f
#define GELU_C2 -0.46162763237953186f
#define GELU_C3 -0.051034148782491684f
#define GELU_C4 0.007168652955442667f
#define GELU_C5 -0.0006095620337873697f
#define GELU_C6 2.30170971917687e-05f
__device__ __forceinline__ float gelu_exact(float v) {
    const float a = fminf(fabsf(v), 6.0f);
    float q = GELU_C6 * a + GELU_C5; q = q * a + GELU_C4; q = q * a + GELU_C3; q = q * a + GELU_C2; q = q * a + GELU_C1; q = q * a + GELU_C0;
    return fmaxf(v, 0.f) - fabsf(v) * __builtin_amdgcn_exp2f(q);
}
typedef float f32x2 __attribute__((ext_vector_type(2)));
__device__ __forceinline__ f32x2 gelu_exact2(f32x2 v) {
    const f32x2 av = __builtin_elementwise_abs(v), a = __builtin_elementwise_min(av, (f32x2){6.0f, 6.0f});
    f32x2 q = (f32x2){GELU_C6, GELU_C6} * a + (f32x2){GELU_C5, GELU_C5};
    q = q * a + (f32x2){GELU_C4, GELU_C4}; q = q * a + (f32x2){GELU_C3, GELU_C3}; q = q * a + (f32x2){GELU_C2, GELU_C2};
    q = q * a + (f32x2){GELU_C1, GELU_C1}; q = q * a + (f32x2){GELU_C0, GELU_C0};
    const f32x2 e = {__builtin_amdgcn_exp2f(q[0]), __builtin_amdgcn_exp2f(q[1])};
    return __builtin_elementwise_max(v, (f32x2){0.f, 0.f}) - av * e;
}
__device__ __forceinline__ float row16_sum(float v) {
    v += __builtin_bit_cast(float, __builtin_amdgcn_update_dpp(0, __builtin_bit_cast(int, v), 0x128, 0xf, 0xf, false));
    v += __builtin_bit_cast(float, __builtin_amdgcn_update_dpp(0, __builtin_bit_cast(int, v), 0x124, 0xf, 0xf, false));
    v += __builtin_bit_cast(float, __builtin_amdgcn_update_dpp(0, __builtin_bit_cast(int, v), 0x122, 0xf, 0xf, false));
    v += __builtin_bit_cast(float, __builtin_amdgcn_update_dpp(0, __builtin_bit_cast(int, v), 0x121, 0xf, 0xf, false));
    return v;
}
__device__ __forceinline__ float wave_sum(float v) {
#pragma unroll
    for (int o = 32; o >= 1; o >>= 1) v += __shfl_xor(v, o);
    return v;
}

template <bool PERM_IN = false>
__device__ __forceinline__ void transpose_convert(const float* __restrict__ W, bf16_t* __restrict__ Wt, int K, int N, int Npad, char* smem, int vb0 = 0, const float* __restrict__ kgain = nullptr, unsigned char* __restrict__ W8 = nullptr, int f8from = 0) {
    float* tile = (float*)smem;
    const int tk = K / 64, tn = Npad / 64, ntile = tk * tn;
    const int tid = VTID;
    if (VBID < vb0) return;
    for (int tl = VBID - vb0; tl < ntile; tl += VGRID - vb0) {
        const int k0 = (tl % tk) * 64, n0 = (tl / tk) * 64;
        const int c = tid & 63, r0 = tid >> 6;
        int nd = n0;
        if (PERM_IN) { if (n0 >= 1024 && n0 < 1536) nd = n0 + 1024; else if (n0 >= 1536 && n0 < 2048) nd = n0 - 512; else if (n0 >= 2048 && n0 < 2560) nd = n0 + 512; else if (n0 >= 2560 && n0 < 3072) nd = n0 - 1024; }
#pragma unroll
        for (int i = 0; i < 16; ++i) {
            const int r = r0 + 4 * i;
            float v = (n0 + c < N) ? W[(size_t)(k0 + r) * N + n0 + c] : 0.f;
            if (kgain) v *= kgain[k0 + r];
            tile[c * 65 + r] = v;
        }
        __syncthreads();
#pragma unroll
        for (int i = 0; i < 16; ++i) {
            const int n = r0 + 4 * i;
            Wt[(size_t)(nd + n) * K + k0 + c] = f2bf(tile[n * 65 + c]);
            if (W8 && nd >= f8from) { const float w64 = tile[n * 65 + c] * 64.0f; W8[(size_t)(nd + n - f8from) * K + k0 + c] = (unsigned char)__builtin_amdgcn_cvt_pk_fp8_f32(w64, w64, 0, false); }
        }
        __syncthreads();
    }
}
__device__ __forceinline__ void quantize_tables_static(const Params& p, int vb0 = 0) {
    const int lane = VTID & 63, wid = VTID >> 6;
    if (VBID < vb0) return;
    for (unsigned task = (unsigned)(VBID - vb0); task < 512u; task += (unsigned)(VGRID - vb0)) {
        const bool isv = task >= 256u;
        const int r0 = (int)(task & 255u) * 128 + wid * 32;
        const float* src = isv ? p.peer_v : p.peer_u;
        unsigned char* recs = p.ws + OFF_UT;
        _Float16* sct = (_Float16*)(p.ws + OFF_USC);
        f32x4 vnx[4];
        {
            const float* x0 = src + (size_t)r0 * 1024 + lane * 4;
#pragma unroll
            for (int i = 0; i < 4; ++i) vnx[i] = *(const f32x4*)(x0 + i * 256);
        }
        for (int rr = 0; rr < 32; ++rr) {
            const int r = r0 + rr;
            f32x4 v[4]; float aml = 0.f;
#pragma unroll
            for (int i = 0; i < 4; ++i) {
                v[i] = vnx[i];
                aml = fmaxf(aml, fmaxf(fmaxf(fabsf(v[i][0]), fabsf(v[i][1])), fmaxf(fabsf(v[i][2]), fabsf(v[i][3]))));
            }
            if (rr + 1 < 32) {
                const float* xn = src + (size_t)(r + 1) * 1024 + lane * 4;
#pragma unroll
                for (int i = 0; i < 4; ++i) vnx[i] = *(const f32x4*)(xn + i * 256);
            }
#pragma unroll
            for (int o = 32; o >= 1; o >>= 1) aml = fmaxf(aml, __shfl_xor(aml, o));
            float ssq = 0.f;
#pragma unroll
            for (int i = 0; i < 4; ++i) ssq += (v[i][0] * v[i][0] + v[i][1] * v[i][1]) + (v[i][2] * v[i][2] + v[i][3] * v[i][3]);
            ssq = wave_sum(ssq);
            const float gmax = aml * (1.002f / 7.5f);
            const _Float16 hs = (_Float16)fminf(fmaxf(0.34f * sqrtf(ssq * (1.0f / 1024.0f)), 0.5f * gmax), gmax);
            const float gs_ = (float)hs, gi_ = gs_ > 0.f ? 1.0f / gs_ : 0.f;
            const int sgn = isv ? 0 : 8;
            unsigned char* rec = recs + (size_t)r * 1024 + (isv ? 512 : 0);
#pragma unroll
            for (int i = 0; i < 4; ++i) {
                unsigned wv = 0;
#pragma unroll
                for (int j = 0; j < 4; ++j) wv |= (unsigned)(min(15, max(0, __float2int_rn(v[i][j] * gi_ + 7.5f))) ^ sgn) << (8 * j);
                wv <<= (lane & 1) * 4;
                wv |= (unsigned)__shfl_xor((int)wv, 1);
                if ((lane & 1) == 0) *(unsigned*)(rec + 128 * i + (lane >> 1) * 4) = wv;
            }
            if (lane == 0) sct[(size_t)r * 2 + (isv ? 1 : 0)] = (_Float16)gs_;
        }
    }
}
__device__ __forceinline__ void rmsnorm_rows(const float* __restrict__ X, const float* __restrict__ g, bf16_t* __restrict__ Hout) {
    const int lane = VTID & 63, wid = VTID >> 6;
    const int gw = VBID * 4 + wid, nw = VGRID * 4;
    for (int t = gw; t < T; t += nw) {
        const float* xr = X + (size_t)t * D;
        float4 v[4]; float ss = 0.f;
#pragma unroll
        for (int i = 0; i < 4; ++i) { v[i] = *(const float4*)(xr + i * 256 + lane * 4); ss += v[i].x * v[i].x + v[i].y * v[i].y + v[i].z * v[i].z + v[i].w * v[i].w; }
        ss = wave_sum(ss);
        const float rstd = rsqrtf(ss * (1.0f / D) + EPS);
#pragma unroll
        for (int i = 0; i < 4; ++i) {
            const float4 gg = *(const float4*)(g + i * 256 + lane * 4);
            uint2 o; o.x = pack2(v[i].x * rstd * gg.x, v[i].y * rstd * gg.y); o.y = pack2(v[i].z * rstd * gg.z, v[i].w * rstd * gg.w);
            *(uint2*)(Hout + (size_t)t * D + i * 256 + lane * 4) = o;
        }
    }
}

__device__ __forceinline__ void store_bf16x4(bf16_t* p, f32x4 v) { uint2 o; o.x = pack2(v[0], v[1]); o.y = pack2(v[2], v[3]); *(uint2*)p = o; }

#define G8_LAS __attribute__((address_space(3)))
namespace g8 {
constexpr int BM = 256, BK = 64, HALF = 128, HTB = HALF * BK * 2, NXCD = 8, WGM = 8;
__device__ __forceinline__ int lds_byte(int r, int c) { const int st = (r >> 4) * 2 + (c >> 5), rr = r & 15, cc = c & 31, ob = rr * 64 + cc * 2; return st * 1024 + (ob ^ (((ob >> 9) & 1) << 5)); }
__device__ __forceinline__ void stage_rc(int b, int& R, int& C) { const int st = b / 1024, sb = b % 1024, swz = sb ^ (((sb >> 9) & 1) << 5); R = (st >> 1) * 16 + swz / 64; C = (st & 1) * 32 + (swz % 64) / 2; }
__device__ __forceinline__ int perm32(int rho) { const int n = rho >> 4, i = rho & 15; return 8 * (i >> 2) + 4 * n + (i & 3); }
struct Unit { int pm, pn; };
struct Gemm { const bf16_t* A0; const bf16_t* A1; int lda, ksplit; const bf16_t* Bt; int M, N, K; };
struct StaticOrder {
    int nM, nN, nwg, G, c;
    __device__ __forceinline__ void init(int M, int N, int G_, int c_) { nM = M / BM; nN = N / BM; nwg = nM * nN; G = G_; c = c_; }
    __device__ __forceinline__ bool next(int i, Unit& u) const {
        const int L = i * G + c; if (L >= nwg) return false;
        int wgid = L; { const int q = nwg / NXCD, r = nwg % NXCD, xcd = wgid % NXCD, off = wgid / NXCD; wgid = (xcd < r ? xcd * (q + 1) : r * (q + 1) + (xcd - r) * q) + off; }
        const int nig = WGM * nN, gid = wgid / nig, fm = gid * WGM, gsz = (nM - fm) < WGM ? (nM - fm) : WGM;
        u.pm = fm + ((wgid % nig) % gsz); u.pn = (wgid % nig) / gsz; return true;
    }
};
typedef int i32x4v __attribute__((ext_vector_type(4)));
typedef int i32x8v __attribute__((ext_vector_type(8)));
template <class Epi, bool F8 = false>
__device__ __forceinline__ void gemm_phase(G8_LAS unsigned char* lds, const Gemm g, const StaticOrder& S, const Epi& E) {
    const int tid = threadIdx.x, wid = __builtin_amdgcn_readfirstlane(tid >> 6), lane = tid & 63, wr = wid >> 2, wc = wid & 3, fr = lane & 15, fq = lane >> 4;
    const int K = g.K, nt = K / BK, lda = g.lda;
    unsigned voffA[2], voffB[2];
#pragma unroll
    for (int i = 0; i < 2; ++i) { int R, C; stage_rc(tid * 16 + i * 8192, R, C); const int Rb = (R & ~31) + perm32(R & 31);
        voffA[i] = (unsigned)(R * lda + C) * 2u; voffB[i] = (unsigned)(Rb * K + C) * 2u; }
    const size_t hstepA = (size_t)HALF * lda * 2, hstepB = (size_t)HALF * K * 2;
    const unsigned ldsw = (unsigned)wid * 1024u;
    const unsigned ldsbase = (unsigned)__builtin_amdgcn_readfirstlane((int)(unsigned)(__SIZE_TYPE__)lds);
    const int fcol = F8 ? 32 * (fq >> 1) + 24 * (fq & 1) : fq * 8;
    const int aoff = lds_byte(wr * 64 + fr, fcol), boff = lds_byte(wc * 32 + fr, fcol);
    const int aoff2 = F8 ? (aoff ^ 16) : aoff + 1024, boff2 = F8 ? (boff ^ 16) : boff + 1024;
    auto aptr = [&](int pm, int kt) -> const char* { const int kb = kt * BK; const bf16_t* b = kb < g.ksplit ? g.A0 + kb : g.A1 + (kb - g.ksplit); return (const char*)b + (size_t)pm * 2 * hstepA; };
    auto bptr = [&](int pn, int kt) -> const char* { return (const char*)(g.Bt + kt * BK) + (size_t)pn * 2 * hstepB; };
#define G8_SA(b, h) (((b) * 2 + (h)) * HTB)
#define G8_SB(b, h) ((4 + (b) * 2 + (h)) * HTB)
#define G8_STAGE(bufoff, gbase, voff) do { _Pragma("unroll") for (int _i = 0; _i < 2; ++_i) { \
        if constexpr (F8) { unsigned _keep; const unsigned _d = ldsbase + (unsigned)(bufoff) + ldsw + _i * 8192u; \
            const char* _gb = (const char*)(gbase) + (size_t)_i * ((voff) == voffA ? hstepA : hstepB) / 2;        \
            asm volatile("s_mov_b32 %0, m0\n\ts_mov_b32 m0, %3\n\ts_nop 0\n\tglobal_load_lds_dwordx4 %1, %2\n\ts_mov_b32 m0, %0" : "=&s"(_keep) : "v"((voff)[0]), "s"(_gb), "s"(_d) : "memory"); } \
        else __builtin_amdgcn_global_load_lds((const unsigned*)((const char*)(gbase) + (voff)[_i]), (G8_LAS unsigned*)(lds + (bufoff) + ldsw + _i * 8192), 16, 0, 0); } } while (0)
#define G8_LD1(d16, d32, addr0, addr1) do { if constexpr (F8) { const i32x4v _lo = *(const G8_LAS i32x4v*)(addr0), _hi = *(const G8_LAS i32x4v*)(addr1); \
            d32 = __builtin_shufflevector(_lo, _hi, 0, 1, 2, 3, 4, 5, 6, 7); } \
        else { d16[0] = *(const G8_LAS bf16x8*)(addr0); d16[1] = *(const G8_LAS bf16x8*)(addr1); } } while (0)
#define G8_LDA(dst, b, h) do { _Pragma("unroll") for (int m = 0; m < 4; ++m) G8_LD1(dst[m], dst##8[m], lds + G8_SA(b, h) + aoff + m * 2048, lds + G8_SA(b, h) + aoff2 + m * 2048); } while (0)
#define G8_LDB(dst, b, h) do { _Pragma("unroll") for (int n = 0; n < 2; ++n) G8_LD1(dst[n], dst##8[n], lds + G8_SB(b, h) + boff + n * 2048, lds + G8_SB(b, h) + boff2 + n * 2048); } while (0)
#define G8_MMA(ai, bj, At, Bt) do { __builtin_amdgcn_s_setprio(1); _Pragma("unroll") for (int m = 0; m < 4; ++m) _Pragma("unroll") for (int n = 0; n < 2; ++n) { \
        if constexpr (F8) acc[ai][bj][m][n] = __builtin_amdgcn_mfma_scale_f32_16x16x128_f8f6f4(Bt##8[n], At##8[m], acc[ai][bj][m][n], 0, 0, 0, sc1, 0, sc1); \
        else { _Pragma("unroll") for (int k = 0; k < 2; ++k) acc[ai][bj][m][n] = __builtin_amdgcn_mfma_f32_16x16x32_bf16(Bt[n][k], At[m][k], acc[ai][bj][m][n], 0, 0, 0); } } \
        __builtin_amdgcn_s_setprio(0); } while (0)
#define G8_WAIT_V(n) asm volatile("s_waitcnt vmcnt(" #n ")" ::: "memory")
#define G8_WAIT_L(n) asm volatile("s_waitcnt lgkmcnt(" #n ")" ::: "memory")
#define G8_BAR __builtin_amdgcn_s_barrier()
#define G8_SCHED __builtin_amdgcn_sched_barrier(0)
    Unit cur, nxt; int ui = 0;
    if (!S.next(0, cur)) return;
    int sc1 = 0x7f7f7f7f; asm volatile("" : "+v"(sc1));
    f32x4 acc[2][2][4][2];
#pragma unroll
    for (int a = 0; a < 2; ++a)
#pragma unroll
        for (int b = 0; b < 2; ++b)
#pragma unroll
            for (int m = 0; m < 4; ++m)
#pragma unroll
                for (int n = 0; n < 2; ++n) acc[a][b][m][n] = (f32x4){0.f, 0.f, 0.f, 0.f};
    bf16x8 At[4][2], B0[2][2], B1[2][2];
    i32x8v At8[4], B08[2], B18[2];
    {
        const char* cA = aptr(cur.pm, 0); const char* cB = bptr(cur.pn, 0); const char* cA1 = aptr(cur.pm, 1); const char* cB1 = bptr(cur.pn, 1);
        G8_STAGE(G8_SB(0, 0), cB, voffB); G8_STAGE(G8_SB(0, 1), cB + hstepB, voffB); G8_STAGE(G8_SA(0, 0), cA, voffA); G8_STAGE(G8_SA(0, 1), cA + hstepA, voffA);
        if (wr == 1) G8_BAR;
        G8_WAIT_V(2); G8_BAR;
        G8_STAGE(G8_SB(1, 0), cB1, voffB); G8_STAGE(G8_SA(1, 0), cA1, voffA); G8_STAGE(G8_SB(1, 1), cB1 + hstepB, voffB);
        G8_WAIT_V(6); G8_BAR;
    }
    for (;;) {
        const bool has_next = S.next(ui + 1, nxt);
        const int npm = has_next ? nxt.pm : cur.pm, npn = has_next ? nxt.pn : cur.pn;
#pragma unroll 1
        for (int t = 0; t < nt; t += 2) {
            const bool last = (t == nt - 2);
            const char* a1 = aptr(cur.pm, t + 1);
            const char* a2 = last ? aptr(npm, 0) : aptr(cur.pm, t + 2); const char* b2 = last ? bptr(npn, 0) : bptr(cur.pn, t + 2);
            const char* a3 = last ? aptr(npm, 1) : aptr(cur.pm, t + 3); const char* b3 = last ? bptr(npn, 1) : bptr(cur.pn, t + 3);
            G8_LDB(B0, 0, 0); G8_LDB(B1, 0, 1); G8_SCHED; G8_LDA(At, 0, 0); G8_STAGE(G8_SA(1, 1), a1 + hstepA, voffA);
            G8_WAIT_V(8); G8_WAIT_L(0); G8_BAR; G8_MMA(0, 0, At, B0); G8_MMA(0, 1, At, B1); G8_BAR; G8_SCHED;
            G8_LDA(At, 0, 1); G8_STAGE(G8_SB(0, 0), b2, voffB); G8_STAGE(G8_SB(0, 1), b2 + hstepB, voffB); G8_STAGE(G8_SA(0, 0), a2, voffA);
            G8_WAIT_V(8); G8_WAIT_L(0); G8_BAR; G8_MMA(1, 0, At, B0); G8_MMA(1, 1, At, B1); G8_BAR; G8_SCHED;
            G8_LDB(B0, 1, 0); G8_LDB(B1, 1, 1); G8_SCHED; G8_LDA(At, 1, 0); G8_STAGE(G8_SA(0, 1), a2 + hstepA, voffA);
            G8_WAIT_V(8); G8_WAIT_L(0); G8_BAR; G8_MMA(0, 0, At, B0); G8_MMA(0, 1, At, B1); G8_BAR; G8_SCHED;
            G8_LDA(At, 1, 1); G8_STAGE(G8_SB(1, 0), b3, voffB); G8_STAGE(G8_SB(1, 1), b3 + hstepB, voffB); G8_STAGE(G8_SA(1, 0), a3, voffA);
            G8_WAIT_V(8); G8_WAIT_L(0); G8_BAR; G8_MMA(1, 0, At, B0); G8_MMA(1, 1, At, B1); G8_BAR; G8_SCHED;
        }
        if (wr == 0) G8_BAR;
        E(acc, cur, wr, wc, fr, fq);
        if (!has_next) break;
#pragma unroll
        for (int a = 0; a < 2; ++a)
#pragma unroll
            for (int b = 0; b < 2; ++b)
#pragma unroll
                for (int m = 0; m < 4; ++m)
#pragma unroll
                    for (int n = 0; n < 2; ++n) acc[a][b][m][n] = (f32x4){0.f, 0.f, 0.f, 0.f};
        cur = nxt; ++ui;
        if (wr == 1) G8_BAR;
    }
    G8_WAIT_V(0);
    G8_BAR;
#undef G8_SA
#undef G8_SB
#undef G8_STAGE
#undef G8_LDA
#undef G8_LDB
#undef G8_MMA
#undef G8_LD1
#undef G8_WAIT_V
#undef G8_WAIT_L
#undef G8_BAR
#undef G8_SCHED
}
struct EpiResid {
    const float* R32; bf16_t* S; float* SSQP; unsigned char* S8;
    __device__ __forceinline__ void operator()(const f32x4 (&acc)[2][2][4][2], const Unit& u, int wr, int wc, int fr, int fq) const {
#pragma unroll
        for (int ai = 0; ai < 2; ++ai)
#pragma unroll
            for (int m = 0; m < 4; ++m) {
                const int row = u.pm * 256 + ai * 128 + wr * 64 + m * 16 + fr;
                const size_t o = (size_t)row * 1024 + u.pn * 256 + wc * 32 + fq * 8;
                float ss = 0.f;
#pragma unroll
                for (int bj = 0; bj < 2; ++bj) {
                    f32x4 a, b;
                    if (R32) { a = *(const f32x4*)(R32 + o + bj * 128); b = *(const f32x4*)(R32 + o + bj * 128 + 4); }
                    else { const u32x4 r = *(const u32x4*)(S + o + bj * 128); a = (f32x4){lo2f(r[0]), hi2f(r[0]), lo2f(r[1]), hi2f(r[1])}; b = (f32x4){lo2f(r[2]), hi2f(r[2]), lo2f(r[3]), hi2f(r[3])}; }
                    a += acc[ai][bj][m][0]; b += acc[ai][bj][m][1];
                    ss += a[0] * a[0] + a[1] * a[1] + a[2] * a[2] + a[3] * a[3] + b[0] * b[0] + b[1] * b[1] + b[2] * b[2] + b[3] * b[3];
                    uint4 w; w.x = pack2(a[0], a[1]); w.y = pack2(a[2], a[3]); w.z = pack2(b[0], b[1]); w.w = pack2(b[2], b[3]);
                    *(uint4*)(S + o + bj * 128) = w;
                    { int p0 = __builtin_amdgcn_cvt_pk_fp8_f32(a[0], a[1], 0, false); p0 = __builtin_amdgcn_cvt_pk_fp8_f32(a[2], a[3], p0, true);
                      int p1 = __builtin_amdgcn_cvt_pk_fp8_f32(b[0], b[1], 0, false); p1 = __builtin_amdgcn_cvt_pk_fp8_f32(b[2], b[3], p1, true);
                      *(uint2*)(S8 + o + bj * 128) = make_uint2((unsigned)p0, (unsigned)p1); }
                }
                ss += __shfl_xor(ss, 16); ss += __shfl_xor(ss, 32);
                if (fq == 0) SSQP[(size_t)row * 32 + u.pn * 4 + wc] = ss;
            }
    }
};
struct EpiCinUS {
    bf16_t* U; const bf16_t* VT; const float* SSQ; const float* Wsp; const float* bsp; const float* vnorm; G8_LAS unsigned char* L; const float* RSTD;
    __device__ __forceinline__ void operator()(const f32x4 (&acc)[2][2][4][2], const Unit& u, int wr, int wc, int fr_, int fq_) const {
        int lz = 0; asm volatile("" : "+v"(lz));
        const int tid = (int)threadIdx.x + lz, fr = tid & 15, fq = (tid >> 4) & 3, g = u.pn; (void)fr_; (void)fq_;
        G8_LAS float* RS = (G8_LAS float*)(L + 24576);
        unsigned gu[2][2][4][4];
#pragma unroll
        for (int ai = 0; ai < 2; ++ai)
#pragma unroll
            for (int bj = 0; bj < 2; ++bj)
#pragma unroll
                for (int m = 0; m < 4; ++m) {
                    const float rs = RSTD[u.pm * 256 + ai * 128 + wr * 64 + m * 16 + fr];
                    const f32x4 a = acc[ai][bj][m][0] * rs, b = acc[ai][bj][m][1] * rs;
                    const f32x2 g0 = gelu_exact2((f32x2){a[0], a[1]}), g1 = gelu_exact2((f32x2){a[2], a[3]}), g2 = gelu_exact2((f32x2){b[0], b[1]}), g3 = gelu_exact2((f32x2){b[2], b[3]});
                    gu[ai][bj][m][0] = pack2(g0[0], g0[1]); gu[ai][bj][m][1] = pack2(g1[0], g1[1]); gu[ai][bj][m][2] = pack2(g2[0], g2[1]); gu[ai][bj][m][3] = pack2(g3[0], g3[1]);
                }
        if (tid < 256) {
            const float* sp = SSQ + (size_t)(u.pm * 256 + tid) * 32;
            f32x4 s4 = *(const f32x4*)sp;
#pragma unroll
            for (int i = 1; i < 8; ++i) s4 += *(const f32x4*)(sp + 4 * i);
            RS[tid] = rsqrtf(((s4[0] + s4[1]) + (s4[2] + s4[3])) * (1.0f / 2048.0f) + EPS);
        }
        __syncthreads();
#pragma unroll
        for (int ai = 0; ai < 2; ++ai) {
            const int chunk = u.pm * 2 + ai;
            {
                const int t1 = tid >> 3, c1 = tid & 7;
#pragma unroll
                for (int part = 0; part < 3; ++part) {
                    const int t = part == 0 ? t1 : 64 + ((tid + (part - 1) * 512) >> 4), ch = part == 0 ? c1 : ((tid + (part - 1) * 512) & 15), s0 = ch * 8;
                    const float* wp = Wsp + (size_t)(g * 128 + t) * 128 + s0;
                    const f32x4 w0 = *(const f32x4*)wp, w1 = *(const f32x4*)(wp + 4);
                    const f32x4 r0 = *(const G8_LAS f32x4*)(RS + ai * 128 + s0), r1 = *(const G8_LAS f32x4*)(RS + ai * 128 + s0 + 4);
                    float v[8];
#pragma unroll
                    for (int j = 0; j < 4; ++j) { v[j] = (s0 + j <= t) ? w0[j] * r0[j] : 0.f; v[4 + j] = (s0 + 4 + j <= t) ? w1[j] * r1[j] : 0.f; }
                    u32x4 o; o.x = pack2(v[0], v[1]); o.y = pack2(v[2], v[3]); o.z = pack2(v[4], v[5]); o.w = pack2(v[6], v[7]);
                    const int off = part == 0 ? t * 128 + ((ch ^ (t & 7)) << 4) : 8192 + (t - 64) * 256 + ((ch ^ (t & 7)) << 4);
                    *(G8_LAS u32x4*)(L + off) = o;
                }
            }
            __syncthreads();
            float bias[4];
#pragma unroll
            for (int m = 0; m < 4; ++m) bias[m] = bsp[g * 128 + wr * 64 + m * 16 + fr];
#pragma unroll
            for (int bj = 0; bj < 2; ++bj) {
                f32x4 mac[4][2];
#pragma unroll
                for (int m = 0; m < 4; ++m)
#pragma unroll
                    for (int n = 0; n < 2; ++n) mac[m][n] = (f32x4){0.f, 0.f, 0.f, 0.f};
                const int cb = u.pn * 256 + bj * 128 + wc * 32;
                const bf16_t* vrow0 = VT + ((size_t)chunk * 2048 + cb + perm32(fr)) * 128 + fq * 8;
                const bf16_t* vrow1 = VT + ((size_t)chunk * 2048 + cb + perm32(16 + fr)) * 128 + fq * 8;
                bf16x8 bf0[4], bf1[4];
#pragma unroll
                for (int kk = 0; kk < 4; ++kk) { if (kk < 2 || wr == 1) { bf0[kk] = *(const bf16x8*)(vrow0 + kk * 32); bf1[kk] = *(const bf16x8*)(vrow1 + kk * 32); } }
#pragma unroll
                for (int kk = 0; kk < 4; ++kk) {
                    if (kk < 2 || wr == 1) {
                        bf16x8 af[4];
#pragma unroll
                        for (int m = 0; m < 4; ++m) {
                            const int t = wr * 64 + m * 16 + fr, chn = kk * 4 + fq;
                            const int off = wr == 0 ? t * 128 + ((chn ^ (t & 7)) << 4) : 8192 + (t - 64) * 256 + ((chn ^ (t & 7)) << 4);
                            af[m] = *(const G8_LAS bf16x8*)(L + off);
                        }
#pragma unroll
                        for (int m = 0; m < 4; ++m) {
                            mac[m][0] = __builtin_amdgcn_mfma_f32_16x16x32_bf16(bf0[kk], af[m], mac[m][0], 0, 0, 0);
                            mac[m][1] = __builtin_amdgcn_mfma_f32_16x16x32_bf16(bf1[kk], af[m], mac[m][1], 0, 0, 0);
                        }
                    }
                }
                const f32x4 vn0 = *(const f32x4*)(vnorm + cb + fq * 8), vn1 = *(const f32x4*)(vnorm + cb + fq * 8 + 4);
#pragma unroll
                for (int m = 0; m < 4; ++m) {
                    const f32x4 x0 = vn0 * mac[m][0] + bias[m], x1 = vn1 * mac[m][1] + bias[m];
                    const unsigned q0 = gu[ai][bj][m][0], q1 = gu[ai][bj][m][1], q2 = gu[ai][bj][m][2], q3 = gu[ai][bj][m][3];
                    uint4 o; o.x = pack2(lo2f(q0) * x0[0], hi2f(q0) * x0[1]); o.y = pack2(lo2f(q1) * x0[2], hi2f(q1) * x0[3]); o.z = pack2(lo2f(q2) * x1[0], hi2f(q2) * x1[1]); o.w = pack2(lo2f(q3) * x1[2], hi2f(q3) * x1[3]);
                    *(uint4*)(U + (size_t)(u.pm * 256 + ai * 128 + wr * 64 + m * 16 + fr) * 2048 + cb + fq * 8) = o;
                }
            }
            __syncthreads();
        }
    }
};
struct EpiCinV {
    bf16_t* VT; float* SSQ; const float* RSTD;
    __device__ __forceinline__ void operator()(const f32x4 (&acc)[2][2][4][2], const Unit& u, int wr, int wc, int fr_, int fq_) const {
        int lz = 0; asm volatile("" : "+v"(lz));
        const int lane_ = (int)(threadIdx.x & 63) + lz, fr = lane_ & 15, fq = lane_ >> 4; (void)fr_; (void)fq_;
        f32x4 rs[2][2];
#pragma unroll
        for (int bj = 0; bj < 2; ++bj)
#pragma unroll
            for (int n = 0; n < 2; ++n) rs[bj][n] = *(const f32x4*)(RSTD + u.pn * 256 + bj * 128 + wc * 32 + fq * 8 + n * 4) * (1.0f / 64.0f);
#pragma unroll
        for (int ai = 0; ai < 2; ++ai) {
            float ss[16];
#pragma unroll
            for (int i = 0; i < 16; ++i) ss[i] = 0.f;
#pragma unroll
            for (int m = 0; m < 4; ++m) {
                const int c = u.pm * 256 + ai * 128 + wr * 64 + m * 16 + fr;
#pragma unroll
                for (int bj = 0; bj < 2; ++bj) {
                    float g[8];
#pragma unroll
                    for (int n = 0; n < 2; ++n)
#pragma unroll
                        for (int r = 0; r < 4; r += 2) {
                            const f32x2 x = gelu_exact2((f32x2){acc[ai][bj][m][n][r] * rs[bj][n][r], acc[ai][bj][m][n][r + 1] * rs[bj][n][r + 1]});
                            g[n * 4 + r] = x[0]; g[n * 4 + r + 1] = x[1]; ss[bj * 8 + n * 4 + r] += x[0] * x[0]; ss[bj * 8 + n * 4 + r + 1] += x[1] * x[1];
                        }
                    uint4 o; o.x = pack2(g[0], g[1]); o.y = pack2(g[2], g[3]); o.z = pack2(g[4], g[5]); o.w = pack2(g[6], g[7]);
                    *(uint4*)(VT + ((size_t)(u.pn * 2 + bj) * 2048 + c) * 128 + wc * 32 + fq * 8) = o;
                }
            }
            float mine = 0.f;
#pragma unroll
            for (int i = 0; i < 16; ++i) { const float s = row16_sum(ss[i]); mine = (fr == i) ? s : mine; }
            const int tok = u.pn * 256 + (fr >> 3) * 128 + wc * 32 + fq * 8 + (fr & 7);
            SSQ[(size_t)tok * 32 + u.pm * 4 + ai * 2 + wr] = mine;
        }
    }
};
struct EpiInN {
    bf16_t* R;
    __device__ __forceinline__ void operator()(const f32x4 (&acc)[2][2][4][2], const Unit& u, int wr, int wc, int fr, int fq) const {
        bf16_t* base; int pitch; float sc = 1.0f;
        if (u.pn < 2) { base = R + R_QSB + u.pn * 256; pitch = 512; sc = 0.125f; }
        else if (u.pn < 4) { base = R + R_KSB + (u.pn - 2) * 256; pitch = 512; }
        else if (u.pn == 4) { base = R + R_QG; pitch = 256; }
        else if (u.pn == 5) { base = R + R_KG; pitch = 256; }
        else { base = R + R_GG + (u.pn - 6) * 256; pitch = 512; }
#pragma unroll
        for (int ai = 0; ai < 2; ++ai)
#pragma unroll
            for (int m = 0; m < 4; ++m) {
                bf16_t* rp = base + (size_t)(u.pm * 256 + ai * 128 + wr * 64 + m * 16 + fr) * pitch + wc * 32 + fq * 8;
#pragma unroll
                for (int bj = 0; bj < 2; ++bj) {
                    f32x4 a = acc[ai][bj][m][0] * sc, b = acc[ai][bj][m][1] * sc;
                    if (u.pn >= 6) {
#pragma unroll
                        for (int r = 0; r < 4; ++r) { a[r] = a[r] * __builtin_amdgcn_rcpf(1.0f + __expf(-a[r])); b[r] = b[r] * __builtin_amdgcn_rcpf(1.0f + __expf(-b[r])); }
                    }
                    uint4 o; o.x = pack2(a[0], a[1]); o.y = pack2(a[2], a[3]); o.z = pack2(b[0], b[1]); o.w = pack2(b[2], b[3]);
                    *(uint4*)(rp + bj * 128) = o;
                }
            }
    }
};
struct EpiInT {
    bf16_t* R;
    __device__ __forceinline__ void operator()(const f32x4 (&acc)[2][2][4][2], const Unit& u, int wr, int wc, int fr, int fq) const {
#pragma unroll
        for (int ai = 0; ai < 2; ++ai)
#pragma unroll
            for (int m = 0; m < 4; ++m) {
                const int c = u.pm * 256 + ai * 128 + wr * 64 + m * 16 + fr;
#pragma unroll
                for (int bj = 0; bj < 2; ++bj) {
                    const int t = u.pn * 256 + bj * 128 + wc * 32 + fq * 8, b = t >> 11, s = t & 2047;
                    bf16_t* dst;
                    if (c < 512) dst = R + R_VTSB + ((size_t)((b * 8 + (c >> 6)) * 64 + (c & 63))) * 2048 + s;
                    else { const int c2 = c - 512; dst = R + R_VTG + ((size_t)((b * 4 + (c2 >> 7)) * 128 + (c2 & 127))) * 2048 + s; }
                    const f32x4 a = acc[ai][bj][m][0], bb = acc[ai][bj][m][1];
                    uint4 o; o.x = pack2(a[0], a[1]); o.y = pack2(a[2], a[3]); o.z = pack2(bb[0], bb[1]); o.w = pack2(bb[2], bb[3]);
                    *(uint4*)dst = o;
                }
            }
    }
};
}
__device__ __forceinline__ void phase_gemm_resid8(const bf16_t* A0, const bf16_t* A1, int lda, int ksplit, const bf16_t* Bt, int K, const float* R32, bf16_t* Sres, float* SSQP, unsigned char* S8, char* smem_phys) {
    g8::Gemm g{A0, A1, lda, ksplit, Bt, T, 1024, K};
    g8::StaticOrder S; S.init(T, 1024, (int)gridDim.x, (int)blockIdx.x);
    g8::EpiResid E{R32, Sres, SSQP, S8};
    g8::gemm_phase<g8::EpiResid>((G8_LAS unsigned char*)smem_phys, g, S, E);
}

__device__ __forceinline__ void phase_gemm_cin8_v(const Params& p, char* smem_phys) {
    bf16_t* U = (bf16_t*)(p.ws + OFF_REGION); bf16_t* VT = U + (size_t)T * 2048; float* SSQ = (float*)(p.ws + OFF_SSQ);
    const bf16_t* Wv = (const bf16_t*)(p.ws + OFF_SK_W8); const bf16_t* H8 = (const bf16_t*)(p.ws + OFF_H + ((size_t)32 << 20));
    g8::Gemm g{Wv, Wv, 512, 512, H8, 2048, T, 512};
    g8::StaticOrder S; S.init(2048, T, (int)gridDim.x, (int)blockIdx.x);
    g8::EpiCinV E{VT, SSQ, (const float*)(p.ws + OFF_VSC)};
    g8::gemm_phase<g8::EpiCinV, true>((G8_LAS unsigned char*)smem_phys, g, S, E);
}
__device__ __forceinline__ void phase_gemm_cin8_u(const Params& p, char* smem_phys) {
    const bf16_t* H = (const bf16_t*)(p.ws + OFF_S); const bf16_t* W = (const bf16_t*)(p.ws + OFF_WT_CIN);
    bf16_t* U = (bf16_t*)(p.ws + OFF_REGION); bf16_t* VT = U + (size_t)T * 2048; float* SSQ = (float*)(p.ws + OFF_SSQ);
    g8::Gemm g{H, H, 1024, 1024, W, T, 2048, 1024};
    g8::StaticOrder S; S.init(T, 2048, (int)gridDim.x, (int)blockIdx.x);
    g8::EpiCinUS E{U, VT, SSQ, p.c_w_spatial, p.c_b_spatial, p.c_v_norm, (G8_LAS unsigned char*)(smem_phys + 131072), (const float*)(p.ws + OFF_VSC)};
    g8::gemm_phase<g8::EpiCinUS>((G8_LAS unsigned char*)smem_phys, g, S, E);
}
__device__ __forceinline__ void phase_gemm_in8(const Params& p, char* smem_phys) {
    const bf16_t* H = (const bf16_t*)(p.ws + OFF_H); const bf16_t* W = (const bf16_t*)(p.ws + OFF_WT_IN);
    bf16_t* R = (bf16_t*)(p.ws + OFF_REGION);
    {
        g8::Gemm g{H, H, 1024, 1024, W, T, 2048, 1024};
        g8::StaticOrder S; S.init(T, 2048, (int)gridDim.x, (int)blockIdx.x);
        g8::EpiInN E{R};
        g8::gemm_phase<g8::EpiInN>((G8_LAS unsigned char*)smem_phys, g, S, E);
    }
    {
        const bf16_t* Wv = W + (size_t)2048 * 1024;
        g8::Gemm g{Wv, Wv, 1024, 1024, H, 1024, T, 1024};
        g8::StaticOrder S; S.init(1024, T, (int)gridDim.x, (int)blockIdx.x);
        g8::EpiInT E{R};
        g8::gemm_phase<g8::EpiInT>((G8_LAS unsigned char*)smem_phys, g, S, E);
    }
    {
        const int lane = threadIdx.x & 63, wid = threadIdx.x >> 6, fr = lane & 15, fq = lane >> 4;
        float* ALR = (float*)(R + R_ALR);
        for (int task = (int)blockIdx.x * 8 + wid; task < T / 16; task += (int)gridDim.x * 8) {
            const bf16_t* a = H + (size_t)(task * 16 + fr) * 1024 + fq * 8; const bf16_t* w = W + (size_t)(3072 + fr) * 1024 + fq * 8;
            f32x4 acc = (f32x4){0.f, 0.f, 0.f, 0.f};
#pragma unroll 8
            for (int kk = 0; kk < 32; ++kk) {
                const bf16x8 af = *(const bf16x8*)(a + kk * 32), wf = *(const bf16x8*)(w + kk * 32);
                acc = __builtin_amdgcn_mfma_f32_16x16x32_bf16(wf, af, acc, 0, 0, 0);
            }
            *(f32x4*)(ALR + (size_t)(task * 16 + fr) * 16 + fq * 4) = acc;
        }
    }
}


typedef float f32x16 __attribute__((ext_vector_type(16)));
__device__ __forceinline__ void sb_fast(const Params& p, char* smem, unsigned* ctr) {
    bf16_t* R = (bf16_t*)(p.ws + OFF_REGION);
    char* KT = smem; char* VTt = smem + 8192;
    volatile int* flags = (volatile int*)(smem + 32768); volatile unsigned* slot = (volatile unsigned*)(smem + 32832);
    const int tid = threadIdx.x, lane = tid & 63, w = tid >> 6, r31 = lane & 31, h = lane >> 5;
    for (;;) {
        __syncthreads();
        if (tid == 0) *slot = atomicAdd(ctr, 1u);
        __syncthreads();
        const unsigned task = *slot;
        if (task >= 1024u) break;
        const int qblk = 7 - (int)(task >> 7), bh = task & 127, b = bh >> 3, hh = bh & 7;
        const int q0 = qblk * 256, qbase = q0 + 32 * w;
        bf16_t* qrow = R + R_QSB + (size_t)(b * 2048 + qbase + r31) * 512 + hh * 64;
        bf16x8 qf[4];
#pragma unroll
        for (int kk = 0; kk < 4; ++kk) qf[kk] = *(const bf16x8*)(qrow + 16 * kk + 8 * h);
        f32x16 oacc[2];
#pragma unroll
        for (int nt = 0; nt < 2; ++nt)
#pragma unroll
            for (int i = 0; i < 16; ++i) oacc[nt][i] = 0.f;
        float Rr = 1.0f;
        const int t = qbase + r31;
        for (int kt = q0 / 64 + 3; kt >= 0; --kt) {
            __syncthreads();
            { const int wd = __all(Rr == 0.f); if (lane == 0) flags[w] = wd; }
            __syncthreads();
            if (flags[0] & flags[1] & flags[2] & flags[3] & flags[4] & flags[5] & flags[6] & flags[7]) break;
            const int s_tile = kt * 64;
            {
                const int c = tid, row = c >> 3, ch = c & 7;
                const u32x4 kv = *(const u32x4*)(R + R_KSB + (size_t)(b * 2048 + s_tile + row) * 512 + hh * 64 + ch * 8);
                const u32x4 vv = *(const u32x4*)(R + R_VTSB + ((size_t)((b * 8 + hh) * 64 + row)) * 2048 + s_tile + ch * 8);
                *(u32x4*)(KT + row * 128 + ((ch ^ (row & 7)) << 4)) = kv;
                *(uint2*)(VTt + row * 136 + ch * 16) = make_uint2(vv[0], vv[1]);
                *(uint2*)(VTt + row * 136 + ch * 16 + 8) = make_uint2(vv[2], vv[3]);
            }
            __syncthreads();
#pragma unroll
            for (int sbk = 1; sbk >= 0; --sbk) {
                const int key_lo = s_tile + 32 * sbk;
                if (key_lo >= qbase + 31) continue;
                if (__all(Rr == 0.f)) continue;
                f32x16 st;
#pragma unroll
                for (int i = 0; i < 16; ++i) st[i] = 0.f;
                const int krow = 32 * sbk + r31;
#pragma unroll
                for (int kk = 0; kk < 4; ++kk) {
                    const bf16x8 kf = *(const bf16x8*)(KT + krow * 128 + (((2 * kk + h) ^ (krow & 7)) << 4));
                    st = __builtin_amdgcn_mfma_f32_32x32x16_bf16(kf, qf[kk], st, 0, 0, 0);
                }
                float a[16], G[4];
                const bool diag = key_lo + 31 >= qbase;
#pragma unroll
                for (int g = 0; g < 4; ++g) {
                    float sg[4], m[4];
#pragma unroll
                    for (int i = 0; i < 4; ++i) {
                        const float z = fmaxf(st[4 * g + i], -80.f);
                        const float ez = __builtin_amdgcn_exp2f(z * -1.4426950409f), sig = __builtin_amdgcn_rcpf(1.0f + ez);
                        sg[i] = sig; m[i] = ez * sig;
                    }
                    if (diag) {
#pragma unroll
                        for (int i = 0; i < 4; ++i) { const bool valid = key_lo + 8 * g + 4 * h + i < t; sg[i] = valid ? sg[i] : 0.f; m[i] = valid ? m[i] : 1.0f; }
                    }
                    const float x2 = m[3], x1 = x2 * m[2], x0 = x1 * m[1];
                    G[g] = x0 * m[0];
                    a[4 * g + 3] = sg[3]; a[4 * g + 2] = sg[2] * x2; a[4 * g + 1] = sg[1] * x1; a[4 * g] = sg[0] * x0;
                }
                float Go[4], P[4];
#pragma unroll
                for (int g = 0; g < 4; ++g) { Go[g] = __shfl_xor(G[g], 32); P[g] = G[g] * Go[g]; }
                const float c2 = P[3], c1 = c2 * P[2], c0 = c1 * P[1];
                float Tg[4];
                Tg[3] = Rr; Tg[2] = Rr * c2; Tg[1] = Rr * c1; Tg[0] = Rr * c0;
#pragma unroll
                for (int g = 0; g < 4; ++g) {
                    const float tg = (h == 0) ? Tg[g] * Go[g] : Tg[g];
                    a[4 * g] *= tg; a[4 * g + 1] *= tg; a[4 * g + 2] *= tg; a[4 * g + 3] *= tg;
                }
                Rr = Rr * c0 * P[0];
#pragma unroll
                for (int s2 = 0; s2 < 2; ++s2) {
                    union { bf16x8 v; unsigned u[4]; } af;
#pragma unroll
                    for (int j2 = 0; j2 < 4; ++j2) af.u[j2] = pack2(a[8 * s2 + 2 * j2], a[8 * s2 + 2 * j2 + 1]);
#pragma unroll
                    for (int nt = 0; nt < 2; ++nt) {
                        const char* vp = VTt + (32 * nt + r31) * 136 + 64 * sbk + 32 * s2 + 8 * h;
                        union { bf16x8 v; uint2 hh2[2]; } vf;
                        vf.hh2[0] = *(const uint2*)vp; vf.hh2[1] = *(const uint2*)(vp + 16);
                        oacc[nt] = __builtin_amdgcn_mfma_f32_32x32x16_bf16(af.v, vf.v, oacc[nt], 0, 0, 0);
                    }
                }
            }
        }
#pragma unroll
        for (int nt = 0; nt < 2; ++nt)
#pragma unroll
            for (int i = 0; i < 16; ++i) {
                const int qq = (i & 3) + 8 * (i >> 2) + 4 * h;
                R[R_QSB + (size_t)(b * 2048 + qbase + qq) * 512 + hh * 64 + 32 * nt + r31] = f2bf(oacc[nt][i]);
            }
    }
}
__device__ __forceinline__ float log_sigmoid(float x) { return fminf(x, 0.f) - __logf(1.0f + __expf(-fabsf(x))); }
__device__ __forceinline__ int swz(int row, int chunk) { return row * 128 + ((chunk ^ (row & 7)) << 4); }
__device__ __forceinline__ void gla_prep(const Params& p, char* smem) {
    bf16_t* R = (bf16_t*)(p.ws + OFF_REGION);
    const float* ALR = (const float*)(R + R_ALR);
    bf16_t* KOTg = R + R_KOT; float* DECg = (float*)(R + R_DEC);
    float* SEG = (float*)smem; float* ALRs = SEG + 256;
    const int tid = VTID, d = tid & 63, w = tid >> 6;
    for (int task = VBID; task < 2048; task += VGRID) {
        const int bh = task >> 5, c = task & 31, b = bh >> 2, hh = bh & 3;
        const size_t rowbase = (size_t)b * 2048 + c * 64;
        unsigned qr[16], kr[16];
#pragma unroll
        for (int i = 0; i < 16; ++i) { const size_t row = rowbase + w * 16 + i; qr[i] = R[R_QG + row * 256 + hh * 64 + d]; kr[i] = R[R_KG + row * 256 + hh * 64 + d]; }
        const f32x4 ar = *(const f32x4*)(ALR + rowbase * 16 + tid * 4);
        float w2r[16];
#pragma unroll
        for (int r = 0; r < 16; ++r) w2r[r] = p.ab_w_alpha2[r * 256 + hh * 64 + d];
        const float b2r = p.ab_b_alpha2[hh * 64 + d];
        __syncthreads();
        *(f32x4*)(ALRs + tid * 4) = ar;
        __syncthreads();
        float cs[16]; float run = 0.f;
#pragma unroll
        for (int i = 0; i < 16; ++i) {
            const float* al = ALRs + (w * 16 + i) * 16;
            float pre = b2r;
#pragma unroll
            for (int r = 0; r < 16; ++r) pre += al[r] * w2r[r];
            run += log_sigmoid(pre) * (1.0f / 16.0f);
            cs[i] = run;
        }
        SEG[w * 64 + d] = run;
        __syncthreads();
        float off = 0.f, tot = 0.f;
#pragma unroll
        for (int w2 = 0; w2 < 4; ++w2) { const float s = SEG[w2 * 64 + d]; tot += s; if (w2 < w) off += s; }
        unsigned kop[8];
#pragma unroll
        for (int i2 = 0; i2 < 8; ++i2) {
            float kov[2];
#pragma unroll
            for (int u = 0; u < 2; ++u) {
                const int i = 2 * i2 + u;
                const float bc = off + cs[i];
                const float kv = bf2f((bf16_t)kr[i]);
                const size_t row = rowbase + w * 16 + i;
                R[R_QG + row * 256 + hh * 64 + d] = f2bf(bf2f((bf16_t)qr[i]) * 0.125f * __expf(bc));
                R[R_KG + row * 256 + hh * 64 + d] = f2bf(kv * __expf(-bc));
                kov[u] = kv * __expf(tot - bc);
            }
            kop[i2] = pack2(kov[0], kov[1]);
        }
        bf16_t* kp = KOTg + ((size_t)task * 64 + d) * 64 + w * 16;
        *(uint4*)kp = make_uint4(kop[0], kop[1], kop[2], kop[3]);
        *(uint4*)(kp + 8) = make_uint4(kop[4], kop[5], kop[6], kop[7]);
        if (w == 0) DECg[(size_t)task * 64 + d] = __expf(tot);
    }
}
__device__ __forceinline__ void gla_scan(const Params& p, char* smem, bool dry = false) {
    bf16_t* R = (bf16_t*)(p.ws + OFF_REGION);
    const bf16_t* KOTg = R + R_KOT; const float* DECg = (const float*)(R + R_DEC);
    char* QS = smem; char* KS = smem + 8192; char* KOT = smem + 16384; char* VTs = smem + 24576; char* SPT = smem + 40960;
    float* DEC = (float*)(smem + 57344); float* GN = DEC + 64;
    const int tid = VTID, lane = tid & 63, w = tid >> 6, l15_ = lane & 15, q4 = lane >> 4;
    for (int task = VBID; task < 64; task += VGRID) {
        const int b = task >> 2, hh = task & 3;
        f32x4 Sacc[8];
#pragma unroll
        for (int nt = 0; nt < 8; ++nt) Sacc[nt] = (f32x4){0.f, 0.f, 0.f, 0.f};
        __syncthreads();
        for (int i = tid; i < 1024; i += 256) *(uint4*)(SPT + i * 16) = make_uint4(0, 0, 0, 0);
        if (tid < 128) GN[tid] = p.ab_gla_norm[hh * 128 + tid];
        const size_t rowbase = (size_t)b * 2048;
        const bf16_t* vbase = R + R_VTG + ((size_t)((b * 4 + hh) * 128)) * 2048;
        u32x4 tq[2], tk[2], tko[2], vr[4]; float td = 0.f;
        auto prefetch = [&](int c) {
            const int t0 = c * 64;
#pragma unroll
            for (int i = 0; i < 2; ++i) {
                const int cid = tid + 256 * i, row = cid >> 3, ch = cid & 7;
                tq[i] = *(const u32x4*)(R + R_QG + (rowbase + t0 + row) * 256 + hh * 64 + ch * 8);
                tk[i] = *(const u32x4*)(R + R_KG + (rowbase + t0 + row) * 256 + hh * 64 + ch * 8);
                tko[i] = *(const u32x4*)(KOTg + (((size_t)task * 32 + c) * 64 + row) * 64 + ch * 8);
            }
#pragma unroll
            for (int i = 0; i < 4; ++i) { const int cid = tid + 256 * i, e = cid >> 3, ch = cid & 7; vr[i] = *(const u32x4*)(vbase + (size_t)e * 2048 + t0 + ch * 8); }
            if (tid < 64) td = DECg[((size_t)task * 32 + c) * 64 + tid];
        };
        prefetch(0);
        for (int c = 0; c < 32; ++c) {
            int lz = 0; asm volatile("" : "+v"(lz));
            const int l15 = l15_ + lz;
            const int cx = (q4 ^ (l15 & 7)) << 4;
            const int rb0 = l15 * 128 + cx, rb1 = l15 * 128 + (cx ^ 64);
#pragma unroll
            for (int i = 0; i < 2; ++i) {
                const int cid = tid + 256 * i + lz, row = cid >> 3, ch = cid & 7;
                *(u32x4*)(QS + swz(row, ch)) = tq[i]; *(u32x4*)(KS + swz(row, ch)) = tk[i]; *(u32x4*)(KOT + swz(row, ch)) = tko[i];
            }
#pragma unroll
            for (int i = 0; i < 4; ++i) { const int cid = tid + 256 * i + lz, e = cid >> 3, ch = cid & 7; *(u32x4*)(VTs + swz(e, ch)) = vr[i]; }
            if (tid < 64) DEC[tid] = td;
            uint2 gr[8];
            const unsigned goff = (unsigned)((rowbase + c * 64 + 16 * w + l15) * 512 + hh * 128 + 4 * q4);
            bf16_t* const gbase = R + R_GG;
#pragma unroll
            for (int nt = 0; nt < 8; ++nt) gr[nt] = *(const uint2*)(gbase + (goff + 16 * nt));
            if (c + 1 < 32) prefetch(c + 1);
            __syncthreads();
            bf16x8 qf[2];
#pragma unroll
            for (int kk = 0; kk < 2; ++kk) qf[kk] = *(const bf16x8*)(QS + w * 2048 + (kk ? rb1 : rb0));
            f32x4 sT[4];
#pragma unroll
            for (int st = 0; st < 4; ++st) {
                sT[st] = (f32x4){0.f, 0.f, 0.f, 0.f};
                if (st <= w) {
#pragma unroll
                    for (int kk = 0; kk < 2; ++kk) { const bf16x8 kf = *(const bf16x8*)(KS + st * 2048 + (kk ? rb1 : rb0)); sT[st] = __builtin_amdgcn_mfma_f32_16x16x32_bf16(kf, qf[kk], sT[st], 0, 0, 0); }
#pragma unroll
                    for (int r = 0; r < 4; ++r) if (16 * st + 4 * q4 + r > 16 * w + l15) sT[st][r] = 0.f;
                }
            }
            bf16x8 af[2];
#pragma unroll
            for (int ks2 = 0; ks2 < 2; ++ks2) {
                union { bf16x8 v; unsigned u[4]; } cv;
                cv.u[0] = pack2(sT[2 * ks2][0], sT[2 * ks2][1]); cv.u[1] = pack2(sT[2 * ks2][2], sT[2 * ks2][3]);
                cv.u[2] = pack2(sT[2 * ks2 + 1][0], sT[2 * ks2 + 1][1]); cv.u[3] = pack2(sT[2 * ks2 + 1][2], sT[2 * ks2 + 1][3]);
                af[ks2] = cv.v;
            }
            const int vb = l15 * 128 + ((((q4 >> 1) ^ (l15 & 7)) << 4) | ((q4 & 1) * 8));
            f32x4 o[8];
#pragma unroll
            for (int nt = 0; nt < 8; ++nt) {
                o[nt] = (f32x4){0.f, 0.f, 0.f, 0.f};
                const int e = 16 * nt + l15;
#pragma unroll
                for (int kk = 0; kk < 2; ++kk) { const bf16x8 sf = *(const bf16x8*)(SPT + nt * 2048 + (kk ? rb1 : rb0)); o[nt] = __builtin_amdgcn_mfma_f32_16x16x32_bf16(sf, qf[kk], o[nt], 0, 0, 0); }
#pragma unroll
                for (int ks2 = 0; ks2 < 2; ++ks2) {
                    if (2 * ks2 <= w) {
                        union { bf16x8 v; uint2 h[2]; } cv;
                        cv.h[0] = *(const uint2*)(VTs + nt * 2048 + (vb ^ (ks2 * 64)));
                        cv.h[1] = *(const uint2*)(VTs + nt * 2048 + (vb ^ (ks2 * 64) ^ 32));
                        o[nt] = __builtin_amdgcn_mfma_f32_16x16x32_bf16(cv.v, af[ks2], o[nt], 0, 0, 0);
                    }
                }
            }
            {
                const float4 dc = *(const float4*)(DEC + 16 * w + 4 * q4);
                bf16x8 kof[2];
#pragma unroll
                for (int kk = 0; kk < 2; ++kk) kof[kk] = *(const bf16x8*)(KOT + w * 2048 + (kk ? rb1 : rb0));
#pragma unroll
                for (int nt = 0; nt < 8; ++nt) {
                    Sacc[nt][0] *= dc.x; Sacc[nt][1] *= dc.y; Sacc[nt][2] *= dc.z; Sacc[nt][3] *= dc.w;
#pragma unroll
                    for (int kk = 0; kk < 2; ++kk) { const bf16x8 vf = *(const bf16x8*)(VTs + nt * 2048 + (kk ? rb1 : rb0)); Sacc[nt] = __builtin_amdgcn_mfma_f32_16x16x32_bf16(kof[kk], vf, Sacc[nt], 0, 0, 0); }
                }
            }
            __syncthreads();
#pragma unroll
            for (int nt = 0; nt < 8; ++nt) {
                const int e = 16 * nt + l15;
                uint2 pk; pk.x = pack2(Sacc[nt][0], Sacc[nt][1]); pk.y = pack2(Sacc[nt][2], Sacc[nt][3]);
                *(uint2*)(SPT + nt * 2048 + l15 * 128 + (((2 * w + (q4 >> 1)) ^ (l15 & 7)) << 4) + (q4 & 1) * 8) = pk;
            }
            float ssq = 0.f;
#pragma unroll
            for (int nt = 0; nt < 8; ++nt) ssq += (o[nt][0] * o[nt][0] + o[nt][1] * o[nt][1]) + (o[nt][2] * o[nt][2] + o[nt][3] * o[nt][3]);
            ssq += __shfl_xor(ssq, 16); ssq += __shfl_xor(ssq, 32);
            const float rsd = rsqrtf(ssq * (1.0f / 128.0f) + EPS);
#pragma unroll
            for (int nt = 0; nt < 8; ++nt) {
                asm volatile("" ::: "memory");
                const f32x4 gn = *(const f32x4*)(GN + 16 * nt + 4 * q4);
                const float g0 = lo2f(gr[nt].x), g1 = hi2f(gr[nt].x), g2 = lo2f(gr[nt].y), g3 = hi2f(gr[nt].y);
                uint2 ov;
                ov.x = pack2(o[nt][0] * rsd * gn[0] * g0, o[nt][1] * rsd * gn[1] * g1);
                ov.y = pack2(o[nt][2] * rsd * gn[2] * g2, o[nt][3] * rsd * gn[3] * g3);
                if (!dry || ov.x == 0x7fc17fc1u) *(uint2*)(gbase + (goff + 16 * nt)) = ov;
            }
        }
    }
}

#define KEY_PAD 0xff800000u
__device__ __forceinline__ unsigned ord_key(float f) { return __float_as_uint(f); }
__device__ __forceinline__ float unord_key(unsigned k) { return __uint_as_float(k); }
__device__ __forceinline__ unsigned key_max(unsigned a, unsigned b) { unsigned r; asm("v_max_f32 %0, %1, %2" : "=v"(r) : "v"(a), "v"(b)); return r; }
__device__ __forceinline__ unsigned key_min(unsigned a, unsigned b) { unsigned r; asm("v_min_f32 %0, %1, %2" : "=v"(r) : "v"(a), "v"(b)); return r; }
__device__ __forceinline__ void ce_desc(unsigned& a, unsigned& b) { const unsigned hi = key_max(a, b), lo = key_min(a, b); a = hi; b = lo; }
__device__ __forceinline__ void bitonic_sort16_desc(unsigned (&a)[16]) {
#pragma unroll
    for (int k = 2; k <= 16; k <<= 1)
#pragma unroll
        for (int j = k >> 1; j > 0; j >>= 1)
#pragma unroll
            for (int i = 0; i < 16; ++i) { const int l = i ^ j; if (l > i) { if ((i & k) == 0) ce_desc(a[i], a[l]); else ce_desc(a[l], a[i]); } }
}
__device__ __forceinline__ void merge_top16(unsigned (&L)[16], const unsigned (&B)[16]) {
#pragma unroll
    for (int i = 0; i < 16; ++i) L[i] = key_max(L[i], B[15 - i]);
#pragma unroll
    for (int j = 8; j > 0; j >>= 1)
#pragma unroll
        for (int i = 0; i < 16; ++i) { const int l = i ^ j; if (l > i) ce_desc(L[i], L[l]); }
}
__device__ constexpr int cand_i(int n) { int c = 0; for (int i = 0; i < 16; ++i) for (int j = 0; j < 16; ++j) if ((i + 1) * (j + 1) <= 16) { if (c == n) return i; ++c; } return -1; }
__device__ constexpr int cand_j(int n) { int c = 0; for (int i = 0; i < 16; ++i) for (int j = 0; j < 16; ++j) if ((i + 1) * (j + 1) <= 16) { if (c == n) return j; ++c; } return -1; }
template <int N> struct CandTab { int i[N], j[N]; constexpr CandTab() : i(), j() { for (int n = 0; n < N; ++n) { i[n] = cand_i(n); j[n] = cand_j(n); } } };

__device__ __forceinline__ bf16x8 pack8(const float4 a, const float4 b) {
    u32x4 t; t.x = pack2(a.x, a.y); t.y = pack2(a.z, a.w); t.z = pack2(b.x, b.y); t.w = pack2(b.z, b.w);
    return __builtin_bit_cast(bf16x8, t);
}
__device__ __forceinline__ void fold_query_weights(const Params& p, int vb0 = 0) {
    int lz = 0; asm volatile("" : "+v"(lz));
    const int lane = (VTID & 63) + lz, wid = VTID >> 6, fr = lane & 15, fq = lane >> 4;
    unsigned char* Wf = p.ws + OFF_WT_Q;
    if (VBID < vb0) return;
    for (int task = VBID - vb0; task < 512; task += VGRID - vb0) {
        const int kb = task & 15, pp = (task >> 4) & 1, h = (task >> 5) & 7, layer = task >> 8;
        const float* wq = p.peer_w_q + (size_t)layer * 1024 * 2048 + (size_t)(kb * 64 + fr) * 2048 + h * 256 + pp * 128 + fq * 8;
        const float* sk = p.peer_subkeys + ((size_t)((layer * 8 + h) * 2 + pp) * 128 + wid * 32 + fr) * 128 + fq * 8;
        f32x4 acc[4][2];
#pragma unroll
        for (int kt = 0; kt < 4; ++kt)
#pragma unroll
            for (int jt = 0; jt < 2; ++jt) acc[kt][jt] = (f32x4){0.f, 0.f, 0.f, 0.f};
#pragma unroll 1
        for (int s = 0; s < 4; ++s) {
            bf16x8 a[4], b[2];
#pragma unroll
            for (int kt = 0; kt < 4; ++kt) { const float* q = wq + (size_t)(kt * 16) * 2048 + s * 32; a[kt] = pack8(*(const float4*)q, *(const float4*)(q + 4)); }
#pragma unroll
            for (int jt = 0; jt < 2; ++jt) { const float* q = sk + (size_t)(jt * 16) * 128 + s * 32; b[jt] = pack8(*(const float4*)q, *(const float4*)(q + 4)); }
#pragma unroll
            for (int kt = 0; kt < 4; ++kt)
#pragma unroll
                for (int jt = 0; jt < 2; ++jt) acc[kt][jt] = __builtin_amdgcn_mfma_f32_16x16x32_bf16(a[kt], b[jt], acc[kt][jt], 0, 0, 0);
        }
#pragma unroll
        for (int jt = 0; jt < 2; ++jt) {
            const int key = wid * 32 + jt * 16 + fr, cu = 128 * ((key >> 5) & 1) + 32 * (2 * pp + (key >> 6)) + (key & 31);
            unsigned char* row = Wf + ((size_t)layer * 2048 + h * 256 + cu) * 1024 + kb * 64 + 4 * fq;
#pragma unroll
            for (int kt = 0; kt < 4; ++kt) {
                const f32x4 wv = acc[kt][jt] * *(const f32x4*)(p.norm_ffn + layer * 1024 + kb * 64 + kt * 16 + 4 * fq) * 64.0f;
                int pk = __builtin_amdgcn_cvt_pk_fp8_f32(wv[0], wv[1], 0, false); pk = __builtin_amdgcn_cvt_pk_fp8_f32(wv[2], wv[3], pk, true);
                *(int*)(row + kt * 16) = pk;
            }
        }
    }
}
__device__ __forceinline__ void bitonic_merge16_desc(unsigned (&L)[16]) {
#pragma unroll
    for (int j = 8; j > 0; j >>= 1)
#pragma unroll
        for (int i = 0; i < 16; ++i) { const int l = i ^ j; if (l > i) ce_desc(L[i], L[l]); }
}
__device__ __forceinline__ void bitonic_sort8_desc(unsigned (&a)[8]) {
#pragma unroll
    for (int k = 2; k <= 8; k <<= 1)
#pragma unroll
        for (int j = k >> 1; j > 0; j >>= 1)
#pragma unroll
            for (int i = 0; i < 8; ++i) { const int l = i ^ j; if (l > i) { if ((i & k) == 0) ce_desc(a[i], a[l]); else ce_desc(a[l], a[i]); } }
}
__device__ __forceinline__ void sort16_desc(unsigned (&a)[16]) {
#define CE_(i, j) ce_desc(a[i], a[j])
    CE_(0,13); CE_(1,12); CE_(2,15); CE_(3,14); CE_(4,8); CE_(5,6); CE_(7,11); CE_(9,10);
    CE_(0,5); CE_(1,7); CE_(2,9); CE_(3,4); CE_(6,13); CE_(8,14); CE_(10,15); CE_(11,12);
    CE_(0,1); CE_(2,3); CE_(4,5); CE_(6,8); CE_(7,9); CE_(10,11); CE_(12,13); CE_(14,15);
    CE_(0,2); CE_(1,3); CE_(4,10); CE_(5,11); CE_(6,7); CE_(8,9); CE_(12,14); CE_(13,15);
    CE_(1,2); CE_(3,12); CE_(4,6); CE_(5,7); CE_(8,10); CE_(9,11); CE_(13,14);
    CE_(1,4); CE_(2,6); CE_(5,8); CE_(7,10); CE_(9,13); CE_(11,14);
    CE_(2,4); CE_(3,6); CE_(9,12); CE_(11,13);
    CE_(3,5); CE_(6,8); CE_(7,9); CE_(10,12);
    CE_(3,4); CE_(5,6); CE_(7,8); CE_(9,10); CE_(11,12);
    CE_(6,7); CE_(8,9);
#undef CE_
}
struct EpiSelect {
    unsigned* IDX; float* GATE; G8_LAS unsigned* X; const float* SSQP; const unsigned* SCT;
    __device__ __forceinline__ void operator()(const f32x4 (&acc)[2][2][4][2], const g8::Unit& u, int wr, int wc, int fr_, int fq_) const {
        int lz = 0; asm volatile("" : "+v"(lz));
        const int lane_ = (int)(threadIdx.x & 63) + lz, fr = lane_ & 15, fq = lane_ >> 4; (void)fr_; (void)fq_;
        const int pp = wc >> 1, half = wc & 1, wid = wr * 4 + wc;
        const unsigned kb = 127u - (unsigned)(half * 64 + fq * 8);
        unsigned Lst[4][16];
#pragma unroll
        for (int ai = 0; ai < 2; ++ai)
#pragma unroll
            for (int m = 0; m < 4; ++m) {
                unsigned C[16], Xc[16];
#pragma unroll
                for (int bj = 0; bj < 2; ++bj)
#pragma unroll
                    for (int n = 0; n < 2; ++n)
#pragma unroll
                        for (int r = 0; r < 4; ++r) C[bj * 8 + n * 4 + r] = (ord_key(acc[ai][bj][m][n][r]) & ~127u) | (kb - (unsigned)(bj * 32 + n * 4 + r));
                sort16_desc(C);
#pragma unroll
                for (int i = 0; i < 16; ++i) Xc[i] = (unsigned)__shfl_xor((int)C[i], 16);
                merge_top16(C, Xc);
#pragma unroll
                for (int i = 0; i < 16; ++i) Xc[i] = (unsigned)__shfl_xor((int)C[i], 32);
                merge_top16(C, Xc);
                if ((m >> 1) == half) {
#pragma unroll
                    for (int i = 0; i < 16; ++i) Lst[ai * 2 + (m & 1)][i] = C[i];
                } else if (fq == 0) {
                    G8_LAS unsigned* xs = X + (((ai * 2 + wr) * 2 + pp) * 4 + m) * 256 + fr;
#pragma unroll
                    for (int i = 0; i < 16; ++i) xs[(i ^ m) << 4] = C[i];
                }
            }
        __syncthreads();
#pragma unroll
        for (int ai = 0; ai < 2; ++ai)
#pragma unroll
            for (int e = 0; e < 2; ++e) {
                const int m = half * 2 + e;
                unsigned Xc[16];
                G8_LAS unsigned* xs = X + (((ai * 2 + wr) * 2 + pp) * 4 + m) * 256 + fr;
#pragma unroll
                for (int i = 0; i < 16; ++i) Xc[i] = xs[(i ^ m) << 4];
                merge_top16(Lst[ai * 2 + e], Xc);
                if (fq == 0) {
#pragma unroll
                    for (int i = 0; i < 16; ++i) xs[(i ^ m) << 4] = Lst[ai * 2 + e][i];
                }
            }
        __syncthreads();
        if (wid < 4) {
            G8_LAS unsigned* x0 = X + ((wid * 2 + 0) * 4 + fq) * 256 + fr; G8_LAS unsigned* x1 = X + ((wid * 2 + 1) * 4 + fq) * 256 + fr;
            float s0[16], s1[16];
#pragma unroll
            for (int i = 0; i < 16; ++i) { s0[i] = unord_key(x0[(i ^ fq) << 4] & ~127u); s1[i] = unord_key(x1[(i ^ fq) << 4] & ~127u); }
#define SEL_CAND(i, j) ((ord_key(s0[i] + s1[j]) & ~255u) | (unsigned)(255 - ((i) * 16 + (j))))
            unsigned C[16], B[16], M2[16], M3[8];
#pragma unroll
            for (int j = 0; j < 16; ++j) C[j] = SEL_CAND(0, j);
#pragma unroll
            for (int k = 0; k < 15; ++k) B[k] = SEL_CAND(k + 1, 0);
            B[15] = KEY_PAD;
            merge_top16(C, B);
#pragma unroll
            for (int j = 0; j < 7; ++j) M2[j] = SEL_CAND(1, j + 1);
            M2[7] = KEY_PAD; M2[8] = KEY_PAD; M2[9] = KEY_PAD;
#pragma unroll
            for (int k = 0; k < 6; ++k) M2[15 - k] = SEL_CAND(k + 2, 1);
            bitonic_merge16_desc(M2);
            M3[0] = SEL_CAND(2, 2); M3[1] = SEL_CAND(2, 3); M3[2] = SEL_CAND(2, 4); M3[3] = SEL_CAND(3, 2); M3[4] = SEL_CAND(4, 2); M3[5] = SEL_CAND(3, 3); M3[6] = KEY_PAD; M3[7] = KEY_PAD;
            bitonic_sort8_desc(M3);
#pragma unroll
            for (int i = 0; i < 8; ++i) B[i] = M3[i];
#pragma unroll
            for (int i = 8; i < 16; ++i) B[i] = KEY_PAD;
            merge_top16(M2, B);
            merge_top16(C, M2);
#undef SEL_CAND
            const int tok = u.pm * 256 + (wid >> 1) * 128 + (wid & 1) * 64 + fq * 16 + fr;
            float rstd;
            {
                const f32x4 q0 = *(const f32x4*)(SSQP + (size_t)tok * 32), q1 = *(const f32x4*)(SSQP + (size_t)tok * 32 + 4), q2 = *(const f32x4*)(SSQP + (size_t)tok * 32 + 8), q3 = *(const f32x4*)(SSQP + (size_t)tok * 32 + 12);
                const f32x4 q = (q0 + q1) + (q2 + q3);
                rstd = rsqrtf(((q[0] + q[1]) + (q[2] + q[3])) * (1.0f / D) + EPS);
            }
            const float mx = unord_key(C[0] & ~255u);
            float e[16]; float sum = 0.f;
#pragma unroll
            for (int r = 0; r < 16; ++r) { e[r] = __expf((unord_key(C[r] & ~255u) - mx) * (rstd * (1.0f / 64.0f))); sum += e[r]; }
            const float inv = 1.0f / sum;
            const size_t ob = (size_t)tok * 128 + u.pn * 16;
            unsigned iw[16];
#pragma unroll
            for (int r = 0; r < 16; ++r) {
                const unsigned code = 255u - (C[r] & 255u);
                const unsigned e0 = 127u - (x0[((code >> 4) ^ (unsigned)fq) << 4] & 127u), e1 = 127u - (x1[((code & 15u) ^ (unsigned)fq) << 4] & 127u);
                iw[r] = e0 * 128u + e1;
            }
            unsigned sc[16];
#pragma unroll
            for (int r = 0; r < 16; ++r) sc[r] = SCT[iw[r]];
#pragma unroll
            for (int r = 0; r < 16; ++r) {
                iw[r] |= sc[r] << 16;
                e[r] *= inv * (float)__builtin_bit_cast(_Float16, (unsigned short)(sc[r] >> 16));
            }
#pragma unroll
            for (int r = 0; r < 4; ++r) *(uint4*)(IDX + ob + r * 4) = make_uint4(iw[4 * r], iw[4 * r + 1], iw[4 * r + 2], iw[4 * r + 3]);
#pragma unroll
            for (int r = 0; r < 4; ++r) *(float4*)(GATE + ob + r * 4) = make_float4(e[4 * r], e[4 * r + 1], e[4 * r + 2], e[4 * r + 3]);
        }
        __syncthreads();
    }
};
__device__ __forceinline__ void phase_select8(const Params& p, int layer, char* smem_phys) {
    const bf16_t* H = (const bf16_t*)(p.ws + OFF_H); const bf16_t* Wf = (const bf16_t*)(p.ws + OFF_WT_Q + (size_t)layer * 2048 * 1024);
    g8::Gemm g{H, H, 512, 512, Wf, T, 2048, 512};
    g8::StaticOrder S; S.init(T, 2048, (int)gridDim.x, (int)blockIdx.x);
    EpiSelect E{(unsigned*)(p.ws + OFF_IDX), (float*)(p.ws + OFF_GATE), (G8_LAS unsigned*)(smem_phys + 131072), (const float*)(p.ws + OFF_SSQ), (const unsigned*)(p.ws + OFF_USC) + (size_t)layer * NEXP};
    g8::gemm_phase<EpiSelect, true>((G8_LAS unsigned char*)smem_phys, g, S, E);
    __syncthreads();
    if (threadIdx.x == 0) *(uint4*)(smem_phys + kDynLds - 16) = make_uint4(0u, 0u, 0u, 0u);
    __syncthreads();
}

__device__ __forceinline__ float ub0(unsigned w) { float f; asm("v_cvt_f32_ubyte0 %0, %1" : "=v"(f) : "v"(w)); return f; }
__device__ __forceinline__ float ub1(unsigned w) { float f; asm("v_cvt_f32_ubyte1 %0, %1" : "=v"(f) : "v"(w)); return f; }
__device__ __forceinline__ float ub2(unsigned w) { float f; asm("v_cvt_f32_ubyte2 %0, %1" : "=v"(f) : "v"(w)); return f; }
__device__ __forceinline__ float ub3(unsigned w) { float f; asm("v_cvt_f32_ubyte3 %0, %1" : "=v"(f) : "v"(w)); return f; }
typedef _Float16 f16x2 __attribute__((ext_vector_type(2)));
__device__ __forceinline__ void glds16(const void* gsrc, unsigned lds_dst) {
    unsigned keep; const unsigned d = (unsigned)__builtin_amdgcn_readfirstlane((int)lds_dst);
    asm volatile("s_mov_b32 %0, m0\n\ts_mov_b32 m0, %2\n\ts_nop 0\n\tglobal_load_lds_dwordx4 %1, off\n\ts_mov_b32 m0, %0" : "=&s"(keep) : "v"(gsrc), "s"(d) : "memory");
}
__device__ __forceinline__ void peer_gather(const Params& p, int layer, const float* __restrict__ gnext, bool final_out, char* smem) {
    const unsigned char* REC = p.ws + OFF_UT + (size_t)layer * NEXP * 1024;
    bf16_t* H = (bf16_t*)(p.ws + OFF_H);
    const unsigned* IDX = (const unsigned*)(p.ws + OFF_IDX); const float* GATE = (const float*)(p.ws + OFF_GATE);
    bf16_t* S = (bf16_t*)(p.ws + OFF_S);
    float* sGain = (float*)(smem + 139264);
    { int lz0 = 0; asm volatile("" : "+v"(lz0)); const int i = (int)threadIdx.x + lz0; if (i < 256) ((f32x4*)sGain)[i] = ((const f32x4*)(p.norm_ffn + layer * 1024))[i]; }
    __syncthreads();
    const int lane = VTID & 63, wid = VTID >> 6, sub = lane >> 4, li = lane & 15;
    char* wbase = smem + (int)(threadIdx.x >> 6) * 17408;
    unsigned* sIdx = (unsigned*)wbase; float* sGate = (float*)(wbase + 512);
    const char* ring = wbase + 1024; const unsigned ringb = (unsigned)(size_t)ring;
    const int gw = VBID * 4 + wid, nw = VGRID * 4;
    for (int t = gw; t < T; t += nw) {
        {
            int lz = 0; asm volatile("" : "+v"(lz));
            const int l2 = 2 * (lane + lz);
            const uint2 idp = *(const uint2*)(IDX + (size_t)t * 128 + l2);
            const float2 g2 = *(const float2*)(GATE + (size_t)t * 128 + l2);
            *(uint2*)(sIdx + l2) = idp; *(float2*)(sGate + l2) = g2;
        }
        int XH[2][4], XL[2][4]; float sx; float xg;
        {
            const int jq = sub >> 1, dq = (sub & 1) * 2;
            f32x4 xr[4]; float am = 0.f, ssx = 0.f;
#pragma unroll
            for (int k = 0; k < 2; ++k) {
                const int col = (16 * jq + li) * 32 + (dq + k) * 8;
                const u32x4 raw = *(const u32x4*)(S + (size_t)t * 1024 + col);
                const f32x4 g0 = *(const f32x4*)(sGain + col), g1 = *(const f32x4*)(sGain + col + 4);
                const f32x4 x0 = (f32x4){lo2f(raw[0]), hi2f(raw[0]), lo2f(raw[1]), hi2f(raw[1])}, x1 = (f32x4){lo2f(raw[2]), hi2f(raw[2]), lo2f(raw[3]), hi2f(raw[3])};
                ssx += (x0[0] * x0[0] + x0[1] * x0[1]) + (x0[2] * x0[2] + x0[3] * x0[3]) + (x1[0] * x1[0] + x1[1] * x1[1]) + (x1[2] * x1[2] + x1[3] * x1[3]);
                xr[2 * k] = x0 * g0; xr[2 * k + 1] = x1 * g1;
#pragma unroll
                for (int c = 0; c < 4; ++c) am = fmaxf(am, fmaxf(fabsf(xr[2 * k][c]), fabsf(xr[2 * k + 1][c])));
            }
            am = fmaxf(am, __shfl_xor(am, 1)); am = fmaxf(am, __shfl_xor(am, 2)); am = fmaxf(am, __shfl_xor(am, 4)); am = fmaxf(am, __shfl_xor(am, 8));
            am = fmaxf(am, __shfl_xor(am, 16)); am = fmaxf(am, __shfl_xor(am, 32));
            ssx = row16_sum(ssx); ssx += __shfl_xor(ssx, 16); ssx += __shfl_xor(ssx, 32);
            const float inv = am > 0.f ? 119.0f / am : 0.f;
            sx = am * (1.0f / 119.0f) * rsqrtf(ssx * (1.0f / D) + EPS);
            int xs = 0; int myL[2], myH[2];
#pragma unroll
            for (int k = 0; k < 2; ++k) {
                unsigned lo = 0u, hi = 0u;
#pragma unroll
                for (int i = 0; i < 8; ++i) {
                    const int q = __float2int_rn(xr[k * 2 + (i >> 2)][i & 3] * inv);
                    const int sh = (i & 3) * 8 + (i >> 2) * 4;
                    lo |= ((unsigned)q & 15u) << sh; hi |= ((unsigned)((q + 8) >> 4) & 15u) << sh;
                    xs += q;
                }
                myL[k] = (int)lo; myH[k] = (int)hi;
            }
            xs += __shfl_xor(xs, 16); xs += __shfl_xor(xs, 32);
#pragma unroll
            for (int j = 0; j < 2; ++j)
#pragma unroll
                for (int d = 0; d < 4; ++d) { const int srcl = (2 * j + (d >> 1)) * 16 + li; XL[j][d] = __shfl(myL[d & 1], srcl); XH[j][d] = __shfl(myH[d & 1], srcl); }
            xg = 0.5f * (float)xs;
        }
        f16x2 accp[2][16];
#pragma unroll
        for (int j = 0; j < 2; ++j)
#pragma unroll
            for (int c = 0; c < 16; ++c) accp[j][c] = (f16x2){(_Float16)0.f, (_Float16)0.f};
        float wsg = 0.f;
        auto issue = [&](int sg) {
            const unsigned e_ = sIdx[sg * 4 + sub] & 0xffffu;
            const unsigned char* rec = REC + (size_t)e_ * 1024 + li * 16;
            const unsigned dst = ringb + (unsigned)(sg & 3) * 4096u;
            glds16(rec, dst); glds16(rec + 256, dst + 1024u); glds16(rec + 512, dst + 2048u); glds16(rec + 768, dst + 3072u);
        };
        auto compute = [&](int sg, bool refill) {
            const char* sl = ring + (sg & 3) * 4096;
            const u32x4 du0 = *(const u32x4*)(sl + lane * 16), du1 = *(const u32x4*)(sl + 1024 + lane * 16);
            const u32x4 dv0 = *(const u32x4*)(sl + 2048 + lane * 16), dv1 = *(const u32x4*)(sl + 3072 + lane * 16);
            const float us = (float)__builtin_bit_cast(_Float16, (unsigned short)(sIdx[sg * 4 + sub] >> 16));
            const float gt = sGate[sg * 4 + sub];
            if (refill) { asm volatile("s_waitcnt lgkmcnt(0)" ::: "memory"); issue(sg + 4); }
            int iah = 0, ial = 0;
#pragma unroll
            for (int j = 0; j < 2; ++j) {
#pragma unroll
                for (int d = 0; d < 4; ++d) {
                    const int w = (int)(j ? du1[d] : du0[d]);
                    iah = __builtin_amdgcn_sdot8(w, XH[j][d], iah, false);
                    ial = __builtin_amdgcn_sdot8(w, XL[j][d], ial, false);
                }
            }
            float pa = us * ((float)(16 * iah + ial) + xg);
            pa = row16_sum(pa);
            const float ww = gt * gelu_exact(pa * sx);
            wsg += ww;
            const float wc = fminf(fmaxf(ww * 65536.0f, -65504.0f), 65504.0f);
            const _Float16 wha = (_Float16)wc, whb = (_Float16)(wc * 0.0625f);
            const f16x2 wa = {wha, wha}, wb = {whb, whb};
#pragma unroll
            for (int j = 0; j < 2; ++j) {
#pragma unroll
                for (int d = 0; d < 4; ++d) {
                    const unsigned wv = j ? dv1[d] : dv0[d], wt = wv >> 8;
                    const f16x2 c0 = __builtin_bit_cast(f16x2, wv & 0x000f000fu), c1 = __builtin_bit_cast(f16x2, wv & 0x00f000f0u);
                    const f16x2 c2 = __builtin_bit_cast(f16x2, wt & 0x000f000fu), c3 = __builtin_bit_cast(f16x2, wt & 0x00f000f0u);
                    accp[j][4 * d + 0] = __builtin_elementwise_fma(c0, wa, accp[j][4 * d + 0]); accp[j][4 * d + 1] = __builtin_elementwise_fma(c1, wb, accp[j][4 * d + 1]);
                    accp[j][4 * d + 2] = __builtin_elementwise_fma(c2, wa, accp[j][4 * d + 2]); accp[j][4 * d + 3] = __builtin_elementwise_fma(c3, wb, accp[j][4 * d + 3]);
                }
            }
        };
        asm volatile("s_waitcnt vmcnt(0)" ::: "memory");
        issue(0); issue(1); issue(2); issue(3);
#pragma unroll 1
        for (int sg = 0; sg < 28; ++sg) {
            asm volatile("s_waitcnt vmcnt(12)" ::: "memory");
            compute(sg, true);
        }
        asm volatile("s_waitcnt vmcnt(12)" ::: "memory");
        compute(28, false);
        asm volatile("s_waitcnt vmcnt(8)" ::: "memory");
        compute(29, false);
        asm volatile("s_waitcnt vmcnt(4)" ::: "memory");
        compute(30, false);
        asm volatile("s_waitcnt vmcnt(0)" ::: "memory");
        compute(31, false);
        const bool up2 = (sub & 2) != 0, up1 = (sub & 1) != 0;
        float wsum = wsg + __shfl_xor(wsg, 32);
        wsum += __shfl_xor(wsum, 16);
        f16x2 r1p[16];
#pragma unroll
        for (int c = 0; c < 16; ++c) {
            const f16x2 keep = up2 ? accp[1][c] : accp[0][c], give = up2 ? accp[0][c] : accp[1][c];
            r1p[c] = keep + __builtin_bit_cast(f16x2, __shfl_xor(__builtin_bit_cast(int, give), 32));
        }
        f16x2 r2p[8];
#pragma unroll
        for (int c = 0; c < 8; ++c) {
            const f16x2 keep = up1 ? r1p[8 + c] : r1p[c], give = up1 ? r1p[c] : r1p[8 + c];
            r2p[c] = keep + __builtin_bit_cast(f16x2, __shfl_xor(__builtin_bit_cast(int, give), 16));
        }
        float r2[16];
#pragma unroll
        for (int dl = 0; dl < 2; ++dl) {
            r2[8 * dl + 0] = 256.0f * (float)r2p[4 * dl + 0][0]; r2[8 * dl + 2] = 256.0f * (float)r2p[4 * dl + 0][1];
            r2[8 * dl + 4] = 256.0f * (float)r2p[4 * dl + 1][0]; r2[8 * dl + 6] = 256.0f * (float)r2p[4 * dl + 1][1];
            r2[8 * dl + 1] = 256.0f * (float)r2p[4 * dl + 2][0]; r2[8 * dl + 3] = 256.0f * (float)r2p[4 * dl + 2][1];
            r2[8 * dl + 5] = 256.0f * (float)r2p[4 * dl + 3][0]; r2[8 * dl + 7] = 256.0f * (float)r2p[4 * dl + 3][1];
        }
        const int col0 = (16 * (sub >> 1) + li) * 32 + (sub & 1) * 16;
        float ss = 0.f;
        bf16_t* srow = S + (size_t)t * 1024 + col0;
        {
            const u32x4 b0 = *(const u32x4*)srow, b1 = *(const u32x4*)(srow + 8);
#pragma unroll
            for (int c = 0; c < 8; ++c) {
                const unsigned wsrc = c < 4 ? b0[c] : b1[c - 4];
                r2[2 * c] = r2[2 * c] - 7.5f * wsum + lo2f(wsrc); r2[2 * c + 1] = r2[2 * c + 1] - 7.5f * wsum + hi2f(wsrc);
                ss += r2[2 * c] * r2[2 * c] + r2[2 * c + 1] * r2[2 * c + 1];
            }
        }
        ss = wave_sum(ss);
        const float rstd = rsqrtf(ss * (1.0f / D) + EPS);
        const float* gp = gnext + col0;
        if (final_out) {
            float* orow = p.out + (size_t)t * 1024 + col0;
#pragma unroll
            for (int c4 = 0; c4 < 4; ++c4) {
                const f32x4 g = *(const f32x4*)(gp + c4 * 4);
                *(f32x4*)(orow + c4 * 4) = (f32x4){r2[c4 * 4] * rstd * g[0], r2[c4 * 4 + 1] * rstd * g[1], r2[c4 * 4 + 2] * rstd * g[2], r2[c4 * 4 + 3] * rstd * g[3]};
            }
        } else {
            u32x4 sv[2];
#pragma unroll
            for (int c4 = 0; c4 < 4; ++c4) { sv[c4 >> 1][(c4 & 1) * 2] = pack2(r2[c4 * 4], r2[c4 * 4 + 1]); sv[c4 >> 1][(c4 & 1) * 2 + 1] = pack2(r2[c4 * 4 + 2], r2[c4 * 4 + 3]); }
            *(u32x4*)srow = sv[0]; *(u32x4*)(srow + 8) = sv[1];
            { u32x4 e8;
#pragma unroll
              for (int c = 0; c < 4; ++c) { int pk = __builtin_amdgcn_cvt_pk_fp8_f32(r2[4 * c], r2[4 * c + 1], 0, false); pk = __builtin_amdgcn_cvt_pk_fp8_f32(r2[4 * c + 2], r2[4 * c + 3], pk, true); e8[c] = (unsigned)pk; }
              *(u32x4*)(p.ws + OFF_H + ((size_t)32 << 20) + (size_t)t * 1024 + col0) = e8; }
            if (lane == 0) ((float*)(p.ws + OFF_VSC))[t] = rstd;
        }
    }
}


#define XB_TMO      128
#define XB_XCNT(j)  (256  + 64 * (j))
#define XB_XSUB(j)  (1280 + 64 * (j))
#define XB_XGEN(j)  (2304 + 64 * (j))
#define XB_TOP      3328
#define XB_TOPGEN   3392
#define XCD_BAR_WORDS 3456
#define XB_SPIN_CAP (1u << 22)
#define LAS __attribute__((address_space(3)))
__device__ __forceinline__ unsigned xb_ld(unsigned* p)              { return __hip_atomic_load(p, __ATOMIC_RELAXED, __HIP_MEMORY_SCOPE_AGENT); }
__device__ __forceinline__ unsigned xb_add(unsigned* p, unsigned v) { return __hip_atomic_fetch_add(p, v, __ATOMIC_RELAXED, __HIP_MEMORY_SCOPE_AGENT); }
__device__ __forceinline__ unsigned xb_xcc_id() { return (unsigned)__builtin_amdgcn_s_getreg((3 << 11) | 20) & 0xFu; }
#define XB_SPIN(cond, bar) do { unsigned _sp = 0; while (cond) { __builtin_amdgcn_s_sleep(1); \
    if ((++_sp & 255u) == 0u) { if (xb_ld(&(bar)[XB_TMO])) break; if (_sp > XB_SPIN_CAP) { atomicAdd(&(bar)[XB_TMO], 1u); break; } } } } while (0)
struct XcdBarrier { unsigned* bar; unsigned x; volatile LAS unsigned* st; };
__device__ __forceinline__ XcdBarrier xcd_barrier_post(unsigned* bar, volatile LAS unsigned* st) {
    XcdBarrier b; b.bar = bar; b.x = xb_xcc_id(); b.st = st;
    if (threadIdx.x == 0) (void)xb_add(&bar[XB_XCNT(b.x)], 1u);
    return b;
}
__device__ __forceinline__ void xcd_barrier_complete(unsigned* bar, unsigned x, unsigned& nloc, unsigned& nx) {
    const unsigned G = gridDim.x * gridDim.y * gridDim.z;
    unsigned sum, cnt, mine, sp = 0u;
    for (;;) {
        sum = 0u; cnt = 0u; mine = 0u;
#pragma unroll
        for (unsigned j = 0; j < 16; ++j) { const unsigned c = xb_ld(&bar[XB_XCNT(j)]); sum += c; cnt += (c > 0u) ? 1u : 0u; mine = (j == x) ? c : mine; }
        if (sum == G) break;
        __builtin_amdgcn_s_sleep(1);
        if ((++sp & 255u) == 0u) { if (xb_ld(&bar[XB_TMO])) break; if (sp > XB_SPIN_CAP) { atomicAdd(&bar[XB_TMO], 1u); break; } }
    }
    nloc = mine > 0u ? mine : 1u; nx = cnt > 0u ? cnt : 1u;
}
__device__ __forceinline__ void xcd_barrier(const XcdBarrier& b) {
    asm volatile("s_waitcnt vmcnt(0)" ::: "memory");
    __syncthreads();
    if (threadIdx.x == 0) {
        unsigned* bar = b.bar;
        __builtin_amdgcn_s_waitcnt(0);
        unsigned nloc = b.st[0], nx = b.st[1];
        if (nloc == 0u) { xcd_barrier_complete(bar, b.x, nloc, nx); b.st[0] = nloc; b.st[1] = nx; }
        const unsigned old = xb_add(&bar[XB_XSUB(b.x)], 1u);
        const unsigned gen = old / nloc;
        if (old + 1u == (gen + 1u) * nloc) {
            __builtin_amdgcn_fence(__ATOMIC_RELEASE, "agent");
            asm volatile("s_waitcnt vmcnt(0)" ::: "memory");
            const unsigned og = xb_add(&bar[XB_TOP], 1u);
            const unsigned tg = og / nx;
            if (og + 1u == (tg + 1u) * nx) xb_add(&bar[XB_TOPGEN], 1u);
            else XB_SPIN(xb_ld(&bar[XB_TOPGEN]) == tg, bar);
            __builtin_amdgcn_fence(__ATOMIC_ACQUIRE, "agent");
            xb_add(&bar[XB_XGEN(b.x)], 1u);
            asm volatile("s_waitcnt vmcnt(0)" ::: "memory");
        } else {
            XB_SPIN(xb_ld(&bar[XB_XGEN(b.x)]) == gen, bar);
            __builtin_amdgcn_fence(__ATOMIC_ACQUIRE, "agent");
            asm volatile("s_waitcnt vmcnt(0)" ::: "memory");
        }
    }
    __syncthreads();
}

constexpr int NPHASE = 12;
__global__ void __launch_bounds__(512, 2) mega(Params p, int ph_lo, int ph_hi) {
    extern __shared__ __attribute__((aligned(16))) char smem_phys[];
    uint4& xb_words = *(uint4*)(smem_phys + kDynLds - 16);
    if (threadIdx.x == 0) xb_words = make_uint4(0u, 0u, 0u, 0u);
    __syncthreads();
    const XcdBarrier xbar = xcd_barrier_post((unsigned*)(p.ws + OFF_BAR), (volatile LAS unsigned*)&xb_words);
    char* smem = smem_phys + (threadIdx.x >> 8) * 65536;
    bf16_t* Rg = (bf16_t*)(p.ws + OFF_REGION);
    bf16_t* Hb = (bf16_t*)(p.ws + OFF_H);
#define PHASE(k, ...) if (ph_lo <= (k) && (k) < ph_hi) { __VA_ARGS__; if ((k) + 1 < ph_hi) xcd_barrier(xbar); }
    unsigned* sbctr = (unsigned*)(p.ws + OFF_BAR + 14336);
    PHASE(0,
        transpose_convert<true>(p.ab_w_in, (bf16_t*)(p.ws + OFF_WT_IN), 1024, AB_IN, AB_IN_PAD, smem);
        rmsnorm_rows(p.x, p.norm_mix, Hb))
    PHASE(1, phase_gemm_in8(p, smem_phys))
    PHASE(2, gla_prep(p, smem))
    PHASE(3, gla_scan(p, smem); sb_fast(p, smem_phys + 98304, sbctr);
        quantize_tables_static(p, 64);
        transpose_convert(p.ab_w_out, (bf16_t*)(p.ws + OFF_WT_OUT), 1024, 1024, 1024, smem, 64);
        transpose_convert(p.c_w_in, (bf16_t*)(p.ws + OFF_WT_CIN), 1024, 4096, 4096, smem, 64, p.norm_mix + 1024, p.ws + OFF_SK_W8, 2048);
        transpose_convert(p.c_w_out, (bf16_t*)(p.ws + OFF_WT_COUT), 2048, 1024, 1024, smem, 64);
        fold_query_weights(p, 64))
    PHASE(4, phase_gemm_resid8(Rg + R_QSB, Rg + R_GG, 512, 512, (const bf16_t*)(p.ws + OFF_WT_OUT), 1024, p.x, (bf16_t*)(p.ws + OFF_S), (float*)(p.ws + OFF_SSQ), p.ws + OFF_H, smem_phys))
    PHASE(5, phase_select8(p, 0, smem_phys))
    PHASE(6, peer_gather(p, 0, p.norm_mix + 1024, false, smem_phys))
    PHASE(7, phase_gemm_cin8_v(p, smem_phys))
    PHASE(8, phase_gemm_cin8_u(p, smem_phys))
    PHASE(9, phase_gemm_resid8(Rg, Rg, 2048, 2048, (const bf16_t*)(p.ws + OFF_WT_COUT), 2048, nullptr, (bf16_t*)(p.ws + OFF_S), (float*)(p.ws + OFF_SSQ), p.ws + OFF_H, smem_phys))
    PHASE(10, phase_select8(p, 1, smem_phys))
    PHASE(11, peer_gather(p, 1, p.final_norm, true, smem_phys))
}

extern "C" void kernel_launch(void* const* d_in, const int* in_sizes, int n_in, void* d_out, int out_size, void* d_ws, size_t ws_size, hipStream_t stream) {
    static int grid_blocks = 0;
    if (!grid_blocks) {
        int dev = 0, cus = 0, per_cu = 0;
        hipGetDevice(&dev);
        hipDeviceGetAttribute(&cus, hipDeviceAttributeMultiprocessorCount, dev);
        hipFuncSetAttribute((const void*)mega, hipFuncAttributeMaxDynamicSharedMemorySize, kDynLds);
        hipOccupancyMaxActiveBlocksPerMultiprocessor(&per_cu, mega, 512, kDynLds);
        if (per_cu < 1) per_cu = 1;
        if (per_cu > 1) per_cu = 1;
        grid_blocks = cus * per_cu;
        if (n_in != 18 || ws_size < WS_END) fprintf(stderr, "kernel_launch: unexpected n_in %d or ws_size %zu < %zu\n", n_in, ws_size, (size_t)WS_END);
    }
    Params p{};
    p.x = (const float*)d_in[0]; p.norm_mix = (const float*)d_in[1]; p.norm_ffn = (const float*)d_in[2]; p.ab_w_in = (const float*)d_in[3];
    p.ab_w_alpha2 = (const float*)d_in[4]; p.ab_b_alpha2 = (const float*)d_in[5]; p.ab_gla_norm = (const float*)d_in[6]; p.ab_w_out = (const float*)d_in[7];
    p.c_w_in = (const float*)d_in[8]; p.c_v_norm = (const float*)d_in[9]; p.c_w_spatial = (const float*)d_in[10]; p.c_b_spatial = (const float*)d_in[11];
    p.c_w_out = (const float*)d_in[12]; p.peer_w_q = (const float*)d_in[13]; p.peer_subkeys = (const float*)d_in[14]; p.peer_u = (const float*)d_in[15];
    p.peer_v = (const float*)d_in[16]; p.final_norm = (const float*)d_in[17];
    p.out = (float*)d_out; p.ws = (unsigned char*)d_ws;
    (void)hipMemsetAsync((char*)d_ws + OFF_BAR, 0, 16384, stream);
#if ONE_LAUNCH
    int lo = 0, hi = NPHASE;
    void* args[] = {&p, &lo, &hi};
    hipError_t e = hipLaunchCooperativeKernel((void*)mega, dim3(grid_blocks), dim3(512), args, kDynLds, stream);
    if (e != hipSuccess) fprintf(stderr, "cooperative launch failed: %s (grid %d)\n", hipGetErrorString(e), grid_blocks);
#else
    for (int ph = 0; ph < NPHASE; ++ph) hipLaunchKernelGGL(mega, dim3(grid_blocks), dim3(512), kDynLds, stream, p, ph, ph + 1);
#endif
}
```

```cpp
#include <hip/hip_runtime.h>
#include <cstdio>
#include <cstdint>

#ifndef ONE_LAUNCH
#define ONE_LAUNCH 1
#endif


#define VTID ((int)(threadIdx.x & 255))
#define VBID ((int)(blockIdx.x * 2 + (threadIdx.x >> 8)))
#define VGRID ((int)(gridDim.x * 2))
typedef unsigned short bf16_t;
typedef short bf16x8 __attribute__((ext_vector_type(8)));
typedef float f32x4 __attribute__((ext_vector_type(4)));
typedef unsigned u32x4 __attribute__((ext_vector_type(4)));
typedef __bf16 bf16x2_t __attribute__((ext_vector_type(2)));

constexpr int T = 32768, D = 1024, SEQ = 2048, NB = 16;
constexpr int AB_IN = 3088, AB_IN_PAD = 3200;
constexpr float EPS = 1e-6f;
constexpr int NEXP = 16384;
constexpr int kDynLds = 163840;

constexpr size_t SZ_WT_IN = (size_t)AB_IN_PAD * 1024 * 2;
constexpr size_t SZ_WT_OUT = (size_t)1024 * 1024 * 2;
constexpr size_t SZ_WT_CIN = (size_t)4096 * 1024 * 2;
constexpr size_t SZ_WT_COUT = (size_t)1024 * 2048 * 2;
constexpr size_t SZ_WT_Q = (size_t)2 * 2048 * 1024 * 2;
constexpr size_t SZ_SK = (size_t)2 * 8 * 2 * 128 * 128 * 2;
constexpr size_t SZ_TAB = (size_t)2 * NEXP * 1024;
constexpr size_t SZ_TSC = (size_t)2 * NEXP * 4;
constexpr size_t OFF_WT_IN = 0;
constexpr size_t OFF_WT_OUT = OFF_WT_IN + SZ_WT_IN;
constexpr size_t OFF_WT_CIN = OFF_WT_OUT + SZ_WT_OUT;
constexpr size_t OFF_WT_COUT = OFF_WT_CIN + SZ_WT_CIN;
constexpr size_t OFF_WT_Q = OFF_WT_COUT + SZ_WT_COUT;
constexpr size_t OFF_SK = OFF_WT_Q + SZ_WT_Q;
constexpr size_t OFF_UT = OFF_SK;
constexpr size_t OFF_USC = OFF_UT + SZ_TAB;
constexpr size_t OFF_VSC = OFF_USC + SZ_TSC;
constexpr size_t OFF_H = OFF_VSC + SZ_TSC;
constexpr size_t OFF_IDX = OFF_H + (size_t)T * 1024 * 2;
constexpr size_t OFF_GATE = OFF_IDX + (size_t)T * 128 * 4;
constexpr size_t OFF_SSQ = OFF_GATE + (size_t)T * 128 * 4;
constexpr size_t OFF_REGION = OFF_SSQ + (size_t)T * 32 * 4;
constexpr size_t SZ_REGION = (size_t)256 << 20;
constexpr size_t OFF_S = OFF_REGION + SZ_REGION;
constexpr size_t OFF_SK_W8 = OFF_S + (size_t)T * 1024 * 2;
constexpr size_t OFF_BAR = OFF_SK_W8 + (size_t)2048 * 1024;
constexpr size_t WS_END = OFF_BAR + 16384;
constexpr size_t R_QSB = 0;
constexpr size_t R_KSB = R_QSB + (size_t)T * 512;
constexpr size_t R_VTSB = R_KSB + (size_t)T * 512;
constexpr size_t R_QG = R_VTSB + (size_t)T * 512;
constexpr size_t R_KG = R_QG + (size_t)T * 256;
constexpr size_t R_VTG = R_KG + (size_t)T * 256;
constexpr size_t R_GG = R_VTG + (size_t)T * 512;
constexpr size_t R_ALR = R_GG + (size_t)T * 512;
constexpr size_t R_KOT = R_ALR + (size_t)T * 32;
constexpr size_t R_DEC = R_KOT + (size_t)T * 256;

struct Params {
    const float* x; const float* norm_mix; const float* norm_ffn; const float* ab_w_in; const float* ab_w_alpha2; const float* ab_b_alpha2;
    const float* ab_gla_norm; const float* ab_w_out; const float* c_w_in; const float* c_v_norm; const float* c_w_spatial; const float* c_b_spatial;
    const float* c_w_out; const float* peer_w_q; const float* peer_subkeys; const float* peer_u; const float* peer_v; const float* final_norm;
    float* out; unsigned char* ws;
};

__device__ __forceinline__ float bf2f(bf16_t v) { return __uint_as_float(((unsigned)v) << 16); }
__device__ __forceinline__ bf16_t f2bf(float f) { unsigned r; asm("v_cvt_pk_bf16_f32 %0, %1, %1" : "=v"(r) : "v"(f)); return (bf16_t)r; }
__device__ __forceinline__ unsigned pack2(float lo, float hi) { unsigned r; asm("v_cvt_pk_bf16_f32 %0, %1, %2" : "=v"(r) : "v"(lo), "v"(hi)); return r; }
__device__ __forceinline__ float lo2f(unsigned w) { return __uint_as_float(w << 16); }
__device__ __forceinline__ float hi2f(unsigned w) { return __uint_as_float(w & 0xffff0000u); }
__device__ __forceinline__ float dot2(unsigned a, unsigned b, float acc) { return __builtin_amdgcn_fdot2_f32_bf16(__builtin_bit_cast(bf16x2_t, a), __builtin_bit_cast(bf16x2_t, b), acc, false); }
#define GELU_C0 -1.0001451969146729f
#define GELU_C1 -1.1498452425003052f
#define GELU_C2 -0.46162763237953186f
#define GELU_C3 -0.051034148782491684f
#define GELU_C4 0.007168652955442667f
#define GELU_C5 -0.0006095620337873697f
#define GELU_C6 2.30170971917687e-05f
__device__ __forceinline__ float gelu_exact(float v) {
    const float a = fminf(fabsf(v), 6.0f);
    float q = GELU_C6 * a + GELU_C5; q = q * a + GELU_C4; q = q * a + GELU_C3; q = q * a + GELU_C2; q = q * a + GELU_C1; q = q * a + GELU_C0;
    return fmaxf(v, 0.f) - fabsf(v) * __builtin_amdgcn_exp2f(q);
}
typedef float f32x2 __attribute__((ext_vector_type(2)));
__device__ __forceinline__ f32x2 gelu_exact2(f32x2 v) {
    const f32x2 av = __builtin_elementwise_abs(v), a = __builtin_elementwise_min(av, (f32x2){6.0f, 6.0f});
    f32x2 q = (f32x2){GELU_C6, GELU_C6} * a + (f32x2){GELU_C5, GELU_C5};
    q = q * a + (f32x2){GELU_C4, GELU_C4}; q = q * a + (f32x2){GELU_C3, GELU_C3}; q = q * a + (f32x2){GELU_C2, GELU_C2};
    q = q * a + (f32x2){GELU_C1, GELU_C1}; q = q * a + (f32x2){GELU_C0, GELU_C0};
    const f32x2 e = {__builtin_amdgcn_exp2f(q[0]), __builtin_amdgcn_exp2f(q[1])};
    return __builtin_elementwise_max(v, (f32x2){0.f, 0.f}) - av * e;
}
__device__ __forceinline__ float row16_sum(float v) {
    v += __builtin_bit_cast(float, __builtin_amdgcn_update_dpp(0, __builtin_bit_cast(int, v), 0x128, 0xf, 0xf, false));
    v += __builtin_bit_cast(float, __builtin_amdgcn_update_dpp(0, __builtin_bit_cast(int, v), 0x124, 0xf, 0xf, false));
    v += __builtin_bit_cast(float, __builtin_amdgcn_update_dpp(0, __builtin_bit_cast(int, v), 0x122, 0xf, 0xf, false));
    v += __builtin_bit_cast(float, __builtin_amdgcn_update_dpp(0, __builtin_bit_cast(int, v), 0x121, 0xf, 0xf, false));
    return v;
}
__device__ __forceinline__ float wave_sum(float v) {
#pragma unroll
    for (int o = 32; o >= 1; o >>= 1) v += __shfl_xor(v, o);
    return v;
}

template <bool PERM_IN = false>
__device__ __forceinline__ void transpose_convert(const float* __restrict__ W, bf16_t* __restrict__ Wt, int K, int N, int Npad, char* smem, int vb0 = 0, const float* __restrict__ kgain = nullptr, unsigned char* __restrict__ W8 = nullptr, int f8from = 0) {
    float* tile = (float*)smem;
    const int tk = K / 64, tn = Npad / 64, ntile = tk * tn;
    const int tid = VTID;
    if (VBID < vb0) return;
    for (int tl = VBID - vb0; tl < ntile; tl += VGRID - vb0) {
        const int k0 = (tl % tk) * 64, n0 = (tl / tk) * 64;
        const int c = tid & 63, r0 = tid >> 6;
        int nd = n0;
        if (PERM_IN) { if (n0 >= 1024 && n0 < 1536) nd = n0 + 1024; else if (n0 >= 1536 && n0 < 2048) nd = n0 - 512; else if (n0 >= 2048 && n0 < 2560) nd = n0 + 512; else if (n0 >= 2560 && n0 < 3072) nd = n0 - 1024; }
#pragma unroll
        for (int i = 0; i < 16; ++i) {
            const int r = r0 + 4 * i;
            float v = (n0 + c < N) ? W[(size_t)(k0 + r) * N + n0 + c] : 0.f;
            if (kgain) v *= kgain[k0 + r];
            tile[c * 65 + r] = v;
        }
        __syncthreads();
#pragma unroll
        for (int i = 0; i < 16; ++i) {
            const int n = r0 + 4 * i;
            Wt[(size_t)(nd + n) * K + k0 + c] = f2bf(tile[n * 65 + c]);
            if (W8 && nd >= f8from) { const float w64 = tile[n * 65 + c] * 64.0f; W8[(size_t)(nd + n - f8from) * K + k0 + c] = (unsigned char)__builtin_amdgcn_cvt_pk_fp8_f32(w64, w64, 0, false); }
        }
        __syncthreads();
    }
}
__device__ __forceinline__ void quantize_tables_static(const Params& p, int vb0 = 0) {
    const int lane = VTID & 63, wid = VTID >> 6;
    if (VBID < vb0) return;
    for (unsigned task = (unsigned)(VBID - vb0); task < 512u; task += (unsigned)(VGRID - vb0)) {
        const bool isv = task >= 256u;
        const int r0 = (int)(task & 255u) * 128 + wid * 32;
        const float* src = isv ? p.peer_v : p.peer_u;
        unsigned char* recs = p.ws + OFF_UT;
        _Float16* sct = (_Float16*)(p.ws + OFF_USC);
        f32x4 vnx[4];
        {
            const float* x0 = src + (size_t)r0 * 1024 + lane * 4;
#pragma unroll
            for (int i = 0; i < 4; ++i) vnx[i] = *(const f32x4*)(x0 + i * 256);
        }
        for (int rr = 0; rr < 32; ++rr) {
            const int r = r0 + rr;
            f32x4 v[4]; float aml = 0.f;
#pragma unroll
            for (int i = 0; i < 4; ++i) {
                v[i] = vnx[i];
                aml = fmaxf(aml, fmaxf(fmaxf(fabsf(v[i][0]), fabsf(v[i][1])), fmaxf(fabsf(v[i][2]), fabsf(v[i][3]))));
            }
            if (rr + 1 < 32) {
                const float* xn = src + (size_t)(r + 1) * 1024 + lane * 4;
#pragma unroll
                for (int i = 0; i < 4; ++i) vnx[i] = *(const f32x4*)(xn + i * 256);
            }
#pragma unroll
            for (int o = 32; o >= 1; o >>= 1) aml = fmaxf(aml, __shfl_xor(aml, o));
            float ssq = 0.f;
#pragma unroll
            for (int i = 0; i < 4; ++i) ssq += (v[i][0] * v[i][0] + v[i][1] * v[i][1]) + (v[i][2] * v[i][2] + v[i][3] * v[i][3]);
            ssq = wave_sum(ssq);
            const float gmax = aml * (1.002f / 7.5f);
            const _Float16 hs = (_Float16)fminf(fmaxf(0.34f * sqrtf(ssq * (1.0f / 1024.0f)), 0.5f * gmax), gmax);
            const float gs_ = (float)hs, gi_ = gs_ > 0.f ? 1.0f / gs_ : 0.f;
            const int sgn = isv ? 0 : 8;
            unsigned char* rec = recs + (size_t)r * 1024 + (isv ? 512 : 0);
#pragma unroll
            for (int i = 0; i < 4; ++i) {
                unsigned wv = 0;
#pragma unroll
                for (int j = 0; j < 4; ++j) wv |= (unsigned)(min(15, max(0, __float2int_rn(v[i][j] * gi_ + 7.5f))) ^ sgn) << (8 * j);
                wv <<= (lane & 1) * 4;
                wv |= (unsigned)__shfl_xor((int)wv, 1);
                if ((lane & 1) == 0) *(unsigned*)(rec + 128 * i + (lane >> 1) * 4) = wv;
            }
            if (lane == 0) sct[(size_t)r * 2 + (isv ? 1 : 0)] = (_Float16)gs_;
        }
    }
}
__device__ __forceinline__ void convert_rows(const float* __restrict__ X, bf16_t* __restrict__ Xb, float* __restrict__ RSTD) {
    const int lane = VTID & 63, wid = VTID >> 6;
    const int gw = VBID * 4 + wid, nw = VGRID * 4;
    for (int t = gw; t < T; t += nw) {
        const float* xr = X + (size_t)t * D;
        float4 v[4]; float ss = 0.f;
#pragma unroll
        for (int i = 0; i < 4; ++i) { v[i] = *(const float4*)(xr + i * 256 + lane * 4); ss += v[i].x * v[i].x + v[i].y * v[i].y + v[i].z * v[i].z + v[i].w * v[i].w; }
        ss = wave_sum(ss);
#pragma unroll
        for (int i = 0; i < 4; ++i) { uint2 o; o.x = pack2(v[i].x, v[i].y); o.y = pack2(v[i].z, v[i].w); *(uint2*)(Xb + (size_t)t * D + i * 256 + lane * 4) = o; }
        if (lane == 0) RSTD[t] = rsqrtf(ss * (1.0f / D) + EPS);
    }
}
__device__ __forceinline__ void rmsnorm_rows(const float* __restrict__ X, const float* __restrict__ g, bf16_t* __restrict__ Hout) {
    const int lane = VTID & 63, wid = VTID >> 6;
    const int gw = VBID * 4 + wid, nw = VGRID * 4;
    for (int t = gw; t < T; t += nw) {
        const float* xr = X + (size_t)t * D;
        float4 v[4]; float ss = 0.f;
#pragma unroll
        for (int i = 0; i < 4; ++i) { v[i] = *(const float4*)(xr + i * 256 + lane * 4); ss += v[i].x * v[i].x + v[i].y * v[i].y + v[i].z * v[i].z + v[i].w * v[i].w; }
        ss = wave_sum(ss);
        const float rstd = rsqrtf(ss * (1.0f / D) + EPS);
#pragma unroll
        for (int i = 0; i < 4; ++i) {
            const float4 gg = *(const float4*)(g + i * 256 + lane * 4);
            uint2 o; o.x = pack2(v[i].x * rstd * gg.x, v[i].y * rstd * gg.y); o.y = pack2(v[i].z * rstd * gg.z, v[i].w * rstd * gg.w);
            *(uint2*)(Hout + (size_t)t * D + i * 256 + lane * 4) = o;
        }
    }
}

__device__ __forceinline__ void store_bf16x4(bf16_t* p, f32x4 v) { uint2 o; o.x = pack2(v[0], v[1]); o.y = pack2(v[2], v[3]); *(uint2*)p = o; }

#define G8_LAS __attribute__((address_space(3)))
namespace g8 {
constexpr int BM = 256, BK = 64, HALF = 128, HTB = HALF * BK * 2, NXCD = 8, WGM = 8;
__device__ __forceinline__ int lds_byte(int r, int c) { const int st = (r >> 4) * 2 + (c >> 5), rr = r & 15, cc = c & 31, ob = rr * 64 + cc * 2; return st * 1024 + (ob ^ (((ob >> 9) & 1) << 5)); }
__device__ __forceinline__ void stage_rc(int b, int& R, int& C) { const int st = b / 1024, sb = b % 1024, swz = sb ^ (((sb >> 9) & 1) << 5); R = (st >> 1) * 16 + swz / 64; C = (st & 1) * 32 + (swz % 64) / 2; }
__device__ __forceinline__ int perm32(int rho) { const int n = rho >> 4, i = rho & 15; return 8 * (i >> 2) + 4 * n + (i & 3); }
struct Unit { int pm, pn; };
struct Gemm { const bf16_t* A0; const bf16_t* A1; int lda, ksplit; const bf16_t* Bt; int M, N, K; };
struct StaticOrder {
    int nM, nN, nwg, G, c;
    __device__ __forceinline__ void init(int M, int N, int G_, int c_) { nM = M / BM; nN = N / BM; nwg = nM * nN; G = G_; c = c_; }
    __device__ __forceinline__ bool next(int i, Unit& u) const {
        const int L = i * G + c; if (L >= nwg) return false;
        int wgid = L; { const int q = nwg / NXCD, r = nwg % NXCD, xcd = wgid % NXCD, off = wgid / NXCD; wgid = (xcd < r ? xcd * (q + 1) : r * (q + 1) + (xcd - r) * q) + off; }
        const int nig = WGM * nN, gid = wgid / nig, fm = gid * WGM, gsz = (nM - fm) < WGM ? (nM - fm) : WGM;
        u.pm = fm + ((wgid % nig) % gsz); u.pn = (wgid % nig) / gsz; return true;
    }
};
typedef int i32x4v __attribute__((ext_vector_type(4)));
typedef int i32x8v __attribute__((ext_vector_type(8)));
template <class Epi, bool F8 = false>
__device__ __forceinline__ void gemm_phase(G8_LAS unsigned char* lds, const Gemm g, const StaticOrder& S, const Epi& E) {
    const int tid = threadIdx.x, wid = __builtin_amdgcn_readfirstlane(tid >> 6), lane = tid & 63, wr = wid >> 2, wc = wid & 3, fr = lane & 15, fq = lane >> 4;
    const int K = g.K, nt = K / BK, lda = g.lda;
    unsigned voffA[2], voffB[2];
#pragma unroll
    for (int i = 0; i < 2; ++i) { int R, C; stage_rc(tid * 16 + i * 8192, R, C); const int Rb = (R & ~31) + perm32(R & 31);
        voffA[i] = (unsigned)(R * lda + C) * 2u; voffB[i] = (unsigned)(Rb * K + C) * 2u; }
    const size_t hstepA = (size_t)HALF * lda * 2, hstepB = (size_t)HALF * K * 2;
    const unsigned ldsw = (unsigned)wid * 1024u;
    const unsigned ldsbase = (unsigned)__builtin_amdgcn_readfirstlane((int)(unsigned)(__SIZE_TYPE__)lds);
    const int fcol = F8 ? 32 * (fq >> 1) + 24 * (fq & 1) : fq * 8;
    const int aoff = lds_byte(wr * 64 + fr, fcol), boff = lds_byte(wc * 32 + fr, fcol);
    const int aoff2 = F8 ? (aoff ^ 16) : aoff + 1024, boff2 = F8 ? (boff ^ 16) : boff + 1024;
    auto aptr = [&](int pm, int kt) -> const char* { const int kb = kt * BK; const bf16_t* b = kb < g.ksplit ? g.A0 + kb : g.A1 + (kb - g.ksplit); return (const char*)b + (size_t)pm * 2 * hstepA; };
    auto bptr = [&](int pn, int kt) -> const char* { return (const char*)(g.Bt + kt * BK) + (size_t)pn * 2 * hstepB; };
#define G8_SA(b, h) (((b) * 2 + (h)) * HTB)
#define G8_SB(b, h) ((4 + (b) * 2 + (h)) * HTB)
#define G8_STAGE(bufoff, gbase, voff) do { _Pragma("unroll") for (int _i = 0; _i < 2; ++_i) { \
        if constexpr (F8) { unsigned _keep; const unsigned _d = ldsbase + (unsigned)(bufoff) + ldsw + _i * 8192u; \
            const char* _gb = (const char*)(gbase) + (size_t)_i * ((voff) == voffA ? hstepA : hstepB) / 2;        \
            asm volatile("s_mov_b32 %0, m0\n\ts_mov_b32 m0, %3\n\ts_nop 0\n\tglobal_load_lds_dwordx4 %1, %2\n\ts_mov_b32 m0, %0" : "=&s"(_keep) : "v"((voff)[0]), "s"(_gb), "s"(_d) : "memory"); } \
        else __builtin_amdgcn_global_load_lds((const unsigned*)((const char*)(gbase) + (voff)[_i]), (G8_LAS unsigned*)(lds + (bufoff) + ldsw + _i * 8192), 16, 0, 0); } } while (0)
#define G8_LD1(d16, d32, addr0, addr1) do { if constexpr (F8) { const i32x4v _lo = *(const G8_LAS i32x4v*)(addr0), _hi = *(const G8_LAS i32x4v*)(addr1); \
            d32 = __builtin_shufflevector(_lo, _hi, 0, 1, 2, 3, 4, 5, 6, 7); } \
        else { d16[0] = *(const G8_LAS bf16x8*)(addr0); d16[1] = *(const G8_LAS bf16x8*)(addr1); } } while (0)
#define G8_LDA(dst, b, h) do { _Pragma("unroll") for (int m = 0; m < 4; ++m) G8_LD1(dst[m], dst##8[m], lds + G8_SA(b, h) + aoff + m * 2048, lds + G8_SA(b, h) + aoff2 + m * 2048); } while (0)
#define G8_LDB(dst, b, h) do { _Pragma("unroll") for (int n = 0; n < 2; ++n) G8_LD1(dst[n], dst##8[n], lds + G8_SB(b, h) + boff + n * 2048, lds + G8_SB(b, h) + boff2 + n * 2048); } while (0)
#define G8_MMA(ai, bj, At, Bt) do { __builtin_amdgcn_s_setprio(1); _Pragma("unroll") for (int m = 0; m < 4; ++m) _Pragma("unroll") for (int n = 0; n < 2; ++n) { \
        if constexpr (F8) acc[ai][bj][m][n] = __builtin_amdgcn_mfma_scale_f32_16x16x128_f8f6f4(Bt##8[n], At##8[m], acc[ai][bj][m][n], 0, 0, 0, sc1, 0, sc1); \
        else { _Pragma("unroll") for (int k = 0; k < 2; ++k) acc[ai][bj][m][n] = __builtin_amdgcn_mfma_f32_16x16x32_bf16(Bt[n][k], At[m][k], acc[ai][bj][m][n], 0, 0, 0); } } \
        __builtin_amdgcn_s_setprio(0); } while (0)
#define G8_WAIT_V(n) asm volatile("s_waitcnt vmcnt(" #n ")" ::: "memory")
#define G8_WAIT_L(n) asm volatile("s_waitcnt lgkmcnt(" #n ")" ::: "memory")
#define G8_BAR __builtin_amdgcn_s_barrier()
#define G8_SCHED __builtin_amdgcn_sched_barrier(0)
    Unit cur, nxt; int ui = 0;
    if (!S.next(0, cur)) return;
    int sc1 = 0x7f7f7f7f; asm volatile("" : "+v"(sc1));
    f32x4 acc[2][2][4][2];
#pragma unroll
    for (int a = 0; a < 2; ++a)
#pragma unroll
        for (int b = 0; b < 2; ++b)
#pragma unroll
            for (int m = 0; m < 4; ++m)
#pragma unroll
                for (int n = 0; n < 2; ++n) acc[a][b][m][n] = (f32x4){0.f, 0.f, 0.f, 0.f};
    bf16x8 At[4][2], B0[2][2], B1[2][2];
    i32x8v At8[4], B08[2], B18[2];
    {
        const char* cA = aptr(cur.pm, 0); const char* cB = bptr(cur.pn, 0); const char* cA1 = aptr(cur.pm, 1); const char* cB1 = bptr(cur.pn, 1);
        G8_STAGE(G8_SB(0, 0), cB, voffB); G8_STAGE(G8_SB(0, 1), cB + hstepB, voffB); G8_STAGE(G8_SA(0, 0), cA, voffA); G8_STAGE(G8_SA(0, 1), cA + hstepA, voffA);
        if (wr == 1) G8_BAR;
        G8_WAIT_V(2); G8_BAR;
        G8_STAGE(G8_SB(1, 0), cB1, voffB); G8_STAGE(G8_SA(1, 0), cA1, voffA); G8_STAGE(G8_SB(1, 1), cB1 + hstepB, voffB);
        G8_WAIT_V(6); G8_BAR;
    }
    for (;;) {
        const bool has_next = S.next(ui + 1, nxt);
        const int npm = has_next ? nxt.pm : cur.pm, npn = has_next ? nxt.pn : cur.pn;
#pragma unroll 1
        for (int t = 0; t < nt; t += 2) {
            const bool last = (t == nt - 2);
            const char* a1 = aptr(cur.pm, t + 1);
            const char* a2 = last ? aptr(npm, 0) : aptr(cur.pm, t + 2); const char* b2 = last ? bptr(npn, 0) : bptr(cur.pn, t + 2);
            const char* a3 = last ? aptr(npm, 1) : aptr(cur.pm, t + 3); const char* b3 = last ? bptr(npn, 1) : bptr(cur.pn, t + 3);
            G8_LDB(B0, 0, 0); G8_LDB(B1, 0, 1); G8_SCHED; G8_LDA(At, 0, 0); G8_STAGE(G8_SA(1, 1), a1 + hstepA, voffA);
            G8_WAIT_V(8); G8_WAIT_L(0); G8_BAR; G8_MMA(0, 0, At, B0); G8_MMA(0, 1, At, B1); G8_BAR; G8_SCHED;
            G8_LDA(At, 0, 1); G8_STAGE(G8_SB(0, 0), b2, voffB); G8_STAGE(G8_SB(0, 1), b2 + hstepB, voffB); G8_STAGE(G8_SA(0, 0), a2, voffA);
            G8_WAIT_V(8); G8_WAIT_L(0); G8_BAR; G8_MMA(1, 0, At, B0); G8_MMA(1, 1, At, B1); G8_BAR; G8_SCHED;
            G8_LDB(B0, 1, 0); G8_LDB(B1, 1, 1); G8_SCHED; G8_LDA(At, 1, 0); G8_STAGE(G8_SA(0, 1), a2 + hstepA, voffA);
            G8_WAIT_V(8); G8_WAIT_L(0); G8_BAR; G8_MMA(0, 0, At, B0); G8_MMA(0, 1, At, B1); G8_BAR; G8_SCHED;
            G8_LDA(At, 1, 1); G8_STAGE(G8_SB(1, 0), b3, voffB); G8_STAGE(G8_SB(1, 1), b3 + hstepB, voffB); G8_STAGE(G8_SA(1, 0), a3, voffA);
            G8_WAIT_V(8); G8_WAIT_L(0); G8_BAR; G8_MMA(1, 0, At, B0); G8_MMA(1, 1, At, B1); G8_BAR; G8_SCHED;
        }
        if (wr == 0) G8_BAR;
        E(acc, cur, wr, wc, fr, fq);
        if (!has_next) break;
#pragma unroll
        for (int a = 0; a < 2; ++a)
#pragma unroll
            for (int b = 0; b < 2; ++b)
#pragma unroll
                for (int m = 0; m < 4; ++m)
#pragma unroll
                    for (int n = 0; n < 2; ++n) acc[a][b][m][n] = (f32x4){0.f, 0.f, 0.f, 0.f};
        cur = nxt; ++ui;
        if (wr == 1) G8_BAR;
    }
    G8_WAIT_V(0);
    G8_BAR;
#undef G8_SA
#undef G8_SB
#undef G8_STAGE
#undef G8_LDA
#undef G8_LDB
#undef G8_MMA
#undef G8_LD1
#undef G8_WAIT_V
#undef G8_WAIT_L
#undef G8_BAR
#undef G8_SCHED
}
struct EpiResid {
    const float* R32; bf16_t* S; float* SSQP; unsigned char* S8;
    __device__ __forceinline__ void operator()(const f32x4 (&acc)[2][2][4][2], const Unit& u, int wr, int wc, int fr, int fq) const {
#pragma unroll
        for (int ai = 0; ai < 2; ++ai)
#pragma unroll
            for (int m = 0; m < 4; ++m) {
                const int row = u.pm * 256 + ai * 128 + wr * 64 + m * 16 + fr;
                const size_t o = (size_t)row * 1024 + u.pn * 256 + wc * 32 + fq * 8;
                float ss = 0.f;
#pragma unroll
                for (int bj = 0; bj < 2; ++bj) {
                    f32x4 a, b;
                    if (R32) { a = *(const f32x4*)(R32 + o + bj * 128); b = *(const f32x4*)(R32 + o + bj * 128 + 4); }
                    else { const u32x4 r = *(const u32x4*)(S + o + bj * 128); a = (f32x4){lo2f(r[0]), hi2f(r[0]), lo2f(r[1]), hi2f(r[1])}; b = (f32x4){lo2f(r[2]), hi2f(r[2]), lo2f(r[3]), hi2f(r[3])}; }
                    a += acc[ai][bj][m][0]; b += acc[ai][bj][m][1];
                    ss += a[0] * a[0] + a[1] * a[1] + a[2] * a[2] + a[3] * a[3] + b[0] * b[0] + b[1] * b[1] + b[2] * b[2] + b[3] * b[3];
                    uint4 w; w.x = pack2(a[0], a[1]); w.y = pack2(a[2], a[3]); w.z = pack2(b[0], b[1]); w.w = pack2(b[2], b[3]);
                    *(uint4*)(S + o + bj * 128) = w;
                    { int p0 = __builtin_amdgcn_cvt_pk_fp8_f32(a[0], a[1], 0, false); p0 = __builtin_amdgcn_cvt_pk_fp8_f32(a[2], a[3], p0, true);
                      int p1 = __builtin_amdgcn_cvt_pk_fp8_f32(b[0], b[1], 0, false); p1 = __builtin_amdgcn_cvt_pk_fp8_f32(b[2], b[3], p1, true);
                      *(uint2*)(S8 + o + bj * 128) = make_uint2((unsigned)p0, (unsigned)p1); }
                }
                ss += __shfl_xor(ss, 16); ss += __shfl_xor(ss, 32);
                if (fq == 0) SSQP[(size_t)row * 32 + u.pn * 4 + wc] = ss;
            }
    }
};
struct EpiCinUS {
    bf16_t* U; const bf16_t* VT; const float* SSQ; const float* Wsp; const float* bsp; const float* vnorm; G8_LAS unsigned char* L; const float* RSTD;
    __device__ __forceinline__ void operator()(const f32x4 (&acc)[2][2][4][2], const Unit& u, int wr, int wc, int fr_, int fq_) const {
        int lz = 0; asm volatile("" : "+v"(lz));
        const int tid = (int)threadIdx.x + lz, fr = tid & 15, fq = (tid >> 4) & 3, g = u.pn; (void)fr_; (void)fq_;
        G8_LAS float* RS = (G8_LAS float*)(L + 24576);
        unsigned gu[2][2][4][4];
#pragma unroll
        for (int ai = 0; ai < 2; ++ai)
#pragma unroll
            for (int bj = 0; bj < 2; ++bj)
#pragma unroll
                for (int m = 0; m < 4; ++m) {
                    const float rs = RSTD[u.pm * 256 + ai * 128 + wr * 64 + m * 16 + fr];
                    const f32x4 a = acc[ai][bj][m][0] * rs, b = acc[ai][bj][m][1] * rs;
                    const f32x2 g0 = gelu_exact2((f32x2){a[0], a[1]}), g1 = gelu_exact2((f32x2){a[2], a[3]}), g2 = gelu_exact2((f32x2){b[0], b[1]}), g3 = gelu_exact2((f32x2){b[2], b[3]});
                    gu[ai][bj][m][0] = pack2(g0[0], g0[1]); gu[ai][bj][m][1] = pack2(g1[0], g1[1]); gu[ai][bj][m][2] = pack2(g2[0], g2[1]); gu[ai][bj][m][3] = pack2(g3[0], g3[1]);
                }
        if (tid < 256) {
            const float* sp = SSQ + (size_t)(u.pm * 256 + tid) * 32;
            f32x4 s4 = *(const f32x4*)sp;
#pragma unroll
            for (int i = 1; i < 8; ++i) s4 += *(const f32x4*)(sp + 4 * i);
            RS[tid] = rsqrtf(((s4[0] + s4[1]) + (s4[2] + s4[3])) * (1.0f / 2048.0f) + EPS);
        }
        __syncthreads();
#pragma unroll
        for (int ai = 0; ai < 2; ++ai) {
            const int chunk = u.pm * 2 + ai;
            {
                const int t1 = tid >> 3, c1 = tid & 7;
#pragma unroll
                for (int part = 0; part < 3; ++part) {
                    const int t = part == 0 ? t1 : 64 + ((tid + (part - 1) * 512) >> 4), ch = part == 0 ? c1 : ((tid + (part - 1) * 512) & 15), s0 = ch * 8;
                    const float* wp = Wsp + (size_t)(g * 128 + t) * 128 + s0;
                    const f32x4 w0 = *(const f32x4*)wp, w1 = *(const f32x4*)(wp + 4);
                    const f32x4 r0 = *(const G8_LAS f32x4*)(RS + ai * 128 + s0), r1 = *(const G8_LAS f32x4*)(RS + ai * 128 + s0 + 4);
                    float v[8];
#pragma unroll
                    for (int j = 0; j < 4; ++j) { v[j] = (s0 + j <= t) ? w0[j] * r0[j] : 0.f; v[4 + j] = (s0 + 4 + j <= t) ? w1[j] * r1[j] : 0.f; }
                    u32x4 o; o.x = pack2(v[0], v[1]); o.y = pack2(v[2], v[3]); o.z = pack2(v[4], v[5]); o.w = pack2(v[6], v[7]);
                    const int off = part == 0 ? t * 128 + ((ch ^ (t & 7)) << 4) : 8192 + (t - 64) * 256 + ((ch ^ (t & 7)) << 4);
                    *(G8_LAS u32x4*)(L + off) = o;
                }
            }
            __syncthreads();
            float bias[4];
#pragma unroll
            for (int m = 0; m < 4; ++m) bias[m] = bsp[g * 128 + wr * 64 + m * 16 + fr];
#pragma unroll
            for (int bj = 0; bj < 2; ++bj) {
                f32x4 mac[4][2];
#pragma unroll
                for (int m = 0; m < 4; ++m)
#pragma unroll
                    for (int n = 0; n < 2; ++n) mac[m][n] = (f32x4){0.f, 0.f, 0.f, 0.f};
                const int cb = u.pn * 256 + bj * 128 + wc * 32;
                const bf16_t* vrow0 = VT + ((size_t)chunk * 2048 + cb + perm32(fr)) * 128 + fq * 8;
                const bf16_t* vrow1 = VT + ((size_t)chunk * 2048 + cb + perm32(16 + fr)) * 128 + fq * 8;
                bf16x8 bf0[4], bf1[4];
#pragma unroll
                for (int kk = 0; kk < 4; ++kk) { if (kk < 2 || wr == 1) { bf0[kk] = *(const bf16x8*)(vrow0 + kk * 32); bf1[kk] = *(const bf16x8*)(vrow1 + kk * 32); } }
#pragma unroll
                for (int kk = 0; kk < 4; ++kk) {
                    if (kk < 2 || wr == 1) {
                        bf16x8 af[4];
#pragma unroll
                        for (int m = 0; m < 4; ++m) {
                            const int t = wr * 64 + m * 16 + fr, chn = kk * 4 + fq;
                            const int off = wr == 0 ? t * 128 + ((chn ^ (t & 7)) << 4) : 8192 + (t - 64) * 256 + ((chn ^ (t & 7)) << 4);
                            af[m] = *(const G8_LAS bf16x8*)(L + off);
                        }
#pragma unroll
                        for (int m = 0; m < 4; ++m) {
                            mac[m][0] = __builtin_amdgcn_mfma_f32_16x16x32_bf16(bf0[kk], af[m], mac[m][0], 0, 0, 0);
                            mac[m][1] = __builtin_amdgcn_mfma_f32_16x16x32_bf16(bf1[kk], af[m], mac[m][1], 0, 0, 0);
                        }
                    }
                }
                const f32x4 vn0 = *(const f32x4*)(vnorm + cb + fq * 8), vn1 = *(const f32x4*)(vnorm + cb + fq * 8 + 4);
#pragma unroll
                for (int m = 0; m < 4; ++m) {
                    const f32x4 x0 = vn0 * mac[m][0] + bias[m], x1 = vn1 * mac[m][1] + bias[m];
                    const unsigned q0 = gu[ai][bj][m][0], q1 = gu[ai][bj][m][1], q2 = gu[ai][bj][m][2], q3 = gu[ai][bj][m][3];
                    uint4 o; o.x = pack2(lo2f(q0) * x0[0], hi2f(q0) * x0[1]); o.y = pack2(lo2f(q1) * x0[2], hi2f(q1) * x0[3]); o.z = pack2(lo2f(q2) * x1[0], hi2f(q2) * x1[1]); o.w = pack2(lo2f(q3) * x1[2], hi2f(q3) * x1[3]);
                    *(uint4*)(U + (size_t)(u.pm * 256 + ai * 128 + wr * 64 + m * 16 + fr) * 2048 + cb + fq * 8) = o;
                }
            }
            __syncthreads();
        }
    }
};
struct EpiCinV {
    bf16_t* VT; float* SSQ; const float* RSTD;
    __device__ __forceinline__ void operator()(const f32x4 (&acc)[2][2][4][2], const Unit& u, int wr, int wc, int fr_, int fq_) const {
        int lz = 0; asm volatile("" : "+v"(lz));
        const int lane_ = (int)(threadIdx.x & 63) + lz, fr = lane_ & 15, fq = lane_ >> 4; (void)fr_; (void)fq_;
        f32x4 rs[2][2];
#pragma unroll
        for (int bj = 0; bj < 2; ++bj)
#pragma unroll
            for (int n = 0; n < 2; ++n) rs[bj][n] = *(const f32x4*)(RSTD + u.pn * 256 + bj * 128 + wc * 32 + fq * 8 + n * 4) * (1.0f / 64.0f);
#pragma unroll
        for (int ai = 0; ai < 2; ++ai) {
            float ss[16];
#pragma unroll
            for (int i = 0; i < 16; ++i) ss[i] = 0.f;
#pragma unroll
            for (int m = 0; m < 4; ++m) {
                const int c = u.pm * 256 + ai * 128 + wr * 64 + m * 16 + fr;
#pragma unroll
                for (int bj = 0; bj < 2; ++bj) {
                    float g[8];
#pragma unroll
                    for (int n = 0; n < 2; ++n)
#pragma unroll
                        for (int r = 0; r < 4; r += 2) {
                            const f32x2 x = gelu_exact2((f32x2){acc[ai][bj][m][n][r] * rs[bj][n][r], acc[ai][bj][m][n][r + 1] * rs[bj][n][r + 1]});
                            g[n * 4 + r] = x[0]; g[n * 4 + r + 1] = x[1]; ss[bj * 8 + n * 4 + r] += x[0] * x[0]; ss[bj * 8 + n * 4 + r + 1] += x[1] * x[1];
                        }
                    uint4 o; o.x = pack2(g[0], g[1]); o.y = pack2(g[2], g[3]); o.z = pack2(g[4], g[5]); o.w = pack2(g[6], g[7]);
                    *(uint4*)(VT + ((size_t)(u.pn * 2 + bj) * 2048 + c) * 128 + wc * 32 + fq * 8) = o;
                }
            }
            float mine = 0.f;
#pragma unroll
            for (int i = 0; i < 16; ++i) { const float s = row16_sum(ss[i]); mine = (fr == i) ? s : mine; }
            const int tok = u.pn * 256 + (fr >> 3) * 128 + wc * 32 + fq * 8 + (fr & 7);
            SSQ[(size_t)tok * 32 + u.pm * 4 + ai * 2 + wr] = mine;
        }
    }
};
struct EpiInN {
    bf16_t* R; const float* RSTD;
    __device__ __forceinline__ void operator()(const f32x4 (&acc)[2][2][4][2], const Unit& u, int wr, int wc, int fr, int fq) const {
        bf16_t* base; int pitch; float sc = 1.0f;
        if (u.pn < 2) { base = R + R_QSB + u.pn * 256; pitch = 512; sc = 0.125f; }
        else if (u.pn < 4) { base = R + R_KSB + (u.pn - 2) * 256; pitch = 512; }
        else if (u.pn == 4) { base = R + R_QG; pitch = 256; }
        else if (u.pn == 5) { base = R + R_KG; pitch = 256; }
        else { base = R + R_GG + (u.pn - 6) * 256; pitch = 512; }
#pragma unroll
        for (int ai = 0; ai < 2; ++ai)
#pragma unroll
            for (int m = 0; m < 4; ++m) {
                const int row = u.pm * 256 + ai * 128 + wr * 64 + m * 16 + fr;
                bf16_t* rp = base + (size_t)row * pitch + wc * 32 + fq * 8;
                const float rsc = sc * RSTD[row];
#pragma unroll
                for (int bj = 0; bj < 2; ++bj) {
                    f32x4 a = acc[ai][bj][m][0] * rsc, b = acc[ai][bj][m][1] * rsc;
                    if (u.pn >= 6) {
#pragma unroll
                        for (int r = 0; r < 4; ++r) { a[r] = a[r] * __builtin_amdgcn_rcpf(1.0f + __expf(-a[r])); b[r] = b[r] * __builtin_amdgcn_rcpf(1.0f + __expf(-b[r])); }
                    }
                    uint4 o; o.x = pack2(a[0], a[1]); o.y = pack2(a[2], a[3]); o.z = pack2(b[0], b[1]); o.w = pack2(b[2], b[3]);
                    *(uint4*)(rp + bj * 128) = o;
                }
            }
    }
};
struct EpiInT {
    bf16_t* R; const float* RSTD;
    __device__ __forceinline__ void operator()(const f32x4 (&acc)[2][2][4][2], const Unit& u, int wr, int wc, int fr, int fq) const {
#pragma unroll
        for (int ai = 0; ai < 2; ++ai)
#pragma unroll
            for (int m = 0; m < 4; ++m) {
                const int c = u.pm * 256 + ai * 128 + wr * 64 + m * 16 + fr;
#pragma unroll
                for (int bj = 0; bj < 2; ++bj) {
                    const int t = u.pn * 256 + bj * 128 + wc * 32 + fq * 8, b = t >> 11, s = t & 2047;
                    bf16_t* dst;
                    if (c < 512) dst = R + R_VTSB + ((size_t)((b * 8 + (c >> 6)) * 64 + (c & 63))) * 2048 + s;
                    else { const int c2 = c - 512; dst = R + R_VTG + ((size_t)((b * 4 + (c2 >> 7)) * 128 + (c2 & 127))) * 2048 + s; }
                    const f32x4 a = acc[ai][bj][m][0] * *(const f32x4*)(RSTD + t), bb = acc[ai][bj][m][1] * *(const f32x4*)(RSTD + t + 4);
                    uint4 o; o.x = pack2(a[0], a[1]); o.y = pack2(a[2], a[3]); o.z = pack2(bb[0], bb[1]); o.w = pack2(bb[2], bb[3]);
                    *(uint4*)dst = o;
                }
            }
    }
};
}
__device__ __forceinline__ void phase_gemm_resid8(const bf16_t* A0, const bf16_t* A1, int lda, int ksplit, const bf16_t* Bt, int K, const float* R32, bf16_t* Sres, float* SSQP, unsigned char* S8, char* smem_phys) {
    g8::Gemm g{A0, A1, lda, ksplit, Bt, T, 1024, K};
    g8::StaticOrder S; S.init(T, 1024, (int)gridDim.x, (int)blockIdx.x);
    g8::EpiResid E{R32, Sres, SSQP, S8};
    g8::gemm_phase<g8::EpiResid>((G8_LAS unsigned char*)smem_phys, g, S, E);
}

__device__ __forceinline__ void phase_gemm_cin8_v(const Params& p, char* smem_phys) {
    bf16_t* U = (bf16_t*)(p.ws + OFF_REGION); bf16_t* VT = U + (size_t)T * 2048; float* SSQ = (float*)(p.ws + OFF_SSQ);
    const bf16_t* Wv = (const bf16_t*)(p.ws + OFF_SK_W8); const bf16_t* H8 = (const bf16_t*)(p.ws + OFF_H + ((size_t)32 << 20));
    g8::Gemm g{Wv, Wv, 512, 512, H8, 2048, T, 512};
    g8::StaticOrder S; S.init(2048, T, (int)gridDim.x, (int)blockIdx.x);
    g8::EpiCinV E{VT, SSQ, (const float*)(p.ws + OFF_VSC)};
    g8::gemm_phase<g8::EpiCinV, true>((G8_LAS unsigned char*)smem_phys, g, S, E);
}
__device__ __forceinline__ void phase_gemm_cin8_u(const Params& p, char* smem_phys) {
    const bf16_t* H = (const bf16_t*)(p.ws + OFF_S); const bf16_t* W = (const bf16_t*)(p.ws + OFF_WT_CIN);
    bf16_t* U = (bf16_t*)(p.ws + OFF_REGION); bf16_t* VT = U + (size_t)T * 2048; float* SSQ = (float*)(p.ws + OFF_SSQ);
    g8::Gemm g{H, H, 1024, 1024, W, T, 2048, 1024};
    g8::StaticOrder S; S.init(T, 2048, (int)gridDim.x, (int)blockIdx.x);
    g8::EpiCinUS E{U, VT, SSQ, p.c_w_spatial, p.c_b_spatial, p.c_v_norm, (G8_LAS unsigned char*)(smem_phys + 131072), (const float*)(p.ws + OFF_VSC)};
    g8::gemm_phase<g8::EpiCinUS>((G8_LAS unsigned char*)smem_phys, g, S, E);
}
__device__ __forceinline__ void phase_gemm_in8(const Params& p, char* smem_phys) {
    const bf16_t* H = (const bf16_t*)(p.ws + OFF_S); const bf16_t* W = (const bf16_t*)(p.ws + OFF_WT_IN);
    bf16_t* R = (bf16_t*)(p.ws + OFF_REGION);
    {
        g8::Gemm g{H, H, 1024, 1024, W, T, 2048, 1024};
        g8::StaticOrder S; S.init(T, 2048, (int)gridDim.x, (int)blockIdx.x);
        g8::EpiInN E{R, (const float*)(p.ws + OFF_VSC)};
        g8::gemm_phase<g8::EpiInN>((G8_LAS unsigned char*)smem_phys, g, S, E);
    }
    {
        const bf16_t* Wv = W + (size_t)2048 * 1024;
        g8::Gemm g{Wv, Wv, 1024, 1024, H, 1024, T, 1024};
        g8::StaticOrder S; S.init(1024, T, (int)gridDim.x, (int)blockIdx.x);
        g8::EpiInT E{R, (const float*)(p.ws + OFF_VSC)};
        g8::gemm_phase<g8::EpiInT>((G8_LAS unsigned char*)smem_phys, g, S, E);
    }
    {
        const int lane = threadIdx.x & 63, wid = threadIdx.x >> 6, fr = lane & 15, fq = lane >> 4;
        float* ALR = (float*)(R + R_ALR);
        for (int task = (int)blockIdx.x * 8 + wid; task < T / 16; task += (int)gridDim.x * 8) {
            const bf16_t* a = H + (size_t)(task * 16 + fr) * 1024 + fq * 8; const bf16_t* w = W + (size_t)(3072 + fr) * 1024 + fq * 8;
            f32x4 acc = (f32x4){0.f, 0.f, 0.f, 0.f};
#pragma unroll 8
            for (int kk = 0; kk < 32; ++kk) {
                const bf16x8 af = *(const bf16x8*)(a + kk * 32), wf = *(const bf16x8*)(w + kk * 32);
                acc = __builtin_amdgcn_mfma_f32_16x16x32_bf16(wf, af, acc, 0, 0, 0);
            }
            *(f32x4*)(ALR + (size_t)(task * 16 + fr) * 16 + fq * 4) = acc * ((const float*)(p.ws + OFF_VSC))[task * 16 + fr];
        }
    }
}


typedef float f32x16 __attribute__((ext_vector_type(16)));
__device__ __forceinline__ void sb_fast(const Params& p, char* smem, unsigned* ctr) {
    bf16_t* R = (bf16_t*)(p.ws + OFF_REGION);
    char* KT = smem; char* VTt = smem + 8192;
    volatile int* flags = (volatile int*)(smem + 32768); volatile unsigned* slot = (volatile unsigned*)(smem + 32832);
    const int tid = threadIdx.x, lane = tid & 63, w = tid >> 6, r31 = lane & 31, h = lane >> 5;
    for (;;) {
        __syncthreads();
        if (tid == 0) *slot = atomicAdd(ctr, 1u);
        __syncthreads();
        const unsigned task = *slot;
        if (task >= 1024u) break;
        const int qblk = 7 - (int)(task >> 7), bh = task & 127, b = bh >> 3, hh = bh & 7;
        const int q0 = qblk * 256, qbase = q0 + 32 * w;
        bf16_t* qrow = R + R_QSB + (size_t)(b * 2048 + qbase + r31) * 512 + hh * 64;
        bf16x8 qf[4];
#pragma unroll
        for (int kk = 0; kk < 4; ++kk) qf[kk] = *(const bf16x8*)(qrow + 16 * kk + 8 * h);
        f32x16 oacc[2];
#pragma unroll
        for (int nt = 0; nt < 2; ++nt)
#pragma unroll
            for (int i = 0; i < 16; ++i) oacc[nt][i] = 0.f;
        float Rr = 1.0f;
        const int t = qbase + r31;
        for (int kt = q0 / 64 + 3; kt >= 0; --kt) {
            __syncthreads();
            { const int wd = __all(Rr == 0.f); if (lane == 0) flags[w] = wd; }
            __syncthreads();
            if (flags[0] & flags[1] & flags[2] & flags[3] & flags[4] & flags[5] & flags[6] & flags[7]) break;
            const int s_tile = kt * 64;
            {
                const int c = tid, row = c >> 3, ch = c & 7;
                const u32x4 kv = *(const u32x4*)(R + R_KSB + (size_t)(b * 2048 + s_tile + row) * 512 + hh * 64 + ch * 8);
                const u32x4 vv = *(const u32x4*)(R + R_VTSB + ((size_t)((b * 8 + hh) * 64 + row)) * 2048 + s_tile + ch * 8);
                *(u32x4*)(KT + row * 128 + ((ch ^ (row & 7)) << 4)) = kv;
                *(uint2*)(VTt + row * 136 + ch * 16) = make_uint2(vv[0], vv[1]);
                *(uint2*)(VTt + row * 136 + ch * 16 + 8) = make_uint2(vv[2], vv[3]);
            }
            __syncthreads();
#pragma unroll
            for (int sbk = 1; sbk >= 0; --sbk) {
                const int key_lo = s_tile + 32 * sbk;
                if (key_lo >= qbase + 31) continue;
                if (__all(Rr == 0.f)) continue;
                f32x16 st;
#pragma unroll
                for (int i = 0; i < 16; ++i) st[i] = 0.f;
                const int krow = 32 * sbk + r31;
#pragma unroll
                for (int kk = 0; kk < 4; ++kk) {
                    const bf16x8 kf = *(const bf16x8*)(KT + krow * 128 + (((2 * kk + h) ^ (krow & 7)) << 4));
                    st = __builtin_amdgcn_mfma_f32_32x32x16_bf16(kf, qf[kk], st, 0, 0, 0);
                }
                float a[16], G[4];
                const bool diag = key_lo + 31 >= qbase;
#pragma unroll
                for (int g = 0; g < 4; ++g) {
                    float sg[4], m[4];
#pragma unroll
                    for (int i = 0; i < 4; ++i) {
                        const float z = fmaxf(st[4 * g + i], -80.f);
                        const float ez = __builtin_amdgcn_exp2f(z * -1.4426950409f), sig = __builtin_amdgcn_rcpf(1.0f + ez);
                        sg[i] = sig; m[i] = ez * sig;
                    }
                    if (diag) {
#pragma unroll
                        for (int i = 0; i < 4; ++i) { const bool valid = key_lo + 8 * g + 4 * h + i < t; sg[i] = valid ? sg[i] : 0.f; m[i] = valid ? m[i] : 1.0f; }
                    }
                    const float x2 = m[3], x1 = x2 * m[2], x0 = x1 * m[1];
                    G[g] = x0 * m[0];
                    a[4 * g + 3] = sg[3]; a[4 * g + 2] = sg[2] * x2; a[4 * g + 1] = sg[1] * x1; a[4 * g] = sg[0] * x0;
                }
                float Go[4], P[4];
#pragma unroll
                for (int g = 0; g < 4; ++g) { Go[g] = __shfl_xor(G[g], 32); P[g] = G[g] * Go[g]; }
                const float c2 = P[3], c1 = c2 * P[2], c0 = c1 * P[1];
                float Tg[4];
                Tg[3] = Rr; Tg[2] = Rr * c2; Tg[1] = Rr * c1; Tg[0] = Rr * c0;
#pragma unroll
                for (int g = 0; g < 4; ++g) {
                    const float tg = (h == 0) ? Tg[g] * Go[g] : Tg[g];
                    a[4 * g] *= tg; a[4 * g + 1] *= tg; a[4 * g + 2] *= tg; a[4 * g + 3] *= tg;
                }
                Rr = Rr * c0 * P[0];
#pragma unroll
                for (int s2 = 0; s2 < 2; ++s2) {
                    union { bf16x8 v; unsigned u[4]; } af;
#pragma unroll
                    for (int j2 = 0; j2 < 4; ++j2) af.u[j2] = pack2(a[8 * s2 + 2 * j2], a[8 * s2 + 2 * j2 + 1]);
#pragma unroll
                    for (int nt = 0; nt < 2; ++nt) {
                        const char* vp = VTt + (32 * nt + r31) * 136 + 64 * sbk + 32 * s2 + 8 * h;
                        union { bf16x8 v; uint2 hh2[2]; } vf;
                        vf.hh2[0] = *(const uint2*)vp; vf.hh2[1] = *(const uint2*)(vp + 16);
                        oacc[nt] = __builtin_amdgcn_mfma_f32_32x32x16_bf16(af.v, vf.v, oacc[nt], 0, 0, 0);
                    }
                }
            }
        }
#pragma unroll
        for (int nt = 0; nt < 2; ++nt)
#pragma unroll
            for (int i = 0; i < 16; ++i) {
                const int qq = (i & 3) + 8 * (i >> 2) + 4 * h;
                R[R_QSB + (size_t)(b * 2048 + qbase + qq) * 512 + hh * 64 + 32 * nt + r31] = f2bf(oacc[nt][i]);
            }
    }
}
__device__ __forceinline__ float log_sigmoid(float x) { return fminf(x, 0.f) - __logf(1.0f + __expf(-fabsf(x))); }
__device__ __forceinline__ int swz(int row, int chunk) { return row * 128 + ((chunk ^ (row & 7)) << 4); }
__device__ __forceinline__ void gla_prep(const Params& p, char* smem) {
    bf16_t* R = (bf16_t*)(p.ws + OFF_REGION);
    const float* ALR = (const float*)(R + R_ALR);
    bf16_t* KOTg = R + R_KOT; float* DECg = (float*)(R + R_DEC);
    float* SEG = (float*)smem; float* ALRs = SEG + 256;
    const int tid = VTID, d = tid & 63, w = tid >> 6;
    for (int task = VBID; task < 2048; task += VGRID) {
        const int bh = task >> 5, c = task & 31, b = bh >> 2, hh = bh & 3;
        const size_t rowbase = (size_t)b * 2048 + c * 64;
        unsigned qr[16], kr[16];
#pragma unroll
        for (int i = 0; i < 16; ++i) { const size_t row = rowbase + w * 16 + i; qr[i] = R[R_QG + row * 256 + hh * 64 + d]; kr[i] = R[R_KG + row * 256 + hh * 64 + d]; }
        const f32x4 ar = *(const f32x4*)(ALR + rowbase * 16 + tid * 4);
        float w2r[16];
#pragma unroll
        for (int r = 0; r < 16; ++r) w2r[r] = p.ab_w_alpha2[r * 256 + hh * 64 + d];
        const float b2r = p.ab_b_alpha2[hh * 64 + d];
        __syncthreads();
        *(f32x4*)(ALRs + tid * 4) = ar;
        __syncthreads();
        float cs[16]; float run = 0.f;
#pragma unroll
        for (int i = 0; i < 16; ++i) {
            const float* al = ALRs + (w * 16 + i) * 16;
            float pre = b2r;
#pragma unroll
            for (int r = 0; r < 16; ++r) pre += al[r] * w2r[r];
            run += log_sigmoid(pre) * (1.0f / 16.0f);
            cs[i] = run;
        }
        SEG[w * 64 + d] = run;
        __syncthreads();
        float off = 0.f, tot = 0.f;
#pragma unroll
        for (int w2 = 0; w2 < 4; ++w2) { const float s = SEG[w2 * 64 + d]; tot += s; if (w2 < w) off += s; }
        unsigned kop[8];
#pragma unroll
        for (int i2 = 0; i2 < 8; ++i2) {
            float kov[2];
#pragma unroll
            for (int u = 0; u < 2; ++u) {
                const int i = 2 * i2 + u;
                const float bc = off + cs[i];
                const float kv = bf2f((bf16_t)kr[i]);
                const size_t row = rowbase + w * 16 + i;
                R[R_QG + row * 256 + hh * 64 + d] = f2bf(bf2f((bf16_t)qr[i]) * 0.125f * __expf(bc));
                R[R_KG + row * 256 + hh * 64 + d] = f2bf(kv * __expf(-bc));
                kov[u] = kv * __expf(tot - bc);
            }
            kop[i2] = pack2(kov[0], kov[1]);
        }
        bf16_t* kp = KOTg + ((size_t)task * 64 + d) * 64 + w * 16;
        *(uint4*)kp = make_uint4(kop[0], kop[1], kop[2], kop[3]);
        *(uint4*)(kp + 8) = make_uint4(kop[4], kop[5], kop[6], kop[7]);
        if (w == 0) DECg[(size_t)task * 64 + d] = __expf(tot);
    }
}
__device__ __forceinline__ void gla_scan(const Params& p, char* smem, bool dry = false) {
    bf16_t* R = (bf16_t*)(p.ws + OFF_REGION);
    const bf16_t* KOTg = R + R_KOT; const float* DECg = (const float*)(R + R_DEC);
    char* QS = smem; char* KS = smem + 8192; char* KOT = smem + 16384; char* VTs = smem + 24576; char* SPT = smem + 40960;
    float* DEC = (float*)(smem + 57344); float* GN = DEC + 64;
    const int tid = VTID, lane = tid & 63, w = tid >> 6, l15_ = lane & 15, q4 = lane >> 4;
    for (int task = VBID; task < 64; task += VGRID) {
        const int b = task >> 2, hh = task & 3;
        f32x4 Sacc[8];
#pragma unroll
        for (int nt = 0; nt < 8; ++nt) Sacc[nt] = (f32x4){0.f, 0.f, 0.f, 0.f};
        __syncthreads();
        for (int i = tid; i < 1024; i += 256) *(uint4*)(SPT + i * 16) = make_uint4(0, 0, 0, 0);
        if (tid < 128) GN[tid] = p.ab_gla_norm[hh * 128 + tid];
        const size_t rowbase = (size_t)b * 2048;
        const bf16_t* vbase = R + R_VTG + ((size_t)((b * 4 + hh) * 128)) * 2048;
        u32x4 tq[2], tk[2], tko[2], vr[4]; float td = 0.f;
        auto prefetch = [&](int c) {
            const int t0 = c * 64;
#pragma unroll
            for (int i = 0; i < 2; ++i) {
                const int cid = tid + 256 * i, row = cid >> 3, ch = cid & 7;
                tq[i] = *(const u32x4*)(R + R_QG + (rowbase + t0 + row) * 256 + hh * 64 + ch * 8);
                tk[i] = *(const u32x4*)(R + R_KG + (rowbase + t0 + row) * 256 + hh * 64 + ch * 8);
                tko[i] = *(const u32x4*)(KOTg + (((size_t)task * 32 + c) * 64 + row) * 64 + ch * 8);
            }
#pragma unroll
            for (int i = 0; i < 4; ++i) { const int cid = tid + 256 * i, e = cid >> 3, ch = cid & 7; vr[i] = *(const u32x4*)(vbase + (size_t)e * 2048 + t0 + ch * 8); }
            if (tid < 64) td = DECg[((size_t)task * 32 + c) * 64 + tid];
        };
        prefetch(0);
        for (int c = 0; c < 32; ++c) {
            int lz = 0; asm volatile("" : "+v"(lz));
            const int l15 = l15_ + lz;
            const int cx = (q4 ^ (l15 & 7)) << 4;
            const int rb0 = l15 * 128 + cx, rb1 = l15 * 128 + (cx ^ 64);
#pragma unroll
            for (int i = 0; i < 2; ++i) {
                const int cid = tid + 256 * i + lz, row = cid >> 3, ch = cid & 7;
                *(u32x4*)(QS + swz(row, ch)) = tq[i]; *(u32x4*)(KS + swz(row, ch)) = tk[i]; *(u32x4*)(KOT + swz(row, ch)) = tko[i];
            }
#pragma unroll
            for (int i = 0; i < 4; ++i) { const int cid = tid + 256 * i + lz, e = cid >> 3, ch = cid & 7; *(u32x4*)(VTs + swz(e, ch)) = vr[i]; }
            if (tid < 64) DEC[tid] = td;
            uint2 gr[8];
            const unsigned goff = (unsigned)((rowbase + c * 64 + 16 * w + l15) * 512 + hh * 128 + 4 * q4);
            bf16_t* const gbase = R + R_GG;
#pragma unroll
            for (int nt = 0; nt < 8; ++nt) gr[nt] = *(const uint2*)(gbase + (goff + 16 * nt));
            if (c + 1 < 32) prefetch(c + 1);
            __syncthreads();
            bf16x8 qf[2];
#pragma unroll
            for (int kk = 0; kk < 2; ++kk) qf[kk] = *(const bf16x8*)(QS + w * 2048 + (kk ? rb1 : rb0));
            f32x4 sT[4];
#pragma unroll
            for (int st = 0; st < 4; ++st) {
                sT[st] = (f32x4){0.f, 0.f, 0.f, 0.f};
                if (st <= w) {
#pragma unroll
                    for (int kk = 0; kk < 2; ++kk) { const bf16x8 kf = *(const bf16x8*)(KS + st * 2048 + (kk ? rb1 : rb0)); sT[st] = __builtin_amdgcn_mfma_f32_16x16x32_bf16(kf, qf[kk], sT[st], 0, 0, 0); }
#pragma unroll
                    for (int r = 0; r < 4; ++r) if (16 * st + 4 * q4 + r > 16 * w + l15) sT[st][r] = 0.f;
                }
            }
            bf16x8 af[2];
#pragma unroll
            for (int ks2 = 0; ks2 < 2; ++ks2) {
                union { bf16x8 v; unsigned u[4]; } cv;
                cv.u[0] = pack2(sT[2 * ks2][0], sT[2 * ks2][1]); cv.u[1] = pack2(sT[2 * ks2][2], sT[2 * ks2][3]);
                cv.u[2] = pack2(sT[2 * ks2 + 1][0], sT[2 * ks2 + 1][1]); cv.u[3] = pack2(sT[2 * ks2 + 1][2], sT[2 * ks2 + 1][3]);
                af[ks2] = cv.v;
            }
            const int vb = l15 * 128 + ((((q4 >> 1) ^ (l15 & 7)) << 4) | ((q4 & 1) * 8));
            f32x4 o[8];
#pragma unroll
            for (int nt = 0; nt < 8; ++nt) {
                o[nt] = (f32x4){0.f, 0.f, 0.f, 0.f};
                const int e = 16 * nt + l15;
#pragma unroll
                for (int kk = 0; kk < 2; ++kk) { const bf16x8 sf = *(const bf16x8*)(SPT + nt * 2048 + (kk ? rb1 : rb0)); o[nt] = __builtin_amdgcn_mfma_f32_16x16x32_bf16(sf, qf[kk], o[nt], 0, 0, 0); }
#pragma unroll
                for (int ks2 = 0; ks2 < 2; ++ks2) {
                    if (2 * ks2 <= w) {
                        union { bf16x8 v; uint2 h[2]; } cv;
                        cv.h[0] = *(const uint2*)(VTs + nt * 2048 + (vb ^ (ks2 * 64)));
                        cv.h[1] = *(const uint2*)(VTs + nt * 2048 + (vb ^ (ks2 * 64) ^ 32));
                        o[nt] = __builtin_amdgcn_mfma_f32_16x16x32_bf16(cv.v, af[ks2], o[nt], 0, 0, 0);
                    }
                }
            }
            {
                const float4 dc = *(const float4*)(DEC + 16 * w + 4 * q4);
                bf16x8 kof[2];
#pragma unroll
                for (int kk = 0; kk < 2; ++kk) kof[kk] = *(const bf16x8*)(KOT + w * 2048 + (kk ? rb1 : rb0));
#pragma unroll
                for (int nt = 0; nt < 8; ++nt) {
                    Sacc[nt][0] *= dc.x; Sacc[nt][1] *= dc.y; Sacc[nt][2] *= dc.z; Sacc[nt][3] *= dc.w;
#pragma unroll
                    for (int kk = 0; kk < 2; ++kk) { const bf16x8 vf = *(const bf16x8*)(VTs + nt * 2048 + (kk ? rb1 : rb0)); Sacc[nt] = __builtin_amdgcn_mfma_f32_16x16x32_bf16(kof[kk], vf, Sacc[nt], 0, 0, 0); }
                }
            }
            __syncthreads();
#pragma unroll
            for (int nt = 0; nt < 8; ++nt) {
                const int e = 16 * nt + l15;
                uint2 pk; pk.x = pack2(Sacc[nt][0], Sacc[nt][1]); pk.y = pack2(Sacc[nt][2], Sacc[nt][3]);
                *(uint2*)(SPT + nt * 2048 + l15 * 128 + (((2 * w + (q4 >> 1)) ^ (l15 & 7)) << 4) + (q4 & 1) * 8) = pk;
            }
            float ssq = 0.f;
#pragma unroll
            for (int nt = 0; nt < 8; ++nt) ssq += (o[nt][0] * o[nt][0] + o[nt][1] * o[nt][1]) + (o[nt][2] * o[nt][2] + o[nt][3] * o[nt][3]);
            ssq += __shfl_xor(ssq, 16); ssq += __shfl_xor(ssq, 32);
            const float rsd = rsqrtf(ssq * (1.0f / 128.0f) + EPS);
#pragma unroll
            for (int nt = 0; nt < 8; ++nt) {
                asm volatile("" ::: "memory");
                const f32x4 gn = *(const f32x4*)(GN + 16 * nt + 4 * q4);
                const float g0 = lo2f(gr[nt].x), g1 = hi2f(gr[nt].x), g2 = lo2f(gr[nt].y), g3 = hi2f(gr[nt].y);
                uint2 ov;
                ov.x = pack2(o[nt][0] * rsd * gn[0] * g0, o[nt][1] * rsd * gn[1] * g1);
                ov.y = pack2(o[nt][2] * rsd * gn[2] * g2, o[nt][3] * rsd * gn[3] * g3);
                if (!dry || ov.x == 0x7fc17fc1u) *(uint2*)(gbase + (goff + 16 * nt)) = ov;
            }
        }
    }
}

#define KEY_PAD 0xff800000u
__device__ __forceinline__ unsigned ord_key(float f) { return __float_as_uint(f); }
__device__ __forceinline__ float unord_key(unsigned k) { return __uint_as_float(k); }
__device__ __forceinline__ unsigned key_max(unsigned a, unsigned b) { unsigned r; asm("v_max_f32 %0, %1, %2" : "=v"(r) : "v"(a), "v"(b)); return r; }
__device__ __forceinline__ unsigned key_min(unsigned a, unsigned b) { unsigned r; asm("v_min_f32 %0, %1, %2" : "=v"(r) : "v"(a), "v"(b)); return r; }
__device__ __forceinline__ void ce_desc(unsigned& a, unsigned& b) { const unsigned hi = key_max(a, b), lo = key_min(a, b); a = hi; b = lo; }
__device__ __forceinline__ void bitonic_sort16_desc(unsigned (&a)[16]) {
#pragma unroll
    for (int k = 2; k <= 16; k <<= 1)
#pragma unroll
        for (int j = k >> 1; j > 0; j >>= 1)
#pragma unroll
            for (int i = 0; i < 16; ++i) { const int l = i ^ j; if (l > i) { if ((i & k) == 0) ce_desc(a[i], a[l]); else ce_desc(a[l], a[i]); } }
}
__device__ __forceinline__ void merge_top16(unsigned (&L)[16], const unsigned (&B)[16]) {
#pragma unroll
    for (int i = 0; i < 16; ++i) L[i] = key_max(L[i], B[15 - i]);
#pragma unroll
    for (int j = 8; j > 0; j >>= 1)
#pragma unroll
        for (int i = 0; i < 16; ++i) { const int l = i ^ j; if (l > i) ce_desc(L[i], L[l]); }
}
__device__ constexpr int cand_i(int n) { int c = 0; for (int i = 0; i < 16; ++i) for (int j = 0; j < 16; ++j) if ((i + 1) * (j + 1) <= 16) { if (c == n) return i; ++c; } return -1; }
__device__ constexpr int cand_j(int n) { int c = 0; for (int i = 0; i < 16; ++i) for (int j = 0; j < 16; ++j) if ((i + 1) * (j + 1) <= 16) { if (c == n) return j; ++c; } return -1; }
template <int N> struct CandTab { int i[N], j[N]; constexpr CandTab() : i(), j() { for (int n = 0; n < N; ++n) { i[n] = cand_i(n); j[n] = cand_j(n); } } };

__device__ __forceinline__ bf16x8 pack8(const float4 a, const float4 b) {
    u32x4 t; t.x = pack2(a.x, a.y); t.y = pack2(a.z, a.w); t.z = pack2(b.x, b.y); t.w = pack2(b.z, b.w);
    return __builtin_bit_cast(bf16x8, t);
}
__device__ __forceinline__ void fold_query_weights(const Params& p, int vb0 = 0) {
    int lz = 0; asm volatile("" : "+v"(lz));
    const int lane = (VTID & 63) + lz, wid = VTID >> 6, fr = lane & 15, fq = lane >> 4;
    unsigned char* Wf = p.ws + OFF_WT_Q;
    if (VBID < vb0) return;
    for (int task = VBID - vb0; task < 512; task += VGRID - vb0) {
        const int kb = task & 15, pp = (task >> 4) & 1, h = (task >> 5) & 7, layer = task >> 8;
        const float* wq = p.peer_w_q + (size_t)layer * 1024 * 2048 + (size_t)(kb * 64 + fr) * 2048 + h * 256 + pp * 128 + fq * 8;
        const float* sk = p.peer_subkeys + ((size_t)((layer * 8 + h) * 2 + pp) * 128 + wid * 32 + fr) * 128 + fq * 8;
        f32x4 acc[4][2];
#pragma unroll
        for (int kt = 0; kt < 4; ++kt)
#pragma unroll
            for (int jt = 0; jt < 2; ++jt) acc[kt][jt] = (f32x4){0.f, 0.f, 0.f, 0.f};
#pragma unroll 1
        for (int s = 0; s < 4; ++s) {
            bf16x8 a[4], b[2];
#pragma unroll
            for (int kt = 0; kt < 4; ++kt) { const float* q = wq + (size_t)(kt * 16) * 2048 + s * 32; a[kt] = pack8(*(const float4*)q, *(const float4*)(q + 4)); }
#pragma unroll
            for (int jt = 0; jt < 2; ++jt) { const float* q = sk + (size_t)(jt * 16) * 128 + s * 32; b[jt] = pack8(*(const float4*)q, *(const float4*)(q + 4)); }
#pragma unroll
            for (int kt = 0; kt < 4; ++kt)
#pragma unroll
                for (int jt = 0; jt < 2; ++jt) acc[kt][jt] = __builtin_amdgcn_mfma_f32_16x16x32_bf16(a[kt], b[jt], acc[kt][jt], 0, 0, 0);
        }
#pragma unroll
        for (int jt = 0; jt < 2; ++jt) {
            const int key = wid * 32 + jt * 16 + fr, cu = 128 * ((key >> 5) & 1) + 32 * (2 * pp + (key >> 6)) + (key & 31);
            unsigned char* row = Wf + ((size_t)layer * 2048 + h * 256 + cu) * 1024 + kb * 64 + 4 * fq;
#pragma unroll
            for (int kt = 0; kt < 4; ++kt) {
                const f32x4 wv = acc[kt][jt] * *(const f32x4*)(p.norm_ffn + layer * 1024 + kb * 64 + kt * 16 + 4 * fq) * 64.0f;
                int pk = __builtin_amdgcn_cvt_pk_fp8_f32(wv[0], wv[1], 0, false); pk = __builtin_amdgcn_cvt_pk_fp8_f32(wv[2], wv[3], pk, true);
                *(int*)(row + kt * 16) = pk;
            }
        }
    }
}
__device__ __forceinline__ void bitonic_merge16_desc(unsigned (&L)[16]) {
#pragma unroll
    for (int j = 8; j > 0; j >>= 1)
#pragma unroll
        for (int i = 0; i < 16; ++i) { const int l = i ^ j; if (l > i) ce_desc(L[i], L[l]); }
}
__device__ __forceinline__ void bitonic_sort8_desc(unsigned (&a)[8]) {
#pragma unroll
    for (int k = 2; k <= 8; k <<= 1)
#pragma unroll
        for (int j = k >> 1; j > 0; j >>= 1)
#pragma unroll
            for (int i = 0; i < 8; ++i) { const int l = i ^ j; if (l > i) { if ((i & k) == 0) ce_desc(a[i], a[l]); else ce_desc(a[l], a[i]); } }
}
__device__ __forceinline__ void sort16_desc(unsigned (&a)[16]) {
#define CE_(i, j) ce_desc(a[i], a[j])
    CE_(0,13); CE_(1,12); CE_(2,15); CE_(3,14); CE_(4,8); CE_(5,6); CE_(7,11); CE_(9,10);
    CE_(0,5); CE_(1,7); CE_(2,9); CE_(3,4); CE_(6,13); CE_(8,14); CE_(10,15); CE_(11,12);
    CE_(0,1); CE_(2,3); CE_(4,5); CE_(6,8); CE_(7,9); CE_(10,11); CE_(12,13); CE_(14,15);
    CE_(0,2); CE_(1,3); CE_(4,10); CE_(5,11); CE_(6,7); CE_(8,9); CE_(12,14); CE_(13,15);
    CE_(1,2); CE_(3,12); CE_(4,6); CE_(5,7); CE_(8,10); CE_(9,11); CE_(13,14);
    CE_(1,4); CE_(2,6); CE_(5,8); CE_(7,10); CE_(9,13); CE_(11,14);
    CE_(2,4); CE_(3,6); CE_(9,12); CE_(11,13);
    CE_(3,5); CE_(6,8); CE_(7,9); CE_(10,12);
    CE_(3,4); CE_(5,6); CE_(7,8); CE_(9,10); CE_(11,12);
    CE_(6,7); CE_(8,9);
#undef CE_
}
struct EpiSelect {
    unsigned* IDX; float* GATE; G8_LAS unsigned* X; const float* SSQP; const unsigned* SCT;
    __device__ __forceinline__ void operator()(const f32x4 (&acc)[2][2][4][2], const g8::Unit& u, int wr, int wc, int fr_, int fq_) const {
        int lz = 0; asm volatile("" : "+v"(lz));
        const int lane_ = (int)(threadIdx.x & 63) + lz, fr = lane_ & 15, fq = lane_ >> 4; (void)fr_; (void)fq_;
        const int pp = wc >> 1, half = wc & 1, wid = wr * 4 + wc;
        const unsigned kb = 127u - (unsigned)(half * 64 + fq * 8);
        unsigned Lst[4][16];
#pragma unroll
        for (int ai = 0; ai < 2; ++ai)
#pragma unroll
            for (int m = 0; m < 4; ++m) {
                unsigned C[16], Xc[16];
#pragma unroll
                for (int bj = 0; bj < 2; ++bj)
#pragma unroll
                    for (int n = 0; n < 2; ++n)
#pragma unroll
                        for (int r = 0; r < 4; ++r) C[bj * 8 + n * 4 + r] = (ord_key(acc[ai][bj][m][n][r]) & ~127u) | (kb - (unsigned)(bj * 32 + n * 4 + r));
                sort16_desc(C);
#pragma unroll
                for (int i = 0; i < 16; ++i) Xc[i] = (unsigned)__shfl_xor((int)C[i], 16);
                merge_top16(C, Xc);
#pragma unroll
                for (int i = 0; i < 16; ++i) Xc[i] = (unsigned)__shfl_xor((int)C[i], 32);
                merge_top16(C, Xc);
                if ((m >> 1) == half) {
#pragma unroll
                    for (int i = 0; i < 16; ++i) Lst[ai * 2 + (m & 1)][i] = C[i];
                } else if (fq == 0) {
                    G8_LAS unsigned* xs = X + (((ai * 2 + wr) * 2 + pp) * 4 + m) * 256 + fr;
#pragma unroll
                    for (int i = 0; i < 16; ++i) xs[(i ^ m) << 4] = C[i];
                }
            }
        __syncthreads();
#pragma unroll
        for (int ai = 0; ai < 2; ++ai)
#pragma unroll
            for (int e = 0; e < 2; ++e) {
                const int m = half * 2 + e;
                unsigned Xc[16];
                G8_LAS unsigned* xs = X + (((ai * 2 + wr) * 2 + pp) * 4 + m) * 256 + fr;
#pragma unroll
                for (int i = 0; i < 16; ++i) Xc[i] = xs[(i ^ m) << 4];
                merge_top16(Lst[ai * 2 + e], Xc);
                if (fq == 0) {
#pragma unroll
                    for (int i = 0; i < 16; ++i) xs[(i ^ m) << 4] = Lst[ai * 2 + e][i];
                }
            }
        __syncthreads();
        if (wid < 4) {
            G8_LAS unsigned* x0 = X + ((wid * 2 + 0) * 4 + fq) * 256 + fr; G8_LAS unsigned* x1 = X + ((wid * 2 + 1) * 4 + fq) * 256 + fr;
            float s0[16], s1[16];
#pragma unroll
            for (int i = 0; i < 16; ++i) { s0[i] = unord_key(x0[(i ^ fq) << 4] & ~127u); s1[i] = unord_key(x1[(i ^ fq) << 4] & ~127u); }
#define SEL_CAND(i, j) ((ord_key(s0[i] + s1[j]) & ~255u) | (unsigned)(255 - ((i) * 16 + (j))))
            unsigned C[16], B[16], M2[16], M3[8];
#pragma unroll
            for (int j = 0; j < 16; ++j) C[j] = SEL_CAND(0, j);
#pragma unroll
            for (int k = 0; k < 15; ++k) B[k] = SEL_CAND(k + 1, 0);
            B[15] = KEY_PAD;
            merge_top16(C, B);
#pragma unroll
            for (int j = 0; j < 7; ++j) M2[j] = SEL_CAND(1, j + 1);
            M2[7] = KEY_PAD; M2[8] = KEY_PAD; M2[9] = KEY_PAD;
#pragma unroll
            for (int k = 0; k < 6; ++k) M2[15 - k] = SEL_CAND(k + 2, 1);
            bitonic_merge16_desc(M2);
            M3[0] = SEL_CAND(2, 2); M3[1] = SEL_CAND(2, 3); M3[2] = SEL_CAND(2, 4); M3[3] = SEL_CAND(3, 2); M3[4] = SEL_CAND(4, 2); M3[5] = SEL_CAND(3, 3); M3[6] = KEY_PAD; M3[7] = KEY_PAD;
            bitonic_sort8_desc(M3);
#pragma unroll
            for (int i = 0; i < 8; ++i) B[i] = M3[i];
#pragma unroll
            for (int i = 8; i < 16; ++i) B[i] = KEY_PAD;
            merge_top16(M2, B);
            merge_top16(C, M2);
#undef SEL_CAND
            const int tok = u.pm * 256 + (wid >> 1) * 128 + (wid & 1) * 64 + fq * 16 + fr;
            float rstd;
            {
                const f32x4 q0 = *(const f32x4*)(SSQP + (size_t)tok * 32), q1 = *(const f32x4*)(SSQP + (size_t)tok * 32 + 4), q2 = *(const f32x4*)(SSQP + (size_t)tok * 32 + 8), q3 = *(const f32x4*)(SSQP + (size_t)tok * 32 + 12);
                const f32x4 q = (q0 + q1) + (q2 + q3);
                rstd = rsqrtf(((q[0] + q[1]) + (q[2] + q[3])) * (1.0f / D) + EPS);
            }
            const float mx = unord_key(C[0] & ~255u);
            float e[16]; float sum = 0.f;
#pragma unroll
            for (int r = 0; r < 16; ++r) { e[r] = __expf((unord_key(C[r] & ~255u) - mx) * (rstd * (1.0f / 64.0f))); sum += e[r]; }
            const float inv = 1.0f / sum;
            const size_t ob = (size_t)tok * 128 + u.pn * 16;
            unsigned iw[16];
#pragma unroll
            for (int r = 0; r < 16; ++r) {
                const unsigned code = 255u - (C[r] & 255u);
                const unsigned e0 = 127u - (x0[((code >> 4) ^ (unsigned)fq) << 4] & 127u), e1 = 127u - (x1[((code & 15u) ^ (unsigned)fq) << 4] & 127u);
                iw[r] = e0 * 128u + e1;
            }
            unsigned sc[16];
#pragma unroll
            for (int r = 0; r < 16; ++r) sc[r] = SCT[iw[r]];
#pragma unroll
            for (int r = 0; r < 16; ++r) {
                iw[r] |= sc[r] << 16;
                e[r] *= inv * (float)__builtin_bit_cast(_Float16, (unsigned short)(sc[r] >> 16));
            }
#pragma unroll
            for (int r = 0; r < 4; ++r) *(uint4*)(IDX + ob + r * 4) = make_uint4(iw[4 * r], iw[4 * r + 1], iw[4 * r + 2], iw[4 * r + 3]);
#pragma unroll
            for (int r = 0; r < 4; ++r) *(float4*)(GATE + ob + r * 4) = make_float4(e[4 * r], e[4 * r + 1], e[4 * r + 2], e[4 * r + 3]);
        }
        __syncthreads();
    }
};
__device__ __forceinline__ void phase_select8(const Params& p, int layer, char* smem_phys) {
    const bf16_t* H = (const bf16_t*)(p.ws + OFF_H); const bf16_t* Wf = (const bf16_t*)(p.ws + OFF_WT_Q + (size_t)layer * 2048 * 1024);
    g8::Gemm g{H, H, 512, 512, Wf, T, 2048, 512};
    g8::StaticOrder S; S.init(T, 2048, (int)gridDim.x, (int)blockIdx.x);
    EpiSelect E{(unsigned*)(p.ws + OFF_IDX), (float*)(p.ws + OFF_GATE), (G8_LAS unsigned*)(smem_phys + 131072), (const float*)(p.ws + OFF_SSQ), (const unsigned*)(p.ws + OFF_USC) + (size_t)layer * NEXP};
    g8::gemm_phase<EpiSelect, true>((G8_LAS unsigned char*)smem_phys, g, S, E);
    __syncthreads();
    if (threadIdx.x == 0) *(uint4*)(smem_phys + kDynLds - 16) = make_uint4(0u, 0u, 0u, 0u);
    __syncthreads();
}

__device__ __forceinline__ float ub0(unsigned w) { float f; asm("v_cvt_f32_ubyte0 %0, %1" : "=v"(f) : "v"(w)); return f; }
__device__ __forceinline__ float ub1(unsigned w) { float f; asm("v_cvt_f32_ubyte1 %0, %1" : "=v"(f) : "v"(w)); return f; }
__device__ __forceinline__ float ub2(unsigned w) { float f; asm("v_cvt_f32_ubyte2 %0, %1" : "=v"(f) : "v"(w)); return f; }
__device__ __forceinline__ float ub3(unsigned w) { float f; asm("v_cvt_f32_ubyte3 %0, %1" : "=v"(f) : "v"(w)); return f; }
typedef _Float16 f16x2 __attribute__((ext_vector_type(2)));
__device__ __forceinline__ void glds16(const void* gsrc, unsigned lds_dst) {
    unsigned keep; const unsigned d = (unsigned)__builtin_amdgcn_readfirstlane((int)lds_dst);
    asm volatile("s_mov_b32 %0, m0\n\ts_mov_b32 m0, %2\n\ts_nop 0\n\tglobal_load_lds_dwordx4 %1, off\n\ts_mov_b32 m0, %0" : "=&s"(keep) : "v"(gsrc), "s"(d) : "memory");
}
__device__ __forceinline__ void peer_gather(const Params& p, int layer, const float* __restrict__ gnext, bool final_out, char* smem) {
    const unsigned char* REC = p.ws + OFF_UT + (size_t)layer * NEXP * 1024;
    bf16_t* H = (bf16_t*)(p.ws + OFF_H);
    const unsigned* IDX = (const unsigned*)(p.ws + OFF_IDX); const float* GATE = (const float*)(p.ws + OFF_GATE);
    bf16_t* S = (bf16_t*)(p.ws + OFF_S);
    float* sGain = (float*)(smem + 139264);
    { int lz0 = 0; asm volatile("" : "+v"(lz0)); const int i = (int)threadIdx.x + lz0; if (i < 256) ((f32x4*)sGain)[i] = ((const f32x4*)(p.norm_ffn + layer * 1024))[i]; }
    __syncthreads();
    const int lane = VTID & 63, wid = VTID >> 6, sub = lane >> 4, li = lane & 15;
    char* wbase = smem + (int)(threadIdx.x >> 6) * 17408;
    unsigned* sIdx = (unsigned*)wbase; float* sGate = (float*)(wbase + 512);
    const char* ring = wbase + 1024; const unsigned ringb = (unsigned)(size_t)ring;
    const int gw = VBID * 4 + wid, nw = VGRID * 4;
    for (int t = gw; t < T; t += nw) {
        {
            int lz = 0; asm volatile("" : "+v"(lz));
            const int l2 = 2 * (lane + lz);
            const uint2 idp = *(const uint2*)(IDX + (size_t)t * 128 + l2);
            const float2 g2 = *(const float2*)(GATE + (size_t)t * 128 + l2);
            *(uint2*)(sIdx + l2) = idp; *(float2*)(sGate + l2) = g2;
        }
        int XH[2][4], XL[2][4]; float sx; float xg;
        {
            const int jq = sub >> 1, dq = (sub & 1) * 2;
            f32x4 xr[4]; float am = 0.f, ssx = 0.f;
#pragma unroll
            for (int k = 0; k < 2; ++k) {
                const int col = (16 * jq + li) * 32 + (dq + k) * 8;
                const u32x4 raw = *(const u32x4*)(S + (size_t)t * 1024 + col);
                const f32x4 g0 = *(const f32x4*)(sGain + col), g1 = *(const f32x4*)(sGain + col + 4);
                const f32x4 x0 = (f32x4){lo2f(raw[0]), hi2f(raw[0]), lo2f(raw[1]), hi2f(raw[1])}, x1 = (f32x4){lo2f(raw[2]), hi2f(raw[2]), lo2f(raw[3]), hi2f(raw[3])};
                ssx += (x0[0] * x0[0] + x0[1] * x0[1]) + (x0[2] * x0[2] + x0[3] * x0[3]) + (x1[0] * x1[0] + x1[1] * x1[1]) + (x1[2] * x1[2] + x1[3] * x1[3]);
                xr[2 * k] = x0 * g0; xr[2 * k + 1] = x1 * g1;
#pragma unroll
                for (int c = 0; c < 4; ++c) am = fmaxf(am, fmaxf(fabsf(xr[2 * k][c]), fabsf(xr[2 * k + 1][c])));
            }
            am = fmaxf(am, __shfl_xor(am, 1)); am = fmaxf(am, __shfl_xor(am, 2)); am = fmaxf(am, __shfl_xor(am, 4)); am = fmaxf(am, __shfl_xor(am, 8));
            am = fmaxf(am, __shfl_xor(am, 16)); am = fmaxf(am, __shfl_xor(am, 32));
            ssx = row16_sum(ssx); ssx += __shfl_xor(ssx, 16); ssx += __shfl_xor(ssx, 32);
            const float inv = am > 0.f ? 119.0f / am : 0.f;
            sx = am * (1.0f / 119.0f) * rsqrtf(ssx * (1.0f / D) + EPS);
            int xs = 0; int myL[2], myH[2];
#pragma unroll
            for (int k = 0; k < 2; ++k) {
                unsigned lo = 0u, hi = 0u;
#pragma unroll
                for (int i = 0; i < 8; ++i) {
                    const int q = __float2int_rn(xr[k * 2 + (i >> 2)][i & 3] * inv);
                    const int sh = (i & 3) * 8 + (i >> 2) * 4;
                    lo |= ((unsigned)q & 15u) << sh; hi |= ((unsigned)((q + 8) >> 4) & 15u) << sh;
                    xs += q;
                }
                myL[k] = (int)lo; myH[k] = (int)hi;
            }
            xs += __shfl_xor(xs, 16); xs += __shfl_xor(xs, 32);
#pragma unroll
            for (int j = 0; j < 2; ++j)
#pragma unroll
                for (int d = 0; d < 4; ++d) { const int srcl = (2 * j + (d >> 1)) * 16 + li; XL[j][d] = __shfl(myL[d & 1], srcl); XH[j][d] = __shfl(myH[d & 1], srcl); }
            xg = 0.5f * (float)xs;
        }
        f16x2 accp[2][16];
#pragma unroll
        for (int j = 0; j < 2; ++j)
#pragma unroll
            for (int c = 0; c < 16; ++c) accp[j][c] = (f16x2){(_Float16)0.f, (_Float16)0.f};
        float wsg = 0.f;
        auto issue = [&](int sg) {
            const unsigned e_ = sIdx[sg * 4 + sub] & 0xffffu;
            const unsigned char* rec = REC + (size_t)e_ * 1024 + li * 16;
            const unsigned dst = ringb + (unsigned)(sg & 3) * 4096u;
            glds16(rec, dst); glds16(rec + 256, dst + 1024u); glds16(rec + 512, dst + 2048u); glds16(rec + 768, dst + 3072u);
        };
        auto compute = [&](int sg, bool refill) {
            const char* sl = ring + (sg & 3) * 4096;
            const u32x4 du0 = *(const u32x4*)(sl + lane * 16), du1 = *(const u32x4*)(sl + 1024 + lane * 16);
            const u32x4 dv0 = *(const u32x4*)(sl + 2048 + lane * 16), dv1 = *(const u32x4*)(sl + 3072 + lane * 16);
            const float us = (float)__builtin_bit_cast(_Float16, (unsigned short)(sIdx[sg * 4 + sub] >> 16));
            const float gt = sGate[sg * 4 + sub];
            if (refill) { asm volatile("s_waitcnt lgkmcnt(0)" ::: "memory"); issue(sg + 4); }
            int iah = 0, ial = 0;
#pragma unroll
            for (int j = 0; j < 2; ++j) {
#pragma unroll
                for (int d = 0; d < 4; ++d) {
                    const int w = (int)(j ? du1[d] : du0[d]);
                    iah = __builtin_amdgcn_sdot8(w, XH[j][d], iah, false);
                    ial = __builtin_amdgcn_sdot8(w, XL[j][d], ial, false);
                }
            }
            float pa = us * ((float)(16 * iah + ial) + xg);
            pa = row16_sum(pa);
            const float ww = gt * gelu_exact(pa * sx);
            wsg += ww;
            const float wc = fminf(fmaxf(ww * 65536.0f, -65504.0f), 65504.0f);
            const _Float16 wha = (_Float16)wc, whb = (_Float16)(wc * 0.0625f);
            const f16x2 wa = {wha, wha}, wb = {whb, whb};
#pragma unroll
            for (int j = 0; j < 2; ++j) {
#pragma unroll
                for (int d = 0; d < 4; ++d) {
                    const unsigned wv = j ? dv1[d] : dv0[d], wt = wv >> 8;
                    const f16x2 c0 = __builtin_bit_cast(f16x2, wv & 0x000f000fu), c1 = __builtin_bit_cast(f16x2, wv & 0x00f000f0u);
                    const f16x2 c2 = __builtin_bit_cast(f16x2, wt & 0x000f000fu), c3 = __builtin_bit_cast(f16x2, wt & 0x00f000f0u);
                    accp[j][4 * d + 0] = __builtin_elementwise_fma(c0, wa, accp[j][4 * d + 0]); accp[j][4 * d + 1] = __builtin_elementwise_fma(c1, wb, accp[j][4 * d + 1]);
                    accp[j][4 * d + 2] = __builtin_elementwise_fma(c2, wa, accp[j][4 * d + 2]); accp[j][4 * d + 3] = __builtin_elementwise_fma(c3, wb, accp[j][4 * d + 3]);
                }
            }
        };
        asm volatile("s_waitcnt vmcnt(0)" ::: "memory");
        issue(0); issue(1); issue(2); issue(3);
#pragma unroll 1
        for (int sg = 0; sg < 28; ++sg) {
            asm volatile("s_waitcnt vmcnt(12)" ::: "memory");
            compute(sg, true);
        }
        asm volatile("s_waitcnt vmcnt(12)" ::: "memory");
        compute(28, false);
        asm volatile("s_waitcnt vmcnt(8)" ::: "memory");
        compute(29, false);
        asm volatile("s_waitcnt vmcnt(4)" ::: "memory");
        compute(30, false);
        asm volatile("s_waitcnt vmcnt(0)" ::: "memory");
        compute(31, false);
        const bool up2 = (sub & 2) != 0, up1 = (sub & 1) != 0;
        float wsum = wsg + __shfl_xor(wsg, 32);
        wsum += __shfl_xor(wsum, 16);
        f16x2 r1p[16];
#pragma unroll
        for (int c = 0; c < 16; ++c) {
            const f16x2 keep = up2 ? accp[1][c] : accp[0][c], give = up2 ? accp[0][c] : accp[1][c];
            r1p[c] = keep + __builtin_bit_cast(f16x2, __shfl_xor(__builtin_bit_cast(int, give), 32));
        }
        f16x2 r2p[8];
#pragma unroll
        for (int c = 0; c < 8; ++c) {
            const f16x2 keep = up1 ? r1p[8 + c] : r1p[c], give = up1 ? r1p[c] : r1p[8 + c];
            r2p[c] = keep + __builtin_bit_cast(f16x2, __shfl_xor(__builtin_bit_cast(int, give), 16));
        }
        float r2[16];
#pragma unroll
        for (int dl = 0; dl < 2; ++dl) {
            r2[8 * dl + 0] = 256.0f * (float)r2p[4 * dl + 0][0]; r2[8 * dl + 2] = 256.0f * (float)r2p[4 * dl + 0][1];
            r2[8 * dl + 4] = 256.0f * (float)r2p[4 * dl + 1][0]; r2[8 * dl + 6] = 256.0f * (float)r2p[4 * dl + 1][1];
            r2[8 * dl + 1] = 256.0f * (float)r2p[4 * dl + 2][0]; r2[8 * dl + 3] = 256.0f * (float)r2p[4 * dl + 2][1];
            r2[8 * dl + 5] = 256.0f * (float)r2p[4 * dl + 3][0]; r2[8 * dl + 7] = 256.0f * (float)r2p[4 * dl + 3][1];
        }
        const int col0 = (16 * (sub >> 1) + li) * 32 + (sub & 1) * 16;
        float ss = 0.f;
        bf16_t* srow = S + (size_t)t * 1024 + col0;
        {
            const u32x4 b0 = *(const u32x4*)srow, b1 = *(const u32x4*)(srow + 8);
#pragma unroll
            for (int c = 0; c < 8; ++c) {
                const unsigned wsrc = c < 4 ? b0[c] : b1[c - 4];
                r2[2 * c] = r2[2 * c] - 7.5f * wsum + lo2f(wsrc); r2[2 * c + 1] = r2[2 * c + 1] - 7.5f * wsum + hi2f(wsrc);
                ss += r2[2 * c] * r2[2 * c] + r2[2 * c + 1] * r2[2 * c + 1];
            }
        }
        ss = wave_sum(ss);
        const float rstd = rsqrtf(ss * (1.0f / D) + EPS);
        const float* gp = gnext + col0;
        if (final_out) {
            float* orow = p.out + (size_t)t * 1024 + col0;
#pragma unroll
            for (int c4 = 0; c4 < 4; ++c4) {
                const f32x4 g = *(const f32x4*)(gp + c4 * 4);
                *(f32x4*)(orow + c4 * 4) = (f32x4){r2[c4 * 4] * rstd * g[0], r2[c4 * 4 + 1] * rstd * g[1], r2[c4 * 4 + 2] * rstd * g[2], r2[c4 * 4 + 3] * rstd * g[3]};
            }
        } else {
            u32x4 sv[2];
#pragma unroll
            for (int c4 = 0; c4 < 4; ++c4) { sv[c4 >> 1][(c4 & 1) * 2] = pack2(r2[c4 * 4], r2[c4 * 4 + 1]); sv[c4 >> 1][(c4 & 1) * 2 + 1] = pack2(r2[c4 * 4 + 2], r2[c4 * 4 + 3]); }
            *(u32x4*)srow = sv[0]; *(u32x4*)(srow + 8) = sv[1];
            { u32x4 e8;
#pragma unroll
              for (int c = 0; c < 4; ++c) { int pk = __builtin_amdgcn_cvt_pk_fp8_f32(r2[4 * c], r2[4 * c + 1], 0, false); pk = __builtin_amdgcn_cvt_pk_fp8_f32(r2[4 * c + 2], r2[4 * c + 3], pk, true); e8[c] = (unsigned)pk; }
              *(u32x4*)(p.ws + OFF_H + ((size_t)32 << 20) + (size_t)t * 1024 + col0) = e8; }
            if (lane == 0) ((float*)(p.ws + OFF_VSC))[t] = rstd;
        }
    }
}


#define XB_TMO      128
#define XB_XCNT(j)  (256  + 64 * (j))
#define XB_XSUB(j)  (1280 + 64 * (j))
#define XB_XGEN(j)  (2304 + 64 * (j))
#define XB_TOP      3328
#define XB_TOPGEN   3392
#define XCD_BAR_WORDS 3456
#define XB_SPIN_CAP (1u << 22)
#define LAS __attribute__((address_space(3)))
__device__ __forceinline__ unsigned xb_ld(unsigned* p)              { return __hip_atomic_load(p, __ATOMIC_RELAXED, __HIP_MEMORY_SCOPE_AGENT); }
__device__ __forceinline__ unsigned xb_add(unsigned* p, unsigned v) { return __hip_atomic_fetch_add(p, v, __ATOMIC_RELAXED, __HIP_MEMORY_SCOPE_AGENT); }
__device__ __forceinline__ unsigned xb_xcc_id() { return (unsigned)__builtin_amdgcn_s_getreg((3 << 11) | 20) & 0xFu; }
#define XB_SPIN(cond, bar) do { unsigned _sp = 0; while (cond) { __builtin_amdgcn_s_sleep(1); \
    if ((++_sp & 255u) == 0u) { if (xb_ld(&(bar)[XB_TMO])) break; if (_sp > XB_SPIN_CAP) { atomicAdd(&(bar)[XB_TMO], 1u); break; } } } } while (0)
struct XcdBarrier { unsigned* bar; unsigned x; volatile LAS unsigned* st; };
__device__ __forceinline__ XcdBarrier xcd_barrier_post(unsigned* bar, volatile LAS unsigned* st) {
    XcdBarrier b; b.bar = bar; b.x = xb_xcc_id(); b.st = st;
    if (threadIdx.x == 0) (void)xb_add(&bar[XB_XCNT(b.x)], 1u);
    return b;
}
__device__ __forceinline__ void xcd_barrier_complete(unsigned* bar, unsigned x, unsigned& nloc, unsigned& nx) {
    const unsigned G = gridDim.x * gridDim.y * gridDim.z;
    unsigned sum, cnt, mine, sp = 0u;
    for (;;) {
        sum = 0u; cnt = 0u; mine = 0u;
#pragma unroll
        for (unsigned j = 0; j < 16; ++j) { const unsigned c = xb_ld(&bar[XB_XCNT(j)]); sum += c; cnt += (c > 0u) ? 1u : 0u; mine = (j == x) ? c : mine; }
        if (sum == G) break;
        __builtin_amdgcn_s_sleep(1);
        if ((++sp & 255u) == 0u) { if (xb_ld(&bar[XB_TMO])) break; if (sp > XB_SPIN_CAP) { atomicAdd(&bar[XB_TMO], 1u); break; } }
    }
    nloc = mine > 0u ? mine : 1u; nx = cnt > 0u ? cnt : 1u;
}
__device__ __forceinline__ void xcd_barrier(const XcdBarrier& b) {
    asm volatile("s_waitcnt vmcnt(0)" ::: "memory");
    __syncthreads();
    if (threadIdx.x == 0) {
        unsigned* bar = b.bar;
        __builtin_amdgcn_s_waitcnt(0);
        unsigned nloc = b.st[0], nx = b.st[1];
        if (nloc == 0u) { xcd_barrier_complete(bar, b.x, nloc, nx); b.st[0] = nloc; b.st[1] = nx; }
        const unsigned old = xb_add(&bar[XB_XSUB(b.x)], 1u);
        const unsigned gen = old / nloc;
        if (old + 1u == (gen + 1u) * nloc) {
            __builtin_amdgcn_fence(__ATOMIC_RELEASE, "agent");
            asm volatile("s_waitcnt vmcnt(0)" ::: "memory");
            const unsigned og = xb_add(&bar[XB_TOP], 1u);
            const unsigned tg = og / nx;
            if (og + 1u == (tg + 1u) * nx) xb_add(&bar[XB_TOPGEN], 1u);
            else XB_SPIN(xb_ld(&bar[XB_TOPGEN]) == tg, bar);
            __builtin_amdgcn_fence(__ATOMIC_ACQUIRE, "agent");
            xb_add(&bar[XB_XGEN(b.x)], 1u);
            asm volatile("s_waitcnt vmcnt(0)" ::: "memory");
        } else {
            XB_SPIN(xb_ld(&bar[XB_XGEN(b.x)]) == gen, bar);
            __builtin_amdgcn_fence(__ATOMIC_ACQUIRE, "agent");
            asm volatile("s_waitcnt vmcnt(0)" ::: "memory");
        }
    }
    __syncthreads();
}

constexpr int NPHASE = 12;
__global__ void __launch_bounds__(512, 2) mega(Params p, int ph_lo, int ph_hi) {
    extern __shared__ __attribute__((aligned(16))) char smem_phys[];
    uint4& xb_words = *(uint4*)(smem_phys + kDynLds - 16);
    if (threadIdx.x == 0) xb_words = make_uint4(0u, 0u, 0u, 0u);
    __syncthreads();
    const XcdBarrier xbar = xcd_barrier_post((unsigned*)(p.ws + OFF_BAR), (volatile LAS unsigned*)&xb_words);
    char* smem = smem_phys + (threadIdx.x >> 8) * 65536;
    bf16_t* Rg = (bf16_t*)(p.ws + OFF_REGION);
    bf16_t* Hb = (bf16_t*)(p.ws + OFF_H);
#define PHASE(k, ...) if (ph_lo <= (k) && (k) < ph_hi) { __VA_ARGS__; if ((k) + 1 < ph_hi) xcd_barrier(xbar); }
    unsigned* sbctr = (unsigned*)(p.ws + OFF_BAR + 14336);
    PHASE(0,
        transpose_convert<true>(p.ab_w_in, (bf16_t*)(p.ws + OFF_WT_IN), 1024, AB_IN, AB_IN_PAD, smem, 0, p.norm_mix);
        convert_rows(p.x, (bf16_t*)(p.ws + OFF_S), (float*)(p.ws + OFF_VSC)))
    PHASE(1, phase_gemm_in8(p, smem_phys))
    PHASE(2, gla_prep(p, smem))
    PHASE(3, gla_scan(p, smem); sb_fast(p, smem_phys + 98304, sbctr);
        quantize_tables_static(p, 64);
        transpose_convert(p.ab_w_out, (bf16_t*)(p.ws + OFF_WT_OUT), 1024, 1024, 1024, smem, 64);
        transpose_convert(p.c_w_in, (bf16_t*)(p.ws + OFF_WT_CIN), 1024, 4096, 4096, smem, 64, p.norm_mix + 1024, p.ws + OFF_SK_W8, 2048);
        transpose_convert(p.c_w_out, (bf16_t*)(p.ws + OFF_WT_COUT), 2048, 1024, 1024, smem, 64);
        fold_query_weights(p, 64))
    PHASE(4, phase_gemm_resid8(Rg + R_QSB, Rg + R_GG, 512, 512, (const bf16_t*)(p.ws + OFF_WT_OUT), 1024, nullptr, (bf16_t*)(p.ws + OFF_S), (float*)(p.ws + OFF_SSQ), p.ws + OFF_H, smem_phys))
    PHASE(5, phase_select8(p, 0, smem_phys))
    PHASE(6, peer_gather(p, 0, p.norm_mix + 1024, false, smem_phys))
    PHASE(7, phase_gemm_cin8_v(p, smem_phys))
    PHASE(8, phase_gemm_cin8_u(p, smem_phys))
    PHASE(9, phase_gemm_resid8(Rg, Rg, 2048, 2048, (const bf16_t*)(p.ws + OFF_WT_COUT), 2048, nullptr, (bf16_t*)(p.ws + OFF_S), (float*)(p.ws + OFF_SSQ), p.ws + OFF_H, smem_phys))
    PHASE(10, phase_select8(p, 1, smem_phys))
    PHASE(11, peer_gather(p, 1, p.final_norm, true, smem_phys))
}

extern "C" void kernel_launch(void* const* d_in, const int* in_sizes, int n_in, void* d_out, int out_size, void* d_ws, size_t ws_size, hipStream_t stream) {
    static int grid_blocks = 0;
    if (!grid_blocks) {
        int dev = 0, cus = 0, per_cu = 0;
        hipGetDevice(&dev);
        hipDeviceGetAttribute(&cus, hipDeviceAttributeMultiprocessorCount, dev);
        hipFuncSetAttribute((const void*)mega, hipFuncAttributeMaxDynamicSharedMemorySize, kDynLds);
        hipOccupancyMaxActiveBlocksPerMultiprocessor(&per_cu, mega, 512, kDynLds);
        if (per_cu < 1) per_cu = 1;
        if (per_cu > 1) per_cu = 1;
        grid_blocks = cus * per_cu;
        if (n_in != 18 || ws_size < WS_END) fprintf(stderr, "kernel_launch: unexpected n_in %d or ws_size %zu < %zu\n", n_in, ws_size, (size_t)WS_END);
    }
    Params p{};
    p.x = (const float*)d_in[0]; p.norm_mix = (const float*)d_in[1]; p.norm_ffn = (const float*)d_in[2]; p.ab_w_in = (const float*)d_in[3];
    p.ab_w_alpha2 = (const float*)d_in[4]; p.ab_b_alpha2 = (const float*)d_in[5]; p.ab_gla_norm = (const float*)d_in[6]; p.ab_w_out = (const float*)d_in[7];
    p.c_w_in = (const float*)d_in[8]; p.c_v_norm = (const float*)d_in[9]; p.c_w_spatial = (const float*)d_in[10]; p.c_b_spatial = (const float*)d_in[11];
    p.c_w_out = (const float*)d_in[12]; p.peer_w_q = (const float*)d_in[13]; p.peer_subkeys = (const float*)d_in[14]; p.peer_u = (const float*)d_in[15];
    p.peer_v = (const float*)d_in[16]; p.final_norm = (const float*)d_in[17];
    p.out = (float*)d_out; p.ws = (unsigned char*)d_ws;
    (void)hipMemsetAsync((char*)d_ws + OFF_BAR, 0, 16384, stream);
#if ONE_LAUNCH
    int lo = 0, hi = NPHASE;
    void* args[] = {&p, &lo, &hi};
    hipError_t e = hipLaunchCooperativeKernel((void*)mega, dim3(grid_blocks), dim3(512), args, kDynLds, stream);
    if (e != hipSuccess) fprintf(stderr, "cooperative launch failed: %s (grid %d)\n", hipGetErrorString(e), grid_blocks);
#else
    for (int ph = 0; ph < NPHASE; ++ph) hipLaunchKernelGGL(mega, dim3(grid_blocks), dim3(512), kDynLds, stream, p, ph, ph + 1);
#endif
}
```

```cpp
#include <hip/hip_runtime.h>
#include <cstdio>
#include <cstdint>

#ifndef ONE_LAUNCH
#define ONE_LAUNCH 1
#endif


#define VTID ((int)(threadIdx.x & 255))
#define VBID ((int)(blockIdx.x * 2 + (threadIdx.x >> 8)))
#define VGRID ((int)(gridDim.x * 2))
typedef unsigned short bf16_t;
typedef short bf16x8 __attribute__((ext_vector_type(8)));
typedef float f32x4 __attribute__((ext_vector_type(4)));
typedef unsigned u32x4 __attribute__((ext_vector_type(4)));
typedef __bf16 bf16x2_t __attribute__((ext_vector_type(2)));

constexpr int T = 32768, D = 1024, SEQ = 2048, NB = 16;
constexpr int AB_IN = 3088, AB_IN_PAD = 3200;
constexpr float EPS = 1e-6f;
constexpr int NEXP = 16384;
constexpr int kDynLds = 163840;

constexpr size_t SZ_WT_IN = (size_t)AB_IN_PAD * 1024 * 2;
constexpr size_t SZ_WT_OUT = (size_t)1024 * 1024 * 2;
constexpr size_t SZ_WT_CIN = (size_t)4096 * 1024 * 2;
constexpr size_t SZ_WT_COUT = (size_t)1024 * 2048 * 2;
constexpr size_t SZ_WT_Q = (size_t)2 * 2048 * 1024 * 2;
constexpr size_t SZ_SK = (size_t)2 * 8 * 2 * 128 * 128 * 2;
constexpr size_t SZ_TAB = (size_t)2 * NEXP * 1024;
constexpr size_t SZ_TSC = (size_t)2 * NEXP * 4;
constexpr size_t OFF_WT_IN = 0;
constexpr size_t OFF_WT_OUT = OFF_WT_IN + SZ_WT_IN;
constexpr size_t OFF_WT_CIN = OFF_WT_OUT + SZ_WT_OUT;
constexpr size_t OFF_WT_COUT = OFF_WT_CIN + SZ_WT_CIN;
constexpr size_t OFF_WT_Q = OFF_WT_COUT + SZ_WT_COUT;
constexpr size_t OFF_SK = OFF_WT_Q + SZ_WT_Q;
constexpr size_t OFF_UT = OFF_SK;
constexpr size_t OFF_USC = OFF_UT + SZ_TAB;
constexpr size_t OFF_VSC = OFF_USC + SZ_TSC;
constexpr size_t OFF_H = OFF_VSC + SZ_TSC;
constexpr size_t OFF_IDX = OFF_H + (size_t)T * 1024 * 2;
constexpr size_t OFF_GATE = OFF_IDX + (size_t)T * 128 * 4;
constexpr size_t OFF_SSQ = OFF_GATE + (size_t)T * 128 * 4;
constexpr size_t OFF_REGION = OFF_SSQ + (size_t)T * 32 * 4;
constexpr size_t SZ_REGION = (size_t)256 << 20;
constexpr size_t OFF_S = OFF_REGION + SZ_REGION;
constexpr size_t OFF_SK_W8 = OFF_S + (size_t)T * 1024 * 2;
constexpr size_t OFF_BAR = OFF_SK_W8 + (size_t)2048 * 1024;
constexpr size_t WS_END = OFF_BAR + 16384;
constexpr size_t R_QSB = 0;
constexpr size_t R_KSB = R_QSB + (size_t)T * 512;
constexpr size_t R_VTSB = R_KSB + (size_t)T * 512;
constexpr size_t R_QG = R_VTSB + (size_t)T * 512;
constexpr size_t R_KG = R_QG + (size_t)T * 256;
constexpr size_t R_VTG = R_KG + (size_t)T * 256;
constexpr size_t R_GG = R_VTG + (size_t)T * 512;
constexpr size_t R_ALR = R_GG + (size_t)T * 512;
constexpr size_t R_KOT = R_ALR + (size_t)T * 32;
constexpr size_t R_DEC = R_KOT + (size_t)T * 256;

struct Params {
    const float* x; const float* norm_mix; const float* norm_ffn; const float* ab_w_in; const float* ab_w_alpha2; const float* ab_b_alpha2;
    const float* ab_gla_norm; const float* ab_w_out; const float* c_w_in; const float* c_v_norm; const float* c_w_spatial; const float* c_b_spatial;
    const float* c_w_out; const float* peer_w_q; const float* peer_subkeys; const float* peer_u; const float* peer_v; const float* final_norm;
    float* out; unsigned char* ws;
};

__device__ __forceinline__ float bf2f(bf16_t v) { return __uint_as_float(((unsigned)v) << 16); }
__device__ __forceinline__ bf16_t f2bf(float f) { unsigned r; asm("v_cvt_pk_bf16_f32 %0, %1, %1" : "=v"(r) : "v"(f)); return (bf16_t)r; }
__device__ __forceinline__ unsigned pack2(float lo, float hi) { unsigned r; asm("v_cvt_pk_bf16_f32 %0, %1, %2" : "=v"(r) : "v"(lo), "v"(hi)); return r; }
__device__ __forceinline__ float lo2f(unsigned w) { return __uint_as_float(w << 16); }
__device__ __forceinline__ float hi2f(unsigned w) { return __uint_as_float(w & 0xffff0000u); }
__device__ __forceinline__ float dot2(unsigned a, unsigned b, float acc) { return __builtin_amdgcn_fdot2_f32_bf16(__builtin_bit_cast(bf16x2_t, a), __builtin_bit_cast(bf16x2_t, b), acc, false); }
#define GELU_C0 -1.0001451969146729f
#define GELU_C1 -1.1498452425003052f
#define GELU_C2 -0.46162763237953186f
#define GELU_C3 -0.051034148782491684f
#define GELU_C4 0.007168652955442667f
#define GELU_C5 -0.0006095620337873697f
#define GELU_C6 2.30170971917687e-05f
__device__ __forceinline__ float gelu_exact(float v) {
    const float a = fminf(fabsf(v), 6.0f);
    float q = GELU_C6 * a + GELU_C5; q = q * a + GELU_C4; q = q * a + GELU_C3; q = q * a + GELU_C2; q = q * a + GELU_C1; q = q * a + GELU_C0;
    return fmaxf(v, 0.f) - fabsf(v) * __builtin_amdgcn_exp2f(q);
}
typedef float f32x2 __attribute__((ext_vector_type(2)));
__device__ __forceinline__ f32x2 gelu_exact2(f32x2 v) {
    const f32x2 av = __builtin_elementwise_abs(v), a = __builtin_elementwise_min(av, (f32x2){6.0f, 6.0f});
    f32x2 q = (f32x2){GELU_C6, GELU_C6} * a + (f32x2){GELU_C5, GELU_C5};
    q = q * a + (f32x2){GELU_C4, GELU_C4}; q = q * a + (f32x2){GELU_C3, GELU_C3}; q = q * a + (f32x2){GELU_C2, GELU_C2};
    q = q * a + (f32x2){GELU_C1, GELU_C1}; q = q * a + (f32x2){GELU_C0, GELU_C0};
    const f32x2 e = {__builtin_amdgcn_exp2f(q[0]), __builtin_amdgcn_exp2f(q[1])};
    return __builtin_elementwise_max(v, (f32x2){0.f, 0.f}) - av * e;
}
__device__ __forceinline__ float row16_sum(float v) {
    v += __builtin_bit_cast(float, __builtin_amdgcn_update_dpp(0, __builtin_bit_cast(int, v), 0x128, 0xf, 0xf, false));
    v += __builtin_bit_cast(float, __builtin_amdgcn_update_dpp(0, __builtin_bit_cast(int, v), 0x124, 0xf, 0xf, false));
    v += __builtin_bit_cast(float, __builtin_amdgcn_update_dpp(0, __builtin_bit_cast(int, v), 0x122, 0xf, 0xf, false));
    v += __builtin_bit_cast(float, __builtin_amdgcn_update_dpp(0, __builtin_bit_cast(int, v), 0x121, 0xf, 0xf, false));
    return v;
}
__device__ __forceinline__ float wave_sum(float v) {
#pragma unroll
    for (int o = 32; o >= 1; o >>= 1) v += __shfl_xor(v, o);
    return v;
}

template <bool PERM_IN = false>
__device__ __forceinline__ void transpose_convert(const float* __restrict__ W, bf16_t* __restrict__ Wt, int K, int N, int Npad, char* smem, int vb0 = 0, const float* __restrict__ kgain = nullptr, unsigned char* __restrict__ W8 = nullptr, int f8from = 0) {
    float* tile = (float*)smem;
    const int tk = K / 64, tn = Npad / 64, ntile = tk * tn;
    const int tid = VTID;
    if (VBID < vb0) return;
    for (int tl = VBID - vb0; tl < ntile; tl += VGRID - vb0) {
        const int k0 = (tl % tk) * 64, n0 = (tl / tk) * 64;
        const int c = tid & 63, r0 = tid >> 6;
        int nd = n0;
        if (PERM_IN) { if (n0 >= 1024 && n0 < 1536) nd = n0 + 1024; else if (n0 >= 1536 && n0 < 2048) nd = n0 - 512; else if (n0 >= 2048 && n0 < 2560) nd = n0 + 512; else if (n0 >= 2560 && n0 < 3072) nd = n0 - 1024; }
#pragma unroll
        for (int i = 0; i < 16; ++i) {
            const int r = r0 + 4 * i;
            float v = (n0 + c < N) ? W[(size_t)(k0 + r) * N + n0 + c] : 0.f;
            if (kgain) v *= kgain[k0 + r];
            tile[c * 65 + r] = v;
        }
        __syncthreads();
#pragma unroll
        for (int i = 0; i < 16; ++i) {
            const int n = r0 + 4 * i;
            Wt[(size_t)(nd + n) * K + k0 + c] = f2bf(tile[n * 65 + c]);
            if (W8 && nd >= f8from) { const float w64 = tile[n * 65 + c] * 64.0f; W8[(size_t)(nd + n - f8from) * K + k0 + c] = (unsigned char)__builtin_amdgcn_cvt_pk_fp8_f32(w64, w64, 0, false); }
        }
        __syncthreads();
    }
}
__device__ __forceinline__ void dma16nt(const void* gsrc, unsigned lds_dst) {
    unsigned keep; const unsigned d = (unsigned)__builtin_amdgcn_readfirstlane((int)lds_dst);
    asm volatile("s_mov_b32 %0, m0\n\ts_mov_b32 m0, %2\n\ts_nop 0\n\tglobal_load_lds_dwordx4 %1, off nt\n\ts_mov_b32 m0, %0" : "=&s"(keep) : "v"(gsrc), "s"(d) : "memory");
}
__device__ __forceinline__ void quantize_tables_static(const Params& p, int vb0, char* smem) {
    const int lane = VTID & 63, wid = VTID >> 6;
    const char* ring = smem + wid * 16384; const unsigned ringb = (unsigned)(size_t)ring;
    if (VBID < vb0) return;
    for (unsigned task = (unsigned)(VBID - vb0); task < 512u; task += (unsigned)(VGRID - vb0)) {
        const bool isv = task >= 256u;
        const int r0 = (int)(task & 255u) * 128 + wid * 32;
        const float* src = isv ? p.peer_v : p.peer_u;
        unsigned char* recs = p.ws + OFF_UT;
        _Float16* sct = (_Float16*)(p.ws + OFF_USC);
        auto issue = [&](int rr) {
            const char* gp = (const char*)(src + (size_t)(r0 + rr) * 1024) + lane * 16;
            const unsigned d = ringb + (unsigned)(rr & 3) * 4096u;
            dma16nt(gp, d); dma16nt(gp + 1024, d + 1024u); dma16nt(gp + 2048, d + 2048u); dma16nt(gp + 3072, d + 3072u);
        };
        asm volatile("s_waitcnt vmcnt(0)" ::: "memory");
        issue(0); issue(1); issue(2);
        for (int rr = 0; rr < 32; ++rr) {
            const int r = r0 + rr;
            if (rr + 3 < 32) { issue(rr + 3); asm volatile("s_waitcnt vmcnt(12)" ::: "memory"); }
            else if (rr == 29) asm volatile("s_waitcnt vmcnt(8)" ::: "memory");
            else if (rr == 30) asm volatile("s_waitcnt vmcnt(4)" ::: "memory");
            else asm volatile("s_waitcnt vmcnt(0)" ::: "memory");
            f32x4 v[4]; float aml = 0.f;
            const char* sl = ring + (rr & 3) * 4096 + lane * 16;
#pragma unroll
            for (int i = 0; i < 4; ++i) {
                v[i] = *(const f32x4*)(sl + i * 1024);
                aml = fmaxf(aml, fmaxf(fmaxf(fabsf(v[i][0]), fabsf(v[i][1])), fmaxf(fabsf(v[i][2]), fabsf(v[i][3]))));
            }
            asm volatile("s_waitcnt lgkmcnt(0)" ::: "memory");
#pragma unroll
            for (int o = 32; o >= 1; o >>= 1) aml = fmaxf(aml, __shfl_xor(aml, o));
            float ssq = 0.f;
#pragma unroll
            for (int i = 0; i < 4; ++i) ssq += (v[i][0] * v[i][0] + v[i][1] * v[i][1]) + (v[i][2] * v[i][2] + v[i][3] * v[i][3]);
            ssq = wave_sum(ssq);
            const float gmax = aml * (1.002f / 7.5f);
            const _Float16 hs = (_Float16)fminf(fmaxf(0.34f * sqrtf(ssq * (1.0f / 1024.0f)), 0.5f * gmax), gmax);
            const float gs_ = (float)hs, gi_ = gs_ > 0.f ? 1.0f / gs_ : 0.f;
            const int sgn = isv ? 0 : 8;
            unsigned char* rec = recs + (size_t)r * 1024 + (isv ? 512 : 0);
#pragma unroll
            for (int i = 0; i < 4; ++i) {
                unsigned wv = 0;
#pragma unroll
                for (int j = 0; j < 4; ++j) wv |= (unsigned)(min(15, max(0, __float2int_rn(v[i][j] * gi_ + 7.5f))) ^ sgn) << (8 * j);
                wv <<= (lane & 1) * 4;
                wv |= (unsigned)__shfl_xor((int)wv, 1);
                if ((lane & 1) == 0) *(unsigned*)(rec + 128 * i + (lane >> 1) * 4) = wv;
            }
            if (lane == 0) sct[(size_t)r * 2 + (isv ? 1 : 0)] = (_Float16)gs_;
        }
    }
}
__device__ __forceinline__ void convert_rows(const float* __restrict__ X, bf16_t* __restrict__ Xb, float* __restrict__ RSTD, char* smem) {
    int lz = 0; asm volatile("" : "+v"(lz));
    const int tidl = VTID + lz, lane = tidl & 63, wid = tidl >> 6;
    const int gw = VBID * 4 + wid, nw = VGRID * 4;
    const char* ring = smem + wid * 16384; const unsigned ringb = (unsigned)(size_t)ring;
    const int nrow = (T - gw + nw - 1) / nw;
    auto issue = [&](int k) {
        const char* gp = (const char*)(X + (size_t)(gw + k * nw) * D) + lane * 16;
        const unsigned d = ringb + (unsigned)(k & 3) * 4096u;
        dma16nt(gp, d); dma16nt(gp + 1024, d + 1024u); dma16nt(gp + 2048, d + 2048u); dma16nt(gp + 3072, d + 3072u);
    };
    asm volatile("s_waitcnt vmcnt(0)" ::: "memory");
    for (int k = 0; k < 3 && k < nrow; ++k) issue(k);
    for (int k = 0; k < nrow; ++k) {
        const int t = gw + k * nw;
        if (k + 3 < nrow) { issue(k + 3); asm volatile("s_waitcnt vmcnt(12)" ::: "memory"); }
        else asm volatile("s_waitcnt vmcnt(0)" ::: "memory");
        f32x4 v[4]; float ss = 0.f;
        const char* sl = ring + (k & 3) * 4096 + lane * 16;
#pragma unroll
        for (int i = 0; i < 4; ++i) { v[i] = *(const f32x4*)(sl + i * 1024); ss += (v[i][0] * v[i][0] + v[i][1] * v[i][1]) + (v[i][2] * v[i][2] + v[i][3] * v[i][3]); }
        asm volatile("s_waitcnt lgkmcnt(0)" ::: "memory");
        ss = wave_sum(ss);
#pragma unroll
        for (int i = 0; i < 4; ++i) { uint2 o; o.x = pack2(v[i][0], v[i][1]); o.y = pack2(v[i][2], v[i][3]); *(uint2*)(Xb + (size_t)t * D + i * 256 + lane * 4) = o; }
        if (lane == 0) RSTD[t] = rsqrtf(ss * (1.0f / D) + EPS);
    }
}
__device__ __forceinline__ void rmsnorm_rows(const float* __restrict__ X, const float* __restrict__ g, bf16_t* __restrict__ Hout) {
    const int lane = VTID & 63, wid = VTID >> 6;
    const int gw = VBID * 4 + wid, nw = VGRID * 4;
    for (int t = gw; t < T; t += nw) {
        const float* xr = X + (size_t)t * D;
        float4 v[4]; float ss = 0.f;
#pragma unroll
        for (int i = 0; i < 4; ++i) { v[i] = *(const float4*)(xr + i * 256 + lane * 4); ss += v[i].x * v[i].x + v[i].y * v[i].y + v[i].z * v[i].z + v[i].w * v[i].w; }
        ss = wave_sum(ss);
        const float rstd = rsqrtf(ss * (1.0f / D) + EPS);
#pragma unroll
        for (int i = 0; i < 4; ++i) {
            const float4 gg = *(const float4*)(g + i * 256 + lane * 4);
            uint2 o; o.x = pack2(v[i].x * rstd * gg.x, v[i].y * rstd * gg.y); o.y = pack2(v[i].z * rstd * gg.z, v[i].w * rstd * gg.w);
            *(uint2*)(Hout + (size_t)t * D + i * 256 + lane * 4) = o;
        }
    }
}

__device__ __forceinline__ void store_bf16x4(bf16_t* p, f32x4 v) { uint2 o; o.x = pack2(v[0], v[1]); o.y = pack2(v[2], v[3]); *(uint2*)p = o; }

#define G8_LAS __attribute__((address_space(3)))
namespace g8 {
constexpr int BM = 256, BK = 64, HALF = 128, HTB = HALF * BK * 2, NXCD = 8, WGM = 8;
__device__ __forceinline__ int lds_byte(int r, int c) { const int st = (r >> 4) * 2 + (c >> 5), rr = r & 15, cc = c & 31, ob = rr * 64 + cc * 2; return st * 1024 + (ob ^ (((ob >> 9) & 1) << 5)); }
__device__ __forceinline__ void stage_rc(int b, int& R, int& C) { const int st = b / 1024, sb = b % 1024, swz = sb ^ (((sb >> 9) & 1) << 5); R = (st >> 1) * 16 + swz / 64; C = (st & 1) * 32 + (swz % 64) / 2; }
__device__ __forceinline__ int perm32(int rho) { const int n = rho >> 4, i = rho & 15; return 8 * (i >> 2) + 4 * n + (i & 3); }
struct Unit { int pm, pn; };
struct Gemm { const bf16_t* A0; const bf16_t* A1; int lda, ksplit; const bf16_t* Bt; int M, N, K; };
struct StaticOrder {
    int nM, nN, nwg, G, c;
    __device__ __forceinline__ void init(int M, int N, int G_, int c_) { nM = M / BM; nN = N / BM; nwg = nM * nN; G = G_; c = c_; }
    __device__ __forceinline__ bool next(int i, Unit& u) const {
        const int L = i * G + c; if (L >= nwg) return false;
        int wgid = L; { const int q = nwg / NXCD, r = nwg % NXCD, xcd = wgid % NXCD, off = wgid / NXCD; wgid = (xcd < r ? xcd * (q + 1) : r * (q + 1) + (xcd - r) * q) + off; }
        const int nig = WGM * nN, gid = wgid / nig, fm = gid * WGM, gsz = (nM - fm) < WGM ? (nM - fm) : WGM;
        u.pm = fm + ((wgid % nig) % gsz); u.pn = (wgid % nig) / gsz; return true;
    }
};
typedef int i32x4v __attribute__((ext_vector_type(4)));
typedef int i32x8v __attribute__((ext_vector_type(8)));
template <class Epi, bool F8 = false>
__device__ __forceinline__ void gemm_phase(G8_LAS unsigned char* lds, const Gemm g, const StaticOrder& S, const Epi& E) {
    const int tid = threadIdx.x, wid = __builtin_amdgcn_readfirstlane(tid >> 6), lane = tid & 63, wr = wid >> 2, wc = wid & 3, fr = lane & 15, fq = lane >> 4;
    const int K = g.K, nt = K / BK, lda = g.lda;
    unsigned voffA[2], voffB[2];
#pragma unroll
    for (int i = 0; i < 2; ++i) { int R, C; stage_rc(tid * 16 + i * 8192, R, C); const int Rb = (R & ~31) + perm32(R & 31);
        voffA[i] = (unsigned)(R * lda + C) * 2u; voffB[i] = (unsigned)(Rb * K + C) * 2u; }
    const size_t hstepA = (size_t)HALF * lda * 2, hstepB = (size_t)HALF * K * 2;
    const unsigned ldsw = (unsigned)wid * 1024u;
    const unsigned ldsbase = (unsigned)__builtin_amdgcn_readfirstlane((int)(unsigned)(__SIZE_TYPE__)lds);
    const int fcol = F8 ? 32 * (fq >> 1) + 24 * (fq & 1) : fq * 8;
    const int aoff = lds_byte(wr * 64 + fr, fcol), boff = lds_byte(wc * 32 + fr, fcol);
    const int aoff2 = F8 ? (aoff ^ 16) : aoff + 1024, boff2 = F8 ? (boff ^ 16) : boff + 1024;
    auto aptr = [&](int pm, int kt) -> const char* { const int kb = kt * BK; const bf16_t* b = kb < g.ksplit ? g.A0 + kb : g.A1 + (kb - g.ksplit); return (const char*)b + (size_t)pm * 2 * hstepA; };
    auto bptr = [&](int pn, int kt) -> const char* { return (const char*)(g.Bt + kt * BK) + (size_t)pn * 2 * hstepB; };
#define G8_SA(b, h) (((b) * 2 + (h)) * HTB)
#define G8_SB(b, h) ((4 + (b) * 2 + (h)) * HTB)
#define G8_STAGE(bufoff, gbase, voff) do { _Pragma("unroll") for (int _i = 0; _i < 2; ++_i) { \
        if constexpr (F8) { unsigned _keep; const unsigned _d = ldsbase + (unsigned)(bufoff) + ldsw + _i * 8192u; \
            const char* _gb = (const char*)(gbase) + (size_t)_i * ((voff) == voffA ? hstepA : hstepB) / 2;        \
            asm volatile("s_mov_b32 %0, m0\n\ts_mov_b32 m0, %3\n\ts_nop 0\n\tglobal_load_lds_dwordx4 %1, %2\n\ts_mov_b32 m0, %0" : "=&s"(_keep) : "v"((voff)[0]), "s"(_gb), "s"(_d) : "memory"); } \
        else __builtin_amdgcn_global_load_lds((const unsigned*)((const char*)(gbase) + (voff)[_i]), (G8_LAS unsigned*)(lds + (bufoff) + ldsw + _i * 8192), 16, 0, 0); } } while (0)
#define G8_LD1(d16, d32, addr0, addr1) do { if constexpr (F8) { const i32x4v _lo = *(const G8_LAS i32x4v*)(addr0), _hi = *(const G8_LAS i32x4v*)(addr1); \
            d32 = __builtin_shufflevector(_lo, _hi, 0, 1, 2, 3, 4, 5, 6, 7); } \
        else { d16[0] = *(const G8_LAS bf16x8*)(addr0); d16[1] = *(const G8_LAS bf16x8*)(addr1); } } while (0)
#define G8_LDA(dst, b, h) do { _Pragma("unroll") for (int m = 0; m < 4; ++m) G8_LD1(dst[m], dst##8[m], lds + G8_SA(b, h) + aoff + m * 2048, lds + G8_SA(b, h) + aoff2 + m * 2048); } while (0)
#define G8_LDB(dst, b, h) do { _Pragma("unroll") for (int n = 0; n < 2; ++n) G8_LD1(dst[n], dst##8[n], lds + G8_SB(b, h) + boff + n * 2048, lds + G8_SB(b, h) + boff2 + n * 2048); } while (0)
#define G8_MMA(ai, bj, At, Bt) do { __builtin_amdgcn_s_setprio(1); _Pragma("unroll") for (int m = 0; m < 4; ++m) _Pragma("unroll") for (int n = 0; n < 2; ++n) { \
        if constexpr (F8) acc[ai][bj][m][n] = __builtin_amdgcn_mfma_scale_f32_16x16x128_f8f6f4(Bt##8[n], At##8[m], acc[ai][bj][m][n], 0, 0, 0, sc1, 0, sc1); \
        else { _Pragma("unroll") for (int k = 0; k < 2; ++k) acc[ai][bj][m][n] = __builtin_amdgcn_mfma_f32_16x16x32_bf16(Bt[n][k], At[m][k], acc[ai][bj][m][n], 0, 0, 0); } } \
        __builtin_amdgcn_s_setprio(0); } while (0)
#define G8_WAIT_V(n) asm volatile("s_waitcnt vmcnt(" #n ")" ::: "memory")
#define G8_WAIT_L(n) asm volatile("s_waitcnt lgkmcnt(" #n ")" ::: "memory")
#define G8_BAR __builtin_amdgcn_s_barrier()
#define G8_SCHED __builtin_amdgcn_sched_barrier(0)
    Unit cur, nxt; int ui = 0;
    if (!S.next(0, cur)) return;
    int sc1 = 0x7f7f7f7f; asm volatile("" : "+v"(sc1));
    f32x4 acc[2][2][4][2];
#pragma unroll
    for (int a = 0; a < 2; ++a)
#pragma unroll
        for (int b = 0; b < 2; ++b)
#pragma unroll
            for (int m = 0; m < 4; ++m)
#pragma unroll
                for (int n = 0; n < 2; ++n) acc[a][b][m][n] = (f32x4){0.f, 0.f, 0.f, 0.f};
    bf16x8 At[4][2], B0[2][2], B1[2][2];
    i32x8v At8[4], B08[2], B18[2];
    {
        const char* cA = aptr(cur.pm, 0); const char* cB = bptr(cur.pn, 0); const char* cA1 = aptr(cur.pm, 1); const char* cB1 = bptr(cur.pn, 1);
        G8_STAGE(G8_SB(0, 0), cB, voffB); G8_STAGE(G8_SB(0, 1), cB + hstepB, voffB); G8_STAGE(G8_SA(0, 0), cA, voffA); G8_STAGE(G8_SA(0, 1), cA + hstepA, voffA);
        if (wr == 1) G8_BAR;
        G8_WAIT_V(2); G8_BAR;
        G8_STAGE(G8_SB(1, 0), cB1, voffB); G8_STAGE(G8_SA(1, 0), cA1, voffA); G8_STAGE(G8_SB(1, 1), cB1 + hstepB, voffB);
        G8_WAIT_V(6); G8_BAR;
    }
    for (;;) {
        const bool has_next = S.next(ui + 1, nxt);
        const int npm = has_next ? nxt.pm : cur.pm, npn = has_next ? nxt.pn : cur.pn;
#pragma unroll 1
        for (int t = 0; t < nt; t += 2) {
            const bool last = (t == nt - 2);
            const char* a1 = aptr(cur.pm, t + 1);
            const char* a2 = last ? aptr(npm, 0) : aptr(cur.pm, t + 2); const char* b2 = last ? bptr(npn, 0) : bptr(cur.pn, t + 2);
            const char* a3 = last ? aptr(npm, 1) : aptr(cur.pm, t + 3); const char* b3 = last ? bptr(npn, 1) : bptr(cur.pn, t + 3);
            G8_LDB(B0, 0, 0); G8_LDB(B1, 0, 1); G8_SCHED; G8_LDA(At, 0, 0); G8_STAGE(G8_SA(1, 1), a1 + hstepA, voffA);
            G8_WAIT_V(8); G8_WAIT_L(0); G8_BAR; G8_MMA(0, 0, At, B0); G8_MMA(0, 1, At, B1); G8_BAR; G8_SCHED;
            G8_LDA(At, 0, 1); G8_STAGE(G8_SB(0, 0), b2, voffB); G8_STAGE(G8_SB(0, 1), b2 + hstepB, voffB); G8_STAGE(G8_SA(0, 0), a2, voffA);
            G8_WAIT_V(8); G8_WAIT_L(0); G8_BAR; G8_MMA(1, 0, At, B0); G8_MMA(1, 1, At, B1); G8_BAR; G8_SCHED;
            G8_LDB(B0, 1, 0); G8_LDB(B1, 1, 1); G8_SCHED; G8_LDA(At, 1, 0); G8_STAGE(G8_SA(0, 1), a2 + hstepA, voffA);
            G8_WAIT_V(8); G8_WAIT_L(0); G8_BAR; G8_MMA(0, 0, At, B0); G8_MMA(0, 1, At, B1); G8_BAR; G8_SCHED;
            G8_LDA(At, 1, 1); G8_STAGE(G8_SB(1, 0), b3, voffB); G8_STAGE(G8_SB(1, 1), b3 + hstepB, voffB); G8_STAGE(G8_SA(1, 0), a3, voffA);
            G8_WAIT_V(8); G8_WAIT_L(0); G8_BAR; G8_MMA(1, 0, At, B0); G8_MMA(1, 1, At, B1); G8_BAR; G8_SCHED;
        }
        if (wr == 0) G8_BAR;
        E(acc, cur, wr, wc, fr, fq);
        if (!has_next) break;
#pragma unroll
        for (int a = 0; a < 2; ++a)
#pragma unroll
            for (int b = 0; b < 2; ++b)
#pragma unroll
                for (int m = 0; m < 4; ++m)
#pragma unroll
                    for (int n = 0; n < 2; ++n) acc[a][b][m][n] = (f32x4){0.f, 0.f, 0.f, 0.f};
        cur = nxt; ++ui;
        if (wr == 1) G8_BAR;
    }
    G8_WAIT_V(0);
    G8_BAR;
#undef G8_SA
#undef G8_SB
#undef G8_STAGE
#undef G8_LDA
#undef G8_LDB
#undef G8_MMA
#undef G8_LD1
#undef G8_WAIT_V
#undef G8_WAIT_L
#undef G8_BAR
#undef G8_SCHED
}
struct EpiResid {
    const float* R32; bf16_t* S; float* SSQP; unsigned char* S8;
    __device__ __forceinline__ void operator()(const f32x4 (&acc)[2][2][4][2], const Unit& u, int wr, int wc, int fr, int fq) const {
#pragma unroll
        for (int ai = 0; ai < 2; ++ai)
#pragma unroll
            for (int m = 0; m < 4; ++m) {
                const int row = u.pm * 256 + ai * 128 + wr * 64 + m * 16 + fr;
                const size_t o = (size_t)row * 1024 + u.pn * 256 + wc * 32 + fq * 8;
                float ss = 0.f;
#pragma unroll
                for (int bj = 0; bj < 2; ++bj) {
                    f32x4 a, b;
                    if (R32) { a = *(const f32x4*)(R32 + o + bj * 128); b = *(const f32x4*)(R32 + o + bj * 128 + 4); }
                    else { const u32x4 r = *(const u32x4*)(S + o + bj * 128); a = (f32x4){lo2f(r[0]), hi2f(r[0]), lo2f(r[1]), hi2f(r[1])}; b = (f32x4){lo2f(r[2]), hi2f(r[2]), lo2f(r[3]), hi2f(r[3])}; }
                    a += acc[ai][bj][m][0]; b += acc[ai][bj][m][1];
                    ss += a[0] * a[0] + a[1] * a[1] + a[2] * a[2] + a[3] * a[3] + b[0] * b[0] + b[1] * b[1] + b[2] * b[2] + b[3] * b[3];
                    uint4 w; w.x = pack2(a[0], a[1]); w.y = pack2(a[2], a[3]); w.z = pack2(b[0], b[1]); w.w = pack2(b[2], b[3]);
                    *(uint4*)(S + o + bj * 128) = w;
                    { int p0 = __builtin_amdgcn_cvt_pk_fp8_f32(a[0], a[1], 0, false); p0 = __builtin_amdgcn_cvt_pk_fp8_f32(a[2], a[3], p0, true);
                      int p1 = __builtin_amdgcn_cvt_pk_fp8_f32(b[0], b[1], 0, false); p1 = __builtin_amdgcn_cvt_pk_fp8_f32(b[2], b[3], p1, true);
                      *(uint2*)(S8 + o + bj * 128) = make_uint2((unsigned)p0, (unsigned)p1); }
                }
                ss += __shfl_xor(ss, 16); ss += __shfl_xor(ss, 32);
                if (fq == 0) SSQP[(size_t)row * 32 + u.pn * 4 + wc] = ss;
            }
    }
};
struct EpiCinUS {
    bf16_t* U; const bf16_t* VT; const float* SSQ; const float* Wsp; const float* bsp; const float* vnorm; G8_LAS unsigned char* L; const float* RSTD;
    __device__ __forceinline__ void operator()(const f32x4 (&acc)[2][2][4][2], const Unit& u, int wr, int wc, int fr_, int fq_) const {
        int lz = 0; asm volatile("" : "+v"(lz));
        const int tid = (int)threadIdx.x + lz, fr = tid & 15, fq = (tid >> 4) & 3, g = u.pn; (void)fr_; (void)fq_;
        G8_LAS float* RS = (G8_LAS float*)(L + 24576);
        unsigned gu[2][2][4][4];
#pragma unroll
        for (int ai = 0; ai < 2; ++ai)
#pragma unroll
            for (int bj = 0; bj < 2; ++bj)
#pragma unroll
                for (int m = 0; m < 4; ++m) {
                    const float rs = RSTD[u.pm * 256 + ai * 128 + wr * 64 + m * 16 + fr];
                    const f32x4 a = acc[ai][bj][m][0] * rs, b = acc[ai][bj][m][1] * rs;
                    const f32x2 g0 = gelu_exact2((f32x2){a[0], a[1]}), g1 = gelu_exact2((f32x2){a[2], a[3]}), g2 = gelu_exact2((f32x2){b[0], b[1]}), g3 = gelu_exact2((f32x2){b[2], b[3]});
                    gu[ai][bj][m][0] = pack2(g0[0], g0[1]); gu[ai][bj][m][1] = pack2(g1[0], g1[1]); gu[ai][bj][m][2] = pack2(g2[0], g2[1]); gu[ai][bj][m][3] = pack2(g3[0], g3[1]);
                }
        if (tid < 256) {
            const float* sp = SSQ + (size_t)(u.pm * 256 + tid) * 32;
            f32x4 s4 = *(const f32x4*)sp;
#pragma unroll
            for (int i = 1; i < 8; ++i) s4 += *(const f32x4*)(sp + 4 * i);
            RS[tid] = rsqrtf(((s4[0] + s4[1]) + (s4[2] + s4[3])) * (1.0f / 2048.0f) + EPS);
        }
        __syncthreads();
#pragma unroll
        for (int ai = 0; ai < 2; ++ai) {
            const int chunk = u.pm * 2 + ai;
            {
                const int t1 = tid >> 3, c1 = tid & 7;
#pragma unroll
                for (int part = 0; part < 3; ++part) {
                    const int t = part == 0 ? t1 : 64 + ((tid + (part - 1) * 512) >> 4), ch = part == 0 ? c1 : ((tid + (part - 1) * 512) & 15), s0 = ch * 8;
                    const float* wp = Wsp + (size_t)(g * 128 + t) * 128 + s0;
                    const f32x4 w0 = *(const f32x4*)wp, w1 = *(const f32x4*)(wp + 4);
                    const f32x4 r0 = *(const G8_LAS f32x4*)(RS + ai * 128 + s0), r1 = *(const G8_LAS f32x4*)(RS + ai * 128 + s0 + 4);
                    float v[8];
#pragma unroll
                    for (int j = 0; j < 4; ++j) { v[j] = (s0 + j <= t) ? w0[j] * r0[j] : 0.f; v[4 + j] = (s0 + 4 + j <= t) ? w1[j] * r1[j] : 0.f; }
                    u32x4 o; o.x = pack2(v[0], v[1]); o.y = pack2(v[2], v[3]); o.z = pack2(v[4], v[5]); o.w = pack2(v[6], v[7]);
                    const int off = part == 0 ? t * 128 + ((ch ^ (t & 7)) << 4) : 8192 + (t - 64) * 256 + ((ch ^ (t & 7)) << 4);
                    *(G8_LAS u32x4*)(L + off) = o;
                }
            }
            __syncthreads();
            float bias[4];
#pragma unroll
            for (int m = 0; m < 4; ++m) bias[m] = bsp[g * 128 + wr * 64 + m * 16 + fr];
#pragma unroll
            for (int bj = 0; bj < 2; ++bj) {
                f32x4 mac[4][2];
#pragma unroll
                for (int m = 0; m < 4; ++m)
#pragma unroll
                    for (int n = 0; n < 2; ++n) mac[m][n] = (f32x4){0.f, 0.f, 0.f, 0.f};
                const int cb = u.pn * 256 + bj * 128 + wc * 32;
                const bf16_t* vrow0 = VT + ((size_t)chunk * 2048 + cb + perm32(fr)) * 128 + fq * 8;
                const bf16_t* vrow1 = VT + ((size_t)chunk * 2048 + cb + perm32(16 + fr)) * 128 + fq * 8;
                bf16x8 bf0[4], bf1[4];
#pragma unroll
                for (int kk = 0; kk < 4; ++kk) { if (kk < 2 || wr == 1) { bf0[kk] = *(const bf16x8*)(vrow0 + kk * 32); bf1[kk] = *(const bf16x8*)(vrow1 + kk * 32); } }
#pragma unroll
                for (int kk = 0; kk < 4; ++kk) {
                    if (kk < 2 || wr == 1) {
                        bf16x8 af[4];
#pragma unroll
                        for (int m = 0; m < 4; ++m) {
                            const int t = wr * 64 + m * 16 + fr, chn = kk * 4 + fq;
                            const int off = wr == 0 ? t * 128 + ((chn ^ (t & 7)) << 4) : 8192 + (t - 64) * 256 + ((chn ^ (t & 7)) << 4);
                            af[m] = *(const G8_LAS bf16x8*)(L + off);
                        }
#pragma unroll
                        for (int m = 0; m < 4; ++m) {
                            mac[m][0] = __builtin_amdgcn_mfma_f32_16x16x32_bf16(bf0[kk], af[m], mac[m][0], 0, 0, 0);
                            mac[m][1] = __builtin_amdgcn_mfma_f32_16x16x32_bf16(bf1[kk], af[m], mac[m][1], 0, 0, 0);
                        }
                    }
                }
                const f32x4 vn0 = *(const f32x4*)(vnorm + cb + fq * 8), vn1 = *(const f32x4*)(vnorm + cb + fq * 8 + 4);
#pragma unroll
                for (int m = 0; m < 4; ++m) {
                    const f32x4 x0 = vn0 * mac[m][0] + bias[m], x1 = vn1 * mac[m][1] + bias[m];
                    const unsigned q0 = gu[ai][bj][m][0], q1 = gu[ai][bj][m][1], q2 = gu[ai][bj][m][2], q3 = gu[ai][bj][m][3];
                    uint4 o; o.x = pack2(lo2f(q0) * x0[0], hi2f(q0) * x0[1]); o.y = pack2(lo2f(q1) * x0[2], hi2f(q1) * x0[3]); o.z = pack2(lo2f(q2) * x1[0], hi2f(q2) * x1[1]); o.w = pack2(lo2f(q3) * x1[2], hi2f(q3) * x1[3]);
                    *(uint4*)(U + (size_t)(u.pm * 256 + ai * 128 + wr * 64 + m * 16 + fr) * 2048 + cb + fq * 8) = o;
                }
            }
            __syncthreads();
        }
    }
};
struct EpiCinV {
    bf16_t* VT; float* SSQ; const float* RSTD;
    __device__ __forceinline__ void operator()(const f32x4 (&acc)[2][2][4][2], const Unit& u, int wr, int wc, int fr_, int fq_) const {
        int lz = 0; asm volatile("" : "+v"(lz));
        const int lane_ = (int)(threadIdx.x & 63) + lz, fr = lane_ & 15, fq = lane_ >> 4; (void)fr_; (void)fq_;
        f32x4 rs[2][2];
#pragma unroll
        for (int bj = 0; bj < 2; ++bj)
#pragma unroll
            for (int n = 0; n < 2; ++n) rs[bj][n] = *(const f32x4*)(RSTD + u.pn * 256 + bj * 128 + wc * 32 + fq * 8 + n * 4) * (1.0f / 64.0f);
#pragma unroll
        for (int ai = 0; ai < 2; ++ai) {
            float ss[16];
#pragma unroll
            for (int i = 0; i < 16; ++i) ss[i] = 0.f;
#pragma unroll
            for (int m = 0; m < 4; ++m) {
                const int c = u.pm * 256 + ai * 128 + wr * 64 + m * 16 + fr;
#pragma unroll
                for (int bj = 0; bj < 2; ++bj) {
                    float g[8];
#pragma unroll
                    for (int n = 0; n < 2; ++n)
#pragma unroll
                        for (int r = 0; r < 4; r += 2) {
                            const f32x2 x = gelu_exact2((f32x2){acc[ai][bj][m][n][r] * rs[bj][n][r], acc[ai][bj][m][n][r + 1] * rs[bj][n][r + 1]});
                            g[n * 4 + r] = x[0]; g[n * 4 + r + 1] = x[1]; ss[bj * 8 + n * 4 + r] += x[0] * x[0]; ss[bj * 8 + n * 4 + r + 1] += x[1] * x[1];
                        }
                    uint4 o; o.x = pack2(g[0], g[1]); o.y = pack2(g[2], g[3]); o.z = pack2(g[4], g[5]); o.w = pack2(g[6], g[7]);
                    *(uint4*)(VT + ((size_t)(u.pn * 2 + bj) * 2048 + c) * 128 + wc * 32 + fq * 8) = o;
                }
            }
            float mine = 0.f;
#pragma unroll
            for (int i = 0; i < 16; ++i) { const float s = row16_sum(ss[i]); mine = (fr == i) ? s : mine; }
            const int tok = u.pn * 256 + (fr >> 3) * 128 + wc * 32 + fq * 8 + (fr & 7);
            SSQ[(size_t)tok * 32 + u.pm * 4 + ai * 2 + wr] = mine;
        }
    }
};
struct EpiInN {
    bf16_t* R; const float* RSTD;
    __device__ __forceinline__ void operator()(const f32x4 (&acc)[2][2][4][2], const Unit& u, int wr, int wc, int fr, int fq) const {
        bf16_t* base; int pitch; float sc = 1.0f;
        if (u.pn < 2) { base = R + R_QSB + u.pn * 256; pitch = 512; sc = 0.125f; }
        else if (u.pn < 4) { base = R + R_KSB + (u.pn - 2) * 256; pitch = 512; }
        else if (u.pn == 4) { base = R + R_QG; pitch = 256; }
        else if (u.pn == 5) { base = R + R_KG; pitch = 256; }
        else { base = R + R_GG + (u.pn - 6) * 256; pitch = 512; }
#pragma unroll
        for (int ai = 0; ai < 2; ++ai)
#pragma unroll
            for (int m = 0; m < 4; ++m) {
                const int row = u.pm * 256 + ai * 128 + wr * 64 + m * 16 + fr;
                bf16_t* rp = base + (size_t)row * pitch + wc * 32 + fq * 8;
                const float rsc = sc * RSTD[row];
#pragma unroll
                for (int bj = 0; bj < 2; ++bj) {
                    f32x4 a = acc[ai][bj][m][0] * rsc, b = acc[ai][bj][m][1] * rsc;
                    if (u.pn >= 6) {
#pragma unroll
                        for (int r = 0; r < 4; ++r) { a[r] = a[r] * __builtin_amdgcn_rcpf(1.0f + __expf(-a[r])); b[r] = b[r] * __builtin_amdgcn_rcpf(1.0f + __expf(-b[r])); }
                    }
                    uint4 o; o.x = pack2(a[0], a[1]); o.y = pack2(a[2], a[3]); o.z = pack2(b[0], b[1]); o.w = pack2(b[2], b[3]);
                    *(uint4*)(rp + bj * 128) = o;
                }
            }
    }
};
struct EpiInT {
    bf16_t* R; const float* RSTD;
    __device__ __forceinline__ void operator()(const f32x4 (&acc)[2][2][4][2], const Unit& u, int wr, int wc, int fr, int fq) const {
#pragma unroll
        for (int ai = 0; ai < 2; ++ai)
#pragma unroll
            for (int m = 0; m < 4; ++m) {
                const int c = u.pm * 256 + ai * 128 + wr * 64 + m * 16 + fr;
#pragma unroll
                for (int bj = 0; bj < 2; ++bj) {
                    const int t = u.pn * 256 + bj * 128 + wc * 32 + fq * 8, b = t >> 11, s = t & 2047;
                    bf16_t* dst;
                    if (c < 512) dst = R + R_VTSB + ((size_t)((b * 8 + (c >> 6)) * 64 + (c & 63))) * 2048 + s;
                    else { const int c2 = c - 512; dst = R + R_VTG + ((size_t)((b * 4 + (c2 >> 7)) * 128 + (c2 & 127))) * 2048 + s; }
                    const f32x4 a = acc[ai][bj][m][0] * *(const f32x4*)(RSTD + t), bb = acc[ai][bj][m][1] * *(const f32x4*)(RSTD + t + 4);
                    uint4 o; o.x = pack2(a[0], a[1]); o.y = pack2(a[2], a[3]); o.z = pack2(bb[0], bb[1]); o.w = pack2(bb[2], bb[3]);
                    *(uint4*)dst = o;
                }
            }
    }
};
}
__device__ __forceinline__ void phase_gemm_resid8(const bf16_t* A0, const bf16_t* A1, int lda, int ksplit, const bf16_t* Bt, int K, const float* R32, bf16_t* Sres, float* SSQP, unsigned char* S8, char* smem_phys) {
    g8::Gemm g{A0, A1, lda, ksplit, Bt, T, 1024, K};
    g8::StaticOrder S; S.init(T, 1024, (int)gridDim.x, (int)blockIdx.x);
    g8::EpiResid E{R32, Sres, SSQP, S8};
    g8::gemm_phase<g8::EpiResid>((G8_LAS unsigned char*)smem_phys, g, S, E);
}

__device__ __forceinline__ void phase_gemm_cin8_v(const Params& p, char* smem_phys) {
    bf16_t* U = (bf16_t*)(p.ws + OFF_REGION); bf16_t* VT = U + (size_t)T * 2048; float* SSQ = (float*)(p.ws + OFF_SSQ);
    const bf16_t* Wv = (const bf16_t*)(p.ws + OFF_SK_W8); const bf16_t* H8 = (const bf16_t*)(p.ws + OFF_H + ((size_t)32 << 20));
    g8::Gemm g{Wv, Wv, 512, 512, H8, 2048, T, 512};
    g8::StaticOrder S; S.init(2048, T, (int)gridDim.x, (int)blockIdx.x);
    g8::EpiCinV E{VT, SSQ, (const float*)(p.ws + OFF_VSC)};
    g8::gemm_phase<g8::EpiCinV, true>((G8_LAS unsigned char*)smem_phys, g, S, E);
}
__device__ __forceinline__ void phase_gemm_cin8_u(const Params& p, char* smem_phys) {
    const bf16_t* H = (const bf16_t*)(p.ws + OFF_S); const bf16_t* W = (const bf16_t*)(p.ws + OFF_WT_CIN);
    bf16_t* U = (bf16_t*)(p.ws + OFF_REGION); bf16_t* VT = U + (size_t)T * 2048; float* SSQ = (float*)(p.ws + OFF_SSQ);
    g8::Gemm g{H, H, 1024, 1024, W, T, 2048, 1024};
    g8::StaticOrder S; S.init(T, 2048, (int)gridDim.x, (int)blockIdx.x);
    g8::EpiCinUS E{U, VT, SSQ, p.c_w_spatial, p.c_b_spatial, p.c_v_norm, (G8_LAS unsigned char*)(smem_phys + 131072), (const float*)(p.ws + OFF_VSC)};
    g8::gemm_phase<g8::EpiCinUS>((G8_LAS unsigned char*)smem_phys, g, S, E);
}
__device__ __forceinline__ void phase_gemm_in8(const Params& p, char* smem_phys) {
    const bf16_t* H = (const bf16_t*)(p.ws + OFF_S); const bf16_t* W = (const bf16_t*)(p.ws + OFF_WT_IN);
    bf16_t* R = (bf16_t*)(p.ws + OFF_REGION);
    {
        g8::Gemm g{H, H, 1024, 1024, W, T, 2048, 1024};
        g8::StaticOrder S; S.init(T, 2048, (int)gridDim.x, (int)blockIdx.x);
        g8::EpiInN E{R, (const float*)(p.ws + OFF_VSC)};
        g8::gemm_phase<g8::EpiInN>((G8_LAS unsigned char*)smem_phys, g, S, E);
    }
    {
        const bf16_t* Wv = W + (size_t)2048 * 1024;
        g8::Gemm g{Wv, Wv, 1024, 1024, H, 1024, T, 1024};
        g8::StaticOrder S; S.init(1024, T, (int)gridDim.x, (int)blockIdx.x);
        g8::EpiInT E{R, (const float*)(p.ws + OFF_VSC)};
        g8::gemm_phase<g8::EpiInT>((G8_LAS unsigned char*)smem_phys, g, S, E);
    }
    {
        const int lane = threadIdx.x & 63, wid = threadIdx.x >> 6, fr = lane & 15, fq = lane >> 4;
        float* ALR = (float*)(R + R_ALR);
        for (int task = (int)blockIdx.x * 8 + wid; task < T / 16; task += (int)gridDim.x * 8) {
            const bf16_t* a = H + (size_t)(task * 16 + fr) * 1024 + fq * 8; const bf16_t* w = W + (size_t)(3072 + fr) * 1024 + fq * 8;
            f32x4 acc = (f32x4){0.f, 0.f, 0.f, 0.f};
#pragma unroll 8
            for (int kk = 0; kk < 32; ++kk) {
                const bf16x8 af = *(const bf16x8*)(a + kk * 32), wf = *(const bf16x8*)(w + kk * 32);
                acc = __builtin_amdgcn_mfma_f32_16x16x32_bf16(wf, af, acc, 0, 0, 0);
            }
            *(f32x4*)(ALR + (size_t)(task * 16 + fr) * 16 + fq * 4) = acc * ((const float*)(p.ws + OFF_VSC))[task * 16 + fr];
        }
    }
}


typedef float f32x16 __attribute__((ext_vector_type(16)));
__device__ __forceinline__ void sb_fast(const Params& p, char* smem, unsigned* ctr) {
    bf16_t* R = (bf16_t*)(p.ws + OFF_REGION);
    char* KT = smem; char* VTt = smem + 8192;
    volatile int* flags = (volatile int*)(smem + 32768); volatile unsigned* slot = (volatile unsigned*)(smem + 32832);
    const int tid = threadIdx.x, lane = tid & 63, w = tid >> 6, r31 = lane & 31, h = lane >> 5;
    for (;;) {
        __syncthreads();
        if (tid == 0) *slot = atomicAdd(ctr, 1u);
        __syncthreads();
        const unsigned task = *slot;
        if (task >= 1024u) break;
        const int qblk = 7 - (int)(task >> 7), bh = task & 127, b = bh >> 3, hh = bh & 7;
        const int q0 = qblk * 256, qbase = q0 + 32 * w;
        bf16_t* qrow = R + R_QSB + (size_t)(b * 2048 + qbase + r31) * 512 + hh * 64;
        bf16x8 qf[4];
#pragma unroll
        for (int kk = 0; kk < 4; ++kk) qf[kk] = *(const bf16x8*)(qrow + 16 * kk + 8 * h);
        f32x16 oacc[2];
#pragma unroll
        for (int nt = 0; nt < 2; ++nt)
#pragma unroll
            for (int i = 0; i < 16; ++i) oacc[nt][i] = 0.f;
        float Rr = 1.0f;
        const int t = qbase + r31;
        for (int kt = q0 / 64 + 3; kt >= 0; --kt) {
            __syncthreads();
            { const int wd = __all(Rr == 0.f); if (lane == 0) flags[w] = wd; }
            __syncthreads();
            if (flags[0] & flags[1] & flags[2] & flags[3] & flags[4] & flags[5] & flags[6] & flags[7]) break;
            const int s_tile = kt * 64;
            {
                const int c = tid, row = c >> 3, ch = c & 7;
                const u32x4 kv = *(const u32x4*)(R + R_KSB + (size_t)(b * 2048 + s_tile + row) * 512 + hh * 64 + ch * 8);
                const u32x4 vv = *(const u32x4*)(R + R_VTSB + ((size_t)((b * 8 + hh) * 64 + row)) * 2048 + s_tile + ch * 8);
                *(u32x4*)(KT + row * 128 + ((ch ^ (row & 7)) << 4)) = kv;
                *(uint2*)(VTt + row * 136 + ch * 16) = make_uint2(vv[0], vv[1]);
                *(uint2*)(VTt + row * 136 + ch * 16 + 8) = make_uint2(vv[2], vv[3]);
            }
            __syncthreads();
#pragma unroll
            for (int sbk = 1; sbk >= 0; --sbk) {
                const int key_lo = s_tile + 32 * sbk;
                if (key_lo >= qbase + 31) continue;
                if (__all(Rr == 0.f)) continue;
                f32x16 st;
#pragma unroll
                for (int i = 0; i < 16; ++i) st[i] = 0.f;
                const int krow = 32 * sbk + r31;
#pragma unroll
                for (int kk = 0; kk < 4; ++kk) {
                    const bf16x8 kf = *(const bf16x8*)(KT + krow * 128 + (((2 * kk + h) ^ (krow & 7)) << 4));
                    st = __builtin_amdgcn_mfma_f32_32x32x16_bf16(kf, qf[kk], st, 0, 0, 0);
                }
                float a[16], G[4];
                const bool diag = key_lo + 31 >= qbase;
#pragma unroll
                for (int g = 0; g < 4; ++g) {
                    float sg[4], m[4];
#pragma unroll
                    for (int i = 0; i < 4; ++i) {
                        const float z = fmaxf(st[4 * g + i], -80.f);
                        const float ez = __builtin_amdgcn_exp2f(z * -1.4426950409f), sig = __builtin_amdgcn_rcpf(1.0f + ez);
                        sg[i] = sig; m[i] = ez * sig;
                    }
                    if (diag) {
#pragma unroll
                        for (int i = 0; i < 4; ++i) { const bool valid = key_lo + 8 * g + 4 * h + i < t; sg[i] = valid ? sg[i] : 0.f; m[i] = valid ? m[i] : 1.0f; }
                    }
                    const float x2 = m[3], x1 = x2 * m[2], x0 = x1 * m[1];
                    G[g] = x0 * m[0];
                    a[4 * g + 3] = sg[3]; a[4 * g + 2] = sg[2] * x2; a[4 * g + 1] = sg[1] * x1; a[4 * g] = sg[0] * x0;
                }
                float Go[4], P[4];
#pragma unroll
                for (int g = 0; g < 4; ++g) { Go[g] = __shfl_xor(G[g], 32); P[g] = G[g] * Go[g]; }
                const float c2 = P[3], c1 = c2 * P[2], c0 = c1 * P[1];
                float Tg[4];
                Tg[3] = Rr; Tg[2] = Rr * c2; Tg[1] = Rr * c1; Tg[0] = Rr * c0;
#pragma unroll
                for (int g = 0; g < 4; ++g) {
                    const float tg = (h == 0) ? Tg[g] * Go[g] : Tg[g];
                    a[4 * g] *= tg; a[4 * g + 1] *= tg; a[4 * g + 2] *= tg; a[4 * g + 3] *= tg;
                }
                Rr = Rr * c0 * P[0];
#pragma unroll
                for (int s2 = 0; s2 < 2; ++s2) {
                    union { bf16x8 v; unsigned u[4]; } af;
#pragma unroll
                    for (int j2 = 0; j2 < 4; ++j2) af.u[j2] = pack2(a[8 * s2 + 2 * j2], a[8 * s2 + 2 * j2 + 1]);
#pragma unroll
                    for (int nt = 0; nt < 2; ++nt) {
                        const char* vp = VTt + (32 * nt + r31) * 136 + 64 * sbk + 32 * s2 + 8 * h;
                        union { bf16x8 v; uint2 hh2[2]; } vf;
                        vf.hh2[0] = *(const uint2*)vp; vf.hh2[1] = *(const uint2*)(vp + 16);
                        oacc[nt] = __builtin_amdgcn_mfma_f32_32x32x16_bf16(af.v, vf.v, oacc[nt], 0, 0, 0);
                    }
                }
            }
        }
#pragma unroll
        for (int nt = 0; nt < 2; ++nt)
#pragma unroll
            for (int i = 0; i < 16; ++i) {
                const int qq = (i & 3) + 8 * (i >> 2) + 4 * h;
                R[R_QSB + (size_t)(b * 2048 + qbase + qq) * 512 + hh * 64 + 32 * nt + r31] = f2bf(oacc[nt][i]);
            }
    }
}
__device__ __forceinline__ float log_sigmoid(float x) { return fminf(x, 0.f) - __logf(1.0f + __expf(-fabsf(x))); }
__device__ __forceinline__ int swz(int row, int chunk) { return row * 128 + ((chunk ^ (row & 7)) << 4); }
__device__ __forceinline__ void gla_prep(const Params& p, char* smem) {
    bf16_t* R = (bf16_t*)(p.ws + OFF_REGION);
    const float* ALR = (const float*)(R + R_ALR);
    bf16_t* KOTg = R + R_KOT; float* DECg = (float*)(R + R_DEC);
    float* SEG = (float*)smem; float* ALRs = SEG + 256;
    const int tid = VTID, d = tid & 63, w = tid >> 6;
    for (int task = VBID; task < 2048; task += VGRID) {
        const int bh = task >> 5, c = task & 31, b = bh >> 2, hh = bh & 3;
        const size_t rowbase = (size_t)b * 2048 + c * 64;
        unsigned qr[16], kr[16];
#pragma unroll
        for (int i = 0; i < 16; ++i) { const size_t row = rowbase + w * 16 + i; qr[i] = R[R_QG + row * 256 + hh * 64 + d]; kr[i] = R[R_KG + row * 256 + hh * 64 + d]; }
        const f32x4 ar = *(const f32x4*)(ALR + rowbase * 16 + tid * 4);
        float w2r[16];
#pragma unroll
        for (int r = 0; r < 16; ++r) w2r[r] = p.ab_w_alpha2[r * 256 + hh * 64 + d];
        const float b2r = p.ab_b_alpha2[hh * 64 + d];
        __syncthreads();
        *(f32x4*)(ALRs + tid * 4) = ar;
        __syncthreads();
        float cs[16]; float run = 0.f;
#pragma unroll
        for (int i = 0; i < 16; ++i) {
            const float* al = ALRs + (w * 16 + i) * 16;
            float pre = b2r;
#pragma unroll
            for (int r = 0; r < 16; ++r) pre += al[r] * w2r[r];
            run += log_sigmoid(pre) * (1.0f / 16.0f);
            cs[i] = run;
        }
        SEG[w * 64 + d] = run;
        __syncthreads();
        float off = 0.f, tot = 0.f;
#pragma unroll
        for (int w2 = 0; w2 < 4; ++w2) { const float s = SEG[w2 * 64 + d]; tot += s; if (w2 < w) off += s; }
        unsigned kop[8];
#pragma unroll
        for (int i2 = 0; i2 < 8; ++i2) {
            float kov[2];
#pragma unroll
            for (int u = 0; u < 2; ++u) {
                const int i = 2 * i2 + u;
                const float bc = off + cs[i];
                const float kv = bf2f((bf16_t)kr[i]);
                const size_t row = rowbase + w * 16 + i;
                R[R_QG + row * 256 + hh * 64 + d] = f2bf(bf2f((bf16_t)qr[i]) * 0.125f * __expf(bc));
                R[R_KG + row * 256 + hh * 64 + d] = f2bf(kv * __expf(-bc));
                kov[u] = kv * __expf(tot - bc);
            }
            kop[i2] = pack2(kov[0], kov[1]);
        }
        bf16_t* kp = KOTg + ((size_t)task * 64 + d) * 64 + w * 16;
        *(uint4*)kp = make_uint4(kop[0], kop[1], kop[2], kop[3]);
        *(uint4*)(kp + 8) = make_uint4(kop[4], kop[5], kop[6], kop[7]);
        if (w == 0) DECg[(size_t)task * 64 + d] = __expf(tot);
    }
}
__device__ __forceinline__ void gla_scan(const Params& p, char* smem, bool dry = false) {
    bf16_t* R = (bf16_t*)(p.ws + OFF_REGION);
    const bf16_t* KOTg = R + R_KOT; const float* DECg = (const float*)(R + R_DEC);
    char* QS = smem; char* KS = smem + 8192; char* KOT = smem + 16384; char* VTs = smem + 24576; char* SPT = smem + 40960;
    float* DEC = (float*)(smem + 57344); float* GN = DEC + 64;
    const int tid = VTID, lane = tid & 63, w = tid >> 6, l15_ = lane & 15, q4 = lane >> 4;
    for (int task = VBID; task < 64; task += VGRID) {
        const int b = task >> 2, hh = task & 3;
        f32x4 Sacc[8];
#pragma unroll
        for (int nt = 0; nt < 8; ++nt) Sacc[nt] = (f32x4){0.f, 0.f, 0.f, 0.f};
        __syncthreads();
        for (int i = tid; i < 1024; i += 256) *(uint4*)(SPT + i * 16) = make_uint4(0, 0, 0, 0);
        if (tid < 128) GN[tid] = p.ab_gla_norm[hh * 128 + tid];
        const size_t rowbase = (size_t)b * 2048;
        const bf16_t* vbase = R + R_VTG + ((size_t)((b * 4 + hh) * 128)) * 2048;
        u32x4 tq[2], tk[2], tko[2], vr[4]; float td = 0.f;
        auto prefetch = [&](int c) {
            const int t0 = c * 64;
#pragma unroll
            for (int i = 0; i < 2; ++i) {
                const int cid = tid + 256 * i, row = cid >> 3, ch = cid & 7;
                tq[i] = *(const u32x4*)(R + R_QG + (rowbase + t0 + row) * 256 + hh * 64 + ch * 8);
                tk[i] = *(const u32x4*)(R + R_KG + (rowbase + t0 + row) * 256 + hh * 64 + ch * 8);
                tko[i] = *(const u32x4*)(KOTg + (((size_t)task * 32 + c) * 64 + row) * 64 + ch * 8);
            }
#pragma unroll
            for (int i = 0; i < 4; ++i) { const int cid = tid + 256 * i, e = cid >> 3, ch = cid & 7; vr[i] = *(const u32x4*)(vbase + (size_t)e * 2048 + t0 + ch * 8); }
            if (tid < 64) td = DECg[((size_t)task * 32 + c) * 64 + tid];
        };
        prefetch(0);
        for (int c = 0; c < 32; ++c) {
            int lz = 0; asm volatile("" : "+v"(lz));
            const int l15 = l15_ + lz;
            const int cx = (q4 ^ (l15 & 7)) << 4;
            const int rb0 = l15 * 128 + cx, rb1 = l15 * 128 + (cx ^ 64);
#pragma unroll
            for (int i = 0; i < 2; ++i) {
                const int cid = tid + 256 * i + lz, row = cid >> 3, ch = cid & 7;
                *(u32x4*)(QS + swz(row, ch)) = tq[i]; *(u32x4*)(KS + swz(row, ch)) = tk[i]; *(u32x4*)(KOT + swz(row, ch)) = tko[i];
            }
#pragma unroll
            for (int i = 0; i < 4; ++i) { const int cid = tid + 256 * i + lz, e = cid >> 3, ch = cid & 7; *(u32x4*)(VTs + swz(e, ch)) = vr[i]; }
            if (tid < 64) DEC[tid] = td;
            uint2 gr[8];
            const unsigned goff = (unsigned)((rowbase + c * 64 + 16 * w + l15) * 512 + hh * 128 + 4 * q4);
            bf16_t* const gbase = R + R_GG;
#pragma unroll
            for (int nt = 0; nt < 8; ++nt) gr[nt] = *(const uint2*)(gbase + (goff + 16 * nt));
            if (c + 1 < 32) prefetch(c + 1);
            __syncthreads();
            bf16x8 qf[2];
#pragma unroll
            for (int kk = 0; kk < 2; ++kk) qf[kk] = *(const bf16x8*)(QS + w * 2048 + (kk ? rb1 : rb0));
            f32x4 sT[4];
#pragma unroll
            for (int st = 0; st < 4; ++st) {
                sT[st] = (f32x4){0.f, 0.f, 0.f, 0.f};
                if (st <= w) {
#pragma unroll
                    for (int kk = 0; kk < 2; ++kk) { const bf16x8 kf = *(const bf16x8*)(KS + st * 2048 + (kk ? rb1 : rb0)); sT[st] = __builtin_amdgcn_mfma_f32_16x16x32_bf16(kf, qf[kk], sT[st], 0, 0, 0); }
#pragma unroll
                    for (int r = 0; r < 4; ++r) if (16 * st + 4 * q4 + r > 16 * w + l15) sT[st][r] = 0.f;
                }
            }
            bf16x8 af[2];
#pragma unroll
            for (int ks2 = 0; ks2 < 2; ++ks2) {
                union { bf16x8 v; unsigned u[4]; } cv;
                cv.u[0] = pack2(sT[2 * ks2][0], sT[2 * ks2][1]); cv.u[1] = pack2(sT[2 * ks2][2], sT[2 * ks2][3]);
                cv.u[2] = pack2(sT[2 * ks2 + 1][0], sT[2 * ks2 + 1][1]); cv.u[3] = pack2(sT[2 * ks2 + 1][2], sT[2 * ks2 + 1][3]);
                af[ks2] = cv.v;
            }
            const int vb = l15 * 128 + ((((q4 >> 1) ^ (l15 & 7)) << 4) | ((q4 & 1) * 8));
            f32x4 o[8];
#pragma unroll
            for (int nt = 0; nt < 8; ++nt) {
                o[nt] = (f32x4){0.f, 0.f, 0.f, 0.f};
                const int e = 16 * nt + l15;
#pragma unroll
                for (int kk = 0; kk < 2; ++kk) { const bf16x8 sf = *(const bf16x8*)(SPT + nt * 2048 + (kk ? rb1 : rb0)); o[nt] = __builtin_amdgcn_mfma_f32_16x16x32_bf16(sf, qf[kk], o[nt], 0, 0, 0); }
#pragma unroll
                for (int ks2 = 0; ks2 < 2; ++ks2) {
                    if (2 * ks2 <= w) {
                        union { bf16x8 v; uint2 h[2]; } cv;
                        cv.h[0] = *(const uint2*)(VTs + nt * 2048 + (vb ^ (ks2 * 64)));
                        cv.h[1] = *(const uint2*)(VTs + nt * 2048 + (vb ^ (ks2 * 64) ^ 32));
                        o[nt] = __builtin_amdgcn_mfma_f32_16x16x32_bf16(cv.v, af[ks2], o[nt], 0, 0, 0);
                    }
                }
            }
            {
                const float4 dc = *(const float4*)(DEC + 16 * w + 4 * q4);
                bf16x8 kof[2];
#pragma unroll
                for (int kk = 0; kk < 2; ++kk) kof[kk] = *(const bf16x8*)(KOT + w * 2048 + (kk ? rb1 : rb0));
#pragma unroll
                for (int nt = 0; nt < 8; ++nt) {
                    Sacc[nt][0] *= dc.x; Sacc[nt][1] *= dc.y; Sacc[nt][2] *= dc.z; Sacc[nt][3] *= dc.w;
#pragma unroll
                    for (int kk = 0; kk < 2; ++kk) { const bf16x8 vf = *(const bf16x8*)(VTs + nt * 2048 + (kk ? rb1 : rb0)); Sacc[nt] = __builtin_amdgcn_mfma_f32_16x16x32_bf16(kof[kk], vf, Sacc[nt], 0, 0, 0); }
                }
            }
            __syncthreads();
#pragma unroll
            for (int nt = 0; nt < 8; ++nt) {
                const int e = 16 * nt + l15;
                uint2 pk; pk.x = pack2(Sacc[nt][0], Sacc[nt][1]); pk.y = pack2(Sacc[nt][2], Sacc[nt][3]);
                *(uint2*)(SPT + nt * 2048 + l15 * 128 + (((2 * w + (q4 >> 1)) ^ (l15 & 7)) << 4) + (q4 & 1) * 8) = pk;
            }
            float ssq = 0.f;
#pragma unroll
            for (int nt = 0; nt < 8; ++nt) ssq += (o[nt][0] * o[nt][0] + o[nt][1] * o[nt][1]) + (o[nt][2] * o[nt][2] + o[nt][3] * o[nt][3]);
            ssq += __shfl_xor(ssq, 16); ssq += __shfl_xor(ssq, 32);
            const float rsd = rsqrtf(ssq * (1.0f / 128.0f) + EPS);
#pragma unroll
            for (int nt = 0; nt < 8; ++nt) {
                asm volatile("" ::: "memory");
                const f32x4 gn = *(const f32x4*)(GN + 16 * nt + 4 * q4);
                const float g0 = lo2f(gr[nt].x), g1 = hi2f(gr[nt].x), g2 = lo2f(gr[nt].y), g3 = hi2f(gr[nt].y);
                uint2 ov;
                ov.x = pack2(o[nt][0] * rsd * gn[0] * g0, o[nt][1] * rsd * gn[1] * g1);
                ov.y = pack2(o[nt][2] * rsd * gn[2] * g2, o[nt][3] * rsd * gn[3] * g3);
                if (!dry || ov.x == 0x7fc17fc1u) *(uint2*)(gbase + (goff + 16 * nt)) = ov;
            }
        }
    }
}

#define KEY_PAD 0xff800000u
__device__ __forceinline__ unsigned ord_key(float f) { return __float_as_uint(f); }
__device__ __forceinline__ float unord_key(unsigned k) { return __uint_as_float(k); }
__device__ __forceinline__ unsigned key_max(unsigned a, unsigned b) { unsigned r; asm("v_max_f32 %0, %1, %2" : "=v"(r) : "v"(a), "v"(b)); return r; }
__device__ __forceinline__ unsigned key_min(unsigned a, unsigned b) { unsigned r; asm("v_min_f32 %0, %1, %2" : "=v"(r) : "v"(a), "v"(b)); return r; }
__device__ __forceinline__ void ce_desc(unsigned& a, unsigned& b) { const unsigned hi = key_max(a, b), lo = key_min(a, b); a = hi; b = lo; }
__device__ __forceinline__ void bitonic_sort16_desc(unsigned (&a)[16]) {
#pragma unroll
    for (int k = 2; k <= 16; k <<= 1)
#pragma unroll
        for (int j = k >> 1; j > 0; j >>= 1)
#pragma unroll
            for (int i = 0; i < 16; ++i) { const int l = i ^ j; if (l > i) { if ((i & k) == 0) ce_desc(a[i], a[l]); else ce_desc(a[l], a[i]); } }
}
__device__ __forceinline__ void merge_top16(unsigned (&L)[16], const unsigned (&B)[16]) {
#pragma unroll
    for (int i = 0; i < 16; ++i) L[i] = key_max(L[i], B[15 - i]);
#pragma unroll
    for (int j = 8; j > 0; j >>= 1)
#pragma unroll
        for (int i = 0; i < 16; ++i) { const int l = i ^ j; if (l > i) ce_desc(L[i], L[l]); }
}
__device__ constexpr int cand_i(int n) { int c = 0; for (int i = 0; i < 16; ++i) for (int j = 0; j < 16; ++j) if ((i + 1) * (j + 1) <= 16) { if (c == n) return i; ++c; } return -1; }
__device__ constexpr int cand_j(int n) { int c = 0; for (int i = 0; i < 16; ++i) for (int j = 0; j < 16; ++j) if ((i + 1) * (j + 1) <= 16) { if (c == n) return j; ++c; } return -1; }
template <int N> struct CandTab { int i[N], j[N]; constexpr CandTab() : i(), j() { for (int n = 0; n < N; ++n) { i[n] = cand_i(n); j[n] = cand_j(n); } } };

__device__ __forceinline__ bf16x8 pack8(const float4 a, const float4 b) {
    u32x4 t; t.x = pack2(a.x, a.y); t.y = pack2(a.z, a.w); t.z = pack2(b.x, b.y); t.w = pack2(b.z, b.w);
    return __builtin_bit_cast(bf16x8, t);
}
__device__ __forceinline__ void fold_query_weights(const Params& p, int vb0 = 0) {
    int lz = 0; asm volatile("" : "+v"(lz));
    const int lane = (VTID & 63) + lz, wid = VTID >> 6, fr = lane & 15, fq = lane >> 4;
    unsigned char* Wf = p.ws + OFF_WT_Q;
    if (VBID < vb0) return;
    for (int task = VBID - vb0; task < 512; task += VGRID - vb0) {
        const int kb = task & 15, pp = (task >> 4) & 1, h = (task >> 5) & 7, layer = task >> 8;
        const float* wq = p.peer_w_q + (size_t)layer * 1024 * 2048 + (size_t)(kb * 64 + fr) * 2048 + h * 256 + pp * 128 + fq * 8;
        const float* sk = p.peer_subkeys + ((size_t)((layer * 8 + h) * 2 + pp) * 128 + wid * 32 + fr) * 128 + fq * 8;
        f32x4 acc[4][2];
#pragma unroll
        for (int kt = 0; kt < 4; ++kt)
#pragma unroll
            for (int jt = 0; jt < 2; ++jt) acc[kt][jt] = (f32x4){0.f, 0.f, 0.f, 0.f};
#pragma unroll 1
        for (int s = 0; s < 4; ++s) {
            bf16x8 a[4], b[2];
#pragma unroll
            for (int kt = 0; kt < 4; ++kt) { const float* q = wq + (size_t)(kt * 16) * 2048 + s * 32; a[kt] = pack8(*(const float4*)q, *(const float4*)(q + 4)); }
#pragma unroll
            for (int jt = 0; jt < 2; ++jt) { const float* q = sk + (size_t)(jt * 16) * 128 + s * 32; b[jt] = pack8(*(const float4*)q, *(const float4*)(q + 4)); }
#pragma unroll
            for (int kt = 0; kt < 4; ++kt)
#pragma unroll
                for (int jt = 0; jt < 2; ++jt) acc[kt][jt] = __builtin_amdgcn_mfma_f32_16x16x32_bf16(a[kt], b[jt], acc[kt][jt], 0, 0, 0);
        }
#pragma unroll
        for (int jt = 0; jt < 2; ++jt) {
            const int key = wid * 32 + jt * 16 + fr, cu = 128 * ((key >> 5) & 1) + 32 * (2 * pp + (key >> 6)) + (key & 31);
            unsigned char* row = Wf + ((size_t)layer * 2048 + h * 256 + cu) * 1024 + kb * 64 + 4 * fq;
#pragma unroll
            for (int kt = 0; kt < 4; ++kt) {
                const f32x4 wv = acc[kt][jt] * *(const f32x4*)(p.norm_ffn + layer * 1024 + kb * 64 + kt * 16 + 4 * fq) * 64.0f;
                int pk = __builtin_amdgcn_cvt_pk_fp8_f32(wv[0], wv[1], 0, false); pk = __builtin_amdgcn_cvt_pk_fp8_f32(wv[2], wv[3], pk, true);
                *(int*)(row + kt * 16) = pk;
            }
        }
    }
}
__device__ __forceinline__ void bitonic_merge16_desc(unsigned (&L)[16]) {
#pragma unroll
    for (int j = 8; j > 0; j >>= 1)
#pragma unroll
        for (int i = 0; i < 16; ++i) { const int l = i ^ j; if (l > i) ce_desc(L[i], L[l]); }
}
__device__ __forceinline__ void bitonic_sort8_desc(unsigned (&a)[8]) {
#pragma unroll
    for (int k = 2; k <= 8; k <<= 1)
#pragma unroll
        for (int j = k >> 1; j > 0; j >>= 1)
#pragma unroll
            for (int i = 0; i < 8; ++i) { const int l = i ^ j; if (l > i) { if ((i & k) == 0) ce_desc(a[i], a[l]); else ce_desc(a[l], a[i]); } }
}
__device__ __forceinline__ void sort16_desc(unsigned (&a)[16]) {
#define CE_(i, j) ce_desc(a[i], a[j])
    CE_(0,13); CE_(1,12); CE_(2,15); CE_(3,14); CE_(4,8); CE_(5,6); CE_(7,11); CE_(9,10);
    CE_(0,5); CE_(1,7); CE_(2,9); CE_(3,4); CE_(6,13); CE_(8,14); CE_(10,15); CE_(11,12);
    CE_(0,1); CE_(2,3); CE_(4,5); CE_(6,8); CE_(7,9); CE_(10,11); CE_(12,13); CE_(14,15);
    CE_(0,2); CE_(1,3); CE_(4,10); CE_(5,11); CE_(6,7); CE_(8,9); CE_(12,14); CE_(13,15);
    CE_(1,2); CE_(3,12); CE_(4,6); CE_(5,7); CE_(8,10); CE_(9,11); CE_(13,14);
    CE_(1,4); CE_(2,6); CE_(5,8); CE_(7,10); CE_(9,13); CE_(11,14);
    CE_(2,4); CE_(3,6); CE_(9,12); CE_(11,13);
    CE_(3,5); CE_(6,8); CE_(7,9); CE_(10,12);
    CE_(3,4); CE_(5,6); CE_(7,8); CE_(9,10); CE_(11,12);
    CE_(6,7); CE_(8,9);
#undef CE_
}
struct EpiSelect {
    unsigned* IDX; float* GATE; G8_LAS unsigned* X; const float* SSQP; const unsigned* SCT;
    __device__ __forceinline__ void operator()(const f32x4 (&acc)[2][2][4][2], const g8::Unit& u, int wr, int wc, int fr_, int fq_) const {
        int lz = 0; asm volatile("" : "+v"(lz));
        const int lane_ = (int)(threadIdx.x & 63) + lz, fr = lane_ & 15, fq = lane_ >> 4; (void)fr_; (void)fq_;
        const int pp = wc >> 1, half = wc & 1, wid = wr * 4 + wc;
        const unsigned kb = 127u - (unsigned)(half * 64 + fq * 8);
        unsigned Lst[4][16];
#pragma unroll
        for (int ai = 0; ai < 2; ++ai)
#pragma unroll
            for (int m = 0; m < 4; ++m) {
                unsigned C[16], Xc[16];
#pragma unroll
                for (int bj = 0; bj < 2; ++bj)
#pragma unroll
                    for (int n = 0; n < 2; ++n)
#pragma unroll
                        for (int r = 0; r < 4; ++r) C[bj * 8 + n * 4 + r] = (ord_key(acc[ai][bj][m][n][r]) & ~127u) | (kb - (unsigned)(bj * 32 + n * 4 + r));
                sort16_desc(C);
#pragma unroll
                for (int i = 0; i < 16; ++i) Xc[i] = (unsigned)__shfl_xor((int)C[i], 16);
                merge_top16(C, Xc);
#pragma unroll
                for (int i = 0; i < 16; ++i) Xc[i] = (unsigned)__shfl_xor((int)C[i], 32);
                merge_top16(C, Xc);
                if ((m >> 1) == half) {
#pragma unroll
                    for (int i = 0; i < 16; ++i) Lst[ai * 2 + (m & 1)][i] = C[i];
                } else if (fq == 0) {
                    G8_LAS unsigned* xs = X + (((ai * 2 + wr) * 2 + pp) * 4 + m) * 256 + fr;
#pragma unroll
                    for (int i = 0; i < 16; ++i) xs[(i ^ m) << 4] = C[i];
                }
            }
        __syncthreads();
#pragma unroll
        for (int ai = 0; ai < 2; ++ai)
#pragma unroll
            for (int e = 0; e < 2; ++e) {
                const int m = half * 2 + e;
                unsigned Xc[16];
                G8_LAS unsigned* xs = X + (((ai * 2 + wr) * 2 + pp) * 4 + m) * 256 + fr;
#pragma unroll
                for (int i = 0; i < 16; ++i) Xc[i] = xs[(i ^ m) << 4];
                merge_top16(Lst[ai * 2 + e], Xc);
                if (fq == 0) {
#pragma unroll
                    for (int i = 0; i < 16; ++i) xs[(i ^ m) << 4] = Lst[ai * 2 + e][i];
                }
            }
        __syncthreads();
        if (wid < 4) {
            G8_LAS unsigned* x0 = X + ((wid * 2 + 0) * 4 + fq) * 256 + fr; G8_LAS unsigned* x1 = X + ((wid * 2 + 1) * 4 + fq) * 256 + fr;
            float s0[16], s1[16];
#pragma unroll
            for (int i = 0; i < 16; ++i) { s0[i] = unord_key(x0[(i ^ fq) << 4] & ~127u); s1[i] = unord_key(x1[(i ^ fq) << 4] & ~127u); }
#define SEL_CAND(i, j) ((ord_key(s0[i] + s1[j]) & ~255u) | (unsigned)(255 - ((i) * 16 + (j))))
            unsigned C[16], B[16], M2[16], M3[8];
#pragma unroll
            for (int j = 0; j < 16; ++j) C[j] = SEL_CAND(0, j);
#pragma unroll
            for (int k = 0; k < 15; ++k) B[k] = SEL_CAND(k + 1, 0);
            B[15] = KEY_PAD;
            merge_top16(C, B);
#pragma unroll
            for (int j = 0; j < 7; ++j) M2[j] = SEL_CAND(1, j + 1);
            M2[7] = KEY_PAD; M2[8] = KEY_PAD; M2[9] = KEY_PAD;
#pragma unroll
            for (int k = 0; k < 6; ++k) M2[15 - k] = SEL_CAND(k + 2, 1);
            bitonic_merge16_desc(M2);
            M3[0] = SEL_CAND(2, 2); M3[1] = SEL_CAND(2, 3); M3[2] = SEL_CAND(2, 4); M3[3] = SEL_CAND(3, 2); M3[4] = SEL_CAND(4, 2); M3[5] = SEL_CAND(3, 3); M3[6] = KEY_PAD; M3[7] = KEY_PAD;
            bitonic_sort8_desc(M3);
#pragma unroll
            for (int i = 0; i < 8; ++i) B[i] = M3[i];
#pragma unroll
            for (int i = 8; i < 16; ++i) B[i] = KEY_PAD;
            merge_top16(M2, B);
            merge_top16(C, M2);
#undef SEL_CAND
            const int tok = u.pm * 256 + (wid >> 1) * 128 + (wid & 1) * 64 + fq * 16 + fr;
            float rstd;
            {
                const f32x4 q0 = *(const f32x4*)(SSQP + (size_t)tok * 32), q1 = *(const f32x4*)(SSQP + (size_t)tok * 32 + 4), q2 = *(const f32x4*)(SSQP + (size_t)tok * 32 + 8), q3 = *(const f32x4*)(SSQP + (size_t)tok * 32 + 12);
                const f32x4 q = (q0 + q1) + (q2 + q3);
                rstd = rsqrtf(((q[0] + q[1]) + (q[2] + q[3])) * (1.0f / D) + EPS);
            }
            const float mx = unord_key(C[0] & ~255u);
            float e[16]; float sum = 0.f;
#pragma unroll
            for (int r = 0; r < 16; ++r) { e[r] = __expf((unord_key(C[r] & ~255u) - mx) * (rstd * (1.0f / 64.0f))); sum += e[r]; }
            const float inv = 1.0f / sum;
            const size_t ob = (size_t)tok * 128 + u.pn * 16;
            unsigned iw[16];
#pragma unroll
            for (int r = 0; r < 16; ++r) {
                const unsigned code = 255u - (C[r] & 255u);
                const unsigned e0 = 127u - (x0[((code >> 4) ^ (unsigned)fq) << 4] & 127u), e1 = 127u - (x1[((code & 15u) ^ (unsigned)fq) << 4] & 127u);
                iw[r] = e0 * 128u + e1;
            }
            unsigned sc[16];
#pragma unroll
            for (int r = 0; r < 16; ++r) sc[r] = SCT[iw[r]];
#pragma unroll
            for (int r = 0; r < 16; ++r) {
                iw[r] |= sc[r] << 16;
                e[r] *= inv * (float)__builtin_bit_cast(_Float16, (unsigned short)(sc[r] >> 16));
            }
#pragma unroll
            for (int r = 0; r < 4; ++r) *(uint4*)(IDX + ob + r * 4) = make_uint4(iw[4 * r], iw[4 * r + 1], iw[4 * r + 2], iw[4 * r + 3]);
#pragma unroll
            for (int r = 0; r < 4; ++r) *(float4*)(GATE + ob + r * 4) = make_float4(e[4 * r], e[4 * r + 1], e[4 * r + 2], e[4 * r + 3]);
        }
        __syncthreads();
    }
};
__device__ __forceinline__ void phase_select8(const Params& p, int layer, char* smem_phys) {
    const bf16_t* H = (const bf16_t*)(p.ws + OFF_H); const bf16_t* Wf = (const bf16_t*)(p.ws + OFF_WT_Q + (size_t)layer * 2048 * 1024);
    g8::Gemm g{H, H, 512, 512, Wf, T, 2048, 512};
    g8::StaticOrder S; S.init(T, 2048, (int)gridDim.x, (int)blockIdx.x);
    EpiSelect E{(unsigned*)(p.ws + OFF_IDX), (float*)(p.ws + OFF_GATE), (G8_LAS unsigned*)(smem_phys + 131072), (const float*)(p.ws + OFF_SSQ), (const unsigned*)(p.ws + OFF_USC) + (size_t)layer * NEXP};
    g8::gemm_phase<EpiSelect, true>((G8_LAS unsigned char*)smem_phys, g, S, E);
    __syncthreads();
    if (threadIdx.x == 0) *(uint4*)(smem_phys + kDynLds - 16) = make_uint4(0u, 0u, 0u, 0u);
    __syncthreads();
}

__device__ __forceinline__ float ub0(unsigned w) { float f; asm("v_cvt_f32_ubyte0 %0, %1" : "=v"(f) : "v"(w)); return f; }
__device__ __forceinline__ float ub1(unsigned w) { float f; asm("v_cvt_f32_ubyte1 %0, %1" : "=v"(f) : "v"(w)); return f; }
__device__ __forceinline__ float ub2(unsigned w) { float f; asm("v_cvt_f32_ubyte2 %0, %1" : "=v"(f) : "v"(w)); return f; }
__device__ __forceinline__ float ub3(unsigned w) { float f; asm("v_cvt_f32_ubyte3 %0, %1" : "=v"(f) : "v"(w)); return f; }
typedef _Float16 f16x2 __attribute__((ext_vector_type(2)));
__device__ __forceinline__ void glds16(const void* gsrc, unsigned lds_dst) {
    unsigned keep; const unsigned d = (unsigned)__builtin_amdgcn_readfirstlane((int)lds_dst);
    asm volatile("s_mov_b32 %0, m0\n\ts_mov_b32 m0, %2\n\ts_nop 0\n\tglobal_load_lds_dwordx4 %1, off\n\ts_mov_b32 m0, %0" : "=&s"(keep) : "v"(gsrc), "s"(d) : "memory");
}
__device__ __forceinline__ void peer_gather(const Params& p, int layer, const float* __restrict__ gnext, bool final_out, char* smem) {
    const unsigned char* REC = p.ws + OFF_UT + (size_t)layer * NEXP * 1024;
    bf16_t* H = (bf16_t*)(p.ws + OFF_H);
    const unsigned* IDX = (const unsigned*)(p.ws + OFF_IDX); const float* GATE = (const float*)(p.ws + OFF_GATE);
    bf16_t* S = (bf16_t*)(p.ws + OFF_S);
    float* sGain = (float*)(smem + 139264);
    { int lz0 = 0; asm volatile("" : "+v"(lz0)); const int i = (int)threadIdx.x + lz0; if (i < 256) ((f32x4*)sGain)[i] = ((const f32x4*)(p.norm_ffn + layer * 1024))[i]; }
    __syncthreads();
    const int lane = VTID & 63, wid = VTID >> 6, sub = lane >> 4, li = lane & 15;
    char* wbase = smem + (int)(threadIdx.x >> 6) * 17408;
    unsigned* sIdx = (unsigned*)wbase; float* sGate = (float*)(wbase + 512);
    const char* ring = wbase + 1024; const unsigned ringb = (unsigned)(size_t)ring;
    const int gw = VBID * 4 + wid, nw = VGRID * 4;
    for (int t = gw; t < T; t += nw) {
        {
            int lz = 0; asm volatile("" : "+v"(lz));
            const int l2 = 2 * (lane + lz);
            const uint2 idp = *(const uint2*)(IDX + (size_t)t * 128 + l2);
            const float2 g2 = *(const float2*)(GATE + (size_t)t * 128 + l2);
            *(uint2*)(sIdx + l2) = idp; *(float2*)(sGate + l2) = g2;
        }
        int XH[2][4], XL[2][4]; float sx; float xg;
        {
            const int jq = sub >> 1, dq = (sub & 1) * 2;
            f32x4 xr[4]; float am = 0.f, ssx = 0.f;
#pragma unroll
            for (int k = 0; k < 2; ++k) {
                const int col = (16 * jq + li) * 32 + (dq + k) * 8;
                const u32x4 raw = *(const u32x4*)(S + (size_t)t * 1024 + col);
                const f32x4 g0 = *(const f32x4*)(sGain + col), g1 = *(const f32x4*)(sGain + col + 4);
                const f32x4 x0 = (f32x4){lo2f(raw[0]), hi2f(raw[0]), lo2f(raw[1]), hi2f(raw[1])}, x1 = (f32x4){lo2f(raw[2]), hi2f(raw[2]), lo2f(raw[3]), hi2f(raw[3])};
                ssx += (x0[0] * x0[0] + x0[1] * x0[1]) + (x0[2] * x0[2] + x0[3] * x0[3]) + (x1[0] * x1[0] + x1[1] * x1[1]) + (x1[2] * x1[2] + x1[3] * x1[3]);
                xr[2 * k] = x0 * g0; xr[2 * k + 1] = x1 * g1;
#pragma unroll
                for (int c = 0; c < 4; ++c) am = fmaxf(am, fmaxf(fabsf(xr[2 * k][c]), fabsf(xr[2 * k + 1][c])));
            }
            am = fmaxf(am, __shfl_xor(am, 1)); am = fmaxf(am, __shfl_xor(am, 2)); am = fmaxf(am, __shfl_xor(am, 4)); am = fmaxf(am, __shfl_xor(am, 8));
            am = fmaxf(am, __shfl_xor(am, 16)); am = fmaxf(am, __shfl_xor(am, 32));
            ssx = row16_sum(ssx); ssx += __shfl_xor(ssx, 16); ssx += __shfl_xor(ssx, 32);
            const float inv = am > 0.f ? 119.0f / am : 0.f;
            sx = am * (1.0f / 119.0f) * rsqrtf(ssx * (1.0f / D) + EPS);
            int xs = 0; int myL[2], myH[2];
#pragma unroll
            for (int k = 0; k < 2; ++k) {
                unsigned lo = 0u, hi = 0u;
#pragma unroll
                for (int i = 0; i < 8; ++i) {
                    const int q = __float2int_rn(xr[k * 2 + (i >> 2)][i & 3] * inv);
                    const int sh = (i & 3) * 8 + (i >> 2) * 4;
                    lo |= ((unsigned)q & 15u) << sh; hi |= ((unsigned)((q + 8) >> 4) & 15u) << sh;
                    xs += q;
                }
                myL[k] = (int)lo; myH[k] = (int)hi;
            }
            xs += __shfl_xor(xs, 16); xs += __shfl_xor(xs, 32);
#pragma unroll
            for (int j = 0; j < 2; ++j)
#pragma unroll
                for (int d = 0; d < 4; ++d) { const int srcl = (2 * j + (d >> 1)) * 16 + li; XL[j][d] = __shfl(myL[d & 1], srcl); XH[j][d] = __shfl(myH[d & 1], srcl); }
            xg = 0.5f * (float)xs;
        }
        f16x2 accp[2][16];
#pragma unroll
        for (int j = 0; j < 2; ++j)
#pragma unroll
            for (int c = 0; c < 16; ++c) accp[j][c] = (f16x2){(_Float16)0.f, (_Float16)0.f};
        float wsg = 0.f;
        auto issue = [&](int sg) {
            const unsigned e_ = sIdx[sg * 4 + sub] & 0xffffu;
            const unsigned char* rec = REC + (size_t)e_ * 1024 + li * 16;
            const unsigned dst = ringb + (unsigned)(sg & 3) * 4096u;
            glds16(rec, dst); glds16(rec + 256, dst + 1024u); glds16(rec + 512, dst + 2048u); glds16(rec + 768, dst + 3072u);
        };
        auto compute = [&](int sg, bool refill) {
            const char* sl = ring + (sg & 3) * 4096;
            const u32x4 du0 = *(const u32x4*)(sl + lane * 16), du1 = *(const u32x4*)(sl + 1024 + lane * 16);
            const u32x4 dv0 = *(const u32x4*)(sl + 2048 + lane * 16), dv1 = *(const u32x4*)(sl + 3072 + lane * 16);
            const float us = (float)__builtin_bit_cast(_Float16, (unsigned short)(sIdx[sg * 4 + sub] >> 16));
            const float gt = sGate[sg * 4 + sub];
            if (refill) { asm volatile("s_waitcnt lgkmcnt(0)" ::: "memory"); issue(sg + 4); }
            int iah = 0, ial = 0;
#pragma unroll
            for (int j = 0; j < 2; ++j) {
#pragma unroll
                for (int d = 0; d < 4; ++d) {
                    const int w = (int)(j ? du1[d] : du0[d]);
                    iah = __builtin_amdgcn_sdot8(w, XH[j][d], iah, false);
                    ial = __builtin_amdgcn_sdot8(w, XL[j][d], ial, false);
                }
            }
            float pa = us * ((float)(16 * iah + ial) + xg);
            pa = row16_sum(pa);
            const float ww = gt * gelu_exact(pa * sx);
            wsg += ww;
            const float wc = fminf(fmaxf(ww * 65536.0f, -65504.0f), 65504.0f);
            const _Float16 wha = (_Float16)wc, whb = (_Float16)(wc * 0.0625f);
            const f16x2 wa = {wha, wha}, wb = {whb, whb};
#pragma unroll
            for (int j = 0; j < 2; ++j) {
#pragma unroll
                for (int d = 0; d < 4; ++d) {
                    const unsigned wv = j ? dv1[d] : dv0[d], wt = wv >> 8;
                    const f16x2 c0 = __builtin_bit_cast(f16x2, wv & 0x000f000fu), c1 = __builtin_bit_cast(f16x2, wv & 0x00f000f0u);
                    const f16x2 c2 = __builtin_bit_cast(f16x2, wt & 0x000f000fu), c3 = __builtin_bit_cast(f16x2, wt & 0x00f000f0u);
                    accp[j][4 * d + 0] = __builtin_elementwise_fma(c0, wa, accp[j][4 * d + 0]); accp[j][4 * d + 1] = __builtin_elementwise_fma(c1, wb, accp[j][4 * d + 1]);
                    accp[j][4 * d + 2] = __builtin_elementwise_fma(c2, wa, accp[j][4 * d + 2]); accp[j][4 * d + 3] = __builtin_elementwise_fma(c3, wb, accp[j][4 * d + 3]);
                }
            }
        };
        asm volatile("s_waitcnt vmcnt(0)" ::: "memory");
        issue(0); issue(1); issue(2); issue(3);
#pragma unroll 1
        for (int sg = 0; sg < 28; ++sg) {
            asm volatile("s_waitcnt vmcnt(12)" ::: "memory");
            compute(sg, true);
        }
        asm volatile("s_waitcnt vmcnt(12)" ::: "memory");
        compute(28, false);
        asm volatile("s_waitcnt vmcnt(8)" ::: "memory");
        compute(29, false);
        asm volatile("s_waitcnt vmcnt(4)" ::: "memory");
        compute(30, false);
        asm volatile("s_waitcnt vmcnt(0)" ::: "memory");
        compute(31, false);
        const bool up2 = (sub & 2) != 0, up1 = (sub & 1) != 0;
        float wsum = wsg + __shfl_xor(wsg, 32);
        wsum += __shfl_xor(wsum, 16);
        f16x2 r1p[16];
#pragma unroll
        for (int c = 0; c < 16; ++c) {
            const f16x2 keep = up2 ? accp[1][c] : accp[0][c], give = up2 ? accp[0][c] : accp[1][c];
            r1p[c] = keep + __builtin_bit_cast(f16x2, __shfl_xor(__builtin_bit_cast(int, give), 32));
        }
        f16x2 r2p[8];
#pragma unroll
        for (int c = 0; c < 8; ++c) {
            const f16x2 keep = up1 ? r1p[8 + c] : r1p[c], give = up1 ? r1p[c] : r1p[8 + c];
            r2p[c] = keep + __builtin_bit_cast(f16x2, __shfl_xor(__builtin_bit_cast(int, give), 16));
        }
        float r2[16];
#pragma unroll
        for (int dl = 0; dl < 2; ++dl) {
            r2[8 * dl + 0] = 256.0f * (float)r2p[4 * dl + 0][0]; r2[8 * dl + 2] = 256.0f * (float)r2p[4 * dl + 0][1];
            r2[8 * dl + 4] = 256.0f * (float)r2p[4 * dl + 1][0]; r2[8 * dl + 6] = 256.0f * (float)r2p[4 * dl + 1][1];
            r2[8 * dl + 1] = 256.0f * (float)r2p[4 * dl + 2][0]; r2[8 * dl + 3] = 256.0f * (float)r2p[4 * dl + 2][1];
            r2[8 * dl + 5] = 256.0f * (float)r2p[4 * dl + 3][0]; r2[8 * dl + 7] = 256.0f * (float)r2p[4 * dl + 3][1];
        }
        const int col0 = (16 * (sub >> 1) + li) * 32 + (sub & 1) * 16;
        float ss = 0.f;
        bf16_t* srow = S + (size_t)t * 1024 + col0;
        {
            const u32x4 b0 = *(const u32x4*)srow, b1 = *(const u32x4*)(srow + 8);
#pragma unroll
            for (int c = 0; c < 8; ++c) {
                const unsigned wsrc = c < 4 ? b0[c] : b1[c - 4];
                r2[2 * c] = r2[2 * c] - 7.5f * wsum + lo2f(wsrc); r2[2 * c + 1] = r2[2 * c + 1] - 7.5f * wsum + hi2f(wsrc);
                ss += r2[2 * c] * r2[2 * c] + r2[2 * c + 1] * r2[2 * c + 1];
            }
        }
        ss = wave_sum(ss);
        const float rstd = rsqrtf(ss * (1.0f / D) + EPS);
        const float* gp = gnext + col0;
        if (final_out) {
            float* orow = p.out + (size_t)t * 1024 + col0;
#pragma unroll
            for (int c4 = 0; c4 < 4; ++c4) {
                const f32x4 g = *(const f32x4*)(gp + c4 * 4);
                *(f32x4*)(orow + c4 * 4) = (f32x4){r2[c4 * 4] * rstd * g[0], r2[c4 * 4 + 1] * rstd * g[1], r2[c4 * 4 + 2] * rstd * g[2], r2[c4 * 4 + 3] * rstd * g[3]};
            }
        } else {
            u32x4 sv[2];
#pragma unroll
            for (int c4 = 0; c4 < 4; ++c4) { sv[c4 >> 1][(c4 & 1) * 2] = pack2(r2[c4 * 4], r2[c4 * 4 + 1]); sv[c4 >> 1][(c4 & 1) * 2 + 1] = pack2(r2[c4 * 4 + 2], r2[c4 * 4 + 3]); }
            *(u32x4*)srow = sv[0]; *(u32x4*)(srow + 8) = sv[1];
            { u32x4 e8;
#pragma unroll
              for (int c = 0; c < 4; ++c) { int pk = __builtin_amdgcn_cvt_pk_fp8_f32(r2[4 * c], r2[4 * c + 1], 0, false); pk = __builtin_amdgcn_cvt_pk_fp8_f32(r2[4 * c + 2], r2[4 * c + 3], pk, true); e8[c] = (unsigned)pk; }
              *(u32x4*)(p.ws + OFF_H + ((size_t)32 << 20) + (size_t)t * 1024 + col0) = e8; }
            if (lane == 0) ((float*)(p.ws + OFF_VSC))[t] = rstd;
        }
    }
}


#define XB_TMO      128
#define XB_XCNT(j)  (256  + 64 * (j))
#define XB_XSUB(j)  (1280 + 64 * (j))
#define XB_XGEN(j)  (2304 + 64 * (j))
#define XB_TOP      3328
#define XB_TOPGEN   3392
#define XCD_BAR_WORDS 3456
#define XB_SPIN_CAP (1u << 22)
#define LAS __attribute__((address_space(3)))
__device__ __forceinline__ unsigned xb_ld(unsigned* p)              { return __hip_atomic_load(p, __ATOMIC_RELAXED, __HIP_MEMORY_SCOPE_AGENT); }
__device__ __forceinline__ unsigned xb_add(unsigned* p, unsigned v) { return __hip_atomic_fetch_add(p, v, __ATOMIC_RELAXED, __HIP_MEMORY_SCOPE_AGENT); }
__device__ __forceinline__ unsigned xb_xcc_id() { return (unsigned)__builtin_amdgcn_s_getreg((3 << 11) | 20) & 0xFu; }
#define XB_SPIN(cond, bar) do { unsigned _sp = 0; while (cond) { __builtin_amdgcn_s_sleep(1); \
    if ((++_sp & 255u) == 0u) { if (xb_ld(&(bar)[XB_TMO])) break; if (_sp > XB_SPIN_CAP) { atomicAdd(&(bar)[XB_TMO], 1u); break; } } } } while (0)
struct XcdBarrier { unsigned* bar; unsigned x; volatile LAS unsigned* st; };
__device__ __forceinline__ XcdBarrier xcd_barrier_post(unsigned* bar, volatile LAS unsigned* st) {
    XcdBarrier b; b.bar = bar; b.x = xb_xcc_id(); b.st = st;
    if (threadIdx.x == 0) (void)xb_add(&bar[XB_XCNT(b.x)], 1u);
    return b;
}
__device__ __forceinline__ void xcd_barrier_complete(unsigned* bar, unsigned x, unsigned& nloc, unsigned& nx) {
    const unsigned G = gridDim.x * gridDim.y * gridDim.z;
    unsigned sum, cnt, mine, sp = 0u;
    for (;;) {
        sum = 0u; cnt = 0u; mine = 0u;
#pragma unroll
        for (unsigned j = 0; j < 16; ++j) { const unsigned c = xb_ld(&bar[XB_XCNT(j)]); sum += c; cnt += (c > 0u) ? 1u : 0u; mine = (j == x) ? c : mine; }
        if (sum == G) break;
        __builtin_amdgcn_s_sleep(1);
        if ((++sp & 255u) == 0u) { if (xb_ld(&bar[XB_TMO])) break; if (sp > XB_SPIN_CAP) { atomicAdd(&bar[XB_TMO], 1u); break; } }
    }
    nloc = mine > 0u ? mine : 1u; nx = cnt > 0u ? cnt : 1u;
}
__device__ __forceinline__ void xcd_barrier(const XcdBarrier& b) {
    asm volatile("s_waitcnt vmcnt(0)" ::: "memory");
    __syncthreads();
    if (threadIdx.x == 0) {
        unsigned* bar = b.bar;
        __builtin_amdgcn_s_waitcnt(0);
        unsigned nloc = b.st[0], nx = b.st[1];
        if (nloc == 0u) { xcd_barrier_complete(bar, b.x, nloc, nx); b.st[0] = nloc; b.st[1] = nx; }
        const unsigned old = xb_add(&bar[XB_XSUB(b.x)], 1u);
        const unsigned gen = old / nloc;
        if (old + 1u == (gen + 1u) * nloc) {
            __builtin_amdgcn_fence(__ATOMIC_RELEASE, "agent");
            asm volatile("s_waitcnt vmcnt(0)" ::: "memory");
            const unsigned og = xb_add(&bar[XB_TOP], 1u);
            const unsigned tg = og / nx;
            if (og + 1u == (tg + 1u) * nx) xb_add(&bar[XB_TOPGEN], 1u);
            else XB_SPIN(xb_ld(&bar[XB_TOPGEN]) == tg, bar);
            __builtin_amdgcn_fence(__ATOMIC_ACQUIRE, "agent");
            xb_add(&bar[XB_XGEN(b.x)], 1u);
            asm volatile("s_waitcnt vmcnt(0)" ::: "memory");
        } else {
            XB_SPIN(xb_ld(&bar[XB_XGEN(b.x)]) == gen, bar);
            __builtin_amdgcn_fence(__ATOMIC_ACQUIRE, "agent");
            asm volatile("s_waitcnt vmcnt(0)" ::: "memory");
        }
    }
    __syncthreads();
}

constexpr int NPHASE = 12;
__global__ void __launch_bounds__(512, 2) mega(Params p, int ph_lo, int ph_hi) {
    extern __shared__ __attribute__((aligned(16))) char smem_phys[];
    uint4& xb_words = *(uint4*)(smem_phys + kDynLds - 16);
    if (threadIdx.x == 0) xb_words = make_uint4(0u, 0u, 0u, 0u);
    __syncthreads();
    const XcdBarrier xbar = xcd_barrier_post((unsigned*)(p.ws + OFF_BAR), (volatile LAS unsigned*)&xb_words);
    char* smem = smem_phys + (threadIdx.x >> 8) * 65536;
    bf16_t* Rg = (bf16_t*)(p.ws + OFF_REGION);
    bf16_t* Hb = (bf16_t*)(p.ws + OFF_H);
#define PHASE(k, ...) if (ph_lo <= (k) && (k) < ph_hi) { __VA_ARGS__; if ((k) + 1 < ph_hi) xcd_barrier(xbar); }
    unsigned* sbctr = (unsigned*)(p.ws + OFF_BAR + 14336);
    PHASE(0,
        transpose_convert<true>(p.ab_w_in, (bf16_t*)(p.ws + OFF_WT_IN), 1024, AB_IN, AB_IN_PAD, smem, 0, p.norm_mix);
        convert_rows(p.x, (bf16_t*)(p.ws + OFF_S), (float*)(p.ws + OFF_VSC), smem))
    PHASE(1, phase_gemm_in8(p, smem_phys))
    PHASE(2, gla_prep(p, smem))
    PHASE(3, gla_scan(p, smem); sb_fast(p, smem_phys + 98304, sbctr);
        __syncthreads();
        quantize_tables_static(p, 64, smem);
        __syncthreads();
        transpose_convert(p.ab_w_out, (bf16_t*)(p.ws + OFF_WT_OUT), 1024, 1024, 1024, smem, 64);
        transpose_convert(p.c_w_in, (bf16_t*)(p.ws + OFF_WT_CIN), 1024, 4096, 4096, smem, 64, p.norm_mix + 1024, p.ws + OFF_SK_W8, 2048);
        transpose_convert(p.c_w_out, (bf16_t*)(p.ws + OFF_WT_COUT), 2048, 1024, 1024, smem, 64);
        fold_query_weights(p, 64))
    PHASE(4, phase_gemm_resid8(Rg + R_QSB, Rg + R_GG, 512, 512, (const bf16_t*)(p.ws + OFF_WT_OUT), 1024, nullptr, (bf16_t*)(p.ws + OFF_S), (float*)(p.ws + OFF_SSQ), p.ws + OFF_H, smem_phys))
    PHASE(5, phase_select8(p, 0, smem_phys))
    PHASE(6, peer_gather(p, 0, p.norm_mix + 1024, false, smem_phys))
    PHASE(7, phase_gemm_cin8_v(p, smem_phys))
    PHASE(8, phase_gemm_cin8_u(p, smem_phys))
    PHASE(9, phase_gemm_resid8(Rg, Rg, 2048, 2048, (const bf16_t*)(p.ws + OFF_WT_COUT), 2048, nullptr, (bf16_t*)(p.ws + OFF_S), (float*)(p.ws + OFF_SSQ), p.ws + OFF_H, smem_phys))
    PHASE(10, phase_select8(p, 1, smem_phys))
    PHASE(11, peer_gather(p, 1, p.final_norm, true, smem_phys))
}

extern "C" void kernel_launch(void* const* d_in, const int* in_sizes, int n_in, void* d_out, int out_size, void* d_ws, size_t ws_size, hipStream_t stream) {
    static int grid_blocks = 0;
    if (!grid_blocks) {
        int dev = 0, cus = 0, per_cu = 0;
        hipGetDevice(&dev);
        hipDeviceGetAttribute(&cus, hipDeviceAttributeMultiprocessorCount, dev);
        hipFuncSetAttribute((const void*)mega, hipFuncAttributeMaxDynamicSharedMemorySize, kDynLds);
        hipOccupancyMaxActiveBlocksPerMultiprocessor(&per_cu, mega, 512, kDynLds);
        if (per_cu < 1) per_cu = 1;
        if (per_cu > 1) per_cu = 1;
        grid_blocks = cus * per_cu;
        if (n_in != 18 || ws_size < WS_END) fprintf(stderr, "kernel_launch: unexpected n_in %d or ws_size %zu < %zu\n", n_in, ws_size, (size_t)WS_END);
    }
    Params p{};
    p.x = (const float*)d_in[0]; p.norm_mix = (const float*)d_in[1]; p.norm_ffn = (const float*)d_in[2]; p.ab_w_in = (const float*)d_in[3];
    p.ab_w_alpha2 = (const float*)d_in[4]; p.ab_b_alpha2 = (const float*)d_in[5]; p.ab_gla_norm = (const float*)d_in[6]; p.ab_w_out = (const float*)d_in[7];
    p.c_w_in = (const float*)d_in[8]; p.c_v_norm = (const float*)d_in[9]; p.c_w_spatial = (const float*)d_in[10]; p.c_b_spatial = (const float*)d_in[11];
    p.c_w_out = (const float*)d_in[12]; p.peer_w_q = (const float*)d_in[13]; p.peer_subkeys = (const float*)d_in[14]; p.peer_u = (const float*)d_in[15];
    p.peer_v = (const float*)d_in[16]; p.final_norm = (const float*)d_in[17];
    p.out = (float*)d_out; p.ws = (unsigned char*)d_ws;
    (void)hipMemsetAsync((char*)d_ws + OFF_BAR, 0, 16384, stream);
#if ONE_LAUNCH
    int lo = 0, hi = NPHASE;
    void* args[] = {&p, &lo, &hi};
    hipError_t e = hipLaunchCooperativeKernel((void*)mega, dim3(grid_blocks), dim3(512), args, kDynLds, stream);
    if (e != hipSuccess) fprintf(stderr, "cooperative launch failed: %s (grid %d)\n", hipGetErrorString(e), grid_blocks);
#else
    for (int ph = 0; ph < NPHASE; ++ph) hipLaunchKernelGGL(mega, dim3(grid_blocks), dim3(512), kDynLds, stream, p, ph, ph + 1);
#endif
}
```

```cpp
#include <hip/hip_runtime.h>
#include <cstdio>
#include <cstdint>

#ifndef ONE_LAUNCH
#define ONE_LAUNCH 1
#endif


#define VTID ((int)(threadIdx.x & 255))
#define VBID ((int)(blockIdx.x * 2 + (threadIdx.x >> 8)))
#define VGRID ((int)(gridDim.x * 2))
typedef unsigned short bf16_t;
typedef short bf16x8 __attribute__((ext_vector_type(8)));
typedef float f32x4 __attribute__((ext_vector_type(4)));
typedef unsigned u32x4 __attribute__((ext_vector_type(4)));
typedef __bf16 bf16x2_t __attribute__((ext_vector_type(2)));

constexpr int T = 32768, D = 1024, SEQ = 2048, NB = 16;
constexpr int AB_IN = 3088, AB_IN_PAD = 3200;
constexpr float EPS = 1e-6f;
constexpr int NEXP = 16384;
constexpr int kDynLds = 163840;

constexpr size_t SZ_WT_IN = (size_t)AB_IN_PAD * 1024 * 2;
constexpr size_t SZ_WT_OUT = (size_t)1024 * 1024 * 2;
constexpr size_t SZ_WT_CIN = (size_t)4096 * 1024 * 2;
constexpr size_t SZ_WT_COUT = (size_t)1024 * 2048 * 2;
constexpr size_t SZ_WT_Q = (size_t)2 * 2048 * 1024 * 2;
constexpr size_t SZ_SK = (size_t)2 * 8 * 2 * 128 * 128 * 2;
constexpr size_t SZ_TAB = (size_t)2 * NEXP * 1024;
constexpr size_t SZ_TSC = (size_t)2 * NEXP * 4;
constexpr size_t OFF_WT_IN = 0;
constexpr size_t OFF_WT_OUT = OFF_WT_IN + SZ_WT_IN;
constexpr size_t OFF_WT_CIN = OFF_WT_OUT + SZ_WT_OUT;
constexpr size_t OFF_WT_COUT = OFF_WT_CIN + SZ_WT_CIN;
constexpr size_t OFF_WT_Q = OFF_WT_COUT + SZ_WT_COUT;
constexpr size_t OFF_SK = OFF_WT_Q + SZ_WT_Q;
constexpr size_t OFF_UT = OFF_SK;
constexpr size_t OFF_USC = OFF_UT + SZ_TAB;
constexpr size_t OFF_VSC = OFF_USC + SZ_TSC;
constexpr size_t OFF_H = OFF_VSC + SZ_TSC;
constexpr size_t OFF_IDX = OFF_H + (size_t)T * 1024 * 2;
constexpr size_t OFF_GATE = OFF_IDX + (size_t)T * 128 * 4;
constexpr size_t OFF_SSQ = OFF_GATE + (size_t)T * 128 * 4;
constexpr size_t OFF_REGION = OFF_SSQ + (size_t)T * 32 * 4;
constexpr size_t SZ_REGION = (size_t)256 << 20;
constexpr size_t OFF_S = OFF_REGION + SZ_REGION;
constexpr size_t OFF_SK_W8 = OFF_S + (size_t)T * 1024 * 2;
constexpr size_t OFF_BAR = OFF_SK_W8 + (size_t)2048 * 1024;
constexpr size_t WS_END = OFF_BAR + 16384;
constexpr size_t R_QSB = 0;
constexpr size_t R_KSB = R_QSB + (size_t)T * 512;
constexpr size_t R_VTSB = R_KSB + (size_t)T * 512;
constexpr size_t R_QG = R_VTSB + (size_t)T * 512;
constexpr size_t R_KG = R_QG + (size_t)T * 256;
constexpr size_t R_VTG = R_KG + (size_t)T * 256;
constexpr size_t R_GG = R_VTG + (size_t)T * 512;
constexpr size_t R_ALR = R_GG + (size_t)T * 512;
constexpr size_t R_KOT = R_ALR + (size_t)T * 32;
constexpr size_t R_DEC = R_KOT + (size_t)T * 256;

struct Params {
    const float* x; const float* norm_mix; const float* norm_ffn; const float* ab_w_in; const float* ab_w_alpha2; const float* ab_b_alpha2;
    const float* ab_gla_norm; const float* ab_w_out; const float* c_w_in; const float* c_v_norm; const float* c_w_spatial; const float* c_b_spatial;
    const float* c_w_out; const float* peer_w_q; const float* peer_subkeys; const float* peer_u; const float* peer_v; const float* final_norm;
    float* out; unsigned char* ws;
};

__device__ __forceinline__ float bf2f(bf16_t v) { return __uint_as_float(((unsigned)v) << 16); }
__device__ __forceinline__ bf16_t f2bf(float f) { unsigned r; asm("v_cvt_pk_bf16_f32 %0, %1, %1" : "=v"(r) : "v"(f)); return (bf16_t)r; }
__device__ __forceinline__ unsigned pack2(float lo, float hi) { unsigned r; asm("v_cvt_pk_bf16_f32 %0, %1, %2" : "=v"(r) : "v"(lo), "v"(hi)); return r; }
__device__ __forceinline__ float lo2f(unsigned w) { return __uint_as_float(w << 16); }
__device__ __forceinline__ float hi2f(unsigned w) { return __uint_as_float(w & 0xffff0000u); }
__device__ __forceinline__ float dot2(unsigned a, unsigned b, float acc) { return __builtin_amdgcn_fdot2_f32_bf16(__builtin_bit_cast(bf16x2_t, a), __builtin_bit_cast(bf16x2_t, b), acc, false); }
#define GELU_C0 -1.0001451969146729f
#define GELU_C1 -1.1498452425003052f
#define GELU_C2 -0.46162763237953186f
#define GELU_C3 -0.051034148782491684f
#define GELU_C4 0.007168652955442667f
#define GELU_C5 -0.0006095620337873697f
#define GELU_C6 2.30170971917687e-05f
__device__ __forceinline__ float gelu_exact(float v) {
    const float a = fminf(fabsf(v), 6.0f);
    float q = GELU_C6 * a + GELU_C5; q = q * a + GELU_C4; q = q * a + GELU_C3; q = q * a + GELU_C2; q = q * a + GELU_C1; q = q * a + GELU_C0;
    return fmaxf(v, 0.f) - fabsf(v) * __builtin_amdgcn_exp2f(q);
}
typedef float f32x2 __attribute__((ext_vector_type(2)));
__device__ __forceinline__ f32x2 gelu_exact2(f32x2 v) {
    const f32x2 av = __builtin_elementwise_abs(v), a = __builtin_elementwise_min(av, (f32x2){6.0f, 6.0f});
    f32x2 q = (f32x2){GELU_C6, GELU_C6} * a + (f32x2){GELU_C5, GELU_C5};
    q = q * a + (f32x2){GELU_C4, GELU_C4}; q = q * a + (f32x2){GELU_C3, GELU_C3}; q = q * a + (f32x2){GELU_C2, GELU_C2};
    q = q * a + (f32x2){GELU_C1, GELU_C1}; q = q * a + (f32x2){GELU_C0, GELU_C0};
    const f32x2 e = {__builtin_amdgcn_exp2f(q[0]), __builtin_amdgcn_exp2f(q[1])};
    return __builtin_elementwise_max(v, (f32x2){0.f, 0.f}) - av * e;
}
__device__ __forceinline__ float row16_sum(float v) {
    v += __builtin_bit_cast(float, __builtin_amdgcn_update_dpp(0, __builtin_bit_cast(int, v), 0x128, 0xf, 0xf, false));
    v += __builtin_bit_cast(float, __builtin_amdgcn_update_dpp(0, __builtin_bit_cast(int, v), 0x124, 0xf, 0xf, false));
    v += __builtin_bit_cast(float, __builtin_amdgcn_update_dpp(0, __builtin_bit_cast(int, v), 0x122, 0xf, 0xf, false));
    v += __builtin_bit_cast(float, __builtin_amdgcn_update_dpp(0, __builtin_bit_cast(int, v), 0x121, 0xf, 0xf, false));
    return v;
}
__device__ __forceinline__ float wave_sum(float v) {
#pragma unroll
    for (int o = 32; o >= 1; o >>= 1) v += __shfl_xor(v, o);
    return v;
}

template <bool PERM_IN = false>
__device__ __forceinline__ void transpose_convert(const float* __restrict__ W, bf16_t* __restrict__ Wt, int K, int N, int Npad, char* smem, int vb0 = 0, const float* __restrict__ kgain = nullptr, unsigned char* __restrict__ W8 = nullptr, int f8from = 0) {
    float* tile = (float*)smem;
    const int tk = K / 64, tn = Npad / 64, ntile = tk * tn;
    const int tid = VTID;
    if (VBID < vb0) return;
    for (int tl = VBID - vb0; tl < ntile; tl += VGRID - vb0) {
        const int k0 = (tl % tk) * 64, n0 = (tl / tk) * 64;
        const int c = tid & 63, r0 = tid >> 6;
        int nd = n0;
        if (PERM_IN) { if (n0 >= 1024 && n0 < 1536) nd = n0 + 1024; else if (n0 >= 1536 && n0 < 2048) nd = n0 - 512; else if (n0 >= 2048 && n0 < 2560) nd = n0 + 512; else if (n0 >= 2560 && n0 < 3072) nd = n0 - 1024; }
#pragma unroll
        for (int i = 0; i < 16; ++i) {
            const int r = r0 + 4 * i;
            float v = (n0 + c < N) ? W[(size_t)(k0 + r) * N + n0 + c] : 0.f;
            if (kgain) v *= kgain[k0 + r];
            tile[c * 65 + r] = v;
        }
        __syncthreads();
#pragma unroll
        for (int i = 0; i < 16; ++i) {
            const int n = r0 + 4 * i;
            Wt[(size_t)(nd + n) * K + k0 + c] = f2bf(tile[n * 65 + c]);
            if (W8 && nd >= f8from) { const float w64 = tile[n * 65 + c] * 64.0f; W8[(size_t)(nd + n - f8from) * K + k0 + c] = (unsigned char)__builtin_amdgcn_cvt_pk_fp8_f32(w64, w64, 0, false); }
        }
        __syncthreads();
    }
}
__device__ __forceinline__ void dma16nt(const void* gsrc, unsigned lds_dst) {
    unsigned keep; const unsigned d = (unsigned)__builtin_amdgcn_readfirstlane((int)lds_dst);
    asm volatile("s_mov_b32 %0, m0\n\ts_mov_b32 m0, %2\n\ts_nop 0\n\tglobal_load_lds_dwordx4 %1, off nt\n\ts_mov_b32 m0, %0" : "=&s"(keep) : "v"(gsrc), "s"(d) : "memory");
}
__device__ __forceinline__ void quantize_tables_static(const Params& p, int vb0, char* smem) {
    const int lane = VTID & 63, wid = VTID >> 6;
    const char* ring = smem + wid * 16384; const unsigned ringb = (unsigned)(size_t)ring;
    if (VBID < vb0) return;
    for (unsigned task = (unsigned)(VBID - vb0); task < 1024u; task += (unsigned)(VGRID - vb0)) {
        const bool isv = task >= 512u;
        const int r0 = (int)(task & 511u) * 64 + wid * 16;
        const float* src = isv ? p.peer_v : p.peer_u;
        unsigned char* recs = p.ws + OFF_UT;
        _Float16* sct = (_Float16*)(p.ws + OFF_USC);
        auto issue = [&](int rr) {
            const char* gp = (const char*)(src + (size_t)(r0 + rr) * 1024) + lane * 16;
            const unsigned d = ringb + (unsigned)(rr & 3) * 4096u;
            dma16nt(gp, d); dma16nt(gp + 1024, d + 1024u); dma16nt(gp + 2048, d + 2048u); dma16nt(gp + 3072, d + 3072u);
        };
        asm volatile("s_waitcnt vmcnt(0)" ::: "memory");
        issue(0); issue(1); issue(2);
        for (int rr = 0; rr < 16; ++rr) {
            const int r = r0 + rr;
            if (rr + 3 < 16) { issue(rr + 3); asm volatile("s_waitcnt vmcnt(12)" ::: "memory"); }
            else if (rr == 13) asm volatile("s_waitcnt vmcnt(8)" ::: "memory");
            else if (rr == 14) asm volatile("s_waitcnt vmcnt(4)" ::: "memory");
            else asm volatile("s_waitcnt vmcnt(0)" ::: "memory");
            f32x4 v[4]; float aml = 0.f;
            const char* sl = ring + (rr & 3) * 4096 + lane * 16;
#pragma unroll
            for (int i = 0; i < 4; ++i) {
                v[i] = *(const f32x4*)(sl + i * 1024);
                aml = fmaxf(aml, fmaxf(fmaxf(fabsf(v[i][0]), fabsf(v[i][1])), fmaxf(fabsf(v[i][2]), fabsf(v[i][3]))));
            }
            asm volatile("s_waitcnt lgkmcnt(0)" ::: "memory");
#pragma unroll
            for (int o = 32; o >= 1; o >>= 1) aml = fmaxf(aml, __shfl_xor(aml, o));
            float ssq = 0.f;
#pragma unroll
            for (int i = 0; i < 4; ++i) ssq += (v[i][0] * v[i][0] + v[i][1] * v[i][1]) + (v[i][2] * v[i][2] + v[i][3] * v[i][3]);
            ssq = wave_sum(ssq);
            const float gmax = aml * (1.002f / 7.5f);
            const _Float16 hs = (_Float16)fminf(fmaxf(0.34f * sqrtf(ssq * (1.0f / 1024.0f)), 0.5f * gmax), gmax);
            const float gs_ = (float)hs, gi_ = gs_ > 0.f ? 1.0f / gs_ : 0.f;
            const int sgn = isv ? 0 : 8;
            unsigned char* rec = recs + (size_t)r * 1024 + (isv ? 512 : 0);
#pragma unroll
            for (int i = 0; i < 4; ++i) {
                unsigned wv = 0;
#pragma unroll
                for (int j = 0; j < 4; ++j) wv |= (unsigned)(min(15, max(0, __float2int_rn(v[i][j] * gi_ + 7.5f))) ^ sgn) << (8 * j);
                wv <<= (lane & 1) * 4;
                wv |= (unsigned)__shfl_xor((int)wv, 1);
                if ((lane & 1) == 0) *(unsigned*)(rec + 128 * i + (lane >> 1) * 4) = wv;
            }
            if (lane == 0) sct[(size_t)r * 2 + (isv ? 1 : 0)] = (_Float16)gs_;
        }
    }
}
__device__ __forceinline__ void convert_rows(const float* __restrict__ X, bf16_t* __restrict__ Xb, float* __restrict__ RSTD, char* smem) {
    int lz = 0; asm volatile("" : "+v"(lz));
    const int tidl = VTID + lz, lane = tidl & 63, wid = tidl >> 6;
    const int gw = VBID * 4 + wid, nw = VGRID * 4;
    const char* ring = smem + wid * 16384; const unsigned ringb = (unsigned)(size_t)ring;
    const int nrow = (T - gw + nw - 1) / nw;
    auto issue = [&](int k) {
        const char* gp = (const char*)(X + (size_t)(gw + k * nw) * D) + lane * 16;
        const unsigned d = ringb + (unsigned)(k & 3) * 4096u;
        dma16nt(gp, d); dma16nt(gp + 1024, d + 1024u); dma16nt(gp + 2048, d + 2048u); dma16nt(gp + 3072, d + 3072u);
    };
    asm volatile("s_waitcnt vmcnt(0)" ::: "memory");
    for (int k = 0; k < 3 && k < nrow; ++k) issue(k);
    for (int k = 0; k < nrow; ++k) {
        const int t = gw + k * nw;
        if (k + 3 < nrow) { issue(k + 3); asm volatile("s_waitcnt vmcnt(12)" ::: "memory"); }
        else asm volatile("s_waitcnt vmcnt(0)" ::: "memory");
        f32x4 v[4]; float ss = 0.f;
        const char* sl = ring + (k & 3) * 4096 + lane * 16;
#pragma unroll
        for (int i = 0; i < 4; ++i) { v[i] = *(const f32x4*)(sl + i * 1024); ss += (v[i][0] * v[i][0] + v[i][1] * v[i][1]) + (v[i][2] * v[i][2] + v[i][3] * v[i][3]); }
        asm volatile("s_waitcnt lgkmcnt(0)" ::: "memory");
        ss = wave_sum(ss);
#pragma unroll
        for (int i = 0; i < 4; ++i) { uint2 o; o.x = pack2(v[i][0], v[i][1]); o.y = pack2(v[i][2], v[i][3]); *(uint2*)(Xb + (size_t)t * D + i * 256 + lane * 4) = o; }
        if (lane == 0) RSTD[t] = rsqrtf(ss * (1.0f / D) + EPS);
    }
}
__device__ __forceinline__ void rmsnorm_rows(const float* __restrict__ X, const float* __restrict__ g, bf16_t* __restrict__ Hout) {
    const int lane = VTID & 63, wid = VTID >> 6;
    const int gw = VBID * 4 + wid, nw = VGRID * 4;
    for (int t = gw; t < T; t += nw) {
        const float* xr = X + (size_t)t * D;
        float4 v[4]; float ss = 0.f;
#pragma unroll
        for (int i = 0; i < 4; ++i) { v[i] = *(const float4*)(xr + i * 256 + lane * 4); ss += v[i].x * v[i].x + v[i].y * v[i].y + v[i].z * v[i].z + v[i].w * v[i].w; }
        ss = wave_sum(ss);
        const float rstd = rsqrtf(ss * (1.0f / D) + EPS);
#pragma unroll
        for (int i = 0; i < 4; ++i) {
            const float4 gg = *(const float4*)(g + i * 256 + lane * 4);
            uint2 o; o.x = pack2(v[i].x * rstd * gg.x, v[i].y * rstd * gg.y); o.y = pack2(v[i].z * rstd * gg.z, v[i].w * rstd * gg.w);
            *(uint2*)(Hout + (size_t)t * D + i * 256 + lane * 4) = o;
        }
    }
}

__device__ __forceinline__ void store_bf16x4(bf16_t* p, f32x4 v) { uint2 o; o.x = pack2(v[0], v[1]); o.y = pack2(v[2], v[3]); *(uint2*)p = o; }

#define G8_LAS __attribute__((address_space(3)))
namespace g8 {
constexpr int BM = 256, BK = 64, HALF = 128, HTB = HALF * BK * 2, NXCD = 8, WGM = 8;
__device__ __forceinline__ int lds_byte(int r, int c) { const int st = (r >> 4) * 2 + (c >> 5), rr = r & 15, cc = c & 31, ob = rr * 64 + cc * 2; return st * 1024 + (ob ^ (((ob >> 9) & 1) << 5)); }
__device__ __forceinline__ void stage_rc(int b, int& R, int& C) { const int st = b / 1024, sb = b % 1024, swz = sb ^ (((sb >> 9) & 1) << 5); R = (st >> 1) * 16 + swz / 64; C = (st & 1) * 32 + (swz % 64) / 2; }
__device__ __forceinline__ int perm32(int rho) { const int n = rho >> 4, i = rho & 15; return 8 * (i >> 2) + 4 * n + (i & 3); }
struct Unit { int pm, pn; };
struct Gemm { const bf16_t* A0; const bf16_t* A1; int lda, ksplit; const bf16_t* Bt; int M, N, K; };
struct StaticOrder {
    int nM, nN, nwg, G, c;
    __device__ __forceinline__ void init(int M, int N, int G_, int c_) { nM = M / BM; nN = N / BM; nwg = nM * nN; G = G_; c = c_; }
    __device__ __forceinline__ bool next(int i, Unit& u) const {
        const int L = i * G + c; if (L >= nwg) return false;
        int wgid = L; { const int q = nwg / NXCD, r = nwg % NXCD, xcd = wgid % NXCD, off = wgid / NXCD; wgid = (xcd < r ? xcd * (q + 1) : r * (q + 1) + (xcd - r) * q) + off; }
        const int nig = WGM * nN, gid = wgid / nig, fm = gid * WGM, gsz = (nM - fm) < WGM ? (nM - fm) : WGM;
        u.pm = fm + ((wgid % nig) % gsz); u.pn = (wgid % nig) / gsz; return true;
    }
};
typedef int i32x4v __attribute__((ext_vector_type(4)));
typedef int i32x8v __attribute__((ext_vector_type(8)));
template <class Epi, bool F8 = false>
__device__ __forceinline__ void gemm_phase(G8_LAS unsigned char* lds, const Gemm g, const StaticOrder& S, const Epi& E) {
    const int tid = threadIdx.x, wid = __builtin_amdgcn_readfirstlane(tid >> 6), lane = tid & 63, wr = wid >> 2, wc = wid & 3, fr = lane & 15, fq = lane >> 4;
    const int K = g.K, nt = K / BK, lda = g.lda;
    unsigned voffA[2], voffB[2];
#pragma unroll
    for (int i = 0; i < 2; ++i) { int R, C; stage_rc(tid * 16 + i * 8192, R, C); const int Rb = (R & ~31) + perm32(R & 31);
        voffA[i] = (unsigned)(R * lda + C) * 2u; voffB[i] = (unsigned)(Rb * K + C) * 2u; }
    const size_t hstepA = (size_t)HALF * lda * 2, hstepB = (size_t)HALF * K * 2;
    const unsigned ldsw = (unsigned)wid * 1024u;
    const unsigned ldsbase = (unsigned)__builtin_amdgcn_readfirstlane((int)(unsigned)(__SIZE_TYPE__)lds);
    const int fcol = F8 ? 32 * (fq >> 1) + 24 * (fq & 1) : fq * 8;
    const int aoff = lds_byte(wr * 64 + fr, fcol), boff = lds_byte(wc * 32 + fr, fcol);
    const int aoff2 = F8 ? (aoff ^ 16) : aoff + 1024, boff2 = F8 ? (boff ^ 16) : boff + 1024;
    auto aptr = [&](int pm, int kt) -> const char* { const int kb = kt * BK; const bf16_t* b = kb < g.ksplit ? g.A0 + kb : g.A1 + (kb - g.ksplit); return (const char*)b + (size_t)pm * 2 * hstepA; };
    auto bptr = [&](int pn, int kt) -> const char* { return (const char*)(g.Bt + kt * BK) + (size_t)pn * 2 * hstepB; };
#define G8_SA(b, h) (((b) * 2 + (h)) * HTB)
#define G8_SB(b, h) ((4 + (b) * 2 + (h)) * HTB)
#define G8_STAGE(bufoff, gbase, voff) do { _Pragma("unroll") for (int _i = 0; _i < 2; ++_i) { \
        if constexpr (F8) { unsigned _keep; const unsigned _d = ldsbase + (unsigned)(bufoff) + ldsw + _i * 8192u; \
            const char* _gb = (const char*)(gbase) + (size_t)_i * ((voff) == voffA ? hstepA : hstepB) / 2;        \
            asm volatile("s_mov_b32 %0, m0\n\ts_mov_b32 m0, %3\n\ts_nop 0\n\tglobal_load_lds_dwordx4 %1, %2\n\ts_mov_b32 m0, %0" : "=&s"(_keep) : "v"((voff)[0]), "s"(_gb), "s"(_d) : "memory"); } \
        else __builtin_amdgcn_global_load_lds((const unsigned*)((const char*)(gbase) + (voff)[_i]), (G8_LAS unsigned*)(lds + (bufoff) + ldsw + _i * 8192), 16, 0, 0); } } while (0)
#define G8_LD1(d16, d32, addr0, addr1) do { if constexpr (F8) { const i32x4v _lo = *(const G8_LAS i32x4v*)(addr0), _hi = *(const G8_LAS i32x4v*)(addr1); \
            d32 = __builtin_shufflevector(_lo, _hi, 0, 1, 2, 3, 4, 5, 6, 7); } \
        else { d16[0] = *(const G8_LAS bf16x8*)(addr0); d16[1] = *(const G8_LAS bf16x8*)(addr1); } } while (0)
#define G8_LDA(dst, b, h) do { _Pragma("unroll") for (int m = 0; m < 4; ++m) G8_LD1(dst[m], dst##8[m], lds + G8_SA(b, h) + aoff + m * 2048, lds + G8_SA(b, h) + aoff2 + m * 2048); } while (0)
#define G8_LDB(dst, b, h) do { _Pragma("unroll") for (int n = 0; n < 2; ++n) G8_LD1(dst[n], dst##8[n], lds + G8_SB(b, h) + boff + n * 2048, lds + G8_SB(b, h) + boff2 + n * 2048); } while (0)
#define G8_MMA(ai, bj, At, Bt) do { __builtin_amdgcn_s_setprio(1); _Pragma("unroll") for (int m = 0; m < 4; ++m) _Pragma("unroll") for (int n = 0; n < 2; ++n) { \
        if constexpr (F8) acc[ai][bj][m][n] = __builtin_amdgcn_mfma_scale_f32_16x16x128_f8f6f4(Bt##8[n], At##8[m], acc[ai][bj][m][n], 0, 0, 0, sc1, 0, sc1); \
        else { _Pragma("unroll") for (int k = 0; k < 2; ++k) acc[ai][bj][m][n] = __builtin_amdgcn_mfma_f32_16x16x32_bf16(Bt[n][k], At[m][k], acc[ai][bj][m][n], 0, 0, 0); } } \
        __builtin_amdgcn_s_setprio(0); } while (0)
#define G8_WAIT_V(n) asm volatile("s_waitcnt vmcnt(" #n ")" ::: "memory")
#define G8_WAIT_L(n) asm volatile("s_waitcnt lgkmcnt(" #n ")" ::: "memory")
#define G8_BAR __builtin_amdgcn_s_barrier()
#define G8_SCHED __builtin_amdgcn_sched_barrier(0)
    Unit cur, nxt; int ui = 0;
    if (!S.next(0, cur)) return;
    int sc1 = 0x7f7f7f7f; asm volatile("" : "+v"(sc1));
    f32x4 acc[2][2][4][2];
#pragma unroll
    for (int a = 0; a < 2; ++a)
#pragma unroll
        for (int b = 0; b < 2; ++b)
#pragma unroll
            for (int m = 0; m < 4; ++m)
#pragma unroll
                for (int n = 0; n < 2; ++n) acc[a][b][m][n] = (f32x4){0.f, 0.f, 0.f, 0.f};
    bf16x8 At[4][2], B0[2][2], B1[2][2];
    i32x8v At8[4], B08[2], B18[2];
    {
        const char* cA = aptr(cur.pm, 0); const char* cB = bptr(cur.pn, 0); const char* cA1 = aptr(cur.pm, 1); const char* cB1 = bptr(cur.pn, 1);
        G8_STAGE(G8_SB(0, 0), cB, voffB); G8_STAGE(G8_SB(0, 1), cB + hstepB, voffB); G8_STAGE(G8_SA(0, 0), cA, voffA); G8_STAGE(G8_SA(0, 1), cA + hstepA, voffA);
        if (wr == 1) G8_BAR;
        G8_WAIT_V(2); G8_BAR;
        G8_STAGE(G8_SB(1, 0), cB1, voffB); G8_STAGE(G8_SA(1, 0), cA1, voffA); G8_STAGE(G8_SB(1, 1), cB1 + hstepB, voffB);
        G8_WAIT_V(6); G8_BAR;
    }
    for (;;) {
        const bool has_next = S.next(ui + 1, nxt);
        const int npm = has_next ? nxt.pm : cur.pm, npn = has_next ? nxt.pn : cur.pn;
#pragma unroll 1
        for (int t = 0; t < nt; t += 2) {
            const bool last = (t == nt - 2);
            const char* a1 = aptr(cur.pm, t + 1);
            const char* a2 = last ? aptr(npm, 0) : aptr(cur.pm, t + 2); const char* b2 = last ? bptr(npn, 0) : bptr(cur.pn, t + 2);
            const char* a3 = last ? aptr(npm, 1) : aptr(cur.pm, t + 3); const char* b3 = last ? bptr(npn, 1) : bptr(cur.pn, t + 3);
            G8_LDB(B0, 0, 0); G8_LDB(B1, 0, 1); G8_SCHED; G8_LDA(At, 0, 0); G8_STAGE(G8_SA(1, 1), a1 + hstepA, voffA);
            G8_WAIT_V(8); G8_WAIT_L(0); G8_BAR; G8_MMA(0, 0, At, B0); G8_MMA(0, 1, At, B1); G8_BAR; G8_SCHED;
            G8_LDA(At, 0, 1); G8_STAGE(G8_SB(0, 0), b2, voffB); G8_STAGE(G8_SB(0, 1), b2 + hstepB, voffB); G8_STAGE(G8_SA(0, 0), a2, voffA);
            G8_WAIT_V(8); G8_WAIT_L(0); G8_BAR; G8_MMA(1, 0, At, B0); G8_MMA(1, 1, At, B1); G8_BAR; G8_SCHED;
            G8_LDB(B0, 1, 0); G8_LDB(B1, 1, 1); G8_SCHED; G8_LDA(At, 1, 0); G8_STAGE(G8_SA(0, 1), a2 + hstepA, voffA);
            G8_WAIT_V(8); G8_WAIT_L(0); G8_BAR; G8_MMA(0, 0, At, B0); G8_MMA(0, 1, At, B1); G8_BAR; G8_SCHED;
            G8_LDA(At, 1, 1); G8_STAGE(G8_SB(1, 0), b3, voffB); G8_STAGE(G8_SB(1, 1), b3 + hstepB, voffB); G8_STAGE(G8_SA(1, 0), a3, voffA);
            G8_WAIT_V(8); G8_WAIT_L(0); G8_BAR; G8_MMA(1, 0, At, B0); G8_MMA(1, 1, At, B1); G8_BAR; G8_SCHED;
        }
        if (wr == 0) G8_BAR;
        E(acc, cur, wr, wc, fr, fq);
        if (!has_next) break;
#pragma unroll
        for (int a = 0; a < 2; ++a)
#pragma unroll
            for (int b = 0; b < 2; ++b)
#pragma unroll
                for (int m = 0; m < 4; ++m)
#pragma unroll
                    for (int n = 0; n < 2; ++n) acc[a][b][m][n] = (f32x4){0.f, 0.f, 0.f, 0.f};
        cur = nxt; ++ui;
        if (wr == 1) G8_BAR;
    }
    G8_WAIT_V(0);
    G8_BAR;
#undef G8_SA
#undef G8_SB
#undef G8_STAGE
#undef G8_LDA
#undef G8_LDB
#undef G8_MMA
#undef G8_LD1
#undef G8_WAIT_V
#undef G8_WAIT_L
#undef G8_BAR
#undef G8_SCHED
}
struct EpiResid {
    const float* R32; bf16_t* S; float* SSQP; unsigned char* S8;
    __device__ __forceinline__ void operator()(const f32x4 (&acc)[2][2][4][2], const Unit& u, int wr, int wc, int fr, int fq) const {
#pragma unroll
        for (int ai = 0; ai < 2; ++ai)
#pragma unroll
            for (int m = 0; m < 4; ++m) {
                const int row = u.pm * 256 + ai * 128 + wr * 64 + m * 16 + fr;
                const size_t o = (size_t)row * 1024 + u.pn * 256 + wc * 32 + fq * 8;
                float ss = 0.f;
#pragma unroll
                for (int bj = 0; bj < 2; ++bj) {
                    f32x4 a, b;
                    if (R32) { a = *(const f32x4*)(R32 + o + bj * 128); b = *(const f32x4*)(R32 + o + bj * 128 + 4); }
                    else { const u32x4 r = *(const u32x4*)(S + o + bj * 128); a = (f32x4){lo2f(r[0]), hi2f(r[0]), lo2f(r[1]), hi2f(r[1])}; b = (f32x4){lo2f(r[2]), hi2f(r[2]), lo2f(r[3]), hi2f(r[3])}; }
                    a += acc[ai][bj][m][0]; b += acc[ai][bj][m][1];
                    ss += a[0] * a[0] + a[1] * a[1] + a[2] * a[2] + a[3] * a[3] + b[0] * b[0] + b[1] * b[1] + b[2] * b[2] + b[3] * b[3];
                    uint4 w; w.x = pack2(a[0], a[1]); w.y = pack2(a[2], a[3]); w.z = pack2(b[0], b[1]); w.w = pack2(b[2], b[3]);
                    *(uint4*)(S + o + bj * 128) = w;
                    { int p0 = __builtin_amdgcn_cvt_pk_fp8_f32(a[0], a[1], 0, false); p0 = __builtin_amdgcn_cvt_pk_fp8_f32(a[2], a[3], p0, true);
                      int p1 = __builtin_amdgcn_cvt_pk_fp8_f32(b[0], b[1], 0, false); p1 = __builtin_amdgcn_cvt_pk_fp8_f32(b[2], b[3], p1, true);
                      *(uint2*)(S8 + o + bj * 128) = make_uint2((unsigned)p0, (unsigned)p1); }
                }
                ss += __shfl_xor(ss, 16); ss += __shfl_xor(ss, 32);
                if (fq == 0) SSQP[(size_t)row * 32 + u.pn * 4 + wc] = ss;
            }
    }
};
struct EpiCinUS {
    bf16_t* U; const bf16_t* VT; const float* SSQ; const float* Wsp; const float* bsp; const float* vnorm; G8_LAS unsigned char* L; const float* RSTD;
    __device__ __forceinline__ void operator()(const f32x4 (&acc)[2][2][4][2], const Unit& u, int wr, int wc, int fr_, int fq_) const {
        int lz = 0; asm volatile("" : "+v"(lz));
        const int tid = (int)threadIdx.x + lz, fr = tid & 15, fq = (tid >> 4) & 3, g = u.pn; (void)fr_; (void)fq_;
        G8_LAS float* RS = (G8_LAS float*)(L + 24576);
        unsigned gu[2][2][4][4];
#pragma unroll
        for (int ai = 0; ai < 2; ++ai)
#pragma unroll
            for (int bj = 0; bj < 2; ++bj)
#pragma unroll
                for (int m = 0; m < 4; ++m) {
                    const float rs = RSTD[u.pm * 256 + ai * 128 + wr * 64 + m * 16 + fr];
                    const f32x4 a = acc[ai][bj][m][0] * rs, b = acc[ai][bj][m][1] * rs;
                    const f32x2 g0 = gelu_exact2((f32x2){a[0], a[1]}), g1 = gelu_exact2((f32x2){a[2], a[3]}), g2 = gelu_exact2((f32x2){b[0], b[1]}), g3 = gelu_exact2((f32x2){b[2], b[3]});
                    gu[ai][bj][m][0] = pack2(g0[0], g0[1]); gu[ai][bj][m][1] = pack2(g1[0], g1[1]); gu[ai][bj][m][2] = pack2(g2[0], g2[1]); gu[ai][bj][m][3] = pack2(g3[0], g3[1]);
                }
        if (tid < 256) {
            const float* sp = SSQ + (size_t)(u.pm * 256 + tid) * 32;
            f32x4 s4 = *(const f32x4*)sp;
#pragma unroll
            for (int i = 1; i < 8; ++i) s4 += *(const f32x4*)(sp + 4 * i);
            RS[tid] = rsqrtf(((s4[0] + s4[1]) + (s4[2] + s4[3])) * (1.0f / 2048.0f) + EPS);
        }
        __syncthreads();
#pragma unroll
        for (int ai = 0; ai < 2; ++ai) {
            const int chunk = u.pm * 2 + ai;
            {
                const int t1 = tid >> 3, c1 = tid & 7;
#pragma unroll
                for (int part = 0; part < 3; ++part) {
                    const int t = part == 0 ? t1 : 64 + ((tid + (part - 1) * 512) >> 4), ch = part == 0 ? c1 : ((tid + (part - 1) * 512) & 15), s0 = ch * 8;
                    const float* wp = Wsp + (size_t)(g * 128 + t) * 128 + s0;
                    const f32x4 w0 = *(const f32x4*)wp, w1 = *(const f32x4*)(wp + 4);
                    const f32x4 r0 = *(const G8_LAS f32x4*)(RS + ai * 128 + s0), r1 = *(const G8_LAS f32x4*)(RS + ai * 128 + s0 + 4);
                    float v[8];
#pragma unroll
                    for (int j = 0; j < 4; ++j) { v[j] = (s0 + j <= t) ? w0[j] * r0[j] : 0.f; v[4 + j] = (s0 + 4 + j <= t) ? w1[j] * r1[j] : 0.f; }
                    u32x4 o; o.x = pack2(v[0], v[1]); o.y = pack2(v[2], v[3]); o.z = pack2(v[4], v[5]); o.w = pack2(v[6], v[7]);
                    const int off = part == 0 ? t * 128 + ((ch ^ (t & 7)) << 4) : 8192 + (t - 64) * 256 + ((ch ^ (t & 7)) << 4);
                    *(G8_LAS u32x4*)(L + off) = o;
                }
            }
            __syncthreads();
            float bias[4];
#pragma unroll
            for (int m = 0; m < 4; ++m) bias[m] = bsp[g * 128 + wr * 64 + m * 16 + fr];
#pragma unroll
            for (int bj = 0; bj < 2; ++bj) {
                f32x4 mac[4][2];
#pragma unroll
                for (int m = 0; m < 4; ++m)
#pragma unroll
                    for (int n = 0; n < 2; ++n) mac[m][n] = (f32x4){0.f, 0.f, 0.f, 0.f};
                const int cb = u.pn * 256 + bj * 128 + wc * 32;
                const bf16_t* vrow0 = VT + ((size_t)chunk * 2048 + cb + perm32(fr)) * 128 + fq * 8;
                const bf16_t* vrow1 = VT + ((size_t)chunk * 2048 + cb + perm32(16 + fr)) * 128 + fq * 8;
                bf16x8 bf0[4], bf1[4];
#pragma unroll
                for (int kk = 0; kk < 4; ++kk) { if (kk < 2 || wr == 1) { bf0[kk] = *(const bf16x8*)(vrow0 + kk * 32); bf1[kk] = *(const bf16x8*)(vrow1 + kk * 32); } }
#pragma unroll
                for (int kk = 0; kk < 4; ++kk) {
                    if (kk < 2 || wr == 1) {
                        bf16x8 af[4];
#pragma unroll
                        for (int m = 0; m < 4; ++m) {
                            const int t = wr * 64 + m * 16 + fr, chn = kk * 4 + fq;
                            const int off = wr == 0 ? t * 128 + ((chn ^ (t & 7)) << 4) : 8192 + (t - 64) * 256 + ((chn ^ (t & 7)) << 4);
                            af[m] = *(const G8_LAS bf16x8*)(L + off);
                        }
#pragma unroll
                        for (int m = 0; m < 4; ++m) {
                            mac[m][0] = __builtin_amdgcn_mfma_f32_16x16x32_bf16(bf0[kk], af[m], mac[m][0], 0, 0, 0);
                            mac[m][1] = __builtin_amdgcn_mfma_f32_16x16x32_bf16(bf1[kk], af[m], mac[m][1], 0, 0, 0);
                        }
                    }
                }
                const f32x4 vn0 = *(const f32x4*)(vnorm + cb + fq * 8), vn1 = *(const f32x4*)(vnorm + cb + fq * 8 + 4);
#pragma unroll
                for (int m = 0; m < 4; ++m) {
                    const f32x4 x0 = vn0 * mac[m][0] + bias[m], x1 = vn1 * mac[m][1] + bias[m];
                    const unsigned q0 = gu[ai][bj][m][0], q1 = gu[ai][bj][m][1], q2 = gu[ai][bj][m][2], q3 = gu[ai][bj][m][3];
                    uint4 o; o.x = pack2(lo2f(q0) * x0[0], hi2f(q0) * x0[1]); o.y = pack2(lo2f(q1) * x0[2], hi2f(q1) * x0[3]); o.z = pack2(lo2f(q2) * x1[0], hi2f(q2) * x1[1]); o.w = pack2(lo2f(q3) * x1[2], hi2f(q3) * x1[3]);
                    *(uint4*)(U + (size_t)(u.pm * 256 + ai * 128 + wr * 64 + m * 16 + fr) * 2048 + cb + fq * 8) = o;
                }
            }
            __syncthreads();
        }
    }
};
struct EpiCinV {
    bf16_t* VT; float* SSQ; const float* RSTD;
    __device__ __forceinline__ void operator()(const f32x4 (&acc)[2][2][4][2], const Unit& u, int wr, int wc, int fr_, int fq_) const {
        int lz = 0; asm volatile("" : "+v"(lz));
        const int lane_ = (int)(threadIdx.x & 63) + lz, fr = lane_ & 15, fq = lane_ >> 4; (void)fr_; (void)fq_;
        f32x4 rs[2][2];
#pragma unroll
        for (int bj = 0; bj < 2; ++bj)
#pragma unroll
            for (int n = 0; n < 2; ++n) rs[bj][n] = *(const f32x4*)(RSTD + u.pn * 256 + bj * 128 + wc * 32 + fq * 8 + n * 4) * (1.0f / 64.0f);
#pragma unroll
        for (int ai = 0; ai < 2; ++ai) {
            float ss[16];
#pragma unroll
            for (int i = 0; i < 16; ++i) ss[i] = 0.f;
#pragma unroll
            for (int m = 0; m < 4; ++m) {
                const int c = u.pm * 256 + ai * 128 + wr * 64 + m * 16 + fr;
#pragma unroll
                for (int bj = 0; bj < 2; ++bj) {
                    float g[8];
#pragma unroll
                    for (int n = 0; n < 2; ++n)
#pragma unroll
                        for (int r = 0; r < 4; r += 2) {
                            const f32x2 x = gelu_exact2((f32x2){acc[ai][bj][m][n][r] * rs[bj][n][r], acc[ai][bj][m][n][r + 1] * rs[bj][n][r + 1]});
                            g[n * 4 + r] = x[0]; g[n * 4 + r + 1] = x[1]; ss[bj * 8 + n * 4 + r] += x[0] * x[0]; ss[bj * 8 + n * 4 + r + 1] += x[1] * x[1];
                        }
                    uint4 o; o.x = pack2(g[0], g[1]); o.y = pack2(g[2], g[3]); o.z = pack2(g[4], g[5]); o.w = pack2(g[6], g[7]);
                    *(uint4*)(VT + ((size_t)(u.pn * 2 + bj) * 2048 + c) * 128 + wc * 32 + fq * 8) = o;
                }
            }
            float mine = 0.f;
#pragma unroll
            for (int i = 0; i < 16; ++i) { const float s = row16_sum(ss[i]); mine = (fr == i) ? s : mine; }
            const int tok = u.pn * 256 + (fr >> 3) * 128 + wc * 32 + fq * 8 + (fr & 7);
            SSQ[(size_t)tok * 32 + u.pm * 4 + ai * 2 + wr] = mine;
        }
    }
};
struct EpiInN {
    bf16_t* R; const float* RSTD;
    __device__ __forceinline__ void operator()(const f32x4 (&acc)[2][2][4][2], const Unit& u, int wr, int wc, int fr, int fq) const {
        bf16_t* base; int pitch; float sc = 1.0f;
        if (u.pn < 2) { base = R + R_QSB + u.pn * 256; pitch = 512; sc = 0.125f; }
        else if (u.pn < 4) { base = R + R_KSB + (u.pn - 2) * 256; pitch = 512; }
        else if (u.pn == 4) { base = R + R_QG; pitch = 256; }
        else if (u.pn == 5) { base = R + R_KG; pitch = 256; }
        else { base = R + R_GG + (u.pn - 6) * 256; pitch = 512; }
#pragma unroll
        for (int ai = 0; ai < 2; ++ai)
#pragma unroll
            for (int m = 0; m < 4; ++m) {
                const int row = u.pm * 256 + ai * 128 + wr * 64 + m * 16 + fr;
                bf16_t* rp = base + (size_t)row * pitch + wc * 32 + fq * 8;
                const float rsc = sc * RSTD[row];
#pragma unroll
                for (int bj = 0; bj < 2; ++bj) {
                    f32x4 a = acc[ai][bj][m][0] * rsc, b = acc[ai][bj][m][1] * rsc;
                    if (u.pn >= 6) {
#pragma unroll
                        for (int r = 0; r < 4; ++r) { a[r] = a[r] * __builtin_amdgcn_rcpf(1.0f + __expf(-a[r])); b[r] = b[r] * __builtin_amdgcn_rcpf(1.0f + __expf(-b[r])); }
                    }
                    uint4 o; o.x = pack2(a[0], a[1]); o.y = pack2(a[2], a[3]); o.z = pack2(b[0], b[1]); o.w = pack2(b[2], b[3]);
                    *(uint4*)(rp + bj * 128) = o;
                }
            }
    }
};
struct EpiInT {
    bf16_t* R; const float* RSTD;
    __device__ __forceinline__ void operator()(const f32x4 (&acc)[2][2][4][2], const Unit& u, int wr, int wc, int fr, int fq) const {
#pragma unroll
        for (int ai = 0; ai < 2; ++ai)
#pragma unroll
            for (int m = 0; m < 4; ++m) {
                const int c = u.pm * 256 + ai * 128 + wr * 64 + m * 16 + fr;
#pragma unroll
                for (int bj = 0; bj < 2; ++bj) {
                    const int t = u.pn * 256 + bj * 128 + wc * 32 + fq * 8, b = t >> 11, s = t & 2047;
                    bf16_t* dst;
                    if (c < 512) dst = R + R_VTSB + ((size_t)((b * 8 + (c >> 6)) * 64 + (c & 63))) * 2048 + s;
                    else { const int c2 = c - 512; dst = R + R_VTG + ((size_t)((b * 4 + (c2 >> 7)) * 128 + (c2 & 127))) * 2048 + s; }
                    const f32x4 a = acc[ai][bj][m][0] * *(const f32x4*)(RSTD + t), bb = acc[ai][bj][m][1] * *(const f32x4*)(RSTD + t + 4);
                    uint4 o; o.x = pack2(a[0], a[1]); o.y = pack2(a[2], a[3]); o.z = pack2(bb[0], bb[1]); o.w = pack2(bb[2], bb[3]);
                    *(uint4*)dst = o;
                }
            }
    }
};
}
__device__ __forceinline__ void phase_gemm_resid8(const bf16_t* A0, const bf16_t* A1, int lda, int ksplit, const bf16_t* Bt, int K, const float* R32, bf16_t* Sres, float* SSQP, unsigned char* S8, char* smem_phys) {
    g8::Gemm g{A0, A1, lda, ksplit, Bt, T, 1024, K};
    g8::StaticOrder S; S.init(T, 1024, (int)gridDim.x, (int)blockIdx.x);
    g8::EpiResid E{R32, Sres, SSQP, S8};
    g8::gemm_phase<g8::EpiResid>((G8_LAS unsigned char*)smem_phys, g, S, E);
}

__device__ __forceinline__ void phase_gemm_cin8_v(const Params& p, char* smem_phys) {
    bf16_t* U = (bf16_t*)(p.ws + OFF_REGION); bf16_t* VT = U + (size_t)T * 2048; float* SSQ = (float*)(p.ws + OFF_SSQ);
    const bf16_t* Wv = (const bf16_t*)(p.ws + OFF_SK_W8); const bf16_t* H8 = (const bf16_t*)(p.ws + OFF_H + ((size_t)32 << 20));
    g8::Gemm g{Wv, Wv, 512, 512, H8, 2048, T, 512};
    g8::StaticOrder S; S.init(2048, T, (int)gridDim.x, (int)blockIdx.x);
    g8::EpiCinV E{VT, SSQ, (const float*)(p.ws + OFF_VSC)};
    g8::gemm_phase<g8::EpiCinV, true>((G8_LAS unsigned char*)smem_phys, g, S, E);
}
__device__ __forceinline__ void phase_gemm_cin8_u(const Params& p, char* smem_phys) {
    const bf16_t* H = (const bf16_t*)(p.ws + OFF_S); const bf16_t* W = (const bf16_t*)(p.ws + OFF_WT_CIN);
    bf16_t* U = (bf16_t*)(p.ws + OFF_REGION); bf16_t* VT = U + (size_t)T * 2048; float* SSQ = (float*)(p.ws + OFF_SSQ);
    g8::Gemm g{H, H, 1024, 1024, W, T, 2048, 1024};
    g8::StaticOrder S; S.init(T, 2048, (int)gridDim.x, (int)blockIdx.x);
    g8::EpiCinUS E{U, VT, SSQ, p.c_w_spatial, p.c_b_spatial, p.c_v_norm, (G8_LAS unsigned char*)(smem_phys + 131072), (const float*)(p.ws + OFF_VSC)};
    g8::gemm_phase<g8::EpiCinUS>((G8_LAS unsigned char*)smem_phys, g, S, E);
}
__device__ __forceinline__ void phase_gemm_in8(const Params& p, char* smem_phys) {
    const bf16_t* H = (const bf16_t*)(p.ws + OFF_S); const bf16_t* W = (const bf16_t*)(p.ws + OFF_WT_IN);
    bf16_t* R = (bf16_t*)(p.ws + OFF_REGION);
    {
        g8::Gemm g{H, H, 1024, 1024, W, T, 2048, 1024};
        g8::StaticOrder S; S.init(T, 2048, (int)gridDim.x, (int)blockIdx.x);
        g8::EpiInN E{R, (const float*)(p.ws + OFF_VSC)};
        g8::gemm_phase<g8::EpiInN>((G8_LAS unsigned char*)smem_phys, g, S, E);
    }
    {
        const bf16_t* Wv = W + (size_t)2048 * 1024;
        g8::Gemm g{Wv, Wv, 1024, 1024, H, 1024, T, 1024};
        g8::StaticOrder S; S.init(1024, T, (int)gridDim.x, (int)blockIdx.x);
        g8::EpiInT E{R, (const float*)(p.ws + OFF_VSC)};
        g8::gemm_phase<g8::EpiInT>((G8_LAS unsigned char*)smem_phys, g, S, E);
    }
    {
        const int lane = threadIdx.x & 63, wid = threadIdx.x >> 6, fr = lane & 15, fq = lane >> 4;
        float* ALR = (float*)(R + R_ALR);
        for (int task = (int)blockIdx.x * 8 + wid; task < T / 16; task += (int)gridDim.x * 8) {
            const bf16_t* a = H + (size_t)(task * 16 + fr) * 1024 + fq * 8; const bf16_t* w = W + (size_t)(3072 + fr) * 1024 + fq * 8;
            f32x4 acc = (f32x4){0.f, 0.f, 0.f, 0.f};
#pragma unroll 8
            for (int kk = 0; kk < 32; ++kk) {
                const bf16x8 af = *(const bf16x8*)(a + kk * 32), wf = *(const bf16x8*)(w + kk * 32);
                acc = __builtin_amdgcn_mfma_f32_16x16x32_bf16(wf, af, acc, 0, 0, 0);
            }
            *(f32x4*)(ALR + (size_t)(task * 16 + fr) * 16 + fq * 4) = acc * ((const float*)(p.ws + OFF_VSC))[task * 16 + fr];
        }
    }
}


typedef float f32x16 __attribute__((ext_vector_type(16)));
typedef int i32x4f __attribute__((ext_vector_type(4)));
__device__ __forceinline__ void sb_fast(const Params& p, char* smem, unsigned* ctr) {
    bf16_t* R = (bf16_t*)(p.ws + OFF_REGION);
    char* KT = smem; char* VTt = smem + 8192;
    volatile int* flags = (volatile int*)(smem + 32768); volatile unsigned* slot = (volatile unsigned*)(smem + 32832);
    const int tid = threadIdx.x, lane = tid & 63, w = tid >> 6, r31 = lane & 31, h = lane >> 5;
    for (;;) {
        __syncthreads();
        if (tid == 0) *slot = atomicAdd(ctr, 1u);
        __syncthreads();
        const unsigned task = *slot;
        if (task >= 1024u) break;
        const int qblk = 7 - (int)(task >> 7), bh = task & 127, b = bh >> 3, hh = bh & 7;
        const int q0 = qblk * 256, qbase = q0 + 32 * w;
        bf16_t* qrow = R + R_QSB + (size_t)(b * 2048 + qbase + r31) * 512 + hh * 64;
        bf16x8 qf[4];
#pragma unroll
        for (int kk = 0; kk < 4; ++kk) qf[kk] = *(const bf16x8*)(qrow + 16 * kk + 8 * h);
        f32x16 oacc[2];
#pragma unroll
        for (int nt = 0; nt < 2; ++nt)
#pragma unroll
            for (int i = 0; i < 16; ++i) oacc[nt][i] = 0.f;
        float Rr = 1.0f;
        const int t = qbase + r31;
        for (int kt = q0 / 64 + 3; kt >= 0; --kt) {
            __syncthreads();
            { const int wd = __all(Rr == 0.f); if (lane == 0) flags[w] = wd; }
            __syncthreads();
            if (flags[0] & flags[1] & flags[2] & flags[3] & flags[4] & flags[5] & flags[6] & flags[7]) break;
            const int s_tile = kt * 64;
            {
                const int c = tid, row = c >> 3, ch = c & 7;
                const u32x4 kv = *(const u32x4*)(R + R_KSB + (size_t)(b * 2048 + s_tile + row) * 512 + hh * 64 + ch * 8);
                const u32x4 vv = *(const u32x4*)(R + R_VTSB + ((size_t)((b * 8 + hh) * 64 + row)) * 2048 + s_tile + ch * 8);
                *(u32x4*)(KT + row * 128 + ((ch ^ (row & 7)) << 4)) = kv;
                *(uint2*)(VTt + row * 136 + ch * 16) = make_uint2(vv[0], vv[1]);
                *(uint2*)(VTt + row * 136 + ch * 16 + 8) = make_uint2(vv[2], vv[3]);
            }
            __syncthreads();
#pragma unroll
            for (int sbk = 1; sbk >= 0; --sbk) {
                const int key_lo = s_tile + 32 * sbk;
                if (key_lo >= qbase + 31) continue;
                if (__all(Rr == 0.f)) continue;
                f32x16 st;
#pragma unroll
                for (int i = 0; i < 16; ++i) st[i] = 0.f;
                const int krow = 32 * sbk + r31;
#pragma unroll
                for (int kk = 0; kk < 4; ++kk) {
                    const bf16x8 kf = *(const bf16x8*)(KT + krow * 128 + (((2 * kk + h) ^ (krow & 7)) << 4));
                    st = __builtin_amdgcn_mfma_f32_32x32x16_bf16(kf, qf[kk], st, 0, 0, 0);
                }
                float a[16], G[4];
                const bool diag = key_lo + 31 >= qbase;
#pragma unroll
                for (int g = 0; g < 4; ++g) {
                    float sg[4], m[4];
#pragma unroll
                    for (int i = 0; i < 4; ++i) {
                        const float ea = fminf(st[4 * g + i] * -1.4426950409f, 115.0f);
                        const float ez = __builtin_amdgcn_exp2f(ea), sig = __builtin_amdgcn_rcpf(1.0f + ez);
                        sg[i] = sig; m[i] = ez * sig;
                    }
                    if (diag) {
#pragma unroll
                        for (int i = 0; i < 4; ++i) { const bool valid = key_lo + 8 * g + 4 * h + i < t; sg[i] = valid ? sg[i] : 0.f; m[i] = valid ? m[i] : 1.0f; }
                    }
                    const float x2 = m[3], x1 = x2 * m[2], x0 = x1 * m[1];
                    G[g] = x0 * m[0];
                    a[4 * g + 3] = sg[3]; a[4 * g + 2] = sg[2] * x2; a[4 * g + 1] = sg[1] * x1; a[4 * g] = sg[0] * x0;
                }
                float Go[4], P[4];
#pragma unroll
                for (int g = 0; g < 4; ++g) { Go[g] = __shfl_xor(G[g], 32); P[g] = G[g] * Go[g]; }
                const float c2 = P[3], c1 = c2 * P[2], c0 = c1 * P[1];
                float Tg[4];
                Tg[3] = Rr; Tg[2] = Rr * c2; Tg[1] = Rr * c1; Tg[0] = Rr * c0;
#pragma unroll
                for (int g = 0; g < 4; ++g) {
                    const float tg = (h == 0) ? Tg[g] * Go[g] : Tg[g];
                    a[4 * g] *= tg; a[4 * g + 1] *= tg; a[4 * g + 2] *= tg; a[4 * g + 3] *= tg;
                }
                Rr = Rr * c0 * P[0];
#pragma unroll
                for (int s2 = 0; s2 < 2; ++s2) {
                    union { bf16x8 v; unsigned u[4]; } af;
#pragma unroll
                    for (int j2 = 0; j2 < 4; ++j2) af.u[j2] = pack2(a[8 * s2 + 2 * j2], a[8 * s2 + 2 * j2 + 1]);
#pragma unroll
                    for (int nt = 0; nt < 2; ++nt) {
                        const char* vp = VTt + (32 * nt + r31) * 136 + 64 * sbk + 32 * s2 + 8 * h;
                        union { bf16x8 v; uint2 hh2[2]; } vf;
                        vf.hh2[0] = *(const uint2*)vp; vf.hh2[1] = *(const uint2*)(vp + 16);
                        oacc[nt] = __builtin_amdgcn_mfma_f32_32x32x16_bf16(af.v, vf.v, oacc[nt], 0, 0, 0);
                    }
                }
            }
        }
#pragma unroll
        for (int nt = 0; nt < 2; ++nt)
#pragma unroll
            for (int i = 0; i < 16; ++i) {
                const int qq = (i & 3) + 8 * (i >> 2) + 4 * h;
                R[R_QSB + (size_t)(b * 2048 + qbase + qq) * 512 + hh * 64 + 32 * nt + r31] = f2bf(oacc[nt][i]);
            }
    }
}
__device__ __forceinline__ float log_sigmoid(float x) { return fminf(x, 0.f) - __logf(1.0f + __expf(-fabsf(x))); }
__device__ __forceinline__ int swz(int row, int chunk) { return row * 128 + ((chunk ^ (row & 7)) << 4); }
__device__ __forceinline__ void gla_prep(const Params& p, char* smem) {
    bf16_t* R = (bf16_t*)(p.ws + OFF_REGION);
    const float* ALR = (const float*)(R + R_ALR);
    bf16_t* KOTg = R + R_KOT; float* DECg = (float*)(R + R_DEC);
    float* SEG = (float*)smem; float* ALRs = SEG + 256;
    const int tid = VTID, d = tid & 63, w = tid >> 6;
    for (int task = VBID; task < 2048; task += VGRID) {
        const int bh = task >> 5, c = task & 31, b = bh >> 2, hh = bh & 3;
        const size_t rowbase = (size_t)b * 2048 + c * 64;
        unsigned qr[16], kr[16];
#pragma unroll
        for (int i = 0; i < 16; ++i) { const size_t row = rowbase + w * 16 + i; qr[i] = R[R_QG + row * 256 + hh * 64 + d]; kr[i] = R[R_KG + row * 256 + hh * 64 + d]; }
        const f32x4 ar = *(const f32x4*)(ALR + rowbase * 16 + tid * 4);
        float w2r[16];
#pragma unroll
        for (int r = 0; r < 16; ++r) w2r[r] = p.ab_w_alpha2[r * 256 + hh * 64 + d];
        const float b2r = p.ab_b_alpha2[hh * 64 + d];
        __syncthreads();
        *(f32x4*)(ALRs + tid * 4) = ar;
        __syncthreads();
        float cs[16]; float run = 0.f;
#pragma unroll
        for (int i = 0; i < 16; ++i) {
            const float* al = ALRs + (w * 16 + i) * 16;
            float pre = b2r;
#pragma unroll
            for (int r = 0; r < 16; ++r) pre += al[r] * w2r[r];
            run += log_sigmoid(pre) * (1.0f / 16.0f);
            cs[i] = run;
        }
        SEG[w * 64 + d] = run;
        __syncthreads();
        float off = 0.f, tot = 0.f;
#pragma unroll
        for (int w2 = 0; w2 < 4; ++w2) { const float s = SEG[w2 * 64 + d]; tot += s; if (w2 < w) off += s; }
        unsigned kop[8];
#pragma unroll
        for (int i2 = 0; i2 < 8; ++i2) {
            float kov[2];
#pragma unroll
            for (int u = 0; u < 2; ++u) {
                const int i = 2 * i2 + u;
                const float bc = off + cs[i];
                const float kv = bf2f((bf16_t)kr[i]);
                const size_t row = rowbase + w * 16 + i;
                R[R_QG + row * 256 + hh * 64 + d] = f2bf(bf2f((bf16_t)qr[i]) * 0.125f * __expf(bc));
                R[R_KG + row * 256 + hh * 64 + d] = f2bf(kv * __expf(-bc));
                kov[u] = kv * __expf(tot - bc);
            }
            kop[i2] = pack2(kov[0], kov[1]);
        }
        bf16_t* kp = KOTg + ((size_t)task * 64 + d) * 64 + w * 16;
        *(uint4*)kp = make_uint4(kop[0], kop[1], kop[2], kop[3]);
        *(uint4*)(kp + 8) = make_uint4(kop[4], kop[5], kop[6], kop[7]);
        if (w == 0) DECg[(size_t)task * 64 + d] = __expf(tot);
    }
}
__device__ __forceinline__ void gla_scan(const Params& p, char* smem, bool dry = false) {
    bf16_t* R = (bf16_t*)(p.ws + OFF_REGION);
    const bf16_t* KOTg = R + R_KOT; const float* DECg = (const float*)(R + R_DEC);
    char* QS = smem; char* KS = smem + 8192; char* KOT = smem + 16384; char* VTs = smem + 24576; char* SPT = smem + 40960;
    float* DEC = (float*)(smem + 57344); float* GN = DEC + 64;
    const int tid = VTID, lane = tid & 63, w = tid >> 6, l15_ = lane & 15, q4 = lane >> 4;
    for (int task = VBID; task < 64; task += VGRID) {
        const int b = task >> 2, hh = task & 3;
        f32x4 Sacc[8];
#pragma unroll
        for (int nt = 0; nt < 8; ++nt) Sacc[nt] = (f32x4){0.f, 0.f, 0.f, 0.f};
        __syncthreads();
        for (int i = tid; i < 1024; i += 256) *(uint4*)(SPT + i * 16) = make_uint4(0, 0, 0, 0);
        if (tid < 128) GN[tid] = p.ab_gla_norm[hh * 128 + tid];
        const size_t rowbase = (size_t)b * 2048;
        const bf16_t* vbase = R + R_VTG + ((size_t)((b * 4 + hh) * 128)) * 2048;
        u32x4 tq[2], tk[2], tko[2], vr[4]; float td = 0.f;
        auto prefetch = [&](int c) {
            const int t0 = c * 64;
#pragma unroll
            for (int i = 0; i < 2; ++i) {
                const int cid = tid + 256 * i, row = cid >> 3, ch = cid & 7;
                tq[i] = *(const u32x4*)(R + R_QG + (rowbase + t0 + row) * 256 + hh * 64 + ch * 8);
                tk[i] = *(const u32x4*)(R + R_KG + (rowbase + t0 + row) * 256 + hh * 64 + ch * 8);
                tko[i] = *(const u32x4*)(KOTg + (((size_t)task * 32 + c) * 64 + row) * 64 + ch * 8);
            }
#pragma unroll
            for (int i = 0; i < 4; ++i) { const int cid = tid + 256 * i, e = cid >> 3, ch = cid & 7; vr[i] = *(const u32x4*)(vbase + (size_t)e * 2048 + t0 + ch * 8); }
            if (tid < 64) td = DECg[((size_t)task * 32 + c) * 64 + tid];
        };
        prefetch(0);
        for (int c = 0; c < 32; ++c) {
            int lz = 0; asm volatile("" : "+v"(lz));
            const int l15 = l15_ + lz;
            const int cx = (q4 ^ (l15 & 7)) << 4;
            const int rb0 = l15 * 128 + cx, rb1 = l15 * 128 + (cx ^ 64);
#pragma unroll
            for (int i = 0; i < 2; ++i) {
                const int cid = tid + 256 * i + lz, row = cid >> 3, ch = cid & 7;
                *(u32x4*)(QS + swz(row, ch)) = tq[i]; *(u32x4*)(KS + swz(row, ch)) = tk[i]; *(u32x4*)(KOT + swz(row, ch)) = tko[i];
            }
#pragma unroll
            for (int i = 0; i < 4; ++i) { const int cid = tid + 256 * i + lz, e = cid >> 3, ch = cid & 7; *(u32x4*)(VTs + swz(e, ch)) = vr[i]; }
            if (tid < 64) DEC[tid] = td;
            uint2 gr[8];
            const unsigned goff = (unsigned)((rowbase + c * 64 + 16 * w + l15) * 512 + hh * 128 + 4 * q4);
            bf16_t* const gbase = R + R_GG;
#pragma unroll
            for (int nt = 0; nt < 8; ++nt) gr[nt] = *(const uint2*)(gbase + (goff + 16 * nt));
            if (c + 1 < 32) prefetch(c + 1);
            __syncthreads();
            bf16x8 qf[2];
#pragma unroll
            for (int kk = 0; kk < 2; ++kk) qf[kk] = *(const bf16x8*)(QS + w * 2048 + (kk ? rb1 : rb0));
            f32x4 sT[4];
#pragma unroll
            for (int st = 0; st < 4; ++st) {
                sT[st] = (f32x4){0.f, 0.f, 0.f, 0.f};
                if (st <= w) {
#pragma unroll
                    for (int kk = 0; kk < 2; ++kk) { const bf16x8 kf = *(const bf16x8*)(KS + st * 2048 + (kk ? rb1 : rb0)); sT[st] = __builtin_amdgcn_mfma_f32_16x16x32_bf16(kf, qf[kk], sT[st], 0, 0, 0); }
#pragma unroll
                    for (int r = 0; r < 4; ++r) if (16 * st + 4 * q4 + r > 16 * w + l15) sT[st][r] = 0.f;
                }
            }
            bf16x8 af[2];
#pragma unroll
            for (int ks2 = 0; ks2 < 2; ++ks2) {
                union { bf16x8 v; unsigned u[4]; } cv;
                cv.u[0] = pack2(sT[2 * ks2][0], sT[2 * ks2][1]); cv.u[1] = pack2(sT[2 * ks2][2], sT[2 * ks2][3]);
                cv.u[2] = pack2(sT[2 * ks2 + 1][0], sT[2 * ks2 + 1][1]); cv.u[3] = pack2(sT[2 * ks2 + 1][2], sT[2 * ks2 + 1][3]);
                af[ks2] = cv.v;
            }
            const int vb = l15 * 128 + ((((q4 >> 1) ^ (l15 & 7)) << 4) | ((q4 & 1) * 8));
            f32x4 o[8];
#pragma unroll
            for (int nt = 0; nt < 8; ++nt) {
                o[nt] = (f32x4){0.f, 0.f, 0.f, 0.f};
                const int e = 16 * nt + l15;
#pragma unroll
                for (int kk = 0; kk < 2; ++kk) { const bf16x8 sf = *(const bf16x8*)(SPT + nt * 2048 + (kk ? rb1 : rb0)); o[nt] = __builtin_amdgcn_mfma_f32_16x16x32_bf16(sf, qf[kk], o[nt], 0, 0, 0); }
#pragma unroll
                for (int ks2 = 0; ks2 < 2; ++ks2) {
                    if (2 * ks2 <= w) {
                        union { bf16x8 v; uint2 h[2]; } cv;
                        cv.h[0] = *(const uint2*)(VTs + nt * 2048 + (vb ^ (ks2 * 64)));
                        cv.h[1] = *(const uint2*)(VTs + nt * 2048 + (vb ^ (ks2 * 64) ^ 32));
                        o[nt] = __builtin_amdgcn_mfma_f32_16x16x32_bf16(cv.v, af[ks2], o[nt], 0, 0, 0);
                    }
                }
            }
            {
                const float4 dc = *(const float4*)(DEC + 16 * w + 4 * q4);
                bf16x8 kof[2];
#pragma unroll
                for (int kk = 0; kk < 2; ++kk) kof[kk] = *(const bf16x8*)(KOT + w * 2048 + (kk ? rb1 : rb0));
#pragma unroll
                for (int nt = 0; nt < 8; ++nt) {
                    Sacc[nt][0] *= dc.x; Sacc[nt][1] *= dc.y; Sacc[nt][2] *= dc.z; Sacc[nt][3] *= dc.w;
#pragma unroll
                    for (int kk = 0; kk < 2; ++kk) { const bf16x8 vf = *(const bf16x8*)(VTs + nt * 2048 + (kk ? rb1 : rb0)); Sacc[nt] = __builtin_amdgcn_mfma_f32_16x16x32_bf16(kof[kk], vf, Sacc[nt], 0, 0, 0); }
                }
            }
            __syncthreads();
#pragma unroll
            for (int nt = 0; nt < 8; ++nt) {
                const int e = 16 * nt + l15;
                uint2 pk; pk.x = pack2(Sacc[nt][0], Sacc[nt][1]); pk.y = pack2(Sacc[nt][2], Sacc[nt][3]);
                *(uint2*)(SPT + nt * 2048 + l15 * 128 + (((2 * w + (q4 >> 1)) ^ (l15 & 7)) << 4) + (q4 & 1) * 8) = pk;
            }
            float ssq = 0.f;
#pragma unroll
            for (int nt = 0; nt < 8; ++nt) ssq += (o[nt][0] * o[nt][0] + o[nt][1] * o[nt][1]) + (o[nt][2] * o[nt][2] + o[nt][3] * o[nt][3]);
            ssq += __shfl_xor(ssq, 16); ssq += __shfl_xor(ssq, 32);
            const float rsd = rsqrtf(ssq * (1.0f / 128.0f) + EPS);
#pragma unroll
            for (int nt = 0; nt < 8; ++nt) {
                asm volatile("" ::: "memory");
                const f32x4 gn = *(const f32x4*)(GN + 16 * nt + 4 * q4);
                const float g0 = lo2f(gr[nt].x), g1 = hi2f(gr[nt].x), g2 = lo2f(gr[nt].y), g3 = hi2f(gr[nt].y);
                uint2 ov;
                ov.x = pack2(o[nt][0] * rsd * gn[0] * g0, o[nt][1] * rsd * gn[1] * g1);
                ov.y = pack2(o[nt][2] * rsd * gn[2] * g2, o[nt][3] * rsd * gn[3] * g3);
                if (!dry || ov.x == 0x7fc17fc1u) *(uint2*)(gbase + (goff + 16 * nt)) = ov;
            }
        }
    }
}

#define KEY_PAD 0xff800000u
__device__ __forceinline__ unsigned ord_key(float f) { return __float_as_uint(f); }
__device__ __forceinline__ float unord_key(unsigned k) { return __uint_as_float(k); }
__device__ __forceinline__ unsigned key_max(unsigned a, unsigned b) { unsigned r; asm("v_max_f32 %0, %1, %2" : "=v"(r) : "v"(a), "v"(b)); return r; }
__device__ __forceinline__ unsigned key_min(unsigned a, unsigned b) { unsigned r; asm("v_min_f32 %0, %1, %2" : "=v"(r) : "v"(a), "v"(b)); return r; }
__device__ __forceinline__ void ce_desc(unsigned& a, unsigned& b) { const unsigned hi = key_max(a, b), lo = key_min(a, b); a = hi; b = lo; }
__device__ __forceinline__ void bitonic_sort16_desc(unsigned (&a)[16]) {
#pragma unroll
    for (int k = 2; k <= 16; k <<= 1)
#pragma unroll
        for (int j = k >> 1; j > 0; j >>= 1)
#pragma unroll
            for (int i = 0; i < 16; ++i) { const int l = i ^ j; if (l > i) { if ((i & k) == 0) ce_desc(a[i], a[l]); else ce_desc(a[l], a[i]); } }
}
__device__ __forceinline__ void merge_top16(unsigned (&L)[16], const unsigned (&B)[16]) {
#pragma unroll
    for (int i = 0; i < 16; ++i) L[i] = key_max(L[i], B[15 - i]);
#pragma unroll
    for (int j = 8; j > 0; j >>= 1)
#pragma unroll
        for (int i = 0; i < 16; ++i) { const int l = i ^ j; if (l > i) ce_desc(L[i], L[l]); }
}
__device__ constexpr int cand_i(int n) { int c = 0; for (int i = 0; i < 16; ++i) for (int j = 0; j < 16; ++j) if ((i + 1) * (j + 1) <= 16) { if (c == n) return i; ++c; } return -1; }
__device__ constexpr int cand_j(int n) { int c = 0; for (int i = 0; i < 16; ++i) for (int j = 0; j < 16; ++j) if ((i + 1) * (j + 1) <= 16) { if (c == n) return j; ++c; } return -1; }
template <int N> struct CandTab { int i[N], j[N]; constexpr CandTab() : i(), j() { for (int n = 0; n < N; ++n) { i[n] = cand_i(n); j[n] = cand_j(n); } } };

__device__ __forceinline__ bf16x8 pack8(const float4 a, const float4 b) {
    u32x4 t; t.x = pack2(a.x, a.y); t.y = pack2(a.z, a.w); t.z = pack2(b.x, b.y); t.w = pack2(b.z, b.w);
    return __builtin_bit_cast(bf16x8, t);
}
__device__ __forceinline__ void fold_query_weights(const Params& p, int vb0 = 0) {
    int lz = 0; asm volatile("" : "+v"(lz));
    const int lane = (VTID & 63) + lz, wid = VTID >> 6, fr = lane & 15, fq = lane >> 4;
    unsigned char* Wf = p.ws + OFF_WT_Q;
    if (VBID < vb0) return;
    for (int task = VBID - vb0; task < 512; task += VGRID - vb0) {
        const int kb = task & 15, pp = (task >> 4) & 1, h = (task >> 5) & 7, layer = task >> 8;
        const float* wq = p.peer_w_q + (size_t)layer * 1024 * 2048 + (size_t)(kb * 64 + fr) * 2048 + h * 256 + pp * 128 + fq * 8;
        const float* sk = p.peer_subkeys + ((size_t)((layer * 8 + h) * 2 + pp) * 128 + wid * 32 + fr) * 128 + fq * 8;
        f32x4 acc[4][2];
#pragma unroll
        for (int kt = 0; kt < 4; ++kt)
#pragma unroll
            for (int jt = 0; jt < 2; ++jt) acc[kt][jt] = (f32x4){0.f, 0.f, 0.f, 0.f};
#pragma unroll 1
        for (int s = 0; s < 4; ++s) {
            bf16x8 a[4], b[2];
#pragma unroll
            for (int kt = 0; kt < 4; ++kt) { const float* q = wq + (size_t)(kt * 16) * 2048 + s * 32; a[kt] = pack8(*(const float4*)q, *(const float4*)(q + 4)); }
#pragma unroll
            for (int jt = 0; jt < 2; ++jt) { const float* q = sk + (size_t)(jt * 16) * 128 + s * 32; b[jt] = pack8(*(const float4*)q, *(const float4*)(q + 4)); }
#pragma unroll
            for (int kt = 0; kt < 4; ++kt)
#pragma unroll
                for (int jt = 0; jt < 2; ++jt) acc[kt][jt] = __builtin_amdgcn_mfma_f32_16x16x32_bf16(a[kt], b[jt], acc[kt][jt], 0, 0, 0);
        }
#pragma unroll
        for (int jt = 0; jt < 2; ++jt) {
            const int key = wid * 32 + jt * 16 + fr, cu = 128 * ((key >> 5) & 1) + 32 * (2 * pp + (key >> 6)) + (key & 31);
            unsigned char* row = Wf + ((size_t)layer * 2048 + h * 256 + cu) * 1024 + kb * 64 + 4 * fq;
#pragma unroll
            for (int kt = 0; kt < 4; ++kt) {
                const f32x4 wv = acc[kt][jt] * *(const f32x4*)(p.norm_ffn + layer * 1024 + kb * 64 + kt * 16 + 4 * fq) * 64.0f;
                int pk = __builtin_amdgcn_cvt_pk_fp8_f32(wv[0], wv[1], 0, false); pk = __builtin_amdgcn_cvt_pk_fp8_f32(wv[2], wv[3], pk, true);
                *(int*)(row + kt * 16) = pk;
            }
        }
    }
}
__device__ __forceinline__ void bitonic_merge16_desc(unsigned (&L)[16]) {
#pragma unroll
    for (int j = 8; j > 0; j >>= 1)
#pragma unroll
        for (int i = 0; i < 16; ++i) { const int l = i ^ j; if (l > i) ce_desc(L[i], L[l]); }
}
__device__ __forceinline__ void bitonic_sort8_desc(unsigned (&a)[8]) {
#pragma unroll
    for (int k = 2; k <= 8; k <<= 1)
#pragma unroll
        for (int j = k >> 1; j > 0; j >>= 1)
#pragma unroll
            for (int i = 0; i < 8; ++i) { const int l = i ^ j; if (l > i) { if ((i & k) == 0) ce_desc(a[i], a[l]); else ce_desc(a[l], a[i]); } }
}
__device__ __forceinline__ void sort16_desc(unsigned (&a)[16]) {
#define CE_(i, j) ce_desc(a[i], a[j])
    CE_(0,13); CE_(1,12); CE_(2,15); CE_(3,14); CE_(4,8); CE_(5,6); CE_(7,11); CE_(9,10);
    CE_(0,5); CE_(1,7); CE_(2,9); CE_(3,4); CE_(6,13); CE_(8,14); CE_(10,15); CE_(11,12);
    CE_(0,1); CE_(2,3); CE_(4,5); CE_(6,8); CE_(7,9); CE_(10,11); CE_(12,13); CE_(14,15);
    CE_(0,2); CE_(1,3); CE_(4,10); CE_(5,11); CE_(6,7); CE_(8,9); CE_(12,14); CE_(13,15);
    CE_(1,2); CE_(3,12); CE_(4,6); CE_(5,7); CE_(8,10); CE_(9,11); CE_(13,14);
    CE_(1,4); CE_(2,6); CE_(5,8); CE_(7,10); CE_(9,13); CE_(11,14);
    CE_(2,4); CE_(3,6); CE_(9,12); CE_(11,13);
    CE_(3,5); CE_(6,8); CE_(7,9); CE_(10,12);
    CE_(3,4); CE_(5,6); CE_(7,8); CE_(9,10); CE_(11,12);
    CE_(6,7); CE_(8,9);
#undef CE_
}
struct EpiSelect {
    unsigned* IDX; float* GATE; G8_LAS unsigned* X; const float* SSQP; const unsigned* SCT;
    __device__ __forceinline__ void operator()(const f32x4 (&acc)[2][2][4][2], const g8::Unit& u, int wr, int wc, int fr_, int fq_) const {
        int lz = 0; asm volatile("" : "+v"(lz));
        const int lane_ = (int)(threadIdx.x & 63) + lz, fr = lane_ & 15, fq = lane_ >> 4; (void)fr_; (void)fq_;
        const int pp = wc >> 1, half = wc & 1, wid = wr * 4 + wc;
        const unsigned kb = 127u - (unsigned)(half * 64 + fq * 8);
        unsigned Lst[4][16];
#pragma unroll
        for (int ai = 0; ai < 2; ++ai)
#pragma unroll
            for (int m = 0; m < 4; ++m) {
                unsigned C[16], Xc[16];
#pragma unroll
                for (int bj = 0; bj < 2; ++bj)
#pragma unroll
                    for (int n = 0; n < 2; ++n)
#pragma unroll
                        for (int r = 0; r < 4; ++r) C[bj * 8 + n * 4 + r] = (ord_key(acc[ai][bj][m][n][r]) & ~127u) | (kb - (unsigned)(bj * 32 + n * 4 + r));
                sort16_desc(C);
#pragma unroll
                for (int i = 0; i < 16; ++i) Xc[i] = (unsigned)__shfl_xor((int)C[i], 16);
                merge_top16(C, Xc);
#pragma unroll
                for (int i = 0; i < 16; ++i) Xc[i] = (unsigned)__shfl_xor((int)C[i], 32);
                merge_top16(C, Xc);
                if ((m >> 1) == half) {
#pragma unroll
                    for (int i = 0; i < 16; ++i) Lst[ai * 2 + (m & 1)][i] = C[i];
                } else if (fq == 0) {
                    G8_LAS unsigned* xs = X + (((ai * 2 + wr) * 2 + pp) * 4 + m) * 256 + fr;
#pragma unroll
                    for (int i = 0; i < 16; ++i) xs[(i ^ m) << 4] = C[i];
                }
            }
        __syncthreads();
#pragma unroll
        for (int ai = 0; ai < 2; ++ai)
#pragma unroll
            for (int e = 0; e < 2; ++e) {
                const int m = half * 2 + e;
                unsigned Xc[16];
                G8_LAS unsigned* xs = X + (((ai * 2 + wr) * 2 + pp) * 4 + m) * 256 + fr;
#pragma unroll
                for (int i = 0; i < 16; ++i) Xc[i] = xs[(i ^ m) << 4];
                merge_top16(Lst[ai * 2 + e], Xc);
                if (fq == 0) {
#pragma unroll
                    for (int i = 0; i < 16; ++i) xs[(i ^ m) << 4] = Lst[ai * 2 + e][i];
                }
            }
        __syncthreads();
        if (wid < 4) {
            G8_LAS unsigned* x0 = X + ((wid * 2 + 0) * 4 + fq) * 256 + fr; G8_LAS unsigned* x1 = X + ((wid * 2 + 1) * 4 + fq) * 256 + fr;
            float s0[16], s1[16];
#pragma unroll
            for (int i = 0; i < 16; ++i) { s0[i] = unord_key(x0[(i ^ fq) << 4] & ~127u); s1[i] = unord_key(x1[(i ^ fq) << 4] & ~127u); }
#define SEL_CAND(i, j) ((ord_key(s0[i] + s1[j]) & ~255u) | (unsigned)(255 - ((i) * 16 + (j))))
            unsigned C[16], B[16], M2[16], M3[8];
#pragma unroll
            for (int j = 0; j < 16; ++j) C[j] = SEL_CAND(0, j);
#pragma unroll
            for (int k = 0; k < 15; ++k) B[k] = SEL_CAND(k + 1, 0);
            B[15] = KEY_PAD;
            merge_top16(C, B);
#pragma unroll
            for (int j = 0; j < 7; ++j) M2[j] = SEL_CAND(1, j + 1);
            M2[7] = KEY_PAD; M2[8] = KEY_PAD; M2[9] = KEY_PAD;
#pragma unroll
            for (int k = 0; k < 6; ++k) M2[15 - k] = SEL_CAND(k + 2, 1);
            bitonic_merge16_desc(M2);
            M3[0] = SEL_CAND(2, 2); M3[1] = SEL_CAND(2, 3); M3[2] = SEL_CAND(2, 4); M3[3] = SEL_CAND(3, 2); M3[4] = SEL_CAND(4, 2); M3[5] = SEL_CAND(3, 3); M3[6] = KEY_PAD; M3[7] = KEY_PAD;
            bitonic_sort8_desc(M3);
#pragma unroll
            for (int i = 0; i < 8; ++i) B[i] = M3[i];
#pragma unroll
            for (int i = 8; i < 16; ++i) B[i] = KEY_PAD;
            merge_top16(M2, B);
            merge_top16(C, M2);
#undef SEL_CAND
            const int tok = u.pm * 256 + (wid >> 1) * 128 + (wid & 1) * 64 + fq * 16 + fr;
            float rstd;
            {
                const f32x4 q0 = *(const f32x4*)(SSQP + (size_t)tok * 32), q1 = *(const f32x4*)(SSQP + (size_t)tok * 32 + 4), q2 = *(const f32x4*)(SSQP + (size_t)tok * 32 + 8), q3 = *(const f32x4*)(SSQP + (size_t)tok * 32 + 12);
                const f32x4 q = (q0 + q1) + (q2 + q3);
                rstd = rsqrtf(((q[0] + q[1]) + (q[2] + q[3])) * (1.0f / D) + EPS);
            }
            const float mx = unord_key(C[0] & ~255u);
            float e[16]; float sum = 0.f;
#pragma unroll
            for (int r = 0; r < 16; ++r) { e[r] = __expf((unord_key(C[r] & ~255u) - mx) * (rstd * (1.0f / 64.0f))); sum += e[r]; }
            const float inv = 1.0f / sum;
            const size_t ob = (size_t)tok * 128 + u.pn * 16;
            unsigned iw[16];
#pragma unroll
            for (int r = 0; r < 16; ++r) {
                const unsigned code = 255u - (C[r] & 255u);
                const unsigned e0 = 127u - (x0[((code >> 4) ^ (unsigned)fq) << 4] & 127u), e1 = 127u - (x1[((code & 15u) ^ (unsigned)fq) << 4] & 127u);
                iw[r] = e0 * 128u + e1;
            }
            unsigned sc[16];
#pragma unroll
            for (int r = 0; r < 16; ++r) sc[r] = SCT[iw[r]];
#pragma unroll
            for (int r = 0; r < 16; ++r) {
                iw[r] |= sc[r] << 16;
                e[r] *= inv * (float)__builtin_bit_cast(_Float16, (unsigned short)(sc[r] >> 16));
            }
#pragma unroll
            for (int r = 0; r < 4; ++r) *(uint4*)(IDX + ob + r * 4) = make_uint4(iw[4 * r], iw[4 * r + 1], iw[4 * r + 2], iw[4 * r + 3]);
#pragma unroll
            for (int r = 0; r < 4; ++r) *(float4*)(GATE + ob + r * 4) = make_float4(e[4 * r], e[4 * r + 1], e[4 * r + 2], e[4 * r + 3]);
        }
        __syncthreads();
    }
};
__device__ __forceinline__ void phase_select8(const Params& p, int layer, char* smem_phys) {
    const bf16_t* H = (const bf16_t*)(p.ws + OFF_H); const bf16_t* Wf = (const bf16_t*)(p.ws + OFF_WT_Q + (size_t)layer * 2048 * 1024);
    g8::Gemm g{H, H, 512, 512, Wf, T, 2048, 512};
    g8::StaticOrder S; S.init(T, 2048, (int)gridDim.x, (int)blockIdx.x);
    EpiSelect E{(unsigned*)(p.ws + OFF_IDX), (float*)(p.ws + OFF_GATE), (G8_LAS unsigned*)(smem_phys + 131072), (const float*)(p.ws + OFF_SSQ), (const unsigned*)(p.ws + OFF_USC) + (size_t)layer * NEXP};
    g8::gemm_phase<EpiSelect, true>((G8_LAS unsigned char*)smem_phys, g, S, E);
    __syncthreads();
    if (threadIdx.x == 0) *(uint4*)(smem_phys + kDynLds - 16) = make_uint4(0u, 0u, 0u, 0u);
    __syncthreads();
}

__device__ __forceinline__ float ub0(unsigned w) { float f; asm("v_cvt_f32_ubyte0 %0, %1" : "=v"(f) : "v"(w)); return f; }
__device__ __forceinline__ float ub1(unsigned w) { float f; asm("v_cvt_f32_ubyte1 %0, %1" : "=v"(f) : "v"(w)); return f; }
__device__ __forceinline__ float ub2(unsigned w) { float f; asm("v_cvt_f32_ubyte2 %0, %1" : "=v"(f) : "v"(w)); return f; }
__device__ __forceinline__ float ub3(unsigned w) { float f; asm("v_cvt_f32_ubyte3 %0, %1" : "=v"(f) : "v"(w)); return f; }
typedef _Float16 f16x2 __attribute__((ext_vector_type(2)));
__device__ __forceinline__ void glds16(const void* gsrc, unsigned lds_dst) {
    unsigned keep; const unsigned d = (unsigned)__builtin_amdgcn_readfirstlane((int)lds_dst);
    asm volatile("s_mov_b32 %0, m0\n\ts_mov_b32 m0, %2\n\ts_nop 0\n\tglobal_load_lds_dwordx4 %1, off\n\ts_mov_b32 m0, %0" : "=&s"(keep) : "v"(gsrc), "s"(d) : "memory");
}
template <int V> struct GIC { static constexpr int v = V; };
__device__ __forceinline__ void glds16s(const void* sbase, unsigned voff, unsigned lds_dst) {
    unsigned keep; const unsigned d = (unsigned)__builtin_amdgcn_readfirstlane((int)lds_dst);
    asm volatile("s_mov_b32 %0, m0\n\ts_mov_b32 m0, %3\n\ts_nop 0\n\tglobal_load_lds_dwordx4 %1, %2\n\ts_mov_b32 m0, %0" : "=&s"(keep) : "v"(voff), "s"(sbase), "s"(d) : "memory");
}
__device__ __forceinline__ void peer_gather(const Params& p, int layer, const float* __restrict__ gnext, bool final_out, char* smem) {
    const unsigned char* REC = p.ws + OFF_UT + (size_t)layer * NEXP * 1024;
    const unsigned* IDX = (const unsigned*)(p.ws + OFF_IDX); const float* GATE = (const float*)(p.ws + OFF_GATE);
    bf16_t* S = (bf16_t*)(p.ws + OFF_S);
    float* sGain = (float*)(smem + 155648);
    { int lz0 = 0; asm volatile("" : "+v"(lz0)); const int i = (int)threadIdx.x + lz0; if (i < 256) ((f32x4*)sGain)[i] = ((const f32x4*)(p.norm_ffn + layer * 1024))[i]; }
    __syncthreads();
    const int lane = VTID & 63, wid = VTID >> 6, sub = lane >> 4, li = lane & 15;
    char* wbase = smem + (int)(threadIdx.x >> 6) * 19456;
    unsigned* sIdx = (unsigned*)wbase; _Float16* sGate = (_Float16*)(wbase + 2048);
    const char* ring = wbase + 3072; const unsigned ringb = (unsigned)(size_t)ring;
    const int gw = VBID * 4 + wid, nw = VGRID * 4;
    const unsigned smlo = sub < 2 ? (0xffffu << (16 * sub)) : 0u, smhi = sub >= 2 ? (0xffffu << (16 * (sub - 2))) : 0u;
    for (int t = gw; t < T; t += 4 * nw) {
        const int tt = t + sub * nw;
        {
            int lz = 0; asm volatile("" : "+v"(lz));
            const int l8 = 8 * (li + lz);
            const uint4 ia = *(const uint4*)(IDX + (size_t)tt * 128 + l8), ib = *(const uint4*)(IDX + (size_t)tt * 128 + l8 + 4);
            const float4 ga = *(const float4*)(GATE + (size_t)tt * 128 + l8), gb = *(const float4*)(GATE + (size_t)tt * 128 + l8 + 4);
            const unsigned id[8] = {ia.x, ia.y, ia.z, ia.w, ib.x, ib.y, ib.z, ib.w};
            const float gg[8] = {ga.x, ga.y, ga.z, ga.w, gb.x, gb.y, gb.z, gb.w};
            unsigned pos[8], lrank[8]; unsigned w[4] = {0u, 0u, 0u, 0u};
#pragma unroll
            for (int r = 0; r < 8; ++r) {
                const unsigned sh = (id[r] >> 7) & 0x18u, wq = (id[r] >> 12) & 3u;
                const unsigned cur = wq == 0u ? w[0] : (wq == 1u ? w[1] : (wq == 2u ? w[2] : w[3]));
                lrank[r] = __builtin_amdgcn_ubfe(cur, sh, 8u);
                const unsigned inc = 1u << sh;
#pragma unroll
                for (int k = 0; k < 4; ++k) w[k] += (wq == (unsigned)k) ? inc : 0u;
            }
            unsigned pf[4], c[4]; unsigned below = 0u;
#pragma unroll
            for (int k = 0; k < 4; ++k) {
                unsigned x = w[k];
                x += (unsigned)__builtin_amdgcn_update_dpp(0, (int)x, 0x111, 0xf, 0xf, true); x += (unsigned)__builtin_amdgcn_update_dpp(0, (int)x, 0x112, 0xf, 0xf, true);
                x += (unsigned)__builtin_amdgcn_update_dpp(0, (int)x, 0x114, 0xf, 0xf, true); x += (unsigned)__builtin_amdgcn_update_dpp(0, (int)x, 0x118, 0xf, 0xf, true);
                pf[k] = x;
            }
#pragma unroll
            for (int k = 0; k < 4; ++k) {
                const unsigned tot = (unsigned)__shfl((int)pf[k], (lane & 48) | 15);
                c[k] = tot * 0x01010100u + below * 0x01010101u + (pf[k] - w[k]);
                below += (tot * 0x01010101u) >> 24;
            }
#pragma unroll
            for (int r = 0; r < 8; ++r) {
                const unsigned sh = (id[r] >> 7) & 0x18u, wq = (id[r] >> 12) & 3u;
                pos[r] = __builtin_amdgcn_ubfe(wq == 0u ? c[0] : (wq == 1u ? c[1] : (wq == 2u ? c[2] : c[3])), sh, 8u) + lrank[r];
            }
#pragma unroll
            for (int r = 0; r < 8; ++r) { sIdx[sub * 128 + pos[r]] = id[r]; sGate[sub * 128 + pos[r]] = (_Float16)gg[r]; }
        }
        int XH[2][4], XL[2][4]; float sx; float xg;
        {
            f32x4 xr[16]; float am = 0.f, ssx = 0.f;
#pragma unroll
            for (int k = 0; k < 8; ++k) {
                const int col = (16 * (k >> 2) + li) * 32 + (k & 3) * 8;
                const u32x4 raw = *(const u32x4*)(S + (size_t)tt * 1024 + col);
                const f32x4 g0 = *(const f32x4*)(sGain + col), g1 = *(const f32x4*)(sGain + col + 4);
                const f32x4 x0 = (f32x4){lo2f(raw[0]), hi2f(raw[0]), lo2f(raw[1]), hi2f(raw[1])}, x1 = (f32x4){lo2f(raw[2]), hi2f(raw[2]), lo2f(raw[3]), hi2f(raw[3])};
                ssx += (x0[0] * x0[0] + x0[1] * x0[1]) + (x0[2] * x0[2] + x0[3] * x0[3]) + (x1[0] * x1[0] + x1[1] * x1[1]) + (x1[2] * x1[2] + x1[3] * x1[3]);
                xr[2 * k] = x0 * g0; xr[2 * k + 1] = x1 * g1;
#pragma unroll
                for (int c = 0; c < 4; ++c) am = fmaxf(am, fmaxf(fabsf(xr[2 * k][c]), fabsf(xr[2 * k + 1][c])));
            }
            am = fmaxf(am, __shfl_xor(am, 1)); am = fmaxf(am, __shfl_xor(am, 2)); am = fmaxf(am, __shfl_xor(am, 4)); am = fmaxf(am, __shfl_xor(am, 8));
            ssx = row16_sum(ssx);
            const float inv = am > 0.f ? 119.0f / am : 0.f;
            sx = am * (1.0f / 119.0f) * rsqrtf(ssx * (1.0f / D) + EPS);
            int xs = 0;
#pragma unroll
            for (int j = 0; j < 2; ++j)
#pragma unroll
                for (int d = 0; d < 4; ++d) {
                    unsigned lo = 0u, hi = 0u;
#pragma unroll
                    for (int i = 0; i < 8; ++i) {
                        const int q = __float2int_rn(xr[(j * 4 + d) * 2 + (i >> 2)][i & 3] * inv);
                        const int sh = (i & 3) * 8 + (i >> 2) * 4;
                        lo |= ((unsigned)q & 15u) << sh; hi |= ((unsigned)((q + 8) >> 4) & 15u) << sh;
                        xs += q;
                    }
                    XL[j][d] = (int)lo; XH[j][d] = (int)hi;
                }
            xg = 0.5f * (float)xs;
        }
        f16x2 accp[2][16];
#pragma unroll
        for (int j = 0; j < 2; ++j)
#pragma unroll
            for (int c = 0; c < 16; ++c) accp[j][c] = (f16x2){(_Float16)0.f, (_Float16)0.f};
        float wsg = 0.f;
        auto issue = [&](int q) {
            const unsigned voff = ((sIdx[sub * 128 + q] & 0xffffu) << 10) + (unsigned)li * 16u;
            const unsigned dst = ringb + (unsigned)(q & 3) * 4096u;
            glds16s(REC, voff, dst); glds16s(REC + 256, voff, dst + 1024u); glds16s(REC + 512, voff, dst + 2048u); glds16s(REC + 768, voff, dst + 3072u);
        };
        auto compute = [&](int q, bool refill) {
            const char* sl = ring + (q & 3) * 4096;
            const u32x4 du0 = *(const u32x4*)(sl + lane * 16), du1 = *(const u32x4*)(sl + 1024 + lane * 16);
            const u32x4 dv0 = *(const u32x4*)(sl + 2048 + lane * 16), dv1 = *(const u32x4*)(sl + 3072 + lane * 16);
            const float us = (float)__builtin_bit_cast(_Float16, (unsigned short)(sIdx[sub * 128 + q] >> 16));
            const float gt = (float)sGate[sub * 128 + q];
            if (refill) { asm volatile("s_waitcnt lgkmcnt(0)" ::: "memory"); issue(q + 4); }
            int iah = 0, ial = 0;
#pragma unroll
            for (int j = 0; j < 2; ++j) {
#pragma unroll
                for (int d = 0; d < 4; ++d) {
                    const int w = (int)(j ? du1[d] : du0[d]);
                    iah = __builtin_amdgcn_sdot8(w, XH[j][d], iah, false);
                    ial = __builtin_amdgcn_sdot8(w, XL[j][d], ial, false);
                }
            }
            float pa = us * ((float)(16 * iah + ial) + xg);
            pa = row16_sum(pa);
            const float ww = gt * gelu_exact(pa * sx);
            wsg += ww;
            const float wc = fminf(fmaxf(ww * 65536.0f, -65504.0f), 65504.0f);
            const _Float16 wha = (_Float16)wc, whb = (_Float16)(wc * 0.0625f);
            const f16x2 wa = {wha, wha}, wb = {whb, whb};
#pragma unroll
            for (int j = 0; j < 2; ++j) {
#pragma unroll
                for (int d = 0; d < 4; ++d) {
                    const unsigned wv = j ? dv1[d] : dv0[d], wt = wv >> 8;
                    const f16x2 c0 = __builtin_bit_cast(f16x2, wv & 0x000f000fu), c1 = __builtin_bit_cast(f16x2, wv & 0x00f000f0u);
                    const f16x2 c2 = __builtin_bit_cast(f16x2, wt & 0x000f000fu), c3 = __builtin_bit_cast(f16x2, wt & 0x00f000f0u);
                    accp[j][4 * d + 0] = __builtin_elementwise_fma(c0, wa, accp[j][4 * d + 0]); accp[j][4 * d + 1] = __builtin_elementwise_fma(c1, wb, accp[j][4 * d + 1]);
                    accp[j][4 * d + 2] = __builtin_elementwise_fma(c2, wa, accp[j][4 * d + 2]); accp[j][4 * d + 3] = __builtin_elementwise_fma(c3, wb, accp[j][4 * d + 3]);
                }
            }
        };
        asm volatile("s_waitcnt vmcnt(0)" ::: "memory");
        issue(0); issue(1); issue(2); issue(3);
#pragma unroll 1
        for (int q = 0; q < 124; ++q) {
            asm volatile("s_waitcnt vmcnt(12)" ::: "memory");
            compute(q, true);
        }
        asm volatile("s_waitcnt vmcnt(12)" ::: "memory");
        compute(124, false);
        asm volatile("s_waitcnt vmcnt(8)" ::: "memory");
        compute(125, false);
        asm volatile("s_waitcnt vmcnt(4)" ::: "memory");
        compute(126, false);
        asm volatile("s_waitcnt vmcnt(0)" ::: "memory");
        compute(127, false);
        float acc[2][32];
#pragma unroll
        for (int j = 0; j < 2; ++j)
#pragma unroll
            for (int d = 0; d < 4; ++d) {
                acc[j][8 * d + 0] = 256.0f * (float)accp[j][4 * d + 0][0]; acc[j][8 * d + 2] = 256.0f * (float)accp[j][4 * d + 0][1];
                acc[j][8 * d + 4] = 256.0f * (float)accp[j][4 * d + 1][0]; acc[j][8 * d + 6] = 256.0f * (float)accp[j][4 * d + 1][1];
                acc[j][8 * d + 1] = 256.0f * (float)accp[j][4 * d + 2][0]; acc[j][8 * d + 3] = 256.0f * (float)accp[j][4 * d + 2][1];
                acc[j][8 * d + 5] = 256.0f * (float)accp[j][4 * d + 3][0]; acc[j][8 * d + 7] = 256.0f * (float)accp[j][4 * d + 3][1];
            }
        const float wsum = wsg;
        float ss = 0.f;
#pragma unroll
        for (int j = 0; j < 2; ++j)
#pragma unroll
            for (int c8 = 0; c8 < 4; ++c8) {
                const u32x4 b = *(const u32x4*)(S + (size_t)tt * 1024 + (16 * j + li) * 32 + c8 * 8);
#pragma unroll
                for (int c = 0; c < 4; ++c) {
                    float& a0 = acc[j][c8 * 8 + 2 * c]; float& a1 = acc[j][c8 * 8 + 2 * c + 1];
                    a0 = a0 - 7.5f * wsum + lo2f(b[c]); a1 = a1 - 7.5f * wsum + hi2f(b[c]);
                    ss += a0 * a0 + a1 * a1;
                }
            }
        ss = row16_sum(ss);
        const float rstd = rsqrtf(ss * (1.0f / D) + EPS);
#pragma unroll
        for (int j = 0; j < 2; ++j) {
            const int colj = (16 * j + li) * 32;
            if (final_out) {
                float* orow = p.out + (size_t)tt * 1024 + colj; const float* gp = gnext + colj;
#pragma unroll
                for (int c4 = 0; c4 < 8; ++c4) {
                    const f32x4 g = *(const f32x4*)(gp + c4 * 4);
                    *(f32x4*)(orow + c4 * 4) = (f32x4){acc[j][c4 * 4] * rstd * g[0], acc[j][c4 * 4 + 1] * rstd * g[1], acc[j][c4 * 4 + 2] * rstd * g[2], acc[j][c4 * 4 + 3] * rstd * g[3]};
                }
            } else {
                bf16_t* srow = S + (size_t)tt * 1024 + colj;
#pragma unroll
                for (int c8 = 0; c8 < 4; ++c8) {
                    u32x4 sv;
#pragma unroll
                    for (int c = 0; c < 4; ++c) sv[c] = pack2(acc[j][c8 * 8 + 2 * c], acc[j][c8 * 8 + 2 * c + 1]);
                    *(u32x4*)(srow + c8 * 8) = sv;
                }
                unsigned char* e8row = p.ws + OFF_H + ((size_t)32 << 20) + (size_t)tt * 1024 + colj;
#pragma unroll
                for (int c16 = 0; c16 < 2; ++c16) {
                    u32x4 e8;
#pragma unroll
                    for (int c = 0; c < 4; ++c) { const int o = c16 * 16 + 4 * c; int pk = __builtin_amdgcn_cvt_pk_fp8_f32(acc[j][o], acc[j][o + 1], 0, false); pk = __builtin_amdgcn_cvt_pk_fp8_f32(acc[j][o + 2], acc[j][o + 3], pk, true); e8[c] = (unsigned)pk; }
                    *(u32x4*)(e8row + c16 * 16) = e8;
                }
            }
        }
        if (!final_out && li == 0) ((float*)(p.ws + OFF_VSC))[tt] = rstd;
    }
}

#define XB_TMO      128
#define XB_XCNT(j)  (256  + 64 * (j))
#define XB_XSUB(j)  (1280 + 64 * (j))
#define XB_XGEN(j)  (2304 + 64 * (j))
#define XB_TOP      3328
#define XB_TOPGEN   3392
#define XCD_BAR_WORDS 3456
#define XB_SPIN_CAP (1u << 22)
#define LAS __attribute__((address_space(3)))
__device__ __forceinline__ unsigned xb_ld(unsigned* p)              { return __hip_atomic_load(p, __ATOMIC_RELAXED, __HIP_MEMORY_SCOPE_AGENT); }
__device__ __forceinline__ unsigned xb_add(unsigned* p, unsigned v) { return __hip_atomic_fetch_add(p, v, __ATOMIC_RELAXED, __HIP_MEMORY_SCOPE_AGENT); }
__device__ __forceinline__ unsigned xb_xcc_id() { return (unsigned)__builtin_amdgcn_s_getreg((3 << 11) | 20) & 0xFu; }
#define XB_SPIN(cond, bar) do { unsigned _sp = 0; while (cond) { __builtin_amdgcn_s_sleep(1); \
    if ((++_sp & 255u) == 0u) { if (xb_ld(&(bar)[XB_TMO])) break; if (_sp > XB_SPIN_CAP) { atomicAdd(&(bar)[XB_TMO], 1u); break; } } } } while (0)
struct XcdBarrier { unsigned* bar; unsigned x; volatile LAS unsigned* st; };
__device__ __forceinline__ XcdBarrier xcd_barrier_post(unsigned* bar, volatile LAS unsigned* st) {
    XcdBarrier b; b.bar = bar; b.x = xb_xcc_id(); b.st = st;
    if (threadIdx.x == 0) (void)xb_add(&bar[XB_XCNT(b.x)], 1u);
    return b;
}
__device__ __forceinline__ void xcd_barrier_complete(unsigned* bar, unsigned x, unsigned& nloc, unsigned& nx) {
    const unsigned G = gridDim.x * gridDim.y * gridDim.z;
    unsigned sum, cnt, mine, sp = 0u;
    for (;;) {
        sum = 0u; cnt = 0u; mine = 0u;
#pragma unroll
        for (unsigned j = 0; j < 16; ++j) { const unsigned c = xb_ld(&bar[XB_XCNT(j)]); sum += c; cnt += (c > 0u) ? 1u : 0u; mine = (j == x) ? c : mine; }
        if (sum == G) break;
        __builtin_amdgcn_s_sleep(1);
        if ((++sp & 255u) == 0u) { if (xb_ld(&bar[XB_TMO])) break; if (sp > XB_SPIN_CAP) { atomicAdd(&bar[XB_TMO], 1u); break; } }
    }
    nloc = mine > 0u ? mine : 1u; nx = cnt > 0u ? cnt : 1u;
}
__device__ __forceinline__ void xcd_barrier(const XcdBarrier& b) {
    asm volatile("s_waitcnt vmcnt(0)" ::: "memory");
    __syncthreads();
    if (threadIdx.x == 0) {
        unsigned* bar = b.bar;
        __builtin_amdgcn_s_waitcnt(0);
        unsigned nloc = b.st[0], nx = b.st[1];
        if (nloc == 0u) { xcd_barrier_complete(bar, b.x, nloc, nx); b.st[0] = nloc; b.st[1] = nx; }
        const unsigned old = xb_add(&bar[XB_XSUB(b.x)], 1u);
        const unsigned gen = old / nloc;
        if (old + 1u == (gen + 1u) * nloc) {
            __builtin_amdgcn_fence(__ATOMIC_RELEASE, "agent");
            asm volatile("s_waitcnt vmcnt(0)" ::: "memory");
            const unsigned og = xb_add(&bar[XB_TOP], 1u);
            const unsigned tg = og / nx;
            if (og + 1u == (tg + 1u) * nx) xb_add(&bar[XB_TOPGEN], 1u);
            else XB_SPIN(xb_ld(&bar[XB_TOPGEN]) == tg, bar);
            __builtin_amdgcn_fence(__ATOMIC_ACQUIRE, "agent");
            xb_add(&bar[XB_XGEN(b.x)], 1u);
            asm volatile("s_waitcnt vmcnt(0)" ::: "memory");
        } else {
            XB_SPIN(xb_ld(&bar[XB_XGEN(b.x)]) == gen, bar);
            __builtin_amdgcn_fence(__ATOMIC_ACQUIRE, "agent");
            asm volatile("s_waitcnt vmcnt(0)" ::: "memory");
        }
    }
    __syncthreads();
}

constexpr int NPHASE = 12;
__global__ void __launch_bounds__(512, 2) mega(Params p, int ph_lo, int ph_hi) {
    extern __shared__ __attribute__((aligned(16))) char smem_phys[];
    uint4& xb_words = *(uint4*)(smem_phys + kDynLds - 16);
    if (threadIdx.x == 0) xb_words = make_uint4(0u, 0u, 0u, 0u);
    __syncthreads();
    const XcdBarrier xbar = xcd_barrier_post((unsigned*)(p.ws + OFF_BAR), (volatile LAS unsigned*)&xb_words);
    char* smem = smem_phys + (threadIdx.x >> 8) * 65536;
    bf16_t* Rg = (bf16_t*)(p.ws + OFF_REGION);
    bf16_t* Hb = (bf16_t*)(p.ws + OFF_H);
#define PHASE(k, ...) if (ph_lo <= (k) && (k) < ph_hi) { __VA_ARGS__; if ((k) + 1 < ph_hi) xcd_barrier(xbar); }
    unsigned* sbctr = (unsigned*)(p.ws + OFF_BAR + 14336);
    PHASE(0,
        transpose_convert<true>(p.ab_w_in, (bf16_t*)(p.ws + OFF_WT_IN), 1024, AB_IN, AB_IN_PAD, smem, 0, p.norm_mix);
        convert_rows(p.x, (bf16_t*)(p.ws + OFF_S), (float*)(p.ws + OFF_VSC), smem))
    PHASE(1, phase_gemm_in8(p, smem_phys))
    PHASE(2, gla_prep(p, smem))
    PHASE(3, gla_scan(p, smem); sb_fast(p, smem_phys + 98304, sbctr);
        __syncthreads();
        quantize_tables_static(p, 64, smem);
        __syncthreads();
        transpose_convert(p.ab_w_out, (bf16_t*)(p.ws + OFF_WT_OUT), 1024, 1024, 1024, smem, 64);
        transpose_convert(p.c_w_in, (bf16_t*)(p.ws + OFF_WT_CIN), 1024, 4096, 4096, smem, 64, p.norm_mix + 1024, p.ws + OFF_SK_W8, 2048);
        transpose_convert(p.c_w_out, (bf16_t*)(p.ws + OFF_WT_COUT), 2048, 1024, 1024, smem, 64);
        fold_query_weights(p, 64))
    PHASE(4, phase_gemm_resid8(Rg + R_QSB, Rg + R_GG, 512, 512, (const bf16_t*)(p.ws + OFF_WT_OUT), 1024, nullptr, (bf16_t*)(p.ws + OFF_S), (float*)(p.ws + OFF_SSQ), p.ws + OFF_H, smem_phys))
    PHASE(5, phase_select8(p, 0, smem_phys))
    PHASE(6, peer_gather(p, 0, p.norm_mix + 1024, false, smem_phys))
    PHASE(7, phase_gemm_cin8_v(p, smem_phys))
    PHASE(8, phase_gemm_cin8_u(p, smem_phys))
    PHASE(9, phase_gemm_resid8(Rg, Rg, 2048, 2048, (const bf16_t*)(p.ws + OFF_WT_COUT), 2048, nullptr, (bf16_t*)(p.ws + OFF_S), (float*)(p.ws + OFF_SSQ), p.ws + OFF_H, smem_phys))
    PHASE(10, phase_select8(p, 1, smem_phys))
    PHASE(11, peer_gather(p, 1, p.final_norm, true, smem_phys))
}

extern "C" void kernel_launch(void* const* d_in, const int* in_sizes, int n_in, void* d_out, int out_size, void* d_ws, size_t ws_size, hipStream_t stream) {
    static int grid_blocks = 0;
    if (!grid_blocks) {
        int dev = 0, cus = 0, per_cu = 0;
        hipGetDevice(&dev);
        hipDeviceGetAttribute(&cus, hipDeviceAttributeMultiprocessorCount, dev);
        hipFuncSetAttribute((const void*)mega, hipFuncAttributeMaxDynamicSharedMemorySize, kDynLds);
        hipOccupancyMaxActiveBlocksPerMultiprocessor(&per_cu, mega, 512, kDynLds);
        if (per_cu < 1) per_cu = 1;
        if (per_cu > 1) per_cu = 1;
        grid_blocks = cus * per_cu;
        if (n_in != 18 || ws_size < WS_END) fprintf(stderr, "kernel_launch: unexpected n_in %d or ws_size %zu < %zu\n", n_in, ws_size, (size_t)WS_END);
    }
    Params p{};
    p.x = (const float*)d_in[0]; p.norm_mix = (const float*)d_in[1]; p.norm_ffn = (const float*)d_in[2]; p.ab_w_in = (const float*)d_in[3];
    p.ab_w_alpha2 = (const float*)d_in[4]; p.ab_b_alpha2 = (const float*)d_in[5]; p.ab_gla_norm = (const float*)d_in[6]; p.ab_w_out = (const float*)d_in[7];
    p.c_w_in = (const float*)d_in[8]; p.c_v_norm = (const float*)d_in[9]; p.c_w_spatial = (const float*)d_in[10]; p.c_b_spatial = (const float*)d_in[11];
    p.c_w_out = (const float*)d_in[12]; p.peer_w_q = (const float*)d_in[13]; p.peer_subkeys = (const float*)d_in[14]; p.peer_u = (const float*)d_in[15];
    p.peer_v = (const float*)d_in[16]; p.final_norm = (const float*)d_in[17];
    p.out = (float*)d_out; p.ws = (unsigned char*)d_ws;
    (void)hipMemsetAsync((char*)d_ws + OFF_BAR, 0, 16384, stream);
#if ONE_LAUNCH
    int lo = 0, hi = NPHASE;
    void* args[] = {&p, &lo, &hi};
    hipError_t e = hipLaunchCooperativeKernel((void*)mega, dim3(grid_blocks), dim3(512), args, kDynLds, stream);
    if (e != hipSuccess) fprintf(stderr, "cooperative launch failed: %s (grid %d)\n", hipGetErrorString(e), grid_blocks);
#else
    for (int ph = 0; ph < NPHASE; ++ph) hipLaunchKernelGGL(mega, dim3(grid_blocks), dim3(512), kDynLds, stream, p, ph, ph + 1);
#endif
}
```
